# Optimizing an MI355X kernel written in HIP

```python
import jax, jax.numpy as jnp
from jax import lax
import numpy as np

D_MODEL = 1024
BATCH = 2
SEQ = 8192
DEPTH = 4
DEC_BATCH = 32
DEC_SEQ = 1
PAST_LEN = 8192
PAGE_SIZE = 128

HEAD_DIM = 64
N_ATT_HEADS = D_MODEL // (2 * HEAD_DIM)
N_RWKV_HEADS = D_MODEL // HEAD_DIM - N_ATT_HEADS
ATT_W = N_ATT_HEADS * HEAD_DIM
RWKV_W = N_RWKV_HEADS * HEAD_DIM
LORA_DECAY = 64
LORA_ICLR = 64
LORA_GATE = 128
LORA_VRES = 32
ATT_COLS = 3 * ATT_W
RWKV_COLS = 3 * RWKV_W + LORA_DECAY + LORA_ICLR + LORA_GATE
DILATED_PATTERNS = ((128, 1), (512, 4), (2048, 16))
WINDOW_MAX = max(w for w, _ in DILATED_PATTERNS)
BAND_BLOCK = 128
ROPE_THETA = 10000.0
D_FF = 4 * D_MODEL
DEEPNORM_ALPHA = (2.0 * DEPTH) ** 0.25
DEEPNORM_BETA = (8.0 * DEPTH) ** -0.25
LN_EPS = 1e-5
GN_EPS = 64e-5
RMS_EPS = 1e-6
F32 = jnp.float32

kernel_name = "hymba_rwkv7_dilated_swa_deepnorm_step"


def layer_norm(x, g, b):
    xf = x.astype(F32)
    mu = xf.mean(-1, keepdims=True)
    var = jnp.square(xf - mu).mean(-1, keepdims=True)
    return ((xf - mu) * lax.rsqrt(var + LN_EPS) * g.astype(F32) + b.astype(F32)).astype(x.dtype)


def rope(x, pos):
    half = HEAD_DIM // 2
    inv = ROPE_THETA ** (-jnp.arange(half, dtype=F32) * (2.0 / HEAD_DIM))
    ang = pos.astype(F32)[:, None] * inv[None, :]
    cos = jnp.cos(ang)[None, :, None, :]
    sin = jnp.sin(ang)[None, :, None, :]
    xf = x.astype(F32)
    x1, x2 = xf[..., :half], xf[..., half:]
    return jnp.concatenate([x1 * cos - x2 * sin, x1 * sin + x2 * cos], -1).astype(x.dtype)


def combine_dilations(outs, lses):
    wts = jax.nn.softmax(jnp.stack(lses, 0), axis=0)
    return jnp.einsum('pbth,pbthd->bthd', wts, jnp.stack(outs, 0))


def dilated_band_attention(q, k, v, dilation, n_back):
    B, T, H, Dh = q.shape
    span = dilation * BAND_BLOCK
    Tp = -(-T // span) * span
    M = Tp // dilation
    nb = M // BAND_BLOCK

    def to_blocks(a):
        a = jnp.pad(a, ((0, 0), (0, Tp - T), (0, 0), (0, 0)))
        a = a.reshape(B, M, dilation, H, Dh).transpose(0, 2, 1, 3, 4)
        return a.reshape(B, dilation, nb, BAND_BLOCK, H, Dh)

    def with_prev(a):
        prev = jnp.pad(a[:, :, :-1], ((0, 0), (0, 0), (1, 0), (0, 0), (0, 0), (0, 0)))
        return jnp.concatenate([prev, a], axis=3)

    qb = to_blocks(q)
    kb = with_prev(to_blocks(k))
    vb = with_prev(to_blocks(v))
    s = jnp.einsum('brnqhd,brnkhd->brnhqk', qb, kb, preferred_element_type=F32) * (HEAD_DIM ** -0.5)
    qi = jnp.arange(BAND_BLOCK)
    ki = jnp.arange(2 * BAND_BLOCK) - BAND_BLOCK
    dist = qi[:, None] - ki[None, :]
    key_m = jnp.arange(nb)[:, None] * BAND_BLOCK + ki[None, :]
    valid = ((dist >= 0) & (dist <= n_back))[None] & (key_m >= 0)[:, None, :]
    s = jnp.where(valid[None, None, :, None], s, -jnp.inf)
    mx = s.max(-1, keepdims=True)
    e = jnp.exp(s - mx)
    den = e.sum(-1, keepdims=True)
    o = jnp.einsum('brnhqk,brnkhd->brnhqd', e, vb.astype(F32)) / den
    lse = (mx + jnp.log(den))[..., 0]
    o = o.transpose(0, 1, 2, 4, 3, 5).reshape(B, dilation, M, H, Dh)
    o = o.transpose(0, 2, 1, 3, 4).reshape(B, Tp, H, Dh)[:, :T]
    lse = lse.transpose(0, 1, 2, 4, 3).reshape(B, dilation, M, H)
    lse = lse.transpose(0, 2, 1, 3).reshape(B, Tp, H)[:, :T]
    return o, lse


def dilated_attention_prompt(q, k, v):
    outs, lses = [], []
    for window, dilation in DILATED_PATTERNS:
        o, l = dilated_band_attention(q, k, v, dilation, window // dilation)
        outs.append(o)
        lses.append(l)
    return combine_dilations(outs, lses)


def dilated_attention_decode(q, k_new, v_new, k_buf, v_buf):
    L = k_buf.shape[1]
    S = q.shape[1]
    k_ext = jnp.concatenate([k_buf.astype(k_new.dtype), k_new], axis=1)
    v_ext = jnp.concatenate([v_buf.astype(v_new.dtype), v_new], axis=1)
    outs, lses = [], []
    for window, dilation in DILATED_PATTERNS:
        offs = jnp.arange(window // dilation + 1) * dilation
        idx = L + jnp.arange(S)[:, None] - offs[None, :]
        valid = idx >= 0
        idx = jnp.maximum(idx, 0)
        kg = jnp.take(k_ext, idx, axis=1)
        vg = jnp.take(v_ext, idx, axis=1)
        s = jnp.einsum('bshd,bsjhd->bshj', q, kg, preferred_element_type=F32) * (HEAD_DIM ** -0.5)
        s = jnp.where(valid[None, :, None, :], s, -jnp.inf)
        mx = s.max(-1, keepdims=True)
        e = jnp.exp(s - mx)
        den = e.sum(-1, keepdims=True)
        outs.append(jnp.einsum('bshj,bsjhd->bshd', e, vg.astype(F32)) / den)
        lses.append((mx + jnp.log(den))[..., 0])
    return combine_dilations(outs, lses)


def token_shift(p, p_prev0, mu):
    prev = jnp.concatenate([p_prev0[:, None], p[:, :-1]], axis=1)
    return p + (prev - p) * mu


def rwkv7_time_mix(z, v_first, wkv0, lp):
    B, T, _ = z.shape
    H, N = N_RWKV_HEADS, HEAD_DIM
    z = z.astype(F32)
    r = z[..., :RWKV_W]
    k = z[..., RWKV_W:2 * RWKV_W]
    v = z[..., 2 * RWKV_W:3 * RWKV_W]
    o = 3 * RWKV_W
    w_lo = z[..., o:o + LORA_DECAY]
    o += LORA_DECAY
    a_lo = z[..., o:o + LORA_ICLR]
    o += LORA_ICLR
    g_lo = z[..., o:o + LORA_GATE]
    w = -jax.nn.softplus(-(lp['decay_base'].astype(F32) + jnp.tanh(w_lo) @ lp['decay_up'].astype(F32))) - 0.5
    decay = jnp.exp(-jnp.exp(w))
    a = jax.nn.sigmoid(lp['iclr_base'].astype(F32) + a_lo @ lp['iclr_up'].astype(F32))
    g = jax.nn.sigmoid(g_lo) @ lp['gate_up'].astype(F32)
    if v_first is None:
        v_first = v
    else:
        vres_lo = z[..., RWKV_COLS:]
        v = v + (v_first - v) * jax.nn.sigmoid(lp['vres_base'].astype(F32) + vres_lo @ lp['vres_up'].astype(F32))
    kk = (k * lp['key_scale_k'].astype(F32)).reshape(B, T, H, N)
    kk = kk / jnp.maximum(jnp.sqrt(jnp.sum(kk * kk, -1, keepdims=True)), 1e-12)
    k = k * (1.0 + (a - 1.0) * lp['key_scale_a'].astype(F32))
    rh, kh, vh = (t.reshape(B, T, H, N) for t in (r, k, v))
    dh, ah = decay.reshape(B, T, H, N), a.reshape(B, T, H, N)

    def step(S, inp):
        r_t, w_t, k_t, v_t, a_t, b_t = inp
        sa = jnp.einsum('bhvk,bhk->bhv', S, a_t)
        S = S * w_t[:, :, None, :] + sa[..., None] * b_t[:, :, None, :] + v_t[..., None] * k_t[:, :, None, :]
        return S, jnp.einsum('bhvk,bhk->bhv', S, r_t)

    xs = tuple(jnp.moveaxis(t, 1, 0) for t in (rh, dh, kh, vh, -kk, kk * ah))
    S_T, y = lax.scan(step, wkv0.astype(F32), xs)
    y = jnp.moveaxis(y, 0, 1)
    mu = y.mean(-1, keepdims=True)
    var = jnp.square(y - mu).mean(-1, keepdims=True)
    y = ((y - mu) * lax.rsqrt(var + GN_EPS)).reshape(B, T, RWKV_W)
    y = y * lp['gn_g'].astype(F32) + lp['gn_b'].astype(F32)
    bonus = jnp.sum(rh * kh * lp['bonus_rk'].astype(F32).reshape(H, N), -1, keepdims=True) * vh
    y = (y + bonus.reshape(B, T, RWKV_W)) * g
    return y, v_first, S_T


def hybrid_layer(x, pos, x_prev, wkv0, kv_buf, v_first, lp):
    B, T, _ = x.shape
    w_comb = lp['w_in']
    p = x @ w_comb
    q = p[..., :ATT_W].reshape(B, T, N_ATT_HEADS, HEAD_DIM)
    k = p[..., ATT_W:2 * ATT_W].reshape(B, T, N_ATT_HEADS, HEAD_DIM)
    v = p[..., 2 * ATT_W:ATT_COLS].reshape(B, T, N_ATT_HEADS, HEAD_DIM)
    q, k = rope(q, pos), rope(k, pos)
    if kv_buf is None:
        att = dilated_attention_prompt(q, k, v)
    else:
        att = dilated_attention_decode(q, k, v, kv_buf[0], kv_buf[1])
    att = att.reshape(B, T, ATT_W)
    att = att * lax.rsqrt(jnp.mean(jnp.square(att), -1, keepdims=True) + RMS_EPS) * lp['att_gain'].astype(F32)
    pr = p[..., ATT_COLS:]
    if x_prev is None:
        prev0 = jnp.zeros((B, pr.shape[-1]), pr.dtype)
    else:
        prev0 = x_prev.astype(x.dtype) @ w_comb[:, ATT_COLS:]
    z = token_shift(pr, prev0, lp['shift_mu'])
    rw, v_first, S_T = rwkv7_time_mix(z, v_first, wkv0, lp)
    mix = jnp.concatenate([att.astype(x.dtype), rw.astype(x.dtype)], -1) @ lp['w_out']
    x1 = layer_norm(DEEPNORM_ALPHA * x + mix, lp['ln1_g'], lp['ln1_b'])
    h = jnp.square(jax.nn.relu(x1 @ lp['w_ff_up'])) @ lp['w_ff_down']
    y = layer_norm(DEEPNORM_ALPHA * x1 + h, lp['ln2_g'], lp['ln2_b'])
    return y, x[:, -1], S_T, k, v, v_first


def setup_inputs(seed: int = 0) -> dict:
    key = jax.random.key(seed)
    ks = iter(jax.random.split(key, 40))

    def nrm(shape, scale):
        return jax.random.normal(next(ks), shape, F32) * scale

    def unif(shape, lo, hi):
        return jax.random.uniform(next(ks), shape, F32, lo, hi)

    kv_len = min(WINDOW_MAX, PAST_LEN)
    p_main = ATT_COLS + RWKV_COLS
    return {
        "x_prompt": nrm((BATCH, SEQ, D_MODEL), 1.0),
        "x_sample": nrm((DEC_BATCH, DEC_SEQ, D_MODEL), 1.0),
        "state_shift": nrm((DEPTH, DEC_BATCH, D_MODEL), 1.0),
        "state_wkv": nrm((DEPTH, DEC_BATCH, N_RWKV_HEADS, HEAD_DIM, HEAD_DIM), 0.5),
        "cache_k": nrm((DEPTH, DEC_BATCH, kv_len, N_ATT_HEADS, HEAD_DIM), 1.0),
        "cache_v": nrm((DEPTH, DEC_BATCH, kv_len, N_ATT_HEADS, HEAD_DIM), 1.0),
        "w_in": nrm((DEPTH, D_MODEL, p_main), D_MODEL ** -0.5),
        "w_vres_in": nrm((DEPTH - 1, D_MODEL, LORA_VRES), D_MODEL ** -0.5),
        "shift_mu": unif((DEPTH, RWKV_COLS), 0.1, 0.9),
        "vres_mu": unif((DEPTH - 1, LORA_VRES), 0.1, 0.9),
        "decay_base": unif((DEPTH, RWKV_W), -6.0, 0.0),
        "decay_up": nrm((DEPTH, LORA_DECAY, RWKV_W), 0.05),
        "iclr_base": nrm((DEPTH, RWKV_W), 0.2),
        "iclr_up": nrm((DEPTH, LORA_ICLR, RWKV_W), 0.5 * LORA_ICLR ** -0.5),
        "gate_up": nrm((DEPTH, LORA_GATE, RWKV_W), LORA_GATE ** -0.5),
        "vres_base": 1.0 + nrm((DEPTH - 1, RWKV_W), 0.1),
        "vres_up": nrm((DEPTH - 1, LORA_VRES, RWKV_W), 0.1),
        "key_scale_k": 0.85 + nrm((DEPTH, RWKV_W), 0.05),
        "key_scale_a": 1.0 + nrm((DEPTH, RWKV_W), 0.05),
        "bonus_rk": nrm((DEPTH, RWKV_W), 0.1),
        "gn_g": 1.0 + nrm((DEPTH, RWKV_W), 0.05),
        "gn_b": nrm((DEPTH, RWKV_W), 0.02),
        "att_gain": 1.0 + nrm((DEPTH, ATT_W), 0.05),
        "w_out": nrm((DEPTH, D_MODEL, D_MODEL), DEEPNORM_BETA * D_MODEL ** -0.5),
        "ln1_g": 1.0 + nrm((DEPTH, D_MODEL), 0.05),
        "ln1_b": nrm((DEPTH, D_MODEL), 0.02),
        "w_ff_up": nrm((DEPTH, D_MODEL, D_FF), D_MODEL ** -0.5),
        "w_ff_down": nrm((DEPTH, D_FF, D_MODEL), DEEPNORM_BETA * D_FF ** -0.5),
        "ln2_g": 1.0 + nrm((DEPTH, D_MODEL), 0.05),
        "ln2_b": nrm((DEPTH, D_MODEL), 0.02),
    }


def reference(x_prompt, x_sample, state_shift, state_wkv, cache_k, cache_v, w_in, w_vres_in, shift_mu,
              vres_mu, decay_base, decay_up, iclr_base, iclr_up, gate_up, vres_base, vres_up, key_scale_k,
              key_scale_a, bonus_rk, gn_g, gn_b, att_gain, w_out, ln1_g, ln1_b, w_ff_up, w_ff_down, ln2_g,
              ln2_b):
    T_p = x_prompt.shape[1]
    pos_prompt = jnp.arange(T_p)
    pos_sample = PAST_LEN + jnp.arange(x_sample.shape[1])
    keep = min(WINDOW_MAX, T_p)
    wkv_zero = jnp.zeros((x_prompt.shape[0], N_RWKV_HEADS, HEAD_DIM, HEAD_DIM), F32)
    hp, hs = x_prompt, x_sample
    vf_p, vf_s = None, None
    shift_p, shift_s, wkv_p, wkv_s, kp_l, vp_l, ks_l, vs_l = [], [], [], [], [], [], [], []
    for l in range(DEPTH):
        lp = dict(w_in=w_in[l], shift_mu=shift_mu[l], decay_base=decay_base[l], decay_up=decay_up[l],
                  iclr_base=iclr_base[l], iclr_up=iclr_up[l], gate_up=gate_up[l],
                  key_scale_k=key_scale_k[l], key_scale_a=key_scale_a[l], bonus_rk=bonus_rk[l],
                  gn_g=gn_g[l], gn_b=gn_b[l], att_gain=att_gain[l], w_out=w_out[l],
                  ln1_g=ln1_g[l], ln1_b=ln1_b[l], w_ff_up=w_ff_up[l], w_ff_down=w_ff_down[l],
                  ln2_g=ln2_g[l], ln2_b=ln2_b[l])
        if l > 0:
            lp['w_in'] = jnp.concatenate([w_in[l], w_vres_in[l - 1]], axis=1)
            lp['shift_mu'] = jnp.concatenate([shift_mu[l], vres_mu[l - 1]], axis=0)
            lp['vres_base'] = vres_base[l - 1]
            lp['vres_up'] = vres_up[l - 1]
        hp, sp, Sp, kp, vp, vf_p = hybrid_layer(hp, pos_prompt, None, wkv_zero, None, vf_p, lp)
        hs, ss, Ss, kss, vss, vf_s = hybrid_layer(hs, pos_sample, state_shift[l], state_wkv[l],
                                                  (cache_k[l], cache_v[l]), vf_s, lp)
        shift_p.append(sp)
        shift_s.append(ss)
        wkv_p.append(Sp)
        wkv_s.append(Ss)
        kp_l.append(kp[:, T_p - keep:])
        vp_l.append(vp[:, T_p - keep:])
        ks_l.append(kss)
        vs_l.append(vss)
    return (hp, hs, jnp.stack(shift_p), jnp.stack(shift_s), jnp.stack(wkv_p), jnp.stack(wkv_s),
            jnp.stack(kp_l), jnp.stack(vp_l), jnp.stack(ks_l), jnp.stack(vs_l))
```

```cpp
#include <hip/hip_runtime.h>
#include <cstdio>
#include <cstdint>
#include <cmath>
namespace pg8 {
#define PG8_LAS __attribute__((address_space(3)))
typedef unsigned short bf16_t;
typedef short bf16x8 __attribute__((ext_vector_type(8)));
typedef float f32x4 __attribute__((ext_vector_type(4)));
typedef unsigned u32x4 __attribute__((ext_vector_type(4)));
constexpr int BM = 256, BK = 64, HALF = 128, HTB = HALF * BK * 2  , STAGE_BYTES = 8 * HTB, NXCD = 8, WGM = 8;

__host__ __device__ __forceinline__ int lds_byte(int r, int c) { const int st = (r >> 4) * 2 + (c >> 5), rr = r & 15, cc = c & 31, ob = rr * 64 + cc * 2; return st * 1024 + (ob ^ (((ob >> 9) & 1) << 5)); }
__host__ __device__ __forceinline__ void stage_rc(int b, int& R, int& C) { const int st = b / 1024, sb = b % 1024, swz = sb ^ (((sb >> 9) & 1) << 5); R = (st >> 1) * 16 + swz / 64; C = (st & 1) * 32 + (swz % 64) / 2; }
__host__ __device__ __forceinline__ int perm32(int rho) { const int n = rho >> 4, i = rho & 15; return 8 * (i >> 2) + 4 * n + (i & 3); }

struct Unit { int pm, pn; };
struct Gemm { const bf16_t* A; const bf16_t* Bt; int M, N, K; };

struct StaticOrder {
    int nM, nN, nwg, G, c;
    __host__ __device__ void init(int M, int N, int G_, int c_) { nM = M / BM; nN = N / BM; nwg = nM * nN; G = G_; c = c_; }
    __host__ __device__ bool next(int i, Unit& u) const {
        const long L = (long)i * G + c; if (L >= nwg) return false;
        int wgid = (int)L; { const int q = nwg / NXCD, r = nwg % NXCD, xcd = wgid % NXCD, off = wgid / NXCD; wgid = (xcd < r ? xcd * (q + 1) : r * (q + 1) + (xcd - r) * q) + off; }
        const int nig = WGM * nN, gid = wgid / nig, fm = gid * WGM, gsz = (nM - fm) < WGM ? (nM - fm) : WGM;
        u.pm = fm + ((wgid % nig) % gsz); u.pn = (wgid % nig) / gsz; return true;
    }
    __device__ __forceinline__ void a_ready(const Unit&) const {}
    __device__ __forceinline__ void done(const Unit&) const {}
};

__device__ __forceinline__ unsigned cvt_pk_bf16(float lo, float hi) { unsigned r; asm volatile("v_cvt_pk_bf16_f32 %0, %1, %2" : "=v"(r) : "v"(lo), "v"(hi)); return r; }
typedef float f32x2 __attribute__((ext_vector_type(2)));
constexpr size_t WSO_C1IN = 1u << 20, WSO_C2IN = WSO_C1IN + 4 * 3584 * 4, WSO_C1UP = WSO_C2IN + 4 * 3584 * 4, WSO_C2UP = WSO_C1UP + 4 * 4096 * 4, WSO_ROPE = 3u << 20, WSO_STAT1 = 8u << 20, WSO_STAT2 = 9u << 20;
constexpr size_t WSO_XB2 = 132ull << 20, WSO_XB1 = 164ull << 20, WSO_T1 = 196ull << 20, WSO_T2 = 260ull << 20, WSO_QB = 324ull << 20, WSO_KB = 340ull << 20, WSO_VB = 356ull << 20, WSO_PR = 372ull << 20, WSO_H = 580ull << 20;
constexpr size_t OO_SHP = 16809984, OO_KP = 21405696, OO_VP = 29794304;
__device__ __forceinline__ void row_stats(const float* stat, int row, float& mu, float& rs) {
    const f32x4 a = *(const f32x4*)(stat + (size_t)row * 8), b = *(const f32x4*)(stat + (size_t)row * 8 + 4);
    const float s = (a[0] + a[2]) + (b[0] + b[2]), q = (a[1] + a[3]) + (b[1] + b[3]);
    mu = s * (1.f / 1024.f); const float var = fmaxf(q * (1.f / 1024.f) - mu * mu, 0.f); rs = 1.0f / sqrtf(var + 1e-5f);
}
typedef float f32x2e __attribute__((ext_vector_type(2)));
typedef unsigned u32x2e __attribute__((ext_vector_type(2)));
struct EpiIn {
    static constexpr bool PERM = false, AFTER_DRAIN = false;
    unsigned char* ws; float* out; int l;
    __device__ __forceinline__ void operator()(const f32x4 (&acc)[2][2][4][2], const Unit& u, int wr, int wc, int fr, int fq) const {
        const int fold = l > 0; const float* stat = (const float*)(ws + WSO_STAT2); const float* c1 = (const float*)(ws + WSO_C1IN) + l * 3584; const float* c2 = (const float*)(ws + WSO_C2IN) + l * 3584;
        bf16_t* QB = (bf16_t*)(ws + WSO_QB); bf16_t* KB = (bf16_t*)(ws + WSO_KB); bf16_t* VB = (bf16_t*)(ws + WSO_VB); bf16_t* PR = (bf16_t*)(ws + WSO_PR); const float* rope = (const float*)(ws + WSO_ROPE);
        float* outk = out + OO_KP + (size_t)l * 2 * 2048 * 512; float* outv = out + OO_VP + (size_t)l * 2 * 2048 * 512; const float qscale = 0.125f * 1.4426950408889634f;
        const int cb = u.pn * BM + wc * 32 + 4 * fq;
#pragma unroll
        for (int ai = 0; ai < 2; ++ai)
#pragma unroll
            for (int m = 0; m < 4; ++m) {
                const int r = u.pm * BM + ai * HALF + wr * 64 + m * 16 + fr;
                float mu = 0.f, rs = 1.f; if (fold) row_stats(stat, r, mu, rs);
                f32x4 v[2][2];
#pragma unroll
                for (int bj = 0; bj < 2; ++bj)
#pragma unroll
                    for (int n = 0; n < 2; ++n) { v[bj][n] = acc[ai][bj][m][n]; if (fold) v[bj][n] = (v[bj][n] - mu * *(const f32x4*)(c1 + cb + bj * HALF + n * 16)) * rs + *(const f32x4*)(c2 + cb + bj * HALF + n * 16); }
                const int pos = r & 8191, b = r >> 13;
                if (u.pn < 4) {
                    const int i0 = 16 * (wc & 1) + 4 * fq;
                    const f32x4 ra = *(const f32x4*)(rope + ((size_t)pos * 32 + i0) * 2), rb = *(const f32x4*)(rope + ((size_t)pos * 32 + i0) * 2 + 4);
                    const f32x4 cs = {ra[0], ra[2], rb[0], rb[2]}, sn = {ra[1], ra[3], rb[1], rb[3]};
#pragma unroll
                    for (int bj = 0; bj < 2; ++bj) {
                        const int head = (u.pn & 1) * 4 + bj * 2 + (wc >> 1);
                        f32x4 y1 = v[bj][0] * cs - v[bj][1] * sn, y2 = v[bj][0] * sn + v[bj][1] * cs;
                        const size_t o = (size_t)r * 512 + head * 64 + i0;
                        if (u.pn < 2) { y1 = y1 * qscale; y2 = y2 * qscale;
                            u32x2e w; w.x = cvt_pk_bf16(y1[0], y1[1]); w.y = cvt_pk_bf16(y1[2], y1[3]); *(u32x2e*)(QB + o) = w;
                            w.x = cvt_pk_bf16(y2[0], y2[1]); w.y = cvt_pk_bf16(y2[2], y2[3]); *(u32x2e*)(QB + o + 32) = w;
                        } else {
                            u32x2e w; w.x = cvt_pk_bf16(y1[0], y1[1]); w.y = cvt_pk_bf16(y1[2], y1[3]); *(u32x2e*)(KB + o) = w;
                            w.x = cvt_pk_bf16(y2[0], y2[1]); w.y = cvt_pk_bf16(y2[2], y2[3]); *(u32x2e*)(KB + o + 32) = w;
                            if (pos >= 6144) { float* ok = outk + ((size_t)(b * 2048 + pos - 6144)) * 512 + head * 64 + i0; *(f32x4*)ok = y1; *(f32x4*)(ok + 32) = y2; }
                        }
                    }
                } else if (u.pn < 6) {
#pragma unroll
                    for (int bj = 0; bj < 2; ++bj)
#pragma unroll
                        for (int n = 0; n < 2; ++n) { const int c = cb + bj * HALF + n * 16 - 1024; const f32x4 x = v[bj][n];
                            u32x2e w; w.x = cvt_pk_bf16(x[0], x[1]); w.y = cvt_pk_bf16(x[2], x[3]); *(u32x2e*)(VB + (size_t)r * 512 + c) = w;
                            if (pos >= 6144) *(f32x4*)(outv + ((size_t)(b * 2048 + pos - 6144)) * 512 + c) = x; }
                } else {
#pragma unroll
                    for (int bj = 0; bj < 2; ++bj)
#pragma unroll
                        for (int n = 0; n < 2; ++n) { const int c = cb + bj * HALF + n * 16 - 1536; const f32x4 x = v[bj][n];
                            if (c < 1824) { u32x2e w; w.x = cvt_pk_bf16(x[0], x[1]); w.y = cvt_pk_bf16(x[2], x[3]); *(u32x2e*)(PR + (size_t)r * 2048 + c) = w; } }
                }
                asm volatile("" ::: "memory");
            }
    }
};
template <bool IS_F> struct EpiRes {
    static constexpr bool PERM = false, AFTER_DRAIN = true;
    unsigned char* ws; const float* const* in; float* out; int l;
    __device__ __forceinline__ void fused(f32x4 (&acc)[2][2][4][2], const Unit& u, int wr, int wc, int fr, int fq, PG8_LAS unsigned char* lds, int wid, int lane) const {
        const int raw = (!IS_F && l == 0) ? 1 : 0;
        const float* src = IS_F ? (const float*)(ws + WSO_T1) : (l == 0 ? in[0] : (const float*)(ws + WSO_T2));
        const float* sstat = (const float*)(ws + (IS_F ? WSO_STAT1 : WSO_STAT2));
        const float* g = IS_F ? in[24] + (size_t)l * 1024 : in[28] + (size_t)(l > 0 ? l - 1 : 0) * 1024; const float* b = IS_F ? in[25] + (size_t)l * 1024 : in[29] + (size_t)(l > 0 ? l - 1 : 0) * 1024;
        float* T = (float*)(ws + (IS_F ? WSO_T2 : WSO_T1)); bf16_t* XB = (bf16_t*)(ws + (IS_F ? WSO_XB2 : WSO_XB1)); float* ostat = (float*)(ws + (IS_F ? WSO_STAT2 : WSO_STAT1));
        float* shiftout = IS_F ? nullptr : out + OO_SHP + (size_t)l * 2 * 1024; const float alpha = 1.6817928305074290f;
        PG8_LAS f32x2e* P = (PG8_LAS f32x2e*)lds;
        const int cb = u.pn * BM + wc * 32 + 4 * fq;
        f32x4 gv[2][2], bv[2][2];
#pragma unroll
        for (int bj = 0; bj < 2; ++bj)
#pragma unroll
            for (int n = 0; n < 2; ++n) { gv[bj][n] = raw ? (f32x4){1.f, 1.f, 1.f, 1.f} : *(const f32x4*)(g + cb + bj * HALF + n * 16); bv[bj][n] = raw ? (f32x4){0.f, 0.f, 0.f, 0.f} : *(const f32x4*)(b + cb + bj * HALF + n * 16); }
#pragma unroll
        for (int ai = 0; ai < 2; ++ai)
#pragma unroll
            for (int m = 0; m < 4; ++m) {
                const int r = u.pm * BM + ai * HALF + wr * 64 + m * 16 + fr;
                float mu = 0.f, rs = 1.f; if (!raw) row_stats(sstat, r, mu, rs);
                float s = 0.f, q = 0.f;
#pragma unroll
                for (int bj = 0; bj < 2; ++bj)
#pragma unroll
                    for (int n = 0; n < 2; ++n) { const int c = cb + bj * HALF + n * 16; const size_t off = (size_t)r * 1024 + c;
                        f32x4 x = *(const f32x4*)(src + off); x = (x - mu) * rs * gv[bj][n] + bv[bj][n];
                        const f32x4 t = x * alpha + acc[ai][bj][m][n];
                        *(f32x4*)(T + off) = t; u32x2e w; w.x = cvt_pk_bf16(t[0], t[1]); w.y = cvt_pk_bf16(t[2], t[3]); *(u32x2e*)(XB + off) = w;
                        s += (t[0] + t[1]) + (t[2] + t[3]); q += (t[0] * t[0] + t[1] * t[1]) + (t[2] * t[2] + t[3] * t[3]);
                        if (shiftout && (r & 8191) == 8191) *(f32x4*)(shiftout + (size_t)(r >> 13) * 1024 + c) = x; }
                s += __shfl_xor(s, 16); s += __shfl_xor(s, 32); q += __shfl_xor(q, 16); q += __shfl_xor(q, 32);
                if (fq == 0) P[(ai * HALF + wr * 64 + m * 16 + fr) * 4 + wc] = (f32x2e){s, q};
                asm volatile("" ::: "memory");
            }
        asm volatile("s_waitcnt lgkmcnt(0)" ::: "memory"); __builtin_amdgcn_s_barrier(); asm volatile("" ::: "memory");
        if (threadIdx.x < 256) { const int row = threadIdx.x; const f32x2e a = P[row * 4 + 0], b2 = P[row * 4 + 1], c = P[row * 4 + 2], d = P[row * 4 + 3];
            *(f32x2e*)(ostat + (size_t)(u.pm * BM + row) * 8 + u.pn * 2) = (f32x2e){(a.x + b2.x) + (c.x + d.x), (a.y + b2.y) + (c.y + d.y)}; }
        asm volatile("s_waitcnt lgkmcnt(0)" ::: "memory"); __builtin_amdgcn_s_barrier(); asm volatile("" ::: "memory");
    }
};
struct EpiUp {
    static constexpr bool PERM = true, AFTER_DRAIN = false;
    unsigned char* ws; int l;
    __device__ __forceinline__ void operator()(const f32x4 (&acc)[2][2][4][2], const Unit& u, int wr, int wc, int fr, int fq) const {
        const float* stat = (const float*)(ws + WSO_STAT1); const float* c1 = (const float*)(ws + WSO_C1UP) + l * 4096; const float* c2 = (const float*)(ws + WSO_C2UP) + l * 4096; bf16_t* H = (bf16_t*)(ws + WSO_H);
        const int cb = u.pn * BM + wc * 32 + 8 * fq;
        f32x4 c1v[2][2], c2v[2][2];
#pragma unroll
        for (int bj = 0; bj < 2; ++bj)
#pragma unroll
            for (int n = 0; n < 2; ++n) { c1v[bj][n] = *(const f32x4*)(c1 + cb + bj * HALF + 4 * n); c2v[bj][n] = *(const f32x4*)(c2 + cb + bj * HALF + 4 * n); }
#pragma unroll
        for (int ai = 0; ai < 2; ++ai)
#pragma unroll
            for (int m = 0; m < 4; ++m) {
                const int r = u.pm * BM + ai * HALF + wr * 64 + m * 16 + fr;
                float mu, rs; row_stats(stat, r, mu, rs);
#pragma unroll
                for (int bj = 0; bj < 2; ++bj) {
                    f32x4 v0 = (acc[ai][bj][m][0] - mu * c1v[bj][0]) * rs + c2v[bj][0], v1 = (acc[ai][bj][m][1] - mu * c1v[bj][1]) * rs + c2v[bj][1];
#pragma unroll
                    for (int e = 0; e < 4; ++e) { const float a = fmaxf(v0[e], 0.f), b = fmaxf(v1[e], 0.f); v0[e] = a * a; v1[e] = b * b; }
                    u32x4 w; w.x = cvt_pk_bf16(v0[0], v0[1]); w.y = cvt_pk_bf16(v0[2], v0[3]); w.z = cvt_pk_bf16(v1[0], v1[1]); w.w = cvt_pk_bf16(v1[2], v1[3]);
                    *(u32x4*)(H + (size_t)r * 4096 + cb + bj * HALF) = w; }
                asm volatile("" ::: "memory");
            }
    }
};
template <class Epi, class Sched, bool ALIGN_EPI = false, bool SP2 = false>
__device__ __forceinline__ void gemm_phase(PG8_LAS unsigned char* lds, const Gemm g, const Sched& S, const Epi& E, const int tid) {
    const int wid = __builtin_amdgcn_readfirstlane(tid >> 6), lane = tid & 63, wr = wid >> 2, wc = wid & 3, fr = lane & 15, fq = lane >> 4;
    const int K = g.K, nt = K / BK;
    unsigned voffA[2], voffB[2];
#pragma unroll
    for (int i = 0; i < 2; ++i) { int R, C; stage_rc(tid * 16 + i * 8192, R, C); const int Rb = Epi::PERM ? ((R & ~31) + perm32(R & 31)) : R;
        voffA[i] = (unsigned)(R * K + C) * 2u; voffB[i] = (unsigned)(Rb * K + C) * 2u; }
    const size_t kstep = (size_t)(BK * 2);
    const size_t hstep = (size_t)HALF * K * 2;
    const size_t tstep = 2 * hstep;
    const unsigned ldsw = (unsigned)wid * 1024u;
    const int aoff = lds_byte(wr * 64 + fr, fq * 8), boff = lds_byte(wc * 32 + fr, fq * 8);
#define PG8_SA(b, h) (((b) * 2 + (h)) * HTB)
#define PG8_SB(b, h) ((4 + (b) * 2 + (h)) * HTB)
#define PG8_STAGE(bufoff, gbase, voff) do { _Pragma("unroll") for (int _i = 0; _i < 2; ++_i) \
        __builtin_amdgcn_global_load_lds((const unsigned*)((const char*)(gbase) + (voff)[_i]), (PG8_LAS unsigned*)(lds + (bufoff) + ldsw + _i * 8192), 16, 0, 0); } while (0)
#define PG8_LDA(dst, b, h) do { _Pragma("unroll") for (int m = 0; m < 4; ++m) _Pragma("unroll") for (int k = 0; k < 2; ++k) dst[m][k] = *(const PG8_LAS bf16x8*)(lds + PG8_SA(b, h) + aoff + m * 2048 + k * 1024); } while (0)
#define PG8_LDB(dst, b, h) do { _Pragma("unroll") for (int n = 0; n < 2; ++n) _Pragma("unroll") for (int k = 0; k < 2; ++k) dst[n][k] = *(const PG8_LAS bf16x8*)(lds + PG8_SB(b, h) + boff + n * 2048 + k * 1024); } while (0)
#define PG8_MMA(ai, bj, At, Bt) do { __builtin_amdgcn_s_setprio(1); _Pragma("unroll") for (int m = 0; m < 4; ++m) _Pragma("unroll") for (int n = 0; n < 2; ++n) _Pragma("unroll") for (int k = 0; k < 2; ++k) \
        acc[ai][bj][m][n] = __builtin_amdgcn_mfma_f32_16x16x32_bf16(Bt[n][k], At[m][k], acc[ai][bj][m][n], 0, 0, 0); __builtin_amdgcn_s_setprio(0); } while (0)
#define PG8_WAIT_V(n) asm volatile("s_waitcnt vmcnt(" #n ")" ::: "memory")
#define PG8_WAIT_L(n) asm volatile("s_waitcnt lgkmcnt(" #n ")" ::: "memory")
#define PG8_BAR __builtin_amdgcn_s_barrier()
#define PG8_SCHED __builtin_amdgcn_sched_barrier(0)
    Unit cur, nxt; int ui = 0;
    if (!S.next(0, cur)) return;
    f32x4 acc[2][2][4][2];
#pragma unroll
    for (int a = 0; a < 2; ++a)
#pragma unroll
        for (int b = 0; b < 2; ++b)
#pragma unroll
            for (int m = 0; m < 4; ++m)
#pragma unroll
                for (int n = 0; n < 2; ++n) acc[a][b][m][n] = (f32x4){0.f, 0.f, 0.f, 0.f};
    bf16x8 At[4][2], B0[2][2], B1[2][2];
    const char* cA = (const char*)g.A + (size_t)cur.pm * tstep; const char* cB = (const char*)g.Bt + (size_t)cur.pn * tstep;
    S.a_ready(cur);
    if constexpr (SP2) {
        PG8_STAGE(PG8_SB(0, 0), cB, voffB); PG8_STAGE(PG8_SB(0, 1), cB + hstep, voffB); PG8_STAGE(PG8_SA(0, 0), cA, voffA); PG8_STAGE(PG8_SA(0, 1), cA + hstep, voffA);
        if (wr == 1) PG8_BAR;
        PG8_WAIT_V(2); PG8_BAR;
        PG8_STAGE(PG8_SB(1, 0), cB + kstep, voffB); PG8_STAGE(PG8_SA(1, 0), cA + kstep, voffA); PG8_STAGE(PG8_SB(1, 1), cB + hstep + kstep, voffB);
        PG8_WAIT_V(6); PG8_BAR;
    } else {
        PG8_STAGE(PG8_SB(0, 0), cB, voffB); PG8_STAGE(PG8_SA(0, 0), cA, voffA); PG8_STAGE(PG8_SB(0, 1), cB + hstep, voffB); PG8_STAGE(PG8_SA(0, 1), cA + hstep, voffA);
        if (wr == 1) PG8_BAR;
        PG8_WAIT_V(4); PG8_BAR;
        PG8_STAGE(PG8_SB(1, 0), cB + kstep, voffB); PG8_STAGE(PG8_SA(1, 0), cA + kstep, voffA); PG8_STAGE(PG8_SB(1, 1), cB + hstep + kstep, voffB);
        PG8_WAIT_V(6); PG8_BAR;
    }
    for (;;) {
        const bool has_next = S.next(ui + 1, nxt);
        const char* nA = has_next ? (const char*)g.A + (size_t)nxt.pm * tstep : cA; const char* nB = has_next ? (const char*)g.Bt + (size_t)nxt.pn * tstep : cB;
        for (int t = 0; t < nt; t += 2) {
            const bool last = (t == nt - 2);
            const char* a1 = cA + (size_t)(t + 1) * kstep;
            const char* a2 = last ? nA : cA + (size_t)(t + 2) * kstep; const char* b2 = last ? nB : cB + (size_t)(t + 2) * kstep;
            const char* a3 = a2 + kstep; const char* b3 = b2 + kstep;
            if (last && has_next) S.a_ready(nxt);
            if constexpr (SP2) {
            PG8_LDB(B0, 0, 0); PG8_LDB(B1, 0, 1); PG8_SCHED; PG8_LDA(At, 0, 0); PG8_STAGE(PG8_SA(1, 1), a1 + hstep, voffA);
            PG8_WAIT_V(8); PG8_WAIT_L(0); PG8_BAR; PG8_MMA(0, 0, At, B0); PG8_MMA(0, 1, At, B1); PG8_BAR; PG8_SCHED;
            PG8_LDA(At, 0, 1); PG8_STAGE(PG8_SB(0, 0), b2, voffB); PG8_STAGE(PG8_SB(0, 1), b2 + hstep, voffB); PG8_STAGE(PG8_SA(0, 0), a2, voffA);
            PG8_WAIT_V(8); PG8_WAIT_L(0); PG8_BAR; PG8_MMA(1, 0, At, B0); PG8_MMA(1, 1, At, B1); PG8_BAR; PG8_SCHED;
            PG8_LDB(B0, 1, 0); PG8_LDB(B1, 1, 1); PG8_SCHED; PG8_LDA(At, 1, 0); PG8_STAGE(PG8_SA(0, 1), a2 + hstep, voffA);
            PG8_WAIT_V(8); PG8_WAIT_L(0); PG8_BAR; PG8_MMA(0, 0, At, B0); PG8_MMA(0, 1, At, B1); PG8_BAR; PG8_SCHED;
            PG8_LDA(At, 1, 1); PG8_STAGE(PG8_SB(1, 0), b3, voffB); PG8_STAGE(PG8_SB(1, 1), b3 + hstep, voffB); PG8_STAGE(PG8_SA(1, 0), a3, voffA);
            PG8_WAIT_V(8); PG8_WAIT_L(0); PG8_BAR; PG8_MMA(1, 0, At, B0); PG8_MMA(1, 1, At, B1); PG8_BAR; PG8_SCHED;
            } else {
            PG8_LDB(B0, 0, 0); PG8_SCHED; PG8_LDA(At, 0, 0); PG8_STAGE(PG8_SA(1, 1), a1 + hstep, voffA);
            PG8_WAIT_L(8); PG8_BAR; PG8_WAIT_L(0); PG8_MMA(0, 0, At, B0); PG8_BAR; PG8_SCHED;
            PG8_LDB(B1, 0, 1); PG8_STAGE(PG8_SB(0, 0), b2, voffB);
            PG8_BAR; PG8_WAIT_L(0); PG8_MMA(0, 1, At, B1); PG8_BAR;
            PG8_LDA(At, 0, 1); PG8_STAGE(PG8_SA(0, 0), a2, voffA);
            PG8_BAR; PG8_WAIT_L(0); PG8_MMA(1, 0, At, B0); PG8_BAR; PG8_SCHED;
            PG8_STAGE(PG8_SB(0, 1), b2 + hstep, voffB);
            PG8_WAIT_V(6); PG8_BAR; PG8_MMA(1, 1, At, B1); PG8_BAR;
            PG8_LDB(B0, 1, 0); PG8_SCHED; PG8_LDA(At, 1, 0); PG8_STAGE(PG8_SA(0, 1), a2 + hstep, voffA);
            PG8_WAIT_L(8); PG8_BAR; PG8_WAIT_L(0); PG8_MMA(0, 0, At, B0); PG8_BAR; PG8_SCHED;
            PG8_LDB(B1, 1, 1); PG8_STAGE(PG8_SB(1, 0), b3, voffB);
            PG8_BAR; PG8_WAIT_L(0); PG8_MMA(0, 1, At, B1); PG8_BAR;
            PG8_LDA(At, 1, 1); PG8_STAGE(PG8_SA(1, 0), a3, voffA);
            PG8_BAR; PG8_WAIT_L(0); PG8_MMA(1, 0, At, B0); PG8_BAR; PG8_SCHED;
            PG8_STAGE(PG8_SB(1, 1), b3 + hstep, voffB);
            PG8_WAIT_V(6); PG8_BAR; PG8_MMA(1, 1, At, B1); PG8_BAR;
            }
        }
        if constexpr (ALIGN_EPI) { if (wr == 0) PG8_BAR; }
        if constexpr (!Epi::AFTER_DRAIN) { E(acc, cur, wr, wc, fr, fq); S.done(cur); }
        if (!has_next) break;
#pragma unroll
        for (int a = 0; a < 2; ++a)
#pragma unroll
            for (int b = 0; b < 2; ++b)
#pragma unroll
                for (int m = 0; m < 4; ++m)
#pragma unroll
                    for (int n = 0; n < 2; ++n) acc[a][b][m][n] = (f32x4){0.f, 0.f, 0.f, 0.f};
        cur = nxt; cA = nA; cB = nB; ++ui;
        if constexpr (ALIGN_EPI) { if (wr == 1) PG8_BAR; }
    }
    PG8_WAIT_V(0);
    if constexpr (!ALIGN_EPI) { if (wr == 0) PG8_BAR; }
    PG8_BAR;
    if constexpr (Epi::AFTER_DRAIN) { E.fused(acc, cur, wr, wc, fr, fq, lds, wid, lane); S.done(cur); }
#undef PG8_SA
#undef PG8_SB
#undef PG8_STAGE
#undef PG8_LDA
#undef PG8_LDB
#undef PG8_MMA
#undef PG8_WAIT_V
#undef PG8_WAIT_L
#undef PG8_BAR
#undef PG8_SCHED
}
}
constexpr int NWAVES = 8;
constexpr int M = 16384, TSEQ = 8192, DM = 1024, FFD = 4096, DEPTH = 4, MD = 32, NH = 8, HD = 64;
constexpr int NIN = 3584;
constexpr int RW0 = 1536;
constexpr int PRP = 2048;
constexpr int NRWU = 1856;
constexpr int CH = 16, NCH = TSEQ / CH;
constexpr int NUNIT = 2 * NH * NCH;
constexpr float LN_EPS = 1e-5f, GN_EPS = 64e-5f, RMS_EPS = 1e-6f;
constexpr float ALPHA = 1.6817928305074290f;
constexpr float QSCALE = 0.125f * 1.4426950408889634f;
constexpr size_t O_Y = 0, O_YS = 16777216, O_SHP = 16809984, O_SHS = 16818176, O_WKP = 16949248, O_WKS = 17211392,
                 O_KP = 21405696, O_VP = 29794304, O_KS = 38182912, O_VS = 38248448, O_END = 38313984;
constexpr size_t MiB = 1u << 20;
constexpr size_t WS_CTL = 0, CTL_ZERO_BYTES = 1 * MiB;
constexpr size_t WS_C1IN = 1 * MiB;
constexpr size_t WS_C2IN = WS_C1IN + 4 * NIN * 4;
constexpr size_t WS_C1UP = WS_C2IN + 4 * NIN * 4;
constexpr size_t WS_C2UP = WS_C1UP + 4 * FFD * 4;
constexpr size_t WS_DUPT = WS_C2UP + 4 * FFD * 4;
constexpr size_t WS_IUPT = WS_DUPT + 4 * 512 * 64 * 2;
constexpr size_t WS_GUPT = WS_IUPT + 4 * 512 * 64 * 2;
constexpr size_t WS_VUPT = WS_GUPT + 4 * 512 * 128 * 2;
constexpr size_t WS_SMALL_END = WS_VUPT + 3 * 512 * 32 * 2;
static_assert(WS_SMALL_END <= 3 * MiB, "small region");
constexpr size_t WS_ROPE = 3 * MiB;
constexpr size_t WS_DEC = 6 * MiB;
constexpr size_t WS_STAT1 = 8 * MiB, WS_STAT2 = 9 * MiB;
constexpr size_t WS_BON = 10 * MiB;
constexpr size_t WS_LSE = 11 * MiB;
constexpr size_t WS_GC = 13 * MiB;
constexpr size_t WS_WIN = 16 * MiB;
constexpr size_t WS_WINU = 44 * MiB;
constexpr size_t WS_WOUT = 60 * MiB;
constexpr size_t WS_WUP = 68 * MiB;
constexpr size_t WS_WDN = 100 * MiB;
constexpr size_t WS_XB2 = 132 * MiB;
constexpr size_t WS_XB1 = 164 * MiB;
constexpr size_t WS_T1 = 196 * MiB;
constexpr size_t WS_T2 = 260 * MiB;
constexpr size_t WS_QB = 324 * MiB, WS_KB = 340 * MiB, WS_VB = 356 * MiB;
constexpr size_t WS_PR = 372 * MiB;
constexpr size_t WS_OP = 436 * MiB;
constexpr size_t WS_MIX = 484 * MiB;
constexpr size_t WS_VF = 516 * MiB, WS_VV = 532 * MiB;
constexpr size_t WS_YPRE = 548 * MiB;
constexpr size_t WS_H = 580 * MiB;
constexpr size_t WS_PT = 580 * MiB;
constexpr size_t WS_QT = 644 * MiB;
constexpr size_t WS_REFF = 708 * MiB;
constexpr size_t WS_YLOC = 724 * MiB;
constexpr size_t WS_END = 756 * MiB;
static_assert(WS_H + (size_t)M * FFD * 2 <= WS_END + 0 * MiB || true, "");
constexpr size_t DEC_XB2 = 0;
constexpr size_t DEC_XB1 = 64 * 1024;
constexpr size_t DEC_SHB = 128 * 1024;
constexpr size_t DEC_MIXB = 384 * 1024;
constexpr size_t DEC_HB = 448 * 1024;
constexpr size_t DEC_T1 = 704 * 1024;
constexpr size_t DEC_T2 = 832 * 1024;
constexpr size_t DEC_PD = 960 * 1024;
constexpr size_t DEC_PS = 1408 * 1024;
constexpr size_t DEC_OP = 1640 * 1024;
constexpr size_t DEC_LSE = 1832 * 1024;
constexpr size_t DEC_MIX = 1836 * 1024;
constexpr size_t DEC_ST1 = 1964 * 1024;
constexpr size_t DEC_ST2 = 1972 * 1024;
constexpr size_t DEC_VF = 1980 * 1024;
static_assert(DEC_VF + 32 * 512 * 4 <= 2 * MiB, "decode scratch");
constexpr int CW_BAR = 4096;
constexpr int RING_BYTES = 131072;
constexpr int MISC_OFF = RING_BYTES + 320;
constexpr int LDS_BYTES = 147456;
static_assert(pg8::WSO_C1IN == WS_C1IN && pg8::WSO_C2IN == WS_C2IN && pg8::WSO_C1UP == WS_C1UP && pg8::WSO_C2UP == WS_C2UP && pg8::WSO_ROPE == WS_ROPE && pg8::WSO_STAT1 == WS_STAT1 && pg8::WSO_STAT2 == WS_STAT2 &&
              pg8::WSO_XB2 == WS_XB2 && pg8::WSO_XB1 == WS_XB1 && pg8::WSO_T1 == WS_T1 && pg8::WSO_T2 == WS_T2 && pg8::WSO_QB == WS_QB && pg8::WSO_KB == WS_KB && pg8::WSO_VB == WS_VB && pg8::WSO_PR == WS_PR && pg8::WSO_H == WS_H &&
              pg8::OO_SHP == O_SHP && pg8::OO_KP == O_KP && pg8::OO_VP == O_VP, "epilogue offset mirrors");
#define GAS __attribute__((address_space(1)))
#define LAS __attribute__((address_space(3)))
typedef unsigned short bf16;
typedef unsigned v4u __attribute__((ext_vector_type(4)));
typedef unsigned v2u __attribute__((ext_vector_type(2)));
typedef float f32x4 __attribute__((ext_vector_type(4)));
typedef float f32x2 __attribute__((ext_vector_type(2)));
typedef float f32x16 __attribute__((ext_vector_type(16)));
typedef short bf16x8 __attribute__((ext_vector_type(8)));
typedef short s16x4 __attribute__((ext_vector_type(4)));
typedef GAS unsigned gu32;
#define RLX_AGENT __ATOMIC_RELAXED, __HIP_MEMORY_SCOPE_AGENT
#define LDS_WAIT() asm volatile("s_waitcnt lgkmcnt(0)" ::: "memory")
#define VM_WAIT() asm volatile("s_waitcnt vmcnt(0)" ::: "memory")
#define DI __device__ __forceinline__
DI unsigned f2bf(float f) { unsigned u = __builtin_bit_cast(unsigned, f); return (u + 0x7fffu + ((u >> 16) & 1u)) >> 16; }
DI float bf2f(unsigned b) { return __builtin_bit_cast(float, b << 16); }
DI float bflo(unsigned w) { return __builtin_bit_cast(float, w << 16); }
DI float bfhi(unsigned w) { return __builtin_bit_cast(float, w & 0xffff0000u); }
typedef __bf16 bf16x2_t __attribute__((ext_vector_type(2)));
DI unsigned pk2(float lo, float hi) { const f32x2 v = {lo, hi}; const bf16x2_t b = __builtin_convertvector(v, bf16x2_t); return __builtin_bit_cast(unsigned, b); }
DI float rbf(float x) { return bf2f(f2bf(x)); }
DI bf16x8 pk8(float a0, float a1, float a2, float a3, float a4, float a5, float a6, float a7) {
    v4u w; w.x = pk2(a0, a1); w.y = pk2(a2, a3); w.z = pk2(a4, a5); w.w = pk2(a6, a7); return __builtin_bit_cast(bf16x8, w); }
DI bf16x8 pk8v(f32x4 a, f32x4 b) { return pk8(a[0], a[1], a[2], a[3], b[0], b[1], b[2], b[3]); }
DI bf16x8 pk4z(f32x4 a) { v4u w; w.x = pk2(a[0], a[1]); w.y = pk2(a[2], a[3]); w.z = 0u; w.w = 0u; return __builtin_bit_cast(bf16x8, w); }
DI bf16x8 ld8(const void* p) { return *(const bf16x8*)p; }
DI bf16x8 ld4z(const void* p) { v2u t = *(const v2u*)p; v4u w; w.x = t.x; w.y = t.y; w.z = 0u; w.w = 0u; return __builtin_bit_cast(bf16x8, w); }
DI f32x4 mfma16(bf16x8 a, bf16x8 b, f32x4 c) { return __builtin_amdgcn_mfma_f32_16x16x32_bf16(a, b, c, 0, 0, 0); }
DI f32x16 mfma32(bf16x8 a, bf16x8 b, f32x16 c) { return __builtin_amdgcn_mfma_f32_32x32x16_bf16(a, b, c, 0, 0, 0); }
DI int crow(int r, int hi) { return (r & 3) + 8 * (r >> 2) + 4 * hi; }
DI float wave_sum(float v) {
#pragma unroll
    for (int o = 1; o < 64; o <<= 1) v += __shfl_xor(v, o);
    return v; }
DI float fexp(float x) { return __expf(x); }
DI float fsigmoid(float x) { return __builtin_amdgcn_rcpf(1.f + __expf(-x)); }
DI float ftanh(float x) { return 1.f - 2.f * __builtin_amdgcn_rcpf(__expf(2.f * x) + 1.f); }
DI float fsoftplus(float x) { return fmaxf(x, 0.f) + __logf(1.f + __expf(-fabsf(x))); }
DI int swap45(int c) { return (c & ~0x30) | ((c & 0x10) << 1) | ((c & 0x20) >> 1); }
#define XB_TMO      128
#define XB_XCNT(j)  (256  + 64 * (j))
#define XB_XSUB(j)  (1280 + 64 * (j))
#define XB_XGEN(j)  (2304 + 64 * (j))
#define XB_TOP      3328
#define XB_TOPGEN   3392
#define XCD_BAR_WORDS 3456
#define XB_SPIN_CAP (1u << 18)

__device__ __forceinline__ unsigned xb_ld(unsigned* p)              { return __hip_atomic_load(p, __ATOMIC_RELAXED, __HIP_MEMORY_SCOPE_AGENT); }
__device__ __forceinline__ unsigned xb_add(unsigned* p, unsigned v) { return __hip_atomic_fetch_add(p, v, __ATOMIC_RELAXED, __HIP_MEMORY_SCOPE_AGENT); }
__device__ __forceinline__ unsigned xb_xcc_id() { return (unsigned)__builtin_amdgcn_s_getreg((3 << 11) | 20) & 0xFu; }
#define XB_SPIN(cond, bar) do { unsigned _sp = 0; while (cond) { __builtin_amdgcn_s_sleep(1); \
    if ((++_sp & 255u) == 0u) { if (xb_ld(&(bar)[XB_TMO])) break; if (_sp > XB_SPIN_CAP) { atomicAdd(&(bar)[XB_TMO], 1u); break; } } } } while (0)

struct XcdBarrier {
    unsigned* bar; unsigned x;
    volatile LAS unsigned* st;
};

__device__ __forceinline__ XcdBarrier xcd_barrier_post(unsigned* bar, volatile LAS unsigned* st) {
    XcdBarrier b; b.bar = bar; b.x = xb_xcc_id(); b.st = st;
    if (threadIdx.x == 0) (void)xb_add(&bar[XB_XCNT(b.x)], 1u);
    return b;
}
__device__ __forceinline__ void xcd_barrier_complete(unsigned* bar, unsigned x, unsigned& nloc, unsigned& nx) {
    const unsigned G = gridDim.x * gridDim.y * gridDim.z;
    unsigned sum, cnt, mine, sp = 0u;
    for (;;) {
        sum = 0u; cnt = 0u; mine = 0u;
#pragma unroll
        for (unsigned j = 0; j < 16; ++j) { const unsigned c = xb_ld(&bar[XB_XCNT(j)]); sum += c; cnt += (c > 0u) ? 1u : 0u; mine = (j == x) ? c : mine; }
        if (sum == G) break;
        __builtin_amdgcn_s_sleep(1);
        if ((++sp & 255u) == 0u) { if (xb_ld(&bar[XB_TMO])) break; if (sp > XB_SPIN_CAP) { atomicAdd(&bar[XB_TMO], 1u); break; } }
    }
    nloc = mine > 0u ? mine : 1u; nx = cnt > 0u ? cnt : 1u;
}

__device__ __forceinline__ void xcd_barrier(const XcdBarrier& b) {
    asm volatile("s_waitcnt vmcnt(0)" ::: "memory");
    __syncthreads();
    if (threadIdx.x == 0) {
        unsigned* bar = b.bar;
        __builtin_amdgcn_s_waitcnt(0);
        unsigned nloc = b.st[0], nx = b.st[1];
        if (nloc == 0u) { xcd_barrier_complete(bar, b.x, nloc, nx); b.st[0] = nloc; b.st[1] = nx; }
        const unsigned old = xb_add(&bar[XB_XSUB(b.x)], 1u);
        const unsigned gen = old / nloc;
        if (old + 1u == (gen + 1u) * nloc) {
            __builtin_amdgcn_fence(__ATOMIC_RELEASE, "agent");
            asm volatile("s_waitcnt vmcnt(0)" ::: "memory");
            const unsigned og = xb_add(&bar[XB_TOP], 1u);
            const unsigned tg = og / nx;
            if (og + 1u == (tg + 1u) * nx) xb_add(&bar[XB_TOPGEN], 1u);
            else XB_SPIN(xb_ld(&bar[XB_TOPGEN]) == tg, bar);
            __builtin_amdgcn_fence(__ATOMIC_ACQUIRE, "agent");
            xb_add(&bar[XB_XGEN(b.x)], 1u);
            asm volatile("s_waitcnt vmcnt(0)" ::: "memory");
        } else {
            XB_SPIN(xb_ld(&bar[XB_XGEN(b.x)]) == gen, bar);
            __builtin_amdgcn_fence(__ATOMIC_ACQUIRE, "agent");
            asm volatile("s_waitcnt vmcnt(0)" ::: "memory");
        }
    }
    __syncthreads();
}
struct Args { const float* in[30]; float* out; unsigned char* ws; };
struct Frame {
    unsigned char* lds;
    volatile LAS unsigned* MISC;
    gu32* ctl;
    int tid, lane, wave, vcu, G, gw, NGW;
    const float* const* in; float* out; unsigned char* ws;
};
template <bool SWAP>
DI void p0_transpose_item(const float* W, int ldw, int K, int csrc0, bf16* WT, int row_off, const float* gsc, LAS float* scr, int kb, int nb, int lane) {
    const int k0 = 64 * kb, n0 = 32 * nb;
#pragma unroll 8
    for (int i = 0; i < 32; ++i) { const int kk = 2 * i + (lane >> 5); float v = W[(size_t)(k0 + kk) * ldw + csrc0 + n0 + (lane & 31)]; if (gsc) v *= gsc[k0 + kk]; scr[kk * 33 + (lane & 31)] = v; }
    LDS_WAIT(); asm volatile("" ::: "memory");
    const int c = lane & 7;
#pragma unroll
    for (int j = 0; j < 4; ++j) { const int n = (lane >> 3) + 8 * j; const LAS float* s = scr + (8 * c) * 33 + n;
        v4u o; o.x = pk2(s[0 * 33], s[1 * 33]); o.y = pk2(s[2 * 33], s[3 * 33]); o.z = pk2(s[4 * 33], s[5 * 33]); o.w = pk2(s[6 * 33], s[7 * 33]);
        int dr = n0 + n; if (SWAP) dr = swap45(dr);
        *(v4u*)(WT + (size_t)(row_off + dr) * K + k0 + 8 * c) = o; }
    LDS_WAIT(); asm volatile("" ::: "memory");
}
DI void p0_colsum_item(const float* W, int ldw, int K, int ncols, const float* W2, int ld2, int ncols2, bool swap, const float* g, const float* b, float* c1, float* c2, int grp, int lane) {
    const int p = grp * 64 + lane; const bool ok = p < ncols + ncols2;
    const float* src; int ld;
    if (p < ncols) { src = W + (swap && p < 1024 ? swap45(p) : p); ld = ldw; } else { src = W2 + (ok ? p - ncols : 0); ld = ld2; }
    float s1 = 0.f, s2 = 0.f;
    if (ok) {
#pragma unroll 8
        for (int k = 0; k < K; ++k) { const float w = src[(size_t)k * ld]; s1 += rbf(g[k] * w); s2 += b[k] * w; }
        c1[p] = s1; c2[p] = s2; }
}
DI void p0_prologue(Frame& F) {
    LAS float* scr = (LAS float*)((LAS unsigned char*)F.lds + F.wave * 16384);
    const float* const* in = F.in; unsigned char* ws = F.ws;
    constexpr int I_IN = 16 * 104, I_VR = 16, I_INU = 16 * 56, I_OUT = 16 * 32, I_UP = 16 * 128, I_DN = 64 * 32;
    constexpr int I_L = I_IN + I_VR + I_INU + I_VR + I_OUT + I_UP + I_DN;
    for (int it = F.gw; it < DEPTH * I_L; it += F.NGW) {
        const int l = it / I_L; int r = it % I_L;
        const float* g2p = l > 0 ? in[28] + (size_t)(l - 1) * DM : nullptr;
        bf16* win = (bf16*)(ws + WS_WIN) + (size_t)l * NIN * DM; bf16* winu = (bf16*)(ws + WS_WINU) + (size_t)l * NRWU * DM;
        if (r < I_IN) { const int kb = r / 104, nb = r % 104; const float* W = in[6] + (size_t)l * DM * 3328;
            if (nb < 32) p0_transpose_item<true>(W, 3328, DM, 0, win, 0, g2p, scr, kb, nb, F.lane); else p0_transpose_item<false>(W, 3328, DM, 0, win, 0, g2p, scr, kb, nb, F.lane); continue; } r -= I_IN;
        if (r < I_VR) { if (l > 0) p0_transpose_item<false>(in[7] + (size_t)(l - 1) * DM * 32, 32, DM, 0, win, 3328, g2p, scr, r, 0, F.lane); continue; } r -= I_VR;
        if (r < I_INU) { const int kb = r / 56, nb = r % 56; p0_transpose_item<false>(in[6] + (size_t)l * DM * 3328, 3328, DM, RW0, winu, 0, nullptr, scr, kb, nb, F.lane); continue; } r -= I_INU;
        if (r < I_VR) { if (l > 0) p0_transpose_item<false>(in[7] + (size_t)(l - 1) * DM * 32, 32, DM, 0, winu, 1792, nullptr, scr, r, 0, F.lane); continue; } r -= I_VR;
        if (r < I_OUT) { p0_transpose_item<false>(in[23] + (size_t)l * DM * DM, DM, DM, 0, (bf16*)(ws + WS_WOUT) + (size_t)l * DM * DM, 0, nullptr, scr, r / 32, r % 32, F.lane); continue; } r -= I_OUT;
        if (r < I_UP) { p0_transpose_item<false>(in[26] + (size_t)l * DM * FFD, FFD, DM, 0, (bf16*)(ws + WS_WUP) + (size_t)l * FFD * DM, 0, in[24] + (size_t)l * DM, scr, r / 128, r % 128, F.lane); continue; } r -= I_UP;
        p0_transpose_item<false>(in[27] + (size_t)l * FFD * DM, DM, FFD, 0, (bf16*)(ws + WS_WDN) + (size_t)l * DM * FFD, 0, nullptr, scr, r / 32, r % 32, F.lane);
    }
    {   constexpr int G_IN = 53, G_UP = 64, G_L = G_IN + G_UP;
        for (int it = F.NGW - 1 - F.gw; it < DEPTH * G_L; it += F.NGW) {
            const int l = it / G_L, r = it % G_L;
            if (r < G_IN) { if (l > 0) p0_colsum_item(in[6] + (size_t)l * DM * 3328, 3328, DM, 3328, in[7] + (size_t)(l - 1) * DM * 32, 32, 32, true, in[28] + (size_t)(l - 1) * DM, in[29] + (size_t)(l - 1) * DM,
                                                      (float*)(ws + WS_C1IN) + l * NIN, (float*)(ws + WS_C2IN) + l * NIN, r, F.lane); }
            else p0_colsum_item(in[26] + (size_t)l * DM * FFD, FFD, DM, FFD, nullptr, 0, 0, false, in[24] + (size_t)l * DM, in[25] + (size_t)l * DM, (float*)(ws + WS_C1UP) + l * FFD, (float*)(ws + WS_C2UP) + l * FFD, r - G_IN, F.lane);
        } }
    for (int m = F.gw; m < M; m += F.NGW) { const f32x4* xr = (const f32x4*)(in[0] + (size_t)m * DM) + F.lane; unsigned long long* o8 = (unsigned long long*)((bf16*)(ws + WS_XB2) + (size_t)m * DM) + F.lane;
#pragma unroll
        for (int j = 0; j < 4; ++j) { const f32x4 v = xr[64 * j]; o8[64 * j] = (unsigned long long)pk2(v.x, v.y) | ((unsigned long long)pk2(v.z, v.w) << 32); } }
    const int gt = F.gw * 64 + F.lane, NGT = F.NGW * 64;
    for (int e = gt; e < 8193 * 32; e += NGT) { const int pos = e >> 5, i = e & 31; const double ang = (double)pos * pow(10000.0, -(double)i / 32.0); ((f32x2*)(ws + WS_ROPE))[e] = (f32x2){(float)cos(ang), (float)sin(ang)}; }
    for (int e = gt; e < 4 * 512 * 64; e += NGT) { const int l = e / (512 * 64), n = (e / 64) % 512, m = e % 64; ((bf16*)(ws + WS_DUPT))[e] = (bf16)f2bf(in[11][((size_t)l * 64 + m) * 512 + n]); ((bf16*)(ws + WS_IUPT))[e] = (bf16)f2bf(in[13][((size_t)l * 64 + m) * 512 + n]); }
    for (int e = gt; e < 4 * 512 * 128; e += NGT) { const int l = e / (512 * 128), n = (e / 128) % 512, m = e % 128; ((bf16*)(ws + WS_GUPT))[e] = (bf16)f2bf(in[14][((size_t)l * 128 + m) * 512 + n]); }
    for (int e = gt; e < 3 * 512 * 32; e += NGT) { const int l = e / (512 * 32), n = (e / 32) % 512, m = e % 32; ((bf16*)(ws + WS_VUPT))[e] = (bf16)f2bf(in[16][((size_t)l * 32 + m) * 512 + n]); }
    for (int e = gt; e < MD * DM; e += NGT) { ((bf16*)(ws + WS_DEC + DEC_XB2))[e] = (bf16)f2bf(in[1][e]); }
    for (int e = gt; e < DEPTH * MD * DM; e += NGT) { ((bf16*)(ws + WS_DEC + DEC_SHB))[e] = (bf16)f2bf(in[2][e]); }
}
constexpr int VPITCH = 144;
constexpr int ATT_WLDS = 2 * 32 * VPITCH + 256;
DI void tr_read8(unsigned base, s16x4 (&t)[8]) {
    asm volatile("ds_read_b64_tr_b16 %0, %8\n\tds_read_b64_tr_b16 %1, %8 offset:%c9\n\tds_read_b64_tr_b16 %2, %8 offset:%c10\n\tds_read_b64_tr_b16 %3, %8 offset:%c11\n\t"
                 "ds_read_b64_tr_b16 %4, %8 offset:%c12\n\tds_read_b64_tr_b16 %5, %8 offset:%c13\n\tds_read_b64_tr_b16 %6, %8 offset:%c14\n\tds_read_b64_tr_b16 %7, %8 offset:%c15\n\ts_waitcnt lgkmcnt(0)"
                 : "=&v"(t[0]), "=&v"(t[1]), "=&v"(t[2]), "=&v"(t[3]), "=&v"(t[4]), "=&v"(t[5]), "=&v"(t[6]), "=&v"(t[7])
                 : "v"(base), "i"(8 * VPITCH), "i"(64), "i"(8 * VPITCH + 64), "i"(16 * VPITCH), "i"(24 * VPITCH), "i"(16 * VPITCH + 64), "i"(24 * VPITCH + 64) : "memory");
}
DI void attn_task(const bf16* QB, const bf16* KB, const bf16* VB, bf16* OP, float* LSE, int b, int h, int p, int cls, int qblk, LAS unsigned char* wl, int lane) {
    asm volatile("" : "+v"(lane));
    const int dd = 1 << (2 * p), r32 = lane & 31, hi = lane >> 5;
    const int m0 = 32 * qblk;
    const size_t rowb = (size_t)b * TSEQ;
    const size_t qrow = rowb + (size_t)(m0 + r32) * dd + cls;
    bf16x8 qf[4];
#pragma unroll
    for (int d0 = 0; d0 < 4; ++d0) qf[d0] = ld8(QB + qrow * 512 + h * 64 + d0 * 16 + hi * 8);
    f32x16 s[5];
    const int kt0 = (m0 >= 128) ? 0 : (128 - m0) / 32;
#pragma unroll
    for (int kt = 0; kt < 5; ++kt) {
        f32x16 a; for (int i = 0; i < 16; ++i) a[i] = 0.f;
        if (kt >= kt0) {
            const int mk = m0 - 128 + 32 * kt + r32;
            const size_t krow = rowb + (size_t)mk * dd + cls;
            bf16x8 kf[4];
#pragma unroll
            for (int d0 = 0; d0 < 4; ++d0) kf[d0] = ld8(KB + krow * 512 + h * 64 + d0 * 16 + hi * 8);
#pragma unroll
            for (int d0 = 0; d0 < 4; ++d0) a = mfma32(kf[d0], qf[d0], a);
        }
#pragma unroll
        for (int i = 0; i < 16; ++i) { const int jk = crow(i, hi); bool ok = kt >= kt0; if (kt == 0) ok = ok && (jk >= r32); if (kt == 4) ok = ok && (jk <= r32); a[i] = ok ? a[i] : -INFINITY; }
        s[kt] = a;
    }
    float mx = -INFINITY;
#pragma unroll
    for (int kt = 0; kt < 5; ++kt)
#pragma unroll
        for (int i = 0; i < 16; ++i) mx = fmaxf(mx, s[kt][i]);
    mx = fmaxf(mx, __shfl_xor(mx, 32));
    float lsum = 0.f;
#pragma unroll
    for (int kt = 0; kt < 5; ++kt)
#pragma unroll
        for (int i = 0; i < 16; ++i) { const float e = __builtin_amdgcn_exp2f(s[kt][i] - mx); s[kt][i] = e; lsum += e; }
    lsum += __shfl_xor(lsum, 32);
    f32x16 o[2]; for (int i = 0; i < 16; ++i) { o[0][i] = 0.f; o[1][i] = 0.f; }
    LAS float* wsf = (LAS float*)(wl + 2 * 32 * VPITCH);
    const unsigned vb0 = (unsigned)(uintptr_t)wl;
    const int g = lane >> 4, i16 = lane & 15, qq = i16 >> 2, pp = i16 & 3;
    const unsigned traddr = (unsigned)((4 * (g >> 1) + qq) * VPITCH + (16 * (g & 1) + 4 * pp) * 2);
    const int vkey = lane >> 1, vhalf = lane & 1;
    v4u vr[4];
#define ATT_LOADV(KT) do { const int mk_ = m0 - 128 + 32 * (KT) + vkey; const size_t vrow_ = rowb + (size_t)mk_ * dd + cls; const v4u* src_ = (const v4u*)(VB + vrow_ * 512 + h * 64 + vhalf * 32); \
        vr[0] = src_[0]; vr[1] = src_[1]; vr[2] = src_[2]; vr[3] = src_[3]; } while (0)
    ATT_LOADV(kt0);
#pragma unroll
    for (int kt = 0; kt < 5; ++kt) {
        if (kt >= kt0) {
            LAS unsigned char* vb = wl + (kt & 1) * 32 * VPITCH;
            { LAS v4u* dst = (LAS v4u*)(vb + vkey * VPITCH + vhalf * 64); dst[0] = vr[0]; dst[1] = vr[1]; dst[2] = vr[2]; dst[3] = vr[3]; }
            if (kt + 1 < 5) ATT_LOADV(kt + 1);
            LDS_WAIT();
            const unsigned base = vb0 + (unsigned)((kt & 1) * 32 * VPITCH) + traddr;
            s16x4 t[8];
            tr_read8(base, t);
#pragma unroll
            for (int ss = 0; ss < 2; ++ss) {
                const bf16x8 pa = pk8(s[kt][8 * ss], s[kt][8 * ss + 1], s[kt][8 * ss + 2], s[kt][8 * ss + 3], s[kt][8 * ss + 4], s[kt][8 * ss + 5], s[kt][8 * ss + 6], s[kt][8 * ss + 7]);
#pragma unroll
                for (int db = 0; db < 2; ++db) { const bf16x8 vf = __builtin_shufflevector(t[4 * ss + 2 * db], t[4 * ss + 2 * db + 1], 0, 1, 2, 3, 4, 5, 6, 7); o[db] = mfma32(pa, vf, o[db]); }
            }
        }
    }
#undef ATT_LOADV
    if (hi == 0) { wsf[r32] = __builtin_amdgcn_rcpf(lsum); LSE[((size_t)p * M + qrow) * 8 + h] = mx + __builtin_amdgcn_logf(lsum); }
    LDS_WAIT();
#pragma unroll
    for (int i = 0; i < 16; ++i) { const int q = crow(i, hi); const float li = wsf[q]; const size_t orow = rowb + (size_t)(m0 + q) * dd + cls;
        bf16* op = OP + ((size_t)p * M + orow) * 512 + h * 64 + r32;
        op[0] = (bf16)f2bf(o[0][i] * li); op[32] = (bf16)f2bf(o[1][i] * li); }
    LDS_WAIT();
}
DI void attn_finalize_row(const bf16* OP, const float* LSE, const float* gain, bf16* MIX, int row, int lane) {
    asm volatile("" : "+v"(lane));
    const int h = lane >> 3;
    float l0 = LSE[((size_t)0 * M + row) * 8 + h], l1 = LSE[((size_t)1 * M + row) * 8 + h], l2 = LSE[((size_t)2 * M + row) * 8 + h];
    const float mx = fmaxf(l0, fmaxf(l1, l2));
    float w0 = __builtin_amdgcn_exp2f(l0 - mx), w1 = __builtin_amdgcn_exp2f(l1 - mx), w2 = __builtin_amdgcn_exp2f(l2 - mx);
    const float inv = __builtin_amdgcn_rcpf(w0 + w1 + w2); w0 *= inv; w1 *= inv; w2 *= inv;
    const v4u a = *(const v4u*)(OP + ((size_t)0 * M + row) * 512 + lane * 8), b = *(const v4u*)(OP + ((size_t)1 * M + row) * 512 + lane * 8), c = *(const v4u*)(OP + ((size_t)2 * M + row) * 512 + lane * 8);
    float v[8]; float ss = 0.f;
#pragma unroll
    for (int j = 0; j < 4; ++j) { v[2 * j] = w0 * bflo(a[j]) + w1 * bflo(b[j]) + w2 * bflo(c[j]); v[2 * j + 1] = w0 * bfhi(a[j]) + w1 * bfhi(b[j]) + w2 * bfhi(c[j]); ss += v[2 * j] * v[2 * j] + v[2 * j + 1] * v[2 * j + 1]; }
    ss = wave_sum(ss);
    const float rinv = 1.0f / sqrtf(ss * (1.f / 512.f) + RMS_EPS);
    const f32x4 g0 = *(const f32x4*)(gain + lane * 8), g1 = *(const f32x4*)(gain + lane * 8 + 4);
    v4u w; w.x = pk2(v[0] * rinv * g0[0], v[1] * rinv * g0[1]); w.y = pk2(v[2] * rinv * g0[2], v[3] * rinv * g0[3]); w.z = pk2(v[4] * rinv * g1[0], v[5] * rinv * g1[1]); w.w = pk2(v[6] * rinv * g1[2], v[7] * rinv * g1[3]);
    *(v4u*)(MIX + (size_t)row * 1024 + lane * 8) = w;
}
constexpr int B1_IMG = 2048, B1_WLDS = 5 * B1_IMG + 1024;
DI float dpp_shr(float x, int n) { int v;
    switch (n) { case 1: v = __builtin_amdgcn_update_dpp(0, __builtin_bit_cast(int, x), 0x111, 0xf, 0xf, true); break; case 2: v = __builtin_amdgcn_update_dpp(0, __builtin_bit_cast(int, x), 0x112, 0xf, 0xf, true); break;
                 case 4: v = __builtin_amdgcn_update_dpp(0, __builtin_bit_cast(int, x), 0x114, 0xf, 0xf, true); break; default: v = __builtin_amdgcn_update_dpp(0, __builtin_bit_cast(int, x), 0x118, 0xf, 0xf, true); break; }
    return __builtin_bit_cast(float, v); }
struct RwkvP {
    const bf16* PR; const float* mu; const float* muv;
    const float *dbase, *ibase, *vbase, *ksk, *ksa, *brk, *gng, *gnb;
    const bf16 *dupT, *iupT, *vupT, *gupT;
    bf16 *VF, *VV; float* BON; float* GC; bf16 *W1S, *REFF, *BM; v4u* REC; float* YPRE; bf16* MIX; int layer0;
};
DI void lerp8(const bf16* PR, size_t row, bool hasprev, int col, const float* mu, float (&z)[8]) {
    const v4u cur = *(const v4u*)(PR + row * PRP + col); v4u prv = {0u, 0u, 0u, 0u}; if (hasprev) prv = *(const v4u*)(PR + (row - 1) * PRP + col);
    const f32x4 m0 = *(const f32x4*)(mu), m1 = *(const f32x4*)(mu + 4);
#pragma unroll
    for (int j = 0; j < 4; ++j) { const float a = bflo(cur[j]), b = bfhi(cur[j]), pa = bflo(prv[j]), pb = bfhi(prv[j]); const float ma = j < 2 ? m0[2 * j] : m1[2 * j - 4], mb = j < 2 ? m0[2 * j + 1] : m1[2 * j - 3];
        z[2 * j] = a + (pa - a) * ma; z[2 * j + 1] = b + (pb - b) * mb; }
}
DI f32x4 lerp4(const bf16* PR, size_t row, bool hasprev, int col, const float* mu) {
    const v2u cur = *(const v2u*)(PR + row * PRP + col); v2u prv = {0u, 0u}; if (hasprev) prv = *(const v2u*)(PR + (row - 1) * PRP + col);
    const f32x4 m = *(const f32x4*)(mu);
    f32x4 z; z[0] = bflo(cur.x) + (bflo(prv.x) - bflo(cur.x)) * m[0]; z[1] = bfhi(cur.x) + (bfhi(prv.x) - bfhi(cur.x)) * m[1];
    z[2] = bflo(cur.y) + (bflo(prv.y) - bflo(cur.y)) * m[2]; z[3] = bfhi(cur.y) + (bfhi(prv.y) - bfhi(cur.y)) * m[3]; return z;
}
DI void img_write(LAS unsigned char* img, const f32x4 (&x)[4], int fr, int fq) {
#pragma unroll
    for (int mb = 0; mb < 4; ++mb)
#pragma unroll
        for (int reg = 0; reg < 4; ++reg) *(LAS bf16*)(img + (16 * mb + 4 * fq + reg) * 32 + fr * 2) = (bf16)f2bf(x[mb][reg]);
}
DI bf16x8 lds4z(const LAS unsigned char* p) { const v2u t = *(const LAS v2u*)p; v4u w; w.x = t.x; w.y = t.y; w.z = 0u; w.w = 0u; return __builtin_bit_cast(bf16x8, w); }
DI void rwkv_b1_unit(const RwkvP& P, int unit, LAS unsigned char* wl, int lane) {
    asm volatile("" : "+v"(lane));
    const int fr = lane & 15, fq = lane >> 4;
    const int seq = unit >> 9, c = unit & 511, b = seq >> 3, h = seq & 7;
    const size_t row = (size_t)b * TSEQ + 16 * c + fr;
    const bool hasprev = (c | fr) != 0;
    const f32x4 z4 = {0.f, 0.f, 0.f, 0.f};
    bf16x8 tw[2], al[2], vl;
#pragma unroll
    for (int ks = 0; ks < 2; ++ks) { float z[8]; lerp8(P.PR, row, hasprev, 1536 + 8 * fq + 32 * ks, P.mu + 1536 + 8 * fq + 32 * ks, z);
        tw[ks] = pk8(ftanh(z[0]), ftanh(z[1]), ftanh(z[2]), ftanh(z[3]), ftanh(z[4]), ftanh(z[5]), ftanh(z[6]), ftanh(z[7]));
        lerp8(P.PR, row, hasprev, 1600 + 8 * fq + 32 * ks, P.mu + 1600 + 8 * fq + 32 * ks, z); al[ks] = pk8(z[0], z[1], z[2], z[3], z[4], z[5], z[6], z[7]); }
    if (!P.layer0) { float z[8]; lerp8(P.PR, row, hasprev, 1792 + 8 * fq, P.muv + 8 * fq, z); vl = pk8(z[0], z[1], z[2], z[3], z[4], z[5], z[6], z[7]); }
    f32x4 zr[4], k2[4], kk[4], ai[4], ld[4];
    float nrm = 0.f, bon = 0.f;
#pragma unroll
    for (int mb = 0; mb < 4; ++mb) { const int ch = h * 64 + 16 * mb + 4 * fq; const int n = h * 64 + 16 * mb + fr;
        f32x4 dw = z4, da = z4, dv = z4;
        dw = mfma16(ld8(P.dupT + (size_t)n * 64 + 8 * fq), tw[0], dw); dw = mfma16(ld8(P.dupT + (size_t)n * 64 + 8 * fq + 32), tw[1], dw);
        da = mfma16(ld8(P.iupT + (size_t)n * 64 + 8 * fq), al[0], da); da = mfma16(ld8(P.iupT + (size_t)n * 64 + 8 * fq + 32), al[1], da);
        if (!P.layer0) dv = mfma16(ld8(P.vupT + (size_t)n * 32 + 8 * fq), vl, z4);
        zr[mb] = lerp4(P.PR, row, hasprev, ch, P.mu + ch);
        const f32x4 zk = lerp4(P.PR, row, hasprev, 512 + ch, P.mu + 512 + ch);
        f32x4 zv = lerp4(P.PR, row, hasprev, 1024 + ch, P.mu + 1024 + ch);
        const f32x4 db = *(const f32x4*)(P.dbase + ch), ib = *(const f32x4*)(P.ibase + ch), sk = *(const f32x4*)(P.ksk + ch), sa = *(const f32x4*)(P.ksa + ch), br = *(const f32x4*)(P.brk + ch);
        if (P.layer0) { v2u w; w.x = pk2(zv[0], zv[1]); w.y = pk2(zv[2], zv[3]); *(v2u*)(P.VF + row * 512 + ch) = w; }
        else { const v2u f = *(const v2u*)(P.VF + row * 512 + ch); const f32x4 vb = *(const f32x4*)(P.vbase + ch); const f32x4 vf = {bflo(f.x), bfhi(f.x), bflo(f.y), bfhi(f.y)};
#pragma unroll
            for (int e = 0; e < 4; ++e) zv[e] = zv[e] + (vf[e] - zv[e]) * fsigmoid(vb[e] + dv[e]); }
        { v2u w; w.x = pk2(zv[0], zv[1]); w.y = pk2(zv[2], zv[3]); *(v2u*)(P.VV + row * 512 + ch) = w; }
#pragma unroll
        for (int reg = 0; reg < 4; ++reg) *(LAS bf16*)(wl + 2 * B1_IMG + (16 * mb + 4 * fq + reg) * 32 + fr * 2) = (bf16)f2bf(zv[reg]);
#pragma unroll
        for (int e = 0; e < 4; ++e) {
            const float w = -fsoftplus(-(db[e] + dw[e])) - 0.5f; ld[mb][e] = -fexp(w);
            const float a = fsigmoid(ib[e] + da[e]); ai[mb][e] = a;
            const float kr = zk[e] * sk[e]; kk[mb][e] = kr; nrm += kr * kr;
            const float kx = zk[e] * (1.f + (a - 1.f) * sa[e]); k2[mb][e] = kx; bon += zr[mb][e] * kx * br[e]; }
        asm volatile("" ::: "memory");
    }
    nrm += __shfl_xor(nrm, 16); nrm += __shfl_xor(nrm, 32); bon += __shfl_xor(bon, 16); bon += __shfl_xor(bon, 32);
    if (fq == 0) P.BON[row * 8 + h] = bon;
    const float kinv = 1.0f / fmaxf(sqrtf(nrm), 1e-12f);
    f32x4 rt[4], kh[4];
    bf16x8 pa[2], pb[2], pk[2], pr[2];
#pragma unroll
    for (int ks = 0; ks < 2; ++ks) {
        f32x4 at2[2], bt2[2], kt2[2];
#pragma unroll
        for (int m2 = 0; m2 < 2; ++m2) { const int mb = 2 * ks + m2;
            f32x4 gcv, bhv;
#pragma unroll
            for (int e = 0; e < 4; ++e) {
                float lg = ld[mb][e]; lg += dpp_shr(lg, 1); lg += dpp_shr(lg, 2); lg += dpp_shr(lg, 4); lg += dpp_shr(lg, 8);
                const float lgc = __shfl(lg, lane | 15);
                const float kn = kk[mb][e] * kinv, bb = kn * ai[mb][e];
                const float en = fexp(-lg), ec = fexp(lgc - lg);
                at2[m2][e] = -kn * fexp(lg - ld[mb][e]); bt2[m2][e] = bb * en; kt2[m2][e] = k2[mb][e] * en; rt[mb][e] = zr[mb][e] * fexp(lg);
                bhv[e] = bb * ec; kh[mb][e] = k2[mb][e] * ec; gcv[e] = fexp(lgc); }
            if (fr == 0) *(f32x4*)(P.GC + (size_t)unit * 64 + 16 * mb + 4 * fq) = gcv;
#pragma unroll
            for (int reg = 0; reg < 4; ++reg) { const int o = (16 * mb + 4 * fq + reg) * 32 + fr * 2;
                *(LAS bf16*)(wl + 0 * B1_IMG + o) = (bf16)f2bf(at2[m2][reg]); *(LAS bf16*)(wl + 1 * B1_IMG + o) = (bf16)f2bf(bhv[reg]); }
        }
        pa[ks] = pk8v(at2[0], at2[1]); pb[ks] = pk8v(bt2[0], bt2[1]); pk[ks] = pk8v(kt2[0], kt2[1]); pr[ks] = pk8v(rt[2 * ks], rt[2 * ks + 1]);
    }
    const f32x4 z4b = {0.f, 0.f, 0.f, 0.f};
    f32x4 Aab = mfma16(pb[1], pa[1], mfma16(pb[0], pa[0], z4b));
    f32x4 AakT = mfma16(pa[1], pk[1], mfma16(pa[0], pk[0], z4b));
    f32x4 Arb = mfma16(pb[1], pr[1], mfma16(pb[0], pr[0], z4b));
    f32x4 Ark = mfma16(pk[1], pr[1], mfma16(pk[0], pr[0], z4b));
#pragma unroll
    for (int e = 0; e < 4; ++e) { const int rr = 4 * fq + e; Aab[e] = rr < fr ? Aab[e] : 0.f; AakT[e] = fr < rr ? AakT[e] : 0.f; Arb[e] = rr <= fr ? Arb[e] : 0.f; Ark[e] = rr <= fr ? Ark[e] : 0.f; }
    LAS float* As = (LAS float*)(wl + 5 * B1_IMG);
#pragma unroll
    for (int e = 0; e < 4; ++e) As[(4 * fq + e) * 16 + fr] = Aab[e];
    LDS_WAIT();
    float x[16];
#pragma unroll
    for (int s = 15; s >= 0; --s) { float acc = (s == fr) ? 1.f : 0.f;
        const f32x4 r0 = *(const LAS f32x4*)(As + s * 16), r1 = *(const LAS f32x4*)(As + s * 16 + 4), r2 = *(const LAS f32x4*)(As + s * 16 + 8), r3 = *(const LAS f32x4*)(As + s * 16 + 12);
        const float rowv[16] = {r0[0], r0[1], r0[2], r0[3], r1[0], r1[1], r1[2], r1[3], r2[0], r2[1], r2[2], r2[3], r3[0], r3[1], r3[2], r3[3]};
#pragma unroll
        for (int uu = s + 1; uu < 16; ++uu) acc += rowv[uu] * x[uu];
        x[s] = acc; if ((s & 1) == 0) asm volatile("" ::: "memory"); }
    f32x4 xs;
#pragma unroll
    for (int e = 0; e < 4; ++e) xs[e] = fq == 0 ? x[e] : fq == 1 ? x[4 + e] : fq == 2 ? x[8 + e] : x[12 + e];
    const bf16x8 Tsel = pk4z(xs);
    f32x4 W1[4];
#pragma unroll
    for (int mb = 0; mb < 4; ++mb) W1[mb] = mfma16(lds4z(wl + 0 * B1_IMG + (16 * mb + fr) * 32 + 8 * fq), Tsel, z4);
    const f32x4 GT = mfma16(Tsel, pk4z(AakT), z4);
    img_write(wl + 3 * B1_IMG, W1, fr, fq);
    f32x4 M1T[4];
    const bf16x8 GTp = pk4z(GT);
#pragma unroll
    for (int mb = 0; mb < 4; ++mb) M1T[mb] = mfma16(lds4z(wl + 1 * B1_IMG + (16 * mb + fr) * 32 + 8 * fq), GTp, kh[mb]);
    img_write(wl + 4 * B1_IMG, M1T, fr, fq);
    LDS_WAIT();
    const bf16x8 Arbp = pk4z(Arb);
    f32x4 RE[4];
#pragma unroll
    for (int mb = 0; mb < 4; ++mb) RE[mb] = mfma16(lds4z(wl + 3 * B1_IMG + (16 * mb + fr) * 32 + 8 * fq), Arbp, rt[mb]);
    const f32x4 M2 = mfma16(GTp, Arbp, Ark);
    {   bf16* w1s = P.W1S + ((size_t)unit * 16 + fr) * 64; bf16* re = P.REFF + ((size_t)unit * 16 + fr) * 64;
#pragma unroll
        for (int mb = 0; mb < 4; ++mb) { const int sg = (mb >> 1) * 32 + fq * 8 + (mb & 1) * 4;
            v2u w; w.x = pk2(W1[mb][0], W1[mb][1]); w.y = pk2(W1[mb][2], W1[mb][3]); *(v2u*)(w1s + sg) = w;
            w.x = pk2(RE[mb][0], RE[mb][1]); w.y = pk2(RE[mb][2], RE[mb][3]); *(v2u*)(re + sg) = w; }
        const v2u m2p = {pk2(M2[0], M2[1]), pk2(M2[2], M2[3])};
#pragma unroll
        for (int mb = 0; mb < 4; ++mb) {
            const v2u bq = *(const LAS v2u*)(wl + 1 * B1_IMG + (16 * mb + fr) * 32 + 8 * fq), mq = *(const LAS v2u*)(wl + 4 * B1_IMG + (16 * mb + fr) * 32 + 8 * fq);
            *(v4u*)(P.BM + (((size_t)unit * 64 + 16 * mb + fr) * 4 + fq) * 8) = (v4u){bq.x, bq.y, mq.x, mq.y};
            const v2u vq = *(const LAS v2u*)(wl + 2 * B1_IMG + (16 * mb + fr) * 32 + 8 * fq);
            P.REC[((size_t)unit * 4 + mb) * 64 + lane] = (v4u){vq.x, vq.y, m2p.x, m2p.y}; }
    }
    LDS_WAIT();
}
struct ChainIn { bf16x8 w1[2], re[2], bm[4]; v4u rec; f32x4 gc[4]; };
DI void chain_load(ChainIn& c, const RwkvP& P, int unit, int rb, int lane) {
    const int fr = lane & 15, fq = lane >> 4;
    const bf16* w1s = P.W1S + ((size_t)unit * 16 + fr) * 64 + fq * 8; const bf16* re = P.REFF + ((size_t)unit * 16 + fr) * 64 + fq * 8;
    c.w1[0] = ld8(w1s); c.w1[1] = ld8(w1s + 32); c.re[0] = ld8(re); c.re[1] = ld8(re + 32);
#pragma unroll
    for (int mb = 0; mb < 4; ++mb) { c.bm[mb] = ld8(P.BM + (((size_t)unit * 64 + 16 * mb + fr) * 4 + fq) * 8); c.gc[mb] = *(const f32x4*)(P.GC + (size_t)unit * 64 + 16 * mb + 4 * fq); }
    c.rec = P.REC[((size_t)unit * 4 + rb) * 64 + lane];
}
DI void chain_step(f32x4 (&S)[4], const ChainIn& c, float* ypre  ) {
    const f32x4 z4 = {0.f, 0.f, 0.f, 0.f};
    const bf16x8 b0 = pk8v(S[0], S[1]), b1 = pk8v(S[2], S[3]);
    f32x4 ut = mfma16(c.w1[1], b1, mfma16(c.w1[0], b0, z4));
    v4u vlo; vlo.x = c.rec.x; vlo.y = c.rec.y; vlo.z = 0u; vlo.w = 0u;
    v4u m2a; m2a.x = c.rec.z; m2a.y = c.rec.w; m2a.z = 0u; m2a.w = 0u;
    f32x4 y = mfma16(__builtin_bit_cast(bf16x8, m2a), __builtin_bit_cast(bf16x8, vlo), z4);
    y = mfma16(c.re[0], b0, y); y = mfma16(c.re[1], b1, y);
#pragma unroll
    for (int e = 0; e < 4; ++e) ypre[(size_t)e * 512] = y[e];
    v4u uv; uv.x = pk2(ut[0], ut[1]); uv.y = pk2(ut[2], ut[3]); uv.z = c.rec.x; uv.w = c.rec.y;
    const bf16x8 ub = __builtin_bit_cast(bf16x8, uv);
#pragma unroll
    for (int mb = 0; mb < 4; ++mb) S[mb] = mfma16(c.bm[mb], ub, S[mb] * c.gc[mb]);
}
DI void rwkv_chain(const RwkvP& P, int seq, int rb, float* wkv_out  , int lane) {
    const int fr = lane & 15, fq = lane >> 4, b = seq >> 3, h = seq & 7;
    f32x4 S[4]; for (int mb = 0; mb < 4; ++mb) S[mb] = (f32x4){0.f, 0.f, 0.f, 0.f};
    float* yp = P.YPRE + ((size_t)b * TSEQ + 4 * fq) * 512 + h * 64 + 16 * rb + fr;
    ChainIn ca, cb;
    chain_load(ca, P, seq * NCH, rb, lane);
    for (int c = 0; c < NCH; c += 2) {
        chain_load(cb, P, seq * NCH + c + 1, rb, lane);
        chain_step(S, ca, yp + (size_t)c * 16 * 512);
        if (c + 2 < NCH) chain_load(ca, P, seq * NCH + c + 2, rb, lane);
        chain_step(S, cb, yp + (size_t)(c + 1) * 16 * 512);
    }
#pragma unroll
    for (int mb = 0; mb < 4; ++mb) *(f32x4*)(wkv_out + (size_t)(16 * rb + fr) * 64 + 16 * mb + 4 * fq) = S[mb];
}
DI void rwkv_b3_unit(const RwkvP& P, int unit, int lane) {
    asm volatile("" : "+v"(lane));
    const int fr = lane & 15, fq = lane >> 4;
    const int seq = unit >> 9, c = unit & 511, b = seq >> 3, h = seq & 7;
    const size_t row = (size_t)b * TSEQ + 16 * c + fr;
    const bool hasprev = (c | fr) != 0;
    const f32x4 z4 = {0.f, 0.f, 0.f, 0.f};
    bf16x8 sg[4];
#pragma unroll
    for (int ks = 0; ks < 4; ++ks) { float z[8]; lerp8(P.PR, row, hasprev, 1664 + 8 * fq + 32 * ks, P.mu + 1664 + 8 * fq + 32 * ks, z);
        sg[ks] = pk8(fsigmoid(z[0]), fsigmoid(z[1]), fsigmoid(z[2]), fsigmoid(z[3]), fsigmoid(z[4]), fsigmoid(z[5]), fsigmoid(z[6]), fsigmoid(z[7])); }
    f32x4 g[4], y[4]; float s = 0.f;
#pragma unroll
    for (int mb = 0; mb < 4; ++mb) { const int n = h * 64 + 16 * mb + fr; f32x4 a = z4;
#pragma unroll
        for (int ks = 0; ks < 4; ++ks) a = mfma16(ld8(P.gupT + (size_t)n * 128 + 8 * fq + 32 * ks), sg[ks], a);
        g[mb] = a;
        y[mb] = *(const f32x4*)(P.YPRE + row * 512 + h * 64 + 16 * mb + 4 * fq); s += (y[mb][0] + y[mb][1]) + (y[mb][2] + y[mb][3]); }
    s += __shfl_xor(s, 16); s += __shfl_xor(s, 32);
    const float mean = s * (1.f / 64.f); float q = 0.f;
#pragma unroll
    for (int mb = 0; mb < 4; ++mb) { y[mb] = y[mb] - mean; q += (y[mb][0] * y[mb][0] + y[mb][1] * y[mb][1]) + (y[mb][2] * y[mb][2] + y[mb][3] * y[mb][3]); }
    q += __shfl_xor(q, 16); q += __shfl_xor(q, 32);
    const float rstd = 1.0f / sqrtf(q * (1.f / 64.f) + GN_EPS);
    const float bon = P.BON[row * 8 + h];
#pragma unroll
    for (int mb = 0; mb < 4; ++mb) { const int ch = h * 64 + 16 * mb + 4 * fq;
        const f32x4 gg = *(const f32x4*)(P.gng + ch), gb = *(const f32x4*)(P.gnb + ch); const v2u vw = *(const v2u*)(P.VV + row * 512 + ch);
        const f32x4 v = {bflo(vw.x), bfhi(vw.x), bflo(vw.y), bfhi(vw.y)};
        const f32x4 o = (y[mb] * rstd * gg + gb + v * bon) * g[mb];
        v2u w; w.x = pk2(o[0], o[1]); w.y = pk2(o[2], o[3]); *(v2u*)(P.MIX + row * 1024 + 512 + ch) = w; }
}
DI f32x16 dec_gemm(const bf16* A, const bf16* Wt, int K, int lane) {
    const int r = lane & 31, h = lane >> 5;
    const bf16* ap = A + (size_t)r * K + 8 * h; const bf16* bp = Wt + (size_t)r * K + 8 * h;
    f32x16 acc; for (int i = 0; i < 16; ++i) acc[i] = 0.f;
#pragma unroll 8
    for (int k = 0; k < K; k += 16) acc = mfma32(ld8(ap + k), ld8(bp + k), acc);
    return acc;
}
DI void dec_row_stats(const float* st, LAS float* sc, int lane) {
    if (lane < 32) { float s = 0.f, q = 0.f; const f32x4* p = (const f32x4*)(st + (size_t)lane * 64);
#pragma unroll
        for (int i = 0; i < 16; ++i) { const f32x4 v = p[i]; s += v[0] + v[2]; q += v[1] + v[3]; }
        const float mu = s * (1.f / 1024.f), var = fmaxf(q * (1.f / 1024.f) - mu * mu, 0.f); sc[2 * lane] = mu; sc[2 * lane + 1] = 1.0f / sqrtf(var + LN_EPS); }
    LDS_WAIT();
}
struct DecP {
    unsigned char* dec; int l;
    const float* xs;
    const float *c1in, *c2in, *c1up, *c2up, *g1, *b1, *g2p, *b2p;
    const bf16 *win, *winu, *wout, *wup, *wdn;
    float* out;
};
DI void dec_unit_in(const DecP& D, int u, LAS float* sc, int lane) {
    const int r32 = lane & 31, hi = lane >> 5;
    if (u < 105) {
        const int n = 32 * u + r32; const bool fold = D.l > 0;
        const f32x16 acc = dec_gemm((const bf16*)(D.dec + DEC_XB2), D.win + (size_t)(32 * u) * DM, DM, lane);
        if (fold) dec_row_stats((const float*)(D.dec + DEC_ST2), sc, lane);
        const float c1 = fold ? D.c1in[n] : 0.f, c2 = fold ? D.c2in[n] : 0.f; const int on = n < 1024 ? swap45(n) : n;
        float* PD = (float*)(D.dec + DEC_PD);
#pragma unroll
        for (int i = 0; i < 16; ++i) { const int row = crow(i, hi); float mu = 0.f, rs = 1.f; if (fold) { mu = sc[2 * row]; rs = sc[2 * row + 1]; } PD[(size_t)row * NIN + on] = (acc[i] - mu * c1) * rs + c2; }
    } else {
        const int v = u - 105, n = 32 * v + r32;
        const f32x16 acc = dec_gemm((const bf16*)(D.dec + DEC_SHB) + (size_t)D.l * MD * DM, D.winu + (size_t)(32 * v) * DM, DM, lane);
        float* PS = (float*)(D.dec + DEC_PS);
#pragma unroll
        for (int i = 0; i < 16; ++i) PS[(size_t)crow(i, hi) * NRWU + n] = acc[i];
    }
    LDS_WAIT();
}
DI void dec_unit_res(const bf16* A, const bf16* Wt, int K, int u, bool raw, const float* src, const float* sstat, const float* g, const float* b, float* T, bf16* XB, float* ostat, float* shiftout, LAS float* sc, int lane) {
    const int r32 = lane & 31, hi = lane >> 5, n = 32 * u + r32;
    const f32x16 acc = dec_gemm(A, Wt + (size_t)(32 * u) * K, K, lane);
    if (!raw) dec_row_stats(sstat, sc, lane);
    const float gg = raw ? 1.f : g[n], bb = raw ? 0.f : b[n];
#pragma unroll
    for (int i = 0; i < 16; ++i) { const int row = crow(i, hi); float mu = 0.f, rs = 1.f; if (!raw) { mu = sc[2 * row]; rs = sc[2 * row + 1]; }
        const float x = (src[(size_t)row * DM + n] - mu) * rs * gg + bb; const float t = ALPHA * x + acc[i];
        T[(size_t)row * DM + n] = t; XB[(size_t)row * DM + n] = (bf16)f2bf(t); if (shiftout) shiftout[(size_t)row * DM + n] = x;
        float s = t, q = t * t;
#pragma unroll
        for (int o = 1; o < 32; o <<= 1) { s += __shfl_xor(s, o); q += __shfl_xor(q, o); }
        if (r32 == 0) { ostat[((size_t)row * 32 + u) * 2] = s; ostat[((size_t)row * 32 + u) * 2 + 1] = q; } }
    LDS_WAIT();
}
DI void dec_unit_up(const DecP& D, int u, LAS float* sc, int lane) {
    const int r32 = lane & 31, hi = lane >> 5, n = 32 * u + r32;
    const f32x16 acc = dec_gemm((const bf16*)(D.dec + DEC_XB1), D.wup + (size_t)(32 * u) * DM, DM, lane);
    dec_row_stats((const float*)(D.dec + DEC_ST1), sc, lane);
    const float c1 = D.c1up[n], c2 = D.c2up[n]; bf16* HB = (bf16*)(D.dec + DEC_HB);
#pragma unroll
    for (int i = 0; i < 16; ++i) { const int row = crow(i, hi); const float v = fmaxf((acc[i] - sc[2 * row] * c1) * sc[2 * row + 1] + c2, 0.f); HB[(size_t)row * FFD + n] = (bf16)f2bf(v * v); }
    LDS_WAIT();
}
DI void dec_attn_task(const DecP& D, const float* ck, const float* cv, const float* rope, int bd, int h, int p, int lane) {
    const int g = lane >> 4, dq = lane & 15, dd = 1 << (2 * p);
    const float* PD = (const float*)(D.dec + DEC_PD) + (size_t)bd * NIN;
    const f32x4 rr0 = *(const f32x4*)(rope + ((size_t)8192 * 32 + ((4 * dq) & 31)) * 2), rr1 = *(const f32x4*)(rope + ((size_t)8192 * 32 + ((4 * dq) & 31)) * 2 + 4);
    const f32x4 cs = {rr0[0], rr0[2], rr1[0], rr1[2]}, sn = {rr0[1], rr0[3], rr1[1], rr1[3]};
    const float sgn = dq < 8 ? -1.f : 1.f;
    f32x4 q = *(const f32x4*)(PD + h * 64 + 4 * dq), kn = *(const f32x4*)(PD + 512 + h * 64 + 4 * dq); const f32x4 vn = *(const f32x4*)(PD + 1024 + h * 64 + 4 * dq);
    { f32x4 qp, kp;
#pragma unroll
      for (int e = 0; e < 4; ++e) { qp[e] = __shfl_xor(q[e], 8); kp[e] = __shfl_xor(kn[e], 8); }
      q = q * cs + qp * sn * sgn; kn = kn * cs + kp * sn * sgn; }
    if (p == 0 && g == 0) { *(f32x4*)(D.out + O_KS + ((size_t)D.l * MD + bd) * 512 + h * 64 + 4 * dq) = kn; *(f32x4*)(D.out + O_VS + ((size_t)D.l * MD + bd) * 512 + h * 64 + 4 * dq) = vn; }
    float s0 = (q[0] * kn[0] + q[1] * kn[1]) + (q[2] * kn[2] + q[3] * kn[3]);
#pragma unroll
    for (int o = 1; o < 16; o <<= 1) s0 += __shfl_xor(s0, o);
    s0 *= 0.125f;
    const size_t cbase = (((size_t)D.l * MD + bd) * 2048) * 512 + h * 64 + 4 * dq;
    float mx = -INFINITY, den = 0.f; f32x4 o4 = {0.f, 0.f, 0.f, 0.f};
#pragma unroll 4
    for (int it = 0; it < 32; ++it) { const int j = 1 + 4 * it + g; const size_t off = cbase + (size_t)(2048 - j * dd) * 512;
        const f32x4 kr = *(const f32x4*)(ck + off); const f32x4 vr = *(const f32x4*)(cv + off);
        float s = (q[0] * kr[0] + q[1] * kr[1]) + (q[2] * kr[2] + q[3] * kr[3]);
#pragma unroll
        for (int o = 1; o < 16; o <<= 1) s += __shfl_xor(s, o);
        s *= 0.125f;
        const float mn = fmaxf(mx, s), sc = fexp(mx - mn), pj = fexp(s - mn);
        den = den * sc + pj; o4 = o4 * sc + vr * pj; mx = mn; }
    float mg = fmaxf(mx, __shfl_xor(mx, 16)); mg = fmaxf(mg, __shfl_xor(mg, 32)); mg = fmaxf(mg, s0);
    { const float sc = fexp(mx - mg); den *= sc; o4 = o4 * sc; }
    den += __shfl_xor(den, 16); den += __shfl_xor(den, 32);
#pragma unroll
    for (int e = 0; e < 4; ++e) { o4[e] += __shfl_xor(o4[e], 16); o4[e] += __shfl_xor(o4[e], 32); }
    const float p0 = fexp(s0 - mg); den += p0; o4 = (o4 + vn * p0) * (1.0f / den); mx = mg;
    if (g == 0) *(f32x4*)((float*)(D.dec + DEC_OP) + ((size_t)p * MD + bd) * 512 + h * 64 + 4 * dq) = o4;
    if (lane == 0) ((float*)(D.dec + DEC_LSE))[((size_t)p * MD + bd) * 8 + h] = mx + __logf(den);
}
DI void dec_rwkv_task(const DecP& D, const float* const* in, int bd, int h, LAS float* sv  , int lane) {
    const int l = D.l, ch = h * 64 + lane;
    const float* PD = (const float*)(D.dec + DEC_PD) + (size_t)bd * NIN + RW0; const float* PS = (const float*)(D.dec + DEC_PS) + (size_t)bd * NRWU;
    const float* mu = in[8] + (size_t)l * 1792;
    auto zf = [&](int col) { const float pr = PD[col], pv = PS[col]; return pr + (pv - pr) * mu[col]; };
    const float zr = zf(ch), zk = zf(512 + ch), zv0 = zf(1024 + ch);
    float vl = 0.f; if (l > 0 && lane < 32) { const float pr = PD[1792 + lane], pv = PS[1792 + lane]; vl = pr + (pv - pr) * in[9][(size_t)(l - 1) * 32 + lane]; }
    sv[lane] = ftanh(zf(1536 + lane)); sv[64 + lane] = zf(1600 + lane); sv[128 + lane] = fsigmoid(zf(1664 + lane)); sv[192 + lane] = fsigmoid(zf(1728 + lane)); sv[256 + lane] = vl;
    LDS_WAIT();
    float dw = 0.f, da = 0.f, dv = 0.f, gt = 0.f;
    const float* du = in[11] + (size_t)l * 64 * 512 + ch; const float* iu = in[13] + (size_t)l * 64 * 512 + ch; const float* gu = in[14] + (size_t)l * 128 * 512 + ch;
#pragma unroll 2
    for (int m4 = 0; m4 < 16; ++m4) { const f32x4 a = *(const LAS f32x4*)(sv + 4 * m4), b = *(const LAS f32x4*)(sv + 64 + 4 * m4), c = *(const LAS f32x4*)(sv + 128 + 4 * m4), d = *(const LAS f32x4*)(sv + 192 + 4 * m4);
#pragma unroll
        for (int e = 0; e < 4; ++e) { const int m = 4 * m4 + e; dw += a[e] * du[(size_t)m * 512]; da += b[e] * iu[(size_t)m * 512]; gt += c[e] * gu[(size_t)m * 512] + d[e] * gu[(size_t)(64 + m) * 512]; } }
    if (l > 0) { const float* vu = in[16] + (size_t)(l - 1) * 32 * 512 + ch;
#pragma unroll 2
        for (int m4 = 0; m4 < 8; ++m4) { const f32x4 a = *(const LAS f32x4*)(sv + 256 + 4 * m4);
#pragma unroll
            for (int e = 0; e < 4; ++e) dv += a[e] * vu[(size_t)(4 * m4 + e) * 512]; } }
    const float w = -fsoftplus(-(in[10][(size_t)l * 512 + ch] + dw)) - 0.5f, decay = fexp(-fexp(w));
    const float a = fsigmoid(in[12][(size_t)l * 512 + ch] + da);
    float* VFD = (float*)(D.dec + DEC_VF) + (size_t)bd * 512 + ch;
    float v = zv0; if (l == 0) *VFD = zv0; else v = zv0 + (*VFD - zv0) * fsigmoid(in[15][(size_t)(l - 1) * 512 + ch] + dv);
    const float kr = zk * in[17][(size_t)l * 512 + ch]; const float kn = kr / fmaxf(sqrtf(wave_sum(kr * kr)), 1e-12f);
    const float k2 = zk * (1.f + (a - 1.f) * in[18][(size_t)l * 512 + ch]);
    const float bon = wave_sum(zr * k2 * in[19][(size_t)l * 512 + ch]);
    LDS_WAIT();
    sv[320 + lane] = -kn; sv[384 + lane] = decay; sv[448 + lane] = kn * a; sv[512 + lane] = k2; sv[576 + lane] = zr;
    LDS_WAIT();
    const float* S0 = in[3] + ((((size_t)l * MD + bd) * NH + h) * 64 + lane) * 64;
    float* So = D.out + O_WKS + ((((size_t)l * MD + bd) * NH + h) * 64 + lane) * 64;
    float sa = 0.f;
#pragma unroll 4
    for (int q = 0; q < 16; ++q) { const f32x4 s4 = *(const f32x4*)(S0 + 4 * q), a4 = *(const LAS f32x4*)(sv + 320 + 4 * q); sa += (s4[0] * a4[0] + s4[1] * a4[1]) + (s4[2] * a4[2] + s4[3] * a4[3]); }
    float y = 0.f;
#pragma unroll 4
    for (int q = 0; q < 16; ++q) { f32x4 s4 = *(const f32x4*)(S0 + 4 * q); const f32x4 w4 = *(const LAS f32x4*)(sv + 384 + 4 * q), b4 = *(const LAS f32x4*)(sv + 448 + 4 * q), k4 = *(const LAS f32x4*)(sv + 512 + 4 * q), r4 = *(const LAS f32x4*)(sv + 576 + 4 * q);
        s4 = s4 * w4 + b4 * sa + k4 * v; *(f32x4*)(So + 4 * q) = s4; y += (s4[0] * r4[0] + s4[1] * r4[1]) + (s4[2] * r4[2] + s4[3] * r4[3]); }
    const float mean = wave_sum(y) * (1.f / 64.f), dy = y - mean, var = wave_sum(dy * dy) * (1.f / 64.f);
    const float o = (dy * (1.0f / sqrtf(var + GN_EPS)) * in[20][(size_t)l * 512 + ch] + in[21][(size_t)l * 512 + ch] + bon * v) * gt;
    ((float*)(D.dec + DEC_MIX))[(size_t)bd * DM + 512 + ch] = o;
    LDS_WAIT();
}
DI void dec_finalize_row(const DecP& D, const float* gain, int bd, int lane) {
    const int h = lane >> 3; const float* L = (const float*)(D.dec + DEC_LSE); const float* OPD = (const float*)(D.dec + DEC_OP);
    const float l0 = L[((size_t)0 * MD + bd) * 8 + h], l1 = L[((size_t)1 * MD + bd) * 8 + h], l2 = L[((size_t)2 * MD + bd) * 8 + h];
    const float mx = fmaxf(l0, fmaxf(l1, l2)); float w0 = fexp(l0 - mx), w1 = fexp(l1 - mx), w2 = fexp(l2 - mx); const float inv = 1.0f / (w0 + w1 + w2); w0 *= inv; w1 *= inv; w2 *= inv;
    float v[8]; float ss = 0.f;
#pragma unroll
    for (int e = 0; e < 8; ++e) { v[e] = w0 * OPD[((size_t)0 * MD + bd) * 512 + lane * 8 + e] + w1 * OPD[((size_t)1 * MD + bd) * 512 + lane * 8 + e] + w2 * OPD[((size_t)2 * MD + bd) * 512 + lane * 8 + e]; ss += v[e] * v[e]; }
    ss = wave_sum(ss); const float rinv = 1.0f / sqrtf(ss * (1.f / 512.f) + RMS_EPS);
    bf16* MB = (bf16*)(D.dec + DEC_MIXB) + (size_t)bd * DM; const float* MX = (const float*)(D.dec + DEC_MIX) + (size_t)bd * DM + 512;
#pragma unroll
    for (int e = 0; e < 8; ++e) { MB[lane * 8 + e] = (bf16)f2bf(v[e] * rinv * gain[lane * 8 + e]); MB[512 + lane * 8 + e] = (bf16)f2bf(MX[lane * 8 + e]); }
}
#ifndef PH_MASK
#define PH_MASK 0x1ff
#endif
#define PH_ON(k) ((PH_MASK >> (k)) & 1)
DI unsigned lds_task_next(volatile LAS unsigned* ctr, int lane) {
    unsigned t = 0; if (lane == 0) t = __hip_atomic_fetch_add((LAS unsigned*)ctr, 1u, __ATOMIC_RELAXED, __HIP_MEMORY_SCOPE_WORKGROUP);
    return (unsigned)__builtin_amdgcn_readfirstlane((int)t);
}
DI DecP make_dec(unsigned char* ws, const float* const* in, float* out, int l) {
    DecP D; D.dec = ws + WS_DEC; D.l = l; D.xs = in[1];
    D.c1in = (const float*)(ws + WS_C1IN) + l * NIN; D.c2in = (const float*)(ws + WS_C2IN) + l * NIN; D.c1up = (const float*)(ws + WS_C1UP) + l * FFD; D.c2up = (const float*)(ws + WS_C2UP) + l * FFD;
    D.g1 = in[24] + (size_t)l * DM; D.b1 = in[25] + (size_t)l * DM; D.g2p = l > 0 ? in[28] + (size_t)(l - 1) * DM : nullptr; D.b2p = l > 0 ? in[29] + (size_t)(l - 1) * DM : nullptr;
    D.win = (const bf16*)(ws + WS_WIN) + (size_t)l * NIN * DM; D.winu = (const bf16*)(ws + WS_WINU) + (size_t)l * NRWU * DM; D.wout = (const bf16*)(ws + WS_WOUT) + (size_t)l * DM * DM;
    D.wup = (const bf16*)(ws + WS_WUP) + (size_t)l * FFD * DM; D.wdn = (const bf16*)(ws + WS_WDN) + (size_t)l * DM * FFD; D.out = out; return D;
}
DI RwkvP make_rwkv(unsigned char* ws, const float* const* in, int l) {
    RwkvP R; R.PR = (const bf16*)(ws + WS_PR); R.mu = in[8] + (size_t)l * 1792; R.muv = l > 0 ? in[9] + (size_t)(l - 1) * 32 : nullptr;
    R.dbase = in[10] + (size_t)l * 512; R.ibase = in[12] + (size_t)l * 512; R.vbase = l > 0 ? in[15] + (size_t)(l - 1) * 512 : nullptr; R.ksk = in[17] + (size_t)l * 512; R.ksa = in[18] + (size_t)l * 512; R.brk = in[19] + (size_t)l * 512;
    R.gng = in[20] + (size_t)l * 512; R.gnb = in[21] + (size_t)l * 512;
    R.dupT = (const bf16*)(ws + WS_DUPT) + (size_t)l * 512 * 64; R.iupT = (const bf16*)(ws + WS_IUPT) + (size_t)l * 512 * 64; R.vupT = l > 0 ? (const bf16*)(ws + WS_VUPT) + (size_t)(l - 1) * 512 * 32 : nullptr; R.gupT = (const bf16*)(ws + WS_GUPT) + (size_t)l * 512 * 128;
    R.VF = (bf16*)(ws + WS_VF); R.VV = (bf16*)(ws + WS_VV); R.BON = (float*)(ws + WS_BON); R.GC = (float*)(ws + WS_GC); R.W1S = (bf16*)(ws + WS_PT); R.REFF = (bf16*)(ws + WS_REFF); R.BM = (bf16*)(ws + WS_QT); R.REC = (v4u*)(ws + WS_YLOC);
    R.YPRE = (float*)(ws + WS_YPRE); R.MIX = (bf16*)(ws + WS_MIX); R.layer0 = (l == 0); return R;
}
#define PHASE_VARS() int tid_p = (int)threadIdx.x; asm volatile("" : "+v"(tid_p)); const int lane = tid_p & 63; const int wave = __builtin_amdgcn_readfirstlane(tid_p >> 6); \
    unsigned zo_p; asm volatile("s_mov_b32 %0, 0" : "=s"(zo_p)); unsigned char* ws = args.ws + zo_p; const float* const* in = args.in + zo_p; float* out = args.out + zo_p; \
    const int gw = F.vcu * NWAVES + wave; const int rgw = (F.G - 1 - (int)blockIdx.x) * NWAVES + wave; LAS float* dsc = (LAS float*)(L3 + wave * 12288); (void)gw; (void)rgw; (void)dsc; (void)lane; (void)in; (void)out
__global__ void __launch_bounds__(NWAVES * 64, 2) mega_fwd(Args args) {
    extern __shared__ __attribute__((aligned(16))) unsigned char lds[];
    Frame F;
    F.lds = lds; F.MISC = (volatile LAS unsigned*)((LAS unsigned char*)lds + MISC_OFF);
    F.tid = threadIdx.x; F.lane = F.tid & 63; F.wave = __builtin_amdgcn_readfirstlane(F.tid >> 6);
    F.G = gridDim.x; { const int bx = blockIdx.x; F.vcu = (F.G % 8 == 0) ? (bx % 8) * (F.G / 8) + bx / 8 : bx; }
    F.gw = F.vcu * NWAVES + F.wave; F.NGW = F.G * NWAVES;
    F.in = args.in; F.out = args.out; F.ws = args.ws; F.ctl = (gu32*)(args.ws + WS_CTL);
    LAS unsigned char* L3 = (LAS unsigned char*)lds;
    for (int u = F.tid; u < (LDS_BYTES - RING_BYTES) / 4; u += NWAVES * 64) ((LAS unsigned*)(L3 + RING_BYTES))[u] = 0u;
    __syncthreads();
    XcdBarrier bar = xcd_barrier_post((unsigned*)(F.ctl + CW_BAR), F.MISC + 8);
#define GRID_BAR() do { XcdBarrier b2_ = bar; asm volatile("" : "+s"(b2_.x)); xcd_barrier(b2_); } while (0)

    if (PH_ON(0)) p0_prologue(F);
    GRID_BAR();

    for (int l = 0; l < DEPTH; ++l) {
        if (PH_ON(1))
        {   PHASE_VARS(); const DecP D = make_dec(ws, in, out, l);
            pg8::Gemm g{(const pg8::bf16_t*)(ws + WS_XB2), (const pg8::bf16_t*)D.win, M, NIN, DM}; pg8::StaticOrder S; S.init(M, NIN, F.G, (int)blockIdx.x);
            pg8::EpiIn E{ws, out, l};
            pg8::gemm_phase<pg8::EpiIn, pg8::StaticOrder, true, true>((PG8_LAS unsigned char*)L3, g, S, E, tid_p);
            for (int u = rgw; u < 162; u += F.NGW) dec_unit_in(D, u, dsc, lane);
        }
        GRID_BAR();

        if (PH_ON(2))
        {   PHASE_VARS(); const RwkvP R = make_rwkv(ws, in, l); LAS unsigned char* wl = L3 + wave * 12288;
            for (int u = gw; u < NUNIT; u += F.NGW) rwkv_b1_unit(R, u, wl, lane);
        }
        GRID_BAR();

        if (PH_ON(3))
        {   PHASE_VARS(); const DecP D = make_dec(ws, in, out, l); const RwkvP R = make_rwkv(ws, in, l);
            if (tid_p == 0) F.MISC[0] = 0u;
            __syncthreads();
            bool attend = true;
            if (blockIdx.x < 64) { if (wave == 7) { const int seq = blockIdx.x >> 2, rb = blockIdx.x & 3; rwkv_chain(R, seq, rb, out + O_WKP + ((size_t)l * 16 + seq) * 4096, lane); attend = false; } }
            else { const int dt = ((int)blockIdx.x - 64) * NWAVES + wave;
                if (dt < 768) dec_attn_task(D, in[4], in[5], (const float*)(ws + WS_ROPE), dt / 24, (dt % 24) / 3, dt % 3, lane);
                else if (dt < 1024) dec_rwkv_task(D, in, (dt - 768) >> 3, (dt - 768) & 7, (LAS float*)(L3 + wave * 10240), lane); }
            if (attend) {
                LAS unsigned char* wl = L3 + wave * 10240;
                const int bh = F.vcu >> 4, span = F.vcu & 15;
                for (;;) { const unsigned t = lds_task_next(F.MISC, lane); if (t >= 48u) break;
                    const int p = (int)t >> 4, idx = (int)t & 15;
                    const int cls = p == 0 ? 0 : p == 1 ? (idx >> 2) : idx, qblk = p == 0 ? span * 16 + idx : p == 1 ? span * 4 + (idx & 3) : span;
                    attn_task((const bf16*)(ws + WS_QB), (const bf16*)(ws + WS_KB), (const bf16*)(ws + WS_VB), (bf16*)(ws + WS_OP), (float*)(ws + WS_LSE), bh >> 3, bh & 7, p, cls, qblk, wl, lane); }
            }
        }
        GRID_BAR();

        if (PH_ON(4))
        {   PHASE_VARS(); const DecP D = make_dec(ws, in, out, l); const RwkvP R = make_rwkv(ws, in, l);
            for (int u = gw; u < NUNIT; u += F.NGW) rwkv_b3_unit(R, u, lane);
            for (int r = gw; r < M; r += F.NGW) attn_finalize_row((const bf16*)(ws + WS_OP), (const float*)(ws + WS_LSE), in[22] + (size_t)l * 512, (bf16*)(ws + WS_MIX), r, lane);
            if (rgw < MD) dec_finalize_row(D, in[22] + (size_t)l * 512, rgw, lane);
        }
        GRID_BAR();

        if (PH_ON(5))
        {   PHASE_VARS(); const DecP D = make_dec(ws, in, out, l);
            pg8::Gemm g{(const pg8::bf16_t*)(ws + WS_MIX), (const pg8::bf16_t*)D.wout, M, DM, DM}; pg8::StaticOrder S; S.init(M, DM, F.G, (int)blockIdx.x);
            pg8::EpiRes<false> E{ws, in, out, l};
            pg8::gemm_phase<pg8::EpiRes<false>, pg8::StaticOrder, false, true>((PG8_LAS unsigned char*)L3, g, S, E, tid_p);
            for (int u = rgw; u < 32; u += F.NGW)
                dec_unit_res((const bf16*)(D.dec + DEC_MIXB), D.wout, DM, u, l == 0, l == 0 ? D.xs : (const float*)(D.dec + DEC_T2), (const float*)(D.dec + DEC_ST2), D.g2p, D.b2p, (float*)(D.dec + DEC_T1), (bf16*)(D.dec + DEC_XB1), (float*)(D.dec + DEC_ST1),
                             out + O_SHS + (size_t)l * MD * DM, dsc, lane);
        }
        GRID_BAR();

        if (PH_ON(6))
        {   PHASE_VARS(); const DecP D = make_dec(ws, in, out, l);
            pg8::Gemm g{(const pg8::bf16_t*)(ws + WS_XB1), (const pg8::bf16_t*)D.wup, M, FFD, DM}; pg8::StaticOrder S; S.init(M, FFD, F.G, (int)blockIdx.x);
            pg8::EpiUp E{ws, l};
            pg8::gemm_phase<pg8::EpiUp, pg8::StaticOrder, true, true>((PG8_LAS unsigned char*)L3, g, S, E, tid_p);
            for (int u = rgw; u < 128; u += F.NGW) dec_unit_up(D, u, dsc, lane);
        }
        GRID_BAR();

        if (PH_ON(7))
        {   PHASE_VARS(); const DecP D = make_dec(ws, in, out, l);
            pg8::Gemm g{(const pg8::bf16_t*)(ws + WS_H), (const pg8::bf16_t*)D.wdn, M, DM, FFD}; pg8::StaticOrder S; S.init(M, DM, F.G, (int)blockIdx.x);
            pg8::EpiRes<true> E{ws, in, out, l};
            pg8::gemm_phase<pg8::EpiRes<true>, pg8::StaticOrder, false, true>((PG8_LAS unsigned char*)L3, g, S, E, tid_p);
            for (int u = rgw; u < 32; u += F.NGW)
                dec_unit_res((const bf16*)(D.dec + DEC_HB), D.wdn, FFD, u, false, (const float*)(D.dec + DEC_T1), (const float*)(D.dec + DEC_ST1), D.g1, D.b1, (float*)(D.dec + DEC_T2), (bf16*)(D.dec + DEC_XB2), (float*)(D.dec + DEC_ST2), nullptr, dsc, lane);
        }
        GRID_BAR();
    }
    if (PH_ON(8))
    {   PHASE_VARS(); const float* g = in[28] + (size_t)3 * DM; const float* b = in[29] + (size_t)3 * DM;
        for (int r = gw; r < M; r += F.NGW) { float mu, rs; pg8::row_stats((const float*)(ws + WS_STAT2), r, mu, rs);
            const f32x4* t = (const f32x4*)((const float*)(ws + WS_T2) + (size_t)r * DM) + lane; f32x4* o = (f32x4*)(out + O_Y + (size_t)r * DM) + lane;
#pragma unroll
            for (int j = 0; j < 4; ++j) { const f32x4 gg = *((const f32x4*)g + lane + 64 * j), bb = *((const f32x4*)b + lane + 64 * j); o[64 * j] = (t[64 * j] - mu) * rs * gg + bb; } }
        if (rgw < MD) { dec_row_stats((const float*)(ws + WS_DEC + DEC_ST2), dsc, lane); const float mu = dsc[2 * rgw], rs = dsc[2 * rgw + 1];
            const f32x4* t = (const f32x4*)((const float*)(ws + WS_DEC + DEC_T2) + (size_t)rgw * DM) + lane; f32x4* o = (f32x4*)(out + O_YS + (size_t)rgw * DM) + lane;
#pragma unroll
            for (int j = 0; j < 4; ++j) { const f32x4 gg = *((const f32x4*)g + lane + 64 * j), bb = *((const f32x4*)b + lane + 64 * j); o[64 * j] = (t[64 * j] - mu) * rs * gg + bb; } }
    }
}

extern "C" void kernel_launch(void* const* d_in, const int* in_sizes, int n_in, void* d_out, int out_size, void* d_ws, size_t ws_size, hipStream_t stream) {
    static int grid = 0;
    if (grid == 0) {
        if (n_in != 30 || out_size != (int)O_END || ws_size < WS_END) { fprintf(stderr, "kernel_launch: unexpected problem (n_in %d, out %d, ws %zu); nothing launched\n", n_in, out_size, ws_size); grid = -1; return; }
        int dev = 0, cus = 0, per_cu = 0;
        if (hipGetDevice(&dev) != hipSuccess || hipDeviceGetAttribute(&cus, hipDeviceAttributeMultiprocessorCount, dev) != hipSuccess) { fprintf(stderr, "kernel_launch: device query failed\n"); grid = -1; return; }
        if (hipFuncSetAttribute((const void*)mega_fwd, hipFuncAttributeMaxDynamicSharedMemorySize, LDS_BYTES) != hipSuccess) { fprintf(stderr, "kernel_launch: hipFuncSetAttribute failed\n"); grid = -1; return; }
        if (hipOccupancyMaxActiveBlocksPerMultiprocessor(&per_cu, (const void*)mega_fwd, NWAVES * 64, LDS_BYTES) != hipSuccess || per_cu < 1) fprintf(stderr, "kernel_launch: occupancy query reports %d\n", per_cu);
        (void)hipGetLastError();
        if (cus < 256) { fprintf(stderr, "kernel_launch: needs 256 CUs (found %d)\n", cus); grid = -1; return; }
        grid = 256;
    }
    if (grid < 0) return;
    if (hipMemsetAsync((char*)d_ws + WS_CTL, 0, CTL_ZERO_BYTES, stream) != hipSuccess) { fprintf(stderr, "kernel_launch: memset failed\n"); return; }
    Args a{};
    for (int i = 0; i < 30; ++i) a.in[i] = (const float*)d_in[i];
    a.out = (float*)d_out; a.ws = (unsigned char*)d_ws;
    hipLaunchKernelGGL(mega_fwd, dim3(grid), dim3(NWAVES * 64), LDS_BYTES, stream, a);
    const hipError_t le = hipPeekAtLastError();
    if (le != hipSuccess) fprintf(stderr, "kernel_launch: launch failed: %s\n", hipGetErrorName(le));
}
```

```cpp
#define PH_DUP 0x0
#include <hip/hip_runtime.h>
#include <cstdio>
#include <cstdint>
#include <cmath>
namespace pg8 {
#define PG8_LAS __attribute__((address_space(3)))
typedef unsigned short bf16_t;
typedef short bf16x8 __attribute__((ext_vector_type(8)));
typedef float f32x4 __attribute__((ext_vector_type(4)));
typedef unsigned u32x4 __attribute__((ext_vector_type(4)));
constexpr int BM = 256, BK = 64, HALF = 128, HTB = HALF * BK * 2  , STAGE_BYTES = 8 * HTB, NXCD = 8, WGM = 8;

__host__ __device__ __forceinline__ int lds_byte(int r, int c) { const int st = (r >> 4) * 2 + (c >> 5), rr = r & 15, cc = c & 31, ob = rr * 64 + cc * 2; return st * 1024 + (ob ^ (((ob >> 9) & 1) << 5)); }
__host__ __device__ __forceinline__ void stage_rc(int b, int& R, int& C) { const int st = b / 1024, sb = b % 1024, swz = sb ^ (((sb >> 9) & 1) << 5); R = (st >> 1) * 16 + swz / 64; C = (st & 1) * 32 + (swz % 64) / 2; }
__host__ __device__ __forceinline__ int perm32(int rho) { const int n = rho >> 4, i = rho & 15; return 8 * (i >> 2) + 4 * n + (i & 3); }

struct Unit { int pm, pn; };
struct Gemm { const bf16_t* A; const bf16_t* Bt; int M, N, K; };

struct StaticOrder {
    int nM, nN, nwg, G, c;
    __host__ __device__ void init(int M, int N, int G_, int c_) { nM = M / BM; nN = N / BM; nwg = nM * nN; G = G_; c = c_; }
    __host__ __device__ bool next(int i, Unit& u) const {
        const long L = (long)i * G + c; if (L >= nwg) return false;
        int wgid = (int)L; { const int q = nwg / NXCD, r = nwg % NXCD, xcd = wgid % NXCD, off = wgid / NXCD; wgid = (xcd < r ? xcd * (q + 1) : r * (q + 1) + (xcd - r) * q) + off; }
        const int nig = WGM * nN, gid = wgid / nig, fm = gid * WGM, gsz = (nM - fm) < WGM ? (nM - fm) : WGM;
        u.pm = fm + ((wgid % nig) % gsz); u.pn = (wgid % nig) / gsz; return true;
    }
    __device__ __forceinline__ void a_ready(const Unit&) const {}
    __device__ __forceinline__ void done(const Unit&) const {}
};

__device__ __forceinline__ unsigned cvt_pk_bf16(float lo, float hi) { unsigned r; asm volatile("v_cvt_pk_bf16_f32 %0, %1, %2" : "=v"(r) : "v"(lo), "v"(hi)); return r; }
typedef float f32x2 __attribute__((ext_vector_type(2)));
constexpr size_t WSO_C1IN = 1u << 20, WSO_C2IN = WSO_C1IN + 4 * 3584 * 4, WSO_C1UP = WSO_C2IN + 4 * 3584 * 4, WSO_C2UP = WSO_C1UP + 4 * 4096 * 4, WSO_ROPE = 3u << 20, WSO_STAT1 = 8u << 20, WSO_STAT2 = 9u << 20;
constexpr size_t WSO_XB2 = 132ull << 20, WSO_XB1 = 164ull << 20, WSO_T1 = 196ull << 20, WSO_T2 = 260ull << 20, WSO_QB = 324ull << 20, WSO_KB = 340ull << 20, WSO_VB = 356ull << 20, WSO_PR = 372ull << 20, WSO_H = 580ull << 20;
constexpr size_t OO_SHP = 16809984, OO_KP = 21405696, OO_VP = 29794304;
__device__ __forceinline__ void row_stats(const float* stat, int row, float& mu, float& rs) {
    const f32x4 a = *(const f32x4*)(stat + (size_t)row * 8), b = *(const f32x4*)(stat + (size_t)row * 8 + 4);
    const float s = (a[0] + a[2]) + (b[0] + b[2]), q = (a[1] + a[3]) + (b[1] + b[3]);
    mu = s * (1.f / 1024.f); const float var = fmaxf(q * (1.f / 1024.f) - mu * mu, 0.f); rs = 1.0f / sqrtf(var + 1e-5f);
}
typedef float f32x2e __attribute__((ext_vector_type(2)));
typedef unsigned u32x2e __attribute__((ext_vector_type(2)));
struct EpiIn {
    static constexpr bool PERM = false, AFTER_DRAIN = false;
    unsigned char* ws; float* out; int l;
    __device__ __forceinline__ void operator()(const f32x4 (&acc)[2][2][4][2], const Unit& u, int wr, int wc, int fr, int fq) const {
        asm volatile("" ::: "memory"); __builtin_amdgcn_sched_barrier(0);
        const int fold = l > 0; const float* stat = (const float*)(ws + WSO_STAT2); const float* c1 = (const float*)(ws + WSO_C1IN) + l * 3584; const float* c2 = (const float*)(ws + WSO_C2IN) + l * 3584;
        bf16_t* QB = (bf16_t*)(ws + WSO_QB); bf16_t* KB = (bf16_t*)(ws + WSO_KB); bf16_t* VB = (bf16_t*)(ws + WSO_VB); bf16_t* PR = (bf16_t*)(ws + WSO_PR); const float* rope = (const float*)(ws + WSO_ROPE);
        float* outk = out + OO_KP + (size_t)l * 2 * 2048 * 512; float* outv = out + OO_VP + (size_t)l * 2 * 2048 * 512; const float qscale = 0.125f * 1.4426950408889634f;
        const int cb = u.pn * BM + wc * 32 + 4 * fq;
        const int i0 = 16 * (wc & 1) + 4 * fq; const bool roped = u.pn < 4;
        const int rbase = u.pm * BM + wr * 64 + fr;
        float mu8[8], rs8[8];
#pragma unroll
        for (int gq = 0; gq < 8; ++gq) { mu8[gq] = 0.f; rs8[gq] = 1.f; if (fold) row_stats(stat, rbase + (gq >> 2) * HALF + (gq & 3) * 16, mu8[gq], rs8[gq]); }
#pragma unroll
        for (int bj = 0; bj < 2; ++bj) {
            f32x4 c1v[2], c2v[2];
#pragma unroll
            for (int n = 0; n < 2; ++n) { c1v[n] = fold ? *(const f32x4*)(c1 + cb + bj * HALF + n * 16) : (f32x4){0.f, 0.f, 0.f, 0.f}; c2v[n] = fold ? *(const f32x4*)(c2 + cb + bj * HALF + n * 16) : (f32x4){0.f, 0.f, 0.f, 0.f}; }
#pragma unroll
            for (int gq = 0; gq < 8; ++gq) {
                const int ai = gq >> 2, m = gq & 3;
                const int r = rbase + ai * HALF + m * 16;
                const float mu = mu8[gq], rs = rs8[gq];
                f32x4 ra = {0.f, 0.f, 0.f, 0.f}, rb = ra;
                if (roped) { const float* rp = rope + ((size_t)(r & 8191) * 32 + i0) * 2; ra = *(const f32x4*)rp; rb = *(const f32x4*)(rp + 4); }
                if ((gq & 3) == 3) asm volatile("" ::: "memory");
                f32x4 v[2];
#pragma unroll
                for (int n = 0; n < 2; ++n) v[n] = (acc[ai][bj][m][n] - mu * c1v[n]) * rs + c2v[n];
                const int pos = r & 8191, b = r >> 13;
                if (roped) {
                    const f32x4 cs = {ra[0], ra[2], rb[0], rb[2]}, sn = {ra[1], ra[3], rb[1], rb[3]};
                    const int head = (u.pn & 1) * 4 + bj * 2 + (wc >> 1);
                    f32x4 y1 = v[0] * cs - v[1] * sn, y2 = v[0] * sn + v[1] * cs;
                    const size_t o = (size_t)r * 512 + head * 64 + i0;
                    if (u.pn < 2) { y1 = y1 * qscale; y2 = y2 * qscale;
                        u32x2e w; w.x = cvt_pk_bf16(y1[0], y1[1]); w.y = cvt_pk_bf16(y1[2], y1[3]); *(u32x2e*)(QB + o) = w;
                        w.x = cvt_pk_bf16(y2[0], y2[1]); w.y = cvt_pk_bf16(y2[2], y2[3]); *(u32x2e*)(QB + o + 32) = w;
                    } else {
                        u32x2e w; w.x = cvt_pk_bf16(y1[0], y1[1]); w.y = cvt_pk_bf16(y1[2], y1[3]); *(u32x2e*)(KB + o) = w;
                        w.x = cvt_pk_bf16(y2[0], y2[1]); w.y = cvt_pk_bf16(y2[2], y2[3]); *(u32x2e*)(KB + o + 32) = w;
                        if (pos >= 6144) { float* ok = outk + ((size_t)(b * 2048 + pos - 6144)) * 512 + head * 64 + i0; *(f32x4*)ok = y1; *(f32x4*)(ok + 32) = y2; }
                    }
                } else if (u.pn < 6) {
#pragma unroll
                    for (int n = 0; n < 2; ++n) { const int c = cb + bj * HALF + n * 16 - 1024; const f32x4 x = v[n];
                        u32x2e w; w.x = cvt_pk_bf16(x[0], x[1]); w.y = cvt_pk_bf16(x[2], x[3]); *(u32x2e*)(VB + (size_t)r * 512 + c) = w;
                        if (pos >= 6144) *(f32x4*)(outv + ((size_t)(b * 2048 + pos - 6144)) * 512 + c) = x; }
                } else {
#pragma unroll
                    for (int n = 0; n < 2; ++n) { const int c = cb + bj * HALF + n * 16 - 1536; const f32x4 x = v[n];
                        if (c < 1824) { u32x2e w; w.x = cvt_pk_bf16(x[0], x[1]); w.y = cvt_pk_bf16(x[2], x[3]); *(u32x2e*)(PR + (size_t)r * 2048 + c) = w; } }
                }
            }
        }
    }
};
template <bool IS_F> struct EpiRes {
    static constexpr bool PERM = false, AFTER_DRAIN = true;
    unsigned char* ws; const float* const* in; float* out; int l;
    __device__ __forceinline__ void fused(f32x4 (&acc)[2][2][4][2], const Unit& u, int wr, int wc, int fr, int fq, PG8_LAS unsigned char* lds, int wid, int lane) const {
        const int raw = (!IS_F && l == 0) ? 1 : 0;
        const float* src = IS_F ? (const float*)(ws + WSO_T1) : (l == 0 ? in[0] : (const float*)(ws + WSO_T2));
        const float* sstat = (const float*)(ws + (IS_F ? WSO_STAT1 : WSO_STAT2));
        const float* g = IS_F ? in[24] + (size_t)l * 1024 : in[28] + (size_t)(l > 0 ? l - 1 : 0) * 1024; const float* b = IS_F ? in[25] + (size_t)l * 1024 : in[29] + (size_t)(l > 0 ? l - 1 : 0) * 1024;
        float* T = (float*)(ws + (IS_F ? WSO_T2 : WSO_T1)); bf16_t* XB = (bf16_t*)(ws + (IS_F ? WSO_XB2 : WSO_XB1)); float* ostat = (float*)(ws + (IS_F ? WSO_STAT2 : WSO_STAT1));
        float* shiftout = IS_F ? nullptr : out + OO_SHP + (size_t)l * 2 * 1024; const float alpha = 1.6817928305074290f;
        PG8_LAS f32x2e* P = (PG8_LAS f32x2e*)lds;
        const int cb = u.pn * BM + wc * 32 + 4 * fq;
        const int rbase = u.pm * BM + wr * 64 + fr;
        f32x4 cur[2][2], nxt[2][2], sa = {0.f, 0.f, 0.f, 0.f}, sb = sa, san = sa, sbn = sa;
#pragma unroll
        for (int bj = 0; bj < 2; ++bj)
#pragma unroll
            for (int n = 0; n < 2; ++n) { cur[bj][n] = *(const f32x4*)(src + (size_t)rbase * 1024 + cb + bj * HALF + n * 16); nxt[bj][n] = cur[bj][n]; }
        if (!raw) { sa = *(const f32x4*)(sstat + (size_t)rbase * 8); sb = *(const f32x4*)(sstat + (size_t)rbase * 8 + 4); }
#pragma unroll
        for (int gq = 0; gq < 8; ++gq) {
            const int ai = gq >> 2, m = gq & 3;
            const int r = rbase + ai * HALF + m * 16;
            if (gq < 7) { const int rn = rbase + ((gq + 1) >> 2) * HALF + ((gq + 1) & 3) * 16;
#pragma unroll
                for (int bj = 0; bj < 2; ++bj)
#pragma unroll
                    for (int n = 0; n < 2; ++n) nxt[bj][n] = *(const f32x4*)(src + (size_t)rn * 1024 + cb + bj * HALF + n * 16);
                if (!raw) { san = *(const f32x4*)(sstat + (size_t)rn * 8); sbn = *(const f32x4*)(sstat + (size_t)rn * 8 + 4); } }
            asm volatile("" ::: "memory");
            float mu = 0.f, rs = 1.f;
            if (!raw) { const float ssum = (sa[0] + sa[2]) + (sb[0] + sb[2]), qsum = (sa[1] + sa[3]) + (sb[1] + sb[3]); mu = ssum * (1.f / 1024.f); rs = 1.0f / sqrtf(fmaxf(qsum * (1.f / 1024.f) - mu * mu, 0.f) + 1e-5f); }
            float s = 0.f, q = 0.f;
#pragma unroll
            for (int bj = 0; bj < 2; ++bj)
#pragma unroll
                for (int n = 0; n < 2; ++n) { const int c = cb + bj * HALF + n * 16; const size_t off = (size_t)r * 1024 + c;
                    const f32x4 gvv = raw ? (f32x4){1.f, 1.f, 1.f, 1.f} : *(const f32x4*)(g + c), bvv = raw ? (f32x4){0.f, 0.f, 0.f, 0.f} : *(const f32x4*)(b + c);
                    const f32x4 x = (cur[bj][n] - mu) * rs * gvv + bvv;
                    const f32x4 t = x * alpha + acc[ai][bj][m][n];
                    *(f32x4*)(T + off) = t; u32x2e w; w.x = cvt_pk_bf16(t[0], t[1]); w.y = cvt_pk_bf16(t[2], t[3]); *(u32x2e*)(XB + off) = w;
                    s += (t[0] + t[1]) + (t[2] + t[3]); q += (t[0] * t[0] + t[1] * t[1]) + (t[2] * t[2] + t[3] * t[3]);
                    if (shiftout && (r & 8191) == 8191) *(f32x4*)(shiftout + (size_t)(r >> 13) * 1024 + c) = x; }
            s += __shfl_xor(s, 16); s += __shfl_xor(s, 32); q += __shfl_xor(q, 16); q += __shfl_xor(q, 32);
            if (fq == 0) P[(ai * HALF + wr * 64 + m * 16 + fr) * 4 + wc] = (f32x2e){s, q};
#pragma unroll
            for (int bj = 0; bj < 2; ++bj)
#pragma unroll
                for (int n = 0; n < 2; ++n) cur[bj][n] = nxt[bj][n];
            sa = san; sb = sbn;
        }
        asm volatile("s_waitcnt lgkmcnt(0)" ::: "memory"); __builtin_amdgcn_s_barrier(); asm volatile("" ::: "memory");
        if (threadIdx.x < 256) { const int row = threadIdx.x; const f32x2e a = P[row * 4 + 0], b2 = P[row * 4 + 1], c = P[row * 4 + 2], d = P[row * 4 + 3];
            *(f32x2e*)(ostat + (size_t)(u.pm * BM + row) * 8 + u.pn * 2) = (f32x2e){(a.x + b2.x) + (c.x + d.x), (a.y + b2.y) + (c.y + d.y)}; }
        asm volatile("s_waitcnt lgkmcnt(0)" ::: "memory"); __builtin_amdgcn_s_barrier(); asm volatile("" ::: "memory");
    }
};
struct EpiUp {
    static constexpr bool PERM = true, AFTER_DRAIN = false;
    unsigned char* ws; int l;
    __device__ __forceinline__ void operator()(const f32x4 (&acc)[2][2][4][2], const Unit& u, int wr, int wc, int fr, int fq) const {
        asm volatile("" ::: "memory"); __builtin_amdgcn_sched_barrier(0);
        const float* stat = (const float*)(ws + WSO_STAT1); const float* c1 = (const float*)(ws + WSO_C1UP) + l * 4096; const float* c2 = (const float*)(ws + WSO_C2UP) + l * 4096; bf16_t* H = (bf16_t*)(ws + WSO_H);
        const int cb = u.pn * BM + wc * 32 + 8 * fq;
        float mu8[8], rs8[8];
#pragma unroll
        for (int gq = 0; gq < 8; ++gq) row_stats(stat, u.pm * BM + (gq >> 2) * HALF + wr * 64 + (gq & 3) * 16 + fr, mu8[gq], rs8[gq]);
#pragma unroll
        for (int bj = 0; bj < 2; ++bj) {
            f32x4 c1v[2], c2v[2];
#pragma unroll
            for (int n = 0; n < 2; ++n) { c1v[n] = *(const f32x4*)(c1 + cb + bj * HALF + 4 * n); c2v[n] = *(const f32x4*)(c2 + cb + bj * HALF + 4 * n); }
#pragma unroll
            for (int ai = 0; ai < 2; ++ai) {
#pragma unroll
                for (int m = 0; m < 4; ++m) {
                    const int r = u.pm * BM + ai * HALF + wr * 64 + m * 16 + fr;
                    const float mu = mu8[ai * 4 + m], rs = rs8[ai * 4 + m];
                    f32x4 v0 = (acc[ai][bj][m][0] - mu * c1v[0]) * rs + c2v[0], v1 = (acc[ai][bj][m][1] - mu * c1v[1]) * rs + c2v[1];
#pragma unroll
                    for (int e = 0; e < 4; ++e) { const float a = fmaxf(v0[e], 0.f), b = fmaxf(v1[e], 0.f); v0[e] = a * a; v1[e] = b * b; }
                    u32x4 w; w.x = cvt_pk_bf16(v0[0], v0[1]); w.y = cvt_pk_bf16(v0[2], v0[3]); w.z = cvt_pk_bf16(v1[0], v1[1]); w.w = cvt_pk_bf16(v1[2], v1[3]);
                    *(u32x4*)(H + (size_t)r * 4096 + cb + bj * HALF) = w; }
            }
        }
    }
};
template <class Epi, class Sched, bool ALIGN_EPI = false, bool SP2 = false>
__device__ __forceinline__ void gemm_phase(PG8_LAS unsigned char* lds, const Gemm g, const Sched& S, const Epi& E, const int tid) {
    const int wid = __builtin_amdgcn_readfirstlane(tid >> 6), lane = tid & 63, wr = wid >> 2, wc = wid & 3, fr = lane & 15, fq = lane >> 4;
    const int K = g.K, nt = K / BK;
    unsigned voffA[2], voffB[2];
#pragma unroll
    for (int i = 0; i < 2; ++i) { int R, C; stage_rc(tid * 16 + i * 8192, R, C); const int Rb = Epi::PERM ? ((R & ~31) + perm32(R & 31)) : R;
        voffA[i] = (unsigned)(R * K + C) * 2u; voffB[i] = (unsigned)(Rb * K + C) * 2u; }
    const size_t kstep = (size_t)(BK * 2);
    const size_t hstep = (size_t)HALF * K * 2;
    const size_t tstep = 2 * hstep;
    const unsigned ldsw = (unsigned)wid * 1024u;
    const int aoff = lds_byte(wr * 64 + fr, fq * 8), boff = lds_byte(wc * 32 + fr, fq * 8);
#define PG8_SA(b, h) (((b) * 2 + (h)) * HTB)
#define PG8_SB(b, h) ((4 + (b) * 2 + (h)) * HTB)
#define PG8_STAGE(bufoff, gbase, voff) do { _Pragma("unroll") for (int _i = 0; _i < 2; ++_i) \
        __builtin_amdgcn_global_load_lds((const unsigned*)((const char*)(gbase) + (voff)[_i]), (PG8_LAS unsigned*)(lds + (bufoff) + ldsw + _i * 8192), 16, 0, 0); } while (0)
#define PG8_LDA(dst, b, h) do { _Pragma("unroll") for (int m = 0; m < 4; ++m) _Pragma("unroll") for (int k = 0; k < 2; ++k) dst[m][k] = *(const PG8_LAS bf16x8*)(lds + PG8_SA(b, h) + aoff + m * 2048 + k * 1024); } while (0)
#define PG8_LDB(dst, b, h) do { _Pragma("unroll") for (int n = 0; n < 2; ++n) _Pragma("unroll") for (int k = 0; k < 2; ++k) dst[n][k] = *(const PG8_LAS bf16x8*)(lds + PG8_SB(b, h) + boff + n * 2048 + k * 1024); } while (0)
#define PG8_MMA(ai, bj, At, Bt) do { __builtin_amdgcn_s_setprio(1); _Pragma("unroll") for (int m = 0; m < 4; ++m) _Pragma("unroll") for (int n = 0; n < 2; ++n) _Pragma("unroll") for (int k = 0; k < 2; ++k) \
        acc[ai][bj][m][n] = __builtin_amdgcn_mfma_f32_16x16x32_bf16(Bt[n][k], At[m][k], acc[ai][bj][m][n], 0, 0, 0); __builtin_amdgcn_s_setprio(0); } while (0)
#define PG8_WAIT_V(n) asm volatile("s_waitcnt vmcnt(" #n ")" ::: "memory")
#define PG8_WAIT_L(n) asm volatile("s_waitcnt lgkmcnt(" #n ")" ::: "memory")
#define PG8_BAR __builtin_amdgcn_s_barrier()
#define PG8_SCHED __builtin_amdgcn_sched_barrier(0)
    Unit cur, nxt; int ui = 0;
    if (!S.next(0, cur)) return;
    f32x4 acc[2][2][4][2];
#pragma unroll
    for (int a = 0; a < 2; ++a)
#pragma unroll
        for (int b = 0; b < 2; ++b)
#pragma unroll
            for (int m = 0; m < 4; ++m)
#pragma unroll
                for (int n = 0; n < 2; ++n) acc[a][b][m][n] = (f32x4){0.f, 0.f, 0.f, 0.f};
    bf16x8 At[4][2], B0[2][2], B1[2][2];
    const char* cA = (const char*)g.A + (size_t)cur.pm * tstep; const char* cB = (const char*)g.Bt + (size_t)cur.pn * tstep;
    S.a_ready(cur);
    if constexpr (SP2) {
        PG8_STAGE(PG8_SB(0, 0), cB, voffB); PG8_STAGE(PG8_SB(0, 1), cB + hstep, voffB); PG8_STAGE(PG8_SA(0, 0), cA, voffA); PG8_STAGE(PG8_SA(0, 1), cA + hstep, voffA);
        if (wr == 1) PG8_BAR;
        PG8_WAIT_V(2); PG8_BAR;
        PG8_STAGE(PG8_SB(1, 0), cB + kstep, voffB); PG8_STAGE(PG8_SA(1, 0), cA + kstep, voffA); PG8_STAGE(PG8_SB(1, 1), cB + hstep + kstep, voffB);
        PG8_WAIT_V(6); PG8_BAR;
    } else {
        PG8_STAGE(PG8_SB(0, 0), cB, voffB); PG8_STAGE(PG8_SA(0, 0), cA, voffA); PG8_STAGE(PG8_SB(0, 1), cB + hstep, voffB); PG8_STAGE(PG8_SA(0, 1), cA + hstep, voffA);
        if (wr == 1) PG8_BAR;
        PG8_WAIT_V(4); PG8_BAR;
        PG8_STAGE(PG8_SB(1, 0), cB + kstep, voffB); PG8_STAGE(PG8_SA(1, 0), cA + kstep, voffA); PG8_STAGE(PG8_SB(1, 1), cB + hstep + kstep, voffB);
        PG8_WAIT_V(6); PG8_BAR;
    }
    for (;;) {
        const bool has_next = S.next(ui + 1, nxt);
        const char* nA = has_next ? (const char*)g.A + (size_t)nxt.pm * tstep : cA; const char* nB = has_next ? (const char*)g.Bt + (size_t)nxt.pn * tstep : cB;
        for (int t = 0; t < nt; t += 2) {
            const bool last = (t == nt - 2);
            const char* a1 = cA + (size_t)(t + 1) * kstep;
            const char* a2 = last ? nA : cA + (size_t)(t + 2) * kstep; const char* b2 = last ? nB : cB + (size_t)(t + 2) * kstep;
            const char* a3 = a2 + kstep; const char* b3 = b2 + kstep;
            if (last && has_next) S.a_ready(nxt);
            if constexpr (SP2) {
            PG8_LDB(B0, 0, 0); PG8_LDB(B1, 0, 1); PG8_SCHED; PG8_LDA(At, 0, 0); PG8_STAGE(PG8_SA(1, 1), a1 + hstep, voffA);
            PG8_WAIT_V(8); PG8_WAIT_L(0); PG8_BAR; PG8_MMA(0, 0, At, B0); PG8_MMA(0, 1, At, B1); PG8_BAR; PG8_SCHED;
            PG8_LDA(At, 0, 1); PG8_STAGE(PG8_SB(0, 0), b2, voffB); PG8_STAGE(PG8_SB(0, 1), b2 + hstep, voffB); PG8_STAGE(PG8_SA(0, 0), a2, voffA);
            PG8_WAIT_V(8); PG8_WAIT_L(0); PG8_BAR; PG8_MMA(1, 0, At, B0); PG8_MMA(1, 1, At, B1); PG8_BAR; PG8_SCHED;
            PG8_LDB(B0, 1, 0); PG8_LDB(B1, 1, 1); PG8_SCHED; PG8_LDA(At, 1, 0); PG8_STAGE(PG8_SA(0, 1), a2 + hstep, voffA);
            PG8_WAIT_V(8); PG8_WAIT_L(0); PG8_BAR; PG8_MMA(0, 0, At, B0); PG8_MMA(0, 1, At, B1); PG8_BAR; PG8_SCHED;
            PG8_LDA(At, 1, 1); PG8_STAGE(PG8_SB(1, 0), b3, voffB); PG8_STAGE(PG8_SB(1, 1), b3 + hstep, voffB); PG8_STAGE(PG8_SA(1, 0), a3, voffA);
            PG8_WAIT_V(8); PG8_WAIT_L(0); PG8_BAR; PG8_MMA(1, 0, At, B0); PG8_MMA(1, 1, At, B1); PG8_BAR; PG8_SCHED;
            } else {
            PG8_LDB(B0, 0, 0); PG8_SCHED; PG8_LDA(At, 0, 0); PG8_STAGE(PG8_SA(1, 1), a1 + hstep, voffA);
            PG8_WAIT_L(8); PG8_BAR; PG8_WAIT_L(0); PG8_MMA(0, 0, At, B0); PG8_BAR; PG8_SCHED;
            PG8_LDB(B1, 0, 1); PG8_STAGE(PG8_SB(0, 0), b2, voffB);
            PG8_BAR; PG8_WAIT_L(0); PG8_MMA(0, 1, At, B1); PG8_BAR;
            PG8_LDA(At, 0, 1); PG8_STAGE(PG8_SA(0, 0), a2, voffA);
            PG8_BAR; PG8_WAIT_L(0); PG8_MMA(1, 0, At, B0); PG8_BAR; PG8_SCHED;
            PG8_STAGE(PG8_SB(0, 1), b2 + hstep, voffB);
            PG8_WAIT_V(6); PG8_BAR; PG8_MMA(1, 1, At, B1); PG8_BAR;
            PG8_LDB(B0, 1, 0); PG8_SCHED; PG8_LDA(At, 1, 0); PG8_STAGE(PG8_SA(0, 1), a2 + hstep, voffA);
            PG8_WAIT_L(8); PG8_BAR; PG8_WAIT_L(0); PG8_MMA(0, 0, At, B0); PG8_BAR; PG8_SCHED;
            PG8_LDB(B1, 1, 1); PG8_STAGE(PG8_SB(1, 0), b3, voffB);
            PG8_BAR; PG8_WAIT_L(0); PG8_MMA(0, 1, At, B1); PG8_BAR;
            PG8_LDA(At, 1, 1); PG8_STAGE(PG8_SA(1, 0), a3, voffA);
            PG8_BAR; PG8_WAIT_L(0); PG8_MMA(1, 0, At, B0); PG8_BAR; PG8_SCHED;
            PG8_STAGE(PG8_SB(1, 1), b3 + hstep, voffB);
            PG8_WAIT_V(6); PG8_BAR; PG8_MMA(1, 1, At, B1); PG8_BAR;
            }
        }
        if constexpr (ALIGN_EPI) { if (wr == 0) PG8_BAR; }
        if constexpr (!Epi::AFTER_DRAIN) { E(acc, cur, wr, wc, fr, fq); S.done(cur); }
        if (!has_next) break;
#pragma unroll
        for (int a = 0; a < 2; ++a)
#pragma unroll
            for (int b = 0; b < 2; ++b)
#pragma unroll
                for (int m = 0; m < 4; ++m)
#pragma unroll
                    for (int n = 0; n < 2; ++n) acc[a][b][m][n] = (f32x4){0.f, 0.f, 0.f, 0.f};
        cur = nxt; cA = nA; cB = nB; ++ui;
        if constexpr (ALIGN_EPI) { if (wr == 1) PG8_BAR; }
    }
    PG8_WAIT_V(0);
    if constexpr (!ALIGN_EPI) { if (wr == 0) PG8_BAR; }
    PG8_BAR;
    if constexpr (Epi::AFTER_DRAIN) { E.fused(acc, cur, wr, wc, fr, fq, lds, wid, lane); S.done(cur); }
#undef PG8_SA
#undef PG8_SB
#undef PG8_STAGE
#undef PG8_LDA
#undef PG8_LDB
#undef PG8_MMA
#undef PG8_WAIT_V
#undef PG8_WAIT_L
#undef PG8_BAR
#undef PG8_SCHED
}
}
constexpr int NWAVES = 8;
constexpr int M = 16384, TSEQ = 8192, DM = 1024, FFD = 4096, DEPTH = 4, MD = 32, NH = 8, HD = 64;
constexpr int NIN = 3584;
constexpr int RW0 = 1536;
constexpr int PRP = 2048;
constexpr int NRWU = 1856;
constexpr int CH = 16, NCH = TSEQ / CH;
constexpr int NUNIT = 2 * NH * NCH;
constexpr float LN_EPS = 1e-5f, GN_EPS = 64e-5f, RMS_EPS = 1e-6f;
constexpr float ALPHA = 1.6817928305074290f;
constexpr float QSCALE = 0.125f * 1.4426950408889634f;
constexpr size_t O_Y = 0, O_YS = 16777216, O_SHP = 16809984, O_SHS = 16818176, O_WKP = 16949248, O_WKS = 17211392,
                 O_KP = 21405696, O_VP = 29794304, O_KS = 38182912, O_VS = 38248448, O_END = 38313984;
constexpr size_t MiB = 1u << 20;
constexpr size_t WS_CTL = 0, CTL_ZERO_BYTES = 1 * MiB;
constexpr size_t WS_C1IN = 1 * MiB;
constexpr size_t WS_C2IN = WS_C1IN + 4 * NIN * 4;
constexpr size_t WS_C1UP = WS_C2IN + 4 * NIN * 4;
constexpr size_t WS_C2UP = WS_C1UP + 4 * FFD * 4;
constexpr size_t WS_DUPT = WS_C2UP + 4 * FFD * 4;
constexpr size_t WS_IUPT = WS_DUPT + 4 * 512 * 64 * 2;
constexpr size_t WS_GUPT = WS_IUPT + 4 * 512 * 64 * 2;
constexpr size_t WS_VUPT = WS_GUPT + 4 * 512 * 128 * 2;
constexpr size_t WS_SMALL_END = WS_VUPT + 3 * 512 * 32 * 2;
static_assert(WS_SMALL_END <= 3 * MiB, "small region");
constexpr size_t WS_ROPE = 3 * MiB;
constexpr size_t WS_DEC = 6 * MiB;
constexpr size_t WS_STAT1 = 8 * MiB, WS_STAT2 = 9 * MiB;
constexpr size_t WS_BON = 10 * MiB;
constexpr size_t WS_LSE = 11 * MiB;
constexpr size_t WS_GC = 13 * MiB;
constexpr size_t WS_WIN = 16 * MiB;
constexpr size_t WS_WINU = 44 * MiB;
constexpr size_t WS_WOUT = 60 * MiB;
constexpr size_t WS_WUP = 68 * MiB;
constexpr size_t WS_WDN = 100 * MiB;
constexpr size_t WS_XB2 = 132 * MiB;
constexpr size_t WS_XB1 = 164 * MiB;
constexpr size_t WS_T1 = 196 * MiB;
constexpr size_t WS_T2 = 260 * MiB;
constexpr size_t WS_QB = 324 * MiB, WS_KB = 340 * MiB, WS_VB = 356 * MiB;
constexpr size_t WS_PR = 372 * MiB;
constexpr size_t WS_OP = 436 * MiB;
constexpr size_t WS_MIX = 484 * MiB;
constexpr size_t WS_VF = 516 * MiB, WS_VV = 532 * MiB;
constexpr size_t WS_YPRE = 548 * MiB;
constexpr size_t WS_H = 580 * MiB;
constexpr size_t WS_PT = 580 * MiB;
constexpr size_t WS_QT = 644 * MiB;
constexpr size_t WS_REFF = 708 * MiB;
constexpr size_t WS_YLOC = 724 * MiB;
constexpr size_t WS_SEGQ = 756 * MiB, WS_SEGP = 760 * MiB;
constexpr size_t WS_CSUM = 764 * MiB;
constexpr size_t WS_CSUP = 766 * MiB;
constexpr size_t WS_END = 768 * MiB;
static_assert(WS_H + (size_t)M * FFD * 2 <= WS_END + 0 * MiB || true, "");
constexpr size_t DEC_XB2 = 0;
constexpr size_t DEC_XB1 = 64 * 1024;
constexpr size_t DEC_SHB = 128 * 1024;
constexpr size_t DEC_MIXB = 384 * 1024;
constexpr size_t DEC_HB = 448 * 1024;
constexpr size_t DEC_T1 = 704 * 1024;
constexpr size_t DEC_T2 = 832 * 1024;
constexpr size_t DEC_PD = 960 * 1024;
constexpr size_t DEC_PS = 1408 * 1024;
constexpr size_t DEC_OP = 1640 * 1024;
constexpr size_t DEC_LSE = 1832 * 1024;
constexpr size_t DEC_MIX = 1836 * 1024;
constexpr size_t DEC_ST1 = 1964 * 1024;
constexpr size_t DEC_ST2 = 1972 * 1024;
constexpr size_t DEC_VF = 1980 * 1024;
static_assert(DEC_VF + 32 * 512 * 4 <= 2 * MiB, "decode scratch");
constexpr int CW_BAR = 4096;
constexpr int RING_BYTES = 131072;
constexpr int MISC_OFF = RING_BYTES + 320;
constexpr int LDS_BYTES = 147456;
static_assert(pg8::WSO_C1IN == WS_C1IN && pg8::WSO_C2IN == WS_C2IN && pg8::WSO_C1UP == WS_C1UP && pg8::WSO_C2UP == WS_C2UP && pg8::WSO_ROPE == WS_ROPE && pg8::WSO_STAT1 == WS_STAT1 && pg8::WSO_STAT2 == WS_STAT2 &&
              pg8::WSO_XB2 == WS_XB2 && pg8::WSO_XB1 == WS_XB1 && pg8::WSO_T1 == WS_T1 && pg8::WSO_T2 == WS_T2 && pg8::WSO_QB == WS_QB && pg8::WSO_KB == WS_KB && pg8::WSO_VB == WS_VB && pg8::WSO_PR == WS_PR && pg8::WSO_H == WS_H &&
              pg8::OO_SHP == O_SHP && pg8::OO_KP == O_KP && pg8::OO_VP == O_VP, "epilogue offset mirrors");
#define GAS __attribute__((address_space(1)))
#define LAS __attribute__((address_space(3)))
typedef unsigned short bf16;
typedef unsigned v4u __attribute__((ext_vector_type(4)));
typedef unsigned v2u __attribute__((ext_vector_type(2)));
typedef float f32x4 __attribute__((ext_vector_type(4)));
typedef float f32x2 __attribute__((ext_vector_type(2)));
typedef float f32x16 __attribute__((ext_vector_type(16)));
typedef short bf16x8 __attribute__((ext_vector_type(8)));
typedef short s16x4 __attribute__((ext_vector_type(4)));
typedef GAS unsigned gu32;
#define RLX_AGENT __ATOMIC_RELAXED, __HIP_MEMORY_SCOPE_AGENT
#define LDS_WAIT() asm volatile("s_waitcnt lgkmcnt(0)" ::: "memory")
#define VM_WAIT() asm volatile("s_waitcnt vmcnt(0)" ::: "memory")
#define DI __device__ __forceinline__
DI unsigned f2bf(float f) { unsigned u = __builtin_bit_cast(unsigned, f); return (u + 0x7fffu + ((u >> 16) & 1u)) >> 16; }
DI float bf2f(unsigned b) { return __builtin_bit_cast(float, b << 16); }
DI float bflo(unsigned w) { return __builtin_bit_cast(float, w << 16); }
DI float bfhi(unsigned w) { return __builtin_bit_cast(float, w & 0xffff0000u); }
typedef __bf16 bf16x2_t __attribute__((ext_vector_type(2)));
DI unsigned pk2(float lo, float hi) { const f32x2 v = {lo, hi}; const bf16x2_t b = __builtin_convertvector(v, bf16x2_t); return __builtin_bit_cast(unsigned, b); }
DI unsigned pk2z(float x) { return pk2(x, 0.f) & 0xffffu; }
DI float rbf(float x) { return bf2f(f2bf(x)); }
DI bf16x8 pk8(float a0, float a1, float a2, float a3, float a4, float a5, float a6, float a7) {
    v4u w; w.x = pk2(a0, a1); w.y = pk2(a2, a3); w.z = pk2(a4, a5); w.w = pk2(a6, a7); return __builtin_bit_cast(bf16x8, w); }
DI bf16x8 pk8v(f32x4 a, f32x4 b) { return pk8(a[0], a[1], a[2], a[3], b[0], b[1], b[2], b[3]); }
DI bf16x8 pk4z(f32x4 a) { v4u w; w.x = pk2(a[0], a[1]); w.y = pk2(a[2], a[3]); w.z = 0u; w.w = 0u; return __builtin_bit_cast(bf16x8, w); }
DI bf16x8 ld8(const void* p) { return *(const bf16x8*)p; }
DI bf16x8 ld4z(const void* p) { v2u t = *(const v2u*)p; v4u w; w.x = t.x; w.y = t.y; w.z = 0u; w.w = 0u; return __builtin_bit_cast(bf16x8, w); }
DI f32x4 mfma16(bf16x8 a, bf16x8 b, f32x4 c) { return __builtin_amdgcn_mfma_f32_16x16x32_bf16(a, b, c, 0, 0, 0); }
DI f32x16 mfma32(bf16x8 a, bf16x8 b, f32x16 c) { return __builtin_amdgcn_mfma_f32_32x32x16_bf16(a, b, c, 0, 0, 0); }
DI int crow(int r, int hi) { return (r & 3) + 8 * (r >> 2) + 4 * hi; }
DI float wave_sum(float v) {
#pragma unroll
    for (int o = 1; o < 64; o <<= 1) v += __shfl_xor(v, o);
    return v; }
DI float fexp(float x) { return __expf(x); }
DI float fsigmoid(float x) { return __builtin_amdgcn_rcpf(1.f + __expf(-x)); }
DI float ftanh(float x) { return 1.f - 2.f * __builtin_amdgcn_rcpf(__expf(2.f * x) + 1.f); }
DI float fsoftplus(float x) { return fmaxf(x, 0.f) + __logf(1.f + __expf(-fabsf(x))); }
DI int swap45(int c) { return (c & ~0x30) | ((c & 0x10) << 1) | ((c & 0x20) >> 1); }
#define XB_TMO      128
#define XB_XCNT(j)  (256  + 64 * (j))
#define XB_XSUB(j)  (1280 + 64 * (j))
#define XB_XGEN(j)  (2304 + 64 * (j))
#define XB_TOP      3328
#define XB_TOPGEN   3392
#define XCD_BAR_WORDS 3456
#define XB_SPIN_CAP (1u << 18)

__device__ __forceinline__ unsigned xb_ld(unsigned* p)              { return __hip_atomic_load(p, __ATOMIC_RELAXED, __HIP_MEMORY_SCOPE_AGENT); }
__device__ __forceinline__ unsigned xb_add(unsigned* p, unsigned v) { return __hip_atomic_fetch_add(p, v, __ATOMIC_RELAXED, __HIP_MEMORY_SCOPE_AGENT); }
__device__ __forceinline__ unsigned xb_xcc_id() { return (unsigned)__builtin_amdgcn_s_getreg((3 << 11) | 20) & 0xFu; }
#define XB_SPIN(cond, bar) do { unsigned _sp = 0; while (cond) { __builtin_amdgcn_s_sleep(1); \
    if ((++_sp & 255u) == 0u) { if (xb_ld(&(bar)[XB_TMO])) break; if (_sp > XB_SPIN_CAP) { atomicAdd(&(bar)[XB_TMO], 1u); break; } } } } while (0)

struct XcdBarrier {
    unsigned* bar; unsigned x;
    volatile LAS unsigned* st;
};

__device__ __forceinline__ XcdBarrier xcd_barrier_post(unsigned* bar, volatile LAS unsigned* st) {
    XcdBarrier b; b.bar = bar; b.x = xb_xcc_id(); b.st = st;
    if (threadIdx.x == 0) (void)xb_add(&bar[XB_XCNT(b.x)], 1u);
    return b;
}
__device__ __forceinline__ void xcd_barrier_complete(unsigned* bar, unsigned x, unsigned& nloc, unsigned& nx) {
    const unsigned G = gridDim.x * gridDim.y * gridDim.z;
    unsigned sum, cnt, mine, sp = 0u;
    for (;;) {
        sum = 0u; cnt = 0u; mine = 0u;
#pragma unroll
        for (unsigned j = 0; j < 16; ++j) { const unsigned c = xb_ld(&bar[XB_XCNT(j)]); sum += c; cnt += (c > 0u) ? 1u : 0u; mine = (j == x) ? c : mine; }
        if (sum == G) break;
        __builtin_amdgcn_s_sleep(1);
        if ((++sp & 255u) == 0u) { if (xb_ld(&bar[XB_TMO])) break; if (sp > XB_SPIN_CAP) { atomicAdd(&bar[XB_TMO], 1u); break; } }
    }
    nloc = mine > 0u ? mine : 1u; nx = cnt > 0u ? cnt : 1u;
}

__device__ __forceinline__ void xcd_barrier(const XcdBarrier& b) {
    asm volatile("s_waitcnt vmcnt(0)" ::: "memory");
    __syncthreads();
    if (threadIdx.x == 0) {
        unsigned* bar = b.bar;
        __builtin_amdgcn_s_waitcnt(0);
        unsigned nloc = b.st[0], nx = b.st[1];
        if (nloc == 0u) { xcd_barrier_complete(bar, b.x, nloc, nx); b.st[0] = nloc; b.st[1] = nx; }
        const unsigned old = xb_add(&bar[XB_XSUB(b.x)], 1u);
        const unsigned gen = old / nloc;
        if (old + 1u == (gen + 1u) * nloc) {
            __builtin_amdgcn_fence(__ATOMIC_RELEASE, "agent");
            asm volatile("s_waitcnt vmcnt(0)" ::: "memory");
            const unsigned og = xb_add(&bar[XB_TOP], 1u);
            const unsigned tg = og / nx;
            if (og + 1u == (tg + 1u) * nx) xb_add(&bar[XB_TOPGEN], 1u);
            else XB_SPIN(xb_ld(&bar[XB_TOPGEN]) == tg, bar);
            __builtin_amdgcn_fence(__ATOMIC_ACQUIRE, "agent");
            xb_add(&bar[XB_XGEN(b.x)], 1u);
            asm volatile("s_waitcnt vmcnt(0)" ::: "memory");
        } else {
            XB_SPIN(xb_ld(&bar[XB_XGEN(b.x)]) == gen, bar);
            __builtin_amdgcn_fence(__ATOMIC_ACQUIRE, "agent");
            asm volatile("s_waitcnt vmcnt(0)" ::: "memory");
        }
    }
    __syncthreads();
}
struct Args { const float* in[30]; float* out; unsigned char* ws; };
struct Frame {
    unsigned char* lds;
    volatile LAS unsigned* MISC;
    gu32* ctl;
    int tid, lane, wave, vcu, G, gw, NGW;
    const float* const* in; float* out; unsigned char* ws;
};
template <bool SWAP>
DI void p0_transpose_item(const float* W, int ldw, int K, int csrc0, bf16* WT, int row_off, const float* gsc, LAS float* scr, int kb, int nb, int lane, float* csum = nullptr, int ncs = 0, const float* bsh = nullptr) {
    const int k0 = 64 * kb, n0 = 32 * nb;
    float s1 = 0.f, s2 = 0.f;
    float wv[32], gk = 1.f, bk = 0.f;
#pragma unroll
    for (int i = 0; i < 32; ++i) wv[i] = W[(size_t)(k0 + 2 * i + (lane >> 5)) * ldw + csrc0 + n0 + (lane & 31)];
    if (gsc) gk = gsc[k0 + lane]; if (bsh) bk = bsh[k0 + lane];
#pragma unroll
    for (int i = 0; i < 32; ++i) { const int kk = 2 * i + (lane >> 5); float v = wv[i]; s2 += v * __shfl(bk, kk); v *= __shfl(gk, kk); s1 += rbf(v); scr[kk * 33 + (lane & 31)] = v; }
    if (csum) { s1 += __shfl_xor(s1, 32); s2 += __shfl_xor(s2, 32); if (lane < 32) { int dr = n0 + lane; if (SWAP) dr = swap45(dr); csum[(size_t)(kb * 2 + 0) * ncs + row_off + dr] = s1; csum[(size_t)(kb * 2 + 1) * ncs + row_off + dr] = s2; } }
    LDS_WAIT(); asm volatile("" ::: "memory");
    const int c = lane & 7;
#pragma unroll
    for (int j = 0; j < 4; ++j) { const int n = (lane >> 3) + 8 * j; const LAS float* s = scr + (8 * c) * 33 + n;
        v4u o; o.x = pk2(s[0 * 33], s[1 * 33]); o.y = pk2(s[2 * 33], s[3 * 33]); o.z = pk2(s[4 * 33], s[5 * 33]); o.w = pk2(s[6 * 33], s[7 * 33]);
        int dr = n0 + n; if (SWAP) dr = swap45(dr);
        *(v4u*)(WT + (size_t)(row_off + dr) * K + k0 + 8 * c) = o; }
    LDS_WAIT(); asm volatile("" ::: "memory");
}
DI void p0_prologue(Frame& F) {
    LAS float* scr = (LAS float*)((LAS unsigned char*)F.lds + F.wave * 16384);
    const float* const* in = F.in; unsigned char* ws = F.ws;
    constexpr int I_IN = 16 * 104, I_VR = 16, I_INU = 16 * 56, I_OUT = 16 * 32, I_UP = 16 * 128, I_DN = 64 * 32;
    constexpr int I_L = I_IN + I_VR + I_INU + I_VR + I_OUT + I_UP + I_DN;
    for (int it = F.gw; it < DEPTH * I_L; it += F.NGW) {
        const int l = it / I_L; int r = it % I_L;
        const float* g2p = l > 0 ? in[28] + (size_t)(l - 1) * DM : nullptr;
        bf16* win = (bf16*)(ws + WS_WIN) + (size_t)l * NIN * DM; bf16* winu = (bf16*)(ws + WS_WINU) + (size_t)l * NRWU * DM;
        if (r < I_IN) { const int kb = r / 104, nb = r % 104; const float* W = in[6] + (size_t)l * DM * 3328;
            float* cs = l > 0 ? (float*)(ws + WS_CSUM) + (size_t)l * 32 * NIN : nullptr; const float* b2p = l > 0 ? in[29] + (size_t)(l - 1) * DM : nullptr;
            if (nb < 32) p0_transpose_item<true>(W, 3328, DM, 0, win, 0, g2p, scr, kb, nb, F.lane, cs, NIN, b2p); else p0_transpose_item<false>(W, 3328, DM, 0, win, 0, g2p, scr, kb, nb, F.lane, cs, NIN, b2p); continue; } r -= I_IN;
        if (r < I_VR) { if (l > 0) p0_transpose_item<false>(in[7] + (size_t)(l - 1) * DM * 32, 32, DM, 0, win, 3328, g2p, scr, r, 0, F.lane, (float*)(ws + WS_CSUM) + (size_t)l * 32 * NIN, NIN, in[29] + (size_t)(l - 1) * DM); continue; } r -= I_VR;
        if (r < I_INU) { const int kb = r / 56, nb = r % 56; p0_transpose_item<false>(in[6] + (size_t)l * DM * 3328, 3328, DM, RW0, winu, 0, nullptr, scr, kb, nb, F.lane); continue; } r -= I_INU;
        if (r < I_VR) { if (l > 0) p0_transpose_item<false>(in[7] + (size_t)(l - 1) * DM * 32, 32, DM, 0, winu, 1792, nullptr, scr, r, 0, F.lane); continue; } r -= I_VR;
        if (r < I_OUT) { p0_transpose_item<false>(in[23] + (size_t)l * DM * DM, DM, DM, 0, (bf16*)(ws + WS_WOUT) + (size_t)l * DM * DM, 0, nullptr, scr, r / 32, r % 32, F.lane); continue; } r -= I_OUT;
        if (r < I_UP) { p0_transpose_item<false>(in[26] + (size_t)l * DM * FFD, FFD, DM, 0, (bf16*)(ws + WS_WUP) + (size_t)l * FFD * DM, 0, in[24] + (size_t)l * DM, scr, r / 128, r % 128, F.lane, (float*)(ws + WS_CSUP) + (size_t)l * 32 * FFD, FFD, in[25] + (size_t)l * DM); continue; } r -= I_UP;
        p0_transpose_item<false>(in[27] + (size_t)l * FFD * DM, DM, FFD, 0, (bf16*)(ws + WS_WDN) + (size_t)l * DM * FFD, 0, nullptr, scr, r / 32, r % 32, F.lane);
    }
    for (int m0 = F.gw; m0 < M; m0 += 4 * F.NGW) { f32x4 v[4][4];
#pragma unroll
        for (int q = 0; q < 4; ++q) { const f32x4* xr = (const f32x4*)(in[0] + (size_t)(m0 + q * F.NGW) * DM) + F.lane;
#pragma unroll
            for (int j = 0; j < 4; ++j) v[q][j] = xr[64 * j]; }
#pragma unroll
        for (int q = 0; q < 4; ++q) { unsigned long long* o8 = (unsigned long long*)((bf16*)(ws + WS_XB2) + (size_t)(m0 + q * F.NGW) * DM) + F.lane;
#pragma unroll
            for (int j = 0; j < 4; ++j) o8[64 * j] = (unsigned long long)pk2(v[q][j].x, v[q][j].y) | ((unsigned long long)pk2(v[q][j].z, v[q][j].w) << 32); } }
    const int gt = F.gw * 64 + F.lane, NGT = F.NGW * 64;
    for (int e = gt; e < 8193 * 32; e += NGT) { const int pos = e >> 5, i = e & 31; const double ang = (double)pos * pow(10000.0, -(double)i / 32.0); ((f32x2*)(ws + WS_ROPE))[e] = (f32x2){(float)cos(ang), (float)sin(ang)}; }
    for (int e = gt; e < 4 * 512 * 64; e += NGT) { const int l = e / (512 * 64), n = (e / 64) % 512, m = e % 64; ((bf16*)(ws + WS_DUPT))[e] = (bf16)f2bf(in[11][((size_t)l * 64 + m) * 512 + n]); ((bf16*)(ws + WS_IUPT))[e] = (bf16)f2bf(in[13][((size_t)l * 64 + m) * 512 + n]); }
    for (int e = gt; e < 4 * 512 * 128; e += NGT) { const int l = e / (512 * 128), n = (e / 128) % 512, m = e % 128; ((bf16*)(ws + WS_GUPT))[e] = (bf16)f2bf(in[14][((size_t)l * 128 + m) * 512 + n]); }
    for (int e = gt; e < 3 * 512 * 32; e += NGT) { const int l = e / (512 * 32), n = (e / 32) % 512, m = e % 32; ((bf16*)(ws + WS_VUPT))[e] = (bf16)f2bf(in[16][((size_t)l * 32 + m) * 512 + n]); }
    for (int e = gt; e < MD * DM; e += NGT) { ((bf16*)(ws + WS_DEC + DEC_XB2))[e] = (bf16)f2bf(in[1][e]); }
    for (int e = gt; e < DEPTH * MD * DM; e += NGT) { ((bf16*)(ws + WS_DEC + DEC_SHB))[e] = (bf16)f2bf(in[2][e]); }
}
DI void colsum_finish(unsigned char* ws, int gt, int NGT) {
    for (int e = gt; e < 3 * NIN; e += NGT) { const int l = 1 + e / NIN, p = e % NIN; if (p >= 3360) continue; const float* cs = (const float*)(ws + WS_CSUM) + (size_t)l * 32 * NIN + p; float s1 = 0.f, s2 = 0.f;
#pragma unroll
        for (int kb = 0; kb < 16; ++kb) { s1 += cs[(size_t)(2 * kb) * NIN]; s2 += cs[(size_t)(2 * kb + 1) * NIN]; }
        ((float*)(ws + WS_C1IN))[l * NIN + p] = s1; ((float*)(ws + WS_C2IN))[l * NIN + p] = s2; }
    for (int e = gt; e < 4 * FFD; e += NGT) { const int l = e / FFD, p = e % FFD; const float* cs = (const float*)(ws + WS_CSUP) + (size_t)l * 32 * FFD + p; float s1 = 0.f, s2 = 0.f;
#pragma unroll
        for (int kb = 0; kb < 16; ++kb) { s1 += cs[(size_t)(2 * kb) * FFD]; s2 += cs[(size_t)(2 * kb + 1) * FFD]; }
        ((float*)(ws + WS_C1UP))[l * FFD + p] = s1; ((float*)(ws + WS_C2UP))[l * FFD + p] = s2; }
}
constexpr int VPITCH = 144;
constexpr int ATT_WLDS = 2 * 32 * VPITCH + 256;
DI void tr_read8(unsigned base, s16x4 (&t)[8]) {
    asm volatile("ds_read_b64_tr_b16 %0, %8\n\tds_read_b64_tr_b16 %1, %8 offset:%c9\n\tds_read_b64_tr_b16 %2, %8 offset:%c10\n\tds_read_b64_tr_b16 %3, %8 offset:%c11\n\t"
                 "ds_read_b64_tr_b16 %4, %8 offset:%c12\n\tds_read_b64_tr_b16 %5, %8 offset:%c13\n\tds_read_b64_tr_b16 %6, %8 offset:%c14\n\tds_read_b64_tr_b16 %7, %8 offset:%c15\n\ts_waitcnt lgkmcnt(0)"
                 : "=&v"(t[0]), "=&v"(t[1]), "=&v"(t[2]), "=&v"(t[3]), "=&v"(t[4]), "=&v"(t[5]), "=&v"(t[6]), "=&v"(t[7])
                 : "v"(base), "i"(8 * VPITCH), "i"(64), "i"(8 * VPITCH + 64), "i"(16 * VPITCH), "i"(24 * VPITCH), "i"(16 * VPITCH + 64), "i"(24 * VPITCH + 64) : "memory");
}
DI void attn_task(const bf16* QB, const bf16* KB, const bf16* VB, bf16* OP, float* LSE, int b, int h, int p, int cls, int qblk, LAS unsigned char* wl, int lane) {
    asm volatile("" : "+v"(lane));
    const int dd = 1 << (2 * p), r32 = lane & 31, hi = lane >> 5;
    const int m0 = 32 * qblk;
    const size_t rowb = (size_t)b * TSEQ;
    const size_t qrow = rowb + (size_t)(m0 + r32) * dd + cls;
    bf16x8 qf[4];
#pragma unroll
    for (int d0 = 0; d0 < 4; ++d0) qf[d0] = ld8(QB + qrow * 512 + h * 64 + d0 * 16 + hi * 8);
    f32x16 s[5];
    const int kt0 = (m0 >= 128) ? 0 : (128 - m0) / 32;
    bf16x8 kf[5][4];
#pragma unroll
    for (int kt = 0; kt < 5; ++kt) {
        const int mk = m0 - 128 + 32 * kt + r32;
        const size_t krow = rowb + (size_t)(mk < 0 ? 0 : mk) * dd + cls;
#pragma unroll
        for (int d0 = 0; d0 < 4; ++d0) kf[kt][d0] = ld8(KB + krow * 512 + h * 64 + d0 * 16 + hi * 8);
    }
#pragma unroll
    for (int kt = 0; kt < 5; ++kt) {
        f32x16 a; for (int i = 0; i < 16; ++i) a[i] = 0.f;
#pragma unroll
        for (int d0 = 0; d0 < 4; ++d0) a = mfma32(kf[kt][d0], qf[d0], a);
        s[kt] = a;
    }
#pragma unroll
    for (int kt = 0; kt < 5; ++kt) {
        if (kt < kt0) {
#pragma unroll
            for (int i = 0; i < 16; ++i) s[kt][i] = -INFINITY;
        } else if (kt == 0) {
#pragma unroll
            for (int i = 0; i < 16; ++i) s[kt][i] = (crow(i, hi) >= r32) ? s[kt][i] : -INFINITY;
        } else if (kt == 4) {
#pragma unroll
            for (int i = 0; i < 16; ++i) s[kt][i] = (crow(i, hi) <= r32) ? s[kt][i] : -INFINITY;
        }
    }
    float mx = -INFINITY;
#pragma unroll
    for (int kt = 0; kt < 5; ++kt)
#pragma unroll
        for (int i = 0; i < 16; ++i) mx = fmaxf(mx, s[kt][i]);
    mx = fmaxf(mx, __shfl_xor(mx, 32));
    float lsum = 0.f;
#pragma unroll
    for (int kt = 0; kt < 5; ++kt)
#pragma unroll
        for (int i = 0; i < 16; ++i) { const float e = __builtin_amdgcn_exp2f(s[kt][i] - mx); s[kt][i] = e; lsum += e; }
    lsum += __shfl_xor(lsum, 32);
    f32x16 o[2]; for (int i = 0; i < 16; ++i) { o[0][i] = 0.f; o[1][i] = 0.f; }
    LAS float* wsf = (LAS float*)(wl + 2 * 32 * VPITCH);
    const unsigned vb0 = (unsigned)(uintptr_t)wl;
    const int g = lane >> 4, i16 = lane & 15, qq = i16 >> 2, pp = i16 & 3;
    const unsigned traddr = (unsigned)((4 * (g >> 1) + qq) * VPITCH + (16 * (g & 1) + 4 * pp) * 2);
    const int vkey = lane >> 1, vhalf = lane & 1;
    v4u vr[4];
#define ATT_LOADV(KT) do { const int mk_ = m0 - 128 + 32 * (KT) + vkey; const size_t vrow_ = rowb + (size_t)mk_ * dd + cls; const v4u* src_ = (const v4u*)(VB + vrow_ * 512 + h * 64 + vhalf * 32); \
        vr[0] = src_[0]; vr[1] = src_[1]; vr[2] = src_[2]; vr[3] = src_[3]; } while (0)
    ATT_LOADV(kt0);
#pragma unroll
    for (int kt = 0; kt < 5; ++kt) {
        if (kt >= kt0) {
            LAS unsigned char* vb = wl + (kt & 1) * 32 * VPITCH;
            { LAS v4u* dst = (LAS v4u*)(vb + vkey * VPITCH + vhalf * 64); dst[0] = vr[0]; dst[1] = vr[1]; dst[2] = vr[2]; dst[3] = vr[3]; }
            if (kt + 1 < 5) ATT_LOADV(kt + 1);
            LDS_WAIT();
            const unsigned base = vb0 + (unsigned)((kt & 1) * 32 * VPITCH) + traddr;
            s16x4 t[8];
            tr_read8(base, t);
#pragma unroll
            for (int ss = 0; ss < 2; ++ss) {
                const bf16x8 pa = pk8(s[kt][8 * ss], s[kt][8 * ss + 1], s[kt][8 * ss + 2], s[kt][8 * ss + 3], s[kt][8 * ss + 4], s[kt][8 * ss + 5], s[kt][8 * ss + 6], s[kt][8 * ss + 7]);
#pragma unroll
                for (int db = 0; db < 2; ++db) { const bf16x8 vf = __builtin_shufflevector(t[4 * ss + 2 * db], t[4 * ss + 2 * db + 1], 0, 1, 2, 3, 4, 5, 6, 7); o[db] = mfma32(pa, vf, o[db]); }
            }
        }
    }
#undef ATT_LOADV
    if (hi == 0) { wsf[r32] = __builtin_amdgcn_rcpf(lsum); LSE[((size_t)p * M + qrow) * 8 + h] = mx + __builtin_amdgcn_logf(lsum); }
    LDS_WAIT();
#pragma unroll
    for (int i = 0; i < 16; ++i) { const int q = crow(i, hi); const float li = wsf[q]; const size_t orow = rowb + (size_t)(m0 + q) * dd + cls;
        bf16* op = OP + ((size_t)p * M + orow) * 512 + h * 64 + r32;
        op[0] = (bf16)pk2z(o[0][i] * li); op[32] = (bf16)pk2z(o[1][i] * li); }
    LDS_WAIT();
}
DI void attn_finalize_row(const bf16* OP, const float* LSE, const float* gain, bf16* MIX, int row, int lane) {
    asm volatile("" : "+v"(lane));
    const int h = lane >> 3;
    float l0 = LSE[((size_t)0 * M + row) * 8 + h], l1 = LSE[((size_t)1 * M + row) * 8 + h], l2 = LSE[((size_t)2 * M + row) * 8 + h];
    const float mx = fmaxf(l0, fmaxf(l1, l2));
    float w0 = __builtin_amdgcn_exp2f(l0 - mx), w1 = __builtin_amdgcn_exp2f(l1 - mx), w2 = __builtin_amdgcn_exp2f(l2 - mx);
    const float inv = __builtin_amdgcn_rcpf(w0 + w1 + w2); w0 *= inv; w1 *= inv; w2 *= inv;
    const v4u a = *(const v4u*)(OP + ((size_t)0 * M + row) * 512 + lane * 8), b = *(const v4u*)(OP + ((size_t)1 * M + row) * 512 + lane * 8), c = *(const v4u*)(OP + ((size_t)2 * M + row) * 512 + lane * 8);
    float v[8]; float ss = 0.f;
#pragma unroll
    for (int j = 0; j < 4; ++j) { v[2 * j] = w0 * bflo(a[j]) + w1 * bflo(b[j]) + w2 * bflo(c[j]); v[2 * j + 1] = w0 * bfhi(a[j]) + w1 * bfhi(b[j]) + w2 * bfhi(c[j]); ss += v[2 * j] * v[2 * j] + v[2 * j + 1] * v[2 * j + 1]; }
    ss = wave_sum(ss);
    const float rinv = 1.0f / sqrtf(ss * (1.f / 512.f) + RMS_EPS);
    const f32x4 g0 = *(const f32x4*)(gain + lane * 8), g1 = *(const f32x4*)(gain + lane * 8 + 4);
    v4u w; w.x = pk2(v[0] * rinv * g0[0], v[1] * rinv * g0[1]); w.y = pk2(v[2] * rinv * g0[2], v[3] * rinv * g0[3]); w.z = pk2(v[4] * rinv * g1[0], v[5] * rinv * g1[1]); w.w = pk2(v[6] * rinv * g1[2], v[7] * rinv * g1[3]);
    *(v4u*)(MIX + (size_t)row * 1024 + lane * 8) = w;
}
constexpr int B1_IMG = 2048, B1_WLDS = 5 * B1_IMG + 1024;
DI float dpp_shr(float x, int n) { int v;
    switch (n) { case 1: v = __builtin_amdgcn_update_dpp(0, __builtin_bit_cast(int, x), 0x111, 0xf, 0xf, true); break; case 2: v = __builtin_amdgcn_update_dpp(0, __builtin_bit_cast(int, x), 0x112, 0xf, 0xf, true); break;
                 case 4: v = __builtin_amdgcn_update_dpp(0, __builtin_bit_cast(int, x), 0x114, 0xf, 0xf, true); break; default: v = __builtin_amdgcn_update_dpp(0, __builtin_bit_cast(int, x), 0x118, 0xf, 0xf, true); break; }
    return __builtin_bit_cast(float, v); }
DI float dpp_shr1(float x, int n) { int v; const int one = 0x3f800000;
    switch (n) { case 1: v = __builtin_amdgcn_update_dpp(one, __builtin_bit_cast(int, x), 0x111, 0xf, 0xf, false); break; case 2: v = __builtin_amdgcn_update_dpp(one, __builtin_bit_cast(int, x), 0x112, 0xf, 0xf, false); break;
                 case 4: v = __builtin_amdgcn_update_dpp(one, __builtin_bit_cast(int, x), 0x114, 0xf, 0xf, false); break; default: v = __builtin_amdgcn_update_dpp(one, __builtin_bit_cast(int, x), 0x118, 0xf, 0xf, false); break; }
    return __builtin_bit_cast(float, v); }
struct RwkvP {
    const bf16* PR; const float* mu; const float* muv;
    const float *dbase, *ibase, *vbase, *ksk, *ksa, *brk, *gng, *gnb;
    const bf16 *dupT, *iupT, *vupT, *gupT;
    const bf16* ZROW; bf16 *VF, *VV; float* BON; float* GC; bf16 *W1S, *REFF, *BM; v4u* REC; float* YPRE; bf16* MIX; int layer0;
};
DI void lerp8(const bf16* crow_, const bf16* prow_, int col, const float* mu, float (&z)[8]) {
    const v4u cur = *(const v4u*)(crow_ + col); const v4u prv = *(const v4u*)(prow_ + col);
    const f32x4 m0 = *(const f32x4*)(mu), m1 = *(const f32x4*)(mu + 4);
#pragma unroll
    for (int j = 0; j < 4; ++j) { const float a = bflo(cur[j]), b = bfhi(cur[j]), pa = bflo(prv[j]), pb = bfhi(prv[j]); const float ma = j < 2 ? m0[2 * j] : m1[2 * j - 4], mb = j < 2 ? m0[2 * j + 1] : m1[2 * j - 3];
        z[2 * j] = a + (pa - a) * ma; z[2 * j + 1] = b + (pb - b) * mb; }
}
DI f32x4 lerp4(const bf16* crow_, const bf16* prow_, int col, const float* mu) {
    const v2u cur = *(const v2u*)(crow_ + col); const v2u prv = *(const v2u*)(prow_ + col);
    const f32x4 m = *(const f32x4*)(mu);
    f32x4 z; z[0] = bflo(cur.x) + (bflo(prv.x) - bflo(cur.x)) * m[0]; z[1] = bfhi(cur.x) + (bfhi(prv.x) - bfhi(cur.x)) * m[1];
    z[2] = bflo(cur.y) + (bflo(prv.y) - bflo(cur.y)) * m[2]; z[3] = bfhi(cur.y) + (bfhi(prv.y) - bfhi(cur.y)) * m[3]; return z;
}
DI void img_write(LAS unsigned char* img, const f32x4 (&x)[4], int fr, int fq) {
#pragma unroll
    for (int mb = 0; mb < 4; ++mb)
#pragma unroll
        for (int reg = 0; reg < 4; ++reg) *(LAS bf16*)(img + (16 * mb + 4 * fq + reg) * 32 + fr * 2) = (bf16)pk2z(x[mb][reg]);
}
DI bf16x8 lds4z(const LAS unsigned char* p) { const v2u t = *(const LAS v2u*)p; v4u w; w.x = t.x; w.y = t.y; w.z = 0u; w.w = 0u; return __builtin_bit_cast(bf16x8, w); }
DI void rwkv_b1_unit(const RwkvP& P, int unit, LAS unsigned char* wl, int lane) {
    asm volatile("" : "+v"(lane));
    const int fr = lane & 15, fq = lane >> 4;
    const int seq = unit >> 9, c = unit & 511, b = seq >> 3, h = seq & 7;
    const size_t row = (size_t)b * TSEQ + 16 * c + fr;
    const bool hasprev = (c | fr) != 0;
    const bf16* crp = P.PR + row * PRP; const bf16* prp = hasprev ? crp - PRP : P.ZROW;
    const f32x4 z4 = {0.f, 0.f, 0.f, 0.f};
    bf16x8 tw[2], al[2], vl;
#pragma unroll
    for (int ks = 0; ks < 2; ++ks) { float z[8]; lerp8(crp, prp, 1536 + 8 * fq + 32 * ks, P.mu + 1536 + 8 * fq + 32 * ks, z);
        tw[ks] = pk8(ftanh(z[0]), ftanh(z[1]), ftanh(z[2]), ftanh(z[3]), ftanh(z[4]), ftanh(z[5]), ftanh(z[6]), ftanh(z[7]));
        lerp8(crp, prp, 1600 + 8 * fq + 32 * ks, P.mu + 1600 + 8 * fq + 32 * ks, z); al[ks] = pk8(z[0], z[1], z[2], z[3], z[4], z[5], z[6], z[7]); }
    if (!P.layer0) { float z[8]; lerp8(crp, prp, 1792 + 8 * fq, P.muv + 8 * fq, z); vl = pk8(z[0], z[1], z[2], z[3], z[4], z[5], z[6], z[7]); }
    f32x4 zr[4], k2[4], kk[4], ai[4], ld[4];
    float nrm = 0.f, bon = 0.f;
#pragma unroll
    for (int mb = 0; mb < 4; ++mb) { const int ch = h * 64 + 16 * mb + 4 * fq; const int n = h * 64 + 16 * mb + fr;
        f32x4 dw = z4, da = z4, dv = z4;
        dw = mfma16(ld8(P.dupT + (size_t)n * 64 + 8 * fq), tw[0], dw); dw = mfma16(ld8(P.dupT + (size_t)n * 64 + 8 * fq + 32), tw[1], dw);
        da = mfma16(ld8(P.iupT + (size_t)n * 64 + 8 * fq), al[0], da); da = mfma16(ld8(P.iupT + (size_t)n * 64 + 8 * fq + 32), al[1], da);
        if (!P.layer0) dv = mfma16(ld8(P.vupT + (size_t)n * 32 + 8 * fq), vl, z4);
        zr[mb] = lerp4(crp, prp, ch, P.mu + ch);
        const f32x4 zk = lerp4(crp, prp, 512 + ch, P.mu + 512 + ch);
        f32x4 zv = lerp4(crp, prp, 1024 + ch, P.mu + 1024 + ch);
        const f32x4 db = *(const f32x4*)(P.dbase + ch), ib = *(const f32x4*)(P.ibase + ch), sk = *(const f32x4*)(P.ksk + ch), sa = *(const f32x4*)(P.ksa + ch), br = *(const f32x4*)(P.brk + ch);
        if (P.layer0) { v2u w; w.x = pk2(zv[0], zv[1]); w.y = pk2(zv[2], zv[3]); *(v2u*)(P.VF + row * 512 + ch) = w; }
        else { const v2u f = *(const v2u*)(P.VF + row * 512 + ch); const f32x4 vb = *(const f32x4*)(P.vbase + ch); const f32x4 vf = {bflo(f.x), bfhi(f.x), bflo(f.y), bfhi(f.y)};
#pragma unroll
            for (int e = 0; e < 4; ++e) zv[e] = zv[e] + (vf[e] - zv[e]) * fsigmoid(vb[e] + dv[e]); }
        { v2u w; w.x = pk2(zv[0], zv[1]); w.y = pk2(zv[2], zv[3]); *(v2u*)(P.VV + row * 512 + ch) = w; }
#pragma unroll
        for (int reg = 0; reg < 4; ++reg) *(LAS bf16*)(wl + 2 * B1_IMG + (16 * mb + 4 * fq + reg) * 32 + fr * 2) = (bf16)pk2z(zv[reg]);
#pragma unroll
        for (int e = 0; e < 4; ++e) {
            ld[mb][e] = fexp(-0.60653065971f * fsigmoid(db[e] + dw[e]));
            const float a = fsigmoid(ib[e] + da[e]); ai[mb][e] = a;
            const float kr = zk[e] * sk[e]; kk[mb][e] = kr; nrm += kr * kr;
            const float kx = zk[e] * (1.f + (a - 1.f) * sa[e]); k2[mb][e] = kx; bon += zr[mb][e] * kx * br[e]; }
        asm volatile("" ::: "memory");
    }
    nrm += __shfl_xor(nrm, 16); nrm += __shfl_xor(nrm, 32); bon += __shfl_xor(bon, 16); bon += __shfl_xor(bon, 32);
    if (fq == 0) P.BON[row * 8 + h] = bon;
    const float kinv = 1.0f / fmaxf(sqrtf(nrm), 1e-12f);
    f32x4 rt[4], kh[4];
    bf16x8 pa[2], pb[2], pk[2], pr[2];
#pragma unroll
    for (int ks = 0; ks < 2; ++ks) {
        f32x4 at2[2], bt2[2], kt2[2];
#pragma unroll
        for (int m2 = 0; m2 < 2; ++m2) { const int mb = 2 * ks + m2;
            f32x4 gcv, bhv;
#pragma unroll
            for (int e = 0; e < 4; ++e) {
                float gm = ld[mb][e]; gm *= dpp_shr1(gm, 1); gm *= dpp_shr1(gm, 2); gm *= dpp_shr1(gm, 4); gm *= dpp_shr1(gm, 8);
                const float gc = __shfl(gm, lane | 15), gp = dpp_shr1(gm, 1), gi = __builtin_amdgcn_rcpf(gm), ec = gc * gi;
                const float kn = kk[mb][e] * kinv, bb = kn * ai[mb][e];
                at2[m2][e] = -kn * gp; bt2[m2][e] = bb * gi; kt2[m2][e] = k2[mb][e] * gi; rt[mb][e] = zr[mb][e] * gm;
                bhv[e] = bb * ec; kh[mb][e] = k2[mb][e] * ec; gcv[e] = gc; }
            if (fr == 0) *(f32x4*)(P.GC + (size_t)unit * 64 + 16 * mb + 4 * fq) = gcv;
#pragma unroll
            for (int reg = 0; reg < 4; ++reg) { const int o = (16 * mb + 4 * fq + reg) * 32 + fr * 2;
                *(LAS bf16*)(wl + 0 * B1_IMG + o) = (bf16)pk2z(at2[m2][reg]); *(LAS bf16*)(wl + 1 * B1_IMG + o) = (bf16)pk2z(bhv[reg]); }
        }
        pa[ks] = pk8v(at2[0], at2[1]); pb[ks] = pk8v(bt2[0], bt2[1]); pk[ks] = pk8v(kt2[0], kt2[1]); pr[ks] = pk8v(rt[2 * ks], rt[2 * ks + 1]);
    }
    const f32x4 z4b = {0.f, 0.f, 0.f, 0.f};
    f32x4 Aab = mfma16(pb[1], pa[1], mfma16(pb[0], pa[0], z4b));
    f32x4 AakT = mfma16(pa[1], pk[1], mfma16(pa[0], pk[0], z4b));
    f32x4 Arb = mfma16(pb[1], pr[1], mfma16(pb[0], pr[0], z4b));
    f32x4 Ark = mfma16(pk[1], pr[1], mfma16(pk[0], pr[0], z4b));
#pragma unroll
    for (int e = 0; e < 4; ++e) { const int rr = 4 * fq + e; Aab[e] = rr < fr ? Aab[e] : 0.f; AakT[e] = fr < rr ? AakT[e] : 0.f; Arb[e] = rr <= fr ? Arb[e] : 0.f; Ark[e] = rr <= fr ? Ark[e] : 0.f; }
    LAS float* As = (LAS float*)(wl + 5 * B1_IMG);
#pragma unroll
    for (int e = 0; e < 4; ++e) As[(4 * fq + e) * 16 + fr] = Aab[e];
    LDS_WAIT();
    float x[16];
#pragma unroll
    for (int s = 15; s >= 0; --s) { float acc = (s == fr) ? 1.f : 0.f;
        const f32x4 r0 = *(const LAS f32x4*)(As + s * 16), r1 = *(const LAS f32x4*)(As + s * 16 + 4), r2 = *(const LAS f32x4*)(As + s * 16 + 8), r3 = *(const LAS f32x4*)(As + s * 16 + 12);
        const float rowv[16] = {r0[0], r0[1], r0[2], r0[3], r1[0], r1[1], r1[2], r1[3], r2[0], r2[1], r2[2], r2[3], r3[0], r3[1], r3[2], r3[3]};
#pragma unroll
        for (int uu = s + 1; uu < 16; ++uu) acc += rowv[uu] * x[uu];
        x[s] = acc; if ((s & 1) == 0) asm volatile("" ::: "memory"); }
    f32x4 xs;
#pragma unroll
    for (int e = 0; e < 4; ++e) xs[e] = fq == 0 ? x[e] : fq == 1 ? x[4 + e] : fq == 2 ? x[8 + e] : x[12 + e];
    const bf16x8 Tsel = pk4z(xs);
    f32x4 W1[4];
#pragma unroll
    for (int mb = 0; mb < 4; ++mb) W1[mb] = mfma16(lds4z(wl + 0 * B1_IMG + (16 * mb + fr) * 32 + 8 * fq), Tsel, z4);
    const f32x4 GT = mfma16(Tsel, pk4z(AakT), z4);
    img_write(wl + 3 * B1_IMG, W1, fr, fq);
    f32x4 M1T[4];
    const bf16x8 GTp = pk4z(GT);
#pragma unroll
    for (int mb = 0; mb < 4; ++mb) M1T[mb] = mfma16(lds4z(wl + 1 * B1_IMG + (16 * mb + fr) * 32 + 8 * fq), GTp, kh[mb]);
    img_write(wl + 4 * B1_IMG, M1T, fr, fq);
    LDS_WAIT();
    const bf16x8 Arbp = pk4z(Arb);
    f32x4 RE[4];
#pragma unroll
    for (int mb = 0; mb < 4; ++mb) RE[mb] = mfma16(lds4z(wl + 3 * B1_IMG + (16 * mb + fr) * 32 + 8 * fq), Arbp, rt[mb]);
    const f32x4 M2 = mfma16(GTp, Arbp, Ark);
    {   bf16* w1s = P.W1S + ((size_t)unit * 16 + fr) * 64; bf16* re = P.REFF + ((size_t)unit * 16 + fr) * 64;
#pragma unroll
        for (int mb = 0; mb < 4; ++mb) { const int sg = (mb >> 1) * 32 + fq * 8 + (mb & 1) * 4;
            v2u w; w.x = pk2(W1[mb][0], W1[mb][1]); w.y = pk2(W1[mb][2], W1[mb][3]); *(v2u*)(w1s + sg) = w;
            w.x = pk2(RE[mb][0], RE[mb][1]); w.y = pk2(RE[mb][2], RE[mb][3]); *(v2u*)(re + sg) = w; }
        const v2u m2p = {pk2(M2[0], M2[1]), pk2(M2[2], M2[3])};
#pragma unroll
        for (int mb = 0; mb < 4; ++mb) {
            const v2u bq = *(const LAS v2u*)(wl + 1 * B1_IMG + (16 * mb + fr) * 32 + 8 * fq), mq = *(const LAS v2u*)(wl + 4 * B1_IMG + (16 * mb + fr) * 32 + 8 * fq);
            *(v4u*)(P.BM + (((size_t)unit * 64 + 16 * mb + fr) * 4 + fq) * 8) = (v4u){bq.x, bq.y, mq.x, mq.y};
            const v2u vq = *(const LAS v2u*)(wl + 2 * B1_IMG + (16 * mb + fr) * 32 + 8 * fq);
            P.REC[((size_t)unit * 4 + mb) * 64 + lane] = (v4u){vq.x, vq.y, m2p.x, m2p.y}; }
    }
    LDS_WAIT();
}
constexpr int NSEG = 16, SEGCH = NCH / NSEG;
struct ChainIn { bf16x8 w1[2], re[2], bm[4]; v4u rec; f32x4 gc[4]; };
template <int MODE> DI void chain_load(ChainIn& c, const RwkvP& P, int unit, int rb, int lane) {
    const int fr = lane & 15, fq = lane >> 4;
    const bf16* w1s = P.W1S + ((size_t)unit * 16 + fr) * 64 + fq * 8;
    c.w1[0] = ld8(w1s); c.w1[1] = ld8(w1s + 32);
    if (MODE == 2) { const bf16* re = P.REFF + ((size_t)unit * 16 + fr) * 64 + fq * 8; c.re[0] = ld8(re); c.re[1] = ld8(re + 32); }
#pragma unroll
    for (int mb = 0; mb < 4; ++mb) { c.bm[mb] = ld8(P.BM + (((size_t)unit * 64 + 16 * mb + fr) * 4 + fq) * 8); c.gc[mb] = *(const f32x4*)(P.GC + (size_t)unit * 64 + 16 * mb + 4 * fq); }
    if (MODE != 1) c.rec = P.REC[((size_t)unit * 4 + rb) * 64 + lane];
}
template <int MODE> DI void chain_step(f32x4 (&S)[4], const ChainIn& c, float* ypre  ) {
    const f32x4 z4 = {0.f, 0.f, 0.f, 0.f};
    const bf16x8 b0 = pk8v(S[0], S[1]), b1 = pk8v(S[2], S[3]);
    f32x4 ut = mfma16(c.w1[1], b1, mfma16(c.w1[0], b0, z4));
    if (MODE == 2) {
        v4u vlo; vlo.x = c.rec.x; vlo.y = c.rec.y; vlo.z = 0u; vlo.w = 0u;
        v4u m2a; m2a.x = c.rec.z; m2a.y = c.rec.w; m2a.z = 0u; m2a.w = 0u;
        f32x4 y = mfma16(__builtin_bit_cast(bf16x8, m2a), __builtin_bit_cast(bf16x8, vlo), z4);
        y = mfma16(c.re[0], b0, y); y = mfma16(c.re[1], b1, y);
#pragma unroll
        for (int e = 0; e < 4; ++e) ypre[(size_t)e * 512] = y[e];
    }
    v4u uv; uv.x = pk2(ut[0], ut[1]); uv.y = pk2(ut[2], ut[3]); uv.z = MODE == 1 ? 0u : c.rec.x; uv.w = MODE == 1 ? 0u : c.rec.y;
    const bf16x8 ub = __builtin_bit_cast(bf16x8, uv);
#pragma unroll
    for (int mb = 0; mb < 4; ++mb) S[mb] = mfma16(c.bm[mb], ub, S[mb] * c.gc[mb]);
}
template <int MODE> DI void chain_run(f32x4 (&S)[4], const RwkvP& P, int unit0, int nsteps  , int rb, float* yp, int lane) {
    ChainIn c0, c1, c2;
    chain_load<MODE>(c0, P, unit0, rb, lane); chain_load<MODE>(c1, P, unit0 + 1, rb, lane);
    int c = 0;
    for (; c + 3 <= nsteps; c += 3) {
        chain_load<MODE>(c2, P, unit0 + c + 2, rb, lane);
        chain_step<MODE>(S, c0, yp + (size_t)c * 16 * 512);
        if (c + 3 < nsteps) chain_load<MODE>(c0, P, unit0 + c + 3, rb, lane);
        chain_step<MODE>(S, c1, yp + (size_t)(c + 1) * 16 * 512);
        if (c + 4 < nsteps) chain_load<MODE>(c1, P, unit0 + c + 4, rb, lane);
        chain_step<MODE>(S, c2, yp + (size_t)(c + 2) * 16 * 512);
    }
    if (c < nsteps) { chain_step<MODE>(S, c0, yp + (size_t)c * 16 * 512); ++c; }
    if (c < nsteps) { chain_step<MODE>(S, c1, yp + (size_t)c * 16 * 512); ++c; }
}
template <int MODE> DI void chain_run2(f32x4 (&S)[4], const RwkvP& P, int unit0, int nsteps  , int rb, float* yp, int lane) {
    ChainIn ca, cb;
    chain_load<MODE>(ca, P, unit0, rb, lane);
    for (int c = 0; c < nsteps; c += 2) {
        chain_load<MODE>(cb, P, unit0 + c + 1, rb, lane);
        asm volatile("" ::: "memory");
        chain_step<MODE>(S, ca, yp + (size_t)c * 16 * 512);
        if (c + 2 < nsteps) chain_load<MODE>(ca, P, unit0 + c + 2, rb, lane);
        asm volatile("" ::: "memory");
        chain_step<MODE>(S, cb, yp + (size_t)(c + 1) * 16 * 512);
    }
}
DI void chain_pass1(const RwkvP& P, float* QSEG, float* PSEGT, int seq, int g, int part, int rb, int lane) {
    const int fr = lane & 15, fq = lane >> 4;
    f32x4 S[4];
#pragma unroll
    for (int mb = 0; mb < 4; ++mb)
#pragma unroll
        for (int e = 0; e < 4; ++e) S[mb][e] = (part == 1 && (16 * mb + 4 * fq + e) == (16 * rb + fr)) ? 1.f : 0.f;
    const int unit0 = seq * NCH + g * SEGCH;
    if (part == 0) chain_run2<0>(S, P, unit0, SEGCH, rb, nullptr, lane); else chain_run2<1>(S, P, unit0, SEGCH, rb, nullptr, lane);
    const size_t sb = ((size_t)seq * NSEG + g) * 4096;
    if (part == 0) {
#pragma unroll
        for (int mb = 0; mb < 4; ++mb) *(f32x4*)(QSEG + sb + (size_t)(16 * rb + fr) * 64 + 16 * mb + 4 * fq) = S[mb];
    } else {
#pragma unroll
        for (int mb = 0; mb < 4; ++mb)
#pragma unroll
            for (int e = 0; e < 4; ++e) PSEGT[sb + (size_t)(16 * mb + 4 * fq + e) * 64 + 16 * rb + fr] = S[mb][e];
    }
}
DI void split_hl(const f32x4 a, const f32x4 b, bf16x8& hi, bf16x8& lo) {
    f32x4 ah, bh;
#pragma unroll
    for (int e = 0; e < 4; ++e) { ah[e] = rbf(a[e]); bh[e] = rbf(b[e]); }
    hi = pk8v(ah, bh); lo = pk8v(a - ah, b - bh);
}
DI void chain_pass23(const RwkvP& P, const float* QSEG, const float* PSEGT, int seq, int g, int rb, float* wkv_out, int lane) {
    const int fr = lane & 15, fq = lane >> 4, b = seq >> 3, h = seq & 7;
    f32x4 S[4]; for (int mb = 0; mb < 4; ++mb) S[mb] = (f32x4){0.f, 0.f, 0.f, 0.f};
    f32x4 pc[4][2][2], pn[4][2][2];
#define P2_LOAD(PD_, GP_) do { const size_t sb_ = ((size_t)seq * NSEG + (GP_)) * 4096; _Pragma("unroll") for (int mb = 0; mb < 4; ++mb) { \
        _Pragma("unroll") for (int ks = 0; ks < 2; ++ks) { const float* pr_ = PSEGT + sb_ + (size_t)(16 * mb + fr) * 64 + 32 * ks + 4 * fq; PD_[mb][ks][0] = *(const f32x4*)pr_; PD_[mb][ks][1] = *(const f32x4*)(pr_ + 16); } } } while (0)
    if (g > 0) P2_LOAD(pc, 0);
    for (int gp = 0; gp < g; ++gp) {
        f32x4 qc[4];
        { const size_t sb_ = ((size_t)seq * NSEG + gp) * 4096;
#pragma unroll
          for (int mb = 0; mb < 4; ++mb) qc[mb] = *(const f32x4*)(QSEG + sb_ + (size_t)(16 * rb + fr) * 64 + 16 * mb + 4 * fq); }
        if (gp + 1 < g) P2_LOAD(pn, gp + 1);
        bf16x8 bh[2], bl[2]; split_hl(S[0], S[1], bh[0], bl[0]); split_hl(S[2], S[3], bh[1], bl[1]);
#pragma unroll
        for (int mb = 0; mb < 4; ++mb) { f32x4 acc = {0.f, 0.f, 0.f, 0.f};
#pragma unroll
            for (int ks = 0; ks < 2; ++ks) { bf16x8 ah, al; split_hl(pc[mb][ks][0], pc[mb][ks][1], ah, al);
                acc = mfma16(ah, bh[ks], acc); acc = mfma16(al, bh[ks], acc); acc = mfma16(ah, bl[ks], acc); }
            S[mb] = acc + qc[mb]; }
#pragma unroll
        for (int mb = 0; mb < 4; ++mb) {
#pragma unroll
            for (int ks = 0; ks < 2; ++ks) { pc[mb][ks][0] = pn[mb][ks][0]; pc[mb][ks][1] = pn[mb][ks][1]; } }
    }
#undef P2_LOAD
    float* yp = P.YPRE + ((size_t)b * TSEQ + (size_t)g * SEGCH * 16 + 4 * fq) * 512 + h * 64 + 16 * rb + fr;
    chain_run<2>(S, P, seq * NCH + g * SEGCH, SEGCH, rb, yp, lane);
    if (g == NSEG - 1) {
#pragma unroll
        for (int mb = 0; mb < 4; ++mb) *(f32x4*)(wkv_out + (size_t)(16 * rb + fr) * 64 + 16 * mb + 4 * fq) = S[mb];
    }
}
DI void rwkv_b3_unit(const RwkvP& P, int unit, int lane) {
    asm volatile("" : "+v"(lane));
    const int fr = lane & 15, fq = lane >> 4;
    const int seq = unit >> 9, c = unit & 511, b = seq >> 3, h = seq & 7;
    const size_t row = (size_t)b * TSEQ + 16 * c + fr;
    const bool hasprev = (c | fr) != 0;
    const bf16* crp = P.PR + row * PRP; const bf16* prp = hasprev ? crp - PRP : P.ZROW;
    const f32x4 z4 = {0.f, 0.f, 0.f, 0.f};
    bf16x8 sg[4];
#pragma unroll
    for (int ks = 0; ks < 4; ++ks) { float z[8]; lerp8(crp, prp, 1664 + 8 * fq + 32 * ks, P.mu + 1664 + 8 * fq + 32 * ks, z);
        sg[ks] = pk8(fsigmoid(z[0]), fsigmoid(z[1]), fsigmoid(z[2]), fsigmoid(z[3]), fsigmoid(z[4]), fsigmoid(z[5]), fsigmoid(z[6]), fsigmoid(z[7])); }
    f32x4 g[4], y[4]; float s = 0.f;
#pragma unroll
    for (int mb = 0; mb < 4; ++mb) { const int n = h * 64 + 16 * mb + fr; f32x4 a = z4;
#pragma unroll
        for (int ks = 0; ks < 4; ++ks) a = mfma16(ld8(P.gupT + (size_t)n * 128 + 8 * fq + 32 * ks), sg[ks], a);
        g[mb] = a;
        y[mb] = *(const f32x4*)(P.YPRE + row * 512 + h * 64 + 16 * mb + 4 * fq); s += (y[mb][0] + y[mb][1]) + (y[mb][2] + y[mb][3]); }
    s += __shfl_xor(s, 16); s += __shfl_xor(s, 32);
    const float mean = s * (1.f / 64.f); float q = 0.f;
#pragma unroll
    for (int mb = 0; mb < 4; ++mb) { y[mb] = y[mb] - mean; q += (y[mb][0] * y[mb][0] + y[mb][1] * y[mb][1]) + (y[mb][2] * y[mb][2] + y[mb][3] * y[mb][3]); }
    q += __shfl_xor(q, 16); q += __shfl_xor(q, 32);
    const float rstd = 1.0f / sqrtf(q * (1.f / 64.f) + GN_EPS);
    const float bon = P.BON[row * 8 + h];
#pragma unroll
    for (int mb = 0; mb < 4; ++mb) { const int ch = h * 64 + 16 * mb + 4 * fq;
        const f32x4 gg = *(const f32x4*)(P.gng + ch), gb = *(const f32x4*)(P.gnb + ch); const v2u vw = *(const v2u*)(P.VV + row * 512 + ch);
        const f32x4 v = {bflo(vw.x), bfhi(vw.x), bflo(vw.y), bfhi(vw.y)};
        const f32x4 o = (y[mb] * rstd * gg + gb + v * bon) * g[mb];
        v2u w; w.x = pk2(o[0], o[1]); w.y = pk2(o[2], o[3]); *(v2u*)(P.MIX + row * 1024 + 512 + ch) = w; }
}
DI f32x16 dec_gemm(const bf16* A, const bf16* Wt, int K, LAS float* red  , int wave, int lane) {
    const int r = lane & 31, h = lane >> 5, kw = K >> 3;
    const bf16* ap = A + (size_t)r * K + wave * kw + 8 * h; const bf16* bp = Wt + (size_t)r * K + wave * kw + 8 * h;
    f32x16 acc; for (int i = 0; i < 16; ++i) acc[i] = 0.f;
#pragma unroll 16
    for (int k = 0; k < kw; k += 16) acc = mfma32(ld8(ap + k), ld8(bp + k), acc);
    __syncthreads();
#pragma unroll
    for (int i = 0; i < 16; ++i) red[(wave * 16 + i) * 64 + lane] = acc[i];
    __syncthreads();
    if (wave == 0) {
#pragma unroll
        for (int i = 0; i < 16; ++i) { float s = 0.f;
#pragma unroll
            for (int w = 0; w < 8; ++w) s += red[(w * 16 + i) * 64 + lane];
            asm volatile("" : "+v"(s) :: "memory"); acc[i] = s; } }
    return acc;
}
DI void dec_row_stats(const float* st, LAS float* sc, int lane) {
    if (lane < 32) { float s = 0.f, q = 0.f; const f32x4* p = (const f32x4*)(st + (size_t)lane * 64);
#pragma unroll
        for (int i = 0; i < 16; ++i) { const f32x4 v = p[i]; s += v[0] + v[2]; q += v[1] + v[3]; if ((i & 3) == 3) asm volatile("" : "+v"(s), "+v"(q) :: "memory"); }
        const float mu = s * (1.f / 1024.f), var = fmaxf(q * (1.f / 1024.f) - mu * mu, 0.f); sc[2 * lane] = mu; sc[2 * lane + 1] = 1.0f / sqrtf(var + LN_EPS); }
    LDS_WAIT();
}
struct DecP {
    unsigned char* dec; int l;
    const float* xs;
    const float *c1in, *c2in, *c1up, *c2up, *g1, *b1, *g2p, *b2p;
    const bf16 *win, *winu, *wout, *wup, *wdn;
    float* out;
};
DI void dec_unit_in(const DecP& D, int u, LAS float* red, LAS float* sc, int wave, int lane) {
    const int r32 = lane & 31, hi = lane >> 5;
    if (u < 105) {
        const int n = 32 * u + r32; const bool fold = D.l > 0;
        const f32x16 acc = dec_gemm((const bf16*)(D.dec + DEC_XB2), D.win + (size_t)(32 * u) * DM, DM, red, wave, lane);
        if (wave != 0) return;
        if (fold) dec_row_stats((const float*)(D.dec + DEC_ST2), sc, lane);
        const float c1 = fold ? D.c1in[n] : 0.f, c2 = fold ? D.c2in[n] : 0.f; const int on = n < 1024 ? swap45(n) : n;
        float* PD = (float*)(D.dec + DEC_PD);
#pragma unroll
        for (int i = 0; i < 16; ++i) { const int row = crow(i, hi); float mu = 0.f, rs = 1.f; if (fold) { mu = sc[2 * row]; rs = sc[2 * row + 1]; } PD[(size_t)row * NIN + on] = (acc[i] - mu * c1) * rs + c2; }
    } else {
        const int v = u - 105, n = 32 * v + r32;
        const f32x16 acc = dec_gemm((const bf16*)(D.dec + DEC_SHB) + (size_t)D.l * MD * DM, D.winu + (size_t)(32 * v) * DM, DM, red, wave, lane);
        if (wave != 0) return;
        float* PS = (float*)(D.dec + DEC_PS);
#pragma unroll
        for (int i = 0; i < 16; ++i) PS[(size_t)crow(i, hi) * NRWU + n] = acc[i];
    }
    LDS_WAIT();
}
DI void dec_unit_res(const bf16* A, const bf16* Wt, int K, int u, bool raw, const float* src, const float* sstat, const float* g, const float* b, float* T, bf16* XB, float* ostat, float* shiftout, LAS float* red, LAS float* sc, int wave, int lane) {
    const int r32 = lane & 31, hi = lane >> 5, n = 32 * u + r32;
    const f32x16 acc = dec_gemm(A, Wt + (size_t)(32 * u) * K, K, red, wave, lane);
    if (wave != 0) return;
    if (!raw) dec_row_stats(sstat, sc, lane);
    const float gg = raw ? 1.f : g[n], bb = raw ? 0.f : b[n];
#pragma unroll
    for (int i = 0; i < 16; ++i) { const int row = crow(i, hi); float mu = 0.f, rs = 1.f; if (!raw) { mu = sc[2 * row]; rs = sc[2 * row + 1]; }
        const float x = (src[(size_t)row * DM + n] - mu) * rs * gg + bb; const float t = ALPHA * x + acc[i];
        T[(size_t)row * DM + n] = t; XB[(size_t)row * DM + n] = (bf16)f2bf(t); if (shiftout) shiftout[(size_t)row * DM + n] = x;
        float s = t, q = t * t;
#pragma unroll
        for (int o = 1; o < 32; o <<= 1) { s += __shfl_xor(s, o); q += __shfl_xor(q, o); }
        if (r32 == 0) { ostat[((size_t)row * 32 + u) * 2] = s; ostat[((size_t)row * 32 + u) * 2 + 1] = q; } }
    LDS_WAIT();
}
DI void dec_unit_up(const DecP& D, int u, LAS float* red, LAS float* sc, int wave, int lane) {
    const int r32 = lane & 31, hi = lane >> 5, n = 32 * u + r32;
    const f32x16 acc = dec_gemm((const bf16*)(D.dec + DEC_XB1), D.wup + (size_t)(32 * u) * DM, DM, red, wave, lane);
    if (wave != 0) return;
    dec_row_stats((const float*)(D.dec + DEC_ST1), sc, lane);
    const float c1 = D.c1up[n], c2 = D.c2up[n]; bf16* HB = (bf16*)(D.dec + DEC_HB);
#pragma unroll
    for (int i = 0; i < 16; ++i) { const int row = crow(i, hi); const float v = fmaxf((acc[i] - sc[2 * row] * c1) * sc[2 * row + 1] + c2, 0.f); HB[(size_t)row * FFD + n] = (bf16)f2bf(v * v); }
    LDS_WAIT();
}
DI void dec_attn_task(const DecP& D, const float* ck, const float* cv, const float* rope, int bd, int h, int p, int lane) {
    const int g = lane >> 4, dq = lane & 15, dd = 1 << (2 * p);
    const float* PD = (const float*)(D.dec + DEC_PD) + (size_t)bd * NIN;
    const f32x4 rr0 = *(const f32x4*)(rope + ((size_t)8192 * 32 + ((4 * dq) & 31)) * 2), rr1 = *(const f32x4*)(rope + ((size_t)8192 * 32 + ((4 * dq) & 31)) * 2 + 4);
    const f32x4 cs = {rr0[0], rr0[2], rr1[0], rr1[2]}, sn = {rr0[1], rr0[3], rr1[1], rr1[3]};
    const float sgn = dq < 8 ? -1.f : 1.f;
    f32x4 q = *(const f32x4*)(PD + h * 64 + 4 * dq), kn = *(const f32x4*)(PD + 512 + h * 64 + 4 * dq); const f32x4 vn = *(const f32x4*)(PD + 1024 + h * 64 + 4 * dq);
    { f32x4 qp, kp;
#pragma unroll
      for (int e = 0; e < 4; ++e) { qp[e] = __shfl_xor(q[e], 8); kp[e] = __shfl_xor(kn[e], 8); }
      q = q * cs + qp * sn * sgn; kn = kn * cs + kp * sn * sgn; }
    if (p == 0 && g == 0) { *(f32x4*)(D.out + O_KS + ((size_t)D.l * MD + bd) * 512 + h * 64 + 4 * dq) = kn; *(f32x4*)(D.out + O_VS + ((size_t)D.l * MD + bd) * 512 + h * 64 + 4 * dq) = vn; }
    float s0 = (q[0] * kn[0] + q[1] * kn[1]) + (q[2] * kn[2] + q[3] * kn[3]);
#pragma unroll
    for (int o = 1; o < 16; o <<= 1) s0 += __shfl_xor(s0, o);
    s0 *= 0.125f;
    const size_t cbase = (((size_t)D.l * MD + bd) * 2048) * 512 + h * 64 + 4 * dq;
    float mx = -INFINITY, den = 0.f; f32x4 o4 = {0.f, 0.f, 0.f, 0.f};
#pragma unroll 8
    for (int it = 0; it < 32; ++it) { const int j = 1 + 4 * it + g; const size_t off = cbase + (size_t)(2048 - j * dd) * 512;
        const f32x4 kr = *(const f32x4*)(ck + off); const f32x4 vr = *(const f32x4*)(cv + off);
        float s = (q[0] * kr[0] + q[1] * kr[1]) + (q[2] * kr[2] + q[3] * kr[3]);
#pragma unroll
        for (int o = 1; o < 16; o <<= 1) s += __shfl_xor(s, o);
        s *= 0.125f;
        const float mn = fmaxf(mx, s), sc = fexp(mx - mn), pj = fexp(s - mn);
        den = den * sc + pj; o4 = o4 * sc + vr * pj; mx = mn; }
    float mg = fmaxf(mx, __shfl_xor(mx, 16)); mg = fmaxf(mg, __shfl_xor(mg, 32)); mg = fmaxf(mg, s0);
    { const float sc = fexp(mx - mg); den *= sc; o4 = o4 * sc; }
    den += __shfl_xor(den, 16); den += __shfl_xor(den, 32);
#pragma unroll
    for (int e = 0; e < 4; ++e) { o4[e] += __shfl_xor(o4[e], 16); o4[e] += __shfl_xor(o4[e], 32); }
    const float p0 = fexp(s0 - mg); den += p0; o4 = (o4 + vn * p0) * (1.0f / den); mx = mg;
    if (g == 0) *(f32x4*)((float*)(D.dec + DEC_OP) + ((size_t)p * MD + bd) * 512 + h * 64 + 4 * dq) = o4;
    if (lane == 0) ((float*)(D.dec + DEC_LSE))[((size_t)p * MD + bd) * 8 + h] = mx + __logf(den);
}
DI void dec_rwkv_task(const DecP& D, const float* const* in, int bd, int h, LAS float* sv  , int lane) {
    const int l = D.l, ch = h * 64 + lane;
    const float* PD = (const float*)(D.dec + DEC_PD) + (size_t)bd * NIN + RW0; const float* PS = (const float*)(D.dec + DEC_PS) + (size_t)bd * NRWU;
    const float* mu = in[8] + (size_t)l * 1792;
    auto zf = [&](int col) { const float pr = PD[col], pv = PS[col]; return pr + (pv - pr) * mu[col]; };
    const float zr = zf(ch), zk = zf(512 + ch), zv0 = zf(1024 + ch);
    float vl = 0.f; if (l > 0 && lane < 32) { const float pr = PD[1792 + lane], pv = PS[1792 + lane]; vl = pr + (pv - pr) * in[9][(size_t)(l - 1) * 32 + lane]; }
    sv[lane] = ftanh(zf(1536 + lane)); sv[64 + lane] = zf(1600 + lane); sv[128 + lane] = fsigmoid(zf(1664 + lane)); sv[192 + lane] = fsigmoid(zf(1728 + lane)); sv[256 + lane] = vl;
    LDS_WAIT();
    float dw = 0.f, da = 0.f, dv = 0.f, gt = 0.f;
    const float* du = in[11] + (size_t)l * 64 * 512 + ch; const float* iu = in[13] + (size_t)l * 64 * 512 + ch; const float* gu = in[14] + (size_t)l * 128 * 512 + ch;
#pragma unroll 2
    for (int m4 = 0; m4 < 16; ++m4) { const f32x4 a = *(const LAS f32x4*)(sv + 4 * m4), b = *(const LAS f32x4*)(sv + 64 + 4 * m4), c = *(const LAS f32x4*)(sv + 128 + 4 * m4), d = *(const LAS f32x4*)(sv + 192 + 4 * m4);
#pragma unroll
        for (int e = 0; e < 4; ++e) { const int m = 4 * m4 + e; dw += a[e] * du[(size_t)m * 512]; da += b[e] * iu[(size_t)m * 512]; gt += c[e] * gu[(size_t)m * 512] + d[e] * gu[(size_t)(64 + m) * 512]; } }
    if (l > 0) { const float* vu = in[16] + (size_t)(l - 1) * 32 * 512 + ch;
#pragma unroll
        for (int m4 = 0; m4 < 8; ++m4) { const f32x4 a = *(const LAS f32x4*)(sv + 256 + 4 * m4);
#pragma unroll
            for (int e = 0; e < 4; ++e) dv += a[e] * vu[(size_t)(4 * m4 + e) * 512]; } }
    const float w = -fsoftplus(-(in[10][(size_t)l * 512 + ch] + dw)) - 0.5f, decay = fexp(-fexp(w));
    const float a = fsigmoid(in[12][(size_t)l * 512 + ch] + da);
    float* VFD = (float*)(D.dec + DEC_VF) + (size_t)bd * 512 + ch;
    float v = zv0; if (l == 0) *VFD = zv0; else v = zv0 + (*VFD - zv0) * fsigmoid(in[15][(size_t)(l - 1) * 512 + ch] + dv);
    const float kr = zk * in[17][(size_t)l * 512 + ch]; const float kn = kr / fmaxf(sqrtf(wave_sum(kr * kr)), 1e-12f);
    const float k2 = zk * (1.f + (a - 1.f) * in[18][(size_t)l * 512 + ch]);
    const float bon = wave_sum(zr * k2 * in[19][(size_t)l * 512 + ch]);
    LDS_WAIT();
    sv[320 + lane] = -kn; sv[384 + lane] = decay; sv[448 + lane] = kn * a; sv[512 + lane] = k2; sv[576 + lane] = zr;
    LDS_WAIT();
    const float* S0 = in[3] + ((((size_t)l * MD + bd) * NH + h) * 64 + lane) * 64;
    float* So = D.out + O_WKS + ((((size_t)l * MD + bd) * NH + h) * 64 + lane) * 64;
    float sa = 0.f;
    { f32x4 Sr[16];
#pragma unroll
      for (int q = 0; q < 16; ++q) Sr[q] = *(const f32x4*)(S0 + 4 * q);
#pragma unroll
      for (int q = 0; q < 16; ++q) { const f32x4 a4 = *(const LAS f32x4*)(sv + 320 + 4 * q); sa += (Sr[q][0] * a4[0] + Sr[q][1] * a4[1]) + (Sr[q][2] * a4[2] + Sr[q][3] * a4[3]); } }
    asm volatile("" ::: "memory");
    float y = 0.f;
#pragma unroll 8
    for (int q = 0; q < 16; ++q) { const f32x4 s0 = *(const f32x4*)(S0 + 4 * q); const f32x4 w4 = *(const LAS f32x4*)(sv + 384 + 4 * q), b4 = *(const LAS f32x4*)(sv + 448 + 4 * q), k4 = *(const LAS f32x4*)(sv + 512 + 4 * q), r4 = *(const LAS f32x4*)(sv + 576 + 4 * q);
        const f32x4 s4 = s0 * w4 + b4 * sa + k4 * v; *(f32x4*)(So + 4 * q) = s4; y += (s4[0] * r4[0] + s4[1] * r4[1]) + (s4[2] * r4[2] + s4[3] * r4[3]); }
    const float mean = wave_sum(y) * (1.f / 64.f), dy = y - mean, var = wave_sum(dy * dy) * (1.f / 64.f);
    const float o = (dy * (1.0f / sqrtf(var + GN_EPS)) * in[20][(size_t)l * 512 + ch] + in[21][(size_t)l * 512 + ch] + bon * v) * gt;
    ((float*)(D.dec + DEC_MIX))[(size_t)bd * DM + 512 + ch] = o;
    LDS_WAIT();
}
DI void dec_finalize_row(const DecP& D, const float* gain, int bd, int lane) {
    const int h = lane >> 3; const float* L = (const float*)(D.dec + DEC_LSE); const float* OPD = (const float*)(D.dec + DEC_OP);
    const float l0 = L[((size_t)0 * MD + bd) * 8 + h], l1 = L[((size_t)1 * MD + bd) * 8 + h], l2 = L[((size_t)2 * MD + bd) * 8 + h];
    const float mx = fmaxf(l0, fmaxf(l1, l2)); float w0 = fexp(l0 - mx), w1 = fexp(l1 - mx), w2 = fexp(l2 - mx); const float inv = 1.0f / (w0 + w1 + w2); w0 *= inv; w1 *= inv; w2 *= inv;
    float v[8]; float ss = 0.f;
#pragma unroll
    for (int e = 0; e < 8; ++e) { v[e] = w0 * OPD[((size_t)0 * MD + bd) * 512 + lane * 8 + e] + w1 * OPD[((size_t)1 * MD + bd) * 512 + lane * 8 + e] + w2 * OPD[((size_t)2 * MD + bd) * 512 + lane * 8 + e]; ss += v[e] * v[e]; }
    ss = wave_sum(ss); const float rinv = 1.0f / sqrtf(ss * (1.f / 512.f) + RMS_EPS);
    bf16* MB = (bf16*)(D.dec + DEC_MIXB) + (size_t)bd * DM; const float* MX = (const float*)(D.dec + DEC_MIX) + (size_t)bd * DM + 512;
#pragma unroll
    for (int e = 0; e < 8; ++e) { MB[lane * 8 + e] = (bf16)f2bf(v[e] * rinv * gain[lane * 8 + e]); MB[512 + lane * 8 + e] = (bf16)f2bf(MX[lane * 8 + e]); }
}
#ifndef PH_MASK
#define PH_MASK 0x1ff
#endif
#define PH_ON(k) ((PH_MASK >> (k)) & 1)
#ifndef PH_DUP
#define PH_DUP 0
#endif
#define PH_REP(k) for (int rep_ = 0; rep_ < (((PH_DUP >> (k)) & 1) ? 2 : 1); ++rep_)
DI unsigned lds_task_next(volatile LAS unsigned* ctr, int lane) {
    unsigned t = 0; if (lane == 0) t = __hip_atomic_fetch_add((LAS unsigned*)ctr, 1u, __ATOMIC_RELAXED, __HIP_MEMORY_SCOPE_WORKGROUP);
    return (unsigned)__builtin_amdgcn_readfirstlane((int)t);
}
DI DecP make_dec(unsigned char* ws, const float* const* in, float* out, int l) {
    DecP D; D.dec = ws + WS_DEC; D.l = l; D.xs = in[1];
    D.c1in = (const float*)(ws + WS_C1IN) + l * NIN; D.c2in = (const float*)(ws + WS_C2IN) + l * NIN; D.c1up = (const float*)(ws + WS_C1UP) + l * FFD; D.c2up = (const float*)(ws + WS_C2UP) + l * FFD;
    D.g1 = in[24] + (size_t)l * DM; D.b1 = in[25] + (size_t)l * DM; D.g2p = l > 0 ? in[28] + (size_t)(l - 1) * DM : nullptr; D.b2p = l > 0 ? in[29] + (size_t)(l - 1) * DM : nullptr;
    D.win = (const bf16*)(ws + WS_WIN) + (size_t)l * NIN * DM; D.winu = (const bf16*)(ws + WS_WINU) + (size_t)l * NRWU * DM; D.wout = (const bf16*)(ws + WS_WOUT) + (size_t)l * DM * DM;
    D.wup = (const bf16*)(ws + WS_WUP) + (size_t)l * FFD * DM; D.wdn = (const bf16*)(ws + WS_WDN) + (size_t)l * DM * FFD; D.out = out; return D;
}
DI RwkvP make_rwkv(unsigned char* ws, const float* const* in, int l) {
    RwkvP R; R.PR = (const bf16*)(ws + WS_PR); R.mu = in[8] + (size_t)l * 1792; R.muv = l > 0 ? in[9] + (size_t)(l - 1) * 32 : nullptr;
    R.dbase = in[10] + (size_t)l * 512; R.ibase = in[12] + (size_t)l * 512; R.vbase = l > 0 ? in[15] + (size_t)(l - 1) * 512 : nullptr; R.ksk = in[17] + (size_t)l * 512; R.ksa = in[18] + (size_t)l * 512; R.brk = in[19] + (size_t)l * 512;
    R.gng = in[20] + (size_t)l * 512; R.gnb = in[21] + (size_t)l * 512;
    R.dupT = (const bf16*)(ws + WS_DUPT) + (size_t)l * 512 * 64; R.iupT = (const bf16*)(ws + WS_IUPT) + (size_t)l * 512 * 64; R.vupT = l > 0 ? (const bf16*)(ws + WS_VUPT) + (size_t)(l - 1) * 512 * 32 : nullptr; R.gupT = (const bf16*)(ws + WS_GUPT) + (size_t)l * 512 * 128;
    R.ZROW = (const bf16*)(ws + WS_CTL + 512 * 1024); R.VF = (bf16*)(ws + WS_VF); R.VV = (bf16*)(ws + WS_VV); R.BON = (float*)(ws + WS_BON); R.GC = (float*)(ws + WS_GC); R.W1S = (bf16*)(ws + WS_PT); R.REFF = (bf16*)(ws + WS_REFF); R.BM = (bf16*)(ws + WS_QT); R.REC = (v4u*)(ws + WS_YLOC);
    R.YPRE = (float*)(ws + WS_YPRE); R.MIX = (bf16*)(ws + WS_MIX); R.layer0 = (l == 0); return R;
}
#define PHASE_VARS() int tid_p = (int)threadIdx.x; asm volatile("" : "+v"(tid_p)); const int lane = tid_p & 63; const int wave = __builtin_amdgcn_readfirstlane(tid_p >> 6); \
    unsigned zo_p; asm volatile("s_mov_b32 %0, 0" : "=s"(zo_p)); unsigned char* ws = args.ws + zo_p; const float* const* in = args.in + zo_p; float* out = args.out + zo_p; \
    const int gw = F.vcu * NWAVES + wave; const int rgw = (F.G - 1 - (int)blockIdx.x) * NWAVES + wave; LAS float* dsc = (LAS float*)(L3 + 65536); LAS float* dred = (LAS float*)L3; const int rwg = F.G - 1 - (int)blockIdx.x; (void)gw; (void)rgw; (void)dsc; (void)dred; (void)rwg; (void)lane; (void)in; (void)out
__global__ void __launch_bounds__(NWAVES * 64, 2) mega_fwd(Args args) {
    extern __shared__ __attribute__((aligned(16))) unsigned char lds[];
    Frame F;
    F.lds = lds; F.MISC = (volatile LAS unsigned*)((LAS unsigned char*)lds + MISC_OFF);
    F.tid = threadIdx.x; F.lane = F.tid & 63; F.wave = __builtin_amdgcn_readfirstlane(F.tid >> 6);
    F.G = gridDim.x; { const int bx = blockIdx.x; F.vcu = (F.G % 8 == 0) ? (bx % 8) * (F.G / 8) + bx / 8 : bx; }
    F.gw = F.vcu * NWAVES + F.wave; F.NGW = F.G * NWAVES;
    F.in = args.in; F.out = args.out; F.ws = args.ws; F.ctl = (gu32*)(args.ws + WS_CTL);
    LAS unsigned char* L3 = (LAS unsigned char*)lds;
    for (int u = F.tid; u < (LDS_BYTES - RING_BYTES) / 4; u += NWAVES * 64) ((LAS unsigned*)(L3 + RING_BYTES))[u] = 0u;
    __syncthreads();
    XcdBarrier bar = xcd_barrier_post((unsigned*)(F.ctl + CW_BAR), F.MISC + 8);
#define GRID_BAR() do { XcdBarrier b2_ = bar; asm volatile("" : "+s"(b2_.x)); xcd_barrier(b2_); } while (0)

    PH_REP(0) { if (PH_ON(0)) p0_prologue(F);
    GRID_BAR(); }

    for (int l = 0; l < DEPTH; ++l) {
        PH_REP(1) {
        if (PH_ON(1))
        {   PHASE_VARS(); const DecP D = make_dec(ws, in, out, l);
            pg8::Gemm g{(const pg8::bf16_t*)(ws + WS_XB2), (const pg8::bf16_t*)D.win, M, NIN, DM}; pg8::StaticOrder S; S.init(M, NIN, F.G, (int)blockIdx.x);
            pg8::EpiIn E{ws, out, l};
            pg8::gemm_phase<pg8::EpiIn, pg8::StaticOrder, true, true>((PG8_LAS unsigned char*)L3, g, S, E, tid_p);
            for (int u = rwg; u < 162; u += F.G) dec_unit_in(D, u, dred, dsc, wave, lane);
        }
        GRID_BAR();
        }

        PH_REP(2) {
        if (PH_ON(2))
        {   PHASE_VARS(); const RwkvP R = make_rwkv(ws, in, l); LAS unsigned char* wl = L3 + wave * 12288;
            if (l == 0) colsum_finish(ws, gw * 64 + lane, F.NGW * 64);
            for (int u = gw; u < NUNIT; u += F.NGW) rwkv_b1_unit(R, u, wl, lane);
        }
        GRID_BAR();
        }

#define ATT_QUEUE() do { LAS unsigned char* wl_ = L3 + wave * 10240; const int bh_ = F.vcu >> 4, span_ = F.vcu & 15; \
        for (;;) { const unsigned t_ = lds_task_next(F.MISC, lane); if (t_ >= 48u) break; \
            if (t_ >= 48u) { const int dt_ = (int)blockIdx.x * 4 + (int)(t_ - 48u); \
                if (dt_ < 768) dec_attn_task(D, in[4], in[5], (const float*)(ws + WS_ROPE), dt_ / 24, (dt_ % 24) / 3, dt_ % 3, lane); \
                else dec_rwkv_task(D, in, (dt_ - 768) >> 3, (dt_ - 768) & 7, (LAS float*)wl_, lane); continue; } \
            const int p_ = (int)t_ >> 4, idx_ = (int)t_ & 15; \
            const int cls_ = p_ == 0 ? 0 : p_ == 1 ? (idx_ >> 2) : idx_, qblk_ = p_ == 0 ? span_ * 16 + idx_ : p_ == 1 ? span_ * 4 + (idx_ & 3) : span_; \
            attn_task((const bf16*)(ws + WS_QB), (const bf16*)(ws + WS_KB), (const bf16*)(ws + WS_VB), (bf16*)(ws + WS_OP), (float*)(ws + WS_LSE), bh_ >> 3, bh_ & 7, p_, cls_, qblk_, wl_, lane); } } while (0)
        PH_REP(3) {
        if (PH_ON(3))
        {   PHASE_VARS(); const DecP D = make_dec(ws, in, out, l); const RwkvP R = make_rwkv(ws, in, l);
            if (tid_p == 0) F.MISC[0] = 0u;
            __syncthreads();
            if (wave >= 4) { const int dt = (int)blockIdx.x * 4 + (wave - 4);
                if (dt < 768) dec_attn_task(D, in[4], in[5], (const float*)(ws + WS_ROPE), dt / 24, (dt % 24) / 3, dt % 3, lane);
                else dec_rwkv_task(D, in, (dt - 768) >> 3, (dt - 768) & 7, (LAS float*)(L3 + wave * 10240), lane); }
            PH_REP(13) chain_pass1(R, (float*)(ws + WS_SEGQ), (float*)(ws + WS_SEGP), F.vcu >> 4, F.vcu & 15, wave >> 2, wave & 3, lane);
            ATT_QUEUE();
            if ((PH_DUP >> 12) & 1) { __syncthreads(); if (tid_p == 0) F.MISC[0] = 0u; __syncthreads(); ATT_QUEUE(); }
        }
        GRID_BAR();
        }
        PH_REP(9) {
        if (PH_ON(3))
        {   PHASE_VARS(); const DecP D = make_dec(ws, in, out, l); const RwkvP R = make_rwkv(ws, in, l);
            const int seq = F.vcu >> 4, sg = F.vcu & 15;
            if (wave < 4) chain_pass23(R, (const float*)(ws + WS_SEGQ), (const float*)(ws + WS_SEGP), seq, sg, wave, out + O_WKP + ((size_t)l * 16 + seq) * 4096, lane);
            else { for (int i = 0; i < 16; ++i) attn_finalize_row((const bf16*)(ws + WS_OP), (const float*)(ws + WS_LSE), in[22] + (size_t)l * 512, (bf16*)(ws + WS_MIX), (int)blockIdx.x * 64 + (wave - 4) * 16 + i, lane);
                if (blockIdx.x < MD && wave == 4) dec_finalize_row(D, in[22] + (size_t)l * 512, (int)blockIdx.x, lane); }
            VM_WAIT(); __syncthreads();
#pragma unroll 1
            for (int i = 0; i < 4; ++i) rwkv_b3_unit(R, seq * NCH + sg * SEGCH + wave + 8 * i, lane);
        }
        GRID_BAR();
        }

        PH_REP(5) {
        if (PH_ON(5))
        {   PHASE_VARS(); const DecP D = make_dec(ws, in, out, l);
            pg8::Gemm g{(const pg8::bf16_t*)(ws + WS_MIX), (const pg8::bf16_t*)D.wout, M, DM, DM}; pg8::StaticOrder S; S.init(M, DM, F.G, (int)blockIdx.x);
            pg8::EpiRes<false> E{ws, in, out, l};
            pg8::gemm_phase<pg8::EpiRes<false>, pg8::StaticOrder, false, true>((PG8_LAS unsigned char*)L3, g, S, E, tid_p);
            for (int u = rwg; u < 32; u += F.G)
                dec_unit_res((const bf16*)(D.dec + DEC_MIXB), D.wout, DM, u, l == 0, l == 0 ? D.xs : (const float*)(D.dec + DEC_T2), (const float*)(D.dec + DEC_ST2), D.g2p, D.b2p, (float*)(D.dec + DEC_T1), (bf16*)(D.dec + DEC_XB1), (float*)(D.dec + DEC_ST1),
                             out + O_SHS + (size_t)l * MD * DM, dred, dsc, wave, lane);
        }
        GRID_BAR();
        }

        PH_REP(6) {
        if (PH_ON(6))
        {   PHASE_VARS(); const DecP D = make_dec(ws, in, out, l);
            pg8::Gemm g{(const pg8::bf16_t*)(ws + WS_XB1), (const pg8::bf16_t*)D.wup, M, FFD, DM}; pg8::StaticOrder S; S.init(M, FFD, F.G, (int)blockIdx.x);
            pg8::EpiUp E{ws, l};
            pg8::gemm_phase<pg8::EpiUp, pg8::StaticOrder, true, true>((PG8_LAS unsigned char*)L3, g, S, E, tid_p);
            for (int u = rwg; u < 128; u += F.G) dec_unit_up(D, u, dred, dsc, wave, lane);
        }
        GRID_BAR();
        }

        PH_REP(7) {
        if (PH_ON(7))
        {   PHASE_VARS(); const DecP D = make_dec(ws, in, out, l);
            pg8::Gemm g{(const pg8::bf16_t*)(ws + WS_H), (const pg8::bf16_t*)D.wdn, M, DM, FFD}; pg8::StaticOrder S; S.init(M, DM, F.G, (int)blockIdx.x);
            pg8::EpiRes<true> E{ws, in, out, l};
            PH_REP(11) { pg8::gemm_phase<pg8::EpiRes<true>, pg8::StaticOrder, false, true>((PG8_LAS unsigned char*)L3, g, S, E, tid_p); }
            PH_REP(10) for (int u = rwg; u < 32; u += F.G)
                dec_unit_res((const bf16*)(D.dec + DEC_HB), D.wdn, FFD, u, false, (const float*)(D.dec + DEC_T1), (const float*)(D.dec + DEC_ST1), D.g1, D.b1, (float*)(D.dec + DEC_T2), (bf16*)(D.dec + DEC_XB2), (float*)(D.dec + DEC_ST2), nullptr, dred, dsc, wave, lane);
        }
        GRID_BAR();
        }
    }
    if (PH_ON(8))
    {   PHASE_VARS(); const float* g = in[28] + (size_t)3 * DM; const float* b = in[29] + (size_t)3 * DM;
        for (int r = gw; r < M; r += F.NGW) { float mu, rs; pg8::row_stats((const float*)(ws + WS_STAT2), r, mu, rs);
            const f32x4* t = (const f32x4*)((const float*)(ws + WS_T2) + (size_t)r * DM) + lane; f32x4* o = (f32x4*)(out + O_Y + (size_t)r * DM) + lane;
#pragma unroll
            for (int j = 0; j < 4; ++j) { const f32x4 gg = *((const f32x4*)g + lane + 64 * j), bb = *((const f32x4*)b + lane + 64 * j); o[64 * j] = (t[64 * j] - mu) * rs * gg + bb; } }
        if (rgw < MD) { LAS float* fsc = dsc + wave * 64; dec_row_stats((const float*)(ws + WS_DEC + DEC_ST2), fsc, lane); const float mu = fsc[2 * rgw], rs = fsc[2 * rgw + 1];
            const f32x4* t = (const f32x4*)((const float*)(ws + WS_DEC + DEC_T2) + (size_t)rgw * DM) + lane; f32x4* o = (f32x4*)(out + O_YS + (size_t)rgw * DM) + lane;
#pragma unroll
            for (int j = 0; j < 4; ++j) { const f32x4 gg = *((const f32x4*)g + lane + 64 * j), bb = *((const f32x4*)b + lane + 64 * j); o[64 * j] = (t[64 * j] - mu) * rs * gg + bb; } }
    }
}

extern "C" void kernel_launch(void* const* d_in, const int* in_sizes, int n_in, void* d_out, int out_size, void* d_ws, size_t ws_size, hipStream_t stream) {
    static int grid = 0;
    if (grid == 0) {
        if (n_in != 30 || out_size != (int)O_END || ws_size < WS_END) { fprintf(stderr, "kernel_launch: unexpected problem (n_in %d, out %d, ws %zu); nothing launched\n", n_in, out_size, ws_size); grid = -1; return; }
        int dev = 0, cus = 0, per_cu = 0;
        if (hipGetDevice(&dev) != hipSuccess || hipDeviceGetAttribute(&cus, hipDeviceAttributeMultiprocessorCount, dev) != hipSuccess) { fprintf(stderr, "kernel_launch: device query failed\n"); grid = -1; return; }
        if (hipFuncSetAttribute((const void*)mega_fwd, hipFuncAttributeMaxDynamicSharedMemorySize, LDS_BYTES) != hipSuccess) { fprintf(stderr, "kernel_launch: hipFuncSetAttribute failed\n"); grid = -1; return; }
        if (hipOccupancyMaxActiveBlocksPerMultiprocessor(&per_cu, (const void*)mega_fwd, NWAVES * 64, LDS_BYTES) != hipSuccess || per_cu < 1) fprintf(stderr, "kernel_launch: occupancy query reports %d\n", per_cu);
        (void)hipGetLastError();
        if (cus < 256) { fprintf(stderr, "kernel_launch: needs 256 CUs (found %d)\n", cus); grid = -1; return; }
        grid = 256;
    }
    if (grid < 0) return;
    if (hipMemsetAsync((char*)d_ws + WS_CTL, 0, CTL_ZERO_BYTES, stream) != hipSuccess) { fprintf(stderr, "kernel_launch: memset failed\n"); return; }
    Args a{};
    for (int i = 0; i < 30; ++i) a.in[i] = (const float*)d_in[i];
    a.out = (float*)d_out; a.ws = (unsigned char*)d_ws;
    hipLaunchKernelGGL(mega_fwd, dim3(grid), dim3(NWAVES * 64), LDS_BYTES, stream, a);
    const hipError_t le = hipPeekAtLastError();
    if (le != hipSuccess) fprintf(stderr, "kernel_launch: launch failed: %s\n", hipGetErrorName(le));
}
```

```cpp
#include <hip/hip_runtime.h>
#include <cstdio>
#include <cstdint>
#include <cmath>
namespace pg8 {
#define PG8_LAS __attribute__((address_space(3)))
typedef unsigned short bf16_t;
typedef short bf16x8 __attribute__((ext_vector_type(8)));
typedef float f32x4 __attribute__((ext_vector_type(4)));
typedef unsigned u32x4 __attribute__((ext_vector_type(4)));
constexpr int BM = 256, BK = 64, HALF = 128, HTB = HALF * BK * 2  , STAGE_BYTES = 8 * HTB, NXCD = 8, WGM = 8;

__host__ __device__ __forceinline__ int lds_byte(int r, int c) { const int st = (r >> 4) * 2 + (c >> 5), rr = r & 15, cc = c & 31, ob = rr * 64 + cc * 2; return st * 1024 + (ob ^ (((ob >> 9) & 1) << 5)); }
__host__ __device__ __forceinline__ void stage_rc(int b, int& R, int& C) { const int st = b / 1024, sb = b % 1024, swz = sb ^ (((sb >> 9) & 1) << 5); R = (st >> 1) * 16 + swz / 64; C = (st & 1) * 32 + (swz % 64) / 2; }
__host__ __device__ __forceinline__ int perm32(int rho) { const int n = rho >> 4, i = rho & 15; return 8 * (i >> 2) + 4 * n + (i & 3); }

struct Unit { int pm, pn; };
struct Gemm { const bf16_t* A; const bf16_t* Bt; int M, N, K; };

struct StaticOrder {
    int nM, nN, nwg, G, c;
    __host__ __device__ void init(int M, int N, int G_, int c_) { nM = M / BM; nN = N / BM; nwg = nM * nN; G = G_; c = c_; }
    __host__ __device__ bool next(int i, Unit& u) const {
        const long L = (long)i * G + c; if (L >= nwg) return false;
        int wgid = (int)L; { const int q = nwg / NXCD, r = nwg % NXCD, xcd = wgid % NXCD, off = wgid / NXCD; wgid = (xcd < r ? xcd * (q + 1) : r * (q + 1) + (xcd - r) * q) + off; }
        const int nig = WGM * nN, gid = wgid / nig, fm = gid * WGM, gsz = (nM - fm) < WGM ? (nM - fm) : WGM;
        u.pm = fm + ((wgid % nig) % gsz); u.pn = (wgid % nig) / gsz; return true;
    }
    __device__ __forceinline__ void a_ready(const Unit&) const {}
    __device__ __forceinline__ void done(const Unit&) const {}
};

__device__ __forceinline__ unsigned cvt_pk_bf16(float lo, float hi) { unsigned r; asm volatile("v_cvt_pk_bf16_f32 %0, %1, %2" : "=v"(r) : "v"(lo), "v"(hi)); return r; }
typedef float f32x2 __attribute__((ext_vector_type(2)));
constexpr size_t WSO_C1IN = 1u << 20, WSO_C2IN = WSO_C1IN + 4 * 3584 * 4, WSO_C1UP = WSO_C2IN + 4 * 3584 * 4, WSO_C2UP = WSO_C1UP + 4 * 4096 * 4, WSO_ROPE = 3u << 20, WSO_STAT1 = 8u << 20, WSO_STAT2 = 9u << 20;
constexpr size_t WSO_XB2 = 132ull << 20, WSO_XB1 = 164ull << 20, WSO_T1 = 196ull << 20, WSO_T2 = 260ull << 20, WSO_QB = 324ull << 20, WSO_KB = 340ull << 20, WSO_VB = 356ull << 20, WSO_PR = 372ull << 20, WSO_H = 580ull << 20;
constexpr size_t OO_SHP = 16809984, OO_KP = 21405696, OO_VP = 29794304;
__device__ __forceinline__ void row_stats(const float* stat, int row, float& mu, float& rs) {
    const f32x4 a = *(const f32x4*)(stat + (size_t)row * 8), b = *(const f32x4*)(stat + (size_t)row * 8 + 4);
    const float s = (a[0] + a[2]) + (b[0] + b[2]), q = (a[1] + a[3]) + (b[1] + b[3]);
    mu = s * (1.f / 1024.f); const float var = fmaxf(q * (1.f / 1024.f) - mu * mu, 0.f); rs = 1.0f / sqrtf(var + 1e-5f);
}
typedef float f32x2e __attribute__((ext_vector_type(2)));
typedef unsigned u32x2e __attribute__((ext_vector_type(2)));
struct EpiIn {
    static constexpr bool PERM = false, AFTER_DRAIN = false;
    unsigned char* ws; float* out; int l;
    __device__ __forceinline__ void operator()(const f32x4 (&acc)[2][2][4][2], const Unit& u, int wr, int wc, int fr, int fq) const {
        asm volatile("" ::: "memory"); __builtin_amdgcn_sched_barrier(0);
        const int fold = l > 0; const float* stat = (const float*)(ws + WSO_STAT2); const float* c1 = (const float*)(ws + WSO_C1IN) + l * 3584; const float* c2 = (const float*)(ws + WSO_C2IN) + l * 3584;
        bf16_t* QB = (bf16_t*)(ws + WSO_QB); bf16_t* KB = (bf16_t*)(ws + WSO_KB); bf16_t* VB = (bf16_t*)(ws + WSO_VB); bf16_t* PR = (bf16_t*)(ws + WSO_PR); const float* rope = (const float*)(ws + WSO_ROPE);
        float* outk = out + OO_KP + (size_t)l * 2 * 2048 * 512; float* outv = out + OO_VP + (size_t)l * 2 * 2048 * 512; const float qscale = 0.125f * 1.4426950408889634f;
        const int cb = u.pn * BM + wc * 32 + 4 * fq;
        const int i0 = 16 * (wc & 1) + 4 * fq; const bool roped = u.pn < 4;
        const int rbase = u.pm * BM + wr * 64 + fr;
        float mu8[8], rs8[8];
#pragma unroll
        for (int gq = 0; gq < 8; ++gq) { mu8[gq] = 0.f; rs8[gq] = 1.f; if (fold) row_stats(stat, rbase + (gq >> 2) * HALF + (gq & 3) * 16, mu8[gq], rs8[gq]); }
#pragma unroll
        for (int bj = 0; bj < 2; ++bj) {
            f32x4 c1v[2], c2v[2];
#pragma unroll
            for (int n = 0; n < 2; ++n) { c1v[n] = fold ? *(const f32x4*)(c1 + cb + bj * HALF + n * 16) : (f32x4){0.f, 0.f, 0.f, 0.f}; c2v[n] = fold ? *(const f32x4*)(c2 + cb + bj * HALF + n * 16) : (f32x4){0.f, 0.f, 0.f, 0.f}; }
#pragma unroll
            for (int gq = 0; gq < 8; ++gq) {
                const int ai = gq >> 2, m = gq & 3;
                const int r = rbase + ai * HALF + m * 16;
                const float mu = mu8[gq], rs = rs8[gq];
                f32x4 ra = {0.f, 0.f, 0.f, 0.f}, rb = ra;
                if (roped) { const float* rp = rope + ((size_t)(r & 8191) * 32 + i0) * 2; ra = *(const f32x4*)rp; rb = *(const f32x4*)(rp + 4); }
                if ((gq & 3) == 3) asm volatile("" ::: "memory");
                f32x4 v[2];
#pragma unroll
                for (int n = 0; n < 2; ++n) v[n] = (acc[ai][bj][m][n] - mu * c1v[n]) * rs + c2v[n];
                const int pos = r & 8191, b = r >> 13;
                if (roped) {
                    const f32x4 cs = {ra[0], ra[2], rb[0], rb[2]}, sn = {ra[1], ra[3], rb[1], rb[3]};
                    const int head = (u.pn & 1) * 4 + bj * 2 + (wc >> 1);
                    f32x4 y1 = v[0] * cs - v[1] * sn, y2 = v[0] * sn + v[1] * cs;
                    const size_t o = (size_t)r * 512 + head * 64 + i0;
                    if (u.pn < 2) { y1 = y1 * qscale; y2 = y2 * qscale;
                        u32x2e w; w.x = cvt_pk_bf16(y1[0], y1[1]); w.y = cvt_pk_bf16(y1[2], y1[3]); *(u32x2e*)(QB + o) = w;
                        w.x = cvt_pk_bf16(y2[0], y2[1]); w.y = cvt_pk_bf16(y2[2], y2[3]); *(u32x2e*)(QB + o + 32) = w;
                    } else {
                        u32x2e w; w.x = cvt_pk_bf16(y1[0], y1[1]); w.y = cvt_pk_bf16(y1[2], y1[3]); *(u32x2e*)(KB + o) = w;
                        w.x = cvt_pk_bf16(y2[0], y2[1]); w.y = cvt_pk_bf16(y2[2], y2[3]); *(u32x2e*)(KB + o + 32) = w;
                        if (pos >= 6144) { float* ok = outk + ((size_t)(b * 2048 + pos - 6144)) * 512 + head * 64 + i0; *(f32x4*)ok = y1; *(f32x4*)(ok + 32) = y2; }
                    }
                } else if (u.pn < 6) {
#pragma unroll
                    for (int n = 0; n < 2; ++n) { const int c = cb + bj * HALF + n * 16 - 1024; const f32x4 x = v[n];
                        u32x2e w; w.x = cvt_pk_bf16(x[0], x[1]); w.y = cvt_pk_bf16(x[2], x[3]); *(u32x2e*)(VB + (size_t)r * 512 + c) = w;
                        if (pos >= 6144) *(f32x4*)(outv + ((size_t)(b * 2048 + pos - 6144)) * 512 + c) = x; }
                } else {
#pragma unroll
                    for (int n = 0; n < 2; ++n) { const int c = cb + bj * HALF + n * 16 - 1536; const f32x4 x = v[n];
                        if (c < 1824) { u32x2e w; w.x = cvt_pk_bf16(x[0], x[1]); w.y = cvt_pk_bf16(x[2], x[3]); *(u32x2e*)(PR + (size_t)r * 2048 + c) = w; } }
                }
            }
        }
    }
};
template <bool IS_F> struct EpiRes {
    static constexpr bool PERM = false, AFTER_DRAIN = true;
    unsigned char* ws; const float* const* in; float* out; int l;
    __device__ __forceinline__ void fused(f32x4 (&acc)[2][2][4][2], const Unit& u, int wr, int wc, int fr, int fq, PG8_LAS unsigned char* lds, int wid, int lane) const {
        const int raw = (!IS_F && l == 0) ? 1 : 0;
        const bf16_t* src = (const bf16_t*)(ws + (IS_F ? WSO_XB1 : WSO_XB2));
        const float* sstat = (const float*)(ws + (IS_F ? WSO_STAT1 : WSO_STAT2));
        const float* g = IS_F ? in[24] + (size_t)l * 1024 : in[28] + (size_t)(l > 0 ? l - 1 : 0) * 1024; const float* b = IS_F ? in[25] + (size_t)l * 1024 : in[29] + (size_t)(l > 0 ? l - 1 : 0) * 1024;
        bf16_t* XB = (bf16_t*)(ws + (IS_F ? WSO_XB2 : WSO_XB1)); float* ostat = (float*)(ws + (IS_F ? WSO_STAT2 : WSO_STAT1));
        float* shiftout = (IS_F || raw) ? nullptr : out + OO_SHP + (size_t)l * 2 * 1024; const float alpha = 1.6817928305074290f;
        PG8_LAS f32x2e* P = (PG8_LAS f32x2e*)lds;
        const int cb = u.pn * BM + wc * 32 + 4 * fq;
        const int rbase = u.pm * BM + wr * 64 + fr;
        u32x2e cur[2][2], nxt[2][2]; f32x4 sa = {0.f, 0.f, 0.f, 0.f}, sb = sa, san = sa, sbn = sa;
#pragma unroll
        for (int bj = 0; bj < 2; ++bj)
#pragma unroll
            for (int n = 0; n < 2; ++n) { cur[bj][n] = *(const u32x2e*)(src + (size_t)rbase * 1024 + cb + bj * HALF + n * 16); nxt[bj][n] = cur[bj][n]; }
        if (!raw) { sa = *(const f32x4*)(sstat + (size_t)rbase * 8); sb = *(const f32x4*)(sstat + (size_t)rbase * 8 + 4); }
#pragma unroll
        for (int gq = 0; gq < 8; ++gq) {
            const int ai = gq >> 2, m = gq & 3;
            const int r = rbase + ai * HALF + m * 16;
            if (gq < 7) { const int rn = rbase + ((gq + 1) >> 2) * HALF + ((gq + 1) & 3) * 16;
#pragma unroll
                for (int bj = 0; bj < 2; ++bj)
#pragma unroll
                    for (int n = 0; n < 2; ++n) nxt[bj][n] = *(const u32x2e*)(src + (size_t)rn * 1024 + cb + bj * HALF + n * 16);
                if (!raw) { san = *(const f32x4*)(sstat + (size_t)rn * 8); sbn = *(const f32x4*)(sstat + (size_t)rn * 8 + 4); } }
            asm volatile("" ::: "memory");
            float mu = 0.f, rs = 1.f;
            if (!raw) { const float ssum = (sa[0] + sa[2]) + (sb[0] + sb[2]), qsum = (sa[1] + sa[3]) + (sb[1] + sb[3]); mu = ssum * (1.f / 1024.f); rs = 1.0f / sqrtf(fmaxf(qsum * (1.f / 1024.f) - mu * mu, 0.f) + 1e-5f); }
            float s = 0.f, q = 0.f;
#pragma unroll
            for (int bj = 0; bj < 2; ++bj)
#pragma unroll
                for (int n = 0; n < 2; ++n) { const int c = cb + bj * HALF + n * 16; const size_t off = (size_t)r * 1024 + c;
                    const f32x4 gvv = raw ? (f32x4){1.f, 1.f, 1.f, 1.f} : *(const f32x4*)(g + c), bvv = raw ? (f32x4){0.f, 0.f, 0.f, 0.f} : *(const f32x4*)(b + c);
                    const u32x2e cw = cur[bj][n];
                    const f32x4 cf = {__builtin_bit_cast(float, cw.x << 16), __builtin_bit_cast(float, cw.x & 0xffff0000u), __builtin_bit_cast(float, cw.y << 16), __builtin_bit_cast(float, cw.y & 0xffff0000u)};
                    const f32x4 x = (cf - mu) * rs * gvv + bvv;
                    const f32x4 t = x * alpha + acc[ai][bj][m][n];
                    u32x2e w; w.x = cvt_pk_bf16(t[0], t[1]); w.y = cvt_pk_bf16(t[2], t[3]); *(u32x2e*)(XB + off) = w;
                    s += (t[0] + t[1]) + (t[2] + t[3]); q += (t[0] * t[0] + t[1] * t[1]) + (t[2] * t[2] + t[3] * t[3]);
                    if (shiftout && (r & 8191) == 8191) *(f32x4*)(shiftout + (size_t)(r >> 13) * 1024 + c) = x; }
            s += __shfl_xor(s, 16); s += __shfl_xor(s, 32); q += __shfl_xor(q, 16); q += __shfl_xor(q, 32);
            if (fq == 0) P[(ai * HALF + wr * 64 + m * 16 + fr) * 4 + wc] = (f32x2e){s, q};
#pragma unroll
            for (int bj = 0; bj < 2; ++bj)
#pragma unroll
                for (int n = 0; n < 2; ++n) cur[bj][n] = nxt[bj][n];
            sa = san; sb = sbn;
        }
        asm volatile("s_waitcnt lgkmcnt(0)" ::: "memory"); __builtin_amdgcn_s_barrier(); asm volatile("" ::: "memory");
        if (threadIdx.x < 256) { const int row = threadIdx.x; const f32x2e a = P[row * 4 + 0], b2 = P[row * 4 + 1], c = P[row * 4 + 2], d = P[row * 4 + 3];
            *(f32x2e*)(ostat + (size_t)(u.pm * BM + row) * 8 + u.pn * 2) = (f32x2e){(a.x + b2.x) + (c.x + d.x), (a.y + b2.y) + (c.y + d.y)}; }
        asm volatile("s_waitcnt lgkmcnt(0)" ::: "memory"); __builtin_amdgcn_s_barrier(); asm volatile("" ::: "memory");
    }
};
struct EpiUp {
    static constexpr bool PERM = true, AFTER_DRAIN = false;
    unsigned char* ws; int l;
    __device__ __forceinline__ void operator()(const f32x4 (&acc)[2][2][4][2], const Unit& u, int wr, int wc, int fr, int fq) const {
        asm volatile("" ::: "memory"); __builtin_amdgcn_sched_barrier(0);
        const float* stat = (const float*)(ws + WSO_STAT1); const float* c1 = (const float*)(ws + WSO_C1UP) + l * 4096; const float* c2 = (const float*)(ws + WSO_C2UP) + l * 4096; bf16_t* H = (bf16_t*)(ws + WSO_H);
        const int cb = u.pn * BM + wc * 32 + 8 * fq;
        float mu8[8], rs8[8];
#pragma unroll
        for (int gq = 0; gq < 8; ++gq) row_stats(stat, u.pm * BM + (gq >> 2) * HALF + wr * 64 + (gq & 3) * 16 + fr, mu8[gq], rs8[gq]);
#pragma unroll
        for (int bj = 0; bj < 2; ++bj) {
            f32x4 c1v[2], c2v[2];
#pragma unroll
            for (int n = 0; n < 2; ++n) { c1v[n] = *(const f32x4*)(c1 + cb + bj * HALF + 4 * n); c2v[n] = *(const f32x4*)(c2 + cb + bj * HALF + 4 * n); }
#pragma unroll
            for (int ai = 0; ai < 2; ++ai) {
#pragma unroll
                for (int m = 0; m < 4; ++m) {
                    const int r = u.pm * BM + ai * HALF + wr * 64 + m * 16 + fr;
                    const float mu = mu8[ai * 4 + m], rs = rs8[ai * 4 + m];
                    f32x4 v0 = (acc[ai][bj][m][0] - mu * c1v[0]) * rs + c2v[0], v1 = (acc[ai][bj][m][1] - mu * c1v[1]) * rs + c2v[1];
#pragma unroll
                    for (int e = 0; e < 4; ++e) { const float a = fmaxf(v0[e], 0.f), b = fmaxf(v1[e], 0.f); v0[e] = a * a; v1[e] = b * b; }
                    u32x4 w; w.x = cvt_pk_bf16(v0[0], v0[1]); w.y = cvt_pk_bf16(v0[2], v0[3]); w.z = cvt_pk_bf16(v1[0], v1[1]); w.w = cvt_pk_bf16(v1[2], v1[3]);
                    *(u32x4*)(H + (size_t)r * 4096 + cb + bj * HALF) = w; }
            }
        }
    }
};
template <class Epi, class Sched, bool ALIGN_EPI = false, bool SP2 = false>
__device__ __forceinline__ void gemm_phase(PG8_LAS unsigned char* lds, const Gemm g, const Sched& S, const Epi& E, const int tid) {
    const int wid = __builtin_amdgcn_readfirstlane(tid >> 6), lane = tid & 63, wr = wid >> 2, wc = wid & 3, fr = lane & 15, fq = lane >> 4;
    const int K = g.K, nt = K / BK;
    unsigned voffA[2], voffB[2];
#pragma unroll
    for (int i = 0; i < 2; ++i) { int R, C; stage_rc(tid * 16 + i * 8192, R, C); const int Rb = Epi::PERM ? ((R & ~31) + perm32(R & 31)) : R;
        voffA[i] = (unsigned)(R * K + C) * 2u; voffB[i] = (unsigned)(Rb * K + C) * 2u; }
    const size_t kstep = (size_t)(BK * 2);
    const size_t hstep = (size_t)HALF * K * 2;
    const size_t tstep = 2 * hstep;
    const unsigned ldsw = (unsigned)wid * 1024u;
    const int aoff = lds_byte(wr * 64 + fr, fq * 8), boff = lds_byte(wc * 32 + fr, fq * 8);
#define PG8_SA(b, h) (((b) * 2 + (h)) * HTB)
#define PG8_SB(b, h) ((4 + (b) * 2 + (h)) * HTB)
#define PG8_STAGE(bufoff, gbase, voff) do { _Pragma("unroll") for (int _i = 0; _i < 2; ++_i) \
        __builtin_amdgcn_global_load_lds((const unsigned*)((const char*)(gbase) + (voff)[_i]), (PG8_LAS unsigned*)(lds + (bufoff) + ldsw + _i * 8192), 16, 0, 0); } while (0)
#define PG8_LDA(dst, b, h) do { _Pragma("unroll") for (int m = 0; m < 4; ++m) _Pragma("unroll") for (int k = 0; k < 2; ++k) dst[m][k] = *(const PG8_LAS bf16x8*)(lds + PG8_SA(b, h) + aoff + m * 2048 + k * 1024); } while (0)
#define PG8_LDB(dst, b, h) do { _Pragma("unroll") for (int n = 0; n < 2; ++n) _Pragma("unroll") for (int k = 0; k < 2; ++k) dst[n][k] = *(const PG8_LAS bf16x8*)(lds + PG8_SB(b, h) + boff + n * 2048 + k * 1024); } while (0)
#define PG8_MMA(ai, bj, At, Bt) do { __builtin_amdgcn_s_setprio(1); _Pragma("unroll") for (int m = 0; m < 4; ++m) _Pragma("unroll") for (int n = 0; n < 2; ++n) _Pragma("unroll") for (int k = 0; k < 2; ++k) \
        acc[ai][bj][m][n] = __builtin_amdgcn_mfma_f32_16x16x32_bf16(Bt[n][k], At[m][k], acc[ai][bj][m][n], 0, 0, 0); __builtin_amdgcn_s_setprio(0); } while (0)
#define PG8_WAIT_V(n) asm volatile("s_waitcnt vmcnt(" #n ")" ::: "memory")
#define PG8_WAIT_L(n) asm volatile("s_waitcnt lgkmcnt(" #n ")" ::: "memory")
#define PG8_BAR __builtin_amdgcn_s_barrier()
#define PG8_SCHED __builtin_amdgcn_sched_barrier(0)
    Unit cur, nxt; int ui = 0;
    if (!S.next(0, cur)) return;
    f32x4 acc[2][2][4][2];
#pragma unroll
    for (int a = 0; a < 2; ++a)
#pragma unroll
        for (int b = 0; b < 2; ++b)
#pragma unroll
            for (int m = 0; m < 4; ++m)
#pragma unroll
                for (int n = 0; n < 2; ++n) acc[a][b][m][n] = (f32x4){0.f, 0.f, 0.f, 0.f};
    bf16x8 At[4][2], B0[2][2], B1[2][2];
    const char* cA = (const char*)g.A + (size_t)cur.pm * tstep; const char* cB = (const char*)g.Bt + (size_t)cur.pn * tstep;
    S.a_ready(cur);
    if constexpr (SP2) {
        PG8_STAGE(PG8_SB(0, 0), cB, voffB); PG8_STAGE(PG8_SB(0, 1), cB + hstep, voffB); PG8_STAGE(PG8_SA(0, 0), cA, voffA); PG8_STAGE(PG8_SA(0, 1), cA + hstep, voffA);
        if (wr == 1) PG8_BAR;
        PG8_WAIT_V(2); PG8_BAR;
        PG8_STAGE(PG8_SB(1, 0), cB + kstep, voffB); PG8_STAGE(PG8_SA(1, 0), cA + kstep, voffA); PG8_STAGE(PG8_SB(1, 1), cB + hstep + kstep, voffB);
        PG8_WAIT_V(6); PG8_BAR;
    } else {
        PG8_STAGE(PG8_SB(0, 0), cB, voffB); PG8_STAGE(PG8_SA(0, 0), cA, voffA); PG8_STAGE(PG8_SB(0, 1), cB + hstep, voffB); PG8_STAGE(PG8_SA(0, 1), cA + hstep, voffA);
        if (wr == 1) PG8_BAR;
        PG8_WAIT_V(4); PG8_BAR;
        PG8_STAGE(PG8_SB(1, 0), cB + kstep, voffB); PG8_STAGE(PG8_SA(1, 0), cA + kstep, voffA); PG8_STAGE(PG8_SB(1, 1), cB + hstep + kstep, voffB);
        PG8_WAIT_V(6); PG8_BAR;
    }
    for (;;) {
        const bool has_next = S.next(ui + 1, nxt);
        const char* nA = has_next ? (const char*)g.A + (size_t)nxt.pm * tstep : cA; const char* nB = has_next ? (const char*)g.Bt + (size_t)nxt.pn * tstep : cB;
        for (int t = 0; t < nt; t += 2) {
            const bool last = (t == nt - 2);
            const char* a1 = cA + (size_t)(t + 1) * kstep;
            const char* a2 = last ? nA : cA + (size_t)(t + 2) * kstep; const char* b2 = last ? nB : cB + (size_t)(t + 2) * kstep;
            const char* a3 = a2 + kstep; const char* b3 = b2 + kstep;
            if (last && has_next) S.a_ready(nxt);
            if constexpr (SP2) {
            PG8_LDB(B0, 0, 0); PG8_LDB(B1, 0, 1); PG8_SCHED; PG8_LDA(At, 0, 0); PG8_STAGE(PG8_SA(1, 1), a1 + hstep, voffA);
            PG8_WAIT_V(8); PG8_WAIT_L(0); PG8_BAR; PG8_MMA(0, 0, At, B0); PG8_MMA(0, 1, At, B1); PG8_BAR; PG8_SCHED;
            PG8_LDA(At, 0, 1); PG8_STAGE(PG8_SB(0, 0), b2, voffB); PG8_STAGE(PG8_SB(0, 1), b2 + hstep, voffB); PG8_STAGE(PG8_SA(0, 0), a2, voffA);
            PG8_WAIT_V(8); PG8_WAIT_L(0); PG8_BAR; PG8_MMA(1, 0, At, B0); PG8_MMA(1, 1, At, B1); PG8_BAR; PG8_SCHED;
            PG8_LDB(B0, 1, 0); PG8_LDB(B1, 1, 1); PG8_SCHED; PG8_LDA(At, 1, 0); PG8_STAGE(PG8_SA(0, 1), a2 + hstep, voffA);
            PG8_WAIT_V(8); PG8_WAIT_L(0); PG8_BAR; PG8_MMA(0, 0, At, B0); PG8_MMA(0, 1, At, B1); PG8_BAR; PG8_SCHED;
            PG8_LDA(At, 1, 1); PG8_STAGE(PG8_SB(1, 0), b3, voffB); PG8_STAGE(PG8_SB(1, 1), b3 + hstep, voffB); PG8_STAGE(PG8_SA(1, 0), a3, voffA);
            PG8_WAIT_V(8); PG8_WAIT_L(0); PG8_BAR; PG8_MMA(1, 0, At, B0); PG8_MMA(1, 1, At, B1); PG8_BAR; PG8_SCHED;
            } else {
            PG8_LDB(B0, 0, 0); PG8_SCHED; PG8_LDA(At, 0, 0); PG8_STAGE(PG8_SA(1, 1), a1 + hstep, voffA);
            PG8_WAIT_L(8); PG8_BAR; PG8_WAIT_L(0); PG8_MMA(0, 0, At, B0); PG8_BAR; PG8_SCHED;
            PG8_LDB(B1, 0, 1); PG8_STAGE(PG8_SB(0, 0), b2, voffB);
            PG8_BAR; PG8_WAIT_L(0); PG8_MMA(0, 1, At, B1); PG8_BAR;
            PG8_LDA(At, 0, 1); PG8_STAGE(PG8_SA(0, 0), a2, voffA);
            PG8_BAR; PG8_WAIT_L(0); PG8_MMA(1, 0, At, B0); PG8_BAR; PG8_SCHED;
            PG8_STAGE(PG8_SB(0, 1), b2 + hstep, voffB);
            PG8_WAIT_V(6); PG8_BAR; PG8_MMA(1, 1, At, B1); PG8_BAR;
            PG8_LDB(B0, 1, 0); PG8_SCHED; PG8_LDA(At, 1, 0); PG8_STAGE(PG8_SA(0, 1), a2 + hstep, voffA);
            PG8_WAIT_L(8); PG8_BAR; PG8_WAIT_L(0); PG8_MMA(0, 0, At, B0); PG8_BAR; PG8_SCHED;
            PG8_LDB(B1, 1, 1); PG8_STAGE(PG8_SB(1, 0), b3, voffB);
            PG8_BAR; PG8_WAIT_L(0); PG8_MMA(0, 1, At, B1); PG8_BAR;
            PG8_LDA(At, 1, 1); PG8_STAGE(PG8_SA(1, 0), a3, voffA);
            PG8_BAR; PG8_WAIT_L(0); PG8_MMA(1, 0, At, B0); PG8_BAR; PG8_SCHED;
            PG8_STAGE(PG8_SB(1, 1), b3 + hstep, voffB);
            PG8_WAIT_V(6); PG8_BAR; PG8_MMA(1, 1, At, B1); PG8_BAR;
            }
        }
        if constexpr (ALIGN_EPI) { if (wr == 0) PG8_BAR; }
        if constexpr (!Epi::AFTER_DRAIN) { E(acc, cur, wr, wc, fr, fq); S.done(cur); }
        if (!has_next) break;
#pragma unroll
        for (int a = 0; a < 2; ++a)
#pragma unroll
            for (int b = 0; b < 2; ++b)
#pragma unroll
                for (int m = 0; m < 4; ++m)
#pragma unroll
                    for (int n = 0; n < 2; ++n) acc[a][b][m][n] = (f32x4){0.f, 0.f, 0.f, 0.f};
        cur = nxt; cA = nA; cB = nB; ++ui;
        if constexpr (ALIGN_EPI) { if (wr == 1) PG8_BAR; }
    }
    PG8_WAIT_V(0);
    if constexpr (!ALIGN_EPI) { if (wr == 0) PG8_BAR; }
    PG8_BAR;
    if constexpr (Epi::AFTER_DRAIN) { E.fused(acc, cur, wr, wc, fr, fq, lds, wid, lane); S.done(cur); }
#undef PG8_SA
#undef PG8_SB
#undef PG8_STAGE
#undef PG8_LDA
#undef PG8_LDB
#undef PG8_MMA
#undef PG8_WAIT_V
#undef PG8_WAIT_L
#undef PG8_BAR
#undef PG8_SCHED
}
}
constexpr int NWAVES = 8;
constexpr int M = 16384, TSEQ = 8192, DM = 1024, FFD = 4096, DEPTH = 4, MD = 32, NH = 8, HD = 64;
constexpr int NIN = 3584;
constexpr int RW0 = 1536;
constexpr int PRP = 2048;
constexpr int NRWU = 1856;
constexpr int CH = 16, NCH = TSEQ / CH;
constexpr int NUNIT = 2 * NH * NCH;
constexpr float LN_EPS = 1e-5f, GN_EPS = 64e-5f, RMS_EPS = 1e-6f;
constexpr float ALPHA = 1.6817928305074290f;
constexpr float QSCALE = 0.125f * 1.4426950408889634f;
constexpr size_t O_Y = 0, O_YS = 16777216, O_SHP = 16809984, O_SHS = 16818176, O_WKP = 16949248, O_WKS = 17211392,
                 O_KP = 21405696, O_VP = 29794304, O_KS = 38182912, O_VS = 38248448, O_END = 38313984;
constexpr size_t MiB = 1u << 20;
constexpr size_t WS_CTL = 0, CTL_ZERO_BYTES = 1 * MiB;
constexpr size_t WS_C1IN = 1 * MiB;
constexpr size_t WS_C2IN = WS_C1IN + 4 * NIN * 4;
constexpr size_t WS_C1UP = WS_C2IN + 4 * NIN * 4;
constexpr size_t WS_C2UP = WS_C1UP + 4 * FFD * 4;
constexpr size_t WS_DUPT = WS_C2UP + 4 * FFD * 4;
constexpr size_t WS_IUPT = WS_DUPT + 4 * 512 * 64 * 2;
constexpr size_t WS_GUPT = WS_IUPT + 4 * 512 * 64 * 2;
constexpr size_t WS_VUPT = WS_GUPT + 4 * 512 * 128 * 2;
constexpr size_t WS_SMALL_END = WS_VUPT + 3 * 512 * 32 * 2;
static_assert(WS_SMALL_END <= 3 * MiB, "small region");
constexpr size_t WS_ROPE = 3 * MiB;
constexpr size_t WS_DEC = 6 * MiB;
constexpr size_t WS_STAT1 = 8 * MiB, WS_STAT2 = 9 * MiB;
constexpr size_t WS_BON = 10 * MiB;
constexpr size_t WS_LSE = 11 * MiB;
constexpr size_t WS_GC = 13 * MiB;
constexpr size_t WS_WIN = 16 * MiB;
constexpr size_t WS_WINU = 44 * MiB;
constexpr size_t WS_WOUT = 60 * MiB;
constexpr size_t WS_WUP = 68 * MiB;
constexpr size_t WS_WDN = 100 * MiB;
constexpr size_t WS_XB2 = 132 * MiB;
constexpr size_t WS_XB1 = 164 * MiB;
constexpr size_t WS_T1 = 196 * MiB;
constexpr size_t WS_T2 = 260 * MiB;
constexpr size_t WS_QB = 324 * MiB, WS_KB = 340 * MiB, WS_VB = 356 * MiB;
constexpr size_t WS_PR = 372 * MiB;
constexpr size_t WS_OP = 436 * MiB;
constexpr size_t WS_MIX = 484 * MiB;
constexpr size_t WS_VF = 516 * MiB, WS_VV = 532 * MiB;
constexpr size_t WS_YPRE = 548 * MiB;
constexpr size_t WS_H = 580 * MiB;
constexpr size_t WS_PT = 580 * MiB;
constexpr size_t WS_QT = 644 * MiB;
constexpr size_t WS_REFF = 708 * MiB;
constexpr size_t WS_YLOC = 724 * MiB;
constexpr size_t WS_SEGQ = 756 * MiB, WS_SEGP = 760 * MiB;
constexpr size_t WS_CSUM = 764 * MiB;
constexpr size_t WS_CSUP = 766 * MiB;
constexpr size_t WS_END = 768 * MiB;
static_assert(WS_H + (size_t)M * FFD * 2 <= WS_END + 0 * MiB || true, "");
constexpr size_t DEC_XB2 = 0;
constexpr size_t DEC_XB1 = 64 * 1024;
constexpr size_t DEC_SHB = 128 * 1024;
constexpr size_t DEC_MIXB = 384 * 1024;
constexpr size_t DEC_HB = 448 * 1024;
constexpr size_t DEC_T1 = 704 * 1024;
constexpr size_t DEC_T2 = 832 * 1024;
constexpr size_t DEC_PD = 960 * 1024;
constexpr size_t DEC_PS = 1408 * 1024;
constexpr size_t DEC_OP = 1640 * 1024;
constexpr size_t DEC_LSE = 1832 * 1024;
constexpr size_t DEC_MIX = 1836 * 1024;
constexpr size_t DEC_ST1 = 1964 * 1024;
constexpr size_t DEC_ST2 = 1972 * 1024;
constexpr size_t DEC_VF = 1980 * 1024;
static_assert(DEC_VF + 32 * 512 * 4 <= 2 * MiB, "decode scratch");
constexpr int CW_BAR = 4096;
constexpr int RING_BYTES = 131072;
constexpr int MISC_OFF = RING_BYTES + 320;
constexpr int LDS_BYTES = 147456;
static_assert(pg8::WSO_C1IN == WS_C1IN && pg8::WSO_C2IN == WS_C2IN && pg8::WSO_C1UP == WS_C1UP && pg8::WSO_C2UP == WS_C2UP && pg8::WSO_ROPE == WS_ROPE && pg8::WSO_STAT1 == WS_STAT1 && pg8::WSO_STAT2 == WS_STAT2 &&
              pg8::WSO_XB2 == WS_XB2 && pg8::WSO_XB1 == WS_XB1 && pg8::WSO_T1 == WS_T1 && pg8::WSO_T2 == WS_T2 && pg8::WSO_QB == WS_QB && pg8::WSO_KB == WS_KB && pg8::WSO_VB == WS_VB && pg8::WSO_PR == WS_PR && pg8::WSO_H == WS_H &&
              pg8::OO_SHP == O_SHP && pg8::OO_KP == O_KP && pg8::OO_VP == O_VP, "epilogue offset mirrors");
#define GAS __attribute__((address_space(1)))
#define LAS __attribute__((address_space(3)))
typedef unsigned short bf16;
typedef unsigned v4u __attribute__((ext_vector_type(4)));
typedef unsigned v2u __attribute__((ext_vector_type(2)));
typedef float f32x4 __attribute__((ext_vector_type(4)));
typedef float f32x2 __attribute__((ext_vector_type(2)));
typedef float f32x16 __attribute__((ext_vector_type(16)));
typedef short bf16x8 __attribute__((ext_vector_type(8)));
typedef short s16x4 __attribute__((ext_vector_type(4)));
typedef GAS unsigned gu32;
#define RLX_AGENT __ATOMIC_RELAXED, __HIP_MEMORY_SCOPE_AGENT
#define LDS_WAIT() asm volatile("s_waitcnt lgkmcnt(0)" ::: "memory")
#define VM_WAIT() asm volatile("s_waitcnt vmcnt(0)" ::: "memory")
#define DI __device__ __forceinline__
DI unsigned f2bf(float f) { unsigned u = __builtin_bit_cast(unsigned, f); return (u + 0x7fffu + ((u >> 16) & 1u)) >> 16; }
DI float bf2f(unsigned b) { return __builtin_bit_cast(float, b << 16); }
DI float bflo(unsigned w) { return __builtin_bit_cast(float, w << 16); }
DI float bfhi(unsigned w) { return __builtin_bit_cast(float, w & 0xffff0000u); }
typedef __bf16 bf16x2_t __attribute__((ext_vector_type(2)));
DI unsigned pk2(float lo, float hi) { const f32x2 v = {lo, hi}; const bf16x2_t b = __builtin_convertvector(v, bf16x2_t); return __builtin_bit_cast(unsigned, b); }
DI unsigned pk2z(float x) { return pk2(x, 0.f) & 0xffffu; }
DI float rbf(float x) { return bf2f(f2bf(x)); }
DI bf16x8 pk8(float a0, float a1, float a2, float a3, float a4, float a5, float a6, float a7) {
    v4u w; w.x = pk2(a0, a1); w.y = pk2(a2, a3); w.z = pk2(a4, a5); w.w = pk2(a6, a7); return __builtin_bit_cast(bf16x8, w); }
DI bf16x8 pk8v(f32x4 a, f32x4 b) { return pk8(a[0], a[1], a[2], a[3], b[0], b[1], b[2], b[3]); }
DI bf16x8 pk4z(f32x4 a) { v4u w; w.x = pk2(a[0], a[1]); w.y = pk2(a[2], a[3]); w.z = 0u; w.w = 0u; return __builtin_bit_cast(bf16x8, w); }
DI bf16x8 ld8(const void* p) { return *(const bf16x8*)p; }
DI bf16x8 ld4z(const void* p) { v2u t = *(const v2u*)p; v4u w; w.x = t.x; w.y = t.y; w.z = 0u; w.w = 0u; return __builtin_bit_cast(bf16x8, w); }
DI f32x4 mfma16(bf16x8 a, bf16x8 b, f32x4 c) { return __builtin_amdgcn_mfma_f32_16x16x32_bf16(a, b, c, 0, 0, 0); }
DI f32x16 mfma32(bf16x8 a, bf16x8 b, f32x16 c) { return __builtin_amdgcn_mfma_f32_32x32x16_bf16(a, b, c, 0, 0, 0); }
DI int crow(int r, int hi) { return (r & 3) + 8 * (r >> 2) + 4 * hi; }
DI float wave_sum(float v) {
#pragma unroll
    for (int o = 1; o < 64; o <<= 1) v += __shfl_xor(v, o);
    return v; }
DI float fexp(float x) { return __expf(x); }
DI float fsigmoid(float x) { return __builtin_amdgcn_rcpf(1.f + __expf(-x)); }
DI float ftanh(float x) { return 1.f - 2.f * __builtin_amdgcn_rcpf(__expf(2.f * x) + 1.f); }
DI float fsoftplus(float x) { return fmaxf(x, 0.f) + __logf(1.f + __expf(-fabsf(x))); }
DI int swap45(int c) { return (c & ~0x30) | ((c & 0x10) << 1) | ((c & 0x20) >> 1); }
#define XB_TMO      128
#define XB_XCNT(j)  (256  + 64 * (j))
#define XB_XSUB(j)  (1280 + 64 * (j))
#define XB_XGEN(j)  (2304 + 64 * (j))
#define XB_TOP      3328
#define XB_TOPGEN   3392
#define XCD_BAR_WORDS 3456
#define XB_SPIN_CAP (1u << 18)

__device__ __forceinline__ unsigned xb_ld(unsigned* p)              { return __hip_atomic_load(p, __ATOMIC_RELAXED, __HIP_MEMORY_SCOPE_AGENT); }
__device__ __forceinline__ unsigned xb_add(unsigned* p, unsigned v) { return __hip_atomic_fetch_add(p, v, __ATOMIC_RELAXED, __HIP_MEMORY_SCOPE_AGENT); }
__device__ __forceinline__ unsigned xb_xcc_id() { return (unsigned)__builtin_amdgcn_s_getreg((3 << 11) | 20) & 0xFu; }
#define XB_SPIN(cond, bar) do { unsigned _sp = 0; while (cond) { __builtin_amdgcn_s_sleep(1); \
    if ((++_sp & 255u) == 0u) { if (xb_ld(&(bar)[XB_TMO])) break; if (_sp > XB_SPIN_CAP) { atomicAdd(&(bar)[XB_TMO], 1u); break; } } } } while (0)

struct XcdBarrier {
    unsigned* bar; unsigned x;
    volatile LAS unsigned* st;
};

__device__ __forceinline__ XcdBarrier xcd_barrier_post(unsigned* bar, volatile LAS unsigned* st) {
    XcdBarrier b; b.bar = bar; b.x = xb_xcc_id(); b.st = st;
    if (threadIdx.x == 0) (void)xb_add(&bar[XB_XCNT(b.x)], 1u);
    return b;
}
__device__ __forceinline__ void xcd_barrier_complete(unsigned* bar, unsigned x, unsigned& nloc, unsigned& nx) {
    const unsigned G = gridDim.x * gridDim.y * gridDim.z;
    unsigned sum, cnt, mine, sp = 0u;
    for (;;) {
        sum = 0u; cnt = 0u; mine = 0u;
#pragma unroll
        for (unsigned j = 0; j < 16; ++j) { const unsigned c = xb_ld(&bar[XB_XCNT(j)]); sum += c; cnt += (c > 0u) ? 1u : 0u; mine = (j == x) ? c : mine; }
        if (sum == G) break;
        __builtin_amdgcn_s_sleep(1);
        if ((++sp & 255u) == 0u) { if (xb_ld(&bar[XB_TMO])) break; if (sp > XB_SPIN_CAP) { atomicAdd(&bar[XB_TMO], 1u); break; } }
    }
    nloc = mine > 0u ? mine : 1u; nx = cnt > 0u ? cnt : 1u;
}

__device__ __forceinline__ void xcd_barrier(const XcdBarrier& b) {
    asm volatile("s_waitcnt vmcnt(0)" ::: "memory");
    __syncthreads();
    if (threadIdx.x == 0) {
        unsigned* bar = b.bar;
        __builtin_amdgcn_s_waitcnt(0);
        unsigned nloc = b.st[0], nx = b.st[1];
        if (nloc == 0u) { xcd_barrier_complete(bar, b.x, nloc, nx); b.st[0] = nloc; b.st[1] = nx; }
        const unsigned old = xb_add(&bar[XB_XSUB(b.x)], 1u);
        const unsigned gen = old / nloc;
        if (old + 1u == (gen + 1u) * nloc) {
            __builtin_amdgcn_fence(__ATOMIC_RELEASE, "agent");
            asm volatile("s_waitcnt vmcnt(0)" ::: "memory");
            const unsigned og = xb_add(&bar[XB_TOP], 1u);
            const unsigned tg = og / nx;
            if (og + 1u == (tg + 1u) * nx) xb_add(&bar[XB_TOPGEN], 1u);
            else XB_SPIN(xb_ld(&bar[XB_TOPGEN]) == tg, bar);
            __builtin_amdgcn_fence(__ATOMIC_ACQUIRE, "agent");
            xb_add(&bar[XB_XGEN(b.x)], 1u);
            asm volatile("s_waitcnt vmcnt(0)" ::: "memory");
        } else {
            XB_SPIN(xb_ld(&bar[XB_XGEN(b.x)]) == gen, bar);
            __builtin_amdgcn_fence(__ATOMIC_ACQUIRE, "agent");
            asm volatile("s_waitcnt vmcnt(0)" ::: "memory");
        }
    }
    __syncthreads();
}
struct Args { const float* in[30]; float* out; unsigned char* ws; };
struct Frame {
    unsigned char* lds;
    volatile LAS unsigned* MISC;
    gu32* ctl;
    int tid, lane, wave, vcu, G, gw, NGW;
    const float* const* in; float* out; unsigned char* ws;
};
template <bool SWAP>
DI void p0_transpose_item(const float* W, int ldw, int K, int csrc0, bf16* WT, int row_off, const float* gsc, LAS float* scr, int kb, int nb, int lane, float* csum = nullptr, int ncs = 0, const float* bsh = nullptr) {
    const int k0 = 64 * kb, n0 = 32 * nb;
    float s1 = 0.f, s2 = 0.f;
    float wv[32], gk = 1.f, bk = 0.f;
#pragma unroll
    for (int i = 0; i < 32; ++i) wv[i] = W[(size_t)(k0 + 2 * i + (lane >> 5)) * ldw + csrc0 + n0 + (lane & 31)];
    if (gsc) gk = gsc[k0 + lane]; if (bsh) bk = bsh[k0 + lane];
#pragma unroll
    for (int i = 0; i < 32; ++i) { const int kk = 2 * i + (lane >> 5); float v = wv[i]; s2 += v * __shfl(bk, kk); v *= __shfl(gk, kk); s1 += rbf(v); scr[kk * 33 + (lane & 31)] = v; }
    if (csum) { s1 += __shfl_xor(s1, 32); s2 += __shfl_xor(s2, 32); if (lane < 32) { int dr = n0 + lane; if (SWAP) dr = swap45(dr); csum[(size_t)(kb * 2 + 0) * ncs + row_off + dr] = s1; csum[(size_t)(kb * 2 + 1) * ncs + row_off + dr] = s2; } }
    LDS_WAIT(); asm volatile("" ::: "memory");
    const int c = lane & 7;
#pragma unroll
    for (int j = 0; j < 4; ++j) { const int n = (lane >> 3) + 8 * j; const LAS float* s = scr + (8 * c) * 33 + n;
        v4u o; o.x = pk2(s[0 * 33], s[1 * 33]); o.y = pk2(s[2 * 33], s[3 * 33]); o.z = pk2(s[4 * 33], s[5 * 33]); o.w = pk2(s[6 * 33], s[7 * 33]);
        int dr = n0 + n; if (SWAP) dr = swap45(dr);
        *(v4u*)(WT + (size_t)(row_off + dr) * K + k0 + 8 * c) = o; }
    LDS_WAIT(); asm volatile("" ::: "memory");
}
DI void p0_prologue(Frame& F) {
    LAS float* scr = (LAS float*)((LAS unsigned char*)F.lds + F.wave * 16384);
    const float* const* in = F.in; unsigned char* ws = F.ws;
    constexpr int I_IN = 16 * 104, I_VR = 16, I_INU = 16 * 56, I_OUT = 16 * 32, I_UP = 16 * 128, I_DN = 64 * 32;
    constexpr int I_L = I_IN + I_VR + I_INU + I_VR + I_OUT + I_UP + I_DN;
    for (int it = F.gw; it < DEPTH * I_L; it += F.NGW) {
        const int l = it / I_L; int r = it % I_L;
        const float* g2p = l > 0 ? in[28] + (size_t)(l - 1) * DM : nullptr;
        bf16* win = (bf16*)(ws + WS_WIN) + (size_t)l * NIN * DM; bf16* winu = (bf16*)(ws + WS_WINU) + (size_t)l * NRWU * DM;
        if (r < I_IN) { const int kb = r / 104, nb = r % 104; const float* W = in[6] + (size_t)l * DM * 3328;
            float* cs = l > 0 ? (float*)(ws + WS_CSUM) + (size_t)l * 32 * NIN : nullptr; const float* b2p = l > 0 ? in[29] + (size_t)(l - 1) * DM : nullptr;
            if (nb < 32) p0_transpose_item<true>(W, 3328, DM, 0, win, 0, g2p, scr, kb, nb, F.lane, cs, NIN, b2p); else p0_transpose_item<false>(W, 3328, DM, 0, win, 0, g2p, scr, kb, nb, F.lane, cs, NIN, b2p); continue; } r -= I_IN;
        if (r < I_VR) { if (l > 0) p0_transpose_item<false>(in[7] + (size_t)(l - 1) * DM * 32, 32, DM, 0, win, 3328, g2p, scr, r, 0, F.lane, (float*)(ws + WS_CSUM) + (size_t)l * 32 * NIN, NIN, in[29] + (size_t)(l - 1) * DM); continue; } r -= I_VR;
        if (r < I_INU) { const int kb = r / 56, nb = r % 56; p0_transpose_item<false>(in[6] + (size_t)l * DM * 3328, 3328, DM, RW0, winu, 0, nullptr, scr, kb, nb, F.lane); continue; } r -= I_INU;
        if (r < I_VR) { if (l > 0) p0_transpose_item<false>(in[7] + (size_t)(l - 1) * DM * 32, 32, DM, 0, winu, 1792, nullptr, scr, r, 0, F.lane); continue; } r -= I_VR;
        if (r < I_OUT) { p0_transpose_item<false>(in[23] + (size_t)l * DM * DM, DM, DM, 0, (bf16*)(ws + WS_WOUT) + (size_t)l * DM * DM, 0, nullptr, scr, r / 32, r % 32, F.lane); continue; } r -= I_OUT;
        if (r < I_UP) { p0_transpose_item<false>(in[26] + (size_t)l * DM * FFD, FFD, DM, 0, (bf16*)(ws + WS_WUP) + (size_t)l * FFD * DM, 0, in[24] + (size_t)l * DM, scr, r / 128, r % 128, F.lane, (float*)(ws + WS_CSUP) + (size_t)l * 32 * FFD, FFD, in[25] + (size_t)l * DM); continue; } r -= I_UP;
        p0_transpose_item<false>(in[27] + (size_t)l * FFD * DM, DM, FFD, 0, (bf16*)(ws + WS_WDN) + (size_t)l * DM * FFD, 0, nullptr, scr, r / 32, r % 32, F.lane);
    }
    for (int m0 = F.gw; m0 < M; m0 += 4 * F.NGW) { f32x4 v[4][4];
#pragma unroll
        for (int q = 0; q < 4; ++q) { const f32x4* xr = (const f32x4*)(in[0] + (size_t)(m0 + q * F.NGW) * DM) + F.lane;
#pragma unroll
            for (int j = 0; j < 4; ++j) v[q][j] = xr[64 * j]; }
#pragma unroll
        for (int q = 0; q < 4; ++q) { unsigned long long* o8 = (unsigned long long*)((bf16*)(ws + WS_XB2) + (size_t)(m0 + q * F.NGW) * DM) + F.lane;
#pragma unroll
            for (int j = 0; j < 4; ++j) o8[64 * j] = (unsigned long long)pk2(v[q][j].x, v[q][j].y) | ((unsigned long long)pk2(v[q][j].z, v[q][j].w) << 32); } }
    const int gt = F.gw * 64 + F.lane, NGT = F.NGW * 64;
    for (int e = gt; e < 8193 * 32; e += NGT) { const int pos = e >> 5, i = e & 31; const double ang = (double)pos * pow(10000.0, -(double)i / 32.0); ((f32x2*)(ws + WS_ROPE))[e] = (f32x2){(float)cos(ang), (float)sin(ang)}; }
    for (int e = gt; e < 4 * 512 * 64; e += NGT) { const int l = e / (512 * 64), n = (e / 64) % 512, m = e % 64; ((bf16*)(ws + WS_DUPT))[e] = (bf16)f2bf(in[11][((size_t)l * 64 + m) * 512 + n]); ((bf16*)(ws + WS_IUPT))[e] = (bf16)f2bf(in[13][((size_t)l * 64 + m) * 512 + n]); }
    for (int e = gt; e < 4 * 512 * 128; e += NGT) { const int l = e / (512 * 128), n = (e / 128) % 512, m = e % 128; ((bf16*)(ws + WS_GUPT))[e] = (bf16)f2bf(in[14][((size_t)l * 128 + m) * 512 + n]); }
    for (int e = gt; e < 3 * 512 * 32; e += NGT) { const int l = e / (512 * 32), n = (e / 32) % 512, m = e % 32; ((bf16*)(ws + WS_VUPT))[e] = (bf16)f2bf(in[16][((size_t)l * 32 + m) * 512 + n]); }
    for (int e = gt; e < 2 * DM; e += NGT) F.out[O_SHP + e] = in[0][((size_t)(e / DM) * TSEQ + TSEQ - 1) * DM + (e % DM)];
    for (int e = gt; e < MD * DM; e += NGT) { ((bf16*)(ws + WS_DEC + DEC_XB2))[e] = (bf16)f2bf(in[1][e]); }
    for (int e = gt; e < DEPTH * MD * DM; e += NGT) { ((bf16*)(ws + WS_DEC + DEC_SHB))[e] = (bf16)f2bf(in[2][e]); }
}
DI void colsum_finish(unsigned char* ws, int gt, int NGT) {
    for (int e = gt; e < 3 * NIN; e += NGT) { const int l = 1 + e / NIN, p = e % NIN; if (p >= 3360) continue; const float* cs = (const float*)(ws + WS_CSUM) + (size_t)l * 32 * NIN + p; float s1 = 0.f, s2 = 0.f;
#pragma unroll
        for (int kb = 0; kb < 16; ++kb) { s1 += cs[(size_t)(2 * kb) * NIN]; s2 += cs[(size_t)(2 * kb + 1) * NIN]; }
        ((float*)(ws + WS_C1IN))[l * NIN + p] = s1; ((float*)(ws + WS_C2IN))[l * NIN + p] = s2; }
    for (int e = gt; e < 4 * FFD; e += NGT) { const int l = e / FFD, p = e % FFD; const float* cs = (const float*)(ws + WS_CSUP) + (size_t)l * 32 * FFD + p; float s1 = 0.f, s2 = 0.f;
#pragma unroll
        for (int kb = 0; kb < 16; ++kb) { s1 += cs[(size_t)(2 * kb) * FFD]; s2 += cs[(size_t)(2 * kb + 1) * FFD]; }
        ((float*)(ws + WS_C1UP))[l * FFD + p] = s1; ((float*)(ws + WS_C2UP))[l * FFD + p] = s2; }
}
constexpr int VPITCH = 144;
constexpr int ATT_WLDS = 2 * 32 * VPITCH + 256;
DI void tr_read8(unsigned base, s16x4 (&t)[8]) {
    asm volatile("ds_read_b64_tr_b16 %0, %8\n\tds_read_b64_tr_b16 %1, %8 offset:%c9\n\tds_read_b64_tr_b16 %2, %8 offset:%c10\n\tds_read_b64_tr_b16 %3, %8 offset:%c11\n\t"
                 "ds_read_b64_tr_b16 %4, %8 offset:%c12\n\tds_read_b64_tr_b16 %5, %8 offset:%c13\n\tds_read_b64_tr_b16 %6, %8 offset:%c14\n\tds_read_b64_tr_b16 %7, %8 offset:%c15\n\ts_waitcnt lgkmcnt(0)"
                 : "=&v"(t[0]), "=&v"(t[1]), "=&v"(t[2]), "=&v"(t[3]), "=&v"(t[4]), "=&v"(t[5]), "=&v"(t[6]), "=&v"(t[7])
                 : "v"(base), "i"(8 * VPITCH), "i"(64), "i"(8 * VPITCH + 64), "i"(16 * VPITCH), "i"(24 * VPITCH), "i"(16 * VPITCH + 64), "i"(24 * VPITCH + 64) : "memory");
}
DI void attn_task(const bf16* QB, const bf16* KB, const bf16* VB, bf16* OP, float* LSE, int b, int h, int p, int cls, int qblk, LAS unsigned char* wl, int lane) {
    asm volatile("" : "+v"(lane));
    const int dd = 1 << (2 * p), r32 = lane & 31, hi = lane >> 5;
    const int m0 = 32 * qblk;
    const size_t rowb = (size_t)b * TSEQ;
    const size_t qrow = rowb + (size_t)(m0 + r32) * dd + cls;
    bf16x8 qf[4];
#pragma unroll
    for (int d0 = 0; d0 < 4; ++d0) qf[d0] = ld8(QB + qrow * 512 + h * 64 + d0 * 16 + hi * 8);
    f32x16 s[5];
    const int kt0 = (m0 >= 128) ? 0 : (128 - m0) / 32;
    bf16x8 kf[5][4];
#pragma unroll
    for (int kt = 0; kt < 5; ++kt) {
        const int mk = m0 - 128 + 32 * kt + r32;
        const size_t krow = rowb + (size_t)(mk < 0 ? 0 : mk) * dd + cls;
#pragma unroll
        for (int d0 = 0; d0 < 4; ++d0) kf[kt][d0] = ld8(KB + krow * 512 + h * 64 + d0 * 16 + hi * 8);
    }
#pragma unroll
    for (int kt = 0; kt < 5; ++kt) {
        f32x16 a; for (int i = 0; i < 16; ++i) a[i] = 0.f;
#pragma unroll
        for (int d0 = 0; d0 < 4; ++d0) a = mfma32(kf[kt][d0], qf[d0], a);
        s[kt] = a;
    }
#pragma unroll
    for (int kt = 0; kt < 5; ++kt) {
        if (kt < kt0) {
#pragma unroll
            for (int i = 0; i < 16; ++i) s[kt][i] = -INFINITY;
        } else if (kt == 0) {
#pragma unroll
            for (int i = 0; i < 16; ++i) s[kt][i] = (crow(i, hi) >= r32) ? s[kt][i] : -INFINITY;
        } else if (kt == 4) {
#pragma unroll
            for (int i = 0; i < 16; ++i) s[kt][i] = (crow(i, hi) <= r32) ? s[kt][i] : -INFINITY;
        }
    }
    float mx = -INFINITY;
#pragma unroll
    for (int kt = 0; kt < 5; ++kt)
#pragma unroll
        for (int i = 0; i < 16; ++i) mx = fmaxf(mx, s[kt][i]);
    mx = fmaxf(mx, __shfl_xor(mx, 32));
    float lsum = 0.f;
#pragma unroll
    for (int kt = 0; kt < 5; ++kt)
#pragma unroll
        for (int i = 0; i < 16; ++i) { const float e = __builtin_amdgcn_exp2f(s[kt][i] - mx); s[kt][i] = e; lsum += e; }
    lsum += __shfl_xor(lsum, 32);
    f32x16 o[2]; for (int i = 0; i < 16; ++i) { o[0][i] = 0.f; o[1][i] = 0.f; }
    LAS float* wsf = (LAS float*)(wl + 2 * 32 * VPITCH);
    const unsigned vb0 = (unsigned)(uintptr_t)wl;
    const int g = lane >> 4, i16 = lane & 15, qq = i16 >> 2, pp = i16 & 3;
    const unsigned traddr = (unsigned)((4 * (g >> 1) + qq) * VPITCH + (16 * (g & 1) + 4 * pp) * 2);
    const int vkey = lane >> 1, vhalf = lane & 1;
    v4u vr[4];
#define ATT_LOADV(KT) do { const int mk_ = m0 - 128 + 32 * (KT) + vkey; const size_t vrow_ = rowb + (size_t)mk_ * dd + cls; const v4u* src_ = (const v4u*)(VB + vrow_ * 512 + h * 64 + vhalf * 32); \
        vr[0] = src_[0]; vr[1] = src_[1]; vr[2] = src_[2]; vr[3] = src_[3]; } while (0)
    ATT_LOADV(kt0);
#pragma unroll
    for (int kt = 0; kt < 5; ++kt) {
        if (kt >= kt0) {
            LAS unsigned char* vb = wl + (kt & 1) * 32 * VPITCH;
            { LAS v4u* dst = (LAS v4u*)(vb + vkey * VPITCH + vhalf * 64); dst[0] = vr[0]; dst[1] = vr[1]; dst[2] = vr[2]; dst[3] = vr[3]; }
            if (kt + 1 < 5) ATT_LOADV(kt + 1);
            LDS_WAIT();
            const unsigned base = vb0 + (unsigned)((kt & 1) * 32 * VPITCH) + traddr;
            s16x4 t[8];
            tr_read8(base, t);
#pragma unroll
            for (int ss = 0; ss < 2; ++ss) {
                const bf16x8 pa = pk8(s[kt][8 * ss], s[kt][8 * ss + 1], s[kt][8 * ss + 2], s[kt][8 * ss + 3], s[kt][8 * ss + 4], s[kt][8 * ss + 5], s[kt][8 * ss + 6], s[kt][8 * ss + 7]);
#pragma unroll
                for (int db = 0; db < 2; ++db) { const bf16x8 vf = __builtin_shufflevector(t[4 * ss + 2 * db], t[4 * ss + 2 * db + 1], 0, 1, 2, 3, 4, 5, 6, 7); o[db] = mfma32(pa, vf, o[db]); }
            }
        }
    }
#undef ATT_LOADV
    if (hi == 0) { wsf[r32] = __builtin_amdgcn_rcpf(lsum); LSE[((size_t)p * M + qrow) * 8 + h] = mx + __builtin_amdgcn_logf(lsum); }
    LDS_WAIT();
#pragma unroll
    for (int i = 0; i < 16; ++i) { const int q = crow(i, hi); const float li = wsf[q]; const size_t orow = rowb + (size_t)(m0 + q) * dd + cls;
        bf16* op = OP + ((size_t)p * M + orow) * 512 + h * 64 + r32;
        op[0] = (bf16)pk2z(o[0][i] * li); op[32] = (bf16)pk2z(o[1][i] * li); }
    LDS_WAIT();
}
DI void attn_finalize_row(const bf16* OP, const float* LSE, const float* gain, bf16* MIX, int row, int lane) {
    asm volatile("" : "+v"(lane));
    const int h = lane >> 3;
    float l0 = LSE[((size_t)0 * M + row) * 8 + h], l1 = LSE[((size_t)1 * M + row) * 8 + h], l2 = LSE[((size_t)2 * M + row) * 8 + h];
    const float mx = fmaxf(l0, fmaxf(l1, l2));
    float w0 = __builtin_amdgcn_exp2f(l0 - mx), w1 = __builtin_amdgcn_exp2f(l1 - mx), w2 = __builtin_amdgcn_exp2f(l2 - mx);
    const float inv = __builtin_amdgcn_rcpf(w0 + w1 + w2); w0 *= inv; w1 *= inv; w2 *= inv;
    const v4u a = *(const v4u*)(OP + ((size_t)0 * M + row) * 512 + lane * 8), b = *(const v4u*)(OP + ((size_t)1 * M + row) * 512 + lane * 8), c = *(const v4u*)(OP + ((size_t)2 * M + row) * 512 + lane * 8);
    float v[8]; float ss = 0.f;
#pragma unroll
    for (int j = 0; j < 4; ++j) { v[2 * j] = w0 * bflo(a[j]) + w1 * bflo(b[j]) + w2 * bflo(c[j]); v[2 * j + 1] = w0 * bfhi(a[j]) + w1 * bfhi(b[j]) + w2 * bfhi(c[j]); ss += v[2 * j] * v[2 * j] + v[2 * j + 1] * v[2 * j + 1]; }
    ss = wave_sum(ss);
    const float rinv = 1.0f / sqrtf(ss * (1.f / 512.f) + RMS_EPS);
    const f32x4 g0 = *(const f32x4*)(gain + lane * 8), g1 = *(const f32x4*)(gain + lane * 8 + 4);
    v4u w; w.x = pk2(v[0] * rinv * g0[0], v[1] * rinv * g0[1]); w.y = pk2(v[2] * rinv * g0[2], v[3] * rinv * g0[3]); w.z = pk2(v[4] * rinv * g1[0], v[5] * rinv * g1[1]); w.w = pk2(v[6] * rinv * g1[2], v[7] * rinv * g1[3]);
    *(v4u*)(MIX + (size_t)row * 1024 + lane * 8) = w;
}
constexpr int B1_IMG = 2048, B1_WLDS = 5 * B1_IMG + 1024;
DI float dpp_shr(float x, int n) { int v;
    switch (n) { case 1: v = __builtin_amdgcn_update_dpp(0, __builtin_bit_cast(int, x), 0x111, 0xf, 0xf, true); break; case 2: v = __builtin_amdgcn_update_dpp(0, __builtin_bit_cast(int, x), 0x112, 0xf, 0xf, true); break;
                 case 4: v = __builtin_amdgcn_update_dpp(0, __builtin_bit_cast(int, x), 0x114, 0xf, 0xf, true); break; default: v = __builtin_amdgcn_update_dpp(0, __builtin_bit_cast(int, x), 0x118, 0xf, 0xf, true); break; }
    return __builtin_bit_cast(float, v); }
DI float dpp_shr1(float x, int n) { int v; const int one = 0x3f800000;
    switch (n) { case 1: v = __builtin_amdgcn_update_dpp(one, __builtin_bit_cast(int, x), 0x111, 0xf, 0xf, false); break; case 2: v = __builtin_amdgcn_update_dpp(one, __builtin_bit_cast(int, x), 0x112, 0xf, 0xf, false); break;
                 case 4: v = __builtin_amdgcn_update_dpp(one, __builtin_bit_cast(int, x), 0x114, 0xf, 0xf, false); break; default: v = __builtin_amdgcn_update_dpp(one, __builtin_bit_cast(int, x), 0x118, 0xf, 0xf, false); break; }
    return __builtin_bit_cast(float, v); }
struct RwkvP {
    const bf16* PR; const float* mu; const float* muv;
    const float *dbase, *ibase, *vbase, *ksk, *ksa, *brk, *gng, *gnb;
    const bf16 *dupT, *iupT, *vupT, *gupT;
    const bf16* ZROW; bf16 *VF, *VV; float* BON; float* GC; bf16 *W1S, *REFF, *BM; v4u* REC; float* YPRE; bf16* MIX; int layer0;
};
DI void lerp8(const bf16* crow_, const bf16* prow_, int col, const float* mu, float (&z)[8]) {
    const v4u cur = *(const v4u*)(crow_ + col); const v4u prv = *(const v4u*)(prow_ + col);
    const f32x4 m0 = *(const f32x4*)(mu), m1 = *(const f32x4*)(mu + 4);
#pragma unroll
    for (int j = 0; j < 4; ++j) { const float a = bflo(cur[j]), b = bfhi(cur[j]), pa = bflo(prv[j]), pb = bfhi(prv[j]); const float ma = j < 2 ? m0[2 * j] : m1[2 * j - 4], mb = j < 2 ? m0[2 * j + 1] : m1[2 * j - 3];
        z[2 * j] = a + (pa - a) * ma; z[2 * j + 1] = b + (pb - b) * mb; }
}
DI f32x4 lerp4(const bf16* crow_, const bf16* prow_, int col, const float* mu) {
    const v2u cur = *(const v2u*)(crow_ + col); const v2u prv = *(const v2u*)(prow_ + col);
    const f32x4 m = *(const f32x4*)(mu);
    f32x4 z; z[0] = bflo(cur.x) + (bflo(prv.x) - bflo(cur.x)) * m[0]; z[1] = bfhi(cur.x) + (bfhi(prv.x) - bfhi(cur.x)) * m[1];
    z[2] = bflo(cur.y) + (bflo(prv.y) - bflo(cur.y)) * m[2]; z[3] = bfhi(cur.y) + (bfhi(prv.y) - bfhi(cur.y)) * m[3]; return z;
}
DI void img_write(LAS unsigned char* img, const f32x4 (&x)[4], int fr, int fq) {
#pragma unroll
    for (int mb = 0; mb < 4; ++mb)
#pragma unroll
        for (int reg = 0; reg < 4; ++reg) *(LAS bf16*)(img + (16 * mb + 4 * fq + reg) * 32 + fr * 2) = (bf16)pk2z(x[mb][reg]);
}
DI bf16x8 lds4z(const LAS unsigned char* p) { const v2u t = *(const LAS v2u*)p; v4u w; w.x = t.x; w.y = t.y; w.z = 0u; w.w = 0u; return __builtin_bit_cast(bf16x8, w); }
DI void rwkv_b1_unit(const RwkvP& P, int unit, LAS unsigned char* wl, int lane) {
    asm volatile("" : "+v"(lane));
    const int fr = lane & 15, fq = lane >> 4;
    const int seq = unit >> 9, c = unit & 511, b = seq >> 3, h = seq & 7;
    const size_t row = (size_t)b * TSEQ + 16 * c + fr;
    const bool hasprev = (c | fr) != 0;
    const bf16* crp = P.PR + row * PRP; const bf16* prp = hasprev ? crp - PRP : P.ZROW;
    const f32x4 z4 = {0.f, 0.f, 0.f, 0.f};
    bf16x8 tw[2], al[2], vl;
#pragma unroll
    for (int ks = 0; ks < 2; ++ks) { float z[8]; lerp8(crp, prp, 1536 + 8 * fq + 32 * ks, P.mu + 1536 + 8 * fq + 32 * ks, z);
        tw[ks] = pk8(ftanh(z[0]), ftanh(z[1]), ftanh(z[2]), ftanh(z[3]), ftanh(z[4]), ftanh(z[5]), ftanh(z[6]), ftanh(z[7]));
        lerp8(crp, prp, 1600 + 8 * fq + 32 * ks, P.mu + 1600 + 8 * fq + 32 * ks, z); al[ks] = pk8(z[0], z[1], z[2], z[3], z[4], z[5], z[6], z[7]); }
    if (!P.layer0) { float z[8]; lerp8(crp, prp, 1792 + 8 * fq, P.muv + 8 * fq, z); vl = pk8(z[0], z[1], z[2], z[3], z[4], z[5], z[6], z[7]); }
    f32x4 zr[4], k2[4], kk[4], ai[4], ld[4];
    float nrm = 0.f, bon = 0.f;
#pragma unroll
    for (int mb = 0; mb < 4; ++mb) { const int ch = h * 64 + 16 * mb + 4 * fq; const int n = h * 64 + 16 * mb + fr;
        f32x4 dw = z4, da = z4, dv = z4;
        dw = mfma16(ld8(P.dupT + (size_t)n * 64 + 8 * fq), tw[0], dw); dw = mfma16(ld8(P.dupT + (size_t)n * 64 + 8 * fq + 32), tw[1], dw);
        da = mfma16(ld8(P.iupT + (size_t)n * 64 + 8 * fq), al[0], da); da = mfma16(ld8(P.iupT + (size_t)n * 64 + 8 * fq + 32), al[1], da);
        if (!P.layer0) dv = mfma16(ld8(P.vupT + (size_t)n * 32 + 8 * fq), vl, z4);
        zr[mb] = lerp4(crp, prp, ch, P.mu + ch);
        const f32x4 zk = lerp4(crp, prp, 512 + ch, P.mu + 512 + ch);
        f32x4 zv = lerp4(crp, prp, 1024 + ch, P.mu + 1024 + ch);
        const f32x4 db = *(const f32x4*)(P.dbase + ch), ib = *(const f32x4*)(P.ibase + ch), sk = *(const f32x4*)(P.ksk + ch), sa = *(const f32x4*)(P.ksa + ch), br = *(const f32x4*)(P.brk + ch);
        if (P.layer0) { v2u w; w.x = pk2(zv[0], zv[1]); w.y = pk2(zv[2], zv[3]); *(v2u*)(P.VF + row * 512 + ch) = w; }
        else { const v2u f = *(const v2u*)(P.VF + row * 512 + ch); const f32x4 vb = *(const f32x4*)(P.vbase + ch); const f32x4 vf = {bflo(f.x), bfhi(f.x), bflo(f.y), bfhi(f.y)};
#pragma unroll
            for (int e = 0; e < 4; ++e) zv[e] = zv[e] + (vf[e] - zv[e]) * fsigmoid(vb[e] + dv[e]); }
        { v2u w; w.x = pk2(zv[0], zv[1]); w.y = pk2(zv[2], zv[3]); *(v2u*)(P.VV + row * 512 + ch) = w; }
#pragma unroll
        for (int reg = 0; reg < 4; ++reg) *(LAS bf16*)(wl + 2 * B1_IMG + (16 * mb + 4 * fq + reg) * 32 + fr * 2) = (bf16)pk2z(zv[reg]);
#pragma unroll
        for (int e = 0; e < 4; ++e) {
            ld[mb][e] = fexp(-0.60653065971f * fsigmoid(db[e] + dw[e]));
            const float a = fsigmoid(ib[e] + da[e]); ai[mb][e] = a;
            const float kr = zk[e] * sk[e]; kk[mb][e] = kr; nrm += kr * kr;
            const float kx = zk[e] * (1.f + (a - 1.f) * sa[e]); k2[mb][e] = kx; bon += zr[mb][e] * kx * br[e]; }
        asm volatile("" ::: "memory");
    }
    nrm += __shfl_xor(nrm, 16); nrm += __shfl_xor(nrm, 32); bon += __shfl_xor(bon, 16); bon += __shfl_xor(bon, 32);
    if (fq == 0) P.BON[row * 8 + h] = bon;
    const float kinv = 1.0f / fmaxf(sqrtf(nrm), 1e-12f);
    f32x4 rt[4], kh[4];
    bf16x8 pa[2], pb[2], pk[2], pr[2];
#pragma unroll
    for (int ks = 0; ks < 2; ++ks) {
        f32x4 at2[2], bt2[2], kt2[2];
#pragma unroll
        for (int m2 = 0; m2 < 2; ++m2) { const int mb = 2 * ks + m2;
            f32x4 gcv, bhv;
#pragma unroll
            for (int e = 0; e < 4; ++e) {
                float gm = ld[mb][e]; gm *= dpp_shr1(gm, 1); gm *= dpp_shr1(gm, 2); gm *= dpp_shr1(gm, 4); gm *= dpp_shr1(gm, 8);
                const float gc = __shfl(gm, lane | 15), gp = dpp_shr1(gm, 1), gi = __builtin_amdgcn_rcpf(gm), ec = gc * gi;
                const float kn = kk[mb][e] * kinv, bb = kn * ai[mb][e];
                at2[m2][e] = -kn * gp; bt2[m2][e] = bb * gi; kt2[m2][e] = k2[mb][e] * gi; rt[mb][e] = zr[mb][e] * gm;
                bhv[e] = bb * ec; kh[mb][e] = k2[mb][e] * ec; gcv[e] = gc; }
            if (fr == 0) *(f32x4*)(P.GC + (size_t)unit * 64 + 16 * mb + 4 * fq) = gcv;
#pragma unroll
            for (int reg = 0; reg < 4; ++reg) { const int o = (16 * mb + 4 * fq + reg) * 32 + fr * 2;
                *(LAS bf16*)(wl + 0 * B1_IMG + o) = (bf16)pk2z(at2[m2][reg]); *(LAS bf16*)(wl + 1 * B1_IMG + o) = (bf16)pk2z(bhv[reg]); }
        }
        pa[ks] = pk8v(at2[0], at2[1]); pb[ks] = pk8v(bt2[0], bt2[1]); pk[ks] = pk8v(kt2[0], kt2[1]); pr[ks] = pk8v(rt[2 * ks], rt[2 * ks + 1]);
    }
    const f32x4 z4b = {0.f, 0.f, 0.f, 0.f};
    f32x4 Aab = mfma16(pb[1], pa[1], mfma16(pb[0], pa[0], z4b));
    f32x4 AakT = mfma16(pa[1], pk[1], mfma16(pa[0], pk[0], z4b));
    f32x4 Arb = mfma16(pb[1], pr[1], mfma16(pb[0], pr[0], z4b));
    f32x4 Ark = mfma16(pk[1], pr[1], mfma16(pk[0], pr[0], z4b));
#pragma unroll
    for (int e = 0; e < 4; ++e) { const int rr = 4 * fq + e; Aab[e] = rr < fr ? Aab[e] : 0.f; AakT[e] = fr < rr ? AakT[e] : 0.f; Arb[e] = rr <= fr ? Arb[e] : 0.f; Ark[e] = rr <= fr ? Ark[e] : 0.f; }
    LAS float* As = (LAS float*)(wl + 5 * B1_IMG);
#pragma unroll
    for (int e = 0; e < 4; ++e) As[(4 * fq + e) * 16 + fr] = Aab[e];
    LDS_WAIT();
    float x[16];
#pragma unroll
    for (int s = 15; s >= 0; --s) { float acc = (s == fr) ? 1.f : 0.f;
        const f32x4 r0 = *(const LAS f32x4*)(As + s * 16), r1 = *(const LAS f32x4*)(As + s * 16 + 4), r2 = *(const LAS f32x4*)(As + s * 16 + 8), r3 = *(const LAS f32x4*)(As + s * 16 + 12);
        const float rowv[16] = {r0[0], r0[1], r0[2], r0[3], r1[0], r1[1], r1[2], r1[3], r2[0], r2[1], r2[2], r2[3], r3[0], r3[1], r3[2], r3[3]};
#pragma unroll
        for (int uu = s + 1; uu < 16; ++uu) acc += rowv[uu] * x[uu];
        x[s] = acc; if ((s & 1) == 0) asm volatile("" ::: "memory"); }
    f32x4 xs;
#pragma unroll
    for (int e = 0; e < 4; ++e) xs[e] = fq == 0 ? x[e] : fq == 1 ? x[4 + e] : fq == 2 ? x[8 + e] : x[12 + e];
    const bf16x8 Tsel = pk4z(xs);
    f32x4 W1[4];
#pragma unroll
    for (int mb = 0; mb < 4; ++mb) W1[mb] = mfma16(lds4z(wl + 0 * B1_IMG + (16 * mb + fr) * 32 + 8 * fq), Tsel, z4);
    const f32x4 GT = mfma16(Tsel, pk4z(AakT), z4);
    img_write(wl + 3 * B1_IMG, W1, fr, fq);
    f32x4 M1T[4];
    const bf16x8 GTp = pk4z(GT);
#pragma unroll
    for (int mb = 0; mb < 4; ++mb) M1T[mb] = mfma16(lds4z(wl + 1 * B1_IMG + (16 * mb + fr) * 32 + 8 * fq), GTp, kh[mb]);
    img_write(wl + 4 * B1_IMG, M1T, fr, fq);
    LDS_WAIT();
    const bf16x8 Arbp = pk4z(Arb);
    f32x4 RE[4];
#pragma unroll
    for (int mb = 0; mb < 4; ++mb) RE[mb] = mfma16(lds4z(wl + 3 * B1_IMG + (16 * mb + fr) * 32 + 8 * fq), Arbp, rt[mb]);
    const f32x4 M2 = mfma16(GTp, Arbp, Ark);
    {   bf16* w1s = P.W1S + ((size_t)unit * 16 + fr) * 64; bf16* re = P.REFF + ((size_t)unit * 16 + fr) * 64;
#pragma unroll
        for (int mb = 0; mb < 4; ++mb) { const int sg = (mb >> 1) * 32 + fq * 8 + (mb & 1) * 4;
            v2u w; w.x = pk2(W1[mb][0], W1[mb][1]); w.y = pk2(W1[mb][2], W1[mb][3]); *(v2u*)(w1s + sg) = w;
            w.x = pk2(RE[mb][0], RE[mb][1]); w.y = pk2(RE[mb][2], RE[mb][3]); *(v2u*)(re + sg) = w; }
        const v2u m2p = {pk2(M2[0], M2[1]), pk2(M2[2], M2[3])};
#pragma unroll
        for (int mb = 0; mb < 4; ++mb) {
            const v2u bq = *(const LAS v2u*)(wl + 1 * B1_IMG + (16 * mb + fr) * 32 + 8 * fq), mq = *(const LAS v2u*)(wl + 4 * B1_IMG + (16 * mb + fr) * 32 + 8 * fq);
            *(v4u*)(P.BM + (((size_t)unit * 64 + 16 * mb + fr) * 4 + fq) * 8) = (v4u){bq.x, bq.y, mq.x, mq.y};
            const v2u vq = *(const LAS v2u*)(wl + 2 * B1_IMG + (16 * mb + fr) * 32 + 8 * fq);
            P.REC[((size_t)unit * 4 + mb) * 64 + lane] = (v4u){vq.x, vq.y, m2p.x, m2p.y}; }
    }
    LDS_WAIT();
}
constexpr int NSEG = 16, SEGCH = NCH / NSEG;
struct ChainIn { bf16x8 w1[2], re[2], bm[4]; v4u rec; f32x4 gc[4]; };
template <int MODE> DI void chain_load(ChainIn& c, const RwkvP& P, int unit, int rb, int lane) {
    const int fr = lane & 15, fq = lane >> 4;
    const bf16* w1s = P.W1S + ((size_t)unit * 16 + fr) * 64 + fq * 8;
    c.w1[0] = ld8(w1s); c.w1[1] = ld8(w1s + 32);
    if (MODE == 2) { const bf16* re = P.REFF + ((size_t)unit * 16 + fr) * 64 + fq * 8; c.re[0] = ld8(re); c.re[1] = ld8(re + 32); }
#pragma unroll
    for (int mb = 0; mb < 4; ++mb) { c.bm[mb] = ld8(P.BM + (((size_t)unit * 64 + 16 * mb + fr) * 4 + fq) * 8); c.gc[mb] = *(const f32x4*)(P.GC + (size_t)unit * 64 + 16 * mb + 4 * fq); }
    if (MODE != 1) c.rec = P.REC[((size_t)unit * 4 + rb) * 64 + lane];
}
template <int MODE> DI void chain_step(f32x4 (&S)[4], const ChainIn& c, float* ypre  ) {
    const f32x4 z4 = {0.f, 0.f, 0.f, 0.f};
    const bf16x8 b0 = pk8v(S[0], S[1]), b1 = pk8v(S[2], S[3]);
    f32x4 ut = mfma16(c.w1[1], b1, mfma16(c.w1[0], b0, z4));
    if (MODE == 2) {
        v4u vlo; vlo.x = c.rec.x; vlo.y = c.rec.y; vlo.z = 0u; vlo.w = 0u;
        v4u m2a; m2a.x = c.rec.z; m2a.y = c.rec.w; m2a.z = 0u; m2a.w = 0u;
        f32x4 y = mfma16(__builtin_bit_cast(bf16x8, m2a), __builtin_bit_cast(bf16x8, vlo), z4);
        y = mfma16(c.re[0], b0, y); y = mfma16(c.re[1], b1, y);
#pragma unroll
        for (int e = 0; e < 4; ++e) ypre[(size_t)e * 512] = y[e];
    }
    v4u uv; uv.x = pk2(ut[0], ut[1]); uv.y = pk2(ut[2], ut[3]); uv.z = MODE == 1 ? 0u : c.rec.x; uv.w = MODE == 1 ? 0u : c.rec.y;
    const bf16x8 ub = __builtin_bit_cast(bf16x8, uv);
#pragma unroll
    for (int mb = 0; mb < 4; ++mb) S[mb] = mfma16(c.bm[mb], ub, S[mb] * c.gc[mb]);
}
template <int MODE> DI void chain_run(f32x4 (&S)[4], const RwkvP& P, int unit0, int nsteps  , int rb, float* yp, int lane) {
    ChainIn c0, c1, c2;
    chain_load<MODE>(c0, P, unit0, rb, lane); chain_load<MODE>(c1, P, unit0 + 1, rb, lane);
    int c = 0;
    for (; c + 3 <= nsteps; c += 3) {
        chain_load<MODE>(c2, P, unit0 + c + 2, rb, lane);
        chain_step<MODE>(S, c0, yp + (size_t)c * 16 * 512);
        if (c + 3 < nsteps) chain_load<MODE>(c0, P, unit0 + c + 3, rb, lane);
        chain_step<MODE>(S, c1, yp + (size_t)(c + 1) * 16 * 512);
        if (c + 4 < nsteps) chain_load<MODE>(c1, P, unit0 + c + 4, rb, lane);
        chain_step<MODE>(S, c2, yp + (size_t)(c + 2) * 16 * 512);
    }
    if (c < nsteps) { chain_step<MODE>(S, c0, yp + (size_t)c * 16 * 512); ++c; }
    if (c < nsteps) { chain_step<MODE>(S, c1, yp + (size_t)c * 16 * 512); ++c; }
}
template <int MODE> DI void chain_run2(f32x4 (&S)[4], const RwkvP& P, int unit0, int nsteps  , int rb, float* yp, int lane) {
    ChainIn ca, cb;
    chain_load<MODE>(ca, P, unit0, rb, lane);
    for (int c = 0; c < nsteps; c += 2) {
        chain_load<MODE>(cb, P, unit0 + c + 1, rb, lane);
        asm volatile("" ::: "memory");
        chain_step<MODE>(S, ca, yp + (size_t)c * 16 * 512);
        if (c + 2 < nsteps) chain_load<MODE>(ca, P, unit0 + c + 2, rb, lane);
        asm volatile("" ::: "memory");
        chain_step<MODE>(S, cb, yp + (size_t)(c + 1) * 16 * 512);
    }
}
DI void chain_pass1(const RwkvP& P, float* QSEG, float* PSEGT, int seq, int g, int part, int rb, int lane) {
    const int fr = lane & 15, fq = lane >> 4;
    f32x4 S[4];
#pragma unroll
    for (int mb = 0; mb < 4; ++mb)
#pragma unroll
        for (int e = 0; e < 4; ++e) S[mb][e] = (part == 1 && (16 * mb + 4 * fq + e) == (16 * rb + fr)) ? 1.f : 0.f;
    const int unit0 = seq * NCH + g * SEGCH;
    if (part == 0) chain_run2<0>(S, P, unit0, SEGCH, rb, nullptr, lane); else chain_run2<1>(S, P, unit0, SEGCH, rb, nullptr, lane);
    const size_t sb = ((size_t)seq * NSEG + g) * 4096;
    if (part == 0) {
#pragma unroll
        for (int mb = 0; mb < 4; ++mb) *(f32x4*)(QSEG + sb + (size_t)(16 * rb + fr) * 64 + 16 * mb + 4 * fq) = S[mb];
    } else {
#pragma unroll
        for (int mb = 0; mb < 4; ++mb)
#pragma unroll
            for (int e = 0; e < 4; ++e) PSEGT[sb + (size_t)(16 * mb + 4 * fq + e) * 64 + 16 * rb + fr] = S[mb][e];
    }
}
DI void split_hl(const f32x4 a, const f32x4 b, bf16x8& hi, bf16x8& lo) {
    f32x4 ah, bh;
#pragma unroll
    for (int e = 0; e < 4; ++e) { ah[e] = rbf(a[e]); bh[e] = rbf(b[e]); }
    hi = pk8v(ah, bh); lo = pk8v(a - ah, b - bh);
}
DI void chain_pass23(const RwkvP& P, const float* QSEG, const float* PSEGT, int seq, int g, int rb, float* wkv_out, int lane) {
    const int fr = lane & 15, fq = lane >> 4, b = seq >> 3, h = seq & 7;
    f32x4 S[4]; for (int mb = 0; mb < 4; ++mb) S[mb] = (f32x4){0.f, 0.f, 0.f, 0.f};
    f32x4 pc[4][2][2], pn[4][2][2];
#define P2_LOAD(PD_, GP_) do { const size_t sb_ = ((size_t)seq * NSEG + (GP_)) * 4096; _Pragma("unroll") for (int mb = 0; mb < 4; ++mb) { \
        _Pragma("unroll") for (int ks = 0; ks < 2; ++ks) { const float* pr_ = PSEGT + sb_ + (size_t)(16 * mb + fr) * 64 + 32 * ks + 4 * fq; PD_[mb][ks][0] = *(const f32x4*)pr_; PD_[mb][ks][1] = *(const f32x4*)(pr_ + 16); } } } while (0)
    if (g > 0) P2_LOAD(pc, 0);
    for (int gp = 0; gp < g; ++gp) {
        f32x4 qc[4];
        { const size_t sb_ = ((size_t)seq * NSEG + gp) * 4096;
#pragma unroll
          for (int mb = 0; mb < 4; ++mb) qc[mb] = *(const f32x4*)(QSEG + sb_ + (size_t)(16 * rb + fr) * 64 + 16 * mb + 4 * fq); }
        if (gp + 1 < g) P2_LOAD(pn, gp + 1);
        bf16x8 bh[2], bl[2]; split_hl(S[0], S[1], bh[0], bl[0]); split_hl(S[2], S[3], bh[1], bl[1]);
#pragma unroll
        for (int mb = 0; mb < 4; ++mb) { f32x4 acc = {0.f, 0.f, 0.f, 0.f};
#pragma unroll
            for (int ks = 0; ks < 2; ++ks) { bf16x8 ah, al; split_hl(pc[mb][ks][0], pc[mb][ks][1], ah, al);
                acc = mfma16(ah, bh[ks], acc); acc = mfma16(al, bh[ks], acc); acc = mfma16(ah, bl[ks], acc); }
            S[mb] = acc + qc[mb]; }
#pragma unroll
        for (int mb = 0; mb < 4; ++mb) {
#pragma unroll
            for (int ks = 0; ks < 2; ++ks) { pc[mb][ks][0] = pn[mb][ks][0]; pc[mb][ks][1] = pn[mb][ks][1]; } }
    }
#undef P2_LOAD
    float* yp = P.YPRE + ((size_t)b * TSEQ + (size_t)g * SEGCH * 16 + 4 * fq) * 512 + h * 64 + 16 * rb + fr;
    chain_run<2>(S, P, seq * NCH + g * SEGCH, SEGCH, rb, yp, lane);
    if (g == NSEG - 1) {
#pragma unroll
        for (int mb = 0; mb < 4; ++mb) *(f32x4*)(wkv_out + (size_t)(16 * rb + fr) * 64 + 16 * mb + 4 * fq) = S[mb];
    }
}
DI void rwkv_b3_unit(const RwkvP& P, int unit, int lane) {
    asm volatile("" : "+v"(lane));
    const int fr = lane & 15, fq = lane >> 4;
    const int seq = unit >> 9, c = unit & 511, b = seq >> 3, h = seq & 7;
    const size_t row = (size_t)b * TSEQ + 16 * c + fr;
    const bool hasprev = (c | fr) != 0;
    const bf16* crp = P.PR + row * PRP; const bf16* prp = hasprev ? crp - PRP : P.ZROW;
    const f32x4 z4 = {0.f, 0.f, 0.f, 0.f};
    bf16x8 sg[4];
#pragma unroll
    for (int ks = 0; ks < 4; ++ks) { float z[8]; lerp8(crp, prp, 1664 + 8 * fq + 32 * ks, P.mu + 1664 + 8 * fq + 32 * ks, z);
        sg[ks] = pk8(fsigmoid(z[0]), fsigmoid(z[1]), fsigmoid(z[2]), fsigmoid(z[3]), fsigmoid(z[4]), fsigmoid(z[5]), fsigmoid(z[6]), fsigmoid(z[7])); }
    f32x4 g[4], y[4]; float s = 0.f;
#pragma unroll
    for (int mb = 0; mb < 4; ++mb) { const int n = h * 64 + 16 * mb + fr; f32x4 a = z4;
#pragma unroll
        for (int ks = 0; ks < 4; ++ks) a = mfma16(ld8(P.gupT + (size_t)n * 128 + 8 * fq + 32 * ks), sg[ks], a);
        g[mb] = a;
        y[mb] = *(const f32x4*)(P.YPRE + row * 512 + h * 64 + 16 * mb + 4 * fq); s += (y[mb][0] + y[mb][1]) + (y[mb][2] + y[mb][3]); }
    s += __shfl_xor(s, 16); s += __shfl_xor(s, 32);
    const float mean = s * (1.f / 64.f); float q = 0.f;
#pragma unroll
    for (int mb = 0; mb < 4; ++mb) { y[mb] = y[mb] - mean; q += (y[mb][0] * y[mb][0] + y[mb][1] * y[mb][1]) + (y[mb][2] * y[mb][2] + y[mb][3] * y[mb][3]); }
    q += __shfl_xor(q, 16); q += __shfl_xor(q, 32);
    const float rstd = 1.0f / sqrtf(q * (1.f / 64.f) + GN_EPS);
    const float bon = P.BON[row * 8 + h];
#pragma unroll
    for (int mb = 0; mb < 4; ++mb) { const int ch = h * 64 + 16 * mb + 4 * fq;
        const f32x4 gg = *(const f32x4*)(P.gng + ch), gb = *(const f32x4*)(P.gnb + ch); const v2u vw = *(const v2u*)(P.VV + row * 512 + ch);
        const f32x4 v = {bflo(vw.x), bfhi(vw.x), bflo(vw.y), bfhi(vw.y)};
        const f32x4 o = (y[mb] * rstd * gg + gb + v * bon) * g[mb];
        v2u w; w.x = pk2(o[0], o[1]); w.y = pk2(o[2], o[3]); *(v2u*)(P.MIX + row * 1024 + 512 + ch) = w; }
}
DI f32x16 dec_gemm(const bf16* A, const bf16* Wt, int K, LAS float* red  , int wave, int lane) {
    const int r = lane & 31, h = lane >> 5, kw = K >> 3;
    const bf16* ap = A + (size_t)r * K + wave * kw + 8 * h; const bf16* bp = Wt + (size_t)r * K + wave * kw + 8 * h;
    f32x16 acc; for (int i = 0; i < 16; ++i) acc[i] = 0.f;
#pragma unroll 16
    for (int k = 0; k < kw; k += 16) acc = mfma32(ld8(ap + k), ld8(bp + k), acc);
    __syncthreads();
#pragma unroll
    for (int i = 0; i < 16; ++i) red[(wave * 16 + i) * 64 + lane] = acc[i];
    __syncthreads();
    if (wave == 0) {
#pragma unroll
        for (int i = 0; i < 16; ++i) { float s = 0.f;
#pragma unroll
            for (int w = 0; w < 8; ++w) s += red[(w * 16 + i) * 64 + lane];
            asm volatile("" : "+v"(s) :: "memory"); acc[i] = s; } }
    return acc;
}
DI void dec_row_stats(const float* st, LAS float* sc, int lane) {
    if (lane < 32) { float s = 0.f, q = 0.f; const f32x4* p = (const f32x4*)(st + (size_t)lane * 64);
#pragma unroll
        for (int i = 0; i < 16; ++i) { const f32x4 v = p[i]; s += v[0] + v[2]; q += v[1] + v[3]; if ((i & 3) == 3) asm volatile("" : "+v"(s), "+v"(q) :: "memory"); }
        const float mu = s * (1.f / 1024.f), var = fmaxf(q * (1.f / 1024.f) - mu * mu, 0.f); sc[2 * lane] = mu; sc[2 * lane + 1] = 1.0f / sqrtf(var + LN_EPS); }
    LDS_WAIT();
}
struct DecP {
    unsigned char* dec; int l;
    const float* xs;
    const float *c1in, *c2in, *c1up, *c2up, *g1, *b1, *g2p, *b2p;
    const bf16 *win, *winu, *wout, *wup, *wdn;
    float* out;
};
DI void dec_unit_in(const DecP& D, int u, LAS float* red, LAS float* sc, int wave, int lane) {
    const int r32 = lane & 31, hi = lane >> 5;
    if (u < 105) {
        const int n = 32 * u + r32; const bool fold = D.l > 0;
        const f32x16 acc = dec_gemm((const bf16*)(D.dec + DEC_XB2), D.win + (size_t)(32 * u) * DM, DM, red, wave, lane);
        if (wave != 0) return;
        if (fold) dec_row_stats((const float*)(D.dec + DEC_ST2), sc, lane);
        const float c1 = fold ? D.c1in[n] : 0.f, c2 = fold ? D.c2in[n] : 0.f; const int on = n < 1024 ? swap45(n) : n;
        float* PD = (float*)(D.dec + DEC_PD);
#pragma unroll
        for (int i = 0; i < 16; ++i) { const int row = crow(i, hi); float mu = 0.f, rs = 1.f; if (fold) { mu = sc[2 * row]; rs = sc[2 * row + 1]; } PD[(size_t)row * NIN + on] = (acc[i] - mu * c1) * rs + c2; }
    } else {
        const int v = u - 105, n = 32 * v + r32;
        const f32x16 acc = dec_gemm((const bf16*)(D.dec + DEC_SHB) + (size_t)D.l * MD * DM, D.winu + (size_t)(32 * v) * DM, DM, red, wave, lane);
        if (wave != 0) return;
        float* PS = (float*)(D.dec + DEC_PS);
#pragma unroll
        for (int i = 0; i < 16; ++i) PS[(size_t)crow(i, hi) * NRWU + n] = acc[i];
    }
    LDS_WAIT();
}
DI void dec_unit_res(const bf16* A, const bf16* Wt, int K, int u, bool raw, const float* src, const float* sstat, const float* g, const float* b, float* T, bf16* XB, float* ostat, float* shiftout, LAS float* red, LAS float* sc, int wave, int lane) {
    const int r32 = lane & 31, hi = lane >> 5, n = 32 * u + r32;
    const f32x16 acc = dec_gemm(A, Wt + (size_t)(32 * u) * K, K, red, wave, lane);
    if (wave != 0) return;
    if (!raw) dec_row_stats(sstat, sc, lane);
    const float gg = raw ? 1.f : g[n], bb = raw ? 0.f : b[n];
#pragma unroll
    for (int i = 0; i < 16; ++i) { const int row = crow(i, hi); float mu = 0.f, rs = 1.f; if (!raw) { mu = sc[2 * row]; rs = sc[2 * row + 1]; }
        const float x = (src[(size_t)row * DM + n] - mu) * rs * gg + bb; const float t = ALPHA * x + acc[i];
        T[(size_t)row * DM + n] = t; XB[(size_t)row * DM + n] = (bf16)f2bf(t); if (shiftout) shiftout[(size_t)row * DM + n] = x;
        float s = t, q = t * t;
#pragma unroll
        for (int o = 1; o < 32; o <<= 1) { s += __shfl_xor(s, o); q += __shfl_xor(q, o); }
        if (r32 == 0) { ostat[((size_t)row * 32 + u) * 2] = s; ostat[((size_t)row * 32 + u) * 2 + 1] = q; } }
    LDS_WAIT();
}
DI void dec_unit_up(const DecP& D, int u, LAS float* red, LAS float* sc, int wave, int lane) {
    const int r32 = lane & 31, hi = lane >> 5, n = 32 * u + r32;
    const f32x16 acc = dec_gemm((const bf16*)(D.dec + DEC_XB1), D.wup + (size_t)(32 * u) * DM, DM, red, wave, lane);
    if (wave != 0) return;
    dec_row_stats((const float*)(D.dec + DEC_ST1), sc, lane);
    const float c1 = D.c1up[n], c2 = D.c2up[n]; bf16* HB = (bf16*)(D.dec + DEC_HB);
#pragma unroll
    for (int i = 0; i < 16; ++i) { const int row = crow(i, hi); const float v = fmaxf((acc[i] - sc[2 * row] * c1) * sc[2 * row + 1] + c2, 0.f); HB[(size_t)row * FFD + n] = (bf16)f2bf(v * v); }
    LDS_WAIT();
}
DI void dec_attn_task(const DecP& D, const float* ck, const float* cv, const float* rope, int bd, int h, int p, int lane) {
    const int g = lane >> 4, dq = lane & 15, dd = 1 << (2 * p);
    const float* PD = (const float*)(D.dec + DEC_PD) + (size_t)bd * NIN;
    const f32x4 rr0 = *(const f32x4*)(rope + ((size_t)8192 * 32 + ((4 * dq) & 31)) * 2), rr1 = *(const f32x4*)(rope + ((size_t)8192 * 32 + ((4 * dq) & 31)) * 2 + 4);
    const f32x4 cs = {rr0[0], rr0[2], rr1[0], rr1[2]}, sn = {rr0[1], rr0[3], rr1[1], rr1[3]};
    const float sgn = dq < 8 ? -1.f : 1.f;
    f32x4 q = *(const f32x4*)(PD + h * 64 + 4 * dq), kn = *(const f32x4*)(PD + 512 + h * 64 + 4 * dq); const f32x4 vn = *(const f32x4*)(PD + 1024 + h * 64 + 4 * dq);
    { f32x4 qp, kp;
#pragma unroll
      for (int e = 0; e < 4; ++e) { qp[e] = __shfl_xor(q[e], 8); kp[e] = __shfl_xor(kn[e], 8); }
      q = q * cs + qp * sn * sgn; kn = kn * cs + kp * sn * sgn; }
    if (p == 0 && g == 0) { *(f32x4*)(D.out + O_KS + ((size_t)D.l * MD + bd) * 512 + h * 64 + 4 * dq) = kn; *(f32x4*)(D.out + O_VS + ((size_t)D.l * MD + bd) * 512 + h * 64 + 4 * dq) = vn; }
    float s0 = (q[0] * kn[0] + q[1] * kn[1]) + (q[2] * kn[2] + q[3] * kn[3]);
#pragma unroll
    for (int o = 1; o < 16; o <<= 1) s0 += __shfl_xor(s0, o);
    s0 *= 0.125f;
    const size_t cbase = (((size_t)D.l * MD + bd) * 2048) * 512 + h * 64 + 4 * dq;
    float mx = -INFINITY, den = 0.f; f32x4 o4 = {0.f, 0.f, 0.f, 0.f};
#pragma unroll 8
    for (int it = 0; it < 32; ++it) { const int j = 1 + 4 * it + g; const size_t off = cbase + (size_t)(2048 - j * dd) * 512;
        const f32x4 kr = *(const f32x4*)(ck + off); const f32x4 vr = *(const f32x4*)(cv + off);
        float s = (q[0] * kr[0] + q[1] * kr[1]) + (q[2] * kr[2] + q[3] * kr[3]);
#pragma unroll
        for (int o = 1; o < 16; o <<= 1) s += __shfl_xor(s, o);
        s *= 0.125f;
        const float mn = fmaxf(mx, s), sc = fexp(mx - mn), pj = fexp(s - mn);
        den = den * sc + pj; o4 = o4 * sc + vr * pj; mx = mn; }
    float mg = fmaxf(mx, __shfl_xor(mx, 16)); mg = fmaxf(mg, __shfl_xor(mg, 32)); mg = fmaxf(mg, s0);
    { const float sc = fexp(mx - mg); den *= sc; o4 = o4 * sc; }
    den += __shfl_xor(den, 16); den += __shfl_xor(den, 32);
#pragma unroll
    for (int e = 0; e < 4; ++e) { o4[e] += __shfl_xor(o4[e], 16); o4[e] += __shfl_xor(o4[e], 32); }
    const float p0 = fexp(s0 - mg); den += p0; o4 = (o4 + vn * p0) * (1.0f / den); mx = mg;
    if (g == 0) *(f32x4*)((float*)(D.dec + DEC_OP) + ((size_t)p * MD + bd) * 512 + h * 64 + 4 * dq) = o4;
    if (lane == 0) ((float*)(D.dec + DEC_LSE))[((size_t)p * MD + bd) * 8 + h] = mx + __logf(den);
}
DI void dec_rwkv_task(const DecP& D, const float* const* in, int bd, int h, LAS float* sv  , int lane) {
    const int l = D.l, ch = h * 64 + lane;
    const float* PD = (const float*)(D.dec + DEC_PD) + (size_t)bd * NIN + RW0; const float* PS = (const float*)(D.dec + DEC_PS) + (size_t)bd * NRWU;
    const float* mu = in[8] + (size_t)l * 1792;
    auto zf = [&](int col) { const float pr = PD[col], pv = PS[col]; return pr + (pv - pr) * mu[col]; };
    const float zr = zf(ch), zk = zf(512 + ch), zv0 = zf(1024 + ch);
    float vl = 0.f; if (l > 0 && lane < 32) { const float pr = PD[1792 + lane], pv = PS[1792 + lane]; vl = pr + (pv - pr) * in[9][(size_t)(l - 1) * 32 + lane]; }
    sv[lane] = ftanh(zf(1536 + lane)); sv[64 + lane] = zf(1600 + lane); sv[128 + lane] = fsigmoid(zf(1664 + lane)); sv[192 + lane] = fsigmoid(zf(1728 + lane)); sv[256 + lane] = vl;
    LDS_WAIT();
    float dw = 0.f, da = 0.f, dv = 0.f, gt = 0.f;
    const float* du = in[11] + (size_t)l * 64 * 512 + ch; const float* iu = in[13] + (size_t)l * 64 * 512 + ch; const float* gu = in[14] + (size_t)l * 128 * 512 + ch;
#pragma unroll 2
    for (int m4 = 0; m4 < 16; ++m4) { const f32x4 a = *(const LAS f32x4*)(sv + 4 * m4), b = *(const LAS f32x4*)(sv + 64 + 4 * m4), c = *(const LAS f32x4*)(sv + 128 + 4 * m4), d = *(const LAS f32x4*)(sv + 192 + 4 * m4);
#pragma unroll
        for (int e = 0; e < 4; ++e) { const int m = 4 * m4 + e; dw += a[e] * du[(size_t)m * 512]; da += b[e] * iu[(size_t)m * 512]; gt += c[e] * gu[(size_t)m * 512] + d[e] * gu[(size_t)(64 + m) * 512]; } }
    if (l > 0) { const float* vu = in[16] + (size_t)(l - 1) * 32 * 512 + ch;
#pragma unroll
        for (int m4 = 0; m4 < 8; ++m4) { const f32x4 a = *(const LAS f32x4*)(sv + 256 + 4 * m4);
#pragma unroll
            for (int e = 0; e < 4; ++e) dv += a[e] * vu[(size_t)(4 * m4 + e) * 512]; } }
    const float w = -fsoftplus(-(in[10][(size_t)l * 512 + ch] + dw)) - 0.5f, decay = fexp(-fexp(w));
    const float a = fsigmoid(in[12][(size_t)l * 512 + ch] + da);
    float* VFD = (float*)(D.dec + DEC_VF) + (size_t)bd * 512 + ch;
    float v = zv0; if (l == 0) *VFD = zv0; else v = zv0 + (*VFD - zv0) * fsigmoid(in[15][(size_t)(l - 1) * 512 + ch] + dv);
    const float kr = zk * in[17][(size_t)l * 512 + ch]; const float kn = kr / fmaxf(sqrtf(wave_sum(kr * kr)), 1e-12f);
    const float k2 = zk * (1.f + (a - 1.f) * in[18][(size_t)l * 512 + ch]);
    const float bon = wave_sum(zr * k2 * in[19][(size_t)l * 512 + ch]);
    LDS_WAIT();
    sv[320 + lane] = -kn; sv[384 + lane] = decay; sv[448 + lane] = kn * a; sv[512 + lane] = k2; sv[576 + lane] = zr;
    LDS_WAIT();
    const float* S0 = in[3] + ((((size_t)l * MD + bd) * NH + h) * 64 + lane) * 64;
    float* So = D.out + O_WKS + ((((size_t)l * MD + bd) * NH + h) * 64 + lane) * 64;
    float sa = 0.f;
    { f32x4 Sr[16];
#pragma unroll
      for (int q = 0; q < 16; ++q) Sr[q] = *(const f32x4*)(S0 + 4 * q);
#pragma unroll
      for (int q = 0; q < 16; ++q) { const f32x4 a4 = *(const LAS f32x4*)(sv + 320 + 4 * q); sa += (Sr[q][0] * a4[0] + Sr[q][1] * a4[1]) + (Sr[q][2] * a4[2] + Sr[q][3] * a4[3]); } }
    asm volatile("" ::: "memory");
    float y = 0.f;
#pragma unroll 8
    for (int q = 0; q < 16; ++q) { const f32x4 s0 = *(const f32x4*)(S0 + 4 * q); const f32x4 w4 = *(const LAS f32x4*)(sv + 384 + 4 * q), b4 = *(const LAS f32x4*)(sv + 448 + 4 * q), k4 = *(const LAS f32x4*)(sv + 512 + 4 * q), r4 = *(const LAS f32x4*)(sv + 576 + 4 * q);
        const f32x4 s4 = s0 * w4 + b4 * sa + k4 * v; *(f32x4*)(So + 4 * q) = s4; y += (s4[0] * r4[0] + s4[1] * r4[1]) + (s4[2] * r4[2] + s4[3] * r4[3]); }
    const float mean = wave_sum(y) * (1.f / 64.f), dy = y - mean, var = wave_sum(dy * dy) * (1.f / 64.f);
    const float o = (dy * (1.0f / sqrtf(var + GN_EPS)) * in[20][(size_t)l * 512 + ch] + in[21][(size_t)l * 512 + ch] + bon * v) * gt;
    ((float*)(D.dec + DEC_MIX))[(size_t)bd * DM + 512 + ch] = o;
    LDS_WAIT();
}
DI void dec_finalize_row(const DecP& D, const float* gain, int bd, int lane) {
    const int h = lane >> 3; const float* L = (const float*)(D.dec + DEC_LSE); const float* OPD = (const float*)(D.dec + DEC_OP);
    const float l0 = L[((size_t)0 * MD + bd) * 8 + h], l1 = L[((size_t)1 * MD + bd) * 8 + h], l2 = L[((size_t)2 * MD + bd) * 8 + h];
    const float mx = fmaxf(l0, fmaxf(l1, l2)); float w0 = fexp(l0 - mx), w1 = fexp(l1 - mx), w2 = fexp(l2 - mx); const float inv = 1.0f / (w0 + w1 + w2); w0 *= inv; w1 *= inv; w2 *= inv;
    float v[8]; float ss = 0.f;
#pragma unroll
    for (int e = 0; e < 8; ++e) { v[e] = w0 * OPD[((size_t)0 * MD + bd) * 512 + lane * 8 + e] + w1 * OPD[((size_t)1 * MD + bd) * 512 + lane * 8 + e] + w2 * OPD[((size_t)2 * MD + bd) * 512 + lane * 8 + e]; ss += v[e] * v[e]; }
    ss = wave_sum(ss); const float rinv = 1.0f / sqrtf(ss * (1.f / 512.f) + RMS_EPS);
    bf16* MB = (bf16*)(D.dec + DEC_MIXB) + (size_t)bd * DM; const float* MX = (const float*)(D.dec + DEC_MIX) + (size_t)bd * DM + 512;
#pragma unroll
    for (int e = 0; e < 8; ++e) { MB[lane * 8 + e] = (bf16)f2bf(v[e] * rinv * gain[lane * 8 + e]); MB[512 + lane * 8 + e] = (bf16)f2bf(MX[lane * 8 + e]); }
}
#ifndef PH_MASK
#define PH_MASK 0x1ff
#endif
#define PH_ON(k) ((PH_MASK >> (k)) & 1)
#ifndef PH_DUP
#define PH_DUP 0
#endif
#define PH_REP(k) for (int rep_ = 0; rep_ < (((PH_DUP >> (k)) & 1) ? 2 : 1); ++rep_)
DI unsigned lds_task_next(volatile LAS unsigned* ctr, int lane) {
    unsigned t = 0; if (lane == 0) t = __hip_atomic_fetch_add((LAS unsigned*)ctr, 1u, __ATOMIC_RELAXED, __HIP_MEMORY_SCOPE_WORKGROUP);
    return (unsigned)__builtin_amdgcn_readfirstlane((int)t);
}
DI DecP make_dec(unsigned char* ws, const float* const* in, float* out, int l) {
    DecP D; D.dec = ws + WS_DEC; D.l = l; D.xs = in[1];
    D.c1in = (const float*)(ws + WS_C1IN) + l * NIN; D.c2in = (const float*)(ws + WS_C2IN) + l * NIN; D.c1up = (const float*)(ws + WS_C1UP) + l * FFD; D.c2up = (const float*)(ws + WS_C2UP) + l * FFD;
    D.g1 = in[24] + (size_t)l * DM; D.b1 = in[25] + (size_t)l * DM; D.g2p = l > 0 ? in[28] + (size_t)(l - 1) * DM : nullptr; D.b2p = l > 0 ? in[29] + (size_t)(l - 1) * DM : nullptr;
    D.win = (const bf16*)(ws + WS_WIN) + (size_t)l * NIN * DM; D.winu = (const bf16*)(ws + WS_WINU) + (size_t)l * NRWU * DM; D.wout = (const bf16*)(ws + WS_WOUT) + (size_t)l * DM * DM;
    D.wup = (const bf16*)(ws + WS_WUP) + (size_t)l * FFD * DM; D.wdn = (const bf16*)(ws + WS_WDN) + (size_t)l * DM * FFD; D.out = out; return D;
}
DI RwkvP make_rwkv(unsigned char* ws, const float* const* in, int l) {
    RwkvP R; R.PR = (const bf16*)(ws + WS_PR); R.mu = in[8] + (size_t)l * 1792; R.muv = l > 0 ? in[9] + (size_t)(l - 1) * 32 : nullptr;
    R.dbase = in[10] + (size_t)l * 512; R.ibase = in[12] + (size_t)l * 512; R.vbase = l > 0 ? in[15] + (size_t)(l - 1) * 512 : nullptr; R.ksk = in[17] + (size_t)l * 512; R.ksa = in[18] + (size_t)l * 512; R.brk = in[19] + (size_t)l * 512;
    R.gng = in[20] + (size_t)l * 512; R.gnb = in[21] + (size_t)l * 512;
    R.dupT = (const bf16*)(ws + WS_DUPT) + (size_t)l * 512 * 64; R.iupT = (const bf16*)(ws + WS_IUPT) + (size_t)l * 512 * 64; R.vupT = l > 0 ? (const bf16*)(ws + WS_VUPT) + (size_t)(l - 1) * 512 * 32 : nullptr; R.gupT = (const bf16*)(ws + WS_GUPT) + (size_t)l * 512 * 128;
    R.ZROW = (const bf16*)(ws + WS_CTL + 512 * 1024); R.VF = (bf16*)(ws + WS_VF); R.VV = (bf16*)(ws + WS_VV); R.BON = (float*)(ws + WS_BON); R.GC = (float*)(ws + WS_GC); R.W1S = (bf16*)(ws + WS_PT); R.REFF = (bf16*)(ws + WS_REFF); R.BM = (bf16*)(ws + WS_QT); R.REC = (v4u*)(ws + WS_YLOC);
    R.YPRE = (float*)(ws + WS_YPRE); R.MIX = (bf16*)(ws + WS_MIX); R.layer0 = (l == 0); return R;
}
#define PHASE_VARS() int tid_p = (int)threadIdx.x; asm volatile("" : "+v"(tid_p)); const int lane = tid_p & 63; const int wave = __builtin_amdgcn_readfirstlane(tid_p >> 6); \
    unsigned zo_p; asm volatile("s_mov_b32 %0, 0" : "=s"(zo_p)); unsigned char* ws = args.ws + zo_p; const float* const* in = args.in + zo_p; float* out = args.out + zo_p; \
    const int gw = F.vcu * NWAVES + wave; const int rgw = (F.G - 1 - (int)blockIdx.x) * NWAVES + wave; LAS float* dsc = (LAS float*)(L3 + 65536); LAS float* dred = (LAS float*)L3; const int rwg = F.G - 1 - (int)blockIdx.x; (void)gw; (void)rgw; (void)dsc; (void)dred; (void)rwg; (void)lane; (void)in; (void)out
__global__ void __launch_bounds__(NWAVES * 64, 2) mega_fwd(Args args) {
    extern __shared__ __attribute__((aligned(16))) unsigned char lds[];
    Frame F;
    F.lds = lds; F.MISC = (volatile LAS unsigned*)((LAS unsigned char*)lds + MISC_OFF);
    F.tid = threadIdx.x; F.lane = F.tid & 63; F.wave = __builtin_amdgcn_readfirstlane(F.tid >> 6);
    F.G = gridDim.x; { const int bx = blockIdx.x; F.vcu = (F.G % 8 == 0) ? (bx % 8) * (F.G / 8) + bx / 8 : bx; }
    F.gw = F.vcu * NWAVES + F.wave; F.NGW = F.G * NWAVES;
    F.in = args.in; F.out = args.out; F.ws = args.ws; F.ctl = (gu32*)(args.ws + WS_CTL);
    LAS unsigned char* L3 = (LAS unsigned char*)lds;
    for (int u = F.tid; u < (LDS_BYTES - RING_BYTES) / 4; u += NWAVES * 64) ((LAS unsigned*)(L3 + RING_BYTES))[u] = 0u;
    __syncthreads();
    XcdBarrier bar = xcd_barrier_post((unsigned*)(F.ctl + CW_BAR), F.MISC + 8);
#define GRID_BAR() do { XcdBarrier b2_ = bar; asm volatile("" : "+s"(b2_.x)); xcd_barrier(b2_); } while (0)

    PH_REP(0) { if (PH_ON(0)) p0_prologue(F);
    GRID_BAR(); }

    for (int l = 0; l < DEPTH; ++l) {
        PH_REP(1) {
        if (PH_ON(1))
        {   PHASE_VARS(); const DecP D = make_dec(ws, in, out, l);
            pg8::Gemm g{(const pg8::bf16_t*)(ws + WS_XB2), (const pg8::bf16_t*)D.win, M, NIN, DM}; pg8::StaticOrder S; S.init(M, NIN, F.G, (int)blockIdx.x);
            pg8::EpiIn E{ws, out, l};
            pg8::gemm_phase<pg8::EpiIn, pg8::StaticOrder, true, true>((PG8_LAS unsigned char*)L3, g, S, E, tid_p);
            for (int u = rwg; u < 162; u += F.G) dec_unit_in(D, u, dred, dsc, wave, lane);
        }
        GRID_BAR();
        }

#define ATT_QUEUE() do { LAS unsigned char* wl_ = L3 + wave * 10240; const int bh_ = F.vcu >> 4, span_ = F.vcu & 15; \
        for (;;) { const unsigned t_ = lds_task_next(F.MISC, lane); if (t_ >= 48u) break; \
            if (t_ >= 48u) { const int dt_ = (int)blockIdx.x * 4 + (int)(t_ - 48u); \
                if (dt_ < 768) dec_attn_task(D, in[4], in[5], (const float*)(ws + WS_ROPE), dt_ / 24, (dt_ % 24) / 3, dt_ % 3, lane); \
                else dec_rwkv_task(D, in, (dt_ - 768) >> 3, (dt_ - 768) & 7, (LAS float*)wl_, lane); continue; } \
            const int p_ = (int)t_ >> 4, idx_ = (int)t_ & 15; \
            const int cls_ = p_ == 0 ? 0 : p_ == 1 ? (idx_ >> 2) : idx_, qblk_ = p_ == 0 ? span_ * 16 + idx_ : p_ == 1 ? span_ * 4 + (idx_ & 3) : span_; \
            attn_task((const bf16*)(ws + WS_QB), (const bf16*)(ws + WS_KB), (const bf16*)(ws + WS_VB), (bf16*)(ws + WS_OP), (float*)(ws + WS_LSE), bh_ >> 3, bh_ & 7, p_, cls_, qblk_, wl_, lane); } } while (0)
        PH_REP(3) {
        if (PH_ON(3))
        {   PHASE_VARS(); const DecP D = make_dec(ws, in, out, l); const RwkvP R = make_rwkv(ws, in, l);
            if (tid_p == 0) F.MISC[0] = 0u;
            if (l == 0) colsum_finish(ws, gw * 64 + lane, F.NGW * 64);
            { LAS unsigned char* wl1 = L3 + wave * 12288;
#pragma unroll 1
              for (int i = 0; i < 4; ++i) rwkv_b1_unit(R, F.vcu * 32 + wave + 8 * i, wl1, lane); }
            VM_WAIT(); __syncthreads();
            if (wave >= 4) { const int dt = (int)blockIdx.x * 4 + (wave - 4);
                if (dt < 768) dec_attn_task(D, in[4], in[5], (const float*)(ws + WS_ROPE), dt / 24, (dt % 24) / 3, dt % 3, lane);
                else dec_rwkv_task(D, in, (dt - 768) >> 3, (dt - 768) & 7, (LAS float*)(L3 + wave * 10240), lane); }
            PH_REP(13) chain_pass1(R, (float*)(ws + WS_SEGQ), (float*)(ws + WS_SEGP), F.vcu >> 4, F.vcu & 15, wave >> 2, wave & 3, lane);
            ATT_QUEUE();
            if ((PH_DUP >> 12) & 1) { __syncthreads(); if (tid_p == 0) F.MISC[0] = 0u; __syncthreads(); ATT_QUEUE(); }
        }
        GRID_BAR();
        }
        PH_REP(9) {
        if (PH_ON(3))
        {   PHASE_VARS(); const DecP D = make_dec(ws, in, out, l); const RwkvP R = make_rwkv(ws, in, l);
            const int seq = F.vcu >> 4, sg = F.vcu & 15;
            if (wave < 4) chain_pass23(R, (const float*)(ws + WS_SEGQ), (const float*)(ws + WS_SEGP), seq, sg, wave, out + O_WKP + ((size_t)l * 16 + seq) * 4096, lane);
            else { for (int i = 0; i < 16; ++i) attn_finalize_row((const bf16*)(ws + WS_OP), (const float*)(ws + WS_LSE), in[22] + (size_t)l * 512, (bf16*)(ws + WS_MIX), (int)blockIdx.x * 64 + (wave - 4) * 16 + i, lane);
                if (blockIdx.x < MD && wave == 4) dec_finalize_row(D, in[22] + (size_t)l * 512, (int)blockIdx.x, lane); }
            VM_WAIT(); __syncthreads();
#pragma unroll 1
            for (int i = 0; i < 4; ++i) rwkv_b3_unit(R, seq * NCH + sg * SEGCH + wave + 8 * i, lane);
        }
        GRID_BAR();
        }

        PH_REP(5) {
        if (PH_ON(5))
        {   PHASE_VARS(); const DecP D = make_dec(ws, in, out, l);
            pg8::Gemm g{(const pg8::bf16_t*)(ws + WS_MIX), (const pg8::bf16_t*)D.wout, M, DM, DM}; pg8::StaticOrder S; S.init(M, DM, F.G, (int)blockIdx.x);
            pg8::EpiRes<false> E{ws, in, out, l};
            pg8::gemm_phase<pg8::EpiRes<false>, pg8::StaticOrder, false, true>((PG8_LAS unsigned char*)L3, g, S, E, tid_p);
            for (int u = rwg; u < 32; u += F.G)
                dec_unit_res((const bf16*)(D.dec + DEC_MIXB), D.wout, DM, u, l == 0, l == 0 ? D.xs : (const float*)(D.dec + DEC_T2), (const float*)(D.dec + DEC_ST2), D.g2p, D.b2p, (float*)(D.dec + DEC_T1), (bf16*)(D.dec + DEC_XB1), (float*)(D.dec + DEC_ST1),
                             out + O_SHS + (size_t)l * MD * DM, dred, dsc, wave, lane);
        }
        GRID_BAR();
        }

        PH_REP(6) {
        if (PH_ON(6))
        {   PHASE_VARS(); const DecP D = make_dec(ws, in, out, l);
            pg8::Gemm g{(const pg8::bf16_t*)(ws + WS_XB1), (const pg8::bf16_t*)D.wup, M, FFD, DM}; pg8::StaticOrder S; S.init(M, FFD, F.G, (int)blockIdx.x);
            pg8::EpiUp E{ws, l};
            pg8::gemm_phase<pg8::EpiUp, pg8::StaticOrder, true, true>((PG8_LAS unsigned char*)L3, g, S, E, tid_p);
            for (int u = rwg; u < 128; u += F.G) dec_unit_up(D, u, dred, dsc, wave, lane);
        }
        GRID_BAR();
        }

        PH_REP(7) {
        if (PH_ON(7))
        {   PHASE_VARS(); const DecP D = make_dec(ws, in, out, l);
            pg8::Gemm g{(const pg8::bf16_t*)(ws + WS_H), (const pg8::bf16_t*)D.wdn, M, DM, FFD}; pg8::StaticOrder S; S.init(M, DM, F.G, (int)blockIdx.x);
            pg8::EpiRes<true> E{ws, in, out, l};
            PH_REP(11) { pg8::gemm_phase<pg8::EpiRes<true>, pg8::StaticOrder, false, true>((PG8_LAS unsigned char*)L3, g, S, E, tid_p); }
            PH_REP(10) for (int u = rwg; u < 32; u += F.G)
                dec_unit_res((const bf16*)(D.dec + DEC_HB), D.wdn, FFD, u, false, (const float*)(D.dec + DEC_T1), (const float*)(D.dec + DEC_ST1), D.g1, D.b1, (float*)(D.dec + DEC_T2), (bf16*)(D.dec + DEC_XB2), (float*)(D.dec + DEC_ST2), nullptr, dred, dsc, wave, lane);
        }
        GRID_BAR();
        }
    }
    if (PH_ON(8))
    {   PHASE_VARS(); const float* g = in[28] + (size_t)3 * DM; const float* b = in[29] + (size_t)3 * DM;
        for (int r = gw; r < M; r += F.NGW) { float mu, rs; pg8::row_stats((const float*)(ws + WS_STAT2), r, mu, rs);
            const v2u* t = (const v2u*)((const bf16*)(ws + WS_XB2) + (size_t)r * DM) + lane; f32x4* o = (f32x4*)(out + O_Y + (size_t)r * DM) + lane;
#pragma unroll
            for (int j = 0; j < 4; ++j) { const f32x4 gg = *((const f32x4*)g + lane + 64 * j), bb = *((const f32x4*)b + lane + 64 * j); const v2u w = t[64 * j]; const f32x4 tv = {bflo(w.x), bfhi(w.x), bflo(w.y), bfhi(w.y)}; o[64 * j] = (tv - mu) * rs * gg + bb; } }
        if (rgw < MD) { LAS float* fsc = dsc + wave * 64; dec_row_stats((const float*)(ws + WS_DEC + DEC_ST2), fsc, lane); const float mu = fsc[2 * rgw], rs = fsc[2 * rgw + 1];
            const f32x4* t = (const f32x4*)((const float*)(ws + WS_DEC + DEC_T2) + (size_t)rgw * DM) + lane; f32x4* o = (f32x4*)(out + O_YS + (size_t)rgw * DM) + lane;
#pragma unroll
            for (int j = 0; j < 4; ++j) { const f32x4 gg = *((const f32x4*)g + lane + 64 * j), bb = *((const f32x4*)b + lane + 64 * j); o[64 * j] = (t[64 * j] - mu) * rs * gg + bb; } }
    }
}

extern "C" void kernel_launch(void* const* d_in, const int* in_sizes, int n_in, void* d_out, int out_size, void* d_ws, size_t ws_size, hipStream_t stream) {
    static int grid = 0;
    if (grid == 0) {
        if (n_in != 30 || out_size != (int)O_END || ws_size < WS_END) { fprintf(stderr, "kernel_launch: unexpected problem (n_in %d, out %d, ws %zu); nothing launched\n", n_in, out_size, ws_size); grid = -1; return; }
        int dev = 0, cus = 0, per_cu = 0;
        if (hipGetDevice(&dev) != hipSuccess || hipDeviceGetAttribute(&cus, hipDeviceAttributeMultiprocessorCount, dev) != hipSuccess) { fprintf(stderr, "kernel_launch: device query failed\n"); grid = -1; return; }
        if (hipFuncSetAttribute((const void*)mega_fwd, hipFuncAttributeMaxDynamicSharedMemorySize, LDS_BYTES) != hipSuccess) { fprintf(stderr, "kernel_launch: hipFuncSetAttribute failed\n"); grid = -1; return; }
        if (hipOccupancyMaxActiveBlocksPerMultiprocessor(&per_cu, (const void*)mega_fwd, NWAVES * 64, LDS_BYTES) != hipSuccess || per_cu < 1) fprintf(stderr, "kernel_launch: occupancy query reports %d\n", per_cu);
        (void)hipGetLastError();
        if (cus < 256) { fprintf(stderr, "kernel_launch: needs 256 CUs (found %d)\n", cus); grid = -1; return; }
        grid = 256;
    }
    if (grid < 0) return;
    if (hipMemsetAsync((char*)d_ws + WS_CTL, 0, CTL_ZERO_BYTES, stream) != hipSuccess) { fprintf(stderr, "kernel_launch: memset failed\n"); return; }
    Args a{};
    for (int i = 0; i < 30; ++i) a.in[i] = (const float*)d_in[i];
    a.out = (float*)d_out; a.ws = (unsigned char*)d_ws;
    hipLaunchKernelGGL(mega_fwd, dim3(grid), dim3(NWAVES * 64), LDS_BYTES, stream, a);
    const hipError_t le = hipPeekAtLastError();
    if (le != hipSuccess) fprintf(stderr, "kernel_launch: launch failed: %s\n", hipGetErrorName(le));
}
```

```cpp
#include <hip/hip_runtime.h>
#include <cstdio>
#include <cstdint>
#include <cmath>
namespace pg8 {
#define PG8_LAS __attribute__((address_space(3)))
typedef unsigned short bf16_t;
typedef short bf16x8 __attribute__((ext_vector_type(8)));
typedef float f32x4 __attribute__((ext_vector_type(4)));
typedef unsigned u32x4 __attribute__((ext_vector_type(4)));
constexpr int BM = 256, BK = 64, HALF = 128, HTB = HALF * BK * 2  , STAGE_BYTES = 8 * HTB, NXCD = 8, WGM = 8;

__host__ __device__ __forceinline__ int lds_byte(int r, int c) { const int st = (r >> 4) * 2 + (c >> 5), rr = r & 15, cc = c & 31, ob = rr * 64 + cc * 2; return st * 1024 + (ob ^ (((ob >> 9) & 1) << 5)); }
__host__ __device__ __forceinline__ void stage_rc(int b, int& R, int& C) { const int st = b / 1024, sb = b % 1024, swz = sb ^ (((sb >> 9) & 1) << 5); R = (st >> 1) * 16 + swz / 64; C = (st & 1) * 32 + (swz % 64) / 2; }
__host__ __device__ __forceinline__ int perm32(int rho) { const int n = rho >> 4, i = rho & 15; return 8 * (i >> 2) + 4 * n + (i & 3); }

struct Unit { int pm, pn; };
struct Gemm { const bf16_t* A; const bf16_t* Bt; int M, N, K; };

struct StaticOrder {
    int nM, nN, nwg, G, c;
    __host__ __device__ void init(int M, int N, int G_, int c_) { nM = M / BM; nN = N / BM; nwg = nM * nN; G = G_; c = c_; }
    __host__ __device__ bool next(int i, Unit& u) const {
        const long L = (long)i * G + c; if (L >= nwg) return false;
        int wgid = (int)L; { const int q = nwg / NXCD, r = nwg % NXCD, xcd = wgid % NXCD, off = wgid / NXCD; wgid = (xcd < r ? xcd * (q + 1) : r * (q + 1) + (xcd - r) * q) + off; }
        const int nig = WGM * nN, gid = wgid / nig, fm = gid * WGM, gsz = (nM - fm) < WGM ? (nM - fm) : WGM;
        u.pm = fm + ((wgid % nig) % gsz); u.pn = (wgid % nig) / gsz; return true;
    }
    __device__ __forceinline__ void a_ready(const Unit&) const {}
    __device__ __forceinline__ void done(const Unit&) const {}
};

__device__ __forceinline__ unsigned cvt_pk_bf16(float lo, float hi) { unsigned r; asm volatile("v_cvt_pk_bf16_f32 %0, %1, %2" : "=v"(r) : "v"(lo), "v"(hi)); return r; }
typedef float f32x2 __attribute__((ext_vector_type(2)));
constexpr size_t WSO_C1IN = 1u << 20, WSO_C2IN = WSO_C1IN + 4 * 3584 * 4, WSO_C1UP = WSO_C2IN + 4 * 3584 * 4, WSO_C2UP = WSO_C1UP + 4 * 4096 * 4, WSO_ROPE = 3u << 20, WSO_STAT1 = 8u << 20, WSO_STAT2 = 9u << 20;
constexpr size_t WSO_XB2 = 132ull << 20, WSO_XB1 = 164ull << 20, WSO_T1 = 196ull << 20, WSO_T2 = 260ull << 20, WSO_QB = 324ull << 20, WSO_KB = 340ull << 20, WSO_VB = 356ull << 20, WSO_PR = 372ull << 20, WSO_H = 580ull << 20;
constexpr size_t OO_SHP = 16809984, OO_KP = 21405696, OO_VP = 29794304;
__device__ __forceinline__ void row_stats(const float* stat, int row, float& mu, float& rs) {
    const f32x4 a = *(const f32x4*)(stat + (size_t)row * 8), b = *(const f32x4*)(stat + (size_t)row * 8 + 4);
    const float s = (a[0] + a[2]) + (b[0] + b[2]), q = (a[1] + a[3]) + (b[1] + b[3]);
    mu = s * (1.f / 1024.f); const float var = fmaxf(q * (1.f / 1024.f) - mu * mu, 0.f); rs = 1.0f / sqrtf(var + 1e-5f);
}
typedef float f32x2e __attribute__((ext_vector_type(2)));
typedef unsigned u32x2e __attribute__((ext_vector_type(2)));
struct EpiIn {
    static constexpr bool PERM = false, AFTER_DRAIN = false;
    unsigned char* ws; float* out; int l;
    __device__ __forceinline__ void operator()(const f32x4 (&acc)[2][2][4][2], const Unit& u, int wr, int wc, int fr, int fq) const {
        asm volatile("" ::: "memory"); __builtin_amdgcn_sched_barrier(0);
        const int fold = l > 0; const float* stat = (const float*)(ws + WSO_STAT2); const float* c1 = (const float*)(ws + WSO_C1IN) + l * 3584; const float* c2 = (const float*)(ws + WSO_C2IN) + l * 3584;
        bf16_t* QB = (bf16_t*)(ws + WSO_QB); bf16_t* KB = (bf16_t*)(ws + WSO_KB); bf16_t* VB = (bf16_t*)(ws + WSO_VB); bf16_t* PR = (bf16_t*)(ws + WSO_PR); const float* rope = (const float*)(ws + WSO_ROPE);
        float* outk = out + OO_KP + (size_t)l * 2 * 2048 * 512; float* outv = out + OO_VP + (size_t)l * 2 * 2048 * 512; const float qscale = 0.125f * 1.4426950408889634f;
        const int cb = u.pn * BM + wc * 32 + 4 * fq;
        const int i0 = 16 * (wc & 1) + 4 * fq; const bool roped = u.pn < 4;
        const int rbase = u.pm * BM + wr * 64 + fr;
        float mu8[8], rs8[8];
#pragma unroll
        for (int gq = 0; gq < 8; ++gq) { mu8[gq] = 0.f; rs8[gq] = 1.f; if (fold) row_stats(stat, rbase + (gq >> 2) * HALF + (gq & 3) * 16, mu8[gq], rs8[gq]); }
#pragma unroll
        for (int bj = 0; bj < 2; ++bj) {
            f32x4 c1v[2], c2v[2];
#pragma unroll
            for (int n = 0; n < 2; ++n) { c1v[n] = fold ? *(const f32x4*)(c1 + cb + bj * HALF + n * 16) : (f32x4){0.f, 0.f, 0.f, 0.f}; c2v[n] = fold ? *(const f32x4*)(c2 + cb + bj * HALF + n * 16) : (f32x4){0.f, 0.f, 0.f, 0.f}; }
#pragma unroll
            for (int gq = 0; gq < 8; ++gq) {
                const int ai = gq >> 2, m = gq & 3;
                const int r = rbase + ai * HALF + m * 16;
                const float mu = mu8[gq], rs = rs8[gq];
                f32x4 ra = {0.f, 0.f, 0.f, 0.f}, rb = ra;
                if (roped) { const float* rp = rope + ((size_t)(r & 8191) * 32 + i0) * 2; ra = *(const f32x4*)rp; rb = *(const f32x4*)(rp + 4); }
                if ((gq & 3) == 3) asm volatile("" ::: "memory");
                f32x4 v[2];
#pragma unroll
                for (int n = 0; n < 2; ++n) v[n] = (acc[ai][bj][m][n] - mu * c1v[n]) * rs + c2v[n];
                const int pos = r & 8191, b = r >> 13;
                if (roped) {
                    const f32x4 cs = {ra[0], ra[2], rb[0], rb[2]}, sn = {ra[1], ra[3], rb[1], rb[3]};
                    const int head = (u.pn & 1) * 4 + bj * 2 + (wc >> 1);
                    f32x4 y1 = v[0] * cs - v[1] * sn, y2 = v[0] * sn + v[1] * cs;
                    const size_t o = (size_t)r * 512 + head * 64 + i0;
                    if (u.pn < 2) { y1 = y1 * qscale; y2 = y2 * qscale;
                        u32x2e w; w.x = cvt_pk_bf16(y1[0], y1[1]); w.y = cvt_pk_bf16(y1[2], y1[3]); *(u32x2e*)(QB + o) = w;
                        w.x = cvt_pk_bf16(y2[0], y2[1]); w.y = cvt_pk_bf16(y2[2], y2[3]); *(u32x2e*)(QB + o + 32) = w;
                    } else {
                        u32x2e w; w.x = cvt_pk_bf16(y1[0], y1[1]); w.y = cvt_pk_bf16(y1[2], y1[3]); *(u32x2e*)(KB + o) = w;
                        w.x = cvt_pk_bf16(y2[0], y2[1]); w.y = cvt_pk_bf16(y2[2], y2[3]); *(u32x2e*)(KB + o + 32) = w;
                        if (pos >= 6144) { float* ok = outk + ((size_t)(b * 2048 + pos - 6144)) * 512 + head * 64 + i0; *(f32x4*)ok = y1; *(f32x4*)(ok + 32) = y2; }
                    }
                } else if (u.pn < 6) {
#pragma unroll
                    for (int n = 0; n < 2; ++n) { const int c = cb + bj * HALF + n * 16 - 1024; const f32x4 x = v[n];
                        u32x2e w; w.x = cvt_pk_bf16(x[0], x[1]); w.y = cvt_pk_bf16(x[2], x[3]); *(u32x2e*)(VB + (size_t)r * 512 + c) = w;
                        if (pos >= 6144) *(f32x4*)(outv + ((size_t)(b * 2048 + pos - 6144)) * 512 + c) = x; }
                } else {
#pragma unroll
                    for (int n = 0; n < 2; ++n) { const int c = cb + bj * HALF + n * 16 - 1536; const f32x4 x = v[n];
                        if (c < 1824) { u32x2e w; w.x = cvt_pk_bf16(x[0], x[1]); w.y = cvt_pk_bf16(x[2], x[3]); *(u32x2e*)(PR + (size_t)r * 2048 + c) = w; } }
                }
            }
        }
    }
};
template <bool IS_F> struct EpiRes {
    static constexpr bool PERM = false, AFTER_DRAIN = true;
    unsigned char* ws; const float* const* in; float* out; int l;
    __device__ __forceinline__ void fused(f32x4 (&acc)[2][2][4][2], const Unit& u, int wr, int wc, int fr, int fq, PG8_LAS unsigned char* lds, int wid, int lane) const {
        const int raw = (!IS_F && l == 0) ? 1 : 0;
        const bf16_t* src = (const bf16_t*)(ws + (IS_F ? WSO_XB1 : WSO_XB2));
        const float* sstat = (const float*)(ws + (IS_F ? WSO_STAT1 : WSO_STAT2));
        const float* g = IS_F ? in[24] + (size_t)l * 1024 : in[28] + (size_t)(l > 0 ? l - 1 : 0) * 1024; const float* b = IS_F ? in[25] + (size_t)l * 1024 : in[29] + (size_t)(l > 0 ? l - 1 : 0) * 1024;
        bf16_t* XB = (bf16_t*)(ws + (IS_F ? WSO_XB2 : WSO_XB1)); float* ostat = (float*)(ws + (IS_F ? WSO_STAT2 : WSO_STAT1));
        float* shiftout = (IS_F || raw) ? nullptr : out + OO_SHP + (size_t)l * 2 * 1024; const float alpha = 1.6817928305074290f;
        PG8_LAS f32x2e* P = (PG8_LAS f32x2e*)lds;
        const int cb = u.pn * BM + wc * 32 + 4 * fq;
        const int rbase = u.pm * BM + wr * 64 + fr;
        u32x2e cur[2][2], nxt[2][2]; f32x4 sa = {0.f, 0.f, 0.f, 0.f}, sb = sa, san = sa, sbn = sa;
#pragma unroll
        for (int bj = 0; bj < 2; ++bj)
#pragma unroll
            for (int n = 0; n < 2; ++n) { cur[bj][n] = *(const u32x2e*)(src + (size_t)rbase * 1024 + cb + bj * HALF + n * 16); nxt[bj][n] = cur[bj][n]; }
        if (!raw) { sa = *(const f32x4*)(sstat + (size_t)rbase * 8); sb = *(const f32x4*)(sstat + (size_t)rbase * 8 + 4); }
#pragma unroll
        for (int gq = 0; gq < 8; ++gq) {
            const int ai = gq >> 2, m = gq & 3;
            const int r = rbase + ai * HALF + m * 16;
            if (gq < 7) { const int rn = rbase + ((gq + 1) >> 2) * HALF + ((gq + 1) & 3) * 16;
#pragma unroll
                for (int bj = 0; bj < 2; ++bj)
#pragma unroll
                    for (int n = 0; n < 2; ++n) nxt[bj][n] = *(const u32x2e*)(src + (size_t)rn * 1024 + cb + bj * HALF + n * 16);
                if (!raw) { san = *(const f32x4*)(sstat + (size_t)rn * 8); sbn = *(const f32x4*)(sstat + (size_t)rn * 8 + 4); } }
            asm volatile("" ::: "memory");
            float mu = 0.f, rs = 1.f;
            if (!raw) { const float ssum = (sa[0] + sa[2]) + (sb[0] + sb[2]), qsum = (sa[1] + sa[3]) + (sb[1] + sb[3]); mu = ssum * (1.f / 1024.f); rs = 1.0f / sqrtf(fmaxf(qsum * (1.f / 1024.f) - mu * mu, 0.f) + 1e-5f); }
            float s = 0.f, q = 0.f;
#pragma unroll
            for (int bj = 0; bj < 2; ++bj)
#pragma unroll
                for (int n = 0; n < 2; ++n) { const int c = cb + bj * HALF + n * 16; const size_t off = (size_t)r * 1024 + c;
                    const f32x4 gvv = raw ? (f32x4){1.f, 1.f, 1.f, 1.f} : *(const f32x4*)(g + c), bvv = raw ? (f32x4){0.f, 0.f, 0.f, 0.f} : *(const f32x4*)(b + c);
                    const u32x2e cw = cur[bj][n];
                    const f32x4 cf = {__builtin_bit_cast(float, cw.x << 16), __builtin_bit_cast(float, cw.x & 0xffff0000u), __builtin_bit_cast(float, cw.y << 16), __builtin_bit_cast(float, cw.y & 0xffff0000u)};
                    const f32x4 x = (cf - mu) * rs * gvv + bvv;
                    const f32x4 t = x * alpha + acc[ai][bj][m][n];
                    u32x2e w; w.x = cvt_pk_bf16(t[0], t[1]); w.y = cvt_pk_bf16(t[2], t[3]); *(u32x2e*)(XB + off) = w;
                    s += (t[0] + t[1]) + (t[2] + t[3]); q += (t[0] * t[0] + t[1] * t[1]) + (t[2] * t[2] + t[3] * t[3]);
                    if (shiftout && (r & 8191) == 8191) *(f32x4*)(shiftout + (size_t)(r >> 13) * 1024 + c) = x; }
            s += __shfl_xor(s, 16); s += __shfl_xor(s, 32); q += __shfl_xor(q, 16); q += __shfl_xor(q, 32);
            if (fq == 0) P[(ai * HALF + wr * 64 + m * 16 + fr) * 4 + wc] = (f32x2e){s, q};
#pragma unroll
            for (int bj = 0; bj < 2; ++bj)
#pragma unroll
                for (int n = 0; n < 2; ++n) cur[bj][n] = nxt[bj][n];
            sa = san; sb = sbn;
        }
        asm volatile("s_waitcnt lgkmcnt(0)" ::: "memory"); __builtin_amdgcn_s_barrier(); asm volatile("" ::: "memory");
        if (threadIdx.x < 256) { const int row = threadIdx.x; const f32x2e a = P[row * 4 + 0], b2 = P[row * 4 + 1], c = P[row * 4 + 2], d = P[row * 4 + 3];
            *(f32x2e*)(ostat + (size_t)(u.pm * BM + row) * 8 + u.pn * 2) = (f32x2e){(a.x + b2.x) + (c.x + d.x), (a.y + b2.y) + (c.y + d.y)}; }
        asm volatile("s_waitcnt lgkmcnt(0)" ::: "memory"); __builtin_amdgcn_s_barrier(); asm volatile("" ::: "memory");
    }
};
struct EpiUp {
    static constexpr bool PERM = true, AFTER_DRAIN = false;
    unsigned char* ws; int l;
    __device__ __forceinline__ void operator()(const f32x4 (&acc)[2][2][4][2], const Unit& u, int wr, int wc, int fr, int fq) const {
        asm volatile("" ::: "memory"); __builtin_amdgcn_sched_barrier(0);
        const float* stat = (const float*)(ws + WSO_STAT1); const float* c1 = (const float*)(ws + WSO_C1UP) + l * 4096; const float* c2 = (const float*)(ws + WSO_C2UP) + l * 4096; bf16_t* H = (bf16_t*)(ws + WSO_H);
        const int cb = u.pn * BM + wc * 32 + 8 * fq;
        float mu8[8], rs8[8];
#pragma unroll
        for (int gq = 0; gq < 8; ++gq) row_stats(stat, u.pm * BM + (gq >> 2) * HALF + wr * 64 + (gq & 3) * 16 + fr, mu8[gq], rs8[gq]);
#pragma unroll
        for (int bj = 0; bj < 2; ++bj) {
            f32x4 c1v[2], c2v[2];
#pragma unroll
            for (int n = 0; n < 2; ++n) { c1v[n] = *(const f32x4*)(c1 + cb + bj * HALF + 4 * n); c2v[n] = *(const f32x4*)(c2 + cb + bj * HALF + 4 * n); }
#pragma unroll
            for (int ai = 0; ai < 2; ++ai) {
#pragma unroll
                for (int m = 0; m < 4; ++m) {
                    const int r = u.pm * BM + ai * HALF + wr * 64 + m * 16 + fr;
                    const float mu = mu8[ai * 4 + m], rs = rs8[ai * 4 + m];
                    f32x4 v0 = (acc[ai][bj][m][0] - mu * c1v[0]) * rs + c2v[0], v1 = (acc[ai][bj][m][1] - mu * c1v[1]) * rs + c2v[1];
#pragma unroll
                    for (int e = 0; e < 4; ++e) { const float a = fmaxf(v0[e], 0.f), b = fmaxf(v1[e], 0.f); v0[e] = a * a; v1[e] = b * b; }
                    u32x4 w; w.x = cvt_pk_bf16(v0[0], v0[1]); w.y = cvt_pk_bf16(v0[2], v0[3]); w.z = cvt_pk_bf16(v1[0], v1[1]); w.w = cvt_pk_bf16(v1[2], v1[3]);
                    *(u32x4*)(H + (size_t)r * 4096 + cb + bj * HALF) = w; }
            }
        }
    }
};
template <class Epi, class Sched, bool ALIGN_EPI = false, bool SP2 = false>
__device__ __forceinline__ void gemm_phase(PG8_LAS unsigned char* lds, const Gemm g, const Sched& S, const Epi& E, const int tid) {
    const int wid = __builtin_amdgcn_readfirstlane(tid >> 6), lane = tid & 63, wr = wid >> 2, wc = wid & 3, fr = lane & 15, fq = lane >> 4;
    const int K = g.K, nt = K / BK;
    unsigned voffA[2], voffB[2];
#pragma unroll
    for (int i = 0; i < 2; ++i) { int R, C; stage_rc(tid * 16 + i * 8192, R, C); const int Rb = Epi::PERM ? ((R & ~31) + perm32(R & 31)) : R;
        voffA[i] = (unsigned)(R * K + C) * 2u; voffB[i] = (unsigned)(Rb * K + C) * 2u; }
    const size_t kstep = (size_t)(BK * 2);
    const size_t hstep = (size_t)HALF * K * 2;
    const size_t tstep = 2 * hstep;
    const unsigned ldsw = (unsigned)wid * 1024u;
    const int aoff = lds_byte(wr * 64 + fr, fq * 8), boff = lds_byte(wc * 32 + fr, fq * 8);
#define PG8_SA(b, h) (((b) * 2 + (h)) * HTB)
#define PG8_SB(b, h) ((4 + (b) * 2 + (h)) * HTB)
#define PG8_STAGE(bufoff, gbase, voff) do { _Pragma("unroll") for (int _i = 0; _i < 2; ++_i) \
        __builtin_amdgcn_global_load_lds((const unsigned*)((const char*)(gbase) + (voff)[_i]), (PG8_LAS unsigned*)(lds + (bufoff) + ldsw + _i * 8192), 16, 0, 0); } while (0)
#define PG8_LDA(dst, b, h) do { _Pragma("unroll") for (int m = 0; m < 4; ++m) _Pragma("unroll") for (int k = 0; k < 2; ++k) dst[m][k] = *(const PG8_LAS bf16x8*)(lds + PG8_SA(b, h) + aoff + m * 2048 + k * 1024); } while (0)
#define PG8_LDB(dst, b, h) do { _Pragma("unroll") for (int n = 0; n < 2; ++n) _Pragma("unroll") for (int k = 0; k < 2; ++k) dst[n][k] = *(const PG8_LAS bf16x8*)(lds + PG8_SB(b, h) + boff + n * 2048 + k * 1024); } while (0)
#define PG8_MMA(ai, bj, At, Bt) do { __builtin_amdgcn_s_setprio(1); _Pragma("unroll") for (int m = 0; m < 4; ++m) _Pragma("unroll") for (int n = 0; n < 2; ++n) _Pragma("unroll") for (int k = 0; k < 2; ++k) \
        acc[ai][bj][m][n] = __builtin_amdgcn_mfma_f32_16x16x32_bf16(Bt[n][k], At[m][k], acc[ai][bj][m][n], 0, 0, 0); __builtin_amdgcn_s_setprio(0); } while (0)
#define PG8_WAIT_V(n) asm volatile("s_waitcnt vmcnt(" #n ")" ::: "memory")
#define PG8_WAIT_L(n) asm volatile("s_waitcnt lgkmcnt(" #n ")" ::: "memory")
#define PG8_BAR __builtin_amdgcn_s_barrier()
#define PG8_SCHED __builtin_amdgcn_sched_barrier(0)
    Unit cur, nxt; int ui = 0;
    if (!S.next(0, cur)) return;
    f32x4 acc[2][2][4][2];
#pragma unroll
    for (int a = 0; a < 2; ++a)
#pragma unroll
        for (int b = 0; b < 2; ++b)
#pragma unroll
            for (int m = 0; m < 4; ++m)
#pragma unroll
                for (int n = 0; n < 2; ++n) acc[a][b][m][n] = (f32x4){0.f, 0.f, 0.f, 0.f};
    bf16x8 At[4][2], B0[2][2], B1[2][2];
    const char* cA = (const char*)g.A + (size_t)cur.pm * tstep; const char* cB = (const char*)g.Bt + (size_t)cur.pn * tstep;
    S.a_ready(cur);
    if constexpr (SP2) {
        PG8_STAGE(PG8_SB(0, 0), cB, voffB); PG8_STAGE(PG8_SB(0, 1), cB + hstep, voffB); PG8_STAGE(PG8_SA(0, 0), cA, voffA); PG8_STAGE(PG8_SA(0, 1), cA + hstep, voffA);
        if (wr == 1) PG8_BAR;
        PG8_WAIT_V(2); PG8_BAR;
        PG8_STAGE(PG8_SB(1, 0), cB + kstep, voffB); PG8_STAGE(PG8_SA(1, 0), cA + kstep, voffA); PG8_STAGE(PG8_SB(1, 1), cB + hstep + kstep, voffB);
        PG8_WAIT_V(6); PG8_BAR;
    } else {
        PG8_STAGE(PG8_SB(0, 0), cB, voffB); PG8_STAGE(PG8_SA(0, 0), cA, voffA); PG8_STAGE(PG8_SB(0, 1), cB + hstep, voffB); PG8_STAGE(PG8_SA(0, 1), cA + hstep, voffA);
        if (wr == 1) PG8_BAR;
        PG8_WAIT_V(4); PG8_BAR;
        PG8_STAGE(PG8_SB(1, 0), cB + kstep, voffB); PG8_STAGE(PG8_SA(1, 0), cA + kstep, voffA); PG8_STAGE(PG8_SB(1, 1), cB + hstep + kstep, voffB);
        PG8_WAIT_V(6); PG8_BAR;
    }
    for (;;) {
        const bool has_next = S.next(ui + 1, nxt);
        const char* nA = has_next ? (const char*)g.A + (size_t)nxt.pm * tstep : cA; const char* nB = has_next ? (const char*)g.Bt + (size_t)nxt.pn * tstep : cB;
        for (int t = 0; t < nt; t += 2) {
            const bool last = (t == nt - 2);
            const char* a1 = cA + (size_t)(t + 1) * kstep;
            const char* a2 = last ? nA : cA + (size_t)(t + 2) * kstep; const char* b2 = last ? nB : cB + (size_t)(t + 2) * kstep;
            const char* a3 = a2 + kstep; const char* b3 = b2 + kstep;
            if (last && has_next) S.a_ready(nxt);
            if constexpr (SP2) {
            PG8_LDB(B0, 0, 0); PG8_LDB(B1, 0, 1); PG8_SCHED; PG8_LDA(At, 0, 0); PG8_STAGE(PG8_SA(1, 1), a1 + hstep, voffA);
            PG8_WAIT_V(8); PG8_WAIT_L(0); PG8_BAR; PG8_MMA(0, 0, At, B0); PG8_MMA(0, 1, At, B1); PG8_BAR; PG8_SCHED;
            PG8_LDA(At, 0, 1); PG8_STAGE(PG8_SB(0, 0), b2, voffB); PG8_STAGE(PG8_SB(0, 1), b2 + hstep, voffB); PG8_STAGE(PG8_SA(0, 0), a2, voffA);
            PG8_WAIT_V(8); PG8_WAIT_L(0); PG8_BAR; PG8_MMA(1, 0, At, B0); PG8_MMA(1, 1, At, B1); PG8_BAR; PG8_SCHED;
            PG8_LDB(B0, 1, 0); PG8_LDB(B1, 1, 1); PG8_SCHED; PG8_LDA(At, 1, 0); PG8_STAGE(PG8_SA(0, 1), a2 + hstep, voffA);
            PG8_WAIT_V(8); PG8_WAIT_L(0); PG8_BAR; PG8_MMA(0, 0, At, B0); PG8_MMA(0, 1, At, B1); PG8_BAR; PG8_SCHED;
            PG8_LDA(At, 1, 1); PG8_STAGE(PG8_SB(1, 0), b3, voffB); PG8_STAGE(PG8_SB(1, 1), b3 + hstep, voffB); PG8_STAGE(PG8_SA(1, 0), a3, voffA);
            PG8_WAIT_V(8); PG8_WAIT_L(0); PG8_BAR; PG8_MMA(1, 0, At, B0); PG8_MMA(1, 1, At, B1); PG8_BAR; PG8_SCHED;
            } else {
            PG8_LDB(B0, 0, 0); PG8_SCHED; PG8_LDA(At, 0, 0); PG8_STAGE(PG8_SA(1, 1), a1 + hstep, voffA);
            PG8_WAIT_L(8); PG8_BAR; PG8_WAIT_L(0); PG8_MMA(0, 0, At, B0); PG8_BAR; PG8_SCHED;
            PG8_LDB(B1, 0, 1); PG8_STAGE(PG8_SB(0, 0), b2, voffB);
            PG8_BAR; PG8_WAIT_L(0); PG8_MMA(0, 1, At, B1); PG8_BAR;
            PG8_LDA(At, 0, 1); PG8_STAGE(PG8_SA(0, 0), a2, voffA);
            PG8_BAR; PG8_WAIT_L(0); PG8_MMA(1, 0, At, B0); PG8_BAR; PG8_SCHED;
            PG8_STAGE(PG8_SB(0, 1), b2 + hstep, voffB);
            PG8_WAIT_V(6); PG8_BAR; PG8_MMA(1, 1, At, B1); PG8_BAR;
            PG8_LDB(B0, 1, 0); PG8_SCHED; PG8_LDA(At, 1, 0); PG8_STAGE(PG8_SA(0, 1), a2 + hstep, voffA);
            PG8_WAIT_L(8); PG8_BAR; PG8_WAIT_L(0); PG8_MMA(0, 0, At, B0); PG8_BAR; PG8_SCHED;
            PG8_LDB(B1, 1, 1); PG8_STAGE(PG8_SB(1, 0), b3, voffB);
            PG8_BAR; PG8_WAIT_L(0); PG8_MMA(0, 1, At, B1); PG8_BAR;
            PG8_LDA(At, 1, 1); PG8_STAGE(PG8_SA(1, 0), a3, voffA);
            PG8_BAR; PG8_WAIT_L(0); PG8_MMA(1, 0, At, B0); PG8_BAR; PG8_SCHED;
            PG8_STAGE(PG8_SB(1, 1), b3 + hstep, voffB);
            PG8_WAIT_V(6); PG8_BAR; PG8_MMA(1, 1, At, B1); PG8_BAR;
            }
        }
        if constexpr (ALIGN_EPI) { if (wr == 0) PG8_BAR; }
        if constexpr (!Epi::AFTER_DRAIN) { E(acc, cur, wr, wc, fr, fq); S.done(cur); }
        if (!has_next) break;
#pragma unroll
        for (int a = 0; a < 2; ++a)
#pragma unroll
            for (int b = 0; b < 2; ++b)
#pragma unroll
                for (int m = 0; m < 4; ++m)
#pragma unroll
                    for (int n = 0; n < 2; ++n) acc[a][b][m][n] = (f32x4){0.f, 0.f, 0.f, 0.f};
        cur = nxt; cA = nA; cB = nB; ++ui;
        if constexpr (ALIGN_EPI) { if (wr == 1) PG8_BAR; }
    }
    PG8_WAIT_V(0);
    if constexpr (!ALIGN_EPI) { if (wr == 0) PG8_BAR; }
    PG8_BAR;
    if constexpr (Epi::AFTER_DRAIN) { E.fused(acc, cur, wr, wc, fr, fq, lds, wid, lane); S.done(cur); }
#undef PG8_SA
#undef PG8_SB
#undef PG8_STAGE
#undef PG8_LDA
#undef PG8_LDB
#undef PG8_MMA
#undef PG8_WAIT_V
#undef PG8_WAIT_L
#undef PG8_BAR
#undef PG8_SCHED
}
}
constexpr int NWAVES = 8;
constexpr int M = 16384, TSEQ = 8192, DM = 1024, FFD = 4096, DEPTH = 4, MD = 32, NH = 8, HD = 64;
constexpr int NIN = 3584;
constexpr int RW0 = 1536;
constexpr int PRP = 2048;
constexpr int NRWU = 1856;
constexpr int CH = 16, NCH = TSEQ / CH;
constexpr int NUNIT = 2 * NH * NCH;
constexpr float LN_EPS = 1e-5f, GN_EPS = 64e-5f, RMS_EPS = 1e-6f;
constexpr float ALPHA = 1.6817928305074290f;
constexpr float QSCALE = 0.125f * 1.4426950408889634f;
constexpr size_t O_Y = 0, O_YS = 16777216, O_SHP = 16809984, O_SHS = 16818176, O_WKP = 16949248, O_WKS = 17211392,
                 O_KP = 21405696, O_VP = 29794304, O_KS = 38182912, O_VS = 38248448, O_END = 38313984;
constexpr size_t MiB = 1u << 20;
constexpr size_t WS_CTL = 0, CTL_ZERO_BYTES = 1 * MiB;
constexpr size_t WS_C1IN = 1 * MiB;
constexpr size_t WS_C2IN = WS_C1IN + 4 * NIN * 4;
constexpr size_t WS_C1UP = WS_C2IN + 4 * NIN * 4;
constexpr size_t WS_C2UP = WS_C1UP + 4 * FFD * 4;
constexpr size_t WS_DUPT = WS_C2UP + 4 * FFD * 4;
constexpr size_t WS_IUPT = WS_DUPT + 4 * 512 * 64 * 2;
constexpr size_t WS_GUPT = WS_IUPT + 4 * 512 * 64 * 2;
constexpr size_t WS_VUPT = WS_GUPT + 4 * 512 * 128 * 2;
constexpr size_t WS_SMALL_END = WS_VUPT + 3 * 512 * 32 * 2;
static_assert(WS_SMALL_END <= 3 * MiB, "small region");
constexpr size_t WS_ROPE = 3 * MiB;
constexpr size_t WS_DEC = 6 * MiB;
constexpr size_t WS_STAT1 = 8 * MiB, WS_STAT2 = 9 * MiB;
constexpr size_t WS_BON = 10 * MiB;
constexpr size_t WS_LSE = 11 * MiB;
constexpr size_t WS_GC = 13 * MiB;
constexpr size_t WS_WIN = 16 * MiB;
constexpr size_t WS_WINU = 44 * MiB;
constexpr size_t WS_WOUT = 60 * MiB;
constexpr size_t WS_WUP = 68 * MiB;
constexpr size_t WS_WDN = 100 * MiB;
constexpr size_t WS_XB2 = 132 * MiB;
constexpr size_t WS_XB1 = 164 * MiB;
constexpr size_t WS_T1 = 196 * MiB;
constexpr size_t WS_T2 = 260 * MiB;
constexpr size_t WS_QB = 324 * MiB, WS_KB = 340 * MiB, WS_VB = 356 * MiB;
constexpr size_t WS_PR = 372 * MiB;
constexpr size_t WS_OP = 436 * MiB;
constexpr size_t WS_MIX = 484 * MiB;
constexpr size_t WS_VF = 516 * MiB, WS_VV = 532 * MiB;
constexpr size_t WS_YPRE = 548 * MiB;
constexpr size_t WS_H = 580 * MiB;
constexpr size_t WS_PT = 580 * MiB;
constexpr size_t WS_QT = 644 * MiB;
constexpr size_t WS_REFF = 708 * MiB;
constexpr size_t WS_YLOC = 724 * MiB;
constexpr size_t WS_SEGQ = 756 * MiB, WS_SEGP = 760 * MiB;
constexpr size_t WS_CSUM = 764 * MiB;
constexpr size_t WS_CSUP = 766 * MiB;
constexpr size_t WS_END = 768 * MiB;
static_assert(WS_H + (size_t)M * FFD * 2 <= WS_END + 0 * MiB || true, "");
constexpr size_t DEC_XB2 = 0;
constexpr size_t DEC_XB1 = 64 * 1024;
constexpr size_t DEC_SHB = 128 * 1024;
constexpr size_t DEC_MIXB = 384 * 1024;
constexpr size_t DEC_HB = 448 * 1024;
constexpr size_t DEC_T1 = 704 * 1024;
constexpr size_t DEC_T2 = 832 * 1024;
constexpr size_t DEC_PD = 960 * 1024;
constexpr size_t DEC_PS = 1408 * 1024;
constexpr size_t DEC_OP = 1640 * 1024;
constexpr size_t DEC_LSE = 1832 * 1024;
constexpr size_t DEC_MIX = 1836 * 1024;
constexpr size_t DEC_ST1 = 1964 * 1024;
constexpr size_t DEC_ST2 = 1972 * 1024;
constexpr size_t DEC_VF = 1980 * 1024;
static_assert(DEC_VF + 32 * 512 * 4 <= 2 * MiB, "decode scratch");
constexpr int CW_BAR = 4096;
constexpr int RING_BYTES = 131072;
constexpr int MISC_OFF = RING_BYTES + 320;
constexpr int LDS_BYTES = 147456;
static_assert(pg8::WSO_C1IN == WS_C1IN && pg8::WSO_C2IN == WS_C2IN && pg8::WSO_C1UP == WS_C1UP && pg8::WSO_C2UP == WS_C2UP && pg8::WSO_ROPE == WS_ROPE && pg8::WSO_STAT1 == WS_STAT1 && pg8::WSO_STAT2 == WS_STAT2 &&
              pg8::WSO_XB2 == WS_XB2 && pg8::WSO_XB1 == WS_XB1 && pg8::WSO_T1 == WS_T1 && pg8::WSO_T2 == WS_T2 && pg8::WSO_QB == WS_QB && pg8::WSO_KB == WS_KB && pg8::WSO_VB == WS_VB && pg8::WSO_PR == WS_PR && pg8::WSO_H == WS_H &&
              pg8::OO_SHP == O_SHP && pg8::OO_KP == O_KP && pg8::OO_VP == O_VP, "epilogue offset mirrors");
#define GAS __attribute__((address_space(1)))
#define LAS __attribute__((address_space(3)))
typedef unsigned short bf16;
typedef unsigned v4u __attribute__((ext_vector_type(4)));
typedef unsigned v2u __attribute__((ext_vector_type(2)));
typedef float f32x4 __attribute__((ext_vector_type(4)));
typedef float f32x2 __attribute__((ext_vector_type(2)));
typedef float f32x16 __attribute__((ext_vector_type(16)));
typedef short bf16x8 __attribute__((ext_vector_type(8)));
typedef short s16x4 __attribute__((ext_vector_type(4)));
typedef GAS unsigned gu32;
#define RLX_AGENT __ATOMIC_RELAXED, __HIP_MEMORY_SCOPE_AGENT
#define LDS_WAIT() asm volatile("s_waitcnt lgkmcnt(0)" ::: "memory")
#define VM_WAIT() asm volatile("s_waitcnt vmcnt(0)" ::: "memory")
#define DI __device__ __forceinline__
DI unsigned f2bf(float f) { unsigned u = __builtin_bit_cast(unsigned, f); return (u + 0x7fffu + ((u >> 16) & 1u)) >> 16; }
DI float bf2f(unsigned b) { return __builtin_bit_cast(float, b << 16); }
DI float bflo(unsigned w) { return __builtin_bit_cast(float, w << 16); }
DI float bfhi(unsigned w) { return __builtin_bit_cast(float, w & 0xffff0000u); }
typedef __bf16 bf16x2_t __attribute__((ext_vector_type(2)));
DI unsigned pk2(float lo, float hi) { const f32x2 v = {lo, hi}; const bf16x2_t b = __builtin_convertvector(v, bf16x2_t); return __builtin_bit_cast(unsigned, b); }
DI unsigned pk2z(float x) { return pk2(x, 0.f) & 0xffffu; }
DI float rbf(float x) { return bf2f(f2bf(x)); }
DI bf16x8 pk8(float a0, float a1, float a2, float a3, float a4, float a5, float a6, float a7) {
    v4u w; w.x = pk2(a0, a1); w.y = pk2(a2, a3); w.z = pk2(a4, a5); w.w = pk2(a6, a7); return __builtin_bit_cast(bf16x8, w); }
DI bf16x8 pk8v(f32x4 a, f32x4 b) { return pk8(a[0], a[1], a[2], a[3], b[0], b[1], b[2], b[3]); }
DI bf16x8 pk4z(f32x4 a) { v4u w; w.x = pk2(a[0], a[1]); w.y = pk2(a[2], a[3]); w.z = 0u; w.w = 0u; return __builtin_bit_cast(bf16x8, w); }
DI bf16x8 ld8(const void* p) { return *(const bf16x8*)p; }
DI bf16x8 ld4z(const void* p) { v2u t = *(const v2u*)p; v4u w; w.x = t.x; w.y = t.y; w.z = 0u; w.w = 0u; return __builtin_bit_cast(bf16x8, w); }
DI f32x4 mfma16(bf16x8 a, bf16x8 b, f32x4 c) { return __builtin_amdgcn_mfma_f32_16x16x32_bf16(a, b, c, 0, 0, 0); }
DI f32x16 mfma32(bf16x8 a, bf16x8 b, f32x16 c) { return __builtin_amdgcn_mfma_f32_32x32x16_bf16(a, b, c, 0, 0, 0); }
DI int crow(int r, int hi) { return (r & 3) + 8 * (r >> 2) + 4 * hi; }
DI float wave_sum(float v) {
#pragma unroll
    for (int o = 1; o < 64; o <<= 1) v += __shfl_xor(v, o);
    return v; }
DI float fexp(float x) { return __expf(x); }
DI float fsigmoid(float x) { return __builtin_amdgcn_rcpf(1.f + __expf(-x)); }
DI float ftanh(float x) { return 1.f - 2.f * __builtin_amdgcn_rcpf(__expf(2.f * x) + 1.f); }
DI float fsoftplus(float x) { return fmaxf(x, 0.f) + __logf(1.f + __expf(-fabsf(x))); }
DI int swap45(int c) { return (c & ~0x30) | ((c & 0x10) << 1) | ((c & 0x20) >> 1); }
#define XB_TMO      128
#define XB_XCNT(j)  (256  + 64 * (j))
#define XB_XSUB(j)  (1280 + 64 * (j))
#define XB_XGEN(j)  (2304 + 64 * (j))
#define XB_TOP      3328
#define XB_TOPGEN   3392
#define XCD_BAR_WORDS 3456
#define XB_SPIN_CAP (1u << 18)

__device__ __forceinline__ unsigned xb_ld(unsigned* p)              { return __hip_atomic_load(p, __ATOMIC_RELAXED, __HIP_MEMORY_SCOPE_AGENT); }
__device__ __forceinline__ unsigned xb_add(unsigned* p, unsigned v) { return __hip_atomic_fetch_add(p, v, __ATOMIC_RELAXED, __HIP_MEMORY_SCOPE_AGENT); }
__device__ __forceinline__ unsigned xb_xcc_id() { return (unsigned)__builtin_amdgcn_s_getreg((3 << 11) | 20) & 0xFu; }
#define XB_SPIN(cond, bar) do { unsigned _sp = 0; while (cond) { __builtin_amdgcn_s_sleep(1); \
    if ((++_sp & 255u) == 0u) { if (xb_ld(&(bar)[XB_TMO])) break; if (_sp > XB_SPIN_CAP) { atomicAdd(&(bar)[XB_TMO], 1u); break; } } } } while (0)

struct XcdBarrier {
    unsigned* bar; unsigned x;
    volatile LAS unsigned* st;
};

__device__ __forceinline__ XcdBarrier xcd_barrier_post(unsigned* bar, volatile LAS unsigned* st) {
    XcdBarrier b; b.bar = bar; b.x = xb_xcc_id(); b.st = st;
    if (threadIdx.x == 0) (void)xb_add(&bar[XB_XCNT(b.x)], 1u);
    return b;
}
__device__ __forceinline__ void xcd_barrier_complete(unsigned* bar, unsigned x, unsigned& nloc, unsigned& nx) {
    const unsigned G = gridDim.x * gridDim.y * gridDim.z;
    unsigned sum, cnt, mine, sp = 0u;
    for (;;) {
        sum = 0u; cnt = 0u; mine = 0u;
#pragma unroll
        for (unsigned j = 0; j < 16; ++j) { const unsigned c = xb_ld(&bar[XB_XCNT(j)]); sum += c; cnt += (c > 0u) ? 1u : 0u; mine = (j == x) ? c : mine; }
        if (sum == G) break;
        __builtin_amdgcn_s_sleep(1);
        if ((++sp & 255u) == 0u) { if (xb_ld(&bar[XB_TMO])) break; if (sp > XB_SPIN_CAP) { atomicAdd(&bar[XB_TMO], 1u); break; } }
    }
    nloc = mine > 0u ? mine : 1u; nx = cnt > 0u ? cnt : 1u;
}

__device__ __forceinline__ void xcd_barrier(const XcdBarrier& b) {
    asm volatile("s_waitcnt vmcnt(0)" ::: "memory");
    __syncthreads();
    if (threadIdx.x == 0) {
        unsigned* bar = b.bar;
        __builtin_amdgcn_s_waitcnt(0);
        unsigned nloc = b.st[0], nx = b.st[1];
        if (nloc == 0u) { xcd_barrier_complete(bar, b.x, nloc, nx); b.st[0] = nloc; b.st[1] = nx; }
        const unsigned old = xb_add(&bar[XB_XSUB(b.x)], 1u);
        const unsigned gen = old / nloc;
        if (old + 1u == (gen + 1u) * nloc) {
            __builtin_amdgcn_fence(__ATOMIC_RELEASE, "agent");
            asm volatile("s_waitcnt vmcnt(0)" ::: "memory");
            const unsigned og = xb_add(&bar[XB_TOP], 1u);
            const unsigned tg = og / nx;
            if (og + 1u == (tg + 1u) * nx) xb_add(&bar[XB_TOPGEN], 1u);
            else XB_SPIN(xb_ld(&bar[XB_TOPGEN]) == tg, bar);
            __builtin_amdgcn_fence(__ATOMIC_ACQUIRE, "agent");
            xb_add(&bar[XB_XGEN(b.x)], 1u);
            asm volatile("s_waitcnt vmcnt(0)" ::: "memory");
        } else {
            XB_SPIN(xb_ld(&bar[XB_XGEN(b.x)]) == gen, bar);
            __builtin_amdgcn_fence(__ATOMIC_ACQUIRE, "agent");
            asm volatile("s_waitcnt vmcnt(0)" ::: "memory");
        }
    }
    __syncthreads();
}
struct Args { const float* in[30]; float* out; unsigned char* ws; };
struct Frame {
    unsigned char* lds;
    volatile LAS unsigned* MISC;
    gu32* ctl;
    int tid, lane, wave, vcu, G, gw, NGW;
    const float* const* in; float* out; unsigned char* ws;
};
template <bool SWAP>
DI void p0_transpose_item(const float* W, int ldw, int K, int csrc0, bf16* WT, int row_off, const float* gsc, LAS float* scr, int kb, int nb, int lane, float* csum = nullptr, int ncs = 0, const float* bsh = nullptr) {
    const int k0 = 64 * kb, n0 = 32 * nb;
    float s1 = 0.f, s2 = 0.f;
    float wv[32], gk = 1.f, bk = 0.f;
#pragma unroll
    for (int i = 0; i < 32; ++i) wv[i] = W[(size_t)(k0 + 2 * i + (lane >> 5)) * ldw + csrc0 + n0 + (lane & 31)];
    if (gsc) gk = gsc[k0 + lane]; if (bsh) bk = bsh[k0 + lane];
#pragma unroll
    for (int i = 0; i < 32; ++i) { const int kk = 2 * i + (lane >> 5); float v = wv[i]; s2 += v * __shfl(bk, kk); v *= __shfl(gk, kk); s1 += rbf(v); scr[kk * 33 + (lane & 31)] = v; }
    if (csum) { s1 += __shfl_xor(s1, 32); s2 += __shfl_xor(s2, 32); if (lane < 32) { int dr = n0 + lane; if (SWAP) dr = swap45(dr); csum[(size_t)(kb * 2 + 0) * ncs + row_off + dr] = s1; csum[(size_t)(kb * 2 + 1) * ncs + row_off + dr] = s2; } }
    LDS_WAIT(); asm volatile("" ::: "memory");
    const int c = lane & 7;
#pragma unroll
    for (int j = 0; j < 4; ++j) { const int n = (lane >> 3) + 8 * j; const LAS float* s = scr + (8 * c) * 33 + n;
        v4u o; o.x = pk2(s[0 * 33], s[1 * 33]); o.y = pk2(s[2 * 33], s[3 * 33]); o.z = pk2(s[4 * 33], s[5 * 33]); o.w = pk2(s[6 * 33], s[7 * 33]);
        int dr = n0 + n; if (SWAP) dr = swap45(dr);
        *(v4u*)(WT + (size_t)(row_off + dr) * K + k0 + 8 * c) = o; }
    LDS_WAIT(); asm volatile("" ::: "memory");
}
DI void p0_prologue(Frame& F) {
    LAS float* scr = (LAS float*)((LAS unsigned char*)F.lds + F.wave * 16384);
    const float* const* in = F.in; unsigned char* ws = F.ws;
    constexpr int I_IN = 16 * 104, I_VR = 16, I_INU = 16 * 56, I_OUT = 16 * 32, I_UP = 16 * 128, I_DN = 64 * 32;
    constexpr int I_L = I_IN + I_VR + I_INU + I_VR + I_OUT + I_UP + I_DN;
    for (int it = F.gw; it < DEPTH * I_L; it += F.NGW) {
        const int l = it / I_L; int r = it % I_L;
        const float* g2p = l > 0 ? in[28] + (size_t)(l - 1) * DM : nullptr;
        bf16* win = (bf16*)(ws + WS_WIN) + (size_t)l * NIN * DM; bf16* winu = (bf16*)(ws + WS_WINU) + (size_t)l * NRWU * DM;
        if (r < I_IN) { const int kb = r / 104, nb = r % 104; const float* W = in[6] + (size_t)l * DM * 3328;
            float* cs = l > 0 ? (float*)(ws + WS_CSUM) + (size_t)l * 32 * NIN : nullptr; const float* b2p = l > 0 ? in[29] + (size_t)(l - 1) * DM : nullptr;
            if (nb < 32) p0_transpose_item<true>(W, 3328, DM, 0, win, 0, g2p, scr, kb, nb, F.lane, cs, NIN, b2p); else p0_transpose_item<false>(W, 3328, DM, 0, win, 0, g2p, scr, kb, nb, F.lane, cs, NIN, b2p); continue; } r -= I_IN;
        if (r < I_VR) { if (l > 0) p0_transpose_item<false>(in[7] + (size_t)(l - 1) * DM * 32, 32, DM, 0, win, 3328, g2p, scr, r, 0, F.lane, (float*)(ws + WS_CSUM) + (size_t)l * 32 * NIN, NIN, in[29] + (size_t)(l - 1) * DM); continue; } r -= I_VR;
        if (r < I_INU) { const int kb = r / 56, nb = r % 56; p0_transpose_item<false>(in[6] + (size_t)l * DM * 3328, 3328, DM, RW0, winu, 0, nullptr, scr, kb, nb, F.lane); continue; } r -= I_INU;
        if (r < I_VR) { if (l > 0) p0_transpose_item<false>(in[7] + (size_t)(l - 1) * DM * 32, 32, DM, 0, winu, 1792, nullptr, scr, r, 0, F.lane); continue; } r -= I_VR;
        if (r < I_OUT) { p0_transpose_item<false>(in[23] + (size_t)l * DM * DM, DM, DM, 0, (bf16*)(ws + WS_WOUT) + (size_t)l * DM * DM, 0, nullptr, scr, r / 32, r % 32, F.lane); continue; } r -= I_OUT;
        if (r < I_UP) { p0_transpose_item<false>(in[26] + (size_t)l * DM * FFD, FFD, DM, 0, (bf16*)(ws + WS_WUP) + (size_t)l * FFD * DM, 0, in[24] + (size_t)l * DM, scr, r / 128, r % 128, F.lane, (float*)(ws + WS_CSUP) + (size_t)l * 32 * FFD, FFD, in[25] + (size_t)l * DM); continue; } r -= I_UP;
        p0_transpose_item<false>(in[27] + (size_t)l * FFD * DM, DM, FFD, 0, (bf16*)(ws + WS_WDN) + (size_t)l * DM * FFD, 0, nullptr, scr, r / 32, r % 32, F.lane);
    }
    for (int m0 = F.gw; m0 < M; m0 += 4 * F.NGW) { f32x4 v[4][4];
#pragma unroll
        for (int q = 0; q < 4; ++q) { const f32x4* xr = (const f32x4*)(in[0] + (size_t)(m0 + q * F.NGW) * DM) + F.lane;
#pragma unroll
            for (int j = 0; j < 4; ++j) v[q][j] = xr[64 * j]; }
#pragma unroll
        for (int q = 0; q < 4; ++q) { unsigned long long* o8 = (unsigned long long*)((bf16*)(ws + WS_XB2) + (size_t)(m0 + q * F.NGW) * DM) + F.lane;
#pragma unroll
            for (int j = 0; j < 4; ++j) o8[64 * j] = (unsigned long long)pk2(v[q][j].x, v[q][j].y) | ((unsigned long long)pk2(v[q][j].z, v[q][j].w) << 32); } }
    const int gt = F.gw * 64 + F.lane, NGT = F.NGW * 64;
    for (int e = gt; e < 8193 * 32; e += NGT) { const int pos = e >> 5, i = e & 31; const double ang = (double)pos * pow(10000.0, -(double)i / 32.0); ((f32x2*)(ws + WS_ROPE))[e] = (f32x2){(float)cos(ang), (float)sin(ang)}; }
    for (int e = gt; e < 4 * 512 * 64; e += NGT) { const int l = e / (512 * 64), n = (e / 64) % 512, m = e % 64; ((bf16*)(ws + WS_DUPT))[e] = (bf16)f2bf(in[11][((size_t)l * 64 + m) * 512 + n]); ((bf16*)(ws + WS_IUPT))[e] = (bf16)f2bf(in[13][((size_t)l * 64 + m) * 512 + n]); }
    for (int e = gt; e < 4 * 512 * 128; e += NGT) { const int l = e / (512 * 128), n = (e / 128) % 512, m = e % 128; ((bf16*)(ws + WS_GUPT))[e] = (bf16)f2bf(in[14][((size_t)l * 128 + m) * 512 + n]); }
    for (int e = gt; e < 3 * 512 * 32; e += NGT) { const int l = e / (512 * 32), n = (e / 32) % 512, m = e % 32; ((bf16*)(ws + WS_VUPT))[e] = (bf16)f2bf(in[16][((size_t)l * 32 + m) * 512 + n]); }
    for (int e = gt; e < 2 * DM; e += NGT) F.out[O_SHP + e] = in[0][((size_t)(e / DM) * TSEQ + TSEQ - 1) * DM + (e % DM)];
    for (int e = gt; e < MD * DM; e += NGT) { ((bf16*)(ws + WS_DEC + DEC_XB2))[e] = (bf16)f2bf(in[1][e]); }
    for (int e = gt; e < DEPTH * MD * DM; e += NGT) { ((bf16*)(ws + WS_DEC + DEC_SHB))[e] = (bf16)f2bf(in[2][e]); }
}
DI void colsum_finish(unsigned char* ws, int gt, int NGT) {
    for (int e = gt; e < 3 * NIN; e += NGT) { const int l = 1 + e / NIN, p = e % NIN; if (p >= 3360) continue; const float* cs = (const float*)(ws + WS_CSUM) + (size_t)l * 32 * NIN + p; float s1 = 0.f, s2 = 0.f;
#pragma unroll
        for (int kb = 0; kb < 16; ++kb) { s1 += cs[(size_t)(2 * kb) * NIN]; s2 += cs[(size_t)(2 * kb + 1) * NIN]; }
        ((float*)(ws + WS_C1IN))[l * NIN + p] = s1; ((float*)(ws + WS_C2IN))[l * NIN + p] = s2; }
    for (int e = gt; e < 4 * FFD; e += NGT) { const int l = e / FFD, p = e % FFD; const float* cs = (const float*)(ws + WS_CSUP) + (size_t)l * 32 * FFD + p; float s1 = 0.f, s2 = 0.f;
#pragma unroll
        for (int kb = 0; kb < 16; ++kb) { s1 += cs[(size_t)(2 * kb) * FFD]; s2 += cs[(size_t)(2 * kb + 1) * FFD]; }
        ((float*)(ws + WS_C1UP))[l * FFD + p] = s1; ((float*)(ws + WS_C2UP))[l * FFD + p] = s2; }
}
constexpr int VPITCH = 144;
constexpr int ATT_WLDS = 2 * 32 * VPITCH + 256;
DI void tr_read8(unsigned base, s16x4 (&t)[8]) {
    asm volatile("ds_read_b64_tr_b16 %0, %8\n\tds_read_b64_tr_b16 %1, %8 offset:%c9\n\tds_read_b64_tr_b16 %2, %8 offset:%c10\n\tds_read_b64_tr_b16 %3, %8 offset:%c11\n\t"
                 "ds_read_b64_tr_b16 %4, %8 offset:%c12\n\tds_read_b64_tr_b16 %5, %8 offset:%c13\n\tds_read_b64_tr_b16 %6, %8 offset:%c14\n\tds_read_b64_tr_b16 %7, %8 offset:%c15\n\ts_waitcnt lgkmcnt(0)"
                 : "=&v"(t[0]), "=&v"(t[1]), "=&v"(t[2]), "=&v"(t[3]), "=&v"(t[4]), "=&v"(t[5]), "=&v"(t[6]), "=&v"(t[7])
                 : "v"(base), "i"(8 * VPITCH), "i"(64), "i"(8 * VPITCH + 64), "i"(16 * VPITCH), "i"(24 * VPITCH), "i"(16 * VPITCH + 64), "i"(24 * VPITCH + 64) : "memory");
}
DI void attn_task(const bf16* QB, const bf16* KB, const bf16* VB, bf16* OP, float* LSE, int b, int h, int p, int cls, int qblk, LAS unsigned char* wl, int lane) {
    asm volatile("" : "+v"(lane));
    const int dd = 1 << (2 * p), r32 = lane & 31, hi = lane >> 5;
    const int m0 = 32 * qblk;
    const size_t rowb = (size_t)b * TSEQ;
    const size_t qrow = rowb + (size_t)(m0 + r32) * dd + cls;
    bf16x8 qf[4];
#pragma unroll
    for (int d0 = 0; d0 < 4; ++d0) qf[d0] = ld8(QB + qrow * 512 + h * 64 + d0 * 16 + hi * 8);
    f32x16 s[5];
    const int kt0 = (m0 >= 128) ? 0 : (128 - m0) / 32;
    bf16x8 kf[5][4];
#pragma unroll
    for (int kt = 0; kt < 5; ++kt) {
        const int mk = m0 - 128 + 32 * kt + r32;
        const size_t krow = rowb + (size_t)(mk < 0 ? 0 : mk) * dd + cls;
#pragma unroll
        for (int d0 = 0; d0 < 4; ++d0) kf[kt][d0] = ld8(KB + krow * 512 + h * 64 + d0 * 16 + hi * 8);
    }
#pragma unroll
    for (int kt = 0; kt < 5; ++kt) {
        f32x16 a; for (int i = 0; i < 16; ++i) a[i] = 0.f;
#pragma unroll
        for (int d0 = 0; d0 < 4; ++d0) a = mfma32(kf[kt][d0], qf[d0], a);
        s[kt] = a;
    }
#pragma unroll
    for (int kt = 0; kt < 5; ++kt) {
        if (kt < kt0) {
#pragma unroll
            for (int i = 0; i < 16; ++i) s[kt][i] = -INFINITY;
        } else if (kt == 0) {
#pragma unroll
            for (int i = 0; i < 16; ++i) s[kt][i] = (crow(i, hi) >= r32) ? s[kt][i] : -INFINITY;
        } else if (kt == 4) {
#pragma unroll
            for (int i = 0; i < 16; ++i) s[kt][i] = (crow(i, hi) <= r32) ? s[kt][i] : -INFINITY;
        }
    }
    float mx = -INFINITY;
#pragma unroll
    for (int kt = 0; kt < 5; ++kt)
#pragma unroll
        for (int i = 0; i < 16; ++i) mx = fmaxf(mx, s[kt][i]);
    mx = fmaxf(mx, __shfl_xor(mx, 32));
    float lsum = 0.f;
#pragma unroll
    for (int kt = 0; kt < 5; ++kt)
#pragma unroll
        for (int i = 0; i < 16; ++i) { const float e = __builtin_amdgcn_exp2f(s[kt][i] - mx); s[kt][i] = e; lsum += e; }
    lsum += __shfl_xor(lsum, 32);
    f32x16 o[2]; for (int i = 0; i < 16; ++i) { o[0][i] = 0.f; o[1][i] = 0.f; }
    LAS float* wsf = (LAS float*)(wl + 2 * 32 * VPITCH);
    const unsigned vb0 = (unsigned)(uintptr_t)wl;
    const int g = lane >> 4, i16 = lane & 15, qq = i16 >> 2, pp = i16 & 3;
    const unsigned traddr = (unsigned)((4 * (g >> 1) + qq) * VPITCH + (16 * (g & 1) + 4 * pp) * 2);
    const int vkey = lane >> 1, vhalf = lane & 1;
    v4u vr[4];
#define ATT_LOADV(KT) do { const int mk_ = m0 - 128 + 32 * (KT) + vkey; const size_t vrow_ = rowb + (size_t)mk_ * dd + cls; const v4u* src_ = (const v4u*)(VB + vrow_ * 512 + h * 64 + vhalf * 32); \
        vr[0] = src_[0]; vr[1] = src_[1]; vr[2] = src_[2]; vr[3] = src_[3]; } while (0)
    ATT_LOADV(kt0);
#pragma unroll
    for (int kt = 0; kt < 5; ++kt) {
        if (kt >= kt0) {
            LAS unsigned char* vb = wl + (kt & 1) * 32 * VPITCH;
            { LAS v4u* dst = (LAS v4u*)(vb + vkey * VPITCH + vhalf * 64); dst[0] = vr[0]; dst[1] = vr[1]; dst[2] = vr[2]; dst[3] = vr[3]; }
            if (kt + 1 < 5) ATT_LOADV(kt + 1);
            LDS_WAIT();
            const unsigned base = vb0 + (unsigned)((kt & 1) * 32 * VPITCH) + traddr;
            s16x4 t[8];
            tr_read8(base, t);
#pragma unroll
            for (int ss = 0; ss < 2; ++ss) {
                const bf16x8 pa = pk8(s[kt][8 * ss], s[kt][8 * ss + 1], s[kt][8 * ss + 2], s[kt][8 * ss + 3], s[kt][8 * ss + 4], s[kt][8 * ss + 5], s[kt][8 * ss + 6], s[kt][8 * ss + 7]);
#pragma unroll
                for (int db = 0; db < 2; ++db) { const bf16x8 vf = __builtin_shufflevector(t[4 * ss + 2 * db], t[4 * ss + 2 * db + 1], 0, 1, 2, 3, 4, 5, 6, 7); o[db] = mfma32(pa, vf, o[db]); }
            }
        }
    }
#undef ATT_LOADV
    if (hi == 0) { wsf[r32] = __builtin_amdgcn_rcpf(lsum); LSE[((size_t)p * M + qrow) * 8 + h] = mx + __builtin_amdgcn_logf(lsum); }
    LDS_WAIT();
#pragma unroll
    for (int i = 0; i < 16; ++i) { const int q = crow(i, hi); const float li = wsf[q]; const size_t orow = rowb + (size_t)(m0 + q) * dd + cls;
        bf16* op = OP + ((size_t)p * M + orow) * 512 + h * 64 + r32;
        op[0] = (bf16)pk2z(o[0][i] * li); op[32] = (bf16)pk2z(o[1][i] * li); }
    LDS_WAIT();
}
DI void attn_finalize_row(const bf16* OP, const float* LSE, const float* gain, bf16* MIX, int row, int lane) {
    asm volatile("" : "+v"(lane));
    const int h = lane >> 3;
    float l0 = LSE[((size_t)0 * M + row) * 8 + h], l1 = LSE[((size_t)1 * M + row) * 8 + h], l2 = LSE[((size_t)2 * M + row) * 8 + h];
    const float mx = fmaxf(l0, fmaxf(l1, l2));
    float w0 = __builtin_amdgcn_exp2f(l0 - mx), w1 = __builtin_amdgcn_exp2f(l1 - mx), w2 = __builtin_amdgcn_exp2f(l2 - mx);
    const float inv = __builtin_amdgcn_rcpf(w0 + w1 + w2); w0 *= inv; w1 *= inv; w2 *= inv;
    const v4u a = *(const v4u*)(OP + ((size_t)0 * M + row) * 512 + lane * 8), b = *(const v4u*)(OP + ((size_t)1 * M + row) * 512 + lane * 8), c = *(const v4u*)(OP + ((size_t)2 * M + row) * 512 + lane * 8);
    float v[8]; float ss = 0.f;
#pragma unroll
    for (int j = 0; j < 4; ++j) { v[2 * j] = w0 * bflo(a[j]) + w1 * bflo(b[j]) + w2 * bflo(c[j]); v[2 * j + 1] = w0 * bfhi(a[j]) + w1 * bfhi(b[j]) + w2 * bfhi(c[j]); ss += v[2 * j] * v[2 * j] + v[2 * j + 1] * v[2 * j + 1]; }
    ss = wave_sum(ss);
    const float rinv = 1.0f / sqrtf(ss * (1.f / 512.f) + RMS_EPS);
    const f32x4 g0 = *(const f32x4*)(gain + lane * 8), g1 = *(const f32x4*)(gain + lane * 8 + 4);
    v4u w; w.x = pk2(v[0] * rinv * g0[0], v[1] * rinv * g0[1]); w.y = pk2(v[2] * rinv * g0[2], v[3] * rinv * g0[3]); w.z = pk2(v[4] * rinv * g1[0], v[5] * rinv * g1[1]); w.w = pk2(v[6] * rinv * g1[2], v[7] * rinv * g1[3]);
    *(v4u*)(MIX + (size_t)row * 1024 + lane * 8) = w;
}
constexpr int B1_IMG = 2048, B1_WLDS = 5 * B1_IMG + 1024;
DI float dpp_shr(float x, int n) { int v;
    switch (n) { case 1: v = __builtin_amdgcn_update_dpp(0, __builtin_bit_cast(int, x), 0x111, 0xf, 0xf, true); break; case 2: v = __builtin_amdgcn_update_dpp(0, __builtin_bit_cast(int, x), 0x112, 0xf, 0xf, true); break;
                 case 4: v = __builtin_amdgcn_update_dpp(0, __builtin_bit_cast(int, x), 0x114, 0xf, 0xf, true); break; default: v = __builtin_amdgcn_update_dpp(0, __builtin_bit_cast(int, x), 0x118, 0xf, 0xf, true); break; }
    return __builtin_bit_cast(float, v); }
DI float dpp_shr1(float x, int n) { int v; const int one = 0x3f800000;
    switch (n) { case 1: v = __builtin_amdgcn_update_dpp(one, __builtin_bit_cast(int, x), 0x111, 0xf, 0xf, false); break; case 2: v = __builtin_amdgcn_update_dpp(one, __builtin_bit_cast(int, x), 0x112, 0xf, 0xf, false); break;
                 case 4: v = __builtin_amdgcn_update_dpp(one, __builtin_bit_cast(int, x), 0x114, 0xf, 0xf, false); break; default: v = __builtin_amdgcn_update_dpp(one, __builtin_bit_cast(int, x), 0x118, 0xf, 0xf, false); break; }
    return __builtin_bit_cast(float, v); }
struct RwkvP {
    const bf16* PR; const float* mu; const float* muv;
    const float *dbase, *ibase, *vbase, *ksk, *ksa, *brk, *gng, *gnb;
    const bf16 *dupT, *iupT, *vupT, *gupT;
    const bf16* ZROW; bf16 *VF, *VV; float* BON; float* GC; bf16 *W1S, *REFF, *BM; v4u* REC; float* YPRE; bf16* MIX; int layer0;
};
DI const f32x4* vec4p(const float*) { return nullptr; }
DI const LAS f32x4* vec4p(const LAS float*) { return nullptr; }
template <class MP> DI void lerp8(const bf16* crow_, const bf16* prow_, int col, MP mu, float (&z)[8]) {
    const v4u cur = *(const v4u*)(crow_ + col); const v4u prv = *(const v4u*)(prow_ + col);
    const f32x4 m0 = *(decltype(vec4p(mu)))(mu), m1 = *(decltype(vec4p(mu)))(mu + 4);
#pragma unroll
    for (int j = 0; j < 4; ++j) { const float a = bflo(cur[j]), b = bfhi(cur[j]), pa = bflo(prv[j]), pb = bfhi(prv[j]); const float ma = j < 2 ? m0[2 * j] : m1[2 * j - 4], mb = j < 2 ? m0[2 * j + 1] : m1[2 * j - 3];
        z[2 * j] = a + (pa - a) * ma; z[2 * j + 1] = b + (pb - b) * mb; }
}
template <class MP> DI f32x4 lerp4(const bf16* crow_, const bf16* prow_, int col, MP mu) {
    const v2u cur = *(const v2u*)(crow_ + col); const v2u prv = *(const v2u*)(prow_ + col);
    const f32x4 m = *(decltype(vec4p(mu)))(mu);
    f32x4 z; z[0] = bflo(cur.x) + (bflo(prv.x) - bflo(cur.x)) * m[0]; z[1] = bfhi(cur.x) + (bfhi(prv.x) - bfhi(cur.x)) * m[1];
    z[2] = bflo(cur.y) + (bflo(prv.y) - bflo(cur.y)) * m[2]; z[3] = bfhi(cur.y) + (bfhi(prv.y) - bfhi(cur.y)) * m[3]; return z;
}
DI void img_write(LAS unsigned char* img, const f32x4 (&x)[4], int fr, int fq) {
#pragma unroll
    for (int mb = 0; mb < 4; ++mb)
#pragma unroll
        for (int reg = 0; reg < 4; ++reg) *(LAS bf16*)(img + (16 * mb + 4 * fq + reg) * 32 + fr * 2) = (bf16)pk2z(x[mb][reg]);
}
DI bf16x8 lds4z(const LAS unsigned char* p) { const v2u t = *(const LAS v2u*)p; v4u w; w.x = t.x; w.y = t.y; w.z = 0u; w.w = 0u; return __builtin_bit_cast(bf16x8, w); }
constexpr int HC_DUP = 0, HC_IUP = 9216, HC_VUP = 18432, HC_F = 23552, HC_BYTES = 23552 + 736 * 4;
enum { HF_MUR = 0, HF_MUK = 64, HF_MUV = 128, HF_MUW = 192, HF_MUA = 256, HF_MUVR = 320, HF_DB = 352, HF_IB = 416, HF_VB = 480, HF_SK = 544, HF_SA = 608, HF_BR = 672 };
DI void head_cache_fill(const RwkvP& P, int h, LAS unsigned char* hc, int tid) {
    { const int row = tid >> 3, ch = tid & 7;
      *(LAS v4u*)(hc + HC_DUP + row * 144 + ch * 16) = *(const v4u*)(P.dupT + (size_t)(h * 64 + row) * 64 + ch * 8);
      *(LAS v4u*)(hc + HC_IUP + row * 144 + ch * 16) = *(const v4u*)(P.iupT + (size_t)(h * 64 + row) * 64 + ch * 8); }
    if (tid < 256 && !P.layer0) { const int row = tid >> 2, ch = tid & 3; *(LAS v4u*)(hc + HC_VUP + row * 80 + ch * 16) = *(const v4u*)(P.vupT + (size_t)(h * 64 + row) * 32 + ch * 8); }
    LAS float* f = (LAS float*)(hc + HC_F);
    if (tid < 64) { const int c = h * 64 + tid; f[HF_MUR + tid] = P.mu[c]; f[HF_MUK + tid] = P.mu[512 + c]; f[HF_MUV + tid] = P.mu[1024 + c]; f[HF_MUW + tid] = P.mu[1536 + tid]; f[HF_MUA + tid] = P.mu[1600 + tid];
        f[HF_DB + tid] = P.dbase[c]; f[HF_IB + tid] = P.ibase[c]; f[HF_VB + tid] = P.layer0 ? 0.f : P.vbase[c]; f[HF_SK + tid] = P.ksk[c]; f[HF_SA + tid] = P.ksa[c]; f[HF_BR + tid] = P.brk[c];
        if (tid < 32) f[HF_MUVR + tid] = P.layer0 ? 0.f : P.muv[tid]; }
}
DI void rwkv_b1_unit(const RwkvP& P, int unit, LAS unsigned char* wl, const LAS unsigned char* hc, int lane) {
    asm volatile("" : "+v"(lane));
    const int fr = lane & 15, fq = lane >> 4;
    const int seq = unit >> 9, c = unit & 511, b = seq >> 3, h = seq & 7;
    const size_t row = (size_t)b * TSEQ + 16 * c + fr;
    const bool hasprev = (c | fr) != 0;
    const bf16* crp = P.PR + row * PRP; const bf16* prp = hasprev ? crp - PRP : P.ZROW;
    const f32x4 z4 = {0.f, 0.f, 0.f, 0.f};
    const LAS float* hf = (const LAS float*)(hc + HC_F);
    bf16x8 tw[2], al[2], vl;
#pragma unroll
    for (int ks = 0; ks < 2; ++ks) { float z[8]; lerp8(crp, prp, 1536 + 8 * fq + 32 * ks, hf + HF_MUW + 8 * fq + 32 * ks, z);
        tw[ks] = pk8(ftanh(z[0]), ftanh(z[1]), ftanh(z[2]), ftanh(z[3]), ftanh(z[4]), ftanh(z[5]), ftanh(z[6]), ftanh(z[7]));
        lerp8(crp, prp, 1600 + 8 * fq + 32 * ks, hf + HF_MUA + 8 * fq + 32 * ks, z); al[ks] = pk8(z[0], z[1], z[2], z[3], z[4], z[5], z[6], z[7]); }
    if (!P.layer0) { float z[8]; lerp8(crp, prp, 1792 + 8 * fq, hf + HF_MUVR + 8 * fq, z); vl = pk8(z[0], z[1], z[2], z[3], z[4], z[5], z[6], z[7]); }
    f32x4 zr[4], k2[4], kk[4], ai[4], ld[4];
    float nrm = 0.f, bon = 0.f;
#pragma unroll
    for (int mb = 0; mb < 4; ++mb) { const int ch = h * 64 + 16 * mb + 4 * fq; const int n = h * 64 + 16 * mb + fr;
        f32x4 dw = z4, da = z4, dv = z4;
        dw = mfma16(*(const LAS bf16x8*)(hc + HC_DUP + (16 * mb + fr) * 144 + 16 * fq), tw[0], dw); dw = mfma16(*(const LAS bf16x8*)(hc + HC_DUP + (16 * mb + fr) * 144 + 16 * fq + 64), tw[1], dw);
        da = mfma16(*(const LAS bf16x8*)(hc + HC_IUP + (16 * mb + fr) * 144 + 16 * fq), al[0], da); da = mfma16(*(const LAS bf16x8*)(hc + HC_IUP + (16 * mb + fr) * 144 + 16 * fq + 64), al[1], da);
        if (!P.layer0) dv = mfma16(*(const LAS bf16x8*)(hc + HC_VUP + (16 * mb + fr) * 80 + 16 * fq), vl, z4);
        const int cl = 16 * mb + 4 * fq;
        zr[mb] = lerp4(crp, prp, ch, hf + HF_MUR + cl);
        const f32x4 zk = lerp4(crp, prp, 512 + ch, hf + HF_MUK + cl);
        f32x4 zv = lerp4(crp, prp, 1024 + ch, hf + HF_MUV + cl);
        const f32x4 db = *(const LAS f32x4*)(hf + HF_DB + cl), ib = *(const LAS f32x4*)(hf + HF_IB + cl), sk = *(const LAS f32x4*)(hf + HF_SK + cl), sa = *(const LAS f32x4*)(hf + HF_SA + cl), br = *(const LAS f32x4*)(hf + HF_BR + cl);
        if (P.layer0) { v2u w; w.x = pk2(zv[0], zv[1]); w.y = pk2(zv[2], zv[3]); *(v2u*)(P.VF + row * 512 + ch) = w; }
        else { const v2u f = *(const v2u*)(P.VF + row * 512 + ch); const f32x4 vb = *(const LAS f32x4*)(hf + HF_VB + cl); const f32x4 vf = {bflo(f.x), bfhi(f.x), bflo(f.y), bfhi(f.y)};
#pragma unroll
            for (int e = 0; e < 4; ++e) zv[e] = zv[e] + (vf[e] - zv[e]) * fsigmoid(vb[e] + dv[e]); }
        { v2u w; w.x = pk2(zv[0], zv[1]); w.y = pk2(zv[2], zv[3]); *(v2u*)(P.VV + row * 512 + ch) = w; }
#pragma unroll
        for (int reg = 0; reg < 4; ++reg) *(LAS bf16*)(wl + 2 * B1_IMG + (16 * mb + 4 * fq + reg) * 32 + fr * 2) = (bf16)pk2z(zv[reg]);
#pragma unroll
        for (int e = 0; e < 4; ++e) {
            ld[mb][e] = fexp(-0.60653065971f * fsigmoid(db[e] + dw[e]));
            const float a = fsigmoid(ib[e] + da[e]); ai[mb][e] = a;
            const float kr = zk[e] * sk[e]; kk[mb][e] = kr; nrm += kr * kr;
            const float kx = zk[e] * (1.f + (a - 1.f) * sa[e]); k2[mb][e] = kx; bon += zr[mb][e] * kx * br[e]; }
        asm volatile("" ::: "memory");
    }
    nrm += __shfl_xor(nrm, 16); nrm += __shfl_xor(nrm, 32); bon += __shfl_xor(bon, 16); bon += __shfl_xor(bon, 32);
    if (fq == 0) P.BON[row * 8 + h] = bon;
    const float kinv = 1.0f / fmaxf(sqrtf(nrm), 1e-12f);
    f32x4 rt[4], kh[4];
    bf16x8 pa[2], pb[2], pk[2], pr[2];
#pragma unroll
    for (int ks = 0; ks < 2; ++ks) {
        f32x4 at2[2], bt2[2], kt2[2];
#pragma unroll
        for (int m2 = 0; m2 < 2; ++m2) { const int mb = 2 * ks + m2;
            f32x4 gcv, bhv;
#pragma unroll
            for (int e = 0; e < 4; ++e) {
                float gm = ld[mb][e]; gm *= dpp_shr1(gm, 1); gm *= dpp_shr1(gm, 2); gm *= dpp_shr1(gm, 4); gm *= dpp_shr1(gm, 8);
                const float gc = __shfl(gm, lane | 15), gp = dpp_shr1(gm, 1), gi = __builtin_amdgcn_rcpf(gm), ec = gc * gi;
                const float kn = kk[mb][e] * kinv, bb = kn * ai[mb][e];
                at2[m2][e] = -kn * gp; bt2[m2][e] = bb * gi; kt2[m2][e] = k2[mb][e] * gi; rt[mb][e] = zr[mb][e] * gm;
                bhv[e] = bb * ec; kh[mb][e] = k2[mb][e] * ec; gcv[e] = gc; }
            if (fr == 0) *(f32x4*)(P.GC + (size_t)unit * 64 + 16 * mb + 4 * fq) = gcv;
#pragma unroll
            for (int reg = 0; reg < 4; ++reg) { const int o = (16 * mb + 4 * fq + reg) * 32 + fr * 2;
                *(LAS bf16*)(wl + 0 * B1_IMG + o) = (bf16)pk2z(at2[m2][reg]); *(LAS bf16*)(wl + 1 * B1_IMG + o) = (bf16)pk2z(bhv[reg]); }
        }
        pa[ks] = pk8v(at2[0], at2[1]); pb[ks] = pk8v(bt2[0], bt2[1]); pk[ks] = pk8v(kt2[0], kt2[1]); pr[ks] = pk8v(rt[2 * ks], rt[2 * ks + 1]);
    }
    const f32x4 z4b = {0.f, 0.f, 0.f, 0.f};
    f32x4 Aab = mfma16(pb[1], pa[1], mfma16(pb[0], pa[0], z4b));
    f32x4 AakT = mfma16(pa[1], pk[1], mfma16(pa[0], pk[0], z4b));
    f32x4 Arb = mfma16(pb[1], pr[1], mfma16(pb[0], pr[0], z4b));
    f32x4 Ark = mfma16(pk[1], pr[1], mfma16(pk[0], pr[0], z4b));
#pragma unroll
    for (int e = 0; e < 4; ++e) { const int rr = 4 * fq + e; Aab[e] = rr < fr ? Aab[e] : 0.f; AakT[e] = fr < rr ? AakT[e] : 0.f; Arb[e] = rr <= fr ? Arb[e] : 0.f; Ark[e] = rr <= fr ? Ark[e] : 0.f; }
    LAS float* As = (LAS float*)(wl + 5 * B1_IMG);
#pragma unroll
    for (int e = 0; e < 4; ++e) As[(4 * fq + e) * 16 + fr] = Aab[e];
    LDS_WAIT();
    float x[16];
#pragma unroll
    for (int s = 15; s >= 0; --s) { float acc = (s == fr) ? 1.f : 0.f;
        const f32x4 r0 = *(const LAS f32x4*)(As + s * 16), r1 = *(const LAS f32x4*)(As + s * 16 + 4), r2 = *(const LAS f32x4*)(As + s * 16 + 8), r3 = *(const LAS f32x4*)(As + s * 16 + 12);
        const float rowv[16] = {r0[0], r0[1], r0[2], r0[3], r1[0], r1[1], r1[2], r1[3], r2[0], r2[1], r2[2], r2[3], r3[0], r3[1], r3[2], r3[3]};
#pragma unroll
        for (int uu = s + 1; uu < 16; ++uu) acc += rowv[uu] * x[uu];
        x[s] = acc; if ((s & 1) == 0) asm volatile("" ::: "memory"); }
    f32x4 xs;
#pragma unroll
    for (int e = 0; e < 4; ++e) xs[e] = fq == 0 ? x[e] : fq == 1 ? x[4 + e] : fq == 2 ? x[8 + e] : x[12 + e];
    const bf16x8 Tsel = pk4z(xs);
    f32x4 W1[4];
#pragma unroll
    for (int mb = 0; mb < 4; ++mb) W1[mb] = mfma16(lds4z(wl + 0 * B1_IMG + (16 * mb + fr) * 32 + 8 * fq), Tsel, z4);
    const f32x4 GT = mfma16(Tsel, pk4z(AakT), z4);
    img_write(wl + 3 * B1_IMG, W1, fr, fq);
    f32x4 M1T[4];
    const bf16x8 GTp = pk4z(GT);
#pragma unroll
    for (int mb = 0; mb < 4; ++mb) M1T[mb] = mfma16(lds4z(wl + 1 * B1_IMG + (16 * mb + fr) * 32 + 8 * fq), GTp, kh[mb]);
    img_write(wl + 4 * B1_IMG, M1T, fr, fq);
    LDS_WAIT();
    const bf16x8 Arbp = pk4z(Arb);
    f32x4 RE[4];
#pragma unroll
    for (int mb = 0; mb < 4; ++mb) RE[mb] = mfma16(lds4z(wl + 3 * B1_IMG + (16 * mb + fr) * 32 + 8 * fq), Arbp, rt[mb]);
    const f32x4 M2 = mfma16(GTp, Arbp, Ark);
    {   bf16* w1s = P.W1S + ((size_t)unit * 16 + fr) * 64; bf16* re = P.REFF + ((size_t)unit * 16 + fr) * 64;
#pragma unroll
        for (int mb = 0; mb < 4; ++mb) { const int sg = (mb >> 1) * 32 + fq * 8 + (mb & 1) * 4;
            v2u w; w.x = pk2(W1[mb][0], W1[mb][1]); w.y = pk2(W1[mb][2], W1[mb][3]); *(v2u*)(w1s + sg) = w;
            w.x = pk2(RE[mb][0], RE[mb][1]); w.y = pk2(RE[mb][2], RE[mb][3]); *(v2u*)(re + sg) = w; }
        const v2u m2p = {pk2(M2[0], M2[1]), pk2(M2[2], M2[3])};
#pragma unroll
        for (int mb = 0; mb < 4; ++mb) {
            const v2u bq = *(const LAS v2u*)(wl + 1 * B1_IMG + (16 * mb + fr) * 32 + 8 * fq), mq = *(const LAS v2u*)(wl + 4 * B1_IMG + (16 * mb + fr) * 32 + 8 * fq);
            *(v4u*)(P.BM + (((size_t)unit * 64 + 16 * mb + fr) * 4 + fq) * 8) = (v4u){bq.x, bq.y, mq.x, mq.y};
            const v2u vq = *(const LAS v2u*)(wl + 2 * B1_IMG + (16 * mb + fr) * 32 + 8 * fq);
            P.REC[((size_t)unit * 4 + mb) * 64 + lane] = (v4u){vq.x, vq.y, m2p.x, m2p.y}; }
    }
    LDS_WAIT();
}
constexpr int NSEG = 16, SEGCH = NCH / NSEG;
struct ChainIn { bf16x8 w1[2], re[2], bm[4]; v4u rec; f32x4 gc[4]; };
template <int MODE> DI void chain_load(ChainIn& c, const RwkvP& P, int unit, int rb, int lane) {
    const int fr = lane & 15, fq = lane >> 4;
    const bf16* w1s = P.W1S + ((size_t)unit * 16 + fr) * 64 + fq * 8;
    c.w1[0] = ld8(w1s); c.w1[1] = ld8(w1s + 32);
    if (MODE == 2) { const bf16* re = P.REFF + ((size_t)unit * 16 + fr) * 64 + fq * 8; c.re[0] = ld8(re); c.re[1] = ld8(re + 32); }
#pragma unroll
    for (int mb = 0; mb < 4; ++mb) { c.bm[mb] = ld8(P.BM + (((size_t)unit * 64 + 16 * mb + fr) * 4 + fq) * 8); c.gc[mb] = *(const f32x4*)(P.GC + (size_t)unit * 64 + 16 * mb + 4 * fq); }
    if (MODE != 1) c.rec = P.REC[((size_t)unit * 4 + rb) * 64 + lane];
}
template <int MODE> DI void chain_step(f32x4 (&S)[4], const ChainIn& c, float* ypre  ) {
    const f32x4 z4 = {0.f, 0.f, 0.f, 0.f};
    const bf16x8 b0 = pk8v(S[0], S[1]), b1 = pk8v(S[2], S[3]);
    f32x4 ut = mfma16(c.w1[1], b1, mfma16(c.w1[0], b0, z4));
    if (MODE == 2) {
        v4u vlo; vlo.x = c.rec.x; vlo.y = c.rec.y; vlo.z = 0u; vlo.w = 0u;
        v4u m2a; m2a.x = c.rec.z; m2a.y = c.rec.w; m2a.z = 0u; m2a.w = 0u;
        f32x4 y = mfma16(__builtin_bit_cast(bf16x8, m2a), __builtin_bit_cast(bf16x8, vlo), z4);
        y = mfma16(c.re[0], b0, y); y = mfma16(c.re[1], b1, y);
#pragma unroll
        for (int e = 0; e < 4; ++e) ypre[(size_t)e * 512] = y[e];
    }
    v4u uv; uv.x = pk2(ut[0], ut[1]); uv.y = pk2(ut[2], ut[3]); uv.z = MODE == 1 ? 0u : c.rec.x; uv.w = MODE == 1 ? 0u : c.rec.y;
    const bf16x8 ub = __builtin_bit_cast(bf16x8, uv);
#pragma unroll
    for (int mb = 0; mb < 4; ++mb) S[mb] = mfma16(c.bm[mb], ub, S[mb] * c.gc[mb]);
}
template <int MODE> DI void chain_run(f32x4 (&S)[4], const RwkvP& P, int unit0, int nsteps  , int rb, float* yp, int lane) {
    ChainIn c0, c1, c2;
    chain_load<MODE>(c0, P, unit0, rb, lane); chain_load<MODE>(c1, P, unit0 + 1, rb, lane);
    int c = 0;
    for (; c + 3 <= nsteps; c += 3) {
        chain_load<MODE>(c2, P, unit0 + c + 2, rb, lane);
        chain_step<MODE>(S, c0, yp + (size_t)c * 16 * 512);
        if (c + 3 < nsteps) chain_load<MODE>(c0, P, unit0 + c + 3, rb, lane);
        chain_step<MODE>(S, c1, yp + (size_t)(c + 1) * 16 * 512);
        if (c + 4 < nsteps) chain_load<MODE>(c1, P, unit0 + c + 4, rb, lane);
        chain_step<MODE>(S, c2, yp + (size_t)(c + 2) * 16 * 512);
    }
    if (c < nsteps) { chain_step<MODE>(S, c0, yp + (size_t)c * 16 * 512); ++c; }
    if (c < nsteps) { chain_step<MODE>(S, c1, yp + (size_t)c * 16 * 512); ++c; }
}
template <int MODE> DI void chain_run2(f32x4 (&S)[4], const RwkvP& P, int unit0, int nsteps  , int rb, float* yp, int lane) {
    ChainIn ca, cb;
    chain_load<MODE>(ca, P, unit0, rb, lane);
    for (int c = 0; c < nsteps; c += 2) {
        chain_load<MODE>(cb, P, unit0 + c + 1, rb, lane);
        asm volatile("" ::: "memory");
        chain_step<MODE>(S, ca, yp + (size_t)c * 16 * 512);
        if (c + 2 < nsteps) chain_load<MODE>(ca, P, unit0 + c + 2, rb, lane);
        asm volatile("" ::: "memory");
        chain_step<MODE>(S, cb, yp + (size_t)(c + 1) * 16 * 512);
    }
}
DI void chain_pass1(const RwkvP& P, float* QSEG, float* PSEGT, int seq, int g, int part, int rb, int lane) {
    const int fr = lane & 15, fq = lane >> 4;
    f32x4 S[4];
#pragma unroll
    for (int mb = 0; mb < 4; ++mb)
#pragma unroll
        for (int e = 0; e < 4; ++e) S[mb][e] = (part == 1 && (16 * mb + 4 * fq + e) == (16 * rb + fr)) ? 1.f : 0.f;
    const int unit0 = seq * NCH + g * SEGCH;
    if (part == 0) chain_run<0>(S, P, unit0, SEGCH, rb, nullptr, lane); else chain_run<1>(S, P, unit0, SEGCH, rb, nullptr, lane);
    const size_t sb = ((size_t)seq * NSEG + g) * 4096;
    if (part == 0) {
#pragma unroll
        for (int mb = 0; mb < 4; ++mb) *(f32x4*)(QSEG + sb + (size_t)(16 * rb + fr) * 64 + 16 * mb + 4 * fq) = S[mb];
    } else {
#pragma unroll
        for (int mb = 0; mb < 4; ++mb)
#pragma unroll
            for (int e = 0; e < 4; ++e) PSEGT[sb + (size_t)(16 * mb + 4 * fq + e) * 64 + 16 * rb + fr] = S[mb][e];
    }
}
DI void split_hl(const f32x4 a, const f32x4 b, bf16x8& hi, bf16x8& lo) {
    f32x4 ah, bh;
#pragma unroll
    for (int e = 0; e < 4; ++e) { ah[e] = rbf(a[e]); bh[e] = rbf(b[e]); }
    hi = pk8v(ah, bh); lo = pk8v(a - ah, b - bh);
}
DI void chain_pass23(const RwkvP& P, const float* QSEG, const float* PSEGT, int seq, int g, int rb, float* wkv_out, int lane) {
    const int fr = lane & 15, fq = lane >> 4, b = seq >> 3, h = seq & 7;
    f32x4 S[4]; for (int mb = 0; mb < 4; ++mb) S[mb] = (f32x4){0.f, 0.f, 0.f, 0.f};
    f32x4 pc[4][2][2], pn[4][2][2];
#define P2_LOAD(PD_, GP_) do { const size_t sb_ = ((size_t)seq * NSEG + (GP_)) * 4096; _Pragma("unroll") for (int mb = 0; mb < 4; ++mb) { \
        _Pragma("unroll") for (int ks = 0; ks < 2; ++ks) { const float* pr_ = PSEGT + sb_ + (size_t)(16 * mb + fr) * 64 + 32 * ks + 4 * fq; PD_[mb][ks][0] = *(const f32x4*)pr_; PD_[mb][ks][1] = *(const f32x4*)(pr_ + 16); } } } while (0)
    if (g > 0) P2_LOAD(pc, 0);
    for (int gp = 0; gp < g; ++gp) {
        f32x4 qc[4];
        { const size_t sb_ = ((size_t)seq * NSEG + gp) * 4096;
#pragma unroll
          for (int mb = 0; mb < 4; ++mb) qc[mb] = *(const f32x4*)(QSEG + sb_ + (size_t)(16 * rb + fr) * 64 + 16 * mb + 4 * fq); }
        if (gp + 1 < g) P2_LOAD(pn, gp + 1);
        bf16x8 bh[2], bl[2]; split_hl(S[0], S[1], bh[0], bl[0]); split_hl(S[2], S[3], bh[1], bl[1]);
#pragma unroll
        for (int mb = 0; mb < 4; ++mb) { f32x4 acc = {0.f, 0.f, 0.f, 0.f};
#pragma unroll
            for (int ks = 0; ks < 2; ++ks) { bf16x8 ah, al; split_hl(pc[mb][ks][0], pc[mb][ks][1], ah, al);
                acc = mfma16(ah, bh[ks], acc); acc = mfma16(al, bh[ks], acc); acc = mfma16(ah, bl[ks], acc); }
            S[mb] = acc + qc[mb]; }
#pragma unroll
        for (int mb = 0; mb < 4; ++mb) {
#pragma unroll
            for (int ks = 0; ks < 2; ++ks) { pc[mb][ks][0] = pn[mb][ks][0]; pc[mb][ks][1] = pn[mb][ks][1]; } }
    }
#undef P2_LOAD
    float* yp = P.YPRE + ((size_t)b * TSEQ + (size_t)g * SEGCH * 16 + 4 * fq) * 512 + h * 64 + 16 * rb + fr;
    chain_run<2>(S, P, seq * NCH + g * SEGCH, SEGCH, rb, yp, lane);
    if (g == NSEG - 1) {
#pragma unroll
        for (int mb = 0; mb < 4; ++mb) *(f32x4*)(wkv_out + (size_t)(16 * rb + fr) * 64 + 16 * mb + 4 * fq) = S[mb];
    }
}
DI void rwkv_b3_unit(const RwkvP& P, int unit, int lane) {
    asm volatile("" : "+v"(lane));
    const int fr = lane & 15, fq = lane >> 4;
    const int seq = unit >> 9, c = unit & 511, b = seq >> 3, h = seq & 7;
    const size_t row = (size_t)b * TSEQ + 16 * c + fr;
    const bool hasprev = (c | fr) != 0;
    const bf16* crp = P.PR + row * PRP; const bf16* prp = hasprev ? crp - PRP : P.ZROW;
    const f32x4 z4 = {0.f, 0.f, 0.f, 0.f};
    bf16x8 sg[4];
#pragma unroll
    for (int ks = 0; ks < 4; ++ks) { float z[8]; lerp8(crp, prp, 1664 + 8 * fq + 32 * ks, P.mu + 1664 + 8 * fq + 32 * ks, z);
        sg[ks] = pk8(fsigmoid(z[0]), fsigmoid(z[1]), fsigmoid(z[2]), fsigmoid(z[3]), fsigmoid(z[4]), fsigmoid(z[5]), fsigmoid(z[6]), fsigmoid(z[7])); }
    f32x4 g[4], y[4]; float s = 0.f;
#pragma unroll
    for (int mb = 0; mb < 4; ++mb) { const int n = h * 64 + 16 * mb + fr; f32x4 a = z4;
#pragma unroll
        for (int ks = 0; ks < 4; ++ks) a = mfma16(ld8(P.gupT + (size_t)n * 128 + 8 * fq + 32 * ks), sg[ks], a);
        g[mb] = a;
        y[mb] = *(const f32x4*)(P.YPRE + row * 512 + h * 64 + 16 * mb + 4 * fq); s += (y[mb][0] + y[mb][1]) + (y[mb][2] + y[mb][3]); }
    s += __shfl_xor(s, 16); s += __shfl_xor(s, 32);
    const float mean = s * (1.f / 64.f); float q = 0.f;
#pragma unroll
    for (int mb = 0; mb < 4; ++mb) { y[mb] = y[mb] - mean; q += (y[mb][0] * y[mb][0] + y[mb][1] * y[mb][1]) + (y[mb][2] * y[mb][2] + y[mb][3] * y[mb][3]); }
    q += __shfl_xor(q, 16); q += __shfl_xor(q, 32);
    const float rstd = 1.0f / sqrtf(q * (1.f / 64.f) + GN_EPS);
    const float bon = P.BON[row * 8 + h];
#pragma unroll
    for (int mb = 0; mb < 4; ++mb) { const int ch = h * 64 + 16 * mb + 4 * fq;
        const f32x4 gg = *(const f32x4*)(P.gng + ch), gb = *(const f32x4*)(P.gnb + ch); const v2u vw = *(const v2u*)(P.VV + row * 512 + ch);
        const f32x4 v = {bflo(vw.x), bfhi(vw.x), bflo(vw.y), bfhi(vw.y)};
        const f32x4 o = (y[mb] * rstd * gg + gb + v * bon) * g[mb];
        v2u w; w.x = pk2(o[0], o[1]); w.y = pk2(o[2], o[3]); *(v2u*)(P.MIX + row * 1024 + 512 + ch) = w; }
}
DI f32x16 dec_gemm(const bf16* A, const bf16* Wt, int K, LAS float* red  , int wave, int lane) {
    const int r = lane & 31, h = lane >> 5, kw = K >> 3;
    const bf16* ap = A + (size_t)r * K + wave * kw + 8 * h; const bf16* bp = Wt + (size_t)r * K + wave * kw + 8 * h;
    f32x16 acc; for (int i = 0; i < 16; ++i) acc[i] = 0.f;
#pragma unroll 16
    for (int k = 0; k < kw; k += 16) acc = mfma32(ld8(ap + k), ld8(bp + k), acc);
    __syncthreads();
#pragma unroll
    for (int i = 0; i < 16; ++i) red[(wave * 16 + i) * 64 + lane] = acc[i];
    __syncthreads();
    if (wave == 0) {
#pragma unroll
        for (int i = 0; i < 16; ++i) { float s = 0.f;
#pragma unroll
            for (int w = 0; w < 8; ++w) s += red[(w * 16 + i) * 64 + lane];
            asm volatile("" : "+v"(s) :: "memory"); acc[i] = s; } }
    return acc;
}
DI void dec_row_stats(const float* st, LAS float* sc, int lane) {
    if (lane < 32) { float s = 0.f, q = 0.f; const f32x4* p = (const f32x4*)(st + (size_t)lane * 64);
#pragma unroll
        for (int i = 0; i < 16; ++i) { const f32x4 v = p[i]; s += v[0] + v[2]; q += v[1] + v[3]; if ((i & 3) == 3) asm volatile("" : "+v"(s), "+v"(q) :: "memory"); }
        const float mu = s * (1.f / 1024.f), var = fmaxf(q * (1.f / 1024.f) - mu * mu, 0.f); sc[2 * lane] = mu; sc[2 * lane + 1] = 1.0f / sqrtf(var + LN_EPS); }
    LDS_WAIT();
}
struct DecP {
    unsigned char* dec; int l;
    const float* xs;
    const float *c1in, *c2in, *c1up, *c2up, *g1, *b1, *g2p, *b2p;
    const bf16 *win, *winu, *wout, *wup, *wdn;
    float* out;
};
DI void dec_unit_in(const DecP& D, int u, LAS float* red, LAS float* sc, int wave, int lane) {
    const int r32 = lane & 31, hi = lane >> 5;
    if (u < 105) {
        const int n = 32 * u + r32; const bool fold = D.l > 0;
        const f32x16 acc = dec_gemm((const bf16*)(D.dec + DEC_XB2), D.win + (size_t)(32 * u) * DM, DM, red, wave, lane);
        if (wave != 0) return;
        if (fold) dec_row_stats((const float*)(D.dec + DEC_ST2), sc, lane);
        const float c1 = fold ? D.c1in[n] : 0.f, c2 = fold ? D.c2in[n] : 0.f; const int on = n < 1024 ? swap45(n) : n;
        float* PD = (float*)(D.dec + DEC_PD);
#pragma unroll
        for (int i = 0; i < 16; ++i) { const int row = crow(i, hi); float mu = 0.f, rs = 1.f; if (fold) { mu = sc[2 * row]; rs = sc[2 * row + 1]; } PD[(size_t)row * NIN + on] = (acc[i] - mu * c1) * rs + c2; }
    } else {
        const int v = u - 105, n = 32 * v + r32;
        const f32x16 acc = dec_gemm((const bf16*)(D.dec + DEC_SHB) + (size_t)D.l * MD * DM, D.winu + (size_t)(32 * v) * DM, DM, red, wave, lane);
        if (wave != 0) return;
        float* PS = (float*)(D.dec + DEC_PS);
#pragma unroll
        for (int i = 0; i < 16; ++i) PS[(size_t)crow(i, hi) * NRWU + n] = acc[i];
    }
    LDS_WAIT();
}
DI void dec_unit_res(const bf16* A, const bf16* Wt, int K, int u, bool raw, const float* src, const float* sstat, const float* g, const float* b, float* T, bf16* XB, float* ostat, float* shiftout, LAS float* red, LAS float* sc, int wave, int lane) {
    const int r32 = lane & 31, hi = lane >> 5, n = 32 * u + r32;
    const f32x16 acc = dec_gemm(A, Wt + (size_t)(32 * u) * K, K, red, wave, lane);
    if (wave != 0) return;
    if (!raw) dec_row_stats(sstat, sc, lane);
    const float gg = raw ? 1.f : g[n], bb = raw ? 0.f : b[n];
#pragma unroll
    for (int i = 0; i < 16; ++i) { const int row = crow(i, hi); float mu = 0.f, rs = 1.f; if (!raw) { mu = sc[2 * row]; rs = sc[2 * row + 1]; }
        const float x = (src[(size_t)row * DM + n] - mu) * rs * gg + bb; const float t = ALPHA * x + acc[i];
        T[(size_t)row * DM + n] = t; XB[(size_t)row * DM + n] = (bf16)f2bf(t); if (shiftout) shiftout[(size_t)row * DM + n] = x;
        float s = t, q = t * t;
#pragma unroll
        for (int o = 1; o < 32; o <<= 1) { s += __shfl_xor(s, o); q += __shfl_xor(q, o); }
        if (r32 == 0) { ostat[((size_t)row * 32 + u) * 2] = s; ostat[((size_t)row * 32 + u) * 2 + 1] = q; } }
    LDS_WAIT();
}
DI void dec_unit_up(const DecP& D, int u, LAS float* red, LAS float* sc, int wave, int lane) {
    const int r32 = lane & 31, hi = lane >> 5, n = 32 * u + r32;
    const f32x16 acc = dec_gemm((const bf16*)(D.dec + DEC_XB1), D.wup + (size_t)(32 * u) * DM, DM, red, wave, lane);
    if (wave != 0) return;
    dec_row_stats((const float*)(D.dec + DEC_ST1), sc, lane);
    const float c1 = D.c1up[n], c2 = D.c2up[n]; bf16* HB = (bf16*)(D.dec + DEC_HB);
#pragma unroll
    for (int i = 0; i < 16; ++i) { const int row = crow(i, hi); const float v = fmaxf((acc[i] - sc[2 * row] * c1) * sc[2 * row + 1] + c2, 0.f); HB[(size_t)row * FFD + n] = (bf16)f2bf(v * v); }
    LDS_WAIT();
}
DI void dec_attn_task(const DecP& D, const float* ck, const float* cv, const float* rope, int bd, int h, int p, int lane) {
    const int g = lane >> 4, dq = lane & 15, dd = 1 << (2 * p);
    const float* PD = (const float*)(D.dec + DEC_PD) + (size_t)bd * NIN;
    const f32x4 rr0 = *(const f32x4*)(rope + ((size_t)8192 * 32 + ((4 * dq) & 31)) * 2), rr1 = *(const f32x4*)(rope + ((size_t)8192 * 32 + ((4 * dq) & 31)) * 2 + 4);
    const f32x4 cs = {rr0[0], rr0[2], rr1[0], rr1[2]}, sn = {rr0[1], rr0[3], rr1[1], rr1[3]};
    const float sgn = dq < 8 ? -1.f : 1.f;
    f32x4 q = *(const f32x4*)(PD + h * 64 + 4 * dq), kn = *(const f32x4*)(PD + 512 + h * 64 + 4 * dq); const f32x4 vn = *(const f32x4*)(PD + 1024 + h * 64 + 4 * dq);
    { f32x4 qp, kp;
#pragma unroll
      for (int e = 0; e < 4; ++e) { qp[e] = __shfl_xor(q[e], 8); kp[e] = __shfl_xor(kn[e], 8); }
      q = q * cs + qp * sn * sgn; kn = kn * cs + kp * sn * sgn; }
    if (p == 0 && g == 0) { *(f32x4*)(D.out + O_KS + ((size_t)D.l * MD + bd) * 512 + h * 64 + 4 * dq) = kn; *(f32x4*)(D.out + O_VS + ((size_t)D.l * MD + bd) * 512 + h * 64 + 4 * dq) = vn; }
    float s0 = (q[0] * kn[0] + q[1] * kn[1]) + (q[2] * kn[2] + q[3] * kn[3]);
#pragma unroll
    for (int o = 1; o < 16; o <<= 1) s0 += __shfl_xor(s0, o);
    s0 *= 0.125f;
    const size_t cbase = (((size_t)D.l * MD + bd) * 2048) * 512 + h * 64 + 4 * dq;
    float mx = -INFINITY, den = 0.f; f32x4 o4 = {0.f, 0.f, 0.f, 0.f};
#pragma unroll 8
    for (int it = 0; it < 32; ++it) { const int j = 1 + 4 * it + g; const size_t off = cbase + (size_t)(2048 - j * dd) * 512;
        const f32x4 kr = *(const f32x4*)(ck + off); const f32x4 vr = *(const f32x4*)(cv + off);
        float s = (q[0] * kr[0] + q[1] * kr[1]) + (q[2] * kr[2] + q[3] * kr[3]);
#pragma unroll
        for (int o = 1; o < 16; o <<= 1) s += __shfl_xor(s, o);
        s *= 0.125f;
        const float mn = fmaxf(mx, s), sc = fexp(mx - mn), pj = fexp(s - mn);
        den = den * sc + pj; o4 = o4 * sc + vr * pj; mx = mn; }
    float mg = fmaxf(mx, __shfl_xor(mx, 16)); mg = fmaxf(mg, __shfl_xor(mg, 32)); mg = fmaxf(mg, s0);
    { const float sc = fexp(mx - mg); den *= sc; o4 = o4 * sc; }
    den += __shfl_xor(den, 16); den += __shfl_xor(den, 32);
#pragma unroll
    for (int e = 0; e < 4; ++e) { o4[e] += __shfl_xor(o4[e], 16); o4[e] += __shfl_xor(o4[e], 32); }
    const float p0 = fexp(s0 - mg); den += p0; o4 = (o4 + vn * p0) * (1.0f / den); mx = mg;
    if (g == 0) *(f32x4*)((float*)(D.dec + DEC_OP) + ((size_t)p * MD + bd) * 512 + h * 64 + 4 * dq) = o4;
    if (lane == 0) ((float*)(D.dec + DEC_LSE))[((size_t)p * MD + bd) * 8 + h] = mx + __logf(den);
}
DI void dec_rwkv_task(const DecP& D, const float* const* in, int bd, int h, LAS float* sv  , int lane) {
    const int l = D.l, ch = h * 64 + lane;
    const float* PD = (const float*)(D.dec + DEC_PD) + (size_t)bd * NIN + RW0; const float* PS = (const float*)(D.dec + DEC_PS) + (size_t)bd * NRWU;
    const float* mu = in[8] + (size_t)l * 1792;
    auto zf = [&](int col) { const float pr = PD[col], pv = PS[col]; return pr + (pv - pr) * mu[col]; };
    const float zr = zf(ch), zk = zf(512 + ch), zv0 = zf(1024 + ch);
    float vl = 0.f; if (l > 0 && lane < 32) { const float pr = PD[1792 + lane], pv = PS[1792 + lane]; vl = pr + (pv - pr) * in[9][(size_t)(l - 1) * 32 + lane]; }
    sv[lane] = ftanh(zf(1536 + lane)); sv[64 + lane] = zf(1600 + lane); sv[128 + lane] = fsigmoid(zf(1664 + lane)); sv[192 + lane] = fsigmoid(zf(1728 + lane)); sv[256 + lane] = vl;
    LDS_WAIT();
    float dw = 0.f, da = 0.f, dv = 0.f, gt = 0.f;
    const float* du = in[11] + (size_t)l * 64 * 512 + ch; const float* iu = in[13] + (size_t)l * 64 * 512 + ch; const float* gu = in[14] + (size_t)l * 128 * 512 + ch;
#pragma unroll 2
    for (int m4 = 0; m4 < 16; ++m4) { const f32x4 a = *(const LAS f32x4*)(sv + 4 * m4), b = *(const LAS f32x4*)(sv + 64 + 4 * m4), c = *(const LAS f32x4*)(sv + 128 + 4 * m4), d = *(const LAS f32x4*)(sv + 192 + 4 * m4);
#pragma unroll
        for (int e = 0; e < 4; ++e) { const int m = 4 * m4 + e; dw += a[e] * du[(size_t)m * 512]; da += b[e] * iu[(size_t)m * 512]; gt += c[e] * gu[(size_t)m * 512] + d[e] * gu[(size_t)(64 + m) * 512]; } }
    if (l > 0) { const float* vu = in[16] + (size_t)(l - 1) * 32 * 512 + ch;
#pragma unroll
        for (int m4 = 0; m4 < 8; ++m4) { const f32x4 a = *(const LAS f32x4*)(sv + 256 + 4 * m4);
#pragma unroll
            for (int e = 0; e < 4; ++e) dv += a[e] * vu[(size_t)(4 * m4 + e) * 512]; } }
    const float w = -fsoftplus(-(in[10][(size_t)l * 512 + ch] + dw)) - 0.5f, decay = fexp(-fexp(w));
    const float a = fsigmoid(in[12][(size_t)l * 512 + ch] + da);
    float* VFD = (float*)(D.dec + DEC_VF) + (size_t)bd * 512 + ch;
    float v = zv0; if (l == 0) *VFD = zv0; else v = zv0 + (*VFD - zv0) * fsigmoid(in[15][(size_t)(l - 1) * 512 + ch] + dv);
    const float kr = zk * in[17][(size_t)l * 512 + ch]; const float kn = kr / fmaxf(sqrtf(wave_sum(kr * kr)), 1e-12f);
    const float k2 = zk * (1.f + (a - 1.f) * in[18][(size_t)l * 512 + ch]);
    const float bon = wave_sum(zr * k2 * in[19][(size_t)l * 512 + ch]);
    LDS_WAIT();
    sv[320 + lane] = -kn; sv[384 + lane] = decay; sv[448 + lane] = kn * a; sv[512 + lane] = k2; sv[576 + lane] = zr;
    LDS_WAIT();
    const float* S0 = in[3] + ((((size_t)l * MD + bd) * NH + h) * 64 + lane) * 64;
    float* So = D.out + O_WKS + ((((size_t)l * MD + bd) * NH + h) * 64 + lane) * 64;
    float sa = 0.f;
    { f32x4 Sr[16];
#pragma unroll
      for (int q = 0; q < 16; ++q) Sr[q] = *(const f32x4*)(S0 + 4 * q);
#pragma unroll
      for (int q = 0; q < 16; ++q) { const f32x4 a4 = *(const LAS f32x4*)(sv + 320 + 4 * q); sa += (Sr[q][0] * a4[0] + Sr[q][1] * a4[1]) + (Sr[q][2] * a4[2] + Sr[q][3] * a4[3]); } }
    asm volatile("" ::: "memory");
    float y = 0.f;
#pragma unroll 8
    for (int q = 0; q < 16; ++q) { const f32x4 s0 = *(const f32x4*)(S0 + 4 * q); const f32x4 w4 = *(const LAS f32x4*)(sv + 384 + 4 * q), b4 = *(const LAS f32x4*)(sv + 448 + 4 * q), k4 = *(const LAS f32x4*)(sv + 512 + 4 * q), r4 = *(const LAS f32x4*)(sv + 576 + 4 * q);
        const f32x4 s4 = s0 * w4 + b4 * sa + k4 * v; *(f32x4*)(So + 4 * q) = s4; y += (s4[0] * r4[0] + s4[1] * r4[1]) + (s4[2] * r4[2] + s4[3] * r4[3]); }
    const float mean = wave_sum(y) * (1.f / 64.f), dy = y - mean, var = wave_sum(dy * dy) * (1.f / 64.f);
    const float o = (dy * (1.0f / sqrtf(var + GN_EPS)) * in[20][(size_t)l * 512 + ch] + in[21][(size_t)l * 512 + ch] + bon * v) * gt;
    ((float*)(D.dec + DEC_MIX))[(size_t)bd * DM + 512 + ch] = o;
    LDS_WAIT();
}
DI void dec_finalize_row(const DecP& D, const float* gain, int bd, int lane) {
    const int h = lane >> 3; const float* L = (const float*)(D.dec + DEC_LSE); const float* OPD = (const float*)(D.dec + DEC_OP);
    const float l0 = L[((size_t)0 * MD + bd) * 8 + h], l1 = L[((size_t)1 * MD + bd) * 8 + h], l2 = L[((size_t)2 * MD + bd) * 8 + h];
    const float mx = fmaxf(l0, fmaxf(l1, l2)); float w0 = fexp(l0 - mx), w1 = fexp(l1 - mx), w2 = fexp(l2 - mx); const float inv = 1.0f / (w0 + w1 + w2); w0 *= inv; w1 *= inv; w2 *= inv;
    float v[8]; float ss = 0.f;
#pragma unroll
    for (int e = 0; e < 8; ++e) { v[e] = w0 * OPD[((size_t)0 * MD + bd) * 512 + lane * 8 + e] + w1 * OPD[((size_t)1 * MD + bd) * 512 + lane * 8 + e] + w2 * OPD[((size_t)2 * MD + bd) * 512 + lane * 8 + e]; ss += v[e] * v[e]; }
    ss = wave_sum(ss); const float rinv = 1.0f / sqrtf(ss * (1.f / 512.f) + RMS_EPS);
    bf16* MB = (bf16*)(D.dec + DEC_MIXB) + (size_t)bd * DM; const float* MX = (const float*)(D.dec + DEC_MIX) + (size_t)bd * DM + 512;
#pragma unroll
    for (int e = 0; e < 8; ++e) { MB[lane * 8 + e] = (bf16)f2bf(v[e] * rinv * gain[lane * 8 + e]); MB[512 + lane * 8 + e] = (bf16)f2bf(MX[lane * 8 + e]); }
}
#ifndef PH_MASK
#define PH_MASK 0x1ff
#endif
#define PH_ON(k) ((PH_MASK >> (k)) & 1)
#ifndef PH_DUP
#define PH_DUP 0
#endif
#define PH_REP(k) for (int rep_ = 0; rep_ < (((PH_DUP >> (k)) & 1) ? 2 : 1); ++rep_)
DI unsigned lds_task_next(volatile LAS unsigned* ctr, int lane) {
    unsigned t = 0; if (lane == 0) t = __hip_atomic_fetch_add((LAS unsigned*)ctr, 1u, __ATOMIC_RELAXED, __HIP_MEMORY_SCOPE_WORKGROUP);
    return (unsigned)__builtin_amdgcn_readfirstlane((int)t);
}
DI DecP make_dec(unsigned char* ws, const float* const* in, float* out, int l) {
    DecP D; D.dec = ws + WS_DEC; D.l = l; D.xs = in[1];
    D.c1in = (const float*)(ws + WS_C1IN) + l * NIN; D.c2in = (const float*)(ws + WS_C2IN) + l * NIN; D.c1up = (const float*)(ws + WS_C1UP) + l * FFD; D.c2up = (const float*)(ws + WS_C2UP) + l * FFD;
    D.g1 = in[24] + (size_t)l * DM; D.b1 = in[25] + (size_t)l * DM; D.g2p = l > 0 ? in[28] + (size_t)(l - 1) * DM : nullptr; D.b2p = l > 0 ? in[29] + (size_t)(l - 1) * DM : nullptr;
    D.win = (const bf16*)(ws + WS_WIN) + (size_t)l * NIN * DM; D.winu = (const bf16*)(ws + WS_WINU) + (size_t)l * NRWU * DM; D.wout = (const bf16*)(ws + WS_WOUT) + (size_t)l * DM * DM;
    D.wup = (const bf16*)(ws + WS_WUP) + (size_t)l * FFD * DM; D.wdn = (const bf16*)(ws + WS_WDN) + (size_t)l * DM * FFD; D.out = out; return D;
}
DI RwkvP make_rwkv(unsigned char* ws, const float* const* in, int l) {
    RwkvP R; R.PR = (const bf16*)(ws + WS_PR); R.mu = in[8] + (size_t)l * 1792; R.muv = l > 0 ? in[9] + (size_t)(l - 1) * 32 : nullptr;
    R.dbase = in[10] + (size_t)l * 512; R.ibase = in[12] + (size_t)l * 512; R.vbase = l > 0 ? in[15] + (size_t)(l - 1) * 512 : nullptr; R.ksk = in[17] + (size_t)l * 512; R.ksa = in[18] + (size_t)l * 512; R.brk = in[19] + (size_t)l * 512;
    R.gng = in[20] + (size_t)l * 512; R.gnb = in[21] + (size_t)l * 512;
    R.dupT = (const bf16*)(ws + WS_DUPT) + (size_t)l * 512 * 64; R.iupT = (const bf16*)(ws + WS_IUPT) + (size_t)l * 512 * 64; R.vupT = l > 0 ? (const bf16*)(ws + WS_VUPT) + (size_t)(l - 1) * 512 * 32 : nullptr; R.gupT = (const bf16*)(ws + WS_GUPT) + (size_t)l * 512 * 128;
    R.ZROW = (const bf16*)(ws + WS_CTL + 512 * 1024); R.VF = (bf16*)(ws + WS_VF); R.VV = (bf16*)(ws + WS_VV); R.BON = (float*)(ws + WS_BON); R.GC = (float*)(ws + WS_GC); R.W1S = (bf16*)(ws + WS_PT); R.REFF = (bf16*)(ws + WS_REFF); R.BM = (bf16*)(ws + WS_QT); R.REC = (v4u*)(ws + WS_YLOC);
    R.YPRE = (float*)(ws + WS_YPRE); R.MIX = (bf16*)(ws + WS_MIX); R.layer0 = (l == 0); return R;
}
#define PHASE_VARS() int tid_p = (int)threadIdx.x; asm volatile("" : "+v"(tid_p)); const int lane = tid_p & 63; const int wave = __builtin_amdgcn_readfirstlane(tid_p >> 6); \
    unsigned zo_p; asm volatile("s_mov_b32 %0, 0" : "=s"(zo_p)); unsigned char* ws = args.ws + zo_p; const float* const* in = args.in + zo_p; float* out = args.out + zo_p; \
    const int gw = F.vcu * NWAVES + wave; const int rgw = (F.G - 1 - (int)blockIdx.x) * NWAVES + wave; LAS float* dsc = (LAS float*)(L3 + 65536); LAS float* dred = (LAS float*)L3; const int rwg = F.G - 1 - (int)blockIdx.x; (void)gw; (void)rgw; (void)dsc; (void)dred; (void)rwg; (void)lane; (void)in; (void)out
__global__ void __launch_bounds__(NWAVES * 64, 2) mega_fwd(Args args) {
    extern __shared__ __attribute__((aligned(16))) unsigned char lds[];
    Frame F;
    F.lds = lds; F.MISC = (volatile LAS unsigned*)((LAS unsigned char*)lds + MISC_OFF);
    F.tid = threadIdx.x; F.lane = F.tid & 63; F.wave = __builtin_amdgcn_readfirstlane(F.tid >> 6);
    F.G = gridDim.x; { const int bx = blockIdx.x; F.vcu = (F.G % 8 == 0) ? (bx % 8) * (F.G / 8) + bx / 8 : bx; }
    F.gw = F.vcu * NWAVES + F.wave; F.NGW = F.G * NWAVES;
    F.in = args.in; F.out = args.out; F.ws = args.ws; F.ctl = (gu32*)(args.ws + WS_CTL);
    LAS unsigned char* L3 = (LAS unsigned char*)lds;
    for (int u = F.tid; u < (LDS_BYTES - RING_BYTES) / 4; u += NWAVES * 64) ((LAS unsigned*)(L3 + RING_BYTES))[u] = 0u;
    __syncthreads();
    XcdBarrier bar = xcd_barrier_post((unsigned*)(F.ctl + CW_BAR), F.MISC + 8);
#define GRID_BAR() do { XcdBarrier b2_ = bar; asm volatile("" : "+s"(b2_.x)); xcd_barrier(b2_); } while (0)

    PH_REP(0) { if (PH_ON(0)) p0_prologue(F);
    GRID_BAR(); }

    for (int l = 0; l < DEPTH; ++l) {
        PH_REP(1) {
        if (PH_ON(1))
        {   PHASE_VARS(); const DecP D = make_dec(ws, in, out, l);
            pg8::Gemm g{(const pg8::bf16_t*)(ws + WS_XB2), (const pg8::bf16_t*)D.win, M, NIN, DM}; pg8::StaticOrder S; S.init(M, NIN, F.G, (int)blockIdx.x);
            pg8::EpiIn E{ws, out, l};
            pg8::gemm_phase<pg8::EpiIn, pg8::StaticOrder, true, true>((PG8_LAS unsigned char*)L3, g, S, E, tid_p);
            for (int u = rwg; u < 162; u += F.G) dec_unit_in(D, u, dred, dsc, wave, lane);
        }
        GRID_BAR();
        }

#define ATT_QUEUE() do { LAS unsigned char* wl_ = L3 + wave * 10240; const int bh_ = F.vcu >> 4, span_ = F.vcu & 15; \
        for (;;) { const unsigned t_ = lds_task_next(F.MISC, lane); if (t_ >= 48u) break; \
            if (t_ >= 48u) { const int dt_ = (int)blockIdx.x * 4 + (int)(t_ - 48u); \
                if (dt_ < 768) dec_attn_task(D, in[4], in[5], (const float*)(ws + WS_ROPE), dt_ / 24, (dt_ % 24) / 3, dt_ % 3, lane); \
                else dec_rwkv_task(D, in, (dt_ - 768) >> 3, (dt_ - 768) & 7, (LAS float*)wl_, lane); continue; } \
            const int p_ = (int)t_ >> 4, idx_ = (int)t_ & 15; \
            const int cls_ = p_ == 0 ? 0 : p_ == 1 ? (idx_ >> 2) : idx_, qblk_ = p_ == 0 ? span_ * 16 + idx_ : p_ == 1 ? span_ * 4 + (idx_ & 3) : span_; \
            attn_task((const bf16*)(ws + WS_QB), (const bf16*)(ws + WS_KB), (const bf16*)(ws + WS_VB), (bf16*)(ws + WS_OP), (float*)(ws + WS_LSE), bh_ >> 3, bh_ & 7, p_, cls_, qblk_, wl_, lane); } } while (0)
        PH_REP(3) {
        if (PH_ON(3))
        {   PHASE_VARS(); const DecP D = make_dec(ws, in, out, l); const RwkvP R = make_rwkv(ws, in, l);
            if (tid_p == 0) F.MISC[0] = 0u;
            if (l == 0) colsum_finish(ws, gw * 64 + lane, F.NGW * 64);
            { LAS unsigned char* wl1 = L3 + wave * 12288; LAS unsigned char* hc = L3 + 8 * 12288;
              head_cache_fill(R, (F.vcu >> 4) & 7, hc, tid_p);
              __syncthreads();
#pragma unroll 1
              for (int i = 0; i < 4; ++i) rwkv_b1_unit(R, F.vcu * 32 + wave + 8 * i, wl1, hc, lane); }
            VM_WAIT(); __syncthreads();
            if (wave >= 4) { const int dt = (int)blockIdx.x * 4 + (wave - 4);
                if (dt < 768) dec_attn_task(D, in[4], in[5], (const float*)(ws + WS_ROPE), dt / 24, (dt % 24) / 3, dt % 3, lane);
                else dec_rwkv_task(D, in, (dt - 768) >> 3, (dt - 768) & 7, (LAS float*)(L3 + wave * 10240), lane); }
            PH_REP(13) chain_pass1(R, (float*)(ws + WS_SEGQ), (float*)(ws + WS_SEGP), F.vcu >> 4, F.vcu & 15, wave >> 2, wave & 3, lane);
            ATT_QUEUE();
            if ((PH_DUP >> 12) & 1) { __syncthreads(); if (tid_p == 0) F.MISC[0] = 0u; __syncthreads(); ATT_QUEUE(); }
        }
        GRID_BAR();
        }
        PH_REP(9) {
        if (PH_ON(3))
        {   PHASE_VARS(); const DecP D = make_dec(ws, in, out, l); const RwkvP R = make_rwkv(ws, in, l);
            const int seq = F.vcu >> 4, sg = F.vcu & 15;
            if (wave < 4) chain_pass23(R, (const float*)(ws + WS_SEGQ), (const float*)(ws + WS_SEGP), seq, sg, wave, out + O_WKP + ((size_t)l * 16 + seq) * 4096, lane);
            else { for (int i = 0; i < 16; ++i) attn_finalize_row((const bf16*)(ws + WS_OP), (const float*)(ws + WS_LSE), in[22] + (size_t)l * 512, (bf16*)(ws + WS_MIX), (int)blockIdx.x * 64 + (wave - 4) * 16 + i, lane);
                if (blockIdx.x < MD && wave == 4) dec_finalize_row(D, in[22] + (size_t)l * 512, (int)blockIdx.x, lane); }
            VM_WAIT(); __syncthreads();
#pragma unroll 1
            for (int i = 0; i < 4; ++i) rwkv_b3_unit(R, seq * NCH + sg * SEGCH + wave + 8 * i, lane);
        }
        GRID_BAR();
        }

        PH_REP(5) {
        if (PH_ON(5))
        {   PHASE_VARS(); const DecP D = make_dec(ws, in, out, l);
            pg8::Gemm g{(const pg8::bf16_t*)(ws + WS_MIX), (const pg8::bf16_t*)D.wout, M, DM, DM}; pg8::StaticOrder S; S.init(M, DM, F.G, (int)blockIdx.x);
            pg8::EpiRes<false> E{ws, in, out, l};
            pg8::gemm_phase<pg8::EpiRes<false>, pg8::StaticOrder, false, true>((PG8_LAS unsigned char*)L3, g, S, E, tid_p);
            for (int u = rwg; u < 32; u += F.G)
                dec_unit_res((const bf16*)(D.dec + DEC_MIXB), D.wout, DM, u, l == 0, l == 0 ? D.xs : (const float*)(D.dec + DEC_T2), (const float*)(D.dec + DEC_ST2), D.g2p, D.b2p, (float*)(D.dec + DEC_T1), (bf16*)(D.dec + DEC_XB1), (float*)(D.dec + DEC_ST1),
                             out + O_SHS + (size_t)l * MD * DM, dred, dsc, wave, lane);
        }
        GRID_BAR();
        }

        PH_REP(6) {
        if (PH_ON(6))
        {   PHASE_VARS(); const DecP D = make_dec(ws, in, out, l);
            pg8::Gemm g{(const pg8::bf16_t*)(ws + WS_XB1), (const pg8::bf16_t*)D.wup, M, FFD, DM}; pg8::StaticOrder S; S.init(M, FFD, F.G, (int)blockIdx.x);
            pg8::EpiUp E{ws, l};
            pg8::gemm_phase<pg8::EpiUp, pg8::StaticOrder, true, true>((PG8_LAS unsigned char*)L3, g, S, E, tid_p);
            for (int u = rwg; u < 128; u += F.G) dec_unit_up(D, u, dred, dsc, wave, lane);
        }
        GRID_BAR();
        }

        PH_REP(7) {
        if (PH_ON(7))
        {   PHASE_VARS(); const DecP D = make_dec(ws, in, out, l);
            pg8::Gemm g{(const pg8::bf16_t*)(ws + WS_H), (const pg8::bf16_t*)D.wdn, M, DM, FFD}; pg8::StaticOrder S; S.init(M, DM, F.G, (int)blockIdx.x);
            pg8::EpiRes<true> E{ws, in, out, l};
            PH_REP(11) { pg8::gemm_phase<pg8::EpiRes<true>, pg8::StaticOrder, false, true>((PG8_LAS unsigned char*)L3, g, S, E, tid_p); }
            PH_REP(10) for (int u = rwg; u < 32; u += F.G)
                dec_unit_res((const bf16*)(D.dec + DEC_HB), D.wdn, FFD, u, false, (const float*)(D.dec + DEC_T1), (const float*)(D.dec + DEC_ST1), D.g1, D.b1, (float*)(D.dec + DEC_T2), (bf16*)(D.dec + DEC_XB2), (float*)(D.dec + DEC_ST2), nullptr, dred, dsc, wave, lane);
        }
        GRID_BAR();
        }
    }
    if (PH_ON(8))
    {   PHASE_VARS(); const float* g = in[28] + (size_t)3 * DM; const float* b = in[29] + (size_t)3 * DM;
        for (int r = gw; r < M; r += F.NGW) { float mu, rs; pg8::row_stats((const float*)(ws + WS_STAT2), r, mu, rs);
            const v2u* t = (const v2u*)((const bf16*)(ws + WS_XB2) + (size_t)r * DM) + lane; f32x4* o = (f32x4*)(out + O_Y + (size_t)r * DM) + lane;
#pragma unroll
            for (int j = 0; j < 4; ++j) { const f32x4 gg = *((const f32x4*)g + lane + 64 * j), bb = *((const f32x4*)b + lane + 64 * j); const v2u w = t[64 * j]; const f32x4 tv = {bflo(w.x), bfhi(w.x), bflo(w.y), bfhi(w.y)}; o[64 * j] = (tv - mu) * rs * gg + bb; } }
        if (rgw < MD) { LAS float* fsc = dsc + wave * 64; dec_row_stats((const float*)(ws + WS_DEC + DEC_ST2), fsc, lane); const float mu = fsc[2 * rgw], rs = fsc[2 * rgw + 1];
            const f32x4* t = (const f32x4*)((const float*)(ws + WS_DEC + DEC_T2) + (size_t)rgw * DM) + lane; f32x4* o = (f32x4*)(out + O_YS + (size_t)rgw * DM) + lane;
#pragma unroll
            for (int j = 0; j < 4; ++j) { const f32x4 gg = *((const f32x4*)g + lane + 64 * j), bb = *((const f32x4*)b + lane + 64 * j); o[64 * j] = (t[64 * j] - mu) * rs * gg + bb; } }
    }
}

extern "C" void kernel_launch(void* const* d_in, const int* in_sizes, int n_in, void* d_out, int out_size, void* d_ws, size_t ws_size, hipStream_t stream) {
    static int grid = 0;
    if (grid == 0) {
        if (n_in != 30 || out_size != (int)O_END || ws_size < WS_END) { fprintf(stderr, "kernel_launch: unexpected problem (n_in %d, out %d, ws %zu); nothing launched\n", n_in, out_size, ws_size); grid = -1; return; }
        int dev = 0, cus = 0, per_cu = 0;
        if (hipGetDevice(&dev) != hipSuccess || hipDeviceGetAttribute(&cus, hipDeviceAttributeMultiprocessorCount, dev) != hipSuccess) { fprintf(stderr, "kernel_launch: device query failed\n"); grid = -1; return; }
        if (hipFuncSetAttribute((const void*)mega_fwd, hipFuncAttributeMaxDynamicSharedMemorySize, LDS_BYTES) != hipSuccess) { fprintf(stderr, "kernel_launch: hipFuncSetAttribute failed\n"); grid = -1; return; }
        if (hipOccupancyMaxActiveBlocksPerMultiprocessor(&per_cu, (const void*)mega_fwd, NWAVES * 64, LDS_BYTES) != hipSuccess || per_cu < 1) fprintf(stderr, "kernel_launch: occupancy query reports %d\n", per_cu);
        (void)hipGetLastError();
        if (cus < 256) { fprintf(stderr, "kernel_launch: needs 256 CUs (found %d)\n", cus); grid = -1; return; }
        grid = 256;
    }
    if (grid < 0) return;
    if (hipMemsetAsync((char*)d_ws + WS_CTL, 0, CTL_ZERO_BYTES, stream) != hipSuccess) { fprintf(stderr, "kernel_launch: memset failed\n"); return; }
    Args a{};
    for (int i = 0; i < 30; ++i) a.in[i] = (const float*)d_in[i];
    a.out = (float*)d_out; a.ws = (unsigned char*)d_ws;
    hipLaunchKernelGGL(mega_fwd, dim3(grid), dim3(NWAVES * 64), LDS_BYTES, stream, a);
    const hipError_t le = hipPeekAtLastError();
    if (le != hipSuccess) fprintf(stderr, "kernel_launch: launch failed: %s\n", hipGetErrorName(le));
}
```

```cpp
#include <hip/hip_runtime.h>
#include <cstdio>
#include <cstdint>
#include <cmath>
namespace pg8 {
#define PG8_LAS __attribute__((address_space(3)))
typedef unsigned short bf16_t;
typedef short bf16x8 __attribute__((ext_vector_type(8)));
typedef float f32x4 __attribute__((ext_vector_type(4)));
typedef unsigned u32x4 __attribute__((ext_vector_type(4)));
constexpr int BM = 256, BK = 64, HALF = 128, HTB = HALF * BK * 2  , STAGE_BYTES = 8 * HTB, NXCD = 8, WGM = 8;

__host__ __device__ __forceinline__ int lds_byte(int r, int c) { const int st = (r >> 4) * 2 + (c >> 5), rr = r & 15, cc = c & 31, ob = rr * 64 + cc * 2; return st * 1024 + (ob ^ (((ob >> 9) & 1) << 5)); }
__host__ __device__ __forceinline__ void stage_rc(int b, int& R, int& C) { const int st = b / 1024, sb = b % 1024, swz = sb ^ (((sb >> 9) & 1) << 5); R = (st >> 1) * 16 + swz / 64; C = (st & 1) * 32 + (swz % 64) / 2; }
__host__ __device__ __forceinline__ int perm32(int rho) { const int n = rho >> 4, i = rho & 15; return 8 * (i >> 2) + 4 * n + (i & 3); }

struct Unit { int pm, pn; };
struct Gemm { const bf16_t* A; const bf16_t* Bt; int M, N, K; };

struct StaticOrder {
    int nM, nN, nwg, G, c;
    __host__ __device__ void init(int M, int N, int G_, int c_) { nM = M / BM; nN = N / BM; nwg = nM * nN; G = G_; c = c_; }
    __host__ __device__ bool next(int i, Unit& u) const {
        const long L = (long)i * G + c; if (L >= nwg) return false;
        int wgid = (int)L; { const int q = nwg / NXCD, r = nwg % NXCD, xcd = wgid % NXCD, off = wgid / NXCD; wgid = (xcd < r ? xcd * (q + 1) : r * (q + 1) + (xcd - r) * q) + off; }
        const int nig = WGM * nN, gid = wgid / nig, fm = gid * WGM, gsz = (nM - fm) < WGM ? (nM - fm) : WGM;
        u.pm = fm + ((wgid % nig) % gsz); u.pn = (wgid % nig) / gsz; return true;
    }
    __device__ __forceinline__ void a_ready(const Unit&) const {}
    __device__ __forceinline__ void done(const Unit&) const {}
};

__device__ __forceinline__ unsigned cvt_pk_bf16(float lo, float hi) { unsigned r; asm volatile("v_cvt_pk_bf16_f32 %0, %1, %2" : "=v"(r) : "v"(lo), "v"(hi)); return r; }
typedef float f32x2 __attribute__((ext_vector_type(2)));
constexpr size_t WSO_C1IN = 1u << 20, WSO_C2IN = WSO_C1IN + 4 * 3584 * 4, WSO_C1UP = WSO_C2IN + 4 * 3584 * 4, WSO_C2UP = WSO_C1UP + 4 * 4096 * 4, WSO_ROPE = 3u << 20, WSO_STAT1 = 8u << 20, WSO_STAT2 = 9u << 20;
constexpr size_t WSO_XB2 = 132ull << 20, WSO_XB1 = 164ull << 20, WSO_T1 = 196ull << 20, WSO_T2 = 260ull << 20, WSO_QB = 324ull << 20, WSO_KB = 340ull << 20, WSO_VB = 356ull << 20, WSO_PR = 372ull << 20, WSO_H = 580ull << 20;
constexpr size_t OO_SHP = 16809984, OO_KP = 21405696, OO_VP = 29794304;
__device__ __forceinline__ void row_stats(const float* stat, int row, float& mu, float& rs) {
    const f32x4 a = *(const f32x4*)(stat + (size_t)row * 8), b = *(const f32x4*)(stat + (size_t)row * 8 + 4);
    const float s = (a[0] + a[2]) + (b[0] + b[2]), q = (a[1] + a[3]) + (b[1] + b[3]);
    mu = s * (1.f / 1024.f); const float var = fmaxf(q * (1.f / 1024.f) - mu * mu, 0.f); rs = 1.0f / sqrtf(var + 1e-5f);
}
typedef float f32x2e __attribute__((ext_vector_type(2)));
typedef unsigned u32x2e __attribute__((ext_vector_type(2)));
struct EpiIn {
    static constexpr bool PERM = false, AFTER_DRAIN = false;
    unsigned char* ws; float* out; int l;
    __device__ __forceinline__ void operator()(const f32x4 (&acc)[2][2][4][2], const Unit& u, int wr, int wc, int fr, int fq) const {
        asm volatile("" ::: "memory"); __builtin_amdgcn_sched_barrier(0);
        const int fold = l > 0; const float* stat = (const float*)(ws + WSO_STAT2); const float* c1 = (const float*)(ws + WSO_C1IN) + l * 3584; const float* c2 = (const float*)(ws + WSO_C2IN) + l * 3584;
        bf16_t* QB = (bf16_t*)(ws + WSO_QB); bf16_t* KB = (bf16_t*)(ws + WSO_KB); bf16_t* VB = (bf16_t*)(ws + WSO_VB); bf16_t* PR = (bf16_t*)(ws + WSO_PR); const float* rope = (const float*)(ws + WSO_ROPE);
        float* outk = out + OO_KP + (size_t)l * 2 * 2048 * 512; float* outv = out + OO_VP + (size_t)l * 2 * 2048 * 512; const float qscale = 0.125f * 1.4426950408889634f;
        const int cb = u.pn * BM + wc * 32 + 4 * fq;
        const int i0 = 16 * (wc & 1) + 4 * fq; const bool roped = u.pn < 4;
        const int rbase = u.pm * BM + wr * 64 + fr;
        float mu8[8], rs8[8];
#pragma unroll
        for (int gq = 0; gq < 8; ++gq) { mu8[gq] = 0.f; rs8[gq] = 1.f; if (fold) row_stats(stat, rbase + (gq >> 2) * HALF + (gq & 3) * 16, mu8[gq], rs8[gq]); }
#pragma unroll
        for (int bj = 0; bj < 2; ++bj) {
            f32x4 c1v[2], c2v[2];
#pragma unroll
            for (int n = 0; n < 2; ++n) { c1v[n] = fold ? *(const f32x4*)(c1 + cb + bj * HALF + n * 16) : (f32x4){0.f, 0.f, 0.f, 0.f}; c2v[n] = fold ? *(const f32x4*)(c2 + cb + bj * HALF + n * 16) : (f32x4){0.f, 0.f, 0.f, 0.f}; }
#pragma unroll
            for (int gq = 0; gq < 8; ++gq) {
                const int ai = gq >> 2, m = gq & 3;
                const int r = rbase + ai * HALF + m * 16;
                const float mu = mu8[gq], rs = rs8[gq];
                f32x4 ra = {0.f, 0.f, 0.f, 0.f}, rb = ra;
                if (roped) { const float* rp = rope + ((size_t)(r & 8191) * 32 + i0) * 2; ra = *(const f32x4*)rp; rb = *(const f32x4*)(rp + 4); }
                if ((gq & 3) == 3) asm volatile("" ::: "memory");
                f32x4 v[2];
#pragma unroll
                for (int n = 0; n < 2; ++n) v[n] = (acc[ai][bj][m][n] - mu * c1v[n]) * rs + c2v[n];
                const int pos = r & 8191, b = r >> 13;
                if (roped) {
                    const f32x4 cs = {ra[0], ra[2], rb[0], rb[2]}, sn = {ra[1], ra[3], rb[1], rb[3]};
                    const int head = (u.pn & 1) * 4 + bj * 2 + (wc >> 1);
                    f32x4 y1 = v[0] * cs - v[1] * sn, y2 = v[0] * sn + v[1] * cs;
                    const size_t o = (size_t)r * 512 + head * 64 + i0;
                    if (u.pn < 2) { y1 = y1 * qscale; y2 = y2 * qscale;
                        u32x2e w; w.x = cvt_pk_bf16(y1[0], y1[1]); w.y = cvt_pk_bf16(y1[2], y1[3]); *(u32x2e*)(QB + o) = w;
                        w.x = cvt_pk_bf16(y2[0], y2[1]); w.y = cvt_pk_bf16(y2[2], y2[3]); *(u32x2e*)(QB + o + 32) = w;
                    } else {
                        u32x2e w; w.x = cvt_pk_bf16(y1[0], y1[1]); w.y = cvt_pk_bf16(y1[2], y1[3]); *(u32x2e*)(KB + o) = w;
                        w.x = cvt_pk_bf16(y2[0], y2[1]); w.y = cvt_pk_bf16(y2[2], y2[3]); *(u32x2e*)(KB + o + 32) = w;
                        if (pos >= 6144) { float* ok = outk + ((size_t)(b * 2048 + pos - 6144)) * 512 + head * 64 + i0; *(f32x4*)ok = y1; *(f32x4*)(ok + 32) = y2; }
                    }
                } else if (u.pn < 6) {
#pragma unroll
                    for (int n = 0; n < 2; ++n) { const int c = cb + bj * HALF + n * 16 - 1024; const f32x4 x = v[n];
                        u32x2e w; w.x = cvt_pk_bf16(x[0], x[1]); w.y = cvt_pk_bf16(x[2], x[3]); *(u32x2e*)(VB + (size_t)r * 512 + c) = w;
                        if (pos >= 6144) *(f32x4*)(outv + ((size_t)(b * 2048 + pos - 6144)) * 512 + c) = x; }
                } else {
#pragma unroll
                    for (int n = 0; n < 2; ++n) { const int c = cb + bj * HALF + n * 16 - 1536; const f32x4 x = v[n];
                        if (c < 1824) { u32x2e w; w.x = cvt_pk_bf16(x[0], x[1]); w.y = cvt_pk_bf16(x[2], x[3]); *(u32x2e*)(PR + (size_t)r * 2048 + c) = w; } }
                }
            }
        }
    }
};
template <bool IS_F> struct EpiRes {
    static constexpr bool PERM = false, AFTER_DRAIN = true;
    unsigned char* ws; const float* const* in; float* out; int l;
    __device__ __forceinline__ void fused(f32x4 (&acc)[2][2][4][2], const Unit& u, int wr, int wc, int fr, int fq, PG8_LAS unsigned char* lds, int wid, int lane) const {
        const int raw = (!IS_F && l == 0) ? 1 : 0;
        const bf16_t* src = (const bf16_t*)(ws + (IS_F ? WSO_XB1 : WSO_XB2));
        const float* sstat = (const float*)(ws + (IS_F ? WSO_STAT1 : WSO_STAT2));
        const float* g = IS_F ? in[24] + (size_t)l * 1024 : in[28] + (size_t)(l > 0 ? l - 1 : 0) * 1024; const float* b = IS_F ? in[25] + (size_t)l * 1024 : in[29] + (size_t)(l > 0 ? l - 1 : 0) * 1024;
        bf16_t* XB = (bf16_t*)(ws + (IS_F ? WSO_XB2 : WSO_XB1)); float* ostat = (float*)(ws + (IS_F ? WSO_STAT2 : WSO_STAT1));
        float* shiftout = (IS_F || raw) ? nullptr : out + OO_SHP + (size_t)l * 2 * 1024; const float alpha = 1.6817928305074290f;
        PG8_LAS f32x2e* P = (PG8_LAS f32x2e*)lds;
        const int cb = u.pn * BM + wc * 32 + 4 * fq;
        const int rbase = u.pm * BM + wr * 64 + fr;
        u32x2e cur[2][2], nxt[2][2]; f32x4 sa = {0.f, 0.f, 0.f, 0.f}, sb = sa, san = sa, sbn = sa;
#pragma unroll
        for (int bj = 0; bj < 2; ++bj)
#pragma unroll
            for (int n = 0; n < 2; ++n) { cur[bj][n] = *(const u32x2e*)(src + (size_t)rbase * 1024 + cb + bj * HALF + n * 16); nxt[bj][n] = cur[bj][n]; }
        if (!raw) { sa = *(const f32x4*)(sstat + (size_t)rbase * 8); sb = *(const f32x4*)(sstat + (size_t)rbase * 8 + 4); }
#pragma unroll
        for (int gq = 0; gq < 8; ++gq) {
            const int ai = gq >> 2, m = gq & 3;
            const int r = rbase + ai * HALF + m * 16;
            if (gq < 7) { const int rn = rbase + ((gq + 1) >> 2) * HALF + ((gq + 1) & 3) * 16;
#pragma unroll
                for (int bj = 0; bj < 2; ++bj)
#pragma unroll
                    for (int n = 0; n < 2; ++n) nxt[bj][n] = *(const u32x2e*)(src + (size_t)rn * 1024 + cb + bj * HALF + n * 16);
                if (!raw) { san = *(const f32x4*)(sstat + (size_t)rn * 8); sbn = *(const f32x4*)(sstat + (size_t)rn * 8 + 4); } }
            asm volatile("" ::: "memory");
            float mu = 0.f, rs = 1.f;
            if (!raw) { const float ssum = (sa[0] + sa[2]) + (sb[0] + sb[2]), qsum = (sa[1] + sa[3]) + (sb[1] + sb[3]); mu = ssum * (1.f / 1024.f); rs = 1.0f / sqrtf(fmaxf(qsum * (1.f / 1024.f) - mu * mu, 0.f) + 1e-5f); }
            float s = 0.f, q = 0.f;
#pragma unroll
            for (int bj = 0; bj < 2; ++bj)
#pragma unroll
                for (int n = 0; n < 2; ++n) { const int c = cb + bj * HALF + n * 16; const size_t off = (size_t)r * 1024 + c;
                    const f32x4 gvv = raw ? (f32x4){1.f, 1.f, 1.f, 1.f} : *(const f32x4*)(g + c), bvv = raw ? (f32x4){0.f, 0.f, 0.f, 0.f} : *(const f32x4*)(b + c);
                    const u32x2e cw = cur[bj][n];
                    const f32x4 cf = {__builtin_bit_cast(float, cw.x << 16), __builtin_bit_cast(float, cw.x & 0xffff0000u), __builtin_bit_cast(float, cw.y << 16), __builtin_bit_cast(float, cw.y & 0xffff0000u)};
                    const f32x4 x = (cf - mu) * rs * gvv + bvv;
                    const f32x4 t = x * alpha + acc[ai][bj][m][n];
                    u32x2e w; w.x = cvt_pk_bf16(t[0], t[1]); w.y = cvt_pk_bf16(t[2], t[3]); *(u32x2e*)(XB + off) = w;
                    s += (t[0] + t[1]) + (t[2] + t[3]); q += (t[0] * t[0] + t[1] * t[1]) + (t[2] * t[2] + t[3] * t[3]);
                    if (shiftout && (r & 8191) == 8191) *(f32x4*)(shiftout + (size_t)(r >> 13) * 1024 + c) = x; }
            s += __shfl_xor(s, 16); s += __shfl_xor(s, 32); q += __shfl_xor(q, 16); q += __shfl_xor(q, 32);
            if (fq == 0) P[(ai * HALF + wr * 64 + m * 16 + fr) * 4 + wc] = (f32x2e){s, q};
#pragma unroll
            for (int bj = 0; bj < 2; ++bj)
#pragma unroll
                for (int n = 0; n < 2; ++n) cur[bj][n] = nxt[bj][n];
            sa = san; sb = sbn;
        }
        asm volatile("s_waitcnt lgkmcnt(0)" ::: "memory"); __builtin_amdgcn_s_barrier(); asm volatile("" ::: "memory");
        if (threadIdx.x < 256) { const int row = threadIdx.x; const f32x2e a = P[row * 4 + 0], b2 = P[row * 4 + 1], c = P[row * 4 + 2], d = P[row * 4 + 3];
            *(f32x2e*)(ostat + (size_t)(u.pm * BM + row) * 8 + u.pn * 2) = (f32x2e){(a.x + b2.x) + (c.x + d.x), (a.y + b2.y) + (c.y + d.y)}; }
        asm volatile("s_waitcnt lgkmcnt(0)" ::: "memory"); __builtin_amdgcn_s_barrier(); asm volatile("" ::: "memory");
    }
};
struct EpiUp {
    static constexpr bool PERM = true, AFTER_DRAIN = false;
    unsigned char* ws; int l;
    __device__ __forceinline__ void operator()(const f32x4 (&acc)[2][2][4][2], const Unit& u, int wr, int wc, int fr, int fq) const {
        asm volatile("" ::: "memory"); __builtin_amdgcn_sched_barrier(0);
        const float* stat = (const float*)(ws + WSO_STAT1); const float* c1 = (const float*)(ws + WSO_C1UP) + l * 4096; const float* c2 = (const float*)(ws + WSO_C2UP) + l * 4096; bf16_t* H = (bf16_t*)(ws + WSO_H);
        const int cb = u.pn * BM + wc * 32 + 8 * fq;
        float mu8[8], rs8[8];
#pragma unroll
        for (int gq = 0; gq < 8; ++gq) row_stats(stat, u.pm * BM + (gq >> 2) * HALF + wr * 64 + (gq & 3) * 16 + fr, mu8[gq], rs8[gq]);
#pragma unroll
        for (int bj = 0; bj < 2; ++bj) {
            f32x4 c1v[2], c2v[2];
#pragma unroll
            for (int n = 0; n < 2; ++n) { c1v[n] = *(const f32x4*)(c1 + cb + bj * HALF + 4 * n); c2v[n] = *(const f32x4*)(c2 + cb + bj * HALF + 4 * n); }
#pragma unroll
            for (int ai = 0; ai < 2; ++ai) {
#pragma unroll
                for (int m = 0; m < 4; ++m) {
                    const int r = u.pm * BM + ai * HALF + wr * 64 + m * 16 + fr;
                    const float mu = mu8[ai * 4 + m], rs = rs8[ai * 4 + m];
                    f32x4 v0 = (acc[ai][bj][m][0] - mu * c1v[0]) * rs + c2v[0], v1 = (acc[ai][bj][m][1] - mu * c1v[1]) * rs + c2v[1];
#pragma unroll
                    for (int e = 0; e < 4; ++e) { const float a = fmaxf(v0[e], 0.f), b = fmaxf(v1[e], 0.f); v0[e] = a * a; v1[e] = b * b; }
                    u32x4 w; w.x = cvt_pk_bf16(v0[0], v0[1]); w.y = cvt_pk_bf16(v0[2], v0[3]); w.z = cvt_pk_bf16(v1[0], v1[1]); w.w = cvt_pk_bf16(v1[2], v1[3]);
                    *(u32x4*)(H + (size_t)r * 4096 + cb + bj * HALF) = w; }
            }
        }
    }
};
template <class Epi, class Sched, bool ALIGN_EPI = false, bool SP2 = false>
__device__ __forceinline__ void gemm_phase(PG8_LAS unsigned char* lds, const Gemm g, const Sched& S, const Epi& E, const int tid) {
    const int wid = __builtin_amdgcn_readfirstlane(tid >> 6), lane = tid & 63, wr = wid >> 2, wc = wid & 3, fr = lane & 15, fq = lane >> 4;
    const int K = g.K, nt = K / BK;
    unsigned voffA[2], voffB[2];
#pragma unroll
    for (int i = 0; i < 2; ++i) { int R, C; stage_rc(tid * 16 + i * 8192, R, C); const int Rb = Epi::PERM ? ((R & ~31) + perm32(R & 31)) : R;
        voffA[i] = (unsigned)(R * K + C) * 2u; voffB[i] = (unsigned)(Rb * K + C) * 2u; }
    const size_t kstep = (size_t)(BK * 2);
    const size_t hstep = (size_t)HALF * K * 2;
    const size_t tstep = 2 * hstep;
    const unsigned ldsw = (unsigned)wid * 1024u;
    const int aoff = lds_byte(wr * 64 + fr, fq * 8), boff = lds_byte(wc * 32 + fr, fq * 8);
#define PG8_SA(b, h) (((b) * 2 + (h)) * HTB)
#define PG8_SB(b, h) ((4 + (b) * 2 + (h)) * HTB)
#define PG8_STAGE(bufoff, gbase, voff) do { _Pragma("unroll") for (int _i = 0; _i < 2; ++_i) \
        __builtin_amdgcn_global_load_lds((const unsigned*)((const char*)(gbase) + (voff)[_i]), (PG8_LAS unsigned*)(lds + (bufoff) + ldsw + _i * 8192), 16, 0, 0); } while (0)
#define PG8_LDA(dst, b, h) do { _Pragma("unroll") for (int m = 0; m < 4; ++m) _Pragma("unroll") for (int k = 0; k < 2; ++k) dst[m][k] = *(const PG8_LAS bf16x8*)(lds + PG8_SA(b, h) + aoff + m * 2048 + k * 1024); } while (0)
#define PG8_LDB(dst, b, h) do { _Pragma("unroll") for (int n = 0; n < 2; ++n) _Pragma("unroll") for (int k = 0; k < 2; ++k) dst[n][k] = *(const PG8_LAS bf16x8*)(lds + PG8_SB(b, h) + boff + n * 2048 + k * 1024); } while (0)
#define PG8_MMA(ai, bj, At, Bt) do { __builtin_amdgcn_s_setprio(1); _Pragma("unroll") for (int m = 0; m < 4; ++m) _Pragma("unroll") for (int n = 0; n < 2; ++n) _Pragma("unroll") for (int k = 0; k < 2; ++k) \
        acc[ai][bj][m][n] = __builtin_amdgcn_mfma_f32_16x16x32_bf16(Bt[n][k], At[m][k], acc[ai][bj][m][n], 0, 0, 0); __builtin_amdgcn_s_setprio(0); } while (0)
#define PG8_WAIT_V(n) asm volatile("s_waitcnt vmcnt(" #n ")" ::: "memory")
#define PG8_WAIT_L(n) asm volatile("s_waitcnt lgkmcnt(" #n ")" ::: "memory")
#define PG8_BAR __builtin_amdgcn_s_barrier()
#define PG8_SCHED __builtin_amdgcn_sched_barrier(0)
    Unit cur, nxt; int ui = 0;
    if (!S.next(0, cur)) return;
    f32x4 acc[2][2][4][2];
#pragma unroll
    for (int a = 0; a < 2; ++a)
#pragma unroll
        for (int b = 0; b < 2; ++b)
#pragma unroll
            for (int m = 0; m < 4; ++m)
#pragma unroll
                for (int n = 0; n < 2; ++n) acc[a][b][m][n] = (f32x4){0.f, 0.f, 0.f, 0.f};
    bf16x8 At[4][2], B0[2][2], B1[2][2];
    const char* cA = (const char*)g.A + (size_t)cur.pm * tstep; const char* cB = (const char*)g.Bt + (size_t)cur.pn * tstep;
    S.a_ready(cur);
    if constexpr (SP2) {
        PG8_STAGE(PG8_SB(0, 0), cB, voffB); PG8_STAGE(PG8_SB(0, 1), cB + hstep, voffB); PG8_STAGE(PG8_SA(0, 0), cA, voffA); PG8_STAGE(PG8_SA(0, 1), cA + hstep, voffA);
        if (wr == 1) PG8_BAR;
        PG8_WAIT_V(2); PG8_BAR;
        PG8_STAGE(PG8_SB(1, 0), cB + kstep, voffB); PG8_STAGE(PG8_SA(1, 0), cA + kstep, voffA); PG8_STAGE(PG8_SB(1, 1), cB + hstep + kstep, voffB);
        PG8_WAIT_V(6); PG8_BAR;
    } else {
        PG8_STAGE(PG8_SB(0, 0), cB, voffB); PG8_STAGE(PG8_SA(0, 0), cA, voffA); PG8_STAGE(PG8_SB(0, 1), cB + hstep, voffB); PG8_STAGE(PG8_SA(0, 1), cA + hstep, voffA);
        if (wr == 1) PG8_BAR;
        PG8_WAIT_V(4); PG8_BAR;
        PG8_STAGE(PG8_SB(1, 0), cB + kstep, voffB); PG8_STAGE(PG8_SA(1, 0), cA + kstep, voffA); PG8_STAGE(PG8_SB(1, 1), cB + hstep + kstep, voffB);
        PG8_WAIT_V(6); PG8_BAR;
    }
    for (;;) {
        const bool has_next = S.next(ui + 1, nxt);
        const char* nA = has_next ? (const char*)g.A + (size_t)nxt.pm * tstep : cA; const char* nB = has_next ? (const char*)g.Bt + (size_t)nxt.pn * tstep : cB;
        for (int t = 0; t < nt; t += 2) {
            const bool last = (t == nt - 2);
            const char* a1 = cA + (size_t)(t + 1) * kstep;
            const char* a2 = last ? nA : cA + (size_t)(t + 2) * kstep; const char* b2 = last ? nB : cB + (size_t)(t + 2) * kstep;
            const char* a3 = a2 + kstep; const char* b3 = b2 + kstep;
            if (last && has_next) S.a_ready(nxt);
            if constexpr (SP2) {
            PG8_LDB(B0, 0, 0); PG8_LDB(B1, 0, 1); PG8_SCHED; PG8_LDA(At, 0, 0); PG8_STAGE(PG8_SA(1, 1), a1 + hstep, voffA);
            PG8_WAIT_V(8); PG8_WAIT_L(0); PG8_BAR; PG8_MMA(0, 0, At, B0); PG8_MMA(0, 1, At, B1); PG8_BAR; PG8_SCHED;
            PG8_LDA(At, 0, 1); PG8_STAGE(PG8_SB(0, 0), b2, voffB); PG8_STAGE(PG8_SB(0, 1), b2 + hstep, voffB); PG8_STAGE(PG8_SA(0, 0), a2, voffA);
            PG8_WAIT_V(8); PG8_WAIT_L(0); PG8_BAR; PG8_MMA(1, 0, At, B0); PG8_MMA(1, 1, At, B1); PG8_BAR; PG8_SCHED;
            PG8_LDB(B0, 1, 0); PG8_LDB(B1, 1, 1); PG8_SCHED; PG8_LDA(At, 1, 0); PG8_STAGE(PG8_SA(0, 1), a2 + hstep, voffA);
            PG8_WAIT_V(8); PG8_WAIT_L(0); PG8_BAR; PG8_MMA(0, 0, At, B0); PG8_MMA(0, 1, At, B1); PG8_BAR; PG8_SCHED;
            PG8_LDA(At, 1, 1); PG8_STAGE(PG8_SB(1, 0), b3, voffB); PG8_STAGE(PG8_SB(1, 1), b3 + hstep, voffB); PG8_STAGE(PG8_SA(1, 0), a3, voffA);
            PG8_WAIT_V(8); PG8_WAIT_L(0); PG8_BAR; PG8_MMA(1, 0, At, B0); PG8_MMA(1, 1, At, B1); PG8_BAR; PG8_SCHED;
            } else {
            PG8_LDB(B0, 0, 0); PG8_SCHED; PG8_LDA(At, 0, 0); PG8_STAGE(PG8_SA(1, 1), a1 + hstep, voffA);
            PG8_WAIT_L(8); PG8_BAR; PG8_WAIT_L(0); PG8_MMA(0, 0, At, B0); PG8_BAR; PG8_SCHED;
            PG8_LDB(B1, 0, 1); PG8_STAGE(PG8_SB(0, 0), b2, voffB);
            PG8_BAR; PG8_WAIT_L(0); PG8_MMA(0, 1, At, B1); PG8_BAR;
            PG8_LDA(At, 0, 1); PG8_STAGE(PG8_SA(0, 0), a2, voffA);
            PG8_BAR; PG8_WAIT_L(0); PG8_MMA(1, 0, At, B0); PG8_BAR; PG8_SCHED;
            PG8_STAGE(PG8_SB(0, 1), b2 + hstep, voffB);
            PG8_WAIT_V(6); PG8_BAR; PG8_MMA(1, 1, At, B1); PG8_BAR;
            PG8_LDB(B0, 1, 0); PG8_SCHED; PG8_LDA(At, 1, 0); PG8_STAGE(PG8_SA(0, 1), a2 + hstep, voffA);
            PG8_WAIT_L(8); PG8_BAR; PG8_WAIT_L(0); PG8_MMA(0, 0, At, B0); PG8_BAR; PG8_SCHED;
            PG8_LDB(B1, 1, 1); PG8_STAGE(PG8_SB(1, 0), b3, voffB);
            PG8_BAR; PG8_WAIT_L(0); PG8_MMA(0, 1, At, B1); PG8_BAR;
            PG8_LDA(At, 1, 1); PG8_STAGE(PG8_SA(1, 0), a3, voffA);
            PG8_BAR; PG8_WAIT_L(0); PG8_MMA(1, 0, At, B0); PG8_BAR; PG8_SCHED;
            PG8_STAGE(PG8_SB(1, 1), b3 + hstep, voffB);
            PG8_WAIT_V(6); PG8_BAR; PG8_MMA(1, 1, At, B1); PG8_BAR;
            }
        }
        if constexpr (ALIGN_EPI) { if (wr == 0) PG8_BAR; }
        if constexpr (!Epi::AFTER_DRAIN) { E(acc, cur, wr, wc, fr, fq); S.done(cur); }
        if (!has_next) break;
#pragma unroll
        for (int a = 0; a < 2; ++a)
#pragma unroll
            for (int b = 0; b < 2; ++b)
#pragma unroll
                for (int m = 0; m < 4; ++m)
#pragma unroll
                    for (int n = 0; n < 2; ++n) acc[a][b][m][n] = (f32x4){0.f, 0.f, 0.f, 0.f};
        cur = nxt; cA = nA; cB = nB; ++ui;
        if constexpr (ALIGN_EPI) { if (wr == 1) PG8_BAR; }
    }
    PG8_WAIT_V(0);
    if constexpr (!ALIGN_EPI) { if (wr == 0) PG8_BAR; }
    PG8_BAR;
    if constexpr (Epi::AFTER_DRAIN) { E.fused(acc, cur, wr, wc, fr, fq, lds, wid, lane); S.done(cur); }
#undef PG8_SA
#undef PG8_SB
#undef PG8_STAGE
#undef PG8_LDA
#undef PG8_LDB
#undef PG8_MMA
#undef PG8_WAIT_V
#undef PG8_WAIT_L
#undef PG8_BAR
#undef PG8_SCHED
}
}
constexpr int NWAVES = 8;
constexpr int M = 16384, TSEQ = 8192, DM = 1024, FFD = 4096, DEPTH = 4, MD = 32, NH = 8, HD = 64;
constexpr int NIN = 3584;
constexpr int RW0 = 1536;
constexpr int PRP = 2048;
constexpr int NRWU = 1856;
constexpr int CH = 16, NCH = TSEQ / CH;
constexpr int NUNIT = 2 * NH * NCH;
constexpr float LN_EPS = 1e-5f, GN_EPS = 64e-5f, RMS_EPS = 1e-6f;
constexpr float ALPHA = 1.6817928305074290f;
constexpr float QSCALE = 0.125f * 1.4426950408889634f;
constexpr size_t O_Y = 0, O_YS = 16777216, O_SHP = 16809984, O_SHS = 16818176, O_WKP = 16949248, O_WKS = 17211392,
                 O_KP = 21405696, O_VP = 29794304, O_KS = 38182912, O_VS = 38248448, O_END = 38313984;
constexpr size_t MiB = 1u << 20;
constexpr size_t WS_CTL = 0, CTL_ZERO_BYTES = 1 * MiB;
constexpr size_t WS_C1IN = 1 * MiB;
constexpr size_t WS_C2IN = WS_C1IN + 4 * NIN * 4;
constexpr size_t WS_C1UP = WS_C2IN + 4 * NIN * 4;
constexpr size_t WS_C2UP = WS_C1UP + 4 * FFD * 4;
constexpr size_t WS_DUPT = WS_C2UP + 4 * FFD * 4;
constexpr size_t WS_IUPT = WS_DUPT + 4 * 512 * 64 * 2;
constexpr size_t WS_GUPT = WS_IUPT + 4 * 512 * 64 * 2;
constexpr size_t WS_VUPT = WS_GUPT + 4 * 512 * 128 * 2;
constexpr size_t WS_SMALL_END = WS_VUPT + 3 * 512 * 32 * 2;
static_assert(WS_SMALL_END <= 3 * MiB, "small region");
constexpr size_t WS_ROPE = 3 * MiB;
constexpr size_t WS_DEC = 6 * MiB;
constexpr size_t WS_STAT1 = 8 * MiB, WS_STAT2 = 9 * MiB;
constexpr size_t WS_BON = 10 * MiB;
constexpr size_t WS_LSE = 11 * MiB;
constexpr size_t WS_GC = 13 * MiB;
constexpr size_t WS_WIN = 16 * MiB;
constexpr size_t WS_WINU = 44 * MiB;
constexpr size_t WS_WOUT = 60 * MiB;
constexpr size_t WS_WUP = 68 * MiB;
constexpr size_t WS_WDN = 100 * MiB;
constexpr size_t WS_XB2 = 132 * MiB;
constexpr size_t WS_XB1 = 164 * MiB;
constexpr size_t WS_T1 = 196 * MiB;
constexpr size_t WS_T2 = 260 * MiB;
constexpr size_t WS_QB = 324 * MiB, WS_KB = 340 * MiB, WS_VB = 356 * MiB;
constexpr size_t WS_PR = 372 * MiB;
constexpr size_t WS_OP = 436 * MiB;
constexpr size_t WS_MIX = 484 * MiB;
constexpr size_t WS_VF = 516 * MiB, WS_VV = 532 * MiB;
constexpr size_t WS_YPRE = 548 * MiB;
constexpr size_t WS_H = 580 * MiB;
constexpr size_t WS_PT = 580 * MiB;
constexpr size_t WS_QT = 644 * MiB;
constexpr size_t WS_REFF = 708 * MiB;
constexpr size_t WS_YLOC = 724 * MiB;
constexpr size_t WS_SEGQ = 756 * MiB, WS_SEGP = 760 * MiB;
constexpr size_t WS_CSUM = 764 * MiB;
constexpr size_t WS_CSUP = 766 * MiB;
constexpr size_t WS_END = 768 * MiB;
static_assert(WS_H + (size_t)M * FFD * 2 <= WS_END + 0 * MiB || true, "");
constexpr size_t DEC_XB2 = 0;
constexpr size_t DEC_XB1 = 64 * 1024;
constexpr size_t DEC_SHB = 128 * 1024;
constexpr size_t DEC_MIXB = 384 * 1024;
constexpr size_t DEC_HB = 448 * 1024;
constexpr size_t DEC_T1 = 704 * 1024;
constexpr size_t DEC_T2 = 832 * 1024;
constexpr size_t DEC_PD = 960 * 1024;
constexpr size_t DEC_PS = 1408 * 1024;
constexpr size_t DEC_OP = 1640 * 1024;
constexpr size_t DEC_LSE = 1832 * 1024;
constexpr size_t DEC_MIX = 1836 * 1024;
constexpr size_t DEC_ST1 = 1964 * 1024;
constexpr size_t DEC_ST2 = 1972 * 1024;
constexpr size_t DEC_VF = 1980 * 1024;
static_assert(DEC_VF + 32 * 512 * 4 <= 2 * MiB, "decode scratch");
constexpr int CW_BAR = 4096;
constexpr int RING_BYTES = 131072;
constexpr int MISC_OFF = RING_BYTES + 320;
constexpr int LDS_BYTES = 147456;
static_assert(pg8::WSO_C1IN == WS_C1IN && pg8::WSO_C2IN == WS_C2IN && pg8::WSO_C1UP == WS_C1UP && pg8::WSO_C2UP == WS_C2UP && pg8::WSO_ROPE == WS_ROPE && pg8::WSO_STAT1 == WS_STAT1 && pg8::WSO_STAT2 == WS_STAT2 &&
              pg8::WSO_XB2 == WS_XB2 && pg8::WSO_XB1 == WS_XB1 && pg8::WSO_T1 == WS_T1 && pg8::WSO_T2 == WS_T2 && pg8::WSO_QB == WS_QB && pg8::WSO_KB == WS_KB && pg8::WSO_VB == WS_VB && pg8::WSO_PR == WS_PR && pg8::WSO_H == WS_H &&
              pg8::OO_SHP == O_SHP && pg8::OO_KP == O_KP && pg8::OO_VP == O_VP, "epilogue offset mirrors");
#define GAS __attribute__((address_space(1)))
#define LAS __attribute__((address_space(3)))
typedef unsigned short bf16;
typedef unsigned v4u __attribute__((ext_vector_type(4)));
typedef unsigned v2u __attribute__((ext_vector_type(2)));
typedef float f32x4 __attribute__((ext_vector_type(4)));
typedef float f32x2 __attribute__((ext_vector_type(2)));
typedef float f32x16 __attribute__((ext_vector_type(16)));
typedef short bf16x8 __attribute__((ext_vector_type(8)));
typedef short s16x4 __attribute__((ext_vector_type(4)));
typedef GAS unsigned gu32;
#define RLX_AGENT __ATOMIC_RELAXED, __HIP_MEMORY_SCOPE_AGENT
#define LDS_WAIT() asm volatile("s_waitcnt lgkmcnt(0)" ::: "memory")
#define VM_WAIT() asm volatile("s_waitcnt vmcnt(0)" ::: "memory")
#define DI __device__ __forceinline__
DI unsigned f2bf(float f) { unsigned u = __builtin_bit_cast(unsigned, f); return (u + 0x7fffu + ((u >> 16) & 1u)) >> 16; }
DI float bf2f(unsigned b) { return __builtin_bit_cast(float, b << 16); }
DI float bflo(unsigned w) { return __builtin_bit_cast(float, w << 16); }
DI float bfhi(unsigned w) { return __builtin_bit_cast(float, w & 0xffff0000u); }
typedef __bf16 bf16x2_t __attribute__((ext_vector_type(2)));
DI unsigned pk2(float lo, float hi) { const f32x2 v = {lo, hi}; const bf16x2_t b = __builtin_convertvector(v, bf16x2_t); return __builtin_bit_cast(unsigned, b); }
DI unsigned pk2z(float x) { return pk2(x, 0.f) & 0xffffu; }
DI float rbf(float x) { return bf2f(f2bf(x)); }
DI bf16x8 pk8(float a0, float a1, float a2, float a3, float a4, float a5, float a6, float a7) {
    v4u w; w.x = pk2(a0, a1); w.y = pk2(a2, a3); w.z = pk2(a4, a5); w.w = pk2(a6, a7); return __builtin_bit_cast(bf16x8, w); }
DI bf16x8 pk8v(f32x4 a, f32x4 b) { return pk8(a[0], a[1], a[2], a[3], b[0], b[1], b[2], b[3]); }
DI bf16x8 pk4z(f32x4 a) { v4u w; w.x = pk2(a[0], a[1]); w.y = pk2(a[2], a[3]); w.z = 0u; w.w = 0u; return __builtin_bit_cast(bf16x8, w); }
DI bf16x8 ld8(const void* p) { return *(const bf16x8*)p; }
DI bf16x8 ld4z(const void* p) { v2u t = *(const v2u*)p; v4u w; w.x = t.x; w.y = t.y; w.z = 0u; w.w = 0u; return __builtin_bit_cast(bf16x8, w); }
DI f32x4 mfma16(bf16x8 a, bf16x8 b, f32x4 c) { return __builtin_amdgcn_mfma_f32_16x16x32_bf16(a, b, c, 0, 0, 0); }
DI f32x16 mfma32(bf16x8 a, bf16x8 b, f32x16 c) { return __builtin_amdgcn_mfma_f32_32x32x16_bf16(a, b, c, 0, 0, 0); }
DI int crow(int r, int hi) { return (r & 3) + 8 * (r >> 2) + 4 * hi; }
DI float wave_sum(float v) {
#pragma unroll
    for (int o = 1; o < 64; o <<= 1) v += __shfl_xor(v, o);
    return v; }
DI float fexp(float x) { return __expf(x); }
DI float fsigmoid(float x) { return __builtin_amdgcn_rcpf(1.f + __expf(-x)); }
DI float ftanh(float x) { return 1.f - 2.f * __builtin_amdgcn_rcpf(__expf(2.f * x) + 1.f); }
DI float fsoftplus(float x) { return fmaxf(x, 0.f) + __logf(1.f + __expf(-fabsf(x))); }
DI int swap45(int c) { return (c & ~0x30) | ((c & 0x10) << 1) | ((c & 0x20) >> 1); }
#define XB_TMO      128
#define XB_XCNT(j)  (256  + 64 * (j))
#define XB_XSUB(j)  (1280 + 64 * (j))
#define XB_XGEN(j)  (2304 + 64 * (j))
#define XB_TOP      3328
#define XB_TOPGEN   3392
#define XCD_BAR_WORDS 3456
#define XB_SPIN_CAP (1u << 18)

__device__ __forceinline__ unsigned xb_ld(unsigned* p)              { return __hip_atomic_load(p, __ATOMIC_RELAXED, __HIP_MEMORY_SCOPE_AGENT); }
__device__ __forceinline__ unsigned xb_add(unsigned* p, unsigned v) { return __hip_atomic_fetch_add(p, v, __ATOMIC_RELAXED, __HIP_MEMORY_SCOPE_AGENT); }
__device__ __forceinline__ unsigned xb_xcc_id() { return (unsigned)__builtin_amdgcn_s_getreg((3 << 11) | 20) & 0xFu; }
#define XB_SPIN(cond, bar) do { unsigned _sp = 0; while (cond) { __builtin_amdgcn_s_sleep(1); \
    if ((++_sp & 255u) == 0u) { if (xb_ld(&(bar)[XB_TMO])) break; if (_sp > XB_SPIN_CAP) { atomicAdd(&(bar)[XB_TMO], 1u); break; } } } } while (0)

struct XcdBarrier {
    unsigned* bar; unsigned x;
    volatile LAS unsigned* st;
};

__device__ __forceinline__ XcdBarrier xcd_barrier_post(unsigned* bar, volatile LAS unsigned* st) {
    XcdBarrier b; b.bar = bar; b.x = xb_xcc_id(); b.st = st;
    if (threadIdx.x == 0) (void)xb_add(&bar[XB_XCNT(b.x)], 1u);
    return b;
}
__device__ __forceinline__ void xcd_barrier_complete(unsigned* bar, unsigned x, unsigned& nloc, unsigned& nx) {
    const unsigned G = gridDim.x * gridDim.y * gridDim.z;
    unsigned sum, cnt, mine, sp = 0u;
    for (;;) {
        sum = 0u; cnt = 0u; mine = 0u;
#pragma unroll
        for (unsigned j = 0; j < 16; ++j) { const unsigned c = xb_ld(&bar[XB_XCNT(j)]); sum += c; cnt += (c > 0u) ? 1u : 0u; mine = (j == x) ? c : mine; }
        if (sum == G) break;
        __builtin_amdgcn_s_sleep(1);
        if ((++sp & 255u) == 0u) { if (xb_ld(&bar[XB_TMO])) break; if (sp > XB_SPIN_CAP) { atomicAdd(&bar[XB_TMO], 1u); break; } }
    }
    nloc = mine > 0u ? mine : 1u; nx = cnt > 0u ? cnt : 1u;
}

__device__ __forceinline__ void xcd_barrier(const XcdBarrier& b) {
    asm volatile("s_waitcnt vmcnt(0)" ::: "memory");
    __syncthreads();
    if (threadIdx.x == 0) {
        unsigned* bar = b.bar;
        __builtin_amdgcn_s_waitcnt(0);
        unsigned nloc = b.st[0], nx = b.st[1];
        if (nloc == 0u) { xcd_barrier_complete(bar, b.x, nloc, nx); b.st[0] = nloc; b.st[1] = nx; }
        const unsigned old = xb_add(&bar[XB_XSUB(b.x)], 1u);
        const unsigned gen = old / nloc;
        if (old + 1u == (gen + 1u) * nloc) {
            __builtin_amdgcn_fence(__ATOMIC_RELEASE, "agent");
            asm volatile("s_waitcnt vmcnt(0)" ::: "memory");
            const unsigned og = xb_add(&bar[XB_TOP], 1u);
            const unsigned tg = og / nx;
            if (og + 1u == (tg + 1u) * nx) xb_add(&bar[XB_TOPGEN], 1u);
            else XB_SPIN(xb_ld(&bar[XB_TOPGEN]) == tg, bar);
            __builtin_amdgcn_fence(__ATOMIC_ACQUIRE, "agent");
            xb_add(&bar[XB_XGEN(b.x)], 1u);
            asm volatile("s_waitcnt vmcnt(0)" ::: "memory");
        } else {
            XB_SPIN(xb_ld(&bar[XB_XGEN(b.x)]) == gen, bar);
            __builtin_amdgcn_fence(__ATOMIC_ACQUIRE, "agent");
            asm volatile("s_waitcnt vmcnt(0)" ::: "memory");
        }
    }
    __syncthreads();
}
struct Args { const float* in[30]; float* out; unsigned char* ws; };
struct Frame {
    unsigned char* lds;
    volatile LAS unsigned* MISC;
    gu32* ctl;
    int tid, lane, wave, vcu, G, gw, NGW;
    const float* const* in; float* out; unsigned char* ws;
};
template <bool SWAP>
DI void p0_transpose_item(const float* W, int ldw, int K, int csrc0, bf16* WT, int row_off, const float* gsc, LAS float* scr, int kb, int nb, int lane, float* csum = nullptr, int ncs = 0, const float* bsh = nullptr) {
    const int k0 = 64 * kb, n0 = 32 * nb;
    float s1 = 0.f, s2 = 0.f;
    float wv[32], gk = 1.f, bk = 0.f;
#pragma unroll
    for (int i = 0; i < 32; ++i) wv[i] = W[(size_t)(k0 + 2 * i + (lane >> 5)) * ldw + csrc0 + n0 + (lane & 31)];
    if (gsc) gk = gsc[k0 + lane]; if (bsh) bk = bsh[k0 + lane];
#pragma unroll
    for (int i = 0; i < 32; ++i) { const int kk = 2 * i + (lane >> 5); float v = wv[i]; s2 += v * __shfl(bk, kk); v *= __shfl(gk, kk); s1 += rbf(v); scr[kk * 33 + (lane & 31)] = v; }
    if (csum) { s1 += __shfl_xor(s1, 32); s2 += __shfl_xor(s2, 32); if (lane < 32) { int dr = n0 + lane; if (SWAP) dr = swap45(dr); csum[(size_t)(kb * 2 + 0) * ncs + row_off + dr] = s1; csum[(size_t)(kb * 2 + 1) * ncs + row_off + dr] = s2; } }
    LDS_WAIT(); asm volatile("" ::: "memory");
    const int c = lane & 7;
#pragma unroll
    for (int j = 0; j < 4; ++j) { const int n = (lane >> 3) + 8 * j; const LAS float* s = scr + (8 * c) * 33 + n;
        v4u o; o.x = pk2(s[0 * 33], s[1 * 33]); o.y = pk2(s[2 * 33], s[3 * 33]); o.z = pk2(s[4 * 33], s[5 * 33]); o.w = pk2(s[6 * 33], s[7 * 33]);
        int dr = n0 + n; if (SWAP) dr = swap45(dr);
        *(v4u*)(WT + (size_t)(row_off + dr) * K + k0 + 8 * c) = o; }
    LDS_WAIT(); asm volatile("" ::: "memory");
}
DI void p0_prologue(Frame& F) {
    LAS float* scr = (LAS float*)((LAS unsigned char*)F.lds + F.wave * 16384);
    const float* const* in = F.in; unsigned char* ws = F.ws;
    constexpr int I_IN = 16 * 104, I_VR = 16, I_INU = 16 * 56, I_OUT = 16 * 32, I_UP = 16 * 128, I_DN = 64 * 32;
    constexpr int I_L = I_IN + I_VR + I_INU + I_VR + I_OUT + I_UP + I_DN;
    for (int it = F.gw; it < DEPTH * I_L; it += F.NGW) {
        const int l = it / I_L; int r = it % I_L;
        const float* g2p = l > 0 ? in[28] + (size_t)(l - 1) * DM : nullptr;
        bf16* win = (bf16*)(ws + WS_WIN) + (size_t)l * NIN * DM; bf16* winu = (bf16*)(ws + WS_WINU) + (size_t)l * NRWU * DM;
        if (r < I_IN) { const int kb = r / 104, nb = r % 104; const float* W = in[6] + (size_t)l * DM * 3328;
            float* cs = l > 0 ? (float*)(ws + WS_CSUM) + (size_t)l * 32 * NIN : nullptr; const float* b2p = l > 0 ? in[29] + (size_t)(l - 1) * DM : nullptr;
            if (nb < 32) p0_transpose_item<true>(W, 3328, DM, 0, win, 0, g2p, scr, kb, nb, F.lane, cs, NIN, b2p); else p0_transpose_item<false>(W, 3328, DM, 0, win, 0, g2p, scr, kb, nb, F.lane, cs, NIN, b2p); continue; } r -= I_IN;
        if (r < I_VR) { if (l > 0) p0_transpose_item<false>(in[7] + (size_t)(l - 1) * DM * 32, 32, DM, 0, win, 3328, g2p, scr, r, 0, F.lane, (float*)(ws + WS_CSUM) + (size_t)l * 32 * NIN, NIN, in[29] + (size_t)(l - 1) * DM); continue; } r -= I_VR;
        if (r < I_INU) { const int kb = r / 56, nb = r % 56; p0_transpose_item<false>(in[6] + (size_t)l * DM * 3328, 3328, DM, RW0, winu, 0, nullptr, scr, kb, nb, F.lane); continue; } r -= I_INU;
        if (r < I_VR) { if (l > 0) p0_transpose_item<false>(in[7] + (size_t)(l - 1) * DM * 32, 32, DM, 0, winu, 1792, nullptr, scr, r, 0, F.lane); continue; } r -= I_VR;
        if (r < I_OUT) { p0_transpose_item<false>(in[23] + (size_t)l * DM * DM, DM, DM, 0, (bf16*)(ws + WS_WOUT) + (size_t)l * DM * DM, 0, nullptr, scr, r / 32, r % 32, F.lane); continue; } r -= I_OUT;
        if (r < I_UP) { p0_transpose_item<false>(in[26] + (size_t)l * DM * FFD, FFD, DM, 0, (bf16*)(ws + WS_WUP) + (size_t)l * FFD * DM, 0, in[24] + (size_t)l * DM, scr, r / 128, r % 128, F.lane, (float*)(ws + WS_CSUP) + (size_t)l * 32 * FFD, FFD, in[25] + (size_t)l * DM); continue; } r -= I_UP;
        p0_transpose_item<false>(in[27] + (size_t)l * FFD * DM, DM, FFD, 0, (bf16*)(ws + WS_WDN) + (size_t)l * DM * FFD, 0, nullptr, scr, r / 32, r % 32, F.lane);
    }
    for (int m0 = F.gw; m0 < M; m0 += 4 * F.NGW) { f32x4 v[4][4];
#pragma unroll
        for (int q = 0; q < 4; ++q) { const f32x4* xr = (const f32x4*)(in[0] + (size_t)(m0 + q * F.NGW) * DM) + F.lane;
#pragma unroll
            for (int j = 0; j < 4; ++j) v[q][j] = xr[64 * j]; }
#pragma unroll
        for (int q = 0; q < 4; ++q) { unsigned long long* o8 = (unsigned long long*)((bf16*)(ws + WS_XB2) + (size_t)(m0 + q * F.NGW) * DM) + F.lane;
#pragma unroll
            for (int j = 0; j < 4; ++j) o8[64 * j] = (unsigned long long)pk2(v[q][j].x, v[q][j].y) | ((unsigned long long)pk2(v[q][j].z, v[q][j].w) << 32); } }
    const int gt = F.gw * 64 + F.lane, NGT = F.NGW * 64;
    for (int e = gt; e < 8193 * 32; e += NGT) { const int pos = e >> 5, i = e & 31; const double ang = (double)pos * pow(10000.0, -(double)i / 32.0); ((f32x2*)(ws + WS_ROPE))[e] = (f32x2){(float)cos(ang), (float)sin(ang)}; }
    for (int e = gt; e < 4 * 512 * 64; e += NGT) { const int l = e / (512 * 64), n = (e / 64) % 512, m = e % 64; ((bf16*)(ws + WS_DUPT))[e] = (bf16)f2bf(in[11][((size_t)l * 64 + m) * 512 + n]); ((bf16*)(ws + WS_IUPT))[e] = (bf16)f2bf(in[13][((size_t)l * 64 + m) * 512 + n]); }
    for (int e = gt; e < 4 * 512 * 128; e += NGT) { const int l = e / (512 * 128), n = (e / 128) % 512, m = e % 128; ((bf16*)(ws + WS_GUPT))[e] = (bf16)f2bf(in[14][((size_t)l * 128 + m) * 512 + n]); }
    for (int e = gt; e < 3 * 512 * 32; e += NGT) { const int l = e / (512 * 32), n = (e / 32) % 512, m = e % 32; ((bf16*)(ws + WS_VUPT))[e] = (bf16)f2bf(in[16][((size_t)l * 32 + m) * 512 + n]); }
    for (int e = gt; e < 2 * DM; e += NGT) F.out[O_SHP + e] = in[0][((size_t)(e / DM) * TSEQ + TSEQ - 1) * DM + (e % DM)];
    for (int e = gt; e < MD * DM; e += NGT) { ((bf16*)(ws + WS_DEC + DEC_XB2))[e] = (bf16)f2bf(in[1][e]); }
    for (int e = gt; e < DEPTH * MD * DM; e += NGT) { ((bf16*)(ws + WS_DEC + DEC_SHB))[e] = (bf16)f2bf(in[2][e]); }
}
DI void colsum_finish(unsigned char* ws, int gt, int NGT) {
    for (int e = gt; e < 3 * NIN; e += NGT) { const int l = 1 + e / NIN, p = e % NIN; if (p >= 3360) continue; const float* cs = (const float*)(ws + WS_CSUM) + (size_t)l * 32 * NIN + p; float s1 = 0.f, s2 = 0.f;
#pragma unroll
        for (int kb = 0; kb < 16; ++kb) { s1 += cs[(size_t)(2 * kb) * NIN]; s2 += cs[(size_t)(2 * kb + 1) * NIN]; }
        ((float*)(ws + WS_C1IN))[l * NIN + p] = s1; ((float*)(ws + WS_C2IN))[l * NIN + p] = s2; }
    for (int e = gt; e < 4 * FFD; e += NGT) { const int l = e / FFD, p = e % FFD; const float* cs = (const float*)(ws + WS_CSUP) + (size_t)l * 32 * FFD + p; float s1 = 0.f, s2 = 0.f;
#pragma unroll
        for (int kb = 0; kb < 16; ++kb) { s1 += cs[(size_t)(2 * kb) * FFD]; s2 += cs[(size_t)(2 * kb + 1) * FFD]; }
        ((float*)(ws + WS_C1UP))[l * FFD + p] = s1; ((float*)(ws + WS_C2UP))[l * FFD + p] = s2; }
}
constexpr int VPITCH = 144;
constexpr int ATT_WLDS = 2 * 32 * VPITCH + 256;
DI void tr_read8(unsigned base, s16x4 (&t)[8]) {
    asm volatile("ds_read_b64_tr_b16 %0, %8\n\tds_read_b64_tr_b16 %1, %8 offset:%c9\n\tds_read_b64_tr_b16 %2, %8 offset:%c10\n\tds_read_b64_tr_b16 %3, %8 offset:%c11\n\t"
                 "ds_read_b64_tr_b16 %4, %8 offset:%c12\n\tds_read_b64_tr_b16 %5, %8 offset:%c13\n\tds_read_b64_tr_b16 %6, %8 offset:%c14\n\tds_read_b64_tr_b16 %7, %8 offset:%c15\n\ts_waitcnt lgkmcnt(0)"
                 : "=&v"(t[0]), "=&v"(t[1]), "=&v"(t[2]), "=&v"(t[3]), "=&v"(t[4]), "=&v"(t[5]), "=&v"(t[6]), "=&v"(t[7])
                 : "v"(base), "i"(8 * VPITCH), "i"(64), "i"(8 * VPITCH + 64), "i"(16 * VPITCH), "i"(24 * VPITCH), "i"(16 * VPITCH + 64), "i"(24 * VPITCH + 64) : "memory");
}
DI void attn_task(const bf16* QB, const bf16* KB, const bf16* VB, bf16* OP, float* LSE, int b, int h, int p, int cls, int qblk, LAS unsigned char* wl, int lane) {
    asm volatile("" : "+v"(lane));
    const int dd = 1 << (2 * p), r32 = lane & 31, hi = lane >> 5;
    const int m0 = 32 * qblk;
    const size_t rowb = (size_t)b * TSEQ;
    const size_t qrow = rowb + (size_t)(m0 + r32) * dd + cls;
    bf16x8 qf[4];
#pragma unroll
    for (int d0 = 0; d0 < 4; ++d0) qf[d0] = ld8(QB + qrow * 512 + h * 64 + d0 * 16 + hi * 8);
    f32x16 s[5];
    const int kt0 = (m0 >= 128) ? 0 : (128 - m0) / 32;
    bf16x8 kf[5][4];
#pragma unroll
    for (int kt = 0; kt < 5; ++kt) {
        const int mk = m0 - 128 + 32 * kt + r32;
        const size_t krow = rowb + (size_t)(mk < 0 ? 0 : mk) * dd + cls;
#pragma unroll
        for (int d0 = 0; d0 < 4; ++d0) kf[kt][d0] = ld8(KB + krow * 512 + h * 64 + d0 * 16 + hi * 8);
    }
#pragma unroll
    for (int kt = 0; kt < 5; ++kt) {
        f32x16 a; for (int i = 0; i < 16; ++i) a[i] = 0.f;
#pragma unroll
        for (int d0 = 0; d0 < 4; ++d0) a = mfma32(kf[kt][d0], qf[d0], a);
        s[kt] = a;
    }
#pragma unroll
    for (int kt = 0; kt < 5; ++kt) {
        if (kt < kt0) {
#pragma unroll
            for (int i = 0; i < 16; ++i) s[kt][i] = -INFINITY;
        } else if (kt == 0) {
#pragma unroll
            for (int i = 0; i < 16; ++i) s[kt][i] = (crow(i, hi) >= r32) ? s[kt][i] : -INFINITY;
        } else if (kt == 4) {
#pragma unroll
            for (int i = 0; i < 16; ++i) s[kt][i] = (crow(i, hi) <= r32) ? s[kt][i] : -INFINITY;
        }
    }
    float mx = -INFINITY;
#pragma unroll
    for (int kt = 0; kt < 5; ++kt)
#pragma unroll
        for (int i = 0; i < 16; ++i) mx = fmaxf(mx, s[kt][i]);
    mx = fmaxf(mx, __shfl_xor(mx, 32));
    float lsum = 0.f;
#pragma unroll
    for (int kt = 0; kt < 5; ++kt)
#pragma unroll
        for (int i = 0; i < 16; ++i) { const float e = __builtin_amdgcn_exp2f(s[kt][i] - mx); s[kt][i] = e; lsum += e; }
    lsum += __shfl_xor(lsum, 32);
    f32x16 o[2]; for (int i = 0; i < 16; ++i) { o[0][i] = 0.f; o[1][i] = 0.f; }
    LAS float* wsf = (LAS float*)(wl + 2 * 32 * VPITCH);
    const unsigned vb0 = (unsigned)(uintptr_t)wl;
    const int g = lane >> 4, i16 = lane & 15, qq = i16 >> 2, pp = i16 & 3;
    const unsigned traddr = (unsigned)((4 * (g >> 1) + qq) * VPITCH + (16 * (g & 1) + 4 * pp) * 2);
    const int vkey = lane >> 1, vhalf = lane & 1;
    v4u vr[4];
#define ATT_LOADV(KT) do { const int mk_ = m0 - 128 + 32 * (KT) + vkey; const size_t vrow_ = rowb + (size_t)mk_ * dd + cls; const v4u* src_ = (const v4u*)(VB + vrow_ * 512 + h * 64 + vhalf * 32); \
        vr[0] = src_[0]; vr[1] = src_[1]; vr[2] = src_[2]; vr[3] = src_[3]; } while (0)
    ATT_LOADV(kt0);
#pragma unroll
    for (int kt = 0; kt < 5; ++kt) {
        if (kt >= kt0) {
            LAS unsigned char* vb = wl + (kt & 1) * 32 * VPITCH;
            { LAS v4u* dst = (LAS v4u*)(vb + vkey * VPITCH + vhalf * 64); dst[0] = vr[0]; dst[1] = vr[1]; dst[2] = vr[2]; dst[3] = vr[3]; }
            if (kt + 1 < 5) ATT_LOADV(kt + 1);
            LDS_WAIT();
            const unsigned base = vb0 + (unsigned)((kt & 1) * 32 * VPITCH) + traddr;
            s16x4 t[8];
            tr_read8(base, t);
#pragma unroll
            for (int ss = 0; ss < 2; ++ss) {
                const bf16x8 pa = pk8(s[kt][8 * ss], s[kt][8 * ss + 1], s[kt][8 * ss + 2], s[kt][8 * ss + 3], s[kt][8 * ss + 4], s[kt][8 * ss + 5], s[kt][8 * ss + 6], s[kt][8 * ss + 7]);
#pragma unroll
                for (int db = 0; db < 2; ++db) { const bf16x8 vf = __builtin_shufflevector(t[4 * ss + 2 * db], t[4 * ss + 2 * db + 1], 0, 1, 2, 3, 4, 5, 6, 7); o[db] = mfma32(pa, vf, o[db]); }
            }
        }
    }
#undef ATT_LOADV
    if (hi == 0) { wsf[r32] = __builtin_amdgcn_rcpf(lsum); LSE[((size_t)p * M + qrow) * 8 + h] = mx + __builtin_amdgcn_logf(lsum); }
    LDS_WAIT();
#pragma unroll
    for (int i = 0; i < 16; ++i) { const int q = crow(i, hi); const float li = wsf[q]; const size_t orow = rowb + (size_t)(m0 + q) * dd + cls;
        bf16* op = OP + ((size_t)p * M + orow) * 512 + h * 64 + r32;
        op[0] = (bf16)pk2z(o[0][i] * li); op[32] = (bf16)pk2z(o[1][i] * li); }
    LDS_WAIT();
}
DI void attn_finalize_row(const bf16* OP, const float* LSE, const float* gain, bf16* MIX, int row, int lane) {
    asm volatile("" : "+v"(lane));
    const int h = lane >> 3;
    float l0 = LSE[((size_t)0 * M + row) * 8 + h], l1 = LSE[((size_t)1 * M + row) * 8 + h], l2 = LSE[((size_t)2 * M + row) * 8 + h];
    const float mx = fmaxf(l0, fmaxf(l1, l2));
    float w0 = __builtin_amdgcn_exp2f(l0 - mx), w1 = __builtin_amdgcn_exp2f(l1 - mx), w2 = __builtin_amdgcn_exp2f(l2 - mx);
    const float inv = __builtin_amdgcn_rcpf(w0 + w1 + w2); w0 *= inv; w1 *= inv; w2 *= inv;
    const v4u a = *(const v4u*)(OP + ((size_t)0 * M + row) * 512 + lane * 8), b = *(const v4u*)(OP + ((size_t)1 * M + row) * 512 + lane * 8), c = *(const v4u*)(OP + ((size_t)2 * M + row) * 512 + lane * 8);
    float v[8]; float ss = 0.f;
#pragma unroll
    for (int j = 0; j < 4; ++j) { v[2 * j] = w0 * bflo(a[j]) + w1 * bflo(b[j]) + w2 * bflo(c[j]); v[2 * j + 1] = w0 * bfhi(a[j]) + w1 * bfhi(b[j]) + w2 * bfhi(c[j]); ss += v[2 * j] * v[2 * j] + v[2 * j + 1] * v[2 * j + 1]; }
    ss = wave_sum(ss);
    const float rinv = 1.0f / sqrtf(ss * (1.f / 512.f) + RMS_EPS);
    const f32x4 g0 = *(const f32x4*)(gain + lane * 8), g1 = *(const f32x4*)(gain + lane * 8 + 4);
    v4u w; w.x = pk2(v[0] * rinv * g0[0], v[1] * rinv * g0[1]); w.y = pk2(v[2] * rinv * g0[2], v[3] * rinv * g0[3]); w.z = pk2(v[4] * rinv * g1[0], v[5] * rinv * g1[1]); w.w = pk2(v[6] * rinv * g1[2], v[7] * rinv * g1[3]);
    *(v4u*)(MIX + (size_t)row * 1024 + lane * 8) = w;
}
constexpr int B1_IMG = 2048, B1_WLDS = 5 * B1_IMG + 1024;
DI float dpp_shr(float x, int n) { int v;
    switch (n) { case 1: v = __builtin_amdgcn_update_dpp(0, __builtin_bit_cast(int, x), 0x111, 0xf, 0xf, true); break; case 2: v = __builtin_amdgcn_update_dpp(0, __builtin_bit_cast(int, x), 0x112, 0xf, 0xf, true); break;
                 case 4: v = __builtin_amdgcn_update_dpp(0, __builtin_bit_cast(int, x), 0x114, 0xf, 0xf, true); break; default: v = __builtin_amdgcn_update_dpp(0, __builtin_bit_cast(int, x), 0x118, 0xf, 0xf, true); break; }
    return __builtin_bit_cast(float, v); }
DI float dpp_shr1(float x, int n) { int v; const int one = 0x3f800000;
    switch (n) { case 1: v = __builtin_amdgcn_update_dpp(one, __builtin_bit_cast(int, x), 0x111, 0xf, 0xf, false); break; case 2: v = __builtin_amdgcn_update_dpp(one, __builtin_bit_cast(int, x), 0x112, 0xf, 0xf, false); break;
                 case 4: v = __builtin_amdgcn_update_dpp(one, __builtin_bit_cast(int, x), 0x114, 0xf, 0xf, false); break; default: v = __builtin_amdgcn_update_dpp(one, __builtin_bit_cast(int, x), 0x118, 0xf, 0xf, false); break; }
    return __builtin_bit_cast(float, v); }
struct RwkvP {
    const bf16* PR; const float* mu; const float* muv;
    const float *dbase, *ibase, *vbase, *ksk, *ksa, *brk, *gng, *gnb;
    const bf16 *dupT, *iupT, *vupT, *gupT;
    const bf16* ZROW; bf16 *VF, *VV; float* BON; float* GC; bf16 *W1S, *REFF, *BM; v4u* REC; float* YPRE; bf16* MIX; int layer0;
};
DI const f32x4* vec4p(const float*) { return nullptr; }
DI const LAS f32x4* vec4p(const LAS float*) { return nullptr; }
template <class MP> DI void lerp8(const bf16* crow_, const bf16* prow_, int col, MP mu, float (&z)[8]) {
    const v4u cur = *(const v4u*)(crow_ + col); const v4u prv = *(const v4u*)(prow_ + col);
    const f32x4 m0 = *(decltype(vec4p(mu)))(mu), m1 = *(decltype(vec4p(mu)))(mu + 4);
#pragma unroll
    for (int j = 0; j < 4; ++j) { const float a = bflo(cur[j]), b = bfhi(cur[j]), pa = bflo(prv[j]), pb = bfhi(prv[j]); const float ma = j < 2 ? m0[2 * j] : m1[2 * j - 4], mb = j < 2 ? m0[2 * j + 1] : m1[2 * j - 3];
        z[2 * j] = a + (pa - a) * ma; z[2 * j + 1] = b + (pb - b) * mb; }
}
template <class MP> DI f32x4 lerp4(const bf16* crow_, const bf16* prow_, int col, MP mu) {
    const v2u cur = *(const v2u*)(crow_ + col); const v2u prv = *(const v2u*)(prow_ + col);
    const f32x4 m = *(decltype(vec4p(mu)))(mu);
    f32x4 z; z[0] = bflo(cur.x) + (bflo(prv.x) - bflo(cur.x)) * m[0]; z[1] = bfhi(cur.x) + (bfhi(prv.x) - bfhi(cur.x)) * m[1];
    z[2] = bflo(cur.y) + (bflo(prv.y) - bflo(cur.y)) * m[2]; z[3] = bfhi(cur.y) + (bfhi(prv.y) - bfhi(cur.y)) * m[3]; return z;
}
DI void img_write(LAS unsigned char* img, const f32x4 (&x)[4], int fr, int fq) {
#pragma unroll
    for (int mb = 0; mb < 4; ++mb)
#pragma unroll
        for (int reg = 0; reg < 4; ++reg) *(LAS bf16*)(img + (16 * mb + 4 * fq + reg) * 32 + fr * 2) = (bf16)pk2z(x[mb][reg]);
}
DI bf16x8 lds4z(const LAS unsigned char* p) { const v2u t = *(const LAS v2u*)p; v4u w; w.x = t.x; w.y = t.y; w.z = 0u; w.w = 0u; return __builtin_bit_cast(bf16x8, w); }
constexpr int HC_DUP = 0, HC_IUP = 9216, HC_VUP = 18432, HC_F = 23552, HC_BYTES = 23552 + 736 * 4;
enum { HF_MUR = 0, HF_MUK = 64, HF_MUV = 128, HF_MUW = 192, HF_MUA = 256, HF_MUVR = 320, HF_DB = 352, HF_IB = 416, HF_VB = 480, HF_SK = 544, HF_SA = 608, HF_BR = 672 };
DI void head_cache_fill(const RwkvP& P, int h, LAS unsigned char* hc, int tid) {
    { const int row = tid >> 3, ch = tid & 7;
      *(LAS v4u*)(hc + HC_DUP + row * 144 + ch * 16) = *(const v4u*)(P.dupT + (size_t)(h * 64 + row) * 64 + ch * 8);
      *(LAS v4u*)(hc + HC_IUP + row * 144 + ch * 16) = *(const v4u*)(P.iupT + (size_t)(h * 64 + row) * 64 + ch * 8); }
    if (tid < 256 && !P.layer0) { const int row = tid >> 2, ch = tid & 3; *(LAS v4u*)(hc + HC_VUP + row * 80 + ch * 16) = *(const v4u*)(P.vupT + (size_t)(h * 64 + row) * 32 + ch * 8); }
    LAS float* f = (LAS float*)(hc + HC_F);
    if (tid < 64) { const int c = h * 64 + tid; f[HF_MUR + tid] = P.mu[c]; f[HF_MUK + tid] = P.mu[512 + c]; f[HF_MUV + tid] = P.mu[1024 + c]; f[HF_MUW + tid] = P.mu[1536 + tid]; f[HF_MUA + tid] = P.mu[1600 + tid];
        f[HF_DB + tid] = P.dbase[c]; f[HF_IB + tid] = P.ibase[c]; f[HF_VB + tid] = P.layer0 ? 0.f : P.vbase[c]; f[HF_SK + tid] = P.ksk[c]; f[HF_SA + tid] = P.ksa[c]; f[HF_BR + tid] = P.brk[c];
        if (tid < 32) f[HF_MUVR + tid] = P.layer0 ? 0.f : P.muv[tid]; }
}
DI void rwkv_b1_unit(const RwkvP& P, int unit, LAS unsigned char* wl, const LAS unsigned char* hc, int lane) {
    asm volatile("" : "+v"(lane));
    const int fr = lane & 15, fq = lane >> 4;
    const int seq = unit >> 9, c = unit & 511, b = seq >> 3, h = seq & 7;
    const size_t row = (size_t)b * TSEQ + 16 * c + fr;
    const bool hasprev = (c | fr) != 0;
    const bf16* crp = P.PR + row * PRP; const bf16* prp = hasprev ? crp - PRP : P.ZROW;
    const f32x4 z4 = {0.f, 0.f, 0.f, 0.f};
    const LAS float* hf = (const LAS float*)(hc + HC_F);
    bf16x8 tw[2], al[2], vl;
#pragma unroll
    for (int ks = 0; ks < 2; ++ks) { float z[8]; lerp8(crp, prp, 1536 + 8 * fq + 32 * ks, hf + HF_MUW + 8 * fq + 32 * ks, z);
        tw[ks] = pk8(ftanh(z[0]), ftanh(z[1]), ftanh(z[2]), ftanh(z[3]), ftanh(z[4]), ftanh(z[5]), ftanh(z[6]), ftanh(z[7]));
        lerp8(crp, prp, 1600 + 8 * fq + 32 * ks, hf + HF_MUA + 8 * fq + 32 * ks, z); al[ks] = pk8(z[0], z[1], z[2], z[3], z[4], z[5], z[6], z[7]); }
    if (!P.layer0) { float z[8]; lerp8(crp, prp, 1792 + 8 * fq, hf + HF_MUVR + 8 * fq, z); vl = pk8(z[0], z[1], z[2], z[3], z[4], z[5], z[6], z[7]); }
    f32x4 zr[4], k2[4], kk[4], ai[4], ld[4];
    float nrm = 0.f, bon = 0.f;
#pragma unroll
    for (int mb = 0; mb < 4; ++mb) { const int ch = h * 64 + 16 * mb + 4 * fq; const int n = h * 64 + 16 * mb + fr;
        f32x4 dw = z4, da = z4, dv = z4;
        dw = mfma16(*(const LAS bf16x8*)(hc + HC_DUP + (16 * mb + fr) * 144 + 16 * fq), tw[0], dw); dw = mfma16(*(const LAS bf16x8*)(hc + HC_DUP + (16 * mb + fr) * 144 + 16 * fq + 64), tw[1], dw);
        da = mfma16(*(const LAS bf16x8*)(hc + HC_IUP + (16 * mb + fr) * 144 + 16 * fq), al[0], da); da = mfma16(*(const LAS bf16x8*)(hc + HC_IUP + (16 * mb + fr) * 144 + 16 * fq + 64), al[1], da);
        if (!P.layer0) dv = mfma16(*(const LAS bf16x8*)(hc + HC_VUP + (16 * mb + fr) * 80 + 16 * fq), vl, z4);
        const int cl = 16 * mb + 4 * fq;
        zr[mb] = lerp4(crp, prp, ch, hf + HF_MUR + cl);
        const f32x4 zk = lerp4(crp, prp, 512 + ch, hf + HF_MUK + cl);
        f32x4 zv = lerp4(crp, prp, 1024 + ch, hf + HF_MUV + cl);
        const f32x4 db = *(const LAS f32x4*)(hf + HF_DB + cl), ib = *(const LAS f32x4*)(hf + HF_IB + cl), sk = *(const LAS f32x4*)(hf + HF_SK + cl), sa = *(const LAS f32x4*)(hf + HF_SA + cl), br = *(const LAS f32x4*)(hf + HF_BR + cl);
        if (P.layer0) { v2u w; w.x = pk2(zv[0], zv[1]); w.y = pk2(zv[2], zv[3]); *(v2u*)(P.VF + row * 512 + ch) = w; }
        else { const v2u f = *(const v2u*)(P.VF + row * 512 + ch); const f32x4 vb = *(const LAS f32x4*)(hf + HF_VB + cl); const f32x4 vf = {bflo(f.x), bfhi(f.x), bflo(f.y), bfhi(f.y)};
#pragma unroll
            for (int e = 0; e < 4; ++e) zv[e] = zv[e] + (vf[e] - zv[e]) * fsigmoid(vb[e] + dv[e]); }
        { v2u w; w.x = pk2(zv[0], zv[1]); w.y = pk2(zv[2], zv[3]); *(v2u*)(P.VV + row * 512 + ch) = w; }
#pragma unroll
        for (int reg = 0; reg < 4; ++reg) *(LAS bf16*)(wl + 2 * B1_IMG + (16 * mb + 4 * fq + reg) * 32 + fr * 2) = (bf16)pk2z(zv[reg]);
#pragma unroll
        for (int e = 0; e < 4; ++e) {
            ld[mb][e] = fexp(-0.60653065971f * fsigmoid(db[e] + dw[e]));
            const float a = fsigmoid(ib[e] + da[e]); ai[mb][e] = a;
            const float kr = zk[e] * sk[e]; kk[mb][e] = kr; nrm += kr * kr;
            const float kx = zk[e] * (1.f + (a - 1.f) * sa[e]); k2[mb][e] = kx; bon += zr[mb][e] * kx * br[e]; }
        asm volatile("" ::: "memory");
    }
    nrm += __shfl_xor(nrm, 16); nrm += __shfl_xor(nrm, 32); bon += __shfl_xor(bon, 16); bon += __shfl_xor(bon, 32);
    if (fq == 0) P.BON[row * 8 + h] = bon;
    const float kinv = 1.0f / fmaxf(sqrtf(nrm), 1e-12f);
    f32x4 rt[4], kh[4];
    bf16x8 pa[2], pb[2], pk[2], pr[2];
#pragma unroll
    for (int ks = 0; ks < 2; ++ks) {
        f32x4 at2[2], bt2[2], kt2[2];
#pragma unroll
        for (int m2 = 0; m2 < 2; ++m2) { const int mb = 2 * ks + m2;
            f32x4 gcv, bhv;
#pragma unroll
            for (int e = 0; e < 4; ++e) {
                float gm = ld[mb][e]; gm *= dpp_shr1(gm, 1); gm *= dpp_shr1(gm, 2); gm *= dpp_shr1(gm, 4); gm *= dpp_shr1(gm, 8);
                const float gc = __shfl(gm, lane | 15), gp = dpp_shr1(gm, 1), gi = __builtin_amdgcn_rcpf(gm), ec = gc * gi;
                const float kn = kk[mb][e] * kinv, bb = kn * ai[mb][e];
                at2[m2][e] = -kn * gp; bt2[m2][e] = bb * gi; kt2[m2][e] = k2[mb][e] * gi; rt[mb][e] = zr[mb][e] * gm;
                bhv[e] = bb * ec; kh[mb][e] = k2[mb][e] * ec; gcv[e] = gc; }
            if (fr == 0) *(f32x4*)(P.GC + (size_t)unit * 64 + 16 * mb + 4 * fq) = gcv;
#pragma unroll
            for (int reg = 0; reg < 4; ++reg) { const int o = (16 * mb + 4 * fq + reg) * 32 + fr * 2;
                *(LAS bf16*)(wl + 0 * B1_IMG + o) = (bf16)pk2z(at2[m2][reg]); *(LAS bf16*)(wl + 1 * B1_IMG + o) = (bf16)pk2z(bhv[reg]); }
        }
        pa[ks] = pk8v(at2[0], at2[1]); pb[ks] = pk8v(bt2[0], bt2[1]); pk[ks] = pk8v(kt2[0], kt2[1]); pr[ks] = pk8v(rt[2 * ks], rt[2 * ks + 1]);
    }
    const f32x4 z4b = {0.f, 0.f, 0.f, 0.f};
    f32x4 Aab = mfma16(pb[1], pa[1], mfma16(pb[0], pa[0], z4b));
    f32x4 AakT = mfma16(pa[1], pk[1], mfma16(pa[0], pk[0], z4b));
    f32x4 Arb = mfma16(pb[1], pr[1], mfma16(pb[0], pr[0], z4b));
    f32x4 Ark = mfma16(pk[1], pr[1], mfma16(pk[0], pr[0], z4b));
#pragma unroll
    for (int e = 0; e < 4; ++e) { const int rr = 4 * fq + e; Aab[e] = rr < fr ? Aab[e] : 0.f; AakT[e] = fr < rr ? AakT[e] : 0.f; Arb[e] = rr <= fr ? Arb[e] : 0.f; Ark[e] = rr <= fr ? Ark[e] : 0.f; }
    LAS float* As = (LAS float*)(wl + 5 * B1_IMG);
#pragma unroll
    for (int e = 0; e < 4; ++e) As[(4 * fq + e) * 16 + fr] = Aab[e];
    LDS_WAIT();
    float x[16];
#pragma unroll
    for (int s = 15; s >= 0; --s) { float acc = (s == fr) ? 1.f : 0.f;
        const f32x4 r0 = *(const LAS f32x4*)(As + s * 16), r1 = *(const LAS f32x4*)(As + s * 16 + 4), r2 = *(const LAS f32x4*)(As + s * 16 + 8), r3 = *(const LAS f32x4*)(As + s * 16 + 12);
        const float rowv[16] = {r0[0], r0[1], r0[2], r0[3], r1[0], r1[1], r1[2], r1[3], r2[0], r2[1], r2[2], r2[3], r3[0], r3[1], r3[2], r3[3]};
#pragma unroll
        for (int uu = s + 1; uu < 16; ++uu) acc += rowv[uu] * x[uu];
        x[s] = acc; if ((s & 1) == 0) asm volatile("" ::: "memory"); }
    f32x4 xs;
#pragma unroll
    for (int e = 0; e < 4; ++e) xs[e] = fq == 0 ? x[e] : fq == 1 ? x[4 + e] : fq == 2 ? x[8 + e] : x[12 + e];
    const bf16x8 Tsel = pk4z(xs);
    f32x4 W1[4];
#pragma unroll
    for (int mb = 0; mb < 4; ++mb) W1[mb] = mfma16(lds4z(wl + 0 * B1_IMG + (16 * mb + fr) * 32 + 8 * fq), Tsel, z4);
    const f32x4 GT = mfma16(Tsel, pk4z(AakT), z4);
    img_write(wl + 3 * B1_IMG, W1, fr, fq);
    f32x4 M1T[4];
    const bf16x8 GTp = pk4z(GT);
#pragma unroll
    for (int mb = 0; mb < 4; ++mb) M1T[mb] = mfma16(lds4z(wl + 1 * B1_IMG + (16 * mb + fr) * 32 + 8 * fq), GTp, kh[mb]);
    img_write(wl + 4 * B1_IMG, M1T, fr, fq);
    LDS_WAIT();
    const bf16x8 Arbp = pk4z(Arb);
    f32x4 RE[4];
#pragma unroll
    for (int mb = 0; mb < 4; ++mb) RE[mb] = mfma16(lds4z(wl + 3 * B1_IMG + (16 * mb + fr) * 32 + 8 * fq), Arbp, rt[mb]);
    const f32x4 M2 = mfma16(GTp, Arbp, Ark);
    {   bf16* w1s = P.W1S + ((size_t)unit * 16 + fr) * 64; bf16* re = P.REFF + ((size_t)unit * 16 + fr) * 64;
#pragma unroll
        for (int mb = 0; mb < 4; ++mb) { const int sg = (mb >> 1) * 32 + fq * 8 + (mb & 1) * 4;
            v2u w; w.x = pk2(W1[mb][0], W1[mb][1]); w.y = pk2(W1[mb][2], W1[mb][3]); *(v2u*)(w1s + sg) = w;
            w.x = pk2(RE[mb][0], RE[mb][1]); w.y = pk2(RE[mb][2], RE[mb][3]); *(v2u*)(re + sg) = w; }
        const v2u m2p = {pk2(M2[0], M2[1]), pk2(M2[2], M2[3])};
#pragma unroll
        for (int mb = 0; mb < 4; ++mb) {
            const v2u bq = *(const LAS v2u*)(wl + 1 * B1_IMG + (16 * mb + fr) * 32 + 8 * fq), mq = *(const LAS v2u*)(wl + 4 * B1_IMG + (16 * mb + fr) * 32 + 8 * fq);
            *(v4u*)(P.BM + (((size_t)unit * 64 + 16 * mb + fr) * 4 + fq) * 8) = (v4u){bq.x, bq.y, mq.x, mq.y};
            const v2u vq = *(const LAS v2u*)(wl + 2 * B1_IMG + (16 * mb + fr) * 32 + 8 * fq);
            P.REC[((size_t)unit * 4 + mb) * 64 + lane] = (v4u){vq.x, vq.y, m2p.x, m2p.y}; }
    }
    LDS_WAIT();
}
constexpr int NSEG = 16, SEGCH = NCH / NSEG;
struct ChainIn { bf16x8 w1[2], re[2], bm[4]; v4u rec; f32x4 gc[4]; };
template <int MODE> DI void chain_load(ChainIn& c, const RwkvP& P, int unit, int rb, int lane) {
    const int fr = lane & 15, fq = lane >> 4;
    const bf16* w1s = P.W1S + ((size_t)unit * 16 + fr) * 64 + fq * 8;
    c.w1[0] = ld8(w1s); c.w1[1] = ld8(w1s + 32);
    if (MODE == 2) { const bf16* re = P.REFF + ((size_t)unit * 16 + fr) * 64 + fq * 8; c.re[0] = ld8(re); c.re[1] = ld8(re + 32); }
#pragma unroll
    for (int mb = 0; mb < 4; ++mb) { c.bm[mb] = ld8(P.BM + (((size_t)unit * 64 + 16 * mb + fr) * 4 + fq) * 8); c.gc[mb] = *(const f32x4*)(P.GC + (size_t)unit * 64 + 16 * mb + 4 * fq); }
    if (MODE != 1) c.rec = P.REC[((size_t)unit * 4 + rb) * 64 + lane];
}
template <int MODE> DI void chain_step(f32x4 (&S)[4], const ChainIn& c, float* ypre  ) {
    const f32x4 z4 = {0.f, 0.f, 0.f, 0.f};
    const bf16x8 b0 = pk8v(S[0], S[1]), b1 = pk8v(S[2], S[3]);
    f32x4 ut = mfma16(c.w1[1], b1, mfma16(c.w1[0], b0, z4));
    if (MODE == 2) {
        v4u vlo; vlo.x = c.rec.x; vlo.y = c.rec.y; vlo.z = 0u; vlo.w = 0u;
        v4u m2a; m2a.x = c.rec.z; m2a.y = c.rec.w; m2a.z = 0u; m2a.w = 0u;
        f32x4 y = mfma16(__builtin_bit_cast(bf16x8, m2a), __builtin_bit_cast(bf16x8, vlo), z4);
        y = mfma16(c.re[0], b0, y); y = mfma16(c.re[1], b1, y);
#pragma unroll
        for (int e = 0; e < 4; ++e) ypre[(size_t)e * 512] = y[e];
    }
    v4u uv; uv.x = pk2(ut[0], ut[1]); uv.y = pk2(ut[2], ut[3]); uv.z = MODE == 1 ? 0u : c.rec.x; uv.w = MODE == 1 ? 0u : c.rec.y;
    const bf16x8 ub = __builtin_bit_cast(bf16x8, uv);
#pragma unroll
    for (int mb = 0; mb < 4; ++mb) S[mb] = mfma16(c.bm[mb], ub, S[mb] * c.gc[mb]);
}
template <int MODE> DI void chain_run(f32x4 (&S)[4], const RwkvP& P, int unit0, int nsteps  , int rb, float* yp, int lane) {
    ChainIn c0, c1, c2;
    chain_load<MODE>(c0, P, unit0, rb, lane); chain_load<MODE>(c1, P, unit0 + 1, rb, lane);
    int c = 0;
    for (; c + 3 <= nsteps; c += 3) {
        chain_load<MODE>(c2, P, unit0 + c + 2, rb, lane);
        chain_step<MODE>(S, c0, yp + (size_t)c * 16 * 512);
        if (c + 3 < nsteps) chain_load<MODE>(c0, P, unit0 + c + 3, rb, lane);
        chain_step<MODE>(S, c1, yp + (size_t)(c + 1) * 16 * 512);
        if (c + 4 < nsteps) chain_load<MODE>(c1, P, unit0 + c + 4, rb, lane);
        chain_step<MODE>(S, c2, yp + (size_t)(c + 2) * 16 * 512);
    }
    if (c < nsteps) { chain_step<MODE>(S, c0, yp + (size_t)c * 16 * 512); ++c; }
    if (c < nsteps) { chain_step<MODE>(S, c1, yp + (size_t)c * 16 * 512); ++c; }
}
template <int MODE> DI void chain_run2(f32x4 (&S)[4], const RwkvP& P, int unit0, int nsteps  , int rb, float* yp, int lane) {
    ChainIn ca, cb;
    chain_load<MODE>(ca, P, unit0, rb, lane);
    for (int c = 0; c < nsteps; c += 2) {
        chain_load<MODE>(cb, P, unit0 + c + 1, rb, lane);
        asm volatile("" ::: "memory");
        chain_step<MODE>(S, ca, yp + (size_t)c * 16 * 512);
        if (c + 2 < nsteps) chain_load<MODE>(ca, P, unit0 + c + 2, rb, lane);
        asm volatile("" ::: "memory");
        chain_step<MODE>(S, cb, yp + (size_t)(c + 1) * 16 * 512);
    }
}
DI void chain_pass1(const RwkvP& P, float* QSEG, float* PSEGT, int seq, int g, int part, int rb, int lane) {
    const int fr = lane & 15, fq = lane >> 4;
    f32x4 S[4];
#pragma unroll
    for (int mb = 0; mb < 4; ++mb)
#pragma unroll
        for (int e = 0; e < 4; ++e) S[mb][e] = (part == 1 && (16 * mb + 4 * fq + e) == (16 * rb + fr)) ? 1.f : 0.f;
    const int unit0 = seq * NCH + g * SEGCH;
    if (part == 0) chain_run<0>(S, P, unit0, SEGCH, rb, nullptr, lane); else chain_run<1>(S, P, unit0, SEGCH, rb, nullptr, lane);
    const size_t sb = ((size_t)seq * NSEG + g) * 4096;
    if (part == 0) {
#pragma unroll
        for (int mb = 0; mb < 4; ++mb) *(f32x4*)(QSEG + sb + (size_t)(16 * rb + fr) * 64 + 16 * mb + 4 * fq) = S[mb];
    } else {
#pragma unroll
        for (int mb = 0; mb < 4; ++mb)
#pragma unroll
            for (int e = 0; e < 4; ++e) PSEGT[sb + (size_t)(16 * mb + 4 * fq + e) * 64 + 16 * rb + fr] = S[mb][e];
    }
}
DI void split_hl(const f32x4 a, const f32x4 b, bf16x8& hi, bf16x8& lo) {
    f32x4 ah, bh;
#pragma unroll
    for (int e = 0; e < 4; ++e) { ah[e] = rbf(a[e]); bh[e] = rbf(b[e]); }
    hi = pk8v(ah, bh); lo = pk8v(a - ah, b - bh);
}
DI void chain_pass23(const RwkvP& P, const float* QSEG, const float* PSEGT, int seq, int g, int rb, float* wkv_out, int lane) {
    const int fr = lane & 15, fq = lane >> 4, b = seq >> 3, h = seq & 7;
    f32x4 S[4]; for (int mb = 0; mb < 4; ++mb) S[mb] = (f32x4){0.f, 0.f, 0.f, 0.f};
    f32x4 pc[4][2][2], pn[4][2][2];
#define P2_LOAD(PD_, GP_) do { const size_t sb_ = ((size_t)seq * NSEG + (GP_)) * 4096; _Pragma("unroll") for (int mb = 0; mb < 4; ++mb) { \
        _Pragma("unroll") for (int ks = 0; ks < 2; ++ks) { const float* pr_ = PSEGT + sb_ + (size_t)(16 * mb + fr) * 64 + 32 * ks + 4 * fq; PD_[mb][ks][0] = *(const f32x4*)pr_; PD_[mb][ks][1] = *(const f32x4*)(pr_ + 16); } } } while (0)
    if (g > 0) P2_LOAD(pc, 0);
    for (int gp = 0; gp < g; ++gp) {
        f32x4 qc[4];
        { const size_t sb_ = ((size_t)seq * NSEG + gp) * 4096;
#pragma unroll
          for (int mb = 0; mb < 4; ++mb) qc[mb] = *(const f32x4*)(QSEG + sb_ + (size_t)(16 * rb + fr) * 64 + 16 * mb + 4 * fq); }
        if (gp + 1 < g) P2_LOAD(pn, gp + 1);
        bf16x8 bh[2], bl[2]; split_hl(S[0], S[1], bh[0], bl[0]); split_hl(S[2], S[3], bh[1], bl[1]);
#pragma unroll
        for (int mb = 0; mb < 4; ++mb) { f32x4 acc = {0.f, 0.f, 0.f, 0.f};
#pragma unroll
            for (int ks = 0; ks < 2; ++ks) { bf16x8 ah, al; split_hl(pc[mb][ks][0], pc[mb][ks][1], ah, al);
                acc = mfma16(ah, bh[ks], acc); acc = mfma16(al, bh[ks], acc); acc = mfma16(ah, bl[ks], acc); }
            S[mb] = acc + qc[mb]; }
#pragma unroll
        for (int mb = 0; mb < 4; ++mb) {
#pragma unroll
            for (int ks = 0; ks < 2; ++ks) { pc[mb][ks][0] = pn[mb][ks][0]; pc[mb][ks][1] = pn[mb][ks][1]; } }
    }
#undef P2_LOAD
    float* yp = P.YPRE + ((size_t)b * TSEQ + (size_t)g * SEGCH * 16 + 4 * fq) * 512 + h * 64 + 16 * rb + fr;
    chain_run<2>(S, P, seq * NCH + g * SEGCH, SEGCH, rb, yp, lane);
    if (g == NSEG - 1) {
#pragma unroll
        for (int mb = 0; mb < 4; ++mb) *(f32x4*)(wkv_out + (size_t)(16 * rb + fr) * 64 + 16 * mb + 4 * fq) = S[mb];
    }
}
constexpr int GC_GUP = 0, GC_F = 64 * 272, GC_BYTES = 64 * 272 + 256 * 4;
DI void gate_cache_fill(const RwkvP& P, int h, LAS unsigned char* gc, int tid) {
#pragma unroll
    for (int q = 0; q < 2; ++q) { const int idx = tid + 512 * q, row = idx >> 4, ch = idx & 15;
        *(LAS v4u*)(gc + GC_GUP + row * 272 + ch * 16) = *(const v4u*)(P.gupT + (size_t)(h * 64 + row) * 128 + ch * 8); }
    LAS float* f = (LAS float*)(gc + GC_F);
    if (tid < 64) { f[tid] = P.gng[h * 64 + tid]; f[64 + tid] = P.gnb[h * 64 + tid]; }
    if (tid >= 64 && tid < 192) f[128 + tid - 64] = P.mu[1664 + tid - 64];
}
DI void rwkv_b3_unit(const RwkvP& P, int unit, const LAS unsigned char* gc, int lane) {
    asm volatile("" : "+v"(lane));
    const int fr = lane & 15, fq = lane >> 4;
    const int seq = unit >> 9, c = unit & 511, b = seq >> 3, h = seq & 7;
    const size_t row = (size_t)b * TSEQ + 16 * c + fr;
    const bool hasprev = (c | fr) != 0;
    const bf16* crp = P.PR + row * PRP; const bf16* prp = hasprev ? crp - PRP : P.ZROW;
    const f32x4 z4 = {0.f, 0.f, 0.f, 0.f};
    const LAS float* gf = (const LAS float*)(gc + GC_F);
    bf16x8 sg[4];
#pragma unroll
    for (int ks = 0; ks < 4; ++ks) { float z[8]; lerp8(crp, prp, 1664 + 8 * fq + 32 * ks, gf + 128 + 8 * fq + 32 * ks, z);
        sg[ks] = pk8(fsigmoid(z[0]), fsigmoid(z[1]), fsigmoid(z[2]), fsigmoid(z[3]), fsigmoid(z[4]), fsigmoid(z[5]), fsigmoid(z[6]), fsigmoid(z[7])); }
    f32x4 g[4], y[4]; float s = 0.f;
#pragma unroll
    for (int mb = 0; mb < 4; ++mb) { f32x4 a = z4;
#pragma unroll
        for (int ks = 0; ks < 4; ++ks) a = mfma16(*(const LAS bf16x8*)(gc + GC_GUP + (16 * mb + fr) * 272 + 16 * fq + 64 * ks), sg[ks], a);
        g[mb] = a;
        y[mb] = *(const f32x4*)(P.YPRE + row * 512 + h * 64 + 16 * mb + 4 * fq); s += (y[mb][0] + y[mb][1]) + (y[mb][2] + y[mb][3]); }
    s += __shfl_xor(s, 16); s += __shfl_xor(s, 32);
    const float mean = s * (1.f / 64.f); float q = 0.f;
#pragma unroll
    for (int mb = 0; mb < 4; ++mb) { y[mb] = y[mb] - mean; q += (y[mb][0] * y[mb][0] + y[mb][1] * y[mb][1]) + (y[mb][2] * y[mb][2] + y[mb][3] * y[mb][3]); }
    q += __shfl_xor(q, 16); q += __shfl_xor(q, 32);
    const float rstd = 1.0f / sqrtf(q * (1.f / 64.f) + GN_EPS);
    const float bon = P.BON[row * 8 + h];
#pragma unroll
    for (int mb = 0; mb < 4; ++mb) { const int cl = 16 * mb + 4 * fq, ch = h * 64 + cl;
        const f32x4 gg = *(const LAS f32x4*)(gf + cl), gb = *(const LAS f32x4*)(gf + 64 + cl); const v2u vw = *(const v2u*)(P.VV + row * 512 + ch);
        const f32x4 v = {bflo(vw.x), bfhi(vw.x), bflo(vw.y), bfhi(vw.y)};
        const f32x4 o = (y[mb] * rstd * gg + gb + v * bon) * g[mb];
        v2u w; w.x = pk2(o[0], o[1]); w.y = pk2(o[2], o[3]); *(v2u*)(P.MIX + row * 1024 + 512 + ch) = w; }
}
DI f32x16 dec_gemm(const bf16* A, const bf16* Wt, int K, LAS float* red  , int wave, int lane) {
    const int r = lane & 31, h = lane >> 5, kw = K >> 3;
    const bf16* ap = A + (size_t)r * K + wave * kw + 8 * h; const bf16* bp = Wt + (size_t)r * K + wave * kw + 8 * h;
    f32x16 acc; for (int i = 0; i < 16; ++i) acc[i] = 0.f;
#pragma unroll 16
    for (int k = 0; k < kw; k += 16) acc = mfma32(ld8(ap + k), ld8(bp + k), acc);
    __syncthreads();
#pragma unroll
    for (int i = 0; i < 16; ++i) red[(wave * 16 + i) * 64 + lane] = acc[i];
    __syncthreads();
    if (wave == 0) {
#pragma unroll
        for (int i = 0; i < 16; ++i) { float s = 0.f;
#pragma unroll
            for (int w = 0; w < 8; ++w) s += red[(w * 16 + i) * 64 + lane];
            asm volatile("" : "+v"(s) :: "memory"); acc[i] = s; } }
    return acc;
}
DI void dec_row_stats(const float* st, LAS float* sc, int lane) {
    if (lane < 32) { float s = 0.f, q = 0.f; const f32x4* p = (const f32x4*)(st + (size_t)lane * 64);
#pragma unroll
        for (int i = 0; i < 16; ++i) { const f32x4 v = p[i]; s += v[0] + v[2]; q += v[1] + v[3]; if ((i & 3) == 3) asm volatile("" : "+v"(s), "+v"(q) :: "memory"); }
        const float mu = s * (1.f / 1024.f), var = fmaxf(q * (1.f / 1024.f) - mu * mu, 0.f); sc[2 * lane] = mu; sc[2 * lane + 1] = 1.0f / sqrtf(var + LN_EPS); }
    LDS_WAIT();
}
struct DecP {
    unsigned char* dec; int l;
    const float* xs;
    const float *c1in, *c2in, *c1up, *c2up, *g1, *b1, *g2p, *b2p;
    const bf16 *win, *winu, *wout, *wup, *wdn;
    float* out;
};
DI void dec_unit_in(const DecP& D, int u, LAS float* red, LAS float* sc, int wave, int lane) {
    const int r32 = lane & 31, hi = lane >> 5;
    if (u < 105) {
        const int n = 32 * u + r32; const bool fold = D.l > 0;
        const f32x16 acc = dec_gemm((const bf16*)(D.dec + DEC_XB2), D.win + (size_t)(32 * u) * DM, DM, red, wave, lane);
        if (wave != 0) return;
        if (fold) dec_row_stats((const float*)(D.dec + DEC_ST2), sc, lane);
        const float c1 = fold ? D.c1in[n] : 0.f, c2 = fold ? D.c2in[n] : 0.f; const int on = n < 1024 ? swap45(n) : n;
        float* PD = (float*)(D.dec + DEC_PD);
#pragma unroll
        for (int i = 0; i < 16; ++i) { const int row = crow(i, hi); float mu = 0.f, rs = 1.f; if (fold) { mu = sc[2 * row]; rs = sc[2 * row + 1]; } PD[(size_t)row * NIN + on] = (acc[i] - mu * c1) * rs + c2; }
    } else {
        const int v = u - 105, n = 32 * v + r32;
        const f32x16 acc = dec_gemm((const bf16*)(D.dec + DEC_SHB) + (size_t)D.l * MD * DM, D.winu + (size_t)(32 * v) * DM, DM, red, wave, lane);
        if (wave != 0) return;
        float* PS = (float*)(D.dec + DEC_PS);
#pragma unroll
        for (int i = 0; i < 16; ++i) PS[(size_t)crow(i, hi) * NRWU + n] = acc[i];
    }
    LDS_WAIT();
}
DI void dec_unit_res(const bf16* A, const bf16* Wt, int K, int u, bool raw, const float* src, const float* sstat, const float* g, const float* b, float* T, bf16* XB, float* ostat, float* shiftout, LAS float* red, LAS float* sc, int wave, int lane) {
    const int r32 = lane & 31, hi = lane >> 5, n = 32 * u + r32;
    const f32x16 acc = dec_gemm(A, Wt + (size_t)(32 * u) * K, K, red, wave, lane);
    if (wave != 0) return;
    if (!raw) dec_row_stats(sstat, sc, lane);
    const float gg = raw ? 1.f : g[n], bb = raw ? 0.f : b[n];
#pragma unroll
    for (int i = 0; i < 16; ++i) { const int row = crow(i, hi); float mu = 0.f, rs = 1.f; if (!raw) { mu = sc[2 * row]; rs = sc[2 * row + 1]; }
        const float x = (src[(size_t)row * DM + n] - mu) * rs * gg + bb; const float t = ALPHA * x + acc[i];
        T[(size_t)row * DM + n] = t; XB[(size_t)row * DM + n] = (bf16)f2bf(t); if (shiftout) shiftout[(size_t)row * DM + n] = x;
        float s = t, q = t * t;
#pragma unroll
        for (int o = 1; o < 32; o <<= 1) { s += __shfl_xor(s, o); q += __shfl_xor(q, o); }
        if (r32 == 0) { ostat[((size_t)row * 32 + u) * 2] = s; ostat[((size_t)row * 32 + u) * 2 + 1] = q; } }
    LDS_WAIT();
}
DI void dec_unit_up(const DecP& D, int u, LAS float* red, LAS float* sc, int wave, int lane) {
    const int r32 = lane & 31, hi = lane >> 5, n = 32 * u + r32;
    const f32x16 acc = dec_gemm((const bf16*)(D.dec + DEC_XB1), D.wup + (size_t)(32 * u) * DM, DM, red, wave, lane);
    if (wave != 0) return;
    dec_row_stats((const float*)(D.dec + DEC_ST1), sc, lane);
    const float c1 = D.c1up[n], c2 = D.c2up[n]; bf16* HB = (bf16*)(D.dec + DEC_HB);
#pragma unroll
    for (int i = 0; i < 16; ++i) { const int row = crow(i, hi); const float v = fmaxf((acc[i] - sc[2 * row] * c1) * sc[2 * row + 1] + c2, 0.f); HB[(size_t)row * FFD + n] = (bf16)f2bf(v * v); }
    LDS_WAIT();
}
DI void dec_attn_task(const DecP& D, const float* ck, const float* cv, const float* rope, int bd, int h, int p, int lane) {
    const int g = lane >> 4, dq = lane & 15, dd = 1 << (2 * p);
    const float* PD = (const float*)(D.dec + DEC_PD) + (size_t)bd * NIN;
    const f32x4 rr0 = *(const f32x4*)(rope + ((size_t)8192 * 32 + ((4 * dq) & 31)) * 2), rr1 = *(const f32x4*)(rope + ((size_t)8192 * 32 + ((4 * dq) & 31)) * 2 + 4);
    const f32x4 cs = {rr0[0], rr0[2], rr1[0], rr1[2]}, sn = {rr0[1], rr0[3], rr1[1], rr1[3]};
    const float sgn = dq < 8 ? -1.f : 1.f;
    f32x4 q = *(const f32x4*)(PD + h * 64 + 4 * dq), kn = *(const f32x4*)(PD + 512 + h * 64 + 4 * dq); const f32x4 vn = *(const f32x4*)(PD + 1024 + h * 64 + 4 * dq);
    { f32x4 qp, kp;
#pragma unroll
      for (int e = 0; e < 4; ++e) { qp[e] = __shfl_xor(q[e], 8); kp[e] = __shfl_xor(kn[e], 8); }
      q = q * cs + qp * sn * sgn; kn = kn * cs + kp * sn * sgn; }
    if (p == 0 && g == 0) { *(f32x4*)(D.out + O_KS + ((size_t)D.l * MD + bd) * 512 + h * 64 + 4 * dq) = kn; *(f32x4*)(D.out + O_VS + ((size_t)D.l * MD + bd) * 512 + h * 64 + 4 * dq) = vn; }
    float s0 = (q[0] * kn[0] + q[1] * kn[1]) + (q[2] * kn[2] + q[3] * kn[3]);
#pragma unroll
    for (int o = 1; o < 16; o <<= 1) s0 += __shfl_xor(s0, o);
    s0 *= 0.125f;
    const size_t cbase = (((size_t)D.l * MD + bd) * 2048) * 512 + h * 64 + 4 * dq;
    float mx = -INFINITY, den = 0.f; f32x4 o4 = {0.f, 0.f, 0.f, 0.f};
#pragma unroll 8
    for (int it = 0; it < 32; ++it) { const int j = 1 + 4 * it + g; const size_t off = cbase + (size_t)(2048 - j * dd) * 512;
        const f32x4 kr = *(const f32x4*)(ck + off); const f32x4 vr = *(const f32x4*)(cv + off);
        float s = (q[0] * kr[0] + q[1] * kr[1]) + (q[2] * kr[2] + q[3] * kr[3]);
#pragma unroll
        for (int o = 1; o < 16; o <<= 1) s += __shfl_xor(s, o);
        s *= 0.125f;
        const float mn = fmaxf(mx, s), sc = fexp(mx - mn), pj = fexp(s - mn);
        den = den * sc + pj; o4 = o4 * sc + vr * pj; mx = mn; }
    float mg = fmaxf(mx, __shfl_xor(mx, 16)); mg = fmaxf(mg, __shfl_xor(mg, 32)); mg = fmaxf(mg, s0);
    { const float sc = fexp(mx - mg); den *= sc; o4 = o4 * sc; }
    den += __shfl_xor(den, 16); den += __shfl_xor(den, 32);
#pragma unroll
    for (int e = 0; e < 4; ++e) { o4[e] += __shfl_xor(o4[e], 16); o4[e] += __shfl_xor(o4[e], 32); }
    const float p0 = fexp(s0 - mg); den += p0; o4 = (o4 + vn * p0) * (1.0f / den); mx = mg;
    if (g == 0) *(f32x4*)((float*)(D.dec + DEC_OP) + ((size_t)p * MD + bd) * 512 + h * 64 + 4 * dq) = o4;
    if (lane == 0) ((float*)(D.dec + DEC_LSE))[((size_t)p * MD + bd) * 8 + h] = mx + __logf(den);
}
DI void dec_rwkv_task(const DecP& D, const float* const* in, int bd, int h, LAS float* sv  , int lane) {
    const int l = D.l, ch = h * 64 + lane;
    const float* PD = (const float*)(D.dec + DEC_PD) + (size_t)bd * NIN + RW0; const float* PS = (const float*)(D.dec + DEC_PS) + (size_t)bd * NRWU;
    const float* mu = in[8] + (size_t)l * 1792;
    auto zf = [&](int col) { const float pr = PD[col], pv = PS[col]; return pr + (pv - pr) * mu[col]; };
    const float zr = zf(ch), zk = zf(512 + ch), zv0 = zf(1024 + ch);
    float vl = 0.f; if (l > 0 && lane < 32) { const float pr = PD[1792 + lane], pv = PS[1792 + lane]; vl = pr + (pv - pr) * in[9][(size_t)(l - 1) * 32 + lane]; }
    sv[lane] = ftanh(zf(1536 + lane)); sv[64 + lane] = zf(1600 + lane); sv[128 + lane] = fsigmoid(zf(1664 + lane)); sv[192 + lane] = fsigmoid(zf(1728 + lane)); sv[256 + lane] = vl;
    LDS_WAIT();
    float dw = 0.f, da = 0.f, dv = 0.f, gt = 0.f;
    const float* du = in[11] + (size_t)l * 64 * 512 + ch; const float* iu = in[13] + (size_t)l * 64 * 512 + ch; const float* gu = in[14] + (size_t)l * 128 * 512 + ch;
#pragma unroll 2
    for (int m4 = 0; m4 < 16; ++m4) { const f32x4 a = *(const LAS f32x4*)(sv + 4 * m4), b = *(const LAS f32x4*)(sv + 64 + 4 * m4), c = *(const LAS f32x4*)(sv + 128 + 4 * m4), d = *(const LAS f32x4*)(sv + 192 + 4 * m4);
#pragma unroll
        for (int e = 0; e < 4; ++e) { const int m = 4 * m4 + e; dw += a[e] * du[(size_t)m * 512]; da += b[e] * iu[(size_t)m * 512]; gt += c[e] * gu[(size_t)m * 512] + d[e] * gu[(size_t)(64 + m) * 512]; } }
    if (l > 0) { const float* vu = in[16] + (size_t)(l - 1) * 32 * 512 + ch;
#pragma unroll
        for (int m4 = 0; m4 < 8; ++m4) { const f32x4 a = *(const LAS f32x4*)(sv + 256 + 4 * m4);
#pragma unroll
            for (int e = 0; e < 4; ++e) dv += a[e] * vu[(size_t)(4 * m4 + e) * 512]; } }
    const float w = -fsoftplus(-(in[10][(size_t)l * 512 + ch] + dw)) - 0.5f, decay = fexp(-fexp(w));
    const float a = fsigmoid(in[12][(size_t)l * 512 + ch] + da);
    float* VFD = (float*)(D.dec + DEC_VF) + (size_t)bd * 512 + ch;
    float v = zv0; if (l == 0) *VFD = zv0; else v = zv0 + (*VFD - zv0) * fsigmoid(in[15][(size_t)(l - 1) * 512 + ch] + dv);
    const float kr = zk * in[17][(size_t)l * 512 + ch]; const float kn = kr / fmaxf(sqrtf(wave_sum(kr * kr)), 1e-12f);
    const float k2 = zk * (1.f + (a - 1.f) * in[18][(size_t)l * 512 + ch]);
    const float bon = wave_sum(zr * k2 * in[19][(size_t)l * 512 + ch]);
    LDS_WAIT();
    sv[320 + lane] = -kn; sv[384 + lane] = decay; sv[448 + lane] = kn * a; sv[512 + lane] = k2; sv[576 + lane] = zr;
    LDS_WAIT();
    const float* S0 = in[3] + ((((size_t)l * MD + bd) * NH + h) * 64 + lane) * 64;
    float* So = D.out + O_WKS + ((((size_t)l * MD + bd) * NH + h) * 64 + lane) * 64;
    float sa = 0.f;
    { f32x4 Sr[16];
#pragma unroll
      for (int q = 0; q < 16; ++q) Sr[q] = *(const f32x4*)(S0 + 4 * q);
#pragma unroll
      for (int q = 0; q < 16; ++q) { const f32x4 a4 = *(const LAS f32x4*)(sv + 320 + 4 * q); sa += (Sr[q][0] * a4[0] + Sr[q][1] * a4[1]) + (Sr[q][2] * a4[2] + Sr[q][3] * a4[3]); } }
    asm volatile("" ::: "memory");
    float y = 0.f;
#pragma unroll 8
    for (int q = 0; q < 16; ++q) { const f32x4 s0 = *(const f32x4*)(S0 + 4 * q); const f32x4 w4 = *(const LAS f32x4*)(sv + 384 + 4 * q), b4 = *(const LAS f32x4*)(sv + 448 + 4 * q), k4 = *(const LAS f32x4*)(sv + 512 + 4 * q), r4 = *(const LAS f32x4*)(sv + 576 + 4 * q);
        const f32x4 s4 = s0 * w4 + b4 * sa + k4 * v; *(f32x4*)(So + 4 * q) = s4; y += (s4[0] * r4[0] + s4[1] * r4[1]) + (s4[2] * r4[2] + s4[3] * r4[3]); }
    const float mean = wave_sum(y) * (1.f / 64.f), dy = y - mean, var = wave_sum(dy * dy) * (1.f / 64.f);
    const float o = (dy * (1.0f / sqrtf(var + GN_EPS)) * in[20][(size_t)l * 512 + ch] + in[21][(size_t)l * 512 + ch] + bon * v) * gt;
    ((float*)(D.dec + DEC_MIX))[(size_t)bd * DM + 512 + ch] = o;
    LDS_WAIT();
}
DI void dec_finalize_row(const DecP& D, const float* gain, int bd, int lane) {
    const int h = lane >> 3; const float* L = (const float*)(D.dec + DEC_LSE); const float* OPD = (const float*)(D.dec + DEC_OP);
    const float l0 = L[((size_t)0 * MD + bd) * 8 + h], l1 = L[((size_t)1 * MD + bd) * 8 + h], l2 = L[((size_t)2 * MD + bd) * 8 + h];
    const float mx = fmaxf(l0, fmaxf(l1, l2)); float w0 = fexp(l0 - mx), w1 = fexp(l1 - mx), w2 = fexp(l2 - mx); const float inv = 1.0f / (w0 + w1 + w2); w0 *= inv; w1 *= inv; w2 *= inv;
    float v[8]; float ss = 0.f;
#pragma unroll
    for (int e = 0; e < 8; ++e) { v[e] = w0 * OPD[((size_t)0 * MD + bd) * 512 + lane * 8 + e] + w1 * OPD[((size_t)1 * MD + bd) * 512 + lane * 8 + e] + w2 * OPD[((size_t)2 * MD + bd) * 512 + lane * 8 + e]; ss += v[e] * v[e]; }
    ss = wave_sum(ss); const float rinv = 1.0f / sqrtf(ss * (1.f / 512.f) + RMS_EPS);
    bf16* MB = (bf16*)(D.dec + DEC_MIXB) + (size_t)bd * DM; const float* MX = (const float*)(D.dec + DEC_MIX) + (size_t)bd * DM + 512;
#pragma unroll
    for (int e = 0; e < 8; ++e) { MB[lane * 8 + e] = (bf16)f2bf(v[e] * rinv * gain[lane * 8 + e]); MB[512 + lane * 8 + e] = (bf16)f2bf(MX[lane * 8 + e]); }
}
#ifndef PH_MASK
#define PH_MASK 0x1ff
#endif
#define PH_ON(k) ((PH_MASK >> (k)) & 1)
#ifndef PH_DUP
#define PH_DUP 0
#endif
#define PH_REP(k) for (int rep_ = 0; rep_ < (((PH_DUP >> (k)) & 1) ? 2 : 1); ++rep_)
DI unsigned lds_task_next(volatile LAS unsigned* ctr, int lane) {
    unsigned t = 0; if (lane == 0) t = __hip_atomic_fetch_add((LAS unsigned*)ctr, 1u, __ATOMIC_RELAXED, __HIP_MEMORY_SCOPE_WORKGROUP);
    return (unsigned)__builtin_amdgcn_readfirstlane((int)t);
}
DI DecP make_dec(unsigned char* ws, const float* const* in, float* out, int l) {
    DecP D; D.dec = ws + WS_DEC; D.l = l; D.xs = in[1];
    D.c1in = (const float*)(ws + WS_C1IN) + l * NIN; D.c2in = (const float*)(ws + WS_C2IN) + l * NIN; D.c1up = (const float*)(ws + WS_C1UP) + l * FFD; D.c2up = (const float*)(ws + WS_C2UP) + l * FFD;
    D.g1 = in[24] + (size_t)l * DM; D.b1 = in[25] + (size_t)l * DM; D.g2p = l > 0 ? in[28] + (size_t)(l - 1) * DM : nullptr; D.b2p = l > 0 ? in[29] + (size_t)(l - 1) * DM : nullptr;
    D.win = (const bf16*)(ws + WS_WIN) + (size_t)l * NIN * DM; D.winu = (const bf16*)(ws + WS_WINU) + (size_t)l * NRWU * DM; D.wout = (const bf16*)(ws + WS_WOUT) + (size_t)l * DM * DM;
    D.wup = (const bf16*)(ws + WS_WUP) + (size_t)l * FFD * DM; D.wdn = (const bf16*)(ws + WS_WDN) + (size_t)l * DM * FFD; D.out = out; return D;
}
DI RwkvP make_rwkv(unsigned char* ws, const float* const* in, int l) {
    RwkvP R; R.PR = (const bf16*)(ws + WS_PR); R.mu = in[8] + (size_t)l * 1792; R.muv = l > 0 ? in[9] + (size_t)(l - 1) * 32 : nullptr;
    R.dbase = in[10] + (size_t)l * 512; R.ibase = in[12] + (size_t)l * 512; R.vbase = l > 0 ? in[15] + (size_t)(l - 1) * 512 : nullptr; R.ksk = in[17] + (size_t)l * 512; R.ksa = in[18] + (size_t)l * 512; R.brk = in[19] + (size_t)l * 512;
    R.gng = in[20] + (size_t)l * 512; R.gnb = in[21] + (size_t)l * 512;
    R.dupT = (const bf16*)(ws + WS_DUPT) + (size_t)l * 512 * 64; R.iupT = (const bf16*)(ws + WS_IUPT) + (size_t)l * 512 * 64; R.vupT = l > 0 ? (const bf16*)(ws + WS_VUPT) + (size_t)(l - 1) * 512 * 32 : nullptr; R.gupT = (const bf16*)(ws + WS_GUPT) + (size_t)l * 512 * 128;
    R.ZROW = (const bf16*)(ws + WS_CTL + 512 * 1024); R.VF = (bf16*)(ws + WS_VF); R.VV = (bf16*)(ws + WS_VV); R.BON = (float*)(ws + WS_BON); R.GC = (float*)(ws + WS_GC); R.W1S = (bf16*)(ws + WS_PT); R.REFF = (bf16*)(ws + WS_REFF); R.BM = (bf16*)(ws + WS_QT); R.REC = (v4u*)(ws + WS_YLOC);
    R.YPRE = (float*)(ws + WS_YPRE); R.MIX = (bf16*)(ws + WS_MIX); R.layer0 = (l == 0); return R;
}
#define PHASE_VARS() int tid_p = (int)threadIdx.x; asm volatile("" : "+v"(tid_p)); const int lane = tid_p & 63; const int wave = __builtin_amdgcn_readfirstlane(tid_p >> 6); \
    unsigned zo_p; asm volatile("s_mov_b32 %0, 0" : "=s"(zo_p)); unsigned char* ws = args.ws + zo_p; const float* const* in = args.in + zo_p; float* out = args.out + zo_p; \
    const int gw = F.vcu * NWAVES + wave; const int rgw = (F.G - 1 - (int)blockIdx.x) * NWAVES + wave; LAS float* dsc = (LAS float*)(L3 + 65536); LAS float* dred = (LAS float*)L3; const int rwg = F.G - 1 - (int)blockIdx.x; (void)gw; (void)rgw; (void)dsc; (void)dred; (void)rwg; (void)lane; (void)in; (void)out
__global__ void __launch_bounds__(NWAVES * 64, 2) mega_fwd(Args args) {
    extern __shared__ __attribute__((aligned(16))) unsigned char lds[];
    Frame F;
    F.lds = lds; F.MISC = (volatile LAS unsigned*)((LAS unsigned char*)lds + MISC_OFF);
    F.tid = threadIdx.x; F.lane = F.tid & 63; F.wave = __builtin_amdgcn_readfirstlane(F.tid >> 6);
    F.G = gridDim.x; { const int bx = blockIdx.x; F.vcu = (F.G % 8 == 0) ? (bx % 8) * (F.G / 8) + bx / 8 : bx; }
    F.gw = F.vcu * NWAVES + F.wave; F.NGW = F.G * NWAVES;
    F.in = args.in; F.out = args.out; F.ws = args.ws; F.ctl = (gu32*)(args.ws + WS_CTL);
    LAS unsigned char* L3 = (LAS unsigned char*)lds;
    for (int u = F.tid; u < (LDS_BYTES - RING_BYTES) / 4; u += NWAVES * 64) ((LAS unsigned*)(L3 + RING_BYTES))[u] = 0u;
    __syncthreads();
    XcdBarrier bar = xcd_barrier_post((unsigned*)(F.ctl + CW_BAR), F.MISC + 8);
#define GRID_BAR() do { XcdBarrier b2_ = bar; asm volatile("" : "+s"(b2_.x)); xcd_barrier(b2_); } while (0)

    PH_REP(0) { if (PH_ON(0)) p0_prologue(F);
    GRID_BAR(); }

    for (int l = 0; l < DEPTH; ++l) {
        PH_REP(1) {
        if (PH_ON(1))
        {   PHASE_VARS(); const DecP D = make_dec(ws, in, out, l);
            pg8::Gemm g{(const pg8::bf16_t*)(ws + WS_XB2), (const pg8::bf16_t*)D.win, M, NIN, DM}; pg8::StaticOrder S; S.init(M, NIN, F.G, (int)blockIdx.x);
            pg8::EpiIn E{ws, out, l};
            pg8::gemm_phase<pg8::EpiIn, pg8::StaticOrder, true, true>((PG8_LAS unsigned char*)L3, g, S, E, tid_p);
            for (int u = rwg; u < 162; u += F.G) dec_unit_in(D, u, dred, dsc, wave, lane);
        }
        GRID_BAR();
        }

#define ATT_QUEUE() do { LAS unsigned char* wl_ = L3 + wave * 10240; const int bh_ = F.vcu >> 4, span_ = F.vcu & 15; \
        for (;;) { const unsigned t_ = lds_task_next(F.MISC, lane); if (t_ >= 48u) break; \
            if (t_ >= 48u) { const int dt_ = (int)blockIdx.x * 4 + (int)(t_ - 48u); \
                if (dt_ < 768) dec_attn_task(D, in[4], in[5], (const float*)(ws + WS_ROPE), dt_ / 24, (dt_ % 24) / 3, dt_ % 3, lane); \
                else dec_rwkv_task(D, in, (dt_ - 768) >> 3, (dt_ - 768) & 7, (LAS float*)wl_, lane); continue; } \
            const int p_ = (int)t_ >> 4, idx_ = (int)t_ & 15; \
            const int cls_ = p_ == 0 ? 0 : p_ == 1 ? (idx_ >> 2) : idx_, qblk_ = p_ == 0 ? span_ * 16 + idx_ : p_ == 1 ? span_ * 4 + (idx_ & 3) : span_; \
            attn_task((const bf16*)(ws + WS_QB), (const bf16*)(ws + WS_KB), (const bf16*)(ws + WS_VB), (bf16*)(ws + WS_OP), (float*)(ws + WS_LSE), bh_ >> 3, bh_ & 7, p_, cls_, qblk_, wl_, lane); } } while (0)
        PH_REP(3) {
        if (PH_ON(3))
        {   PHASE_VARS(); const DecP D = make_dec(ws, in, out, l); const RwkvP R = make_rwkv(ws, in, l);
            if (tid_p == 0) F.MISC[0] = 0u;
            if (l == 0) colsum_finish(ws, gw * 64 + lane, F.NGW * 64);
            { LAS unsigned char* wl1 = L3 + wave * 12288; LAS unsigned char* hc = L3 + 8 * 12288;
              head_cache_fill(R, (F.vcu >> 4) & 7, hc, tid_p);
              __syncthreads();
#pragma unroll 1
              for (int i = 0; i < 4; ++i) rwkv_b1_unit(R, F.vcu * 32 + wave + 8 * i, wl1, hc, lane); }
            VM_WAIT(); __syncthreads();
            if (wave >= 4) { const int dt = (int)blockIdx.x * 4 + (wave - 4);
                if (dt < 768) dec_attn_task(D, in[4], in[5], (const float*)(ws + WS_ROPE), dt / 24, (dt % 24) / 3, dt % 3, lane);
                else dec_rwkv_task(D, in, (dt - 768) >> 3, (dt - 768) & 7, (LAS float*)(L3 + wave * 10240), lane); }
            PH_REP(13) chain_pass1(R, (float*)(ws + WS_SEGQ), (float*)(ws + WS_SEGP), F.vcu >> 4, F.vcu & 15, wave >> 2, wave & 3, lane);
            ATT_QUEUE();
            if ((PH_DUP >> 12) & 1) { __syncthreads(); if (tid_p == 0) F.MISC[0] = 0u; __syncthreads(); ATT_QUEUE(); }
        }
        GRID_BAR();
        }
        PH_REP(9) {
        if (PH_ON(3))
        {   PHASE_VARS(); const DecP D = make_dec(ws, in, out, l); const RwkvP R = make_rwkv(ws, in, l);
            const int seq = F.vcu >> 4, sg = F.vcu & 15;
            LAS unsigned char* gcache = L3 + 98304; gate_cache_fill(R, seq & 7, gcache, tid_p);
            if (wave < 4) chain_pass23(R, (const float*)(ws + WS_SEGQ), (const float*)(ws + WS_SEGP), seq, sg, wave, out + O_WKP + ((size_t)l * 16 + seq) * 4096, lane);
            else { for (int i = 0; i < 16; ++i) attn_finalize_row((const bf16*)(ws + WS_OP), (const float*)(ws + WS_LSE), in[22] + (size_t)l * 512, (bf16*)(ws + WS_MIX), (int)blockIdx.x * 64 + (wave - 4) * 16 + i, lane);
                if (blockIdx.x < MD && wave == 4) dec_finalize_row(D, in[22] + (size_t)l * 512, (int)blockIdx.x, lane); }
            VM_WAIT(); __syncthreads();
#pragma unroll 1
            for (int i = 0; i < 4; ++i) rwkv_b3_unit(R, seq * NCH + sg * SEGCH + wave + 8 * i, gcache, lane);
        }
        GRID_BAR();
        }

        PH_REP(5) {
        if (PH_ON(5))
        {   PHASE_VARS(); const DecP D = make_dec(ws, in, out, l);
            pg8::Gemm g{(const pg8::bf16_t*)(ws + WS_MIX), (const pg8::bf16_t*)D.wout, M, DM, DM}; pg8::StaticOrder S; S.init(M, DM, F.G, (int)blockIdx.x);
            pg8::EpiRes<false> E{ws, in, out, l};
            pg8::gemm_phase<pg8::EpiRes<false>, pg8::StaticOrder, false, true>((PG8_LAS unsigned char*)L3, g, S, E, tid_p);
            for (int u = rwg; u < 32; u += F.G)
                dec_unit_res((const bf16*)(D.dec + DEC_MIXB), D.wout, DM, u, l == 0, l == 0 ? D.xs : (const float*)(D.dec + DEC_T2), (const float*)(D.dec + DEC_ST2), D.g2p, D.b2p, (float*)(D.dec + DEC_T1), (bf16*)(D.dec + DEC_XB1), (float*)(D.dec + DEC_ST1),
                             out + O_SHS + (size_t)l * MD * DM, dred, dsc, wave, lane);
        }
        GRID_BAR();
        }

        PH_REP(6) {
        if (PH_ON(6))
        {   PHASE_VARS(); const DecP D = make_dec(ws, in, out, l);
            pg8::Gemm g{(const pg8::bf16_t*)(ws + WS_XB1), (const pg8::bf16_t*)D.wup, M, FFD, DM}; pg8::StaticOrder S; S.init(M, FFD, F.G, (int)blockIdx.x);
            pg8::EpiUp E{ws, l};
            pg8::gemm_phase<pg8::EpiUp, pg8::StaticOrder, true, true>((PG8_LAS unsigned char*)L3, g, S, E, tid_p);
            for (int u = rwg; u < 128; u += F.G) dec_unit_up(D, u, dred, dsc, wave, lane);
        }
        GRID_BAR();
        }

        PH_REP(7) {
        if (PH_ON(7))
        {   PHASE_VARS(); const DecP D = make_dec(ws, in, out, l);
            pg8::Gemm g{(const pg8::bf16_t*)(ws + WS_H), (const pg8::bf16_t*)D.wdn, M, DM, FFD}; pg8::StaticOrder S; S.init(M, DM, F.G, (int)blockIdx.x);
            pg8::EpiRes<true> E{ws, in, out, l};
            PH_REP(11) { pg8::gemm_phase<pg8::EpiRes<true>, pg8::StaticOrder, false, true>((PG8_LAS unsigned char*)L3, g, S, E, tid_p); }
            PH_REP(10) for (int u = rwg; u < 32; u += F.G)
                dec_unit_res((const bf16*)(D.dec + DEC_HB), D.wdn, FFD, u, false, (const float*)(D.dec + DEC_T1), (const float*)(D.dec + DEC_ST1), D.g1, D.b1, (float*)(D.dec + DEC_T2), (bf16*)(D.dec + DEC_XB2), (float*)(D.dec + DEC_ST2), nullptr, dred, dsc, wave, lane);
        }
        GRID_BAR();
        }
    }
    if (PH_ON(8))
    {   PHASE_VARS(); const float* g = in[28] + (size_t)3 * DM; const float* b = in[29] + (size_t)3 * DM;
        for (int r = gw; r < M; r += F.NGW) { float mu, rs; pg8::row_stats((const float*)(ws + WS_STAT2), r, mu, rs);
            const v2u* t = (const v2u*)((const bf16*)(ws + WS_XB2) + (size_t)r * DM) + lane; f32x4* o = (f32x4*)(out + O_Y + (size_t)r * DM) + lane;
#pragma unroll
            for (int j = 0; j < 4; ++j) { const f32x4 gg = *((const f32x4*)g + lane + 64 * j), bb = *((const f32x4*)b + lane + 64 * j); const v2u w = t[64 * j]; const f32x4 tv = {bflo(w.x), bfhi(w.x), bflo(w.y), bfhi(w.y)}; o[64 * j] = (tv - mu) * rs * gg + bb; } }
        if (rgw < MD) { LAS float* fsc = dsc + wave * 64; dec_row_stats((const float*)(ws + WS_DEC + DEC_ST2), fsc, lane); const float mu = fsc[2 * rgw], rs = fsc[2 * rgw + 1];
            const f32x4* t = (const f32x4*)((const float*)(ws + WS_DEC + DEC_T2) + (size_t)rgw * DM) + lane; f32x4* o = (f32x4*)(out + O_YS + (size_t)rgw * DM) + lane;
#pragma unroll
            for (int j = 0; j < 4; ++j) { const f32x4 gg = *((const f32x4*)g + lane + 64 * j), bb = *((const f32x4*)b + lane + 64 * j); o[64 * j] = (t[64 * j] - mu) * rs * gg + bb; } }
    }
}

extern "C" void kernel_launch(void* const* d_in, const int* in_sizes, int n_in, void* d_out, int out_size, void* d_ws, size_t ws_size, hipStream_t stream) {
    static int grid = 0;
    if (grid == 0) {
        if (n_in != 30 || out_size != (int)O_END || ws_size < WS_END) { fprintf(stderr, "kernel_launch: unexpected problem (n_in %d, out %d, ws %zu); nothing launched\n", n_in, out_size, ws_size); grid = -1; return; }
        int dev = 0, cus = 0, per_cu = 0;
        if (hipGetDevice(&dev) != hipSuccess || hipDeviceGetAttribute(&cus, hipDeviceAttributeMultiprocessorCount, dev) != hipSuccess) { fprintf(stderr, "kernel_launch: device query failed\n"); grid = -1; return; }
        if (hipFuncSetAttribute((const void*)mega_fwd, hipFuncAttributeMaxDynamicSharedMemorySize, LDS_BYTES) != hipSuccess) { fprintf(stderr, "kernel_launch: hipFuncSetAttribute failed\n"); grid = -1; return; }
        if (hipOccupancyMaxActiveBlocksPerMultiprocessor(&per_cu, (const void*)mega_fwd, NWAVES * 64, LDS_BYTES) != hipSuccess || per_cu < 1) fprintf(stderr, "kernel_launch: occupancy query reports %d\n", per_cu);
        (void)hipGetLastError();
        if (cus < 256) { fprintf(stderr, "kernel_launch: needs 256 CUs (found %d)\n", cus); grid = -1; return; }
        grid = 256;
    }
    if (grid < 0) return;
    if (hipMemsetAsync((char*)d_ws + WS_CTL, 0, CTL_ZERO_BYTES, stream) != hipSuccess) { fprintf(stderr, "kernel_launch: memset failed\n"); return; }
    Args a{};
    for (int i = 0; i < 30; ++i) a.in[i] = (const float*)d_in[i];
    a.out = (float*)d_out; a.ws = (unsigned char*)d_ws;
    hipLaunchKernelGGL(mega_fwd, dim3(grid), dim3(NWAVES * 64), LDS_BYTES, stream, a);
    const hipError_t le = hipPeekAtLastError();
    if (le != hipSuccess) fprintf(stderr, "kernel_launch: launch failed: %s\n", hipGetErrorName(le));
}
```

```cpp
#include <hip/hip_runtime.h>
#include <cstdio>
#include <cstdint>
#include <cmath>
namespace pg8 {
#define PG8_LAS __attribute__((address_space(3)))
typedef unsigned short bf16_t;
typedef short bf16x8 __attribute__((ext_vector_type(8)));
typedef float f32x4 __attribute__((ext_vector_type(4)));
typedef unsigned u32x4 __attribute__((ext_vector_type(4)));
constexpr int BM = 256, BK = 64, HALF = 128, HTB = HALF * BK * 2  , STAGE_BYTES = 8 * HTB, NXCD = 8, WGM = 8;

__host__ __device__ __forceinline__ int lds_byte(int r, int c) { const int st = (r >> 4) * 2 + (c >> 5), rr = r & 15, cc = c & 31, ob = rr * 64 + cc * 2; return st * 1024 + (ob ^ (((ob >> 9) & 1) << 5)); }
__host__ __device__ __forceinline__ void stage_rc(int b, int& R, int& C) { const int st = b / 1024, sb = b % 1024, swz = sb ^ (((sb >> 9) & 1) << 5); R = (st >> 1) * 16 + swz / 64; C = (st & 1) * 32 + (swz % 64) / 2; }
__host__ __device__ __forceinline__ int perm32(int rho) { const int n = rho >> 4, i = rho & 15; return 8 * (i >> 2) + 4 * n + (i & 3); }

struct Unit { int pm, pn; };
struct Gemm { const bf16_t* A; const bf16_t* Bt; int M, N, K; };

struct StaticOrder {
    int nM, nN, nwg, G, c;
    __host__ __device__ void init(int M, int N, int G_, int c_) { nM = M / BM; nN = N / BM; nwg = nM * nN; G = G_; c = c_; }
    __host__ __device__ bool next(int i, Unit& u) const {
        const long L = (long)i * G + c; if (L >= nwg) return false;
        int wgid = (int)L; { const int q = nwg / NXCD, r = nwg % NXCD, xcd = wgid % NXCD, off = wgid / NXCD; wgid = (xcd < r ? xcd * (q + 1) : r * (q + 1) + (xcd - r) * q) + off; }
        const int nig = WGM * nN, gid = wgid / nig, fm = gid * WGM, gsz = (nM - fm) < WGM ? (nM - fm) : WGM;
        u.pm = fm + ((wgid % nig) % gsz); u.pn = (wgid % nig) / gsz; return true;
    }
    __device__ __forceinline__ void a_ready(const Unit&) const {}
    __device__ __forceinline__ void done(const Unit&) const {}
};

__device__ __forceinline__ unsigned cvt_pk_bf16(float lo, float hi) { unsigned r; asm volatile("v_cvt_pk_bf16_f32 %0, %1, %2" : "=v"(r) : "v"(lo), "v"(hi)); return r; }
typedef float f32x2 __attribute__((ext_vector_type(2)));
constexpr size_t WSO_C1IN = 1u << 20, WSO_C2IN = WSO_C1IN + 4 * 3584 * 4, WSO_C1UP = WSO_C2IN + 4 * 3584 * 4, WSO_C2UP = WSO_C1UP + 4 * 4096 * 4, WSO_ROPE = 3u << 20, WSO_STAT1 = 8u << 20, WSO_STAT2 = 9u << 20;
constexpr size_t WSO_XB2 = 132ull << 20, WSO_XB1 = 164ull << 20, WSO_T1 = 196ull << 20, WSO_T2 = 260ull << 20, WSO_QB = 324ull << 20, WSO_KB = 340ull << 20, WSO_VB = 356ull << 20, WSO_PR = 372ull << 20, WSO_H = 580ull << 20;
constexpr size_t OO_SHP = 16809984, OO_KP = 21405696, OO_VP = 29794304;
__device__ __forceinline__ void row_stats(const float* stat, int row, float& mu, float& rs) {
    const f32x4 a = *(const f32x4*)(stat + (size_t)row * 8), b = *(const f32x4*)(stat + (size_t)row * 8 + 4);
    const float s = (a[0] + a[2]) + (b[0] + b[2]), q = (a[1] + a[3]) + (b[1] + b[3]);
    mu = s * (1.f / 1024.f); const float var = fmaxf(q * (1.f / 1024.f) - mu * mu, 0.f); rs = 1.0f / sqrtf(var + 1e-5f);
}
typedef float f32x2e __attribute__((ext_vector_type(2)));
typedef unsigned u32x2e __attribute__((ext_vector_type(2)));
struct EpiIn {
    static constexpr bool PERM = false, AFTER_DRAIN = false;
    unsigned char* ws; float* out; int l;
    __device__ __forceinline__ void operator()(const f32x4 (&acc)[2][2][4][2], const Unit& u, int wr, int wc, int fr, int fq) const {
        asm volatile("" ::: "memory"); __builtin_amdgcn_sched_barrier(0);
        const int fold = l > 0; const float* stat = (const float*)(ws + WSO_STAT2); const float* c1 = (const float*)(ws + WSO_C1IN) + l * 3584; const float* c2 = (const float*)(ws + WSO_C2IN) + l * 3584;
        bf16_t* QB = (bf16_t*)(ws + WSO_QB); bf16_t* KB = (bf16_t*)(ws + WSO_KB); bf16_t* VB = (bf16_t*)(ws + WSO_VB); bf16_t* PR = (bf16_t*)(ws + WSO_PR); const float* rope = (const float*)(ws + WSO_ROPE);
        float* outk = out + OO_KP + (size_t)l * 2 * 2048 * 512; float* outv = out + OO_VP + (size_t)l * 2 * 2048 * 512; const float qscale = 0.125f * 1.4426950408889634f;
        const int cb = u.pn * BM + wc * 32 + 4 * fq;
        const int i0 = 16 * (wc & 1) + 4 * fq; const bool roped = u.pn < 4;
        const int rbase = u.pm * BM + wr * 64 + fr;
        float mu8[8], rs8[8];
#pragma unroll
        for (int gq = 0; gq < 8; ++gq) { mu8[gq] = 0.f; rs8[gq] = 1.f; if (fold) row_stats(stat, rbase + (gq >> 2) * HALF + (gq & 3) * 16, mu8[gq], rs8[gq]); }
#pragma unroll
        for (int bj = 0; bj < 2; ++bj) {
            f32x4 c1v[2], c2v[2];
#pragma unroll
            for (int n = 0; n < 2; ++n) { c1v[n] = fold ? *(const f32x4*)(c1 + cb + bj * HALF + n * 16) : (f32x4){0.f, 0.f, 0.f, 0.f}; c2v[n] = fold ? *(const f32x4*)(c2 + cb + bj * HALF + n * 16) : (f32x4){0.f, 0.f, 0.f, 0.f}; }
#pragma unroll
            for (int gq = 0; gq < 8; ++gq) {
                const int ai = gq >> 2, m = gq & 3;
                const int r = rbase + ai * HALF + m * 16;
                const float mu = mu8[gq], rs = rs8[gq];
                f32x4 ra = {0.f, 0.f, 0.f, 0.f}, rb = ra;
                if (roped) { const float* rp = rope + ((size_t)(r & 8191) * 32 + i0) * 2; ra = *(const f32x4*)rp; rb = *(const f32x4*)(rp + 4); }
                if ((gq & 3) == 3) asm volatile("" ::: "memory");
                f32x4 v[2];
#pragma unroll
                for (int n = 0; n < 2; ++n) v[n] = (acc[ai][bj][m][n] - mu * c1v[n]) * rs + c2v[n];
                const int pos = r & 8191, b = r >> 13;
                if (roped) {
                    const f32x4 cs = {ra[0], ra[2], rb[0], rb[2]}, sn = {ra[1], ra[3], rb[1], rb[3]};
                    const int head = (u.pn & 1) * 4 + bj * 2 + (wc >> 1);
                    f32x4 y1 = v[0] * cs - v[1] * sn, y2 = v[0] * sn + v[1] * cs;
                    const size_t o = (size_t)r * 512 + head * 64 + i0;
                    if (u.pn < 2) { y1 = y1 * qscale; y2 = y2 * qscale;
                        u32x2e w; w.x = cvt_pk_bf16(y1[0], y1[1]); w.y = cvt_pk_bf16(y1[2], y1[3]); *(u32x2e*)(QB + o) = w;
                        w.x = cvt_pk_bf16(y2[0], y2[1]); w.y = cvt_pk_bf16(y2[2], y2[3]); *(u32x2e*)(QB + o + 32) = w;
                    } else {
                        u32x2e w; w.x = cvt_pk_bf16(y1[0], y1[1]); w.y = cvt_pk_bf16(y1[2], y1[3]); *(u32x2e*)(KB + o) = w;
                        w.x = cvt_pk_bf16(y2[0], y2[1]); w.y = cvt_pk_bf16(y2[2], y2[3]); *(u32x2e*)(KB + o + 32) = w;
                        if (pos >= 6144) { float* ok = outk + ((size_t)(b * 2048 + pos - 6144)) * 512 + head * 64 + i0; *(f32x4*)ok = y1; *(f32x4*)(ok + 32) = y2; }
                    }
                } else if (u.pn < 6) {
#pragma unroll
                    for (int n = 0; n < 2; ++n) { const int c = cb + bj * HALF + n * 16 - 1024; const f32x4 x = v[n];
                        u32x2e w; w.x = cvt_pk_bf16(x[0], x[1]); w.y = cvt_pk_bf16(x[2], x[3]); *(u32x2e*)(VB + (size_t)r * 512 + c) = w;
                        if (pos >= 6144) *(f32x4*)(outv + ((size_t)(b * 2048 + pos - 6144)) * 512 + c) = x; }
                } else {
#pragma unroll
                    for (int n = 0; n < 2; ++n) { const int c = cb + bj * HALF + n * 16 - 1536; const f32x4 x = v[n];
                        if (c < 1824) { u32x2e w; w.x = cvt_pk_bf16(x[0], x[1]); w.y = cvt_pk_bf16(x[2], x[3]); *(u32x2e*)(PR + (size_t)r * 2048 + c) = w; } }
                }
            }
        }
    }
};
template <bool IS_F> struct EpiRes {
    static constexpr bool PERM = false, AFTER_DRAIN = true;
    unsigned char* ws; const float* const* in; float* out; int l;
    __device__ __forceinline__ void fused(f32x4 (&acc)[2][2][4][2], const Unit& u, int wr, int wc, int fr, int fq, PG8_LAS unsigned char* lds, int wid, int lane) const {
        const int raw = (!IS_F && l == 0) ? 1 : 0;
        const bf16_t* src = (const bf16_t*)(ws + (IS_F ? WSO_XB1 : WSO_XB2));
        const float* sstat = (const float*)(ws + (IS_F ? WSO_STAT1 : WSO_STAT2));
        const float* g = IS_F ? in[24] + (size_t)l * 1024 : in[28] + (size_t)(l > 0 ? l - 1 : 0) * 1024; const float* b = IS_F ? in[25] + (size_t)l * 1024 : in[29] + (size_t)(l > 0 ? l - 1 : 0) * 1024;
        bf16_t* XB = (bf16_t*)(ws + (IS_F ? WSO_XB2 : WSO_XB1)); float* ostat = (float*)(ws + (IS_F ? WSO_STAT2 : WSO_STAT1));
        float* shiftout = (IS_F || raw) ? nullptr : out + OO_SHP + (size_t)l * 2 * 1024; const float alpha = 1.6817928305074290f;
        PG8_LAS f32x2e* P = (PG8_LAS f32x2e*)lds;
        const int cb = u.pn * BM + wc * 32 + 4 * fq;
        const int rbase = u.pm * BM + wr * 64 + fr;
        u32x2e cur[2][2], nxt[2][2]; f32x4 sa = {0.f, 0.f, 0.f, 0.f}, sb = sa, san = sa, sbn = sa;
#pragma unroll
        for (int bj = 0; bj < 2; ++bj)
#pragma unroll
            for (int n = 0; n < 2; ++n) { cur[bj][n] = *(const u32x2e*)(src + (size_t)rbase * 1024 + cb + bj * HALF + n * 16); nxt[bj][n] = cur[bj][n]; }
        if (!raw) { sa = *(const f32x4*)(sstat + (size_t)rbase * 8); sb = *(const f32x4*)(sstat + (size_t)rbase * 8 + 4); }
#pragma unroll
        for (int gq = 0; gq < 8; ++gq) {
            const int ai = gq >> 2, m = gq & 3;
            const int r = rbase + ai * HALF + m * 16;
            if (gq < 7) { const int rn = rbase + ((gq + 1) >> 2) * HALF + ((gq + 1) & 3) * 16;
#pragma unroll
                for (int bj = 0; bj < 2; ++bj)
#pragma unroll
                    for (int n = 0; n < 2; ++n) nxt[bj][n] = *(const u32x2e*)(src + (size_t)rn * 1024 + cb + bj * HALF + n * 16);
                if (!raw) { san = *(const f32x4*)(sstat + (size_t)rn * 8); sbn = *(const f32x4*)(sstat + (size_t)rn * 8 + 4); } }
            asm volatile("" ::: "memory");
            float mu = 0.f, rs = 1.f;
            if (!raw) { const float ssum = (sa[0] + sa[2]) + (sb[0] + sb[2]), qsum = (sa[1] + sa[3]) + (sb[1] + sb[3]); mu = ssum * (1.f / 1024.f); rs = 1.0f / sqrtf(fmaxf(qsum * (1.f / 1024.f) - mu * mu, 0.f) + 1e-5f); }
            float s = 0.f, q = 0.f;
#pragma unroll
            for (int bj = 0; bj < 2; ++bj)
#pragma unroll
                for (int n = 0; n < 2; ++n) { const int c = cb + bj * HALF + n * 16; const size_t off = (size_t)r * 1024 + c;
                    const f32x4 gvv = raw ? (f32x4){1.f, 1.f, 1.f, 1.f} : *(const f32x4*)(g + c), bvv = raw ? (f32x4){0.f, 0.f, 0.f, 0.f} : *(const f32x4*)(b + c);
                    const u32x2e cw = cur[bj][n];
                    const f32x4 cf = {__builtin_bit_cast(float, cw.x << 16), __builtin_bit_cast(float, cw.x & 0xffff0000u), __builtin_bit_cast(float, cw.y << 16), __builtin_bit_cast(float, cw.y & 0xffff0000u)};
                    const f32x4 x = (cf - mu) * rs * gvv + bvv;
                    const f32x4 t = x * alpha + acc[ai][bj][m][n];
                    u32x2e w; w.x = cvt_pk_bf16(t[0], t[1]); w.y = cvt_pk_bf16(t[2], t[3]); *(u32x2e*)(XB + off) = w;
                    s += (t[0] + t[1]) + (t[2] + t[3]); q += (t[0] * t[0] + t[1] * t[1]) + (t[2] * t[2] + t[3] * t[3]);
                    if (shiftout && (r & 8191) == 8191) *(f32x4*)(shiftout + (size_t)(r >> 13) * 1024 + c) = x; }
            s += __shfl_xor(s, 16); s += __shfl_xor(s, 32); q += __shfl_xor(q, 16); q += __shfl_xor(q, 32);
            if (fq == 0) P[(ai * HALF + wr * 64 + m * 16 + fr) * 4 + wc] = (f32x2e){s, q};
#pragma unroll
            for (int bj = 0; bj < 2; ++bj)
#pragma unroll
                for (int n = 0; n < 2; ++n) cur[bj][n] = nxt[bj][n];
            sa = san; sb = sbn;
        }
        asm volatile("s_waitcnt lgkmcnt(0)" ::: "memory"); __builtin_amdgcn_s_barrier(); asm volatile("" ::: "memory");
        if (threadIdx.x < 256) { const int row = threadIdx.x; const f32x2e a = P[row * 4 + 0], b2 = P[row * 4 + 1], c = P[row * 4 + 2], d = P[row * 4 + 3];
            *(f32x2e*)(ostat + (size_t)(u.pm * BM + row) * 8 + u.pn * 2) = (f32x2e){(a.x + b2.x) + (c.x + d.x), (a.y + b2.y) + (c.y + d.y)}; }
        asm volatile("s_waitcnt lgkmcnt(0)" ::: "memory"); __builtin_amdgcn_s_barrier(); asm volatile("" ::: "memory");
    }
};
struct EpiUp {
    static constexpr bool PERM = true, AFTER_DRAIN = false;
    unsigned char* ws; int l;
    __device__ __forceinline__ void operator()(const f32x4 (&acc)[2][2][4][2], const Unit& u, int wr, int wc, int fr, int fq) const {
        asm volatile("" ::: "memory"); __builtin_amdgcn_sched_barrier(0);
        const float* stat = (const float*)(ws + WSO_STAT1); const float* c1 = (const float*)(ws + WSO_C1UP) + l * 4096; const float* c2 = (const float*)(ws + WSO_C2UP) + l * 4096; bf16_t* H = (bf16_t*)(ws + WSO_H);
        const int cb = u.pn * BM + wc * 32 + 8 * fq;
        float mu8[8], rs8[8];
#pragma unroll
        for (int gq = 0; gq < 8; ++gq) row_stats(stat, u.pm * BM + (gq >> 2) * HALF + wr * 64 + (gq & 3) * 16 + fr, mu8[gq], rs8[gq]);
#pragma unroll
        for (int bj = 0; bj < 2; ++bj) {
            f32x4 c1v[2], c2v[2];
#pragma unroll
            for (int n = 0; n < 2; ++n) { c1v[n] = *(const f32x4*)(c1 + cb + bj * HALF + 4 * n); c2v[n] = *(const f32x4*)(c2 + cb + bj * HALF + 4 * n); }
#pragma unroll
            for (int ai = 0; ai < 2; ++ai) {
#pragma unroll
                for (int m = 0; m < 4; ++m) {
                    const int r = u.pm * BM + ai * HALF + wr * 64 + m * 16 + fr;
                    const float mu = mu8[ai * 4 + m], rs = rs8[ai * 4 + m];
                    f32x4 v0 = (acc[ai][bj][m][0] - mu * c1v[0]) * rs + c2v[0], v1 = (acc[ai][bj][m][1] - mu * c1v[1]) * rs + c2v[1];
#pragma unroll
                    for (int e = 0; e < 4; ++e) { const float a = fmaxf(v0[e], 0.f), b = fmaxf(v1[e], 0.f); v0[e] = a * a; v1[e] = b * b; }
                    u32x4 w; w.x = cvt_pk_bf16(v0[0], v0[1]); w.y = cvt_pk_bf16(v0[2], v0[3]); w.z = cvt_pk_bf16(v1[0], v1[1]); w.w = cvt_pk_bf16(v1[2], v1[3]);
                    *(u32x4*)(H + (size_t)r * 4096 + cb + bj * HALF) = w; }
            }
        }
    }
};
template <class Epi, class Sched, bool ALIGN_EPI = false, bool SP2 = false>
__device__ __forceinline__ void gemm_phase(PG8_LAS unsigned char* lds, const Gemm g, const Sched& S, const Epi& E, const int tid) {
    const int wid = __builtin_amdgcn_readfirstlane(tid >> 6), lane = tid & 63, wr = wid >> 2, wc = wid & 3, fr = lane & 15, fq = lane >> 4;
    const int K = g.K, nt = K / BK;
    unsigned voffA[2], voffB[2];
#pragma unroll
    for (int i = 0; i < 2; ++i) { int R, C; stage_rc(tid * 16 + i * 8192, R, C); const int Rb = Epi::PERM ? ((R & ~31) + perm32(R & 31)) : R;
        voffA[i] = (unsigned)(R * K + C) * 2u; voffB[i] = (unsigned)(Rb * K + C) * 2u; }
    const size_t kstep = (size_t)(BK * 2);
    const size_t hstep = (size_t)HALF * K * 2;
    const size_t tstep = 2 * hstep;
    const unsigned ldsw = (unsigned)wid * 1024u;
    const int aoff = lds_byte(wr * 64 + fr, fq * 8), boff = lds_byte(wc * 32 + fr, fq * 8);
#define PG8_SA(b, h) (((b) * 2 + (h)) * HTB)
#define PG8_SB(b, h) ((4 + (b) * 2 + (h)) * HTB)
#define PG8_STAGE(bufoff, gbase, voff) do { _Pragma("unroll") for (int _i = 0; _i < 2; ++_i) \
        __builtin_amdgcn_global_load_lds((const unsigned*)((const char*)(gbase) + (voff)[_i]), (PG8_LAS unsigned*)(lds + (bufoff) + ldsw + _i * 8192), 16, 0, 0); } while (0)
#define PG8_LDA(dst, b, h) do { _Pragma("unroll") for (int m = 0; m < 4; ++m) _Pragma("unroll") for (int k = 0; k < 2; ++k) dst[m][k] = *(const PG8_LAS bf16x8*)(lds + PG8_SA(b, h) + aoff + m * 2048 + k * 1024); } while (0)
#define PG8_LDB(dst, b, h) do { _Pragma("unroll") for (int n = 0; n < 2; ++n) _Pragma("unroll") for (int k = 0; k < 2; ++k) dst[n][k] = *(const PG8_LAS bf16x8*)(lds + PG8_SB(b, h) + boff + n * 2048 + k * 1024); } while (0)
#define PG8_MMA(ai, bj, At, Bt) do { __builtin_amdgcn_s_setprio(1); _Pragma("unroll") for (int m = 0; m < 4; ++m) _Pragma("unroll") for (int n = 0; n < 2; ++n) _Pragma("unroll") for (int k = 0; k < 2; ++k) \
        acc[ai][bj][m][n] = __builtin_amdgcn_mfma_f32_16x16x32_bf16(Bt[n][k], At[m][k], acc[ai][bj][m][n], 0, 0, 0); __builtin_amdgcn_s_setprio(0); } while (0)
#define PG8_WAIT_V(n) asm volatile("s_waitcnt vmcnt(" #n ")" ::: "memory")
#define PG8_WAIT_L(n) asm volatile("s_waitcnt lgkmcnt(" #n ")" ::: "memory")
#define PG8_BAR __builtin_amdgcn_s_barrier()
#define PG8_SCHED __builtin_amdgcn_sched_barrier(0)
    Unit cur, nxt; int ui = 0;
    if (!S.next(0, cur)) return;
    f32x4 acc[2][2][4][2];
#pragma unroll
    for (int a = 0; a < 2; ++a)
#pragma unroll
        for (int b = 0; b < 2; ++b)
#pragma unroll
            for (int m = 0; m < 4; ++m)
#pragma unroll
                for (int n = 0; n < 2; ++n) acc[a][b][m][n] = (f32x4){0.f, 0.f, 0.f, 0.f};
    bf16x8 At[4][2], B0[2][2], B1[2][2];
    const char* cA = (const char*)g.A + (size_t)cur.pm * tstep; const char* cB = (const char*)g.Bt + (size_t)cur.pn * tstep;
    S.a_ready(cur);
    if constexpr (SP2) {
        PG8_STAGE(PG8_SB(0, 0), cB, voffB); PG8_STAGE(PG8_SB(0, 1), cB + hstep, voffB); PG8_STAGE(PG8_SA(0, 0), cA, voffA); PG8_STAGE(PG8_SA(0, 1), cA + hstep, voffA);
        if (wr == 1) PG8_BAR;
        PG8_WAIT_V(2); PG8_BAR;
        PG8_STAGE(PG8_SB(1, 0), cB + kstep, voffB); PG8_STAGE(PG8_SA(1, 0), cA + kstep, voffA); PG8_STAGE(PG8_SB(1, 1), cB + hstep + kstep, voffB);
        PG8_WAIT_V(6); PG8_BAR;
    } else {
        PG8_STAGE(PG8_SB(0, 0), cB, voffB); PG8_STAGE(PG8_SA(0, 0), cA, voffA); PG8_STAGE(PG8_SB(0, 1), cB + hstep, voffB); PG8_STAGE(PG8_SA(0, 1), cA + hstep, voffA);
        if (wr == 1) PG8_BAR;
        PG8_WAIT_V(4); PG8_BAR;
        PG8_STAGE(PG8_SB(1, 0), cB + kstep, voffB); PG8_STAGE(PG8_SA(1, 0), cA + kstep, voffA); PG8_STAGE(PG8_SB(1, 1), cB + hstep + kstep, voffB);
        PG8_WAIT_V(6); PG8_BAR;
    }
    for (;;) {
        const bool has_next = S.next(ui + 1, nxt);
        const char* nA = has_next ? (const char*)g.A + (size_t)nxt.pm * tstep : cA; const char* nB = has_next ? (const char*)g.Bt + (size_t)nxt.pn * tstep : cB;
        for (int t = 0; t < nt; t += 2) {
            const bool last = (t == nt - 2);
            const char* a1 = cA + (size_t)(t + 1) * kstep;
            const char* a2 = last ? nA : cA + (size_t)(t + 2) * kstep; const char* b2 = last ? nB : cB + (size_t)(t + 2) * kstep;
            const char* a3 = a2 + kstep; const char* b3 = b2 + kstep;
            if (last && has_next) S.a_ready(nxt);
            if constexpr (SP2) {
            PG8_LDB(B0, 0, 0); PG8_LDB(B1, 0, 1); PG8_SCHED; PG8_LDA(At, 0, 0); PG8_STAGE(PG8_SA(1, 1), a1 + hstep, voffA);
            PG8_WAIT_V(8); PG8_WAIT_L(0); PG8_BAR; PG8_MMA(0, 0, At, B0); PG8_MMA(0, 1, At, B1); PG8_BAR; PG8_SCHED;
            PG8_LDA(At, 0, 1); PG8_STAGE(PG8_SB(0, 0), b2, voffB); PG8_STAGE(PG8_SB(0, 1), b2 + hstep, voffB); PG8_STAGE(PG8_SA(0, 0), a2, voffA);
            PG8_WAIT_V(8); PG8_WAIT_L(0); PG8_BAR; PG8_MMA(1, 0, At, B0); PG8_MMA(1, 1, At, B1); PG8_BAR; PG8_SCHED;
            PG8_LDB(B0, 1, 0); PG8_LDB(B1, 1, 1); PG8_SCHED; PG8_LDA(At, 1, 0); PG8_STAGE(PG8_SA(0, 1), a2 + hstep, voffA);
            PG8_WAIT_V(8); PG8_WAIT_L(0); PG8_BAR; PG8_MMA(0, 0, At, B0); PG8_MMA(0, 1, At, B1); PG8_BAR; PG8_SCHED;
            PG8_LDA(At, 1, 1); PG8_STAGE(PG8_SB(1, 0), b3, voffB); PG8_STAGE(PG8_SB(1, 1), b3 + hstep, voffB); PG8_STAGE(PG8_SA(1, 0), a3, voffA);
            PG8_WAIT_V(8); PG8_WAIT_L(0); PG8_BAR; PG8_MMA(1, 0, At, B0); PG8_MMA(1, 1, At, B1); PG8_BAR; PG8_SCHED;
            } else {
            PG8_LDB(B0, 0, 0); PG8_SCHED; PG8_LDA(At, 0, 0); PG8_STAGE(PG8_SA(1, 1), a1 + hstep, voffA);
            PG8_WAIT_L(8); PG8_BAR; PG8_WAIT_L(0); PG8_MMA(0, 0, At, B0); PG8_BAR; PG8_SCHED;
            PG8_LDB(B1, 0, 1); PG8_STAGE(PG8_SB(0, 0), b2, voffB);
            PG8_BAR; PG8_WAIT_L(0); PG8_MMA(0, 1, At, B1); PG8_BAR;
            PG8_LDA(At, 0, 1); PG8_STAGE(PG8_SA(0, 0), a2, voffA);
            PG8_BAR; PG8_WAIT_L(0); PG8_MMA(1, 0, At, B0); PG8_BAR; PG8_SCHED;
            PG8_STAGE(PG8_SB(0, 1), b2 + hstep, voffB);
            PG8_WAIT_V(6); PG8_BAR; PG8_MMA(1, 1, At, B1); PG8_BAR;
            PG8_LDB(B0, 1, 0); PG8_SCHED; PG8_LDA(At, 1, 0); PG8_STAGE(PG8_SA(0, 1), a2 + hstep, voffA);
            PG8_WAIT_L(8); PG8_BAR; PG8_WAIT_L(0); PG8_MMA(0, 0, At, B0); PG8_BAR; PG8_SCHED;
            PG8_LDB(B1, 1, 1); PG8_STAGE(PG8_SB(1, 0), b3, voffB);
            PG8_BAR; PG8_WAIT_L(0); PG8_MMA(0, 1, At, B1); PG8_BAR;
            PG8_LDA(At, 1, 1); PG8_STAGE(PG8_SA(1, 0), a3, voffA);
            PG8_BAR; PG8_WAIT_L(0); PG8_MMA(1, 0, At, B0); PG8_BAR; PG8_SCHED;
            PG8_STAGE(PG8_SB(1, 1), b3 + hstep, voffB);
            PG8_WAIT_V(6); PG8_BAR; PG8_MMA(1, 1, At, B1); PG8_BAR;
            }
        }
        if constexpr (ALIGN_EPI) { if (wr == 0) PG8_BAR; }
        if constexpr (!Epi::AFTER_DRAIN) { E(acc, cur, wr, wc, fr, fq); S.done(cur); }
        if (!has_next) break;
#pragma unroll
        for (int a = 0; a < 2; ++a)
#pragma unroll
            for (int b = 0; b < 2; ++b)
#pragma unroll
                for (int m = 0; m < 4; ++m)
#pragma unroll
                    for (int n = 0; n < 2; ++n) acc[a][b][m][n] = (f32x4){0.f, 0.f, 0.f, 0.f};
        cur = nxt; cA = nA; cB = nB; ++ui;
        if constexpr (ALIGN_EPI) { if (wr == 1) PG8_BAR; }
    }
    PG8_WAIT_V(0);
    if constexpr (!ALIGN_EPI) { if (wr == 0) PG8_BAR; }
    PG8_BAR;
    if constexpr (Epi::AFTER_DRAIN) { E.fused(acc, cur, wr, wc, fr, fq, lds, wid, lane); S.done(cur); }
#undef PG8_SA
#undef PG8_SB
#undef PG8_STAGE
#undef PG8_LDA
#undef PG8_LDB
#undef PG8_MMA
#undef PG8_WAIT_V
#undef PG8_WAIT_L
#undef PG8_BAR
#undef PG8_SCHED
}
}
constexpr int NWAVES = 8;
constexpr int M = 16384, TSEQ = 8192, DM = 1024, FFD = 4096, DEPTH = 4, MD = 32, NH = 8, HD = 64;
constexpr int NIN = 3584;
constexpr int RW0 = 1536;
constexpr int PRP = 2048;
constexpr int NRWU = 1856;
constexpr int CH = 16, NCH = TSEQ / CH;
constexpr int NUNIT = 2 * NH * NCH;
constexpr float LN_EPS = 1e-5f, GN_EPS = 64e-5f, RMS_EPS = 1e-6f;
constexpr float ALPHA = 1.6817928305074290f;
constexpr float QSCALE = 0.125f * 1.4426950408889634f;
constexpr size_t O_Y = 0, O_YS = 16777216, O_SHP = 16809984, O_SHS = 16818176, O_WKP = 16949248, O_WKS = 17211392,
                 O_KP = 21405696, O_VP = 29794304, O_KS = 38182912, O_VS = 38248448, O_END = 38313984;
constexpr size_t MiB = 1u << 20;
constexpr size_t WS_CTL = 0, CTL_ZERO_BYTES = 1 * MiB;
constexpr size_t WS_C1IN = 1 * MiB;
constexpr size_t WS_C2IN = WS_C1IN + 4 * NIN * 4;
constexpr size_t WS_C1UP = WS_C2IN + 4 * NIN * 4;
constexpr size_t WS_C2UP = WS_C1UP + 4 * FFD * 4;
constexpr size_t WS_DUPT = WS_C2UP + 4 * FFD * 4;
constexpr size_t WS_IUPT = WS_DUPT + 4 * 512 * 64 * 2;
constexpr size_t WS_GUPT = WS_IUPT + 4 * 512 * 64 * 2;
constexpr size_t WS_VUPT = WS_GUPT + 4 * 512 * 128 * 2;
constexpr size_t WS_SMALL_END = WS_VUPT + 3 * 512 * 32 * 2;
static_assert(WS_SMALL_END <= 3 * MiB, "small region");
constexpr size_t WS_ROPE = 3 * MiB;
constexpr size_t WS_DEC = 6 * MiB;
constexpr size_t WS_STAT1 = 8 * MiB, WS_STAT2 = 9 * MiB;
constexpr size_t WS_BON = 10 * MiB;
constexpr size_t WS_LSE = 11 * MiB;
constexpr size_t WS_GC = 13 * MiB;
constexpr size_t WS_WIN = 16 * MiB;
constexpr size_t WS_WINU = 44 * MiB;
constexpr size_t WS_WOUT = 60 * MiB;
constexpr size_t WS_WUP = 68 * MiB;
constexpr size_t WS_WDN = 100 * MiB;
constexpr size_t WS_XB2 = 132 * MiB;
constexpr size_t WS_XB1 = 164 * MiB;
constexpr size_t WS_T1 = 196 * MiB;
constexpr size_t WS_T2 = 260 * MiB;
constexpr size_t WS_QB = 324 * MiB, WS_KB = 340 * MiB, WS_VB = 356 * MiB;
constexpr size_t WS_PR = 372 * MiB;
constexpr size_t WS_OP = 436 * MiB;
constexpr size_t WS_MIX = 484 * MiB;
constexpr size_t WS_VF = 516 * MiB, WS_VV = 532 * MiB;
constexpr size_t WS_YPRE = 548 * MiB;
constexpr size_t WS_H = 580 * MiB;
constexpr size_t WS_PT = 580 * MiB;
constexpr size_t WS_QT = 644 * MiB;
constexpr size_t WS_REFF = 708 * MiB;
constexpr size_t WS_YLOC = 724 * MiB;
constexpr size_t WS_SEGQ = 756 * MiB, WS_SEGP = 760 * MiB;
constexpr size_t WS_CSUM = 764 * MiB;
constexpr size_t WS_CSUP = 766 * MiB;
constexpr size_t WS_END = 768 * MiB;
static_assert(WS_H + (size_t)M * FFD * 2 <= WS_END + 0 * MiB || true, "");
constexpr size_t DEC_XB2 = 0;
constexpr size_t DEC_XB1 = 64 * 1024;
constexpr size_t DEC_SHB = 128 * 1024;
constexpr size_t DEC_MIXB = 384 * 1024;
constexpr size_t DEC_HB = 448 * 1024;
constexpr size_t DEC_T1 = 704 * 1024;
constexpr size_t DEC_T2 = 832 * 1024;
constexpr size_t DEC_PD = 960 * 1024;
constexpr size_t DEC_PS = 1408 * 1024;
constexpr size_t DEC_OP = 1640 * 1024;
constexpr size_t DEC_LSE = 1832 * 1024;
constexpr size_t DEC_MIX = 1836 * 1024;
constexpr size_t DEC_ST1 = 1964 * 1024;
constexpr size_t DEC_ST2 = 1972 * 1024;
constexpr size_t DEC_VF = 1980 * 1024;
static_assert(DEC_VF + 32 * 512 * 4 <= 2 * MiB, "decode scratch");
constexpr int CW_BAR = 4096;
constexpr int RING_BYTES = 131072;
constexpr int MISC_OFF = RING_BYTES + 320;
constexpr int LDS_BYTES = 147456;
static_assert(pg8::WSO_C1IN == WS_C1IN && pg8::WSO_C2IN == WS_C2IN && pg8::WSO_C1UP == WS_C1UP && pg8::WSO_C2UP == WS_C2UP && pg8::WSO_ROPE == WS_ROPE && pg8::WSO_STAT1 == WS_STAT1 && pg8::WSO_STAT2 == WS_STAT2 &&
              pg8::WSO_XB2 == WS_XB2 && pg8::WSO_XB1 == WS_XB1 && pg8::WSO_T1 == WS_T1 && pg8::WSO_T2 == WS_T2 && pg8::WSO_QB == WS_QB && pg8::WSO_KB == WS_KB && pg8::WSO_VB == WS_VB && pg8::WSO_PR == WS_PR && pg8::WSO_H == WS_H &&
              pg8::OO_SHP == O_SHP && pg8::OO_KP == O_KP && pg8::OO_VP == O_VP, "epilogue offset mirrors");
#define GAS __attribute__((address_space(1)))
#define LAS __attribute__((address_space(3)))
typedef unsigned short bf16;
typedef unsigned v4u __attribute__((ext_vector_type(4)));
typedef unsigned v2u __attribute__((ext_vector_type(2)));
typedef float f32x4 __attribute__((ext_vector_type(4)));
typedef float f32x2 __attribute__((ext_vector_type(2)));
typedef float f32x16 __attribute__((ext_vector_type(16)));
typedef short bf16x8 __attribute__((ext_vector_type(8)));
typedef short s16x4 __attribute__((ext_vector_type(4)));
typedef GAS unsigned gu32;
#define RLX_AGENT __ATOMIC_RELAXED, __HIP_MEMORY_SCOPE_AGENT
#define LDS_WAIT() asm volatile("s_waitcnt lgkmcnt(0)" ::: "memory")
#define VM_WAIT() asm volatile("s_waitcnt vmcnt(0)" ::: "memory")
#define DI __device__ __forceinline__
DI unsigned f2bf(float f) { unsigned u = __builtin_bit_cast(unsigned, f); return (u + 0x7fffu + ((u >> 16) & 1u)) >> 16; }
DI float bf2f(unsigned b) { return __builtin_bit_cast(float, b << 16); }
DI float bflo(unsigned w) { return __builtin_bit_cast(float, w << 16); }
DI float bfhi(unsigned w) { return __builtin_bit_cast(float, w & 0xffff0000u); }
typedef __bf16 bf16x2_t __attribute__((ext_vector_type(2)));
DI unsigned pk2(float lo, float hi) { const f32x2 v = {lo, hi}; const bf16x2_t b = __builtin_convertvector(v, bf16x2_t); return __builtin_bit_cast(unsigned, b); }
DI unsigned pk2z(float x) { return pk2(x, 0.f) & 0xffffu; }
DI float rbf(float x) { return bf2f(f2bf(x)); }
DI bf16x8 pk8(float a0, float a1, float a2, float a3, float a4, float a5, float a6, float a7) {
    v4u w; w.x = pk2(a0, a1); w.y = pk2(a2, a3); w.z = pk2(a4, a5); w.w = pk2(a6, a7); return __builtin_bit_cast(bf16x8, w); }
DI bf16x8 pk8v(f32x4 a, f32x4 b) { return pk8(a[0], a[1], a[2], a[3], b[0], b[1], b[2], b[3]); }
DI bf16x8 pk4z(f32x4 a) { v4u w; w.x = pk2(a[0], a[1]); w.y = pk2(a[2], a[3]); w.z = 0u; w.w = 0u; return __builtin_bit_cast(bf16x8, w); }
DI bf16x8 ld8(const void* p) { return *(const bf16x8*)p; }
DI bf16x8 ld4z(const void* p) { v2u t = *(const v2u*)p; v4u w; w.x = t.x; w.y = t.y; w.z = 0u; w.w = 0u; return __builtin_bit_cast(bf16x8, w); }
DI f32x4 mfma16(bf16x8 a, bf16x8 b, f32x4 c) { return __builtin_amdgcn_mfma_f32_16x16x32_bf16(a, b, c, 0, 0, 0); }
DI f32x16 mfma32(bf16x8 a, bf16x8 b, f32x16 c) { return __builtin_amdgcn_mfma_f32_32x32x16_bf16(a, b, c, 0, 0, 0); }
DI int crow(int r, int hi) { return (r & 3) + 8 * (r >> 2) + 4 * hi; }
DI float wave_sum(float v) {
#pragma unroll
    for (int o = 1; o < 64; o <<= 1) v += __shfl_xor(v, o);
    return v; }
DI float fexp(float x) { return __expf(x); }
DI float fsigmoid(float x) { return __builtin_amdgcn_rcpf(1.f + __expf(-x)); }
DI float ftanh(float x) { return 1.f - 2.f * __builtin_amdgcn_rcpf(__expf(2.f * x) + 1.f); }
DI float fsoftplus(float x) { return fmaxf(x, 0.f) + __logf(1.f + __expf(-fabsf(x))); }
DI int swap45(int c) { return (c & ~0x30) | ((c & 0x10) << 1) | ((c & 0x20) >> 1); }
#define XB_TMO      128
#define XB_XCNT(j)  (256  + 64 * (j))
#define XB_XSUB(j)  (1280 + 64 * (j))
#define XB_XGEN(j)  (2304 + 64 * (j))
#define XB_TOP      3328
#define XB_TOPGEN   3392
#define XCD_BAR_WORDS 3456
#define XB_SPIN_CAP (1u << 18)

__device__ __forceinline__ unsigned xb_ld(unsigned* p)              { return __hip_atomic_load(p, __ATOMIC_RELAXED, __HIP_MEMORY_SCOPE_AGENT); }
__device__ __forceinline__ unsigned xb_add(unsigned* p, unsigned v) { return __hip_atomic_fetch_add(p, v, __ATOMIC_RELAXED, __HIP_MEMORY_SCOPE_AGENT); }
__device__ __forceinline__ unsigned xb_xcc_id() { return (unsigned)__builtin_amdgcn_s_getreg((3 << 11) | 20) & 0xFu; }
#define XB_SPIN(cond, bar) do { unsigned _sp = 0; while (cond) { __builtin_amdgcn_s_sleep(1); \
    if ((++_sp & 255u) == 0u) { if (xb_ld(&(bar)[XB_TMO])) break; if (_sp > XB_SPIN_CAP) { atomicAdd(&(bar)[XB_TMO], 1u); break; } } } } while (0)

struct XcdBarrier {
    unsigned* bar; unsigned x;
    volatile LAS unsigned* st;
};

__device__ __forceinline__ XcdBarrier xcd_barrier_post(unsigned* bar, volatile LAS unsigned* st) {
    XcdBarrier b; b.bar = bar; b.x = xb_xcc_id(); b.st = st;
    if (threadIdx.x == 0) (void)xb_add(&bar[XB_XCNT(b.x)], 1u);
    return b;
}
__device__ __forceinline__ void xcd_barrier_complete(unsigned* bar, unsigned x, unsigned& nloc, unsigned& nx) {
    const unsigned G = gridDim.x * gridDim.y * gridDim.z;
    unsigned sum, cnt, mine, sp = 0u;
    for (;;) {
        sum = 0u; cnt = 0u; mine = 0u;
#pragma unroll
        for (unsigned j = 0; j < 16; ++j) { const unsigned c = xb_ld(&bar[XB_XCNT(j)]); sum += c; cnt += (c > 0u) ? 1u : 0u; mine = (j == x) ? c : mine; }
        if (sum == G) break;
        __builtin_amdgcn_s_sleep(1);
        if ((++sp & 255u) == 0u) { if (xb_ld(&bar[XB_TMO])) break; if (sp > XB_SPIN_CAP) { atomicAdd(&bar[XB_TMO], 1u); break; } }
    }
    nloc = mine > 0u ? mine : 1u; nx = cnt > 0u ? cnt : 1u;
}

__device__ __forceinline__ void xcd_barrier(const XcdBarrier& b) {
    asm volatile("s_waitcnt vmcnt(0)" ::: "memory");
    __syncthreads();
    if (threadIdx.x == 0) {
        unsigned* bar = b.bar;
        __builtin_amdgcn_s_waitcnt(0);
        unsigned nloc = b.st[0], nx = b.st[1];
        if (nloc == 0u) { xcd_barrier_complete(bar, b.x, nloc, nx); b.st[0] = nloc; b.st[1] = nx; }
        const unsigned old = xb_add(&bar[XB_XSUB(b.x)], 1u);
        const unsigned gen = old / nloc;
        if (old + 1u == (gen + 1u) * nloc) {
            __builtin_amdgcn_fence(__ATOMIC_RELEASE, "agent");
            asm volatile("s_waitcnt vmcnt(0)" ::: "memory");
            const unsigned og = xb_add(&bar[XB_TOP], 1u);
            const unsigned tg = og / nx;
            if (og + 1u == (tg + 1u) * nx) xb_add(&bar[XB_TOPGEN], 1u);
            else XB_SPIN(xb_ld(&bar[XB_TOPGEN]) == tg, bar);
            __builtin_amdgcn_fence(__ATOMIC_ACQUIRE, "agent");
            xb_add(&bar[XB_XGEN(b.x)], 1u);
            asm volatile("s_waitcnt vmcnt(0)" ::: "memory");
        } else {
            XB_SPIN(xb_ld(&bar[XB_XGEN(b.x)]) == gen, bar);
            __builtin_amdgcn_fence(__ATOMIC_ACQUIRE, "agent");
            asm volatile("s_waitcnt vmcnt(0)" ::: "memory");
        }
    }
    __syncthreads();
}
struct Args { const float* in[30]; float* out; unsigned char* ws; };
struct Frame {
    unsigned char* lds;
    volatile LAS unsigned* MISC;
    gu32* ctl;
    int tid, lane, wave, vcu, G, gw, NGW;
    const float* const* in; float* out; unsigned char* ws;
};
template <bool SWAP>
DI void p0_transpose_item(const float* W, int ldw, int K, int csrc0, bf16* WT, int row_off, const float* gsc, LAS float* scr, int kb, int nb, int lane, float* csum = nullptr, int ncs = 0, const float* bsh = nullptr) {
    const int k0 = 64 * kb, n0 = 32 * nb;
    float s1 = 0.f, s2 = 0.f;
    float wv[32], gk = 1.f, bk = 0.f;
#pragma unroll
    for (int i = 0; i < 32; ++i) wv[i] = W[(size_t)(k0 + 2 * i + (lane >> 5)) * ldw + csrc0 + n0 + (lane & 31)];
    if (gsc) gk = gsc[k0 + lane]; if (bsh) bk = bsh[k0 + lane];
#pragma unroll
    for (int i = 0; i < 32; ++i) { const int kk = 2 * i + (lane >> 5); float v = wv[i]; s2 += v * __shfl(bk, kk); v *= __shfl(gk, kk); s1 += rbf(v); scr[kk * 33 + (lane & 31)] = v; }
    if (csum) { s1 += __shfl_xor(s1, 32); s2 += __shfl_xor(s2, 32); if (lane < 32) { int dr = n0 + lane; if (SWAP) dr = swap45(dr); csum[(size_t)(kb * 2 + 0) * ncs + row_off + dr] = s1; csum[(size_t)(kb * 2 + 1) * ncs + row_off + dr] = s2; } }
    LDS_WAIT(); asm volatile("" ::: "memory");
    const int c = lane & 7;
#pragma unroll
    for (int j = 0; j < 4; ++j) { const int n = (lane >> 3) + 8 * j; const LAS float* s = scr + (8 * c) * 33 + n;
        v4u o; o.x = pk2(s[0 * 33], s[1 * 33]); o.y = pk2(s[2 * 33], s[3 * 33]); o.z = pk2(s[4 * 33], s[5 * 33]); o.w = pk2(s[6 * 33], s[7 * 33]);
        int dr = n0 + n; if (SWAP) dr = swap45(dr);
        *(v4u*)(WT + (size_t)(row_off + dr) * K + k0 + 8 * c) = o; }
    LDS_WAIT(); asm volatile("" ::: "memory");
}
DI void p0_prologue(Frame& F) {
    LAS float* scr = (LAS float*)((LAS unsigned char*)F.lds + F.wave * 16384);
    const float* const* in = F.in; unsigned char* ws = F.ws;
    constexpr int I_IN = 16 * 104, I_VR = 16, I_INU = 16 * 56, I_OUT = 16 * 32, I_UP = 16 * 128, I_DN = 64 * 32;
    constexpr int I_L = I_IN + I_VR + I_INU + I_VR + I_OUT + I_UP + I_DN;
    for (int it = F.gw; it < DEPTH * I_L; it += F.NGW) {
        const int l = it / I_L; int r = it % I_L;
        const float* g2p = l > 0 ? in[28] + (size_t)(l - 1) * DM : nullptr;
        bf16* win = (bf16*)(ws + WS_WIN) + (size_t)l * NIN * DM; bf16* winu = (bf16*)(ws + WS_WINU) + (size_t)l * NRWU * DM;
        if (r < I_IN) { const int kb = r / 104, nb = r % 104; const float* W = in[6] + (size_t)l * DM * 3328;
            float* cs = l > 0 ? (float*)(ws + WS_CSUM) + (size_t)l * 32 * NIN : nullptr; const float* b2p = l > 0 ? in[29] + (size_t)(l - 1) * DM : nullptr;
            if (nb < 32) p0_transpose_item<true>(W, 3328, DM, 0, win, 0, g2p, scr, kb, nb, F.lane, cs, NIN, b2p); else p0_transpose_item<false>(W, 3328, DM, 0, win, 0, g2p, scr, kb, nb, F.lane, cs, NIN, b2p); continue; } r -= I_IN;
        if (r < I_VR) { if (l > 0) p0_transpose_item<false>(in[7] + (size_t)(l - 1) * DM * 32, 32, DM, 0, win, 3328, g2p, scr, r, 0, F.lane, (float*)(ws + WS_CSUM) + (size_t)l * 32 * NIN, NIN, in[29] + (size_t)(l - 1) * DM); continue; } r -= I_VR;
        if (r < I_INU) { const int kb = r / 56, nb = r % 56; p0_transpose_item<false>(in[6] + (size_t)l * DM * 3328, 3328, DM, RW0, winu, 0, nullptr, scr, kb, nb, F.lane); continue; } r -= I_INU;
        if (r < I_VR) { if (l > 0) p0_transpose_item<false>(in[7] + (size_t)(l - 1) * DM * 32, 32, DM, 0, winu, 1792, nullptr, scr, r, 0, F.lane); continue; } r -= I_VR;
        if (r < I_OUT) { p0_transpose_item<false>(in[23] + (size_t)l * DM * DM, DM, DM, 0, (bf16*)(ws + WS_WOUT) + (size_t)l * DM * DM, 0, nullptr, scr, r / 32, r % 32, F.lane); continue; } r -= I_OUT;
        if (r < I_UP) { p0_transpose_item<false>(in[26] + (size_t)l * DM * FFD, FFD, DM, 0, (bf16*)(ws + WS_WUP) + (size_t)l * FFD * DM, 0, in[24] + (size_t)l * DM, scr, r / 128, r % 128, F.lane, (float*)(ws + WS_CSUP) + (size_t)l * 32 * FFD, FFD, in[25] + (size_t)l * DM); continue; } r -= I_UP;
        p0_transpose_item<false>(in[27] + (size_t)l * FFD * DM, DM, FFD, 0, (bf16*)(ws + WS_WDN) + (size_t)l * DM * FFD, 0, nullptr, scr, r / 32, r % 32, F.lane);
    }
    for (int m0 = F.gw; m0 < M; m0 += 4 * F.NGW) { f32x4 v[4][4];
#pragma unroll
        for (int q = 0; q < 4; ++q) { const f32x4* xr = (const f32x4*)(in[0] + (size_t)(m0 + q * F.NGW) * DM) + F.lane;
#pragma unroll
            for (int j = 0; j < 4; ++j) v[q][j] = xr[64 * j]; }
#pragma unroll
        for (int q = 0; q < 4; ++q) { unsigned long long* o8 = (unsigned long long*)((bf16*)(ws + WS_XB2) + (size_t)(m0 + q * F.NGW) * DM) + F.lane;
#pragma unroll
            for (int j = 0; j < 4; ++j) o8[64 * j] = (unsigned long long)pk2(v[q][j].x, v[q][j].y) | ((unsigned long long)pk2(v[q][j].z, v[q][j].w) << 32); } }
    const int gt = F.gw * 64 + F.lane, NGT = F.NGW * 64;
    for (int e = gt; e < 8193 * 32; e += NGT) { const int pos = e >> 5, i = e & 31; const double ang = (double)pos * pow(10000.0, -(double)i / 32.0); ((f32x2*)(ws + WS_ROPE))[e] = (f32x2){(float)cos(ang), (float)sin(ang)}; }
    for (int e = gt; e < 4 * 512 * 64; e += NGT) { const int l = e / (512 * 64), n = (e / 64) % 512, m = e % 64; ((bf16*)(ws + WS_DUPT))[e] = (bf16)f2bf(in[11][((size_t)l * 64 + m) * 512 + n]); ((bf16*)(ws + WS_IUPT))[e] = (bf16)f2bf(in[13][((size_t)l * 64 + m) * 512 + n]); }
    for (int e = gt; e < 4 * 512 * 128; e += NGT) { const int l = e / (512 * 128), n = (e / 128) % 512, m = e % 128; ((bf16*)(ws + WS_GUPT))[e] = (bf16)f2bf(in[14][((size_t)l * 128 + m) * 512 + n]); }
    for (int e = gt; e < 3 * 512 * 32; e += NGT) { const int l = e / (512 * 32), n = (e / 32) % 512, m = e % 32; ((bf16*)(ws + WS_VUPT))[e] = (bf16)f2bf(in[16][((size_t)l * 32 + m) * 512 + n]); }
    for (int e = gt; e < 2 * DM; e += NGT) F.out[O_SHP + e] = in[0][((size_t)(e / DM) * TSEQ + TSEQ - 1) * DM + (e % DM)];
    for (int e = gt; e < MD * DM; e += NGT) { ((bf16*)(ws + WS_DEC + DEC_XB2))[e] = (bf16)f2bf(in[1][e]); }
    for (int e = gt; e < DEPTH * MD * DM; e += NGT) { ((bf16*)(ws + WS_DEC + DEC_SHB))[e] = (bf16)f2bf(in[2][e]); }
}
DI void colsum_finish(unsigned char* ws, int gt, int NGT) {
    for (int e = gt; e < 3 * NIN; e += NGT) { const int l = 1 + e / NIN, p = e % NIN; if (p >= 3360) continue; const float* cs = (const float*)(ws + WS_CSUM) + (size_t)l * 32 * NIN + p; float s1 = 0.f, s2 = 0.f;
#pragma unroll
        for (int kb = 0; kb < 16; ++kb) { s1 += cs[(size_t)(2 * kb) * NIN]; s2 += cs[(size_t)(2 * kb + 1) * NIN]; }
        ((float*)(ws + WS_C1IN))[l * NIN + p] = s1; ((float*)(ws + WS_C2IN))[l * NIN + p] = s2; }
    for (int e = gt; e < 4 * FFD; e += NGT) { const int l = e / FFD, p = e % FFD; const float* cs = (const float*)(ws + WS_CSUP) + (size_t)l * 32 * FFD + p; float s1 = 0.f, s2 = 0.f;
#pragma unroll
        for (int kb = 0; kb < 16; ++kb) { s1 += cs[(size_t)(2 * kb) * FFD]; s2 += cs[(size_t)(2 * kb + 1) * FFD]; }
        ((float*)(ws + WS_C1UP))[l * FFD + p] = s1; ((float*)(ws + WS_C2UP))[l * FFD + p] = s2; }
}
constexpr int VPITCH = 144;
constexpr int ATT_WLDS = 2 * 32 * VPITCH + 256;
DI void tr_read8(unsigned base, s16x4 (&t)[8]) {
    asm volatile("ds_read_b64_tr_b16 %0, %8\n\tds_read_b64_tr_b16 %1, %8 offset:%c9\n\tds_read_b64_tr_b16 %2, %8 offset:%c10\n\tds_read_b64_tr_b16 %3, %8 offset:%c11\n\t"
                 "ds_read_b64_tr_b16 %4, %8 offset:%c12\n\tds_read_b64_tr_b16 %5, %8 offset:%c13\n\tds_read_b64_tr_b16 %6, %8 offset:%c14\n\tds_read_b64_tr_b16 %7, %8 offset:%c15\n\ts_waitcnt lgkmcnt(0)"
                 : "=&v"(t[0]), "=&v"(t[1]), "=&v"(t[2]), "=&v"(t[3]), "=&v"(t[4]), "=&v"(t[5]), "=&v"(t[6]), "=&v"(t[7])
                 : "v"(base), "i"(8 * VPITCH), "i"(64), "i"(8 * VPITCH + 64), "i"(16 * VPITCH), "i"(24 * VPITCH), "i"(16 * VPITCH + 64), "i"(24 * VPITCH + 64) : "memory");
}
DI void attn_task(const bf16* QB, const bf16* KB, const bf16* VB, bf16* OP, float* LSE, int b, int h, int p, int cls, int qblk, LAS unsigned char* wl, int lane) {
    asm volatile("" : "+v"(lane));
    const int dd = 1 << (2 * p), r32 = lane & 31, hi = lane >> 5;
    const int m0 = 32 * qblk;
    const size_t rowb = (size_t)b * TSEQ;
    const size_t qrow = rowb + (size_t)(m0 + r32) * dd + cls;
    bf16x8 qf[4];
#pragma unroll
    for (int d0 = 0; d0 < 4; ++d0) qf[d0] = ld8(QB + qrow * 512 + h * 64 + d0 * 16 + hi * 8);
    f32x16 s[5];
    const int kt0 = (m0 >= 128) ? 0 : (128 - m0) / 32;
    bf16x8 kf[5][4];
#pragma unroll
    for (int kt = 0; kt < 5; ++kt) {
        const int mk = m0 - 128 + 32 * kt + r32;
        const size_t krow = rowb + (size_t)(mk < 0 ? 0 : mk) * dd + cls;
#pragma unroll
        for (int d0 = 0; d0 < 4; ++d0) kf[kt][d0] = ld8(KB + krow * 512 + h * 64 + d0 * 16 + hi * 8);
    }
#pragma unroll
    for (int kt = 0; kt < 5; ++kt) {
        f32x16 a; for (int i = 0; i < 16; ++i) a[i] = 0.f;
#pragma unroll
        for (int d0 = 0; d0 < 4; ++d0) a = mfma32(kf[kt][d0], qf[d0], a);
        s[kt] = a;
    }
#pragma unroll
    for (int kt = 0; kt < 5; ++kt) {
        if (kt < kt0) {
#pragma unroll
            for (int i = 0; i < 16; ++i) s[kt][i] = -INFINITY;
        } else if (kt == 0) {
#pragma unroll
            for (int i = 0; i < 16; ++i) s[kt][i] = (crow(i, hi) >= r32) ? s[kt][i] : -INFINITY;
        } else if (kt == 4) {
#pragma unroll
            for (int i = 0; i < 16; ++i) s[kt][i] = (crow(i, hi) <= r32) ? s[kt][i] : -INFINITY;
        }
    }
    float mx = -INFINITY;
#pragma unroll
    for (int kt = 0; kt < 5; ++kt)
#pragma unroll
        for (int i = 0; i < 16; ++i) mx = fmaxf(mx, s[kt][i]);
    mx = fmaxf(mx, __shfl_xor(mx, 32));
    float lsum = 0.f;
#pragma unroll
    for (int kt = 0; kt < 5; ++kt)
#pragma unroll
        for (int i = 0; i < 16; ++i) { const float e = __builtin_amdgcn_exp2f(s[kt][i] - mx); s[kt][i] = e; lsum += e; }
    lsum += __shfl_xor(lsum, 32);
    f32x16 o[2]; for (int i = 0; i < 16; ++i) { o[0][i] = 0.f; o[1][i] = 0.f; }
    LAS float* wsf = (LAS float*)(wl + 2 * 32 * VPITCH);
    const unsigned vb0 = (unsigned)(uintptr_t)wl;
    const int g = lane >> 4, i16 = lane & 15, qq = i16 >> 2, pp = i16 & 3;
    const unsigned traddr = (unsigned)((4 * (g >> 1) + qq) * VPITCH + (16 * (g & 1) + 4 * pp) * 2);
    const int vkey = lane >> 1, vhalf = lane & 1;
    v4u vr[4];
#define ATT_LOADV(KT) do { const int mk_ = m0 - 128 + 32 * (KT) + vkey; const size_t vrow_ = rowb + (size_t)mk_ * dd + cls; const v4u* src_ = (const v4u*)(VB + vrow_ * 512 + h * 64 + vhalf * 32); \
        vr[0] = src_[0]; vr[1] = src_[1]; vr[2] = src_[2]; vr[3] = src_[3]; } while (0)
    ATT_LOADV(kt0);
#pragma unroll
    for (int kt = 0; kt < 5; ++kt) {
        if (kt >= kt0) {
            LAS unsigned char* vb = wl + (kt & 1) * 32 * VPITCH;
            { LAS v4u* dst = (LAS v4u*)(vb + vkey * VPITCH + vhalf * 64); dst[0] = vr[0]; dst[1] = vr[1]; dst[2] = vr[2]; dst[3] = vr[3]; }
            if (kt + 1 < 5) ATT_LOADV(kt + 1);
            LDS_WAIT();
            const unsigned base = vb0 + (unsigned)((kt & 1) * 32 * VPITCH) + traddr;
            s16x4 t[8];
            tr_read8(base, t);
#pragma unroll
            for (int ss = 0; ss < 2; ++ss) {
                const bf16x8 pa = pk8(s[kt][8 * ss], s[kt][8 * ss + 1], s[kt][8 * ss + 2], s[kt][8 * ss + 3], s[kt][8 * ss + 4], s[kt][8 * ss + 5], s[kt][8 * ss + 6], s[kt][8 * ss + 7]);
#pragma unroll
                for (int db = 0; db < 2; ++db) { const bf16x8 vf = __builtin_shufflevector(t[4 * ss + 2 * db], t[4 * ss + 2 * db + 1], 0, 1, 2, 3, 4, 5, 6, 7); o[db] = mfma32(pa, vf, o[db]); }
            }
        }
    }
#undef ATT_LOADV
    if (hi == 0) { wsf[r32] = __builtin_amdgcn_rcpf(lsum); LSE[((size_t)p * M + qrow) * 8 + h] = mx + __builtin_amdgcn_logf(lsum); }
    LDS_WAIT();
#pragma unroll
    for (int i = 0; i < 16; ++i) { const int q = crow(i, hi); const float li = wsf[q]; const size_t orow = rowb + (size_t)(m0 + q) * dd + cls;
        bf16* op = OP + ((size_t)p * M + orow) * 512 + h * 64 + r32;
        op[0] = (bf16)pk2z(o[0][i] * li); op[32] = (bf16)pk2z(o[1][i] * li); }
    LDS_WAIT();
}
DI void attn_finalize_row(const bf16* OP, const float* LSE, const float* gain, bf16* MIX, int row, int lane) {
    asm volatile("" : "+v"(lane));
    const int h = lane >> 3;
    float l0 = LSE[((size_t)0 * M + row) * 8 + h], l1 = LSE[((size_t)1 * M + row) * 8 + h], l2 = LSE[((size_t)2 * M + row) * 8 + h];
    const float mx = fmaxf(l0, fmaxf(l1, l2));
    float w0 = __builtin_amdgcn_exp2f(l0 - mx), w1 = __builtin_amdgcn_exp2f(l1 - mx), w2 = __builtin_amdgcn_exp2f(l2 - mx);
    const float inv = __builtin_amdgcn_rcpf(w0 + w1 + w2); w0 *= inv; w1 *= inv; w2 *= inv;
    const v4u a = *(const v4u*)(OP + ((size_t)0 * M + row) * 512 + lane * 8), b = *(const v4u*)(OP + ((size_t)1 * M + row) * 512 + lane * 8), c = *(const v4u*)(OP + ((size_t)2 * M + row) * 512 + lane * 8);
    float v[8]; float ss = 0.f;
#pragma unroll
    for (int j = 0; j < 4; ++j) { v[2 * j] = w0 * bflo(a[j]) + w1 * bflo(b[j]) + w2 * bflo(c[j]); v[2 * j + 1] = w0 * bfhi(a[j]) + w1 * bfhi(b[j]) + w2 * bfhi(c[j]); ss += v[2 * j] * v[2 * j] + v[2 * j + 1] * v[2 * j + 1]; }
    ss = wave_sum(ss);
    const float rinv = 1.0f / sqrtf(ss * (1.f / 512.f) + RMS_EPS);
    const f32x4 g0 = *(const f32x4*)(gain + lane * 8), g1 = *(const f32x4*)(gain + lane * 8 + 4);
    v4u w; w.x = pk2(v[0] * rinv * g0[0], v[1] * rinv * g0[1]); w.y = pk2(v[2] * rinv * g0[2], v[3] * rinv * g0[3]); w.z = pk2(v[4] * rinv * g1[0], v[5] * rinv * g1[1]); w.w = pk2(v[6] * rinv * g1[2], v[7] * rinv * g1[3]);
    *(v4u*)(MIX + (size_t)row * 1024 + lane * 8) = w;
}
constexpr int B1_IMG = 2048, B1_WLDS = 5 * B1_IMG + 1024;
DI float dpp_shr(float x, int n) { int v;
    switch (n) { case 1: v = __builtin_amdgcn_update_dpp(0, __builtin_bit_cast(int, x), 0x111, 0xf, 0xf, true); break; case 2: v = __builtin_amdgcn_update_dpp(0, __builtin_bit_cast(int, x), 0x112, 0xf, 0xf, true); break;
                 case 4: v = __builtin_amdgcn_update_dpp(0, __builtin_bit_cast(int, x), 0x114, 0xf, 0xf, true); break; default: v = __builtin_amdgcn_update_dpp(0, __builtin_bit_cast(int, x), 0x118, 0xf, 0xf, true); break; }
    return __builtin_bit_cast(float, v); }
DI float dpp_shr1(float x, int n) { int v; const int one = 0x3f800000;
    switch (n) { case 1: v = __builtin_amdgcn_update_dpp(one, __builtin_bit_cast(int, x), 0x111, 0xf, 0xf, false); break; case 2: v = __builtin_amdgcn_update_dpp(one, __builtin_bit_cast(int, x), 0x112, 0xf, 0xf, false); break;
                 case 4: v = __builtin_amdgcn_update_dpp(one, __builtin_bit_cast(int, x), 0x114, 0xf, 0xf, false); break; default: v = __builtin_amdgcn_update_dpp(one, __builtin_bit_cast(int, x), 0x118, 0xf, 0xf, false); break; }
    return __builtin_bit_cast(float, v); }
struct RwkvP {
    const bf16* PR; const float* mu; const float* muv;
    const float *dbase, *ibase, *vbase, *ksk, *ksa, *brk, *gng, *gnb;
    const bf16 *dupT, *iupT, *vupT, *gupT;
    const bf16* ZROW; bf16 *VF, *VV; float* BON; float* GC; bf16 *W1S, *REFF, *BM; v4u* REC; float* YPRE; bf16* MIX; int layer0;
};
DI const f32x4* vec4p(const float*) { return nullptr; }
DI const LAS f32x4* vec4p(const LAS float*) { return nullptr; }
template <class MP> DI void lerp8(const bf16* crow_, const bf16* prow_, int col, MP mu, float (&z)[8]) {
    const v4u cur = *(const v4u*)(crow_ + col); const v4u prv = *(const v4u*)(prow_ + col);
    const f32x4 m0 = *(decltype(vec4p(mu)))(mu), m1 = *(decltype(vec4p(mu)))(mu + 4);
#pragma unroll
    for (int j = 0; j < 4; ++j) { const float a = bflo(cur[j]), b = bfhi(cur[j]), pa = bflo(prv[j]), pb = bfhi(prv[j]); const float ma = j < 2 ? m0[2 * j] : m1[2 * j - 4], mb = j < 2 ? m0[2 * j + 1] : m1[2 * j - 3];
        z[2 * j] = a + (pa - a) * ma; z[2 * j + 1] = b + (pb - b) * mb; }
}
template <class MP> DI f32x4 lerp4(const bf16* crow_, const bf16* prow_, int col, MP mu) {
    const v2u cur = *(const v2u*)(crow_ + col); const v2u prv = *(const v2u*)(prow_ + col);
    const f32x4 m = *(decltype(vec4p(mu)))(mu);
    f32x4 z; z[0] = bflo(cur.x) + (bflo(prv.x) - bflo(cur.x)) * m[0]; z[1] = bfhi(cur.x) + (bfhi(prv.x) - bfhi(cur.x)) * m[1];
    z[2] = bflo(cur.y) + (bflo(prv.y) - bflo(cur.y)) * m[2]; z[3] = bfhi(cur.y) + (bfhi(prv.y) - bfhi(cur.y)) * m[3]; return z;
}
DI void img_write(LAS unsigned char* img, const f32x4 (&x)[4], int fr, int fq) {
#pragma unroll
    for (int mb = 0; mb < 4; ++mb)
#pragma unroll
        for (int reg = 0; reg < 4; ++reg) *(LAS bf16*)(img + (16 * mb + 4 * fq + reg) * 32 + fr * 2) = (bf16)pk2z(x[mb][reg]);
}
DI bf16x8 lds4z(const LAS unsigned char* p) { const v2u t = *(const LAS v2u*)p; v4u w; w.x = t.x; w.y = t.y; w.z = 0u; w.w = 0u; return __builtin_bit_cast(bf16x8, w); }
constexpr int HC_DUP = 0, HC_IUP = 9216, HC_VUP = 18432, HC_F = 23552, HC_BYTES = 23552 + 736 * 4;
enum { HF_MUR = 0, HF_MUK = 64, HF_MUV = 128, HF_MUW = 192, HF_MUA = 256, HF_MUVR = 320, HF_DB = 352, HF_IB = 416, HF_VB = 480, HF_SK = 544, HF_SA = 608, HF_BR = 672 };
DI void head_cache_fill(const RwkvP& P, int h, LAS unsigned char* hc, int tid) {
    { const int row = tid >> 3, ch = tid & 7;
      *(LAS v4u*)(hc + HC_DUP + row * 144 + ch * 16) = *(const v4u*)(P.dupT + (size_t)(h * 64 + row) * 64 + ch * 8);
      *(LAS v4u*)(hc + HC_IUP + row * 144 + ch * 16) = *(const v4u*)(P.iupT + (size_t)(h * 64 + row) * 64 + ch * 8); }
    if (tid < 256 && !P.layer0) { const int row = tid >> 2, ch = tid & 3; *(LAS v4u*)(hc + HC_VUP + row * 80 + ch * 16) = *(const v4u*)(P.vupT + (size_t)(h * 64 + row) * 32 + ch * 8); }
    LAS float* f = (LAS float*)(hc + HC_F);
    if (tid < 64) { const int c = h * 64 + tid; f[HF_MUR + tid] = P.mu[c]; f[HF_MUK + tid] = P.mu[512 + c]; f[HF_MUV + tid] = P.mu[1024 + c]; f[HF_MUW + tid] = P.mu[1536 + tid]; f[HF_MUA + tid] = P.mu[1600 + tid];
        f[HF_DB + tid] = P.dbase[c]; f[HF_IB + tid] = P.ibase[c]; f[HF_VB + tid] = P.layer0 ? 0.f : P.vbase[c]; f[HF_SK + tid] = P.ksk[c]; f[HF_SA + tid] = P.ksa[c]; f[HF_BR + tid] = P.brk[c];
        if (tid < 32) f[HF_MUVR + tid] = P.layer0 ? 0.f : P.muv[tid]; }
}
DI void rwkv_b1_unit(const RwkvP& P, int unit, LAS unsigned char* wl, const LAS unsigned char* hc, int lane) {
    asm volatile("" : "+v"(lane));
    const int fr = lane & 15, fq = lane >> 4;
    const int seq = unit >> 9, c = unit & 511, b = seq >> 3, h = seq & 7;
    const size_t row = (size_t)b * TSEQ + 16 * c + fr;
    const bool hasprev = (c | fr) != 0;
    const bf16* crp = P.PR + row * PRP; const bf16* prp = hasprev ? crp - PRP : P.ZROW;
    const f32x4 z4 = {0.f, 0.f, 0.f, 0.f};
    const LAS float* hf = (const LAS float*)(hc + HC_F);
    bf16x8 tw[2], al[2], vl;
#pragma unroll
    for (int ks = 0; ks < 2; ++ks) { float z[8]; lerp8(crp, prp, 1536 + 8 * fq + 32 * ks, hf + HF_MUW + 8 * fq + 32 * ks, z);
        tw[ks] = pk8(ftanh(z[0]), ftanh(z[1]), ftanh(z[2]), ftanh(z[3]), ftanh(z[4]), ftanh(z[5]), ftanh(z[6]), ftanh(z[7]));
        lerp8(crp, prp, 1600 + 8 * fq + 32 * ks, hf + HF_MUA + 8 * fq + 32 * ks, z); al[ks] = pk8(z[0], z[1], z[2], z[3], z[4], z[5], z[6], z[7]); }
    if (!P.layer0) { float z[8]; lerp8(crp, prp, 1792 + 8 * fq, hf + HF_MUVR + 8 * fq, z); vl = pk8(z[0], z[1], z[2], z[3], z[4], z[5], z[6], z[7]); }
    f32x4 zr[4], k2[4], kk[4], ai[4], ld[4];
    float nrm = 0.f, bon = 0.f;
#pragma unroll
    for (int mb = 0; mb < 4; ++mb) { const int ch = h * 64 + 16 * mb + 4 * fq; const int n = h * 64 + 16 * mb + fr;
        f32x4 dw = z4, da = z4, dv = z4;
        dw = mfma16(*(const LAS bf16x8*)(hc + HC_DUP + (16 * mb + fr) * 144 + 16 * fq), tw[0], dw); dw = mfma16(*(const LAS bf16x8*)(hc + HC_DUP + (16 * mb + fr) * 144 + 16 * fq + 64), tw[1], dw);
        da = mfma16(*(const LAS bf16x8*)(hc + HC_IUP + (16 * mb + fr) * 144 + 16 * fq), al[0], da); da = mfma16(*(const LAS bf16x8*)(hc + HC_IUP + (16 * mb + fr) * 144 + 16 * fq + 64), al[1], da);
        if (!P.layer0) dv = mfma16(*(const LAS bf16x8*)(hc + HC_VUP + (16 * mb + fr) * 80 + 16 * fq), vl, z4);
        const int cl = 16 * mb + 4 * fq;
        zr[mb] = lerp4(crp, prp, ch, hf + HF_MUR + cl);
        const f32x4 zk = lerp4(crp, prp, 512 + ch, hf + HF_MUK + cl);
        f32x4 zv = lerp4(crp, prp, 1024 + ch, hf + HF_MUV + cl);
        const f32x4 db = *(const LAS f32x4*)(hf + HF_DB + cl), ib = *(const LAS f32x4*)(hf + HF_IB + cl), sk = *(const LAS f32x4*)(hf + HF_SK + cl), sa = *(const LAS f32x4*)(hf + HF_SA + cl), br = *(const LAS f32x4*)(hf + HF_BR + cl);
        if (P.layer0) { v2u w; w.x = pk2(zv[0], zv[1]); w.y = pk2(zv[2], zv[3]); *(v2u*)(P.VF + row * 512 + ch) = w; }
        else { const v2u f = *(const v2u*)(P.VF + row * 512 + ch); const f32x4 vb = *(const LAS f32x4*)(hf + HF_VB + cl); const f32x4 vf = {bflo(f.x), bfhi(f.x), bflo(f.y), bfhi(f.y)};
#pragma unroll
            for (int e = 0; e < 4; ++e) zv[e] = zv[e] + (vf[e] - zv[e]) * fsigmoid(vb[e] + dv[e]); }
        { v2u w; w.x = pk2(zv[0], zv[1]); w.y = pk2(zv[2], zv[3]); *(v2u*)(P.VV + row * 512 + ch) = w; }
#pragma unroll
        for (int reg = 0; reg < 4; ++reg) *(LAS bf16*)(wl + 2 * B1_IMG + (16 * mb + 4 * fq + reg) * 32 + fr * 2) = (bf16)pk2z(zv[reg]);
#pragma unroll
        for (int e = 0; e < 4; ++e) {
            ld[mb][e] = fexp(-0.60653065971f * fsigmoid(db[e] + dw[e]));
            const float a = fsigmoid(ib[e] + da[e]); ai[mb][e] = a;
            const float kr = zk[e] * sk[e]; kk[mb][e] = kr; nrm += kr * kr;
            const float kx = zk[e] * (1.f + (a - 1.f) * sa[e]); k2[mb][e] = kx; bon += zr[mb][e] * kx * br[e]; }
        asm volatile("" ::: "memory");
    }
    nrm += __shfl_xor(nrm, 16); nrm += __shfl_xor(nrm, 32); bon += __shfl_xor(bon, 16); bon += __shfl_xor(bon, 32);
    if (fq == 0) P.BON[row * 8 + h] = bon;
    const float kinv = 1.0f / fmaxf(sqrtf(nrm), 1e-12f);
    f32x4 rt[4], kh[4];
    bf16x8 pa[2], pb[2], pk[2], pr[2];
#pragma unroll
    for (int ks = 0; ks < 2; ++ks) {
        f32x4 at2[2], bt2[2], kt2[2];
#pragma unroll
        for (int m2 = 0; m2 < 2; ++m2) { const int mb = 2 * ks + m2;
            f32x4 gcv, bhv;
#pragma unroll
            for (int e = 0; e < 4; ++e) {
                float gm = ld[mb][e]; gm *= dpp_shr1(gm, 1); gm *= dpp_shr1(gm, 2); gm *= dpp_shr1(gm, 4); gm *= dpp_shr1(gm, 8);
                const float gc = __shfl(gm, lane | 15), gp = dpp_shr1(gm, 1), gi = __builtin_amdgcn_rcpf(gm), ec = gc * gi;
                const float kn = kk[mb][e] * kinv, bb = kn * ai[mb][e];
                at2[m2][e] = -kn * gp; bt2[m2][e] = bb * gi; kt2[m2][e] = k2[mb][e] * gi; rt[mb][e] = zr[mb][e] * gm;
                bhv[e] = bb * ec; kh[mb][e] = k2[mb][e] * ec; gcv[e] = gc; }
            if (fr == 0) *(f32x4*)(P.GC + (size_t)unit * 64 + 16 * mb + 4 * fq) = gcv;
#pragma unroll
            for (int reg = 0; reg < 4; ++reg) { const int o = (16 * mb + 4 * fq + reg) * 32 + fr * 2;
                *(LAS bf16*)(wl + 0 * B1_IMG + o) = (bf16)pk2z(at2[m2][reg]); *(LAS bf16*)(wl + 1 * B1_IMG + o) = (bf16)pk2z(bhv[reg]); }
        }
        pa[ks] = pk8v(at2[0], at2[1]); pb[ks] = pk8v(bt2[0], bt2[1]); pk[ks] = pk8v(kt2[0], kt2[1]); pr[ks] = pk8v(rt[2 * ks], rt[2 * ks + 1]);
    }
    const f32x4 z4b = {0.f, 0.f, 0.f, 0.f};
    f32x4 Aab = mfma16(pb[1], pa[1], mfma16(pb[0], pa[0], z4b));
    f32x4 AakT = mfma16(pa[1], pk[1], mfma16(pa[0], pk[0], z4b));
    f32x4 Arb = mfma16(pb[1], pr[1], mfma16(pb[0], pr[0], z4b));
    f32x4 Ark = mfma16(pk[1], pr[1], mfma16(pk[0], pr[0], z4b));
#pragma unroll
    for (int e = 0; e < 4; ++e) { const int rr = 4 * fq + e; Aab[e] = rr < fr ? Aab[e] : 0.f; AakT[e] = fr < rr ? AakT[e] : 0.f; Arb[e] = rr <= fr ? Arb[e] : 0.f; Ark[e] = rr <= fr ? Ark[e] : 0.f; }
    LAS float* As = (LAS float*)(wl + 5 * B1_IMG);
#pragma unroll
    for (int e = 0; e < 4; ++e) As[(4 * fq + e) * 16 + fr] = Aab[e];
    LDS_WAIT();
    float x[16];
#pragma unroll
    for (int s = 15; s >= 0; --s) { float acc = (s == fr) ? 1.f : 0.f;
        const f32x4 r0 = *(const LAS f32x4*)(As + s * 16), r1 = *(const LAS f32x4*)(As + s * 16 + 4), r2 = *(const LAS f32x4*)(As + s * 16 + 8), r3 = *(const LAS f32x4*)(As + s * 16 + 12);
        const float rowv[16] = {r0[0], r0[1], r0[2], r0[3], r1[0], r1[1], r1[2], r1[3], r2[0], r2[1], r2[2], r2[3], r3[0], r3[1], r3[2], r3[3]};
#pragma unroll
        for (int uu = s + 1; uu < 16; ++uu) acc += rowv[uu] * x[uu];
        x[s] = acc; if ((s & 1) == 0) asm volatile("" ::: "memory"); }
    f32x4 xs;
#pragma unroll
    for (int e = 0; e < 4; ++e) xs[e] = fq == 0 ? x[e] : fq == 1 ? x[4 + e] : fq == 2 ? x[8 + e] : x[12 + e];
    const bf16x8 Tsel = pk4z(xs);
    f32x4 W1[4];
#pragma unroll
    for (int mb = 0; mb < 4; ++mb) W1[mb] = mfma16(lds4z(wl + 0 * B1_IMG + (16 * mb + fr) * 32 + 8 * fq), Tsel, z4);
    const f32x4 GT = mfma16(Tsel, pk4z(AakT), z4);
    img_write(wl + 3 * B1_IMG, W1, fr, fq);
    f32x4 M1T[4];
    const bf16x8 GTp = pk4z(GT);
#pragma unroll
    for (int mb = 0; mb < 4; ++mb) M1T[mb] = mfma16(lds4z(wl + 1 * B1_IMG + (16 * mb + fr) * 32 + 8 * fq), GTp, kh[mb]);
    img_write(wl + 4 * B1_IMG, M1T, fr, fq);
    LDS_WAIT();
    const bf16x8 Arbp = pk4z(Arb);
    f32x4 RE[4];
#pragma unroll
    for (int mb = 0; mb < 4; ++mb) RE[mb] = mfma16(lds4z(wl + 3 * B1_IMG + (16 * mb + fr) * 32 + 8 * fq), Arbp, rt[mb]);
    const f32x4 M2 = mfma16(GTp, Arbp, Ark);
    {   bf16* w1s = P.W1S + ((size_t)unit * 16 + fr) * 64; bf16* re = P.REFF + ((size_t)unit * 16 + fr) * 64;
#pragma unroll
        for (int mb = 0; mb < 4; ++mb) { const int sg = (mb >> 1) * 32 + fq * 8 + (mb & 1) * 4;
            v2u w; w.x = pk2(W1[mb][0], W1[mb][1]); w.y = pk2(W1[mb][2], W1[mb][3]); *(v2u*)(w1s + sg) = w;
            w.x = pk2(RE[mb][0], RE[mb][1]); w.y = pk2(RE[mb][2], RE[mb][3]); *(v2u*)(re + sg) = w; }
        const v2u m2p = {pk2(M2[0], M2[1]), pk2(M2[2], M2[3])};
#pragma unroll
        for (int mb = 0; mb < 4; ++mb) {
            const v2u bq = *(const LAS v2u*)(wl + 1 * B1_IMG + (16 * mb + fr) * 32 + 8 * fq), mq = *(const LAS v2u*)(wl + 4 * B1_IMG + (16 * mb + fr) * 32 + 8 * fq);
            *(v4u*)(P.BM + (((size_t)unit * 64 + 16 * mb + fr) * 4 + fq) * 8) = (v4u){bq.x, bq.y, mq.x, mq.y};
            const v2u vq = *(const LAS v2u*)(wl + 2 * B1_IMG + (16 * mb + fr) * 32 + 8 * fq);
            P.REC[((size_t)unit * 4 + mb) * 64 + lane] = (v4u){vq.x, vq.y, m2p.x, m2p.y}; }
    }
    LDS_WAIT();
}
constexpr int NSEG = 16, SEGCH = NCH / NSEG;
struct ChainIn { bf16x8 w1[2], re[2], bm[4]; v4u rec; f32x4 gc[4]; };
template <int MODE> DI void chain_load(ChainIn& c, const RwkvP& P, int unit, int rb, int lane) {
    const int fr = lane & 15, fq = lane >> 4;
    const bf16* w1s = P.W1S + ((size_t)unit * 16 + fr) * 64 + fq * 8;
    c.w1[0] = ld8(w1s); c.w1[1] = ld8(w1s + 32);
    if (MODE == 2) { const bf16* re = P.REFF + ((size_t)unit * 16 + fr) * 64 + fq * 8; c.re[0] = ld8(re); c.re[1] = ld8(re + 32); }
#pragma unroll
    for (int mb = 0; mb < 4; ++mb) { c.bm[mb] = ld8(P.BM + (((size_t)unit * 64 + 16 * mb + fr) * 4 + fq) * 8); c.gc[mb] = *(const f32x4*)(P.GC + (size_t)unit * 64 + 16 * mb + 4 * fq); }
    if (MODE != 1) c.rec = P.REC[((size_t)unit * 4 + rb) * 64 + lane];
}
template <int MODE> DI void chain_step(f32x4 (&S)[4], const ChainIn& c, float* ypre  ) {
    const f32x4 z4 = {0.f, 0.f, 0.f, 0.f};
    const bf16x8 b0 = pk8v(S[0], S[1]), b1 = pk8v(S[2], S[3]);
    f32x4 ut = mfma16(c.w1[1], b1, mfma16(c.w1[0], b0, z4));
    if (MODE == 2) {
        v4u vlo; vlo.x = c.rec.x; vlo.y = c.rec.y; vlo.z = 0u; vlo.w = 0u;
        v4u m2a; m2a.x = c.rec.z; m2a.y = c.rec.w; m2a.z = 0u; m2a.w = 0u;
        f32x4 y = mfma16(__builtin_bit_cast(bf16x8, m2a), __builtin_bit_cast(bf16x8, vlo), z4);
        y = mfma16(c.re[0], b0, y); y = mfma16(c.re[1], b1, y);
#pragma unroll
        for (int e = 0; e < 4; ++e) ypre[(size_t)e * 512] = y[e];
    }
    v4u uv; uv.x = pk2(ut[0], ut[1]); uv.y = pk2(ut[2], ut[3]); uv.z = MODE == 1 ? 0u : c.rec.x; uv.w = MODE == 1 ? 0u : c.rec.y;
    const bf16x8 ub = __builtin_bit_cast(bf16x8, uv);
#pragma unroll
    for (int mb = 0; mb < 4; ++mb) S[mb] = mfma16(c.bm[mb], ub, S[mb] * c.gc[mb]);
}
template <int MODE> DI void chain_run(f32x4 (&S)[4], const RwkvP& P, int unit0, int nsteps  , int rb, float* yp, int lane) {
    ChainIn c0, c1, c2;
    chain_load<MODE>(c0, P, unit0, rb, lane); chain_load<MODE>(c1, P, unit0 + 1, rb, lane);
    int c = 0;
    for (; c + 3 <= nsteps; c += 3) {
        chain_load<MODE>(c2, P, unit0 + c + 2, rb, lane);
        chain_step<MODE>(S, c0, yp + (size_t)c * 16 * 512);
        if (c + 3 < nsteps) chain_load<MODE>(c0, P, unit0 + c + 3, rb, lane);
        chain_step<MODE>(S, c1, yp + (size_t)(c + 1) * 16 * 512);
        if (c + 4 < nsteps) chain_load<MODE>(c1, P, unit0 + c + 4, rb, lane);
        chain_step<MODE>(S, c2, yp + (size_t)(c + 2) * 16 * 512);
    }
    if (c < nsteps) { chain_step<MODE>(S, c0, yp + (size_t)c * 16 * 512); ++c; }
    if (c < nsteps) { chain_step<MODE>(S, c1, yp + (size_t)c * 16 * 512); ++c; }
}
DI void chain_step_dual(f32x4 (&SQ)[4], f32x4 (&SP)[4], const ChainIn& c) {
    const f32x4 z4 = {0.f, 0.f, 0.f, 0.f};
    const bf16x8 q0 = pk8v(SQ[0], SQ[1]), q1 = pk8v(SQ[2], SQ[3]), p0 = pk8v(SP[0], SP[1]), p1 = pk8v(SP[2], SP[3]);
    const f32x4 utq = mfma16(c.w1[1], q1, mfma16(c.w1[0], q0, z4)), utp = mfma16(c.w1[1], p1, mfma16(c.w1[0], p0, z4));
    v4u uq; uq.x = pk2(utq[0], utq[1]); uq.y = pk2(utq[2], utq[3]); uq.z = c.rec.x; uq.w = c.rec.y;
    v4u up; up.x = pk2(utp[0], utp[1]); up.y = pk2(utp[2], utp[3]); up.z = 0u; up.w = 0u;
    const bf16x8 ubq = __builtin_bit_cast(bf16x8, uq), ubp = __builtin_bit_cast(bf16x8, up);
#pragma unroll
    for (int mb = 0; mb < 4; ++mb) { SQ[mb] = mfma16(c.bm[mb], ubq, SQ[mb] * c.gc[mb]); SP[mb] = mfma16(c.bm[mb], ubp, SP[mb] * c.gc[mb]); }
}
DI void chain_pass1(const RwkvP& P, float* QSEG, float* PSEGT, int seq, int g, int rb, int lane) {
    const int fr = lane & 15, fq = lane >> 4;
    f32x4 SQ[4], SP[4];
#pragma unroll
    for (int mb = 0; mb < 4; ++mb)
#pragma unroll
        for (int e = 0; e < 4; ++e) { SQ[mb][e] = 0.f; SP[mb][e] = ((16 * mb + 4 * fq + e) == (16 * rb + fr)) ? 1.f : 0.f; }
    const int unit0 = seq * NCH + g * SEGCH;
    {   ChainIn c0, c1, c2;
        chain_load<0>(c0, P, unit0, rb, lane); chain_load<0>(c1, P, unit0 + 1, rb, lane);
        int c = 0;
        for (; c + 3 <= SEGCH; c += 3) {
            chain_load<0>(c2, P, unit0 + c + 2, rb, lane);
            chain_step_dual(SQ, SP, c0);
            if (c + 3 < SEGCH) chain_load<0>(c0, P, unit0 + c + 3, rb, lane);
            chain_step_dual(SQ, SP, c1);
            if (c + 4 < SEGCH) chain_load<0>(c1, P, unit0 + c + 4, rb, lane);
            chain_step_dual(SQ, SP, c2);
        }
        if (c < SEGCH) { chain_step_dual(SQ, SP, c0); ++c; }
        if (c < SEGCH) { chain_step_dual(SQ, SP, c1); ++c; }
    }
    const size_t sb = ((size_t)seq * NSEG + g) * 4096;
#pragma unroll
    for (int mb = 0; mb < 4; ++mb) *(f32x4*)(QSEG + sb + (size_t)(16 * rb + fr) * 64 + 16 * mb + 4 * fq) = SQ[mb];
#pragma unroll
    for (int mb = 0; mb < 4; ++mb)
#pragma unroll
        for (int e = 0; e < 4; ++e) PSEGT[sb + (size_t)(16 * mb + 4 * fq + e) * 64 + 16 * rb + fr] = SP[mb][e];
}
DI void split_hl(const f32x4 a, const f32x4 b, bf16x8& hi, bf16x8& lo) {
    f32x4 ah, bh;
#pragma unroll
    for (int e = 0; e < 4; ++e) { ah[e] = rbf(a[e]); bh[e] = rbf(b[e]); }
    hi = pk8v(ah, bh); lo = pk8v(a - ah, b - bh);
}
DI void chain_pass23(const RwkvP& P, const float* QSEG, const float* PSEGT, int seq, int g, int rb, float* wkv_out, int lane) {
    const int fr = lane & 15, fq = lane >> 4, b = seq >> 3, h = seq & 7;
    f32x4 S[4]; for (int mb = 0; mb < 4; ++mb) S[mb] = (f32x4){0.f, 0.f, 0.f, 0.f};
    f32x4 pc[4][2][2], pn[4][2][2];
#define P2_LOAD(PD_, GP_) do { const size_t sb_ = ((size_t)seq * NSEG + (GP_)) * 4096; _Pragma("unroll") for (int mb = 0; mb < 4; ++mb) { \
        _Pragma("unroll") for (int ks = 0; ks < 2; ++ks) { const float* pr_ = PSEGT + sb_ + (size_t)(16 * mb + fr) * 64 + 32 * ks + 4 * fq; PD_[mb][ks][0] = *(const f32x4*)pr_; PD_[mb][ks][1] = *(const f32x4*)(pr_ + 16); } } } while (0)
    if (g > 0) P2_LOAD(pc, 0);
    for (int gp = 0; gp < g; ++gp) {
        f32x4 qc[4];
        { const size_t sb_ = ((size_t)seq * NSEG + gp) * 4096;
#pragma unroll
          for (int mb = 0; mb < 4; ++mb) qc[mb] = *(const f32x4*)(QSEG + sb_ + (size_t)(16 * rb + fr) * 64 + 16 * mb + 4 * fq); }
        if (gp + 1 < g) P2_LOAD(pn, gp + 1);
        bf16x8 bh[2], bl[2]; split_hl(S[0], S[1], bh[0], bl[0]); split_hl(S[2], S[3], bh[1], bl[1]);
#pragma unroll
        for (int mb = 0; mb < 4; ++mb) { f32x4 acc = {0.f, 0.f, 0.f, 0.f};
#pragma unroll
            for (int ks = 0; ks < 2; ++ks) { bf16x8 ah, al; split_hl(pc[mb][ks][0], pc[mb][ks][1], ah, al);
                acc = mfma16(ah, bh[ks], acc); acc = mfma16(al, bh[ks], acc); acc = mfma16(ah, bl[ks], acc); }
            S[mb] = acc + qc[mb]; }
#pragma unroll
        for (int mb = 0; mb < 4; ++mb) {
#pragma unroll
            for (int ks = 0; ks < 2; ++ks) { pc[mb][ks][0] = pn[mb][ks][0]; pc[mb][ks][1] = pn[mb][ks][1]; } }
    }
#undef P2_LOAD
    float* yp = P.YPRE + ((size_t)b * TSEQ + (size_t)g * SEGCH * 16 + 4 * fq) * 512 + h * 64 + 16 * rb + fr;
    chain_run<2>(S, P, seq * NCH + g * SEGCH, SEGCH, rb, yp, lane);
    if (g == NSEG - 1) {
#pragma unroll
        for (int mb = 0; mb < 4; ++mb) *(f32x4*)(wkv_out + (size_t)(16 * rb + fr) * 64 + 16 * mb + 4 * fq) = S[mb];
    }
}
constexpr int GC_GUP = 0, GC_F = 64 * 272, GC_BYTES = 64 * 272 + 256 * 4;
DI void gate_cache_fill(const RwkvP& P, int h, LAS unsigned char* gc, int tid) {
#pragma unroll
    for (int q = 0; q < 2; ++q) { const int idx = tid + 512 * q, row = idx >> 4, ch = idx & 15;
        *(LAS v4u*)(gc + GC_GUP + row * 272 + ch * 16) = *(const v4u*)(P.gupT + (size_t)(h * 64 + row) * 128 + ch * 8); }
    LAS float* f = (LAS float*)(gc + GC_F);
    if (tid < 64) { f[tid] = P.gng[h * 64 + tid]; f[64 + tid] = P.gnb[h * 64 + tid]; }
    if (tid >= 64 && tid < 192) f[128 + tid - 64] = P.mu[1664 + tid - 64];
}
DI void rwkv_b3_unit(const RwkvP& P, int unit, const LAS unsigned char* gc, int lane) {
    asm volatile("" : "+v"(lane));
    const int fr = lane & 15, fq = lane >> 4;
    const int seq = unit >> 9, c = unit & 511, b = seq >> 3, h = seq & 7;
    const size_t row = (size_t)b * TSEQ + 16 * c + fr;
    const bool hasprev = (c | fr) != 0;
    const bf16* crp = P.PR + row * PRP; const bf16* prp = hasprev ? crp - PRP : P.ZROW;
    const f32x4 z4 = {0.f, 0.f, 0.f, 0.f};
    const LAS float* gf = (const LAS float*)(gc + GC_F);
    bf16x8 sg[4];
#pragma unroll
    for (int ks = 0; ks < 4; ++ks) { float z[8]; lerp8(crp, prp, 1664 + 8 * fq + 32 * ks, gf + 128 + 8 * fq + 32 * ks, z);
        sg[ks] = pk8(fsigmoid(z[0]), fsigmoid(z[1]), fsigmoid(z[2]), fsigmoid(z[3]), fsigmoid(z[4]), fsigmoid(z[5]), fsigmoid(z[6]), fsigmoid(z[7])); }
    f32x4 g[4], y[4]; float s = 0.f;
#pragma unroll
    for (int mb = 0; mb < 4; ++mb) { f32x4 a = z4;
#pragma unroll
        for (int ks = 0; ks < 4; ++ks) a = mfma16(*(const LAS bf16x8*)(gc + GC_GUP + (16 * mb + fr) * 272 + 16 * fq + 64 * ks), sg[ks], a);
        g[mb] = a;
        y[mb] = *(const f32x4*)(P.YPRE + row * 512 + h * 64 + 16 * mb + 4 * fq); s += (y[mb][0] + y[mb][1]) + (y[mb][2] + y[mb][3]); }
    s += __shfl_xor(s, 16); s += __shfl_xor(s, 32);
    const float mean = s * (1.f / 64.f); float q = 0.f;
#pragma unroll
    for (int mb = 0; mb < 4; ++mb) { y[mb] = y[mb] - mean; q += (y[mb][0] * y[mb][0] + y[mb][1] * y[mb][1]) + (y[mb][2] * y[mb][2] + y[mb][3] * y[mb][3]); }
    q += __shfl_xor(q, 16); q += __shfl_xor(q, 32);
    const float rstd = 1.0f / sqrtf(q * (1.f / 64.f) + GN_EPS);
    const float bon = P.BON[row * 8 + h];
#pragma unroll
    for (int mb = 0; mb < 4; ++mb) { const int cl = 16 * mb + 4 * fq, ch = h * 64 + cl;
        const f32x4 gg = *(const LAS f32x4*)(gf + cl), gb = *(const LAS f32x4*)(gf + 64 + cl); const v2u vw = *(const v2u*)(P.VV + row * 512 + ch);
        const f32x4 v = {bflo(vw.x), bfhi(vw.x), bflo(vw.y), bfhi(vw.y)};
        const f32x4 o = (y[mb] * rstd * gg + gb + v * bon) * g[mb];
        v2u w; w.x = pk2(o[0], o[1]); w.y = pk2(o[2], o[3]); *(v2u*)(P.MIX + row * 1024 + 512 + ch) = w; }
}
DI f32x16 dec_gemm(const bf16* A, const bf16* Wt, int K, LAS float* red  , int wave, int lane) {
    const int r = lane & 31, h = lane >> 5, kw = K >> 3;
    const bf16* ap = A + (size_t)r * K + wave * kw + 8 * h; const bf16* bp = Wt + (size_t)r * K + wave * kw + 8 * h;
    f32x16 acc; for (int i = 0; i < 16; ++i) acc[i] = 0.f;
#pragma unroll 16
    for (int k = 0; k < kw; k += 16) acc = mfma32(ld8(ap + k), ld8(bp + k), acc);
    __syncthreads();
#pragma unroll
    for (int i = 0; i < 16; ++i) red[(wave * 16 + i) * 64 + lane] = acc[i];
    __syncthreads();
    if (wave == 0) {
#pragma unroll
        for (int i = 0; i < 16; ++i) { float s = 0.f;
#pragma unroll
            for (int w = 0; w < 8; ++w) s += red[(w * 16 + i) * 64 + lane];
            asm volatile("" : "+v"(s) :: "memory"); acc[i] = s; } }
    return acc;
}
DI void dec_row_stats(const float* st, LAS float* sc, int lane) {
    if (lane < 32) { float s = 0.f, q = 0.f; const f32x4* p = (const f32x4*)(st + (size_t)lane * 64);
#pragma unroll
        for (int i = 0; i < 16; ++i) { const f32x4 v = p[i]; s += v[0] + v[2]; q += v[1] + v[3]; if ((i & 3) == 3) asm volatile("" : "+v"(s), "+v"(q) :: "memory"); }
        const float mu = s * (1.f / 1024.f), var = fmaxf(q * (1.f / 1024.f) - mu * mu, 0.f); sc[2 * lane] = mu; sc[2 * lane + 1] = 1.0f / sqrtf(var + LN_EPS); }
    LDS_WAIT();
}
struct DecP {
    unsigned char* dec; int l;
    const float* xs;
    const float *c1in, *c2in, *c1up, *c2up, *g1, *b1, *g2p, *b2p;
    const bf16 *win, *winu, *wout, *wup, *wdn;
    float* out;
};
DI void dec_unit_in(const DecP& D, int u, LAS float* red, LAS float* sc, int wave, int lane) {
    const int r32 = lane & 31, hi = lane >> 5;
    if (u < 105) {
        const int n = 32 * u + r32; const bool fold = D.l > 0;
        const f32x16 acc = dec_gemm((const bf16*)(D.dec + DEC_XB2), D.win + (size_t)(32 * u) * DM, DM, red, wave, lane);
        if (wave != 0) return;
        if (fold) dec_row_stats((const float*)(D.dec + DEC_ST2), sc, lane);
        const float c1 = fold ? D.c1in[n] : 0.f, c2 = fold ? D.c2in[n] : 0.f; const int on = n < 1024 ? swap45(n) : n;
        float* PD = (float*)(D.dec + DEC_PD);
#pragma unroll
        for (int i = 0; i < 16; ++i) { const int row = crow(i, hi); float mu = 0.f, rs = 1.f; if (fold) { mu = sc[2 * row]; rs = sc[2 * row + 1]; } PD[(size_t)row * NIN + on] = (acc[i] - mu * c1) * rs + c2; }
    } else {
        const int v = u - 105, n = 32 * v + r32;
        const f32x16 acc = dec_gemm((const bf16*)(D.dec + DEC_SHB) + (size_t)D.l * MD * DM, D.winu + (size_t)(32 * v) * DM, DM, red, wave, lane);
        if (wave != 0) return;
        float* PS = (float*)(D.dec + DEC_PS);
#pragma unroll
        for (int i = 0; i < 16; ++i) PS[(size_t)crow(i, hi) * NRWU + n] = acc[i];
    }
    LDS_WAIT();
}
DI void dec_unit_res(const bf16* A, const bf16* Wt, int K, int u, bool raw, const float* src, const float* sstat, const float* g, const float* b, float* T, bf16* XB, float* ostat, float* shiftout, LAS float* red, LAS float* sc, int wave, int lane) {
    const int r32 = lane & 31, hi = lane >> 5, n = 32 * u + r32;
    const f32x16 acc = dec_gemm(A, Wt + (size_t)(32 * u) * K, K, red, wave, lane);
    if (wave != 0) return;
    if (!raw) dec_row_stats(sstat, sc, lane);
    const float gg = raw ? 1.f : g[n], bb = raw ? 0.f : b[n];
#pragma unroll
    for (int i = 0; i < 16; ++i) { const int row = crow(i, hi); float mu = 0.f, rs = 1.f; if (!raw) { mu = sc[2 * row]; rs = sc[2 * row + 1]; }
        const float x = (src[(size_t)row * DM + n] - mu) * rs * gg + bb; const float t = ALPHA * x + acc[i];
        T[(size_t)row * DM + n] = t; XB[(size_t)row * DM + n] = (bf16)f2bf(t); if (shiftout) shiftout[(size_t)row * DM + n] = x;
        float s = t, q = t * t;
#pragma unroll
        for (int o = 1; o < 32; o <<= 1) { s += __shfl_xor(s, o); q += __shfl_xor(q, o); }
        if (r32 == 0) { ostat[((size_t)row * 32 + u) * 2] = s; ostat[((size_t)row * 32 + u) * 2 + 1] = q; } }
    LDS_WAIT();
}
DI void dec_unit_up(const DecP& D, int u, LAS float* red, LAS float* sc, int wave, int lane) {
    const int r32 = lane & 31, hi = lane >> 5, n = 32 * u + r32;
    const f32x16 acc = dec_gemm((const bf16*)(D.dec + DEC_XB1), D.wup + (size_t)(32 * u) * DM, DM, red, wave, lane);
    if (wave != 0) return;
    dec_row_stats((const float*)(D.dec + DEC_ST1), sc, lane);
    const float c1 = D.c1up[n], c2 = D.c2up[n]; bf16* HB = (bf16*)(D.dec + DEC_HB);
#pragma unroll
    for (int i = 0; i < 16; ++i) { const int row = crow(i, hi); const float v = fmaxf((acc[i] - sc[2 * row] * c1) * sc[2 * row + 1] + c2, 0.f); HB[(size_t)row * FFD + n] = (bf16)f2bf(v * v); }
    LDS_WAIT();
}
DI void dec_attn_task(const DecP& D, const float* ck, const float* cv, const float* rope, int bd, int h, int p, int lane) {
    const int g = lane >> 4, dq = lane & 15, dd = 1 << (2 * p);
    const float* PD = (const float*)(D.dec + DEC_PD) + (size_t)bd * NIN;
    const f32x4 rr0 = *(const f32x4*)(rope + ((size_t)8192 * 32 + ((4 * dq) & 31)) * 2), rr1 = *(const f32x4*)(rope + ((size_t)8192 * 32 + ((4 * dq) & 31)) * 2 + 4);
    const f32x4 cs = {rr0[0], rr0[2], rr1[0], rr1[2]}, sn = {rr0[1], rr0[3], rr1[1], rr1[3]};
    const float sgn = dq < 8 ? -1.f : 1.f;
    f32x4 q = *(const f32x4*)(PD + h * 64 + 4 * dq), kn = *(const f32x4*)(PD + 512 + h * 64 + 4 * dq); const f32x4 vn = *(const f32x4*)(PD + 1024 + h * 64 + 4 * dq);
    { f32x4 qp, kp;
#pragma unroll
      for (int e = 0; e < 4; ++e) { qp[e] = __shfl_xor(q[e], 8); kp[e] = __shfl_xor(kn[e], 8); }
      q = q * cs + qp * sn * sgn; kn = kn * cs + kp * sn * sgn; }
    if (p == 0 && g == 0) { *(f32x4*)(D.out + O_KS + ((size_t)D.l * MD + bd) * 512 + h * 64 + 4 * dq) = kn; *(f32x4*)(D.out + O_VS + ((size_t)D.l * MD + bd) * 512 + h * 64 + 4 * dq) = vn; }
    float s0 = (q[0] * kn[0] + q[1] * kn[1]) + (q[2] * kn[2] + q[3] * kn[3]);
#pragma unroll
    for (int o = 1; o < 16; o <<= 1) s0 += __shfl_xor(s0, o);
    s0 *= 0.125f;
    const size_t cbase = (((size_t)D.l * MD + bd) * 2048) * 512 + h * 64 + 4 * dq;
    float mx = -INFINITY, den = 0.f; f32x4 o4 = {0.f, 0.f, 0.f, 0.f};
#pragma unroll 8
    for (int it = 0; it < 32; ++it) { const int j = 1 + 4 * it + g; const size_t off = cbase + (size_t)(2048 - j * dd) * 512;
        const f32x4 kr = *(const f32x4*)(ck + off); const f32x4 vr = *(const f32x4*)(cv + off);
        float s = (q[0] * kr[0] + q[1] * kr[1]) + (q[2] * kr[2] + q[3] * kr[3]);
#pragma unroll
        for (int o = 1; o < 16; o <<= 1) s += __shfl_xor(s, o);
        s *= 0.125f;
        const float mn = fmaxf(mx, s), sc = fexp(mx - mn), pj = fexp(s - mn);
        den = den * sc + pj; o4 = o4 * sc + vr * pj; mx = mn; }
    float mg = fmaxf(mx, __shfl_xor(mx, 16)); mg = fmaxf(mg, __shfl_xor(mg, 32)); mg = fmaxf(mg, s0);
    { const float sc = fexp(mx - mg); den *= sc; o4 = o4 * sc; }
    den += __shfl_xor(den, 16); den += __shfl_xor(den, 32);
#pragma unroll
    for (int e = 0; e < 4; ++e) { o4[e] += __shfl_xor(o4[e], 16); o4[e] += __shfl_xor(o4[e], 32); }
    const float p0 = fexp(s0 - mg); den += p0; o4 = (o4 + vn * p0) * (1.0f / den); mx = mg;
    if (g == 0) *(f32x4*)((float*)(D.dec + DEC_OP) + ((size_t)p * MD + bd) * 512 + h * 64 + 4 * dq) = o4;
    if (lane == 0) ((float*)(D.dec + DEC_LSE))[((size_t)p * MD + bd) * 8 + h] = mx + __logf(den);
}
DI void dec_rwkv_task(const DecP& D, const float* const* in, int bd, int h, LAS float* sv  , int lane) {
    const int l = D.l, ch = h * 64 + lane;
    const float* PD = (const float*)(D.dec + DEC_PD) + (size_t)bd * NIN + RW0; const float* PS = (const float*)(D.dec + DEC_PS) + (size_t)bd * NRWU;
    const float* mu = in[8] + (size_t)l * 1792;
    auto zf = [&](int col) { const float pr = PD[col], pv = PS[col]; return pr + (pv - pr) * mu[col]; };
    const float zr = zf(ch), zk = zf(512 + ch), zv0 = zf(1024 + ch);
    float vl = 0.f; if (l > 0 && lane < 32) { const float pr = PD[1792 + lane], pv = PS[1792 + lane]; vl = pr + (pv - pr) * in[9][(size_t)(l - 1) * 32 + lane]; }
    sv[lane] = ftanh(zf(1536 + lane)); sv[64 + lane] = zf(1600 + lane); sv[128 + lane] = fsigmoid(zf(1664 + lane)); sv[192 + lane] = fsigmoid(zf(1728 + lane)); sv[256 + lane] = vl;
    LDS_WAIT();
    float dw = 0.f, da = 0.f, dv = 0.f, gt = 0.f;
    const float* du = in[11] + (size_t)l * 64 * 512 + ch; const float* iu = in[13] + (size_t)l * 64 * 512 + ch; const float* gu = in[14] + (size_t)l * 128 * 512 + ch;
#pragma unroll 2
    for (int m4 = 0; m4 < 16; ++m4) { const f32x4 a = *(const LAS f32x4*)(sv + 4 * m4), b = *(const LAS f32x4*)(sv + 64 + 4 * m4), c = *(const LAS f32x4*)(sv + 128 + 4 * m4), d = *(const LAS f32x4*)(sv + 192 + 4 * m4);
#pragma unroll
        for (int e = 0; e < 4; ++e) { const int m = 4 * m4 + e; dw += a[e] * du[(size_t)m * 512]; da += b[e] * iu[(size_t)m * 512]; gt += c[e] * gu[(size_t)m * 512] + d[e] * gu[(size_t)(64 + m) * 512]; } }
    if (l > 0) { const float* vu = in[16] + (size_t)(l - 1) * 32 * 512 + ch;
#pragma unroll
        for (int m4 = 0; m4 < 8; ++m4) { const f32x4 a = *(const LAS f32x4*)(sv + 256 + 4 * m4);
#pragma unroll
            for (int e = 0; e < 4; ++e) dv += a[e] * vu[(size_t)(4 * m4 + e) * 512]; } }
    const float w = -fsoftplus(-(in[10][(size_t)l * 512 + ch] + dw)) - 0.5f, decay = fexp(-fexp(w));
    const float a = fsigmoid(in[12][(size_t)l * 512 + ch] + da);
    float* VFD = (float*)(D.dec + DEC_VF) + (size_t)bd * 512 + ch;
    float v = zv0; if (l == 0) *VFD = zv0; else v = zv0 + (*VFD - zv0) * fsigmoid(in[15][(size_t)(l - 1) * 512 + ch] + dv);
    const float kr = zk * in[17][(size_t)l * 512 + ch]; const float kn = kr / fmaxf(sqrtf(wave_sum(kr * kr)), 1e-12f);
    const float k2 = zk * (1.f + (a - 1.f) * in[18][(size_t)l * 512 + ch]);
    const float bon = wave_sum(zr * k2 * in[19][(size_t)l * 512 + ch]);
    LDS_WAIT();
    sv[320 + lane] = -kn; sv[384 + lane] = decay; sv[448 + lane] = kn * a; sv[512 + lane] = k2; sv[576 + lane] = zr;
    LDS_WAIT();
    const float* S0 = in[3] + ((((size_t)l * MD + bd) * NH + h) * 64 + lane) * 64;
    float* So = D.out + O_WKS + ((((size_t)l * MD + bd) * NH + h) * 64 + lane) * 64;
    float sa = 0.f;
    { f32x4 Sr[16];
#pragma unroll
      for (int q = 0; q < 16; ++q) Sr[q] = *(const f32x4*)(S0 + 4 * q);
#pragma unroll
      for (int q = 0; q < 16; ++q) { const f32x4 a4 = *(const LAS f32x4*)(sv + 320 + 4 * q); sa += (Sr[q][0] * a4[0] + Sr[q][1] * a4[1]) + (Sr[q][2] * a4[2] + Sr[q][3] * a4[3]); } }
    asm volatile("" ::: "memory");
    float y = 0.f;
#pragma unroll 8
    for (int q = 0; q < 16; ++q) { const f32x4 s0 = *(const f32x4*)(S0 + 4 * q); const f32x4 w4 = *(const LAS f32x4*)(sv + 384 + 4 * q), b4 = *(const LAS f32x4*)(sv + 448 + 4 * q), k4 = *(const LAS f32x4*)(sv + 512 + 4 * q), r4 = *(const LAS f32x4*)(sv + 576 + 4 * q);
        const f32x4 s4 = s0 * w4 + b4 * sa + k4 * v; *(f32x4*)(So + 4 * q) = s4; y += (s4[0] * r4[0] + s4[1] * r4[1]) + (s4[2] * r4[2] + s4[3] * r4[3]); }
    const float mean = wave_sum(y) * (1.f / 64.f), dy = y - mean, var = wave_sum(dy * dy) * (1.f / 64.f);
    const float o = (dy * (1.0f / sqrtf(var + GN_EPS)) * in[20][(size_t)l * 512 + ch] + in[21][(size_t)l * 512 + ch] + bon * v) * gt;
    ((float*)(D.dec + DEC_MIX))[(size_t)bd * DM + 512 + ch] = o;
    LDS_WAIT();
}
DI void dec_finalize_row(const DecP& D, const float* gain, int bd, int lane) {
    const int h = lane >> 3; const float* L = (const float*)(D.dec + DEC_LSE); const float* OPD = (const float*)(D.dec + DEC_OP);
    const float l0 = L[((size_t)0 * MD + bd) * 8 + h], l1 = L[((size_t)1 * MD + bd) * 8 + h], l2 = L[((size_t)2 * MD + bd) * 8 + h];
    const float mx = fmaxf(l0, fmaxf(l1, l2)); float w0 = fexp(l0 - mx), w1 = fexp(l1 - mx), w2 = fexp(l2 - mx); const float inv = 1.0f / (w0 + w1 + w2); w0 *= inv; w1 *= inv; w2 *= inv;
    float v[8]; float ss = 0.f;
#pragma unroll
    for (int e = 0; e < 8; ++e) { v[e] = w0 * OPD[((size_t)0 * MD + bd) * 512 + lane * 8 + e] + w1 * OPD[((size_t)1 * MD + bd) * 512 + lane * 8 + e] + w2 * OPD[((size_t)2 * MD + bd) * 512 + lane * 8 + e]; ss += v[e] * v[e]; }
    ss = wave_sum(ss); const float rinv = 1.0f / sqrtf(ss * (1.f / 512.f) + RMS_EPS);
    bf16* MB = (bf16*)(D.dec + DEC_MIXB) + (size_t)bd * DM; const float* MX = (const float*)(D.dec + DEC_MIX) + (size_t)bd * DM + 512;
#pragma unroll
    for (int e = 0; e < 8; ++e) { MB[lane * 8 + e] = (bf16)f2bf(v[e] * rinv * gain[lane * 8 + e]); MB[512 + lane * 8 + e] = (bf16)f2bf(MX[lane * 8 + e]); }
}
#ifndef PH_MASK
#define PH_MASK 0x1ff
#endif
#define PH_ON(k) ((PH_MASK >> (k)) & 1)
#ifndef PH_DUP
#define PH_DUP 0
#endif
#define PH_REP(k) for (int rep_ = 0; rep_ < (((PH_DUP >> (k)) & 1) ? 2 : 1); ++rep_)
DI unsigned lds_task_next(volatile LAS unsigned* ctr, int lane) {
    unsigned t = 0; if (lane == 0) t = __hip_atomic_fetch_add((LAS unsigned*)ctr, 1u, __ATOMIC_RELAXED, __HIP_MEMORY_SCOPE_WORKGROUP);
    return (unsigned)__builtin_amdgcn_readfirstlane((int)t);
}
DI DecP make_dec(unsigned char* ws, const float* const* in, float* out, int l) {
    DecP D; D.dec = ws + WS_DEC; D.l = l; D.xs = in[1];
    D.c1in = (const float*)(ws + WS_C1IN) + l * NIN; D.c2in = (const float*)(ws + WS_C2IN) + l * NIN; D.c1up = (const float*)(ws + WS_C1UP) + l * FFD; D.c2up = (const float*)(ws + WS_C2UP) + l * FFD;
    D.g1 = in[24] + (size_t)l * DM; D.b1 = in[25] + (size_t)l * DM; D.g2p = l > 0 ? in[28] + (size_t)(l - 1) * DM : nullptr; D.b2p = l > 0 ? in[29] + (size_t)(l - 1) * DM : nullptr;
    D.win = (const bf16*)(ws + WS_WIN) + (size_t)l * NIN * DM; D.winu = (const bf16*)(ws + WS_WINU) + (size_t)l * NRWU * DM; D.wout = (const bf16*)(ws + WS_WOUT) + (size_t)l * DM * DM;
    D.wup = (const bf16*)(ws + WS_WUP) + (size_t)l * FFD * DM; D.wdn = (const bf16*)(ws + WS_WDN) + (size_t)l * DM * FFD; D.out = out; return D;
}
DI RwkvP make_rwkv(unsigned char* ws, const float* const* in, int l) {
    RwkvP R; R.PR = (const bf16*)(ws + WS_PR); R.mu = in[8] + (size_t)l * 1792; R.muv = l > 0 ? in[9] + (size_t)(l - 1) * 32 : nullptr;
    R.dbase = in[10] + (size_t)l * 512; R.ibase = in[12] + (size_t)l * 512; R.vbase = l > 0 ? in[15] + (size_t)(l - 1) * 512 : nullptr; R.ksk = in[17] + (size_t)l * 512; R.ksa = in[18] + (size_t)l * 512; R.brk = in[19] + (size_t)l * 512;
    R.gng = in[20] + (size_t)l * 512; R.gnb = in[21] + (size_t)l * 512;
    R.dupT = (const bf16*)(ws + WS_DUPT) + (size_t)l * 512 * 64; R.iupT = (const bf16*)(ws + WS_IUPT) + (size_t)l * 512 * 64; R.vupT = l > 0 ? (const bf16*)(ws + WS_VUPT) + (size_t)(l - 1) * 512 * 32 : nullptr; R.gupT = (const bf16*)(ws + WS_GUPT) + (size_t)l * 512 * 128;
    R.ZROW = (const bf16*)(ws + WS_CTL + 512 * 1024); R.VF = (bf16*)(ws + WS_VF); R.VV = (bf16*)(ws + WS_VV); R.BON = (float*)(ws + WS_BON); R.GC = (float*)(ws + WS_GC); R.W1S = (bf16*)(ws + WS_PT); R.REFF = (bf16*)(ws + WS_REFF); R.BM = (bf16*)(ws + WS_QT); R.REC = (v4u*)(ws + WS_YLOC);
    R.YPRE = (float*)(ws + WS_YPRE); R.MIX = (bf16*)(ws + WS_MIX); R.layer0 = (l == 0); return R;
}
#define PHASE_VARS() int tid_p = (int)threadIdx.x; asm volatile("" : "+v"(tid_p)); const int lane = tid_p & 63; const int wave = __builtin_amdgcn_readfirstlane(tid_p >> 6); \
    unsigned zo_p; asm volatile("s_mov_b32 %0, 0" : "=s"(zo_p)); unsigned char* ws = args.ws + zo_p; const float* const* in = args.in + zo_p; float* out = args.out + zo_p; \
    const int gw = F.vcu * NWAVES + wave; const int rgw = (F.G - 1 - (int)blockIdx.x) * NWAVES + wave; LAS float* dsc = (LAS float*)(L3 + 65536); LAS float* dred = (LAS float*)L3; const int rwg = F.G - 1 - (int)blockIdx.x; (void)gw; (void)rgw; (void)dsc; (void)dred; (void)rwg; (void)lane; (void)in; (void)out
__global__ void __launch_bounds__(NWAVES * 64, 2) mega_fwd(Args args) {
    extern __shared__ __attribute__((aligned(16))) unsigned char lds[];
    Frame F;
    F.lds = lds; F.MISC = (volatile LAS unsigned*)((LAS unsigned char*)lds + MISC_OFF);
    F.tid = threadIdx.x; F.lane = F.tid & 63; F.wave = __builtin_amdgcn_readfirstlane(F.tid >> 6);
    F.G = gridDim.x; { const int bx = blockIdx.x; F.vcu = (F.G % 8 == 0) ? (bx % 8) * (F.G / 8) + bx / 8 : bx; }
    F.gw = F.vcu * NWAVES + F.wave; F.NGW = F.G * NWAVES;
    F.in = args.in; F.out = args.out; F.ws = args.ws; F.ctl = (gu32*)(args.ws + WS_CTL);
    LAS unsigned char* L3 = (LAS unsigned char*)lds;
    for (int u = F.tid; u < (LDS_BYTES - RING_BYTES) / 4; u += NWAVES * 64) ((LAS unsigned*)(L3 + RING_BYTES))[u] = 0u;
    __syncthreads();
    XcdBarrier bar = xcd_barrier_post((unsigned*)(F.ctl + CW_BAR), F.MISC + 8);
#define GRID_BAR() do { XcdBarrier b2_ = bar; asm volatile("" : "+s"(b2_.x)); xcd_barrier(b2_); } while (0)

    PH_REP(0) { if (PH_ON(0)) p0_prologue(F);
    GRID_BAR(); }

    for (int l = 0; l < DEPTH; ++l) {
        PH_REP(1) {
        if (PH_ON(1))
        {   PHASE_VARS(); const DecP D = make_dec(ws, in, out, l);
            pg8::Gemm g{(const pg8::bf16_t*)(ws + WS_XB2), (const pg8::bf16_t*)D.win, M, NIN, DM}; pg8::StaticOrder S; S.init(M, NIN, F.G, (int)blockIdx.x);
            pg8::EpiIn E{ws, out, l};
            pg8::gemm_phase<pg8::EpiIn, pg8::StaticOrder, true, true>((PG8_LAS unsigned char*)L3, g, S, E, tid_p);
            for (int u = rwg; u < 162; u += F.G) dec_unit_in(D, u, dred, dsc, wave, lane);
        }
        GRID_BAR();
        }

#define ATT_QUEUE() do { LAS unsigned char* wl_ = L3 + wave * 10240; const int bh_ = F.vcu >> 4, span_ = F.vcu & 15; \
        for (;;) { const unsigned t_ = lds_task_next(F.MISC, lane); if (t_ >= 48u) break; \
            if (t_ >= 48u) { const int dt_ = (int)blockIdx.x * 4 + (int)(t_ - 48u); \
                if (dt_ < 768) dec_attn_task(D, in[4], in[5], (const float*)(ws + WS_ROPE), dt_ / 24, (dt_ % 24) / 3, dt_ % 3, lane); \
                else dec_rwkv_task(D, in, (dt_ - 768) >> 3, (dt_ - 768) & 7, (LAS float*)wl_, lane); continue; } \
            const int p_ = (int)t_ >> 4, idx_ = (int)t_ & 15; \
            const int cls_ = p_ == 0 ? 0 : p_ == 1 ? (idx_ >> 2) : idx_, qblk_ = p_ == 0 ? span_ * 16 + idx_ : p_ == 1 ? span_ * 4 + (idx_ & 3) : span_; \
            attn_task((const bf16*)(ws + WS_QB), (const bf16*)(ws + WS_KB), (const bf16*)(ws + WS_VB), (bf16*)(ws + WS_OP), (float*)(ws + WS_LSE), bh_ >> 3, bh_ & 7, p_, cls_, qblk_, wl_, lane); } } while (0)
        PH_REP(3) {
        if (PH_ON(3))
        {   PHASE_VARS(); const DecP D = make_dec(ws, in, out, l); const RwkvP R = make_rwkv(ws, in, l);
            if (tid_p == 0) F.MISC[0] = 0u;
            if (l == 0) colsum_finish(ws, gw * 64 + lane, F.NGW * 64);
            { LAS unsigned char* wl1 = L3 + wave * 12288; LAS unsigned char* hc = L3 + 8 * 12288;
              head_cache_fill(R, (F.vcu >> 4) & 7, hc, tid_p);
              __syncthreads();
#pragma unroll 1
              for (int i = 0; i < 4; ++i) rwkv_b1_unit(R, F.vcu * 32 + wave + 8 * i, wl1, hc, lane); }
            VM_WAIT(); __syncthreads();
            if (wave >= 4) { const int dt = (int)blockIdx.x * 4 + (wave - 4);
                if (dt < 768) dec_attn_task(D, in[4], in[5], (const float*)(ws + WS_ROPE), dt / 24, (dt % 24) / 3, dt % 3, lane);
                else dec_rwkv_task(D, in, (dt - 768) >> 3, (dt - 768) & 7, (LAS float*)(L3 + wave * 10240), lane); }
            if (wave < 4) chain_pass1(R, (float*)(ws + WS_SEGQ), (float*)(ws + WS_SEGP), F.vcu >> 4, F.vcu & 15, wave, lane);
            ATT_QUEUE();
            if ((PH_DUP >> 12) & 1) { __syncthreads(); if (tid_p == 0) F.MISC[0] = 0u; __syncthreads(); ATT_QUEUE(); }
        }
        GRID_BAR();
        }
        PH_REP(9) {
        if (PH_ON(3))
        {   PHASE_VARS(); const DecP D = make_dec(ws, in, out, l); const RwkvP R = make_rwkv(ws, in, l);
            const int seq = F.vcu >> 4, sg = F.vcu & 15;
            LAS unsigned char* gcache = L3 + 98304; gate_cache_fill(R, seq & 7, gcache, tid_p);
            if (wave < 4) chain_pass23(R, (const float*)(ws + WS_SEGQ), (const float*)(ws + WS_SEGP), seq, sg, wave, out + O_WKP + ((size_t)l * 16 + seq) * 4096, lane);
            else { for (int i = 0; i < 16; ++i) attn_finalize_row((const bf16*)(ws + WS_OP), (const float*)(ws + WS_LSE), in[22] + (size_t)l * 512, (bf16*)(ws + WS_MIX), (int)blockIdx.x * 64 + (wave - 4) * 16 + i, lane);
                if (blockIdx.x < MD && wave == 4) dec_finalize_row(D, in[22] + (size_t)l * 512, (int)blockIdx.x, lane); }
            VM_WAIT(); __syncthreads();
#pragma unroll 1
            for (int i = 0; i < 4; ++i) rwkv_b3_unit(R, seq * NCH + sg * SEGCH + wave + 8 * i, gcache, lane);
        }
        GRID_BAR();
        }

        PH_REP(5) {
        if (PH_ON(5))
        {   PHASE_VARS(); const DecP D = make_dec(ws, in, out, l);
            pg8::Gemm g{(const pg8::bf16_t*)(ws + WS_MIX), (const pg8::bf16_t*)D.wout, M, DM, DM}; pg8::StaticOrder S; S.init(M, DM, F.G, (int)blockIdx.x);
            pg8::EpiRes<false> E{ws, in, out, l};
            pg8::gemm_phase<pg8::EpiRes<false>, pg8::StaticOrder, false, true>((PG8_LAS unsigned char*)L3, g, S, E, tid_p);
            for (int u = rwg; u < 32; u += F.G)
                dec_unit_res((const bf16*)(D.dec + DEC_MIXB), D.wout, DM, u, l == 0, l == 0 ? D.xs : (const float*)(D.dec + DEC_T2), (const float*)(D.dec + DEC_ST2), D.g2p, D.b2p, (float*)(D.dec + DEC_T1), (bf16*)(D.dec + DEC_XB1), (float*)(D.dec + DEC_ST1),
                             out + O_SHS + (size_t)l * MD * DM, dred, dsc, wave, lane);
        }
        GRID_BAR();
        }

        PH_REP(6) {
        if (PH_ON(6))
        {   PHASE_VARS(); const DecP D = make_dec(ws, in, out, l);
            pg8::Gemm g{(const pg8::bf16_t*)(ws + WS_XB1), (const pg8::bf16_t*)D.wup, M, FFD, DM}; pg8::StaticOrder S; S.init(M, FFD, F.G, (int)blockIdx.x);
            pg8::EpiUp E{ws, l};
            pg8::gemm_phase<pg8::EpiUp, pg8::StaticOrder, true, true>((PG8_LAS unsigned char*)L3, g, S, E, tid_p);
            for (int u = rwg; u < 128; u += F.G) dec_unit_up(D, u, dred, dsc, wave, lane);
        }
        GRID_BAR();
        }

        PH_REP(7) {
        if (PH_ON(7))
        {   PHASE_VARS(); const DecP D = make_dec(ws, in, out, l);
            pg8::Gemm g{(const pg8::bf16_t*)(ws + WS_H), (const pg8::bf16_t*)D.wdn, M, DM, FFD}; pg8::StaticOrder S; S.init(M, DM, F.G, (int)blockIdx.x);
            pg8::EpiRes<true> E{ws, in, out, l};
            PH_REP(11) { pg8::gemm_phase<pg8::EpiRes<true>, pg8::StaticOrder, false, true>((PG8_LAS unsigned char*)L3, g, S, E, tid_p); }
            PH_REP(10) for (int u = rwg; u < 32; u += F.G)
                dec_unit_res((const bf16*)(D.dec + DEC_HB), D.wdn, FFD, u, false, (const float*)(D.dec + DEC_T1), (const float*)(D.dec + DEC_ST1), D.g1, D.b1, (float*)(D.dec + DEC_T2), (bf16*)(D.dec + DEC_XB2), (float*)(D.dec + DEC_ST2), nullptr, dred, dsc, wave, lane);
        }
        GRID_BAR();
        }
    }
    if (PH_ON(8))
    {   PHASE_VARS(); const float* g = in[28] + (size_t)3 * DM; const float* b = in[29] + (size_t)3 * DM;
        for (int r = gw; r < M; r += F.NGW) { float mu, rs; pg8::row_stats((const float*)(ws + WS_STAT2), r, mu, rs);
            const v2u* t = (const v2u*)((const bf16*)(ws + WS_XB2) + (size_t)r * DM) + lane; f32x4* o = (f32x4*)(out + O_Y + (size_t)r * DM) + lane;
#pragma unroll
            for (int j = 0; j < 4; ++j) { const f32x4 gg = *((const f32x4*)g + lane + 64 * j), bb = *((const f32x4*)b + lane + 64 * j); const v2u w = t[64 * j]; const f32x4 tv = {bflo(w.x), bfhi(w.x), bflo(w.y), bfhi(w.y)}; o[64 * j] = (tv - mu) * rs * gg + bb; } }
        if (rgw < MD) { LAS float* fsc = dsc + wave * 64; dec_row_stats((const float*)(ws + WS_DEC + DEC_ST2), fsc, lane); const float mu = fsc[2 * rgw], rs = fsc[2 * rgw + 1];
            const f32x4* t = (const f32x4*)((const float*)(ws + WS_DEC + DEC_T2) + (size_t)rgw * DM) + lane; f32x4* o = (f32x4*)(out + O_YS + (size_t)rgw * DM) + lane;
#pragma unroll
            for (int j = 0; j < 4; ++j) { const f32x4 gg = *((const f32x4*)g + lane + 64 * j), bb = *((const f32x4*)b + lane + 64 * j); o[64 * j] = (t[64 * j] - mu) * rs * gg + bb; } }
    }
}

extern "C" void kernel_launch(void* const* d_in, const int* in_sizes, int n_in, void* d_out, int out_size, void* d_ws, size_t ws_size, hipStream_t stream) {
    static int grid = 0;
    if (grid == 0) {
        if (n_in != 30 || out_size != (int)O_END || ws_size < WS_END) { fprintf(stderr, "kernel_launch: unexpected problem (n_in %d, out %d, ws %zu); nothing launched\n", n_in, out_size, ws_size); grid = -1; return; }
        int dev = 0, cus = 0, per_cu = 0;
        if (hipGetDevice(&dev) != hipSuccess || hipDeviceGetAttribute(&cus, hipDeviceAttributeMultiprocessorCount, dev) != hipSuccess) { fprintf(stderr, "kernel_launch: device query failed\n"); grid = -1; return; }
        if (hipFuncSetAttribute((const void*)mega_fwd, hipFuncAttributeMaxDynamicSharedMemorySize, LDS_BYTES) != hipSuccess) { fprintf(stderr, "kernel_launch: hipFuncSetAttribute failed\n"); grid = -1; return; }
        if (hipOccupancyMaxActiveBlocksPerMultiprocessor(&per_cu, (const void*)mega_fwd, NWAVES * 64, LDS_BYTES) != hipSuccess || per_cu < 1) fprintf(stderr, "kernel_launch: occupancy query reports %d\n", per_cu);
        (void)hipGetLastError();
        if (cus < 256) { fprintf(stderr, "kernel_launch: needs 256 CUs (found %d)\n", cus); grid = -1; return; }
        grid = 256;
    }
    if (grid < 0) return;
    if (hipMemsetAsync((char*)d_ws + WS_CTL, 0, CTL_ZERO_BYTES, stream) != hipSuccess) { fprintf(stderr, "kernel_launch: memset failed\n"); return; }
    Args a{};
    for (int i = 0; i < 30; ++i) a.in[i] = (const float*)d_in[i];
    a.out = (float*)d_out; a.ws = (unsigned char*)d_ws;
    hipLaunchKernelGGL(mega_fwd, dim3(grid), dim3(NWAVES * 64), LDS_BYTES, stream, a);
    const hipError_t le = hipPeekAtLastError();
    if (le != hipSuccess) fprintf(stderr, "kernel_launch: launch failed: %s\n", hipGetErrorName(le));
}
```

```cpp
#include <hip/hip_runtime.h>
#include <cstdio>
#include <cstdint>
#include <cmath>
namespace pg8 {
#define PG8_LAS __attribute__((address_space(3)))
typedef unsigned short bf16_t;
typedef short bf16x8 __attribute__((ext_vector_type(8)));
typedef float f32x4 __attribute__((ext_vector_type(4)));
typedef unsigned u32x4 __attribute__((ext_vector_type(4)));
constexpr int BM = 256, BK = 64, HALF = 128, HTB = HALF * BK * 2  , STAGE_BYTES = 8 * HTB, NXCD = 8, WGM = 8;

__host__ __device__ __forceinline__ int lds_byte(int r, int c) { const int st = (r >> 4) * 2 + (c >> 5), rr = r & 15, cc = c & 31, ob = rr * 64 + cc * 2; return st * 1024 + (ob ^ (((ob >> 9) & 1) << 5)); }
__host__ __device__ __forceinline__ void stage_rc(int b, int& R, int& C) { const int st = b / 1024, sb = b % 1024, swz = sb ^ (((sb >> 9) & 1) << 5); R = (st >> 1) * 16 + swz / 64; C = (st & 1) * 32 + (swz % 64) / 2; }
__host__ __device__ __forceinline__ int perm32(int rho) { const int n = rho >> 4, i = rho & 15; return 8 * (i >> 2) + 4 * n + (i & 3); }

struct Unit { int pm, pn; };
struct Gemm { const bf16_t* A; const bf16_t* Bt; int M, N, K; };

struct StaticOrder {
    int nM, nN, nwg, G, c;
    __host__ __device__ void init(int M, int N, int G_, int c_) { nM = M / BM; nN = N / BM; nwg = nM * nN; G = G_; c = c_; }
    __host__ __device__ bool next(int i, Unit& u) const {
        const long L = (long)i * G + c; if (L >= nwg) return false;
        int wgid = (int)L; { const int q = nwg / NXCD, r = nwg % NXCD, xcd = wgid % NXCD, off = wgid / NXCD; wgid = (xcd < r ? xcd * (q + 1) : r * (q + 1) + (xcd - r) * q) + off; }
        const int nig = WGM * nN, gid = wgid / nig, fm = gid * WGM, gsz = (nM - fm) < WGM ? (nM - fm) : WGM;
        u.pm = fm + ((wgid % nig) % gsz); u.pn = (wgid % nig) / gsz; return true;
    }
    __device__ __forceinline__ void a_ready(const Unit&) const {}
    __device__ __forceinline__ void done(const Unit&) const {}
};

__device__ __forceinline__ unsigned cvt_pk_bf16(float lo, float hi) { unsigned r; asm volatile("v_cvt_pk_bf16_f32 %0, %1, %2" : "=v"(r) : "v"(lo), "v"(hi)); return r; }
typedef float f32x2 __attribute__((ext_vector_type(2)));
constexpr size_t WSO_C1IN = 1u << 20, WSO_C2IN = WSO_C1IN + 4 * 3584 * 4, WSO_C1UP = WSO_C2IN + 4 * 3584 * 4, WSO_C2UP = WSO_C1UP + 4 * 4096 * 4, WSO_ROPE = 3u << 20, WSO_STAT1 = 8u << 20, WSO_STAT2 = 9u << 20;
constexpr size_t WSO_XB2 = 132ull << 20, WSO_XB1 = 164ull << 20, WSO_T1 = 196ull << 20, WSO_T2 = 260ull << 20, WSO_QB = 324ull << 20, WSO_KB = 340ull << 20, WSO_VB = 356ull << 20, WSO_PR = 372ull << 20, WSO_H = 580ull << 20;
constexpr size_t OO_SHP = 16809984, OO_KP = 21405696, OO_VP = 29794304;
__device__ __forceinline__ void row_stats(const float* stat, int row, float& mu, float& rs) {
    const f32x4 a = *(const f32x4*)(stat + (size_t)row * 8), b = *(const f32x4*)(stat + (size_t)row * 8 + 4);
    const float s = (a[0] + a[2]) + (b[0] + b[2]), q = (a[1] + a[3]) + (b[1] + b[3]);
    mu = s * (1.f / 1024.f); const float var = fmaxf(q * (1.f / 1024.f) - mu * mu, 0.f); rs = 1.0f / sqrtf(var + 1e-5f);
}
typedef float f32x2e __attribute__((ext_vector_type(2)));
typedef unsigned u32x2e __attribute__((ext_vector_type(2)));
struct EpiIn {
    static constexpr bool PERM = true, AFTER_DRAIN = false;
    unsigned char* ws; float* out; int l;
    __device__ __forceinline__ void operator()(const f32x4 (&acc)[2][2][4][2], const Unit& u, int wr, int wc, int fr, int fq) const {
        asm volatile("" ::: "memory"); __builtin_amdgcn_sched_barrier(0);
        const int fold = l > 0; const float* stat = (const float*)(ws + WSO_STAT2); const float* c1 = (const float*)(ws + WSO_C1IN) + l * 3584; const float* c2 = (const float*)(ws + WSO_C2IN) + l * 3584;
        bf16_t* QB = (bf16_t*)(ws + WSO_QB); bf16_t* KB = (bf16_t*)(ws + WSO_KB); bf16_t* VB = (bf16_t*)(ws + WSO_VB); bf16_t* PR = (bf16_t*)(ws + WSO_PR); const float* rope = (const float*)(ws + WSO_ROPE);
        float* outk = out + OO_KP + (size_t)l * 2 * 2048 * 512; float* outv = out + OO_VP + (size_t)l * 2 * 2048 * 512; const float qscale = 0.125f * 1.4426950408889634f;
        const int cb = u.pn * BM + wc * 32 + 8 * fq;
        const int i0 = 16 * (wc & 1) + 4 * fq; const bool roped = u.pn < 4;
        const int rbase = u.pm * BM + wr * 64 + fr;
        float mu8[8], rs8[8];
#pragma unroll
        for (int gq = 0; gq < 8; ++gq) { mu8[gq] = 0.f; rs8[gq] = 1.f; if (fold) row_stats(stat, rbase + (gq >> 2) * HALF + (gq & 3) * 16, mu8[gq], rs8[gq]); }
#pragma unroll
        for (int bj = 0; bj < 2; ++bj) {
            f32x4 c1v[2], c2v[2];
#pragma unroll
            for (int n = 0; n < 2; ++n) { c1v[n] = fold ? *(const f32x4*)(c1 + cb + bj * HALF + n * 4) : (f32x4){0.f, 0.f, 0.f, 0.f}; c2v[n] = fold ? *(const f32x4*)(c2 + cb + bj * HALF + n * 4) : (f32x4){0.f, 0.f, 0.f, 0.f}; }
#pragma unroll
            for (int gq = 0; gq < 8; ++gq) {
                const int ai = gq >> 2, m = gq & 3;
                const int r = rbase + ai * HALF + m * 16;
                const float mu = mu8[gq], rs = rs8[gq];
                f32x4 ra = {0.f, 0.f, 0.f, 0.f}, rb = ra;
                if (roped) { const float* rp = rope + ((size_t)(r & 8191) * 32 + i0) * 2; ra = *(const f32x4*)rp; rb = *(const f32x4*)(rp + 4); }
                if ((gq & 3) == 3) asm volatile("" ::: "memory");
                f32x4 v[2];
#pragma unroll
                for (int n = 0; n < 2; ++n) v[n] = (acc[ai][bj][m][n] - mu * c1v[n]) * rs + c2v[n];
                const int pos = r & 8191, b = r >> 13;
                if (roped) {
                    const f32x4 cs = {ra[0], ra[2], rb[0], rb[2]}, sn = {ra[1], ra[3], rb[1], rb[3]};
                    const int head = (u.pn & 1) * 4 + bj * 2 + (wc >> 1);
                    f32x4 y1 = v[0] * cs - v[1] * sn, y2 = v[0] * sn + v[1] * cs;
                    const size_t o = (size_t)r * 512 + head * 64 + i0;
                    if (u.pn < 2) { y1 = y1 * qscale; y2 = y2 * qscale;
                        u32x2e w; w.x = cvt_pk_bf16(y1[0], y1[1]); w.y = cvt_pk_bf16(y1[2], y1[3]); *(u32x2e*)(QB + o) = w;
                        w.x = cvt_pk_bf16(y2[0], y2[1]); w.y = cvt_pk_bf16(y2[2], y2[3]); *(u32x2e*)(QB + o + 32) = w;
                    } else {
                        u32x2e w; w.x = cvt_pk_bf16(y1[0], y1[1]); w.y = cvt_pk_bf16(y1[2], y1[3]); *(u32x2e*)(KB + o) = w;
                        w.x = cvt_pk_bf16(y2[0], y2[1]); w.y = cvt_pk_bf16(y2[2], y2[3]); *(u32x2e*)(KB + o + 32) = w;
                        if (pos >= 6144) { float* ok = outk + ((size_t)(b * 2048 + pos - 6144)) * 512 + head * 64 + i0; *(f32x4*)ok = y1; *(f32x4*)(ok + 32) = y2; }
                    }
                } else if (u.pn < 6) {
                    const int c = cb + bj * HALF - 1024;
                    u32x4 w; w.x = cvt_pk_bf16(v[0][0], v[0][1]); w.y = cvt_pk_bf16(v[0][2], v[0][3]); w.z = cvt_pk_bf16(v[1][0], v[1][1]); w.w = cvt_pk_bf16(v[1][2], v[1][3]); *(u32x4*)(VB + (size_t)r * 512 + c) = w;
                    if (pos >= 6144) { float* ov = outv + ((size_t)(b * 2048 + pos - 6144)) * 512 + c; *(f32x4*)ov = v[0]; *(f32x4*)(ov + 4) = v[1]; }
                } else {
                    const int c = cb + bj * HALF - 1536;
                    if (c < 1824) { u32x4 w; w.x = cvt_pk_bf16(v[0][0], v[0][1]); w.y = cvt_pk_bf16(v[0][2], v[0][3]); w.z = cvt_pk_bf16(v[1][0], v[1][1]); w.w = cvt_pk_bf16(v[1][2], v[1][3]); *(u32x4*)(PR + (size_t)r * 2048 + c) = w; }
                }
            }
        }
    }
};
template <bool IS_F> struct EpiRes {
    static constexpr bool PERM = true, AFTER_DRAIN = true;
    unsigned char* ws; const float* const* in; float* out; int l;
    __device__ __forceinline__ void fused(f32x4 (&acc)[2][2][4][2], const Unit& u, int wr, int wc, int fr, int fq, PG8_LAS unsigned char* lds, int wid, int lane) const {
        const int raw = (!IS_F && l == 0) ? 1 : 0;
        const bf16_t* src = (const bf16_t*)(ws + (IS_F ? WSO_XB1 : WSO_XB2));
        const float* sstat = (const float*)(ws + (IS_F ? WSO_STAT1 : WSO_STAT2));
        const float* g = IS_F ? in[24] + (size_t)l * 1024 : in[28] + (size_t)(l > 0 ? l - 1 : 0) * 1024; const float* b = IS_F ? in[25] + (size_t)l * 1024 : in[29] + (size_t)(l > 0 ? l - 1 : 0) * 1024;
        bf16_t* XB = (bf16_t*)(ws + (IS_F ? WSO_XB2 : WSO_XB1)); float* ostat = (float*)(ws + (IS_F ? WSO_STAT2 : WSO_STAT1));
        float* shiftout = (IS_F || raw) ? nullptr : out + OO_SHP + (size_t)l * 2 * 1024; const float alpha = 1.6817928305074290f;
        PG8_LAS f32x2e* P = (PG8_LAS f32x2e*)lds;
        const int cb = u.pn * BM + wc * 32 + 8 * fq;
        const int rbase = u.pm * BM + wr * 64 + fr;
        u32x4 cur[2], nxt[2]; f32x4 sa = {0.f, 0.f, 0.f, 0.f}, sb = sa, san = sa, sbn = sa;
#pragma unroll
        for (int bj = 0; bj < 2; ++bj) { cur[bj] = *(const u32x4*)(src + (size_t)rbase * 1024 + cb + bj * HALF); nxt[bj] = cur[bj]; }
        if (!raw) { sa = *(const f32x4*)(sstat + (size_t)rbase * 8); sb = *(const f32x4*)(sstat + (size_t)rbase * 8 + 4); }
#pragma unroll
        for (int gq = 0; gq < 8; ++gq) {
            const int ai = gq >> 2, m = gq & 3;
            const int r = rbase + ai * HALF + m * 16;
            if (gq < 7) { const int rn = rbase + ((gq + 1) >> 2) * HALF + ((gq + 1) & 3) * 16;
#pragma unroll
                for (int bj = 0; bj < 2; ++bj) nxt[bj] = *(const u32x4*)(src + (size_t)rn * 1024 + cb + bj * HALF);
                if (!raw) { san = *(const f32x4*)(sstat + (size_t)rn * 8); sbn = *(const f32x4*)(sstat + (size_t)rn * 8 + 4); } }
            asm volatile("" ::: "memory");
            float mu = 0.f, rs = 1.f;
            if (!raw) { const float ssum = (sa[0] + sa[2]) + (sb[0] + sb[2]), qsum = (sa[1] + sa[3]) + (sb[1] + sb[3]); mu = ssum * (1.f / 1024.f); rs = 1.0f / sqrtf(fmaxf(qsum * (1.f / 1024.f) - mu * mu, 0.f) + 1e-5f); }
            float s = 0.f, q = 0.f;
#pragma unroll
            for (int bj = 0; bj < 2; ++bj) { const int c = cb + bj * HALF; const size_t off = (size_t)r * 1024 + c; const u32x4 cw = cur[bj]; u32x4 wout;
#pragma unroll
                for (int n = 0; n < 2; ++n) {
                    const f32x4 gvv = raw ? (f32x4){1.f, 1.f, 1.f, 1.f} : *(const f32x4*)(g + c + 4 * n), bvv = raw ? (f32x4){0.f, 0.f, 0.f, 0.f} : *(const f32x4*)(b + c + 4 * n);
                    const unsigned w0 = n ? cw.z : cw.x, w1 = n ? cw.w : cw.y;
                    const f32x4 cf = {__builtin_bit_cast(float, w0 << 16), __builtin_bit_cast(float, w0 & 0xffff0000u), __builtin_bit_cast(float, w1 << 16), __builtin_bit_cast(float, w1 & 0xffff0000u)};
                    const f32x4 x = (cf - mu) * rs * gvv + bvv;
                    const f32x4 t = x * alpha + acc[ai][bj][m][n];
                    const unsigned p0 = cvt_pk_bf16(t[0], t[1]), p1 = cvt_pk_bf16(t[2], t[3]); if (n) { wout.z = p0; wout.w = p1; } else { wout.x = p0; wout.y = p1; }
                    s += (t[0] + t[1]) + (t[2] + t[3]); q += (t[0] * t[0] + t[1] * t[1]) + (t[2] * t[2] + t[3] * t[3]);
                    if (shiftout && (r & 8191) == 8191) *(f32x4*)(shiftout + (size_t)(r >> 13) * 1024 + c + 4 * n) = x; }
                *(u32x4*)(XB + off) = wout; }
            s += __shfl_xor(s, 16); s += __shfl_xor(s, 32); q += __shfl_xor(q, 16); q += __shfl_xor(q, 32);
            if (fq == 0) P[(ai * HALF + wr * 64 + m * 16 + fr) * 4 + wc] = (f32x2e){s, q};
#pragma unroll
            for (int bj = 0; bj < 2; ++bj) cur[bj] = nxt[bj];
            sa = san; sb = sbn;
        }
        asm volatile("s_waitcnt lgkmcnt(0)" ::: "memory"); __builtin_amdgcn_s_barrier(); asm volatile("" ::: "memory");
        if (threadIdx.x < 256) { const int row = threadIdx.x; const f32x2e a = P[row * 4 + 0], b2 = P[row * 4 + 1], c = P[row * 4 + 2], d = P[row * 4 + 3];
            *(f32x2e*)(ostat + (size_t)(u.pm * BM + row) * 8 + u.pn * 2) = (f32x2e){(a.x + b2.x) + (c.x + d.x), (a.y + b2.y) + (c.y + d.y)}; }
        asm volatile("s_waitcnt lgkmcnt(0)" ::: "memory"); __builtin_amdgcn_s_barrier(); asm volatile("" ::: "memory");
    }
};
struct EpiUp {
    static constexpr bool PERM = true, AFTER_DRAIN = false;
    unsigned char* ws; int l;
    __device__ __forceinline__ void operator()(const f32x4 (&acc)[2][2][4][2], const Unit& u, int wr, int wc, int fr, int fq) const {
        asm volatile("" ::: "memory"); __builtin_amdgcn_sched_barrier(0);
        const float* stat = (const float*)(ws + WSO_STAT1); const float* c1 = (const float*)(ws + WSO_C1UP) + l * 4096; const float* c2 = (const float*)(ws + WSO_C2UP) + l * 4096; bf16_t* H = (bf16_t*)(ws + WSO_H);
        const int cb = u.pn * BM + wc * 32 + 8 * fq;
        float mu8[8], rs8[8];
#pragma unroll
        for (int gq = 0; gq < 8; ++gq) row_stats(stat, u.pm * BM + (gq >> 2) * HALF + wr * 64 + (gq & 3) * 16 + fr, mu8[gq], rs8[gq]);
#pragma unroll
        for (int bj = 0; bj < 2; ++bj) {
            f32x4 c1v[2], c2v[2];
#pragma unroll
            for (int n = 0; n < 2; ++n) { c1v[n] = *(const f32x4*)(c1 + cb + bj * HALF + 4 * n); c2v[n] = *(const f32x4*)(c2 + cb + bj * HALF + 4 * n); }
#pragma unroll
            for (int ai = 0; ai < 2; ++ai) {
#pragma unroll
                for (int m = 0; m < 4; ++m) {
                    const int r = u.pm * BM + ai * HALF + wr * 64 + m * 16 + fr;
                    const float mu = mu8[ai * 4 + m], rs = rs8[ai * 4 + m];
                    f32x4 v0 = (acc[ai][bj][m][0] - mu * c1v[0]) * rs + c2v[0], v1 = (acc[ai][bj][m][1] - mu * c1v[1]) * rs + c2v[1];
#pragma unroll
                    for (int e = 0; e < 4; ++e) { const float a = fmaxf(v0[e], 0.f), b = fmaxf(v1[e], 0.f); v0[e] = a * a; v1[e] = b * b; }
                    u32x4 w; w.x = cvt_pk_bf16(v0[0], v0[1]); w.y = cvt_pk_bf16(v0[2], v0[3]); w.z = cvt_pk_bf16(v1[0], v1[1]); w.w = cvt_pk_bf16(v1[2], v1[3]);
                    *(u32x4*)(H + (size_t)r * 4096 + cb + bj * HALF) = w; }
            }
        }
    }
};
template <class Epi, class Sched, bool ALIGN_EPI = false, bool SP2 = false>
__device__ __forceinline__ void gemm_phase(PG8_LAS unsigned char* lds, const Gemm g, const Sched& S, const Epi& E, const int tid) {
    const int wid = __builtin_amdgcn_readfirstlane(tid >> 6), lane = tid & 63, wr = wid >> 2, wc = wid & 3, fr = lane & 15, fq = lane >> 4;
    const int K = g.K, nt = K / BK;
    unsigned voffA[2], voffB[2];
#pragma unroll
    for (int i = 0; i < 2; ++i) { int R, C; stage_rc(tid * 16 + i * 8192, R, C); const int Rb = Epi::PERM ? ((R & ~31) + perm32(R & 31)) : R;
        voffA[i] = (unsigned)(R * K + C) * 2u; voffB[i] = (unsigned)(Rb * K + C) * 2u; }
    const size_t kstep = (size_t)(BK * 2);
    const size_t hstep = (size_t)HALF * K * 2;
    const size_t tstep = 2 * hstep;
    const unsigned ldsw = (unsigned)wid * 1024u;
    const int aoff = lds_byte(wr * 64 + fr, fq * 8), boff = lds_byte(wc * 32 + fr, fq * 8);
#define PG8_SA(b, h) (((b) * 2 + (h)) * HTB)
#define PG8_SB(b, h) ((4 + (b) * 2 + (h)) * HTB)
#define PG8_STAGE(bufoff, gbase, voff) do { _Pragma("unroll") for (int _i = 0; _i < 2; ++_i) \
        __builtin_amdgcn_global_load_lds((const unsigned*)((const char*)(gbase) + (voff)[_i]), (PG8_LAS unsigned*)(lds + (bufoff) + ldsw + _i * 8192), 16, 0, 0); } while (0)
#define PG8_LDA(dst, b, h) do { _Pragma("unroll") for (int m = 0; m < 4; ++m) _Pragma("unroll") for (int k = 0; k < 2; ++k) dst[m][k] = *(const PG8_LAS bf16x8*)(lds + PG8_SA(b, h) + aoff + m * 2048 + k * 1024); } while (0)
#define PG8_LDB(dst, b, h) do { _Pragma("unroll") for (int n = 0; n < 2; ++n) _Pragma("unroll") for (int k = 0; k < 2; ++k) dst[n][k] = *(const PG8_LAS bf16x8*)(lds + PG8_SB(b, h) + boff + n * 2048 + k * 1024); } while (0)
#define PG8_MMA(ai, bj, At, Bt) do { __builtin_amdgcn_s_setprio(1); _Pragma("unroll") for (int m = 0; m < 4; ++m) _Pragma("unroll") for (int n = 0; n < 2; ++n) _Pragma("unroll") for (int k = 0; k < 2; ++k) \
        acc[ai][bj][m][n] = __builtin_amdgcn_mfma_f32_16x16x32_bf16(Bt[n][k], At[m][k], acc[ai][bj][m][n], 0, 0, 0); __builtin_amdgcn_s_setprio(0); } while (0)
#define PG8_WAIT_V(n) asm volatile("s_waitcnt vmcnt(" #n ")" ::: "memory")
#define PG8_WAIT_L(n) asm volatile("s_waitcnt lgkmcnt(" #n ")" ::: "memory")
#define PG8_BAR __builtin_amdgcn_s_barrier()
#define PG8_SCHED __builtin_amdgcn_sched_barrier(0)
    Unit cur, nxt; int ui = 0;
    if (!S.next(0, cur)) return;
    f32x4 acc[2][2][4][2];
#pragma unroll
    for (int a = 0; a < 2; ++a)
#pragma unroll
        for (int b = 0; b < 2; ++b)
#pragma unroll
            for (int m = 0; m < 4; ++m)
#pragma unroll
                for (int n = 0; n < 2; ++n) acc[a][b][m][n] = (f32x4){0.f, 0.f, 0.f, 0.f};
    bf16x8 At[4][2], B0[2][2], B1[2][2];
    const char* cA = (const char*)g.A + (size_t)cur.pm * tstep; const char* cB = (const char*)g.Bt + (size_t)cur.pn * tstep;
    S.a_ready(cur);
    if constexpr (SP2) {
        PG8_STAGE(PG8_SB(0, 0), cB, voffB); PG8_STAGE(PG8_SB(0, 1), cB + hstep, voffB); PG8_STAGE(PG8_SA(0, 0), cA, voffA); PG8_STAGE(PG8_SA(0, 1), cA + hstep, voffA);
        if (wr == 1) PG8_BAR;
        PG8_WAIT_V(2); PG8_BAR;
        PG8_STAGE(PG8_SB(1, 0), cB + kstep, voffB); PG8_STAGE(PG8_SA(1, 0), cA + kstep, voffA); PG8_STAGE(PG8_SB(1, 1), cB + hstep + kstep, voffB);
        PG8_WAIT_V(6); PG8_BAR;
    } else {
        PG8_STAGE(PG8_SB(0, 0), cB, voffB); PG8_STAGE(PG8_SA(0, 0), cA, voffA); PG8_STAGE(PG8_SB(0, 1), cB + hstep, voffB); PG8_STAGE(PG8_SA(0, 1), cA + hstep, voffA);
        if (wr == 1) PG8_BAR;
        PG8_WAIT_V(4); PG8_BAR;
        PG8_STAGE(PG8_SB(1, 0), cB + kstep, voffB); PG8_STAGE(PG8_SA(1, 0), cA + kstep, voffA); PG8_STAGE(PG8_SB(1, 1), cB + hstep + kstep, voffB);
        PG8_WAIT_V(6); PG8_BAR;
    }
    for (;;) {
        const bool has_next = S.next(ui + 1, nxt);
        const char* nA = has_next ? (const char*)g.A + (size_t)nxt.pm * tstep : cA; const char* nB = has_next ? (const char*)g.Bt + (size_t)nxt.pn * tstep : cB;
        for (int t = 0; t < nt; t += 2) {
            const bool last = (t == nt - 2);
            const char* a1 = cA + (size_t)(t + 1) * kstep;
            const char* a2 = last ? nA : cA + (size_t)(t + 2) * kstep; const char* b2 = last ? nB : cB + (size_t)(t + 2) * kstep;
            const char* a3 = a2 + kstep; const char* b3 = b2 + kstep;
            if (last && has_next) S.a_ready(nxt);
            if constexpr (SP2) {
            PG8_LDB(B0, 0, 0); PG8_LDB(B1, 0, 1); PG8_SCHED; PG8_LDA(At, 0, 0); PG8_STAGE(PG8_SA(1, 1), a1 + hstep, voffA);
            PG8_WAIT_V(8); PG8_WAIT_L(0); PG8_BAR; PG8_MMA(0, 0, At, B0); PG8_MMA(0, 1, At, B1); PG8_BAR; PG8_SCHED;
            PG8_LDA(At, 0, 1); PG8_STAGE(PG8_SB(0, 0), b2, voffB); PG8_STAGE(PG8_SB(0, 1), b2 + hstep, voffB); PG8_STAGE(PG8_SA(0, 0), a2, voffA);
            PG8_WAIT_V(8); PG8_WAIT_L(0); PG8_BAR; PG8_MMA(1, 0, At, B0); PG8_MMA(1, 1, At, B1); PG8_BAR; PG8_SCHED;
            PG8_LDB(B0, 1, 0); PG8_LDB(B1, 1, 1); PG8_SCHED; PG8_LDA(At, 1, 0); PG8_STAGE(PG8_SA(0, 1), a2 + hstep, voffA);
            PG8_WAIT_V(8); PG8_WAIT_L(0); PG8_BAR; PG8_MMA(0, 0, At, B0); PG8_MMA(0, 1, At, B1); PG8_BAR; PG8_SCHED;
            PG8_LDA(At, 1, 1); PG8_STAGE(PG8_SB(1, 0), b3, voffB); PG8_STAGE(PG8_SB(1, 1), b3 + hstep, voffB); PG8_STAGE(PG8_SA(1, 0), a3, voffA);
            PG8_WAIT_V(8); PG8_WAIT_L(0); PG8_BAR; PG8_MMA(1, 0, At, B0); PG8_MMA(1, 1, At, B1); PG8_BAR; PG8_SCHED;
            } else {
            PG8_LDB(B0, 0, 0); PG8_SCHED; PG8_LDA(At, 0, 0); PG8_STAGE(PG8_SA(1, 1), a1 + hstep, voffA);
            PG8_WAIT_L(8); PG8_BAR; PG8_WAIT_L(0); PG8_MMA(0, 0, At, B0); PG8_BAR; PG8_SCHED;
            PG8_LDB(B1, 0, 1); PG8_STAGE(PG8_SB(0, 0), b2, voffB);
            PG8_BAR; PG8_WAIT_L(0); PG8_MMA(0, 1, At, B1); PG8_BAR;
            PG8_LDA(At, 0, 1); PG8_STAGE(PG8_SA(0, 0), a2, voffA);
            PG8_BAR; PG8_WAIT_L(0); PG8_MMA(1, 0, At, B0); PG8_BAR; PG8_SCHED;
            PG8_STAGE(PG8_SB(0, 1), b2 + hstep, voffB);
            PG8_WAIT_V(6); PG8_BAR; PG8_MMA(1, 1, At, B1); PG8_BAR;
            PG8_LDB(B0, 1, 0); PG8_SCHED; PG8_LDA(At, 1, 0); PG8_STAGE(PG8_SA(0, 1), a2 + hstep, voffA);
            PG8_WAIT_L(8); PG8_BAR; PG8_WAIT_L(0); PG8_MMA(0, 0, At, B0); PG8_BAR; PG8_SCHED;
            PG8_LDB(B1, 1, 1); PG8_STAGE(PG8_SB(1, 0), b3, voffB);
            PG8_BAR; PG8_WAIT_L(0); PG8_MMA(0, 1, At, B1); PG8_BAR;
            PG8_LDA(At, 1, 1); PG8_STAGE(PG8_SA(1, 0), a3, voffA);
            PG8_BAR; PG8_WAIT_L(0); PG8_MMA(1, 0, At, B0); PG8_BAR; PG8_SCHED;
            PG8_STAGE(PG8_SB(1, 1), b3 + hstep, voffB);
            PG8_WAIT_V(6); PG8_BAR; PG8_MMA(1, 1, At, B1); PG8_BAR;
            }
        }
        if constexpr (ALIGN_EPI) { if (wr == 0) PG8_BAR; }
        if constexpr (!Epi::AFTER_DRAIN) { E(acc, cur, wr, wc, fr, fq); S.done(cur); }
        if (!has_next) break;
#pragma unroll
        for (int a = 0; a < 2; ++a)
#pragma unroll
            for (int b = 0; b < 2; ++b)
#pragma unroll
                for (int m = 0; m < 4; ++m)
#pragma unroll
                    for (int n = 0; n < 2; ++n) acc[a][b][m][n] = (f32x4){0.f, 0.f, 0.f, 0.f};
        cur = nxt; cA = nA; cB = nB; ++ui;
        if constexpr (ALIGN_EPI) { if (wr == 1) PG8_BAR; }
    }
    PG8_WAIT_V(0);
    if constexpr (!ALIGN_EPI) { if (wr == 0) PG8_BAR; }
    PG8_BAR;
    if constexpr (Epi::AFTER_DRAIN) { E.fused(acc, cur, wr, wc, fr, fq, lds, wid, lane); S.done(cur); }
#undef PG8_SA
#undef PG8_SB
#undef PG8_STAGE
#undef PG8_LDA
#undef PG8_LDB
#undef PG8_MMA
#undef PG8_WAIT_V
#undef PG8_WAIT_L
#undef PG8_BAR
#undef PG8_SCHED
}
}
constexpr int NWAVES = 8;
constexpr int M = 16384, TSEQ = 8192, DM = 1024, FFD = 4096, DEPTH = 4, MD = 32, NH = 8, HD = 64;
constexpr int NIN = 3584;
constexpr int RW0 = 1536;
constexpr int PRP = 2048;
constexpr int NRWU = 1856;
constexpr int CH = 16, NCH = TSEQ / CH;
constexpr int NUNIT = 2 * NH * NCH;
constexpr float LN_EPS = 1e-5f, GN_EPS = 64e-5f, RMS_EPS = 1e-6f;
constexpr float ALPHA = 1.6817928305074290f;
constexpr float QSCALE = 0.125f * 1.4426950408889634f;
constexpr size_t O_Y = 0, O_YS = 16777216, O_SHP = 16809984, O_SHS = 16818176, O_WKP = 16949248, O_WKS = 17211392,
                 O_KP = 21405696, O_VP = 29794304, O_KS = 38182912, O_VS = 38248448, O_END = 38313984;
constexpr size_t MiB = 1u << 20;
constexpr size_t WS_CTL = 0, CTL_ZERO_BYTES = 1 * MiB;
constexpr size_t WS_C1IN = 1 * MiB;
constexpr size_t WS_C2IN = WS_C1IN + 4 * NIN * 4;
constexpr size_t WS_C1UP = WS_C2IN + 4 * NIN * 4;
constexpr size_t WS_C2UP = WS_C1UP + 4 * FFD * 4;
constexpr size_t WS_DUPT = WS_C2UP + 4 * FFD * 4;
constexpr size_t WS_IUPT = WS_DUPT + 4 * 512 * 64 * 2;
constexpr size_t WS_GUPT = WS_IUPT + 4 * 512 * 64 * 2;
constexpr size_t WS_VUPT = WS_GUPT + 4 * 512 * 128 * 2;
constexpr size_t WS_SMALL_END = WS_VUPT + 3 * 512 * 32 * 2;
static_assert(WS_SMALL_END <= 3 * MiB, "small region");
constexpr size_t WS_ROPE = 3 * MiB;
constexpr size_t WS_DEC = 6 * MiB;
constexpr size_t WS_STAT1 = 8 * MiB, WS_STAT2 = 9 * MiB;
constexpr size_t WS_BON = 10 * MiB;
constexpr size_t WS_LSE = 11 * MiB;
constexpr size_t WS_GC = 13 * MiB;
constexpr size_t WS_WIN = 16 * MiB;
constexpr size_t WS_WINU = 44 * MiB;
constexpr size_t WS_WOUT = 60 * MiB;
constexpr size_t WS_WUP = 68 * MiB;
constexpr size_t WS_WDN = 100 * MiB;
constexpr size_t WS_XB2 = 132 * MiB;
constexpr size_t WS_XB1 = 164 * MiB;
constexpr size_t WS_T1 = 196 * MiB;
constexpr size_t WS_T2 = 260 * MiB;
constexpr size_t WS_QB = 324 * MiB, WS_KB = 340 * MiB, WS_VB = 356 * MiB;
constexpr size_t WS_PR = 372 * MiB;
constexpr size_t WS_OP = 436 * MiB;
constexpr size_t WS_MIX = 484 * MiB;
constexpr size_t WS_VF = 516 * MiB, WS_VV = 532 * MiB;
constexpr size_t WS_YPRE = 548 * MiB;
constexpr size_t WS_H = 580 * MiB;
constexpr size_t WS_PT = 580 * MiB;
constexpr size_t WS_QT = 644 * MiB;
constexpr size_t WS_REFF = 708 * MiB;
constexpr size_t WS_YLOC = 724 * MiB;
constexpr size_t WS_SEGQ = 756 * MiB, WS_SEGP = 760 * MiB;
constexpr size_t WS_CSUM = 764 * MiB;
constexpr size_t WS_CSUP = 766 * MiB;
constexpr size_t WS_END = 768 * MiB;
static_assert(WS_H + (size_t)M * FFD * 2 <= WS_END + 0 * MiB || true, "");
constexpr size_t DEC_XB2 = 0;
constexpr size_t DEC_XB1 = 64 * 1024;
constexpr size_t DEC_SHB = 128 * 1024;
constexpr size_t DEC_MIXB = 384 * 1024;
constexpr size_t DEC_HB = 448 * 1024;
constexpr size_t DEC_T1 = 704 * 1024;
constexpr size_t DEC_T2 = 832 * 1024;
constexpr size_t DEC_PD = 960 * 1024;
constexpr size_t DEC_PS = 1408 * 1024;
constexpr size_t DEC_OP = 1640 * 1024;
constexpr size_t DEC_LSE = 1832 * 1024;
constexpr size_t DEC_MIX = 1836 * 1024;
constexpr size_t DEC_ST1 = 1964 * 1024;
constexpr size_t DEC_ST2 = 1972 * 1024;
constexpr size_t DEC_VF = 1980 * 1024;
static_assert(DEC_VF + 32 * 512 * 4 <= 2 * MiB, "decode scratch");
constexpr int CW_BAR = 4096;
constexpr int RING_BYTES = 131072;
constexpr int MISC_OFF = RING_BYTES + 320;
constexpr int LDS_BYTES = 147456;
static_assert(pg8::WSO_C1IN == WS_C1IN && pg8::WSO_C2IN == WS_C2IN && pg8::WSO_C1UP == WS_C1UP && pg8::WSO_C2UP == WS_C2UP && pg8::WSO_ROPE == WS_ROPE && pg8::WSO_STAT1 == WS_STAT1 && pg8::WSO_STAT2 == WS_STAT2 &&
              pg8::WSO_XB2 == WS_XB2 && pg8::WSO_XB1 == WS_XB1 && pg8::WSO_T1 == WS_T1 && pg8::WSO_T2 == WS_T2 && pg8::WSO_QB == WS_QB && pg8::WSO_KB == WS_KB && pg8::WSO_VB == WS_VB && pg8::WSO_PR == WS_PR && pg8::WSO_H == WS_H &&
              pg8::OO_SHP == O_SHP && pg8::OO_KP == O_KP && pg8::OO_VP == O_VP, "epilogue offset mirrors");
#define GAS __attribute__((address_space(1)))
#define LAS __attribute__((address_space(3)))
typedef unsigned short bf16;
typedef unsigned v4u __attribute__((ext_vector_type(4)));
typedef unsigned v2u __attribute__((ext_vector_type(2)));
typedef float f32x4 __attribute__((ext_vector_type(4)));
typedef float f32x2 __attribute__((ext_vector_type(2)));
typedef float f32x16 __attribute__((ext_vector_type(16)));
typedef short bf16x8 __attribute__((ext_vector_type(8)));
typedef short s16x4 __attribute__((ext_vector_type(4)));
typedef GAS unsigned gu32;
#define RLX_AGENT __ATOMIC_RELAXED, __HIP_MEMORY_SCOPE_AGENT
#define LDS_WAIT() asm volatile("s_waitcnt lgkmcnt(0)" ::: "memory")
#define VM_WAIT() asm volatile("s_waitcnt vmcnt(0)" ::: "memory")
#define DI __device__ __forceinline__
DI unsigned f2bf(float f) { unsigned u = __builtin_bit_cast(unsigned, f); return (u + 0x7fffu + ((u >> 16) & 1u)) >> 16; }
DI float bf2f(unsigned b) { return __builtin_bit_cast(float, b << 16); }
DI float bflo(unsigned w) { return __builtin_bit_cast(float, w << 16); }
DI float bfhi(unsigned w) { return __builtin_bit_cast(float, w & 0xffff0000u); }
typedef __bf16 bf16x2_t __attribute__((ext_vector_type(2)));
DI unsigned pk2(float lo, float hi) { const f32x2 v = {lo, hi}; const bf16x2_t b = __builtin_convertvector(v, bf16x2_t); return __builtin_bit_cast(unsigned, b); }
DI unsigned pk2z(float x) { return pk2(x, 0.f) & 0xffffu; }
DI float rbf(float x) { return bf2f(f2bf(x)); }
DI bf16x8 pk8(float a0, float a1, float a2, float a3, float a4, float a5, float a6, float a7) {
    v4u w; w.x = pk2(a0, a1); w.y = pk2(a2, a3); w.z = pk2(a4, a5); w.w = pk2(a6, a7); return __builtin_bit_cast(bf16x8, w); }
DI bf16x8 pk8v(f32x4 a, f32x4 b) { return pk8(a[0], a[1], a[2], a[3], b[0], b[1], b[2], b[3]); }
DI bf16x8 pk4z(f32x4 a) { v4u w; w.x = pk2(a[0], a[1]); w.y = pk2(a[2], a[3]); w.z = 0u; w.w = 0u; return __builtin_bit_cast(bf16x8, w); }
DI bf16x8 ld8(const void* p) { return *(const bf16x8*)p; }
DI bf16x8 ld4z(const void* p) { v2u t = *(const v2u*)p; v4u w; w.x = t.x; w.y = t.y; w.z = 0u; w.w = 0u; return __builtin_bit_cast(bf16x8, w); }
DI f32x4 mfma16(bf16x8 a, bf16x8 b, f32x4 c) { return __builtin_amdgcn_mfma_f32_16x16x32_bf16(a, b, c, 0, 0, 0); }
DI f32x16 mfma32(bf16x8 a, bf16x8 b, f32x16 c) { return __builtin_amdgcn_mfma_f32_32x32x16_bf16(a, b, c, 0, 0, 0); }
DI int crow(int r, int hi) { return (r & 3) + 8 * (r >> 2) + 4 * hi; }
DI float wave_sum(float v) {
#pragma unroll
    for (int o = 1; o < 64; o <<= 1) v += __shfl_xor(v, o);
    return v; }
DI float fexp(float x) { return __expf(x); }
DI float fsigmoid(float x) { return __builtin_amdgcn_rcpf(1.f + __expf(-x)); }
DI float ftanh(float x) { return 1.f - 2.f * __builtin_amdgcn_rcpf(__expf(2.f * x) + 1.f); }
DI float fsoftplus(float x) { return fmaxf(x, 0.f) + __logf(1.f + __expf(-fabsf(x))); }
DI int orig2lgcl(int o) { return (o & ~63) | (((o >> 4) & 1) << 5) | (((o >> 2) & 3) << 3) | (((o >> 5) & 1) << 2) | (o & 3); }
DI int lgcl2orig(int c) { return (c & ~63) | (((c >> 2) & 1) << 5) | (((c >> 5) & 1) << 4) | (((c >> 3) & 3) << 2) | (c & 3); }
#define XB_TMO      128
#define XB_XCNT(j)  (256  + 64 * (j))
#define XB_XSUB(j)  (1280 + 64 * (j))
#define XB_XGEN(j)  (2304 + 64 * (j))
#define XB_TOP      3328
#define XB_TOPGEN   3392
#define XCD_BAR_WORDS 3456
#define XB_SPIN_CAP (1u << 18)

__device__ __forceinline__ unsigned xb_ld(unsigned* p)              { return __hip_atomic_load(p, __ATOMIC_RELAXED, __HIP_MEMORY_SCOPE_AGENT); }
__device__ __forceinline__ unsigned xb_add(unsigned* p, unsigned v) { return __hip_atomic_fetch_add(p, v, __ATOMIC_RELAXED, __HIP_MEMORY_SCOPE_AGENT); }
__device__ __forceinline__ unsigned xb_xcc_id() { return (unsigned)__builtin_amdgcn_s_getreg((3 << 11) | 20) & 0xFu; }
#define XB_SPIN(cond, bar) do { unsigned _sp = 0; while (cond) { __builtin_amdgcn_s_sleep(1); \
    if ((++_sp & 255u) == 0u) { if (xb_ld(&(bar)[XB_TMO])) break; if (_sp > XB_SPIN_CAP) { atomicAdd(&(bar)[XB_TMO], 1u); break; } } } } while (0)

struct XcdBarrier {
    unsigned* bar; unsigned x;
    volatile LAS unsigned* st;
};

__device__ __forceinline__ XcdBarrier xcd_barrier_post(unsigned* bar, volatile LAS unsigned* st) {
    XcdBarrier b; b.bar = bar; b.x = xb_xcc_id(); b.st = st;
    if (threadIdx.x == 0) (void)xb_add(&bar[XB_XCNT(b.x)], 1u);
    return b;
}
__device__ __forceinline__ void xcd_barrier_complete(unsigned* bar, unsigned x, unsigned& nloc, unsigned& nx) {
    const unsigned G = gridDim.x * gridDim.y * gridDim.z;
    unsigned sum, cnt, mine, sp = 0u;
    for (;;) {
        sum = 0u; cnt = 0u; mine = 0u;
#pragma unroll
        for (unsigned j = 0; j < 16; ++j) { const unsigned c = xb_ld(&bar[XB_XCNT(j)]); sum += c; cnt += (c > 0u) ? 1u : 0u; mine = (j == x) ? c : mine; }
        if (sum == G) break;
        __builtin_amdgcn_s_sleep(1);
        if ((++sp & 255u) == 0u) { if (xb_ld(&bar[XB_TMO])) break; if (sp > XB_SPIN_CAP) { atomicAdd(&bar[XB_TMO], 1u); break; } }
    }
    nloc = mine > 0u ? mine : 1u; nx = cnt > 0u ? cnt : 1u;
}

__device__ __forceinline__ void xcd_barrier(const XcdBarrier& b) {
    asm volatile("s_waitcnt vmcnt(0)" ::: "memory");
    __syncthreads();
    if (threadIdx.x == 0) {
        unsigned* bar = b.bar;
        __builtin_amdgcn_s_waitcnt(0);
        unsigned nloc = b.st[0], nx = b.st[1];
        if (nloc == 0u) { xcd_barrier_complete(bar, b.x, nloc, nx); b.st[0] = nloc; b.st[1] = nx; }
        const unsigned old = xb_add(&bar[XB_XSUB(b.x)], 1u);
        const unsigned gen = old / nloc;
        if (old + 1u == (gen + 1u) * nloc) {
            __builtin_amdgcn_fence(__ATOMIC_RELEASE, "agent");
            asm volatile("s_waitcnt vmcnt(0)" ::: "memory");
            const unsigned og = xb_add(&bar[XB_TOP], 1u);
            const unsigned tg = og / nx;
            if (og + 1u == (tg + 1u) * nx) xb_add(&bar[XB_TOPGEN], 1u);
            else XB_SPIN(xb_ld(&bar[XB_TOPGEN]) == tg, bar);
            __builtin_amdgcn_fence(__ATOMIC_ACQUIRE, "agent");
            xb_add(&bar[XB_XGEN(b.x)], 1u);
            asm volatile("s_waitcnt vmcnt(0)" ::: "memory");
        } else {
            XB_SPIN(xb_ld(&bar[XB_XGEN(b.x)]) == gen, bar);
            __builtin_amdgcn_fence(__ATOMIC_ACQUIRE, "agent");
            asm volatile("s_waitcnt vmcnt(0)" ::: "memory");
        }
    }
    __syncthreads();
}
struct Args { const float* in[30]; float* out; unsigned char* ws; };
struct Frame {
    unsigned char* lds;
    volatile LAS unsigned* MISC;
    gu32* ctl;
    int tid, lane, wave, vcu, G, gw, NGW;
    const float* const* in; float* out; unsigned char* ws;
};
template <bool SWAP>
DI void p0_transpose_item(const float* W, int ldw, int K, int csrc0, bf16* WT, int row_off, const float* gsc, LAS float* scr, int kb, int nb, int lane, float* csum = nullptr, int ncs = 0, const float* bsh = nullptr) {
    const int k0 = 64 * kb, n0 = 32 * nb;
    float s1 = 0.f, s2 = 0.f;
    float wv[32], gk = 1.f, bk = 0.f;
#pragma unroll
    for (int i = 0; i < 32; ++i) wv[i] = W[(size_t)(k0 + 2 * i + (lane >> 5)) * ldw + csrc0 + n0 + (lane & 31)];
    if (gsc) gk = gsc[k0 + lane]; if (bsh) bk = bsh[k0 + lane];
#pragma unroll
    for (int i = 0; i < 32; ++i) { const int kk = 2 * i + (lane >> 5); float v = wv[i]; s2 += v * __shfl(bk, kk); v *= __shfl(gk, kk); s1 += rbf(v); scr[kk * 33 + (lane & 31)] = v; }
    if (csum) { s1 += __shfl_xor(s1, 32); s2 += __shfl_xor(s2, 32); if (lane < 32) { int dr = n0 + lane; if (SWAP) dr = orig2lgcl(dr); csum[(size_t)(kb * 2 + 0) * ncs + row_off + dr] = s1; csum[(size_t)(kb * 2 + 1) * ncs + row_off + dr] = s2; } }
    LDS_WAIT(); asm volatile("" ::: "memory");
    const int c = lane & 7;
#pragma unroll
    for (int j = 0; j < 4; ++j) { const int n = (lane >> 3) + 8 * j; const LAS float* s = scr + (8 * c) * 33 + n;
        v4u o; o.x = pk2(s[0 * 33], s[1 * 33]); o.y = pk2(s[2 * 33], s[3 * 33]); o.z = pk2(s[4 * 33], s[5 * 33]); o.w = pk2(s[6 * 33], s[7 * 33]);
        int dr = n0 + n; if (SWAP) dr = orig2lgcl(dr);
        *(v4u*)(WT + (size_t)(row_off + dr) * K + k0 + 8 * c) = o; }
    LDS_WAIT(); asm volatile("" ::: "memory");
}
DI void p0_prologue(Frame& F) {
    LAS float* scr = (LAS float*)((LAS unsigned char*)F.lds + F.wave * 16384);
    const float* const* in = F.in; unsigned char* ws = F.ws;
    constexpr int I_IN = 16 * 104, I_VR = 16, I_INU = 16 * 56, I_OUT = 16 * 32, I_UP = 16 * 128, I_DN = 64 * 32;
    constexpr int I_L = I_IN + I_VR + I_INU + I_VR + I_OUT + I_UP + I_DN;
    for (int it = F.gw; it < DEPTH * I_L; it += F.NGW) {
        const int l = it / I_L; int r = it % I_L;
        const float* g2p = l > 0 ? in[28] + (size_t)(l - 1) * DM : nullptr;
        bf16* win = (bf16*)(ws + WS_WIN) + (size_t)l * NIN * DM; bf16* winu = (bf16*)(ws + WS_WINU) + (size_t)l * NRWU * DM;
        if (r < I_IN) { const int kb = r / 104, nb = r % 104; const float* W = in[6] + (size_t)l * DM * 3328;
            float* cs = l > 0 ? (float*)(ws + WS_CSUM) + (size_t)l * 32 * NIN : nullptr; const float* b2p = l > 0 ? in[29] + (size_t)(l - 1) * DM : nullptr;
            if (nb < 32) p0_transpose_item<true>(W, 3328, DM, 0, win, 0, g2p, scr, kb, nb, F.lane, cs, NIN, b2p); else p0_transpose_item<false>(W, 3328, DM, 0, win, 0, g2p, scr, kb, nb, F.lane, cs, NIN, b2p); continue; } r -= I_IN;
        if (r < I_VR) { if (l > 0) p0_transpose_item<false>(in[7] + (size_t)(l - 1) * DM * 32, 32, DM, 0, win, 3328, g2p, scr, r, 0, F.lane, (float*)(ws + WS_CSUM) + (size_t)l * 32 * NIN, NIN, in[29] + (size_t)(l - 1) * DM); continue; } r -= I_VR;
        if (r < I_INU) { const int kb = r / 56, nb = r % 56; p0_transpose_item<false>(in[6] + (size_t)l * DM * 3328, 3328, DM, RW0, winu, 0, nullptr, scr, kb, nb, F.lane); continue; } r -= I_INU;
        if (r < I_VR) { if (l > 0) p0_transpose_item<false>(in[7] + (size_t)(l - 1) * DM * 32, 32, DM, 0, winu, 1792, nullptr, scr, r, 0, F.lane); continue; } r -= I_VR;
        if (r < I_OUT) { p0_transpose_item<false>(in[23] + (size_t)l * DM * DM, DM, DM, 0, (bf16*)(ws + WS_WOUT) + (size_t)l * DM * DM, 0, nullptr, scr, r / 32, r % 32, F.lane); continue; } r -= I_OUT;
        if (r < I_UP) { p0_transpose_item<false>(in[26] + (size_t)l * DM * FFD, FFD, DM, 0, (bf16*)(ws + WS_WUP) + (size_t)l * FFD * DM, 0, in[24] + (size_t)l * DM, scr, r / 128, r % 128, F.lane, (float*)(ws + WS_CSUP) + (size_t)l * 32 * FFD, FFD, in[25] + (size_t)l * DM); continue; } r -= I_UP;
        p0_transpose_item<false>(in[27] + (size_t)l * FFD * DM, DM, FFD, 0, (bf16*)(ws + WS_WDN) + (size_t)l * DM * FFD, 0, nullptr, scr, r / 32, r % 32, F.lane);
    }
    for (int m0 = F.gw; m0 < M; m0 += 4 * F.NGW) { f32x4 v[4][4];
#pragma unroll
        for (int q = 0; q < 4; ++q) { const f32x4* xr = (const f32x4*)(in[0] + (size_t)(m0 + q * F.NGW) * DM) + F.lane;
#pragma unroll
            for (int j = 0; j < 4; ++j) v[q][j] = xr[64 * j]; }
#pragma unroll
        for (int q = 0; q < 4; ++q) { unsigned long long* o8 = (unsigned long long*)((bf16*)(ws + WS_XB2) + (size_t)(m0 + q * F.NGW) * DM) + F.lane;
#pragma unroll
            for (int j = 0; j < 4; ++j) o8[64 * j] = (unsigned long long)pk2(v[q][j].x, v[q][j].y) | ((unsigned long long)pk2(v[q][j].z, v[q][j].w) << 32); } }
    const int gt = F.gw * 64 + F.lane, NGT = F.NGW * 64;
    for (int e = gt; e < 8193 * 32; e += NGT) { const int pos = e >> 5, i = e & 31; const double ang = (double)pos * pow(10000.0, -(double)i / 32.0); ((f32x2*)(ws + WS_ROPE))[e] = (f32x2){(float)cos(ang), (float)sin(ang)}; }
    for (int e = gt; e < 4 * 512 * 64; e += NGT) { const int l = e / (512 * 64), n = (e / 64) % 512, m = e % 64; ((bf16*)(ws + WS_DUPT))[e] = (bf16)f2bf(in[11][((size_t)l * 64 + m) * 512 + n]); ((bf16*)(ws + WS_IUPT))[e] = (bf16)f2bf(in[13][((size_t)l * 64 + m) * 512 + n]); }
    for (int e = gt; e < 4 * 512 * 128; e += NGT) { const int l = e / (512 * 128), n = (e / 128) % 512, m = e % 128; ((bf16*)(ws + WS_GUPT))[e] = (bf16)f2bf(in[14][((size_t)l * 128 + m) * 512 + n]); }
    for (int e = gt; e < 3 * 512 * 32; e += NGT) { const int l = e / (512 * 32), n = (e / 32) % 512, m = e % 32; ((bf16*)(ws + WS_VUPT))[e] = (bf16)f2bf(in[16][((size_t)l * 32 + m) * 512 + n]); }
    for (int e = gt; e < 2 * DM; e += NGT) F.out[O_SHP + e] = in[0][((size_t)(e / DM) * TSEQ + TSEQ - 1) * DM + (e % DM)];
    for (int e = gt; e < MD * DM; e += NGT) { ((bf16*)(ws + WS_DEC + DEC_XB2))[e] = (bf16)f2bf(in[1][e]); }
    for (int e = gt; e < DEPTH * MD * DM; e += NGT) { ((bf16*)(ws + WS_DEC + DEC_SHB))[e] = (bf16)f2bf(in[2][e]); }
}
DI void colsum_finish(unsigned char* ws, int gt, int NGT) {
    for (int e = gt; e < 3 * NIN; e += NGT) { const int l = 1 + e / NIN, p = e % NIN; if (p >= 3360) continue; const float* cs = (const float*)(ws + WS_CSUM) + (size_t)l * 32 * NIN + p; float s1 = 0.f, s2 = 0.f;
#pragma unroll
        for (int kb = 0; kb < 16; ++kb) { s1 += cs[(size_t)(2 * kb) * NIN]; s2 += cs[(size_t)(2 * kb + 1) * NIN]; }
        ((float*)(ws + WS_C1IN))[l * NIN + p] = s1; ((float*)(ws + WS_C2IN))[l * NIN + p] = s2; }
    for (int e = gt; e < 4 * FFD; e += NGT) { const int l = e / FFD, p = e % FFD; const float* cs = (const float*)(ws + WS_CSUP) + (size_t)l * 32 * FFD + p; float s1 = 0.f, s2 = 0.f;
#pragma unroll
        for (int kb = 0; kb < 16; ++kb) { s1 += cs[(size_t)(2 * kb) * FFD]; s2 += cs[(size_t)(2 * kb + 1) * FFD]; }
        ((float*)(ws + WS_C1UP))[l * FFD + p] = s1; ((float*)(ws + WS_C2UP))[l * FFD + p] = s2; }
}
constexpr int VPITCH = 144;
constexpr int ATT_WLDS = 2 * 32 * VPITCH + 256;
DI void tr_read8(unsigned base, s16x4 (&t)[8]) {
    asm volatile("ds_read_b64_tr_b16 %0, %8\n\tds_read_b64_tr_b16 %1, %8 offset:%c9\n\tds_read_b64_tr_b16 %2, %8 offset:%c10\n\tds_read_b64_tr_b16 %3, %8 offset:%c11\n\t"
                 "ds_read_b64_tr_b16 %4, %8 offset:%c12\n\tds_read_b64_tr_b16 %5, %8 offset:%c13\n\tds_read_b64_tr_b16 %6, %8 offset:%c14\n\tds_read_b64_tr_b16 %7, %8 offset:%c15\n\ts_waitcnt lgkmcnt(0)"
                 : "=&v"(t[0]), "=&v"(t[1]), "=&v"(t[2]), "=&v"(t[3]), "=&v"(t[4]), "=&v"(t[5]), "=&v"(t[6]), "=&v"(t[7])
                 : "v"(base), "i"(8 * VPITCH), "i"(64), "i"(8 * VPITCH + 64), "i"(16 * VPITCH), "i"(24 * VPITCH), "i"(16 * VPITCH + 64), "i"(24 * VPITCH + 64) : "memory");
}
DI void attn_task(const bf16* QB, const bf16* KB, const bf16* VB, bf16* OP, float* LSE, int b, int h, int p, int cls, int qblk, LAS unsigned char* wl, int lane) {
    asm volatile("" : "+v"(lane));
    const int dd = 1 << (2 * p), r32 = lane & 31, hi = lane >> 5;
    const int m0 = 32 * qblk;
    const size_t rowb = (size_t)b * TSEQ;
    const size_t qrow = rowb + (size_t)(m0 + r32) * dd + cls;
    bf16x8 qf[4];
#pragma unroll
    for (int d0 = 0; d0 < 4; ++d0) qf[d0] = ld8(QB + qrow * 512 + h * 64 + d0 * 16 + hi * 8);
    f32x16 s[5];
    const int kt0 = (m0 >= 128) ? 0 : (128 - m0) / 32;
    const int krow8 = lane >> 3, kch = lane & 7;
    v4u kr[5][4];
#pragma unroll
    for (int kt = 0; kt < 5; ++kt)
#pragma unroll
        for (int i_ = 0; i_ < 4; ++i_) { const int mk = m0 - 128 + 32 * kt + 8 * i_ + krow8; const size_t krow = rowb + (size_t)(mk < 0 ? 0 : mk) * dd + cls;
            kr[kt][i_] = *(const v4u*)(KB + krow * 512 + h * 64 + kch * 8); }
#pragma unroll
    for (int kt = 0; kt < 5; ++kt) {
        LAS unsigned char* kb = wl + (kt & 1) * 32 * VPITCH;
#pragma unroll
        for (int i_ = 0; i_ < 4; ++i_) *(LAS v4u*)(kb + (8 * i_ + krow8) * VPITCH + kch * 16) = kr[kt][i_];
        LDS_WAIT();
        bf16x8 kf[4];
#pragma unroll
        for (int d0 = 0; d0 < 4; ++d0) kf[d0] = *(const LAS bf16x8*)(kb + r32 * VPITCH + d0 * 32 + hi * 16);
        f32x16 a; for (int i = 0; i < 16; ++i) a[i] = 0.f;
#pragma unroll
        for (int d0 = 0; d0 < 4; ++d0) a = mfma32(kf[d0], qf[d0], a);
        s[kt] = a;
    }
    LDS_WAIT();
#pragma unroll
    for (int kt = 0; kt < 5; ++kt) {
        if (kt < kt0) {
#pragma unroll
            for (int i = 0; i < 16; ++i) s[kt][i] = -INFINITY;
        } else if (kt == 0) {
#pragma unroll
            for (int i = 0; i < 16; ++i) s[kt][i] = (crow(i, hi) >= r32) ? s[kt][i] : -INFINITY;
        } else if (kt == 4) {
#pragma unroll
            for (int i = 0; i < 16; ++i) s[kt][i] = (crow(i, hi) <= r32) ? s[kt][i] : -INFINITY;
        }
    }
    float mx = -INFINITY;
#pragma unroll
    for (int kt = 0; kt < 5; ++kt)
#pragma unroll
        for (int i = 0; i < 16; ++i) mx = fmaxf(mx, s[kt][i]);
    mx = fmaxf(mx, __shfl_xor(mx, 32));
    float lsum = 0.f;
#pragma unroll
    for (int kt = 0; kt < 5; ++kt)
#pragma unroll
        for (int i = 0; i < 16; ++i) { const float e = __builtin_amdgcn_exp2f(s[kt][i] - mx); s[kt][i] = e; lsum += e; }
    lsum += __shfl_xor(lsum, 32);
    f32x16 o[2]; for (int i = 0; i < 16; ++i) { o[0][i] = 0.f; o[1][i] = 0.f; }
    LAS float* wsf = (LAS float*)(wl + 2 * 32 * VPITCH);
    const unsigned vb0 = (unsigned)(uintptr_t)wl;
    const int g = lane >> 4, i16 = lane & 15, qq = i16 >> 2, pp = i16 & 3;
    const unsigned traddr = (unsigned)((4 * (g >> 1) + qq) * VPITCH + (16 * (g & 1) + 4 * pp) * 2);
    const int vrow8 = lane >> 3, vch = lane & 7;
    v4u vr[4];
#define ATT_LOADV(KT) do { _Pragma("unroll") for (int i_ = 0; i_ < 4; ++i_) { const int mk_ = m0 - 128 + 32 * (KT) + 8 * i_ + vrow8; const size_t vrow_ = rowb + (size_t)mk_ * dd + cls; \
        vr[i_] = *(const v4u*)(VB + vrow_ * 512 + h * 64 + vch * 8); } } while (0)
    ATT_LOADV(kt0);
#pragma unroll
    for (int kt = 0; kt < 5; ++kt) {
        if (kt >= kt0) {
            LAS unsigned char* vb = wl + (kt & 1) * 32 * VPITCH;
#pragma unroll
            for (int i_ = 0; i_ < 4; ++i_) *(LAS v4u*)(vb + (8 * i_ + vrow8) * VPITCH + vch * 16) = vr[i_];
            if (kt + 1 < 5) ATT_LOADV(kt + 1);
            LDS_WAIT();
            const unsigned base = vb0 + (unsigned)((kt & 1) * 32 * VPITCH) + traddr;
            s16x4 t[8];
            tr_read8(base, t);
#pragma unroll
            for (int ss = 0; ss < 2; ++ss) {
                const bf16x8 pa = pk8(s[kt][8 * ss], s[kt][8 * ss + 1], s[kt][8 * ss + 2], s[kt][8 * ss + 3], s[kt][8 * ss + 4], s[kt][8 * ss + 5], s[kt][8 * ss + 6], s[kt][8 * ss + 7]);
#pragma unroll
                for (int db = 0; db < 2; ++db) { const bf16x8 vf = __builtin_shufflevector(t[4 * ss + 2 * db], t[4 * ss + 2 * db + 1], 0, 1, 2, 3, 4, 5, 6, 7); o[db] = mfma32(pa, vf, o[db]); }
            }
        }
    }
#undef ATT_LOADV
    if (hi == 0) { wsf[r32] = __builtin_amdgcn_rcpf(lsum); LSE[((size_t)p * M + qrow) * 8 + h] = mx + __builtin_amdgcn_logf(lsum); }
    LDS_WAIT();
#pragma unroll
    for (int i = 0; i < 16; ++i) { const int q = crow(i, hi); const float li = wsf[q];
        *(LAS bf16*)(wl + q * VPITCH + r32 * 2) = (bf16)pk2z(o[0][i] * li); *(LAS bf16*)(wl + q * VPITCH + 64 + r32 * 2) = (bf16)pk2z(o[1][i] * li); }
    LDS_WAIT();
    { const int orow8 = lane >> 3, och = lane & 7;
#pragma unroll
      for (int i_ = 0; i_ < 4; ++i_) { const v4u w = *(const LAS v4u*)(wl + (8 * i_ + orow8) * VPITCH + och * 16); const size_t orow = rowb + (size_t)(m0 + 8 * i_ + orow8) * dd + cls;
          *(v4u*)(OP + ((size_t)p * M + orow) * 512 + h * 64 + och * 8) = w; } }
    LDS_WAIT();
}
DI void attn_finalize_row(const bf16* OP, const float* LSE, const float* gain, bf16* MIX, int row, int lane) {
    asm volatile("" : "+v"(lane));
    const int h = lane >> 3;
    float l0 = LSE[((size_t)0 * M + row) * 8 + h], l1 = LSE[((size_t)1 * M + row) * 8 + h], l2 = LSE[((size_t)2 * M + row) * 8 + h];
    const float mx = fmaxf(l0, fmaxf(l1, l2));
    float w0 = __builtin_amdgcn_exp2f(l0 - mx), w1 = __builtin_amdgcn_exp2f(l1 - mx), w2 = __builtin_amdgcn_exp2f(l2 - mx);
    const float inv = __builtin_amdgcn_rcpf(w0 + w1 + w2); w0 *= inv; w1 *= inv; w2 *= inv;
    const v4u a = *(const v4u*)(OP + ((size_t)0 * M + row) * 512 + lane * 8), b = *(const v4u*)(OP + ((size_t)1 * M + row) * 512 + lane * 8), c = *(const v4u*)(OP + ((size_t)2 * M + row) * 512 + lane * 8);
    float v[8]; float ss = 0.f;
#pragma unroll
    for (int j = 0; j < 4; ++j) { v[2 * j] = w0 * bflo(a[j]) + w1 * bflo(b[j]) + w2 * bflo(c[j]); v[2 * j + 1] = w0 * bfhi(a[j]) + w1 * bfhi(b[j]) + w2 * bfhi(c[j]); ss += v[2 * j] * v[2 * j] + v[2 * j + 1] * v[2 * j + 1]; }
    ss = wave_sum(ss);
    const float rinv = 1.0f / sqrtf(ss * (1.f / 512.f) + RMS_EPS);
    const f32x4 g0 = *(const f32x4*)(gain + lane * 8), g1 = *(const f32x4*)(gain + lane * 8 + 4);
    v4u w; w.x = pk2(v[0] * rinv * g0[0], v[1] * rinv * g0[1]); w.y = pk2(v[2] * rinv * g0[2], v[3] * rinv * g0[3]); w.z = pk2(v[4] * rinv * g1[0], v[5] * rinv * g1[1]); w.w = pk2(v[6] * rinv * g1[2], v[7] * rinv * g1[3]);
    *(v4u*)(MIX + (size_t)row * 1024 + lane * 8) = w;
}
constexpr int B1_IMG = 2048, B1_WLDS = 5 * B1_IMG + 1024;
constexpr int IMG_V = 0, IMG_A = 1 * B1_IMG, IMG_B = 2 * B1_IMG, IMG_W = 3 * B1_IMG, IMG_M = 4 * B1_IMG;
constexpr int TIL = 1 * B1_IMG, TIL_LP = 336, TIL_RP = 144, TIL_RSZ = 17 * TIL_RP;
static_assert(17 * TIL_LP <= 4 * B1_IMG && 3 * TIL_RSZ <= 4 * B1_IMG, "input tiles fit the image area");
DI float dpp_shr(float x, int n) { int v;
    switch (n) { case 1: v = __builtin_amdgcn_update_dpp(0, __builtin_bit_cast(int, x), 0x111, 0xf, 0xf, true); break; case 2: v = __builtin_amdgcn_update_dpp(0, __builtin_bit_cast(int, x), 0x112, 0xf, 0xf, true); break;
                 case 4: v = __builtin_amdgcn_update_dpp(0, __builtin_bit_cast(int, x), 0x114, 0xf, 0xf, true); break; default: v = __builtin_amdgcn_update_dpp(0, __builtin_bit_cast(int, x), 0x118, 0xf, 0xf, true); break; }
    return __builtin_bit_cast(float, v); }
DI float dpp_shr1(float x, int n) { int v; const int one = 0x3f800000;
    switch (n) { case 1: v = __builtin_amdgcn_update_dpp(one, __builtin_bit_cast(int, x), 0x111, 0xf, 0xf, false); break; case 2: v = __builtin_amdgcn_update_dpp(one, __builtin_bit_cast(int, x), 0x112, 0xf, 0xf, false); break;
                 case 4: v = __builtin_amdgcn_update_dpp(one, __builtin_bit_cast(int, x), 0x114, 0xf, 0xf, false); break; default: v = __builtin_amdgcn_update_dpp(one, __builtin_bit_cast(int, x), 0x118, 0xf, 0xf, false); break; }
    return __builtin_bit_cast(float, v); }
struct RwkvP {
    const bf16* PR; const float* mu; const float* muv;
    const float *dbase, *ibase, *vbase, *ksk, *ksa, *brk, *gng, *gnb;
    const bf16 *dupT, *iupT, *vupT, *gupT;
    const bf16* ZROW; bf16 *VF, *VV; float* BON; float* GC; bf16 *W1S, *REFF, *BM; v4u* REC; float* YPRE; bf16* MIX; int layer0;
};
DI const f32x4* vec4p(const float*) { return nullptr; }
DI const LAS f32x4* vec4p(const LAS float*) { return nullptr; }
template <class MP> DI void lerp8(const bf16* crow_, const bf16* prow_, int col, MP mu, float (&z)[8]) {
    const v4u cur = *(const v4u*)(crow_ + col); const v4u prv = *(const v4u*)(prow_ + col);
    const f32x4 m0 = *(decltype(vec4p(mu)))(mu), m1 = *(decltype(vec4p(mu)))(mu + 4);
#pragma unroll
    for (int j = 0; j < 4; ++j) { const float a = bflo(cur[j]), b = bfhi(cur[j]), pa = bflo(prv[j]), pb = bfhi(prv[j]); const float ma = j < 2 ? m0[2 * j] : m1[2 * j - 4], mb = j < 2 ? m0[2 * j + 1] : m1[2 * j - 3];
        z[2 * j] = a + (pa - a) * ma; z[2 * j + 1] = b + (pb - b) * mb; }
}
template <class MP> DI f32x4 lerp4(const bf16* crow_, const bf16* prow_, int col, MP mu) {
    const v2u cur = *(const v2u*)(crow_ + col); const v2u prv = *(const v2u*)(prow_ + col);
    const f32x4 m = *(decltype(vec4p(mu)))(mu);
    f32x4 z; z[0] = bflo(cur.x) + (bflo(prv.x) - bflo(cur.x)) * m[0]; z[1] = bfhi(cur.x) + (bfhi(prv.x) - bfhi(cur.x)) * m[1];
    z[2] = bflo(cur.y) + (bflo(prv.y) - bflo(cur.y)) * m[2]; z[3] = bfhi(cur.y) + (bfhi(prv.y) - bfhi(cur.y)) * m[3]; return z;
}
template <class MP> DI void lerp8l(const LAS unsigned char* crow_, const LAS unsigned char* prow_, int colb, MP mu, float (&z)[8]) {
    const v4u cur = *(const LAS v4u*)(crow_ + colb); const v4u prv = *(const LAS v4u*)(prow_ + colb);
    const f32x4 m0 = *(decltype(vec4p(mu)))(mu), m1 = *(decltype(vec4p(mu)))(mu + 4);
#pragma unroll
    for (int j = 0; j < 4; ++j) { const float a = bflo(cur[j]), b = bfhi(cur[j]), pa = bflo(prv[j]), pb = bfhi(prv[j]); const float ma = j < 2 ? m0[2 * j] : m1[2 * j - 4], mb = j < 2 ? m0[2 * j + 1] : m1[2 * j - 3];
        z[2 * j] = a + (pa - a) * ma; z[2 * j + 1] = b + (pb - b) * mb; }
}
template <class MP> DI f32x4 lerp4l(const LAS unsigned char* crow_, const LAS unsigned char* prow_, int colb, MP mu) {
    const v2u cur = *(const LAS v2u*)(crow_ + colb); const v2u prv = *(const LAS v2u*)(prow_ + colb);
    const f32x4 m = *(decltype(vec4p(mu)))(mu);
    f32x4 z; z[0] = bflo(cur.x) + (bflo(prv.x) - bflo(cur.x)) * m[0]; z[1] = bfhi(cur.x) + (bfhi(prv.x) - bfhi(cur.x)) * m[1];
    z[2] = bflo(cur.y) + (bflo(prv.y) - bflo(cur.y)) * m[2]; z[3] = bfhi(cur.y) + (bfhi(prv.y) - bfhi(cur.y)) * m[3]; return z;
}
DI void img_write(LAS unsigned char* img, const f32x4 (&x)[4], int fr, int fq) {
#pragma unroll
    for (int mb = 0; mb < 4; ++mb)
#pragma unroll
        for (int reg = 0; reg < 4; ++reg) *(LAS bf16*)(img + (16 * mb + 4 * fq + reg) * 32 + fr * 2) = (bf16)pk2z(x[mb][reg]);
}
DI bf16x8 lds4z(const LAS unsigned char* p) { const v2u t = *(const LAS v2u*)p; v4u w; w.x = t.x; w.y = t.y; w.z = 0u; w.w = 0u; return __builtin_bit_cast(bf16x8, w); }
constexpr int HC_DUP = 0, HC_IUP = 9216, HC_VUP = 18432, HC_F = 23552, HC_BYTES = 23552 + 736 * 4;
enum { HF_MUR = 0, HF_MUK = 64, HF_MUV = 128, HF_MUW = 192, HF_MUA = 256, HF_MUVR = 320, HF_DB = 352, HF_IB = 416, HF_VB = 480, HF_SK = 544, HF_SA = 608, HF_BR = 672 };
DI void head_cache_fill(const RwkvP& P, int h, LAS unsigned char* hc, int tid) {
    { const int row = tid >> 3, ch = tid & 7;
      *(LAS v4u*)(hc + HC_DUP + row * 144 + ch * 16) = *(const v4u*)(P.dupT + (size_t)(h * 64 + row) * 64 + ch * 8);
      *(LAS v4u*)(hc + HC_IUP + row * 144 + ch * 16) = *(const v4u*)(P.iupT + (size_t)(h * 64 + row) * 64 + ch * 8); }
    if (tid < 256 && !P.layer0) { const int row = tid >> 2, ch = tid & 3; *(LAS v4u*)(hc + HC_VUP + row * 80 + ch * 16) = *(const v4u*)(P.vupT + (size_t)(h * 64 + row) * 32 + ch * 8); }
    LAS float* f = (LAS float*)(hc + HC_F);
    if (tid < 64) { const int c = h * 64 + tid; f[HF_MUR + tid] = P.mu[c]; f[HF_MUK + tid] = P.mu[512 + c]; f[HF_MUV + tid] = P.mu[1024 + c]; f[HF_MUW + tid] = P.mu[1536 + tid]; f[HF_MUA + tid] = P.mu[1600 + tid];
        f[HF_DB + tid] = P.dbase[c]; f[HF_IB + tid] = P.ibase[c]; f[HF_VB + tid] = P.layer0 ? 0.f : P.vbase[c]; f[HF_SK + tid] = P.ksk[c]; f[HF_SA + tid] = P.ksa[c]; f[HF_BR + tid] = P.brk[c];
        if (tid < 32) f[HF_MUVR + tid] = P.layer0 ? 0.f : P.muv[tid]; }
}
DI void rwkv_b1_unit(const RwkvP& P, int unit, LAS unsigned char* wl, const LAS unsigned char* hc, int lane) {
    asm volatile("" : "+v"(lane));
    const int fr = lane & 15, fq = lane >> 4;
    const int seq = unit >> 9, c = unit & 511, b = seq >> 3, h = seq & 7;
    const size_t row = (size_t)b * TSEQ + 16 * c + fr;
    const f32x4 z4 = {0.f, 0.f, 0.f, 0.f};
    const LAS float* hf = (const LAS float*)(hc + HC_F);
    const bf16* row0p = P.PR + ((size_t)b * TSEQ + 16 * c) * PRP;
#define TROW(rr) (((rr) == 0 && c == 0) ? P.ZROW : row0p + ((rr) - 1) * PRP)
    v4u tl[6], tr3[3][3];
#pragma unroll
    for (int i = 0; i < 5; ++i) { const int idx = lane + 64 * i; if (idx < 272) { const int rr = idx >> 4, pc = idx & 15; tl[i] = *(const v4u*)(TROW(rr) + 1536 + pc * 8); } }
    { const int idx = lane; const int rr = idx >> 2, pc = idx & 3; tl[5] = (v4u){0u, 0u, 0u, 0u}; if (!P.layer0) { tl[5] = *(const v4u*)(TROW(rr) + 1792 + pc * 8); } }
    v4u tl16 = {0u, 0u, 0u, 0u}; if (!P.layer0 && lane < 4) tl16 = *(const v4u*)(TROW(16) + 1792 + lane * 8);
#pragma unroll
    for (int ten = 0; ten < 3; ++ten)
#pragma unroll
        for (int i = 0; i < 3; ++i) { const int idx = lane + 64 * i; if (idx < 136) { const int rr = idx >> 3, pc = idx & 7; tr3[ten][i] = *(const v4u*)(TROW(rr) + ten * 512 + h * 64 + pc * 8); } }
#pragma unroll
    for (int i = 0; i < 5; ++i) { const int idx = lane + 64 * i; if (idx < 272) { const int rr = idx >> 4, pc = idx & 15; *(LAS v4u*)(wl + TIL + rr * TIL_LP + pc * 16) = tl[i]; } }
    { const int rr = lane >> 2, pc = lane & 3; *(LAS v4u*)(wl + TIL + rr * TIL_LP + 256 + pc * 16) = tl[5]; if (lane < 4) *(LAS v4u*)(wl + TIL + 16 * TIL_LP + 256 + lane * 16) = tl16; }
    LDS_WAIT();
    const LAS unsigned char* lcr = wl + TIL + (fr + 1) * TIL_LP; const LAS unsigned char* lpr = wl + TIL + fr * TIL_LP;
    bf16x8 tw[2], al[2], vl;
#pragma unroll
    for (int ks = 0; ks < 2; ++ks) { float z[8]; lerp8l(lcr, lpr, (8 * fq + 32 * ks) * 2, hf + HF_MUW + 8 * fq + 32 * ks, z);
        tw[ks] = pk8(ftanh(z[0]), ftanh(z[1]), ftanh(z[2]), ftanh(z[3]), ftanh(z[4]), ftanh(z[5]), ftanh(z[6]), ftanh(z[7]));
        lerp8l(lcr, lpr, 128 + (8 * fq + 32 * ks) * 2, hf + HF_MUA + 8 * fq + 32 * ks, z); al[ks] = pk8(z[0], z[1], z[2], z[3], z[4], z[5], z[6], z[7]); }
    if (!P.layer0) { float z[8]; lerp8l(lcr, lpr, 256 + 8 * fq * 2, hf + HF_MUVR + 8 * fq, z); vl = pk8(z[0], z[1], z[2], z[3], z[4], z[5], z[6], z[7]); }
    LDS_WAIT();
#pragma unroll
    for (int ten = 0; ten < 3; ++ten)
#pragma unroll
        for (int i = 0; i < 3; ++i) { const int idx = lane + 64 * i; if (idx < 136) { const int rr = idx >> 3, pc = idx & 7; *(LAS v4u*)(wl + TIL + ten * TIL_RSZ + rr * TIL_RP + pc * 16) = tr3[ten][i]; } }
    LDS_WAIT();
#undef TROW
    const LAS unsigned char* rcr = wl + TIL + (fr + 1) * TIL_RP; const LAS unsigned char* rpr = wl + TIL + fr * TIL_RP;
    f32x4 zr[4], k2[4], kk[4], ai[4], ld[4];
    float nrm = 0.f, bon = 0.f;
#pragma unroll
    for (int mb = 0; mb < 4; ++mb) { const int ch = h * 64 + 16 * mb + 4 * fq; const int n = h * 64 + 16 * mb + fr;
        f32x4 dw = z4, da = z4, dv = z4;
        dw = mfma16(*(const LAS bf16x8*)(hc + HC_DUP + (16 * mb + fr) * 144 + 16 * fq), tw[0], dw); dw = mfma16(*(const LAS bf16x8*)(hc + HC_DUP + (16 * mb + fr) * 144 + 16 * fq + 64), tw[1], dw);
        da = mfma16(*(const LAS bf16x8*)(hc + HC_IUP + (16 * mb + fr) * 144 + 16 * fq), al[0], da); da = mfma16(*(const LAS bf16x8*)(hc + HC_IUP + (16 * mb + fr) * 144 + 16 * fq + 64), al[1], da);
        if (!P.layer0) dv = mfma16(*(const LAS bf16x8*)(hc + HC_VUP + (16 * mb + fr) * 80 + 16 * fq), vl, z4);
        const int cl = 16 * mb + 4 * fq;
        zr[mb] = lerp4l(rcr, rpr, cl * 2, hf + HF_MUR + cl);
        const f32x4 zk = lerp4l(rcr + TIL_RSZ, rpr + TIL_RSZ, cl * 2, hf + HF_MUK + cl);
        f32x4 zv = lerp4l(rcr + 2 * TIL_RSZ, rpr + 2 * TIL_RSZ, cl * 2, hf + HF_MUV + cl);
        const f32x4 db = *(const LAS f32x4*)(hf + HF_DB + cl), ib = *(const LAS f32x4*)(hf + HF_IB + cl), sk = *(const LAS f32x4*)(hf + HF_SK + cl), sa = *(const LAS f32x4*)(hf + HF_SA + cl), br = *(const LAS f32x4*)(hf + HF_BR + cl);
        if (P.layer0) { v2u w; w.x = pk2(zv[0], zv[1]); w.y = pk2(zv[2], zv[3]); *(v2u*)(P.VF + row * 512 + ch) = w; }
        else { const v2u f = *(const v2u*)(P.VF + row * 512 + ch); const f32x4 vb = *(const LAS f32x4*)(hf + HF_VB + cl); const f32x4 vf = {bflo(f.x), bfhi(f.x), bflo(f.y), bfhi(f.y)};
#pragma unroll
            for (int e = 0; e < 4; ++e) zv[e] = zv[e] + (vf[e] - zv[e]) * fsigmoid(vb[e] + dv[e]); }
        { v2u w; w.x = pk2(zv[0], zv[1]); w.y = pk2(zv[2], zv[3]); *(v2u*)(P.VV + row * 512 + ch) = w; }
#pragma unroll
        for (int reg = 0; reg < 4; ++reg) *(LAS bf16*)(wl + IMG_V + (16 * mb + 4 * fq + reg) * 32 + fr * 2) = (bf16)pk2z(zv[reg]);
#pragma unroll
        for (int e = 0; e < 4; ++e) {
            ld[mb][e] = fexp(-0.60653065971f * fsigmoid(db[e] + dw[e]));
            const float a = fsigmoid(ib[e] + da[e]); ai[mb][e] = a;
            const float kr = zk[e] * sk[e]; kk[mb][e] = kr; nrm += kr * kr;
            const float kx = zk[e] * (1.f + (a - 1.f) * sa[e]); k2[mb][e] = kx; bon += zr[mb][e] * kx * br[e]; }
        asm volatile("" ::: "memory");
    }
    nrm += __shfl_xor(nrm, 16); nrm += __shfl_xor(nrm, 32); bon += __shfl_xor(bon, 16); bon += __shfl_xor(bon, 32);
    if (fq == 0) P.BON[row * 8 + h] = bon;
    const float kinv = 1.0f / fmaxf(sqrtf(nrm), 1e-12f);
    f32x4 rt[4], kh[4];
    bf16x8 pa[2], pb[2], pk[2], pr[2];
#pragma unroll
    for (int ks = 0; ks < 2; ++ks) {
        f32x4 at2[2], bt2[2], kt2[2];
#pragma unroll
        for (int m2 = 0; m2 < 2; ++m2) { const int mb = 2 * ks + m2;
            f32x4 gcv, bhv;
#pragma unroll
            for (int e = 0; e < 4; ++e) {
                float gm = ld[mb][e]; gm *= dpp_shr1(gm, 1); gm *= dpp_shr1(gm, 2); gm *= dpp_shr1(gm, 4); gm *= dpp_shr1(gm, 8);
                const float gc = __shfl(gm, lane | 15), gp = dpp_shr1(gm, 1), gi = __builtin_amdgcn_rcpf(gm), ec = gc * gi;
                const float kn = kk[mb][e] * kinv, bb = kn * ai[mb][e];
                at2[m2][e] = -kn * gp; bt2[m2][e] = bb * gi; kt2[m2][e] = k2[mb][e] * gi; rt[mb][e] = zr[mb][e] * gm;
                bhv[e] = bb * ec; kh[mb][e] = k2[mb][e] * ec; gcv[e] = gc; }
            if (fr == 0) *(f32x4*)(P.GC + (size_t)unit * 64 + 16 * mb + 4 * fq) = gcv;
#pragma unroll
            for (int reg = 0; reg < 4; ++reg) { const int o = (16 * mb + 4 * fq + reg) * 32 + fr * 2;
                *(LAS bf16*)(wl + IMG_A + o) = (bf16)pk2z(at2[m2][reg]); *(LAS bf16*)(wl + IMG_B + o) = (bf16)pk2z(bhv[reg]); }
        }
        pa[ks] = pk8v(at2[0], at2[1]); pb[ks] = pk8v(bt2[0], bt2[1]); pk[ks] = pk8v(kt2[0], kt2[1]); pr[ks] = pk8v(rt[2 * ks], rt[2 * ks + 1]);
    }
    const f32x4 z4b = {0.f, 0.f, 0.f, 0.f};
    f32x4 Aab = mfma16(pb[1], pa[1], mfma16(pb[0], pa[0], z4b));
    f32x4 AakT = mfma16(pa[1], pk[1], mfma16(pa[0], pk[0], z4b));
    f32x4 Arb = mfma16(pb[1], pr[1], mfma16(pb[0], pr[0], z4b));
    f32x4 Ark = mfma16(pk[1], pr[1], mfma16(pk[0], pr[0], z4b));
#pragma unroll
    for (int e = 0; e < 4; ++e) { const int rr = 4 * fq + e; Aab[e] = rr < fr ? Aab[e] : 0.f; AakT[e] = fr < rr ? AakT[e] : 0.f; Arb[e] = rr <= fr ? Arb[e] : 0.f; Ark[e] = rr <= fr ? Ark[e] : 0.f; }
    LAS float* As = (LAS float*)(wl + 5 * B1_IMG);
#pragma unroll
    for (int e = 0; e < 4; ++e) As[(4 * fq + e) * 16 + fr] = Aab[e];
    LDS_WAIT();
    float x[16];
#pragma unroll
    for (int s = 15; s >= 0; --s) { float acc = (s == fr) ? 1.f : 0.f;
        const f32x4 r0 = *(const LAS f32x4*)(As + s * 16), r1 = *(const LAS f32x4*)(As + s * 16 + 4), r2 = *(const LAS f32x4*)(As + s * 16 + 8), r3 = *(const LAS f32x4*)(As + s * 16 + 12);
        const float rowv[16] = {r0[0], r0[1], r0[2], r0[3], r1[0], r1[1], r1[2], r1[3], r2[0], r2[1], r2[2], r2[3], r3[0], r3[1], r3[2], r3[3]};
#pragma unroll
        for (int uu = s + 1; uu < 16; ++uu) acc += rowv[uu] * x[uu];
        x[s] = acc; if ((s & 1) == 0) asm volatile("" ::: "memory"); }
    f32x4 xs;
#pragma unroll
    for (int e = 0; e < 4; ++e) xs[e] = fq == 0 ? x[e] : fq == 1 ? x[4 + e] : fq == 2 ? x[8 + e] : x[12 + e];
    const bf16x8 Tsel = pk4z(xs);
    f32x4 W1[4];
#pragma unroll
    for (int mb = 0; mb < 4; ++mb) W1[mb] = mfma16(lds4z(wl + IMG_A + (16 * mb + fr) * 32 + 8 * fq), Tsel, z4);
    const f32x4 GT = mfma16(Tsel, pk4z(AakT), z4);
    img_write(wl + IMG_W, W1, fr, fq);
    f32x4 M1T[4];
    const bf16x8 GTp = pk4z(GT);
#pragma unroll
    for (int mb = 0; mb < 4; ++mb) M1T[mb] = mfma16(lds4z(wl + IMG_B + (16 * mb + fr) * 32 + 8 * fq), GTp, kh[mb]);
    img_write(wl + IMG_M, M1T, fr, fq);
    LDS_WAIT();
    const bf16x8 Arbp = pk4z(Arb);
    f32x4 RE[4];
#pragma unroll
    for (int mb = 0; mb < 4; ++mb) RE[mb] = mfma16(lds4z(wl + IMG_W + (16 * mb + fr) * 32 + 8 * fq), Arbp, rt[mb]);
    const f32x4 M2 = mfma16(GTp, Arbp, Ark);
    {   bf16* w1s = P.W1S + (size_t)unit * 1024 + fr * 32; bf16* re = P.REFF + (size_t)unit * 1024 + fr * 32;
#pragma unroll
        for (int kp = 0; kp < 2; ++kp) { const int sg = kp * 512 + fq * 8;
            v4u w; w.x = pk2(W1[2 * kp][0], W1[2 * kp][1]); w.y = pk2(W1[2 * kp][2], W1[2 * kp][3]); w.z = pk2(W1[2 * kp + 1][0], W1[2 * kp + 1][1]); w.w = pk2(W1[2 * kp + 1][2], W1[2 * kp + 1][3]); *(v4u*)(w1s + sg) = w;
            w.x = pk2(RE[2 * kp][0], RE[2 * kp][1]); w.y = pk2(RE[2 * kp][2], RE[2 * kp][3]); w.z = pk2(RE[2 * kp + 1][0], RE[2 * kp + 1][1]); w.w = pk2(RE[2 * kp + 1][2], RE[2 * kp + 1][3]); *(v4u*)(re + sg) = w; }
        const v2u m2p = {pk2(M2[0], M2[1]), pk2(M2[2], M2[3])};
#pragma unroll
        for (int mb = 0; mb < 4; ++mb) {
            const v2u bq = *(const LAS v2u*)(wl + IMG_B + (16 * mb + fr) * 32 + 8 * fq), mq = *(const LAS v2u*)(wl + IMG_M + (16 * mb + fr) * 32 + 8 * fq);
            *(v4u*)(P.BM + (((size_t)unit * 64 + 16 * mb + fr) * 4 + fq) * 8) = (v4u){bq.x, bq.y, mq.x, mq.y};
            const v2u vq = *(const LAS v2u*)(wl + IMG_V + (16 * mb + fr) * 32 + 8 * fq);
            P.REC[((size_t)unit * 4 + mb) * 64 + lane] = (v4u){vq.x, vq.y, m2p.x, m2p.y}; }
    }
    LDS_WAIT();
}
constexpr int NSEG = 16, SEGCH = NCH / NSEG;
struct ChainIn { bf16x8 w1[2], re[2], bm[4]; v4u rec; f32x4 gc[4]; };
template <int MODE> DI void chain_load(ChainIn& c, const RwkvP& P, int unit, int rb, int lane) {
    const int fr = lane & 15, fq = lane >> 4;
    const bf16* w1s = P.W1S + (size_t)unit * 1024 + fr * 32 + fq * 8;
    c.w1[0] = ld8(w1s); c.w1[1] = ld8(w1s + 512);
    if (MODE == 2) { const bf16* re = P.REFF + (size_t)unit * 1024 + fr * 32 + fq * 8; c.re[0] = ld8(re); c.re[1] = ld8(re + 512); }
#pragma unroll
    for (int mb = 0; mb < 4; ++mb) { c.bm[mb] = ld8(P.BM + (((size_t)unit * 64 + 16 * mb + fr) * 4 + fq) * 8); c.gc[mb] = *(const f32x4*)(P.GC + (size_t)unit * 64 + 16 * mb + 4 * fq); }
    if (MODE != 1) c.rec = P.REC[((size_t)unit * 4 + rb) * 64 + lane];
}
template <int MODE> DI void chain_step(f32x4 (&S)[4], const ChainIn& c, float* ypre  ) {
    const f32x4 z4 = {0.f, 0.f, 0.f, 0.f};
    const bf16x8 b0 = pk8v(S[0], S[1]), b1 = pk8v(S[2], S[3]);
    f32x4 ut = mfma16(c.w1[1], b1, mfma16(c.w1[0], b0, z4));
    if (MODE == 2) {
        v4u vlo; vlo.x = c.rec.x; vlo.y = c.rec.y; vlo.z = 0u; vlo.w = 0u;
        v4u m2a; m2a.x = c.rec.z; m2a.y = c.rec.w; m2a.z = 0u; m2a.w = 0u;
        f32x4 y = mfma16(__builtin_bit_cast(bf16x8, m2a), __builtin_bit_cast(bf16x8, vlo), z4);
        y = mfma16(c.re[0], b0, y); y = mfma16(c.re[1], b1, y);
#pragma unroll
        for (int e = 0; e < 4; ++e) ypre[(size_t)e * 512] = y[e];
    }
    v4u uv; uv.x = pk2(ut[0], ut[1]); uv.y = pk2(ut[2], ut[3]); uv.z = MODE == 1 ? 0u : c.rec.x; uv.w = MODE == 1 ? 0u : c.rec.y;
    const bf16x8 ub = __builtin_bit_cast(bf16x8, uv);
#pragma unroll
    for (int mb = 0; mb < 4; ++mb) S[mb] = mfma16(c.bm[mb], ub, S[mb] * c.gc[mb]);
}
template <int MODE> DI void chain_run(f32x4 (&S)[4], const RwkvP& P, int unit0, int nsteps  , int rb, float* yp, int lane) {
    ChainIn c0, c1, c2;
    chain_load<MODE>(c0, P, unit0, rb, lane); chain_load<MODE>(c1, P, unit0 + 1, rb, lane);
    int c = 0;
    for (; c + 3 <= nsteps; c += 3) {
        chain_load<MODE>(c2, P, unit0 + c + 2, rb, lane);
        chain_step<MODE>(S, c0, yp + (size_t)c * 16 * 512);
        if (c + 3 < nsteps) chain_load<MODE>(c0, P, unit0 + c + 3, rb, lane);
        chain_step<MODE>(S, c1, yp + (size_t)(c + 1) * 16 * 512);
        if (c + 4 < nsteps) chain_load<MODE>(c1, P, unit0 + c + 4, rb, lane);
        chain_step<MODE>(S, c2, yp + (size_t)(c + 2) * 16 * 512);
    }
    if (c < nsteps) { chain_step<MODE>(S, c0, yp + (size_t)c * 16 * 512); ++c; }
    if (c < nsteps) { chain_step<MODE>(S, c1, yp + (size_t)c * 16 * 512); ++c; }
}
DI void chain_step_dual(f32x4 (&SQ)[4], f32x4 (&SP)[4], const ChainIn& c) {
    const f32x4 z4 = {0.f, 0.f, 0.f, 0.f};
    const bf16x8 q0 = pk8v(SQ[0], SQ[1]), q1 = pk8v(SQ[2], SQ[3]), p0 = pk8v(SP[0], SP[1]), p1 = pk8v(SP[2], SP[3]);
    const f32x4 utq = mfma16(c.w1[1], q1, mfma16(c.w1[0], q0, z4)), utp = mfma16(c.w1[1], p1, mfma16(c.w1[0], p0, z4));
    v4u uq; uq.x = pk2(utq[0], utq[1]); uq.y = pk2(utq[2], utq[3]); uq.z = c.rec.x; uq.w = c.rec.y;
    v4u up; up.x = pk2(utp[0], utp[1]); up.y = pk2(utp[2], utp[3]); up.z = 0u; up.w = 0u;
    const bf16x8 ubq = __builtin_bit_cast(bf16x8, uq), ubp = __builtin_bit_cast(bf16x8, up);
#pragma unroll
    for (int mb = 0; mb < 4; ++mb) { SQ[mb] = mfma16(c.bm[mb], ubq, SQ[mb] * c.gc[mb]); SP[mb] = mfma16(c.bm[mb], ubp, SP[mb] * c.gc[mb]); }
}
DI void chain_pass1(const RwkvP& P, float* QSEG, float* PSEGT, int seq, int g, int rb, int lane) {
    const int fr = lane & 15, fq = lane >> 4;
    f32x4 SQ[4], SP[4];
#pragma unroll
    for (int mb = 0; mb < 4; ++mb)
#pragma unroll
        for (int e = 0; e < 4; ++e) { SQ[mb][e] = 0.f; SP[mb][e] = ((16 * mb + 4 * fq + e) == (16 * rb + fr)) ? 1.f : 0.f; }
    const int unit0 = seq * NCH + g * SEGCH;
    {   ChainIn c0, c1, c2;
        chain_load<0>(c0, P, unit0, rb, lane); chain_load<0>(c1, P, unit0 + 1, rb, lane);
        int c = 0;
        for (; c + 3 <= SEGCH; c += 3) {
            chain_load<0>(c2, P, unit0 + c + 2, rb, lane);
            chain_step_dual(SQ, SP, c0);
            if (c + 3 < SEGCH) chain_load<0>(c0, P, unit0 + c + 3, rb, lane);
            chain_step_dual(SQ, SP, c1);
            if (c + 4 < SEGCH) chain_load<0>(c1, P, unit0 + c + 4, rb, lane);
            chain_step_dual(SQ, SP, c2);
        }
        if (c < SEGCH) { chain_step_dual(SQ, SP, c0); ++c; }
        if (c < SEGCH) { chain_step_dual(SQ, SP, c1); ++c; }
    }
    const size_t sb = ((size_t)seq * NSEG + g) * 4096;
#pragma unroll
    for (int mb = 0; mb < 4; ++mb) *(f32x4*)(QSEG + sb + (size_t)(16 * rb + fr) * 64 + 16 * mb + 4 * fq) = SQ[mb];
#pragma unroll
    for (int mb = 0; mb < 4; ++mb)
#pragma unroll
        for (int e = 0; e < 4; ++e) PSEGT[sb + (size_t)((mb * 2 + (rb >> 1)) * 2 + (rb & 1)) * 256 + ((4 * fq + e) + 16 * (fr >> 2)) * 4 + (fr & 3)] = SP[mb][e];
}
DI void split_hl(const f32x4 a, const f32x4 b, bf16x8& hi, bf16x8& lo) {
    f32x4 ah, bh;
#pragma unroll
    for (int e = 0; e < 4; ++e) { ah[e] = rbf(a[e]); bh[e] = rbf(b[e]); }
    hi = pk8v(ah, bh); lo = pk8v(a - ah, b - bh);
}
DI void chain_pass23(const RwkvP& P, const float* QSEG, const float* PSEGT, int seq, int g, int rb, float* wkv_out, int lane) {
    const int fr = lane & 15, fq = lane >> 4, b = seq >> 3, h = seq & 7;
    f32x4 S[4]; for (int mb = 0; mb < 4; ++mb) S[mb] = (f32x4){0.f, 0.f, 0.f, 0.f};
    f32x4 pc[4][2][2], pn[4][2][2];
#define P2_LOAD(PD_, GP_) do { const size_t sb_ = ((size_t)seq * NSEG + (GP_)) * 4096; _Pragma("unroll") for (int mb = 0; mb < 4; ++mb) { \
        _Pragma("unroll") for (int ks = 0; ks < 2; ++ks) { const float* pr_ = PSEGT + sb_ + (size_t)((mb * 2 + ks) * 2) * 256 + (fr + 16 * fq) * 4; PD_[mb][ks][0] = *(const f32x4*)pr_; PD_[mb][ks][1] = *(const f32x4*)(pr_ + 256); } } } while (0)
    if (g > 0) P2_LOAD(pc, 0);
    for (int gp = 0; gp < g; ++gp) {
        f32x4 qc[4];
        { const size_t sb_ = ((size_t)seq * NSEG + gp) * 4096;
#pragma unroll
          for (int mb = 0; mb < 4; ++mb) qc[mb] = *(const f32x4*)(QSEG + sb_ + (size_t)(16 * rb + fr) * 64 + 16 * mb + 4 * fq); }
        if (gp + 1 < g) P2_LOAD(pn, gp + 1);
        bf16x8 bh[2], bl[2]; split_hl(S[0], S[1], bh[0], bl[0]); split_hl(S[2], S[3], bh[1], bl[1]);
#pragma unroll
        for (int mb = 0; mb < 4; ++mb) { f32x4 acc = {0.f, 0.f, 0.f, 0.f};
#pragma unroll
            for (int ks = 0; ks < 2; ++ks) { bf16x8 ah, al; split_hl(pc[mb][ks][0], pc[mb][ks][1], ah, al);
                acc = mfma16(ah, bh[ks], acc); acc = mfma16(al, bh[ks], acc); acc = mfma16(ah, bl[ks], acc); }
            S[mb] = acc + qc[mb]; }
#pragma unroll
        for (int mb = 0; mb < 4; ++mb) {
#pragma unroll
            for (int ks = 0; ks < 2; ++ks) { pc[mb][ks][0] = pn[mb][ks][0]; pc[mb][ks][1] = pn[mb][ks][1]; } }
    }
#undef P2_LOAD
    float* yp = P.YPRE + ((size_t)b * TSEQ + (size_t)g * SEGCH * 16 + 4 * fq) * 512 + h * 64 + 16 * rb + fr;
    chain_run<2>(S, P, seq * NCH + g * SEGCH, SEGCH, rb, yp, lane);
    if (g == NSEG - 1) {
#pragma unroll
        for (int mb = 0; mb < 4; ++mb) *(f32x4*)(wkv_out + (size_t)(16 * rb + fr) * 64 + 16 * mb + 4 * fq) = S[mb];
    }
}
constexpr int GC_GUP = 0, GC_F = 64 * 272, GC_BYTES = 64 * 272 + 256 * 4;
DI void gate_cache_fill(const RwkvP& P, int h, LAS unsigned char* gc, int tid) {
#pragma unroll
    for (int q = 0; q < 2; ++q) { const int idx = tid + 512 * q, row = idx >> 4, ch = idx & 15;
        *(LAS v4u*)(gc + GC_GUP + row * 272 + ch * 16) = *(const v4u*)(P.gupT + (size_t)(h * 64 + row) * 128 + ch * 8); }
    LAS float* f = (LAS float*)(gc + GC_F);
    if (tid < 64) { f[tid] = P.gng[h * 64 + tid]; f[64 + tid] = P.gnb[h * 64 + tid]; }
    if (tid >= 64 && tid < 192) f[128 + tid - 64] = P.mu[1664 + tid - 64];
}
DI void rwkv_b3_unit(const RwkvP& P, int unit, const LAS unsigned char* gc, int lane) {
    asm volatile("" : "+v"(lane));
    const int fr = lane & 15, fq = lane >> 4;
    const int seq = unit >> 9, c = unit & 511, b = seq >> 3, h = seq & 7;
    const size_t row = (size_t)b * TSEQ + 16 * c + fr;
    const bool hasprev = (c | fr) != 0;
    const bf16* crp = P.PR + row * PRP; const bf16* prp = hasprev ? crp - PRP : P.ZROW;
    const f32x4 z4 = {0.f, 0.f, 0.f, 0.f};
    const LAS float* gf = (const LAS float*)(gc + GC_F);
    bf16x8 sg[4];
#pragma unroll
    for (int ks = 0; ks < 4; ++ks) { float z[8]; lerp8(crp, prp, 1664 + 8 * fq + 32 * ks, gf + 128 + 8 * fq + 32 * ks, z);
        sg[ks] = pk8(fsigmoid(z[0]), fsigmoid(z[1]), fsigmoid(z[2]), fsigmoid(z[3]), fsigmoid(z[4]), fsigmoid(z[5]), fsigmoid(z[6]), fsigmoid(z[7])); }
    f32x4 g[4], y[4]; float s = 0.f;
#pragma unroll
    for (int mb = 0; mb < 4; ++mb) { f32x4 a = z4;
#pragma unroll
        for (int ks = 0; ks < 4; ++ks) a = mfma16(*(const LAS bf16x8*)(gc + GC_GUP + (16 * mb + fr) * 272 + 16 * fq + 64 * ks), sg[ks], a);
        g[mb] = a;
        y[mb] = *(const f32x4*)(P.YPRE + row * 512 + h * 64 + 16 * mb + 4 * fq); s += (y[mb][0] + y[mb][1]) + (y[mb][2] + y[mb][3]); }
    s += __shfl_xor(s, 16); s += __shfl_xor(s, 32);
    const float mean = s * (1.f / 64.f); float q = 0.f;
#pragma unroll
    for (int mb = 0; mb < 4; ++mb) { y[mb] = y[mb] - mean; q += (y[mb][0] * y[mb][0] + y[mb][1] * y[mb][1]) + (y[mb][2] * y[mb][2] + y[mb][3] * y[mb][3]); }
    q += __shfl_xor(q, 16); q += __shfl_xor(q, 32);
    const float rstd = 1.0f / sqrtf(q * (1.f / 64.f) + GN_EPS);
    const float bon = P.BON[row * 8 + h];
#pragma unroll
    for (int mb = 0; mb < 4; ++mb) { const int cl = 16 * mb + 4 * fq, ch = h * 64 + cl;
        const f32x4 gg = *(const LAS f32x4*)(gf + cl), gb = *(const LAS f32x4*)(gf + 64 + cl); const v2u vw = *(const v2u*)(P.VV + row * 512 + ch);
        const f32x4 v = {bflo(vw.x), bfhi(vw.x), bflo(vw.y), bfhi(vw.y)};
        const f32x4 o = (y[mb] * rstd * gg + gb + v * bon) * g[mb];
        v2u w; w.x = pk2(o[0], o[1]); w.y = pk2(o[2], o[3]); *(v2u*)(P.MIX + row * 1024 + 512 + ch) = w; }
}
DI f32x16 dec_gemm(const bf16* A, const bf16* Wt, int K, LAS float* red  , int wave, int lane) {
    const int r = lane & 31, h = lane >> 5, kw = K >> 3;
    const bf16* ap = A + (size_t)r * K + wave * kw + 8 * h; const bf16* bp = Wt + (size_t)r * K + wave * kw + 8 * h;
    f32x16 acc; for (int i = 0; i < 16; ++i) acc[i] = 0.f;
#pragma unroll 16
    for (int k = 0; k < kw; k += 16) acc = mfma32(ld8(ap + k), ld8(bp + k), acc);
    __syncthreads();
#pragma unroll
    for (int i = 0; i < 16; ++i) red[(wave * 16 + i) * 64 + lane] = acc[i];
    __syncthreads();
    if (wave == 0) {
#pragma unroll
        for (int i = 0; i < 16; ++i) { float s = 0.f;
#pragma unroll
            for (int w = 0; w < 8; ++w) s += red[(w * 16 + i) * 64 + lane];
            asm volatile("" : "+v"(s) :: "memory"); acc[i] = s; } }
    return acc;
}
DI void dec_row_stats(const float* st, LAS float* sc, int lane) {
    if (lane < 32) { float s = 0.f, q = 0.f; const f32x4* p = (const f32x4*)(st + (size_t)lane * 64);
#pragma unroll
        for (int i = 0; i < 16; ++i) { const f32x4 v = p[i]; s += v[0] + v[2]; q += v[1] + v[3]; if ((i & 3) == 3) asm volatile("" : "+v"(s), "+v"(q) :: "memory"); }
        const float mu = s * (1.f / 1024.f), var = fmaxf(q * (1.f / 1024.f) - mu * mu, 0.f); sc[2 * lane] = mu; sc[2 * lane + 1] = 1.0f / sqrtf(var + LN_EPS); }
    LDS_WAIT();
}
struct DecP {
    unsigned char* dec; int l;
    const float* xs;
    const float *c1in, *c2in, *c1up, *c2up, *g1, *b1, *g2p, *b2p;
    const bf16 *win, *winu, *wout, *wup, *wdn;
    float* out;
};
DI void dec_unit_in(const DecP& D, int u, LAS float* red, LAS float* sc, int wave, int lane) {
    const int r32 = lane & 31, hi = lane >> 5;
    if (u < 105) {
        const int n = 32 * u + r32; const bool fold = D.l > 0;
        const f32x16 acc = dec_gemm((const bf16*)(D.dec + DEC_XB2), D.win + (size_t)(32 * u) * DM, DM, red, wave, lane);
        if (wave != 0) return;
        if (fold) dec_row_stats((const float*)(D.dec + DEC_ST2), sc, lane);
        const float c1 = fold ? D.c1in[n] : 0.f, c2 = fold ? D.c2in[n] : 0.f; const int on = n < 1024 ? lgcl2orig(n) : n;
        float* PD = (float*)(D.dec + DEC_PD);
#pragma unroll
        for (int i = 0; i < 16; ++i) { const int row = crow(i, hi); float mu = 0.f, rs = 1.f; if (fold) { mu = sc[2 * row]; rs = sc[2 * row + 1]; } PD[(size_t)row * NIN + on] = (acc[i] - mu * c1) * rs + c2; }
    } else {
        const int v = u - 105, n = 32 * v + r32;
        const f32x16 acc = dec_gemm((const bf16*)(D.dec + DEC_SHB) + (size_t)D.l * MD * DM, D.winu + (size_t)(32 * v) * DM, DM, red, wave, lane);
        if (wave != 0) return;
        float* PS = (float*)(D.dec + DEC_PS);
#pragma unroll
        for (int i = 0; i < 16; ++i) PS[(size_t)crow(i, hi) * NRWU + n] = acc[i];
    }
    LDS_WAIT();
}
DI void dec_unit_res(const bf16* A, const bf16* Wt, int K, int u, bool raw, const float* src, const float* sstat, const float* g, const float* b, float* T, bf16* XB, float* ostat, float* shiftout, LAS float* red, LAS float* sc, int wave, int lane) {
    const int r32 = lane & 31, hi = lane >> 5, n = 32 * u + r32;
    const f32x16 acc = dec_gemm(A, Wt + (size_t)(32 * u) * K, K, red, wave, lane);
    if (wave != 0) return;
    if (!raw) dec_row_stats(sstat, sc, lane);
    const float gg = raw ? 1.f : g[n], bb = raw ? 0.f : b[n];
#pragma unroll
    for (int i = 0; i < 16; ++i) { const int row = crow(i, hi); float mu = 0.f, rs = 1.f; if (!raw) { mu = sc[2 * row]; rs = sc[2 * row + 1]; }
        const float x = (src[(size_t)row * DM + n] - mu) * rs * gg + bb; const float t = ALPHA * x + acc[i];
        T[(size_t)row * DM + n] = t; XB[(size_t)row * DM + n] = (bf16)f2bf(t); if (shiftout) shiftout[(size_t)row * DM + n] = x;
        float s = t, q = t * t;
#pragma unroll
        for (int o = 1; o < 32; o <<= 1) { s += __shfl_xor(s, o); q += __shfl_xor(q, o); }
        if (r32 == 0) { ostat[((size_t)row * 32 + u) * 2] = s; ostat[((size_t)row * 32 + u) * 2 + 1] = q; } }
    LDS_WAIT();
}
DI void dec_unit_up(const DecP& D, int u, LAS float* red, LAS float* sc, int wave, int lane) {
    const int r32 = lane & 31, hi = lane >> 5, n = 32 * u + r32;
    const f32x16 acc = dec_gemm((const bf16*)(D.dec + DEC_XB1), D.wup + (size_t)(32 * u) * DM, DM, red, wave, lane);
    if (wave != 0) return;
    dec_row_stats((const float*)(D.dec + DEC_ST1), sc, lane);
    const float c1 = D.c1up[n], c2 = D.c2up[n]; bf16* HB = (bf16*)(D.dec + DEC_HB);
#pragma unroll
    for (int i = 0; i < 16; ++i) { const int row = crow(i, hi); const float v = fmaxf((acc[i] - sc[2 * row] * c1) * sc[2 * row + 1] + c2, 0.f); HB[(size_t)row * FFD + n] = (bf16)f2bf(v * v); }
    LDS_WAIT();
}
DI void dec_attn_task(const DecP& D, const float* ck, const float* cv, const float* rope, int bd, int h, int p, int lane) {
    const int g = lane >> 4, dq = lane & 15, dd = 1 << (2 * p);
    const float* PD = (const float*)(D.dec + DEC_PD) + (size_t)bd * NIN;
    const f32x4 rr0 = *(const f32x4*)(rope + ((size_t)8192 * 32 + ((4 * dq) & 31)) * 2), rr1 = *(const f32x4*)(rope + ((size_t)8192 * 32 + ((4 * dq) & 31)) * 2 + 4);
    const f32x4 cs = {rr0[0], rr0[2], rr1[0], rr1[2]}, sn = {rr0[1], rr0[3], rr1[1], rr1[3]};
    const float sgn = dq < 8 ? -1.f : 1.f;
    f32x4 q = *(const f32x4*)(PD + h * 64 + 4 * dq), kn = *(const f32x4*)(PD + 512 + h * 64 + 4 * dq); const f32x4 vn = *(const f32x4*)(PD + 1024 + h * 64 + 4 * dq);
    { f32x4 qp, kp;
#pragma unroll
      for (int e = 0; e < 4; ++e) { qp[e] = __shfl_xor(q[e], 8); kp[e] = __shfl_xor(kn[e], 8); }
      q = q * cs + qp * sn * sgn; kn = kn * cs + kp * sn * sgn; }
    if (p == 0 && g == 0) { *(f32x4*)(D.out + O_KS + ((size_t)D.l * MD + bd) * 512 + h * 64 + 4 * dq) = kn; *(f32x4*)(D.out + O_VS + ((size_t)D.l * MD + bd) * 512 + h * 64 + 4 * dq) = vn; }
    float s0 = (q[0] * kn[0] + q[1] * kn[1]) + (q[2] * kn[2] + q[3] * kn[3]);
#pragma unroll
    for (int o = 1; o < 16; o <<= 1) s0 += __shfl_xor(s0, o);
    s0 *= 0.125f;
    const size_t cbase = (((size_t)D.l * MD + bd) * 2048) * 512 + h * 64 + 4 * dq;
    float mx = -INFINITY, den = 0.f; f32x4 o4 = {0.f, 0.f, 0.f, 0.f};
#pragma unroll 8
    for (int it = 0; it < 32; ++it) { const int j = 1 + 4 * it + g; const size_t off = cbase + (size_t)(2048 - j * dd) * 512;
        const f32x4 kr = *(const f32x4*)(ck + off); const f32x4 vr = *(const f32x4*)(cv + off);
        float s = (q[0] * kr[0] + q[1] * kr[1]) + (q[2] * kr[2] + q[3] * kr[3]);
#pragma unroll
        for (int o = 1; o < 16; o <<= 1) s += __shfl_xor(s, o);
        s *= 0.125f;
        const float mn = fmaxf(mx, s), sc = fexp(mx - mn), pj = fexp(s - mn);
        den = den * sc + pj; o4 = o4 * sc + vr * pj; mx = mn; }
    float mg = fmaxf(mx, __shfl_xor(mx, 16)); mg = fmaxf(mg, __shfl_xor(mg, 32)); mg = fmaxf(mg, s0);
    { const float sc = fexp(mx - mg); den *= sc; o4 = o4 * sc; }
    den += __shfl_xor(den, 16); den += __shfl_xor(den, 32);
#pragma unroll
    for (int e = 0; e < 4; ++e) { o4[e] += __shfl_xor(o4[e], 16); o4[e] += __shfl_xor(o4[e], 32); }
    const float p0 = fexp(s0 - mg); den += p0; o4 = (o4 + vn * p0) * (1.0f / den); mx = mg;
    if (g == 0) *(f32x4*)((float*)(D.dec + DEC_OP) + ((size_t)p * MD + bd) * 512 + h * 64 + 4 * dq) = o4;
    if (lane == 0) ((float*)(D.dec + DEC_LSE))[((size_t)p * MD + bd) * 8 + h] = mx + __logf(den);
}
DI void dec_rwkv_task(const DecP& D, const float* const* in, int bd, int h, LAS float* sv  , int lane) {
    const int l = D.l, ch = h * 64 + lane;
    const float* PD = (const float*)(D.dec + DEC_PD) + (size_t)bd * NIN + RW0; const float* PS = (const float*)(D.dec + DEC_PS) + (size_t)bd * NRWU;
    const float* mu = in[8] + (size_t)l * 1792;
    auto zf = [&](int col) { const float pr = PD[col], pv = PS[col]; return pr + (pv - pr) * mu[col]; };
    const float zr = zf(ch), zk = zf(512 + ch), zv0 = zf(1024 + ch);
    float vl = 0.f; if (l > 0 && lane < 32) { const float pr = PD[1792 + lane], pv = PS[1792 + lane]; vl = pr + (pv - pr) * in[9][(size_t)(l - 1) * 32 + lane]; }
    sv[lane] = ftanh(zf(1536 + lane)); sv[64 + lane] = zf(1600 + lane); sv[128 + lane] = fsigmoid(zf(1664 + lane)); sv[192 + lane] = fsigmoid(zf(1728 + lane)); sv[256 + lane] = vl;
    LDS_WAIT();
    float dw = 0.f, da = 0.f, dv = 0.f, gt = 0.f;
    const float* du = in[11] + (size_t)l * 64 * 512 + ch; const float* iu = in[13] + (size_t)l * 64 * 512 + ch; const float* gu = in[14] + (size_t)l * 128 * 512 + ch;
#pragma unroll 2
    for (int m4 = 0; m4 < 16; ++m4) { const f32x4 a = *(const LAS f32x4*)(sv + 4 * m4), b = *(const LAS f32x4*)(sv + 64 + 4 * m4), c = *(const LAS f32x4*)(sv + 128 + 4 * m4), d = *(const LAS f32x4*)(sv + 192 + 4 * m4);
#pragma unroll
        for (int e = 0; e < 4; ++e) { const int m = 4 * m4 + e; dw += a[e] * du[(size_t)m * 512]; da += b[e] * iu[(size_t)m * 512]; gt += c[e] * gu[(size_t)m * 512] + d[e] * gu[(size_t)(64 + m) * 512]; } }
    if (l > 0) { const float* vu = in[16] + (size_t)(l - 1) * 32 * 512 + ch;
#pragma unroll
        for (int m4 = 0; m4 < 8; ++m4) { const f32x4 a = *(const LAS f32x4*)(sv + 256 + 4 * m4);
#pragma unroll
            for (int e = 0; e < 4; ++e) dv += a[e] * vu[(size_t)(4 * m4 + e) * 512]; } }
    const float w = -fsoftplus(-(in[10][(size_t)l * 512 + ch] + dw)) - 0.5f, decay = fexp(-fexp(w));
    const float a = fsigmoid(in[12][(size_t)l * 512 + ch] + da);
    float* VFD = (float*)(D.dec + DEC_VF) + (size_t)bd * 512 + ch;
    float v = zv0; if (l == 0) *VFD = zv0; else v = zv0 + (*VFD - zv0) * fsigmoid(in[15][(size_t)(l - 1) * 512 + ch] + dv);
    const float kr = zk * in[17][(size_t)l * 512 + ch]; const float kn = kr / fmaxf(sqrtf(wave_sum(kr * kr)), 1e-12f);
    const float k2 = zk * (1.f + (a - 1.f) * in[18][(size_t)l * 512 + ch]);
    const float bon = wave_sum(zr * k2 * in[19][(size_t)l * 512 + ch]);
    LDS_WAIT();
    sv[320 + lane] = -kn; sv[384 + lane] = decay; sv[448 + lane] = kn * a; sv[512 + lane] = k2; sv[576 + lane] = zr;
    LDS_WAIT();
    const float* S0 = in[3] + ((((size_t)l * MD + bd) * NH + h) * 64 + lane) * 64;
    float* So = D.out + O_WKS + ((((size_t)l * MD + bd) * NH + h) * 64 + lane) * 64;
    float sa = 0.f;
    { f32x4 Sr[16];
#pragma unroll
      for (int q = 0; q < 16; ++q) Sr[q] = *(const f32x4*)(S0 + 4 * q);
#pragma unroll
      for (int q = 0; q < 16; ++q) { const f32x4 a4 = *(const LAS f32x4*)(sv + 320 + 4 * q); sa += (Sr[q][0] * a4[0] + Sr[q][1] * a4[1]) + (Sr[q][2] * a4[2] + Sr[q][3] * a4[3]); } }
    asm volatile("" ::: "memory");
    float y = 0.f;
#pragma unroll 8
    for (int q = 0; q < 16; ++q) { const f32x4 s0 = *(const f32x4*)(S0 + 4 * q); const f32x4 w4 = *(const LAS f32x4*)(sv + 384 + 4 * q), b4 = *(const LAS f32x4*)(sv + 448 + 4 * q), k4 = *(const LAS f32x4*)(sv + 512 + 4 * q), r4 = *(const LAS f32x4*)(sv + 576 + 4 * q);
        const f32x4 s4 = s0 * w4 + b4 * sa + k4 * v; *(f32x4*)(So + 4 * q) = s4; y += (s4[0] * r4[0] + s4[1] * r4[1]) + (s4[2] * r4[2] + s4[3] * r4[3]); }
    const float mean = wave_sum(y) * (1.f / 64.f), dy = y - mean, var = wave_sum(dy * dy) * (1.f / 64.f);
    const float o = (dy * (1.0f / sqrtf(var + GN_EPS)) * in[20][(size_t)l * 512 + ch] + in[21][(size_t)l * 512 + ch] + bon * v) * gt;
    ((float*)(D.dec + DEC_MIX))[(size_t)bd * DM + 512 + ch] = o;
    LDS_WAIT();
}
DI void dec_finalize_row(const DecP& D, const float* gain, int bd, int lane) {
    const int h = lane >> 3; const float* L = (const float*)(D.dec + DEC_LSE); const float* OPD = (const float*)(D.dec + DEC_OP);
    const float l0 = L[((size_t)0 * MD + bd) * 8 + h], l1 = L[((size_t)1 * MD + bd) * 8 + h], l2 = L[((size_t)2 * MD + bd) * 8 + h];
    const float mx = fmaxf(l0, fmaxf(l1, l2)); float w0 = fexp(l0 - mx), w1 = fexp(l1 - mx), w2 = fexp(l2 - mx); const float inv = 1.0f / (w0 + w1 + w2); w0 *= inv; w1 *= inv; w2 *= inv;
    float v[8]; float ss = 0.f;
#pragma unroll
    for (int e = 0; e < 8; ++e) { v[e] = w0 * OPD[((size_t)0 * MD + bd) * 512 + lane * 8 + e] + w1 * OPD[((size_t)1 * MD + bd) * 512 + lane * 8 + e] + w2 * OPD[((size_t)2 * MD + bd) * 512 + lane * 8 + e]; ss += v[e] * v[e]; }
    ss = wave_sum(ss); const float rinv = 1.0f / sqrtf(ss * (1.f / 512.f) + RMS_EPS);
    bf16* MB = (bf16*)(D.dec + DEC_MIXB) + (size_t)bd * DM; const float* MX = (const float*)(D.dec + DEC_MIX) + (size_t)bd * DM + 512;
#pragma unroll
    for (int e = 0; e < 8; ++e) { MB[lane * 8 + e] = (bf16)f2bf(v[e] * rinv * gain[lane * 8 + e]); MB[512 + lane * 8 + e] = (bf16)f2bf(MX[lane * 8 + e]); }
}
#ifndef PH_MASK
#define PH_MASK 0x1ff
#endif
#define PH_ON(k) ((PH_MASK >> (k)) & 1)
#ifndef PH_DUP
#define PH_DUP 0
#endif
#define PH_REP(k) for (int rep_ = 0; rep_ < (((PH_DUP >> (k)) & 1) ? 2 : 1); ++rep_)
DI unsigned lds_task_next(volatile LAS unsigned* ctr, int lane) {
    unsigned t = 0; if (lane == 0) t = __hip_atomic_fetch_add((LAS unsigned*)ctr, 1u, __ATOMIC_RELAXED, __HIP_MEMORY_SCOPE_WORKGROUP);
    return (unsigned)__builtin_amdgcn_readfirstlane((int)t);
}
DI DecP make_dec(unsigned char* ws, const float* const* in, float* out, int l) {
    DecP D; D.dec = ws + WS_DEC; D.l = l; D.xs = in[1];
    D.c1in = (const float*)(ws + WS_C1IN) + l * NIN; D.c2in = (const float*)(ws + WS_C2IN) + l * NIN; D.c1up = (const float*)(ws + WS_C1UP) + l * FFD; D.c2up = (const float*)(ws + WS_C2UP) + l * FFD;
    D.g1 = in[24] + (size_t)l * DM; D.b1 = in[25] + (size_t)l * DM; D.g2p = l > 0 ? in[28] + (size_t)(l - 1) * DM : nullptr; D.b2p = l > 0 ? in[29] + (size_t)(l - 1) * DM : nullptr;
    D.win = (const bf16*)(ws + WS_WIN) + (size_t)l * NIN * DM; D.winu = (const bf16*)(ws + WS_WINU) + (size_t)l * NRWU * DM; D.wout = (const bf16*)(ws + WS_WOUT) + (size_t)l * DM * DM;
    D.wup = (const bf16*)(ws + WS_WUP) + (size_t)l * FFD * DM; D.wdn = (const bf16*)(ws + WS_WDN) + (size_t)l * DM * FFD; D.out = out; return D;
}
DI RwkvP make_rwkv(unsigned char* ws, const float* const* in, int l) {
    RwkvP R; R.PR = (const bf16*)(ws + WS_PR); R.mu = in[8] + (size_t)l * 1792; R.muv = l > 0 ? in[9] + (size_t)(l - 1) * 32 : nullptr;
    R.dbase = in[10] + (size_t)l * 512; R.ibase = in[12] + (size_t)l * 512; R.vbase = l > 0 ? in[15] + (size_t)(l - 1) * 512 : nullptr; R.ksk = in[17] + (size_t)l * 512; R.ksa = in[18] + (size_t)l * 512; R.brk = in[19] + (size_t)l * 512;
    R.gng = in[20] + (size_t)l * 512; R.gnb = in[21] + (size_t)l * 512;
    R.dupT = (const bf16*)(ws + WS_DUPT) + (size_t)l * 512 * 64; R.iupT = (const bf16*)(ws + WS_IUPT) + (size_t)l * 512 * 64; R.vupT = l > 0 ? (const bf16*)(ws + WS_VUPT) + (size_t)(l - 1) * 512 * 32 : nullptr; R.gupT = (const bf16*)(ws + WS_GUPT) + (size_t)l * 512 * 128;
    R.ZROW = (const bf16*)(ws + WS_CTL + 512 * 1024); R.VF = (bf16*)(ws + WS_VF); R.VV = (bf16*)(ws + WS_VV); R.BON = (float*)(ws + WS_BON); R.GC = (float*)(ws + WS_GC); R.W1S = (bf16*)(ws + WS_PT); R.REFF = (bf16*)(ws + WS_REFF); R.BM = (bf16*)(ws + WS_QT); R.REC = (v4u*)(ws + WS_YLOC);
    R.YPRE = (float*)(ws + WS_YPRE); R.MIX = (bf16*)(ws + WS_MIX); R.layer0 = (l == 0); return R;
}
#define PHASE_VARS() int tid_p = (int)threadIdx.x; asm volatile("" : "+v"(tid_p)); const int lane = tid_p & 63; const int wave = __builtin_amdgcn_readfirstlane(tid_p >> 6); \
    unsigned zo_p; asm volatile("s_mov_b32 %0, 0" : "=s"(zo_p)); unsigned char* ws = args.ws + zo_p; const float* const* in = args.in + zo_p; float* out = args.out + zo_p; \
    const int gw = F.vcu * NWAVES + wave; const int rgw = (F.G - 1 - (int)blockIdx.x) * NWAVES + wave; LAS float* dsc = (LAS float*)(L3 + 65536); LAS float* dred = (LAS float*)L3; const int rwg = F.G - 1 - (int)blockIdx.x; (void)gw; (void)rgw; (void)dsc; (void)dred; (void)rwg; (void)lane; (void)in; (void)out
__global__ void __launch_bounds__(NWAVES * 64, 2) mega_fwd(Args args) {
    extern __shared__ __attribute__((aligned(16))) unsigned char lds[];
    Frame F;
    F.lds = lds; F.MISC = (volatile LAS unsigned*)((LAS unsigned char*)lds + MISC_OFF);
    F.tid = threadIdx.x; F.lane = F.tid & 63; F.wave = __builtin_amdgcn_readfirstlane(F.tid >> 6);
    F.G = gridDim.x; { const int bx = blockIdx.x; F.vcu = (F.G % 8 == 0) ? (bx % 8) * (F.G / 8) + bx / 8 : bx; }
    F.gw = F.vcu * NWAVES + F.wave; F.NGW = F.G * NWAVES;
    F.in = args.in; F.out = args.out; F.ws = args.ws; F.ctl = (gu32*)(args.ws + WS_CTL);
    LAS unsigned char* L3 = (LAS unsigned char*)lds;
    for (int u = F.tid; u < (LDS_BYTES - RING_BYTES) / 4; u += NWAVES * 64) ((LAS unsigned*)(L3 + RING_BYTES))[u] = 0u;
    __syncthreads();
    XcdBarrier bar = xcd_barrier_post((unsigned*)(F.ctl + CW_BAR), F.MISC + 8);
#define GRID_BAR() do { XcdBarrier b2_ = bar; asm volatile("" : "+s"(b2_.x)); xcd_barrier(b2_); } while (0)

    PH_REP(0) { if (PH_ON(0)) p0_prologue(F);
    GRID_BAR(); }

    for (int l = 0; l < DEPTH; ++l) {
        PH_REP(1) {
        if (PH_ON(1))
        {   PHASE_VARS(); const DecP D = make_dec(ws, in, out, l);
            pg8::Gemm g{(const pg8::bf16_t*)(ws + WS_XB2), (const pg8::bf16_t*)D.win, M, NIN, DM}; pg8::StaticOrder S; S.init(M, NIN, F.G, (int)blockIdx.x);
            pg8::EpiIn E{ws, out, l};
            pg8::gemm_phase<pg8::EpiIn, pg8::StaticOrder, true, true>((PG8_LAS unsigned char*)L3, g, S, E, tid_p);
            for (int u = rwg; u < 162; u += F.G) dec_unit_in(D, u, dred, dsc, wave, lane);
        }
        GRID_BAR();
        }

#define ATT_QUEUE() do { LAS unsigned char* wl_ = L3 + wave * 10240; const int bh_ = F.vcu >> 4, span_ = F.vcu & 15; \
        for (;;) { const unsigned t_ = lds_task_next(F.MISC, lane); if (t_ >= 48u) break; \
            if (t_ >= 48u) { const int dt_ = (int)blockIdx.x * 4 + (int)(t_ - 48u); \
                if (dt_ < 768) dec_attn_task(D, in[4], in[5], (const float*)(ws + WS_ROPE), dt_ / 24, (dt_ % 24) / 3, dt_ % 3, lane); \
                else dec_rwkv_task(D, in, (dt_ - 768) >> 3, (dt_ - 768) & 7, (LAS float*)wl_, lane); continue; } \
            const int p_ = (int)t_ >> 4, idx_ = (int)t_ & 15; \
            const int cls_ = p_ == 0 ? 0 : p_ == 1 ? (idx_ >> 2) : idx_, qblk_ = p_ == 0 ? span_ * 16 + idx_ : p_ == 1 ? span_ * 4 + (idx_ & 3) : span_; \
            attn_task((const bf16*)(ws + WS_QB), (const bf16*)(ws + WS_KB), (const bf16*)(ws + WS_VB), (bf16*)(ws + WS_OP), (float*)(ws + WS_LSE), bh_ >> 3, bh_ & 7, p_, cls_, qblk_, wl_, lane); } } while (0)
        PH_REP(3) {
        if (PH_ON(3))
        {   PHASE_VARS(); const DecP D = make_dec(ws, in, out, l); const RwkvP R = make_rwkv(ws, in, l);
            if (tid_p == 0) F.MISC[0] = 0u;
            if (l == 0) colsum_finish(ws, gw * 64 + lane, F.NGW * 64);
            { LAS unsigned char* wl1 = L3 + wave * 12288; LAS unsigned char* hc = L3 + 8 * 12288;
              head_cache_fill(R, (F.vcu >> 4) & 7, hc, tid_p);
              __syncthreads();
#pragma unroll 1
              for (int i = 0; i < 4; ++i) rwkv_b1_unit(R, F.vcu * 32 + wave + 8 * i, wl1, hc, lane); }
            VM_WAIT(); __syncthreads();
            if (wave >= 4) { const int dt = (int)blockIdx.x * 4 + (wave - 4);
                if (dt < 768) dec_attn_task(D, in[4], in[5], (const float*)(ws + WS_ROPE), dt / 24, (dt % 24) / 3, dt % 3, lane);
                else dec_rwkv_task(D, in, (dt - 768) >> 3, (dt - 768) & 7, (LAS float*)(L3 + wave * 10240), lane); }
            if (wave < 4) chain_pass1(R, (float*)(ws + WS_SEGQ), (float*)(ws + WS_SEGP), F.vcu >> 4, F.vcu & 15, wave, lane);
            ATT_QUEUE();
            if ((PH_DUP >> 12) & 1) { __syncthreads(); if (tid_p == 0) F.MISC[0] = 0u; __syncthreads(); ATT_QUEUE(); }
        }
        GRID_BAR();
        }
        PH_REP(9) {
        if (PH_ON(3))
        {   PHASE_VARS(); const DecP D = make_dec(ws, in, out, l); const RwkvP R = make_rwkv(ws, in, l);
            const int seq = F.vcu >> 4, sg = F.vcu & 15;
            LAS unsigned char* gcache = L3 + 98304; gate_cache_fill(R, seq & 7, gcache, tid_p);
            if (wave < 4) chain_pass23(R, (const float*)(ws + WS_SEGQ), (const float*)(ws + WS_SEGP), seq, sg, wave, out + O_WKP + ((size_t)l * 16 + seq) * 4096, lane);
            else { for (int i = 0; i < 16; ++i) attn_finalize_row((const bf16*)(ws + WS_OP), (const float*)(ws + WS_LSE), in[22] + (size_t)l * 512, (bf16*)(ws + WS_MIX), (int)blockIdx.x * 64 + (wave - 4) * 16 + i, lane);
                if (blockIdx.x < MD && wave == 4) dec_finalize_row(D, in[22] + (size_t)l * 512, (int)blockIdx.x, lane); }
            VM_WAIT(); __syncthreads();
#pragma unroll 1
            for (int i = 0; i < 4; ++i) rwkv_b3_unit(R, seq * NCH + sg * SEGCH + wave + 8 * i, gcache, lane);
        }
        GRID_BAR();
        }

        PH_REP(5) {
        if (PH_ON(5))
        {   PHASE_VARS(); const DecP D = make_dec(ws, in, out, l);
            pg8::Gemm g{(const pg8::bf16_t*)(ws + WS_MIX), (const pg8::bf16_t*)D.wout, M, DM, DM}; pg8::StaticOrder S; S.init(M, DM, F.G, (int)blockIdx.x);
            pg8::EpiRes<false> E{ws, in, out, l};
            pg8::gemm_phase<pg8::EpiRes<false>, pg8::StaticOrder, false, true>((PG8_LAS unsigned char*)L3, g, S, E, tid_p);
            for (int u = rwg; u < 32; u += F.G)
                dec_unit_res((const bf16*)(D.dec + DEC_MIXB), D.wout, DM, u, l == 0, l == 0 ? D.xs : (const float*)(D.dec + DEC_T2), (const float*)(D.dec + DEC_ST2), D.g2p, D.b2p, (float*)(D.dec + DEC_T1), (bf16*)(D.dec + DEC_XB1), (float*)(D.dec + DEC_ST1),
                             out + O_SHS + (size_t)l * MD * DM, dred, dsc, wave, lane);
        }
        GRID_BAR();
        }

        PH_REP(6) {
        if (PH_ON(6))
        {   PHASE_VARS(); const DecP D = make_dec(ws, in, out, l);
            pg8::Gemm g{(const pg8::bf16_t*)(ws + WS_XB1), (const pg8::bf16_t*)D.wup, M, FFD, DM}; pg8::StaticOrder S; S.init(M, FFD, F.G, (int)blockIdx.x);
            pg8::EpiUp E{ws, l};
            pg8::gemm_phase<pg8::EpiUp, pg8::StaticOrder, true, true>((PG8_LAS unsigned char*)L3, g, S, E, tid_p);
            for (int u = rwg; u < 128; u += F.G) dec_unit_up(D, u, dred, dsc, wave, lane);
        }
        GRID_BAR();
        }

        PH_REP(7) {
        if (PH_ON(7))
        {   PHASE_VARS(); const DecP D = make_dec(ws, in, out, l);
            pg8::Gemm g{(const pg8::bf16_t*)(ws + WS_H), (const pg8::bf16_t*)D.wdn, M, DM, FFD}; pg8::StaticOrder S; S.init(M, DM, F.G, (int)blockIdx.x);
            pg8::EpiRes<true> E{ws, in, out, l};
            PH_REP(11) { pg8::gemm_phase<pg8::EpiRes<true>, pg8::StaticOrder, false, true>((PG8_LAS unsigned char*)L3, g, S, E, tid_p); }
            PH_REP(10) for (int u = rwg; u < 32; u += F.G)
                dec_unit_res((const bf16*)(D.dec + DEC_HB), D.wdn, FFD, u, false, (const float*)(D.dec + DEC_T1), (const float*)(D.dec + DEC_ST1), D.g1, D.b1, (float*)(D.dec + DEC_T2), (bf16*)(D.dec + DEC_XB2), (float*)(D.dec + DEC_ST2), nullptr, dred, dsc, wave, lane);
        }
        GRID_BAR();
        }
    }
    if (PH_ON(8))
    {   PHASE_VARS(); const float* g = in[28] + (size_t)3 * DM; const float* b = in[29] + (size_t)3 * DM;
        for (int r = gw; r < M; r += F.NGW) { float mu, rs; pg8::row_stats((const float*)(ws + WS_STAT2), r, mu, rs);
            const v2u* t = (const v2u*)((const bf16*)(ws + WS_XB2) + (size_t)r * DM) + lane; f32x4* o = (f32x4*)(out + O_Y + (size_t)r * DM) + lane;
#pragma unroll
            for (int j = 0; j < 4; ++j) { const f32x4 gg = *((const f32x4*)g + lane + 64 * j), bb = *((const f32x4*)b + lane + 64 * j); const v2u w = t[64 * j]; const f32x4 tv = {bflo(w.x), bfhi(w.x), bflo(w.y), bfhi(w.y)}; o[64 * j] = (tv - mu) * rs * gg + bb; } }
        if (rgw < MD) { LAS float* fsc = dsc + wave * 64; dec_row_stats((const float*)(ws + WS_DEC + DEC_ST2), fsc, lane); const float mu = fsc[2 * rgw], rs = fsc[2 * rgw + 1];
            const f32x4* t = (const f32x4*)((const float*)(ws + WS_DEC + DEC_T2) + (size_t)rgw * DM) + lane; f32x4* o = (f32x4*)(out + O_YS + (size_t)rgw * DM) + lane;
#pragma unroll
            for (int j = 0; j < 4; ++j) { const f32x4 gg = *((const f32x4*)g + lane + 64 * j), bb = *((const f32x4*)b + lane + 64 * j); o[64 * j] = (t[64 * j] - mu) * rs * gg + bb; } }
    }
}

extern "C" void kernel_launch(void* const* d_in, const int* in_sizes, int n_in, void* d_out, int out_size, void* d_ws, size_t ws_size, hipStream_t stream) {
    static int grid = 0;
    if (grid == 0) {
        if (n_in != 30 || out_size != (int)O_END || ws_size < WS_END) { fprintf(stderr, "kernel_launch: unexpected problem (n_in %d, out %d, ws %zu); nothing launched\n", n_in, out_size, ws_size); grid = -1; return; }
        int dev = 0, cus = 0, per_cu = 0;
        if (hipGetDevice(&dev) != hipSuccess || hipDeviceGetAttribute(&cus, hipDeviceAttributeMultiprocessorCount, dev) != hipSuccess) { fprintf(stderr, "kernel_launch: device query failed\n"); grid = -1; return; }
        if (hipFuncSetAttribute((const void*)mega_fwd, hipFuncAttributeMaxDynamicSharedMemorySize, LDS_BYTES) != hipSuccess) { fprintf(stderr, "kernel_launch: hipFuncSetAttribute failed\n"); grid = -1; return; }
        if (hipOccupancyMaxActiveBlocksPerMultiprocessor(&per_cu, (const void*)mega_fwd, NWAVES * 64, LDS_BYTES) != hipSuccess || per_cu < 1) fprintf(stderr, "kernel_launch: occupancy query reports %d\n", per_cu);
        (void)hipGetLastError();
        if (cus < 256) { fprintf(stderr, "kernel_launch: needs 256 CUs (found %d)\n", cus); grid = -1; return; }
        grid = 256;
    }
    if (grid < 0) return;
    if (hipMemsetAsync((char*)d_ws + WS_CTL, 0, CTL_ZERO_BYTES, stream) != hipSuccess) { fprintf(stderr, "kernel_launch: memset failed\n"); return; }
    Args a{};
    for (int i = 0; i < 30; ++i) a.in[i] = (const float*)d_in[i];
    a.out = (float*)d_out; a.ws = (unsigned char*)d_ws;
    hipLaunchKernelGGL(mega_fwd, dim3(grid), dim3(NWAVES * 64), LDS_BYTES, stream, a);
    const hipError_t le = hipPeekAtLastError();
    if (le != hipSuccess) fprintf(stderr, "kernel_launch: launch failed: %s\n", hipGetErrorName(le));
}
```

```cpp
#include <hip/hip_runtime.h>
#include <cstdio>
#include <cstdint>
#include <cmath>
namespace pg8 {
#define PG8_LAS __attribute__((address_space(3)))
typedef unsigned short bf16_t;
typedef short bf16x8 __attribute__((ext_vector_type(8)));
typedef float f32x4 __attribute__((ext_vector_type(4)));
typedef unsigned u32x4 __attribute__((ext_vector_type(4)));
constexpr int BM = 256, BK = 64, HALF = 128, HTB = HALF * BK * 2  , STAGE_BYTES = 8 * HTB, NXCD = 8, WGM = 8;

__host__ __device__ __forceinline__ int lds_byte(int r, int c) { const int st = (r >> 4) * 2 + (c >> 5), rr = r & 15, cc = c & 31, ob = rr * 64 + cc * 2; return st * 1024 + (ob ^ (((ob >> 9) & 1) << 5)); }
__host__ __device__ __forceinline__ void stage_rc(int b, int& R, int& C) { const int st = b / 1024, sb = b % 1024, swz = sb ^ (((sb >> 9) & 1) << 5); R = (st >> 1) * 16 + swz / 64; C = (st & 1) * 32 + (swz % 64) / 2; }
__host__ __device__ __forceinline__ int perm32(int rho) { const int n = rho >> 4, i = rho & 15; return 8 * (i >> 2) + 4 * n + (i & 3); }

struct Unit { int pm, pn; };
struct Gemm { const bf16_t* A; const bf16_t* Bt; int M, N, K; };

struct StaticOrder {
    int nM, nN, nwg, G, c;
    __host__ __device__ void init(int M, int N, int G_, int c_) { nM = M / BM; nN = N / BM; nwg = nM * nN; G = G_; c = c_; }
    __host__ __device__ bool next(int i, Unit& u) const {
        const long L = (long)i * G + c; if (L >= nwg) return false;
        int wgid = (int)L; { const int q = nwg / NXCD, r = nwg % NXCD, xcd = wgid % NXCD, off = wgid / NXCD; wgid = (xcd < r ? xcd * (q + 1) : r * (q + 1) + (xcd - r) * q) + off; }
        const int nig = WGM * nN, gid = wgid / nig, fm = gid * WGM, gsz = (nM - fm) < WGM ? (nM - fm) : WGM;
        u.pm = fm + ((wgid % nig) % gsz); u.pn = (wgid % nig) / gsz; return true;
    }
    __device__ __forceinline__ void a_ready(const Unit&) const {}
    __device__ __forceinline__ void done(const Unit&) const {}
};

__device__ __forceinline__ unsigned cvt_pk_bf16(float lo, float hi) { unsigned r; asm volatile("v_cvt_pk_bf16_f32 %0, %1, %2" : "=v"(r) : "v"(lo), "v"(hi)); return r; }
typedef float f32x2 __attribute__((ext_vector_type(2)));
constexpr size_t WSO_C1IN = 1u << 20, WSO_C2IN = WSO_C1IN + 4 * 3584 * 4, WSO_C1UP = WSO_C2IN + 4 * 3584 * 4, WSO_C2UP = WSO_C1UP + 4 * 4096 * 4, WSO_ROPE = 3u << 20, WSO_STAT1 = 8u << 20, WSO_STAT2 = 9u << 20;
constexpr size_t WSO_XB2 = 132ull << 20, WSO_XB1 = 164ull << 20, WSO_T1 = 196ull << 20, WSO_T2 = 260ull << 20, WSO_QB = 324ull << 20, WSO_KB = 340ull << 20, WSO_VB = 356ull << 20, WSO_PR = 372ull << 20, WSO_H = 580ull << 20;
constexpr size_t OO_SHP = 16809984, OO_KP = 21405696, OO_VP = 29794304;
__device__ __forceinline__ void row_stats(const float* stat, int row, float& mu, float& rs) {
    const f32x4 a = *(const f32x4*)(stat + (size_t)row * 8), b = *(const f32x4*)(stat + (size_t)row * 8 + 4);
    const float s = (a[0] + a[2]) + (b[0] + b[2]), q = (a[1] + a[3]) + (b[1] + b[3]);
    mu = s * (1.f / 1024.f); const float var = fmaxf(q * (1.f / 1024.f) - mu * mu, 0.f); rs = 1.0f / sqrtf(var + 1e-5f);
}
typedef float f32x2e __attribute__((ext_vector_type(2)));
typedef unsigned u32x2e __attribute__((ext_vector_type(2)));
struct EpiIn {
    static constexpr bool PERM = true, AFTER_DRAIN = false;
    unsigned char* ws; float* out; int l;
    __device__ __forceinline__ void operator()(const f32x4 (&acc)[2][2][4][2], const Unit& u, int wr, int wc, int fr, int fq) const {
        asm volatile("" ::: "memory"); __builtin_amdgcn_sched_barrier(0);
        const int fold = l > 0; const float* stat = (const float*)(ws + WSO_STAT2); const float* c1 = (const float*)(ws + WSO_C1IN) + l * 3584; const float* c2 = (const float*)(ws + WSO_C2IN) + l * 3584;
        bf16_t* QB = (bf16_t*)(ws + WSO_QB); bf16_t* KB = (bf16_t*)(ws + WSO_KB); bf16_t* VB = (bf16_t*)(ws + WSO_VB); bf16_t* PR = (bf16_t*)(ws + WSO_PR); const float* rope = (const float*)(ws + WSO_ROPE);
        float* outk = out + OO_KP + (size_t)l * 2 * 2048 * 512; float* outv = out + OO_VP + (size_t)l * 2 * 2048 * 512; const float qscale = 0.125f * 1.4426950408889634f;
        const int cb = u.pn * BM + wc * 32 + 8 * fq;
        const int i0 = 16 * (wc & 1) + 4 * fq; const bool roped = u.pn < 4;
        const int rbase = u.pm * BM + wr * 64 + fr;
        float mu8[8], rs8[8];
#pragma unroll
        for (int gq = 0; gq < 8; ++gq) { mu8[gq] = 0.f; rs8[gq] = 1.f; if (fold) row_stats(stat, rbase + (gq >> 2) * HALF + (gq & 3) * 16, mu8[gq], rs8[gq]); }
#pragma unroll
        for (int bj = 0; bj < 2; ++bj) {
            f32x4 c1v[2], c2v[2];
#pragma unroll
            for (int n = 0; n < 2; ++n) { c1v[n] = fold ? *(const f32x4*)(c1 + cb + bj * HALF + n * 4) : (f32x4){0.f, 0.f, 0.f, 0.f}; c2v[n] = fold ? *(const f32x4*)(c2 + cb + bj * HALF + n * 4) : (f32x4){0.f, 0.f, 0.f, 0.f}; }
#pragma unroll
            for (int gq = 0; gq < 8; ++gq) {
                const int ai = gq >> 2, m = gq & 3;
                const int r = rbase + ai * HALF + m * 16;
                const float mu = mu8[gq], rs = rs8[gq];
                f32x4 ra = {0.f, 0.f, 0.f, 0.f}, rb = ra;
                if (roped) { const float* rp = rope + ((size_t)(r & 8191) * 32 + i0) * 2; ra = *(const f32x4*)rp; rb = *(const f32x4*)(rp + 4); }
                if ((gq & 3) == 3) asm volatile("" ::: "memory");
                f32x4 v[2];
#pragma unroll
                for (int n = 0; n < 2; ++n) v[n] = (acc[ai][bj][m][n] - mu * c1v[n]) * rs + c2v[n];
                const int pos = r & 8191, b = r >> 13;
                if (roped) {
                    const f32x4 cs = {ra[0], ra[2], rb[0], rb[2]}, sn = {ra[1], ra[3], rb[1], rb[3]};
                    const int head = (u.pn & 1) * 4 + bj * 2 + (wc >> 1);
                    f32x4 y1 = v[0] * cs - v[1] * sn, y2 = v[0] * sn + v[1] * cs;
                    const size_t o = (size_t)r * 512 + head * 64 + i0;
                    if (u.pn < 2) { y1 = y1 * qscale; y2 = y2 * qscale;
                        u32x2e w; w.x = cvt_pk_bf16(y1[0], y1[1]); w.y = cvt_pk_bf16(y1[2], y1[3]); *(u32x2e*)(QB + o) = w;
                        w.x = cvt_pk_bf16(y2[0], y2[1]); w.y = cvt_pk_bf16(y2[2], y2[3]); *(u32x2e*)(QB + o + 32) = w;
                    } else {
                        u32x2e w; w.x = cvt_pk_bf16(y1[0], y1[1]); w.y = cvt_pk_bf16(y1[2], y1[3]); *(u32x2e*)(KB + o) = w;
                        w.x = cvt_pk_bf16(y2[0], y2[1]); w.y = cvt_pk_bf16(y2[2], y2[3]); *(u32x2e*)(KB + o + 32) = w;
                        if (pos >= 6144) { float* ok = outk + ((size_t)(b * 2048 + pos - 6144)) * 512 + head * 64 + i0; *(f32x4*)ok = y1; *(f32x4*)(ok + 32) = y2; }
                    }
                } else if (u.pn < 6) {
                    const int c = cb + bj * HALF - 1024;
                    u32x4 w; w.x = cvt_pk_bf16(v[0][0], v[0][1]); w.y = cvt_pk_bf16(v[0][2], v[0][3]); w.z = cvt_pk_bf16(v[1][0], v[1][1]); w.w = cvt_pk_bf16(v[1][2], v[1][3]); *(u32x4*)(VB + (size_t)r * 512 + c) = w;
                    if (pos >= 6144) { float* ov = outv + ((size_t)(b * 2048 + pos - 6144)) * 512 + c; *(f32x4*)ov = v[0]; *(f32x4*)(ov + 4) = v[1]; }
                } else {
                    const int c = cb + bj * HALF - 1536;
                    if (c < 1824) { u32x4 w; w.x = cvt_pk_bf16(v[0][0], v[0][1]); w.y = cvt_pk_bf16(v[0][2], v[0][3]); w.z = cvt_pk_bf16(v[1][0], v[1][1]); w.w = cvt_pk_bf16(v[1][2], v[1][3]); *(u32x4*)(PR + (size_t)r * 2048 + c) = w; }
                }
            }
        }
    }
};
template <bool IS_F> struct EpiRes {
    static constexpr bool PERM = true, AFTER_DRAIN = true;
    unsigned char* ws; const float* const* in; float* out; int l;
    __device__ __forceinline__ void fused(f32x4 (&acc)[2][2][4][2], const Unit& u, int wr, int wc, int fr, int fq, PG8_LAS unsigned char* lds, int wid, int lane) const {
        const int raw = (!IS_F && l == 0) ? 1 : 0;
        const bf16_t* src = (const bf16_t*)(ws + (IS_F ? WSO_XB1 : WSO_XB2));
        const float* sstat = (const float*)(ws + (IS_F ? WSO_STAT1 : WSO_STAT2));
        const float* g = IS_F ? in[24] + (size_t)l * 1024 : in[28] + (size_t)(l > 0 ? l - 1 : 0) * 1024; const float* b = IS_F ? in[25] + (size_t)l * 1024 : in[29] + (size_t)(l > 0 ? l - 1 : 0) * 1024;
        bf16_t* XB = (bf16_t*)(ws + (IS_F ? WSO_XB2 : WSO_XB1)); float* ostat = (float*)(ws + (IS_F ? WSO_STAT2 : WSO_STAT1));
        float* shiftout = (IS_F || raw) ? nullptr : out + OO_SHP + (size_t)l * 2 * 1024; const float alpha = 1.6817928305074290f;
        PG8_LAS f32x2e* P = (PG8_LAS f32x2e*)lds;
        const int cb = u.pn * BM + wc * 32 + 8 * fq;
        const int rbase = u.pm * BM + wr * 64 + fr;
        u32x4 cur[2], nxt[2]; f32x4 sa = {0.f, 0.f, 0.f, 0.f}, sb = sa, san = sa, sbn = sa;
#pragma unroll
        for (int bj = 0; bj < 2; ++bj) { cur[bj] = *(const u32x4*)(src + (size_t)rbase * 1024 + cb + bj * HALF); nxt[bj] = cur[bj]; }
        if (!raw) { sa = *(const f32x4*)(sstat + (size_t)rbase * 8); sb = *(const f32x4*)(sstat + (size_t)rbase * 8 + 4); }
#pragma unroll
        for (int gq = 0; gq < 8; ++gq) {
            const int ai = gq >> 2, m = gq & 3;
            const int r = rbase + ai * HALF + m * 16;
            if (gq < 7) { const int rn = rbase + ((gq + 1) >> 2) * HALF + ((gq + 1) & 3) * 16;
#pragma unroll
                for (int bj = 0; bj < 2; ++bj) nxt[bj] = *(const u32x4*)(src + (size_t)rn * 1024 + cb + bj * HALF);
                if (!raw) { san = *(const f32x4*)(sstat + (size_t)rn * 8); sbn = *(const f32x4*)(sstat + (size_t)rn * 8 + 4); } }
            asm volatile("" ::: "memory");
            float mu = 0.f, rs = 1.f;
            if (!raw) { const float ssum = (sa[0] + sa[2]) + (sb[0] + sb[2]), qsum = (sa[1] + sa[3]) + (sb[1] + sb[3]); mu = ssum * (1.f / 1024.f); rs = 1.0f / sqrtf(fmaxf(qsum * (1.f / 1024.f) - mu * mu, 0.f) + 1e-5f); }
            float s = 0.f, q = 0.f;
#pragma unroll
            for (int bj = 0; bj < 2; ++bj) { const int c = cb + bj * HALF; const size_t off = (size_t)r * 1024 + c; const u32x4 cw = cur[bj]; u32x4 wout;
#pragma unroll
                for (int n = 0; n < 2; ++n) {
                    const f32x4 gvv = raw ? (f32x4){1.f, 1.f, 1.f, 1.f} : *(const f32x4*)(g + c + 4 * n), bvv = raw ? (f32x4){0.f, 0.f, 0.f, 0.f} : *(const f32x4*)(b + c + 4 * n);
                    const unsigned w0 = n ? cw.z : cw.x, w1 = n ? cw.w : cw.y;
                    const f32x4 cf = {__builtin_bit_cast(float, w0 << 16), __builtin_bit_cast(float, w0 & 0xffff0000u), __builtin_bit_cast(float, w1 << 16), __builtin_bit_cast(float, w1 & 0xffff0000u)};
                    const f32x4 x = (cf - mu) * rs * gvv + bvv;
                    const f32x4 t = x * alpha + acc[ai][bj][m][n];
                    const unsigned p0 = cvt_pk_bf16(t[0], t[1]), p1 = cvt_pk_bf16(t[2], t[3]); if (n) { wout.z = p0; wout.w = p1; } else { wout.x = p0; wout.y = p1; }
                    s += (t[0] + t[1]) + (t[2] + t[3]); q += (t[0] * t[0] + t[1] * t[1]) + (t[2] * t[2] + t[3] * t[3]);
                    if (shiftout && (r & 8191) == 8191) *(f32x4*)(shiftout + (size_t)(r >> 13) * 1024 + c + 4 * n) = x; }
                *(u32x4*)(XB + off) = wout; }
            s += __shfl_xor(s, 16); s += __shfl_xor(s, 32); q += __shfl_xor(q, 16); q += __shfl_xor(q, 32);
            if (fq == 0) P[(ai * HALF + wr * 64 + m * 16 + fr) * 4 + wc] = (f32x2e){s, q};
#pragma unroll
            for (int bj = 0; bj < 2; ++bj) cur[bj] = nxt[bj];
            sa = san; sb = sbn;
        }
        asm volatile("s_waitcnt lgkmcnt(0)" ::: "memory"); __builtin_amdgcn_s_barrier(); asm volatile("" ::: "memory");
        if (threadIdx.x < 256) { const int row = threadIdx.x; const f32x2e a = P[row * 4 + 0], b2 = P[row * 4 + 1], c = P[row * 4 + 2], d = P[row * 4 + 3];
            *(f32x2e*)(ostat + (size_t)(u.pm * BM + row) * 8 + u.pn * 2) = (f32x2e){(a.x + b2.x) + (c.x + d.x), (a.y + b2.y) + (c.y + d.y)}; }
        asm volatile("s_waitcnt lgkmcnt(0)" ::: "memory"); __builtin_amdgcn_s_barrier(); asm volatile("" ::: "memory");
    }
};
struct EpiUp {
    static constexpr bool PERM = true, AFTER_DRAIN = false;
    unsigned char* ws; int l;
    __device__ __forceinline__ void operator()(const f32x4 (&acc)[2][2][4][2], const Unit& u, int wr, int wc, int fr, int fq) const {
        asm volatile("" ::: "memory"); __builtin_amdgcn_sched_barrier(0);
        const float* stat = (const float*)(ws + WSO_STAT1); const float* c1 = (const float*)(ws + WSO_C1UP) + l * 4096; const float* c2 = (const float*)(ws + WSO_C2UP) + l * 4096; bf16_t* H = (bf16_t*)(ws + WSO_H);
        const int cb = u.pn * BM + wc * 32 + 8 * fq;
        float mu8[8], rs8[8];
#pragma unroll
        for (int gq = 0; gq < 8; ++gq) row_stats(stat, u.pm * BM + (gq >> 2) * HALF + wr * 64 + (gq & 3) * 16 + fr, mu8[gq], rs8[gq]);
#pragma unroll
        for (int bj = 0; bj < 2; ++bj) {
            f32x4 c1v[2], c2v[2];
#pragma unroll
            for (int n = 0; n < 2; ++n) { c1v[n] = *(const f32x4*)(c1 + cb + bj * HALF + 4 * n); c2v[n] = *(const f32x4*)(c2 + cb + bj * HALF + 4 * n); }
#pragma unroll
            for (int ai = 0; ai < 2; ++ai) {
#pragma unroll
                for (int m = 0; m < 4; ++m) {
                    const int r = u.pm * BM + ai * HALF + wr * 64 + m * 16 + fr;
                    const float mu = mu8[ai * 4 + m], rs = rs8[ai * 4 + m];
                    f32x4 v0 = (acc[ai][bj][m][0] - mu * c1v[0]) * rs + c2v[0], v1 = (acc[ai][bj][m][1] - mu * c1v[1]) * rs + c2v[1];
#pragma unroll
                    for (int e = 0; e < 4; ++e) { const float a = fmaxf(v0[e], 0.f), b = fmaxf(v1[e], 0.f); v0[e] = a * a; v1[e] = b * b; }
                    u32x4 w; w.x = cvt_pk_bf16(v0[0], v0[1]); w.y = cvt_pk_bf16(v0[2], v0[3]); w.z = cvt_pk_bf16(v1[0], v1[1]); w.w = cvt_pk_bf16(v1[2], v1[3]);
                    *(u32x4*)(H + (size_t)r * 4096 + cb + bj * HALF) = w; }
            }
        }
    }
};
template <class Epi, class Sched, bool ALIGN_EPI = false, bool SP2 = false>
__device__ __forceinline__ void gemm_phase(PG8_LAS unsigned char* lds, const Gemm g, const Sched& S, const Epi& E, const int tid) {
    const int wid = __builtin_amdgcn_readfirstlane(tid >> 6), lane = tid & 63, wr = wid >> 2, wc = wid & 3, fr = lane & 15, fq = lane >> 4;
    const int K = g.K, nt = K / BK;
    unsigned voffA[2], voffB[2];
#pragma unroll
    for (int i = 0; i < 2; ++i) { int R, C; stage_rc(tid * 16 + i * 8192, R, C); const int Rb = Epi::PERM ? ((R & ~31) + perm32(R & 31)) : R;
        voffA[i] = (unsigned)(R * K + C) * 2u; voffB[i] = (unsigned)(Rb * K + C) * 2u; }
    const size_t kstep = (size_t)(BK * 2);
    const size_t hstep = (size_t)HALF * K * 2;
    const size_t tstep = 2 * hstep;
    const unsigned ldsw = (unsigned)wid * 1024u;
    const int aoff = lds_byte(wr * 64 + fr, fq * 8), boff = lds_byte(wc * 32 + fr, fq * 8);
#define PG8_SA(b, h) (((b) * 2 + (h)) * HTB)
#define PG8_SB(b, h) ((4 + (b) * 2 + (h)) * HTB)
#define PG8_STAGE(bufoff, gbase, voff) do { _Pragma("unroll") for (int _i = 0; _i < 2; ++_i) \
        __builtin_amdgcn_global_load_lds((const unsigned*)((const char*)(gbase) + (voff)[_i]), (PG8_LAS unsigned*)(lds + (bufoff) + ldsw + _i * 8192), 16, 0, 0); } while (0)
#define PG8_LDA(dst, b, h) do { _Pragma("unroll") for (int m = 0; m < 4; ++m) _Pragma("unroll") for (int k = 0; k < 2; ++k) dst[m][k] = *(const PG8_LAS bf16x8*)(lds + PG8_SA(b, h) + aoff + m * 2048 + k * 1024); } while (0)
#define PG8_LDB(dst, b, h) do { _Pragma("unroll") for (int n = 0; n < 2; ++n) _Pragma("unroll") for (int k = 0; k < 2; ++k) dst[n][k] = *(const PG8_LAS bf16x8*)(lds + PG8_SB(b, h) + boff + n * 2048 + k * 1024); } while (0)
#define PG8_MMA(ai, bj, At, Bt) do { __builtin_amdgcn_s_setprio(1); _Pragma("unroll") for (int m = 0; m < 4; ++m) _Pragma("unroll") for (int n = 0; n < 2; ++n) _Pragma("unroll") for (int k = 0; k < 2; ++k) \
        acc[ai][bj][m][n] = __builtin_amdgcn_mfma_f32_16x16x32_bf16(Bt[n][k], At[m][k], acc[ai][bj][m][n], 0, 0, 0); __builtin_amdgcn_s_setprio(0); } while (0)
#define PG8_WAIT_V(n) asm volatile("s_waitcnt vmcnt(" #n ")" ::: "memory")
#define PG8_WAIT_L(n) asm volatile("s_waitcnt lgkmcnt(" #n ")" ::: "memory")
#define PG8_BAR __builtin_amdgcn_s_barrier()
#define PG8_SCHED __builtin_amdgcn_sched_barrier(0)
    Unit cur, nxt; int ui = 0;
    if (!S.next(0, cur)) return;
    f32x4 acc[2][2][4][2];
#pragma unroll
    for (int a = 0; a < 2; ++a)
#pragma unroll
        for (int b = 0; b < 2; ++b)
#pragma unroll
            for (int m = 0; m < 4; ++m)
#pragma unroll
                for (int n = 0; n < 2; ++n) acc[a][b][m][n] = (f32x4){0.f, 0.f, 0.f, 0.f};
    bf16x8 At[4][2], B0[2][2], B1[2][2];
    const char* cA = (const char*)g.A + (size_t)cur.pm * tstep; const char* cB = (const char*)g.Bt + (size_t)cur.pn * tstep;
    S.a_ready(cur);
    if constexpr (SP2) {
        PG8_STAGE(PG8_SB(0, 0), cB, voffB); PG8_STAGE(PG8_SB(0, 1), cB + hstep, voffB); PG8_STAGE(PG8_SA(0, 0), cA, voffA); PG8_STAGE(PG8_SA(0, 1), cA + hstep, voffA);
        if (wr == 1) PG8_BAR;
        PG8_WAIT_V(2); PG8_BAR;
        PG8_STAGE(PG8_SB(1, 0), cB + kstep, voffB); PG8_STAGE(PG8_SA(1, 0), cA + kstep, voffA); PG8_STAGE(PG8_SB(1, 1), cB + hstep + kstep, voffB);
        PG8_WAIT_V(6); PG8_BAR;
    } else {
        PG8_STAGE(PG8_SB(0, 0), cB, voffB); PG8_STAGE(PG8_SA(0, 0), cA, voffA); PG8_STAGE(PG8_SB(0, 1), cB + hstep, voffB); PG8_STAGE(PG8_SA(0, 1), cA + hstep, voffA);
        if (wr == 1) PG8_BAR;
        PG8_WAIT_V(4); PG8_BAR;
        PG8_STAGE(PG8_SB(1, 0), cB + kstep, voffB); PG8_STAGE(PG8_SA(1, 0), cA + kstep, voffA); PG8_STAGE(PG8_SB(1, 1), cB + hstep + kstep, voffB);
        PG8_WAIT_V(6); PG8_BAR;
    }
    for (;;) {
        const bool has_next = S.next(ui + 1, nxt);
        const char* nA = has_next ? (const char*)g.A + (size_t)nxt.pm * tstep : cA; const char* nB = has_next ? (const char*)g.Bt + (size_t)nxt.pn * tstep : cB;
        for (int t = 0; t < nt; t += 2) {
            const bool last = (t == nt - 2);
            const char* a1 = cA + (size_t)(t + 1) * kstep;
            const char* a2 = last ? nA : cA + (size_t)(t + 2) * kstep; const char* b2 = last ? nB : cB + (size_t)(t + 2) * kstep;
            const char* a3 = a2 + kstep; const char* b3 = b2 + kstep;
            if (last && has_next) S.a_ready(nxt);
            if constexpr (SP2) {
            PG8_LDB(B0, 0, 0); PG8_LDB(B1, 0, 1); PG8_SCHED; PG8_LDA(At, 0, 0); PG8_STAGE(PG8_SA(1, 1), a1 + hstep, voffA);
            PG8_WAIT_V(8); PG8_WAIT_L(0); PG8_BAR; PG8_MMA(0, 0, At, B0); PG8_MMA(0, 1, At, B1); PG8_BAR; PG8_SCHED;
            PG8_LDA(At, 0, 1); PG8_STAGE(PG8_SB(0, 0), b2, voffB); PG8_STAGE(PG8_SB(0, 1), b2 + hstep, voffB); PG8_STAGE(PG8_SA(0, 0), a2, voffA);
            PG8_WAIT_V(8); PG8_WAIT_L(0); PG8_BAR; PG8_MMA(1, 0, At, B0); PG8_MMA(1, 1, At, B1); PG8_BAR; PG8_SCHED;
            PG8_LDB(B0, 1, 0); PG8_LDB(B1, 1, 1); PG8_SCHED; PG8_LDA(At, 1, 0); PG8_STAGE(PG8_SA(0, 1), a2 + hstep, voffA);
            PG8_WAIT_V(8); PG8_WAIT_L(0); PG8_BAR; PG8_MMA(0, 0, At, B0); PG8_MMA(0, 1, At, B1); PG8_BAR; PG8_SCHED;
            PG8_LDA(At, 1, 1); PG8_STAGE(PG8_SB(1, 0), b3, voffB); PG8_STAGE(PG8_SB(1, 1), b3 + hstep, voffB); PG8_STAGE(PG8_SA(1, 0), a3, voffA);
            PG8_WAIT_V(8); PG8_WAIT_L(0); PG8_BAR; PG8_MMA(1, 0, At, B0); PG8_MMA(1, 1, At, B1); PG8_BAR; PG8_SCHED;
            } else {
            PG8_LDB(B0, 0, 0); PG8_SCHED; PG8_LDA(At, 0, 0); PG8_STAGE(PG8_SA(1, 1), a1 + hstep, voffA);
            PG8_WAIT_L(8); PG8_BAR; PG8_WAIT_L(0); PG8_MMA(0, 0, At, B0); PG8_BAR; PG8_SCHED;
            PG8_LDB(B1, 0, 1); PG8_STAGE(PG8_SB(0, 0), b2, voffB);
            PG8_BAR; PG8_WAIT_L(0); PG8_MMA(0, 1, At, B1); PG8_BAR;
            PG8_LDA(At, 0, 1); PG8_STAGE(PG8_SA(0, 0), a2, voffA);
            PG8_BAR; PG8_WAIT_L(0); PG8_MMA(1, 0, At, B0); PG8_BAR; PG8_SCHED;
            PG8_STAGE(PG8_SB(0, 1), b2 + hstep, voffB);
            PG8_WAIT_V(6); PG8_BAR; PG8_MMA(1, 1, At, B1); PG8_BAR;
            PG8_LDB(B0, 1, 0); PG8_SCHED; PG8_LDA(At, 1, 0); PG8_STAGE(PG8_SA(0, 1), a2 + hstep, voffA);
            PG8_WAIT_L(8); PG8_BAR; PG8_WAIT_L(0); PG8_MMA(0, 0, At, B0); PG8_BAR; PG8_SCHED;
            PG8_LDB(B1, 1, 1); PG8_STAGE(PG8_SB(1, 0), b3, voffB);
            PG8_BAR; PG8_WAIT_L(0); PG8_MMA(0, 1, At, B1); PG8_BAR;
            PG8_LDA(At, 1, 1); PG8_STAGE(PG8_SA(1, 0), a3, voffA);
            PG8_BAR; PG8_WAIT_L(0); PG8_MMA(1, 0, At, B0); PG8_BAR; PG8_SCHED;
            PG8_STAGE(PG8_SB(1, 1), b3 + hstep, voffB);
            PG8_WAIT_V(6); PG8_BAR; PG8_MMA(1, 1, At, B1); PG8_BAR;
            }
        }
        if constexpr (ALIGN_EPI) { if (wr == 0) PG8_BAR; }
        if constexpr (!Epi::AFTER_DRAIN) { E(acc, cur, wr, wc, fr, fq); S.done(cur); }
        if (!has_next) break;
#pragma unroll
        for (int a = 0; a < 2; ++a)
#pragma unroll
            for (int b = 0; b < 2; ++b)
#pragma unroll
                for (int m = 0; m < 4; ++m)
#pragma unroll
                    for (int n = 0; n < 2; ++n) acc[a][b][m][n] = (f32x4){0.f, 0.f, 0.f, 0.f};
        cur = nxt; cA = nA; cB = nB; ++ui;
        if constexpr (ALIGN_EPI) { if (wr == 1) PG8_BAR; }
    }
    PG8_WAIT_V(0);
    if constexpr (!ALIGN_EPI) { if (wr == 0) PG8_BAR; }
    PG8_BAR;
    if constexpr (Epi::AFTER_DRAIN) { E.fused(acc, cur, wr, wc, fr, fq, lds, wid, lane); S.done(cur); }
#undef PG8_SA
#undef PG8_SB
#undef PG8_STAGE
#undef PG8_LDA
#undef PG8_LDB
#undef PG8_MMA
#undef PG8_WAIT_V
#undef PG8_WAIT_L
#undef PG8_BAR
#undef PG8_SCHED
}
}
constexpr int NWAVES = 8;
constexpr int M = 16384, TSEQ = 8192, DM = 1024, FFD = 4096, DEPTH = 4, MD = 32, NH = 8, HD = 64;
constexpr int NIN = 3584;
constexpr int RW0 = 1536;
constexpr int PRP = 2048;
constexpr int NRWU = 1856;
constexpr int CH = 16, NCH = TSEQ / CH;
constexpr int NUNIT = 2 * NH * NCH;
constexpr float LN_EPS = 1e-5f, GN_EPS = 64e-5f, RMS_EPS = 1e-6f;
constexpr float ALPHA = 1.6817928305074290f;
constexpr float QSCALE = 0.125f * 1.4426950408889634f;
constexpr size_t O_Y = 0, O_YS = 16777216, O_SHP = 16809984, O_SHS = 16818176, O_WKP = 16949248, O_WKS = 17211392,
                 O_KP = 21405696, O_VP = 29794304, O_KS = 38182912, O_VS = 38248448, O_END = 38313984;
constexpr size_t MiB = 1u << 20;
constexpr size_t WS_CTL = 0, CTL_ZERO_BYTES = 1 * MiB;
constexpr size_t WS_C1IN = 1 * MiB;
constexpr size_t WS_C2IN = WS_C1IN + 4 * NIN * 4;
constexpr size_t WS_C1UP = WS_C2IN + 4 * NIN * 4;
constexpr size_t WS_C2UP = WS_C1UP + 4 * FFD * 4;
constexpr size_t WS_DUPT = WS_C2UP + 4 * FFD * 4;
constexpr size_t WS_IUPT = WS_DUPT + 4 * 512 * 64 * 2;
constexpr size_t WS_GUPT = WS_IUPT + 4 * 512 * 64 * 2;
constexpr size_t WS_VUPT = WS_GUPT + 4 * 512 * 128 * 2;
constexpr size_t WS_SMALL_END = WS_VUPT + 3 * 512 * 32 * 2;
static_assert(WS_SMALL_END <= 3 * MiB, "small region");
constexpr size_t WS_ROPE = 3 * MiB;
constexpr size_t WS_DEC = 6 * MiB;
constexpr size_t WS_STAT1 = 8 * MiB, WS_STAT2 = 9 * MiB;
constexpr size_t WS_BON = 10 * MiB;
constexpr size_t WS_LSE = 11 * MiB;
constexpr size_t WS_GC = 13 * MiB;
constexpr size_t WS_WIN = 16 * MiB;
constexpr size_t WS_WINU = 44 * MiB;
constexpr size_t WS_WOUT = 60 * MiB;
constexpr size_t WS_WUP = 68 * MiB;
constexpr size_t WS_WDN = 100 * MiB;
constexpr size_t WS_XB2 = 132 * MiB;
constexpr size_t WS_XB1 = 164 * MiB;
constexpr size_t WS_T1 = 196 * MiB;
constexpr size_t WS_T2 = 260 * MiB;
constexpr size_t WS_QB = 324 * MiB, WS_KB = 340 * MiB, WS_VB = 356 * MiB;
constexpr size_t WS_PR = 372 * MiB;
constexpr size_t WS_OP = 436 * MiB;
constexpr size_t WS_MIX = 484 * MiB;
constexpr size_t WS_VF = 516 * MiB, WS_VV = 532 * MiB;
constexpr size_t WS_YPRE = 548 * MiB;
constexpr size_t WS_H = 580 * MiB;
constexpr size_t WS_PT = 580 * MiB;
constexpr size_t WS_QT = 644 * MiB;
constexpr size_t WS_REFF = 708 * MiB;
constexpr size_t WS_YLOC = 724 * MiB;
constexpr size_t WS_SEGQ = 756 * MiB, WS_SEGP = 760 * MiB;
constexpr size_t WS_CSUM = 764 * MiB;
constexpr size_t WS_CSUP = 766 * MiB;
constexpr size_t WS_END = 768 * MiB;
static_assert(WS_H + (size_t)M * FFD * 2 <= WS_END + 0 * MiB || true, "");
constexpr size_t DEC_XB2 = 0;
constexpr size_t DEC_XB1 = 64 * 1024;
constexpr size_t DEC_SHB = 128 * 1024;
constexpr size_t DEC_MIXB = 384 * 1024;
constexpr size_t DEC_HB = 448 * 1024;
constexpr size_t DEC_T1 = 704 * 1024;
constexpr size_t DEC_T2 = 832 * 1024;
constexpr size_t DEC_PD = 960 * 1024;
constexpr size_t DEC_PS = 1408 * 1024;
constexpr size_t DEC_OP = 1640 * 1024;
constexpr size_t DEC_LSE = 1832 * 1024;
constexpr size_t DEC_MIX = 1836 * 1024;
constexpr size_t DEC_ST1 = 1964 * 1024;
constexpr size_t DEC_ST2 = 1972 * 1024;
constexpr size_t DEC_VF = 1980 * 1024;
static_assert(DEC_VF + 32 * 512 * 4 <= 2 * MiB, "decode scratch");
constexpr int CW_BAR = 4096;
constexpr int RING_BYTES = 131072;
constexpr int MISC_OFF = RING_BYTES + 320;
constexpr int LDS_BYTES = 147456;
static_assert(pg8::WSO_C1IN == WS_C1IN && pg8::WSO_C2IN == WS_C2IN && pg8::WSO_C1UP == WS_C1UP && pg8::WSO_C2UP == WS_C2UP && pg8::WSO_ROPE == WS_ROPE && pg8::WSO_STAT1 == WS_STAT1 && pg8::WSO_STAT2 == WS_STAT2 &&
              pg8::WSO_XB2 == WS_XB2 && pg8::WSO_XB1 == WS_XB1 && pg8::WSO_T1 == WS_T1 && pg8::WSO_T2 == WS_T2 && pg8::WSO_QB == WS_QB && pg8::WSO_KB == WS_KB && pg8::WSO_VB == WS_VB && pg8::WSO_PR == WS_PR && pg8::WSO_H == WS_H &&
              pg8::OO_SHP == O_SHP && pg8::OO_KP == O_KP && pg8::OO_VP == O_VP, "epilogue offset mirrors");
#define GAS __attribute__((address_space(1)))
#define LAS __attribute__((address_space(3)))
typedef unsigned short bf16;
typedef unsigned v4u __attribute__((ext_vector_type(4)));
typedef unsigned v2u __attribute__((ext_vector_type(2)));
typedef float f32x4 __attribute__((ext_vector_type(4)));
typedef float f32x2 __attribute__((ext_vector_type(2)));
typedef float f32x16 __attribute__((ext_vector_type(16)));
typedef short bf16x8 __attribute__((ext_vector_type(8)));
typedef short s16x4 __attribute__((ext_vector_type(4)));
typedef GAS unsigned gu32;
#define RLX_AGENT __ATOMIC_RELAXED, __HIP_MEMORY_SCOPE_AGENT
#define LDS_WAIT() asm volatile("s_waitcnt lgkmcnt(0)" ::: "memory")
#define VM_WAIT() asm volatile("s_waitcnt vmcnt(0)" ::: "memory")
#define DI __device__ __forceinline__
DI unsigned f2bf(float f) { unsigned u = __builtin_bit_cast(unsigned, f); return (u + 0x7fffu + ((u >> 16) & 1u)) >> 16; }
DI float bf2f(unsigned b) { return __builtin_bit_cast(float, b << 16); }
DI float bflo(unsigned w) { return __builtin_bit_cast(float, w << 16); }
DI float bfhi(unsigned w) { return __builtin_bit_cast(float, w & 0xffff0000u); }
typedef __bf16 bf16x2_t __attribute__((ext_vector_type(2)));
DI unsigned pk2(float lo, float hi) { const f32x2 v = {lo, hi}; const bf16x2_t b = __builtin_convertvector(v, bf16x2_t); return __builtin_bit_cast(unsigned, b); }
DI unsigned pk2z(float x) { return pk2(x, 0.f) & 0xffffu; }
DI float rbf(float x) { return bf2f(f2bf(x)); }
DI bf16x8 pk8(float a0, float a1, float a2, float a3, float a4, float a5, float a6, float a7) {
    v4u w; w.x = pk2(a0, a1); w.y = pk2(a2, a3); w.z = pk2(a4, a5); w.w = pk2(a6, a7); return __builtin_bit_cast(bf16x8, w); }
DI bf16x8 pk8v(f32x4 a, f32x4 b) { return pk8(a[0], a[1], a[2], a[3], b[0], b[1], b[2], b[3]); }
DI bf16x8 pk4z(f32x4 a) { v4u w; w.x = pk2(a[0], a[1]); w.y = pk2(a[2], a[3]); w.z = 0u; w.w = 0u; return __builtin_bit_cast(bf16x8, w); }
DI bf16x8 ld8(const void* p) { return *(const bf16x8*)p; }
DI bf16x8 ld4z(const void* p) { v2u t = *(const v2u*)p; v4u w; w.x = t.x; w.y = t.y; w.z = 0u; w.w = 0u; return __builtin_bit_cast(bf16x8, w); }
DI f32x4 mfma16(bf16x8 a, bf16x8 b, f32x4 c) { return __builtin_amdgcn_mfma_f32_16x16x32_bf16(a, b, c, 0, 0, 0); }
DI f32x16 mfma32(bf16x8 a, bf16x8 b, f32x16 c) { return __builtin_amdgcn_mfma_f32_32x32x16_bf16(a, b, c, 0, 0, 0); }
DI int crow(int r, int hi) { return (r & 3) + 8 * (r >> 2) + 4 * hi; }
DI float wave_sum(float v) {
#pragma unroll
    for (int o = 1; o < 64; o <<= 1) v += __shfl_xor(v, o);
    return v; }
DI float fexp(float x) { return __expf(x); }
DI float fsigmoid(float x) { return __builtin_amdgcn_rcpf(1.f + __expf(-x)); }
DI float ftanh(float x) { return 1.f - 2.f * __builtin_amdgcn_rcpf(__expf(2.f * x) + 1.f); }
DI float fsoftplus(float x) { return fmaxf(x, 0.f) + __logf(1.f + __expf(-fabsf(x))); }
DI int orig2lgcl(int o) { return (o & ~63) | (((o >> 4) & 1) << 5) | (((o >> 2) & 3) << 3) | (((o >> 5) & 1) << 2) | (o & 3); }
DI int lgcl2orig(int c) { return (c & ~63) | (((c >> 2) & 1) << 5) | (((c >> 5) & 1) << 4) | (((c >> 3) & 3) << 2) | (c & 3); }
#define XB_TMO      128
#define XB_XCNT(j)  (256  + 64 * (j))
#define XB_XSUB(j)  (1280 + 64 * (j))
#define XB_XGEN(j)  (2304 + 64 * (j))
#define XB_TOP      3328
#define XB_TOPGEN   3392
#define XCD_BAR_WORDS 3456
#define XB_SPIN_CAP (1u << 18)

__device__ __forceinline__ unsigned xb_ld(unsigned* p)              { return __hip_atomic_load(p, __ATOMIC_RELAXED, __HIP_MEMORY_SCOPE_AGENT); }
__device__ __forceinline__ unsigned xb_add(unsigned* p, unsigned v) { return __hip_atomic_fetch_add(p, v, __ATOMIC_RELAXED, __HIP_MEMORY_SCOPE_AGENT); }
__device__ __forceinline__ unsigned xb_xcc_id() { return (unsigned)__builtin_amdgcn_s_getreg((3 << 11) | 20) & 0xFu; }
#define XB_SPIN(cond, bar) do { unsigned _sp = 0; while (cond) { __builtin_amdgcn_s_sleep(1); \
    if ((++_sp & 255u) == 0u) { if (xb_ld(&(bar)[XB_TMO])) break; if (_sp > XB_SPIN_CAP) { atomicAdd(&(bar)[XB_TMO], 1u); break; } } } } while (0)

struct XcdBarrier {
    unsigned* bar; unsigned x;
    volatile LAS unsigned* st;
};

__device__ __forceinline__ XcdBarrier xcd_barrier_post(unsigned* bar, volatile LAS unsigned* st) {
    XcdBarrier b; b.bar = bar; b.x = xb_xcc_id(); b.st = st;
    if (threadIdx.x == 0) (void)xb_add(&bar[XB_XCNT(b.x)], 1u);
    return b;
}
__device__ __forceinline__ void xcd_barrier_complete(unsigned* bar, unsigned x, unsigned& nloc, unsigned& nx) {
    const unsigned G = gridDim.x * gridDim.y * gridDim.z;
    unsigned sum, cnt, mine, sp = 0u;
    for (;;) {
        sum = 0u; cnt = 0u; mine = 0u;
#pragma unroll
        for (unsigned j = 0; j < 16; ++j) { const unsigned c = xb_ld(&bar[XB_XCNT(j)]); sum += c; cnt += (c > 0u) ? 1u : 0u; mine = (j == x) ? c : mine; }
        if (sum == G) break;
        __builtin_amdgcn_s_sleep(1);
        if ((++sp & 255u) == 0u) { if (xb_ld(&bar[XB_TMO])) break; if (sp > XB_SPIN_CAP) { atomicAdd(&bar[XB_TMO], 1u); break; } }
    }
    nloc = mine > 0u ? mine : 1u; nx = cnt > 0u ? cnt : 1u;
}

__device__ __forceinline__ void xcd_barrier(const XcdBarrier& b) {
    asm volatile("s_waitcnt vmcnt(0)" ::: "memory");
    __syncthreads();
    if (threadIdx.x == 0) {
        unsigned* bar = b.bar;
        __builtin_amdgcn_s_waitcnt(0);
        unsigned nloc = b.st[0], nx = b.st[1];
        if (nloc == 0u) { xcd_barrier_complete(bar, b.x, nloc, nx); b.st[0] = nloc; b.st[1] = nx; }
        const unsigned old = xb_add(&bar[XB_XSUB(b.x)], 1u);
        const unsigned gen = old / nloc;
        if (old + 1u == (gen + 1u) * nloc) {
            __builtin_amdgcn_fence(__ATOMIC_RELEASE, "agent");
            asm volatile("s_waitcnt vmcnt(0)" ::: "memory");
            const unsigned og = xb_add(&bar[XB_TOP], 1u);
            const unsigned tg = og / nx;
            if (og + 1u == (tg + 1u) * nx) xb_add(&bar[XB_TOPGEN], 1u);
            else XB_SPIN(xb_ld(&bar[XB_TOPGEN]) == tg, bar);
            __builtin_amdgcn_fence(__ATOMIC_ACQUIRE, "agent");
            xb_add(&bar[XB_XGEN(b.x)], 1u);
            asm volatile("s_waitcnt vmcnt(0)" ::: "memory");
        } else {
            XB_SPIN(xb_ld(&bar[XB_XGEN(b.x)]) == gen, bar);
            __builtin_amdgcn_fence(__ATOMIC_ACQUIRE, "agent");
            asm volatile("s_waitcnt vmcnt(0)" ::: "memory");
        }
    }
    __syncthreads();
}
struct Args { const float* in[30]; float* out; unsigned char* ws; };
struct Frame {
    unsigned char* lds;
    volatile LAS unsigned* MISC;
    gu32* ctl;
    int tid, lane, wave, vcu, G, gw, NGW;
    const float* const* in; float* out; unsigned char* ws;
};
template <bool SWAP>
DI void p0_transpose_item(const float* W, int ldw, int K, int csrc0, bf16* WT, int row_off, const float* gsc, LAS float* scr, int kb, int nb, int lane, float* csum = nullptr, int ncs = 0, const float* bsh = nullptr) {
    const int k0 = 64 * kb, n0 = 32 * nb;
    f32x4 wv[8]; float gk = 1.f, bk = 0.f;
    const int lr = lane >> 3, lc = (lane & 7) * 4;
#pragma unroll
    for (int i = 0; i < 8; ++i) wv[i] = *(const f32x4*)(W + (size_t)(k0 + 8 * i + lr) * ldw + csrc0 + n0 + lc);
    if (gsc) gk = gsc[k0 + lane]; if (bsh) bk = bsh[k0 + lane];
    f32x4 s1v = {0.f, 0.f, 0.f, 0.f}, s2v = s1v;
#pragma unroll
    for (int i = 0; i < 8; ++i) { const int kk = 8 * i + lr; f32x4 v = wv[i]; s2v = s2v + v * __shfl(bk, kk); v = v * __shfl(gk, kk);
#pragma unroll
        for (int e = 0; e < 4; ++e) { s1v[e] += rbf(v[e]); scr[kk * 33 + lc + e] = v[e]; } }
#pragma unroll
    for (int o = 8; o < 64; o <<= 1) {
#pragma unroll
        for (int e = 0; e < 4; ++e) { s1v[e] += __shfl_xor(s1v[e], o); s2v[e] += __shfl_xor(s2v[e], o); } }
    if (csum && lane < 8) {
#pragma unroll
        for (int e = 0; e < 4; ++e) { int dr = n0 + 4 * lane + e; if (SWAP) dr = orig2lgcl(dr); csum[(size_t)(kb * 2 + 0) * ncs + row_off + dr] = s1v[e]; csum[(size_t)(kb * 2 + 1) * ncs + row_off + dr] = s2v[e]; } }
    LDS_WAIT(); asm volatile("" ::: "memory");
    const int c = lane & 7;
#pragma unroll
    for (int j = 0; j < 4; ++j) { const int n = (lane >> 3) + 8 * j; const LAS float* s = scr + (8 * c) * 33 + n;
        v4u o; o.x = pk2(s[0 * 33], s[1 * 33]); o.y = pk2(s[2 * 33], s[3 * 33]); o.z = pk2(s[4 * 33], s[5 * 33]); o.w = pk2(s[6 * 33], s[7 * 33]);
        int dr = n0 + n; if (SWAP) dr = orig2lgcl(dr);
        *(v4u*)(WT + (size_t)(row_off + dr) * K + k0 + 8 * c) = o; }
    LDS_WAIT(); asm volatile("" ::: "memory");
}
DI void p0_prologue(Frame& F) {
    LAS float* scr = (LAS float*)((LAS unsigned char*)F.lds + F.wave * 16384);
    const float* const* in = F.in; unsigned char* ws = F.ws;
    constexpr int I_IN = 16 * 104, I_VR = 16, I_INU = 16 * 56, I_OUT = 16 * 32, I_UP = 16 * 128, I_DN = 64 * 32;
    constexpr int I_L = I_IN + I_VR + I_INU + I_VR + I_OUT + I_UP + I_DN;
    for (int it = F.gw; it < DEPTH * I_L; it += F.NGW) {
        const int l = it / I_L; int r = it % I_L;
        const float* g2p = l > 0 ? in[28] + (size_t)(l - 1) * DM : nullptr;
        bf16* win = (bf16*)(ws + WS_WIN) + (size_t)l * NIN * DM; bf16* winu = (bf16*)(ws + WS_WINU) + (size_t)l * NRWU * DM;
        if (r < I_IN) { const int kb = r / 104, nb = r % 104; const float* W = in[6] + (size_t)l * DM * 3328;
            float* cs = l > 0 ? (float*)(ws + WS_CSUM) + (size_t)l * 32 * NIN : nullptr; const float* b2p = l > 0 ? in[29] + (size_t)(l - 1) * DM : nullptr;
            if (nb < 32) p0_transpose_item<true>(W, 3328, DM, 0, win, 0, g2p, scr, kb, nb, F.lane, cs, NIN, b2p); else p0_transpose_item<false>(W, 3328, DM, 0, win, 0, g2p, scr, kb, nb, F.lane, cs, NIN, b2p); continue; } r -= I_IN;
        if (r < I_VR) { if (l > 0) p0_transpose_item<false>(in[7] + (size_t)(l - 1) * DM * 32, 32, DM, 0, win, 3328, g2p, scr, r, 0, F.lane, (float*)(ws + WS_CSUM) + (size_t)l * 32 * NIN, NIN, in[29] + (size_t)(l - 1) * DM); continue; } r -= I_VR;
        if (r < I_INU) { const int kb = r / 56, nb = r % 56; p0_transpose_item<false>(in[6] + (size_t)l * DM * 3328, 3328, DM, RW0, winu, 0, nullptr, scr, kb, nb, F.lane); continue; } r -= I_INU;
        if (r < I_VR) { if (l > 0) p0_transpose_item<false>(in[7] + (size_t)(l - 1) * DM * 32, 32, DM, 0, winu, 1792, nullptr, scr, r, 0, F.lane); continue; } r -= I_VR;
        if (r < I_OUT) { p0_transpose_item<false>(in[23] + (size_t)l * DM * DM, DM, DM, 0, (bf16*)(ws + WS_WOUT) + (size_t)l * DM * DM, 0, nullptr, scr, r / 32, r % 32, F.lane); continue; } r -= I_OUT;
        if (r < I_UP) { p0_transpose_item<false>(in[26] + (size_t)l * DM * FFD, FFD, DM, 0, (bf16*)(ws + WS_WUP) + (size_t)l * FFD * DM, 0, in[24] + (size_t)l * DM, scr, r / 128, r % 128, F.lane, (float*)(ws + WS_CSUP) + (size_t)l * 32 * FFD, FFD, in[25] + (size_t)l * DM); continue; } r -= I_UP;
        p0_transpose_item<false>(in[27] + (size_t)l * FFD * DM, DM, FFD, 0, (bf16*)(ws + WS_WDN) + (size_t)l * DM * FFD, 0, nullptr, scr, r / 32, r % 32, F.lane);
    }
    for (int m0 = F.gw; m0 < M; m0 += 4 * F.NGW) { f32x4 v[4][4];
#pragma unroll
        for (int q = 0; q < 4; ++q) { const f32x4* xr = (const f32x4*)(in[0] + (size_t)(m0 + q * F.NGW) * DM) + F.lane;
#pragma unroll
            for (int j = 0; j < 4; ++j) v[q][j] = xr[64 * j]; }
#pragma unroll
        for (int q = 0; q < 4; ++q) { unsigned long long* o8 = (unsigned long long*)((bf16*)(ws + WS_XB2) + (size_t)(m0 + q * F.NGW) * DM) + F.lane;
#pragma unroll
            for (int j = 0; j < 4; ++j) o8[64 * j] = (unsigned long long)pk2(v[q][j].x, v[q][j].y) | ((unsigned long long)pk2(v[q][j].z, v[q][j].w) << 32); } }
    const int gt = F.gw * 64 + F.lane, NGT = F.NGW * 64;
    for (int e = gt; e < 8193 * 32; e += NGT) { const int pos = e >> 5, i = e & 31; const double ang = (double)pos * pow(10000.0, -(double)i / 32.0); ((f32x2*)(ws + WS_ROPE))[e] = (f32x2){(float)cos(ang), (float)sin(ang)}; }
    for (int e = gt; e < 4 * 512 * 64; e += NGT) { const int l = e / (512 * 64), n = (e / 64) % 512, m = e % 64; ((bf16*)(ws + WS_DUPT))[e] = (bf16)f2bf(in[11][((size_t)l * 64 + m) * 512 + n]); ((bf16*)(ws + WS_IUPT))[e] = (bf16)f2bf(in[13][((size_t)l * 64 + m) * 512 + n]); }
    for (int e = gt; e < 4 * 512 * 128; e += NGT) { const int l = e / (512 * 128), n = (e / 128) % 512, m = e % 128; ((bf16*)(ws + WS_GUPT))[e] = (bf16)f2bf(in[14][((size_t)l * 128 + m) * 512 + n]); }
    for (int e = gt; e < 3 * 512 * 32; e += NGT) { const int l = e / (512 * 32), n = (e / 32) % 512, m = e % 32; ((bf16*)(ws + WS_VUPT))[e] = (bf16)f2bf(in[16][((size_t)l * 32 + m) * 512 + n]); }
    for (int e = gt; e < 2 * DM; e += NGT) F.out[O_SHP + e] = in[0][((size_t)(e / DM) * TSEQ + TSEQ - 1) * DM + (e % DM)];
    for (int e = gt; e < MD * DM; e += NGT) { ((bf16*)(ws + WS_DEC + DEC_XB2))[e] = (bf16)f2bf(in[1][e]); }
    for (int e = gt; e < DEPTH * MD * DM; e += NGT) { ((bf16*)(ws + WS_DEC + DEC_SHB))[e] = (bf16)f2bf(in[2][e]); }
}
DI void colsum_finish(unsigned char* ws, int gt, int NGT) {
    for (int e = gt; e < 3 * NIN; e += NGT) { const int l = 1 + e / NIN, p = e % NIN; if (p >= 3360) continue; const float* cs = (const float*)(ws + WS_CSUM) + (size_t)l * 32 * NIN + p; float s1 = 0.f, s2 = 0.f;
#pragma unroll
        for (int kb = 0; kb < 16; ++kb) { s1 += cs[(size_t)(2 * kb) * NIN]; s2 += cs[(size_t)(2 * kb + 1) * NIN]; }
        ((float*)(ws + WS_C1IN))[l * NIN + p] = s1; ((float*)(ws + WS_C2IN))[l * NIN + p] = s2; }
    for (int e = gt; e < 4 * FFD; e += NGT) { const int l = e / FFD, p = e % FFD; const float* cs = (const float*)(ws + WS_CSUP) + (size_t)l * 32 * FFD + p; float s1 = 0.f, s2 = 0.f;
#pragma unroll
        for (int kb = 0; kb < 16; ++kb) { s1 += cs[(size_t)(2 * kb) * FFD]; s2 += cs[(size_t)(2 * kb + 1) * FFD]; }
        ((float*)(ws + WS_C1UP))[l * FFD + p] = s1; ((float*)(ws + WS_C2UP))[l * FFD + p] = s2; }
}
constexpr int VPITCH = 144;
constexpr int ATT_WLDS = 2 * 32 * VPITCH + 256;
DI void tr_read8(unsigned base, s16x4 (&t)[8]) {
    asm volatile("ds_read_b64_tr_b16 %0, %8\n\tds_read_b64_tr_b16 %1, %8 offset:%c9\n\tds_read_b64_tr_b16 %2, %8 offset:%c10\n\tds_read_b64_tr_b16 %3, %8 offset:%c11\n\t"
                 "ds_read_b64_tr_b16 %4, %8 offset:%c12\n\tds_read_b64_tr_b16 %5, %8 offset:%c13\n\tds_read_b64_tr_b16 %6, %8 offset:%c14\n\tds_read_b64_tr_b16 %7, %8 offset:%c15\n\ts_waitcnt lgkmcnt(0)"
                 : "=&v"(t[0]), "=&v"(t[1]), "=&v"(t[2]), "=&v"(t[3]), "=&v"(t[4]), "=&v"(t[5]), "=&v"(t[6]), "=&v"(t[7])
                 : "v"(base), "i"(8 * VPITCH), "i"(64), "i"(8 * VPITCH + 64), "i"(16 * VPITCH), "i"(24 * VPITCH), "i"(16 * VPITCH + 64), "i"(24 * VPITCH + 64) : "memory");
}
DI void attn_task(const bf16* QB, const bf16* KB, const bf16* VB, bf16* OP, float* LSE, int b, int h, int p, int cls, int qblk, LAS unsigned char* wl, int lane) {
    asm volatile("" : "+v"(lane));
    const int dd = 1 << (2 * p), r32 = lane & 31, hi = lane >> 5;
    const int m0 = 32 * qblk;
    const size_t rowb = (size_t)b * TSEQ;
    const size_t qrow = rowb + (size_t)(m0 + r32) * dd + cls;
    bf16x8 qf[4];
#pragma unroll
    for (int d0 = 0; d0 < 4; ++d0) qf[d0] = ld8(QB + qrow * 512 + h * 64 + d0 * 16 + hi * 8);
    f32x16 s[5];
    const int kt0 = (m0 >= 128) ? 0 : (128 - m0) / 32;
    const int krow8 = lane >> 3, kch = lane & 7;
    v4u kr[5][4];
#pragma unroll
    for (int kt = 0; kt < 5; ++kt)
#pragma unroll
        for (int i_ = 0; i_ < 4; ++i_) { const int mk = m0 - 128 + 32 * kt + 8 * i_ + krow8; const size_t krow = rowb + (size_t)(mk < 0 ? 0 : mk) * dd + cls;
            kr[kt][i_] = *(const v4u*)(KB + krow * 512 + h * 64 + kch * 8); }
#pragma unroll
    for (int kt = 0; kt < 5; ++kt) {
        LAS unsigned char* kb = wl + (kt & 1) * 32 * VPITCH;
#pragma unroll
        for (int i_ = 0; i_ < 4; ++i_) *(LAS v4u*)(kb + (8 * i_ + krow8) * VPITCH + kch * 16) = kr[kt][i_];
        LDS_WAIT();
        bf16x8 kf[4];
#pragma unroll
        for (int d0 = 0; d0 < 4; ++d0) kf[d0] = *(const LAS bf16x8*)(kb + r32 * VPITCH + d0 * 32 + hi * 16);
        f32x16 a; for (int i = 0; i < 16; ++i) a[i] = 0.f;
#pragma unroll
        for (int d0 = 0; d0 < 4; ++d0) a = mfma32(kf[d0], qf[d0], a);
        s[kt] = a;
    }
    LDS_WAIT();
#pragma unroll
    for (int kt = 0; kt < 5; ++kt) {
        if (kt < kt0) {
#pragma unroll
            for (int i = 0; i < 16; ++i) s[kt][i] = -INFINITY;
        } else if (kt == 0) {
#pragma unroll
            for (int i = 0; i < 16; ++i) s[kt][i] = (crow(i, hi) >= r32) ? s[kt][i] : -INFINITY;
        } else if (kt == 4) {
#pragma unroll
            for (int i = 0; i < 16; ++i) s[kt][i] = (crow(i, hi) <= r32) ? s[kt][i] : -INFINITY;
        }
    }
    float mx = -INFINITY;
#pragma unroll
    for (int kt = 0; kt < 5; ++kt)
#pragma unroll
        for (int i = 0; i < 16; ++i) mx = fmaxf(mx, s[kt][i]);
    mx = fmaxf(mx, __shfl_xor(mx, 32));
    float lsum = 0.f;
#pragma unroll
    for (int kt = 0; kt < 5; ++kt)
#pragma unroll
        for (int i = 0; i < 16; ++i) { const float e = __builtin_amdgcn_exp2f(s[kt][i] - mx); s[kt][i] = e; lsum += e; }
    lsum += __shfl_xor(lsum, 32);
    f32x16 o[2]; for (int i = 0; i < 16; ++i) { o[0][i] = 0.f; o[1][i] = 0.f; }
    LAS float* wsf = (LAS float*)(wl + 2 * 32 * VPITCH);
    const unsigned vb0 = (unsigned)(uintptr_t)wl;
    const int g = lane >> 4, i16 = lane & 15, qq = i16 >> 2, pp = i16 & 3;
    const unsigned traddr = (unsigned)((4 * (g >> 1) + qq) * VPITCH + (16 * (g & 1) + 4 * pp) * 2);
    const int vrow8 = lane >> 3, vch = lane & 7;
    v4u vr[4];
#define ATT_LOADV(KT) do { _Pragma("unroll") for (int i_ = 0; i_ < 4; ++i_) { const int mk_ = m0 - 128 + 32 * (KT) + 8 * i_ + vrow8; const size_t vrow_ = rowb + (size_t)mk_ * dd + cls; \
        vr[i_] = *(const v4u*)(VB + vrow_ * 512 + h * 64 + vch * 8); } } while (0)
    ATT_LOADV(kt0);
#pragma unroll
    for (int kt = 0; kt < 5; ++kt) {
        if (kt >= kt0) {
            LAS unsigned char* vb = wl + (kt & 1) * 32 * VPITCH;
#pragma unroll
            for (int i_ = 0; i_ < 4; ++i_) *(LAS v4u*)(vb + (8 * i_ + vrow8) * VPITCH + vch * 16) = vr[i_];
            if (kt + 1 < 5) ATT_LOADV(kt + 1);
            LDS_WAIT();
            const unsigned base = vb0 + (unsigned)((kt & 1) * 32 * VPITCH) + traddr;
            s16x4 t[8];
            tr_read8(base, t);
#pragma unroll
            for (int ss = 0; ss < 2; ++ss) {
                const bf16x8 pa = pk8(s[kt][8 * ss], s[kt][8 * ss + 1], s[kt][8 * ss + 2], s[kt][8 * ss + 3], s[kt][8 * ss + 4], s[kt][8 * ss + 5], s[kt][8 * ss + 6], s[kt][8 * ss + 7]);
#pragma unroll
                for (int db = 0; db < 2; ++db) { const bf16x8 vf = __builtin_shufflevector(t[4 * ss + 2 * db], t[4 * ss + 2 * db + 1], 0, 1, 2, 3, 4, 5, 6, 7); o[db] = mfma32(pa, vf, o[db]); }
            }
        }
    }
#undef ATT_LOADV
    if (hi == 0) { wsf[r32] = __builtin_amdgcn_rcpf(lsum); LSE[((size_t)p * M + qrow) * 8 + h] = mx + __builtin_amdgcn_logf(lsum); }
    LDS_WAIT();
#pragma unroll
    for (int i = 0; i < 16; ++i) { const int q = crow(i, hi); const float li = wsf[q];
        *(LAS bf16*)(wl + q * VPITCH + r32 * 2) = (bf16)pk2z(o[0][i] * li); *(LAS bf16*)(wl + q * VPITCH + 64 + r32 * 2) = (bf16)pk2z(o[1][i] * li); }
    LDS_WAIT();
    { const int orow8 = lane >> 3, och = lane & 7;
#pragma unroll
      for (int i_ = 0; i_ < 4; ++i_) { const v4u w = *(const LAS v4u*)(wl + (8 * i_ + orow8) * VPITCH + och * 16); const size_t orow = rowb + (size_t)(m0 + 8 * i_ + orow8) * dd + cls;
          *(v4u*)(OP + ((size_t)p * M + orow) * 512 + h * 64 + och * 8) = w; } }
    LDS_WAIT();
}
DI void attn_finalize_row(const bf16* OP, const float* LSE, const float* gain, bf16* MIX, int row, int lane) {
    asm volatile("" : "+v"(lane));
    const int h = lane >> 3;
    float l0 = LSE[((size_t)0 * M + row) * 8 + h], l1 = LSE[((size_t)1 * M + row) * 8 + h], l2 = LSE[((size_t)2 * M + row) * 8 + h];
    const float mx = fmaxf(l0, fmaxf(l1, l2));
    float w0 = __builtin_amdgcn_exp2f(l0 - mx), w1 = __builtin_amdgcn_exp2f(l1 - mx), w2 = __builtin_amdgcn_exp2f(l2 - mx);
    const float inv = __builtin_amdgcn_rcpf(w0 + w1 + w2); w0 *= inv; w1 *= inv; w2 *= inv;
    const v4u a = *(const v4u*)(OP + ((size_t)0 * M + row) * 512 + lane * 8), b = *(const v4u*)(OP + ((size_t)1 * M + row) * 512 + lane * 8), c = *(const v4u*)(OP + ((size_t)2 * M + row) * 512 + lane * 8);
    float v[8]; float ss = 0.f;
#pragma unroll
    for (int j = 0; j < 4; ++j) { v[2 * j] = w0 * bflo(a[j]) + w1 * bflo(b[j]) + w2 * bflo(c[j]); v[2 * j + 1] = w0 * bfhi(a[j]) + w1 * bfhi(b[j]) + w2 * bfhi(c[j]); ss += v[2 * j] * v[2 * j] + v[2 * j + 1] * v[2 * j + 1]; }
    ss = wave_sum(ss);
    const float rinv = 1.0f / sqrtf(ss * (1.f / 512.f) + RMS_EPS);
    const f32x4 g0 = *(const f32x4*)(gain + lane * 8), g1 = *(const f32x4*)(gain + lane * 8 + 4);
    v4u w; w.x = pk2(v[0] * rinv * g0[0], v[1] * rinv * g0[1]); w.y = pk2(v[2] * rinv * g0[2], v[3] * rinv * g0[3]); w.z = pk2(v[4] * rinv * g1[0], v[5] * rinv * g1[1]); w.w = pk2(v[6] * rinv * g1[2], v[7] * rinv * g1[3]);
    *(v4u*)(MIX + (size_t)row * 1024 + lane * 8) = w;
}
constexpr int B1_IMG = 2048, B1_WLDS = 5 * B1_IMG + 1024;
constexpr int IMG_V = 0, IMG_A = 1 * B1_IMG, IMG_B = 2 * B1_IMG, IMG_W = 3 * B1_IMG, IMG_M = 4 * B1_IMG;
constexpr int TIL = 1 * B1_IMG, TIL_LP = 336, TIL_RP = 144, TIL_RSZ = 17 * TIL_RP;
static_assert(17 * TIL_LP <= 4 * B1_IMG && 3 * TIL_RSZ <= 4 * B1_IMG, "input tiles fit the image area");
DI float dpp_shr(float x, int n) { int v;
    switch (n) { case 1: v = __builtin_amdgcn_update_dpp(0, __builtin_bit_cast(int, x), 0x111, 0xf, 0xf, true); break; case 2: v = __builtin_amdgcn_update_dpp(0, __builtin_bit_cast(int, x), 0x112, 0xf, 0xf, true); break;
                 case 4: v = __builtin_amdgcn_update_dpp(0, __builtin_bit_cast(int, x), 0x114, 0xf, 0xf, true); break; default: v = __builtin_amdgcn_update_dpp(0, __builtin_bit_cast(int, x), 0x118, 0xf, 0xf, true); break; }
    return __builtin_bit_cast(float, v); }
DI float dpp_shr1(float x, int n) { int v; const int one = 0x3f800000;
    switch (n) { case 1: v = __builtin_amdgcn_update_dpp(one, __builtin_bit_cast(int, x), 0x111, 0xf, 0xf, false); break; case 2: v = __builtin_amdgcn_update_dpp(one, __builtin_bit_cast(int, x), 0x112, 0xf, 0xf, false); break;
                 case 4: v = __builtin_amdgcn_update_dpp(one, __builtin_bit_cast(int, x), 0x114, 0xf, 0xf, false); break; default: v = __builtin_amdgcn_update_dpp(one, __builtin_bit_cast(int, x), 0x118, 0xf, 0xf, false); break; }
    return __builtin_bit_cast(float, v); }
struct RwkvP {
    const bf16* PR; const float* mu; const float* muv;
    const float *dbase, *ibase, *vbase, *ksk, *ksa, *brk, *gng, *gnb;
    const bf16 *dupT, *iupT, *vupT, *gupT;
    const bf16* ZROW; bf16 *VF, *VV; float* BON; float* GC; bf16 *W1S, *REFF, *BM; v4u* REC; float* YPRE; bf16* MIX; int layer0;
};
DI const f32x4* vec4p(const float*) { return nullptr; }
DI const LAS f32x4* vec4p(const LAS float*) { return nullptr; }
template <class MP> DI void lerp8(const bf16* crow_, const bf16* prow_, int col, MP mu, float (&z)[8]) {
    const v4u cur = *(const v4u*)(crow_ + col); const v4u prv = *(const v4u*)(prow_ + col);
    const f32x4 m0 = *(decltype(vec4p(mu)))(mu), m1 = *(decltype(vec4p(mu)))(mu + 4);
#pragma unroll
    for (int j = 0; j < 4; ++j) { const float a = bflo(cur[j]), b = bfhi(cur[j]), pa = bflo(prv[j]), pb = bfhi(prv[j]); const float ma = j < 2 ? m0[2 * j] : m1[2 * j - 4], mb = j < 2 ? m0[2 * j + 1] : m1[2 * j - 3];
        z[2 * j] = a + (pa - a) * ma; z[2 * j + 1] = b + (pb - b) * mb; }
}
template <class MP> DI f32x4 lerp4(const bf16* crow_, const bf16* prow_, int col, MP mu) {
    const v2u cur = *(const v2u*)(crow_ + col); const v2u prv = *(const v2u*)(prow_ + col);
    const f32x4 m = *(decltype(vec4p(mu)))(mu);
    f32x4 z; z[0] = bflo(cur.x) + (bflo(prv.x) - bflo(cur.x)) * m[0]; z[1] = bfhi(cur.x) + (bfhi(prv.x) - bfhi(cur.x)) * m[1];
    z[2] = bflo(cur.y) + (bflo(prv.y) - bflo(cur.y)) * m[2]; z[3] = bfhi(cur.y) + (bfhi(prv.y) - bfhi(cur.y)) * m[3]; return z;
}
template <class MP> DI void lerp8l(const LAS unsigned char* crow_, const LAS unsigned char* prow_, int colb, MP mu, float (&z)[8]) {
    const v4u cur = *(const LAS v4u*)(crow_ + colb); const v4u prv = *(const LAS v4u*)(prow_ + colb);
    const f32x4 m0 = *(decltype(vec4p(mu)))(mu), m1 = *(decltype(vec4p(mu)))(mu + 4);
#pragma unroll
    for (int j = 0; j < 4; ++j) { const float a = bflo(cur[j]), b = bfhi(cur[j]), pa = bflo(prv[j]), pb = bfhi(prv[j]); const float ma = j < 2 ? m0[2 * j] : m1[2 * j - 4], mb = j < 2 ? m0[2 * j + 1] : m1[2 * j - 3];
        z[2 * j] = a + (pa - a) * ma; z[2 * j + 1] = b + (pb - b) * mb; }
}
template <class MP> DI f32x4 lerp4l(const LAS unsigned char* crow_, const LAS unsigned char* prow_, int colb, MP mu) {
    const v2u cur = *(const LAS v2u*)(crow_ + colb); const v2u prv = *(const LAS v2u*)(prow_ + colb);
    const f32x4 m = *(decltype(vec4p(mu)))(mu);
    f32x4 z; z[0] = bflo(cur.x) + (bflo(prv.x) - bflo(cur.x)) * m[0]; z[1] = bfhi(cur.x) + (bfhi(prv.x) - bfhi(cur.x)) * m[1];
    z[2] = bflo(cur.y) + (bflo(prv.y) - bflo(cur.y)) * m[2]; z[3] = bfhi(cur.y) + (bfhi(prv.y) - bfhi(cur.y)) * m[3]; return z;
}
DI void img_write(LAS unsigned char* img, const f32x4 (&x)[4], int fr, int fq) {
#pragma unroll
    for (int mb = 0; mb < 4; ++mb)
#pragma unroll
        for (int reg = 0; reg < 4; ++reg) *(LAS bf16*)(img + (16 * mb + 4 * fq + reg) * 32 + fr * 2) = (bf16)pk2z(x[mb][reg]);
}
DI bf16x8 lds4z(const LAS unsigned char* p) { const v2u t = *(const LAS v2u*)p; v4u w; w.x = t.x; w.y = t.y; w.z = 0u; w.w = 0u; return __builtin_bit_cast(bf16x8, w); }
constexpr int HC_DUP = 0, HC_IUP = 9216, HC_VUP = 18432, HC_F = 23552, HC_BYTES = 23552 + 736 * 4;
enum { HF_MUR = 0, HF_MUK = 64, HF_MUV = 128, HF_MUW = 192, HF_MUA = 256, HF_MUVR = 320, HF_DB = 352, HF_IB = 416, HF_VB = 480, HF_SK = 544, HF_SA = 608, HF_BR = 672 };
DI void head_cache_fill(const RwkvP& P, int h, LAS unsigned char* hc, int tid) {
    { const int row = tid >> 3, ch = tid & 7;
      *(LAS v4u*)(hc + HC_DUP + row * 144 + ch * 16) = *(const v4u*)(P.dupT + (size_t)(h * 64 + row) * 64 + ch * 8);
      *(LAS v4u*)(hc + HC_IUP + row * 144 + ch * 16) = *(const v4u*)(P.iupT + (size_t)(h * 64 + row) * 64 + ch * 8); }
    if (tid < 256 && !P.layer0) { const int row = tid >> 2, ch = tid & 3; *(LAS v4u*)(hc + HC_VUP + row * 80 + ch * 16) = *(const v4u*)(P.vupT + (size_t)(h * 64 + row) * 32 + ch * 8); }
    LAS float* f = (LAS float*)(hc + HC_F);
    if (tid < 64) { const int c = h * 64 + tid; f[HF_MUR + tid] = P.mu[c]; f[HF_MUK + tid] = P.mu[512 + c]; f[HF_MUV + tid] = P.mu[1024 + c]; f[HF_MUW + tid] = P.mu[1536 + tid]; f[HF_MUA + tid] = P.mu[1600 + tid];
        f[HF_DB + tid] = P.dbase[c]; f[HF_IB + tid] = P.ibase[c]; f[HF_VB + tid] = P.layer0 ? 0.f : P.vbase[c]; f[HF_SK + tid] = P.ksk[c]; f[HF_SA + tid] = P.ksa[c]; f[HF_BR + tid] = P.brk[c];
        if (tid < 32) f[HF_MUVR + tid] = P.layer0 ? 0.f : P.muv[tid]; }
}
DI void rwkv_b1_unit(const RwkvP& P, int unit, LAS unsigned char* wl, const LAS unsigned char* hc, int lane) {
    asm volatile("" : "+v"(lane));
    const int fr = lane & 15, fq = lane >> 4;
    const int seq = unit >> 9, c = unit & 511, b = seq >> 3, h = seq & 7;
    const size_t row = (size_t)b * TSEQ + 16 * c + fr;
    const f32x4 z4 = {0.f, 0.f, 0.f, 0.f};
    const LAS float* hf = (const LAS float*)(hc + HC_F);
    const bf16* row0p = P.PR + ((size_t)b * TSEQ + 16 * c) * PRP;
#define TROW(rr) (((rr) == 0 && c == 0) ? P.ZROW : row0p + ((rr) - 1) * PRP)
    v4u tl[6], tr3[3][3];
#pragma unroll
    for (int i = 0; i < 5; ++i) { const int idx = lane + 64 * i; if (idx < 272) { const int rr = idx >> 4, pc = idx & 15; tl[i] = *(const v4u*)(TROW(rr) + 1536 + pc * 8); } }
    { const int idx = lane; const int rr = idx >> 2, pc = idx & 3; tl[5] = (v4u){0u, 0u, 0u, 0u}; if (!P.layer0) { tl[5] = *(const v4u*)(TROW(rr) + 1792 + pc * 8); } }
    v4u tl16 = {0u, 0u, 0u, 0u}; if (!P.layer0 && lane < 4) tl16 = *(const v4u*)(TROW(16) + 1792 + lane * 8);
#pragma unroll
    for (int ten = 0; ten < 3; ++ten)
#pragma unroll
        for (int i = 0; i < 3; ++i) { const int idx = lane + 64 * i; if (idx < 136) { const int rr = idx >> 3, pc = idx & 7; tr3[ten][i] = *(const v4u*)(TROW(rr) + ten * 512 + h * 64 + pc * 8); } }
#pragma unroll
    for (int i = 0; i < 5; ++i) { const int idx = lane + 64 * i; if (idx < 272) { const int rr = idx >> 4, pc = idx & 15; *(LAS v4u*)(wl + TIL + rr * TIL_LP + pc * 16) = tl[i]; } }
    { const int rr = lane >> 2, pc = lane & 3; *(LAS v4u*)(wl + TIL + rr * TIL_LP + 256 + pc * 16) = tl[5]; if (lane < 4) *(LAS v4u*)(wl + TIL + 16 * TIL_LP + 256 + lane * 16) = tl16; }
    LDS_WAIT();
    const LAS unsigned char* lcr = wl + TIL + (fr + 1) * TIL_LP; const LAS unsigned char* lpr = wl + TIL + fr * TIL_LP;
    bf16x8 tw[2], al[2], vl;
#pragma unroll
    for (int ks = 0; ks < 2; ++ks) { float z[8]; lerp8l(lcr, lpr, (8 * fq + 32 * ks) * 2, hf + HF_MUW + 8 * fq + 32 * ks, z);
        tw[ks] = pk8(ftanh(z[0]), ftanh(z[1]), ftanh(z[2]), ftanh(z[3]), ftanh(z[4]), ftanh(z[5]), ftanh(z[6]), ftanh(z[7]));
        lerp8l(lcr, lpr, 128 + (8 * fq + 32 * ks) * 2, hf + HF_MUA + 8 * fq + 32 * ks, z); al[ks] = pk8(z[0], z[1], z[2], z[3], z[4], z[5], z[6], z[7]); }
    if (!P.layer0) { float z[8]; lerp8l(lcr, lpr, 256 + 8 * fq * 2, hf + HF_MUVR + 8 * fq, z); vl = pk8(z[0], z[1], z[2], z[3], z[4], z[5], z[6], z[7]); }
    LDS_WAIT();
#pragma unroll
    for (int ten = 0; ten < 3; ++ten)
#pragma unroll
        for (int i = 0; i < 3; ++i) { const int idx = lane + 64 * i; if (idx < 136) { const int rr = idx >> 3, pc = idx & 7; *(LAS v4u*)(wl + TIL + ten * TIL_RSZ + rr * TIL_RP + pc * 16) = tr3[ten][i]; } }
    LDS_WAIT();
#undef TROW
    const LAS unsigned char* rcr = wl + TIL + (fr + 1) * TIL_RP; const LAS unsigned char* rpr = wl + TIL + fr * TIL_RP;
    f32x4 zr[4], k2[4], kk[4], ai[4], ld[4];
    float nrm = 0.f, bon = 0.f;
#pragma unroll
    for (int mb = 0; mb < 4; ++mb) { const int ch = h * 64 + 16 * mb + 4 * fq; const int n = h * 64 + 16 * mb + fr;
        f32x4 dw = z4, da = z4, dv = z4;
        dw = mfma16(*(const LAS bf16x8*)(hc + HC_DUP + (16 * mb + fr) * 144 + 16 * fq), tw[0], dw); dw = mfma16(*(const LAS bf16x8*)(hc + HC_DUP + (16 * mb + fr) * 144 + 16 * fq + 64), tw[1], dw);
        da = mfma16(*(const LAS bf16x8*)(hc + HC_IUP + (16 * mb + fr) * 144 + 16 * fq), al[0], da); da = mfma16(*(const LAS bf16x8*)(hc + HC_IUP + (16 * mb + fr) * 144 + 16 * fq + 64), al[1], da);
        if (!P.layer0) dv = mfma16(*(const LAS bf16x8*)(hc + HC_VUP + (16 * mb + fr) * 80 + 16 * fq), vl, z4);
        const int cl = 16 * mb + 4 * fq;
        zr[mb] = lerp4l(rcr, rpr, cl * 2, hf + HF_MUR + cl);
        const f32x4 zk = lerp4l(rcr + TIL_RSZ, rpr + TIL_RSZ, cl * 2, hf + HF_MUK + cl);
        f32x4 zv = lerp4l(rcr + 2 * TIL_RSZ, rpr + 2 * TIL_RSZ, cl * 2, hf + HF_MUV + cl);
        const f32x4 db = *(const LAS f32x4*)(hf + HF_DB + cl), ib = *(const LAS f32x4*)(hf + HF_IB + cl), sk = *(const LAS f32x4*)(hf + HF_SK + cl), sa = *(const LAS f32x4*)(hf + HF_SA + cl), br = *(const LAS f32x4*)(hf + HF_BR + cl);
        if (P.layer0) { v2u w; w.x = pk2(zv[0], zv[1]); w.y = pk2(zv[2], zv[3]); *(v2u*)(P.VF + row * 512 + ch) = w; }
        else { const v2u f = *(const v2u*)(P.VF + row * 512 + ch); const f32x4 vb = *(const LAS f32x4*)(hf + HF_VB + cl); const f32x4 vf = {bflo(f.x), bfhi(f.x), bflo(f.y), bfhi(f.y)};
#pragma unroll
            for (int e = 0; e < 4; ++e) zv[e] = zv[e] + (vf[e] - zv[e]) * fsigmoid(vb[e] + dv[e]); }
        { v2u w; w.x = pk2(zv[0], zv[1]); w.y = pk2(zv[2], zv[3]); *(v2u*)(P.VV + row * 512 + ch) = w; }
#pragma unroll
        for (int reg = 0; reg < 4; ++reg) *(LAS bf16*)(wl + IMG_V + (16 * mb + 4 * fq + reg) * 32 + fr * 2) = (bf16)pk2z(zv[reg]);
#pragma unroll
        for (int e = 0; e < 4; ++e) {
            ld[mb][e] = fexp(-0.60653065971f * fsigmoid(db[e] + dw[e]));
            const float a = fsigmoid(ib[e] + da[e]); ai[mb][e] = a;
            const float kr = zk[e] * sk[e]; kk[mb][e] = kr; nrm += kr * kr;
            const float kx = zk[e] * (1.f + (a - 1.f) * sa[e]); k2[mb][e] = kx; bon += zr[mb][e] * kx * br[e]; }
        asm volatile("" ::: "memory");
    }
    nrm += __shfl_xor(nrm, 16); nrm += __shfl_xor(nrm, 32); bon += __shfl_xor(bon, 16); bon += __shfl_xor(bon, 32);
    if (fq == 0) P.BON[row * 8 + h] = bon;
    const float kinv = 1.0f / fmaxf(sqrtf(nrm), 1e-12f);
    f32x4 rt[4], kh[4];
    bf16x8 pa[2], pb[2], pk[2], pr[2];
#pragma unroll
    for (int ks = 0; ks < 2; ++ks) {
        f32x4 at2[2], bt2[2], kt2[2];
#pragma unroll
        for (int m2 = 0; m2 < 2; ++m2) { const int mb = 2 * ks + m2;
            f32x4 gcv, bhv;
#pragma unroll
            for (int e = 0; e < 4; ++e) {
                float gm = ld[mb][e]; gm *= dpp_shr1(gm, 1); gm *= dpp_shr1(gm, 2); gm *= dpp_shr1(gm, 4); gm *= dpp_shr1(gm, 8);
                const float gc = __shfl(gm, lane | 15), gp = dpp_shr1(gm, 1), gi = __builtin_amdgcn_rcpf(gm), ec = gc * gi;
                const float kn = kk[mb][e] * kinv, bb = kn * ai[mb][e];
                at2[m2][e] = -kn * gp; bt2[m2][e] = bb * gi; kt2[m2][e] = k2[mb][e] * gi; rt[mb][e] = zr[mb][e] * gm;
                bhv[e] = bb * ec; kh[mb][e] = k2[mb][e] * ec; gcv[e] = gc; }
            if (fr == 0) *(f32x4*)(P.GC + (size_t)unit * 64 + 16 * mb + 4 * fq) = gcv;
#pragma unroll
            for (int reg = 0; reg < 4; ++reg) { const int o = (16 * mb + 4 * fq + reg) * 32 + fr * 2;
                *(LAS bf16*)(wl + IMG_A + o) = (bf16)pk2z(at2[m2][reg]); *(LAS bf16*)(wl + IMG_B + o) = (bf16)pk2z(bhv[reg]); }
        }
        pa[ks] = pk8v(at2[0], at2[1]); pb[ks] = pk8v(bt2[0], bt2[1]); pk[ks] = pk8v(kt2[0], kt2[1]); pr[ks] = pk8v(rt[2 * ks], rt[2 * ks + 1]);
    }
    const f32x4 z4b = {0.f, 0.f, 0.f, 0.f};
    f32x4 Aab = mfma16(pb[1], pa[1], mfma16(pb[0], pa[0], z4b));
    f32x4 AakT = mfma16(pa[1], pk[1], mfma16(pa[0], pk[0], z4b));
    f32x4 Arb = mfma16(pb[1], pr[1], mfma16(pb[0], pr[0], z4b));
    f32x4 Ark = mfma16(pk[1], pr[1], mfma16(pk[0], pr[0], z4b));
#pragma unroll
    for (int e = 0; e < 4; ++e) { const int rr = 4 * fq + e; Aab[e] = rr < fr ? Aab[e] : 0.f; AakT[e] = fr < rr ? AakT[e] : 0.f; Arb[e] = rr <= fr ? Arb[e] : 0.f; Ark[e] = rr <= fr ? Ark[e] : 0.f; }
    LAS float* As = (LAS float*)(wl + 5 * B1_IMG);
#pragma unroll
    for (int e = 0; e < 4; ++e) As[(4 * fq + e) * 16 + fr] = Aab[e];
    LDS_WAIT();
    float x[16];
#pragma unroll
    for (int s = 15; s >= 0; --s) { float acc = (s == fr) ? 1.f : 0.f;
        const f32x4 r0 = *(const LAS f32x4*)(As + s * 16), r1 = *(const LAS f32x4*)(As + s * 16 + 4), r2 = *(const LAS f32x4*)(As + s * 16 + 8), r3 = *(const LAS f32x4*)(As + s * 16 + 12);
        const float rowv[16] = {r0[0], r0[1], r0[2], r0[3], r1[0], r1[1], r1[2], r1[3], r2[0], r2[1], r2[2], r2[3], r3[0], r3[1], r3[2], r3[3]};
#pragma unroll
        for (int uu = s + 1; uu < 16; ++uu) acc += rowv[uu] * x[uu];
        x[s] = acc; if ((s & 1) == 0) asm volatile("" ::: "memory"); }
    f32x4 xs;
#pragma unroll
    for (int e = 0; e < 4; ++e) xs[e] = fq == 0 ? x[e] : fq == 1 ? x[4 + e] : fq == 2 ? x[8 + e] : x[12 + e];
    const bf16x8 Tsel = pk4z(xs);
    f32x4 W1[4];
#pragma unroll
    for (int mb = 0; mb < 4; ++mb) W1[mb] = mfma16(lds4z(wl + IMG_A + (16 * mb + fr) * 32 + 8 * fq), Tsel, z4);
    const f32x4 GT = mfma16(Tsel, pk4z(AakT), z4);
    img_write(wl + IMG_W, W1, fr, fq);
    f32x4 M1T[4];
    const bf16x8 GTp = pk4z(GT);
#pragma unroll
    for (int mb = 0; mb < 4; ++mb) M1T[mb] = mfma16(lds4z(wl + IMG_B + (16 * mb + fr) * 32 + 8 * fq), GTp, kh[mb]);
    img_write(wl + IMG_M, M1T, fr, fq);
    LDS_WAIT();
    const bf16x8 Arbp = pk4z(Arb);
    f32x4 RE[4];
#pragma unroll
    for (int mb = 0; mb < 4; ++mb) RE[mb] = mfma16(lds4z(wl + IMG_W + (16 * mb + fr) * 32 + 8 * fq), Arbp, rt[mb]);
    const f32x4 M2 = mfma16(GTp, Arbp, Ark);
    {   bf16* w1s = P.W1S + (size_t)unit * 1024 + fr * 32; bf16* re = P.REFF + (size_t)unit * 1024 + fr * 32;
#pragma unroll
        for (int kp = 0; kp < 2; ++kp) { const int sg = kp * 512 + fq * 8;
            v4u w; w.x = pk2(W1[2 * kp][0], W1[2 * kp][1]); w.y = pk2(W1[2 * kp][2], W1[2 * kp][3]); w.z = pk2(W1[2 * kp + 1][0], W1[2 * kp + 1][1]); w.w = pk2(W1[2 * kp + 1][2], W1[2 * kp + 1][3]); *(v4u*)(w1s + sg) = w;
            w.x = pk2(RE[2 * kp][0], RE[2 * kp][1]); w.y = pk2(RE[2 * kp][2], RE[2 * kp][3]); w.z = pk2(RE[2 * kp + 1][0], RE[2 * kp + 1][1]); w.w = pk2(RE[2 * kp + 1][2], RE[2 * kp + 1][3]); *(v4u*)(re + sg) = w; }
        const v2u m2p = {pk2(M2[0], M2[1]), pk2(M2[2], M2[3])};
#pragma unroll
        for (int mb = 0; mb < 4; ++mb) {
            const v2u bq = *(const LAS v2u*)(wl + IMG_B + (16 * mb + fr) * 32 + 8 * fq), mq = *(const LAS v2u*)(wl + IMG_M + (16 * mb + fr) * 32 + 8 * fq);
            *(v4u*)(P.BM + (((size_t)unit * 64 + 16 * mb + fr) * 4 + fq) * 8) = (v4u){bq.x, bq.y, mq.x, mq.y};
            const v2u vq = *(const LAS v2u*)(wl + IMG_V + (16 * mb + fr) * 32 + 8 * fq);
            P.REC[((size_t)unit * 4 + mb) * 64 + lane] = (v4u){vq.x, vq.y, m2p.x, m2p.y}; }
    }
    LDS_WAIT();
}
constexpr int NSEG = 16, SEGCH = NCH / NSEG;
struct ChainIn { bf16x8 w1[2], re[2], bm[4]; v4u rec; f32x4 gc[4]; };
template <int MODE> DI void chain_load(ChainIn& c, const RwkvP& P, int unit, int rb, int lane) {
    const int fr = lane & 15, fq = lane >> 4;
    const bf16* w1s = P.W1S + (size_t)unit * 1024 + fr * 32 + fq * 8;
    c.w1[0] = ld8(w1s); c.w1[1] = ld8(w1s + 512);
    if (MODE == 2) { const bf16* re = P.REFF + (size_t)unit * 1024 + fr * 32 + fq * 8; c.re[0] = ld8(re); c.re[1] = ld8(re + 512); }
#pragma unroll
    for (int mb = 0; mb < 4; ++mb) { c.bm[mb] = ld8(P.BM + (((size_t)unit * 64 + 16 * mb + fr) * 4 + fq) * 8); c.gc[mb] = *(const f32x4*)(P.GC + (size_t)unit * 64 + 16 * mb + 4 * fq); }
    if (MODE != 1) c.rec = P.REC[((size_t)unit * 4 + rb) * 64 + lane];
}
template <int MODE> DI void chain_step(f32x4 (&S)[4], const ChainIn& c, float* ypre  ) {
    const f32x4 z4 = {0.f, 0.f, 0.f, 0.f};
    const bf16x8 b0 = pk8v(S[0], S[1]), b1 = pk8v(S[2], S[3]);
    f32x4 ut = mfma16(c.w1[1], b1, mfma16(c.w1[0], b0, z4));
    if (MODE == 2) {
        v4u vlo; vlo.x = c.rec.x; vlo.y = c.rec.y; vlo.z = 0u; vlo.w = 0u;
        v4u m2a; m2a.x = c.rec.z; m2a.y = c.rec.w; m2a.z = 0u; m2a.w = 0u;
        f32x4 y = mfma16(__builtin_bit_cast(bf16x8, m2a), __builtin_bit_cast(bf16x8, vlo), z4);
        y = mfma16(c.re[0], b0, y); y = mfma16(c.re[1], b1, y);
#pragma unroll
        for (int e = 0; e < 4; ++e) ypre[(size_t)e * 512] = y[e];
    }
    v4u uv; uv.x = pk2(ut[0], ut[1]); uv.y = pk2(ut[2], ut[3]); uv.z = MODE == 1 ? 0u : c.rec.x; uv.w = MODE == 1 ? 0u : c.rec.y;
    const bf16x8 ub = __builtin_bit_cast(bf16x8, uv);
#pragma unroll
    for (int mb = 0; mb < 4; ++mb) S[mb] = mfma16(c.bm[mb], ub, S[mb] * c.gc[mb]);
}
template <int MODE> DI void chain_run(f32x4 (&S)[4], const RwkvP& P, int unit0, int nsteps  , int rb, float* yp, int lane) {
    ChainIn c0, c1, c2;
    chain_load<MODE>(c0, P, unit0, rb, lane); chain_load<MODE>(c1, P, unit0 + 1, rb, lane);
    int c = 0;
    for (; c + 3 <= nsteps; c += 3) {
        chain_load<MODE>(c2, P, unit0 + c + 2, rb, lane);
        chain_step<MODE>(S, c0, yp + (size_t)c * 16 * 512);
        if (c + 3 < nsteps) chain_load<MODE>(c0, P, unit0 + c + 3, rb, lane);
        chain_step<MODE>(S, c1, yp + (size_t)(c + 1) * 16 * 512);
        if (c + 4 < nsteps) chain_load<MODE>(c1, P, unit0 + c + 4, rb, lane);
        chain_step<MODE>(S, c2, yp + (size_t)(c + 2) * 16 * 512);
    }
    if (c < nsteps) { chain_step<MODE>(S, c0, yp + (size_t)c * 16 * 512); ++c; }
    if (c < nsteps) { chain_step<MODE>(S, c1, yp + (size_t)c * 16 * 512); ++c; }
}
DI void chain_step_dual(f32x4 (&SQ)[4], f32x4 (&SP)[4], const ChainIn& c) {
    const f32x4 z4 = {0.f, 0.f, 0.f, 0.f};
    const bf16x8 q0 = pk8v(SQ[0], SQ[1]), q1 = pk8v(SQ[2], SQ[3]), p0 = pk8v(SP[0], SP[1]), p1 = pk8v(SP[2], SP[3]);
    const f32x4 utq = mfma16(c.w1[1], q1, mfma16(c.w1[0], q0, z4)), utp = mfma16(c.w1[1], p1, mfma16(c.w1[0], p0, z4));
    v4u uq; uq.x = pk2(utq[0], utq[1]); uq.y = pk2(utq[2], utq[3]); uq.z = c.rec.x; uq.w = c.rec.y;
    v4u up; up.x = pk2(utp[0], utp[1]); up.y = pk2(utp[2], utp[3]); up.z = 0u; up.w = 0u;
    const bf16x8 ubq = __builtin_bit_cast(bf16x8, uq), ubp = __builtin_bit_cast(bf16x8, up);
#pragma unroll
    for (int mb = 0; mb < 4; ++mb) { SQ[mb] = mfma16(c.bm[mb], ubq, SQ[mb] * c.gc[mb]); SP[mb] = mfma16(c.bm[mb], ubp, SP[mb] * c.gc[mb]); }
}
DI void chain_pass1(const RwkvP& P, float* QSEG, float* PSEGT, int seq, int g, int rb, int lane) {
    const int fr = lane & 15, fq = lane >> 4;
    f32x4 SQ[4], SP[4];
#pragma unroll
    for (int mb = 0; mb < 4; ++mb)
#pragma unroll
        for (int e = 0; e < 4; ++e) { SQ[mb][e] = 0.f; SP[mb][e] = ((16 * mb + 4 * fq + e) == (16 * rb + fr)) ? 1.f : 0.f; }
    const int unit0 = seq * NCH + g * SEGCH;
    {   ChainIn c0, c1, c2;
        chain_load<0>(c0, P, unit0, rb, lane); chain_load<0>(c1, P, unit0 + 1, rb, lane);
        int c = 0;
        for (; c + 3 <= SEGCH; c += 3) {
            chain_load<0>(c2, P, unit0 + c + 2, rb, lane);
            chain_step_dual(SQ, SP, c0);
            if (c + 3 < SEGCH) chain_load<0>(c0, P, unit0 + c + 3, rb, lane);
            chain_step_dual(SQ, SP, c1);
            if (c + 4 < SEGCH) chain_load<0>(c1, P, unit0 + c + 4, rb, lane);
            chain_step_dual(SQ, SP, c2);
        }
        if (c < SEGCH) { chain_step_dual(SQ, SP, c0); ++c; }
        if (c < SEGCH) { chain_step_dual(SQ, SP, c1); ++c; }
    }
    const size_t sb = ((size_t)seq * NSEG + g) * 4096;
#pragma unroll
    for (int mb = 0; mb < 4; ++mb) *(f32x4*)(QSEG + sb + (size_t)(16 * rb + fr) * 64 + 16 * mb + 4 * fq) = SQ[mb];
#pragma unroll
    for (int mb = 0; mb < 4; ++mb)
#pragma unroll
        for (int e = 0; e < 4; ++e) PSEGT[sb + (size_t)((mb * 2 + (rb >> 1)) * 2 + (rb & 1)) * 256 + ((4 * fq + e) + 16 * (fr >> 2)) * 4 + (fr & 3)] = SP[mb][e];
}
DI void split_hl(const f32x4 a, const f32x4 b, bf16x8& hi, bf16x8& lo) {
    f32x4 ah, bh;
#pragma unroll
    for (int e = 0; e < 4; ++e) { ah[e] = rbf(a[e]); bh[e] = rbf(b[e]); }
    hi = pk8v(ah, bh); lo = pk8v(a - ah, b - bh);
}
DI void chain_pass23(const RwkvP& P, const float* QSEG, const float* PSEGT, int seq, int g, int rb, float* wkv_out, int lane) {
    const int fr = lane & 15, fq = lane >> 4, b = seq >> 3, h = seq & 7;
    f32x4 S[4]; for (int mb = 0; mb < 4; ++mb) S[mb] = (f32x4){0.f, 0.f, 0.f, 0.f};
    f32x4 pc[4][2][2], pn[4][2][2];
#define P2_LOAD(PD_, GP_) do { const size_t sb_ = ((size_t)seq * NSEG + (GP_)) * 4096; _Pragma("unroll") for (int mb = 0; mb < 4; ++mb) { \
        _Pragma("unroll") for (int ks = 0; ks < 2; ++ks) { const float* pr_ = PSEGT + sb_ + (size_t)((mb * 2 + ks) * 2) * 256 + (fr + 16 * fq) * 4; PD_[mb][ks][0] = *(const f32x4*)pr_; PD_[mb][ks][1] = *(const f32x4*)(pr_ + 256); } } } while (0)
    if (g > 0) P2_LOAD(pc, 0);
    for (int gp = 0; gp < g; ++gp) {
        f32x4 qc[4];
        { const size_t sb_ = ((size_t)seq * NSEG + gp) * 4096;
#pragma unroll
          for (int mb = 0; mb < 4; ++mb) qc[mb] = *(const f32x4*)(QSEG + sb_ + (size_t)(16 * rb + fr) * 64 + 16 * mb + 4 * fq); }
        if (gp + 1 < g) P2_LOAD(pn, gp + 1);
        bf16x8 bh[2], bl[2]; split_hl(S[0], S[1], bh[0], bl[0]); split_hl(S[2], S[3], bh[1], bl[1]);
#pragma unroll
        for (int mb = 0; mb < 4; ++mb) { f32x4 acc = {0.f, 0.f, 0.f, 0.f};
#pragma unroll
            for (int ks = 0; ks < 2; ++ks) { bf16x8 ah, al; split_hl(pc[mb][ks][0], pc[mb][ks][1], ah, al);
                acc = mfma16(ah, bh[ks], acc); acc = mfma16(al, bh[ks], acc); acc = mfma16(ah, bl[ks], acc); }
            S[mb] = acc + qc[mb]; }
#pragma unroll
        for (int mb = 0; mb < 4; ++mb) {
#pragma unroll
            for (int ks = 0; ks < 2; ++ks) { pc[mb][ks][0] = pn[mb][ks][0]; pc[mb][ks][1] = pn[mb][ks][1]; } }
    }
#undef P2_LOAD
    float* yp = P.YPRE + ((size_t)b * TSEQ + (size_t)g * SEGCH * 16 + 4 * fq) * 512 + h * 64 + 16 * rb + fr;
    chain_run<2>(S, P, seq * NCH + g * SEGCH, SEGCH, rb, yp, lane);
    if (g == NSEG - 1) {
#pragma unroll
        for (int mb = 0; mb < 4; ++mb) *(f32x4*)(wkv_out + (size_t)(16 * rb + fr) * 64 + 16 * mb + 4 * fq) = S[mb];
    }
}
constexpr int GC_GUP = 0, GC_F = 64 * 272, GC_BYTES = 64 * 272 + 256 * 4;
DI void gate_cache_fill(const RwkvP& P, int h, LAS unsigned char* gc, int tid) {
#pragma unroll
    for (int q = 0; q < 2; ++q) { const int idx = tid + 512 * q, row = idx >> 4, ch = idx & 15;
        *(LAS v4u*)(gc + GC_GUP + row * 272 + ch * 16) = *(const v4u*)(P.gupT + (size_t)(h * 64 + row) * 128 + ch * 8); }
    LAS float* f = (LAS float*)(gc + GC_F);
    if (tid < 64) { f[tid] = P.gng[h * 64 + tid]; f[64 + tid] = P.gnb[h * 64 + tid]; }
    if (tid >= 64 && tid < 192) f[128 + tid - 64] = P.mu[1664 + tid - 64];
}
constexpr int B3_GP = 272, B3_YP = 272, B3_VP = 144, B3_G = 0, B3_Y = 17 * B3_GP, B3_V = B3_Y + 16 * B3_YP, B3_WLDS = B3_V + 16 * B3_VP;
DI void rwkv_b3_unit(const RwkvP& P, int unit, const LAS unsigned char* gc, LAS unsigned char* wl, int lane) {
    asm volatile("" : "+v"(lane));
    const int fr = lane & 15, fq = lane >> 4;
    const int seq = unit >> 9, c = unit & 511, b = seq >> 3, h = seq & 7;
    const size_t row0 = (size_t)b * TSEQ + 16 * c;
    const f32x4 z4 = {0.f, 0.f, 0.f, 0.f};
    const LAS float* gf = (const LAS float*)(gc + GC_F);
    const bf16* row0p = P.PR + row0 * PRP;
    v4u tg[5], ty[4], tv[2];
#pragma unroll
    for (int i = 0; i < 5; ++i) { const int idx = lane + 64 * i; if (idx < 272) { const int rr = idx >> 4, pc = idx & 15; const bf16* rp = (rr == 0 && c == 0) ? P.ZROW : row0p + (rr - 1) * PRP; tg[i] = *(const v4u*)(rp + 1664 + pc * 8); } }
#pragma unroll
    for (int i = 0; i < 4; ++i) { const int idx = lane + 64 * i, rr = idx >> 4, pc = idx & 15; ty[i] = *(const v4u*)(P.YPRE + (row0 + rr) * 512 + h * 64 + pc * 4); }
#pragma unroll
    for (int i = 0; i < 2; ++i) { const int idx = lane + 64 * i, rr = idx >> 3, pc = idx & 7; tv[i] = *(const v4u*)(P.VV + (row0 + rr) * 512 + h * 64 + pc * 8); }
    const float bon = P.BON[(row0 + fr) * 8 + h];
#pragma unroll
    for (int i = 0; i < 5; ++i) { const int idx = lane + 64 * i; if (idx < 272) { const int rr = idx >> 4, pc = idx & 15; *(LAS v4u*)(wl + B3_G + rr * B3_GP + pc * 16) = tg[i]; } }
#pragma unroll
    for (int i = 0; i < 4; ++i) { const int idx = lane + 64 * i, rr = idx >> 4, pc = idx & 15; *(LAS v4u*)(wl + B3_Y + rr * B3_YP + pc * 16) = ty[i]; }
#pragma unroll
    for (int i = 0; i < 2; ++i) { const int idx = lane + 64 * i, rr = idx >> 3, pc = idx & 7; *(LAS v4u*)(wl + B3_V + rr * B3_VP + pc * 16) = tv[i]; }
    LDS_WAIT();
    const LAS unsigned char* gcr = wl + B3_G + (fr + 1) * B3_GP; const LAS unsigned char* gpr = wl + B3_G + fr * B3_GP;
    bf16x8 sg[4];
#pragma unroll
    for (int ks = 0; ks < 4; ++ks) { float z[8]; lerp8l(gcr, gpr, (8 * fq + 32 * ks) * 2, gf + 128 + 8 * fq + 32 * ks, z);
        sg[ks] = pk8(fsigmoid(z[0]), fsigmoid(z[1]), fsigmoid(z[2]), fsigmoid(z[3]), fsigmoid(z[4]), fsigmoid(z[5]), fsigmoid(z[6]), fsigmoid(z[7])); }
    f32x4 g[4], y[4]; float s = 0.f;
#pragma unroll
    for (int mb = 0; mb < 4; ++mb) { f32x4 a = z4;
#pragma unroll
        for (int ks = 0; ks < 4; ++ks) a = mfma16(*(const LAS bf16x8*)(gc + GC_GUP + (16 * mb + fr) * 272 + 16 * fq + 64 * ks), sg[ks], a);
        g[mb] = a;
        y[mb] = *(const LAS f32x4*)(wl + B3_Y + fr * B3_YP + (16 * mb + 4 * fq) * 4); s += (y[mb][0] + y[mb][1]) + (y[mb][2] + y[mb][3]); }
    s += __shfl_xor(s, 16); s += __shfl_xor(s, 32);
    const float mean = s * (1.f / 64.f); float q = 0.f;
#pragma unroll
    for (int mb = 0; mb < 4; ++mb) { y[mb] = y[mb] - mean; q += (y[mb][0] * y[mb][0] + y[mb][1] * y[mb][1]) + (y[mb][2] * y[mb][2] + y[mb][3] * y[mb][3]); }
    q += __shfl_xor(q, 16); q += __shfl_xor(q, 32);
    const float rstd = 1.0f / sqrtf(q * (1.f / 64.f) + GN_EPS);
    LDS_WAIT();
#pragma unroll
    for (int mb = 0; mb < 4; ++mb) { const int cl = 16 * mb + 4 * fq;
        const f32x4 gg = *(const LAS f32x4*)(gf + cl), gb = *(const LAS f32x4*)(gf + 64 + cl); const v2u vw = *(const LAS v2u*)(wl + B3_V + fr * B3_VP + cl * 2);
        const f32x4 v = {bflo(vw.x), bfhi(vw.x), bflo(vw.y), bfhi(vw.y)};
        const f32x4 o = (y[mb] * rstd * gg + gb + v * bon) * g[mb];
        v2u w; w.x = pk2(o[0], o[1]); w.y = pk2(o[2], o[3]); *(LAS v2u*)(wl + B3_G + fr * B3_VP + cl * 2) = w; }
    LDS_WAIT();
#pragma unroll
    for (int i = 0; i < 2; ++i) { const int idx = lane + 64 * i, rr = idx >> 3, pc = idx & 7; *(v4u*)(P.MIX + (row0 + rr) * 1024 + 512 + h * 64 + pc * 8) = *(const LAS v4u*)(wl + B3_G + rr * B3_VP + pc * 16); }
    LDS_WAIT();
}
DI f32x16 dec_gemm(const bf16* A, const bf16* Wt, int K, LAS float* red  , int wave, int lane) {
    const int r = lane & 31, h = lane >> 5, kw = K >> 3;
    const bf16* ap = A + (size_t)r * K + wave * kw + 8 * h; const bf16* bp = Wt + (size_t)r * K + wave * kw + 8 * h;
    f32x16 acc; for (int i = 0; i < 16; ++i) acc[i] = 0.f;
#pragma unroll 16
    for (int k = 0; k < kw; k += 16) acc = mfma32(ld8(ap + k), ld8(bp + k), acc);
    __syncthreads();
#pragma unroll
    for (int i = 0; i < 16; ++i) red[(wave * 16 + i) * 64 + lane] = acc[i];
    __syncthreads();
    if (wave == 0) {
#pragma unroll
        for (int i = 0; i < 16; ++i) { float s = 0.f;
#pragma unroll
            for (int w = 0; w < 8; ++w) s += red[(w * 16 + i) * 64 + lane];
            asm volatile("" : "+v"(s) :: "memory"); acc[i] = s; } }
    return acc;
}
DI void dec_row_stats(const float* st, LAS float* sc, int lane) {
    if (lane < 32) { float s = 0.f, q = 0.f; const f32x4* p = (const f32x4*)(st + (size_t)lane * 64);
#pragma unroll
        for (int i = 0; i < 16; ++i) { const f32x4 v = p[i]; s += v[0] + v[2]; q += v[1] + v[3]; if ((i & 3) == 3) asm volatile("" : "+v"(s), "+v"(q) :: "memory"); }
        const float mu = s * (1.f / 1024.f), var = fmaxf(q * (1.f / 1024.f) - mu * mu, 0.f); sc[2 * lane] = mu; sc[2 * lane + 1] = 1.0f / sqrtf(var + LN_EPS); }
    LDS_WAIT();
}
struct DecP {
    unsigned char* dec; int l;
    const float* xs;
    const float *c1in, *c2in, *c1up, *c2up, *g1, *b1, *g2p, *b2p;
    const bf16 *win, *winu, *wout, *wup, *wdn;
    float* out;
};
DI void dec_unit_in(const DecP& D, int u, LAS float* red, LAS float* sc, int wave, int lane) {
    const int r32 = lane & 31, hi = lane >> 5;
    if (u < 105) {
        const int n = 32 * u + r32; const bool fold = D.l > 0;
        const f32x16 acc = dec_gemm((const bf16*)(D.dec + DEC_XB2), D.win + (size_t)(32 * u) * DM, DM, red, wave, lane);
        if (wave != 0) return;
        if (fold) dec_row_stats((const float*)(D.dec + DEC_ST2), sc, lane);
        const float c1 = fold ? D.c1in[n] : 0.f, c2 = fold ? D.c2in[n] : 0.f; const int on = n < 1024 ? lgcl2orig(n) : n;
        float* PD = (float*)(D.dec + DEC_PD);
#pragma unroll
        for (int i = 0; i < 16; ++i) { const int row = crow(i, hi); float mu = 0.f, rs = 1.f; if (fold) { mu = sc[2 * row]; rs = sc[2 * row + 1]; } PD[(size_t)row * NIN + on] = (acc[i] - mu * c1) * rs + c2; }
    } else {
        const int v = u - 105, n = 32 * v + r32;
        const f32x16 acc = dec_gemm((const bf16*)(D.dec + DEC_SHB) + (size_t)D.l * MD * DM, D.winu + (size_t)(32 * v) * DM, DM, red, wave, lane);
        if (wave != 0) return;
        float* PS = (float*)(D.dec + DEC_PS);
#pragma unroll
        for (int i = 0; i < 16; ++i) PS[(size_t)crow(i, hi) * NRWU + n] = acc[i];
    }
    LDS_WAIT();
}
DI void dec_unit_res(const bf16* A, const bf16* Wt, int K, int u, bool raw, const float* src, const float* sstat, const float* g, const float* b, float* T, bf16* XB, float* ostat, float* shiftout, LAS float* red, LAS float* sc, int wave, int lane) {
    const int r32 = lane & 31, hi = lane >> 5, n = 32 * u + r32;
    const f32x16 acc = dec_gemm(A, Wt + (size_t)(32 * u) * K, K, red, wave, lane);
    if (wave != 0) return;
    if (!raw) dec_row_stats(sstat, sc, lane);
    const float gg = raw ? 1.f : g[n], bb = raw ? 0.f : b[n];
#pragma unroll
    for (int i = 0; i < 16; ++i) { const int row = crow(i, hi); float mu = 0.f, rs = 1.f; if (!raw) { mu = sc[2 * row]; rs = sc[2 * row + 1]; }
        const float x = (src[(size_t)row * DM + n] - mu) * rs * gg + bb; const float t = ALPHA * x + acc[i];
        T[(size_t)row * DM + n] = t; XB[(size_t)row * DM + n] = (bf16)f2bf(t); if (shiftout) shiftout[(size_t)row * DM + n] = x;
        float s = t, q = t * t;
#pragma unroll
        for (int o = 1; o < 32; o <<= 1) { s += __shfl_xor(s, o); q += __shfl_xor(q, o); }
        if (r32 == 0) { ostat[((size_t)row * 32 + u) * 2] = s; ostat[((size_t)row * 32 + u) * 2 + 1] = q; } }
    LDS_WAIT();
}
DI void dec_unit_up(const DecP& D, int u, LAS float* red, LAS float* sc, int wave, int lane) {
    const int r32 = lane & 31, hi = lane >> 5, n = 32 * u + r32;
    const f32x16 acc = dec_gemm((const bf16*)(D.dec + DEC_XB1), D.wup + (size_t)(32 * u) * DM, DM, red, wave, lane);
    if (wave != 0) return;
    dec_row_stats((const float*)(D.dec + DEC_ST1), sc, lane);
    const float c1 = D.c1up[n], c2 = D.c2up[n]; bf16* HB = (bf16*)(D.dec + DEC_HB);
#pragma unroll
    for (int i = 0; i < 16; ++i) { const int row = crow(i, hi); const float v = fmaxf((acc[i] - sc[2 * row] * c1) * sc[2 * row + 1] + c2, 0.f); HB[(size_t)row * FFD + n] = (bf16)f2bf(v * v); }
    LDS_WAIT();
}
DI void dec_attn_task(const DecP& D, const float* ck, const float* cv, const float* rope, int bd, int h, int p, int lane) {
    const int g = lane >> 4, dq = lane & 15, dd = 1 << (2 * p);
    const float* PD = (const float*)(D.dec + DEC_PD) + (size_t)bd * NIN;
    const f32x4 rr0 = *(const f32x4*)(rope + ((size_t)8192 * 32 + ((4 * dq) & 31)) * 2), rr1 = *(const f32x4*)(rope + ((size_t)8192 * 32 + ((4 * dq) & 31)) * 2 + 4);
    const f32x4 cs = {rr0[0], rr0[2], rr1[0], rr1[2]}, sn = {rr0[1], rr0[3], rr1[1], rr1[3]};
    const float sgn = dq < 8 ? -1.f : 1.f;
    f32x4 q = *(const f32x4*)(PD + h * 64 + 4 * dq), kn = *(const f32x4*)(PD + 512 + h * 64 + 4 * dq); const f32x4 vn = *(const f32x4*)(PD + 1024 + h * 64 + 4 * dq);
    { f32x4 qp, kp;
#pragma unroll
      for (int e = 0; e < 4; ++e) { qp[e] = __shfl_xor(q[e], 8); kp[e] = __shfl_xor(kn[e], 8); }
      q = q * cs + qp * sn * sgn; kn = kn * cs + kp * sn * sgn; }
    if (p == 0 && g == 0) { *(f32x4*)(D.out + O_KS + ((size_t)D.l * MD + bd) * 512 + h * 64 + 4 * dq) = kn; *(f32x4*)(D.out + O_VS + ((size_t)D.l * MD + bd) * 512 + h * 64 + 4 * dq) = vn; }
    float s0 = (q[0] * kn[0] + q[1] * kn[1]) + (q[2] * kn[2] + q[3] * kn[3]);
#pragma unroll
    for (int o = 1; o < 16; o <<= 1) s0 += __shfl_xor(s0, o);
    s0 *= 0.125f;
    const size_t cbase = (((size_t)D.l * MD + bd) * 2048) * 512 + h * 64 + 4 * dq;
    float mx = -INFINITY, den = 0.f; f32x4 o4 = {0.f, 0.f, 0.f, 0.f};
#pragma unroll 8
    for (int it = 0; it < 32; ++it) { const int j = 1 + 4 * it + g; const size_t off = cbase + (size_t)(2048 - j * dd) * 512;
        const f32x4 kr = *(const f32x4*)(ck + off); const f32x4 vr = *(const f32x4*)(cv + off);
        float s = (q[0] * kr[0] + q[1] * kr[1]) + (q[2] * kr[2] + q[3] * kr[3]);
#pragma unroll
        for (int o = 1; o < 16; o <<= 1) s += __shfl_xor(s, o);
        s *= 0.125f;
        const float mn = fmaxf(mx, s), sc = fexp(mx - mn), pj = fexp(s - mn);
        den = den * sc + pj; o4 = o4 * sc + vr * pj; mx = mn; }
    float mg = fmaxf(mx, __shfl_xor(mx, 16)); mg = fmaxf(mg, __shfl_xor(mg, 32)); mg = fmaxf(mg, s0);
    { const float sc = fexp(mx - mg); den *= sc; o4 = o4 * sc; }
    den += __shfl_xor(den, 16); den += __shfl_xor(den, 32);
#pragma unroll
    for (int e = 0; e < 4; ++e) { o4[e] += __shfl_xor(o4[e], 16); o4[e] += __shfl_xor(o4[e], 32); }
    const float p0 = fexp(s0 - mg); den += p0; o4 = (o4 + vn * p0) * (1.0f / den); mx = mg;
    if (g == 0) *(f32x4*)((float*)(D.dec + DEC_OP) + ((size_t)p * MD + bd) * 512 + h * 64 + 4 * dq) = o4;
    if (lane == 0) ((float*)(D.dec + DEC_LSE))[((size_t)p * MD + bd) * 8 + h] = mx + __logf(den);
}
DI void dec_rwkv_task(const DecP& D, const float* const* in, int bd, int h, LAS float* sv  , int lane) {
    const int l = D.l, ch = h * 64 + lane;
    const float* PD = (const float*)(D.dec + DEC_PD) + (size_t)bd * NIN + RW0; const float* PS = (const float*)(D.dec + DEC_PS) + (size_t)bd * NRWU;
    const float* mu = in[8] + (size_t)l * 1792;
    auto zf = [&](int col) { const float pr = PD[col], pv = PS[col]; return pr + (pv - pr) * mu[col]; };
    const float zr = zf(ch), zk = zf(512 + ch), zv0 = zf(1024 + ch);
    float vl = 0.f; if (l > 0 && lane < 32) { const float pr = PD[1792 + lane], pv = PS[1792 + lane]; vl = pr + (pv - pr) * in[9][(size_t)(l - 1) * 32 + lane]; }
    sv[lane] = ftanh(zf(1536 + lane)); sv[64 + lane] = zf(1600 + lane); sv[128 + lane] = fsigmoid(zf(1664 + lane)); sv[192 + lane] = fsigmoid(zf(1728 + lane)); sv[256 + lane] = vl;
    LDS_WAIT();
    float dw = 0.f, da = 0.f, dv = 0.f, gt = 0.f;
    const float* du = in[11] + (size_t)l * 64 * 512 + ch; const float* iu = in[13] + (size_t)l * 64 * 512 + ch; const float* gu = in[14] + (size_t)l * 128 * 512 + ch;
#pragma unroll 2
    for (int m4 = 0; m4 < 16; ++m4) { const f32x4 a = *(const LAS f32x4*)(sv + 4 * m4), b = *(const LAS f32x4*)(sv + 64 + 4 * m4), c = *(const LAS f32x4*)(sv + 128 + 4 * m4), d = *(const LAS f32x4*)(sv + 192 + 4 * m4);
#pragma unroll
        for (int e = 0; e < 4; ++e) { const int m = 4 * m4 + e; dw += a[e] * du[(size_t)m * 512]; da += b[e] * iu[(size_t)m * 512]; gt += c[e] * gu[(size_t)m * 512] + d[e] * gu[(size_t)(64 + m) * 512]; } }
    if (l > 0) { const float* vu = in[16] + (size_t)(l - 1) * 32 * 512 + ch;
#pragma unroll
        for (int m4 = 0; m4 < 8; ++m4) { const f32x4 a = *(const LAS f32x4*)(sv + 256 + 4 * m4);
#pragma unroll
            for (int e = 0; e < 4; ++e) dv += a[e] * vu[(size_t)(4 * m4 + e) * 512]; } }
    const float w = -fsoftplus(-(in[10][(size_t)l * 512 + ch] + dw)) - 0.5f, decay = fexp(-fexp(w));
    const float a = fsigmoid(in[12][(size_t)l * 512 + ch] + da);
    float* VFD = (float*)(D.dec + DEC_VF) + (size_t)bd * 512 + ch;
    float v = zv0; if (l == 0) *VFD = zv0; else v = zv0 + (*VFD - zv0) * fsigmoid(in[15][(size_t)(l - 1) * 512 + ch] + dv);
    const float kr = zk * in[17][(size_t)l * 512 + ch]; const float kn = kr / fmaxf(sqrtf(wave_sum(kr * kr)), 1e-12f);
    const float k2 = zk * (1.f + (a - 1.f) * in[18][(size_t)l * 512 + ch]);
    const float bon = wave_sum(zr * k2 * in[19][(size_t)l * 512 + ch]);
    LDS_WAIT();
    sv[320 + lane] = -kn; sv[384 + lane] = decay; sv[448 + lane] = kn * a; sv[512 + lane] = k2; sv[576 + lane] = zr; sv[640 + lane] = v;
    LDS_WAIT();
    const float* S0 = in[3] + (((size_t)l * MD + bd) * NH + h) * 4096;
    float* So = D.out + O_WKS + (((size_t)l * MD + bd) * NH + h) * 4096;
    { const int rr = lane >> 4, cq = lane & 15;
      const f32x4 a4 = *(const LAS f32x4*)(sv + 320 + 4 * cq), w4 = *(const LAS f32x4*)(sv + 384 + 4 * cq), b4 = *(const LAS f32x4*)(sv + 448 + 4 * cq), k4 = *(const LAS f32x4*)(sv + 512 + 4 * cq), r4 = *(const LAS f32x4*)(sv + 576 + 4 * cq);
      f32x4 Sr[16];
#pragma unroll
      for (int q = 0; q < 16; ++q) Sr[q] = *(const f32x4*)(S0 + (size_t)(4 * q + rr) * 64 + 4 * cq);
#pragma unroll
      for (int q = 0; q < 16; ++q) { const int i = 4 * q + rr;
          float sa = (Sr[q][0] * a4[0] + Sr[q][1] * a4[1]) + (Sr[q][2] * a4[2] + Sr[q][3] * a4[3]);
#pragma unroll
          for (int o = 1; o < 16; o <<= 1) sa += __shfl_xor(sa, o);
          const float vi = sv[640 + i];
          const f32x4 s4 = Sr[q] * w4 + b4 * sa + k4 * vi; *(f32x4*)(So + (size_t)i * 64 + 4 * cq) = s4;
          float yp = (s4[0] * r4[0] + s4[1] * r4[1]) + (s4[2] * r4[2] + s4[3] * r4[3]);
#pragma unroll
          for (int o = 1; o < 16; o <<= 1) yp += __shfl_xor(yp, o);
          if (cq == 0) sv[704 + i] = yp; } }
    LDS_WAIT();
    const float y = sv[704 + lane];
    const float mean = wave_sum(y) * (1.f / 64.f), dy = y - mean, var = wave_sum(dy * dy) * (1.f / 64.f);
    const float o = (dy * (1.0f / sqrtf(var + GN_EPS)) * in[20][(size_t)l * 512 + ch] + in[21][(size_t)l * 512 + ch] + bon * v) * gt;
    ((float*)(D.dec + DEC_MIX))[(size_t)bd * DM + 512 + ch] = o;
    LDS_WAIT();
}
DI void dec_finalize_row(const DecP& D, const float* gain, int bd, int lane) {
    const int h = lane >> 3; const float* L = (const float*)(D.dec + DEC_LSE); const float* OPD = (const float*)(D.dec + DEC_OP);
    const float l0 = L[((size_t)0 * MD + bd) * 8 + h], l1 = L[((size_t)1 * MD + bd) * 8 + h], l2 = L[((size_t)2 * MD + bd) * 8 + h];
    const float mx = fmaxf(l0, fmaxf(l1, l2)); float w0 = fexp(l0 - mx), w1 = fexp(l1 - mx), w2 = fexp(l2 - mx); const float inv = 1.0f / (w0 + w1 + w2); w0 *= inv; w1 *= inv; w2 *= inv;
    float v[8]; float ss = 0.f;
#pragma unroll
    for (int e = 0; e < 8; ++e) { v[e] = w0 * OPD[((size_t)0 * MD + bd) * 512 + lane * 8 + e] + w1 * OPD[((size_t)1 * MD + bd) * 512 + lane * 8 + e] + w2 * OPD[((size_t)2 * MD + bd) * 512 + lane * 8 + e]; ss += v[e] * v[e]; }
    ss = wave_sum(ss); const float rinv = 1.0f / sqrtf(ss * (1.f / 512.f) + RMS_EPS);
    bf16* MB = (bf16*)(D.dec + DEC_MIXB) + (size_t)bd * DM; const float* MX = (const float*)(D.dec + DEC_MIX) + (size_t)bd * DM + 512;
#pragma unroll
    for (int e = 0; e < 8; ++e) { MB[lane * 8 + e] = (bf16)f2bf(v[e] * rinv * gain[lane * 8 + e]); MB[512 + lane * 8 + e] = (bf16)f2bf(MX[lane * 8 + e]); }
}
#ifndef PH_MASK
#define PH_MASK 0x1ff
#endif
#define PH_ON(k) ((PH_MASK >> (k)) & 1)
#ifndef PH_DUP
#define PH_DUP 0
#endif
#define PH_REP(k) for (int rep_ = 0; rep_ < (((PH_DUP >> (k)) & 1) ? 2 : 1); ++rep_)
DI unsigned lds_task_next(volatile LAS unsigned* ctr, int lane) {
    unsigned t = 0; if (lane == 0) t = __hip_atomic_fetch_add((LAS unsigned*)ctr, 1u, __ATOMIC_RELAXED, __HIP_MEMORY_SCOPE_WORKGROUP);
    return (unsigned)__builtin_amdgcn_readfirstlane((int)t);
}
DI DecP make_dec(unsigned char* ws, const float* const* in, float* out, int l) {
    DecP D; D.dec = ws + WS_DEC; D.l = l; D.xs = in[1];
    D.c1in = (const float*)(ws + WS_C1IN) + l * NIN; D.c2in = (const float*)(ws + WS_C2IN) + l * NIN; D.c1up = (const float*)(ws + WS_C1UP) + l * FFD; D.c2up = (const float*)(ws + WS_C2UP) + l * FFD;
    D.g1 = in[24] + (size_t)l * DM; D.b1 = in[25] + (size_t)l * DM; D.g2p = l > 0 ? in[28] + (size_t)(l - 1) * DM : nullptr; D.b2p = l > 0 ? in[29] + (size_t)(l - 1) * DM : nullptr;
    D.win = (const bf16*)(ws + WS_WIN) + (size_t)l * NIN * DM; D.winu = (const bf16*)(ws + WS_WINU) + (size_t)l * NRWU * DM; D.wout = (const bf16*)(ws + WS_WOUT) + (size_t)l * DM * DM;
    D.wup = (const bf16*)(ws + WS_WUP) + (size_t)l * FFD * DM; D.wdn = (const bf16*)(ws + WS_WDN) + (size_t)l * DM * FFD; D.out = out; return D;
}
DI RwkvP make_rwkv(unsigned char* ws, const float* const* in, int l) {
    RwkvP R; R.PR = (const bf16*)(ws + WS_PR); R.mu = in[8] + (size_t)l * 1792; R.muv = l > 0 ? in[9] + (size_t)(l - 1) * 32 : nullptr;
    R.dbase = in[10] + (size_t)l * 512; R.ibase = in[12] + (size_t)l * 512; R.vbase = l > 0 ? in[15] + (size_t)(l - 1) * 512 : nullptr; R.ksk = in[17] + (size_t)l * 512; R.ksa = in[18] + (size_t)l * 512; R.brk = in[19] + (size_t)l * 512;
    R.gng = in[20] + (size_t)l * 512; R.gnb = in[21] + (size_t)l * 512;
    R.dupT = (const bf16*)(ws + WS_DUPT) + (size_t)l * 512 * 64; R.iupT = (const bf16*)(ws + WS_IUPT) + (size_t)l * 512 * 64; R.vupT = l > 0 ? (const bf16*)(ws + WS_VUPT) + (size_t)(l - 1) * 512 * 32 : nullptr; R.gupT = (const bf16*)(ws + WS_GUPT) + (size_t)l * 512 * 128;
    R.ZROW = (const bf16*)(ws + WS_CTL + 512 * 1024); R.VF = (bf16*)(ws + WS_VF); R.VV = (bf16*)(ws + WS_VV); R.BON = (float*)(ws + WS_BON); R.GC = (float*)(ws + WS_GC); R.W1S = (bf16*)(ws + WS_PT); R.REFF = (bf16*)(ws + WS_REFF); R.BM = (bf16*)(ws + WS_QT); R.REC = (v4u*)(ws + WS_YLOC);
    R.YPRE = (float*)(ws + WS_YPRE); R.MIX = (bf16*)(ws + WS_MIX); R.layer0 = (l == 0); return R;
}
#define PHASE_VARS() int tid_p = (int)threadIdx.x; asm volatile("" : "+v"(tid_p)); const int lane = tid_p & 63; const int wave = __builtin_amdgcn_readfirstlane(tid_p >> 6); \
    unsigned zo_p; asm volatile("s_mov_b32 %0, 0" : "=s"(zo_p)); unsigned char* ws = args.ws + zo_p; const float* const* in = args.in + zo_p; float* out = args.out + zo_p; \
    const int gw = F.vcu * NWAVES + wave; const int rgw = (F.G - 1 - (int)blockIdx.x) * NWAVES + wave; LAS float* dsc = (LAS float*)(L3 + 65536); LAS float* dred = (LAS float*)L3; const int rwg = F.G - 1 - (int)blockIdx.x; (void)gw; (void)rgw; (void)dsc; (void)dred; (void)rwg; (void)lane; (void)in; (void)out
__global__ void __launch_bounds__(NWAVES * 64, 2) mega_fwd(Args args) {
    extern __shared__ __attribute__((aligned(16))) unsigned char lds[];
    Frame F;
    F.lds = lds; F.MISC = (volatile LAS unsigned*)((LAS unsigned char*)lds + MISC_OFF);
    F.tid = threadIdx.x; F.lane = F.tid & 63; F.wave = __builtin_amdgcn_readfirstlane(F.tid >> 6);
    F.G = gridDim.x; { const int bx = blockIdx.x; F.vcu = (F.G % 8 == 0) ? (bx % 8) * (F.G / 8) + bx / 8 : bx; }
    F.gw = F.vcu * NWAVES + F.wave; F.NGW = F.G * NWAVES;
    F.in = args.in; F.out = args.out; F.ws = args.ws; F.ctl = (gu32*)(args.ws + WS_CTL);
    LAS unsigned char* L3 = (LAS unsigned char*)lds;
    for (int u = F.tid; u < (LDS_BYTES - RING_BYTES) / 4; u += NWAVES * 64) ((LAS unsigned*)(L3 + RING_BYTES))[u] = 0u;
    __syncthreads();
    XcdBarrier bar = xcd_barrier_post((unsigned*)(F.ctl + CW_BAR), F.MISC + 8);
#define GRID_BAR() do { XcdBarrier b2_ = bar; asm volatile("" : "+s"(b2_.x)); xcd_barrier(b2_); } while (0)

    PH_REP(0) { if (PH_ON(0)) p0_prologue(F);
    GRID_BAR(); }

    for (int l = 0; l < DEPTH; ++l) {
        PH_REP(1) {
        if (PH_ON(1))
        {   PHASE_VARS(); const DecP D = make_dec(ws, in, out, l);
            pg8::Gemm g{(const pg8::bf16_t*)(ws + WS_XB2), (const pg8::bf16_t*)D.win, M, NIN, DM}; pg8::StaticOrder S; S.init(M, NIN, F.G, (int)blockIdx.x);
            pg8::EpiIn E{ws, out, l};
            pg8::gemm_phase<pg8::EpiIn, pg8::StaticOrder, true, true>((PG8_LAS unsigned char*)L3, g, S, E, tid_p);
            for (int u = rwg; u < 162; u += F.G) dec_unit_in(D, u, dred, dsc, wave, lane);
        }
        GRID_BAR();
        }

#define ATT_QUEUE() do { LAS unsigned char* wl_ = L3 + wave * 10240; const int bh_ = F.vcu >> 4, span_ = F.vcu & 15; \
        for (;;) { const unsigned t_ = lds_task_next(F.MISC, lane); if (t_ >= 48u) break; \
            if (t_ >= 48u) { const int dt_ = (int)blockIdx.x * 4 + (int)(t_ - 48u); \
                if (dt_ < 768) dec_attn_task(D, in[4], in[5], (const float*)(ws + WS_ROPE), dt_ / 24, (dt_ % 24) / 3, dt_ % 3, lane); \
                else dec_rwkv_task(D, in, (dt_ - 768) >> 3, (dt_ - 768) & 7, (LAS float*)wl_, lane); continue; } \
            const int p_ = (int)t_ >> 4, idx_ = (int)t_ & 15; \
            const int cls_ = p_ == 0 ? 0 : p_ == 1 ? (idx_ >> 2) : idx_, qblk_ = p_ == 0 ? span_ * 16 + idx_ : p_ == 1 ? span_ * 4 + (idx_ & 3) : span_; \
            attn_task((const bf16*)(ws + WS_QB), (const bf16*)(ws + WS_KB), (const bf16*)(ws + WS_VB), (bf16*)(ws + WS_OP), (float*)(ws + WS_LSE), bh_ >> 3, bh_ & 7, p_, cls_, qblk_, wl_, lane); } } while (0)
        PH_REP(3) {
        if (PH_ON(3))
        {   PHASE_VARS(); const DecP D = make_dec(ws, in, out, l); const RwkvP R = make_rwkv(ws, in, l);
            if (tid_p == 0) F.MISC[0] = 0u;
            if (l == 0) colsum_finish(ws, gw * 64 + lane, F.NGW * 64);
            { LAS unsigned char* wl1 = L3 + wave * 12288; LAS unsigned char* hc = L3 + 8 * 12288;
              head_cache_fill(R, (F.vcu >> 4) & 7, hc, tid_p);
              __syncthreads();
#pragma unroll 1
              for (int i = 0; i < 4; ++i) rwkv_b1_unit(R, F.vcu * 32 + wave + 8 * i, wl1, hc, lane); }
            VM_WAIT(); __syncthreads();
            if (wave >= 4) { const int dt = (int)blockIdx.x * 4 + (wave - 4);
                if (dt < 768) dec_attn_task(D, in[4], in[5], (const float*)(ws + WS_ROPE), dt / 24, (dt % 24) / 3, dt % 3, lane);
                else dec_rwkv_task(D, in, (dt - 768) >> 3, (dt - 768) & 7, (LAS float*)(L3 + wave * 10240), lane); }
            if (wave < 4) chain_pass1(R, (float*)(ws + WS_SEGQ), (float*)(ws + WS_SEGP), F.vcu >> 4, F.vcu & 15, wave, lane);
            ATT_QUEUE();
            if ((PH_DUP >> 12) & 1) { __syncthreads(); if (tid_p == 0) F.MISC[0] = 0u; __syncthreads(); ATT_QUEUE(); }
        }
        GRID_BAR();
        }
        PH_REP(9) {
        if (PH_ON(3))
        {   PHASE_VARS(); const DecP D = make_dec(ws, in, out, l); const RwkvP R = make_rwkv(ws, in, l);
            const int seq = F.vcu >> 4, sg = F.vcu & 15;
            LAS unsigned char* gcache = L3 + 98304; gate_cache_fill(R, seq & 7, gcache, tid_p);
            if (wave < 4) chain_pass23(R, (const float*)(ws + WS_SEGQ), (const float*)(ws + WS_SEGP), seq, sg, wave, out + O_WKP + ((size_t)l * 16 + seq) * 4096, lane);
            else { for (int i = 0; i < 16; ++i) attn_finalize_row((const bf16*)(ws + WS_OP), (const float*)(ws + WS_LSE), in[22] + (size_t)l * 512, (bf16*)(ws + WS_MIX), (int)blockIdx.x * 64 + (wave - 4) * 16 + i, lane);
                if (blockIdx.x < MD && wave == 4) dec_finalize_row(D, in[22] + (size_t)l * 512, (int)blockIdx.x, lane); }
            VM_WAIT(); __syncthreads();
#pragma unroll 1
            for (int i = 0; i < 4; ++i) rwkv_b3_unit(R, seq * NCH + sg * SEGCH + wave + 8 * i, gcache, L3 + wave * 12288, lane);
        }
        GRID_BAR();
        }

        PH_REP(5) {
        if (PH_ON(5))
        {   PHASE_VARS(); const DecP D = make_dec(ws, in, out, l);
            pg8::Gemm g{(const pg8::bf16_t*)(ws + WS_MIX), (const pg8::bf16_t*)D.wout, M, DM, DM}; pg8::StaticOrder S; S.init(M, DM, F.G, (int)blockIdx.x);
            pg8::EpiRes<false> E{ws, in, out, l};
            pg8::gemm_phase<pg8::EpiRes<false>, pg8::StaticOrder, false, true>((PG8_LAS unsigned char*)L3, g, S, E, tid_p);
            for (int u = rwg; u < 32; u += F.G)
                dec_unit_res((const bf16*)(D.dec + DEC_MIXB), D.wout, DM, u, l == 0, l == 0 ? D.xs : (const float*)(D.dec + DEC_T2), (const float*)(D.dec + DEC_ST2), D.g2p, D.b2p, (float*)(D.dec + DEC_T1), (bf16*)(D.dec + DEC_XB1), (float*)(D.dec + DEC_ST1),
                             out + O_SHS + (size_t)l * MD * DM, dred, dsc, wave, lane);
        }
        GRID_BAR();
        }

        PH_REP(6) {
        if (PH_ON(6))
        {   PHASE_VARS(); const DecP D = make_dec(ws, in, out, l);
            pg8::Gemm g{(const pg8::bf16_t*)(ws + WS_XB1), (const pg8::bf16_t*)D.wup, M, FFD, DM}; pg8::StaticOrder S; S.init(M, FFD, F.G, (int)blockIdx.x);
            pg8::EpiUp E{ws, l};
            pg8::gemm_phase<pg8::EpiUp, pg8::StaticOrder, true, true>((PG8_LAS unsigned char*)L3, g, S, E, tid_p);
            for (int u = rwg; u < 128; u += F.G) dec_unit_up(D, u, dred, dsc, wave, lane);
        }
        GRID_BAR();
        }

        PH_REP(7) {
        if (PH_ON(7))
        {   PHASE_VARS(); const DecP D = make_dec(ws, in, out, l);
            pg8::Gemm g{(const pg8::bf16_t*)(ws + WS_H), (const pg8::bf16_t*)D.wdn, M, DM, FFD}; pg8::StaticOrder S; S.init(M, DM, F.G, (int)blockIdx.x);
            pg8::EpiRes<true> E{ws, in, out, l};
            PH_REP(11) { pg8::gemm_phase<pg8::EpiRes<true>, pg8::StaticOrder, false, true>((PG8_LAS unsigned char*)L3, g, S, E, tid_p); }
            PH_REP(10) for (int u = rwg; u < 32; u += F.G)
                dec_unit_res((const bf16*)(D.dec + DEC_HB), D.wdn, FFD, u, false, (const float*)(D.dec + DEC_T1), (const float*)(D.dec + DEC_ST1), D.g1, D.b1, (float*)(D.dec + DEC_T2), (bf16*)(D.dec + DEC_XB2), (float*)(D.dec + DEC_ST2), nullptr, dred, dsc, wave, lane);
        }
        GRID_BAR();
        }
    }
    if (PH_ON(8))
    {   PHASE_VARS(); const float* g = in[28] + (size_t)3 * DM; const float* b = in[29] + (size_t)3 * DM;
        for (int r = gw; r < M; r += F.NGW) { float mu, rs; pg8::row_stats((const float*)(ws + WS_STAT2), r, mu, rs);
            const v2u* t = (const v2u*)((const bf16*)(ws + WS_XB2) + (size_t)r * DM) + lane; f32x4* o = (f32x4*)(out + O_Y + (size_t)r * DM) + lane;
#pragma unroll
            for (int j = 0; j < 4; ++j) { const f32x4 gg = *((const f32x4*)g + lane + 64 * j), bb = *((const f32x4*)b + lane + 64 * j); const v2u w = t[64 * j]; const f32x4 tv = {bflo(w.x), bfhi(w.x), bflo(w.y), bfhi(w.y)}; o[64 * j] = (tv - mu) * rs * gg + bb; } }
        if (rgw < MD) { LAS float* fsc = dsc + wave * 64; dec_row_stats((const float*)(ws + WS_DEC + DEC_ST2), fsc, lane); const float mu = fsc[2 * rgw], rs = fsc[2 * rgw + 1];
            const f32x4* t = (const f32x4*)((const float*)(ws + WS_DEC + DEC_T2) + (size_t)rgw * DM) + lane; f32x4* o = (f32x4*)(out + O_YS + (size_t)rgw * DM) + lane;
#pragma unroll
            for (int j = 0; j < 4; ++j) { const f32x4 gg = *((const f32x4*)g + lane + 64 * j), bb = *((const f32x4*)b + lane + 64 * j); o[64 * j] = (t[64 * j] - mu) * rs * gg + bb; } }
    }
}

extern "C" void kernel_launch(void* const* d_in, const int* in_sizes, int n_in, void* d_out, int out_size, void* d_ws, size_t ws_size, hipStream_t stream) {
    static int grid = 0;
    if (grid == 0) {
        if (n_in != 30 || out_size != (int)O_END || ws_size < WS_END) { fprintf(stderr, "kernel_launch: unexpected problem (n_in %d, out %d, ws %zu); nothing launched\n", n_in, out_size, ws_size); grid = -1; return; }
        int dev = 0, cus = 0, per_cu = 0;
        if (hipGetDevice(&dev) != hipSuccess || hipDeviceGetAttribute(&cus, hipDeviceAttributeMultiprocessorCount, dev) != hipSuccess) { fprintf(stderr, "kernel_launch: device query failed\n"); grid = -1; return; }
        if (hipFuncSetAttribute((const void*)mega_fwd, hipFuncAttributeMaxDynamicSharedMemorySize, LDS_BYTES) != hipSuccess) { fprintf(stderr, "kernel_launch: hipFuncSetAttribute failed\n"); grid = -1; return; }
        if (hipOccupancyMaxActiveBlocksPerMultiprocessor(&per_cu, (const void*)mega_fwd, NWAVES * 64, LDS_BYTES) != hipSuccess || per_cu < 1) fprintf(stderr, "kernel_launch: occupancy query reports %d\n", per_cu);
        (void)hipGetLastError();
        if (cus < 256) { fprintf(stderr, "kernel_launch: needs 256 CUs (found %d)\n", cus); grid = -1; return; }
        grid = 256;
    }
    if (grid < 0) return;
    if (hipMemsetAsync((char*)d_ws + WS_CTL, 0, CTL_ZERO_BYTES, stream) != hipSuccess) { fprintf(stderr, "kernel_launch: memset failed\n"); return; }
    Args a{};
    for (int i = 0; i < 30; ++i) a.in[i] = (const float*)d_in[i];
    a.out = (float*)d_out; a.ws = (unsigned char*)d_ws;
    hipLaunchKernelGGL(mega_fwd, dim3(grid), dim3(NWAVES * 64), LDS_BYTES, stream, a);
    const hipError_t le = hipPeekAtLastError();
    if (le != hipSuccess) fprintf(stderr, "kernel_launch: launch failed: %s\n", hipGetErrorName(le));
}
```

```cpp
#include <hip/hip_runtime.h>
#include <cstdio>
#include <cstdint>
#include <cmath>
namespace pg8 {
#define PG8_LAS __attribute__((address_space(3)))
typedef unsigned short bf16_t;
typedef short bf16x8 __attribute__((ext_vector_type(8)));
typedef float f32x4 __attribute__((ext_vector_type(4)));
typedef unsigned u32x4 __attribute__((ext_vector_type(4)));
constexpr int BM = 256, BK = 64, HALF = 128, HTB = HALF * BK * 2  , STAGE_BYTES = 8 * HTB, NXCD = 8, WGM = 8;

__host__ __device__ __forceinline__ int lds_byte(int r, int c) { const int st = (r >> 4) * 2 + (c >> 5), rr = r & 15, cc = c & 31, ob = rr * 64 + cc * 2; return st * 1024 + (ob ^ (((ob >> 9) & 1) << 5)); }
__host__ __device__ __forceinline__ void stage_rc(int b, int& R, int& C) { const int st = b / 1024, sb = b % 1024, swz = sb ^ (((sb >> 9) & 1) << 5); R = (st >> 1) * 16 + swz / 64; C = (st & 1) * 32 + (swz % 64) / 2; }
__host__ __device__ __forceinline__ int perm32(int rho) { const int n = rho >> 4, i = rho & 15; return 8 * (i >> 2) + 4 * n + (i & 3); }

struct Unit { int pm, pn; };
struct Gemm { const bf16_t* A; const bf16_t* Bt; int M, N, K; };

struct StaticOrder {
    int nM, nN, nwg, G, c;
    __host__ __device__ void init(int M, int N, int G_, int c_) { nM = M / BM; nN = N / BM; nwg = nM * nN; G = G_; c = c_; }
    __host__ __device__ bool next(int i, Unit& u) const {
        const long L = (long)i * G + c; if (L >= nwg) return false;
        int wgid = (int)L; { const int q = nwg / NXCD, r = nwg % NXCD, xcd = wgid % NXCD, off = wgid / NXCD; wgid = (xcd < r ? xcd * (q + 1) : r * (q + 1) + (xcd - r) * q) + off; }
        const int nig = WGM * nN, gid = wgid / nig, fm = gid * WGM, gsz = (nM - fm) < WGM ? (nM - fm) : WGM;
        u.pm = fm + ((wgid % nig) % gsz); u.pn = (wgid % nig) / gsz; return true;
    }
    __device__ __forceinline__ void a_ready(const Unit&) const {}
    __device__ __forceinline__ void done(const Unit&) const {}
};

__device__ __forceinline__ unsigned cvt_pk_bf16(float lo, float hi) { unsigned r; asm volatile("v_cvt_pk_bf16_f32 %0, %1, %2" : "=v"(r) : "v"(lo), "v"(hi)); return r; }
typedef float f32x2 __attribute__((ext_vector_type(2)));
constexpr size_t WSO_C1IN = 1u << 20, WSO_C2IN = WSO_C1IN + 4 * 3584 * 4, WSO_C1UP = WSO_C2IN + 4 * 3584 * 4, WSO_C2UP = WSO_C1UP + 4 * 4096 * 4, WSO_ROPE = 3u << 20, WSO_STAT1 = 8u << 20, WSO_STAT2 = 9u << 20;
constexpr size_t WSO_XB2 = 132ull << 20, WSO_XB1 = 164ull << 20, WSO_T1 = 196ull << 20, WSO_T2 = 260ull << 20, WSO_QB = 324ull << 20, WSO_KB = 340ull << 20, WSO_VB = 356ull << 20, WSO_PR = 372ull << 20, WSO_H = 580ull << 20;
constexpr size_t OO_SHP = 16809984, OO_KP = 21405696, OO_VP = 29794304;
__device__ __forceinline__ void row_stats(const float* stat, int row, float& mu, float& rs) {
    const f32x4 a = *(const f32x4*)(stat + (size_t)row * 8), b = *(const f32x4*)(stat + (size_t)row * 8 + 4);
    const float s = (a[0] + a[2]) + (b[0] + b[2]), q = (a[1] + a[3]) + (b[1] + b[3]);
    mu = s * (1.f / 1024.f); const float var = fmaxf(q * (1.f / 1024.f) - mu * mu, 0.f); rs = 1.0f / sqrtf(var + 1e-5f);
}
typedef float f32x2e __attribute__((ext_vector_type(2)));
typedef unsigned u32x2e __attribute__((ext_vector_type(2)));
constexpr int ETAB_OFF = 132096, ETAB_SLOT = 4096;
constexpr int ETAB_IDS = ETAB_OFF + 4 * ETAB_SLOT;
template <class Sched> __device__ __forceinline__ void etab_fill(PG8_LAS unsigned char* lds0, const Sched& S, const float* stat, const float* c1, const float* c2, bool fold, int tid) {
#pragma unroll 1
    for (int i = 0; i < 4; ++i) { Unit u; const bool ok = S.next(i, u);
        if (tid == 0) { ((PG8_LAS int*)(lds0 + ETAB_IDS))[2 * i] = ok ? u.pm : -1; ((PG8_LAS int*)(lds0 + ETAB_IDS))[2 * i + 1] = ok ? u.pn : -1; }
        if (!ok) continue;
        PG8_LAS unsigned char* slot = lds0 + ETAB_OFF + i * ETAB_SLOT;
        if (tid < 256) { float mu = 0.f, rs = 1.f; if (fold) row_stats(stat, u.pm * BM + tid, mu, rs); ((PG8_LAS f32x2e*)slot)[tid] = (f32x2e){mu, rs}; }
        else { const int c = u.pn * BM + tid - 256; ((PG8_LAS float*)(slot + 2048))[tid - 256] = fold ? c1[c] : 0.f; ((PG8_LAS float*)(slot + 3072))[tid - 256] = fold ? c2[c] : 0.f; }
    }
}
__device__ __forceinline__ const PG8_LAS unsigned char* etab_find(const PG8_LAS unsigned char* lds0, const Unit& u) {
    const PG8_LAS int* ids = (const PG8_LAS int*)(lds0 + ETAB_IDS); int s = 0;
#pragma unroll
    for (int i = 1; i < 4; ++i) if (ids[2 * i] == u.pm && ids[2 * i + 1] == u.pn) s = i;
    return lds0 + ETAB_OFF + s * ETAB_SLOT;
}
struct EpiIn {
    static constexpr bool PERM = true, AFTER_DRAIN = false;
    unsigned char* ws; float* out; int l; const PG8_LAS unsigned char* lds0;
    __device__ __forceinline__ void operator()(const f32x4 (&acc)[2][2][4][2], const Unit& u, int wr, int wc, int fr, int fq) const {
        asm volatile("" ::: "memory"); __builtin_amdgcn_sched_barrier(0);
        const PG8_LAS unsigned char* slot = etab_find(lds0, u);
        const PG8_LAS f32x2e* st = (const PG8_LAS f32x2e*)slot; const PG8_LAS float* tc1 = (const PG8_LAS float*)(slot + 2048); const PG8_LAS float* tc2 = (const PG8_LAS float*)(slot + 3072);
        bf16_t* QB = (bf16_t*)(ws + WSO_QB); bf16_t* KB = (bf16_t*)(ws + WSO_KB); bf16_t* VB = (bf16_t*)(ws + WSO_VB); bf16_t* PR = (bf16_t*)(ws + WSO_PR); const float* rope = (const float*)(ws + WSO_ROPE);
        float* outk = out + OO_KP + (size_t)l * 2 * 2048 * 512; float* outv = out + OO_VP + (size_t)l * 2 * 2048 * 512; const float qscale = 0.125f * 1.4426950408889634f;
        const int cb = u.pn * BM + wc * 32 + 8 * fq;
        const int i0 = 16 * (wc & 1) + 4 * fq; const bool roped = u.pn < 4;
        const int rbase = u.pm * BM + wr * 64 + fr;
        const int cl = wc * 32 + 8 * fq;
#pragma unroll
        for (int bj = 0; bj < 2; ++bj) {
            f32x4 c1v[2], c2v[2];
#pragma unroll
            for (int n = 0; n < 2; ++n) { c1v[n] = *(const PG8_LAS f32x4*)(tc1 + cl + bj * HALF + n * 4); c2v[n] = *(const PG8_LAS f32x4*)(tc2 + cl + bj * HALF + n * 4); }
#pragma unroll
            for (int gq = 0; gq < 8; ++gq) {
                const int ai = gq >> 2, m = gq & 3;
                const int r = rbase + ai * HALF + m * 16;
                const f32x2e ms = st[ai * HALF + wr * 64 + m * 16 + fr]; const float mu = ms.x, rs = ms.y;
                f32x4 ra = {0.f, 0.f, 0.f, 0.f}, rb = ra;
                if (roped) { const float* rp = rope + ((size_t)(r & 8191) * 32 + i0) * 2; ra = *(const f32x4*)rp; rb = *(const f32x4*)(rp + 4); }
                if ((gq & 3) == 3) asm volatile("" ::: "memory");
                f32x4 v[2];
#pragma unroll
                for (int n = 0; n < 2; ++n) v[n] = (acc[ai][bj][m][n] - mu * c1v[n]) * rs + c2v[n];
                const int pos = r & 8191, b = r >> 13;
                if (roped) {
                    const f32x4 cs = {ra[0], ra[2], rb[0], rb[2]}, sn = {ra[1], ra[3], rb[1], rb[3]};
                    const int head = (u.pn & 1) * 4 + bj * 2 + (wc >> 1);
                    f32x4 y1 = v[0] * cs - v[1] * sn, y2 = v[0] * sn + v[1] * cs;
                    const size_t o = (size_t)r * 512 + head * 64 + i0;
                    if (u.pn < 2) { y1 = y1 * qscale; y2 = y2 * qscale;
                        u32x2e w; w.x = cvt_pk_bf16(y1[0], y1[1]); w.y = cvt_pk_bf16(y1[2], y1[3]); *(u32x2e*)(QB + o) = w;
                        w.x = cvt_pk_bf16(y2[0], y2[1]); w.y = cvt_pk_bf16(y2[2], y2[3]); *(u32x2e*)(QB + o + 32) = w;
                    } else {
                        u32x2e w; w.x = cvt_pk_bf16(y1[0], y1[1]); w.y = cvt_pk_bf16(y1[2], y1[3]); *(u32x2e*)(KB + o) = w;
                        w.x = cvt_pk_bf16(y2[0], y2[1]); w.y = cvt_pk_bf16(y2[2], y2[3]); *(u32x2e*)(KB + o + 32) = w;
                        if (pos >= 6144) { float* ok = outk + ((size_t)(b * 2048 + pos - 6144)) * 512 + head * 64 + i0; *(f32x4*)ok = y1; *(f32x4*)(ok + 32) = y2; }
                    }
                } else if (u.pn < 6) {
                    const int c = cb + bj * HALF - 1024;
                    u32x4 w; w.x = cvt_pk_bf16(v[0][0], v[0][1]); w.y = cvt_pk_bf16(v[0][2], v[0][3]); w.z = cvt_pk_bf16(v[1][0], v[1][1]); w.w = cvt_pk_bf16(v[1][2], v[1][3]); *(u32x4*)(VB + (size_t)r * 512 + c) = w;
                    if (pos >= 6144) { float* ov = outv + ((size_t)(b * 2048 + pos - 6144)) * 512 + c; *(f32x4*)ov = v[0]; *(f32x4*)(ov + 4) = v[1]; }
                } else {
                    const int c = cb + bj * HALF - 1536;
                    if (c < 1824) { u32x4 w; w.x = cvt_pk_bf16(v[0][0], v[0][1]); w.y = cvt_pk_bf16(v[0][2], v[0][3]); w.z = cvt_pk_bf16(v[1][0], v[1][1]); w.w = cvt_pk_bf16(v[1][2], v[1][3]); *(u32x4*)(PR + (size_t)r * 2048 + c) = w; }
                }
            }
        }
    }
};
template <bool IS_F> struct EpiRes {
    static constexpr bool PERM = true, AFTER_DRAIN = true;
    unsigned char* ws; const float* const* in; float* out; int l;
    __device__ __forceinline__ void fused(f32x4 (&acc)[2][2][4][2], const Unit& u, int wr, int wc, int fr, int fq, PG8_LAS unsigned char* lds, int wid, int lane) const {
        const int raw = (!IS_F && l == 0) ? 1 : 0;
        const bf16_t* src = (const bf16_t*)(ws + (IS_F ? WSO_XB1 : WSO_XB2));
        const float* sstat = (const float*)(ws + (IS_F ? WSO_STAT1 : WSO_STAT2));
        const float* g = IS_F ? in[24] + (size_t)l * 1024 : in[28] + (size_t)(l > 0 ? l - 1 : 0) * 1024; const float* b = IS_F ? in[25] + (size_t)l * 1024 : in[29] + (size_t)(l > 0 ? l - 1 : 0) * 1024;
        bf16_t* XB = (bf16_t*)(ws + (IS_F ? WSO_XB2 : WSO_XB1)); float* ostat = (float*)(ws + (IS_F ? WSO_STAT2 : WSO_STAT1));
        float* shiftout = (IS_F || raw) ? nullptr : out + OO_SHP + (size_t)l * 2 * 1024; const float alpha = 1.6817928305074290f;
        PG8_LAS f32x2e* P = (PG8_LAS f32x2e*)lds;
        const int cb = u.pn * BM + wc * 32 + 8 * fq;
        const int rbase = u.pm * BM + wr * 64 + fr;
        u32x4 cur[2], nxt[2]; f32x4 sa = {0.f, 0.f, 0.f, 0.f}, sb = sa, san = sa, sbn = sa;
#pragma unroll
        for (int bj = 0; bj < 2; ++bj) { cur[bj] = *(const u32x4*)(src + (size_t)rbase * 1024 + cb + bj * HALF); nxt[bj] = cur[bj]; }
        if (!raw) { sa = *(const f32x4*)(sstat + (size_t)rbase * 8); sb = *(const f32x4*)(sstat + (size_t)rbase * 8 + 4); }
#pragma unroll
        for (int gq = 0; gq < 8; ++gq) {
            const int ai = gq >> 2, m = gq & 3;
            const int r = rbase + ai * HALF + m * 16;
            if (gq < 7) { const int rn = rbase + ((gq + 1) >> 2) * HALF + ((gq + 1) & 3) * 16;
#pragma unroll
                for (int bj = 0; bj < 2; ++bj) nxt[bj] = *(const u32x4*)(src + (size_t)rn * 1024 + cb + bj * HALF);
                if (!raw) { san = *(const f32x4*)(sstat + (size_t)rn * 8); sbn = *(const f32x4*)(sstat + (size_t)rn * 8 + 4); } }
            asm volatile("" ::: "memory");
            float mu = 0.f, rs = 1.f;
            if (!raw) { const float ssum = (sa[0] + sa[2]) + (sb[0] + sb[2]), qsum = (sa[1] + sa[3]) + (sb[1] + sb[3]); mu = ssum * (1.f / 1024.f); rs = 1.0f / sqrtf(fmaxf(qsum * (1.f / 1024.f) - mu * mu, 0.f) + 1e-5f); }
            float s = 0.f, q = 0.f;
#pragma unroll
            for (int bj = 0; bj < 2; ++bj) { const int c = cb + bj * HALF; const size_t off = (size_t)r * 1024 + c; const u32x4 cw = cur[bj]; u32x4 wout;
#pragma unroll
                for (int n = 0; n < 2; ++n) {
                    const f32x4 gvv = raw ? (f32x4){1.f, 1.f, 1.f, 1.f} : *(const f32x4*)(g + c + 4 * n), bvv = raw ? (f32x4){0.f, 0.f, 0.f, 0.f} : *(const f32x4*)(b + c + 4 * n);
                    const unsigned w0 = n ? cw.z : cw.x, w1 = n ? cw.w : cw.y;
                    const f32x4 cf = {__builtin_bit_cast(float, w0 << 16), __builtin_bit_cast(float, w0 & 0xffff0000u), __builtin_bit_cast(float, w1 << 16), __builtin_bit_cast(float, w1 & 0xffff0000u)};
                    const f32x4 x = (cf - mu) * rs * gvv + bvv;
                    const f32x4 t = x * alpha + acc[ai][bj][m][n];
                    const unsigned p0 = cvt_pk_bf16(t[0], t[1]), p1 = cvt_pk_bf16(t[2], t[3]); if (n) { wout.z = p0; wout.w = p1; } else { wout.x = p0; wout.y = p1; }
                    s += (t[0] + t[1]) + (t[2] + t[3]); q += (t[0] * t[0] + t[1] * t[1]) + (t[2] * t[2] + t[3] * t[3]);
                    if (shiftout && (r & 8191) == 8191) *(f32x4*)(shiftout + (size_t)(r >> 13) * 1024 + c + 4 * n) = x; }
                *(u32x4*)(XB + off) = wout; }
            s += __shfl_xor(s, 16); s += __shfl_xor(s, 32); q += __shfl_xor(q, 16); q += __shfl_xor(q, 32);
            if (fq == 0) P[(ai * HALF + wr * 64 + m * 16 + fr) * 4 + wc] = (f32x2e){s, q};
#pragma unroll
            for (int bj = 0; bj < 2; ++bj) cur[bj] = nxt[bj];
            sa = san; sb = sbn;
        }
        asm volatile("s_waitcnt lgkmcnt(0)" ::: "memory"); __builtin_amdgcn_s_barrier(); asm volatile("" ::: "memory");
        if (threadIdx.x < 256) { const int row = threadIdx.x; const f32x2e a = P[row * 4 + 0], b2 = P[row * 4 + 1], c = P[row * 4 + 2], d = P[row * 4 + 3];
            *(f32x2e*)(ostat + (size_t)(u.pm * BM + row) * 8 + u.pn * 2) = (f32x2e){(a.x + b2.x) + (c.x + d.x), (a.y + b2.y) + (c.y + d.y)}; }
        asm volatile("s_waitcnt lgkmcnt(0)" ::: "memory"); __builtin_amdgcn_s_barrier(); asm volatile("" ::: "memory");
    }
};
struct EpiUp {
    static constexpr bool PERM = true, AFTER_DRAIN = false;
    unsigned char* ws; const PG8_LAS unsigned char* lds0;
    __device__ __forceinline__ void operator()(const f32x4 (&acc)[2][2][4][2], const Unit& u, int wr, int wc, int fr, int fq) const {
        asm volatile("" ::: "memory"); __builtin_amdgcn_sched_barrier(0);
        bf16_t* H = (bf16_t*)(ws + WSO_H);
        const PG8_LAS unsigned char* slot = etab_find(lds0, u);
        const PG8_LAS f32x2e* st = (const PG8_LAS f32x2e*)slot; const PG8_LAS float* tc1 = (const PG8_LAS float*)(slot + 2048); const PG8_LAS float* tc2 = (const PG8_LAS float*)(slot + 3072);
        const int cb = u.pn * BM + wc * 32 + 8 * fq, cl = wc * 32 + 8 * fq;
#pragma unroll
        for (int bj = 0; bj < 2; ++bj) {
            f32x4 c1v[2], c2v[2];
#pragma unroll
            for (int n = 0; n < 2; ++n) { c1v[n] = *(const PG8_LAS f32x4*)(tc1 + cl + bj * HALF + 4 * n); c2v[n] = *(const PG8_LAS f32x4*)(tc2 + cl + bj * HALF + 4 * n); }
#pragma unroll
            for (int ai = 0; ai < 2; ++ai) {
#pragma unroll
                for (int m = 0; m < 4; ++m) {
                    const int rl = ai * HALF + wr * 64 + m * 16 + fr, r = u.pm * BM + rl;
                    const f32x2e ms = st[rl]; const float mu = ms.x, rs = ms.y;
                    f32x4 v0 = (acc[ai][bj][m][0] - mu * c1v[0]) * rs + c2v[0], v1 = (acc[ai][bj][m][1] - mu * c1v[1]) * rs + c2v[1];
#pragma unroll
                    for (int e = 0; e < 4; ++e) { const float a = fmaxf(v0[e], 0.f), b = fmaxf(v1[e], 0.f); v0[e] = a * a; v1[e] = b * b; }
                    u32x4 w; w.x = cvt_pk_bf16(v0[0], v0[1]); w.y = cvt_pk_bf16(v0[2], v0[3]); w.z = cvt_pk_bf16(v1[0], v1[1]); w.w = cvt_pk_bf16(v1[2], v1[3]);
                    *(u32x4*)(H + (size_t)r * 4096 + cb + bj * HALF) = w; }
            }
        }
    }
};
template <class Epi, class Sched, bool ALIGN_EPI = false, bool SP2 = false>
__device__ __forceinline__ void gemm_phase(PG8_LAS unsigned char* lds, const Gemm g, const Sched& S, const Epi& E, const int tid) {
    const int wid = __builtin_amdgcn_readfirstlane(tid >> 6), lane = tid & 63, wr = wid >> 2, wc = wid & 3, fr = lane & 15, fq = lane >> 4;
    const int K = g.K, nt = K / BK;
    unsigned voffA[2], voffB[2];
#pragma unroll
    for (int i = 0; i < 2; ++i) { int R, C; stage_rc(tid * 16 + i * 8192, R, C); const int Rb = Epi::PERM ? ((R & ~31) + perm32(R & 31)) : R;
        voffA[i] = (unsigned)(R * K + C) * 2u; voffB[i] = (unsigned)(Rb * K + C) * 2u; }
    const size_t kstep = (size_t)(BK * 2);
    const size_t hstep = (size_t)HALF * K * 2;
    const size_t tstep = 2 * hstep;
    const unsigned ldsw = (unsigned)wid * 1024u;
    const int aoff = lds_byte(wr * 64 + fr, fq * 8), boff = lds_byte(wc * 32 + fr, fq * 8);
#define PG8_SA(b, h) (((b) * 2 + (h)) * HTB)
#define PG8_SB(b, h) ((4 + (b) * 2 + (h)) * HTB)
#define PG8_STAGE(bufoff, gbase, voff) do { _Pragma("unroll") for (int _i = 0; _i < 2; ++_i) \
        __builtin_amdgcn_global_load_lds((const unsigned*)((const char*)(gbase) + (voff)[_i]), (PG8_LAS unsigned*)(lds + (bufoff) + ldsw + _i * 8192), 16, 0, 0); } while (0)
#define PG8_LDA(dst, b, h) do { _Pragma("unroll") for (int m = 0; m < 4; ++m) _Pragma("unroll") for (int k = 0; k < 2; ++k) dst[m][k] = *(const PG8_LAS bf16x8*)(lds + PG8_SA(b, h) + aoff + m * 2048 + k * 1024); } while (0)
#define PG8_LDB(dst, b, h) do { _Pragma("unroll") for (int n = 0; n < 2; ++n) _Pragma("unroll") for (int k = 0; k < 2; ++k) dst[n][k] = *(const PG8_LAS bf16x8*)(lds + PG8_SB(b, h) + boff + n * 2048 + k * 1024); } while (0)
#define PG8_MMA(ai, bj, At, Bt) do { __builtin_amdgcn_s_setprio(1); _Pragma("unroll") for (int m = 0; m < 4; ++m) _Pragma("unroll") for (int n = 0; n < 2; ++n) _Pragma("unroll") for (int k = 0; k < 2; ++k) \
        acc[ai][bj][m][n] = __builtin_amdgcn_mfma_f32_16x16x32_bf16(Bt[n][k], At[m][k], acc[ai][bj][m][n], 0, 0, 0); __builtin_amdgcn_s_setprio(0); } while (0)
#define PG8_WAIT_V(n) asm volatile("s_waitcnt vmcnt(" #n ")" ::: "memory")
#define PG8_WAIT_L(n) asm volatile("s_waitcnt lgkmcnt(" #n ")" ::: "memory")
#define PG8_BAR __builtin_amdgcn_s_barrier()
#define PG8_SCHED __builtin_amdgcn_sched_barrier(0)
    Unit cur, nxt; int ui = 0;
    if (!S.next(0, cur)) return;
    f32x4 acc[2][2][4][2];
#pragma unroll
    for (int a = 0; a < 2; ++a)
#pragma unroll
        for (int b = 0; b < 2; ++b)
#pragma unroll
            for (int m = 0; m < 4; ++m)
#pragma unroll
                for (int n = 0; n < 2; ++n) acc[a][b][m][n] = (f32x4){0.f, 0.f, 0.f, 0.f};
    bf16x8 At[4][2], B0[2][2], B1[2][2];
    const char* cA = (const char*)g.A + (size_t)cur.pm * tstep; const char* cB = (const char*)g.Bt + (size_t)cur.pn * tstep;
    S.a_ready(cur);
    if constexpr (SP2) {
        PG8_STAGE(PG8_SB(0, 0), cB, voffB); PG8_STAGE(PG8_SB(0, 1), cB + hstep, voffB); PG8_STAGE(PG8_SA(0, 0), cA, voffA); PG8_STAGE(PG8_SA(0, 1), cA + hstep, voffA);
        if (wr == 1) PG8_BAR;
        PG8_WAIT_V(2); PG8_BAR;
        PG8_STAGE(PG8_SB(1, 0), cB + kstep, voffB); PG8_STAGE(PG8_SA(1, 0), cA + kstep, voffA); PG8_STAGE(PG8_SB(1, 1), cB + hstep + kstep, voffB);
        PG8_WAIT_V(6); PG8_BAR;
    } else {
        PG8_STAGE(PG8_SB(0, 0), cB, voffB); PG8_STAGE(PG8_SA(0, 0), cA, voffA); PG8_STAGE(PG8_SB(0, 1), cB + hstep, voffB); PG8_STAGE(PG8_SA(0, 1), cA + hstep, voffA);
        if (wr == 1) PG8_BAR;
        PG8_WAIT_V(4); PG8_BAR;
        PG8_STAGE(PG8_SB(1, 0), cB + kstep, voffB); PG8_STAGE(PG8_SA(1, 0), cA + kstep, voffA); PG8_STAGE(PG8_SB(1, 1), cB + hstep + kstep, voffB);
        PG8_WAIT_V(6); PG8_BAR;
    }
    for (;;) {
        const bool has_next = S.next(ui + 1, nxt);
        const char* nA = has_next ? (const char*)g.A + (size_t)nxt.pm * tstep : cA; const char* nB = has_next ? (const char*)g.Bt + (size_t)nxt.pn * tstep : cB;
        for (int t = 0; t < nt; t += 2) {
            const bool last = (t == nt - 2);
            const char* a1 = cA + (size_t)(t + 1) * kstep;
            const char* a2 = last ? nA : cA + (size_t)(t + 2) * kstep; const char* b2 = last ? nB : cB + (size_t)(t + 2) * kstep;
            const char* a3 = a2 + kstep; const char* b3 = b2 + kstep;
            if (last && has_next) S.a_ready(nxt);
            if constexpr (SP2) {
            PG8_LDB(B0, 0, 0); PG8_LDB(B1, 0, 1); PG8_SCHED; PG8_LDA(At, 0, 0); PG8_STAGE(PG8_SA(1, 1), a1 + hstep, voffA);
            PG8_WAIT_V(8); PG8_WAIT_L(0); PG8_BAR; PG8_MMA(0, 0, At, B0); PG8_MMA(0, 1, At, B1); PG8_BAR; PG8_SCHED;
            PG8_LDA(At, 0, 1); PG8_STAGE(PG8_SB(0, 0), b2, voffB); PG8_STAGE(PG8_SB(0, 1), b2 + hstep, voffB); PG8_STAGE(PG8_SA(0, 0), a2, voffA);
            PG8_WAIT_V(8); PG8_WAIT_L(0); PG8_BAR; PG8_MMA(1, 0, At, B0); PG8_MMA(1, 1, At, B1); PG8_BAR; PG8_SCHED;
            PG8_LDB(B0, 1, 0); PG8_LDB(B1, 1, 1); PG8_SCHED; PG8_LDA(At, 1, 0); PG8_STAGE(PG8_SA(0, 1), a2 + hstep, voffA);
            PG8_WAIT_V(8); PG8_WAIT_L(0); PG8_BAR; PG8_MMA(0, 0, At, B0); PG8_MMA(0, 1, At, B1); PG8_BAR; PG8_SCHED;
            PG8_LDA(At, 1, 1); PG8_STAGE(PG8_SB(1, 0), b3, voffB); PG8_STAGE(PG8_SB(1, 1), b3 + hstep, voffB); PG8_STAGE(PG8_SA(1, 0), a3, voffA);
            PG8_WAIT_V(8); PG8_WAIT_L(0); PG8_BAR; PG8_MMA(1, 0, At, B0); PG8_MMA(1, 1, At, B1); PG8_BAR; PG8_SCHED;
            } else {
            PG8_LDB(B0, 0, 0); PG8_SCHED; PG8_LDA(At, 0, 0); PG8_STAGE(PG8_SA(1, 1), a1 + hstep, voffA);
            PG8_WAIT_L(8); PG8_BAR; PG8_WAIT_L(0); PG8_MMA(0, 0, At, B0); PG8_BAR; PG8_SCHED;
            PG8_LDB(B1, 0, 1); PG8_STAGE(PG8_SB(0, 0), b2, voffB);
            PG8_BAR; PG8_WAIT_L(0); PG8_MMA(0, 1, At, B1); PG8_BAR;
            PG8_LDA(At, 0, 1); PG8_STAGE(PG8_SA(0, 0), a2, voffA);
            PG8_BAR; PG8_WAIT_L(0); PG8_MMA(1, 0, At, B0); PG8_BAR; PG8_SCHED;
            PG8_STAGE(PG8_SB(0, 1), b2 + hstep, voffB);
            PG8_WAIT_V(6); PG8_BAR; PG8_MMA(1, 1, At, B1); PG8_BAR;
            PG8_LDB(B0, 1, 0); PG8_SCHED; PG8_LDA(At, 1, 0); PG8_STAGE(PG8_SA(0, 1), a2 + hstep, voffA);
            PG8_WAIT_L(8); PG8_BAR; PG8_WAIT_L(0); PG8_MMA(0, 0, At, B0); PG8_BAR; PG8_SCHED;
            PG8_LDB(B1, 1, 1); PG8_STAGE(PG8_SB(1, 0), b3, voffB);
            PG8_BAR; PG8_WAIT_L(0); PG8_MMA(0, 1, At, B1); PG8_BAR;
            PG8_LDA(At, 1, 1); PG8_STAGE(PG8_SA(1, 0), a3, voffA);
            PG8_BAR; PG8_WAIT_L(0); PG8_MMA(1, 0, At, B0); PG8_BAR; PG8_SCHED;
            PG8_STAGE(PG8_SB(1, 1), b3 + hstep, voffB);
            PG8_WAIT_V(6); PG8_BAR; PG8_MMA(1, 1, At, B1); PG8_BAR;
            }
        }
        if constexpr (ALIGN_EPI) { if (wr == 0) PG8_BAR; }
        if constexpr (!Epi::AFTER_DRAIN) { E(acc, cur, wr, wc, fr, fq); S.done(cur); }
        if (!has_next) break;
#pragma unroll
        for (int a = 0; a < 2; ++a)
#pragma unroll
            for (int b = 0; b < 2; ++b)
#pragma unroll
                for (int m = 0; m < 4; ++m)
#pragma unroll
                    for (int n = 0; n < 2; ++n) acc[a][b][m][n] = (f32x4){0.f, 0.f, 0.f, 0.f};
        cur = nxt; cA = nA; cB = nB; ++ui;
        if constexpr (ALIGN_EPI) { if (wr == 1) PG8_BAR; }
    }
    PG8_WAIT_V(0);
    if constexpr (!ALIGN_EPI) { if (wr == 0) PG8_BAR; }
    PG8_BAR;
    if constexpr (Epi::AFTER_DRAIN) { E.fused(acc, cur, wr, wc, fr, fq, lds, wid, lane); S.done(cur); }
#undef PG8_SA
#undef PG8_SB
#undef PG8_STAGE
#undef PG8_LDA
#undef PG8_LDB
#undef PG8_MMA
#undef PG8_WAIT_V
#undef PG8_WAIT_L
#undef PG8_BAR
#undef PG8_SCHED
}
}
constexpr int NWAVES = 8;
constexpr int M = 16384, TSEQ = 8192, DM = 1024, FFD = 4096, DEPTH = 4, MD = 32, NH = 8, HD = 64;
constexpr int NIN = 3584;
constexpr int RW0 = 1536;
constexpr int PRP = 2048;
constexpr int NRWU = 1856;
constexpr int CH = 16, NCH = TSEQ / CH;
constexpr int NUNIT = 2 * NH * NCH;
constexpr float LN_EPS = 1e-5f, GN_EPS = 64e-5f, RMS_EPS = 1e-6f;
constexpr float ALPHA = 1.6817928305074290f;
constexpr float QSCALE = 0.125f * 1.4426950408889634f;
constexpr size_t O_Y = 0, O_YS = 16777216, O_SHP = 16809984, O_SHS = 16818176, O_WKP = 16949248, O_WKS = 17211392,
                 O_KP = 21405696, O_VP = 29794304, O_KS = 38182912, O_VS = 38248448, O_END = 38313984;
constexpr size_t MiB = 1u << 20;
constexpr size_t WS_CTL = 0, CTL_ZERO_BYTES = 1 * MiB;
constexpr size_t WS_C1IN = 1 * MiB;
constexpr size_t WS_C2IN = WS_C1IN + 4 * NIN * 4;
constexpr size_t WS_C1UP = WS_C2IN + 4 * NIN * 4;
constexpr size_t WS_C2UP = WS_C1UP + 4 * FFD * 4;
constexpr size_t WS_DUPT = WS_C2UP + 4 * FFD * 4;
constexpr size_t WS_IUPT = WS_DUPT + 4 * 512 * 64 * 2;
constexpr size_t WS_GUPT = WS_IUPT + 4 * 512 * 64 * 2;
constexpr size_t WS_VUPT = WS_GUPT + 4 * 512 * 128 * 2;
constexpr size_t WS_SMALL_END = WS_VUPT + 3 * 512 * 32 * 2;
static_assert(WS_SMALL_END <= 3 * MiB, "small region");
constexpr size_t WS_ROPE = 3 * MiB;
constexpr size_t WS_DEC = 6 * MiB;
constexpr size_t WS_STAT1 = 8 * MiB, WS_STAT2 = 9 * MiB;
constexpr size_t WS_BON = 10 * MiB;
constexpr size_t WS_LSE = 11 * MiB;
constexpr size_t WS_GC = 13 * MiB;
constexpr size_t WS_WIN = 16 * MiB;
constexpr size_t WS_WINU = 44 * MiB;
constexpr size_t WS_WOUT = 60 * MiB;
constexpr size_t WS_WUP = 68 * MiB;
constexpr size_t WS_WDN = 100 * MiB;
constexpr size_t WS_XB2 = 132 * MiB;
constexpr size_t WS_XB1 = 164 * MiB;
constexpr size_t WS_T1 = 196 * MiB;
constexpr size_t WS_T2 = 260 * MiB;
constexpr size_t WS_QB = 324 * MiB, WS_KB = 340 * MiB, WS_VB = 356 * MiB;
constexpr size_t WS_PR = 372 * MiB;
constexpr size_t WS_OP = 436 * MiB;
constexpr size_t WS_MIX = 484 * MiB;
constexpr size_t WS_VF = 516 * MiB, WS_VV = 532 * MiB;
constexpr size_t WS_YPRE = 548 * MiB;
constexpr size_t WS_H = 580 * MiB;
constexpr size_t WS_PT = 580 * MiB;
constexpr size_t WS_QT = 644 * MiB;
constexpr size_t WS_REFF = 708 * MiB;
constexpr size_t WS_YLOC = 724 * MiB;
constexpr size_t WS_SEGQ = 756 * MiB, WS_SEGP = 760 * MiB;
constexpr size_t WS_CSUM = 764 * MiB;
constexpr size_t WS_CSUP = 766 * MiB;
constexpr size_t WS_END = 768 * MiB;
static_assert(WS_H + (size_t)M * FFD * 2 <= WS_END + 0 * MiB || true, "");
constexpr size_t DEC_XB2 = 0;
constexpr size_t DEC_XB1 = 64 * 1024;
constexpr size_t DEC_SHB = 128 * 1024;
constexpr size_t DEC_MIXB = 384 * 1024;
constexpr size_t DEC_HB = 448 * 1024;
constexpr size_t DEC_T1 = 704 * 1024;
constexpr size_t DEC_T2 = 832 * 1024;
constexpr size_t DEC_PD = 960 * 1024;
constexpr size_t DEC_PS = 1408 * 1024;
constexpr size_t DEC_OP = 1640 * 1024;
constexpr size_t DEC_LSE = 1832 * 1024;
constexpr size_t DEC_MIX = 1836 * 1024;
constexpr size_t DEC_ST1 = 1964 * 1024;
constexpr size_t DEC_ST2 = 1972 * 1024;
constexpr size_t DEC_VF = 1980 * 1024;
static_assert(DEC_VF + 32 * 512 * 4 <= 2 * MiB, "decode scratch");
constexpr int CW_BAR = 4096;
constexpr int RING_BYTES = 131072;
constexpr int MISC_OFF = RING_BYTES + 320;
constexpr int LDS_BYTES = 163840;
static_assert(pg8::WSO_C1IN == WS_C1IN && pg8::WSO_C2IN == WS_C2IN && pg8::WSO_C1UP == WS_C1UP && pg8::WSO_C2UP == WS_C2UP && pg8::WSO_ROPE == WS_ROPE && pg8::WSO_STAT1 == WS_STAT1 && pg8::WSO_STAT2 == WS_STAT2 &&
              pg8::WSO_XB2 == WS_XB2 && pg8::WSO_XB1 == WS_XB1 && pg8::WSO_T1 == WS_T1 && pg8::WSO_T2 == WS_T2 && pg8::WSO_QB == WS_QB && pg8::WSO_KB == WS_KB && pg8::WSO_VB == WS_VB && pg8::WSO_PR == WS_PR && pg8::WSO_H == WS_H &&
              pg8::OO_SHP == O_SHP && pg8::OO_KP == O_KP && pg8::OO_VP == O_VP, "epilogue offset mirrors");
#define GAS __attribute__((address_space(1)))
#define LAS __attribute__((address_space(3)))
typedef unsigned short bf16;
typedef unsigned v4u __attribute__((ext_vector_type(4)));
typedef unsigned v2u __attribute__((ext_vector_type(2)));
typedef float f32x4 __attribute__((ext_vector_type(4)));
typedef float f32x2 __attribute__((ext_vector_type(2)));
typedef float f32x16 __attribute__((ext_vector_type(16)));
typedef short bf16x8 __attribute__((ext_vector_type(8)));
typedef short s16x4 __attribute__((ext_vector_type(4)));
typedef GAS unsigned gu32;
#define RLX_AGENT __ATOMIC_RELAXED, __HIP_MEMORY_SCOPE_AGENT
#define LDS_WAIT() asm volatile("s_waitcnt lgkmcnt(0)" ::: "memory")
#define VM_WAIT() asm volatile("s_waitcnt vmcnt(0)" ::: "memory")
#define DI __device__ __forceinline__
DI unsigned f2bf(float f) { unsigned u = __builtin_bit_cast(unsigned, f); return (u + 0x7fffu + ((u >> 16) & 1u)) >> 16; }
DI float bf2f(unsigned b) { return __builtin_bit_cast(float, b << 16); }
DI float bflo(unsigned w) { return __builtin_bit_cast(float, w << 16); }
DI float bfhi(unsigned w) { return __builtin_bit_cast(float, w & 0xffff0000u); }
typedef __bf16 bf16x2_t __attribute__((ext_vector_type(2)));
DI unsigned pk2(float lo, float hi) { const f32x2 v = {lo, hi}; const bf16x2_t b = __builtin_convertvector(v, bf16x2_t); return __builtin_bit_cast(unsigned, b); }
DI unsigned pk2z(float x) { return pk2(x, 0.f) & 0xffffu; }
DI float rbf(float x) { return bf2f(f2bf(x)); }
DI bf16x8 pk8(float a0, float a1, float a2, float a3, float a4, float a5, float a6, float a7) {
    v4u w; w.x = pk2(a0, a1); w.y = pk2(a2, a3); w.z = pk2(a4, a5); w.w = pk2(a6, a7); return __builtin_bit_cast(bf16x8, w); }
DI bf16x8 pk8v(f32x4 a, f32x4 b) { return pk8(a[0], a[1], a[2], a[3], b[0], b[1], b[2], b[3]); }
DI bf16x8 pk4z(f32x4 a) { v4u w; w.x = pk2(a[0], a[1]); w.y = pk2(a[2], a[3]); w.z = 0u; w.w = 0u; return __builtin_bit_cast(bf16x8, w); }
DI bf16x8 ld8(const void* p) { return *(const bf16x8*)p; }
DI bf16x8 ld4z(const void* p) { v2u t = *(const v2u*)p; v4u w; w.x = t.x; w.y = t.y; w.z = 0u; w.w = 0u; return __builtin_bit_cast(bf16x8, w); }
DI f32x4 mfma16(bf16x8 a, bf16x8 b, f32x4 c) { return __builtin_amdgcn_mfma_f32_16x16x32_bf16(a, b, c, 0, 0, 0); }
DI f32x16 mfma32(bf16x8 a, bf16x8 b, f32x16 c) { return __builtin_amdgcn_mfma_f32_32x32x16_bf16(a, b, c, 0, 0, 0); }
DI int crow(int r, int hi) { return (r & 3) + 8 * (r >> 2) + 4 * hi; }
DI float wave_sum(float v) {
#pragma unroll
    for (int o = 1; o < 64; o <<= 1) v += __shfl_xor(v, o);
    return v; }
DI float fexp(float x) { return __expf(x); }
DI float fsigmoid(float x) { return __builtin_amdgcn_rcpf(1.f + __expf(-x)); }
DI float ftanh(float x) { return 1.f - 2.f * __builtin_amdgcn_rcpf(__expf(2.f * x) + 1.f); }
DI float fsoftplus(float x) { return fmaxf(x, 0.f) + __logf(1.f + __expf(-fabsf(x))); }
DI int orig2lgcl(int o) { return (o & ~63) | (((o >> 4) & 1) << 5) | (((o >> 2) & 3) << 3) | (((o >> 5) & 1) << 2) | (o & 3); }
DI int lgcl2orig(int c) { return (c & ~63) | (((c >> 2) & 1) << 5) | (((c >> 5) & 1) << 4) | (((c >> 3) & 3) << 2) | (c & 3); }
#define XB_TMO      128
#define XB_XCNT(j)  (256  + 64 * (j))
#define XB_XSUB(j)  (1280 + 64 * (j))
#define XB_XGEN(j)  (2304 + 64 * (j))
#define XB_TOP      3328
#define XB_TOPGEN   3392
#define XCD_BAR_WORDS 3456
#define XB_SPIN_CAP (1u << 18)

__device__ __forceinline__ unsigned xb_ld(unsigned* p)              { return __hip_atomic_load(p, __ATOMIC_RELAXED, __HIP_MEMORY_SCOPE_AGENT); }
__device__ __forceinline__ unsigned xb_add(unsigned* p, unsigned v) { return __hip_atomic_fetch_add(p, v, __ATOMIC_RELAXED, __HIP_MEMORY_SCOPE_AGENT); }
__device__ __forceinline__ unsigned xb_xcc_id() { return (unsigned)__builtin_amdgcn_s_getreg((3 << 11) | 20) & 0xFu; }
#define XB_SPIN(cond, bar) do { unsigned _sp = 0; while (cond) { __builtin_amdgcn_s_sleep(1); \
    if ((++_sp & 255u) == 0u) { if (xb_ld(&(bar)[XB_TMO])) break; if (_sp > XB_SPIN_CAP) { atomicAdd(&(bar)[XB_TMO], 1u); break; } } } } while (0)

struct XcdBarrier {
    unsigned* bar; unsigned x;
    volatile LAS unsigned* st;
};

__device__ __forceinline__ XcdBarrier xcd_barrier_post(unsigned* bar, volatile LAS unsigned* st) {
    XcdBarrier b; b.bar = bar; b.x = xb_xcc_id(); b.st = st;
    if (threadIdx.x == 0) (void)xb_add(&bar[XB_XCNT(b.x)], 1u);
    return b;
}
__device__ __forceinline__ void xcd_barrier_complete(unsigned* bar, unsigned x, unsigned& nloc, unsigned& nx) {
    const unsigned G = gridDim.x * gridDim.y * gridDim.z;
    unsigned sum, cnt, mine, sp = 0u;
    for (;;) {
        sum = 0u; cnt = 0u; mine = 0u;
#pragma unroll
        for (unsigned j = 0; j < 16; ++j) { const unsigned c = xb_ld(&bar[XB_XCNT(j)]); sum += c; cnt += (c > 0u) ? 1u : 0u; mine = (j == x) ? c : mine; }
        if (sum == G) break;
        __builtin_amdgcn_s_sleep(1);
        if ((++sp & 255u) == 0u) { if (xb_ld(&bar[XB_TMO])) break; if (sp > XB_SPIN_CAP) { atomicAdd(&bar[XB_TMO], 1u); break; } }
    }
    nloc = mine > 0u ? mine : 1u; nx = cnt > 0u ? cnt : 1u;
}

__device__ __forceinline__ void xcd_barrier(const XcdBarrier& b) {
    asm volatile("s_waitcnt vmcnt(0)" ::: "memory");
    __syncthreads();
    if (threadIdx.x == 0) {
        unsigned* bar = b.bar;
        __builtin_amdgcn_s_waitcnt(0);
        unsigned nloc = b.st[0], nx = b.st[1];
        if (nloc == 0u) { xcd_barrier_complete(bar, b.x, nloc, nx); b.st[0] = nloc; b.st[1] = nx; }
        const unsigned old = xb_add(&bar[XB_XSUB(b.x)], 1u);
        const unsigned gen = old / nloc;
        if (old + 1u == (gen + 1u) * nloc) {
            __builtin_amdgcn_fence(__ATOMIC_RELEASE, "agent");
            asm volatile("s_waitcnt vmcnt(0)" ::: "memory");
            const unsigned og = xb_add(&bar[XB_TOP], 1u);
            const unsigned tg = og / nx;
            if (og + 1u == (tg + 1u) * nx) xb_add(&bar[XB_TOPGEN], 1u);
            else XB_SPIN(xb_ld(&bar[XB_TOPGEN]) == tg, bar);
            __builtin_amdgcn_fence(__ATOMIC_ACQUIRE, "agent");
            xb_add(&bar[XB_XGEN(b.x)], 1u);
            asm volatile("s_waitcnt vmcnt(0)" ::: "memory");
        } else {
            XB_SPIN(xb_ld(&bar[XB_XGEN(b.x)]) == gen, bar);
            __builtin_amdgcn_fence(__ATOMIC_ACQUIRE, "agent");
            asm volatile("s_waitcnt vmcnt(0)" ::: "memory");
        }
    }
    __syncthreads();
}
struct Args { const float* in[30]; float* out; unsigned char* ws; };
struct Frame {
    unsigned char* lds;
    volatile LAS unsigned* MISC;
    gu32* ctl;
    int tid, lane, wave, vcu, G, gw, NGW;
    const float* const* in; float* out; unsigned char* ws;
};
template <bool SWAP>
DI void p0_transpose_item(const float* W, int ldw, int K, int csrc0, bf16* WT, int row_off, const float* gsc, LAS float* scr, int kb, int nb, int lane, float* csum = nullptr, int ncs = 0, const float* bsh = nullptr) {
    const int k0 = 64 * kb, n0 = 32 * nb;
    f32x4 wv[8]; float gk = 1.f, bk = 0.f;
    const int lr = lane >> 3, lc = (lane & 7) * 4;
#pragma unroll
    for (int i = 0; i < 8; ++i) wv[i] = *(const f32x4*)(W + (size_t)(k0 + 8 * i + lr) * ldw + csrc0 + n0 + lc);
    if (gsc) gk = gsc[k0 + lane]; if (bsh) bk = bsh[k0 + lane];
    f32x4 s1v = {0.f, 0.f, 0.f, 0.f}, s2v = s1v;
#pragma unroll
    for (int i = 0; i < 8; ++i) { const int kk = 8 * i + lr; f32x4 v = wv[i]; s2v = s2v + v * __shfl(bk, kk); v = v * __shfl(gk, kk);
#pragma unroll
        for (int e = 0; e < 4; ++e) { s1v[e] += rbf(v[e]); scr[kk * 33 + lc + e] = v[e]; } }
#pragma unroll
    for (int o = 8; o < 64; o <<= 1) {
#pragma unroll
        for (int e = 0; e < 4; ++e) { s1v[e] += __shfl_xor(s1v[e], o); s2v[e] += __shfl_xor(s2v[e], o); } }
    if (csum && lane < 8) {
#pragma unroll
        for (int e = 0; e < 4; ++e) { int dr = n0 + 4 * lane + e; if (SWAP) dr = orig2lgcl(dr); csum[(size_t)(kb * 2 + 0) * ncs + row_off + dr] = s1v[e]; csum[(size_t)(kb * 2 + 1) * ncs + row_off + dr] = s2v[e]; } }
    LDS_WAIT(); asm volatile("" ::: "memory");
    const int c = lane & 7;
#pragma unroll
    for (int j = 0; j < 4; ++j) { const int n = (lane >> 3) + 8 * j; const LAS float* s = scr + (8 * c) * 33 + n;
        v4u o; o.x = pk2(s[0 * 33], s[1 * 33]); o.y = pk2(s[2 * 33], s[3 * 33]); o.z = pk2(s[4 * 33], s[5 * 33]); o.w = pk2(s[6 * 33], s[7 * 33]);
        int dr = n0 + n; if (SWAP) dr = orig2lgcl(dr);
        *(v4u*)(WT + (size_t)(row_off + dr) * K + k0 + 8 * c) = o; }
    LDS_WAIT(); asm volatile("" ::: "memory");
}
DI void p0_prologue(Frame& F) {
    LAS float* scr = (LAS float*)((LAS unsigned char*)F.lds + F.wave * 16384);
    const float* const* in = F.in; unsigned char* ws = F.ws;
    constexpr int I_IN = 16 * 104, I_VR = 16, I_INU = 16 * 56, I_OUT = 16 * 32, I_UP = 16 * 128, I_DN = 64 * 32;
    constexpr int I_L = I_IN + I_VR + I_INU + I_VR + I_OUT + I_UP + I_DN;
    for (int it = F.gw; it < DEPTH * I_L; it += F.NGW) {
        const int l = it / I_L; int r = it % I_L;
        const float* g2p = l > 0 ? in[28] + (size_t)(l - 1) * DM : nullptr;
        bf16* win = (bf16*)(ws + WS_WIN) + (size_t)l * NIN * DM; bf16* winu = (bf16*)(ws + WS_WINU) + (size_t)l * NRWU * DM;
        if (r < I_IN) { const int kb = r / 104, nb = r % 104; const float* W = in[6] + (size_t)l * DM * 3328;
            float* cs = l > 0 ? (float*)(ws + WS_CSUM) + (size_t)l * 32 * NIN : nullptr; const float* b2p = l > 0 ? in[29] + (size_t)(l - 1) * DM : nullptr;
            if (nb < 32) p0_transpose_item<true>(W, 3328, DM, 0, win, 0, g2p, scr, kb, nb, F.lane, cs, NIN, b2p); else p0_transpose_item<false>(W, 3328, DM, 0, win, 0, g2p, scr, kb, nb, F.lane, cs, NIN, b2p); continue; } r -= I_IN;
        if (r < I_VR) { if (l > 0) p0_transpose_item<false>(in[7] + (size_t)(l - 1) * DM * 32, 32, DM, 0, win, 3328, g2p, scr, r, 0, F.lane, (float*)(ws + WS_CSUM) + (size_t)l * 32 * NIN, NIN, in[29] + (size_t)(l - 1) * DM); continue; } r -= I_VR;
        if (r < I_INU) { const int kb = r / 56, nb = r % 56; p0_transpose_item<false>(in[6] + (size_t)l * DM * 3328, 3328, DM, RW0, winu, 0, nullptr, scr, kb, nb, F.lane); continue; } r -= I_INU;
        if (r < I_VR) { if (l > 0) p0_transpose_item<false>(in[7] + (size_t)(l - 1) * DM * 32, 32, DM, 0, winu, 1792, nullptr, scr, r, 0, F.lane); continue; } r -= I_VR;
        if (r < I_OUT) { p0_transpose_item<false>(in[23] + (size_t)l * DM * DM, DM, DM, 0, (bf16*)(ws + WS_WOUT) + (size_t)l * DM * DM, 0, nullptr, scr, r / 32, r % 32, F.lane); continue; } r -= I_OUT;
        if (r < I_UP) { p0_transpose_item<false>(in[26] + (size_t)l * DM * FFD, FFD, DM, 0, (bf16*)(ws + WS_WUP) + (size_t)l * FFD * DM, 0, in[24] + (size_t)l * DM, scr, r / 128, r % 128, F.lane, (float*)(ws + WS_CSUP) + (size_t)l * 32 * FFD, FFD, in[25] + (size_t)l * DM); continue; } r -= I_UP;
        p0_transpose_item<false>(in[27] + (size_t)l * FFD * DM, DM, FFD, 0, (bf16*)(ws + WS_WDN) + (size_t)l * DM * FFD, 0, nullptr, scr, r / 32, r % 32, F.lane);
    }
    for (int m0 = F.gw; m0 < M; m0 += 4 * F.NGW) { f32x4 v[4][4];
#pragma unroll
        for (int q = 0; q < 4; ++q) { const f32x4* xr = (const f32x4*)(in[0] + (size_t)(m0 + q * F.NGW) * DM) + F.lane;
#pragma unroll
            for (int j = 0; j < 4; ++j) v[q][j] = xr[64 * j]; }
#pragma unroll
        for (int q = 0; q < 4; ++q) { unsigned long long* o8 = (unsigned long long*)((bf16*)(ws + WS_XB2) + (size_t)(m0 + q * F.NGW) * DM) + F.lane;
#pragma unroll
            for (int j = 0; j < 4; ++j) o8[64 * j] = (unsigned long long)pk2(v[q][j].x, v[q][j].y) | ((unsigned long long)pk2(v[q][j].z, v[q][j].w) << 32); } }
    const int gt = F.gw * 64 + F.lane, NGT = F.NGW * 64;
    for (int e = gt; e < 8193 * 32; e += NGT) { const int pos = e >> 5, i = e & 31; const double ang = (double)pos * pow(10000.0, -(double)i / 32.0); ((f32x2*)(ws + WS_ROPE))[e] = (f32x2){(float)cos(ang), (float)sin(ang)}; }
    for (int e = gt; e < 4 * 512 * 64; e += NGT) { const int l = e / (512 * 64), n = (e / 64) % 512, m = e % 64; ((bf16*)(ws + WS_DUPT))[e] = (bf16)f2bf(in[11][((size_t)l * 64 + m) * 512 + n]); ((bf16*)(ws + WS_IUPT))[e] = (bf16)f2bf(in[13][((size_t)l * 64 + m) * 512 + n]); }
    for (int e = gt; e < 4 * 512 * 128; e += NGT) { const int l = e / (512 * 128), n = (e / 128) % 512, m = e % 128; ((bf16*)(ws + WS_GUPT))[e] = (bf16)f2bf(in[14][((size_t)l * 128 + m) * 512 + n]); }
    for (int e = gt; e < 3 * 512 * 32; e += NGT) { const int l = e / (512 * 32), n = (e / 32) % 512, m = e % 32; ((bf16*)(ws + WS_VUPT))[e] = (bf16)f2bf(in[16][((size_t)l * 32 + m) * 512 + n]); }
    for (int e = gt; e < 2 * DM; e += NGT) F.out[O_SHP + e] = in[0][((size_t)(e / DM) * TSEQ + TSEQ - 1) * DM + (e % DM)];
    for (int e = gt; e < MD * DM; e += NGT) { ((bf16*)(ws + WS_DEC + DEC_XB2))[e] = (bf16)f2bf(in[1][e]); }
    for (int e = gt; e < DEPTH * MD * DM; e += NGT) { ((bf16*)(ws + WS_DEC + DEC_SHB))[e] = (bf16)f2bf(in[2][e]); }
}
DI void colsum_finish(unsigned char* ws, int gt, int NGT) {
    for (int e = gt; e < 3 * NIN; e += NGT) { const int l = 1 + e / NIN, p = e % NIN; if (p >= 3360) continue; const float* cs = (const float*)(ws + WS_CSUM) + (size_t)l * 32 * NIN + p; float s1 = 0.f, s2 = 0.f;
#pragma unroll
        for (int kb = 0; kb < 16; ++kb) { s1 += cs[(size_t)(2 * kb) * NIN]; s2 += cs[(size_t)(2 * kb + 1) * NIN]; }
        ((float*)(ws + WS_C1IN))[l * NIN + p] = s1; ((float*)(ws + WS_C2IN))[l * NIN + p] = s2; }
    for (int e = gt; e < 4 * FFD; e += NGT) { const int l = e / FFD, p = e % FFD; const float* cs = (const float*)(ws + WS_CSUP) + (size_t)l * 32 * FFD + p; float s1 = 0.f, s2 = 0.f;
#pragma unroll
        for (int kb = 0; kb < 16; ++kb) { s1 += cs[(size_t)(2 * kb) * FFD]; s2 += cs[(size_t)(2 * kb + 1) * FFD]; }
        ((float*)(ws + WS_C1UP))[l * FFD + p] = s1; ((float*)(ws + WS_C2UP))[l * FFD + p] = s2; }
}
constexpr int VPITCH = 144;
constexpr int ATT_WLDS = 2 * 32 * VPITCH + 256;
DI void tr_read8(unsigned base, s16x4 (&t)[8]) {
    asm volatile("ds_read_b64_tr_b16 %0, %8\n\tds_read_b64_tr_b16 %1, %8 offset:%c9\n\tds_read_b64_tr_b16 %2, %8 offset:%c10\n\tds_read_b64_tr_b16 %3, %8 offset:%c11\n\t"
                 "ds_read_b64_tr_b16 %4, %8 offset:%c12\n\tds_read_b64_tr_b16 %5, %8 offset:%c13\n\tds_read_b64_tr_b16 %6, %8 offset:%c14\n\tds_read_b64_tr_b16 %7, %8 offset:%c15\n\ts_waitcnt lgkmcnt(0)"
                 : "=&v"(t[0]), "=&v"(t[1]), "=&v"(t[2]), "=&v"(t[3]), "=&v"(t[4]), "=&v"(t[5]), "=&v"(t[6]), "=&v"(t[7])
                 : "v"(base), "i"(8 * VPITCH), "i"(64), "i"(8 * VPITCH + 64), "i"(16 * VPITCH), "i"(24 * VPITCH), "i"(16 * VPITCH + 64), "i"(24 * VPITCH + 64) : "memory");
}
DI void attn_task(const bf16* QB, const bf16* KB, const bf16* VB, bf16* OP, float* LSE, int b, int h, int p, int cls, int qblk, LAS unsigned char* wl, int lane) {
    asm volatile("" : "+v"(lane));
    const int dd = 1 << (2 * p), r32 = lane & 31, hi = lane >> 5;
    const int m0 = 32 * qblk;
    const size_t rowb = (size_t)b * TSEQ;
    const size_t qrow = rowb + (size_t)(m0 + r32) * dd + cls;
    bf16x8 qf[4];
#pragma unroll
    for (int d0 = 0; d0 < 4; ++d0) qf[d0] = ld8(QB + qrow * 512 + h * 64 + d0 * 16 + hi * 8);
    f32x16 s[5];
    const int kt0 = (m0 >= 128) ? 0 : (128 - m0) / 32;
    const int krow8 = lane >> 3, kch = lane & 7;
    v4u kr[5][4];
#pragma unroll
    for (int kt = 0; kt < 5; ++kt)
#pragma unroll
        for (int i_ = 0; i_ < 4; ++i_) { const int mk = m0 - 128 + 32 * kt + 8 * i_ + krow8; const size_t krow = rowb + (size_t)(mk < 0 ? 0 : mk) * dd + cls;
            kr[kt][i_] = *(const v4u*)(KB + krow * 512 + h * 64 + kch * 8); }
#pragma unroll
    for (int kt = 0; kt < 5; ++kt) {
        LAS unsigned char* kb = wl + (kt & 1) * 32 * VPITCH;
#pragma unroll
        for (int i_ = 0; i_ < 4; ++i_) *(LAS v4u*)(kb + (8 * i_ + krow8) * VPITCH + kch * 16) = kr[kt][i_];
        LDS_WAIT();
        bf16x8 kf[4];
#pragma unroll
        for (int d0 = 0; d0 < 4; ++d0) kf[d0] = *(const LAS bf16x8*)(kb + r32 * VPITCH + d0 * 32 + hi * 16);
        f32x16 a; for (int i = 0; i < 16; ++i) a[i] = 0.f;
#pragma unroll
        for (int d0 = 0; d0 < 4; ++d0) a = mfma32(kf[d0], qf[d0], a);
        s[kt] = a;
    }
    LDS_WAIT();
#pragma unroll
    for (int kt = 0; kt < 5; ++kt) {
        if (kt < kt0) {
#pragma unroll
            for (int i = 0; i < 16; ++i) s[kt][i] = -INFINITY;
        } else if (kt == 0) {
#pragma unroll
            for (int i = 0; i < 16; ++i) s[kt][i] = (crow(i, hi) >= r32) ? s[kt][i] : -INFINITY;
        } else if (kt == 4) {
#pragma unroll
            for (int i = 0; i < 16; ++i) s[kt][i] = (crow(i, hi) <= r32) ? s[kt][i] : -INFINITY;
        }
    }
    float mx = -INFINITY;
#pragma unroll
    for (int kt = 0; kt < 5; ++kt)
#pragma unroll
        for (int i = 0; i < 16; ++i) mx = fmaxf(mx, s[kt][i]);
    mx = fmaxf(mx, __shfl_xor(mx, 32));
    float lsum = 0.f;
#pragma unroll
    for (int kt = 0; kt < 5; ++kt)
#pragma unroll
        for (int i = 0; i < 16; ++i) { const float e = __builtin_amdgcn_exp2f(s[kt][i] - mx); s[kt][i] = e; lsum += e; }
    lsum += __shfl_xor(lsum, 32);
    f32x16 o[2]; for (int i = 0; i < 16; ++i) { o[0][i] = 0.f; o[1][i] = 0.f; }
    LAS float* wsf = (LAS float*)(wl + 2 * 32 * VPITCH);
    const unsigned vb0 = (unsigned)(uintptr_t)wl;
    const int g = lane >> 4, i16 = lane & 15, qq = i16 >> 2, pp = i16 & 3;
    const unsigned traddr = (unsigned)((4 * (g >> 1) + qq) * VPITCH + (16 * (g & 1) + 4 * pp) * 2);
    const int vrow8 = lane >> 3, vch = lane & 7;
    v4u vr[4];
#define ATT_LOADV(KT) do { _Pragma("unroll") for (int i_ = 0; i_ < 4; ++i_) { const int mk_ = m0 - 128 + 32 * (KT) + 8 * i_ + vrow8; const size_t vrow_ = rowb + (size_t)mk_ * dd + cls; \
        vr[i_] = *(const v4u*)(VB + vrow_ * 512 + h * 64 + vch * 8); } } while (0)
    ATT_LOADV(kt0);
#pragma unroll
    for (int kt = 0; kt < 5; ++kt) {
        if (kt >= kt0) {
            LAS unsigned char* vb = wl + (kt & 1) * 32 * VPITCH;
#pragma unroll
            for (int i_ = 0; i_ < 4; ++i_) *(LAS v4u*)(vb + (8 * i_ + vrow8) * VPITCH + vch * 16) = vr[i_];
            if (kt + 1 < 5) ATT_LOADV(kt + 1);
            LDS_WAIT();
            const unsigned base = vb0 + (unsigned)((kt & 1) * 32 * VPITCH) + traddr;
            s16x4 t[8];
            tr_read8(base, t);
#pragma unroll
            for (int ss = 0; ss < 2; ++ss) {
                const bf16x8 pa = pk8(s[kt][8 * ss], s[kt][8 * ss + 1], s[kt][8 * ss + 2], s[kt][8 * ss + 3], s[kt][8 * ss + 4], s[kt][8 * ss + 5], s[kt][8 * ss + 6], s[kt][8 * ss + 7]);
#pragma unroll
                for (int db = 0; db < 2; ++db) { const bf16x8 vf = __builtin_shufflevector(t[4 * ss + 2 * db], t[4 * ss + 2 * db + 1], 0, 1, 2, 3, 4, 5, 6, 7); o[db] = mfma32(pa, vf, o[db]); }
            }
        }
    }
#undef ATT_LOADV
    if (hi == 0) { wsf[r32] = __builtin_amdgcn_rcpf(lsum); LSE[((size_t)p * M + qrow) * 8 + h] = mx + __builtin_amdgcn_logf(lsum); }
    LDS_WAIT();
#pragma unroll
    for (int i = 0; i < 16; ++i) { const int q = crow(i, hi); const float li = wsf[q];
        *(LAS bf16*)(wl + q * VPITCH + r32 * 2) = (bf16)pk2z(o[0][i] * li); *(LAS bf16*)(wl + q * VPITCH + 64 + r32 * 2) = (bf16)pk2z(o[1][i] * li); }
    LDS_WAIT();
    { const int orow8 = lane >> 3, och = lane & 7;
#pragma unroll
      for (int i_ = 0; i_ < 4; ++i_) { const v4u w = *(const LAS v4u*)(wl + (8 * i_ + orow8) * VPITCH + och * 16); const size_t orow = rowb + (size_t)(m0 + 8 * i_ + orow8) * dd + cls;
          *(v4u*)(OP + ((size_t)p * M + orow) * 512 + h * 64 + och * 8) = w; } }
    LDS_WAIT();
}
DI void attn_finalize_row(const bf16* OP, const float* LSE, const float* gain, bf16* MIX, int row, int lane) {
    asm volatile("" : "+v"(lane));
    const int h = lane >> 3;
    float l0 = LSE[((size_t)0 * M + row) * 8 + h], l1 = LSE[((size_t)1 * M + row) * 8 + h], l2 = LSE[((size_t)2 * M + row) * 8 + h];
    const float mx = fmaxf(l0, fmaxf(l1, l2));
    float w0 = __builtin_amdgcn_exp2f(l0 - mx), w1 = __builtin_amdgcn_exp2f(l1 - mx), w2 = __builtin_amdgcn_exp2f(l2 - mx);
    const float inv = __builtin_amdgcn_rcpf(w0 + w1 + w2); w0 *= inv; w1 *= inv; w2 *= inv;
    const v4u a = *(const v4u*)(OP + ((size_t)0 * M + row) * 512 + lane * 8), b = *(const v4u*)(OP + ((size_t)1 * M + row) * 512 + lane * 8), c = *(const v4u*)(OP + ((size_t)2 * M + row) * 512 + lane * 8);
    float v[8]; float ss = 0.f;
#pragma unroll
    for (int j = 0; j < 4; ++j) { v[2 * j] = w0 * bflo(a[j]) + w1 * bflo(b[j]) + w2 * bflo(c[j]); v[2 * j + 1] = w0 * bfhi(a[j]) + w1 * bfhi(b[j]) + w2 * bfhi(c[j]); ss += v[2 * j] * v[2 * j] + v[2 * j + 1] * v[2 * j + 1]; }
    ss = wave_sum(ss);
    const float rinv = 1.0f / sqrtf(ss * (1.f / 512.f) + RMS_EPS);
    const f32x4 g0 = *(const f32x4*)(gain + lane * 8), g1 = *(const f32x4*)(gain + lane * 8 + 4);
    v4u w; w.x = pk2(v[0] * rinv * g0[0], v[1] * rinv * g0[1]); w.y = pk2(v[2] * rinv * g0[2], v[3] * rinv * g0[3]); w.z = pk2(v[4] * rinv * g1[0], v[5] * rinv * g1[1]); w.w = pk2(v[6] * rinv * g1[2], v[7] * rinv * g1[3]);
    *(v4u*)(MIX + (size_t)row * 1024 + lane * 8) = w;
}
constexpr int B1_IMG = 2048, B1_WLDS = 5 * B1_IMG + 1024;
constexpr int IMG_V = 0, IMG_A = 1 * B1_IMG, IMG_B = 2 * B1_IMG, IMG_W = 3 * B1_IMG, IMG_M = 4 * B1_IMG;
constexpr int TIL = 1 * B1_IMG, TIL_LP = 336, TIL_RP = 144, TIL_RSZ = 17 * TIL_RP;
static_assert(17 * TIL_LP <= 4 * B1_IMG && 3 * TIL_RSZ <= 4 * B1_IMG, "input tiles fit the image area");
DI float dpp_shr(float x, int n) { int v;
    switch (n) { case 1: v = __builtin_amdgcn_update_dpp(0, __builtin_bit_cast(int, x), 0x111, 0xf, 0xf, true); break; case 2: v = __builtin_amdgcn_update_dpp(0, __builtin_bit_cast(int, x), 0x112, 0xf, 0xf, true); break;
                 case 4: v = __builtin_amdgcn_update_dpp(0, __builtin_bit_cast(int, x), 0x114, 0xf, 0xf, true); break; default: v = __builtin_amdgcn_update_dpp(0, __builtin_bit_cast(int, x), 0x118, 0xf, 0xf, true); break; }
    return __builtin_bit_cast(float, v); }
DI float dpp_shr1(float x, int n) { int v; const int one = 0x3f800000;
    switch (n) { case 1: v = __builtin_amdgcn_update_dpp(one, __builtin_bit_cast(int, x), 0x111, 0xf, 0xf, false); break; case 2: v = __builtin_amdgcn_update_dpp(one, __builtin_bit_cast(int, x), 0x112, 0xf, 0xf, false); break;
                 case 4: v = __builtin_amdgcn_update_dpp(one, __builtin_bit_cast(int, x), 0x114, 0xf, 0xf, false); break; default: v = __builtin_amdgcn_update_dpp(one, __builtin_bit_cast(int, x), 0x118, 0xf, 0xf, false); break; }
    return __builtin_bit_cast(float, v); }
struct RwkvP {
    const bf16* PR; const float* mu; const float* muv;
    const float *dbase, *ibase, *vbase, *ksk, *ksa, *brk, *gng, *gnb;
    const bf16 *dupT, *iupT, *vupT, *gupT;
    const bf16* ZROW; bf16 *VF, *VV; float* BON; float* GC; bf16 *W1S, *REFF, *BM; v4u* REC; float* YPRE; bf16* MIX; int layer0;
};
DI const f32x4* vec4p(const float*) { return nullptr; }
DI const LAS f32x4* vec4p(const LAS float*) { return nullptr; }
template <class MP> DI void lerp8(const bf16* crow_, const bf16* prow_, int col, MP mu, float (&z)[8]) {
    const v4u cur = *(const v4u*)(crow_ + col); const v4u prv = *(const v4u*)(prow_ + col);
    const f32x4 m0 = *(decltype(vec4p(mu)))(mu), m1 = *(decltype(vec4p(mu)))(mu + 4);
#pragma unroll
    for (int j = 0; j < 4; ++j) { const float a = bflo(cur[j]), b = bfhi(cur[j]), pa = bflo(prv[j]), pb = bfhi(prv[j]); const float ma = j < 2 ? m0[2 * j] : m1[2 * j - 4], mb = j < 2 ? m0[2 * j + 1] : m1[2 * j - 3];
        z[2 * j] = a + (pa - a) * ma; z[2 * j + 1] = b + (pb - b) * mb; }
}
template <class MP> DI f32x4 lerp4(const bf16* crow_, const bf16* prow_, int col, MP mu) {
    const v2u cur = *(const v2u*)(crow_ + col); const v2u prv = *(const v2u*)(prow_ + col);
    const f32x4 m = *(decltype(vec4p(mu)))(mu);
    f32x4 z; z[0] = bflo(cur.x) + (bflo(prv.x) - bflo(cur.x)) * m[0]; z[1] = bfhi(cur.x) + (bfhi(prv.x) - bfhi(cur.x)) * m[1];
    z[2] = bflo(cur.y) + (bflo(prv.y) - bflo(cur.y)) * m[2]; z[3] = bfhi(cur.y) + (bfhi(prv.y) - bfhi(cur.y)) * m[3]; return z;
}
template <class MP> DI void lerp8l(const LAS unsigned char* crow_, const LAS unsigned char* prow_, int colb, MP mu, float (&z)[8]) {
    const v4u cur = *(const LAS v4u*)(crow_ + colb); const v4u prv = *(const LAS v4u*)(prow_ + colb);
    const f32x4 m0 = *(decltype(vec4p(mu)))(mu), m1 = *(decltype(vec4p(mu)))(mu + 4);
#pragma unroll
    for (int j = 0; j < 4; ++j) { const float a = bflo(cur[j]), b = bfhi(cur[j]), pa = bflo(prv[j]), pb = bfhi(prv[j]); const float ma = j < 2 ? m0[2 * j] : m1[2 * j - 4], mb = j < 2 ? m0[2 * j + 1] : m1[2 * j - 3];
        z[2 * j] = a + (pa - a) * ma; z[2 * j + 1] = b + (pb - b) * mb; }
}
template <class MP> DI f32x4 lerp4l(const LAS unsigned char* crow_, const LAS unsigned char* prow_, int colb, MP mu) {
    const v2u cur = *(const LAS v2u*)(crow_ + colb); const v2u prv = *(const LAS v2u*)(prow_ + colb);
    const f32x4 m = *(decltype(vec4p(mu)))(mu);
    f32x4 z; z[0] = bflo(cur.x) + (bflo(prv.x) - bflo(cur.x)) * m[0]; z[1] = bfhi(cur.x) + (bfhi(prv.x) - bfhi(cur.x)) * m[1];
    z[2] = bflo(cur.y) + (bflo(prv.y) - bflo(cur.y)) * m[2]; z[3] = bfhi(cur.y) + (bfhi(prv.y) - bfhi(cur.y)) * m[3]; return z;
}
DI void img_write(LAS unsigned char* img, const f32x4 (&x)[4], int fr, int fq) {
#pragma unroll
    for (int mb = 0; mb < 4; ++mb)
#pragma unroll
        for (int reg = 0; reg < 4; ++reg) *(LAS bf16*)(img + (16 * mb + 4 * fq + reg) * 32 + fr * 2) = (bf16)pk2z(x[mb][reg]);
}
DI bf16x8 lds4z(const LAS unsigned char* p) { const v2u t = *(const LAS v2u*)p; v4u w; w.x = t.x; w.y = t.y; w.z = 0u; w.w = 0u; return __builtin_bit_cast(bf16x8, w); }
constexpr int HC_DUP = 0, HC_IUP = 9216, HC_VUP = 18432, HC_F = 23552, HC_BYTES = 23552 + 736 * 4;
enum { HF_MUR = 0, HF_MUK = 64, HF_MUV = 128, HF_MUW = 192, HF_MUA = 256, HF_MUVR = 320, HF_DB = 352, HF_IB = 416, HF_VB = 480, HF_SK = 544, HF_SA = 608, HF_BR = 672 };
DI void head_cache_fill(const RwkvP& P, int h, LAS unsigned char* hc, int tid) {
    { const int row = tid >> 3, ch = tid & 7;
      *(LAS v4u*)(hc + HC_DUP + row * 144 + ch * 16) = *(const v4u*)(P.dupT + (size_t)(h * 64 + row) * 64 + ch * 8);
      *(LAS v4u*)(hc + HC_IUP + row * 144 + ch * 16) = *(const v4u*)(P.iupT + (size_t)(h * 64 + row) * 64 + ch * 8); }
    if (tid < 256 && !P.layer0) { const int row = tid >> 2, ch = tid & 3; *(LAS v4u*)(hc + HC_VUP + row * 80 + ch * 16) = *(const v4u*)(P.vupT + (size_t)(h * 64 + row) * 32 + ch * 8); }
    LAS float* f = (LAS float*)(hc + HC_F);
    if (tid < 64) { const int c = h * 64 + tid; f[HF_MUR + tid] = P.mu[c]; f[HF_MUK + tid] = P.mu[512 + c]; f[HF_MUV + tid] = P.mu[1024 + c]; f[HF_MUW + tid] = P.mu[1536 + tid]; f[HF_MUA + tid] = P.mu[1600 + tid];
        f[HF_DB + tid] = P.dbase[c]; f[HF_IB + tid] = P.ibase[c]; f[HF_VB + tid] = P.layer0 ? 0.f : P.vbase[c]; f[HF_SK + tid] = P.ksk[c]; f[HF_SA + tid] = P.ksa[c]; f[HF_BR + tid] = P.brk[c];
        if (tid < 32) f[HF_MUVR + tid] = P.layer0 ? 0.f : P.muv[tid]; }
}
DI void rwkv_b1_unit(const RwkvP& P, int unit, LAS unsigned char* wl, const LAS unsigned char* hc, LAS float* gct  , int lane) {
    asm volatile("" : "+v"(lane));
    const int fr = lane & 15, fq = lane >> 4;
    const int seq = unit >> 9, c = unit & 511, b = seq >> 3, h = seq & 7;
    const size_t row = (size_t)b * TSEQ + 16 * c + fr;
    const f32x4 z4 = {0.f, 0.f, 0.f, 0.f};
    const LAS float* hf = (const LAS float*)(hc + HC_F);
    const bf16* row0p = P.PR + ((size_t)b * TSEQ + 16 * c) * PRP;
#define TROW(rr) (((rr) == 0 && c == 0) ? P.ZROW : row0p + ((rr) - 1) * PRP)
    v4u tl[6], tr3[3][3];
#pragma unroll
    for (int i = 0; i < 5; ++i) { const int idx = lane + 64 * i; if (idx < 272) { const int rr = idx >> 4, pc = idx & 15; tl[i] = *(const v4u*)(TROW(rr) + 1536 + pc * 8); } }
    { const int idx = lane; const int rr = idx >> 2, pc = idx & 3; tl[5] = (v4u){0u, 0u, 0u, 0u}; if (!P.layer0) { tl[5] = *(const v4u*)(TROW(rr) + 1792 + pc * 8); } }
    v4u tl16 = {0u, 0u, 0u, 0u}; if (!P.layer0 && lane < 4) tl16 = *(const v4u*)(TROW(16) + 1792 + lane * 8);
#pragma unroll
    for (int ten = 0; ten < 3; ++ten)
#pragma unroll
        for (int i = 0; i < 3; ++i) { const int idx = lane + 64 * i; if (idx < 136) { const int rr = idx >> 3, pc = idx & 7; tr3[ten][i] = *(const v4u*)(TROW(rr) + ten * 512 + h * 64 + pc * 8); } }
#pragma unroll
    for (int i = 0; i < 5; ++i) { const int idx = lane + 64 * i; if (idx < 272) { const int rr = idx >> 4, pc = idx & 15; *(LAS v4u*)(wl + TIL + rr * TIL_LP + pc * 16) = tl[i]; } }
    { const int rr = lane >> 2, pc = lane & 3; *(LAS v4u*)(wl + TIL + rr * TIL_LP + 256 + pc * 16) = tl[5]; if (lane < 4) *(LAS v4u*)(wl + TIL + 16 * TIL_LP + 256 + lane * 16) = tl16; }
    LDS_WAIT();
    const LAS unsigned char* lcr = wl + TIL + (fr + 1) * TIL_LP; const LAS unsigned char* lpr = wl + TIL + fr * TIL_LP;
    bf16x8 tw[2], al[2], vl;
#pragma unroll
    for (int ks = 0; ks < 2; ++ks) { float z[8]; lerp8l(lcr, lpr, (8 * fq + 32 * ks) * 2, hf + HF_MUW + 8 * fq + 32 * ks, z);
        tw[ks] = pk8(ftanh(z[0]), ftanh(z[1]), ftanh(z[2]), ftanh(z[3]), ftanh(z[4]), ftanh(z[5]), ftanh(z[6]), ftanh(z[7]));
        lerp8l(lcr, lpr, 128 + (8 * fq + 32 * ks) * 2, hf + HF_MUA + 8 * fq + 32 * ks, z); al[ks] = pk8(z[0], z[1], z[2], z[3], z[4], z[5], z[6], z[7]); }
    if (!P.layer0) { float z[8]; lerp8l(lcr, lpr, 256 + 8 * fq * 2, hf + HF_MUVR + 8 * fq, z); vl = pk8(z[0], z[1], z[2], z[3], z[4], z[5], z[6], z[7]); }
    LDS_WAIT();
#pragma unroll
    for (int ten = 0; ten < 3; ++ten)
#pragma unroll
        for (int i = 0; i < 3; ++i) { const int idx = lane + 64 * i; if (idx < 136) { const int rr = idx >> 3, pc = idx & 7; *(LAS v4u*)(wl + TIL + ten * TIL_RSZ + rr * TIL_RP + pc * 16) = tr3[ten][i]; } }
    LDS_WAIT();
#undef TROW
    const LAS unsigned char* rcr = wl + TIL + (fr + 1) * TIL_RP; const LAS unsigned char* rpr = wl + TIL + fr * TIL_RP;
    f32x4 zr[4], k2[4], kk[4], ai[4], ld[4];
    float nrm = 0.f, bon = 0.f;
#pragma unroll
    for (int mb = 0; mb < 4; ++mb) { const int ch = h * 64 + 16 * mb + 4 * fq; const int n = h * 64 + 16 * mb + fr;
        f32x4 dw = z4, da = z4, dv = z4;
        dw = mfma16(*(const LAS bf16x8*)(hc + HC_DUP + (16 * mb + fr) * 144 + 16 * fq), tw[0], dw); dw = mfma16(*(const LAS bf16x8*)(hc + HC_DUP + (16 * mb + fr) * 144 + 16 * fq + 64), tw[1], dw);
        da = mfma16(*(const LAS bf16x8*)(hc + HC_IUP + (16 * mb + fr) * 144 + 16 * fq), al[0], da); da = mfma16(*(const LAS bf16x8*)(hc + HC_IUP + (16 * mb + fr) * 144 + 16 * fq + 64), al[1], da);
        if (!P.layer0) dv = mfma16(*(const LAS bf16x8*)(hc + HC_VUP + (16 * mb + fr) * 80 + 16 * fq), vl, z4);
        const int cl = 16 * mb + 4 * fq;
        zr[mb] = lerp4l(rcr, rpr, cl * 2, hf + HF_MUR + cl);
        const f32x4 zk = lerp4l(rcr + TIL_RSZ, rpr + TIL_RSZ, cl * 2, hf + HF_MUK + cl);
        f32x4 zv = lerp4l(rcr + 2 * TIL_RSZ, rpr + 2 * TIL_RSZ, cl * 2, hf + HF_MUV + cl);
        const f32x4 db = *(const LAS f32x4*)(hf + HF_DB + cl), ib = *(const LAS f32x4*)(hf + HF_IB + cl), sk = *(const LAS f32x4*)(hf + HF_SK + cl), sa = *(const LAS f32x4*)(hf + HF_SA + cl), br = *(const LAS f32x4*)(hf + HF_BR + cl);
        if (P.layer0) { v2u w; w.x = pk2(zv[0], zv[1]); w.y = pk2(zv[2], zv[3]); *(v2u*)(P.VF + row * 512 + ch) = w; }
        else { const v2u f = *(const v2u*)(P.VF + row * 512 + ch); const f32x4 vb = *(const LAS f32x4*)(hf + HF_VB + cl); const f32x4 vf = {bflo(f.x), bfhi(f.x), bflo(f.y), bfhi(f.y)};
#pragma unroll
            for (int e = 0; e < 4; ++e) zv[e] = zv[e] + (vf[e] - zv[e]) * fsigmoid(vb[e] + dv[e]); }
        { v2u w; w.x = pk2(zv[0], zv[1]); w.y = pk2(zv[2], zv[3]); *(v2u*)(P.VV + row * 512 + ch) = w; }
#pragma unroll
        for (int reg = 0; reg < 4; ++reg) *(LAS bf16*)(wl + IMG_V + (16 * mb + 4 * fq + reg) * 32 + fr * 2) = (bf16)pk2z(zv[reg]);
#pragma unroll
        for (int e = 0; e < 4; ++e) {
            ld[mb][e] = fexp(-0.60653065971f * fsigmoid(db[e] + dw[e]));
            const float a = fsigmoid(ib[e] + da[e]); ai[mb][e] = a;
            const float kr = zk[e] * sk[e]; kk[mb][e] = kr; nrm += kr * kr;
            const float kx = zk[e] * (1.f + (a - 1.f) * sa[e]); k2[mb][e] = kx; bon += zr[mb][e] * kx * br[e]; }
        asm volatile("" ::: "memory");
    }
    nrm += __shfl_xor(nrm, 16); nrm += __shfl_xor(nrm, 32); bon += __shfl_xor(bon, 16); bon += __shfl_xor(bon, 32);
    if (fq == 0) P.BON[row * 8 + h] = bon;
    const float kinv = 1.0f / fmaxf(sqrtf(nrm), 1e-12f);
    f32x4 rt[4], kh[4];
    bf16x8 pa[2], pb[2], pk[2], pr[2];
#pragma unroll
    for (int ks = 0; ks < 2; ++ks) {
        f32x4 at2[2], bt2[2], kt2[2];
#pragma unroll
        for (int m2 = 0; m2 < 2; ++m2) { const int mb = 2 * ks + m2;
            f32x4 gcv, bhv;
#pragma unroll
            for (int e = 0; e < 4; ++e) {
                float gm = ld[mb][e]; gm *= dpp_shr1(gm, 1); gm *= dpp_shr1(gm, 2); gm *= dpp_shr1(gm, 4); gm *= dpp_shr1(gm, 8);
                const float gc = __shfl(gm, lane | 15), gp = dpp_shr1(gm, 1), gi = __builtin_amdgcn_rcpf(gm), ec = gc * gi;
                const float kn = kk[mb][e] * kinv, bb = kn * ai[mb][e];
                at2[m2][e] = -kn * gp; bt2[m2][e] = bb * gi; kt2[m2][e] = k2[mb][e] * gi; rt[mb][e] = zr[mb][e] * gm;
                bhv[e] = bb * ec; kh[mb][e] = k2[mb][e] * ec; gcv[e] = gc; }
            if (fr == 0) { *(f32x4*)(P.GC + (size_t)unit * 64 + 16 * mb + 4 * fq) = gcv; *(LAS f32x4*)(gct + (unit & 31) * 64 + 16 * mb + 4 * fq) = gcv; }
#pragma unroll
            for (int reg = 0; reg < 4; ++reg) { const int o = (16 * mb + 4 * fq + reg) * 32 + fr * 2;
                *(LAS bf16*)(wl + IMG_A + o) = (bf16)pk2z(at2[m2][reg]); *(LAS bf16*)(wl + IMG_B + o) = (bf16)pk2z(bhv[reg]); }
        }
        pa[ks] = pk8v(at2[0], at2[1]); pb[ks] = pk8v(bt2[0], bt2[1]); pk[ks] = pk8v(kt2[0], kt2[1]); pr[ks] = pk8v(rt[2 * ks], rt[2 * ks + 1]);
    }
    const f32x4 z4b = {0.f, 0.f, 0.f, 0.f};
    f32x4 Aab = mfma16(pb[1], pa[1], mfma16(pb[0], pa[0], z4b));
    f32x4 AakT = mfma16(pa[1], pk[1], mfma16(pa[0], pk[0], z4b));
    f32x4 Arb = mfma16(pb[1], pr[1], mfma16(pb[0], pr[0], z4b));
    f32x4 Ark = mfma16(pk[1], pr[1], mfma16(pk[0], pr[0], z4b));
#pragma unroll
    for (int e = 0; e < 4; ++e) { const int rr = 4 * fq + e; Aab[e] = rr < fr ? Aab[e] : 0.f; AakT[e] = fr < rr ? AakT[e] : 0.f; Arb[e] = rr <= fr ? Arb[e] : 0.f; Ark[e] = rr <= fr ? Ark[e] : 0.f; }
    LAS float* As = (LAS float*)(wl + 5 * B1_IMG);
#pragma unroll
    for (int e = 0; e < 4; ++e) As[(4 * fq + e) * 16 + fr] = Aab[e];
    LDS_WAIT();
    float x[16];
#pragma unroll
    for (int s = 15; s >= 0; --s) { float acc = (s == fr) ? 1.f : 0.f;
        const f32x4 r0 = *(const LAS f32x4*)(As + s * 16), r1 = *(const LAS f32x4*)(As + s * 16 + 4), r2 = *(const LAS f32x4*)(As + s * 16 + 8), r3 = *(const LAS f32x4*)(As + s * 16 + 12);
        const float rowv[16] = {r0[0], r0[1], r0[2], r0[3], r1[0], r1[1], r1[2], r1[3], r2[0], r2[1], r2[2], r2[3], r3[0], r3[1], r3[2], r3[3]};
#pragma unroll
        for (int uu = s + 1; uu < 16; ++uu) acc += rowv[uu] * x[uu];
        x[s] = acc; if ((s & 1) == 0) asm volatile("" ::: "memory"); }
    f32x4 xs;
#pragma unroll
    for (int e = 0; e < 4; ++e) xs[e] = fq == 0 ? x[e] : fq == 1 ? x[4 + e] : fq == 2 ? x[8 + e] : x[12 + e];
    const bf16x8 Tsel = pk4z(xs);
    f32x4 W1[4];
#pragma unroll
    for (int mb = 0; mb < 4; ++mb) W1[mb] = mfma16(lds4z(wl + IMG_A + (16 * mb + fr) * 32 + 8 * fq), Tsel, z4);
    const f32x4 GT = mfma16(Tsel, pk4z(AakT), z4);
    img_write(wl + IMG_W, W1, fr, fq);
    f32x4 M1T[4];
    const bf16x8 GTp = pk4z(GT);
#pragma unroll
    for (int mb = 0; mb < 4; ++mb) M1T[mb] = mfma16(lds4z(wl + IMG_B + (16 * mb + fr) * 32 + 8 * fq), GTp, kh[mb]);
    img_write(wl + IMG_M, M1T, fr, fq);
    LDS_WAIT();
    const bf16x8 Arbp = pk4z(Arb);
    f32x4 RE[4];
#pragma unroll
    for (int mb = 0; mb < 4; ++mb) RE[mb] = mfma16(lds4z(wl + IMG_W + (16 * mb + fr) * 32 + 8 * fq), Arbp, rt[mb]);
    const f32x4 M2 = mfma16(GTp, Arbp, Ark);
    {   bf16* w1s = P.W1S + (size_t)unit * 1024 + fr * 32; bf16* re = P.REFF + (size_t)unit * 1024 + fr * 32;
#pragma unroll
        for (int kp = 0; kp < 2; ++kp) { const int sg = kp * 512 + fq * 8;
            v4u w; w.x = pk2(W1[2 * kp][0], W1[2 * kp][1]); w.y = pk2(W1[2 * kp][2], W1[2 * kp][3]); w.z = pk2(W1[2 * kp + 1][0], W1[2 * kp + 1][1]); w.w = pk2(W1[2 * kp + 1][2], W1[2 * kp + 1][3]); *(v4u*)(w1s + sg) = w;
            w.x = pk2(RE[2 * kp][0], RE[2 * kp][1]); w.y = pk2(RE[2 * kp][2], RE[2 * kp][3]); w.z = pk2(RE[2 * kp + 1][0], RE[2 * kp + 1][1]); w.w = pk2(RE[2 * kp + 1][2], RE[2 * kp + 1][3]); *(v4u*)(re + sg) = w; }
        const v2u m2p = {pk2(M2[0], M2[1]), pk2(M2[2], M2[3])};
#pragma unroll
        for (int mb = 0; mb < 4; ++mb) {
            const v2u bq = *(const LAS v2u*)(wl + IMG_B + (16 * mb + fr) * 32 + 8 * fq), mq = *(const LAS v2u*)(wl + IMG_M + (16 * mb + fr) * 32 + 8 * fq);
            *(v4u*)(P.BM + (((size_t)unit * 64 + 16 * mb + fr) * 4 + fq) * 8) = (v4u){bq.x, bq.y, mq.x, mq.y};
            const v2u vq = *(const LAS v2u*)(wl + IMG_V + (16 * mb + fr) * 32 + 8 * fq);
            P.REC[((size_t)unit * 4 + mb) * 64 + lane] = (v4u){vq.x, vq.y, m2p.x, m2p.y}; }
    }
    LDS_WAIT();
}
constexpr int NSEG = 16, SEGCH = NCH / NSEG;
struct ChainIn { bf16x8 w1[2], re[2], bm[4]; v4u rec; };
constexpr int GCT_OFF = 149504;
template <int MODE> DI void chain_load(ChainIn& c, const RwkvP& P, int unit, int rb, int lane) {
    const int fr = lane & 15, fq = lane >> 4;
    const bf16* w1s = P.W1S + (size_t)unit * 1024 + fr * 32 + fq * 8;
    c.w1[0] = ld8(w1s); c.w1[1] = ld8(w1s + 512);
    if (MODE == 2) { const bf16* re = P.REFF + (size_t)unit * 1024 + fr * 32 + fq * 8; c.re[0] = ld8(re); c.re[1] = ld8(re + 512); }
#pragma unroll
    for (int mb = 0; mb < 4; ++mb) c.bm[mb] = ld8(P.BM + (((size_t)unit * 64 + 16 * mb + fr) * 4 + fq) * 8);
    if (MODE != 1) c.rec = P.REC[((size_t)unit * 4 + rb) * 64 + lane];
}
template <int MODE> DI void chain_step(f32x4 (&S)[4], const ChainIn& c, float* ypre  , const LAS float* gcl  ) {
    const f32x4 z4 = {0.f, 0.f, 0.f, 0.f};
    f32x4 gc[4];
#pragma unroll
    for (int mb = 0; mb < 4; ++mb) gc[mb] = *(const LAS f32x4*)(gcl + 16 * mb);
    const bf16x8 b0 = pk8v(S[0], S[1]), b1 = pk8v(S[2], S[3]);
    f32x4 ut = mfma16(c.w1[1], b1, mfma16(c.w1[0], b0, z4));
    if (MODE == 2) {
        v4u vlo; vlo.x = c.rec.x; vlo.y = c.rec.y; vlo.z = 0u; vlo.w = 0u;
        v4u m2a; m2a.x = c.rec.z; m2a.y = c.rec.w; m2a.z = 0u; m2a.w = 0u;
        f32x4 y = mfma16(__builtin_bit_cast(bf16x8, m2a), __builtin_bit_cast(bf16x8, vlo), z4);
        y = mfma16(c.re[0], b0, y); y = mfma16(c.re[1], b1, y);
#pragma unroll
        for (int e = 0; e < 4; ++e) ypre[(size_t)e * 512] = y[e];
    }
    v4u uv; uv.x = pk2(ut[0], ut[1]); uv.y = pk2(ut[2], ut[3]); uv.z = MODE == 1 ? 0u : c.rec.x; uv.w = MODE == 1 ? 0u : c.rec.y;
    const bf16x8 ub = __builtin_bit_cast(bf16x8, uv);
#pragma unroll
    for (int mb = 0; mb < 4; ++mb) S[mb] = mfma16(c.bm[mb], ub, S[mb] * gc[mb]);
}
template <int MODE> DI void chain_run(f32x4 (&S)[4], const RwkvP& P, int unit0, int nsteps  , int rb, float* yp, const LAS float* gct  , int lane) {
    ChainIn c0, c1, c2, c3;
    chain_load<MODE>(c0, P, unit0, rb, lane); chain_load<MODE>(c1, P, unit0 + 1, rb, lane); chain_load<MODE>(c2, P, unit0 + 2, rb, lane);
    for (int c = 0; c < nsteps; c += 4) {
        chain_load<MODE>(c3, P, unit0 + c + 3, rb, lane);
        chain_step<MODE>(S, c0, yp + (size_t)c * 16 * 512, gct + c * 64);
        if (c + 4 < nsteps) chain_load<MODE>(c0, P, unit0 + c + 4, rb, lane);
        chain_step<MODE>(S, c1, yp + (size_t)(c + 1) * 16 * 512, gct + (c + 1) * 64);
        if (c + 5 < nsteps) chain_load<MODE>(c1, P, unit0 + c + 5, rb, lane);
        chain_step<MODE>(S, c2, yp + (size_t)(c + 2) * 16 * 512, gct + (c + 2) * 64);
        if (c + 6 < nsteps) chain_load<MODE>(c2, P, unit0 + c + 6, rb, lane);
        chain_step<MODE>(S, c3, yp + (size_t)(c + 3) * 16 * 512, gct + (c + 3) * 64);
    }
}
DI void chain_step_dual(f32x4 (&SQ)[4], f32x4 (&SP)[4], const ChainIn& c, const LAS float* gcl) {
    const f32x4 z4 = {0.f, 0.f, 0.f, 0.f};
    f32x4 gc[4];
#pragma unroll
    for (int mb = 0; mb < 4; ++mb) gc[mb] = *(const LAS f32x4*)(gcl + 16 * mb);
    const bf16x8 q0 = pk8v(SQ[0], SQ[1]), q1 = pk8v(SQ[2], SQ[3]), p0 = pk8v(SP[0], SP[1]), p1 = pk8v(SP[2], SP[3]);
    const f32x4 utq = mfma16(c.w1[1], q1, mfma16(c.w1[0], q0, z4)), utp = mfma16(c.w1[1], p1, mfma16(c.w1[0], p0, z4));
    v4u uq; uq.x = pk2(utq[0], utq[1]); uq.y = pk2(utq[2], utq[3]); uq.z = c.rec.x; uq.w = c.rec.y;
    v4u up; up.x = pk2(utp[0], utp[1]); up.y = pk2(utp[2], utp[3]); up.z = 0u; up.w = 0u;
    const bf16x8 ubq = __builtin_bit_cast(bf16x8, uq), ubp = __builtin_bit_cast(bf16x8, up);
#pragma unroll
    for (int mb = 0; mb < 4; ++mb) { SQ[mb] = mfma16(c.bm[mb], ubq, SQ[mb] * gc[mb]); SP[mb] = mfma16(c.bm[mb], ubp, SP[mb] * gc[mb]); }
}
DI void chain_pass1(const RwkvP& P, float* QSEG, float* PSEGT, int seq, int g, int rb, const LAS float* gct0, int lane) {
    const int fr = lane & 15, fq = lane >> 4;
    f32x4 SQ[4], SP[4];
#pragma unroll
    for (int mb = 0; mb < 4; ++mb)
#pragma unroll
        for (int e = 0; e < 4; ++e) { SQ[mb][e] = 0.f; SP[mb][e] = ((16 * mb + 4 * fq + e) == (16 * rb + fr)) ? 1.f : 0.f; }
    const int unit0 = seq * NCH + g * SEGCH; const LAS float* gct = gct0 + 4 * fq;
    {   ChainIn c0, c1, c2;
        chain_load<0>(c0, P, unit0, rb, lane); chain_load<0>(c1, P, unit0 + 1, rb, lane);
        int c = 0;
        for (; c + 3 <= SEGCH; c += 3) {
            chain_load<0>(c2, P, unit0 + c + 2, rb, lane);
            chain_step_dual(SQ, SP, c0, gct + c * 64);
            if (c + 3 < SEGCH) chain_load<0>(c0, P, unit0 + c + 3, rb, lane);
            chain_step_dual(SQ, SP, c1, gct + (c + 1) * 64);
            if (c + 4 < SEGCH) chain_load<0>(c1, P, unit0 + c + 4, rb, lane);
            chain_step_dual(SQ, SP, c2, gct + (c + 2) * 64);
        }
        if (c < SEGCH) { chain_step_dual(SQ, SP, c0, gct + c * 64); ++c; }
        if (c < SEGCH) { chain_step_dual(SQ, SP, c1, gct + c * 64); ++c; }
    }
    const size_t sb = ((size_t)seq * NSEG + g) * 4096;
#pragma unroll
    for (int mb = 0; mb < 4; ++mb) *(f32x4*)(QSEG + sb + (size_t)(16 * rb + fr) * 64 + 16 * mb + 4 * fq) = SQ[mb];
#pragma unroll
    for (int mb = 0; mb < 4; ++mb)
#pragma unroll
        for (int e = 0; e < 4; ++e) PSEGT[sb + (size_t)((mb * 2 + (rb >> 1)) * 2 + (rb & 1)) * 256 + ((4 * fq + e) + 16 * (fr >> 2)) * 4 + (fr & 3)] = SP[mb][e];
}
DI void split_hl(const f32x4 a, const f32x4 b, bf16x8& hi, bf16x8& lo) {
    f32x4 ah, bh;
#pragma unroll
    for (int e = 0; e < 4; ++e) { ah[e] = rbf(a[e]); bh[e] = rbf(b[e]); }
    hi = pk8v(ah, bh); lo = pk8v(a - ah, b - bh);
}
DI void chain_pass23(const RwkvP& P, const float* QSEG, const float* PSEGT, int seq, int g, int rb, float* wkv_out, const LAS float* gct0, int lane) {
    const int fr = lane & 15, fq = lane >> 4, b = seq >> 3, h = seq & 7;
    f32x4 S[4]; for (int mb = 0; mb < 4; ++mb) S[mb] = (f32x4){0.f, 0.f, 0.f, 0.f};
    f32x4 pc[4][2][2], pn[4][2][2];
#define P2_LOAD(PD_, GP_) do { const size_t sb_ = ((size_t)seq * NSEG + (GP_)) * 4096; _Pragma("unroll") for (int mb = 0; mb < 4; ++mb) { \
        _Pragma("unroll") for (int ks = 0; ks < 2; ++ks) { const float* pr_ = PSEGT + sb_ + (size_t)((mb * 2 + ks) * 2) * 256 + (fr + 16 * fq) * 4; PD_[mb][ks][0] = *(const f32x4*)pr_; PD_[mb][ks][1] = *(const f32x4*)(pr_ + 256); } } } while (0)
    if (g > 0) P2_LOAD(pc, 0);
    for (int gp = 0; gp < g; ++gp) {
        f32x4 qc[4];
        { const size_t sb_ = ((size_t)seq * NSEG + gp) * 4096;
#pragma unroll
          for (int mb = 0; mb < 4; ++mb) qc[mb] = *(const f32x4*)(QSEG + sb_ + (size_t)(16 * rb + fr) * 64 + 16 * mb + 4 * fq); }
        if (gp + 1 < g) P2_LOAD(pn, gp + 1);
        bf16x8 bh[2], bl[2]; split_hl(S[0], S[1], bh[0], bl[0]); split_hl(S[2], S[3], bh[1], bl[1]);
#pragma unroll
        for (int mb = 0; mb < 4; ++mb) { f32x4 acc = {0.f, 0.f, 0.f, 0.f};
#pragma unroll
            for (int ks = 0; ks < 2; ++ks) { bf16x8 ah, al; split_hl(pc[mb][ks][0], pc[mb][ks][1], ah, al);
                acc = mfma16(ah, bh[ks], acc); acc = mfma16(al, bh[ks], acc); acc = mfma16(ah, bl[ks], acc); }
            S[mb] = acc + qc[mb]; }
#pragma unroll
        for (int mb = 0; mb < 4; ++mb) {
#pragma unroll
            for (int ks = 0; ks < 2; ++ks) { pc[mb][ks][0] = pn[mb][ks][0]; pc[mb][ks][1] = pn[mb][ks][1]; } }
    }
#undef P2_LOAD
    float* yp = P.YPRE + ((size_t)b * TSEQ + (size_t)g * SEGCH * 16 + 4 * fq) * 512 + h * 64 + 16 * rb + fr;
    chain_run<2>(S, P, seq * NCH + g * SEGCH, SEGCH, rb, yp, gct0 + 4 * fq, lane);
    if (g == NSEG - 1) {
#pragma unroll
        for (int mb = 0; mb < 4; ++mb) *(f32x4*)(wkv_out + (size_t)(16 * rb + fr) * 64 + 16 * mb + 4 * fq) = S[mb];
    }
}
constexpr int GC_GUP = 0, GC_F = 64 * 272, GC_BYTES = 64 * 272 + 256 * 4;
DI void gate_cache_fill(const RwkvP& P, int h, LAS unsigned char* gc, int tid) {
#pragma unroll
    for (int q = 0; q < 2; ++q) { const int idx = tid + 512 * q, row = idx >> 4, ch = idx & 15;
        *(LAS v4u*)(gc + GC_GUP + row * 272 + ch * 16) = *(const v4u*)(P.gupT + (size_t)(h * 64 + row) * 128 + ch * 8); }
    LAS float* f = (LAS float*)(gc + GC_F);
    if (tid < 64) { f[tid] = P.gng[h * 64 + tid]; f[64 + tid] = P.gnb[h * 64 + tid]; }
    if (tid >= 64 && tid < 192) f[128 + tid - 64] = P.mu[1664 + tid - 64];
}
constexpr int B3_GP = 272, B3_YP = 272, B3_VP = 144, B3_G = 0, B3_Y = 17 * B3_GP, B3_V = B3_Y + 16 * B3_YP, B3_WLDS = B3_V + 16 * B3_VP;
DI void rwkv_b3_unit(const RwkvP& P, int unit, const LAS unsigned char* gc, LAS unsigned char* wl, int lane) {
    asm volatile("" : "+v"(lane));
    const int fr = lane & 15, fq = lane >> 4;
    const int seq = unit >> 9, c = unit & 511, b = seq >> 3, h = seq & 7;
    const size_t row0 = (size_t)b * TSEQ + 16 * c;
    const f32x4 z4 = {0.f, 0.f, 0.f, 0.f};
    const LAS float* gf = (const LAS float*)(gc + GC_F);
    const bf16* row0p = P.PR + row0 * PRP;
    v4u tg[5], ty[4], tv[2];
#pragma unroll
    for (int i = 0; i < 5; ++i) { const int idx = lane + 64 * i; if (idx < 272) { const int rr = idx >> 4, pc = idx & 15; const bf16* rp = (rr == 0 && c == 0) ? P.ZROW : row0p + (rr - 1) * PRP; tg[i] = *(const v4u*)(rp + 1664 + pc * 8); } }
#pragma unroll
    for (int i = 0; i < 4; ++i) { const int idx = lane + 64 * i, rr = idx >> 4, pc = idx & 15; ty[i] = *(const v4u*)(P.YPRE + (row0 + rr) * 512 + h * 64 + pc * 4); }
#pragma unroll
    for (int i = 0; i < 2; ++i) { const int idx = lane + 64 * i, rr = idx >> 3, pc = idx & 7; tv[i] = *(const v4u*)(P.VV + (row0 + rr) * 512 + h * 64 + pc * 8); }
    const float bon = P.BON[(row0 + fr) * 8 + h];
#pragma unroll
    for (int i = 0; i < 5; ++i) { const int idx = lane + 64 * i; if (idx < 272) { const int rr = idx >> 4, pc = idx & 15; *(LAS v4u*)(wl + B3_G + rr * B3_GP + pc * 16) = tg[i]; } }
#pragma unroll
    for (int i = 0; i < 4; ++i) { const int idx = lane + 64 * i, rr = idx >> 4, pc = idx & 15; *(LAS v4u*)(wl + B3_Y + rr * B3_YP + pc * 16) = ty[i]; }
#pragma unroll
    for (int i = 0; i < 2; ++i) { const int idx = lane + 64 * i, rr = idx >> 3, pc = idx & 7; *(LAS v4u*)(wl + B3_V + rr * B3_VP + pc * 16) = tv[i]; }
    LDS_WAIT();
    const LAS unsigned char* gcr = wl + B3_G + (fr + 1) * B3_GP; const LAS unsigned char* gpr = wl + B3_G + fr * B3_GP;
    bf16x8 sg[4];
#pragma unroll
    for (int ks = 0; ks < 4; ++ks) { float z[8]; lerp8l(gcr, gpr, (8 * fq + 32 * ks) * 2, gf + 128 + 8 * fq + 32 * ks, z);
        sg[ks] = pk8(fsigmoid(z[0]), fsigmoid(z[1]), fsigmoid(z[2]), fsigmoid(z[3]), fsigmoid(z[4]), fsigmoid(z[5]), fsigmoid(z[6]), fsigmoid(z[7])); }
    f32x4 g[4], y[4]; float s = 0.f;
#pragma unroll
    for (int mb = 0; mb < 4; ++mb) { f32x4 a = z4;
#pragma unroll
        for (int ks = 0; ks < 4; ++ks) a = mfma16(*(const LAS bf16x8*)(gc + GC_GUP + (16 * mb + fr) * 272 + 16 * fq + 64 * ks), sg[ks], a);
        g[mb] = a;
        y[mb] = *(const LAS f32x4*)(wl + B3_Y + fr * B3_YP + (16 * mb + 4 * fq) * 4); s += (y[mb][0] + y[mb][1]) + (y[mb][2] + y[mb][3]); }
    s += __shfl_xor(s, 16); s += __shfl_xor(s, 32);
    const float mean = s * (1.f / 64.f); float q = 0.f;
#pragma unroll
    for (int mb = 0; mb < 4; ++mb) { y[mb] = y[mb] - mean; q += (y[mb][0] * y[mb][0] + y[mb][1] * y[mb][1]) + (y[mb][2] * y[mb][2] + y[mb][3] * y[mb][3]); }
    q += __shfl_xor(q, 16); q += __shfl_xor(q, 32);
    const float rstd = 1.0f / sqrtf(q * (1.f / 64.f) + GN_EPS);
    LDS_WAIT();
#pragma unroll
    for (int mb = 0; mb < 4; ++mb) { const int cl = 16 * mb + 4 * fq;
        const f32x4 gg = *(const LAS f32x4*)(gf + cl), gb = *(const LAS f32x4*)(gf + 64 + cl); const v2u vw = *(const LAS v2u*)(wl + B3_V + fr * B3_VP + cl * 2);
        const f32x4 v = {bflo(vw.x), bfhi(vw.x), bflo(vw.y), bfhi(vw.y)};
        const f32x4 o = (y[mb] * rstd * gg + gb + v * bon) * g[mb];
        v2u w; w.x = pk2(o[0], o[1]); w.y = pk2(o[2], o[3]); *(LAS v2u*)(wl + B3_G + fr * B3_VP + cl * 2) = w; }
    LDS_WAIT();
#pragma unroll
    for (int i = 0; i < 2; ++i) { const int idx = lane + 64 * i, rr = idx >> 3, pc = idx & 7; *(v4u*)(P.MIX + (row0 + rr) * 1024 + 512 + h * 64 + pc * 8) = *(const LAS v4u*)(wl + B3_G + rr * B3_VP + pc * 16); }
    LDS_WAIT();
}
DI f32x16 dec_gemm(const bf16* A, const bf16* Wt, int K, LAS float* red  , int wave, int lane) {
    const int r = lane & 31, h = lane >> 5, kw = K >> 3;
    const bf16* ap = A + (size_t)r * K + wave * kw + 8 * h; const bf16* bp = Wt + (size_t)r * K + wave * kw + 8 * h;
    f32x16 acc; for (int i = 0; i < 16; ++i) acc[i] = 0.f;
#pragma unroll 16
    for (int k = 0; k < kw; k += 16) acc = mfma32(ld8(ap + k), ld8(bp + k), acc);
    __syncthreads();
#pragma unroll
    for (int i = 0; i < 16; ++i) red[(wave * 16 + i) * 64 + lane] = acc[i];
    __syncthreads();
    if (wave == 0) {
#pragma unroll
        for (int i = 0; i < 16; ++i) { float s = 0.f;
#pragma unroll
            for (int w = 0; w < 8; ++w) s += red[(w * 16 + i) * 64 + lane];
            asm volatile("" : "+v"(s) :: "memory"); acc[i] = s; } }
    return acc;
}
DI void dec_row_stats(const float* st, LAS float* sc, int lane) {
    if (lane < 32) { float s = 0.f, q = 0.f; const f32x4* p = (const f32x4*)(st + (size_t)lane * 64);
#pragma unroll
        for (int i = 0; i < 16; ++i) { const f32x4 v = p[i]; s += v[0] + v[2]; q += v[1] + v[3]; if ((i & 3) == 3) asm volatile("" : "+v"(s), "+v"(q) :: "memory"); }
        const float mu = s * (1.f / 1024.f), var = fmaxf(q * (1.f / 1024.f) - mu * mu, 0.f); sc[2 * lane] = mu; sc[2 * lane + 1] = 1.0f / sqrtf(var + LN_EPS); }
    LDS_WAIT();
}
struct DecP {
    unsigned char* dec; int l;
    const float* xs;
    const float *c1in, *c2in, *c1up, *c2up, *g1, *b1, *g2p, *b2p;
    const bf16 *win, *winu, *wout, *wup, *wdn;
    float* out;
};
DI void dec_unit_in(const DecP& D, int u, LAS float* red, LAS float* sc, int wave, int lane) {
    const int r32 = lane & 31, hi = lane >> 5;
    if (u < 105) {
        const int n = 32 * u + r32; const bool fold = D.l > 0;
        const f32x16 acc = dec_gemm((const bf16*)(D.dec + DEC_XB2), D.win + (size_t)(32 * u) * DM, DM, red, wave, lane);
        if (wave != 0) return;
        if (fold) dec_row_stats((const float*)(D.dec + DEC_ST2), sc, lane);
        const float c1 = fold ? D.c1in[n] : 0.f, c2 = fold ? D.c2in[n] : 0.f; const int on = n < 1024 ? lgcl2orig(n) : n;
        float* PD = (float*)(D.dec + DEC_PD);
#pragma unroll
        for (int i = 0; i < 16; ++i) { const int row = crow(i, hi); float mu = 0.f, rs = 1.f; if (fold) { mu = sc[2 * row]; rs = sc[2 * row + 1]; } PD[(size_t)row * NIN + on] = (acc[i] - mu * c1) * rs + c2; }
    } else {
        const int v = u - 105, n = 32 * v + r32;
        const f32x16 acc = dec_gemm((const bf16*)(D.dec + DEC_SHB) + (size_t)D.l * MD * DM, D.winu + (size_t)(32 * v) * DM, DM, red, wave, lane);
        if (wave != 0) return;
        float* PS = (float*)(D.dec + DEC_PS);
#pragma unroll
        for (int i = 0; i < 16; ++i) PS[(size_t)crow(i, hi) * NRWU + n] = acc[i];
    }
    LDS_WAIT();
}
DI void dec_unit_res(const bf16* A, const bf16* Wt, int K, int u, bool raw, const float* src, const float* sstat, const float* g, const float* b, float* T, bf16* XB, float* ostat, float* shiftout, LAS float* red, LAS float* sc, int wave, int lane) {
    const int r32 = lane & 31, hi = lane >> 5, n = 32 * u + r32;
    const f32x16 acc = dec_gemm(A, Wt + (size_t)(32 * u) * K, K, red, wave, lane);
    if (wave != 0) return;
    if (!raw) dec_row_stats(sstat, sc, lane);
    const float gg = raw ? 1.f : g[n], bb = raw ? 0.f : b[n];
#pragma unroll
    for (int i = 0; i < 16; ++i) { const int row = crow(i, hi); float mu = 0.f, rs = 1.f; if (!raw) { mu = sc[2 * row]; rs = sc[2 * row + 1]; }
        const float x = (src[(size_t)row * DM + n] - mu) * rs * gg + bb; const float t = ALPHA * x + acc[i];
        T[(size_t)row * DM + n] = t; XB[(size_t)row * DM + n] = (bf16)f2bf(t); if (shiftout) shiftout[(size_t)row * DM + n] = x;
        float s = t, q = t * t;
#pragma unroll
        for (int o = 1; o < 32; o <<= 1) { s += __shfl_xor(s, o); q += __shfl_xor(q, o); }
        if (r32 == 0) { ostat[((size_t)row * 32 + u) * 2] = s; ostat[((size_t)row * 32 + u) * 2 + 1] = q; } }
    LDS_WAIT();
}
DI void dec_unit_up(const DecP& D, int u, LAS float* red, LAS float* sc, int wave, int lane) {
    const int r32 = lane & 31, hi = lane >> 5, n = 32 * u + r32;
    const f32x16 acc = dec_gemm((const bf16*)(D.dec + DEC_XB1), D.wup + (size_t)(32 * u) * DM, DM, red, wave, lane);
    if (wave != 0) return;
    dec_row_stats((const float*)(D.dec + DEC_ST1), sc, lane);
    const float c1 = D.c1up[n], c2 = D.c2up[n]; bf16* HB = (bf16*)(D.dec + DEC_HB);
#pragma unroll
    for (int i = 0; i < 16; ++i) { const int row = crow(i, hi); const float v = fmaxf((acc[i] - sc[2 * row] * c1) * sc[2 * row + 1] + c2, 0.f); HB[(size_t)row * FFD + n] = (bf16)f2bf(v * v); }
    LDS_WAIT();
}
DI void dec_attn_task(const DecP& D, const float* ck, const float* cv, const float* rope, int bd, int h, int p, int lane) {
    const int g = lane >> 4, dq = lane & 15, dd = 1 << (2 * p);
    const float* PD = (const float*)(D.dec + DEC_PD) + (size_t)bd * NIN;
    const f32x4 rr0 = *(const f32x4*)(rope + ((size_t)8192 * 32 + ((4 * dq) & 31)) * 2), rr1 = *(const f32x4*)(rope + ((size_t)8192 * 32 + ((4 * dq) & 31)) * 2 + 4);
    const f32x4 cs = {rr0[0], rr0[2], rr1[0], rr1[2]}, sn = {rr0[1], rr0[3], rr1[1], rr1[3]};
    const float sgn = dq < 8 ? -1.f : 1.f;
    f32x4 q = *(const f32x4*)(PD + h * 64 + 4 * dq), kn = *(const f32x4*)(PD + 512 + h * 64 + 4 * dq); const f32x4 vn = *(const f32x4*)(PD + 1024 + h * 64 + 4 * dq);
    { f32x4 qp, kp;
#pragma unroll
      for (int e = 0; e < 4; ++e) { qp[e] = __shfl_xor(q[e], 8); kp[e] = __shfl_xor(kn[e], 8); }
      q = q * cs + qp * sn * sgn; kn = kn * cs + kp * sn * sgn; }
    if (p == 0 && g == 0) { *(f32x4*)(D.out + O_KS + ((size_t)D.l * MD + bd) * 512 + h * 64 + 4 * dq) = kn; *(f32x4*)(D.out + O_VS + ((size_t)D.l * MD + bd) * 512 + h * 64 + 4 * dq) = vn; }
    float s0 = (q[0] * kn[0] + q[1] * kn[1]) + (q[2] * kn[2] + q[3] * kn[3]);
#pragma unroll
    for (int o = 1; o < 16; o <<= 1) s0 += __shfl_xor(s0, o);
    s0 *= 0.125f;
    const size_t cbase = (((size_t)D.l * MD + bd) * 2048) * 512 + h * 64 + 4 * dq;
    float mx = -INFINITY, den = 0.f; f32x4 o4 = {0.f, 0.f, 0.f, 0.f};
#pragma unroll 8
    for (int it = 0; it < 32; ++it) { const int j = 1 + 4 * it + g; const size_t off = cbase + (size_t)(2048 - j * dd) * 512;
        const f32x4 kr = *(const f32x4*)(ck + off); const f32x4 vr = *(const f32x4*)(cv + off);
        float s = (q[0] * kr[0] + q[1] * kr[1]) + (q[2] * kr[2] + q[3] * kr[3]);
#pragma unroll
        for (int o = 1; o < 16; o <<= 1) s += __shfl_xor(s, o);
        s *= 0.125f;
        const float mn = fmaxf(mx, s), sc = fexp(mx - mn), pj = fexp(s - mn);
        den = den * sc + pj; o4 = o4 * sc + vr * pj; mx = mn; }
    float mg = fmaxf(mx, __shfl_xor(mx, 16)); mg = fmaxf(mg, __shfl_xor(mg, 32)); mg = fmaxf(mg, s0);
    { const float sc = fexp(mx - mg); den *= sc; o4 = o4 * sc; }
    den += __shfl_xor(den, 16); den += __shfl_xor(den, 32);
#pragma unroll
    for (int e = 0; e < 4; ++e) { o4[e] += __shfl_xor(o4[e], 16); o4[e] += __shfl_xor(o4[e], 32); }
    const float p0 = fexp(s0 - mg); den += p0; o4 = (o4 + vn * p0) * (1.0f / den); mx = mg;
    if (g == 0) *(f32x4*)((float*)(D.dec + DEC_OP) + ((size_t)p * MD + bd) * 512 + h * 64 + 4 * dq) = o4;
    if (lane == 0) ((float*)(D.dec + DEC_LSE))[((size_t)p * MD + bd) * 8 + h] = mx + __logf(den);
}
DI void dec_rwkv_task(const DecP& D, const float* const* in, int bd, int h, LAS float* sv  , int lane) {
    const int l = D.l, ch = h * 64 + lane;
    const float* PD = (const float*)(D.dec + DEC_PD) + (size_t)bd * NIN + RW0; const float* PS = (const float*)(D.dec + DEC_PS) + (size_t)bd * NRWU;
    const float* mu = in[8] + (size_t)l * 1792;
    auto zf = [&](int col) { const float pr = PD[col], pv = PS[col]; return pr + (pv - pr) * mu[col]; };
    const float zr = zf(ch), zk = zf(512 + ch), zv0 = zf(1024 + ch);
    float vl = 0.f; if (l > 0 && lane < 32) { const float pr = PD[1792 + lane], pv = PS[1792 + lane]; vl = pr + (pv - pr) * in[9][(size_t)(l - 1) * 32 + lane]; }
    sv[lane] = ftanh(zf(1536 + lane)); sv[64 + lane] = zf(1600 + lane); sv[128 + lane] = fsigmoid(zf(1664 + lane)); sv[192 + lane] = fsigmoid(zf(1728 + lane)); sv[256 + lane] = vl;
    LDS_WAIT();
    float dw = 0.f, da = 0.f, dv = 0.f, gt = 0.f;
    const float* du = in[11] + (size_t)l * 64 * 512 + ch; const float* iu = in[13] + (size_t)l * 64 * 512 + ch; const float* gu = in[14] + (size_t)l * 128 * 512 + ch;
#pragma unroll 2
    for (int m4 = 0; m4 < 16; ++m4) { const f32x4 a = *(const LAS f32x4*)(sv + 4 * m4), b = *(const LAS f32x4*)(sv + 64 + 4 * m4), c = *(const LAS f32x4*)(sv + 128 + 4 * m4), d = *(const LAS f32x4*)(sv + 192 + 4 * m4);
#pragma unroll
        for (int e = 0; e < 4; ++e) { const int m = 4 * m4 + e; dw += a[e] * du[(size_t)m * 512]; da += b[e] * iu[(size_t)m * 512]; gt += c[e] * gu[(size_t)m * 512] + d[e] * gu[(size_t)(64 + m) * 512]; } }
    if (l > 0) { const float* vu = in[16] + (size_t)(l - 1) * 32 * 512 + ch;
#pragma unroll
        for (int m4 = 0; m4 < 8; ++m4) { const f32x4 a = *(const LAS f32x4*)(sv + 256 + 4 * m4);
#pragma unroll
            for (int e = 0; e < 4; ++e) dv += a[e] * vu[(size_t)(4 * m4 + e) * 512]; } }
    const float w = -fsoftplus(-(in[10][(size_t)l * 512 + ch] + dw)) - 0.5f, decay = fexp(-fexp(w));
    const float a = fsigmoid(in[12][(size_t)l * 512 + ch] + da);
    float* VFD = (float*)(D.dec + DEC_VF) + (size_t)bd * 512 + ch;
    float v = zv0; if (l == 0) *VFD = zv0; else v = zv0 + (*VFD - zv0) * fsigmoid(in[15][(size_t)(l - 1) * 512 + ch] + dv);
    const float kr = zk * in[17][(size_t)l * 512 + ch]; const float kn = kr / fmaxf(sqrtf(wave_sum(kr * kr)), 1e-12f);
    const float k2 = zk * (1.f + (a - 1.f) * in[18][(size_t)l * 512 + ch]);
    const float bon = wave_sum(zr * k2 * in[19][(size_t)l * 512 + ch]);
    LDS_WAIT();
    sv[320 + lane] = -kn; sv[384 + lane] = decay; sv[448 + lane] = kn * a; sv[512 + lane] = k2; sv[576 + lane] = zr; sv[640 + lane] = v;
    LDS_WAIT();
    const float* S0 = in[3] + (((size_t)l * MD + bd) * NH + h) * 4096;
    float* So = D.out + O_WKS + (((size_t)l * MD + bd) * NH + h) * 4096;
    { const int rr = lane >> 4, cq = lane & 15;
      const f32x4 a4 = *(const LAS f32x4*)(sv + 320 + 4 * cq), w4 = *(const LAS f32x4*)(sv + 384 + 4 * cq), b4 = *(const LAS f32x4*)(sv + 448 + 4 * cq), k4 = *(const LAS f32x4*)(sv + 512 + 4 * cq), r4 = *(const LAS f32x4*)(sv + 576 + 4 * cq);
      f32x4 Sr[16];
#pragma unroll
      for (int q = 0; q < 16; ++q) Sr[q] = *(const f32x4*)(S0 + (size_t)(4 * q + rr) * 64 + 4 * cq);
#pragma unroll
      for (int q = 0; q < 16; ++q) { const int i = 4 * q + rr;
          float sa = (Sr[q][0] * a4[0] + Sr[q][1] * a4[1]) + (Sr[q][2] * a4[2] + Sr[q][3] * a4[3]);
#pragma unroll
          for (int o = 1; o < 16; o <<= 1) sa += __shfl_xor(sa, o);
          const float vi = sv[640 + i];
          const f32x4 s4 = Sr[q] * w4 + b4 * sa + k4 * vi; *(f32x4*)(So + (size_t)i * 64 + 4 * cq) = s4;
          float yp = (s4[0] * r4[0] + s4[1] * r4[1]) + (s4[2] * r4[2] + s4[3] * r4[3]);
#pragma unroll
          for (int o = 1; o < 16; o <<= 1) yp += __shfl_xor(yp, o);
          if (cq == 0) sv[704 + i] = yp; } }
    LDS_WAIT();
    const float y = sv[704 + lane];
    const float mean = wave_sum(y) * (1.f / 64.f), dy = y - mean, var = wave_sum(dy * dy) * (1.f / 64.f);
    const float o = (dy * (1.0f / sqrtf(var + GN_EPS)) * in[20][(size_t)l * 512 + ch] + in[21][(size_t)l * 512 + ch] + bon * v) * gt;
    ((float*)(D.dec + DEC_MIX))[(size_t)bd * DM + 512 + ch] = o;
    LDS_WAIT();
}
DI void dec_finalize_row(const DecP& D, const float* gain, int bd, int lane) {
    const int h = lane >> 3; const float* L = (const float*)(D.dec + DEC_LSE); const float* OPD = (const float*)(D.dec + DEC_OP);
    const float l0 = L[((size_t)0 * MD + bd) * 8 + h], l1 = L[((size_t)1 * MD + bd) * 8 + h], l2 = L[((size_t)2 * MD + bd) * 8 + h];
    const float mx = fmaxf(l0, fmaxf(l1, l2)); float w0 = fexp(l0 - mx), w1 = fexp(l1 - mx), w2 = fexp(l2 - mx); const float inv = 1.0f / (w0 + w1 + w2); w0 *= inv; w1 *= inv; w2 *= inv;
    float v[8]; float ss = 0.f;
#pragma unroll
    for (int e = 0; e < 8; ++e) { v[e] = w0 * OPD[((size_t)0 * MD + bd) * 512 + lane * 8 + e] + w1 * OPD[((size_t)1 * MD + bd) * 512 + lane * 8 + e] + w2 * OPD[((size_t)2 * MD + bd) * 512 + lane * 8 + e]; ss += v[e] * v[e]; }
    ss = wave_sum(ss); const float rinv = 1.0f / sqrtf(ss * (1.f / 512.f) + RMS_EPS);
    bf16* MB = (bf16*)(D.dec + DEC_MIXB) + (size_t)bd * DM; const float* MX = (const float*)(D.dec + DEC_MIX) + (size_t)bd * DM + 512;
#pragma unroll
    for (int e = 0; e < 8; ++e) { MB[lane * 8 + e] = (bf16)f2bf(v[e] * rinv * gain[lane * 8 + e]); MB[512 + lane * 8 + e] = (bf16)f2bf(MX[lane * 8 + e]); }
}
#ifndef PH_MASK
#define PH_MASK 0x1ff
#endif
#define PH_ON(k) ((PH_MASK >> (k)) & 1)
#ifndef PH_DUP
#define PH_DUP 0
#endif
#define PH_REP(k) for (int rep_ = 0; rep_ < (((PH_DUP >> (k)) & 1) ? 2 : 1); ++rep_)
DI unsigned lds_task_next(volatile LAS unsigned* ctr, int lane) {
    unsigned t = 0; if (lane == 0) t = __hip_atomic_fetch_add((LAS unsigned*)ctr, 1u, __ATOMIC_RELAXED, __HIP_MEMORY_SCOPE_WORKGROUP);
    return (unsigned)__builtin_amdgcn_readfirstlane((int)t);
}
DI DecP make_dec(unsigned char* ws, const float* const* in, float* out, int l) {
    DecP D; D.dec = ws + WS_DEC; D.l = l; D.xs = in[1];
    D.c1in = (const float*)(ws + WS_C1IN) + l * NIN; D.c2in = (const float*)(ws + WS_C2IN) + l * NIN; D.c1up = (const float*)(ws + WS_C1UP) + l * FFD; D.c2up = (const float*)(ws + WS_C2UP) + l * FFD;
    D.g1 = in[24] + (size_t)l * DM; D.b1 = in[25] + (size_t)l * DM; D.g2p = l > 0 ? in[28] + (size_t)(l - 1) * DM : nullptr; D.b2p = l > 0 ? in[29] + (size_t)(l - 1) * DM : nullptr;
    D.win = (const bf16*)(ws + WS_WIN) + (size_t)l * NIN * DM; D.winu = (const bf16*)(ws + WS_WINU) + (size_t)l * NRWU * DM; D.wout = (const bf16*)(ws + WS_WOUT) + (size_t)l * DM * DM;
    D.wup = (const bf16*)(ws + WS_WUP) + (size_t)l * FFD * DM; D.wdn = (const bf16*)(ws + WS_WDN) + (size_t)l * DM * FFD; D.out = out; return D;
}
DI RwkvP make_rwkv(unsigned char* ws, const float* const* in, int l) {
    RwkvP R; R.PR = (const bf16*)(ws + WS_PR); R.mu = in[8] + (size_t)l * 1792; R.muv = l > 0 ? in[9] + (size_t)(l - 1) * 32 : nullptr;
    R.dbase = in[10] + (size_t)l * 512; R.ibase = in[12] + (size_t)l * 512; R.vbase = l > 0 ? in[15] + (size_t)(l - 1) * 512 : nullptr; R.ksk = in[17] + (size_t)l * 512; R.ksa = in[18] + (size_t)l * 512; R.brk = in[19] + (size_t)l * 512;
    R.gng = in[20] + (size_t)l * 512; R.gnb = in[21] + (size_t)l * 512;
    R.dupT = (const bf16*)(ws + WS_DUPT) + (size_t)l * 512 * 64; R.iupT = (const bf16*)(ws + WS_IUPT) + (size_t)l * 512 * 64; R.vupT = l > 0 ? (const bf16*)(ws + WS_VUPT) + (size_t)(l - 1) * 512 * 32 : nullptr; R.gupT = (const bf16*)(ws + WS_GUPT) + (size_t)l * 512 * 128;
    R.ZROW = (const bf16*)(ws + WS_CTL + 512 * 1024); R.VF = (bf16*)(ws + WS_VF); R.VV = (bf16*)(ws + WS_VV); R.BON = (float*)(ws + WS_BON); R.GC = (float*)(ws + WS_GC); R.W1S = (bf16*)(ws + WS_PT); R.REFF = (bf16*)(ws + WS_REFF); R.BM = (bf16*)(ws + WS_QT); R.REC = (v4u*)(ws + WS_YLOC);
    R.YPRE = (float*)(ws + WS_YPRE); R.MIX = (bf16*)(ws + WS_MIX); R.layer0 = (l == 0); return R;
}
#define PHASE_VARS() int tid_p = (int)threadIdx.x; asm volatile("" : "+v"(tid_p)); const int lane = tid_p & 63; const int wave = __builtin_amdgcn_readfirstlane(tid_p >> 6); \
    unsigned zo_p; asm volatile("s_mov_b32 %0, 0" : "=s"(zo_p)); unsigned char* ws = args.ws + zo_p; const float* const* in = args.in + zo_p; float* out = args.out + zo_p; \
    const int gw = F.vcu * NWAVES + wave; const int rgw = (F.G - 1 - (int)blockIdx.x) * NWAVES + wave; LAS float* dsc = (LAS float*)(L3 + 65536); LAS float* dred = (LAS float*)L3; const int rwg = F.G - 1 - (int)blockIdx.x; (void)gw; (void)rgw; (void)dsc; (void)dred; (void)rwg; (void)lane; (void)in; (void)out
__global__ void __launch_bounds__(NWAVES * 64, 2) mega_fwd(Args args) {
    extern __shared__ __attribute__((aligned(16))) unsigned char lds[];
    Frame F;
    F.lds = lds; F.MISC = (volatile LAS unsigned*)((LAS unsigned char*)lds + MISC_OFF);
    F.tid = threadIdx.x; F.lane = F.tid & 63; F.wave = __builtin_amdgcn_readfirstlane(F.tid >> 6);
    F.G = gridDim.x; { const int bx = blockIdx.x; F.vcu = (F.G % 8 == 0) ? (bx % 8) * (F.G / 8) + bx / 8 : bx; }
    F.gw = F.vcu * NWAVES + F.wave; F.NGW = F.G * NWAVES;
    F.in = args.in; F.out = args.out; F.ws = args.ws; F.ctl = (gu32*)(args.ws + WS_CTL);
    LAS unsigned char* L3 = (LAS unsigned char*)lds;
    for (int u = F.tid; u < (LDS_BYTES - RING_BYTES) / 4; u += NWAVES * 64) ((LAS unsigned*)(L3 + RING_BYTES))[u] = 0u;
    __syncthreads();
    XcdBarrier bar = xcd_barrier_post((unsigned*)(F.ctl + CW_BAR), F.MISC + 8);
#define GRID_BAR() do { XcdBarrier b2_ = bar; asm volatile("" : "+s"(b2_.x)); xcd_barrier(b2_); } while (0)

    PH_REP(0) { if (PH_ON(0)) p0_prologue(F);
    GRID_BAR(); }

    for (int l = 0; l < DEPTH; ++l) {
        PH_REP(1) {
        if (PH_ON(1))
        {   PHASE_VARS(); const DecP D = make_dec(ws, in, out, l);
            pg8::Gemm g{(const pg8::bf16_t*)(ws + WS_XB2), (const pg8::bf16_t*)D.win, M, NIN, DM}; pg8::StaticOrder S; S.init(M, NIN, F.G, (int)blockIdx.x);
            pg8::etab_fill((PG8_LAS unsigned char*)L3, S, (const float*)(ws + WS_STAT2), D.c1in, D.c2in, l > 0, tid_p); __syncthreads();
            pg8::EpiIn E{ws, out, l, (const PG8_LAS unsigned char*)L3};
            pg8::gemm_phase<pg8::EpiIn, pg8::StaticOrder, true, true>((PG8_LAS unsigned char*)L3, g, S, E, tid_p);
            for (int u = rwg; u < 162; u += F.G) dec_unit_in(D, u, dred, dsc, wave, lane);
        }
        GRID_BAR();
        }

#define ATT_QUEUE() do { LAS unsigned char* wl_ = L3 + wave * 10240; const int bh_ = F.vcu >> 4, span_ = F.vcu & 15; \
        for (;;) { const unsigned t_ = lds_task_next(F.MISC, lane); if (t_ >= 48u) break; \
            if (t_ >= 48u) { const int dt_ = (int)blockIdx.x * 4 + (int)(t_ - 48u); \
                if (dt_ < 768) dec_attn_task(D, in[4], in[5], (const float*)(ws + WS_ROPE), dt_ / 24, (dt_ % 24) / 3, dt_ % 3, lane); \
                else dec_rwkv_task(D, in, (dt_ - 768) >> 3, (dt_ - 768) & 7, (LAS float*)wl_, lane); continue; } \
            const int p_ = (int)t_ >> 4, idx_ = (int)t_ & 15; \
            const int cls_ = p_ == 0 ? 0 : p_ == 1 ? (idx_ >> 2) : idx_, qblk_ = p_ == 0 ? span_ * 16 + idx_ : p_ == 1 ? span_ * 4 + (idx_ & 3) : span_; \
            attn_task((const bf16*)(ws + WS_QB), (const bf16*)(ws + WS_KB), (const bf16*)(ws + WS_VB), (bf16*)(ws + WS_OP), (float*)(ws + WS_LSE), bh_ >> 3, bh_ & 7, p_, cls_, qblk_, wl_, lane); } } while (0)
        PH_REP(3) {
        if (PH_ON(3))
        {   PHASE_VARS(); const DecP D = make_dec(ws, in, out, l); const RwkvP R = make_rwkv(ws, in, l);
            if (tid_p == 0) F.MISC[0] = 0u;
            if (l == 0) colsum_finish(ws, gw * 64 + lane, F.NGW * 64);
            { LAS unsigned char* wl1 = L3 + wave * 12288; LAS unsigned char* hc = L3 + 8 * 12288;
              head_cache_fill(R, (F.vcu >> 4) & 7, hc, tid_p);
              __syncthreads();
#pragma unroll 1
              for (int i = 0; i < 4; ++i) rwkv_b1_unit(R, F.vcu * 32 + wave + 8 * i, wl1, hc, (LAS float*)(L3 + GCT_OFF), lane); }
            VM_WAIT(); __syncthreads();
            if (wave >= 4) { const int dt = (int)blockIdx.x * 4 + (wave - 4);
                if (dt < 768) dec_attn_task(D, in[4], in[5], (const float*)(ws + WS_ROPE), dt / 24, (dt % 24) / 3, dt % 3, lane);
                else dec_rwkv_task(D, in, (dt - 768) >> 3, (dt - 768) & 7, (LAS float*)(L3 + wave * 10240), lane); }
            if (wave < 4) chain_pass1(R, (float*)(ws + WS_SEGQ), (float*)(ws + WS_SEGP), F.vcu >> 4, F.vcu & 15, wave, (const LAS float*)(L3 + GCT_OFF), lane);
            ATT_QUEUE();
            if ((PH_DUP >> 12) & 1) { __syncthreads(); if (tid_p == 0) F.MISC[0] = 0u; __syncthreads(); ATT_QUEUE(); }
        }
        GRID_BAR();
        }
        PH_REP(9) {
        if (PH_ON(3))
        {   PHASE_VARS(); const DecP D = make_dec(ws, in, out, l); const RwkvP R = make_rwkv(ws, in, l);
            const int seq = F.vcu >> 4, sg = F.vcu & 15;
            LAS unsigned char* gcache = L3 + 98304; gate_cache_fill(R, seq & 7, gcache, tid_p);
            for (int e = tid_p; e < SEGCH * 64; e += NWAVES * 64) ((LAS float*)(L3 + GCT_OFF))[e] = R.GC[(size_t)(seq * NCH + sg * SEGCH) * 64 + e];
            __syncthreads();
            if (wave < 4) chain_pass23(R, (const float*)(ws + WS_SEGQ), (const float*)(ws + WS_SEGP), seq, sg, wave, out + O_WKP + ((size_t)l * 16 + seq) * 4096, (const LAS float*)(L3 + GCT_OFF), lane);
            else { for (int i = 0; i < 16; ++i) attn_finalize_row((const bf16*)(ws + WS_OP), (const float*)(ws + WS_LSE), in[22] + (size_t)l * 512, (bf16*)(ws + WS_MIX), (int)blockIdx.x * 64 + (wave - 4) * 16 + i, lane);
                if (blockIdx.x < MD && wave == 4) dec_finalize_row(D, in[22] + (size_t)l * 512, (int)blockIdx.x, lane); }
            VM_WAIT(); __syncthreads();
#pragma unroll 1
            for (int i = 0; i < 4; ++i) rwkv_b3_unit(R, seq * NCH + sg * SEGCH + wave + 8 * i, gcache, L3 + wave * 12288, lane);
        }
        GRID_BAR();
        }

        PH_REP(5) {
        if (PH_ON(5))
        {   PHASE_VARS(); const DecP D = make_dec(ws, in, out, l);
            pg8::Gemm g{(const pg8::bf16_t*)(ws + WS_MIX), (const pg8::bf16_t*)D.wout, M, DM, DM}; pg8::StaticOrder S; S.init(M, DM, F.G, (int)blockIdx.x);
            pg8::EpiRes<false> E{ws, in, out, l};
            pg8::gemm_phase<pg8::EpiRes<false>, pg8::StaticOrder, false, true>((PG8_LAS unsigned char*)L3, g, S, E, tid_p);
            for (int u = rwg; u < 32; u += F.G)
                dec_unit_res((const bf16*)(D.dec + DEC_MIXB), D.wout, DM, u, l == 0, l == 0 ? D.xs : (const float*)(D.dec + DEC_T2), (const float*)(D.dec + DEC_ST2), D.g2p, D.b2p, (float*)(D.dec + DEC_T1), (bf16*)(D.dec + DEC_XB1), (float*)(D.dec + DEC_ST1),
                             out + O_SHS + (size_t)l * MD * DM, dred, dsc, wave, lane);
        }
        GRID_BAR();
        }

        PH_REP(6) {
        if (PH_ON(6))
        {   PHASE_VARS(); const DecP D = make_dec(ws, in, out, l);
            pg8::Gemm g{(const pg8::bf16_t*)(ws + WS_XB1), (const pg8::bf16_t*)D.wup, M, FFD, DM}; pg8::StaticOrder S; S.init(M, FFD, F.G, (int)blockIdx.x);
            pg8::etab_fill((PG8_LAS unsigned char*)L3, S, (const float*)(ws + WS_STAT1), D.c1up, D.c2up, true, tid_p); __syncthreads();
            pg8::EpiUp E{ws, (const PG8_LAS unsigned char*)L3};
            pg8::gemm_phase<pg8::EpiUp, pg8::StaticOrder, true, true>((PG8_LAS unsigned char*)L3, g, S, E, tid_p);
            for (int u = rwg; u < 128; u += F.G) dec_unit_up(D, u, dred, dsc, wave, lane);
        }
        GRID_BAR();
        }

        PH_REP(7) {
        if (PH_ON(7))
        {   PHASE_VARS(); const DecP D = make_dec(ws, in, out, l);
            pg8::Gemm g{(const pg8::bf16_t*)(ws + WS_H), (const pg8::bf16_t*)D.wdn, M, DM, FFD}; pg8::StaticOrder S; S.init(M, DM, F.G, (int)blockIdx.x);
            pg8::EpiRes<true> E{ws, in, out, l};
            PH_REP(11) { pg8::gemm_phase<pg8::EpiRes<true>, pg8::StaticOrder, false, true>((PG8_LAS unsigned char*)L3, g, S, E, tid_p); }
            PH_REP(10) for (int u = rwg; u < 32; u += F.G)
                dec_unit_res((const bf16*)(D.dec + DEC_HB), D.wdn, FFD, u, false, (const float*)(D.dec + DEC_T1), (const float*)(D.dec + DEC_ST1), D.g1, D.b1, (float*)(D.dec + DEC_T2), (bf16*)(D.dec + DEC_XB2), (float*)(D.dec + DEC_ST2), nullptr, dred, dsc, wave, lane);
        }
        GRID_BAR();
        }
    }
    if (PH_ON(8))
    {   PHASE_VARS(); const float* g = in[28] + (size_t)3 * DM; const float* b = in[29] + (size_t)3 * DM;
        for (int r = gw; r < M; r += F.NGW) { float mu, rs; pg8::row_stats((const float*)(ws + WS_STAT2), r, mu, rs);
            const v2u* t = (const v2u*)((const bf16*)(ws + WS_XB2) + (size_t)r * DM) + lane; f32x4* o = (f32x4*)(out + O_Y + (size_t)r * DM) + lane;
#pragma unroll
            for (int j = 0; j < 4; ++j) { const f32x4 gg = *((const f32x4*)g + lane + 64 * j), bb = *((const f32x4*)b + lane + 64 * j); const v2u w = t[64 * j]; const f32x4 tv = {bflo(w.x), bfhi(w.x), bflo(w.y), bfhi(w.y)}; o[64 * j] = (tv - mu) * rs * gg + bb; } }
        if (rgw < MD) { LAS float* fsc = dsc + wave * 64; dec_row_stats((const float*)(ws + WS_DEC + DEC_ST2), fsc, lane); const float mu = fsc[2 * rgw], rs = fsc[2 * rgw + 1];
            const f32x4* t = (const f32x4*)((const float*)(ws + WS_DEC + DEC_T2) + (size_t)rgw * DM) + lane; f32x4* o = (f32x4*)(out + O_YS + (size_t)rgw * DM) + lane;
#pragma unroll
            for (int j = 0; j < 4; ++j) { const f32x4 gg = *((const f32x4*)g + lane + 64 * j), bb = *((const f32x4*)b + lane + 64 * j); o[64 * j] = (t[64 * j] - mu) * rs * gg + bb; } }
    }
}

extern "C" void kernel_launch(void* const* d_in, const int* in_sizes, int n_in, void* d_out, int out_size, void* d_ws, size_t ws_size, hipStream_t stream) {
    static int grid = 0;
    if (grid == 0) {
        if (n_in != 30 || out_size != (int)O_END || ws_size < WS_END) { fprintf(stderr, "kernel_launch: unexpected problem (n_in %d, out %d, ws %zu); nothing launched\n", n_in, out_size, ws_size); grid = -1; return; }
        int dev = 0, cus = 0, per_cu = 0;
        if (hipGetDevice(&dev) != hipSuccess || hipDeviceGetAttribute(&cus, hipDeviceAttributeMultiprocessorCount, dev) != hipSuccess) { fprintf(stderr, "kernel_launch: device query failed\n"); grid = -1; return; }
        if (hipFuncSetAttribute((const void*)mega_fwd, hipFuncAttributeMaxDynamicSharedMemorySize, LDS_BYTES) != hipSuccess) { fprintf(stderr, "kernel_launch: hipFuncSetAttribute failed\n"); grid = -1; return; }
        if (hipOccupancyMaxActiveBlocksPerMultiprocessor(&per_cu, (const void*)mega_fwd, NWAVES * 64, LDS_BYTES) != hipSuccess || per_cu < 1) fprintf(stderr, "kernel_launch: occupancy query reports %d\n", per_cu);
        (void)hipGetLastError();
        if (cus < 256) { fprintf(stderr, "kernel_launch: needs 256 CUs (found %d)\n", cus); grid = -1; return; }
        grid = 256;
    }
    if (grid < 0) return;
    if (hipMemsetAsync((char*)d_ws + WS_CTL, 0, CTL_ZERO_BYTES, stream) != hipSuccess) { fprintf(stderr, "kernel_launch: memset failed\n"); return; }
    Args a{};
    for (int i = 0; i < 30; ++i) a.in[i] = (const float*)d_in[i];
    a.out = (float*)d_out; a.ws = (unsigned char*)d_ws;
    hipLaunchKernelGGL(mega_fwd, dim3(grid), dim3(NWAVES * 64), LDS_BYTES, stream, a);
    const hipError_t le = hipPeekAtLastError();
    if (le != hipSuccess) fprintf(stderr, "kernel_launch: launch failed: %s\n", hipGetErrorName(le));
}
```

```cpp
#include <hip/hip_runtime.h>
#include <cstdio>
#include <cstdint>
#include <cmath>
namespace pg8 {
#define PG8_LAS __attribute__((address_space(3)))
typedef unsigned short bf16_t;
typedef short bf16x8 __attribute__((ext_vector_type(8)));
typedef float f32x4 __attribute__((ext_vector_type(4)));
typedef unsigned u32x4 __attribute__((ext_vector_type(4)));
constexpr int BM = 256, BK = 64, HALF = 128, HTB = HALF * BK * 2  , STAGE_BYTES = 8 * HTB, NXCD = 8, WGM = 8;

__host__ __device__ __forceinline__ int lds_byte(int r, int c) { const int st = (r >> 4) * 2 + (c >> 5), rr = r & 15, cc = c & 31, ob = rr * 64 + cc * 2; return st * 1024 + (ob ^ (((ob >> 9) & 1) << 5)); }
__host__ __device__ __forceinline__ void stage_rc(int b, int& R, int& C) { const int st = b / 1024, sb = b % 1024, swz = sb ^ (((sb >> 9) & 1) << 5); R = (st >> 1) * 16 + swz / 64; C = (st & 1) * 32 + (swz % 64) / 2; }
__host__ __device__ __forceinline__ int perm32(int rho) { const int n = rho >> 4, i = rho & 15; return 8 * (i >> 2) + 4 * n + (i & 3); }

struct Unit { int pm, pn; };
struct Gemm { const bf16_t* A; const bf16_t* Bt; int M, N, K; };

struct StaticOrder {
    int nM, nN, nwg, G, c;
    __host__ __device__ void init(int M, int N, int G_, int c_) { nM = M / BM; nN = N / BM; nwg = nM * nN; G = G_; c = c_; }
    __host__ __device__ bool next(int i, Unit& u) const {
        const long L = (long)i * G + c; if (L >= nwg) return false;
        int wgid = (int)L; { const int q = nwg / NXCD, r = nwg % NXCD, xcd = wgid % NXCD, off = wgid / NXCD; wgid = (xcd < r ? xcd * (q + 1) : r * (q + 1) + (xcd - r) * q) + off; }
        const int nig = WGM * nN, gid = wgid / nig, fm = gid * WGM, gsz = (nM - fm) < WGM ? (nM - fm) : WGM;
        u.pm = fm + ((wgid % nig) % gsz); u.pn = (wgid % nig) / gsz; return true;
    }
    __device__ __forceinline__ void a_ready(const Unit&) const {}
    __device__ __forceinline__ void done(const Unit&) const {}
};

__device__ __forceinline__ unsigned cvt_pk_bf16(float lo, float hi) { unsigned r; asm volatile("v_cvt_pk_bf16_f32 %0, %1, %2" : "=v"(r) : "v"(lo), "v"(hi)); return r; }
typedef float f32x2 __attribute__((ext_vector_type(2)));
constexpr size_t WSO_C1IN = 1u << 20, WSO_C2IN = WSO_C1IN + 4 * 3584 * 4, WSO_C1UP = WSO_C2IN + 4 * 3584 * 4, WSO_C2UP = WSO_C1UP + 4 * 4096 * 4, WSO_ROPE = 3u << 20, WSO_STAT1 = 8u << 20, WSO_STAT2 = 9u << 20;
constexpr size_t WSO_XB2 = 132ull << 20, WSO_XB1 = 164ull << 20, WSO_T1 = 196ull << 20, WSO_T2 = 260ull << 20, WSO_QB = 324ull << 20, WSO_KB = 340ull << 20, WSO_VB = 356ull << 20, WSO_PR = 372ull << 20, WSO_H = 580ull << 20;
constexpr size_t OO_SHP = 16809984, OO_KP = 21405696, OO_VP = 29794304;
__device__ __forceinline__ void row_stats(const float* stat, int row, float& mu, float& rs) {
    const f32x4 a = *(const f32x4*)(stat + (size_t)row * 8), b = *(const f32x4*)(stat + (size_t)row * 8 + 4);
    const float s = (a[0] + a[2]) + (b[0] + b[2]), q = (a[1] + a[3]) + (b[1] + b[3]);
    mu = s * (1.f / 1024.f); const float var = fmaxf(q * (1.f / 1024.f) - mu * mu, 0.f); rs = 1.0f / sqrtf(var + 1e-5f);
}
typedef float f32x2e __attribute__((ext_vector_type(2)));
typedef unsigned u32x2e __attribute__((ext_vector_type(2)));
constexpr int ETAB_OFF = 132096, ETAB_SLOT = 4096;
constexpr int ETAB_IDS = ETAB_OFF + 4 * ETAB_SLOT;
template <class Sched> __device__ __forceinline__ void etab_fill(PG8_LAS unsigned char* lds0, const Sched& S, const float* stat, const float* c1, const float* c2, bool fold, int tid) {
#pragma unroll 1
    for (int i = 0; i < 4; ++i) { Unit u; const bool ok = S.next(i, u);
        if (tid == 0) { ((PG8_LAS int*)(lds0 + ETAB_IDS))[2 * i] = ok ? u.pm : -1; ((PG8_LAS int*)(lds0 + ETAB_IDS))[2 * i + 1] = ok ? u.pn : -1; }
        if (!ok) continue;
        PG8_LAS unsigned char* slot = lds0 + ETAB_OFF + i * ETAB_SLOT;
        if (tid < 256) { float mu = 0.f, rs = 1.f; if (fold) row_stats(stat, u.pm * BM + tid, mu, rs); ((PG8_LAS f32x2e*)slot)[tid] = (f32x2e){mu, rs}; }
        else { const int c = u.pn * BM + tid - 256; ((PG8_LAS float*)(slot + 2048))[tid - 256] = fold ? c1[c] : 0.f; ((PG8_LAS float*)(slot + 3072))[tid - 256] = fold ? c2[c] : 0.f; }
    }
}
__device__ __forceinline__ const PG8_LAS unsigned char* etab_find(const PG8_LAS unsigned char* lds0, const Unit& u) {
    const PG8_LAS int* ids = (const PG8_LAS int*)(lds0 + ETAB_IDS); int s = 0;
#pragma unroll
    for (int i = 1; i < 4; ++i) if (ids[2 * i] == u.pm && ids[2 * i + 1] == u.pn) s = i;
    return lds0 + ETAB_OFF + s * ETAB_SLOT;
}
struct EpiIn {
    static constexpr bool PERM = true, AFTER_DRAIN = false;
    unsigned char* ws; float* out; int l; const PG8_LAS unsigned char* lds0;
    __device__ __forceinline__ void operator()(const f32x4 (&acc)[2][2][4][2], const Unit& u, int wr, int wc, int fr, int fq) const {
        asm volatile("" ::: "memory"); __builtin_amdgcn_sched_barrier(0);
        const PG8_LAS unsigned char* slot = etab_find(lds0, u);
        const PG8_LAS f32x2e* st = (const PG8_LAS f32x2e*)slot; const PG8_LAS float* tc1 = (const PG8_LAS float*)(slot + 2048); const PG8_LAS float* tc2 = (const PG8_LAS float*)(slot + 3072);
        bf16_t* QB = (bf16_t*)(ws + WSO_QB); bf16_t* KB = (bf16_t*)(ws + WSO_KB); bf16_t* VB = (bf16_t*)(ws + WSO_VB); bf16_t* PR = (bf16_t*)(ws + WSO_PR); const float* rope = (const float*)(ws + WSO_ROPE);
        float* outk = out + OO_KP + (size_t)l * 2 * 2048 * 512; float* outv = out + OO_VP + (size_t)l * 2 * 2048 * 512; const float qscale = 0.125f * 1.4426950408889634f;
        const int cb = u.pn * BM + wc * 32 + 8 * fq;
        const int i0 = 16 * (wc & 1) + 4 * fq; const bool roped = u.pn < 4;
        const int rbase = u.pm * BM + wr * 64 + fr;
        const int cl = wc * 32 + 8 * fq;
#pragma unroll
        for (int bj = 0; bj < 2; ++bj) {
            f32x4 c1v[2], c2v[2];
#pragma unroll
            for (int n = 0; n < 2; ++n) { c1v[n] = *(const PG8_LAS f32x4*)(tc1 + cl + bj * HALF + n * 4); c2v[n] = *(const PG8_LAS f32x4*)(tc2 + cl + bj * HALF + n * 4); }
            f32x4 ran = {0.f, 0.f, 0.f, 0.f}, rbn = ran;
#pragma unroll
            for (int gq = 0; gq < 8; ++gq) {
                const int ai = gq >> 2, m = gq & 3;
                const int r = rbase + ai * HALF + m * 16;
                const f32x2e ms = st[ai * HALF + wr * 64 + m * 16 + fr]; const float mu = ms.x, rs = ms.y;
                if (gq == 0 && roped) { const float* rp = rope + ((size_t)(r & 8191) * 32 + i0) * 2; ran = *(const f32x4*)rp; rbn = *(const f32x4*)(rp + 4); }
                const f32x4 ra = ran, rb = rbn;
                if (roped && gq < 7) { const int rn = rbase + ((gq + 1) >> 2) * HALF + ((gq + 1) & 3) * 16; const float* rp = rope + ((size_t)(rn & 8191) * 32 + i0) * 2; ran = *(const f32x4*)rp; rbn = *(const f32x4*)(rp + 4); }
                asm volatile("" ::: "memory");
                f32x4 v[2];
#pragma unroll
                for (int n = 0; n < 2; ++n) v[n] = (acc[ai][bj][m][n] - mu * c1v[n]) * rs + c2v[n];
                const int pos = r & 8191, b = r >> 13;
                if (roped) {
                    const f32x4 cs = {ra[0], ra[2], rb[0], rb[2]}, sn = {ra[1], ra[3], rb[1], rb[3]};
                    const int head = (u.pn & 1) * 4 + bj * 2 + (wc >> 1);
                    f32x4 y1 = v[0] * cs - v[1] * sn, y2 = v[0] * sn + v[1] * cs;
                    const size_t o = (size_t)r * 512 + head * 64 + i0;
                    if (u.pn < 2) { y1 = y1 * qscale; y2 = y2 * qscale;
                        u32x2e w; w.x = cvt_pk_bf16(y1[0], y1[1]); w.y = cvt_pk_bf16(y1[2], y1[3]); *(u32x2e*)(QB + o) = w;
                        w.x = cvt_pk_bf16(y2[0], y2[1]); w.y = cvt_pk_bf16(y2[2], y2[3]); *(u32x2e*)(QB + o + 32) = w;
                    } else {
                        u32x2e w; w.x = cvt_pk_bf16(y1[0], y1[1]); w.y = cvt_pk_bf16(y1[2], y1[3]); *(u32x2e*)(KB + o) = w;
                        w.x = cvt_pk_bf16(y2[0], y2[1]); w.y = cvt_pk_bf16(y2[2], y2[3]); *(u32x2e*)(KB + o + 32) = w;
                        if (pos >= 6144) { float* ok = outk + ((size_t)(b * 2048 + pos - 6144)) * 512 + head * 64 + i0; *(f32x4*)ok = y1; *(f32x4*)(ok + 32) = y2; }
                    }
                } else if (u.pn < 6) {
                    const int c = cb + bj * HALF - 1024;
                    u32x4 w; w.x = cvt_pk_bf16(v[0][0], v[0][1]); w.y = cvt_pk_bf16(v[0][2], v[0][3]); w.z = cvt_pk_bf16(v[1][0], v[1][1]); w.w = cvt_pk_bf16(v[1][2], v[1][3]); *(u32x4*)(VB + (size_t)r * 512 + c) = w;
                    if (pos >= 6144) { float* ov = outv + ((size_t)(b * 2048 + pos - 6144)) * 512 + c; *(f32x4*)ov = v[0]; *(f32x4*)(ov + 4) = v[1]; }
                } else {
                    const int c = cb + bj * HALF - 1536;
                    if (c < 1824) { u32x4 w; w.x = cvt_pk_bf16(v[0][0], v[0][1]); w.y = cvt_pk_bf16(v[0][2], v[0][3]); w.z = cvt_pk_bf16(v[1][0], v[1][1]); w.w = cvt_pk_bf16(v[1][2], v[1][3]); *(u32x4*)(PR + (size_t)r * 2048 + c) = w; }
                }
            }
        }
    }
};
template <bool IS_F> struct EpiRes {
    static constexpr bool PERM = true, AFTER_DRAIN = true;
    unsigned char* ws; const float* const* in; float* out; int l;
    __device__ __forceinline__ void fused(f32x4 (&acc)[2][2][4][2], const Unit& u, int wr, int wc, int fr, int fq, PG8_LAS unsigned char* lds, int wid, int lane) const {
        const int raw = (!IS_F && l == 0) ? 1 : 0;
        const bf16_t* src = (const bf16_t*)(ws + (IS_F ? WSO_XB1 : WSO_XB2));
        const float* sstat = (const float*)(ws + (IS_F ? WSO_STAT1 : WSO_STAT2));
        const float* g = IS_F ? in[24] + (size_t)l * 1024 : in[28] + (size_t)(l > 0 ? l - 1 : 0) * 1024; const float* b = IS_F ? in[25] + (size_t)l * 1024 : in[29] + (size_t)(l > 0 ? l - 1 : 0) * 1024;
        bf16_t* XB = (bf16_t*)(ws + (IS_F ? WSO_XB2 : WSO_XB1)); float* ostat = (float*)(ws + (IS_F ? WSO_STAT2 : WSO_STAT1));
        float* shiftout = (IS_F || raw) ? nullptr : out + OO_SHP + (size_t)l * 2 * 1024; const float alpha = 1.6817928305074290f;
        PG8_LAS f32x2e* P = (PG8_LAS f32x2e*)lds;
        const int cb = u.pn * BM + wc * 32 + 8 * fq;
        const int rbase = u.pm * BM + wr * 64 + fr;
        u32x4 cur[2], nxt[2]; f32x4 sa = {0.f, 0.f, 0.f, 0.f}, sb = sa, san = sa, sbn = sa;
#pragma unroll
        for (int bj = 0; bj < 2; ++bj) { cur[bj] = *(const u32x4*)(src + (size_t)rbase * 1024 + cb + bj * HALF); nxt[bj] = cur[bj]; }
        if (!raw) { sa = *(const f32x4*)(sstat + (size_t)rbase * 8); sb = *(const f32x4*)(sstat + (size_t)rbase * 8 + 4); }
#pragma unroll
        for (int gq = 0; gq < 8; ++gq) {
            const int ai = gq >> 2, m = gq & 3;
            const int r = rbase + ai * HALF + m * 16;
            if (gq < 7) { const int rn = rbase + ((gq + 1) >> 2) * HALF + ((gq + 1) & 3) * 16;
#pragma unroll
                for (int bj = 0; bj < 2; ++bj) nxt[bj] = *(const u32x4*)(src + (size_t)rn * 1024 + cb + bj * HALF);
                if (!raw) { san = *(const f32x4*)(sstat + (size_t)rn * 8); sbn = *(const f32x4*)(sstat + (size_t)rn * 8 + 4); } }
            asm volatile("" ::: "memory");
            float mu = 0.f, rs = 1.f;
            if (!raw) { const float ssum = (sa[0] + sa[2]) + (sb[0] + sb[2]), qsum = (sa[1] + sa[3]) + (sb[1] + sb[3]); mu = ssum * (1.f / 1024.f); rs = 1.0f / sqrtf(fmaxf(qsum * (1.f / 1024.f) - mu * mu, 0.f) + 1e-5f); }
            float s = 0.f, q = 0.f;
#pragma unroll
            for (int bj = 0; bj < 2; ++bj) { const int c = cb + bj * HALF; const size_t off = (size_t)r * 1024 + c; const u32x4 cw = cur[bj]; u32x4 wout;
#pragma unroll
                for (int n = 0; n < 2; ++n) {
                    const f32x4 gvv = raw ? (f32x4){1.f, 1.f, 1.f, 1.f} : *(const f32x4*)(g + c + 4 * n), bvv = raw ? (f32x4){0.f, 0.f, 0.f, 0.f} : *(const f32x4*)(b + c + 4 * n);
                    const unsigned w0 = n ? cw.z : cw.x, w1 = n ? cw.w : cw.y;
                    const f32x4 cf = {__builtin_bit_cast(float, w0 << 16), __builtin_bit_cast(float, w0 & 0xffff0000u), __builtin_bit_cast(float, w1 << 16), __builtin_bit_cast(float, w1 & 0xffff0000u)};
                    const f32x4 x = (cf - mu) * rs * gvv + bvv;
                    const f32x4 t = x * alpha + acc[ai][bj][m][n];
                    const unsigned p0 = cvt_pk_bf16(t[0], t[1]), p1 = cvt_pk_bf16(t[2], t[3]); if (n) { wout.z = p0; wout.w = p1; } else { wout.x = p0; wout.y = p1; }
                    s += (t[0] + t[1]) + (t[2] + t[3]); q += (t[0] * t[0] + t[1] * t[1]) + (t[2] * t[2] + t[3] * t[3]);
                    if (shiftout && (r & 8191) == 8191) *(f32x4*)(shiftout + (size_t)(r >> 13) * 1024 + c + 4 * n) = x; }
                *(u32x4*)(XB + off) = wout; }
            s += __shfl_xor(s, 16); s += __shfl_xor(s, 32); q += __shfl_xor(q, 16); q += __shfl_xor(q, 32);
            if (fq == 0) P[(ai * HALF + wr * 64 + m * 16 + fr) * 4 + wc] = (f32x2e){s, q};
#pragma unroll
            for (int bj = 0; bj < 2; ++bj) cur[bj] = nxt[bj];
            sa = san; sb = sbn;
        }
        asm volatile("s_waitcnt lgkmcnt(0)" ::: "memory"); __builtin_amdgcn_s_barrier(); asm volatile("" ::: "memory");
        if (threadIdx.x < 256) { const int row = threadIdx.x; const f32x2e a = P[row * 4 + 0], b2 = P[row * 4 + 1], c = P[row * 4 + 2], d = P[row * 4 + 3];
            *(f32x2e*)(ostat + (size_t)(u.pm * BM + row) * 8 + u.pn * 2) = (f32x2e){(a.x + b2.x) + (c.x + d.x), (a.y + b2.y) + (c.y + d.y)}; }
        asm volatile("s_waitcnt lgkmcnt(0)" ::: "memory"); __builtin_amdgcn_s_barrier(); asm volatile("" ::: "memory");
    }
};
struct EpiUp {
    static constexpr bool PERM = true, AFTER_DRAIN = false;
    unsigned char* ws; const PG8_LAS unsigned char* lds0;
    __device__ __forceinline__ void operator()(const f32x4 (&acc)[2][2][4][2], const Unit& u, int wr, int wc, int fr, int fq) const {
        asm volatile("" ::: "memory"); __builtin_amdgcn_sched_barrier(0);
        bf16_t* H = (bf16_t*)(ws + WSO_H);
        const PG8_LAS unsigned char* slot = etab_find(lds0, u);
        const PG8_LAS f32x2e* st = (const PG8_LAS f32x2e*)slot; const PG8_LAS float* tc1 = (const PG8_LAS float*)(slot + 2048); const PG8_LAS float* tc2 = (const PG8_LAS float*)(slot + 3072);
        const int cb = u.pn * BM + wc * 32 + 8 * fq, cl = wc * 32 + 8 * fq;
#pragma unroll
        for (int bj = 0; bj < 2; ++bj) {
            f32x4 c1v[2], c2v[2];
#pragma unroll
            for (int n = 0; n < 2; ++n) { c1v[n] = *(const PG8_LAS f32x4*)(tc1 + cl + bj * HALF + 4 * n); c2v[n] = *(const PG8_LAS f32x4*)(tc2 + cl + bj * HALF + 4 * n); }
#pragma unroll
            for (int ai = 0; ai < 2; ++ai) {
#pragma unroll
                for (int m = 0; m < 4; ++m) {
                    const int rl = ai * HALF + wr * 64 + m * 16 + fr, r = u.pm * BM + rl;
                    const f32x2e ms = st[rl]; const float mu = ms.x, rs = ms.y;
                    f32x4 v0 = (acc[ai][bj][m][0] - mu * c1v[0]) * rs + c2v[0], v1 = (acc[ai][bj][m][1] - mu * c1v[1]) * rs + c2v[1];
#pragma unroll
                    for (int e = 0; e < 4; ++e) { const float a = fmaxf(v0[e], 0.f), b = fmaxf(v1[e], 0.f); v0[e] = a * a; v1[e] = b * b; }
                    u32x4 w; w.x = cvt_pk_bf16(v0[0], v0[1]); w.y = cvt_pk_bf16(v0[2], v0[3]); w.z = cvt_pk_bf16(v1[0], v1[1]); w.w = cvt_pk_bf16(v1[2], v1[3]);
                    *(u32x4*)(H + (size_t)r * 4096 + cb + bj * HALF) = w; }
            }
        }
    }
};
template <class Epi, class Sched, bool ALIGN_EPI = false, bool SP2 = false>
__device__ __forceinline__ void gemm_phase(PG8_LAS unsigned char* lds, const Gemm g, const Sched& S, const Epi& E, const int tid) {
    const int wid = __builtin_amdgcn_readfirstlane(tid >> 6), lane = tid & 63, wr = wid >> 2, wc = wid & 3, fr = lane & 15, fq = lane >> 4;
    const int K = g.K, nt = K / BK;
    unsigned voffA[2], voffB[2];
#pragma unroll
    for (int i = 0; i < 2; ++i) { int R, C; stage_rc(tid * 16 + i * 8192, R, C); const int Rb = Epi::PERM ? ((R & ~31) + perm32(R & 31)) : R;
        voffA[i] = (unsigned)(R * K + C) * 2u; voffB[i] = (unsigned)(Rb * K + C) * 2u; }
    const size_t kstep = (size_t)(BK * 2);
    const size_t hstep = (size_t)HALF * K * 2;
    const size_t tstep = 2 * hstep;
    const unsigned ldsw = (unsigned)wid * 1024u;
    const int aoff = lds_byte(wr * 64 + fr, fq * 8), boff = lds_byte(wc * 32 + fr, fq * 8);
#define PG8_SA(b, h) (((b) * 2 + (h)) * HTB)
#define PG8_SB(b, h) ((4 + (b) * 2 + (h)) * HTB)
#define PG8_STAGE(bufoff, gbase, voff) do { _Pragma("unroll") for (int _i = 0; _i < 2; ++_i) \
        __builtin_amdgcn_global_load_lds((const unsigned*)((const char*)(gbase) + (voff)[_i]), (PG8_LAS unsigned*)(lds + (bufoff) + ldsw + _i * 8192), 16, 0, 0); } while (0)
#define PG8_LDA(dst, b, h) do { _Pragma("unroll") for (int m = 0; m < 4; ++m) _Pragma("unroll") for (int k = 0; k < 2; ++k) dst[m][k] = *(const PG8_LAS bf16x8*)(lds + PG8_SA(b, h) + aoff + m * 2048 + k * 1024); } while (0)
#define PG8_LDB(dst, b, h) do { _Pragma("unroll") for (int n = 0; n < 2; ++n) _Pragma("unroll") for (int k = 0; k < 2; ++k) dst[n][k] = *(const PG8_LAS bf16x8*)(lds + PG8_SB(b, h) + boff + n * 2048 + k * 1024); } while (0)
#define PG8_MMA(ai, bj, At, Bt) do { __builtin_amdgcn_s_setprio(1); _Pragma("unroll") for (int m = 0; m < 4; ++m) _Pragma("unroll") for (int n = 0; n < 2; ++n) _Pragma("unroll") for (int k = 0; k < 2; ++k) \
        acc[ai][bj][m][n] = __builtin_amdgcn_mfma_f32_16x16x32_bf16(Bt[n][k], At[m][k], acc[ai][bj][m][n], 0, 0, 0); __builtin_amdgcn_s_setprio(0); } while (0)
#define PG8_WAIT_V(n) asm volatile("s_waitcnt vmcnt(" #n ")" ::: "memory")
#define PG8_WAIT_L(n) asm volatile("s_waitcnt lgkmcnt(" #n ")" ::: "memory")
#define PG8_BAR __builtin_amdgcn_s_barrier()
#define PG8_SCHED __builtin_amdgcn_sched_barrier(0)
    Unit cur, nxt; int ui = 0;
    if (!S.next(0, cur)) return;
    f32x4 acc[2][2][4][2];
#pragma unroll
    for (int a = 0; a < 2; ++a)
#pragma unroll
        for (int b = 0; b < 2; ++b)
#pragma unroll
            for (int m = 0; m < 4; ++m)
#pragma unroll
                for (int n = 0; n < 2; ++n) acc[a][b][m][n] = (f32x4){0.f, 0.f, 0.f, 0.f};
    bf16x8 At[4][2], B0[2][2], B1[2][2];
    const char* cA = (const char*)g.A + (size_t)cur.pm * tstep; const char* cB = (const char*)g.Bt + (size_t)cur.pn * tstep;
    S.a_ready(cur);
    if constexpr (SP2) {
        PG8_STAGE(PG8_SB(0, 0), cB, voffB); PG8_STAGE(PG8_SB(0, 1), cB + hstep, voffB); PG8_STAGE(PG8_SA(0, 0), cA, voffA); PG8_STAGE(PG8_SA(0, 1), cA + hstep, voffA);
        if (wr == 1) PG8_BAR;
        PG8_WAIT_V(2); PG8_BAR;
        PG8_STAGE(PG8_SB(1, 0), cB + kstep, voffB); PG8_STAGE(PG8_SA(1, 0), cA + kstep, voffA); PG8_STAGE(PG8_SB(1, 1), cB + hstep + kstep, voffB);
        PG8_WAIT_V(6); PG8_BAR;
    } else {
        PG8_STAGE(PG8_SB(0, 0), cB, voffB); PG8_STAGE(PG8_SA(0, 0), cA, voffA); PG8_STAGE(PG8_SB(0, 1), cB + hstep, voffB); PG8_STAGE(PG8_SA(0, 1), cA + hstep, voffA);
        if (wr == 1) PG8_BAR;
        PG8_WAIT_V(4); PG8_BAR;
        PG8_STAGE(PG8_SB(1, 0), cB + kstep, voffB); PG8_STAGE(PG8_SA(1, 0), cA + kstep, voffA); PG8_STAGE(PG8_SB(1, 1), cB + hstep + kstep, voffB);
        PG8_WAIT_V(6); PG8_BAR;
    }
    for (;;) {
        const bool has_next = S.next(ui + 1, nxt);
        const char* nA = has_next ? (const char*)g.A + (size_t)nxt.pm * tstep : cA; const char* nB = has_next ? (const char*)g.Bt + (size_t)nxt.pn * tstep : cB;
        for (int t = 0; t < nt; t += 2) {
            const bool last = (t == nt - 2);
            const char* a1 = cA + (size_t)(t + 1) * kstep;
            const char* a2 = last ? nA : cA + (size_t)(t + 2) * kstep; const char* b2 = last ? nB : cB + (size_t)(t + 2) * kstep;
            const char* a3 = a2 + kstep; const char* b3 = b2 + kstep;
            if (last && has_next) S.a_ready(nxt);
            if constexpr (SP2) {
            PG8_LDB(B0, 0, 0); PG8_LDB(B1, 0, 1); PG8_SCHED; PG8_LDA(At, 0, 0); PG8_STAGE(PG8_SA(1, 1), a1 + hstep, voffA);
            PG8_WAIT_V(8); PG8_WAIT_L(0); PG8_BAR; PG8_MMA(0, 0, At, B0); PG8_MMA(0, 1, At, B1); PG8_BAR; PG8_SCHED;
            PG8_LDA(At, 0, 1); PG8_STAGE(PG8_SB(0, 0), b2, voffB); PG8_STAGE(PG8_SB(0, 1), b2 + hstep, voffB); PG8_STAGE(PG8_SA(0, 0), a2, voffA);
            PG8_WAIT_V(8); PG8_WAIT_L(0); PG8_BAR; PG8_MMA(1, 0, At, B0); PG8_MMA(1, 1, At, B1); PG8_BAR; PG8_SCHED;
            PG8_LDB(B0, 1, 0); PG8_LDB(B1, 1, 1); PG8_SCHED; PG8_LDA(At, 1, 0); PG8_STAGE(PG8_SA(0, 1), a2 + hstep, voffA);
            PG8_WAIT_V(8); PG8_WAIT_L(0); PG8_BAR; PG8_MMA(0, 0, At, B0); PG8_MMA(0, 1, At, B1); PG8_BAR; PG8_SCHED;
            PG8_LDA(At, 1, 1); PG8_STAGE(PG8_SB(1, 0), b3, voffB); PG8_STAGE(PG8_SB(1, 1), b3 + hstep, voffB); PG8_STAGE(PG8_SA(1, 0), a3, voffA);
            PG8_WAIT_V(8); PG8_WAIT_L(0); PG8_BAR; PG8_MMA(1, 0, At, B0); PG8_MMA(1, 1, At, B1); PG8_BAR; PG8_SCHED;
            } else {
            PG8_LDB(B0, 0, 0); PG8_SCHED; PG8_LDA(At, 0, 0); PG8_STAGE(PG8_SA(1, 1), a1 + hstep, voffA);
            PG8_WAIT_L(8); PG8_BAR; PG8_WAIT_L(0); PG8_MMA(0, 0, At, B0); PG8_BAR; PG8_SCHED;
            PG8_LDB(B1, 0, 1); PG8_STAGE(PG8_SB(0, 0), b2, voffB);
            PG8_BAR; PG8_WAIT_L(0); PG8_MMA(0, 1, At, B1); PG8_BAR;
            PG8_LDA(At, 0, 1); PG8_STAGE(PG8_SA(0, 0), a2, voffA);
            PG8_BAR; PG8_WAIT_L(0); PG8_MMA(1, 0, At, B0); PG8_BAR; PG8_SCHED;
            PG8_STAGE(PG8_SB(0, 1), b2 + hstep, voffB);
            PG8_WAIT_V(6); PG8_BAR; PG8_MMA(1, 1, At, B1); PG8_BAR;
            PG8_LDB(B0, 1, 0); PG8_SCHED; PG8_LDA(At, 1, 0); PG8_STAGE(PG8_SA(0, 1), a2 + hstep, voffA);
            PG8_WAIT_L(8); PG8_BAR; PG8_WAIT_L(0); PG8_MMA(0, 0, At, B0); PG8_BAR; PG8_SCHED;
            PG8_LDB(B1, 1, 1); PG8_STAGE(PG8_SB(1, 0), b3, voffB);
            PG8_BAR; PG8_WAIT_L(0); PG8_MMA(0, 1, At, B1); PG8_BAR;
            PG8_LDA(At, 1, 1); PG8_STAGE(PG8_SA(1, 0), a3, voffA);
            PG8_BAR; PG8_WAIT_L(0); PG8_MMA(1, 0, At, B0); PG8_BAR; PG8_SCHED;
            PG8_STAGE(PG8_SB(1, 1), b3 + hstep, voffB);
            PG8_WAIT_V(6); PG8_BAR; PG8_MMA(1, 1, At, B1); PG8_BAR;
            }
        }
        if constexpr (ALIGN_EPI) { if (wr == 0) PG8_BAR; }
        if constexpr (!Epi::AFTER_DRAIN) { E(acc, cur, wr, wc, fr, fq); S.done(cur); }
        if (!has_next) break;
#pragma unroll
        for (int a = 0; a < 2; ++a)
#pragma unroll
            for (int b = 0; b < 2; ++b)
#pragma unroll
                for (int m = 0; m < 4; ++m)
#pragma unroll
                    for (int n = 0; n < 2; ++n) acc[a][b][m][n] = (f32x4){0.f, 0.f, 0.f, 0.f};
        cur = nxt; cA = nA; cB = nB; ++ui;
        if constexpr (ALIGN_EPI) { if (wr == 1) PG8_BAR; }
    }
    PG8_WAIT_V(0);
    if constexpr (!ALIGN_EPI) { if (wr == 0) PG8_BAR; }
    PG8_BAR;
    if constexpr (Epi::AFTER_DRAIN) { E.fused(acc, cur, wr, wc, fr, fq, lds, wid, lane); S.done(cur); }
#undef PG8_SA
#undef PG8_SB
#undef PG8_STAGE
#undef PG8_LDA
#undef PG8_LDB
#undef PG8_MMA
#undef PG8_WAIT_V
#undef PG8_WAIT_L
#undef PG8_BAR
#undef PG8_SCHED
}
}
constexpr int NWAVES = 8;
constexpr int M = 16384, TSEQ = 8192, DM = 1024, FFD = 4096, DEPTH = 4, MD = 32, NH = 8, HD = 64;
constexpr int NIN = 3584;
constexpr int RW0 = 1536;
constexpr int PRP = 2048;
constexpr int NRWU = 1856;
constexpr int CH = 16, NCH = TSEQ / CH;
constexpr int NUNIT = 2 * NH * NCH;
constexpr float LN_EPS = 1e-5f, GN_EPS = 64e-5f, RMS_EPS = 1e-6f;
constexpr float ALPHA = 1.6817928305074290f;
constexpr float QSCALE = 0.125f * 1.4426950408889634f;
constexpr size_t O_Y = 0, O_YS = 16777216, O_SHP = 16809984, O_SHS = 16818176, O_WKP = 16949248, O_WKS = 17211392,
                 O_KP = 21405696, O_VP = 29794304, O_KS = 38182912, O_VS = 38248448, O_END = 38313984;
constexpr size_t MiB = 1u << 20;
constexpr size_t WS_CTL = 0, CTL_ZERO_BYTES = 1 * MiB;
constexpr size_t WS_C1IN = 1 * MiB;
constexpr size_t WS_C2IN = WS_C1IN + 4 * NIN * 4;
constexpr size_t WS_C1UP = WS_C2IN + 4 * NIN * 4;
constexpr size_t WS_C2UP = WS_C1UP + 4 * FFD * 4;
constexpr size_t WS_DUPT = WS_C2UP + 4 * FFD * 4;
constexpr size_t WS_IUPT = WS_DUPT + 4 * 512 * 64 * 2;
constexpr size_t WS_GUPT = WS_IUPT + 4 * 512 * 64 * 2;
constexpr size_t WS_VUPT = WS_GUPT + 4 * 512 * 128 * 2;
constexpr size_t WS_SMALL_END = WS_VUPT + 3 * 512 * 32 * 2;
static_assert(WS_SMALL_END <= 3 * MiB, "small region");
constexpr size_t WS_ROPE = 3 * MiB;
constexpr size_t WS_DEC = 6 * MiB;
constexpr size_t WS_STAT1 = 8 * MiB, WS_STAT2 = 9 * MiB;
constexpr size_t WS_BON = 10 * MiB;
constexpr size_t WS_LSE = 11 * MiB;
constexpr size_t WS_GC = 13 * MiB;
constexpr size_t WS_WIN = 16 * MiB;
constexpr size_t WS_WINU = 44 * MiB;
constexpr size_t WS_WOUT = 60 * MiB;
constexpr size_t WS_WUP = 68 * MiB;
constexpr size_t WS_WDN = 100 * MiB;
constexpr size_t WS_XB2 = 132 * MiB;
constexpr size_t WS_XB1 = 164 * MiB;
constexpr size_t WS_T1 = 196 * MiB;
constexpr size_t WS_T2 = 260 * MiB;
constexpr size_t WS_QB = 324 * MiB, WS_KB = 340 * MiB, WS_VB = 356 * MiB;
constexpr size_t WS_PR = 372 * MiB;
constexpr size_t WS_OP = 436 * MiB;
constexpr size_t WS_MIX = 484 * MiB;
constexpr size_t WS_VF = 516 * MiB, WS_VV = 532 * MiB;
constexpr size_t WS_YPRE = 548 * MiB;
constexpr size_t WS_H = 580 * MiB;
constexpr size_t WS_PT = 580 * MiB;
constexpr size_t WS_QT = 644 * MiB;
constexpr size_t WS_REFF = 708 * MiB;
constexpr size_t WS_YLOC = 724 * MiB;
constexpr size_t WS_SEGQ = 756 * MiB, WS_SEGP = 760 * MiB;
constexpr size_t WS_CSUM = 764 * MiB;
constexpr size_t WS_CSUP = 766 * MiB;
constexpr size_t WS_END = 768 * MiB;
static_assert(WS_H + (size_t)M * FFD * 2 <= WS_END + 0 * MiB || true, "");
constexpr size_t DEC_XB2 = 0;
constexpr size_t DEC_XB1 = 64 * 1024;
constexpr size_t DEC_SHB = 128 * 1024;
constexpr size_t DEC_MIXB = 384 * 1024;
constexpr size_t DEC_HB = 448 * 1024;
constexpr size_t DEC_T1 = 704 * 1024;
constexpr size_t DEC_T2 = 832 * 1024;
constexpr size_t DEC_PD = 960 * 1024;
constexpr size_t DEC_PS = 1408 * 1024;
constexpr size_t DEC_OP = 1640 * 1024;
constexpr size_t DEC_LSE = 1832 * 1024;
constexpr size_t DEC_MIX = 1836 * 1024;
constexpr size_t DEC_ST1 = 1964 * 1024;
constexpr size_t DEC_ST2 = 1972 * 1024;
constexpr size_t DEC_VF = 1980 * 1024;
static_assert(DEC_VF + 32 * 512 * 4 <= 2 * MiB, "decode scratch");
constexpr int CW_BAR = 4096;
constexpr int RING_BYTES = 131072;
constexpr int MISC_OFF = RING_BYTES + 320;
constexpr int LDS_BYTES = 163840;
static_assert(pg8::WSO_C1IN == WS_C1IN && pg8::WSO_C2IN == WS_C2IN && pg8::WSO_C1UP == WS_C1UP && pg8::WSO_C2UP == WS_C2UP && pg8::WSO_ROPE == WS_ROPE && pg8::WSO_STAT1 == WS_STAT1 && pg8::WSO_STAT2 == WS_STAT2 &&
              pg8::WSO_XB2 == WS_XB2 && pg8::WSO_XB1 == WS_XB1 && pg8::WSO_T1 == WS_T1 && pg8::WSO_T2 == WS_T2 && pg8::WSO_QB == WS_QB && pg8::WSO_KB == WS_KB && pg8::WSO_VB == WS_VB && pg8::WSO_PR == WS_PR && pg8::WSO_H == WS_H &&
              pg8::OO_SHP == O_SHP && pg8::OO_KP == O_KP && pg8::OO_VP == O_VP, "epilogue offset mirrors");
#define GAS __attribute__((address_space(1)))
#define LAS __attribute__((address_space(3)))
typedef unsigned short bf16;
typedef unsigned v4u __attribute__((ext_vector_type(4)));
typedef unsigned v2u __attribute__((ext_vector_type(2)));
typedef float f32x4 __attribute__((ext_vector_type(4)));
typedef float f32x2 __attribute__((ext_vector_type(2)));
typedef float f32x16 __attribute__((ext_vector_type(16)));
typedef short bf16x8 __attribute__((ext_vector_type(8)));
typedef short s16x4 __attribute__((ext_vector_type(4)));
typedef GAS unsigned gu32;
#define RLX_AGENT __ATOMIC_RELAXED, __HIP_MEMORY_SCOPE_AGENT
#define LDS_WAIT() asm volatile("s_waitcnt lgkmcnt(0)" ::: "memory")
#define VM_WAIT() asm volatile("s_waitcnt vmcnt(0)" ::: "memory")
#define DI __device__ __forceinline__
DI unsigned f2bf(float f) { unsigned u = __builtin_bit_cast(unsigned, f); return (u + 0x7fffu + ((u >> 16) & 1u)) >> 16; }
DI float bf2f(unsigned b) { return __builtin_bit_cast(float, b << 16); }
DI float bflo(unsigned w) { return __builtin_bit_cast(float, w << 16); }
DI float bfhi(unsigned w) { return __builtin_bit_cast(float, w & 0xffff0000u); }
typedef __bf16 bf16x2_t __attribute__((ext_vector_type(2)));
DI unsigned pk2(float lo, float hi) { const f32x2 v = {lo, hi}; const bf16x2_t b = __builtin_convertvector(v, bf16x2_t); return __builtin_bit_cast(unsigned, b); }
DI unsigned pk2z(float x) { return pk2(x, 0.f) & 0xffffu; }
DI float rbf(float x) { return bf2f(f2bf(x)); }
DI bf16x8 pk8(float a0, float a1, float a2, float a3, float a4, float a5, float a6, float a7) {
    v4u w; w.x = pk2(a0, a1); w.y = pk2(a2, a3); w.z = pk2(a4, a5); w.w = pk2(a6, a7); return __builtin_bit_cast(bf16x8, w); }
DI bf16x8 pk8v(f32x4 a, f32x4 b) { return pk8(a[0], a[1], a[2], a[3], b[0], b[1], b[2], b[3]); }
DI bf16x8 pk4z(f32x4 a) { v4u w; w.x = pk2(a[0], a[1]); w.y = pk2(a[2], a[3]); w.z = 0u; w.w = 0u; return __builtin_bit_cast(bf16x8, w); }
DI bf16x8 ld8(const void* p) { return *(const bf16x8*)p; }
DI bf16x8 ld8nt(const void* p) { return __builtin_nontemporal_load((const bf16x8*)p); }
DI v4u ldv4nt(const void* p) { return __builtin_nontemporal_load((const v4u*)p); }
DI f32x4 ldf4nt(const void* p) { return __builtin_nontemporal_load((const f32x4*)p); }
DI bf16x8 ld4z(const void* p) { v2u t = *(const v2u*)p; v4u w; w.x = t.x; w.y = t.y; w.z = 0u; w.w = 0u; return __builtin_bit_cast(bf16x8, w); }
DI f32x4 mfma16(bf16x8 a, bf16x8 b, f32x4 c) { return __builtin_amdgcn_mfma_f32_16x16x32_bf16(a, b, c, 0, 0, 0); }
DI f32x16 mfma32(bf16x8 a, bf16x8 b, f32x16 c) { return __builtin_amdgcn_mfma_f32_32x32x16_bf16(a, b, c, 0, 0, 0); }
DI int crow(int r, int hi) { return (r & 3) + 8 * (r >> 2) + 4 * hi; }
DI float wave_sum(float v) {
#pragma unroll
    for (int o = 1; o < 64; o <<= 1) v += __shfl_xor(v, o);
    return v; }
DI float fexp(float x) { return __expf(x); }
DI float fsigmoid(float x) { return __builtin_amdgcn_rcpf(1.f + __expf(-x)); }
DI float ftanh(float x) { return 1.f - 2.f * __builtin_amdgcn_rcpf(__expf(2.f * x) + 1.f); }
DI float fsoftplus(float x) { return fmaxf(x, 0.f) + __logf(1.f + __expf(-fabsf(x))); }
DI int orig2lgcl(int o) { return (o & ~63) | (((o >> 4) & 1) << 5) | (((o >> 2) & 3) << 3) | (((o >> 5) & 1) << 2) | (o & 3); }
DI int lgcl2orig(int c) { return (c & ~63) | (((c >> 2) & 1) << 5) | (((c >> 5) & 1) << 4) | (((c >> 3) & 3) << 2) | (c & 3); }
#define XB_TMO      128
#define XB_XCNT(j)  (256  + 64 * (j))
#define XB_XSUB(j)  (1280 + 64 * (j))
#define XB_XGEN(j)  (2304 + 64 * (j))
#define XB_TOP      3328
#define XB_TOPGEN   3392
#define XCD_BAR_WORDS 3456
#define XB_SPIN_CAP (1u << 18)

__device__ __forceinline__ unsigned xb_ld(unsigned* p)              { return __hip_atomic_load(p, __ATOMIC_RELAXED, __HIP_MEMORY_SCOPE_AGENT); }
__device__ __forceinline__ unsigned xb_add(unsigned* p, unsigned v) { return __hip_atomic_fetch_add(p, v, __ATOMIC_RELAXED, __HIP_MEMORY_SCOPE_AGENT); }
__device__ __forceinline__ unsigned xb_xcc_id() { return (unsigned)__builtin_amdgcn_s_getreg((3 << 11) | 20) & 0xFu; }
#define XB_SPIN(cond, bar) do { unsigned _sp = 0; while (cond) { __builtin_amdgcn_s_sleep(1); \
    if ((++_sp & 255u) == 0u) { if (xb_ld(&(bar)[XB_TMO])) break; if (_sp > XB_SPIN_CAP) { atomicAdd(&(bar)[XB_TMO], 1u); break; } } } } while (0)

struct XcdBarrier {
    unsigned* bar; unsigned x;
    volatile LAS unsigned* st;
};

__device__ __forceinline__ XcdBarrier xcd_barrier_post(unsigned* bar, volatile LAS unsigned* st) {
    XcdBarrier b; b.bar = bar; b.x = xb_xcc_id(); b.st = st;
    if (threadIdx.x == 0) (void)xb_add(&bar[XB_XCNT(b.x)], 1u);
    return b;
}
__device__ __forceinline__ void xcd_barrier_complete(unsigned* bar, unsigned x, unsigned& nloc, unsigned& nx) {
    const unsigned G = gridDim.x * gridDim.y * gridDim.z;
    unsigned sum, cnt, mine, sp = 0u;
    for (;;) {
        sum = 0u; cnt = 0u; mine = 0u;
#pragma unroll
        for (unsigned j = 0; j < 16; ++j) { const unsigned c = xb_ld(&bar[XB_XCNT(j)]); sum += c; cnt += (c > 0u) ? 1u : 0u; mine = (j == x) ? c : mine; }
        if (sum == G) break;
        __builtin_amdgcn_s_sleep(1);
        if ((++sp & 255u) == 0u) { if (xb_ld(&bar[XB_TMO])) break; if (sp > XB_SPIN_CAP) { atomicAdd(&bar[XB_TMO], 1u); break; } }
    }
    nloc = mine > 0u ? mine : 1u; nx = cnt > 0u ? cnt : 1u;
}

__device__ __forceinline__ void xcd_barrier(const XcdBarrier& b) {
    asm volatile("s_waitcnt vmcnt(0)" ::: "memory");
    __syncthreads();
    if (threadIdx.x == 0) {
        unsigned* bar = b.bar;
        __builtin_amdgcn_s_waitcnt(0);
        unsigned nloc = b.st[0], nx = b.st[1];
        if (nloc == 0u) { xcd_barrier_complete(bar, b.x, nloc, nx); b.st[0] = nloc; b.st[1] = nx; }
        const unsigned old = xb_add(&bar[XB_XSUB(b.x)], 1u);
        const unsigned gen = old / nloc;
        if (old + 1u == (gen + 1u) * nloc) {
            __builtin_amdgcn_fence(__ATOMIC_RELEASE, "agent");
            asm volatile("s_waitcnt vmcnt(0)" ::: "memory");
            const unsigned og = xb_add(&bar[XB_TOP], 1u);
            const unsigned tg = og / nx;
            if (og + 1u == (tg + 1u) * nx) xb_add(&bar[XB_TOPGEN], 1u);
            else XB_SPIN(xb_ld(&bar[XB_TOPGEN]) == tg, bar);
            __builtin_amdgcn_fence(__ATOMIC_ACQUIRE, "agent");
            xb_add(&bar[XB_XGEN(b.x)], 1u);
            asm volatile("s_waitcnt vmcnt(0)" ::: "memory");
        } else {
            XB_SPIN(xb_ld(&bar[XB_XGEN(b.x)]) == gen, bar);
            __builtin_amdgcn_fence(__ATOMIC_ACQUIRE, "agent");
            asm volatile("s_waitcnt vmcnt(0)" ::: "memory");
        }
    }
    __syncthreads();
}
struct Args { const float* in[30]; float* out; unsigned char* ws; };
struct Frame {
    unsigned char* lds;
    volatile LAS unsigned* MISC;
    gu32* ctl;
    int tid, lane, wave, vcu, G, gw, NGW;
    const float* const* in; float* out; unsigned char* ws;
};
template <bool SWAP>
DI void p0_transpose_item(const float* W, int ldw, int K, int csrc0, bf16* WT, int row_off, const float* gsc, LAS float* scr, int kb, int nb, int lane, float* csum = nullptr, int ncs = 0, const float* bsh = nullptr) {
    const int k0 = 64 * kb, n0 = 32 * nb;
    f32x4 wv[8]; float gk = 1.f, bk = 0.f;
    const int lr = lane >> 3, lc = (lane & 7) * 4;
#pragma unroll
    for (int i = 0; i < 8; ++i) wv[i] = ldf4nt(W + (size_t)(k0 + 8 * i + lr) * ldw + csrc0 + n0 + lc);
    if (gsc) gk = gsc[k0 + lane]; if (bsh) bk = bsh[k0 + lane];
    f32x4 s1v = {0.f, 0.f, 0.f, 0.f}, s2v = s1v;
#pragma unroll
    for (int i = 0; i < 8; ++i) { const int kk = 8 * i + lr; f32x4 v = wv[i]; s2v = s2v + v * __shfl(bk, kk); v = v * __shfl(gk, kk);
#pragma unroll
        for (int e = 0; e < 4; ++e) { s1v[e] += rbf(v[e]); scr[kk * 33 + lc + e] = v[e]; } }
#pragma unroll
    for (int o = 8; o < 64; o <<= 1) {
#pragma unroll
        for (int e = 0; e < 4; ++e) { s1v[e] += __shfl_xor(s1v[e], o); s2v[e] += __shfl_xor(s2v[e], o); } }
    if (csum && lane < 8) {
#pragma unroll
        for (int e = 0; e < 4; ++e) { int dr = n0 + 4 * lane + e; if (SWAP) dr = orig2lgcl(dr); csum[(size_t)(kb * 2 + 0) * ncs + row_off + dr] = s1v[e]; csum[(size_t)(kb * 2 + 1) * ncs + row_off + dr] = s2v[e]; } }
    LDS_WAIT(); asm volatile("" ::: "memory");
    const int c = lane & 7;
#pragma unroll
    for (int j = 0; j < 4; ++j) { const int n = (lane >> 3) + 8 * j; const LAS float* s = scr + (8 * c) * 33 + n;
        v4u o; o.x = pk2(s[0 * 33], s[1 * 33]); o.y = pk2(s[2 * 33], s[3 * 33]); o.z = pk2(s[4 * 33], s[5 * 33]); o.w = pk2(s[6 * 33], s[7 * 33]);
        int dr = n0 + n; if (SWAP) dr = orig2lgcl(dr);
        *(v4u*)(WT + (size_t)(row_off + dr) * K + k0 + 8 * c) = o; }
    LDS_WAIT(); asm volatile("" ::: "memory");
}
DI void p0_prologue(Frame& F) {
    LAS float* scr = (LAS float*)((LAS unsigned char*)F.lds + F.wave * 16384);
    const float* const* in = F.in; unsigned char* ws = F.ws;
    constexpr int I_IN = 16 * 104, I_VR = 16, I_INU = 16 * 56, I_OUT = 16 * 32, I_UP = 16 * 128, I_DN = 64 * 32;
    constexpr int I_L = I_IN + I_VR + I_INU + I_VR + I_OUT + I_UP + I_DN;
    for (int it = F.gw; it < DEPTH * I_L; it += F.NGW) {
        const int l = it / I_L; int r = it % I_L;
        const float* g2p = l > 0 ? in[28] + (size_t)(l - 1) * DM : nullptr;
        bf16* win = (bf16*)(ws + WS_WIN) + (size_t)l * NIN * DM; bf16* winu = (bf16*)(ws + WS_WINU) + (size_t)l * NRWU * DM;
        if (r < I_IN) { const int kb = r / 104, nb = r % 104; const float* W = in[6] + (size_t)l * DM * 3328;
            float* cs = l > 0 ? (float*)(ws + WS_CSUM) + (size_t)l * 32 * NIN : nullptr; const float* b2p = l > 0 ? in[29] + (size_t)(l - 1) * DM : nullptr;
            if (nb < 32) p0_transpose_item<true>(W, 3328, DM, 0, win, 0, g2p, scr, kb, nb, F.lane, cs, NIN, b2p); else p0_transpose_item<false>(W, 3328, DM, 0, win, 0, g2p, scr, kb, nb, F.lane, cs, NIN, b2p); continue; } r -= I_IN;
        if (r < I_VR) { if (l > 0) p0_transpose_item<false>(in[7] + (size_t)(l - 1) * DM * 32, 32, DM, 0, win, 3328, g2p, scr, r, 0, F.lane, (float*)(ws + WS_CSUM) + (size_t)l * 32 * NIN, NIN, in[29] + (size_t)(l - 1) * DM); continue; } r -= I_VR;
        if (r < I_INU) { const int kb = r / 56, nb = r % 56; p0_transpose_item<false>(in[6] + (size_t)l * DM * 3328, 3328, DM, RW0, winu, 0, nullptr, scr, kb, nb, F.lane); continue; } r -= I_INU;
        if (r < I_VR) { if (l > 0) p0_transpose_item<false>(in[7] + (size_t)(l - 1) * DM * 32, 32, DM, 0, winu, 1792, nullptr, scr, r, 0, F.lane); continue; } r -= I_VR;
        if (r < I_OUT) { p0_transpose_item<false>(in[23] + (size_t)l * DM * DM, DM, DM, 0, (bf16*)(ws + WS_WOUT) + (size_t)l * DM * DM, 0, nullptr, scr, r / 32, r % 32, F.lane); continue; } r -= I_OUT;
        if (r < I_UP) { p0_transpose_item<false>(in[26] + (size_t)l * DM * FFD, FFD, DM, 0, (bf16*)(ws + WS_WUP) + (size_t)l * FFD * DM, 0, in[24] + (size_t)l * DM, scr, r / 128, r % 128, F.lane, (float*)(ws + WS_CSUP) + (size_t)l * 32 * FFD, FFD, in[25] + (size_t)l * DM); continue; } r -= I_UP;
        p0_transpose_item<false>(in[27] + (size_t)l * FFD * DM, DM, FFD, 0, (bf16*)(ws + WS_WDN) + (size_t)l * DM * FFD, 0, nullptr, scr, r / 32, r % 32, F.lane);
    }
    for (int m0 = F.gw; m0 < M; m0 += 4 * F.NGW) { f32x4 v[4][4];
#pragma unroll
        for (int q = 0; q < 4; ++q) { const f32x4* xr = (const f32x4*)(in[0] + (size_t)(m0 + q * F.NGW) * DM) + F.lane;
#pragma unroll
            for (int j = 0; j < 4; ++j) v[q][j] = ldf4nt(xr + 64 * j); }
#pragma unroll
        for (int q = 0; q < 4; ++q) { unsigned long long* o8 = (unsigned long long*)((bf16*)(ws + WS_XB2) + (size_t)(m0 + q * F.NGW) * DM) + F.lane;
#pragma unroll
            for (int j = 0; j < 4; ++j) o8[64 * j] = (unsigned long long)pk2(v[q][j].x, v[q][j].y) | ((unsigned long long)pk2(v[q][j].z, v[q][j].w) << 32); } }
    const int gt = F.gw * 64 + F.lane, NGT = F.NGW * 64;
    for (int e = gt; e < 8193 * 32; e += NGT) { const int pos = e >> 5, i = e & 31; const double ang = (double)pos * pow(10000.0, -(double)i / 32.0); ((f32x2*)(ws + WS_ROPE))[e] = (f32x2){(float)cos(ang), (float)sin(ang)}; }
    for (int e = gt; e < 4 * 512 * 64; e += NGT) { const int l = e / (512 * 64), n = (e / 64) % 512, m = e % 64; ((bf16*)(ws + WS_DUPT))[e] = (bf16)f2bf(in[11][((size_t)l * 64 + m) * 512 + n]); ((bf16*)(ws + WS_IUPT))[e] = (bf16)f2bf(in[13][((size_t)l * 64 + m) * 512 + n]); }
    for (int e = gt; e < 4 * 512 * 128; e += NGT) { const int l = e / (512 * 128), n = (e / 128) % 512, m = e % 128; ((bf16*)(ws + WS_GUPT))[e] = (bf16)f2bf(in[14][((size_t)l * 128 + m) * 512 + n]); }
    for (int e = gt; e < 3 * 512 * 32; e += NGT) { const int l = e / (512 * 32), n = (e / 32) % 512, m = e % 32; ((bf16*)(ws + WS_VUPT))[e] = (bf16)f2bf(in[16][((size_t)l * 32 + m) * 512 + n]); }
    for (int e = gt; e < 2 * DM; e += NGT) F.out[O_SHP + e] = in[0][((size_t)(e / DM) * TSEQ + TSEQ - 1) * DM + (e % DM)];
    for (int e = gt; e < MD * DM; e += NGT) { ((bf16*)(ws + WS_DEC + DEC_XB2))[e] = (bf16)f2bf(in[1][e]); }
    for (int e = gt; e < DEPTH * MD * DM; e += NGT) { ((bf16*)(ws + WS_DEC + DEC_SHB))[e] = (bf16)f2bf(in[2][e]); }
}
DI void colsum_finish(unsigned char* ws, int gt, int NGT) {
    for (int e = gt; e < 3 * NIN; e += NGT) { const int l = 1 + e / NIN, p = e % NIN; if (p >= 3360) continue; const float* cs = (const float*)(ws + WS_CSUM) + (size_t)l * 32 * NIN + p; float s1 = 0.f, s2 = 0.f;
#pragma unroll
        for (int kb = 0; kb < 16; ++kb) { s1 += cs[(size_t)(2 * kb) * NIN]; s2 += cs[(size_t)(2 * kb + 1) * NIN]; }
        ((float*)(ws + WS_C1IN))[l * NIN + p] = s1; ((float*)(ws + WS_C2IN))[l * NIN + p] = s2; }
    for (int e = gt; e < 4 * FFD; e += NGT) { const int l = e / FFD, p = e % FFD; const float* cs = (const float*)(ws + WS_CSUP) + (size_t)l * 32 * FFD + p; float s1 = 0.f, s2 = 0.f;
#pragma unroll
        for (int kb = 0; kb < 16; ++kb) { s1 += cs[(size_t)(2 * kb) * FFD]; s2 += cs[(size_t)(2 * kb + 1) * FFD]; }
        ((float*)(ws + WS_C1UP))[l * FFD + p] = s1; ((float*)(ws + WS_C2UP))[l * FFD + p] = s2; }
}
constexpr int VPITCH = 144;
constexpr int ATT_WLDS = 2 * 32 * VPITCH + 256;
DI void tr_read8(unsigned base, s16x4 (&t)[8]) {
    asm volatile("ds_read_b64_tr_b16 %0, %8\n\tds_read_b64_tr_b16 %1, %8 offset:%c9\n\tds_read_b64_tr_b16 %2, %8 offset:%c10\n\tds_read_b64_tr_b16 %3, %8 offset:%c11\n\t"
                 "ds_read_b64_tr_b16 %4, %8 offset:%c12\n\tds_read_b64_tr_b16 %5, %8 offset:%c13\n\tds_read_b64_tr_b16 %6, %8 offset:%c14\n\tds_read_b64_tr_b16 %7, %8 offset:%c15\n\ts_waitcnt lgkmcnt(0)"
                 : "=&v"(t[0]), "=&v"(t[1]), "=&v"(t[2]), "=&v"(t[3]), "=&v"(t[4]), "=&v"(t[5]), "=&v"(t[6]), "=&v"(t[7])
                 : "v"(base), "i"(8 * VPITCH), "i"(64), "i"(8 * VPITCH + 64), "i"(16 * VPITCH), "i"(24 * VPITCH), "i"(16 * VPITCH + 64), "i"(24 * VPITCH + 64) : "memory");
}
DI void attn_task(const bf16* QB, const bf16* KB, const bf16* VB, bf16* OP, float* LSE, int b, int h, int p, int cls, int qblk, LAS unsigned char* wl, int lane) {
    asm volatile("" : "+v"(lane));
    const int dd = 1 << (2 * p), r32 = lane & 31, hi = lane >> 5;
    const int m0 = 32 * qblk;
    const size_t rowb = (size_t)b * TSEQ;
    const size_t qrow = rowb + (size_t)(m0 + r32) * dd + cls;
    bf16x8 qf[4];
#pragma unroll
    for (int d0 = 0; d0 < 4; ++d0) qf[d0] = ld8(QB + qrow * 512 + h * 64 + d0 * 16 + hi * 8);
    f32x16 s[5];
    const int kt0 = (m0 >= 128) ? 0 : (128 - m0) / 32;
    const int krow8 = lane >> 3, kch = lane & 7;
    v4u kr[5][4];
#pragma unroll
    for (int kt = 0; kt < 5; ++kt)
#pragma unroll
        for (int i_ = 0; i_ < 4; ++i_) { const int mk = m0 - 128 + 32 * kt + 8 * i_ + krow8; const size_t krow = rowb + (size_t)(mk < 0 ? 0 : mk) * dd + cls;
            kr[kt][i_] = *(const v4u*)(KB + krow * 512 + h * 64 + kch * 8); }
#pragma unroll
    for (int kt = 0; kt < 5; ++kt) {
        LAS unsigned char* kb = wl + (kt & 1) * 32 * VPITCH;
#pragma unroll
        for (int i_ = 0; i_ < 4; ++i_) *(LAS v4u*)(kb + (8 * i_ + krow8) * VPITCH + kch * 16) = kr[kt][i_];
        LDS_WAIT();
        bf16x8 kf[4];
#pragma unroll
        for (int d0 = 0; d0 < 4; ++d0) kf[d0] = *(const LAS bf16x8*)(kb + r32 * VPITCH + d0 * 32 + hi * 16);
        f32x16 a; for (int i = 0; i < 16; ++i) a[i] = 0.f;
#pragma unroll
        for (int d0 = 0; d0 < 4; ++d0) a = mfma32(kf[d0], qf[d0], a);
        s[kt] = a;
    }
    LDS_WAIT();
#pragma unroll
    for (int kt = 0; kt < 5; ++kt) {
        if (kt < kt0) {
#pragma unroll
            for (int i = 0; i < 16; ++i) s[kt][i] = -INFINITY;
        } else if (kt == 0) {
#pragma unroll
            for (int i = 0; i < 16; ++i) s[kt][i] = (crow(i, hi) >= r32) ? s[kt][i] : -INFINITY;
        } else if (kt == 4) {
#pragma unroll
            for (int i = 0; i < 16; ++i) s[kt][i] = (crow(i, hi) <= r32) ? s[kt][i] : -INFINITY;
        }
    }
    float mx = -INFINITY;
#pragma unroll
    for (int kt = 0; kt < 5; ++kt)
#pragma unroll
        for (int i = 0; i < 16; ++i) mx = fmaxf(mx, s[kt][i]);
    mx = fmaxf(mx, __shfl_xor(mx, 32));
    float lsum = 0.f;
#pragma unroll
    for (int kt = 0; kt < 5; ++kt)
#pragma unroll
        for (int i = 0; i < 16; ++i) { const float e = __builtin_amdgcn_exp2f(s[kt][i] - mx); s[kt][i] = e; lsum += e; }
    lsum += __shfl_xor(lsum, 32);
    f32x16 o[2]; for (int i = 0; i < 16; ++i) { o[0][i] = 0.f; o[1][i] = 0.f; }
    LAS float* wsf = (LAS float*)(wl + 2 * 32 * VPITCH);
    const unsigned vb0 = (unsigned)(uintptr_t)wl;
    const int g = lane >> 4, i16 = lane & 15, qq = i16 >> 2, pp = i16 & 3;
    const unsigned traddr = (unsigned)((4 * (g >> 1) + qq) * VPITCH + (16 * (g & 1) + 4 * pp) * 2);
    const int vrow8 = lane >> 3, vch = lane & 7;
    v4u vr[4];
#define ATT_LOADV(KT) do { _Pragma("unroll") for (int i_ = 0; i_ < 4; ++i_) { const int mk_ = m0 - 128 + 32 * (KT) + 8 * i_ + vrow8; const size_t vrow_ = rowb + (size_t)mk_ * dd + cls; \
        vr[i_] = *(const v4u*)(VB + vrow_ * 512 + h * 64 + vch * 8); } } while (0)
    ATT_LOADV(kt0);
#pragma unroll
    for (int kt = 0; kt < 5; ++kt) {
        if (kt >= kt0) {
            LAS unsigned char* vb = wl + (kt & 1) * 32 * VPITCH;
#pragma unroll
            for (int i_ = 0; i_ < 4; ++i_) *(LAS v4u*)(vb + (8 * i_ + vrow8) * VPITCH + vch * 16) = vr[i_];
            if (kt + 1 < 5) ATT_LOADV(kt + 1);
            LDS_WAIT();
            const unsigned base = vb0 + (unsigned)((kt & 1) * 32 * VPITCH) + traddr;
            s16x4 t[8];
            tr_read8(base, t);
#pragma unroll
            for (int ss = 0; ss < 2; ++ss) {
                const bf16x8 pa = pk8(s[kt][8 * ss], s[kt][8 * ss + 1], s[kt][8 * ss + 2], s[kt][8 * ss + 3], s[kt][8 * ss + 4], s[kt][8 * ss + 5], s[kt][8 * ss + 6], s[kt][8 * ss + 7]);
#pragma unroll
                for (int db = 0; db < 2; ++db) { const bf16x8 vf = __builtin_shufflevector(t[4 * ss + 2 * db], t[4 * ss + 2 * db + 1], 0, 1, 2, 3, 4, 5, 6, 7); o[db] = mfma32(pa, vf, o[db]); }
            }
        }
    }
#undef ATT_LOADV
    if (hi == 0) { wsf[r32] = __builtin_amdgcn_rcpf(lsum); LSE[((size_t)p * M + qrow) * 8 + h] = mx + __builtin_amdgcn_logf(lsum); }
    LDS_WAIT();
#pragma unroll
    for (int i = 0; i < 16; ++i) { const int q = crow(i, hi); const float li = wsf[q];
        *(LAS bf16*)(wl + q * VPITCH + r32 * 2) = (bf16)pk2z(o[0][i] * li); *(LAS bf16*)(wl + q * VPITCH + 64 + r32 * 2) = (bf16)pk2z(o[1][i] * li); }
    LDS_WAIT();
    { const int orow8 = lane >> 3, och = lane & 7;
#pragma unroll
      for (int i_ = 0; i_ < 4; ++i_) { const v4u w = *(const LAS v4u*)(wl + (8 * i_ + orow8) * VPITCH + och * 16); const size_t orow = rowb + (size_t)(m0 + 8 * i_ + orow8) * dd + cls;
          *(v4u*)(OP + ((size_t)p * M + orow) * 512 + h * 64 + och * 8) = w; } }
    LDS_WAIT();
}
DI void attn_finalize_row(const bf16* OP, const float* LSE, const float* gain, bf16* MIX, int row, int lane) {
    asm volatile("" : "+v"(lane));
    const int h = lane >> 3;
    float l0 = LSE[((size_t)0 * M + row) * 8 + h], l1 = LSE[((size_t)1 * M + row) * 8 + h], l2 = LSE[((size_t)2 * M + row) * 8 + h];
    const float mx = fmaxf(l0, fmaxf(l1, l2));
    float w0 = __builtin_amdgcn_exp2f(l0 - mx), w1 = __builtin_amdgcn_exp2f(l1 - mx), w2 = __builtin_amdgcn_exp2f(l2 - mx);
    const float inv = __builtin_amdgcn_rcpf(w0 + w1 + w2); w0 *= inv; w1 *= inv; w2 *= inv;
    const v4u a = *(const v4u*)(OP + ((size_t)0 * M + row) * 512 + lane * 8), b = *(const v4u*)(OP + ((size_t)1 * M + row) * 512 + lane * 8), c = *(const v4u*)(OP + ((size_t)2 * M + row) * 512 + lane * 8);
    float v[8]; float ss = 0.f;
#pragma unroll
    for (int j = 0; j < 4; ++j) { v[2 * j] = w0 * bflo(a[j]) + w1 * bflo(b[j]) + w2 * bflo(c[j]); v[2 * j + 1] = w0 * bfhi(a[j]) + w1 * bfhi(b[j]) + w2 * bfhi(c[j]); ss += v[2 * j] * v[2 * j] + v[2 * j + 1] * v[2 * j + 1]; }
    ss = wave_sum(ss);
    const float rinv = 1.0f / sqrtf(ss * (1.f / 512.f) + RMS_EPS);
    const f32x4 g0 = *(const f32x4*)(gain + lane * 8), g1 = *(const f32x4*)(gain + lane * 8 + 4);
    v4u w; w.x = pk2(v[0] * rinv * g0[0], v[1] * rinv * g0[1]); w.y = pk2(v[2] * rinv * g0[2], v[3] * rinv * g0[3]); w.z = pk2(v[4] * rinv * g1[0], v[5] * rinv * g1[1]); w.w = pk2(v[6] * rinv * g1[2], v[7] * rinv * g1[3]);
    *(v4u*)(MIX + (size_t)row * 1024 + lane * 8) = w;
}
constexpr int B1_IMG = 2048, B1_WLDS = 5 * B1_IMG + 1024;
constexpr int IMG_V = 0, IMG_A = 1 * B1_IMG, IMG_B = 2 * B1_IMG, IMG_W = 3 * B1_IMG, IMG_M = 4 * B1_IMG;
constexpr int TIL = 1 * B1_IMG, TIL_LP = 336, TIL_RP = 144, TIL_RSZ = 17 * TIL_RP;
static_assert(17 * TIL_LP <= 4 * B1_IMG && 3 * TIL_RSZ <= 4 * B1_IMG, "input tiles fit the image area");
DI float dpp_shr(float x, int n) { int v;
    switch (n) { case 1: v = __builtin_amdgcn_update_dpp(0, __builtin_bit_cast(int, x), 0x111, 0xf, 0xf, true); break; case 2: v = __builtin_amdgcn_update_dpp(0, __builtin_bit_cast(int, x), 0x112, 0xf, 0xf, true); break;
                 case 4: v = __builtin_amdgcn_update_dpp(0, __builtin_bit_cast(int, x), 0x114, 0xf, 0xf, true); break; default: v = __builtin_amdgcn_update_dpp(0, __builtin_bit_cast(int, x), 0x118, 0xf, 0xf, true); break; }
    return __builtin_bit_cast(float, v); }
DI float dpp_shr1(float x, int n) { int v; const int one = 0x3f800000;
    switch (n) { case 1: v = __builtin_amdgcn_update_dpp(one, __builtin_bit_cast(int, x), 0x111, 0xf, 0xf, false); break; case 2: v = __builtin_amdgcn_update_dpp(one, __builtin_bit_cast(int, x), 0x112, 0xf, 0xf, false); break;
                 case 4: v = __builtin_amdgcn_update_dpp(one, __builtin_bit_cast(int, x), 0x114, 0xf, 0xf, false); break; default: v = __builtin_amdgcn_update_dpp(one, __builtin_bit_cast(int, x), 0x118, 0xf, 0xf, false); break; }
    return __builtin_bit_cast(float, v); }
struct RwkvP {
    const bf16* PR; const float* mu; const float* muv;
    const float *dbase, *ibase, *vbase, *ksk, *ksa, *brk, *gng, *gnb;
    const bf16 *dupT, *iupT, *vupT, *gupT;
    const bf16* ZROW; bf16 *VF, *VV; float* BON; float* GC; bf16 *W1S, *REFF, *BM; v4u* REC; float* YPRE; bf16* MIX; int layer0;
};
DI const f32x4* vec4p(const float*) { return nullptr; }
DI const LAS f32x4* vec4p(const LAS float*) { return nullptr; }
template <class MP> DI void lerp8(const bf16* crow_, const bf16* prow_, int col, MP mu, float (&z)[8]) {
    const v4u cur = *(const v4u*)(crow_ + col); const v4u prv = *(const v4u*)(prow_ + col);
    const f32x4 m0 = *(decltype(vec4p(mu)))(mu), m1 = *(decltype(vec4p(mu)))(mu + 4);
#pragma unroll
    for (int j = 0; j < 4; ++j) { const float a = bflo(cur[j]), b = bfhi(cur[j]), pa = bflo(prv[j]), pb = bfhi(prv[j]); const float ma = j < 2 ? m0[2 * j] : m1[2 * j - 4], mb = j < 2 ? m0[2 * j + 1] : m1[2 * j - 3];
        z[2 * j] = a + (pa - a) * ma; z[2 * j + 1] = b + (pb - b) * mb; }
}
template <class MP> DI f32x4 lerp4(const bf16* crow_, const bf16* prow_, int col, MP mu) {
    const v2u cur = *(const v2u*)(crow_ + col); const v2u prv = *(const v2u*)(prow_ + col);
    const f32x4 m = *(decltype(vec4p(mu)))(mu);
    f32x4 z; z[0] = bflo(cur.x) + (bflo(prv.x) - bflo(cur.x)) * m[0]; z[1] = bfhi(cur.x) + (bfhi(prv.x) - bfhi(cur.x)) * m[1];
    z[2] = bflo(cur.y) + (bflo(prv.y) - bflo(cur.y)) * m[2]; z[3] = bfhi(cur.y) + (bfhi(prv.y) - bfhi(cur.y)) * m[3]; return z;
}
template <class MP> DI void lerp8l(const LAS unsigned char* crow_, const LAS unsigned char* prow_, int colb, MP mu, float (&z)[8]) {
    const v4u cur = *(const LAS v4u*)(crow_ + colb); const v4u prv = *(const LAS v4u*)(prow_ + colb);
    const f32x4 m0 = *(decltype(vec4p(mu)))(mu), m1 = *(decltype(vec4p(mu)))(mu + 4);
#pragma unroll
    for (int j = 0; j < 4; ++j) { const float a = bflo(cur[j]), b = bfhi(cur[j]), pa = bflo(prv[j]), pb = bfhi(prv[j]); const float ma = j < 2 ? m0[2 * j] : m1[2 * j - 4], mb = j < 2 ? m0[2 * j + 1] : m1[2 * j - 3];
        z[2 * j] = a + (pa - a) * ma; z[2 * j + 1] = b + (pb - b) * mb; }
}
template <class MP> DI f32x4 lerp4l(const LAS unsigned char* crow_, const LAS unsigned char* prow_, int colb, MP mu) {
    const v2u cur = *(const LAS v2u*)(crow_ + colb); const v2u prv = *(const LAS v2u*)(prow_ + colb);
    const f32x4 m = *(decltype(vec4p(mu)))(mu);
    f32x4 z; z[0] = bflo(cur.x) + (bflo(prv.x) - bflo(cur.x)) * m[0]; z[1] = bfhi(cur.x) + (bfhi(prv.x) - bfhi(cur.x)) * m[1];
    z[2] = bflo(cur.y) + (bflo(prv.y) - bflo(cur.y)) * m[2]; z[3] = bfhi(cur.y) + (bfhi(prv.y) - bfhi(cur.y)) * m[3]; return z;
}
DI void img_write(LAS unsigned char* img, const f32x4 (&x)[4], int fr, int fq) {
#pragma unroll
    for (int mb = 0; mb < 4; ++mb)
#pragma unroll
        for (int reg = 0; reg < 4; ++reg) *(LAS bf16*)(img + (16 * mb + 4 * fq + reg) * 32 + fr * 2) = (bf16)pk2z(x[mb][reg]);
}
DI bf16x8 lds4z(const LAS unsigned char* p) { const v2u t = *(const LAS v2u*)p; v4u w; w.x = t.x; w.y = t.y; w.z = 0u; w.w = 0u; return __builtin_bit_cast(bf16x8, w); }
constexpr int HC_DUP = 0, HC_IUP = 9216, HC_VUP = 18432, HC_F = 23552, HC_BYTES = 23552 + 736 * 4;
enum { HF_MUR = 0, HF_MUK = 64, HF_MUV = 128, HF_MUW = 192, HF_MUA = 256, HF_MUVR = 320, HF_DB = 352, HF_IB = 416, HF_VB = 480, HF_SK = 544, HF_SA = 608, HF_BR = 672 };
DI void head_cache_fill(const RwkvP& P, int h, LAS unsigned char* hc, int tid) {
    { const int row = tid >> 3, ch = tid & 7;
      *(LAS v4u*)(hc + HC_DUP + row * 144 + ch * 16) = *(const v4u*)(P.dupT + (size_t)(h * 64 + row) * 64 + ch * 8);
      *(LAS v4u*)(hc + HC_IUP + row * 144 + ch * 16) = *(const v4u*)(P.iupT + (size_t)(h * 64 + row) * 64 + ch * 8); }
    if (tid < 256 && !P.layer0) { const int row = tid >> 2, ch = tid & 3; *(LAS v4u*)(hc + HC_VUP + row * 80 + ch * 16) = *(const v4u*)(P.vupT + (size_t)(h * 64 + row) * 32 + ch * 8); }
    LAS float* f = (LAS float*)(hc + HC_F);
    if (tid < 64) { const int c = h * 64 + tid; f[HF_MUR + tid] = P.mu[c]; f[HF_MUK + tid] = P.mu[512 + c]; f[HF_MUV + tid] = P.mu[1024 + c]; f[HF_MUW + tid] = P.mu[1536 + tid]; f[HF_MUA + tid] = P.mu[1600 + tid];
        f[HF_DB + tid] = P.dbase[c]; f[HF_IB + tid] = P.ibase[c]; f[HF_VB + tid] = P.layer0 ? 0.f : P.vbase[c]; f[HF_SK + tid] = P.ksk[c]; f[HF_SA + tid] = P.ksa[c]; f[HF_BR + tid] = P.brk[c];
        if (tid < 32) f[HF_MUVR + tid] = P.layer0 ? 0.f : P.muv[tid]; }
}
DI void rwkv_b1_unit(const RwkvP& P, int unit, LAS unsigned char* wl, const LAS unsigned char* hc, LAS float* gct  , int lane) {
    asm volatile("" : "+v"(lane));
    const int fr = lane & 15, fq = lane >> 4;
    const int seq = unit >> 9, c = unit & 511, b = seq >> 3, h = seq & 7;
    const size_t row = (size_t)b * TSEQ + 16 * c + fr;
    const f32x4 z4 = {0.f, 0.f, 0.f, 0.f};
    const LAS float* hf = (const LAS float*)(hc + HC_F);
    const bf16* row0p = P.PR + ((size_t)b * TSEQ + 16 * c) * PRP;
#define TROW(rr) (((rr) == 0 && c == 0) ? P.ZROW : row0p + ((rr) - 1) * PRP)
    v4u tl[6], tr3[3][3];
#pragma unroll
    for (int i = 0; i < 5; ++i) { const int idx = lane + 64 * i; if (idx < 272) { const int rr = idx >> 4, pc = idx & 15; tl[i] = *(const v4u*)(TROW(rr) + 1536 + pc * 8); } }
    { const int idx = lane; const int rr = idx >> 2, pc = idx & 3; tl[5] = (v4u){0u, 0u, 0u, 0u}; if (!P.layer0) { tl[5] = *(const v4u*)(TROW(rr) + 1792 + pc * 8); } }
    v4u tl16 = {0u, 0u, 0u, 0u}; if (!P.layer0 && lane < 4) tl16 = *(const v4u*)(TROW(16) + 1792 + lane * 8);
#pragma unroll
    for (int ten = 0; ten < 3; ++ten)
#pragma unroll
        for (int i = 0; i < 3; ++i) { const int idx = lane + 64 * i; if (idx < 136) { const int rr = idx >> 3, pc = idx & 7; tr3[ten][i] = *(const v4u*)(TROW(rr) + ten * 512 + h * 64 + pc * 8); } }
#pragma unroll
    for (int i = 0; i < 5; ++i) { const int idx = lane + 64 * i; if (idx < 272) { const int rr = idx >> 4, pc = idx & 15; *(LAS v4u*)(wl + TIL + rr * TIL_LP + pc * 16) = tl[i]; } }
    { const int rr = lane >> 2, pc = lane & 3; *(LAS v4u*)(wl + TIL + rr * TIL_LP + 256 + pc * 16) = tl[5]; if (lane < 4) *(LAS v4u*)(wl + TIL + 16 * TIL_LP + 256 + lane * 16) = tl16; }
    LDS_WAIT();
    const LAS unsigned char* lcr = wl + TIL + (fr + 1) * TIL_LP; const LAS unsigned char* lpr = wl + TIL + fr * TIL_LP;
    bf16x8 tw[2], al[2], vl;
#pragma unroll
    for (int ks = 0; ks < 2; ++ks) { float z[8]; lerp8l(lcr, lpr, (8 * fq + 32 * ks) * 2, hf + HF_MUW + 8 * fq + 32 * ks, z);
        tw[ks] = pk8(ftanh(z[0]), ftanh(z[1]), ftanh(z[2]), ftanh(z[3]), ftanh(z[4]), ftanh(z[5]), ftanh(z[6]), ftanh(z[7]));
        lerp8l(lcr, lpr, 128 + (8 * fq + 32 * ks) * 2, hf + HF_MUA + 8 * fq + 32 * ks, z); al[ks] = pk8(z[0], z[1], z[2], z[3], z[4], z[5], z[6], z[7]); }
    if (!P.layer0) { float z[8]; lerp8l(lcr, lpr, 256 + 8 * fq * 2, hf + HF_MUVR + 8 * fq, z); vl = pk8(z[0], z[1], z[2], z[3], z[4], z[5], z[6], z[7]); }
    LDS_WAIT();
#pragma unroll
    for (int ten = 0; ten < 3; ++ten)
#pragma unroll
        for (int i = 0; i < 3; ++i) { const int idx = lane + 64 * i; if (idx < 136) { const int rr = idx >> 3, pc = idx & 7; *(LAS v4u*)(wl + TIL + ten * TIL_RSZ + rr * TIL_RP + pc * 16) = tr3[ten][i]; } }
    LDS_WAIT();
#undef TROW
    const LAS unsigned char* rcr = wl + TIL + (fr + 1) * TIL_RP; const LAS unsigned char* rpr = wl + TIL + fr * TIL_RP;
    f32x4 zr[4], k2[4], kk[4], ai[4], ld[4];
    float nrm = 0.f, bon = 0.f;
#pragma unroll
    for (int mb = 0; mb < 4; ++mb) { const int ch = h * 64 + 16 * mb + 4 * fq; const int n = h * 64 + 16 * mb + fr;
        f32x4 dw = z4, da = z4, dv = z4;
        dw = mfma16(*(const LAS bf16x8*)(hc + HC_DUP + (16 * mb + fr) * 144 + 16 * fq), tw[0], dw); dw = mfma16(*(const LAS bf16x8*)(hc + HC_DUP + (16 * mb + fr) * 144 + 16 * fq + 64), tw[1], dw);
        da = mfma16(*(const LAS bf16x8*)(hc + HC_IUP + (16 * mb + fr) * 144 + 16 * fq), al[0], da); da = mfma16(*(const LAS bf16x8*)(hc + HC_IUP + (16 * mb + fr) * 144 + 16 * fq + 64), al[1], da);
        if (!P.layer0) dv = mfma16(*(const LAS bf16x8*)(hc + HC_VUP + (16 * mb + fr) * 80 + 16 * fq), vl, z4);
        const int cl = 16 * mb + 4 * fq;
        zr[mb] = lerp4l(rcr, rpr, cl * 2, hf + HF_MUR + cl);
        const f32x4 zk = lerp4l(rcr + TIL_RSZ, rpr + TIL_RSZ, cl * 2, hf + HF_MUK + cl);
        f32x4 zv = lerp4l(rcr + 2 * TIL_RSZ, rpr + 2 * TIL_RSZ, cl * 2, hf + HF_MUV + cl);
        const f32x4 db = *(const LAS f32x4*)(hf + HF_DB + cl), ib = *(const LAS f32x4*)(hf + HF_IB + cl), sk = *(const LAS f32x4*)(hf + HF_SK + cl), sa = *(const LAS f32x4*)(hf + HF_SA + cl), br = *(const LAS f32x4*)(hf + HF_BR + cl);
        if (P.layer0) { v2u w; w.x = pk2(zv[0], zv[1]); w.y = pk2(zv[2], zv[3]); *(v2u*)(P.VF + row * 512 + ch) = w; }
        else { const v2u f = *(const v2u*)(P.VF + row * 512 + ch); const f32x4 vb = *(const LAS f32x4*)(hf + HF_VB + cl); const f32x4 vf = {bflo(f.x), bfhi(f.x), bflo(f.y), bfhi(f.y)};
#pragma unroll
            for (int e = 0; e < 4; ++e) zv[e] = zv[e] + (vf[e] - zv[e]) * fsigmoid(vb[e] + dv[e]); }
        { v2u w; w.x = pk2(zv[0], zv[1]); w.y = pk2(zv[2], zv[3]); *(v2u*)(P.VV + row * 512 + ch) = w; }
#pragma unroll
        for (int reg = 0; reg < 4; ++reg) *(LAS bf16*)(wl + IMG_V + (16 * mb + 4 * fq + reg) * 32 + fr * 2) = (bf16)pk2z(zv[reg]);
#pragma unroll
        for (int e = 0; e < 4; ++e) {
            ld[mb][e] = fexp(-0.60653065971f * fsigmoid(db[e] + dw[e]));
            const float a = fsigmoid(ib[e] + da[e]); ai[mb][e] = a;
            const float kr = zk[e] * sk[e]; kk[mb][e] = kr; nrm += kr * kr;
            const float kx = zk[e] * (1.f + (a - 1.f) * sa[e]); k2[mb][e] = kx; bon += zr[mb][e] * kx * br[e]; }
        asm volatile("" ::: "memory");
    }
    nrm += __shfl_xor(nrm, 16); nrm += __shfl_xor(nrm, 32); bon += __shfl_xor(bon, 16); bon += __shfl_xor(bon, 32);
    if (fq == 0) P.BON[row * 8 + h] = bon;
    const float kinv = 1.0f / fmaxf(sqrtf(nrm), 1e-12f);
    f32x4 rt[4], kh[4];
    bf16x8 pa[2], pb[2], pk[2], pr[2];
#pragma unroll
    for (int ks = 0; ks < 2; ++ks) {
        f32x4 at2[2], bt2[2], kt2[2];
#pragma unroll
        for (int m2 = 0; m2 < 2; ++m2) { const int mb = 2 * ks + m2;
            f32x4 gcv, bhv;
#pragma unroll
            for (int e = 0; e < 4; ++e) {
                float gm = ld[mb][e]; gm *= dpp_shr1(gm, 1); gm *= dpp_shr1(gm, 2); gm *= dpp_shr1(gm, 4); gm *= dpp_shr1(gm, 8);
                const float gc = __shfl(gm, lane | 15), gp = dpp_shr1(gm, 1), gi = __builtin_amdgcn_rcpf(gm), ec = gc * gi;
                const float kn = kk[mb][e] * kinv, bb = kn * ai[mb][e];
                at2[m2][e] = -kn * gp; bt2[m2][e] = bb * gi; kt2[m2][e] = k2[mb][e] * gi; rt[mb][e] = zr[mb][e] * gm;
                bhv[e] = bb * ec; kh[mb][e] = k2[mb][e] * ec; gcv[e] = gc; }
            if (fr == 0) { *(f32x4*)(P.GC + (size_t)unit * 64 + 16 * mb + 4 * fq) = gcv; *(LAS f32x4*)(gct + (unit & 31) * 64 + 16 * mb + 4 * fq) = gcv; }
#pragma unroll
            for (int reg = 0; reg < 4; ++reg) { const int o = (16 * mb + 4 * fq + reg) * 32 + fr * 2;
                *(LAS bf16*)(wl + IMG_A + o) = (bf16)pk2z(at2[m2][reg]); *(LAS bf16*)(wl + IMG_B + o) = (bf16)pk2z(bhv[reg]); }
        }
        pa[ks] = pk8v(at2[0], at2[1]); pb[ks] = pk8v(bt2[0], bt2[1]); pk[ks] = pk8v(kt2[0], kt2[1]); pr[ks] = pk8v(rt[2 * ks], rt[2 * ks + 1]);
    }
    const f32x4 z4b = {0.f, 0.f, 0.f, 0.f};
    f32x4 Aab = mfma16(pb[1], pa[1], mfma16(pb[0], pa[0], z4b));
    f32x4 AakT = mfma16(pa[1], pk[1], mfma16(pa[0], pk[0], z4b));
    f32x4 Arb = mfma16(pb[1], pr[1], mfma16(pb[0], pr[0], z4b));
    f32x4 Ark = mfma16(pk[1], pr[1], mfma16(pk[0], pr[0], z4b));
#pragma unroll
    for (int e = 0; e < 4; ++e) { const int rr = 4 * fq + e; Aab[e] = rr < fr ? Aab[e] : 0.f; AakT[e] = fr < rr ? AakT[e] : 0.f; Arb[e] = rr <= fr ? Arb[e] : 0.f; Ark[e] = rr <= fr ? Ark[e] : 0.f; }
    LAS float* As = (LAS float*)(wl + 5 * B1_IMG);
#pragma unroll
    for (int e = 0; e < 4; ++e) As[(4 * fq + e) * 16 + fr] = Aab[e];
    LDS_WAIT();
    float x[16];
#pragma unroll
    for (int s = 15; s >= 0; --s) { float acc = (s == fr) ? 1.f : 0.f;
        const f32x4 r0 = *(const LAS f32x4*)(As + s * 16), r1 = *(const LAS f32x4*)(As + s * 16 + 4), r2 = *(const LAS f32x4*)(As + s * 16 + 8), r3 = *(const LAS f32x4*)(As + s * 16 + 12);
        const float rowv[16] = {r0[0], r0[1], r0[2], r0[3], r1[0], r1[1], r1[2], r1[3], r2[0], r2[1], r2[2], r2[3], r3[0], r3[1], r3[2], r3[3]};
#pragma unroll
        for (int uu = s + 1; uu < 16; ++uu) acc += rowv[uu] * x[uu];
        x[s] = acc; if ((s & 1) == 0) asm volatile("" ::: "memory"); }
    f32x4 xs;
#pragma unroll
    for (int e = 0; e < 4; ++e) xs[e] = fq == 0 ? x[e] : fq == 1 ? x[4 + e] : fq == 2 ? x[8 + e] : x[12 + e];
    const bf16x8 Tsel = pk4z(xs);
    f32x4 W1[4];
#pragma unroll
    for (int mb = 0; mb < 4; ++mb) W1[mb] = mfma16(lds4z(wl + IMG_A + (16 * mb + fr) * 32 + 8 * fq), Tsel, z4);
    const f32x4 GT = mfma16(Tsel, pk4z(AakT), z4);
    img_write(wl + IMG_W, W1, fr, fq);
    f32x4 M1T[4];
    const bf16x8 GTp = pk4z(GT);
#pragma unroll
    for (int mb = 0; mb < 4; ++mb) M1T[mb] = mfma16(lds4z(wl + IMG_B + (16 * mb + fr) * 32 + 8 * fq), GTp, kh[mb]);
    img_write(wl + IMG_M, M1T, fr, fq);
    LDS_WAIT();
    const bf16x8 Arbp = pk4z(Arb);
    f32x4 RE[4];
#pragma unroll
    for (int mb = 0; mb < 4; ++mb) RE[mb] = mfma16(lds4z(wl + IMG_W + (16 * mb + fr) * 32 + 8 * fq), Arbp, rt[mb]);
    const f32x4 M2 = mfma16(GTp, Arbp, Ark);
    {   bf16* w1s = P.W1S + (size_t)unit * 1024 + fr * 32; bf16* re = P.REFF + (size_t)unit * 1024 + fr * 32;
#pragma unroll
        for (int kp = 0; kp < 2; ++kp) { const int sg = kp * 512 + fq * 8;
            v4u w; w.x = pk2(W1[2 * kp][0], W1[2 * kp][1]); w.y = pk2(W1[2 * kp][2], W1[2 * kp][3]); w.z = pk2(W1[2 * kp + 1][0], W1[2 * kp + 1][1]); w.w = pk2(W1[2 * kp + 1][2], W1[2 * kp + 1][3]); *(v4u*)(w1s + sg) = w;
            w.x = pk2(RE[2 * kp][0], RE[2 * kp][1]); w.y = pk2(RE[2 * kp][2], RE[2 * kp][3]); w.z = pk2(RE[2 * kp + 1][0], RE[2 * kp + 1][1]); w.w = pk2(RE[2 * kp + 1][2], RE[2 * kp + 1][3]); *(v4u*)(re + sg) = w; }
        const v2u m2p = {pk2(M2[0], M2[1]), pk2(M2[2], M2[3])};
#pragma unroll
        for (int mb = 0; mb < 4; ++mb) {
            const v2u bq = *(const LAS v2u*)(wl + IMG_B + (16 * mb + fr) * 32 + 8 * fq), mq = *(const LAS v2u*)(wl + IMG_M + (16 * mb + fr) * 32 + 8 * fq);
            *(v4u*)(P.BM + (((size_t)unit * 64 + 16 * mb + fr) * 4 + fq) * 8) = (v4u){bq.x, bq.y, mq.x, mq.y};
            const v2u vq = *(const LAS v2u*)(wl + IMG_V + (16 * mb + fr) * 32 + 8 * fq);
            P.REC[((size_t)unit * 4 + mb) * 64 + lane] = (v4u){vq.x, vq.y, m2p.x, m2p.y}; }
    }
    LDS_WAIT();
}
constexpr int NSEG = 16, SEGCH = NCH / NSEG;
struct ChainIn { bf16x8 w1[2], re[2], bm[4]; v4u rec; };
constexpr int GCT_OFF = 149504;
template <int MODE> DI void chain_load(ChainIn& c, const RwkvP& P, int unit, int rb, int lane) {
    const int fr = lane & 15, fq = lane >> 4;
    const bf16* w1s = P.W1S + (size_t)unit * 1024 + fr * 32 + fq * 8;
    c.w1[0] = ld8(w1s); c.w1[1] = ld8(w1s + 512);
    if (MODE == 2) { const bf16* re = P.REFF + (size_t)unit * 1024 + fr * 32 + fq * 8; c.re[0] = ld8(re); c.re[1] = ld8(re + 512); }
#pragma unroll
    for (int mb = 0; mb < 4; ++mb) c.bm[mb] = ld8(P.BM + (((size_t)unit * 64 + 16 * mb + fr) * 4 + fq) * 8);
    if (MODE != 1) c.rec = P.REC[((size_t)unit * 4 + rb) * 64 + lane];
}
template <int MODE> DI void chain_step(f32x4 (&S)[4], const ChainIn& c, float* ypre  , const LAS float* gcl  ) {
    const f32x4 z4 = {0.f, 0.f, 0.f, 0.f};
    f32x4 gc[4];
#pragma unroll
    for (int mb = 0; mb < 4; ++mb) gc[mb] = *(const LAS f32x4*)(gcl + 16 * mb);
    const bf16x8 b0 = pk8v(S[0], S[1]), b1 = pk8v(S[2], S[3]);
    f32x4 ut = mfma16(c.w1[1], b1, mfma16(c.w1[0], b0, z4));
    if (MODE == 2) {
        v4u vlo; vlo.x = c.rec.x; vlo.y = c.rec.y; vlo.z = 0u; vlo.w = 0u;
        v4u m2a; m2a.x = c.rec.z; m2a.y = c.rec.w; m2a.z = 0u; m2a.w = 0u;
        f32x4 y = mfma16(__builtin_bit_cast(bf16x8, m2a), __builtin_bit_cast(bf16x8, vlo), z4);
        y = mfma16(c.re[0], b0, y); y = mfma16(c.re[1], b1, y);
#pragma unroll
        for (int e = 0; e < 4; ++e) ypre[(size_t)e * 512] = y[e];
    }
    v4u uv; uv.x = pk2(ut[0], ut[1]); uv.y = pk2(ut[2], ut[3]); uv.z = MODE == 1 ? 0u : c.rec.x; uv.w = MODE == 1 ? 0u : c.rec.y;
    const bf16x8 ub = __builtin_bit_cast(bf16x8, uv);
#pragma unroll
    for (int mb = 0; mb < 4; ++mb) S[mb] = mfma16(c.bm[mb], ub, S[mb] * gc[mb]);
}
template <int MODE> DI void chain_run(f32x4 (&S)[4], const RwkvP& P, int unit0, int nsteps  , int rb, float* yp, const LAS float* gct  , int lane) {
    ChainIn c0, c1, c2, c3;
    chain_load<MODE>(c0, P, unit0, rb, lane); chain_load<MODE>(c1, P, unit0 + 1, rb, lane); chain_load<MODE>(c2, P, unit0 + 2, rb, lane);
    for (int c = 0; c < nsteps; c += 4) {
        chain_load<MODE>(c3, P, unit0 + c + 3, rb, lane);
        chain_step<MODE>(S, c0, yp + (size_t)c * 16 * 512, gct + c * 64);
        if (c + 4 < nsteps) chain_load<MODE>(c0, P, unit0 + c + 4, rb, lane);
        chain_step<MODE>(S, c1, yp + (size_t)(c + 1) * 16 * 512, gct + (c + 1) * 64);
        if (c + 5 < nsteps) chain_load<MODE>(c1, P, unit0 + c + 5, rb, lane);
        chain_step<MODE>(S, c2, yp + (size_t)(c + 2) * 16 * 512, gct + (c + 2) * 64);
        if (c + 6 < nsteps) chain_load<MODE>(c2, P, unit0 + c + 6, rb, lane);
        chain_step<MODE>(S, c3, yp + (size_t)(c + 3) * 16 * 512, gct + (c + 3) * 64);
    }
}
DI void chain_step_dual(f32x4 (&SQ)[4], f32x4 (&SP)[4], const ChainIn& c, const LAS float* gcl) {
    const f32x4 z4 = {0.f, 0.f, 0.f, 0.f};
    f32x4 gc[4];
#pragma unroll
    for (int mb = 0; mb < 4; ++mb) gc[mb] = *(const LAS f32x4*)(gcl + 16 * mb);
    const bf16x8 q0 = pk8v(SQ[0], SQ[1]), q1 = pk8v(SQ[2], SQ[3]), p0 = pk8v(SP[0], SP[1]), p1 = pk8v(SP[2], SP[3]);
    const f32x4 utq = mfma16(c.w1[1], q1, mfma16(c.w1[0], q0, z4)), utp = mfma16(c.w1[1], p1, mfma16(c.w1[0], p0, z4));
    v4u uq; uq.x = pk2(utq[0], utq[1]); uq.y = pk2(utq[2], utq[3]); uq.z = c.rec.x; uq.w = c.rec.y;
    v4u up; up.x = pk2(utp[0], utp[1]); up.y = pk2(utp[2], utp[3]); up.z = 0u; up.w = 0u;
    const bf16x8 ubq = __builtin_bit_cast(bf16x8, uq), ubp = __builtin_bit_cast(bf16x8, up);
#pragma unroll
    for (int mb = 0; mb < 4; ++mb) { SQ[mb] = mfma16(c.bm[mb], ubq, SQ[mb] * gc[mb]); SP[mb] = mfma16(c.bm[mb], ubp, SP[mb] * gc[mb]); }
}
DI void chain_pass1(const RwkvP& P, float* QSEG, float* PSEGT, int seq, int g, int rb, const LAS float* gct0, int lane) {
    const int fr = lane & 15, fq = lane >> 4;
    f32x4 SQ[4], SP[4];
#pragma unroll
    for (int mb = 0; mb < 4; ++mb)
#pragma unroll
        for (int e = 0; e < 4; ++e) { SQ[mb][e] = 0.f; SP[mb][e] = ((16 * mb + 4 * fq + e) == (16 * rb + fr)) ? 1.f : 0.f; }
    const int unit0 = seq * NCH + g * SEGCH; const LAS float* gct = gct0 + 4 * fq;
    {   ChainIn c0, c1, c2;
        chain_load<0>(c0, P, unit0, rb, lane); chain_load<0>(c1, P, unit0 + 1, rb, lane);
        int c = 0;
        for (; c + 3 <= SEGCH; c += 3) {
            chain_load<0>(c2, P, unit0 + c + 2, rb, lane);
            chain_step_dual(SQ, SP, c0, gct + c * 64);
            if (c + 3 < SEGCH) chain_load<0>(c0, P, unit0 + c + 3, rb, lane);
            chain_step_dual(SQ, SP, c1, gct + (c + 1) * 64);
            if (c + 4 < SEGCH) chain_load<0>(c1, P, unit0 + c + 4, rb, lane);
            chain_step_dual(SQ, SP, c2, gct + (c + 2) * 64);
        }
        if (c < SEGCH) { chain_step_dual(SQ, SP, c0, gct + c * 64); ++c; }
        if (c < SEGCH) { chain_step_dual(SQ, SP, c1, gct + c * 64); ++c; }
    }
    const size_t sb = ((size_t)seq * NSEG + g) * 4096;
#pragma unroll
    for (int mb = 0; mb < 4; ++mb) *(f32x4*)(QSEG + sb + (size_t)(16 * rb + fr) * 64 + 16 * mb + 4 * fq) = SQ[mb];
#pragma unroll
    for (int mb = 0; mb < 4; ++mb)
#pragma unroll
        for (int e = 0; e < 4; ++e) PSEGT[sb + (size_t)((mb * 2 + (rb >> 1)) * 2 + (rb & 1)) * 256 + ((4 * fq + e) + 16 * (fr >> 2)) * 4 + (fr & 3)] = SP[mb][e];
}
DI void split_hl(const f32x4 a, const f32x4 b, bf16x8& hi, bf16x8& lo) {
    f32x4 ah, bh;
#pragma unroll
    for (int e = 0; e < 4; ++e) { ah[e] = rbf(a[e]); bh[e] = rbf(b[e]); }
    hi = pk8v(ah, bh); lo = pk8v(a - ah, b - bh);
}
DI void chain_pass23(const RwkvP& P, const float* QSEG, const float* PSEGT, int seq, int g, int rb, float* wkv_out, const LAS float* gct0, int lane) {
    const int fr = lane & 15, fq = lane >> 4, b = seq >> 3, h = seq & 7;
    f32x4 S[4]; for (int mb = 0; mb < 4; ++mb) S[mb] = (f32x4){0.f, 0.f, 0.f, 0.f};
    f32x4 pc[4][2][2], pn[4][2][2];
#define P2_LOAD(PD_, GP_) do { const size_t sb_ = ((size_t)seq * NSEG + (GP_)) * 4096; _Pragma("unroll") for (int mb = 0; mb < 4; ++mb) { \
        _Pragma("unroll") for (int ks = 0; ks < 2; ++ks) { const float* pr_ = PSEGT + sb_ + (size_t)((mb * 2 + ks) * 2) * 256 + (fr + 16 * fq) * 4; PD_[mb][ks][0] = *(const f32x4*)pr_; PD_[mb][ks][1] = *(const f32x4*)(pr_ + 256); } } } while (0)
    if (g > 0) P2_LOAD(pc, 0);
    for (int gp = 0; gp < g; ++gp) {
        f32x4 qc[4];
        { const size_t sb_ = ((size_t)seq * NSEG + gp) * 4096;
#pragma unroll
          for (int mb = 0; mb < 4; ++mb) qc[mb] = *(const f32x4*)(QSEG + sb_ + (size_t)(16 * rb + fr) * 64 + 16 * mb + 4 * fq); }
        if (gp + 1 < g) P2_LOAD(pn, gp + 1);
        bf16x8 bh[2], bl[2]; split_hl(S[0], S[1], bh[0], bl[0]); split_hl(S[2], S[3], bh[1], bl[1]);
#pragma unroll
        for (int mb = 0; mb < 4; ++mb) { f32x4 acc = {0.f, 0.f, 0.f, 0.f};
#pragma unroll
            for (int ks = 0; ks < 2; ++ks) { bf16x8 ah, al; split_hl(pc[mb][ks][0], pc[mb][ks][1], ah, al);
                acc = mfma16(ah, bh[ks], acc); acc = mfma16(al, bh[ks], acc); acc = mfma16(ah, bl[ks], acc); }
            S[mb] = acc + qc[mb]; }
#pragma unroll
        for (int mb = 0; mb < 4; ++mb) {
#pragma unroll
            for (int ks = 0; ks < 2; ++ks) { pc[mb][ks][0] = pn[mb][ks][0]; pc[mb][ks][1] = pn[mb][ks][1]; } }
    }
#undef P2_LOAD
    float* yp = P.YPRE + ((size_t)b * TSEQ + (size_t)g * SEGCH * 16 + 4 * fq) * 512 + h * 64 + 16 * rb + fr;
    chain_run<2>(S, P, seq * NCH + g * SEGCH, SEGCH, rb, yp, gct0 + 4 * fq, lane);
    if (g == NSEG - 1) {
#pragma unroll
        for (int mb = 0; mb < 4; ++mb) *(f32x4*)(wkv_out + (size_t)(16 * rb + fr) * 64 + 16 * mb + 4 * fq) = S[mb];
    }
}
constexpr int GC_GUP = 0, GC_F = 64 * 272, GC_BYTES = 64 * 272 + 256 * 4;
DI void gate_cache_fill(const RwkvP& P, int h, LAS unsigned char* gc, int tid) {
#pragma unroll
    for (int q = 0; q < 2; ++q) { const int idx = tid + 512 * q, row = idx >> 4, ch = idx & 15;
        *(LAS v4u*)(gc + GC_GUP + row * 272 + ch * 16) = *(const v4u*)(P.gupT + (size_t)(h * 64 + row) * 128 + ch * 8); }
    LAS float* f = (LAS float*)(gc + GC_F);
    if (tid < 64) { f[tid] = P.gng[h * 64 + tid]; f[64 + tid] = P.gnb[h * 64 + tid]; }
    if (tid >= 64 && tid < 192) f[128 + tid - 64] = P.mu[1664 + tid - 64];
}
constexpr int B3_GP = 272, B3_YP = 272, B3_VP = 144, B3_G = 0, B3_Y = 17 * B3_GP, B3_V = B3_Y + 16 * B3_YP, B3_WLDS = B3_V + 16 * B3_VP;
DI void rwkv_b3_unit(const RwkvP& P, int unit, const LAS unsigned char* gc, LAS unsigned char* wl, int lane) {
    asm volatile("" : "+v"(lane));
    const int fr = lane & 15, fq = lane >> 4;
    const int seq = unit >> 9, c = unit & 511, b = seq >> 3, h = seq & 7;
    const size_t row0 = (size_t)b * TSEQ + 16 * c;
    const f32x4 z4 = {0.f, 0.f, 0.f, 0.f};
    const LAS float* gf = (const LAS float*)(gc + GC_F);
    const bf16* row0p = P.PR + row0 * PRP;
    v4u tg[5], ty[4], tv[2];
#pragma unroll
    for (int i = 0; i < 5; ++i) { const int idx = lane + 64 * i; if (idx < 272) { const int rr = idx >> 4, pc = idx & 15; const bf16* rp = (rr == 0 && c == 0) ? P.ZROW : row0p + (rr - 1) * PRP; tg[i] = *(const v4u*)(rp + 1664 + pc * 8); } }
#pragma unroll
    for (int i = 0; i < 4; ++i) { const int idx = lane + 64 * i, rr = idx >> 4, pc = idx & 15; ty[i] = *(const v4u*)(P.YPRE + (row0 + rr) * 512 + h * 64 + pc * 4); }
#pragma unroll
    for (int i = 0; i < 2; ++i) { const int idx = lane + 64 * i, rr = idx >> 3, pc = idx & 7; tv[i] = *(const v4u*)(P.VV + (row0 + rr) * 512 + h * 64 + pc * 8); }
    const float bon = P.BON[(row0 + fr) * 8 + h];
#pragma unroll
    for (int i = 0; i < 5; ++i) { const int idx = lane + 64 * i; if (idx < 272) { const int rr = idx >> 4, pc = idx & 15; *(LAS v4u*)(wl + B3_G + rr * B3_GP + pc * 16) = tg[i]; } }
#pragma unroll
    for (int i = 0; i < 4; ++i) { const int idx = lane + 64 * i, rr = idx >> 4, pc = idx & 15; *(LAS v4u*)(wl + B3_Y + rr * B3_YP + pc * 16) = ty[i]; }
#pragma unroll
    for (int i = 0; i < 2; ++i) { const int idx = lane + 64 * i, rr = idx >> 3, pc = idx & 7; *(LAS v4u*)(wl + B3_V + rr * B3_VP + pc * 16) = tv[i]; }
    LDS_WAIT();
    const LAS unsigned char* gcr = wl + B3_G + (fr + 1) * B3_GP; const LAS unsigned char* gpr = wl + B3_G + fr * B3_GP;
    bf16x8 sg[4];
#pragma unroll
    for (int ks = 0; ks < 4; ++ks) { float z[8]; lerp8l(gcr, gpr, (8 * fq + 32 * ks) * 2, gf + 128 + 8 * fq + 32 * ks, z);
        sg[ks] = pk8(fsigmoid(z[0]), fsigmoid(z[1]), fsigmoid(z[2]), fsigmoid(z[3]), fsigmoid(z[4]), fsigmoid(z[5]), fsigmoid(z[6]), fsigmoid(z[7])); }
    f32x4 g[4], y[4]; float s = 0.f;
#pragma unroll
    for (int mb = 0; mb < 4; ++mb) { f32x4 a = z4;
#pragma unroll
        for (int ks = 0; ks < 4; ++ks) a = mfma16(*(const LAS bf16x8*)(gc + GC_GUP + (16 * mb + fr) * 272 + 16 * fq + 64 * ks), sg[ks], a);
        g[mb] = a;
        y[mb] = *(const LAS f32x4*)(wl + B3_Y + fr * B3_YP + (16 * mb + 4 * fq) * 4); s += (y[mb][0] + y[mb][1]) + (y[mb][2] + y[mb][3]); }
    s += __shfl_xor(s, 16); s += __shfl_xor(s, 32);
    const float mean = s * (1.f / 64.f); float q = 0.f;
#pragma unroll
    for (int mb = 0; mb < 4; ++mb) { y[mb] = y[mb] - mean; q += (y[mb][0] * y[mb][0] + y[mb][1] * y[mb][1]) + (y[mb][2] * y[mb][2] + y[mb][3] * y[mb][3]); }
    q += __shfl_xor(q, 16); q += __shfl_xor(q, 32);
    const float rstd = 1.0f / sqrtf(q * (1.f / 64.f) + GN_EPS);
    LDS_WAIT();
#pragma unroll
    for (int mb = 0; mb < 4; ++mb) { const int cl = 16 * mb + 4 * fq;
        const f32x4 gg = *(const LAS f32x4*)(gf + cl), gb = *(const LAS f32x4*)(gf + 64 + cl); const v2u vw = *(const LAS v2u*)(wl + B3_V + fr * B3_VP + cl * 2);
        const f32x4 v = {bflo(vw.x), bfhi(vw.x), bflo(vw.y), bfhi(vw.y)};
        const f32x4 o = (y[mb] * rstd * gg + gb + v * bon) * g[mb];
        v2u w; w.x = pk2(o[0], o[1]); w.y = pk2(o[2], o[3]); *(LAS v2u*)(wl + B3_G + fr * B3_VP + cl * 2) = w; }
    LDS_WAIT();
#pragma unroll
    for (int i = 0; i < 2; ++i) { const int idx = lane + 64 * i, rr = idx >> 3, pc = idx & 7; *(v4u*)(P.MIX + (row0 + rr) * 1024 + 512 + h * 64 + pc * 8) = *(const LAS v4u*)(wl + B3_G + rr * B3_VP + pc * 16); }
    LDS_WAIT();
}
DI f32x16 dec_gemm(const bf16* A, const bf16* Wt, int K, LAS float* red  , int wave, int lane) {
    const int r = lane & 31, h = lane >> 5, kw = K >> 3;
    const bf16* ap = A + (size_t)r * K + wave * kw + 8 * h; const bf16* bp = Wt + (size_t)r * K + wave * kw + 8 * h;
    f32x16 acc; for (int i = 0; i < 16; ++i) acc[i] = 0.f;
#pragma unroll 16
    for (int k = 0; k < kw; k += 16) acc = mfma32(ld8(ap + k), ld8(bp + k), acc);
    __syncthreads();
#pragma unroll
    for (int i = 0; i < 16; ++i) red[(wave * 16 + i) * 64 + lane] = acc[i];
    __syncthreads();
    if (wave == 0) {
#pragma unroll
        for (int i = 0; i < 16; ++i) { float s = 0.f;
#pragma unroll
            for (int w = 0; w < 8; ++w) s += red[(w * 16 + i) * 64 + lane];
            asm volatile("" : "+v"(s) :: "memory"); acc[i] = s; } }
    return acc;
}
DI void dec_row_stats(const float* st, LAS float* sc, int lane) {
    if (lane < 32) { float s = 0.f, q = 0.f; const f32x4* p = (const f32x4*)(st + (size_t)lane * 64);
#pragma unroll
        for (int i = 0; i < 16; ++i) { const f32x4 v = p[i]; s += v[0] + v[2]; q += v[1] + v[3]; if ((i & 3) == 3) asm volatile("" : "+v"(s), "+v"(q) :: "memory"); }
        const float mu = s * (1.f / 1024.f), var = fmaxf(q * (1.f / 1024.f) - mu * mu, 0.f); sc[2 * lane] = mu; sc[2 * lane + 1] = 1.0f / sqrtf(var + LN_EPS); }
    LDS_WAIT();
}
struct DecP {
    unsigned char* dec; int l;
    const float* xs;
    const float *c1in, *c2in, *c1up, *c2up, *g1, *b1, *g2p, *b2p;
    const bf16 *win, *winu, *wout, *wup, *wdn;
    float* out;
};
DI void dec_unit_in(const DecP& D, int u, LAS float* red, LAS float* sc, int wave, int lane) {
    const int r32 = lane & 31, hi = lane >> 5;
    if (u < 105) {
        const int n = 32 * u + r32; const bool fold = D.l > 0;
        const f32x16 acc = dec_gemm((const bf16*)(D.dec + DEC_XB2), D.win + (size_t)(32 * u) * DM, DM, red, wave, lane);
        if (wave != 0) return;
        if (fold) dec_row_stats((const float*)(D.dec + DEC_ST2), sc, lane);
        const float c1 = fold ? D.c1in[n] : 0.f, c2 = fold ? D.c2in[n] : 0.f; const int on = n < 1024 ? lgcl2orig(n) : n;
        float* PD = (float*)(D.dec + DEC_PD);
#pragma unroll
        for (int i = 0; i < 16; ++i) { const int row = crow(i, hi); float mu = 0.f, rs = 1.f; if (fold) { mu = sc[2 * row]; rs = sc[2 * row + 1]; } PD[(size_t)row * NIN + on] = (acc[i] - mu * c1) * rs + c2; }
    } else {
        const int v = u - 105, n = 32 * v + r32;
        const f32x16 acc = dec_gemm((const bf16*)(D.dec + DEC_SHB) + (size_t)D.l * MD * DM, D.winu + (size_t)(32 * v) * DM, DM, red, wave, lane);
        if (wave != 0) return;
        float* PS = (float*)(D.dec + DEC_PS);
#pragma unroll
        for (int i = 0; i < 16; ++i) PS[(size_t)crow(i, hi) * NRWU + n] = acc[i];
    }
    LDS_WAIT();
}
DI void dec_unit_res(const bf16* A, const bf16* Wt, int K, int u, bool raw, const float* src, const float* sstat, const float* g, const float* b, float* T, bf16* XB, float* ostat, float* shiftout, LAS float* red, LAS float* sc, int wave, int lane) {
    const int r32 = lane & 31, hi = lane >> 5, n = 32 * u + r32;
    const f32x16 acc = dec_gemm(A, Wt + (size_t)(32 * u) * K, K, red, wave, lane);
    if (wave != 0) return;
    if (!raw) dec_row_stats(sstat, sc, lane);
    const float gg = raw ? 1.f : g[n], bb = raw ? 0.f : b[n];
#pragma unroll
    for (int i = 0; i < 16; ++i) { const int row = crow(i, hi); float mu = 0.f, rs = 1.f; if (!raw) { mu = sc[2 * row]; rs = sc[2 * row + 1]; }
        const float x = (src[(size_t)row * DM + n] - mu) * rs * gg + bb; const float t = ALPHA * x + acc[i];
        T[(size_t)row * DM + n] = t; XB[(size_t)row * DM + n] = (bf16)f2bf(t); if (shiftout) shiftout[(size_t)row * DM + n] = x;
        float s = t, q = t * t;
#pragma unroll
        for (int o = 1; o < 32; o <<= 1) { s += __shfl_xor(s, o); q += __shfl_xor(q, o); }
        if (r32 == 0) { ostat[((size_t)row * 32 + u) * 2] = s; ostat[((size_t)row * 32 + u) * 2 + 1] = q; } }
    LDS_WAIT();
}
DI void dec_unit_up(const DecP& D, int u, LAS float* red, LAS float* sc, int wave, int lane) {
    const int r32 = lane & 31, hi = lane >> 5, n = 32 * u + r32;
    const f32x16 acc = dec_gemm((const bf16*)(D.dec + DEC_XB1), D.wup + (size_t)(32 * u) * DM, DM, red, wave, lane);
    if (wave != 0) return;
    dec_row_stats((const float*)(D.dec + DEC_ST1), sc, lane);
    const float c1 = D.c1up[n], c2 = D.c2up[n]; bf16* HB = (bf16*)(D.dec + DEC_HB);
#pragma unroll
    for (int i = 0; i < 16; ++i) { const int row = crow(i, hi); const float v = fmaxf((acc[i] - sc[2 * row] * c1) * sc[2 * row + 1] + c2, 0.f); HB[(size_t)row * FFD + n] = (bf16)f2bf(v * v); }
    LDS_WAIT();
}
DI void dec_attn_task(const DecP& D, const float* ck, const float* cv, const float* rope, int bd, int h, int p, int lane) {
    const int g = lane >> 4, dq = lane & 15, dd = 1 << (2 * p);
    const float* PD = (const float*)(D.dec + DEC_PD) + (size_t)bd * NIN;
    const f32x4 rr0 = *(const f32x4*)(rope + ((size_t)8192 * 32 + ((4 * dq) & 31)) * 2), rr1 = *(const f32x4*)(rope + ((size_t)8192 * 32 + ((4 * dq) & 31)) * 2 + 4);
    const f32x4 cs = {rr0[0], rr0[2], rr1[0], rr1[2]}, sn = {rr0[1], rr0[3], rr1[1], rr1[3]};
    const float sgn = dq < 8 ? -1.f : 1.f;
    f32x4 q = *(const f32x4*)(PD + h * 64 + 4 * dq), kn = *(const f32x4*)(PD + 512 + h * 64 + 4 * dq); const f32x4 vn = *(const f32x4*)(PD + 1024 + h * 64 + 4 * dq);
    { f32x4 qp, kp;
#pragma unroll
      for (int e = 0; e < 4; ++e) { qp[e] = __shfl_xor(q[e], 8); kp[e] = __shfl_xor(kn[e], 8); }
      q = q * cs + qp * sn * sgn; kn = kn * cs + kp * sn * sgn; }
    if (p == 0 && g == 0) { *(f32x4*)(D.out + O_KS + ((size_t)D.l * MD + bd) * 512 + h * 64 + 4 * dq) = kn; *(f32x4*)(D.out + O_VS + ((size_t)D.l * MD + bd) * 512 + h * 64 + 4 * dq) = vn; }
    float s0 = (q[0] * kn[0] + q[1] * kn[1]) + (q[2] * kn[2] + q[3] * kn[3]);
#pragma unroll
    for (int o = 1; o < 16; o <<= 1) s0 += __shfl_xor(s0, o);
    s0 *= 0.125f;
    const size_t cbase = (((size_t)D.l * MD + bd) * 2048) * 512 + h * 64 + 4 * dq;
    float mx = -INFINITY, den = 0.f; f32x4 o4 = {0.f, 0.f, 0.f, 0.f};
#pragma unroll 8
    for (int it = 0; it < 32; ++it) { const int j = 1 + 4 * it + g; const size_t off = cbase + (size_t)(2048 - j * dd) * 512;
        const f32x4 kr = ldf4nt(ck + off); const f32x4 vr = ldf4nt(cv + off);
        float s = (q[0] * kr[0] + q[1] * kr[1]) + (q[2] * kr[2] + q[3] * kr[3]);
#pragma unroll
        for (int o = 1; o < 16; o <<= 1) s += __shfl_xor(s, o);
        s *= 0.125f;
        const float mn = fmaxf(mx, s), sc = fexp(mx - mn), pj = fexp(s - mn);
        den = den * sc + pj; o4 = o4 * sc + vr * pj; mx = mn; }
    float mg = fmaxf(mx, __shfl_xor(mx, 16)); mg = fmaxf(mg, __shfl_xor(mg, 32)); mg = fmaxf(mg, s0);
    { const float sc = fexp(mx - mg); den *= sc; o4 = o4 * sc; }
    den += __shfl_xor(den, 16); den += __shfl_xor(den, 32);
#pragma unroll
    for (int e = 0; e < 4; ++e) { o4[e] += __shfl_xor(o4[e], 16); o4[e] += __shfl_xor(o4[e], 32); }
    const float p0 = fexp(s0 - mg); den += p0; o4 = (o4 + vn * p0) * (1.0f / den); mx = mg;
    if (g == 0) *(f32x4*)((float*)(D.dec + DEC_OP) + ((size_t)p * MD + bd) * 512 + h * 64 + 4 * dq) = o4;
    if (lane == 0) ((float*)(D.dec + DEC_LSE))[((size_t)p * MD + bd) * 8 + h] = mx + __logf(den);
}
DI void dec_rwkv_task(const DecP& D, const float* const* in, int bd, int h, LAS float* sv  , int lane) {
    const int l = D.l, ch = h * 64 + lane;
    const float* PD = (const float*)(D.dec + DEC_PD) + (size_t)bd * NIN + RW0; const float* PS = (const float*)(D.dec + DEC_PS) + (size_t)bd * NRWU;
    const float* mu = in[8] + (size_t)l * 1792;
    auto zf = [&](int col) { const float pr = PD[col], pv = PS[col]; return pr + (pv - pr) * mu[col]; };
    const float zr = zf(ch), zk = zf(512 + ch), zv0 = zf(1024 + ch);
    float vl = 0.f; if (l > 0 && lane < 32) { const float pr = PD[1792 + lane], pv = PS[1792 + lane]; vl = pr + (pv - pr) * in[9][(size_t)(l - 1) * 32 + lane]; }
    sv[lane] = ftanh(zf(1536 + lane)); sv[64 + lane] = zf(1600 + lane); sv[128 + lane] = fsigmoid(zf(1664 + lane)); sv[192 + lane] = fsigmoid(zf(1728 + lane)); sv[256 + lane] = vl;
    LDS_WAIT();
    float dw = 0.f, da = 0.f, dv = 0.f, gt = 0.f;
    const float* du = in[11] + (size_t)l * 64 * 512 + ch; const float* iu = in[13] + (size_t)l * 64 * 512 + ch; const float* gu = in[14] + (size_t)l * 128 * 512 + ch;
#pragma unroll 2
    for (int m4 = 0; m4 < 16; ++m4) { const f32x4 a = *(const LAS f32x4*)(sv + 4 * m4), b = *(const LAS f32x4*)(sv + 64 + 4 * m4), c = *(const LAS f32x4*)(sv + 128 + 4 * m4), d = *(const LAS f32x4*)(sv + 192 + 4 * m4);
#pragma unroll
        for (int e = 0; e < 4; ++e) { const int m = 4 * m4 + e; dw += a[e] * du[(size_t)m * 512]; da += b[e] * iu[(size_t)m * 512]; gt += c[e] * gu[(size_t)m * 512] + d[e] * gu[(size_t)(64 + m) * 512]; } }
    if (l > 0) { const float* vu = in[16] + (size_t)(l - 1) * 32 * 512 + ch;
#pragma unroll
        for (int m4 = 0; m4 < 8; ++m4) { const f32x4 a = *(const LAS f32x4*)(sv + 256 + 4 * m4);
#pragma unroll
            for (int e = 0; e < 4; ++e) dv += a[e] * vu[(size_t)(4 * m4 + e) * 512]; } }
    const float w = -fsoftplus(-(in[10][(size_t)l * 512 + ch] + dw)) - 0.5f, decay = fexp(-fexp(w));
    const float a = fsigmoid(in[12][(size_t)l * 512 + ch] + da);
    float* VFD = (float*)(D.dec + DEC_VF) + (size_t)bd * 512 + ch;
    float v = zv0; if (l == 0) *VFD = zv0; else v = zv0 + (*VFD - zv0) * fsigmoid(in[15][(size_t)(l - 1) * 512 + ch] + dv);
    const float kr = zk * in[17][(size_t)l * 512 + ch]; const float kn = kr / fmaxf(sqrtf(wave_sum(kr * kr)), 1e-12f);
    const float k2 = zk * (1.f + (a - 1.f) * in[18][(size_t)l * 512 + ch]);
    const float bon = wave_sum(zr * k2 * in[19][(size_t)l * 512 + ch]);
    LDS_WAIT();
    sv[320 + lane] = -kn; sv[384 + lane] = decay; sv[448 + lane] = kn * a; sv[512 + lane] = k2; sv[576 + lane] = zr; sv[640 + lane] = v;
    LDS_WAIT();
    const float* S0 = in[3] + (((size_t)l * MD + bd) * NH + h) * 4096;
    float* So = D.out + O_WKS + (((size_t)l * MD + bd) * NH + h) * 4096;
    { const int rr = lane >> 4, cq = lane & 15;
      const f32x4 a4 = *(const LAS f32x4*)(sv + 320 + 4 * cq), w4 = *(const LAS f32x4*)(sv + 384 + 4 * cq), b4 = *(const LAS f32x4*)(sv + 448 + 4 * cq), k4 = *(const LAS f32x4*)(sv + 512 + 4 * cq), r4 = *(const LAS f32x4*)(sv + 576 + 4 * cq);
      f32x4 Sr[16];
#pragma unroll
      for (int q = 0; q < 16; ++q) Sr[q] = *(const f32x4*)(S0 + (size_t)(4 * q + rr) * 64 + 4 * cq);
#pragma unroll
      for (int q = 0; q < 16; ++q) { const int i = 4 * q + rr;
          float sa = (Sr[q][0] * a4[0] + Sr[q][1] * a4[1]) + (Sr[q][2] * a4[2] + Sr[q][3] * a4[3]);
#pragma unroll
          for (int o = 1; o < 16; o <<= 1) sa += __shfl_xor(sa, o);
          const float vi = sv[640 + i];
          const f32x4 s4 = Sr[q] * w4 + b4 * sa + k4 * vi; *(f32x4*)(So + (size_t)i * 64 + 4 * cq) = s4;
          float yp = (s4[0] * r4[0] + s4[1] * r4[1]) + (s4[2] * r4[2] + s4[3] * r4[3]);
#pragma unroll
          for (int o = 1; o < 16; o <<= 1) yp += __shfl_xor(yp, o);
          if (cq == 0) sv[704 + i] = yp; } }
    LDS_WAIT();
    const float y = sv[704 + lane];
    const float mean = wave_sum(y) * (1.f / 64.f), dy = y - mean, var = wave_sum(dy * dy) * (1.f / 64.f);
    const float o = (dy * (1.0f / sqrtf(var + GN_EPS)) * in[20][(size_t)l * 512 + ch] + in[21][(size_t)l * 512 + ch] + bon * v) * gt;
    ((float*)(D.dec + DEC_MIX))[(size_t)bd * DM + 512 + ch] = o;
    LDS_WAIT();
}
DI void dec_finalize_row(const DecP& D, const float* gain, int bd, int lane) {
    const int h = lane >> 3; const float* L = (const float*)(D.dec + DEC_LSE); const float* OPD = (const float*)(D.dec + DEC_OP);
    const float l0 = L[((size_t)0 * MD + bd) * 8 + h], l1 = L[((size_t)1 * MD + bd) * 8 + h], l2 = L[((size_t)2 * MD + bd) * 8 + h];
    const float mx = fmaxf(l0, fmaxf(l1, l2)); float w0 = fexp(l0 - mx), w1 = fexp(l1 - mx), w2 = fexp(l2 - mx); const float inv = 1.0f / (w0 + w1 + w2); w0 *= inv; w1 *= inv; w2 *= inv;
    float v[8]; float ss = 0.f;
#pragma unroll
    for (int e = 0; e < 8; ++e) { v[e] = w0 * OPD[((size_t)0 * MD + bd) * 512 + lane * 8 + e] + w1 * OPD[((size_t)1 * MD + bd) * 512 + lane * 8 + e] + w2 * OPD[((size_t)2 * MD + bd) * 512 + lane * 8 + e]; ss += v[e] * v[e]; }
    ss = wave_sum(ss); const float rinv = 1.0f / sqrtf(ss * (1.f / 512.f) + RMS_EPS);
    bf16* MB = (bf16*)(D.dec + DEC_MIXB) + (size_t)bd * DM; const float* MX = (const float*)(D.dec + DEC_MIX) + (size_t)bd * DM + 512;
#pragma unroll
    for (int e = 0; e < 8; ++e) { MB[lane * 8 + e] = (bf16)f2bf(v[e] * rinv * gain[lane * 8 + e]); MB[512 + lane * 8 + e] = (bf16)f2bf(MX[lane * 8 + e]); }
}
#ifndef PH_MASK
#define PH_MASK 0x1ff
#endif
#define PH_ON(k) ((PH_MASK >> (k)) & 1)
#ifndef PH_DUP
#define PH_DUP 0
#endif
#define PH_REP(k) for (int rep_ = 0; rep_ < (((PH_DUP >> (k)) & 1) ? 2 : 1); ++rep_)
DI unsigned lds_task_next(volatile LAS unsigned* ctr, int lane) {
    unsigned t = 0; if (lane == 0) t = __hip_atomic_fetch_add((LAS unsigned*)ctr, 1u, __ATOMIC_RELAXED, __HIP_MEMORY_SCOPE_WORKGROUP);
    return (unsigned)__builtin_amdgcn_readfirstlane((int)t);
}
DI DecP make_dec(unsigned char* ws, const float* const* in, float* out, int l) {
    DecP D; D.dec = ws + WS_DEC; D.l = l; D.xs = in[1];
    D.c1in = (const float*)(ws + WS_C1IN) + l * NIN; D.c2in = (const float*)(ws + WS_C2IN) + l * NIN; D.c1up = (const float*)(ws + WS_C1UP) + l * FFD; D.c2up = (const float*)(ws + WS_C2UP) + l * FFD;
    D.g1 = in[24] + (size_t)l * DM; D.b1 = in[25] + (size_t)l * DM; D.g2p = l > 0 ? in[28] + (size_t)(l - 1) * DM : nullptr; D.b2p = l > 0 ? in[29] + (size_t)(l - 1) * DM : nullptr;
    D.win = (const bf16*)(ws + WS_WIN) + (size_t)l * NIN * DM; D.winu = (const bf16*)(ws + WS_WINU) + (size_t)l * NRWU * DM; D.wout = (const bf16*)(ws + WS_WOUT) + (size_t)l * DM * DM;
    D.wup = (const bf16*)(ws + WS_WUP) + (size_t)l * FFD * DM; D.wdn = (const bf16*)(ws + WS_WDN) + (size_t)l * DM * FFD; D.out = out; return D;
}
DI RwkvP make_rwkv(unsigned char* ws, const float* const* in, int l) {
    RwkvP R; R.PR = (const bf16*)(ws + WS_PR); R.mu = in[8] + (size_t)l * 1792; R.muv = l > 0 ? in[9] + (size_t)(l - 1) * 32 : nullptr;
    R.dbase = in[10] + (size_t)l * 512; R.ibase = in[12] + (size_t)l * 512; R.vbase = l > 0 ? in[15] + (size_t)(l - 1) * 512 : nullptr; R.ksk = in[17] + (size_t)l * 512; R.ksa = in[18] + (size_t)l * 512; R.brk = in[19] + (size_t)l * 512;
    R.gng = in[20] + (size_t)l * 512; R.gnb = in[21] + (size_t)l * 512;
    R.dupT = (const bf16*)(ws + WS_DUPT) + (size_t)l * 512 * 64; R.iupT = (const bf16*)(ws + WS_IUPT) + (size_t)l * 512 * 64; R.vupT = l > 0 ? (const bf16*)(ws + WS_VUPT) + (size_t)(l - 1) * 512 * 32 : nullptr; R.gupT = (const bf16*)(ws + WS_GUPT) + (size_t)l * 512 * 128;
    R.ZROW = (const bf16*)(ws + WS_CTL + 512 * 1024); R.VF = (bf16*)(ws + WS_VF); R.VV = (bf16*)(ws + WS_VV); R.BON = (float*)(ws + WS_BON); R.GC = (float*)(ws + WS_GC); R.W1S = (bf16*)(ws + WS_PT); R.REFF = (bf16*)(ws + WS_REFF); R.BM = (bf16*)(ws + WS_QT); R.REC = (v4u*)(ws + WS_YLOC);
    R.YPRE = (float*)(ws + WS_YPRE); R.MIX = (bf16*)(ws + WS_MIX); R.layer0 = (l == 0); return R;
}
#define PHASE_VARS() int tid_p = (int)threadIdx.x; asm volatile("" : "+v"(tid_p)); const int lane = tid_p & 63; const int wave = __builtin_amdgcn_readfirstlane(tid_p >> 6); \
    unsigned zo_p; asm volatile("s_mov_b32 %0, 0" : "=s"(zo_p)); unsigned char* ws = args.ws + zo_p; const float* const* in = args.in + zo_p; float* out = args.out + zo_p; \
    const int gw = F.vcu * NWAVES + wave; const int rgw = (F.G - 1 - (int)blockIdx.x) * NWAVES + wave; LAS float* dsc = (LAS float*)(L3 + 65536); LAS float* dred = (LAS float*)L3; const int rwg = F.G - 1 - (int)blockIdx.x; (void)gw; (void)rgw; (void)dsc; (void)dred; (void)rwg; (void)lane; (void)in; (void)out
__global__ void __launch_bounds__(NWAVES * 64, 2) mega_fwd(Args args) {
    extern __shared__ __attribute__((aligned(16))) unsigned char lds[];
    Frame F;
    F.lds = lds; F.MISC = (volatile LAS unsigned*)((LAS unsigned char*)lds + MISC_OFF);
    F.tid = threadIdx.x; F.lane = F.tid & 63; F.wave = __builtin_amdgcn_readfirstlane(F.tid >> 6);
    F.G = gridDim.x; { const int bx = blockIdx.x; F.vcu = (F.G % 8 == 0) ? (bx % 8) * (F.G / 8) + bx / 8 : bx; }
    F.gw = F.vcu * NWAVES + F.wave; F.NGW = F.G * NWAVES;
    F.in = args.in; F.out = args.out; F.ws = args.ws; F.ctl = (gu32*)(args.ws + WS_CTL);
    LAS unsigned char* L3 = (LAS unsigned char*)lds;
    for (int u = F.tid; u < (LDS_BYTES - RING_BYTES) / 4; u += NWAVES * 64) ((LAS unsigned*)(L3 + RING_BYTES))[u] = 0u;
    __syncthreads();
    XcdBarrier bar = xcd_barrier_post((unsigned*)(F.ctl + CW_BAR), F.MISC + 8);
#define GRID_BAR() do { XcdBarrier b2_ = bar; asm volatile("" : "+s"(b2_.x)); xcd_barrier(b2_); } while (0)

    PH_REP(0) { if (PH_ON(0)) p0_prologue(F);
    GRID_BAR(); }

    for (int l = 0; l < DEPTH; ++l) {
        PH_REP(1) {
        if (PH_ON(1))
        {   PHASE_VARS(); const DecP D = make_dec(ws, in, out, l);
            pg8::Gemm g{(const pg8::bf16_t*)(ws + WS_XB2), (const pg8::bf16_t*)D.win, M, NIN, DM}; pg8::StaticOrder S; S.init(M, NIN, F.G, (int)blockIdx.x);
            pg8::etab_fill((PG8_LAS unsigned char*)L3, S, (const float*)(ws + WS_STAT2), D.c1in, D.c2in, l > 0, tid_p); __syncthreads();
            pg8::EpiIn E{ws, out, l, (const PG8_LAS unsigned char*)L3};
            pg8::gemm_phase<pg8::EpiIn, pg8::StaticOrder, true, true>((PG8_LAS unsigned char*)L3, g, S, E, tid_p);
            for (int u = rwg; u < 162; u += F.G) dec_unit_in(D, u, dred, dsc, wave, lane);
        }
        GRID_BAR();
        }

#define ATT_QUEUE() do { LAS unsigned char* wl_ = L3 + wave * 10240; const int bh_ = F.vcu >> 4, span_ = F.vcu & 15; \
        for (;;) { const unsigned t_ = lds_task_next(F.MISC, lane); if (t_ >= 48u) break; \
            if (t_ >= 48u) { const int dt_ = (int)blockIdx.x * 4 + (int)(t_ - 48u); \
                if (dt_ < 768) dec_attn_task(D, in[4], in[5], (const float*)(ws + WS_ROPE), dt_ / 24, (dt_ % 24) / 3, dt_ % 3, lane); \
                else dec_rwkv_task(D, in, (dt_ - 768) >> 3, (dt_ - 768) & 7, (LAS float*)wl_, lane); continue; } \
            const int p_ = (int)t_ >> 4, idx_ = (int)t_ & 15; \
            const int cls_ = p_ == 0 ? 0 : p_ == 1 ? (idx_ >> 2) : idx_, qblk_ = p_ == 0 ? span_ * 16 + idx_ : p_ == 1 ? span_ * 4 + (idx_ & 3) : span_; \
            attn_task((const bf16*)(ws + WS_QB), (const bf16*)(ws + WS_KB), (const bf16*)(ws + WS_VB), (bf16*)(ws + WS_OP), (float*)(ws + WS_LSE), bh_ >> 3, bh_ & 7, p_, cls_, qblk_, wl_, lane); } } while (0)
        PH_REP(3) {
        if (PH_ON(3))
        {   PHASE_VARS(); const DecP D = make_dec(ws, in, out, l); const RwkvP R = make_rwkv(ws, in, l);
            if (tid_p == 0) F.MISC[0] = 0u;
            if (l == 0) colsum_finish(ws, gw * 64 + lane, F.NGW * 64);
            { LAS unsigned char* wl1 = L3 + wave * 12288; LAS unsigned char* hc = L3 + 8 * 12288;
              head_cache_fill(R, (F.vcu >> 4) & 7, hc, tid_p);
              __syncthreads();
#pragma unroll 1
              for (int i = 0; i < 4; ++i) rwkv_b1_unit(R, F.vcu * 32 + wave + 8 * i, wl1, hc, (LAS float*)(L3 + GCT_OFF), lane); }
            VM_WAIT(); __syncthreads();
            if (wave >= 4) { const int dt = (int)blockIdx.x * 4 + (wave - 4);
                if (dt < 768) dec_attn_task(D, in[4], in[5], (const float*)(ws + WS_ROPE), dt / 24, (dt % 24) / 3, dt % 3, lane);
                else dec_rwkv_task(D, in, (dt - 768) >> 3, (dt - 768) & 7, (LAS float*)(L3 + wave * 10240), lane); }
            if (wave < 4) chain_pass1(R, (float*)(ws + WS_SEGQ), (float*)(ws + WS_SEGP), F.vcu >> 4, F.vcu & 15, wave, (const LAS float*)(L3 + GCT_OFF), lane);
            ATT_QUEUE();
            if ((PH_DUP >> 12) & 1) { __syncthreads(); if (tid_p == 0) F.MISC[0] = 0u; __syncthreads(); ATT_QUEUE(); }
        }
        GRID_BAR();
        }
        PH_REP(9) {
        if (PH_ON(3))
        {   PHASE_VARS(); const DecP D = make_dec(ws, in, out, l); const RwkvP R = make_rwkv(ws, in, l);
            const int seq = F.vcu >> 4, sg = F.vcu & 15;
            LAS unsigned char* gcache = L3 + 98304; gate_cache_fill(R, seq & 7, gcache, tid_p);
            for (int e = tid_p; e < SEGCH * 64; e += NWAVES * 64) ((LAS float*)(L3 + GCT_OFF))[e] = R.GC[(size_t)(seq * NCH + sg * SEGCH) * 64 + e];
            __syncthreads();
            if (wave < 4) chain_pass23(R, (const float*)(ws + WS_SEGQ), (const float*)(ws + WS_SEGP), seq, sg, wave, out + O_WKP + ((size_t)l * 16 + seq) * 4096, (const LAS float*)(L3 + GCT_OFF), lane);
            else { for (int i = 0; i < 16; ++i) attn_finalize_row((const bf16*)(ws + WS_OP), (const float*)(ws + WS_LSE), in[22] + (size_t)l * 512, (bf16*)(ws + WS_MIX), (int)blockIdx.x * 64 + (wave - 4) * 16 + i, lane);
                if (blockIdx.x < MD && wave == 4) dec_finalize_row(D, in[22] + (size_t)l * 512, (int)blockIdx.x, lane); }
            VM_WAIT(); __syncthreads();
#pragma unroll 1
            for (int i = 0; i < 4; ++i) rwkv_b3_unit(R, seq * NCH + sg * SEGCH + wave + 8 * i, gcache, L3 + wave * 12288, lane);
        }
        GRID_BAR();
        }

        PH_REP(5) {
        if (PH_ON(5))
        {   PHASE_VARS(); const DecP D = make_dec(ws, in, out, l);
            pg8::Gemm g{(const pg8::bf16_t*)(ws + WS_MIX), (const pg8::bf16_t*)D.wout, M, DM, DM}; pg8::StaticOrder S; S.init(M, DM, F.G, (int)blockIdx.x);
            pg8::EpiRes<false> E{ws, in, out, l};
            pg8::gemm_phase<pg8::EpiRes<false>, pg8::StaticOrder, false, true>((PG8_LAS unsigned char*)L3, g, S, E, tid_p);
            for (int u = rwg; u < 32; u += F.G)
                dec_unit_res((const bf16*)(D.dec + DEC_MIXB), D.wout, DM, u, l == 0, l == 0 ? D.xs : (const float*)(D.dec + DEC_T2), (const float*)(D.dec + DEC_ST2), D.g2p, D.b2p, (float*)(D.dec + DEC_T1), (bf16*)(D.dec + DEC_XB1), (float*)(D.dec + DEC_ST1),
                             out + O_SHS + (size_t)l * MD * DM, dred, dsc, wave, lane);
        }
        GRID_BAR();
        }

        PH_REP(6) {
        if (PH_ON(6))
        {   PHASE_VARS(); const DecP D = make_dec(ws, in, out, l);
            pg8::Gemm g{(const pg8::bf16_t*)(ws + WS_XB1), (const pg8::bf16_t*)D.wup, M, FFD, DM}; pg8::StaticOrder S; S.init(M, FFD, F.G, (int)blockIdx.x);
            pg8::etab_fill((PG8_LAS unsigned char*)L3, S, (const float*)(ws + WS_STAT1), D.c1up, D.c2up, true, tid_p); __syncthreads();
            pg8::EpiUp E{ws, (const PG8_LAS unsigned char*)L3};
            pg8::gemm_phase<pg8::EpiUp, pg8::StaticOrder, true, true>((PG8_LAS unsigned char*)L3, g, S, E, tid_p);
            for (int u = rwg; u < 128; u += F.G) dec_unit_up(D, u, dred, dsc, wave, lane);
        }
        GRID_BAR();
        }

        PH_REP(7) {
        if (PH_ON(7))
        {   PHASE_VARS(); const DecP D = make_dec(ws, in, out, l);
            pg8::Gemm g{(const pg8::bf16_t*)(ws + WS_H), (const pg8::bf16_t*)D.wdn, M, DM, FFD}; pg8::StaticOrder S; S.init(M, DM, F.G, (int)blockIdx.x);
            pg8::EpiRes<true> E{ws, in, out, l};
            PH_REP(11) { pg8::gemm_phase<pg8::EpiRes<true>, pg8::StaticOrder, false, true>((PG8_LAS unsigned char*)L3, g, S, E, tid_p); }
            PH_REP(10) for (int u = rwg; u < 32; u += F.G)
                dec_unit_res((const bf16*)(D.dec + DEC_HB), D.wdn, FFD, u, false, (const float*)(D.dec + DEC_T1), (const float*)(D.dec + DEC_ST1), D.g1, D.b1, (float*)(D.dec + DEC_T2), (bf16*)(D.dec + DEC_XB2), (float*)(D.dec + DEC_ST2), nullptr, dred, dsc, wave, lane);
        }
        GRID_BAR();
        }
    }
    if (PH_ON(8))
    {   PHASE_VARS(); const float* g = in[28] + (size_t)3 * DM; const float* b = in[29] + (size_t)3 * DM;
        for (int r = gw; r < M; r += F.NGW) { float mu, rs; pg8::row_stats((const float*)(ws + WS_STAT2), r, mu, rs);
            const v2u* t = (const v2u*)((const bf16*)(ws + WS_XB2) + (size_t)r * DM) + lane; f32x4* o = (f32x4*)(out + O_Y + (size_t)r * DM) + lane;
#pragma unroll
            for (int j = 0; j < 4; ++j) { const f32x4 gg = *((const f32x4*)g + lane + 64 * j), bb = *((const f32x4*)b + lane + 64 * j); const v2u w = t[64 * j]; const f32x4 tv = {bflo(w.x), bfhi(w.x), bflo(w.y), bfhi(w.y)}; o[64 * j] = (tv - mu) * rs * gg + bb; } }
        if (rgw < MD) { LAS float* fsc = dsc + wave * 64; dec_row_stats((const float*)(ws + WS_DEC + DEC_ST2), fsc, lane); const float mu = fsc[2 * rgw], rs = fsc[2 * rgw + 1];
            const f32x4* t = (const f32x4*)((const float*)(ws + WS_DEC + DEC_T2) + (size_t)rgw * DM) + lane; f32x4* o = (f32x4*)(out + O_YS + (size_t)rgw * DM) + lane;
#pragma unroll
            for (int j = 0; j < 4; ++j) { const f32x4 gg = *((const f32x4*)g + lane + 64 * j), bb = *((const f32x4*)b + lane + 64 * j); o[64 * j] = (t[64 * j] - mu) * rs * gg + bb; } }
    }
}

extern "C" void kernel_launch(void* const* d_in, const int* in_sizes, int n_in, void* d_out, int out_size, void* d_ws, size_t ws_size, hipStream_t stream) {
    static int grid = 0;
    if (grid == 0) {
        if (n_in != 30 || out_size != (int)O_END || ws_size < WS_END) { fprintf(stderr, "kernel_launch: unexpected problem (n_in %d, out %d, ws %zu); nothing launched\n", n_in, out_size, ws_size); grid = -1; return; }
        int dev = 0, cus = 0, per_cu = 0;
        if (hipGetDevice(&dev) != hipSuccess || hipDeviceGetAttribute(&cus, hipDeviceAttributeMultiprocessorCount, dev) != hipSuccess) { fprintf(stderr, "kernel_launch: device query failed\n"); grid = -1; return; }
        if (hipFuncSetAttribute((const void*)mega_fwd, hipFuncAttributeMaxDynamicSharedMemorySize, LDS_BYTES) != hipSuccess) { fprintf(stderr, "kernel_launch: hipFuncSetAttribute failed\n"); grid = -1; return; }
        if (hipOccupancyMaxActiveBlocksPerMultiprocessor(&per_cu, (const void*)mega_fwd, NWAVES * 64, LDS_BYTES) != hipSuccess || per_cu < 1) fprintf(stderr, "kernel_launch: occupancy query reports %d\n", per_cu);
        (void)hipGetLastError();
        if (cus < 256) { fprintf(stderr, "kernel_launch: needs 256 CUs (found %d)\n", cus); grid = -1; return; }
        grid = 256;
    }
    if (grid < 0) return;
    if (hipMemsetAsync((char*)d_ws + WS_CTL, 0, CTL_ZERO_BYTES, stream) != hipSuccess) { fprintf(stderr, "kernel_launch: memset failed\n"); return; }
    Args a{};
    for (int i = 0; i < 30; ++i) a.in[i] = (const float*)d_in[i];
    a.out = (float*)d_out; a.ws = (unsigned char*)d_ws;
    hipLaunchKernelGGL(mega_fwd, dim3(grid), dim3(NWAVES * 64), LDS_BYTES, stream, a);
    const hipError_t le = hipPeekAtLastError();
    if (le != hipSuccess) fprintf(stderr, "kernel_launch: launch failed: %s\n", hipGetErrorName(le));
}
```

```cpp
#include <hip/hip_runtime.h>
#include <cstdio>
#include <cstdint>
#include <cmath>
namespace pg8 {
#define PG8_LAS __attribute__((address_space(3)))
typedef unsigned short bf16_t;
typedef short bf16x8 __attribute__((ext_vector_type(8)));
typedef float f32x4 __attribute__((ext_vector_type(4)));
typedef unsigned u32x4 __attribute__((ext_vector_type(4)));
constexpr int BM = 256, BK = 64, HALF = 128, HTB = HALF * BK * 2  , STAGE_BYTES = 8 * HTB, NXCD = 8, WGM = 8;

__host__ __device__ __forceinline__ int lds_byte(int r, int c) { const int st = (r >> 4) * 2 + (c >> 5), rr = r & 15, cc = c & 31, ob = rr * 64 + cc * 2; return st * 1024 + (ob ^ (((ob >> 9) & 1) << 5)); }
__host__ __device__ __forceinline__ void stage_rc(int b, int& R, int& C) { const int st = b / 1024, sb = b % 1024, swz = sb ^ (((sb >> 9) & 1) << 5); R = (st >> 1) * 16 + swz / 64; C = (st & 1) * 32 + (swz % 64) / 2; }
__host__ __device__ __forceinline__ int perm32(int rho) { const int n = rho >> 4, i = rho & 15; return 8 * (i >> 2) + 4 * n + (i & 3); }

struct Unit { int pm, pn; };
struct Gemm { const bf16_t* A; const bf16_t* Bt; int M, N, K; };

struct StaticOrder {
    int nM, nN, nwg, G, c;
    __host__ __device__ void init(int M, int N, int G_, int c_) { nM = M / BM; nN = N / BM; nwg = nM * nN; G = G_; c = c_; }
    __host__ __device__ bool next(int i, Unit& u) const {
        const long L = (long)i * G + c; if (L >= nwg) return false;
        int wgid = (int)L; { const int q = nwg / NXCD, r = nwg % NXCD, xcd = wgid % NXCD, off = wgid / NXCD; wgid = (xcd < r ? xcd * (q + 1) : r * (q + 1) + (xcd - r) * q) + off; }
        const int nig = WGM * nN, gid = wgid / nig, fm = gid * WGM, gsz = (nM - fm) < WGM ? (nM - fm) : WGM;
        u.pm = fm + ((wgid % nig) % gsz); u.pn = (wgid % nig) / gsz; return true;
    }
    __device__ __forceinline__ void a_ready(const Unit&) const {}
    __device__ __forceinline__ void done(const Unit&) const {}
};

__device__ __forceinline__ unsigned cvt_pk_bf16(float lo, float hi) { unsigned r; asm volatile("v_cvt_pk_bf16_f32 %0, %1, %2" : "=v"(r) : "v"(lo), "v"(hi)); return r; }
typedef float f32x2 __attribute__((ext_vector_type(2)));
constexpr size_t WSO_C1IN = 1u << 20, WSO_C2IN = WSO_C1IN + 4 * 3584 * 4, WSO_C1UP = WSO_C2IN + 4 * 3584 * 4, WSO_C2UP = WSO_C1UP + 4 * 4096 * 4, WSO_ROPE = 3u << 20, WSO_STAT1 = 8u << 20, WSO_STAT2 = 9u << 20;
constexpr size_t WSO_XB2 = 132ull << 20, WSO_XB1 = 164ull << 20, WSO_T1 = 196ull << 20, WSO_T2 = 260ull << 20, WSO_QB = 324ull << 20, WSO_KB = 340ull << 20, WSO_VB = 356ull << 20, WSO_PR = 372ull << 20, WSO_H = 580ull << 20;
constexpr size_t OO_SHP = 16809984, OO_KP = 21405696, OO_VP = 29794304;
__device__ __forceinline__ void row_stats(const float* stat, int row, float& mu, float& rs) {
    const f32x4 a = *(const f32x4*)(stat + (size_t)row * 8), b = *(const f32x4*)(stat + (size_t)row * 8 + 4);
    const float s = (a[0] + a[2]) + (b[0] + b[2]), q = (a[1] + a[3]) + (b[1] + b[3]);
    mu = s * (1.f / 1024.f); const float var = fmaxf(q * (1.f / 1024.f) - mu * mu, 0.f); rs = 1.0f / sqrtf(var + 1e-5f);
}
typedef float f32x2e __attribute__((ext_vector_type(2)));
typedef unsigned u32x2e __attribute__((ext_vector_type(2)));
constexpr int ETAB_OFF = 132096, ETAB_SLOT = 4096;
constexpr int ETAB_IDS = ETAB_OFF + 4 * ETAB_SLOT;
template <class Sched> __device__ __forceinline__ void etab_fill(PG8_LAS unsigned char* lds0, const Sched& S, const float* stat, const float* c1, const float* c2, bool fold, int tid) {
#pragma unroll 1
    for (int i = 0; i < 4; ++i) { Unit u; const bool ok = S.next(i, u);
        if (tid == 0) { ((PG8_LAS int*)(lds0 + ETAB_IDS))[2 * i] = ok ? u.pm : -1; ((PG8_LAS int*)(lds0 + ETAB_IDS))[2 * i + 1] = ok ? u.pn : -1; }
        if (!ok) continue;
        PG8_LAS unsigned char* slot = lds0 + ETAB_OFF + i * ETAB_SLOT;
        if (tid < 256) { float mu = 0.f, rs = 1.f; if (fold) row_stats(stat, u.pm * BM + tid, mu, rs); ((PG8_LAS f32x2e*)slot)[tid] = (f32x2e){mu, rs}; }
        else { const int c = u.pn * BM + tid - 256; ((PG8_LAS float*)(slot + 2048))[tid - 256] = fold ? c1[c] : 0.f; ((PG8_LAS float*)(slot + 3072))[tid - 256] = fold ? c2[c] : 0.f; }
    }
}
__device__ __forceinline__ const PG8_LAS unsigned char* etab_find(const PG8_LAS unsigned char* lds0, const Unit& u) {
    const PG8_LAS int* ids = (const PG8_LAS int*)(lds0 + ETAB_IDS); int s = 0;
#pragma unroll
    for (int i = 1; i < 4; ++i) if (ids[2 * i] == u.pm && ids[2 * i + 1] == u.pn) s = i;
    return lds0 + ETAB_OFF + s * ETAB_SLOT;
}
struct EpiIn {
    static constexpr bool PERM = true, AFTER_DRAIN = false;
    unsigned char* ws; float* out; int l; const PG8_LAS unsigned char* lds0;
    __device__ __forceinline__ void operator()(const f32x4 (&acc)[2][2][4][2], const Unit& u, int wr, int wc, int fr, int fq) const {
        asm volatile("" ::: "memory"); __builtin_amdgcn_sched_barrier(0);
        const PG8_LAS unsigned char* slot = etab_find(lds0, u);
        const PG8_LAS f32x2e* st = (const PG8_LAS f32x2e*)slot; const PG8_LAS float* tc1 = (const PG8_LAS float*)(slot + 2048); const PG8_LAS float* tc2 = (const PG8_LAS float*)(slot + 3072);
        bf16_t* QB = (bf16_t*)(ws + WSO_QB); bf16_t* KB = (bf16_t*)(ws + WSO_KB); bf16_t* VB = (bf16_t*)(ws + WSO_VB); bf16_t* PR = (bf16_t*)(ws + WSO_PR); const float* rope = (const float*)(ws + WSO_ROPE);
        float* outk = out + OO_KP + (size_t)l * 2 * 2048 * 512; float* outv = out + OO_VP + (size_t)l * 2 * 2048 * 512; const float qscale = 0.125f * 1.4426950408889634f;
        const int cb = u.pn * BM + wc * 32 + 8 * fq;
        const int i0 = 16 * (wc & 1) + 4 * fq; const bool roped = u.pn < 4;
        const int rbase = u.pm * BM + wr * 64 + fr;
        const int cl = wc * 32 + 8 * fq;
#pragma unroll
        for (int bj = 0; bj < 2; ++bj) {
            f32x4 c1v[2], c2v[2];
#pragma unroll
            for (int n = 0; n < 2; ++n) { c1v[n] = *(const PG8_LAS f32x4*)(tc1 + cl + bj * HALF + n * 4); c2v[n] = *(const PG8_LAS f32x4*)(tc2 + cl + bj * HALF + n * 4); }
            f32x4 ran = {0.f, 0.f, 0.f, 0.f}, rbn = ran;
#pragma unroll
            for (int gq = 0; gq < 8; ++gq) {
                const int ai = gq >> 2, m = gq & 3;
                const int r = rbase + ai * HALF + m * 16;
                const f32x2e ms = st[ai * HALF + wr * 64 + m * 16 + fr]; const float mu = ms.x, rs = ms.y;
                if (gq == 0 && roped) { const float* rp = rope + ((size_t)(r & 8191) * 32 + i0) * 2; ran = *(const f32x4*)rp; rbn = *(const f32x4*)(rp + 4); }
                const f32x4 ra = ran, rb = rbn;
                if (roped && gq < 7) { const int rn = rbase + ((gq + 1) >> 2) * HALF + ((gq + 1) & 3) * 16; const float* rp = rope + ((size_t)(rn & 8191) * 32 + i0) * 2; ran = *(const f32x4*)rp; rbn = *(const f32x4*)(rp + 4); }
                asm volatile("" ::: "memory");
                f32x4 v[2];
#pragma unroll
                for (int n = 0; n < 2; ++n) v[n] = (acc[ai][bj][m][n] - mu * c1v[n]) * rs + c2v[n];
                const int pos = r & 8191, b = r >> 13;
                if (roped) {
                    const f32x4 cs = {ra[0], ra[2], rb[0], rb[2]}, sn = {ra[1], ra[3], rb[1], rb[3]};
                    const int head = (u.pn & 1) * 4 + bj * 2 + (wc >> 1);
                    f32x4 y1 = v[0] * cs - v[1] * sn, y2 = v[0] * sn + v[1] * cs;
                    const size_t o = (size_t)r * 512 + head * 64 + i0;
                    if (u.pn < 2) { y1 = y1 * qscale; y2 = y2 * qscale;
                        u32x2e w; w.x = cvt_pk_bf16(y1[0], y1[1]); w.y = cvt_pk_bf16(y1[2], y1[3]); *(u32x2e*)(QB + o) = w;
                        w.x = cvt_pk_bf16(y2[0], y2[1]); w.y = cvt_pk_bf16(y2[2], y2[3]); *(u32x2e*)(QB + o + 32) = w;
                    } else {
                        u32x2e w; w.x = cvt_pk_bf16(y1[0], y1[1]); w.y = cvt_pk_bf16(y1[2], y1[3]); *(u32x2e*)(KB + o) = w;
                        w.x = cvt_pk_bf16(y2[0], y2[1]); w.y = cvt_pk_bf16(y2[2], y2[3]); *(u32x2e*)(KB + o + 32) = w;
                        if (pos >= 6144) { float* ok = outk + ((size_t)(b * 2048 + pos - 6144)) * 512 + head * 64 + i0; *(f32x4*)ok = y1; *(f32x4*)(ok + 32) = y2; }
                    }
                } else if (u.pn < 6) {
                    const int c = cb + bj * HALF - 1024;
                    u32x4 w; w.x = cvt_pk_bf16(v[0][0], v[0][1]); w.y = cvt_pk_bf16(v[0][2], v[0][3]); w.z = cvt_pk_bf16(v[1][0], v[1][1]); w.w = cvt_pk_bf16(v[1][2], v[1][3]); *(u32x4*)(VB + (size_t)r * 512 + c) = w;
                    if (pos >= 6144) { float* ov = outv + ((size_t)(b * 2048 + pos - 6144)) * 512 + c; *(f32x4*)ov = v[0]; *(f32x4*)(ov + 4) = v[1]; }
                } else {
                    const int c = cb + bj * HALF - 1536;
                    if (c < 1824) { u32x4 w; w.x = cvt_pk_bf16(v[0][0], v[0][1]); w.y = cvt_pk_bf16(v[0][2], v[0][3]); w.z = cvt_pk_bf16(v[1][0], v[1][1]); w.w = cvt_pk_bf16(v[1][2], v[1][3]); *(u32x4*)(PR + (size_t)r * 2048 + c) = w; }
                }
            }
        }
    }
};
template <bool IS_F> struct EpiRes {
    static constexpr bool PERM = true, AFTER_DRAIN = true;
    unsigned char* ws; const float* const* in; float* out; int l;
    __device__ __forceinline__ void fused(f32x4 (&acc)[2][2][4][2], const Unit& u, int wr, int wc, int fr, int fq, PG8_LAS unsigned char* lds, int wid, int lane) const {
        const int raw = (!IS_F && l == 0) ? 1 : 0;
        const bf16_t* src = (const bf16_t*)(ws + (IS_F ? WSO_XB1 : WSO_XB2));
        const float* sstat = (const float*)(ws + (IS_F ? WSO_STAT1 : WSO_STAT2));
        const float* g = IS_F ? in[24] + (size_t)l * 1024 : in[28] + (size_t)(l > 0 ? l - 1 : 0) * 1024; const float* b = IS_F ? in[25] + (size_t)l * 1024 : in[29] + (size_t)(l > 0 ? l - 1 : 0) * 1024;
        bf16_t* XB = (bf16_t*)(ws + (IS_F ? WSO_XB2 : WSO_XB1)); float* ostat = (float*)(ws + (IS_F ? WSO_STAT2 : WSO_STAT1));
        float* shiftout = (IS_F || raw) ? nullptr : out + OO_SHP + (size_t)l * 2 * 1024; const float alpha = 1.6817928305074290f;
        PG8_LAS f32x2e* P = (PG8_LAS f32x2e*)lds;
        const int cb = u.pn * BM + wc * 32 + 8 * fq;
        const int rbase = u.pm * BM + wr * 64 + fr;
        u32x4 cur[2], nxt[2]; f32x4 sa = {0.f, 0.f, 0.f, 0.f}, sb = sa, san = sa, sbn = sa;
#pragma unroll
        for (int bj = 0; bj < 2; ++bj) { cur[bj] = *(const u32x4*)(src + (size_t)rbase * 1024 + cb + bj * HALF); nxt[bj] = cur[bj]; }
        if (!raw) { sa = *(const f32x4*)(sstat + (size_t)rbase * 8); sb = *(const f32x4*)(sstat + (size_t)rbase * 8 + 4); }
#pragma unroll
        for (int gq = 0; gq < 8; ++gq) {
            const int ai = gq >> 2, m = gq & 3;
            const int r = rbase + ai * HALF + m * 16;
            if (gq < 7) { const int rn = rbase + ((gq + 1) >> 2) * HALF + ((gq + 1) & 3) * 16;
#pragma unroll
                for (int bj = 0; bj < 2; ++bj) nxt[bj] = *(const u32x4*)(src + (size_t)rn * 1024 + cb + bj * HALF);
                if (!raw) { san = *(const f32x4*)(sstat + (size_t)rn * 8); sbn = *(const f32x4*)(sstat + (size_t)rn * 8 + 4); } }
            asm volatile("" ::: "memory");
            float mu = 0.f, rs = 1.f;
            if (!raw) { const float ssum = (sa[0] + sa[2]) + (sb[0] + sb[2]), qsum = (sa[1] + sa[3]) + (sb[1] + sb[3]); mu = ssum * (1.f / 1024.f); rs = 1.0f / sqrtf(fmaxf(qsum * (1.f / 1024.f) - mu * mu, 0.f) + 1e-5f); }
            float s = 0.f, q = 0.f;
#pragma unroll
            for (int bj = 0; bj < 2; ++bj) { const int c = cb + bj * HALF; const size_t off = (size_t)r * 1024 + c; const u32x4 cw = cur[bj]; u32x4 wout;
#pragma unroll
                for (int n = 0; n < 2; ++n) {
                    const f32x4 gvv = raw ? (f32x4){1.f, 1.f, 1.f, 1.f} : *(const f32x4*)(g + c + 4 * n), bvv = raw ? (f32x4){0.f, 0.f, 0.f, 0.f} : *(const f32x4*)(b + c + 4 * n);
                    const unsigned w0 = n ? cw.z : cw.x, w1 = n ? cw.w : cw.y;
                    const f32x4 cf = {__builtin_bit_cast(float, w0 << 16), __builtin_bit_cast(float, w0 & 0xffff0000u), __builtin_bit_cast(float, w1 << 16), __builtin_bit_cast(float, w1 & 0xffff0000u)};
                    const f32x4 x = (cf - mu) * rs * gvv + bvv;
                    const f32x4 t = x * alpha + acc[ai][bj][m][n];
                    const unsigned p0 = cvt_pk_bf16(t[0], t[1]), p1 = cvt_pk_bf16(t[2], t[3]); if (n) { wout.z = p0; wout.w = p1; } else { wout.x = p0; wout.y = p1; }
                    s += (t[0] + t[1]) + (t[2] + t[3]); q += (t[0] * t[0] + t[1] * t[1]) + (t[2] * t[2] + t[3] * t[3]);
                    if (shiftout && (r & 8191) == 8191) *(f32x4*)(shiftout + (size_t)(r >> 13) * 1024 + c + 4 * n) = x; }
                *(u32x4*)(XB + off) = wout; }
            s += __shfl_xor(s, 16); s += __shfl_xor(s, 32); q += __shfl_xor(q, 16); q += __shfl_xor(q, 32);
            if (fq == 0) P[(ai * HALF + wr * 64 + m * 16 + fr) * 4 + wc] = (f32x2e){s, q};
#pragma unroll
            for (int bj = 0; bj < 2; ++bj) cur[bj] = nxt[bj];
            sa = san; sb = sbn;
        }
        asm volatile("s_waitcnt lgkmcnt(0)" ::: "memory"); __builtin_amdgcn_s_barrier(); asm volatile("" ::: "memory");
        if (threadIdx.x < 256) { const int row = threadIdx.x; const f32x2e a = P[row * 4 + 0], b2 = P[row * 4 + 1], c = P[row * 4 + 2], d = P[row * 4 + 3];
            *(f32x2e*)(ostat + (size_t)(u.pm * BM + row) * 8 + u.pn * 2) = (f32x2e){(a.x + b2.x) + (c.x + d.x), (a.y + b2.y) + (c.y + d.y)}; }
        asm volatile("s_waitcnt lgkmcnt(0)" ::: "memory"); __builtin_amdgcn_s_barrier(); asm volatile("" ::: "memory");
    }
};
struct EpiUp {
    static constexpr bool PERM = true, AFTER_DRAIN = false;
    unsigned char* ws; const PG8_LAS unsigned char* lds0;
    __device__ __forceinline__ void operator()(const f32x4 (&acc)[2][2][4][2], const Unit& u, int wr, int wc, int fr, int fq) const {
        asm volatile("" ::: "memory"); __builtin_amdgcn_sched_barrier(0);
        bf16_t* H = (bf16_t*)(ws + WSO_H);
        const PG8_LAS unsigned char* slot = etab_find(lds0, u);
        const PG8_LAS f32x2e* st = (const PG8_LAS f32x2e*)slot; const PG8_LAS float* tc1 = (const PG8_LAS float*)(slot + 2048); const PG8_LAS float* tc2 = (const PG8_LAS float*)(slot + 3072);
        const int cb = u.pn * BM + wc * 32 + 8 * fq, cl = wc * 32 + 8 * fq;
#pragma unroll
        for (int bj = 0; bj < 2; ++bj) {
            f32x4 c1v[2], c2v[2];
#pragma unroll
            for (int n = 0; n < 2; ++n) { c1v[n] = *(const PG8_LAS f32x4*)(tc1 + cl + bj * HALF + 4 * n); c2v[n] = *(const PG8_LAS f32x4*)(tc2 + cl + bj * HALF + 4 * n); }
#pragma unroll
            for (int ai = 0; ai < 2; ++ai) {
#pragma unroll
                for (int m = 0; m < 4; ++m) {
                    const int rl = ai * HALF + wr * 64 + m * 16 + fr, r = u.pm * BM + rl;
                    const f32x2e ms = st[rl]; const float mu = ms.x, rs = ms.y;
                    f32x4 v0 = (acc[ai][bj][m][0] - mu * c1v[0]) * rs + c2v[0], v1 = (acc[ai][bj][m][1] - mu * c1v[1]) * rs + c2v[1];
#pragma unroll
                    for (int e = 0; e < 4; ++e) { const float a = fmaxf(v0[e], 0.f), b = fmaxf(v1[e], 0.f); v0[e] = a * a; v1[e] = b * b; }
                    u32x4 w; w.x = cvt_pk_bf16(v0[0], v0[1]); w.y = cvt_pk_bf16(v0[2], v0[3]); w.z = cvt_pk_bf16(v1[0], v1[1]); w.w = cvt_pk_bf16(v1[2], v1[3]);
                    *(u32x4*)(H + (size_t)r * 4096 + cb + bj * HALF) = w; }
            }
        }
    }
};
template <class Epi, class Sched, bool ALIGN_EPI = false, bool SP2 = false>
__device__ __forceinline__ void gemm_phase(PG8_LAS unsigned char* lds, const Gemm g, const Sched& S, const Epi& E, const int tid) {
    const int wid = __builtin_amdgcn_readfirstlane(tid >> 6), lane = tid & 63, wr = wid >> 2, wc = wid & 3, fr = lane & 15, fq = lane >> 4;
    const int K = g.K, nt = K / BK;
    unsigned voffA[2], voffB[2];
#pragma unroll
    for (int i = 0; i < 2; ++i) { int R, C; stage_rc(tid * 16 + i * 8192, R, C); const int Rb = Epi::PERM ? ((R & ~31) + perm32(R & 31)) : R;
        voffA[i] = (unsigned)(R * K + C) * 2u; voffB[i] = (unsigned)(Rb * K + C) * 2u; }
    const size_t kstep = (size_t)(BK * 2);
    const size_t hstep = (size_t)HALF * K * 2;
    const size_t tstep = 2 * hstep;
    const unsigned ldsw = (unsigned)wid * 1024u;
    const int aoff = lds_byte(wr * 64 + fr, fq * 8), boff = lds_byte(wc * 32 + fr, fq * 8);
#define PG8_SA(b, h) (((b) * 2 + (h)) * HTB)
#define PG8_SB(b, h) ((4 + (b) * 2 + (h)) * HTB)
#define PG8_STAGE(bufoff, gbase, voff) do { _Pragma("unroll") for (int _i = 0; _i < 2; ++_i) \
        __builtin_amdgcn_global_load_lds((const unsigned*)((const char*)(gbase) + (voff)[_i]), (PG8_LAS unsigned*)(lds + (bufoff) + ldsw + _i * 8192), 16, 0, 0); } while (0)
#define PG8_LDA(dst, b, h) do { _Pragma("unroll") for (int m = 0; m < 4; ++m) _Pragma("unroll") for (int k = 0; k < 2; ++k) dst[m][k] = *(const PG8_LAS bf16x8*)(lds + PG8_SA(b, h) + aoff + m * 2048 + k * 1024); } while (0)
#define PG8_LDB(dst, b, h) do { _Pragma("unroll") for (int n = 0; n < 2; ++n) _Pragma("unroll") for (int k = 0; k < 2; ++k) dst[n][k] = *(const PG8_LAS bf16x8*)(lds + PG8_SB(b, h) + boff + n * 2048 + k * 1024); } while (0)
#define PG8_MMA(ai, bj, At, Bt) do { __builtin_amdgcn_s_setprio(1); _Pragma("unroll") for (int m = 0; m < 4; ++m) _Pragma("unroll") for (int n = 0; n < 2; ++n) _Pragma("unroll") for (int k = 0; k < 2; ++k) \
        acc[ai][bj][m][n] = __builtin_amdgcn_mfma_f32_16x16x32_bf16(Bt[n][k], At[m][k], acc[ai][bj][m][n], 0, 0, 0); __builtin_amdgcn_s_setprio(0); } while (0)
#define PG8_WAIT_V(n) asm volatile("s_waitcnt vmcnt(" #n ")" ::: "memory")
#define PG8_WAIT_L(n) asm volatile("s_waitcnt lgkmcnt(" #n ")" ::: "memory")
#define PG8_BAR __builtin_amdgcn_s_barrier()
#define PG8_SCHED __builtin_amdgcn_sched_barrier(0)
    Unit cur, nxt; int ui = 0;
    if (!S.next(0, cur)) return;
    f32x4 acc[2][2][4][2];
#pragma unroll
    for (int a = 0; a < 2; ++a)
#pragma unroll
        for (int b = 0; b < 2; ++b)
#pragma unroll
            for (int m = 0; m < 4; ++m)
#pragma unroll
                for (int n = 0; n < 2; ++n) acc[a][b][m][n] = (f32x4){0.f, 0.f, 0.f, 0.f};
    bf16x8 At[4][2], B0[2][2], B1[2][2];
    const char* cA = (const char*)g.A + (size_t)cur.pm * tstep; const char* cB = (const char*)g.Bt + (size_t)cur.pn * tstep;
    S.a_ready(cur);
    if constexpr (SP2) {
        PG8_STAGE(PG8_SB(0, 0), cB, voffB); PG8_STAGE(PG8_SB(0, 1), cB + hstep, voffB); PG8_STAGE(PG8_SA(0, 0), cA, voffA); PG8_STAGE(PG8_SA(0, 1), cA + hstep, voffA);
        if (wr == 1) PG8_BAR;
        PG8_WAIT_V(2); PG8_BAR;
        PG8_STAGE(PG8_SB(1, 0), cB + kstep, voffB); PG8_STAGE(PG8_SA(1, 0), cA + kstep, voffA); PG8_STAGE(PG8_SB(1, 1), cB + hstep + kstep, voffB);
        PG8_WAIT_V(6); PG8_BAR;
    } else {
        PG8_STAGE(PG8_SB(0, 0), cB, voffB); PG8_STAGE(PG8_SA(0, 0), cA, voffA); PG8_STAGE(PG8_SB(0, 1), cB + hstep, voffB); PG8_STAGE(PG8_SA(0, 1), cA + hstep, voffA);
        if (wr == 1) PG8_BAR;
        PG8_WAIT_V(4); PG8_BAR;
        PG8_STAGE(PG8_SB(1, 0), cB + kstep, voffB); PG8_STAGE(PG8_SA(1, 0), cA + kstep, voffA); PG8_STAGE(PG8_SB(1, 1), cB + hstep + kstep, voffB);
        PG8_WAIT_V(6); PG8_BAR;
    }
    for (;;) {
        const bool has_next = S.next(ui + 1, nxt);
        const char* nA = has_next ? (const char*)g.A + (size_t)nxt.pm * tstep : cA; const char* nB = has_next ? (const char*)g.Bt + (size_t)nxt.pn * tstep : cB;
        for (int t = 0; t < nt; t += 2) {
            const bool last = (t == nt - 2);
            const char* a1 = cA + (size_t)(t + 1) * kstep;
            const char* a2 = last ? nA : cA + (size_t)(t + 2) * kstep; const char* b2 = last ? nB : cB + (size_t)(t + 2) * kstep;
            const char* a3 = a2 + kstep; const char* b3 = b2 + kstep;
            if (last && has_next) S.a_ready(nxt);
            if constexpr (SP2) {
            PG8_LDB(B0, 0, 0); PG8_LDB(B1, 0, 1); PG8_SCHED; PG8_LDA(At, 0, 0); PG8_STAGE(PG8_SA(1, 1), a1 + hstep, voffA);
            PG8_WAIT_V(8); PG8_WAIT_L(0); PG8_BAR; PG8_MMA(0, 0, At, B0); PG8_MMA(0, 1, At, B1); PG8_BAR; PG8_SCHED;
            PG8_LDA(At, 0, 1); PG8_STAGE(PG8_SB(0, 0), b2, voffB); PG8_STAGE(PG8_SB(0, 1), b2 + hstep, voffB); PG8_STAGE(PG8_SA(0, 0), a2, voffA);
            PG8_WAIT_V(8); PG8_WAIT_L(0); PG8_BAR; PG8_MMA(1, 0, At, B0); PG8_MMA(1, 1, At, B1); PG8_BAR; PG8_SCHED;
            PG8_LDB(B0, 1, 0); PG8_LDB(B1, 1, 1); PG8_SCHED; PG8_LDA(At, 1, 0); PG8_STAGE(PG8_SA(0, 1), a2 + hstep, voffA);
            PG8_WAIT_V(8); PG8_WAIT_L(0); PG8_BAR; PG8_MMA(0, 0, At, B0); PG8_MMA(0, 1, At, B1); PG8_BAR; PG8_SCHED;
            PG8_LDA(At, 1, 1); PG8_STAGE(PG8_SB(1, 0), b3, voffB); PG8_STAGE(PG8_SB(1, 1), b3 + hstep, voffB); PG8_STAGE(PG8_SA(1, 0), a3, voffA);
            PG8_WAIT_V(8); PG8_WAIT_L(0); PG8_BAR; PG8_MMA(1, 0, At, B0); PG8_MMA(1, 1, At, B1); PG8_BAR; PG8_SCHED;
            } else {
            PG8_LDB(B0, 0, 0); PG8_SCHED; PG8_LDA(At, 0, 0); PG8_STAGE(PG8_SA(1, 1), a1 + hstep, voffA);
            PG8_WAIT_L(8); PG8_BAR; PG8_WAIT_L(0); PG8_MMA(0, 0, At, B0); PG8_BAR; PG8_SCHED;
            PG8_LDB(B1, 0, 1); PG8_STAGE(PG8_SB(0, 0), b2, voffB);
            PG8_BAR; PG8_WAIT_L(0); PG8_MMA(0, 1, At, B1); PG8_BAR;
            PG8_LDA(At, 0, 1); PG8_STAGE(PG8_SA(0, 0), a2, voffA);
            PG8_BAR; PG8_WAIT_L(0); PG8_MMA(1, 0, At, B0); PG8_BAR; PG8_SCHED;
            PG8_STAGE(PG8_SB(0, 1), b2 + hstep, voffB);
            PG8_WAIT_V(6); PG8_BAR; PG8_MMA(1, 1, At, B1); PG8_BAR;
            PG8_LDB(B0, 1, 0); PG8_SCHED; PG8_LDA(At, 1, 0); PG8_STAGE(PG8_SA(0, 1), a2 + hstep, voffA);
            PG8_WAIT_L(8); PG8_BAR; PG8_WAIT_L(0); PG8_MMA(0, 0, At, B0); PG8_BAR; PG8_SCHED;
            PG8_LDB(B1, 1, 1); PG8_STAGE(PG8_SB(1, 0), b3, voffB);
            PG8_BAR; PG8_WAIT_L(0); PG8_MMA(0, 1, At, B1); PG8_BAR;
            PG8_LDA(At, 1, 1); PG8_STAGE(PG8_SA(1, 0), a3, voffA);
            PG8_BAR; PG8_WAIT_L(0); PG8_MMA(1, 0, At, B0); PG8_BAR; PG8_SCHED;
            PG8_STAGE(PG8_SB(1, 1), b3 + hstep, voffB);
            PG8_WAIT_V(6); PG8_BAR; PG8_MMA(1, 1, At, B1); PG8_BAR;
            }
        }
        if constexpr (ALIGN_EPI) { if (wr == 0) PG8_BAR; }
        if constexpr (!Epi::AFTER_DRAIN) { E(acc, cur, wr, wc, fr, fq); S.done(cur); }
        if (!has_next) break;
#pragma unroll
        for (int a = 0; a < 2; ++a)
#pragma unroll
            for (int b = 0; b < 2; ++b)
#pragma unroll
                for (int m = 0; m < 4; ++m)
#pragma unroll
                    for (int n = 0; n < 2; ++n) acc[a][b][m][n] = (f32x4){0.f, 0.f, 0.f, 0.f};
        cur = nxt; cA = nA; cB = nB; ++ui;
        if constexpr (ALIGN_EPI) { if (wr == 1) PG8_BAR; }
    }
    PG8_WAIT_V(0);
    if constexpr (!ALIGN_EPI) { if (wr == 0) PG8_BAR; }
    PG8_BAR;
    if constexpr (Epi::AFTER_DRAIN) { E.fused(acc, cur, wr, wc, fr, fq, lds, wid, lane); S.done(cur); }
#undef PG8_SA
#undef PG8_SB
#undef PG8_STAGE
#undef PG8_LDA
#undef PG8_LDB
#undef PG8_MMA
#undef PG8_WAIT_V
#undef PG8_WAIT_L
#undef PG8_BAR
#undef PG8_SCHED
}
}
constexpr int NWAVES = 8;
constexpr int M = 16384, TSEQ = 8192, DM = 1024, FFD = 4096, DEPTH = 4, MD = 32, NH = 8, HD = 64;
constexpr int NIN = 3584;
constexpr int RW0 = 1536;
constexpr int PRP = 2048;
constexpr int NRWU = 1856;
constexpr int CH = 16, NCH = TSEQ / CH;
constexpr int NUNIT = 2 * NH * NCH;
constexpr float LN_EPS = 1e-5f, GN_EPS = 64e-5f, RMS_EPS = 1e-6f;
constexpr float ALPHA = 1.6817928305074290f;
constexpr float QSCALE = 0.125f * 1.4426950408889634f;
constexpr size_t O_Y = 0, O_YS = 16777216, O_SHP = 16809984, O_SHS = 16818176, O_WKP = 16949248, O_WKS = 17211392,
                 O_KP = 21405696, O_VP = 29794304, O_KS = 38182912, O_VS = 38248448, O_END = 38313984;
constexpr size_t MiB = 1u << 20;
constexpr size_t WS_CTL = 0, CTL_ZERO_BYTES = 1 * MiB;
constexpr size_t WS_C1IN = 1 * MiB;
constexpr size_t WS_C2IN = WS_C1IN + 4 * NIN * 4;
constexpr size_t WS_C1UP = WS_C2IN + 4 * NIN * 4;
constexpr size_t WS_C2UP = WS_C1UP + 4 * FFD * 4;
constexpr size_t WS_DUPT = WS_C2UP + 4 * FFD * 4;
constexpr size_t WS_IUPT = WS_DUPT + 4 * 512 * 64 * 2;
constexpr size_t WS_GUPT = WS_IUPT + 4 * 512 * 64 * 2;
constexpr size_t WS_VUPT = WS_GUPT + 4 * 512 * 128 * 2;
constexpr size_t WS_SMALL_END = WS_VUPT + 3 * 512 * 32 * 2;
static_assert(WS_SMALL_END <= 3 * MiB, "small region");
constexpr size_t WS_ROPE = 3 * MiB;
constexpr size_t WS_DEC = 6 * MiB;
constexpr size_t WS_STAT1 = 8 * MiB, WS_STAT2 = 9 * MiB;
constexpr size_t WS_BON = 10 * MiB;
constexpr size_t WS_LSE = 11 * MiB;
constexpr size_t WS_GC = 13 * MiB;
constexpr size_t WS_WIN = 16 * MiB;
constexpr size_t WS_WINU = 44 * MiB;
constexpr size_t WS_WOUT = 60 * MiB;
constexpr size_t WS_WUP = 68 * MiB;
constexpr size_t WS_WDN = 100 * MiB;
constexpr size_t WS_XB2 = 132 * MiB;
constexpr size_t WS_XB1 = 164 * MiB;
constexpr size_t WS_T1 = 196 * MiB;
constexpr size_t WS_T2 = 260 * MiB;
constexpr size_t WS_QB = 324 * MiB, WS_KB = 340 * MiB, WS_VB = 356 * MiB;
constexpr size_t WS_PR = 372 * MiB;
constexpr size_t WS_OP = 436 * MiB;
constexpr size_t WS_MIX = 484 * MiB;
constexpr size_t WS_VF = 516 * MiB, WS_VV = 532 * MiB;
constexpr size_t WS_YPRE = 548 * MiB;
constexpr size_t WS_H = 580 * MiB;
constexpr size_t WS_PT = 580 * MiB;
constexpr size_t WS_QT = 644 * MiB;
constexpr size_t WS_REFF = 708 * MiB;
constexpr size_t WS_YLOC = 724 * MiB;
constexpr size_t WS_SEGQ = 756 * MiB, WS_SEGP = 760 * MiB;
constexpr size_t WS_CSUM = 764 * MiB;
constexpr size_t WS_CSUP = 766 * MiB;
constexpr size_t WS_END = 768 * MiB;
static_assert(WS_H + (size_t)M * FFD * 2 <= WS_END + 0 * MiB || true, "");
constexpr size_t DEC_XB2 = 0;
constexpr size_t DEC_XB1 = 64 * 1024;
constexpr size_t DEC_SHB = 128 * 1024;
constexpr size_t DEC_MIXB = 384 * 1024;
constexpr size_t DEC_HB = 448 * 1024;
constexpr size_t DEC_T1 = 704 * 1024;
constexpr size_t DEC_T2 = 832 * 1024;
constexpr size_t DEC_PD = 960 * 1024;
constexpr size_t DEC_PS = 1408 * 1024;
constexpr size_t DEC_OP = 1640 * 1024;
constexpr size_t DEC_LSE = 1832 * 1024;
constexpr size_t DEC_MIX = 1836 * 1024;
constexpr size_t DEC_ST1 = 1964 * 1024;
constexpr size_t DEC_ST2 = 1972 * 1024;
constexpr size_t DEC_VF = 1980 * 1024;
static_assert(DEC_VF + 32 * 512 * 4 <= 2 * MiB, "decode scratch");
constexpr int CW_BAR = 4096;
constexpr int RING_BYTES = 131072;
constexpr int MISC_OFF = RING_BYTES + 320;
constexpr int LDS_BYTES = 163840;
static_assert(pg8::WSO_C1IN == WS_C1IN && pg8::WSO_C2IN == WS_C2IN && pg8::WSO_C1UP == WS_C1UP && pg8::WSO_C2UP == WS_C2UP && pg8::WSO_ROPE == WS_ROPE && pg8::WSO_STAT1 == WS_STAT1 && pg8::WSO_STAT2 == WS_STAT2 &&
              pg8::WSO_XB2 == WS_XB2 && pg8::WSO_XB1 == WS_XB1 && pg8::WSO_T1 == WS_T1 && pg8::WSO_T2 == WS_T2 && pg8::WSO_QB == WS_QB && pg8::WSO_KB == WS_KB && pg8::WSO_VB == WS_VB && pg8::WSO_PR == WS_PR && pg8::WSO_H == WS_H &&
              pg8::OO_SHP == O_SHP && pg8::OO_KP == O_KP && pg8::OO_VP == O_VP, "epilogue offset mirrors");
#define GAS __attribute__((address_space(1)))
#define LAS __attribute__((address_space(3)))
typedef unsigned short bf16;
typedef unsigned v4u __attribute__((ext_vector_type(4)));
typedef unsigned v2u __attribute__((ext_vector_type(2)));
typedef float f32x4 __attribute__((ext_vector_type(4)));
typedef float f32x2 __attribute__((ext_vector_type(2)));
typedef float f32x16 __attribute__((ext_vector_type(16)));
typedef short bf16x8 __attribute__((ext_vector_type(8)));
typedef short s16x4 __attribute__((ext_vector_type(4)));
typedef GAS unsigned gu32;
#define RLX_AGENT __ATOMIC_RELAXED, __HIP_MEMORY_SCOPE_AGENT
#define LDS_WAIT() asm volatile("s_waitcnt lgkmcnt(0)" ::: "memory")
#define VM_WAIT() asm volatile("s_waitcnt vmcnt(0)" ::: "memory")
#define DI __device__ __forceinline__
DI unsigned f2bf(float f) { unsigned u = __builtin_bit_cast(unsigned, f); return (u + 0x7fffu + ((u >> 16) & 1u)) >> 16; }
DI float bf2f(unsigned b) { return __builtin_bit_cast(float, b << 16); }
DI float bflo(unsigned w) { return __builtin_bit_cast(float, w << 16); }
DI float bfhi(unsigned w) { return __builtin_bit_cast(float, w & 0xffff0000u); }
typedef __bf16 bf16x2_t __attribute__((ext_vector_type(2)));
DI unsigned pk2(float lo, float hi) { const f32x2 v = {lo, hi}; const bf16x2_t b = __builtin_convertvector(v, bf16x2_t); return __builtin_bit_cast(unsigned, b); }
DI unsigned pk2z(float x) { return pk2(x, 0.f) & 0xffffu; }
DI float rbf(float x) { return bf2f(f2bf(x)); }
DI bf16x8 pk8(float a0, float a1, float a2, float a3, float a4, float a5, float a6, float a7) {
    v4u w; w.x = pk2(a0, a1); w.y = pk2(a2, a3); w.z = pk2(a4, a5); w.w = pk2(a6, a7); return __builtin_bit_cast(bf16x8, w); }
DI bf16x8 pk8v(f32x4 a, f32x4 b) { return pk8(a[0], a[1], a[2], a[3], b[0], b[1], b[2], b[3]); }
DI bf16x8 pk4z(f32x4 a) { v4u w; w.x = pk2(a[0], a[1]); w.y = pk2(a[2], a[3]); w.z = 0u; w.w = 0u; return __builtin_bit_cast(bf16x8, w); }
DI bf16x8 ld8(const void* p) { return *(const bf16x8*)p; }
DI bf16x8 ld8nt(const void* p) { return __builtin_nontemporal_load((const bf16x8*)p); }
DI v4u ldv4nt(const void* p) { return __builtin_nontemporal_load((const v4u*)p); }
DI f32x4 ldf4nt(const void* p) { return __builtin_nontemporal_load((const f32x4*)p); }
DI bf16x8 ld4z(const void* p) { v2u t = *(const v2u*)p; v4u w; w.x = t.x; w.y = t.y; w.z = 0u; w.w = 0u; return __builtin_bit_cast(bf16x8, w); }
DI f32x4 mfma16(bf16x8 a, bf16x8 b, f32x4 c) { return __builtin_amdgcn_mfma_f32_16x16x32_bf16(a, b, c, 0, 0, 0); }
DI f32x16 mfma32(bf16x8 a, bf16x8 b, f32x16 c) { return __builtin_amdgcn_mfma_f32_32x32x16_bf16(a, b, c, 0, 0, 0); }
DI int crow(int r, int hi) { return (r & 3) + 8 * (r >> 2) + 4 * hi; }
DI float wave_sum(float v) {
#pragma unroll
    for (int o = 1; o < 64; o <<= 1) v += __shfl_xor(v, o);
    return v; }
DI float fexp(float x) { return __expf(x); }
DI float fsigmoid(float x) { return __builtin_amdgcn_rcpf(1.f + __expf(-x)); }
DI float ftanh(float x) { return 1.f - 2.f * __builtin_amdgcn_rcpf(__expf(2.f * x) + 1.f); }
DI float fsoftplus(float x) { return fmaxf(x, 0.f) + __logf(1.f + __expf(-fabsf(x))); }
DI int orig2lgcl(int o) { return (o & ~63) | (((o >> 4) & 1) << 5) | (((o >> 2) & 3) << 3) | (((o >> 5) & 1) << 2) | (o & 3); }
DI int lgcl2orig(int c) { return (c & ~63) | (((c >> 2) & 1) << 5) | (((c >> 5) & 1) << 4) | (((c >> 3) & 3) << 2) | (c & 3); }
#define XB_TMO      128
#define XB_XCNT(j)  (256  + 64 * (j))
#define XB_XSUB(j)  (1280 + 64 * (j))
#define XB_XGEN(j)  (2304 + 64 * (j))
#define XB_TOP      3328
#define XB_TOPGEN   3392
#define XCD_BAR_WORDS 3456
#define XB_SPIN_CAP (1u << 18)

__device__ __forceinline__ unsigned xb_ld(unsigned* p)              { return __hip_atomic_load(p, __ATOMIC_RELAXED, __HIP_MEMORY_SCOPE_AGENT); }
__device__ __forceinline__ unsigned xb_add(unsigned* p, unsigned v) { return __hip_atomic_fetch_add(p, v, __ATOMIC_RELAXED, __HIP_MEMORY_SCOPE_AGENT); }
__device__ __forceinline__ unsigned xb_xcc_id() { return (unsigned)__builtin_amdgcn_s_getreg((3 << 11) | 20) & 0xFu; }
#define XB_SPIN(cond, bar) do { unsigned _sp = 0; while (cond) { __builtin_amdgcn_s_sleep(1); \
    if ((++_sp & 255u) == 0u) { if (xb_ld(&(bar)[XB_TMO])) break; if (_sp > XB_SPIN_CAP) { atomicAdd(&(bar)[XB_TMO], 1u); break; } } } } while (0)

struct XcdBarrier {
    unsigned* bar; unsigned x;
    volatile LAS unsigned* st;
};

__device__ __forceinline__ XcdBarrier xcd_barrier_post(unsigned* bar, volatile LAS unsigned* st) {
    XcdBarrier b; b.bar = bar; b.x = xb_xcc_id(); b.st = st;
    if (threadIdx.x == 0) (void)xb_add(&bar[XB_XCNT(b.x)], 1u);
    return b;
}
__device__ __forceinline__ void xcd_barrier_complete(unsigned* bar, unsigned x, unsigned& nloc, unsigned& nx) {
    const unsigned G = gridDim.x * gridDim.y * gridDim.z;
    unsigned sum, cnt, mine, sp = 0u;
    for (;;) {
        sum = 0u; cnt = 0u; mine = 0u;
#pragma unroll
        for (unsigned j = 0; j < 16; ++j) { const unsigned c = xb_ld(&bar[XB_XCNT(j)]); sum += c; cnt += (c > 0u) ? 1u : 0u; mine = (j == x) ? c : mine; }
        if (sum == G) break;
        __builtin_amdgcn_s_sleep(1);
        if ((++sp & 255u) == 0u) { if (xb_ld(&bar[XB_TMO])) break; if (sp > XB_SPIN_CAP) { atomicAdd(&bar[XB_TMO], 1u); break; } }
    }
    nloc = mine > 0u ? mine : 1u; nx = cnt > 0u ? cnt : 1u;
}

__device__ __forceinline__ void xcd_barrier(const XcdBarrier& b) {
    asm volatile("s_waitcnt vmcnt(0)" ::: "memory");
    __syncthreads();
    if (threadIdx.x == 0) {
        unsigned* bar = b.bar;
        __builtin_amdgcn_s_waitcnt(0);
        unsigned nloc = b.st[0], nx = b.st[1];
        if (nloc == 0u) { xcd_barrier_complete(bar, b.x, nloc, nx); b.st[0] = nloc; b.st[1] = nx; }
        const unsigned old = xb_add(&bar[XB_XSUB(b.x)], 1u);
        const unsigned gen = old / nloc;
        if (old + 1u == (gen + 1u) * nloc) {
            __builtin_amdgcn_fence(__ATOMIC_RELEASE, "agent");
            asm volatile("s_waitcnt vmcnt(0)" ::: "memory");
            const unsigned og = xb_add(&bar[XB_TOP], 1u);
            const unsigned tg = og / nx;
            if (og + 1u == (tg + 1u) * nx) xb_add(&bar[XB_TOPGEN], 1u);
            else XB_SPIN(xb_ld(&bar[XB_TOPGEN]) == tg, bar);
            __builtin_amdgcn_fence(__ATOMIC_ACQUIRE, "agent");
            xb_add(&bar[XB_XGEN(b.x)], 1u);
            asm volatile("s_waitcnt vmcnt(0)" ::: "memory");
        } else {
            XB_SPIN(xb_ld(&bar[XB_XGEN(b.x)]) == gen, bar);
            __builtin_amdgcn_fence(__ATOMIC_ACQUIRE, "agent");
            asm volatile("s_waitcnt vmcnt(0)" ::: "memory");
        }
    }
    __syncthreads();
}
struct Args { const float* in[30]; float* out; unsigned char* ws; };
struct Frame {
    unsigned char* lds;
    volatile LAS unsigned* MISC;
    gu32* ctl;
    int tid, lane, wave, vcu, G, gw, NGW;
    const float* const* in; float* out; unsigned char* ws;
};
template <bool SWAP>
DI void p0_transpose_item(const float* W, int ldw, int K, int csrc0, bf16* WT, int row_off, const float* gsc, LAS float* scr, int kb, int nb, int lane, float* csum = nullptr, int ncs = 0, const float* bsh = nullptr) {
    const int k0 = 64 * kb, n0 = 32 * nb;
    f32x4 wv[8]; float gk = 1.f, bk = 0.f;
    const int lr = lane >> 3, lc = (lane & 7) * 4;
#pragma unroll
    for (int i = 0; i < 8; ++i) wv[i] = ldf4nt(W + (size_t)(k0 + 8 * i + lr) * ldw + csrc0 + n0 + lc);
    if (gsc) gk = gsc[k0 + lane]; if (bsh) bk = bsh[k0 + lane];
    f32x4 s1v = {0.f, 0.f, 0.f, 0.f}, s2v = s1v;
#pragma unroll
    for (int i = 0; i < 8; ++i) { const int kk = 8 * i + lr; f32x4 v = wv[i]; s2v = s2v + v * __shfl(bk, kk); v = v * __shfl(gk, kk);
#pragma unroll
        for (int e = 0; e < 4; ++e) { s1v[e] += rbf(v[e]); scr[kk * 33 + lc + e] = v[e]; } }
#pragma unroll
    for (int o = 8; o < 64; o <<= 1) {
#pragma unroll
        for (int e = 0; e < 4; ++e) { s1v[e] += __shfl_xor(s1v[e], o); s2v[e] += __shfl_xor(s2v[e], o); } }
    if (csum && lane < 8) {
#pragma unroll
        for (int e = 0; e < 4; ++e) { int dr = n0 + 4 * lane + e; if (SWAP) dr = orig2lgcl(dr); csum[(size_t)(kb * 2 + 0) * ncs + row_off + dr] = s1v[e]; csum[(size_t)(kb * 2 + 1) * ncs + row_off + dr] = s2v[e]; } }
    LDS_WAIT(); asm volatile("" ::: "memory");
    const int c = lane & 7;
#pragma unroll
    for (int j = 0; j < 4; ++j) { const int n = (lane >> 3) + 8 * j; const LAS float* s = scr + (8 * c) * 33 + n;
        v4u o; o.x = pk2(s[0 * 33], s[1 * 33]); o.y = pk2(s[2 * 33], s[3 * 33]); o.z = pk2(s[4 * 33], s[5 * 33]); o.w = pk2(s[6 * 33], s[7 * 33]);
        int dr = n0 + n; if (SWAP) dr = orig2lgcl(dr);
        *(v4u*)(WT + (size_t)(row_off + dr) * K + k0 + 8 * c) = o; }
    LDS_WAIT(); asm volatile("" ::: "memory");
}
DI void p0_prologue(Frame& F) {
    LAS float* scr = (LAS float*)((LAS unsigned char*)F.lds + F.wave * 16384);
    const float* const* in = F.in; unsigned char* ws = F.ws;
    constexpr int I_IN = 16 * 104, I_VR = 16, I_INU = 16 * 56, I_OUT = 16 * 32, I_UP = 16 * 128, I_DN = 64 * 32;
    constexpr int I_L = I_IN + I_VR + I_INU + I_VR + I_OUT + I_UP + I_DN;
    for (int it = F.gw; it < DEPTH * I_L; it += F.NGW) {
        const int l = it / I_L; int r = it % I_L;
        const float* g2p = l > 0 ? in[28] + (size_t)(l - 1) * DM : nullptr;
        bf16* win = (bf16*)(ws + WS_WIN) + (size_t)l * NIN * DM; bf16* winu = (bf16*)(ws + WS_WINU) + (size_t)l * NRWU * DM;
        if (r < I_IN) { const int kb = r / 104, nb = r % 104; const float* W = in[6] + (size_t)l * DM * 3328;
            float* cs = l > 0 ? (float*)(ws + WS_CSUM) + (size_t)l * 32 * NIN : nullptr; const float* b2p = l > 0 ? in[29] + (size_t)(l - 1) * DM : nullptr;
            if (nb < 32) p0_transpose_item<true>(W, 3328, DM, 0, win, 0, g2p, scr, kb, nb, F.lane, cs, NIN, b2p); else p0_transpose_item<false>(W, 3328, DM, 0, win, 0, g2p, scr, kb, nb, F.lane, cs, NIN, b2p); continue; } r -= I_IN;
        if (r < I_VR) { if (l > 0) p0_transpose_item<false>(in[7] + (size_t)(l - 1) * DM * 32, 32, DM, 0, win, 3328, g2p, scr, r, 0, F.lane, (float*)(ws + WS_CSUM) + (size_t)l * 32 * NIN, NIN, in[29] + (size_t)(l - 1) * DM); continue; } r -= I_VR;
        if (r < I_INU) { const int kb = r / 56, nb = r % 56; p0_transpose_item<false>(in[6] + (size_t)l * DM * 3328, 3328, DM, RW0, winu, 0, nullptr, scr, kb, nb, F.lane); continue; } r -= I_INU;
        if (r < I_VR) { if (l > 0) p0_transpose_item<false>(in[7] + (size_t)(l - 1) * DM * 32, 32, DM, 0, winu, 1792, nullptr, scr, r, 0, F.lane); continue; } r -= I_VR;
        if (r < I_OUT) { p0_transpose_item<false>(in[23] + (size_t)l * DM * DM, DM, DM, 0, (bf16*)(ws + WS_WOUT) + (size_t)l * DM * DM, 0, nullptr, scr, r / 32, r % 32, F.lane); continue; } r -= I_OUT;
        if (r < I_UP) { p0_transpose_item<false>(in[26] + (size_t)l * DM * FFD, FFD, DM, 0, (bf16*)(ws + WS_WUP) + (size_t)l * FFD * DM, 0, in[24] + (size_t)l * DM, scr, r / 128, r % 128, F.lane, (float*)(ws + WS_CSUP) + (size_t)l * 32 * FFD, FFD, in[25] + (size_t)l * DM); continue; } r -= I_UP;
        p0_transpose_item<false>(in[27] + (size_t)l * FFD * DM, DM, FFD, 0, (bf16*)(ws + WS_WDN) + (size_t)l * DM * FFD, 0, nullptr, scr, r / 32, r % 32, F.lane);
    }
    for (int m0 = F.gw; m0 < M; m0 += 4 * F.NGW) { f32x4 v[4][4];
#pragma unroll
        for (int q = 0; q < 4; ++q) { const f32x4* xr = (const f32x4*)(in[0] + (size_t)(m0 + q * F.NGW) * DM) + F.lane;
#pragma unroll
            for (int j = 0; j < 4; ++j) v[q][j] = ldf4nt(xr + 64 * j); }
#pragma unroll
        for (int q = 0; q < 4; ++q) { unsigned long long* o8 = (unsigned long long*)((bf16*)(ws + WS_XB2) + (size_t)(m0 + q * F.NGW) * DM) + F.lane;
#pragma unroll
            for (int j = 0; j < 4; ++j) o8[64 * j] = (unsigned long long)pk2(v[q][j].x, v[q][j].y) | ((unsigned long long)pk2(v[q][j].z, v[q][j].w) << 32); } }
    const int gt = F.gw * 64 + F.lane, NGT = F.NGW * 64;
    for (int e = gt; e < 8193 * 32; e += NGT) { const int pos = e >> 5, i = e & 31; const double ang = (double)pos * pow(10000.0, -(double)i / 32.0); ((f32x2*)(ws + WS_ROPE))[e] = (f32x2){(float)cos(ang), (float)sin(ang)}; }
    for (int e = gt; e < 4 * 512 * 64; e += NGT) { const int l = e / (512 * 64), n = (e / 64) % 512, m = e % 64; ((bf16*)(ws + WS_DUPT))[e] = (bf16)f2bf(in[11][((size_t)l * 64 + m) * 512 + n]); ((bf16*)(ws + WS_IUPT))[e] = (bf16)f2bf(in[13][((size_t)l * 64 + m) * 512 + n]); }
    for (int e = gt; e < 4 * 512 * 128; e += NGT) { const int l = e / (512 * 128), n = (e / 128) % 512, m = e % 128; ((bf16*)(ws + WS_GUPT))[e] = (bf16)f2bf(in[14][((size_t)l * 128 + m) * 512 + n]); }
    for (int e = gt; e < 3 * 512 * 32; e += NGT) { const int l = e / (512 * 32), n = (e / 32) % 512, m = e % 32; ((bf16*)(ws + WS_VUPT))[e] = (bf16)f2bf(in[16][((size_t)l * 32 + m) * 512 + n]); }
    for (int e = gt; e < 2 * DM; e += NGT) F.out[O_SHP + e] = in[0][((size_t)(e / DM) * TSEQ + TSEQ - 1) * DM + (e % DM)];
    for (int e = gt; e < MD * DM; e += NGT) { ((bf16*)(ws + WS_DEC + DEC_XB2))[e] = (bf16)f2bf(in[1][e]); }
    for (int e = gt; e < DEPTH * MD * DM; e += NGT) { ((bf16*)(ws + WS_DEC + DEC_SHB))[e] = (bf16)f2bf(in[2][e]); }
}
DI void colsum_finish(unsigned char* ws, int gt, int NGT) {
    for (int e = gt; e < 3 * NIN; e += NGT) { const int l = 1 + e / NIN, p = e % NIN; if (p >= 3360) continue; const float* cs = (const float*)(ws + WS_CSUM) + (size_t)l * 32 * NIN + p; float s1 = 0.f, s2 = 0.f;
#pragma unroll
        for (int kb = 0; kb < 16; ++kb) { s1 += cs[(size_t)(2 * kb) * NIN]; s2 += cs[(size_t)(2 * kb + 1) * NIN]; }
        ((float*)(ws + WS_C1IN))[l * NIN + p] = s1; ((float*)(ws + WS_C2IN))[l * NIN + p] = s2; }
    for (int e = gt; e < 4 * FFD; e += NGT) { const int l = e / FFD, p = e % FFD; const float* cs = (const float*)(ws + WS_CSUP) + (size_t)l * 32 * FFD + p; float s1 = 0.f, s2 = 0.f;
#pragma unroll
        for (int kb = 0; kb < 16; ++kb) { s1 += cs[(size_t)(2 * kb) * FFD]; s2 += cs[(size_t)(2 * kb + 1) * FFD]; }
        ((float*)(ws + WS_C1UP))[l * FFD + p] = s1; ((float*)(ws + WS_C2UP))[l * FFD + p] = s2; }
}
constexpr int VPITCH = 144;
constexpr int ATT_WLDS = 2 * 32 * VPITCH + 256;
DI void tr_read8(unsigned base, s16x4 (&t)[8]) {
    asm volatile("ds_read_b64_tr_b16 %0, %8\n\tds_read_b64_tr_b16 %1, %8 offset:%c9\n\tds_read_b64_tr_b16 %2, %8 offset:%c10\n\tds_read_b64_tr_b16 %3, %8 offset:%c11\n\t"
                 "ds_read_b64_tr_b16 %4, %8 offset:%c12\n\tds_read_b64_tr_b16 %5, %8 offset:%c13\n\tds_read_b64_tr_b16 %6, %8 offset:%c14\n\tds_read_b64_tr_b16 %7, %8 offset:%c15\n\ts_waitcnt lgkmcnt(0)"
                 : "=&v"(t[0]), "=&v"(t[1]), "=&v"(t[2]), "=&v"(t[3]), "=&v"(t[4]), "=&v"(t[5]), "=&v"(t[6]), "=&v"(t[7])
                 : "v"(base), "i"(8 * VPITCH), "i"(64), "i"(8 * VPITCH + 64), "i"(16 * VPITCH), "i"(24 * VPITCH), "i"(16 * VPITCH + 64), "i"(24 * VPITCH + 64) : "memory");
}
DI void attn_task(const bf16* QB, const bf16* KB, const bf16* VB, bf16* OP, float* LSE, int b, int h, int p, int cls, int qblk, LAS unsigned char* wl, int lane) {
    asm volatile("" : "+v"(lane));
    const int dd = 1 << (2 * p), r32 = lane & 31, hi = lane >> 5;
    const int m0 = 32 * qblk;
    const size_t rowb = (size_t)b * TSEQ;
    const size_t qrow = rowb + (size_t)(m0 + r32) * dd + cls;
    bf16x8 qf[4];
#pragma unroll
    for (int d0 = 0; d0 < 4; ++d0) qf[d0] = ld8(QB + qrow * 512 + h * 64 + d0 * 16 + hi * 8);
    f32x16 s[5];
    const int kt0 = (m0 >= 128) ? 0 : (128 - m0) / 32;
    const int krow8 = lane >> 3, kch = lane & 7;
    v4u kr[5][4];
#pragma unroll
    for (int kt = 0; kt < 5; ++kt)
#pragma unroll
        for (int i_ = 0; i_ < 4; ++i_) { const int mk = m0 - 128 + 32 * kt + 8 * i_ + krow8; const size_t krow = rowb + (size_t)(mk < 0 ? 0 : mk) * dd + cls;
            kr[kt][i_] = *(const v4u*)(KB + krow * 512 + h * 64 + kch * 8); }
#pragma unroll
    for (int kt = 0; kt < 5; ++kt) {
        LAS unsigned char* kb = wl + (kt & 1) * 32 * VPITCH;
#pragma unroll
        for (int i_ = 0; i_ < 4; ++i_) *(LAS v4u*)(kb + (8 * i_ + krow8) * VPITCH + kch * 16) = kr[kt][i_];
        LDS_WAIT();
        bf16x8 kf[4];
#pragma unroll
        for (int d0 = 0; d0 < 4; ++d0) kf[d0] = *(const LAS bf16x8*)(kb + r32 * VPITCH + d0 * 32 + hi * 16);
        f32x16 a; for (int i = 0; i < 16; ++i) a[i] = 0.f;
#pragma unroll
        for (int d0 = 0; d0 < 4; ++d0) a = mfma32(kf[d0], qf[d0], a);
        s[kt] = a;
    }
    LDS_WAIT();
#pragma unroll
    for (int kt = 0; kt < 5; ++kt) {
        if (kt < kt0) {
#pragma unroll
            for (int i = 0; i < 16; ++i) s[kt][i] = -INFINITY;
        } else if (kt == 0) {
#pragma unroll
            for (int i = 0; i < 16; ++i) s[kt][i] = (crow(i, hi) >= r32) ? s[kt][i] : -INFINITY;
        } else if (kt == 4) {
#pragma unroll
            for (int i = 0; i < 16; ++i) s[kt][i] = (crow(i, hi) <= r32) ? s[kt][i] : -INFINITY;
        }
    }
    float mx = -INFINITY;
#pragma unroll
    for (int kt = 0; kt < 5; ++kt)
#pragma unroll
        for (int i = 0; i < 16; ++i) mx = fmaxf(mx, s[kt][i]);
    mx = fmaxf(mx, __shfl_xor(mx, 32));
    float lsum = 0.f;
#pragma unroll
    for (int kt = 0; kt < 5; ++kt)
#pragma unroll
        for (int i = 0; i < 16; ++i) { const float e = __builtin_amdgcn_exp2f(s[kt][i] - mx); s[kt][i] = e; lsum += e; }
    lsum += __shfl_xor(lsum, 32);
    f32x16 o[2]; for (int i = 0; i < 16; ++i) { o[0][i] = 0.f; o[1][i] = 0.f; }
    LAS float* wsf = (LAS float*)(wl + 2 * 32 * VPITCH);
    const unsigned vb0 = (unsigned)(uintptr_t)wl;
    const int g = lane >> 4, i16 = lane & 15, qq = i16 >> 2, pp = i16 & 3;
    const unsigned traddr = (unsigned)((4 * (g >> 1) + qq) * VPITCH + (16 * (g & 1) + 4 * pp) * 2);
    const int vrow8 = lane >> 3, vch = lane & 7;
    v4u vr[4];
#define ATT_LOADV(KT) do { _Pragma("unroll") for (int i_ = 0; i_ < 4; ++i_) { const int mk_ = m0 - 128 + 32 * (KT) + 8 * i_ + vrow8; const size_t vrow_ = rowb + (size_t)mk_ * dd + cls; \
        vr[i_] = *(const v4u*)(VB + vrow_ * 512 + h * 64 + vch * 8); } } while (0)
    ATT_LOADV(kt0);
#pragma unroll
    for (int kt = 0; kt < 5; ++kt) {
        if (kt >= kt0) {
            LAS unsigned char* vb = wl + (kt & 1) * 32 * VPITCH;
#pragma unroll
            for (int i_ = 0; i_ < 4; ++i_) *(LAS v4u*)(vb + (8 * i_ + vrow8) * VPITCH + vch * 16) = vr[i_];
            if (kt + 1 < 5) ATT_LOADV(kt + 1);
            LDS_WAIT();
            const unsigned base = vb0 + (unsigned)((kt & 1) * 32 * VPITCH) + traddr;
            s16x4 t[8];
            tr_read8(base, t);
#pragma unroll
            for (int ss = 0; ss < 2; ++ss) {
                const bf16x8 pa = pk8(s[kt][8 * ss], s[kt][8 * ss + 1], s[kt][8 * ss + 2], s[kt][8 * ss + 3], s[kt][8 * ss + 4], s[kt][8 * ss + 5], s[kt][8 * ss + 6], s[kt][8 * ss + 7]);
#pragma unroll
                for (int db = 0; db < 2; ++db) { const bf16x8 vf = __builtin_shufflevector(t[4 * ss + 2 * db], t[4 * ss + 2 * db + 1], 0, 1, 2, 3, 4, 5, 6, 7); o[db] = mfma32(pa, vf, o[db]); }
            }
        }
    }
#undef ATT_LOADV
    if (hi == 0) { wsf[r32] = __builtin_amdgcn_rcpf(lsum); LSE[((size_t)p * M + qrow) * 8 + h] = mx + __builtin_amdgcn_logf(lsum); }
    LDS_WAIT();
#pragma unroll
    for (int i = 0; i < 16; ++i) { const int q = crow(i, hi); const float li = wsf[q];
        *(LAS bf16*)(wl + q * VPITCH + r32 * 2) = (bf16)pk2z(o[0][i] * li); *(LAS bf16*)(wl + q * VPITCH + 64 + r32 * 2) = (bf16)pk2z(o[1][i] * li); }
    LDS_WAIT();
    { const int orow8 = lane >> 3, och = lane & 7;
#pragma unroll
      for (int i_ = 0; i_ < 4; ++i_) { const v4u w = *(const LAS v4u*)(wl + (8 * i_ + orow8) * VPITCH + och * 16); const size_t orow = rowb + (size_t)(m0 + 8 * i_ + orow8) * dd + cls;
          *(v4u*)(OP + ((size_t)p * M + orow) * 512 + h * 64 + och * 8) = w; } }
    LDS_WAIT();
}
DI void attn_finalize_row(const bf16* OP, const float* LSE, const float* gain, bf16* MIX, int row, int lane) {
    asm volatile("" : "+v"(lane));
    const int h = lane >> 3;
    float l0 = LSE[((size_t)0 * M + row) * 8 + h], l1 = LSE[((size_t)1 * M + row) * 8 + h], l2 = LSE[((size_t)2 * M + row) * 8 + h];
    const float mx = fmaxf(l0, fmaxf(l1, l2));
    float w0 = __builtin_amdgcn_exp2f(l0 - mx), w1 = __builtin_amdgcn_exp2f(l1 - mx), w2 = __builtin_amdgcn_exp2f(l2 - mx);
    const float inv = __builtin_amdgcn_rcpf(w0 + w1 + w2); w0 *= inv; w1 *= inv; w2 *= inv;
    const v4u a = *(const v4u*)(OP + ((size_t)0 * M + row) * 512 + lane * 8), b = *(const v4u*)(OP + ((size_t)1 * M + row) * 512 + lane * 8), c = *(const v4u*)(OP + ((size_t)2 * M + row) * 512 + lane * 8);
    float v[8]; float ss = 0.f;
#pragma unroll
    for (int j = 0; j < 4; ++j) { v[2 * j] = w0 * bflo(a[j]) + w1 * bflo(b[j]) + w2 * bflo(c[j]); v[2 * j + 1] = w0 * bfhi(a[j]) + w1 * bfhi(b[j]) + w2 * bfhi(c[j]); ss += v[2 * j] * v[2 * j] + v[2 * j + 1] * v[2 * j + 1]; }
    ss = wave_sum(ss);
    const float rinv = 1.0f / sqrtf(ss * (1.f / 512.f) + RMS_EPS);
    const f32x4 g0 = *(const f32x4*)(gain + lane * 8), g1 = *(const f32x4*)(gain + lane * 8 + 4);
    v4u w; w.x = pk2(v[0] * rinv * g0[0], v[1] * rinv * g0[1]); w.y = pk2(v[2] * rinv * g0[2], v[3] * rinv * g0[3]); w.z = pk2(v[4] * rinv * g1[0], v[5] * rinv * g1[1]); w.w = pk2(v[6] * rinv * g1[2], v[7] * rinv * g1[3]);
    *(v4u*)(MIX + (size_t)row * 1024 + lane * 8) = w;
}
constexpr int B1_IMG = 2048, B1_WLDS = 5 * B1_IMG + 1024;
constexpr int IMG_V = 0, IMG_A = 1 * B1_IMG, IMG_B = 2 * B1_IMG, IMG_W = 3 * B1_IMG, IMG_M = 4 * B1_IMG;
constexpr int TIL = 1 * B1_IMG, TIL_LP = 336, TIL_RP = 144, TIL_RSZ = 17 * TIL_RP;
static_assert(17 * TIL_LP <= 4 * B1_IMG && 3 * TIL_RSZ <= 4 * B1_IMG, "input tiles fit the image area");
DI float dpp_shr(float x, int n) { int v;
    switch (n) { case 1: v = __builtin_amdgcn_update_dpp(0, __builtin_bit_cast(int, x), 0x111, 0xf, 0xf, true); break; case 2: v = __builtin_amdgcn_update_dpp(0, __builtin_bit_cast(int, x), 0x112, 0xf, 0xf, true); break;
                 case 4: v = __builtin_amdgcn_update_dpp(0, __builtin_bit_cast(int, x), 0x114, 0xf, 0xf, true); break; default: v = __builtin_amdgcn_update_dpp(0, __builtin_bit_cast(int, x), 0x118, 0xf, 0xf, true); break; }
    return __builtin_bit_cast(float, v); }
DI float dpp_shr1(float x, int n) { int v; const int one = 0x3f800000;
    switch (n) { case 1: v = __builtin_amdgcn_update_dpp(one, __builtin_bit_cast(int, x), 0x111, 0xf, 0xf, false); break; case 2: v = __builtin_amdgcn_update_dpp(one, __builtin_bit_cast(int, x), 0x112, 0xf, 0xf, false); break;
                 case 4: v = __builtin_amdgcn_update_dpp(one, __builtin_bit_cast(int, x), 0x114, 0xf, 0xf, false); break; default: v = __builtin_amdgcn_update_dpp(one, __builtin_bit_cast(int, x), 0x118, 0xf, 0xf, false); break; }
    return __builtin_bit_cast(float, v); }
struct RwkvP {
    const bf16* PR; const float* mu; const float* muv;
    const float *dbase, *ibase, *vbase, *ksk, *ksa, *brk, *gng, *gnb;
    const bf16 *dupT, *iupT, *vupT, *gupT;
    const bf16* ZROW; bf16 *VF, *VV; float* BON; float* GC; bf16 *W1S, *REFF, *BM; v4u* REC; float* YPRE; bf16* MIX; int layer0;
};
DI const f32x4* vec4p(const float*) { return nullptr; }
DI const LAS f32x4* vec4p(const LAS float*) { return nullptr; }
template <class MP> DI void lerp8(const bf16* crow_, const bf16* prow_, int col, MP mu, float (&z)[8]) {
    const v4u cur = *(const v4u*)(crow_ + col); const v4u prv = *(const v4u*)(prow_ + col);
    const f32x4 m0 = *(decltype(vec4p(mu)))(mu), m1 = *(decltype(vec4p(mu)))(mu + 4);
#pragma unroll
    for (int j = 0; j < 4; ++j) { const float a = bflo(cur[j]), b = bfhi(cur[j]), pa = bflo(prv[j]), pb = bfhi(prv[j]); const float ma = j < 2 ? m0[2 * j] : m1[2 * j - 4], mb = j < 2 ? m0[2 * j + 1] : m1[2 * j - 3];
        z[2 * j] = a + (pa - a) * ma; z[2 * j + 1] = b + (pb - b) * mb; }
}
template <class MP> DI f32x4 lerp4(const bf16* crow_, const bf16* prow_, int col, MP mu) {
    const v2u cur = *(const v2u*)(crow_ + col); const v2u prv = *(const v2u*)(prow_ + col);
    const f32x4 m = *(decltype(vec4p(mu)))(mu);
    f32x4 z; z[0] = bflo(cur.x) + (bflo(prv.x) - bflo(cur.x)) * m[0]; z[1] = bfhi(cur.x) + (bfhi(prv.x) - bfhi(cur.x)) * m[1];
    z[2] = bflo(cur.y) + (bflo(prv.y) - bflo(cur.y)) * m[2]; z[3] = bfhi(cur.y) + (bfhi(prv.y) - bfhi(cur.y)) * m[3]; return z;
}
template <class MP> DI void lerp8l(const LAS unsigned char* crow_, const LAS unsigned char* prow_, int colb, MP mu, float (&z)[8]) {
    const v4u cur = *(const LAS v4u*)(crow_ + colb); const v4u prv = *(const LAS v4u*)(prow_ + colb);
    const f32x4 m0 = *(decltype(vec4p(mu)))(mu), m1 = *(decltype(vec4p(mu)))(mu + 4);
#pragma unroll
    for (int j = 0; j < 4; ++j) { const float a = bflo(cur[j]), b = bfhi(cur[j]), pa = bflo(prv[j]), pb = bfhi(prv[j]); const float ma = j < 2 ? m0[2 * j] : m1[2 * j - 4], mb = j < 2 ? m0[2 * j + 1] : m1[2 * j - 3];
        z[2 * j] = a + (pa - a) * ma; z[2 * j + 1] = b + (pb - b) * mb; }
}
template <class MP> DI f32x4 lerp4l(const LAS unsigned char* crow_, const LAS unsigned char* prow_, int colb, MP mu) {
    const v2u cur = *(const LAS v2u*)(crow_ + colb); const v2u prv = *(const LAS v2u*)(prow_ + colb);
    const f32x4 m = *(decltype(vec4p(mu)))(mu);
    f32x4 z; z[0] = bflo(cur.x) + (bflo(prv.x) - bflo(cur.x)) * m[0]; z[1] = bfhi(cur.x) + (bfhi(prv.x) - bfhi(cur.x)) * m[1];
    z[2] = bflo(cur.y) + (bflo(prv.y) - bflo(cur.y)) * m[2]; z[3] = bfhi(cur.y) + (bfhi(prv.y) - bfhi(cur.y)) * m[3]; return z;
}
DI void img_write(LAS unsigned char* img, const f32x4 (&x)[4], int fr, int fq) {
#pragma unroll
    for (int mb = 0; mb < 4; ++mb)
#pragma unroll
        for (int reg = 0; reg < 4; ++reg) *(LAS bf16*)(img + (16 * mb + 4 * fq + reg) * 32 + fr * 2) = (bf16)pk2z(x[mb][reg]);
}
DI bf16x8 lds4z(const LAS unsigned char* p) { const v2u t = *(const LAS v2u*)p; v4u w; w.x = t.x; w.y = t.y; w.z = 0u; w.w = 0u; return __builtin_bit_cast(bf16x8, w); }
constexpr int HC_DUP = 0, HC_IUP = 9216, HC_VUP = 18432, HC_F = 23552, HC_BYTES = 23552 + 736 * 4;
enum { HF_MUR = 0, HF_MUK = 64, HF_MUV = 128, HF_MUW = 192, HF_MUA = 256, HF_MUVR = 320, HF_DB = 352, HF_IB = 416, HF_VB = 480, HF_SK = 544, HF_SA = 608, HF_BR = 672 };
DI void head_cache_fill(const RwkvP& P, int h, LAS unsigned char* hc, int tid) {
    { const int row = tid >> 3, ch = tid & 7;
      *(LAS v4u*)(hc + HC_DUP + row * 144 + ch * 16) = *(const v4u*)(P.dupT + (size_t)(h * 64 + row) * 64 + ch * 8);
      *(LAS v4u*)(hc + HC_IUP + row * 144 + ch * 16) = *(const v4u*)(P.iupT + (size_t)(h * 64 + row) * 64 + ch * 8); }
    if (tid < 256 && !P.layer0) { const int row = tid >> 2, ch = tid & 3; *(LAS v4u*)(hc + HC_VUP + row * 80 + ch * 16) = *(const v4u*)(P.vupT + (size_t)(h * 64 + row) * 32 + ch * 8); }
    LAS float* f = (LAS float*)(hc + HC_F);
    if (tid < 64) { const int c = h * 64 + tid; f[HF_MUR + tid] = P.mu[c]; f[HF_MUK + tid] = P.mu[512 + c]; f[HF_MUV + tid] = P.mu[1024 + c]; f[HF_MUW + tid] = P.mu[1536 + tid]; f[HF_MUA + tid] = P.mu[1600 + tid];
        f[HF_DB + tid] = P.dbase[c]; f[HF_IB + tid] = P.ibase[c]; f[HF_VB + tid] = P.layer0 ? 0.f : P.vbase[c]; f[HF_SK + tid] = P.ksk[c]; f[HF_SA + tid] = P.ksa[c]; f[HF_BR + tid] = P.brk[c];
        if (tid < 32) f[HF_MUVR + tid] = P.layer0 ? 0.f : P.muv[tid]; }
}
DI void rwkv_b1_unit(const RwkvP& P, int unit, LAS unsigned char* wl, const LAS unsigned char* hc, LAS float* gct  , int lane) {
    asm volatile("" : "+v"(lane));
    const int fr = lane & 15, fq = lane >> 4;
    const int seq = unit >> 9, c = unit & 511, b = seq >> 3, h = seq & 7;
    const size_t row = (size_t)b * TSEQ + 16 * c + fr;
    const f32x4 z4 = {0.f, 0.f, 0.f, 0.f};
    const LAS float* hf = (const LAS float*)(hc + HC_F);
    const bf16* row0p = P.PR + ((size_t)b * TSEQ + 16 * c) * PRP;
#define TROW(rr) (((rr) == 0 && c == 0) ? P.ZROW : row0p + ((rr) - 1) * PRP)
    v4u tl[6], tr3[3][3];
#pragma unroll
    for (int i = 0; i < 5; ++i) { const int idx = lane + 64 * i; if (idx < 272) { const int rr = idx >> 4, pc = idx & 15; tl[i] = *(const v4u*)(TROW(rr) + 1536 + pc * 8); } }
    { const int idx = lane; const int rr = idx >> 2, pc = idx & 3; tl[5] = (v4u){0u, 0u, 0u, 0u}; if (!P.layer0) { tl[5] = *(const v4u*)(TROW(rr) + 1792 + pc * 8); } }
    v4u tl16 = {0u, 0u, 0u, 0u}; if (!P.layer0 && lane < 4) tl16 = *(const v4u*)(TROW(16) + 1792 + lane * 8);
#pragma unroll
    for (int ten = 0; ten < 3; ++ten)
#pragma unroll
        for (int i = 0; i < 3; ++i) { const int idx = lane + 64 * i; if (idx < 136) { const int rr = idx >> 3, pc = idx & 7; tr3[ten][i] = *(const v4u*)(TROW(rr) + ten * 512 + h * 64 + pc * 8); } }
#pragma unroll
    for (int i = 0; i < 5; ++i) { const int idx = lane + 64 * i; if (idx < 272) { const int rr = idx >> 4, pc = idx & 15; *(LAS v4u*)(wl + TIL + rr * TIL_LP + pc * 16) = tl[i]; } }
    { const int rr = lane >> 2, pc = lane & 3; *(LAS v4u*)(wl + TIL + rr * TIL_LP + 256 + pc * 16) = tl[5]; if (lane < 4) *(LAS v4u*)(wl + TIL + 16 * TIL_LP + 256 + lane * 16) = tl16; }
    LDS_WAIT();
    const LAS unsigned char* lcr = wl + TIL + (fr + 1) * TIL_LP; const LAS unsigned char* lpr = wl + TIL + fr * TIL_LP;
    bf16x8 tw[2], al[2], vl;
#pragma unroll
    for (int ks = 0; ks < 2; ++ks) { float z[8]; lerp8l(lcr, lpr, (8 * fq + 32 * ks) * 2, hf + HF_MUW + 8 * fq + 32 * ks, z);
        tw[ks] = pk8(ftanh(z[0]), ftanh(z[1]), ftanh(z[2]), ftanh(z[3]), ftanh(z[4]), ftanh(z[5]), ftanh(z[6]), ftanh(z[7]));
        lerp8l(lcr, lpr, 128 + (8 * fq + 32 * ks) * 2, hf + HF_MUA + 8 * fq + 32 * ks, z); al[ks] = pk8(z[0], z[1], z[2], z[3], z[4], z[5], z[6], z[7]); }
    if (!P.layer0) { float z[8]; lerp8l(lcr, lpr, 256 + 8 * fq * 2, hf + HF_MUVR + 8 * fq, z); vl = pk8(z[0], z[1], z[2], z[3], z[4], z[5], z[6], z[7]); }
    LDS_WAIT();
#pragma unroll
    for (int ten = 0; ten < 3; ++ten)
#pragma unroll
        for (int i = 0; i < 3; ++i) { const int idx = lane + 64 * i; if (idx < 136) { const int rr = idx >> 3, pc = idx & 7; *(LAS v4u*)(wl + TIL + ten * TIL_RSZ + rr * TIL_RP + pc * 16) = tr3[ten][i]; } }
    LDS_WAIT();
#undef TROW
    const LAS unsigned char* rcr = wl + TIL + (fr + 1) * TIL_RP; const LAS unsigned char* rpr = wl + TIL + fr * TIL_RP;
    f32x4 zr[4], k2[4], kk[4], ai[4], ld[4];
    float nrm = 0.f, bon = 0.f;
#pragma unroll
    for (int mb = 0; mb < 4; ++mb) { const int ch = h * 64 + 16 * mb + 4 * fq; const int n = h * 64 + 16 * mb + fr;
        f32x4 dw = z4, da = z4, dv = z4;
        dw = mfma16(*(const LAS bf16x8*)(hc + HC_DUP + (16 * mb + fr) * 144 + 16 * fq), tw[0], dw); dw = mfma16(*(const LAS bf16x8*)(hc + HC_DUP + (16 * mb + fr) * 144 + 16 * fq + 64), tw[1], dw);
        da = mfma16(*(const LAS bf16x8*)(hc + HC_IUP + (16 * mb + fr) * 144 + 16 * fq), al[0], da); da = mfma16(*(const LAS bf16x8*)(hc + HC_IUP + (16 * mb + fr) * 144 + 16 * fq + 64), al[1], da);
        if (!P.layer0) dv = mfma16(*(const LAS bf16x8*)(hc + HC_VUP + (16 * mb + fr) * 80 + 16 * fq), vl, z4);
        const int cl = 16 * mb + 4 * fq;
        zr[mb] = lerp4l(rcr, rpr, cl * 2, hf + HF_MUR + cl);
        const f32x4 zk = lerp4l(rcr + TIL_RSZ, rpr + TIL_RSZ, cl * 2, hf + HF_MUK + cl);
        f32x4 zv = lerp4l(rcr + 2 * TIL_RSZ, rpr + 2 * TIL_RSZ, cl * 2, hf + HF_MUV + cl);
        const f32x4 db = *(const LAS f32x4*)(hf + HF_DB + cl), ib = *(const LAS f32x4*)(hf + HF_IB + cl), sk = *(const LAS f32x4*)(hf + HF_SK + cl), sa = *(const LAS f32x4*)(hf + HF_SA + cl), br = *(const LAS f32x4*)(hf + HF_BR + cl);
        if (P.layer0) { v2u w; w.x = pk2(zv[0], zv[1]); w.y = pk2(zv[2], zv[3]); *(v2u*)(P.VF + row * 512 + ch) = w; }
        else { const v2u f = *(const v2u*)(P.VF + row * 512 + ch); const f32x4 vb = *(const LAS f32x4*)(hf + HF_VB + cl); const f32x4 vf = {bflo(f.x), bfhi(f.x), bflo(f.y), bfhi(f.y)};
#pragma unroll
            for (int e = 0; e < 4; ++e) zv[e] = zv[e] + (vf[e] - zv[e]) * fsigmoid(vb[e] + dv[e]); }
        { v2u w; w.x = pk2(zv[0], zv[1]); w.y = pk2(zv[2], zv[3]); *(v2u*)(P.VV + row * 512 + ch) = w; }
#pragma unroll
        for (int reg = 0; reg < 4; ++reg) *(LAS bf16*)(wl + IMG_V + (16 * mb + 4 * fq + reg) * 32 + fr * 2) = (bf16)pk2z(zv[reg]);
#pragma unroll
        for (int e = 0; e < 4; ++e) {
            ld[mb][e] = fexp(-0.60653065971f * fsigmoid(db[e] + dw[e]));
            const float a = fsigmoid(ib[e] + da[e]); ai[mb][e] = a;
            const float kr = zk[e] * sk[e]; kk[mb][e] = kr; nrm += kr * kr;
            const float kx = zk[e] * (1.f + (a - 1.f) * sa[e]); k2[mb][e] = kx; bon += zr[mb][e] * kx * br[e]; }
        asm volatile("" ::: "memory");
    }
    nrm += __shfl_xor(nrm, 16); nrm += __shfl_xor(nrm, 32); bon += __shfl_xor(bon, 16); bon += __shfl_xor(bon, 32);
    if (fq == 0) P.BON[row * 8 + h] = bon;
    const float kinv = 1.0f / fmaxf(sqrtf(nrm), 1e-12f);
    f32x4 rt[4], kh[4];
    bf16x8 pa[2], pb[2], pk[2], pr[2];
#pragma unroll
    for (int ks = 0; ks < 2; ++ks) {
        f32x4 at2[2], bt2[2], kt2[2];
#pragma unroll
        for (int m2 = 0; m2 < 2; ++m2) { const int mb = 2 * ks + m2;
            f32x4 gcv, bhv;
#pragma unroll
            for (int e = 0; e < 4; ++e) {
                float gm = ld[mb][e]; gm *= dpp_shr1(gm, 1); gm *= dpp_shr1(gm, 2); gm *= dpp_shr1(gm, 4); gm *= dpp_shr1(gm, 8);
                const float gc = __shfl(gm, lane | 15), gp = dpp_shr1(gm, 1), gi = __builtin_amdgcn_rcpf(gm), ec = gc * gi;
                const float kn = kk[mb][e] * kinv, bb = kn * ai[mb][e];
                at2[m2][e] = -kn * gp; bt2[m2][e] = bb * gi; kt2[m2][e] = k2[mb][e] * gi; rt[mb][e] = zr[mb][e] * gm;
                bhv[e] = bb * ec; kh[mb][e] = k2[mb][e] * ec; gcv[e] = gc; }
            if (fr == 0) { *(f32x4*)(P.GC + (size_t)unit * 64 + 16 * mb + 4 * fq) = gcv; *(LAS f32x4*)(gct + (unit & 31) * 64 + 16 * mb + 4 * fq) = gcv; }
#pragma unroll
            for (int reg = 0; reg < 4; ++reg) { const int o = (16 * mb + 4 * fq + reg) * 32 + fr * 2;
                *(LAS bf16*)(wl + IMG_A + o) = (bf16)pk2z(at2[m2][reg]); *(LAS bf16*)(wl + IMG_B + o) = (bf16)pk2z(bhv[reg]); }
        }
        pa[ks] = pk8v(at2[0], at2[1]); pb[ks] = pk8v(bt2[0], bt2[1]); pk[ks] = pk8v(kt2[0], kt2[1]); pr[ks] = pk8v(rt[2 * ks], rt[2 * ks + 1]);
    }
    const f32x4 z4b = {0.f, 0.f, 0.f, 0.f};
    f32x4 Aab = mfma16(pb[1], pa[1], mfma16(pb[0], pa[0], z4b));
    f32x4 AakT = mfma16(pa[1], pk[1], mfma16(pa[0], pk[0], z4b));
    f32x4 Arb = mfma16(pb[1], pr[1], mfma16(pb[0], pr[0], z4b));
    f32x4 Ark = mfma16(pk[1], pr[1], mfma16(pk[0], pr[0], z4b));
#pragma unroll
    for (int e = 0; e < 4; ++e) { const int rr = 4 * fq + e; Aab[e] = rr < fr ? Aab[e] : 0.f; AakT[e] = fr < rr ? AakT[e] : 0.f; Arb[e] = rr <= fr ? Arb[e] : 0.f; Ark[e] = rr <= fr ? Ark[e] : 0.f; }
    LAS float* As = (LAS float*)(wl + 5 * B1_IMG);
#pragma unroll
    for (int e = 0; e < 4; ++e) As[(4 * fq + e) * 16 + fr] = Aab[e];
    LDS_WAIT();
    float x[16];
#pragma unroll
    for (int s = 15; s >= 0; --s) { float acc = (s == fr) ? 1.f : 0.f;
        const f32x4 r0 = *(const LAS f32x4*)(As + s * 16), r1 = *(const LAS f32x4*)(As + s * 16 + 4), r2 = *(const LAS f32x4*)(As + s * 16 + 8), r3 = *(const LAS f32x4*)(As + s * 16 + 12);
        const float rowv[16] = {r0[0], r0[1], r0[2], r0[3], r1[0], r1[1], r1[2], r1[3], r2[0], r2[1], r2[2], r2[3], r3[0], r3[1], r3[2], r3[3]};
#pragma unroll
        for (int uu = s + 1; uu < 16; ++uu) acc += rowv[uu] * x[uu];
        x[s] = acc; if ((s & 1) == 0) asm volatile("" ::: "memory"); }
    f32x4 xs;
#pragma unroll
    for (int e = 0; e < 4; ++e) xs[e] = fq == 0 ? x[e] : fq == 1 ? x[4 + e] : fq == 2 ? x[8 + e] : x[12 + e];
    const bf16x8 Tsel = pk4z(xs);
    f32x4 W1[4];
#pragma unroll
    for (int mb = 0; mb < 4; ++mb) W1[mb] = mfma16(lds4z(wl + IMG_A + (16 * mb + fr) * 32 + 8 * fq), Tsel, z4);
    const f32x4 GT = mfma16(Tsel, pk4z(AakT), z4);
    img_write(wl + IMG_W, W1, fr, fq);
    f32x4 M1T[4];
    const bf16x8 GTp = pk4z(GT);
#pragma unroll
    for (int mb = 0; mb < 4; ++mb) M1T[mb] = mfma16(lds4z(wl + IMG_B + (16 * mb + fr) * 32 + 8 * fq), GTp, kh[mb]);
    img_write(wl + IMG_M, M1T, fr, fq);
    LDS_WAIT();
    const bf16x8 Arbp = pk4z(Arb);
    f32x4 RE[4];
#pragma unroll
    for (int mb = 0; mb < 4; ++mb) RE[mb] = mfma16(lds4z(wl + IMG_W + (16 * mb + fr) * 32 + 8 * fq), Arbp, rt[mb]);
    const f32x4 M2 = mfma16(GTp, Arbp, Ark);
    {   bf16* w1s = P.W1S + (size_t)unit * 1024 + fr * 32; bf16* re = P.REFF + (size_t)unit * 1024 + fr * 32;
#pragma unroll
        for (int kp = 0; kp < 2; ++kp) { const int sg = kp * 512 + fq * 8;
            v4u w; w.x = pk2(W1[2 * kp][0], W1[2 * kp][1]); w.y = pk2(W1[2 * kp][2], W1[2 * kp][3]); w.z = pk2(W1[2 * kp + 1][0], W1[2 * kp + 1][1]); w.w = pk2(W1[2 * kp + 1][2], W1[2 * kp + 1][3]); *(v4u*)(w1s + sg) = w;
            w.x = pk2(RE[2 * kp][0], RE[2 * kp][1]); w.y = pk2(RE[2 * kp][2], RE[2 * kp][3]); w.z = pk2(RE[2 * kp + 1][0], RE[2 * kp + 1][1]); w.w = pk2(RE[2 * kp + 1][2], RE[2 * kp + 1][3]); *(v4u*)(re + sg) = w; }
        const v2u m2p = {pk2(M2[0], M2[1]), pk2(M2[2], M2[3])};
#pragma unroll
        for (int mb = 0; mb < 4; ++mb) {
            const v2u bq = *(const LAS v2u*)(wl + IMG_B + (16 * mb + fr) * 32 + 8 * fq), mq = *(const LAS v2u*)(wl + IMG_M + (16 * mb + fr) * 32 + 8 * fq);
            *(v4u*)(P.BM + (((size_t)unit * 64 + 16 * mb + fr) * 4 + fq) * 8) = (v4u){bq.x, bq.y, mq.x, mq.y};
            const v2u vq = *(const LAS v2u*)(wl + IMG_V + (16 * mb + fr) * 32 + 8 * fq);
            P.REC[((size_t)unit * 4 + mb) * 64 + lane] = (v4u){vq.x, vq.y, m2p.x, m2p.y}; }
    }
    LDS_WAIT();
}
constexpr int NSEG = 16, SEGCH = NCH / NSEG;
struct ChainIn { bf16x8 w1[2], re[2], bm[4]; v4u rec; };
constexpr int GCT_OFF = 149504;
template <int MODE> DI void chain_load(ChainIn& c, const RwkvP& P, int unit, int rb, int lane) {
    const int fr = lane & 15, fq = lane >> 4;
    const bf16* w1s = P.W1S + (size_t)unit * 1024 + fr * 32 + fq * 8;
    c.w1[0] = ld8(w1s); c.w1[1] = ld8(w1s + 512);
    if (MODE == 2) { const bf16* re = P.REFF + (size_t)unit * 1024 + fr * 32 + fq * 8; c.re[0] = ld8(re); c.re[1] = ld8(re + 512); }
#pragma unroll
    for (int mb = 0; mb < 4; ++mb) c.bm[mb] = ld8(P.BM + (((size_t)unit * 64 + 16 * mb + fr) * 4 + fq) * 8);
    if (MODE != 1) c.rec = P.REC[((size_t)unit * 4 + rb) * 64 + lane];
}
template <int MODE> DI void chain_step(f32x4 (&S)[4], const ChainIn& c, float* ypre  , const LAS float* gcl  ) {
    const f32x4 z4 = {0.f, 0.f, 0.f, 0.f};
    f32x4 gc[4];
#pragma unroll
    for (int mb = 0; mb < 4; ++mb) gc[mb] = *(const LAS f32x4*)(gcl + 16 * mb);
    const bf16x8 b0 = pk8v(S[0], S[1]), b1 = pk8v(S[2], S[3]);
    f32x4 ut = mfma16(c.w1[1], b1, mfma16(c.w1[0], b0, z4));
    if (MODE == 2) {
        v4u vlo; vlo.x = c.rec.x; vlo.y = c.rec.y; vlo.z = 0u; vlo.w = 0u;
        v4u m2a; m2a.x = c.rec.z; m2a.y = c.rec.w; m2a.z = 0u; m2a.w = 0u;
        f32x4 y = mfma16(__builtin_bit_cast(bf16x8, m2a), __builtin_bit_cast(bf16x8, vlo), z4);
        y = mfma16(c.re[0], b0, y); y = mfma16(c.re[1], b1, y);
#pragma unroll
        for (int e = 0; e < 4; ++e) ypre[(size_t)e * 512] = y[e];
    }
    v4u uv; uv.x = pk2(ut[0], ut[1]); uv.y = pk2(ut[2], ut[3]); uv.z = MODE == 1 ? 0u : c.rec.x; uv.w = MODE == 1 ? 0u : c.rec.y;
    const bf16x8 ub = __builtin_bit_cast(bf16x8, uv);
#pragma unroll
    for (int mb = 0; mb < 4; ++mb) S[mb] = mfma16(c.bm[mb], ub, S[mb] * gc[mb]);
}
template <int MODE> DI void chain_run(f32x4 (&S)[4], const RwkvP& P, int unit0, int nsteps  , int rb, float* yp, const LAS float* gct  , int lane) {
    ChainIn c0, c1, c2, c3;
    chain_load<MODE>(c0, P, unit0, rb, lane); chain_load<MODE>(c1, P, unit0 + 1, rb, lane); chain_load<MODE>(c2, P, unit0 + 2, rb, lane);
    for (int c = 0; c < nsteps; c += 4) {
        chain_load<MODE>(c3, P, unit0 + c + 3, rb, lane);
        chain_step<MODE>(S, c0, yp + (size_t)c * 16 * 512, gct + c * 64);
        if (c + 4 < nsteps) chain_load<MODE>(c0, P, unit0 + c + 4, rb, lane);
        chain_step<MODE>(S, c1, yp + (size_t)(c + 1) * 16 * 512, gct + (c + 1) * 64);
        if (c + 5 < nsteps) chain_load<MODE>(c1, P, unit0 + c + 5, rb, lane);
        chain_step<MODE>(S, c2, yp + (size_t)(c + 2) * 16 * 512, gct + (c + 2) * 64);
        if (c + 6 < nsteps) chain_load<MODE>(c2, P, unit0 + c + 6, rb, lane);
        chain_step<MODE>(S, c3, yp + (size_t)(c + 3) * 16 * 512, gct + (c + 3) * 64);
    }
}
DI void chain_step_dual(f32x4 (&SQ)[4], f32x4 (&SP)[4], const ChainIn& c, const LAS float* gcl) {
    const f32x4 z4 = {0.f, 0.f, 0.f, 0.f};
    f32x4 gc[4];
#pragma unroll
    for (int mb = 0; mb < 4; ++mb) gc[mb] = *(const LAS f32x4*)(gcl + 16 * mb);
    const bf16x8 q0 = pk8v(SQ[0], SQ[1]), q1 = pk8v(SQ[2], SQ[3]), p0 = pk8v(SP[0], SP[1]), p1 = pk8v(SP[2], SP[3]);
    const f32x4 utq = mfma16(c.w1[1], q1, mfma16(c.w1[0], q0, z4)), utp = mfma16(c.w1[1], p1, mfma16(c.w1[0], p0, z4));
    v4u uq; uq.x = pk2(utq[0], utq[1]); uq.y = pk2(utq[2], utq[3]); uq.z = c.rec.x; uq.w = c.rec.y;
    v4u up; up.x = pk2(utp[0], utp[1]); up.y = pk2(utp[2], utp[3]); up.z = 0u; up.w = 0u;
    const bf16x8 ubq = __builtin_bit_cast(bf16x8, uq), ubp = __builtin_bit_cast(bf16x8, up);
#pragma unroll
    for (int mb = 0; mb < 4; ++mb) { SQ[mb] = mfma16(c.bm[mb], ubq, SQ[mb] * gc[mb]); SP[mb] = mfma16(c.bm[mb], ubp, SP[mb] * gc[mb]); }
}
DI void chain_pass1(const RwkvP& P, float* QSEG, float* PSEGT, int seq, int g, int rb, const LAS float* gct0, int lane) {
    const int fr = lane & 15, fq = lane >> 4;
    f32x4 SQ[4], SP[4];
#pragma unroll
    for (int mb = 0; mb < 4; ++mb)
#pragma unroll
        for (int e = 0; e < 4; ++e) { SQ[mb][e] = 0.f; SP[mb][e] = ((16 * mb + 4 * fq + e) == (16 * rb + fr)) ? 1.f : 0.f; }
    const int unit0 = seq * NCH + g * SEGCH; const LAS float* gct = gct0 + 4 * fq;
    {   ChainIn c0, c1, c2;
        chain_load<0>(c0, P, unit0, rb, lane); chain_load<0>(c1, P, unit0 + 1, rb, lane);
        int c = 0;
        for (; c + 3 <= SEGCH; c += 3) {
            chain_load<0>(c2, P, unit0 + c + 2, rb, lane);
            chain_step_dual(SQ, SP, c0, gct + c * 64);
            if (c + 3 < SEGCH) chain_load<0>(c0, P, unit0 + c + 3, rb, lane);
            chain_step_dual(SQ, SP, c1, gct + (c + 1) * 64);
            if (c + 4 < SEGCH) chain_load<0>(c1, P, unit0 + c + 4, rb, lane);
            chain_step_dual(SQ, SP, c2, gct + (c + 2) * 64);
        }
        if (c < SEGCH) { chain_step_dual(SQ, SP, c0, gct + c * 64); ++c; }
        if (c < SEGCH) { chain_step_dual(SQ, SP, c1, gct + c * 64); ++c; }
    }
    const size_t sb = ((size_t)seq * NSEG + g) * 4096;
#pragma unroll
    for (int mb = 0; mb < 4; ++mb) *(f32x4*)(QSEG + sb + (size_t)(16 * rb + fr) * 64 + 16 * mb + 4 * fq) = SQ[mb];
#pragma unroll
    for (int mb = 0; mb < 4; ++mb)
#pragma unroll
        for (int e = 0; e < 4; ++e) PSEGT[sb + (size_t)((mb * 2 + (rb >> 1)) * 2 + (rb & 1)) * 256 + ((4 * fq + e) + 16 * (fr >> 2)) * 4 + (fr & 3)] = SP[mb][e];
}
DI void split_hl(const f32x4 a, const f32x4 b, bf16x8& hi, bf16x8& lo) {
    f32x4 ah, bh;
#pragma unroll
    for (int e = 0; e < 4; ++e) { ah[e] = rbf(a[e]); bh[e] = rbf(b[e]); }
    hi = pk8v(ah, bh); lo = pk8v(a - ah, b - bh);
}
DI void chain_pass23(const RwkvP& P, const float* QSEG, const float* PSEGT, int seq, int g, int rb, float* wkv_out, const LAS float* gct0, int lane) {
    const int fr = lane & 15, fq = lane >> 4, b = seq >> 3, h = seq & 7;
    f32x4 S[4]; for (int mb = 0; mb < 4; ++mb) S[mb] = (f32x4){0.f, 0.f, 0.f, 0.f};
    f32x4 pc[4][2][2], pn[4][2][2];
#define P2_LOAD(PD_, GP_) do { const size_t sb_ = ((size_t)seq * NSEG + (GP_)) * 4096; _Pragma("unroll") for (int mb = 0; mb < 4; ++mb) { \
        _Pragma("unroll") for (int ks = 0; ks < 2; ++ks) { const float* pr_ = PSEGT + sb_ + (size_t)((mb * 2 + ks) * 2) * 256 + (fr + 16 * fq) * 4; PD_[mb][ks][0] = *(const f32x4*)pr_; PD_[mb][ks][1] = *(const f32x4*)(pr_ + 256); } } } while (0)
    if (g > 0) P2_LOAD(pc, 0);
    for (int gp = 0; gp < g; ++gp) {
        f32x4 qc[4];
        { const size_t sb_ = ((size_t)seq * NSEG + gp) * 4096;
#pragma unroll
          for (int mb = 0; mb < 4; ++mb) qc[mb] = *(const f32x4*)(QSEG + sb_ + (size_t)(16 * rb + fr) * 64 + 16 * mb + 4 * fq); }
        if (gp + 1 < g) P2_LOAD(pn, gp + 1);
        bf16x8 bh[2], bl[2]; split_hl(S[0], S[1], bh[0], bl[0]); split_hl(S[2], S[3], bh[1], bl[1]);
#pragma unroll
        for (int mb = 0; mb < 4; ++mb) { f32x4 acc = {0.f, 0.f, 0.f, 0.f};
#pragma unroll
            for (int ks = 0; ks < 2; ++ks) { bf16x8 ah, al; split_hl(pc[mb][ks][0], pc[mb][ks][1], ah, al);
                acc = mfma16(ah, bh[ks], acc); acc = mfma16(al, bh[ks], acc); acc = mfma16(ah, bl[ks], acc); }
            S[mb] = acc + qc[mb]; }
#pragma unroll
        for (int mb = 0; mb < 4; ++mb) {
#pragma unroll
            for (int ks = 0; ks < 2; ++ks) { pc[mb][ks][0] = pn[mb][ks][0]; pc[mb][ks][1] = pn[mb][ks][1]; } }
    }
#undef P2_LOAD
    float* yp = P.YPRE + ((size_t)b * TSEQ + (size_t)g * SEGCH * 16 + 4 * fq) * 512 + h * 64 + 16 * rb + fr;
    chain_run<2>(S, P, seq * NCH + g * SEGCH, SEGCH, rb, yp, gct0 + 4 * fq, lane);
    if (g == NSEG - 1) {
#pragma unroll
        for (int mb = 0; mb < 4; ++mb) *(f32x4*)(wkv_out + (size_t)(16 * rb + fr) * 64 + 16 * mb + 4 * fq) = S[mb];
    }
}
constexpr int GC_GUP = 0, GC_F = 64 * 272, GC_BYTES = 64 * 272 + 256 * 4;
DI void gate_cache_fill(const RwkvP& P, int h, LAS unsigned char* gc, int tid) {
#pragma unroll
    for (int q = 0; q < 2; ++q) { const int idx = tid + 512 * q, row = idx >> 4, ch = idx & 15;
        *(LAS v4u*)(gc + GC_GUP + row * 272 + ch * 16) = *(const v4u*)(P.gupT + (size_t)(h * 64 + row) * 128 + ch * 8); }
    LAS float* f = (LAS float*)(gc + GC_F);
    if (tid < 64) { f[tid] = P.gng[h * 64 + tid]; f[64 + tid] = P.gnb[h * 64 + tid]; }
    if (tid >= 64 && tid < 192) f[128 + tid - 64] = P.mu[1664 + tid - 64];
}
constexpr int B3_GP = 272, B3_YP = 272, B3_VP = 144, B3_G = 0, B3_Y = 17 * B3_GP, B3_V = B3_Y + 16 * B3_YP, B3_WLDS = B3_V + 16 * B3_VP;
DI void rwkv_b3_unit(const RwkvP& P, int unit, const LAS unsigned char* gc, LAS unsigned char* wl, int lane) {
    asm volatile("" : "+v"(lane));
    const int fr = lane & 15, fq = lane >> 4;
    const int seq = unit >> 9, c = unit & 511, b = seq >> 3, h = seq & 7;
    const size_t row0 = (size_t)b * TSEQ + 16 * c;
    const f32x4 z4 = {0.f, 0.f, 0.f, 0.f};
    const LAS float* gf = (const LAS float*)(gc + GC_F);
    const bf16* row0p = P.PR + row0 * PRP;
    v4u tg[5], ty[4], tv[2];
#pragma unroll
    for (int i = 0; i < 5; ++i) { const int idx = lane + 64 * i; if (idx < 272) { const int rr = idx >> 4, pc = idx & 15; const bf16* rp = (rr == 0 && c == 0) ? P.ZROW : row0p + (rr - 1) * PRP; tg[i] = *(const v4u*)(rp + 1664 + pc * 8); } }
#pragma unroll
    for (int i = 0; i < 4; ++i) { const int idx = lane + 64 * i, rr = idx >> 4, pc = idx & 15; ty[i] = *(const v4u*)(P.YPRE + (row0 + rr) * 512 + h * 64 + pc * 4); }
#pragma unroll
    for (int i = 0; i < 2; ++i) { const int idx = lane + 64 * i, rr = idx >> 3, pc = idx & 7; tv[i] = *(const v4u*)(P.VV + (row0 + rr) * 512 + h * 64 + pc * 8); }
    const float bon = P.BON[(row0 + fr) * 8 + h];
#pragma unroll
    for (int i = 0; i < 5; ++i) { const int idx = lane + 64 * i; if (idx < 272) { const int rr = idx >> 4, pc = idx & 15; *(LAS v4u*)(wl + B3_G + rr * B3_GP + pc * 16) = tg[i]; } }
#pragma unroll
    for (int i = 0; i < 4; ++i) { const int idx = lane + 64 * i, rr = idx >> 4, pc = idx & 15; *(LAS v4u*)(wl + B3_Y + rr * B3_YP + pc * 16) = ty[i]; }
#pragma unroll
    for (int i = 0; i < 2; ++i) { const int idx = lane + 64 * i, rr = idx >> 3, pc = idx & 7; *(LAS v4u*)(wl + B3_V + rr * B3_VP + pc * 16) = tv[i]; }
    LDS_WAIT();
    const LAS unsigned char* gcr = wl + B3_G + (fr + 1) * B3_GP; const LAS unsigned char* gpr = wl + B3_G + fr * B3_GP;
    bf16x8 sg[4];
#pragma unroll
    for (int ks = 0; ks < 4; ++ks) { float z[8]; lerp8l(gcr, gpr, (8 * fq + 32 * ks) * 2, gf + 128 + 8 * fq + 32 * ks, z);
        sg[ks] = pk8(fsigmoid(z[0]), fsigmoid(z[1]), fsigmoid(z[2]), fsigmoid(z[3]), fsigmoid(z[4]), fsigmoid(z[5]), fsigmoid(z[6]), fsigmoid(z[7])); }
    f32x4 g[4], y[4]; float s = 0.f;
#pragma unroll
    for (int mb = 0; mb < 4; ++mb) { f32x4 a = z4;
#pragma unroll
        for (int ks = 0; ks < 4; ++ks) a = mfma16(*(const LAS bf16x8*)(gc + GC_GUP + (16 * mb + fr) * 272 + 16 * fq + 64 * ks), sg[ks], a);
        g[mb] = a;
        y[mb] = *(const LAS f32x4*)(wl + B3_Y + fr * B3_YP + (16 * mb + 4 * fq) * 4); s += (y[mb][0] + y[mb][1]) + (y[mb][2] + y[mb][3]); }
    s += __shfl_xor(s, 16); s += __shfl_xor(s, 32);
    const float mean = s * (1.f / 64.f); float q = 0.f;
#pragma unroll
    for (int mb = 0; mb < 4; ++mb) { y[mb] = y[mb] - mean; q += (y[mb][0] * y[mb][0] + y[mb][1] * y[mb][1]) + (y[mb][2] * y[mb][2] + y[mb][3] * y[mb][3]); }
    q += __shfl_xor(q, 16); q += __shfl_xor(q, 32);
    const float rstd = 1.0f / sqrtf(q * (1.f / 64.f) + GN_EPS);
    LDS_WAIT();
#pragma unroll
    for (int mb = 0; mb < 4; ++mb) { const int cl = 16 * mb + 4 * fq;
        const f32x4 gg = *(const LAS f32x4*)(gf + cl), gb = *(const LAS f32x4*)(gf + 64 + cl); const v2u vw = *(const LAS v2u*)(wl + B3_V + fr * B3_VP + cl * 2);
        const f32x4 v = {bflo(vw.x), bfhi(vw.x), bflo(vw.y), bfhi(vw.y)};
        const f32x4 o = (y[mb] * rstd * gg + gb + v * bon) * g[mb];
        v2u w; w.x = pk2(o[0], o[1]); w.y = pk2(o[2], o[3]); *(LAS v2u*)(wl + B3_G + fr * B3_VP + cl * 2) = w; }
    LDS_WAIT();
#pragma unroll
    for (int i = 0; i < 2; ++i) { const int idx = lane + 64 * i, rr = idx >> 3, pc = idx & 7; *(v4u*)(P.MIX + (row0 + rr) * 1024 + 512 + h * 64 + pc * 8) = *(const LAS v4u*)(wl + B3_G + rr * B3_VP + pc * 16); }
    LDS_WAIT();
}
DI f32x16 dec_gemm(const bf16* A, const bf16* Wt, int K, LAS float* red  , int wave, int lane) {
    const int r = lane & 31, h = lane >> 5, kw = K >> 3;
    const bf16* ap = A + (size_t)r * K + wave * kw + 8 * h; const bf16* bp = Wt + (size_t)r * K + wave * kw + 8 * h;
    f32x16 acc; for (int i = 0; i < 16; ++i) acc[i] = 0.f;
#pragma unroll 16
    for (int k = 0; k < kw; k += 16) acc = mfma32(ld8(ap + k), ld8(bp + k), acc);
    __syncthreads();
#pragma unroll
    for (int i = 0; i < 16; ++i) red[(wave * 16 + i) * 64 + lane] = acc[i];
    __syncthreads();
    if (wave == 0) {
#pragma unroll
        for (int i = 0; i < 16; ++i) { float s = 0.f;
#pragma unroll
            for (int w = 0; w < 8; ++w) s += red[(w * 16 + i) * 64 + lane];
            asm volatile("" : "+v"(s) :: "memory"); acc[i] = s; } }
    return acc;
}
DI void dec_row_stats(const float* st, LAS float* sc, int lane) {
    if (lane < 32) { float s = 0.f, q = 0.f; const f32x4* p = (const f32x4*)(st + (size_t)lane * 64);
#pragma unroll
        for (int i = 0; i < 16; ++i) { const f32x4 v = p[i]; s += v[0] + v[2]; q += v[1] + v[3]; if ((i & 3) == 3) asm volatile("" : "+v"(s), "+v"(q) :: "memory"); }
        const float mu = s * (1.f / 1024.f), var = fmaxf(q * (1.f / 1024.f) - mu * mu, 0.f); sc[2 * lane] = mu; sc[2 * lane + 1] = 1.0f / sqrtf(var + LN_EPS); }
    LDS_WAIT();
}
struct DecP {
    unsigned char* dec; int l;
    const float* xs;
    const float *c1in, *c2in, *c1up, *c2up, *g1, *b1, *g2p, *b2p;
    const bf16 *win, *winu, *wout, *wup, *wdn;
    float* out;
};
DI void dec_unit_in(const DecP& D, int u, LAS float* red, LAS float* sc, int wave, int lane) {
    const int r32 = lane & 31, hi = lane >> 5;
    if (u < 105) {
        const int n = 32 * u + r32; const bool fold = D.l > 0;
        const f32x16 acc = dec_gemm((const bf16*)(D.dec + DEC_XB2), D.win + (size_t)(32 * u) * DM, DM, red, wave, lane);
        if (wave != 0) return;
        if (fold) dec_row_stats((const float*)(D.dec + DEC_ST2), sc, lane);
        const float c1 = fold ? D.c1in[n] : 0.f, c2 = fold ? D.c2in[n] : 0.f; const int on = n < 1024 ? lgcl2orig(n) : n;
        float* PD = (float*)(D.dec + DEC_PD);
#pragma unroll
        for (int i = 0; i < 16; ++i) { const int row = crow(i, hi); float mu = 0.f, rs = 1.f; if (fold) { mu = sc[2 * row]; rs = sc[2 * row + 1]; } PD[(size_t)row * NIN + on] = (acc[i] - mu * c1) * rs + c2; }
    } else {
        const int v = u - 105, n = 32 * v + r32;
        const f32x16 acc = dec_gemm((const bf16*)(D.dec + DEC_SHB) + (size_t)D.l * MD * DM, D.winu + (size_t)(32 * v) * DM, DM, red, wave, lane);
        if (wave != 0) return;
        float* PS = (float*)(D.dec + DEC_PS);
#pragma unroll
        for (int i = 0; i < 16; ++i) PS[(size_t)crow(i, hi) * NRWU + n] = acc[i];
    }
    LDS_WAIT();
}
DI void dec_unit_res(const bf16* A, const bf16* Wt, int K, int u, bool raw, const float* src, const float* sstat, const float* g, const float* b, float* T, bf16* XB, float* ostat, float* shiftout, LAS float* red, LAS float* sc, int wave, int lane) {
    const int r32 = lane & 31, hi = lane >> 5, n = 32 * u + r32;
    const f32x16 acc = dec_gemm(A, Wt + (size_t)(32 * u) * K, K, red, wave, lane);
    if (wave != 0) return;
    if (!raw) dec_row_stats(sstat, sc, lane);
    const float gg = raw ? 1.f : g[n], bb = raw ? 0.f : b[n];
#pragma unroll
    for (int i = 0; i < 16; ++i) { const int row = crow(i, hi); float mu = 0.f, rs = 1.f; if (!raw) { mu = sc[2 * row]; rs = sc[2 * row + 1]; }
        const float x = (src[(size_t)row * DM + n] - mu) * rs * gg + bb; const float t = ALPHA * x + acc[i];
        T[(size_t)row * DM + n] = t; XB[(size_t)row * DM + n] = (bf16)f2bf(t); if (shiftout) shiftout[(size_t)row * DM + n] = x;
        float s = t, q = t * t;
#pragma unroll
        for (int o = 1; o < 32; o <<= 1) { s += __shfl_xor(s, o); q += __shfl_xor(q, o); }
        if (r32 == 0) { ostat[((size_t)row * 32 + u) * 2] = s; ostat[((size_t)row * 32 + u) * 2 + 1] = q; } }
    LDS_WAIT();
}
DI void dec_unit_up(const DecP& D, int u, LAS float* red, LAS float* sc, int wave, int lane) {
    const int r32 = lane & 31, hi = lane >> 5, n = 32 * u + r32;
    const f32x16 acc = dec_gemm((const bf16*)(D.dec + DEC_XB1), D.wup + (size_t)(32 * u) * DM, DM, red, wave, lane);
    if (wave != 0) return;
    dec_row_stats((const float*)(D.dec + DEC_ST1), sc, lane);
    const float c1 = D.c1up[n], c2 = D.c2up[n]; bf16* HB = (bf16*)(D.dec + DEC_HB);
#pragma unroll
    for (int i = 0; i < 16; ++i) { const int row = crow(i, hi); const float v = fmaxf((acc[i] - sc[2 * row] * c1) * sc[2 * row + 1] + c2, 0.f); HB[(size_t)row * FFD + n] = (bf16)f2bf(v * v); }
    LDS_WAIT();
}
DI void dec_attn_task(const DecP& D, const float* ck, const float* cv, const float* rope, int bd, int h, int p, int lane) {
    const int g = lane >> 4, dq = lane & 15, dd = 1 << (2 * p);
    const float* PD = (const float*)(D.dec + DEC_PD) + (size_t)bd * NIN;
    const f32x4 rr0 = *(const f32x4*)(rope + ((size_t)8192 * 32 + ((4 * dq) & 31)) * 2), rr1 = *(const f32x4*)(rope + ((size_t)8192 * 32 + ((4 * dq) & 31)) * 2 + 4);
    const f32x4 cs = {rr0[0], rr0[2], rr1[0], rr1[2]}, sn = {rr0[1], rr0[3], rr1[1], rr1[3]};
    const float sgn = dq < 8 ? -1.f : 1.f;
    f32x4 q = *(const f32x4*)(PD + h * 64 + 4 * dq), kn = *(const f32x4*)(PD + 512 + h * 64 + 4 * dq); const f32x4 vn = *(const f32x4*)(PD + 1024 + h * 64 + 4 * dq);
    { f32x4 qp, kp;
#pragma unroll
      for (int e = 0; e < 4; ++e) { qp[e] = __shfl_xor(q[e], 8); kp[e] = __shfl_xor(kn[e], 8); }
      q = q * cs + qp * sn * sgn; kn = kn * cs + kp * sn * sgn; }
    if (p == 0 && g == 0) { *(f32x4*)(D.out + O_KS + ((size_t)D.l * MD + bd) * 512 + h * 64 + 4 * dq) = kn; *(f32x4*)(D.out + O_VS + ((size_t)D.l * MD + bd) * 512 + h * 64 + 4 * dq) = vn; }
    float s0 = (q[0] * kn[0] + q[1] * kn[1]) + (q[2] * kn[2] + q[3] * kn[3]);
#pragma unroll
    for (int o = 1; o < 16; o <<= 1) s0 += __shfl_xor(s0, o);
    s0 *= 0.125f;
    const size_t cbase = (((size_t)D.l * MD + bd) * 2048) * 512 + h * 64 + 4 * dq;
    float mx = -INFINITY, den = 0.f; f32x4 o4 = {0.f, 0.f, 0.f, 0.f};
#pragma unroll 8
    for (int it = 0; it < 32; ++it) { const int j = 1 + 4 * it + g; const size_t off = cbase + (size_t)(2048 - j * dd) * 512;
        const f32x4 kr = ldf4nt(ck + off); const f32x4 vr = ldf4nt(cv + off);
        float s = (q[0] * kr[0] + q[1] * kr[1]) + (q[2] * kr[2] + q[3] * kr[3]);
#pragma unroll
        for (int o = 1; o < 16; o <<= 1) s += __shfl_xor(s, o);
        s *= 0.125f;
        const float mn = fmaxf(mx, s), sc = fexp(mx - mn), pj = fexp(s - mn);
        den = den * sc + pj; o4 = o4 * sc + vr * pj; mx = mn; }
    float mg = fmaxf(mx, __shfl_xor(mx, 16)); mg = fmaxf(mg, __shfl_xor(mg, 32)); mg = fmaxf(mg, s0);
    { const float sc = fexp(mx - mg); den *= sc; o4 = o4 * sc; }
    den += __shfl_xor(den, 16); den += __shfl_xor(den, 32);
#pragma unroll
    for (int e = 0; e < 4; ++e) { o4[e] += __shfl_xor(o4[e], 16); o4[e] += __shfl_xor(o4[e], 32); }
    const float p0 = fexp(s0 - mg); den += p0; o4 = (o4 + vn * p0) * (1.0f / den); mx = mg;
    if (g == 0) *(f32x4*)((float*)(D.dec + DEC_OP) + ((size_t)p * MD + bd) * 512 + h * 64 + 4 * dq) = o4;
    if (lane == 0) ((float*)(D.dec + DEC_LSE))[((size_t)p * MD + bd) * 8 + h] = mx + __logf(den);
}
DI void dec_rwkv_task(const DecP& D, const float* const* in, int bd, int h, LAS float* sv  , int lane) {
    const int l = D.l, ch = h * 64 + lane;
    const float* PD = (const float*)(D.dec + DEC_PD) + (size_t)bd * NIN + RW0; const float* PS = (const float*)(D.dec + DEC_PS) + (size_t)bd * NRWU;
    const float* mu = in[8] + (size_t)l * 1792;
    auto zf = [&](int col) { const float pr = PD[col], pv = PS[col]; return pr + (pv - pr) * mu[col]; };
    const float zr = zf(ch), zk = zf(512 + ch), zv0 = zf(1024 + ch);
    float vl = 0.f; if (l > 0 && lane < 32) { const float pr = PD[1792 + lane], pv = PS[1792 + lane]; vl = pr + (pv - pr) * in[9][(size_t)(l - 1) * 32 + lane]; }
    sv[lane] = ftanh(zf(1536 + lane)); sv[64 + lane] = zf(1600 + lane); sv[128 + lane] = fsigmoid(zf(1664 + lane)); sv[192 + lane] = fsigmoid(zf(1728 + lane)); sv[256 + lane] = vl;
    LDS_WAIT();
    float dw = 0.f, da = 0.f, dv = 0.f, gt = 0.f;
    const float* du = in[11] + (size_t)l * 64 * 512 + ch; const float* iu = in[13] + (size_t)l * 64 * 512 + ch; const float* gu = in[14] + (size_t)l * 128 * 512 + ch;
#pragma unroll 2
    for (int m4 = 0; m4 < 16; ++m4) { const f32x4 a = *(const LAS f32x4*)(sv + 4 * m4), b = *(const LAS f32x4*)(sv + 64 + 4 * m4), c = *(const LAS f32x4*)(sv + 128 + 4 * m4), d = *(const LAS f32x4*)(sv + 192 + 4 * m4);
#pragma unroll
        for (int e = 0; e < 4; ++e) { const int m = 4 * m4 + e; dw += a[e] * du[(size_t)m * 512]; da += b[e] * iu[(size_t)m * 512]; gt += c[e] * gu[(size_t)m * 512] + d[e] * gu[(size_t)(64 + m) * 512]; } }
    if (l > 0) { const float* vu = in[16] + (size_t)(l - 1) * 32 * 512 + ch;
#pragma unroll
        for (int m4 = 0; m4 < 8; ++m4) { const f32x4 a = *(const LAS f32x4*)(sv + 256 + 4 * m4);
#pragma unroll
            for (int e = 0; e < 4; ++e) dv += a[e] * vu[(size_t)(4 * m4 + e) * 512]; } }
    const float w = -fsoftplus(-(in[10][(size_t)l * 512 + ch] + dw)) - 0.5f, decay = fexp(-fexp(w));
    const float a = fsigmoid(in[12][(size_t)l * 512 + ch] + da);
    float* VFD = (float*)(D.dec + DEC_VF) + (size_t)bd * 512 + ch;
    float v = zv0; if (l == 0) *VFD = zv0; else v = zv0 + (*VFD - zv0) * fsigmoid(in[15][(size_t)(l - 1) * 512 + ch] + dv);
    const float kr = zk * in[17][(size_t)l * 512 + ch]; const float kn = kr / fmaxf(sqrtf(wave_sum(kr * kr)), 1e-12f);
    const float k2 = zk * (1.f + (a - 1.f) * in[18][(size_t)l * 512 + ch]);
    const float bon = wave_sum(zr * k2 * in[19][(size_t)l * 512 + ch]);
    LDS_WAIT();
    sv[320 + lane] = -kn; sv[384 + lane] = decay; sv[448 + lane] = kn * a; sv[512 + lane] = k2; sv[576 + lane] = zr; sv[640 + lane] = v;
    LDS_WAIT();
    const float* S0 = in[3] + (((size_t)l * MD + bd) * NH + h) * 4096;
    float* So = D.out + O_WKS + (((size_t)l * MD + bd) * NH + h) * 4096;
    { const int rr = lane >> 4, cq = lane & 15;
      const f32x4 a4 = *(const LAS f32x4*)(sv + 320 + 4 * cq), w4 = *(const LAS f32x4*)(sv + 384 + 4 * cq), b4 = *(const LAS f32x4*)(sv + 448 + 4 * cq), k4 = *(const LAS f32x4*)(sv + 512 + 4 * cq), r4 = *(const LAS f32x4*)(sv + 576 + 4 * cq);
      f32x4 Sr[16];
#pragma unroll
      for (int q = 0; q < 16; ++q) Sr[q] = *(const f32x4*)(S0 + (size_t)(4 * q + rr) * 64 + 4 * cq);
#pragma unroll
      for (int q = 0; q < 16; ++q) { const int i = 4 * q + rr;
          float sa = (Sr[q][0] * a4[0] + Sr[q][1] * a4[1]) + (Sr[q][2] * a4[2] + Sr[q][3] * a4[3]);
#pragma unroll
          for (int o = 1; o < 16; o <<= 1) sa += __shfl_xor(sa, o);
          const float vi = sv[640 + i];
          const f32x4 s4 = Sr[q] * w4 + b4 * sa + k4 * vi; *(f32x4*)(So + (size_t)i * 64 + 4 * cq) = s4;
          float yp = (s4[0] * r4[0] + s4[1] * r4[1]) + (s4[2] * r4[2] + s4[3] * r4[3]);
#pragma unroll
          for (int o = 1; o < 16; o <<= 1) yp += __shfl_xor(yp, o);
          if (cq == 0) sv[704 + i] = yp; } }
    LDS_WAIT();
    const float y = sv[704 + lane];
    const float mean = wave_sum(y) * (1.f / 64.f), dy = y - mean, var = wave_sum(dy * dy) * (1.f / 64.f);
    const float o = (dy * (1.0f / sqrtf(var + GN_EPS)) * in[20][(size_t)l * 512 + ch] + in[21][(size_t)l * 512 + ch] + bon * v) * gt;
    ((float*)(D.dec + DEC_MIX))[(size_t)bd * DM + 512 + ch] = o;
    LDS_WAIT();
}
DI void dec_finalize_row(const DecP& D, const float* gain, int bd, int lane) {
    const int h = lane >> 3; const float* L = (const float*)(D.dec + DEC_LSE); const float* OPD = (const float*)(D.dec + DEC_OP);
    const float l0 = L[((size_t)0 * MD + bd) * 8 + h], l1 = L[((size_t)1 * MD + bd) * 8 + h], l2 = L[((size_t)2 * MD + bd) * 8 + h];
    const float mx = fmaxf(l0, fmaxf(l1, l2)); float w0 = fexp(l0 - mx), w1 = fexp(l1 - mx), w2 = fexp(l2 - mx); const float inv = 1.0f / (w0 + w1 + w2); w0 *= inv; w1 *= inv; w2 *= inv;
    float v[8]; float ss = 0.f;
#pragma unroll
    for (int e = 0; e < 8; ++e) { v[e] = w0 * OPD[((size_t)0 * MD + bd) * 512 + lane * 8 + e] + w1 * OPD[((size_t)1 * MD + bd) * 512 + lane * 8 + e] + w2 * OPD[((size_t)2 * MD + bd) * 512 + lane * 8 + e]; ss += v[e] * v[e]; }
    ss = wave_sum(ss); const float rinv = 1.0f / sqrtf(ss * (1.f / 512.f) + RMS_EPS);
    bf16* MB = (bf16*)(D.dec + DEC_MIXB) + (size_t)bd * DM; const float* MX = (const float*)(D.dec + DEC_MIX) + (size_t)bd * DM + 512;
#pragma unroll
    for (int e = 0; e < 8; ++e) { MB[lane * 8 + e] = (bf16)f2bf(v[e] * rinv * gain[lane * 8 + e]); MB[512 + lane * 8 + e] = (bf16)f2bf(MX[lane * 8 + e]); }
}
#ifndef PH_MASK
#define PH_MASK 0x1ff
#endif
#define PH_ON(k) ((PH_MASK >> (k)) & 1)
#ifndef PH_DUP
#define PH_DUP 0
#endif
#define PH_REP(k) for (int rep_ = 0; rep_ < (((PH_DUP >> (k)) & 1) ? 2 : 1); ++rep_)
DI unsigned lds_task_next(volatile LAS unsigned* ctr, int lane) {
    unsigned t = 0; if (lane == 0) t = __hip_atomic_fetch_add((LAS unsigned*)ctr, 1u, __ATOMIC_RELAXED, __HIP_MEMORY_SCOPE_WORKGROUP);
    return (unsigned)__builtin_amdgcn_readfirstlane((int)t);
}
DI DecP make_dec(unsigned char* ws, const float* const* in, float* out, int l) {
    DecP D; D.dec = ws + WS_DEC; D.l = l; D.xs = in[1];
    D.c1in = (const float*)(ws + WS_C1IN) + l * NIN; D.c2in = (const float*)(ws + WS_C2IN) + l * NIN; D.c1up = (const float*)(ws + WS_C1UP) + l * FFD; D.c2up = (const float*)(ws + WS_C2UP) + l * FFD;
    D.g1 = in[24] + (size_t)l * DM; D.b1 = in[25] + (size_t)l * DM; D.g2p = l > 0 ? in[28] + (size_t)(l - 1) * DM : nullptr; D.b2p = l > 0 ? in[29] + (size_t)(l - 1) * DM : nullptr;
    D.win = (const bf16*)(ws + WS_WIN) + (size_t)l * NIN * DM; D.winu = (const bf16*)(ws + WS_WINU) + (size_t)l * NRWU * DM; D.wout = (const bf16*)(ws + WS_WOUT) + (size_t)l * DM * DM;
    D.wup = (const bf16*)(ws + WS_WUP) + (size_t)l * FFD * DM; D.wdn = (const bf16*)(ws + WS_WDN) + (size_t)l * DM * FFD; D.out = out; return D;
}
DI RwkvP make_rwkv(unsigned char* ws, const float* const* in, int l) {
    RwkvP R; R.PR = (const bf16*)(ws + WS_PR); R.mu = in[8] + (size_t)l * 1792; R.muv = l > 0 ? in[9] + (size_t)(l - 1) * 32 : nullptr;
    R.dbase = in[10] + (size_t)l * 512; R.ibase = in[12] + (size_t)l * 512; R.vbase = l > 0 ? in[15] + (size_t)(l - 1) * 512 : nullptr; R.ksk = in[17] + (size_t)l * 512; R.ksa = in[18] + (size_t)l * 512; R.brk = in[19] + (size_t)l * 512;
    R.gng = in[20] + (size_t)l * 512; R.gnb = in[21] + (size_t)l * 512;
    R.dupT = (const bf16*)(ws + WS_DUPT) + (size_t)l * 512 * 64; R.iupT = (const bf16*)(ws + WS_IUPT) + (size_t)l * 512 * 64; R.vupT = l > 0 ? (const bf16*)(ws + WS_VUPT) + (size_t)(l - 1) * 512 * 32 : nullptr; R.gupT = (const bf16*)(ws + WS_GUPT) + (size_t)l * 512 * 128;
    R.ZROW = (const bf16*)(ws + WS_CTL + 512 * 1024); R.VF = (bf16*)(ws + WS_VF); R.VV = (bf16*)(ws + WS_VV); R.BON = (float*)(ws + WS_BON); R.GC = (float*)(ws + WS_GC); R.W1S = (bf16*)(ws + WS_PT); R.REFF = (bf16*)(ws + WS_REFF); R.BM = (bf16*)(ws + WS_QT); R.REC = (v4u*)(ws + WS_YLOC);
    R.YPRE = (float*)(ws + WS_YPRE); R.MIX = (bf16*)(ws + WS_MIX); R.layer0 = (l == 0); return R;
}
#define PHASE_VARS() int tid_p = (int)threadIdx.x; asm volatile("" : "+v"(tid_p)); const int lane = tid_p & 63; const int wave = __builtin_amdgcn_readfirstlane(tid_p >> 6); \
    unsigned zo_p; asm volatile("s_mov_b32 %0, 0" : "=s"(zo_p)); unsigned char* ws = args.ws + zo_p; const float* const* in = args.in + zo_p; float* out = args.out + zo_p; \
    const int gw = F.vcu * NWAVES + wave; const int rgw = (F.G - 1 - (int)blockIdx.x) * NWAVES + wave; LAS float* dsc = (LAS float*)(L3 + 65536); LAS float* dred = (LAS float*)L3; const int rwg = F.G - 1 - (int)blockIdx.x; (void)gw; (void)rgw; (void)dsc; (void)dred; (void)rwg; (void)lane; (void)in; (void)out
__global__ void __launch_bounds__(NWAVES * 64, 2) mega_fwd(Args args) {
    extern __shared__ __attribute__((aligned(16))) unsigned char lds[];
    Frame F;
    F.lds = lds; F.MISC = (volatile LAS unsigned*)((LAS unsigned char*)lds + MISC_OFF);
    F.tid = threadIdx.x; F.lane = F.tid & 63; F.wave = __builtin_amdgcn_readfirstlane(F.tid >> 6);
    F.G = gridDim.x; { const int bx = blockIdx.x; F.vcu = (F.G % 8 == 0) ? (bx % 8) * (F.G / 8) + bx / 8 : bx; }
    F.gw = F.vcu * NWAVES + F.wave; F.NGW = F.G * NWAVES;
    F.in = args.in; F.out = args.out; F.ws = args.ws; F.ctl = (gu32*)(args.ws + WS_CTL);
    LAS unsigned char* L3 = (LAS unsigned char*)lds;
    for (int u = F.tid; u < (LDS_BYTES - RING_BYTES) / 4; u += NWAVES * 64) ((LAS unsigned*)(L3 + RING_BYTES))[u] = 0u;
    __syncthreads();
    XcdBarrier bar = xcd_barrier_post((unsigned*)(F.ctl + CW_BAR), F.MISC + 8);
#define GRID_BAR() do { XcdBarrier b2_ = bar; asm volatile("" : "+s"(b2_.x)); xcd_barrier(b2_); } while (0)

    PH_REP(0) { if (PH_ON(0)) p0_prologue(F);
    GRID_BAR(); }

    for (int l = 0; l < DEPTH; ++l) {
        PH_REP(1) {
        if (PH_ON(1))
        {   PHASE_VARS(); const DecP D = make_dec(ws, in, out, l);
            pg8::Gemm g{(const pg8::bf16_t*)(ws + WS_XB2), (const pg8::bf16_t*)D.win, M, NIN, DM}; pg8::StaticOrder S; S.init(M, NIN, F.G, (int)blockIdx.x);
            pg8::etab_fill((PG8_LAS unsigned char*)L3, S, (const float*)(ws + WS_STAT2), D.c1in, D.c2in, l > 0, tid_p); __syncthreads();
            pg8::EpiIn E{ws, out, l, (const PG8_LAS unsigned char*)L3};
            pg8::gemm_phase<pg8::EpiIn, pg8::StaticOrder, true, true>((PG8_LAS unsigned char*)L3, g, S, E, tid_p);
            if (rwg < 128) for (int u = rwg; u < 162; u += 128) dec_unit_in(D, u, dred, dsc, wave, lane);
        }
        GRID_BAR();
        }

#define ATT_QUEUE() do { LAS unsigned char* wl_ = L3 + wave * 10240; const int bh_ = F.vcu >> 4, span_ = F.vcu & 15; \
        for (;;) { const unsigned t_ = lds_task_next(F.MISC, lane); if (t_ >= 48u) break; \
            if (t_ >= 48u) { const int dt_ = (int)blockIdx.x * 4 + (int)(t_ - 48u); \
                if (dt_ < 768) dec_attn_task(D, in[4], in[5], (const float*)(ws + WS_ROPE), dt_ / 24, (dt_ % 24) / 3, dt_ % 3, lane); \
                else dec_rwkv_task(D, in, (dt_ - 768) >> 3, (dt_ - 768) & 7, (LAS float*)wl_, lane); continue; } \
            const int p_ = (int)t_ >> 4, idx_ = (int)t_ & 15; \
            const int cls_ = p_ == 0 ? 0 : p_ == 1 ? (idx_ >> 2) : idx_, qblk_ = p_ == 0 ? span_ * 16 + idx_ : p_ == 1 ? span_ * 4 + (idx_ & 3) : span_; \
            attn_task((const bf16*)(ws + WS_QB), (const bf16*)(ws + WS_KB), (const bf16*)(ws + WS_VB), (bf16*)(ws + WS_OP), (float*)(ws + WS_LSE), bh_ >> 3, bh_ & 7, p_, cls_, qblk_, wl_, lane); } } while (0)
        PH_REP(3) {
        if (PH_ON(3))
        {   PHASE_VARS(); const DecP D = make_dec(ws, in, out, l); const RwkvP R = make_rwkv(ws, in, l);
            if (tid_p == 0) F.MISC[0] = 0u;
            if (l == 0) colsum_finish(ws, gw * 64 + lane, F.NGW * 64);
            { LAS unsigned char* wl1 = L3 + wave * 12288; LAS unsigned char* hc = L3 + 8 * 12288;
              head_cache_fill(R, (F.vcu >> 4) & 7, hc, tid_p);
              __syncthreads();
#pragma unroll 1
              for (int i = 0; i < 4; ++i) rwkv_b1_unit(R, F.vcu * 32 + wave + 8 * i, wl1, hc, (LAS float*)(L3 + GCT_OFF), lane); }
            VM_WAIT(); __syncthreads();
            if (wave >= 4) { const int dt = (int)blockIdx.x * 4 + (wave - 4);
                if (dt < 768) dec_attn_task(D, in[4], in[5], (const float*)(ws + WS_ROPE), dt / 24, (dt % 24) / 3, dt % 3, lane);
                else dec_rwkv_task(D, in, (dt - 768) >> 3, (dt - 768) & 7, (LAS float*)(L3 + wave * 10240), lane); }
            if (wave < 4) chain_pass1(R, (float*)(ws + WS_SEGQ), (float*)(ws + WS_SEGP), F.vcu >> 4, F.vcu & 15, wave, (const LAS float*)(L3 + GCT_OFF), lane);
            ATT_QUEUE();
            if ((PH_DUP >> 12) & 1) { __syncthreads(); if (tid_p == 0) F.MISC[0] = 0u; __syncthreads(); ATT_QUEUE(); }
        }
        GRID_BAR();
        }
        PH_REP(9) {
        if (PH_ON(3))
        {   PHASE_VARS(); const DecP D = make_dec(ws, in, out, l); const RwkvP R = make_rwkv(ws, in, l);
            const int seq = F.vcu >> 4, sg = F.vcu & 15;
            LAS unsigned char* gcache = L3 + 98304; gate_cache_fill(R, seq & 7, gcache, tid_p);
            for (int e = tid_p; e < SEGCH * 64; e += NWAVES * 64) ((LAS float*)(L3 + GCT_OFF))[e] = R.GC[(size_t)(seq * NCH + sg * SEGCH) * 64 + e];
            __syncthreads();
            if (wave < 4) chain_pass23(R, (const float*)(ws + WS_SEGQ), (const float*)(ws + WS_SEGP), seq, sg, wave, out + O_WKP + ((size_t)l * 16 + seq) * 4096, (const LAS float*)(L3 + GCT_OFF), lane);
            else { for (int i = 0; i < 16; ++i) attn_finalize_row((const bf16*)(ws + WS_OP), (const float*)(ws + WS_LSE), in[22] + (size_t)l * 512, (bf16*)(ws + WS_MIX), (int)blockIdx.x * 64 + (wave - 4) * 16 + i, lane);
                if (blockIdx.x < MD && wave == 4) dec_finalize_row(D, in[22] + (size_t)l * 512, (int)blockIdx.x, lane); }
            VM_WAIT(); __syncthreads();
#pragma unroll 1
            for (int i = 0; i < 4; ++i) rwkv_b3_unit(R, seq * NCH + sg * SEGCH + wave + 8 * i, gcache, L3 + wave * 12288, lane);
        }
        GRID_BAR();
        }

        PH_REP(5) {
        if (PH_ON(5))
        {   PHASE_VARS(); const DecP D = make_dec(ws, in, out, l);
            pg8::Gemm g{(const pg8::bf16_t*)(ws + WS_MIX), (const pg8::bf16_t*)D.wout, M, DM, DM}; pg8::StaticOrder S; S.init(M, DM, F.G, (int)blockIdx.x);
            pg8::EpiRes<false> E{ws, in, out, l};
            pg8::gemm_phase<pg8::EpiRes<false>, pg8::StaticOrder, false, true>((PG8_LAS unsigned char*)L3, g, S, E, tid_p);
            for (int u = rwg; u < 32; u += F.G)
                dec_unit_res((const bf16*)(D.dec + DEC_MIXB), D.wout, DM, u, l == 0, l == 0 ? D.xs : (const float*)(D.dec + DEC_T2), (const float*)(D.dec + DEC_ST2), D.g2p, D.b2p, (float*)(D.dec + DEC_T1), (bf16*)(D.dec + DEC_XB1), (float*)(D.dec + DEC_ST1),
                             out + O_SHS + (size_t)l * MD * DM, dred, dsc, wave, lane);
        }
        GRID_BAR();
        }

        PH_REP(6) {
        if (PH_ON(6))
        {   PHASE_VARS(); const DecP D = make_dec(ws, in, out, l);
            pg8::Gemm g{(const pg8::bf16_t*)(ws + WS_XB1), (const pg8::bf16_t*)D.wup, M, FFD, DM}; pg8::StaticOrder S; S.init(M, FFD, F.G, (int)blockIdx.x);
            pg8::etab_fill((PG8_LAS unsigned char*)L3, S, (const float*)(ws + WS_STAT1), D.c1up, D.c2up, true, tid_p); __syncthreads();
            pg8::EpiUp E{ws, (const PG8_LAS unsigned char*)L3};
            pg8::gemm_phase<pg8::EpiUp, pg8::StaticOrder, true, true>((PG8_LAS unsigned char*)L3, g, S, E, tid_p);
            for (int u = rwg; u < 128; u += F.G) dec_unit_up(D, u, dred, dsc, wave, lane);
        }
        GRID_BAR();
        }

        PH_REP(7) {
        if (PH_ON(7))
        {   PHASE_VARS(); const DecP D = make_dec(ws, in, out, l);
            pg8::Gemm g{(const pg8::bf16_t*)(ws + WS_H), (const pg8::bf16_t*)D.wdn, M, DM, FFD}; pg8::StaticOrder S; S.init(M, DM, F.G, (int)blockIdx.x);
            pg8::EpiRes<true> E{ws, in, out, l};
            PH_REP(11) { pg8::gemm_phase<pg8::EpiRes<true>, pg8::StaticOrder, false, true>((PG8_LAS unsigned char*)L3, g, S, E, tid_p); }
            PH_REP(10) for (int u = rwg; u < 32; u += F.G)
                dec_unit_res((const bf16*)(D.dec + DEC_HB), D.wdn, FFD, u, false, (const float*)(D.dec + DEC_T1), (const float*)(D.dec + DEC_ST1), D.g1, D.b1, (float*)(D.dec + DEC_T2), (bf16*)(D.dec + DEC_XB2), (float*)(D.dec + DEC_ST2), nullptr, dred, dsc, wave, lane);
        }
        GRID_BAR();
        }
    }
    if (PH_ON(8))
    {   PHASE_VARS(); const float* g = in[28] + (size_t)3 * DM; const float* b = in[29] + (size_t)3 * DM;
        for (int r = gw; r < M; r += F.NGW) { float mu, rs; pg8::row_stats((const float*)(ws + WS_STAT2), r, mu, rs);
            const v2u* t = (const v2u*)((const bf16*)(ws + WS_XB2) + (size_t)r * DM) + lane; f32x4* o = (f32x4*)(out + O_Y + (size_t)r * DM) + lane;
#pragma unroll
            for (int j = 0; j < 4; ++j) { const f32x4 gg = *((const f32x4*)g + lane + 64 * j), bb = *((const f32x4*)b + lane + 64 * j); const v2u w = t[64 * j]; const f32x4 tv = {bflo(w.x), bfhi(w.x), bflo(w.y), bfhi(w.y)}; o[64 * j] = (tv - mu) * rs * gg + bb; } }
        if (rgw < MD) { LAS float* fsc = dsc + wave * 64; dec_row_stats((const float*)(ws + WS_DEC + DEC_ST2), fsc, lane); const float mu = fsc[2 * rgw], rs = fsc[2 * rgw + 1];
            const f32x4* t = (const f32x4*)((const float*)(ws + WS_DEC + DEC_T2) + (size_t)rgw * DM) + lane; f32x4* o = (f32x4*)(out + O_YS + (size_t)rgw * DM) + lane;
#pragma unroll
            for (int j = 0; j < 4; ++j) { const f32x4 gg = *((const f32x4*)g + lane + 64 * j), bb = *((const f32x4*)b + lane + 64 * j); o[64 * j] = (t[64 * j] - mu) * rs * gg + bb; } }
    }
}

extern "C" void kernel_launch(void* const* d_in, const int* in_sizes, int n_in, void* d_out, int out_size, void* d_ws, size_t ws_size, hipStream_t stream) {
    static int grid = 0;
    if (grid == 0) {
        if (n_in != 30 || out_size != (int)O_END || ws_size < WS_END) { fprintf(stderr, "kernel_launch: unexpected problem (n_in %d, out %d, ws %zu); nothing launched\n", n_in, out_size, ws_size); grid = -1; return; }
        int dev = 0, cus = 0, per_cu = 0;
        if (hipGetDevice(&dev) != hipSuccess || hipDeviceGetAttribute(&cus, hipDeviceAttributeMultiprocessorCount, dev) != hipSuccess) { fprintf(stderr, "kernel_launch: device query failed\n"); grid = -1; return; }
        if (hipFuncSetAttribute((const void*)mega_fwd, hipFuncAttributeMaxDynamicSharedMemorySize, LDS_BYTES) != hipSuccess) { fprintf(stderr, "kernel_launch: hipFuncSetAttribute failed\n"); grid = -1; return; }
        if (hipOccupancyMaxActiveBlocksPerMultiprocessor(&per_cu, (const void*)mega_fwd, NWAVES * 64, LDS_BYTES) != hipSuccess || per_cu < 1) fprintf(stderr, "kernel_launch: occupancy query reports %d\n", per_cu);
        (void)hipGetLastError();
        if (cus < 256) { fprintf(stderr, "kernel_launch: needs 256 CUs (found %d)\n", cus); grid = -1; return; }
        grid = 256;
    }
    if (grid < 0) return;
    if (hipMemsetAsync((char*)d_ws + WS_CTL, 0, CTL_ZERO_BYTES, stream) != hipSuccess) { fprintf(stderr, "kernel_launch: memset failed\n"); return; }
    Args a{};
    for (int i = 0; i < 30; ++i) a.in[i] = (const float*)d_in[i];
    a.out = (float*)d_out; a.ws = (unsigned char*)d_ws;
    hipLaunchKernelGGL(mega_fwd, dim3(grid), dim3(NWAVES * 64), LDS_BYTES, stream, a);
    const hipError_t le = hipPeekAtLastError();
    if (le != hipSuccess) fprintf(stderr, "kernel_launch: launch failed: %s\n", hipGetErrorName(le));
}
```

```cpp
#include <hip/hip_runtime.h>
#include <cstdio>
#include <cstdint>
#include <cmath>
namespace pg8 {
#define PG8_LAS __attribute__((address_space(3)))
typedef unsigned short bf16_t;
typedef short bf16x8 __attribute__((ext_vector_type(8)));
typedef float f32x4 __attribute__((ext_vector_type(4)));
typedef unsigned u32x4 __attribute__((ext_vector_type(4)));
constexpr int BM = 256, BK = 64, HALF = 128, HTB = HALF * BK * 2  , STAGE_BYTES = 8 * HTB, NXCD = 8, WGM = 8;

__host__ __device__ __forceinline__ int lds_byte(int r, int c) { const int st = (r >> 4) * 2 + (c >> 5), rr = r & 15, cc = c & 31, ob = rr * 64 + cc * 2; return st * 1024 + (ob ^ (((ob >> 9) & 1) << 5)); }
__host__ __device__ __forceinline__ void stage_rc(int b, int& R, int& C) { const int st = b / 1024, sb = b % 1024, swz = sb ^ (((sb >> 9) & 1) << 5); R = (st >> 1) * 16 + swz / 64; C = (st & 1) * 32 + (swz % 64) / 2; }
__host__ __device__ __forceinline__ int perm32(int rho) { const int n = rho >> 4, i = rho & 15; return 8 * (i >> 2) + 4 * n + (i & 3); }

struct Unit { int pm, pn; };
struct Gemm { const bf16_t* A; const bf16_t* Bt; int M, N, K; };

struct StaticOrder {
    int nM, nN, nwg, G, c;
    __host__ __device__ void init(int M, int N, int G_, int c_) { nM = M / BM; nN = N / BM; nwg = nM * nN; G = G_; c = c_; }
    __host__ __device__ bool next(int i, Unit& u) const {
        const long L = (long)i * G + c; if (L >= nwg) return false;
        int wgid = (int)L; { const int q = nwg / NXCD, r = nwg % NXCD, xcd = wgid % NXCD, off = wgid / NXCD; wgid = (xcd < r ? xcd * (q + 1) : r * (q + 1) + (xcd - r) * q) + off; }
        const int nig = WGM * nN, gid = wgid / nig, fm = gid * WGM, gsz = (nM - fm) < WGM ? (nM - fm) : WGM;
        u.pm = fm + ((wgid % nig) % gsz); u.pn = (wgid % nig) / gsz; return true;
    }
    __device__ __forceinline__ void a_ready(const Unit&) const {}
    __device__ __forceinline__ void done(const Unit&) const {}
};

__device__ __forceinline__ unsigned cvt_pk_bf16(float lo, float hi) { unsigned r; asm volatile("v_cvt_pk_bf16_f32 %0, %1, %2" : "=v"(r) : "v"(lo), "v"(hi)); return r; }
typedef float f32x2 __attribute__((ext_vector_type(2)));
constexpr size_t WSO_C1IN = 1u << 20, WSO_C2IN = WSO_C1IN + 4 * 3584 * 4, WSO_C1UP = WSO_C2IN + 4 * 3584 * 4, WSO_C2UP = WSO_C1UP + 4 * 4096 * 4, WSO_ROPE = 3u << 20, WSO_STAT1 = 8u << 20, WSO_STAT2 = 9u << 20;
constexpr size_t WSO_XB2 = 132ull << 20, WSO_XB1 = 164ull << 20, WSO_T1 = 196ull << 20, WSO_T2 = 260ull << 20, WSO_QB = 324ull << 20, WSO_KB = 340ull << 20, WSO_VB = 356ull << 20, WSO_PR = 372ull << 20, WSO_H = 580ull << 20;
constexpr size_t OO_SHP = 16809984, OO_KP = 21405696, OO_VP = 29794304;
__device__ __forceinline__ void row_stats(const float* stat, int row, float& mu, float& rs) {
    const f32x4 a = *(const f32x4*)(stat + (size_t)row * 8), b = *(const f32x4*)(stat + (size_t)row * 8 + 4);
    const float s = (a[0] + a[2]) + (b[0] + b[2]), q = (a[1] + a[3]) + (b[1] + b[3]);
    mu = s * (1.f / 1024.f); const float var = fmaxf(q * (1.f / 1024.f) - mu * mu, 0.f); rs = 1.0f / sqrtf(var + 1e-5f);
}
typedef float f32x2e __attribute__((ext_vector_type(2)));
typedef unsigned u32x2e __attribute__((ext_vector_type(2)));
constexpr int ETAB_OFF = 132096, ETAB_SLOT = 4096;
constexpr int ETAB_IDS = ETAB_OFF + 4 * ETAB_SLOT;
template <class Sched> __device__ __forceinline__ void etab_fill(PG8_LAS unsigned char* lds0, const Sched& S, const float* stat, const float* c1, const float* c2, bool fold, int tid) {
#pragma unroll 1
    for (int i = 0; i < 4; ++i) { Unit u; const bool ok = S.next(i, u);
        if (tid == 0) { ((PG8_LAS int*)(lds0 + ETAB_IDS))[2 * i] = ok ? u.pm : -1; ((PG8_LAS int*)(lds0 + ETAB_IDS))[2 * i + 1] = ok ? u.pn : -1; }
        if (!ok) continue;
        PG8_LAS unsigned char* slot = lds0 + ETAB_OFF + i * ETAB_SLOT;
        if (tid < 256) { float mu = 0.f, rs = 1.f; if (fold) row_stats(stat, u.pm * BM + tid, mu, rs); ((PG8_LAS f32x2e*)slot)[tid] = (f32x2e){mu, rs}; }
        else { const int c = u.pn * BM + tid - 256; ((PG8_LAS float*)(slot + 2048))[tid - 256] = fold ? c1[c] : 0.f; ((PG8_LAS float*)(slot + 3072))[tid - 256] = fold ? c2[c] : 0.f; }
    }
}
__device__ __forceinline__ const PG8_LAS unsigned char* etab_find(const PG8_LAS unsigned char* lds0, const Unit& u) {
    const PG8_LAS int* ids = (const PG8_LAS int*)(lds0 + ETAB_IDS); int s = 0;
#pragma unroll
    for (int i = 1; i < 4; ++i) if (ids[2 * i] == u.pm && ids[2 * i + 1] == u.pn) s = i;
    return lds0 + ETAB_OFF + s * ETAB_SLOT;
}
struct EpiIn {
    static constexpr bool PERM = true, AFTER_DRAIN = false;
    unsigned char* ws; float* out; int l; const PG8_LAS unsigned char* lds0;
    __device__ __forceinline__ void operator()(const f32x4 (&acc)[2][2][4][2], const Unit& u, int wr, int wc, int fr, int fq) const {
        asm volatile("" ::: "memory"); __builtin_amdgcn_sched_barrier(0);
        const PG8_LAS unsigned char* slot = etab_find(lds0, u);
        const PG8_LAS f32x2e* st = (const PG8_LAS f32x2e*)slot; const PG8_LAS float* tc1 = (const PG8_LAS float*)(slot + 2048); const PG8_LAS float* tc2 = (const PG8_LAS float*)(slot + 3072);
        bf16_t* QB = (bf16_t*)(ws + WSO_QB); bf16_t* KB = (bf16_t*)(ws + WSO_KB); bf16_t* VB = (bf16_t*)(ws + WSO_VB); bf16_t* PR = (bf16_t*)(ws + WSO_PR); const float* rope = (const float*)(ws + WSO_ROPE);
        float* outk = out + OO_KP + (size_t)l * 2 * 2048 * 512; float* outv = out + OO_VP + (size_t)l * 2 * 2048 * 512; const float qscale = 0.125f * 1.4426950408889634f;
        const int cb = u.pn * BM + wc * 32 + 8 * fq;
        const int i0 = 16 * (wc & 1) + 4 * fq; const bool roped = u.pn < 4;
        const int rbase = u.pm * BM + wr * 64 + fr;
        const int cl = wc * 32 + 8 * fq;
#pragma unroll
        for (int bj = 0; bj < 2; ++bj) {
            f32x4 c1v[2], c2v[2];
#pragma unroll
            for (int n = 0; n < 2; ++n) { c1v[n] = *(const PG8_LAS f32x4*)(tc1 + cl + bj * HALF + n * 4); c2v[n] = *(const PG8_LAS f32x4*)(tc2 + cl + bj * HALF + n * 4); }
            f32x4 ran = {0.f, 0.f, 0.f, 0.f}, rbn = ran;
#pragma unroll
            for (int gq = 0; gq < 8; ++gq) {
                const int ai = gq >> 2, m = gq & 3;
                const int r = rbase + ai * HALF + m * 16;
                const f32x2e ms = st[ai * HALF + wr * 64 + m * 16 + fr]; const float mu = ms.x, rs = ms.y;
                if (gq == 0 && roped) { const float* rp = rope + ((size_t)(r & 8191) * 32 + i0) * 2; ran = *(const f32x4*)rp; rbn = *(const f32x4*)(rp + 4); }
                const f32x4 ra = ran, rb = rbn;
                if (roped && gq < 7) { const int rn = rbase + ((gq + 1) >> 2) * HALF + ((gq + 1) & 3) * 16; const float* rp = rope + ((size_t)(rn & 8191) * 32 + i0) * 2; ran = *(const f32x4*)rp; rbn = *(const f32x4*)(rp + 4); }
                asm volatile("" ::: "memory");
                f32x4 v[2];
#pragma unroll
                for (int n = 0; n < 2; ++n) v[n] = (acc[ai][bj][m][n] - mu * c1v[n]) * rs + c2v[n];
                const int pos = r & 8191, b = r >> 13;
                if (roped) {
                    const f32x4 cs = {ra[0], ra[2], rb[0], rb[2]}, sn = {ra[1], ra[3], rb[1], rb[3]};
                    const int head = (u.pn & 1) * 4 + bj * 2 + (wc >> 1);
                    f32x4 y1 = v[0] * cs - v[1] * sn, y2 = v[0] * sn + v[1] * cs;
                    const size_t o = (size_t)r * 512 + head * 64 + i0;
                    if (u.pn < 2) { y1 = y1 * qscale; y2 = y2 * qscale;
                        u32x2e w; w.x = cvt_pk_bf16(y1[0], y1[1]); w.y = cvt_pk_bf16(y1[2], y1[3]); *(u32x2e*)(QB + o) = w;
                        w.x = cvt_pk_bf16(y2[0], y2[1]); w.y = cvt_pk_bf16(y2[2], y2[3]); *(u32x2e*)(QB + o + 32) = w;
                    } else {
                        u32x2e w; w.x = cvt_pk_bf16(y1[0], y1[1]); w.y = cvt_pk_bf16(y1[2], y1[3]); *(u32x2e*)(KB + o) = w;
                        w.x = cvt_pk_bf16(y2[0], y2[1]); w.y = cvt_pk_bf16(y2[2], y2[3]); *(u32x2e*)(KB + o + 32) = w;
                        if (pos >= 6144) { float* ok = outk + ((size_t)(b * 2048 + pos - 6144)) * 512 + head * 64 + i0; *(f32x4*)ok = y1; *(f32x4*)(ok + 32) = y2; }
                    }
                } else if (u.pn < 6) {
                    const int c = cb + bj * HALF - 1024;
                    u32x4 w; w.x = cvt_pk_bf16(v[0][0], v[0][1]); w.y = cvt_pk_bf16(v[0][2], v[0][3]); w.z = cvt_pk_bf16(v[1][0], v[1][1]); w.w = cvt_pk_bf16(v[1][2], v[1][3]); *(u32x4*)(VB + (size_t)r * 512 + c) = w;
                    if (pos >= 6144) { float* ov = outv + ((size_t)(b * 2048 + pos - 6144)) * 512 + c; *(f32x4*)ov = v[0]; *(f32x4*)(ov + 4) = v[1]; }
                } else {
                    const int c = cb + bj * HALF - 1536;
                    if (c < 1824) { u32x4 w; w.x = cvt_pk_bf16(v[0][0], v[0][1]); w.y = cvt_pk_bf16(v[0][2], v[0][3]); w.z = cvt_pk_bf16(v[1][0], v[1][1]); w.w = cvt_pk_bf16(v[1][2], v[1][3]); *(u32x4*)(PR + (size_t)r * 2048 + c) = w; }
                }
            }
        }
    }
};
template <bool IS_F> struct EpiRes {
    static constexpr bool PERM = true, AFTER_DRAIN = true;
    unsigned char* ws; const float* const* in; float* out; int l;
    __device__ __forceinline__ void fused(f32x4 (&acc)[2][2][4][2], const Unit& u, int wr, int wc, int fr, int fq, PG8_LAS unsigned char* lds, int wid, int lane) const {
        const int raw = (!IS_F && l == 0) ? 1 : 0;
        const bf16_t* src = (const bf16_t*)(ws + (IS_F ? WSO_XB1 : WSO_XB2));
        const float* sstat = (const float*)(ws + (IS_F ? WSO_STAT1 : WSO_STAT2));
        const float* g = IS_F ? in[24] + (size_t)l * 1024 : in[28] + (size_t)(l > 0 ? l - 1 : 0) * 1024; const float* b = IS_F ? in[25] + (size_t)l * 1024 : in[29] + (size_t)(l > 0 ? l - 1 : 0) * 1024;
        bf16_t* XB = (bf16_t*)(ws + (IS_F ? WSO_XB2 : WSO_XB1)); float* ostat = (float*)(ws + (IS_F ? WSO_STAT2 : WSO_STAT1));
        float* shiftout = (IS_F || raw) ? nullptr : out + OO_SHP + (size_t)l * 2 * 1024; const float alpha = 1.6817928305074290f;
        PG8_LAS f32x2e* P = (PG8_LAS f32x2e*)lds;
        const int cb = u.pn * BM + wc * 32 + 8 * fq;
        const int rbase = u.pm * BM + wr * 64 + fr;
        u32x4 cur[2], nxt[2]; f32x4 sa = {0.f, 0.f, 0.f, 0.f}, sb = sa, san = sa, sbn = sa;
#pragma unroll
        for (int bj = 0; bj < 2; ++bj) { cur[bj] = *(const u32x4*)(src + (size_t)rbase * 1024 + cb + bj * HALF); nxt[bj] = cur[bj]; }
        if (!raw) { sa = *(const f32x4*)(sstat + (size_t)rbase * 8); sb = *(const f32x4*)(sstat + (size_t)rbase * 8 + 4); }
#pragma unroll
        for (int gq = 0; gq < 8; ++gq) {
            const int ai = gq >> 2, m = gq & 3;
            const int r = rbase + ai * HALF + m * 16;
            if (gq < 7) { const int rn = rbase + ((gq + 1) >> 2) * HALF + ((gq + 1) & 3) * 16;
#pragma unroll
                for (int bj = 0; bj < 2; ++bj) nxt[bj] = *(const u32x4*)(src + (size_t)rn * 1024 + cb + bj * HALF);
                if (!raw) { san = *(const f32x4*)(sstat + (size_t)rn * 8); sbn = *(const f32x4*)(sstat + (size_t)rn * 8 + 4); } }
            asm volatile("" ::: "memory");
            float mu = 0.f, rs = 1.f;
            if (!raw) { const float ssum = (sa[0] + sa[2]) + (sb[0] + sb[2]), qsum = (sa[1] + sa[3]) + (sb[1] + sb[3]); mu = ssum * (1.f / 1024.f); rs = 1.0f / sqrtf(fmaxf(qsum * (1.f / 1024.f) - mu * mu, 0.f) + 1e-5f); }
            float s = 0.f, q = 0.f;
#pragma unroll
            for (int bj = 0; bj < 2; ++bj) { const int c = cb + bj * HALF; const size_t off = (size_t)r * 1024 + c; const u32x4 cw = cur[bj]; u32x4 wout;
#pragma unroll
                for (int n = 0; n < 2; ++n) {
                    const f32x4 gvv = raw ? (f32x4){1.f, 1.f, 1.f, 1.f} : *(const f32x4*)(g + c + 4 * n), bvv = raw ? (f32x4){0.f, 0.f, 0.f, 0.f} : *(const f32x4*)(b + c + 4 * n);
                    const unsigned w0 = n ? cw.z : cw.x, w1 = n ? cw.w : cw.y;
                    const f32x4 cf = {__builtin_bit_cast(float, w0 << 16), __builtin_bit_cast(float, w0 & 0xffff0000u), __builtin_bit_cast(float, w1 << 16), __builtin_bit_cast(float, w1 & 0xffff0000u)};
                    const f32x4 x = (cf - mu) * rs * gvv + bvv;
                    const f32x4 t = x * alpha + acc[ai][bj][m][n];
                    const unsigned p0 = cvt_pk_bf16(t[0], t[1]), p1 = cvt_pk_bf16(t[2], t[3]); if (n) { wout.z = p0; wout.w = p1; } else { wout.x = p0; wout.y = p1; }
                    s += (t[0] + t[1]) + (t[2] + t[3]); q += (t[0] * t[0] + t[1] * t[1]) + (t[2] * t[2] + t[3] * t[3]);
                    if (shiftout && (r & 8191) == 8191) *(f32x4*)(shiftout + (size_t)(r >> 13) * 1024 + c + 4 * n) = x; }
                *(u32x4*)(XB + off) = wout; }
            s += __shfl_xor(s, 16); s += __shfl_xor(s, 32); q += __shfl_xor(q, 16); q += __shfl_xor(q, 32);
            if (fq == 0) P[(ai * HALF + wr * 64 + m * 16 + fr) * 4 + wc] = (f32x2e){s, q};
#pragma unroll
            for (int bj = 0; bj < 2; ++bj) cur[bj] = nxt[bj];
            sa = san; sb = sbn;
        }
        asm volatile("s_waitcnt lgkmcnt(0)" ::: "memory"); __builtin_amdgcn_s_barrier(); asm volatile("" ::: "memory");
        if (threadIdx.x < 256) { const int row = threadIdx.x; const f32x2e a = P[row * 4 + 0], b2 = P[row * 4 + 1], c = P[row * 4 + 2], d = P[row * 4 + 3];
            *(f32x2e*)(ostat + (size_t)(u.pm * BM + row) * 8 + u.pn * 2) = (f32x2e){(a.x + b2.x) + (c.x + d.x), (a.y + b2.y) + (c.y + d.y)}; }
        asm volatile("s_waitcnt lgkmcnt(0)" ::: "memory"); __builtin_amdgcn_s_barrier(); asm volatile("" ::: "memory");
    }
};
struct EpiUp {
    static constexpr bool PERM = true, AFTER_DRAIN = false;
    unsigned char* ws; const PG8_LAS unsigned char* lds0;
    __device__ __forceinline__ void operator()(const f32x4 (&acc)[2][2][4][2], const Unit& u, int wr, int wc, int fr, int fq) const {
        asm volatile("" ::: "memory"); __builtin_amdgcn_sched_barrier(0);
        bf16_t* H = (bf16_t*)(ws + WSO_H);
        const PG8_LAS unsigned char* slot = etab_find(lds0, u);
        const PG8_LAS f32x2e* st = (const PG8_LAS f32x2e*)slot; const PG8_LAS float* tc1 = (const PG8_LAS float*)(slot + 2048); const PG8_LAS float* tc2 = (const PG8_LAS float*)(slot + 3072);
        const int cb = u.pn * BM + wc * 32 + 8 * fq, cl = wc * 32 + 8 * fq;
#pragma unroll
        for (int bj = 0; bj < 2; ++bj) {
            f32x4 c1v[2], c2v[2];
#pragma unroll
            for (int n = 0; n < 2; ++n) { c1v[n] = *(const PG8_LAS f32x4*)(tc1 + cl + bj * HALF + 4 * n); c2v[n] = *(const PG8_LAS f32x4*)(tc2 + cl + bj * HALF + 4 * n); }
#pragma unroll
            for (int ai = 0; ai < 2; ++ai) {
#pragma unroll
                for (int m = 0; m < 4; ++m) {
                    const int rl = ai * HALF + wr * 64 + m * 16 + fr, r = u.pm * BM + rl;
                    const f32x2e ms = st[rl]; const float mu = ms.x, rs = ms.y;
                    f32x4 v0 = (acc[ai][bj][m][0] - mu * c1v[0]) * rs + c2v[0], v1 = (acc[ai][bj][m][1] - mu * c1v[1]) * rs + c2v[1];
#pragma unroll
                    for (int e = 0; e < 4; ++e) { const float a = fmaxf(v0[e], 0.f), b = fmaxf(v1[e], 0.f); v0[e] = a * a; v1[e] = b * b; }
                    u32x4 w; w.x = cvt_pk_bf16(v0[0], v0[1]); w.y = cvt_pk_bf16(v0[2], v0[3]); w.z = cvt_pk_bf16(v1[0], v1[1]); w.w = cvt_pk_bf16(v1[2], v1[3]);
                    *(u32x4*)(H + (size_t)r * 4096 + cb + bj * HALF) = w; }
            }
        }
    }
};
template <class Epi, class Sched, bool ALIGN_EPI = false, bool SP2 = false>
__device__ __forceinline__ void gemm_phase(PG8_LAS unsigned char* lds, const Gemm g, const Sched& S, const Epi& E, const int tid) {
    const int wid = __builtin_amdgcn_readfirstlane(tid >> 6), lane = tid & 63, wr = wid >> 2, wc = wid & 3, fr = lane & 15, fq = lane >> 4;
    const int K = g.K, nt = K / BK;
    unsigned voffA[2], voffB[2];
#pragma unroll
    for (int i = 0; i < 2; ++i) { int R, C; stage_rc(tid * 16 + i * 8192, R, C); const int Rb = Epi::PERM ? ((R & ~31) + perm32(R & 31)) : R;
        voffA[i] = (unsigned)(R * K + C) * 2u; voffB[i] = (unsigned)(Rb * K + C) * 2u; }
    const size_t kstep = (size_t)(BK * 2);
    const size_t hstep = (size_t)HALF * K * 2;
    const size_t tstep = 2 * hstep;
    const unsigned ldsw = (unsigned)wid * 1024u;
    const int aoff = lds_byte(wr * 64 + fr, fq * 8), boff = lds_byte(wc * 32 + fr, fq * 8);
#define PG8_SA(b, h) (((b) * 2 + (h)) * HTB)
#define PG8_SB(b, h) ((4 + (b) * 2 + (h)) * HTB)
#define PG8_STAGE(bufoff, gbase, voff) do { _Pragma("unroll") for (int _i = 0; _i < 2; ++_i) \
        __builtin_amdgcn_global_load_lds((const unsigned*)((const char*)(gbase) + (voff)[_i]), (PG8_LAS unsigned*)(lds + (bufoff) + ldsw + _i * 8192), 16, 0, 0); } while (0)
#define PG8_LDA(dst, b, h) do { _Pragma("unroll") for (int m = 0; m < 4; ++m) _Pragma("unroll") for (int k = 0; k < 2; ++k) dst[m][k] = *(const PG8_LAS bf16x8*)(lds + PG8_SA(b, h) + aoff + m * 2048 + k * 1024); } while (0)
#define PG8_LDB(dst, b, h) do { _Pragma("unroll") for (int n = 0; n < 2; ++n) _Pragma("unroll") for (int k = 0; k < 2; ++k) dst[n][k] = *(const PG8_LAS bf16x8*)(lds + PG8_SB(b, h) + boff + n * 2048 + k * 1024); } while (0)
#define PG8_MMA(ai, bj, At, Bt) do { __builtin_amdgcn_s_setprio(1); _Pragma("unroll") for (int m = 0; m < 4; ++m) _Pragma("unroll") for (int n = 0; n < 2; ++n) _Pragma("unroll") for (int k = 0; k < 2; ++k) \
        acc[ai][bj][m][n] = __builtin_amdgcn_mfma_f32_16x16x32_bf16(Bt[n][k], At[m][k], acc[ai][bj][m][n], 0, 0, 0); __builtin_amdgcn_s_setprio(0); } while (0)
#define PG8_WAIT_V(n) asm volatile("s_waitcnt vmcnt(" #n ")" ::: "memory")
#define PG8_WAIT_L(n) asm volatile("s_waitcnt lgkmcnt(" #n ")" ::: "memory")
#define PG8_BAR __builtin_amdgcn_s_barrier()
#define PG8_SCHED __builtin_amdgcn_sched_barrier(0)
    Unit cur, nxt; int ui = 0;
    if (!S.next(0, cur)) return;
    f32x4 acc[2][2][4][2];
#pragma unroll
    for (int a = 0; a < 2; ++a)
#pragma unroll
        for (int b = 0; b < 2; ++b)
#pragma unroll
            for (int m = 0; m < 4; ++m)
#pragma unroll
                for (int n = 0; n < 2; ++n) acc[a][b][m][n] = (f32x4){0.f, 0.f, 0.f, 0.f};
    bf16x8 At[4][2], B0[2][2], B1[2][2];
    const char* cA = (const char*)g.A + (size_t)cur.pm * tstep; const char* cB = (const char*)g.Bt + (size_t)cur.pn * tstep;
    S.a_ready(cur);
    if constexpr (SP2) {
        PG8_STAGE(PG8_SB(0, 0), cB, voffB); PG8_STAGE(PG8_SB(0, 1), cB + hstep, voffB); PG8_STAGE(PG8_SA(0, 0), cA, voffA); PG8_STAGE(PG8_SA(0, 1), cA + hstep, voffA);
        if (wr == 1) PG8_BAR;
        PG8_WAIT_V(2); PG8_BAR;
        PG8_STAGE(PG8_SB(1, 0), cB + kstep, voffB); PG8_STAGE(PG8_SA(1, 0), cA + kstep, voffA); PG8_STAGE(PG8_SB(1, 1), cB + hstep + kstep, voffB);
        PG8_WAIT_V(6); PG8_BAR;
    } else {
        PG8_STAGE(PG8_SB(0, 0), cB, voffB); PG8_STAGE(PG8_SA(0, 0), cA, voffA); PG8_STAGE(PG8_SB(0, 1), cB + hstep, voffB); PG8_STAGE(PG8_SA(0, 1), cA + hstep, voffA);
        if (wr == 1) PG8_BAR;
        PG8_WAIT_V(4); PG8_BAR;
        PG8_STAGE(PG8_SB(1, 0), cB + kstep, voffB); PG8_STAGE(PG8_SA(1, 0), cA + kstep, voffA); PG8_STAGE(PG8_SB(1, 1), cB + hstep + kstep, voffB);
        PG8_WAIT_V(6); PG8_BAR;
    }
    for (;;) {
        const bool has_next = S.next(ui + 1, nxt);
        const char* nA = has_next ? (const char*)g.A + (size_t)nxt.pm * tstep : cA; const char* nB = has_next ? (const char*)g.Bt + (size_t)nxt.pn * tstep : cB;
        for (int t = 0; t < nt; t += 2) {
            const bool last = (t == nt - 2);
            const char* a1 = cA + (size_t)(t + 1) * kstep;
            const char* a2 = last ? nA : cA + (size_t)(t + 2) * kstep; const char* b2 = last ? nB : cB + (size_t)(t + 2) * kstep;
            const char* a3 = a2 + kstep; const char* b3 = b2 + kstep;
            if (last && has_next) S.a_ready(nxt);
            if constexpr (SP2) {
            PG8_LDB(B0, 0, 0); PG8_LDB(B1, 0, 1); PG8_SCHED; PG8_LDA(At, 0, 0); PG8_STAGE(PG8_SA(1, 1), a1 + hstep, voffA);
            PG8_WAIT_V(8); PG8_WAIT_L(0); PG8_BAR; PG8_MMA(0, 0, At, B0); PG8_MMA(0, 1, At, B1); PG8_BAR; PG8_SCHED;
            PG8_LDA(At, 0, 1); PG8_STAGE(PG8_SB(0, 0), b2, voffB); PG8_STAGE(PG8_SB(0, 1), b2 + hstep, voffB); PG8_STAGE(PG8_SA(0, 0), a2, voffA);
            PG8_WAIT_V(8); PG8_WAIT_L(0); PG8_BAR; PG8_MMA(1, 0, At, B0); PG8_MMA(1, 1, At, B1); PG8_BAR; PG8_SCHED;
            PG8_LDB(B0, 1, 0); PG8_LDB(B1, 1, 1); PG8_SCHED; PG8_LDA(At, 1, 0); PG8_STAGE(PG8_SA(0, 1), a2 + hstep, voffA);
            PG8_WAIT_V(8); PG8_WAIT_L(0); PG8_BAR; PG8_MMA(0, 0, At, B0); PG8_MMA(0, 1, At, B1); PG8_BAR; PG8_SCHED;
            PG8_LDA(At, 1, 1); PG8_STAGE(PG8_SB(1, 0), b3, voffB); PG8_STAGE(PG8_SB(1, 1), b3 + hstep, voffB); PG8_STAGE(PG8_SA(1, 0), a3, voffA);
            PG8_WAIT_V(8); PG8_WAIT_L(0); PG8_BAR; PG8_MMA(1, 0, At, B0); PG8_MMA(1, 1, At, B1); PG8_BAR; PG8_SCHED;
            } else {
            PG8_LDB(B0, 0, 0); PG8_SCHED; PG8_LDA(At, 0, 0); PG8_STAGE(PG8_SA(1, 1), a1 + hstep, voffA);
            PG8_WAIT_L(8); PG8_BAR; PG8_WAIT_L(0); PG8_MMA(0, 0, At, B0); PG8_BAR; PG8_SCHED;
            PG8_LDB(B1, 0, 1); PG8_STAGE(PG8_SB(0, 0), b2, voffB);
            PG8_BAR; PG8_WAIT_L(0); PG8_MMA(0, 1, At, B1); PG8_BAR;
            PG8_LDA(At, 0, 1); PG8_STAGE(PG8_SA(0, 0), a2, voffA);
            PG8_BAR; PG8_WAIT_L(0); PG8_MMA(1, 0, At, B0); PG8_BAR; PG8_SCHED;
            PG8_STAGE(PG8_SB(0, 1), b2 + hstep, voffB);
            PG8_WAIT_V(6); PG8_BAR; PG8_MMA(1, 1, At, B1); PG8_BAR;
            PG8_LDB(B0, 1, 0); PG8_SCHED; PG8_LDA(At, 1, 0); PG8_STAGE(PG8_SA(0, 1), a2 + hstep, voffA);
            PG8_WAIT_L(8); PG8_BAR; PG8_WAIT_L(0); PG8_MMA(0, 0, At, B0); PG8_BAR; PG8_SCHED;
            PG8_LDB(B1, 1, 1); PG8_STAGE(PG8_SB(1, 0), b3, voffB);
            PG8_BAR; PG8_WAIT_L(0); PG8_MMA(0, 1, At, B1); PG8_BAR;
            PG8_LDA(At, 1, 1); PG8_STAGE(PG8_SA(1, 0), a3, voffA);
            PG8_BAR; PG8_WAIT_L(0); PG8_MMA(1, 0, At, B0); PG8_BAR; PG8_SCHED;
            PG8_STAGE(PG8_SB(1, 1), b3 + hstep, voffB);
            PG8_WAIT_V(6); PG8_BAR; PG8_MMA(1, 1, At, B1); PG8_BAR;
            }
        }
        if constexpr (ALIGN_EPI) { if (wr == 0) PG8_BAR; }
        if constexpr (!Epi::AFTER_DRAIN) { E(acc, cur, wr, wc, fr, fq); S.done(cur); }
        if (!has_next) break;
#pragma unroll
        for (int a = 0; a < 2; ++a)
#pragma unroll
            for (int b = 0; b < 2; ++b)
#pragma unroll
                for (int m = 0; m < 4; ++m)
#pragma unroll
                    for (int n = 0; n < 2; ++n) acc[a][b][m][n] = (f32x4){0.f, 0.f, 0.f, 0.f};
        cur = nxt; cA = nA; cB = nB; ++ui;
        if constexpr (ALIGN_EPI) { if (wr == 1) PG8_BAR; }
    }
    PG8_WAIT_V(0);
    if constexpr (!ALIGN_EPI) { if (wr == 0) PG8_BAR; }
    PG8_BAR;
    if constexpr (Epi::AFTER_DRAIN) { E.fused(acc, cur, wr, wc, fr, fq, lds, wid, lane); S.done(cur); }
#undef PG8_SA
#undef PG8_SB
#undef PG8_STAGE
#undef PG8_LDA
#undef PG8_LDB
#undef PG8_MMA
#undef PG8_WAIT_V
#undef PG8_WAIT_L
#undef PG8_BAR
#undef PG8_SCHED
}
}
constexpr int NWAVES = 8;
constexpr int M = 16384, TSEQ = 8192, DM = 1024, FFD = 4096, DEPTH = 4, MD = 32, NH = 8, HD = 64;
constexpr int NIN = 3584;
constexpr int RW0 = 1536;
constexpr int PRP = 2048;
constexpr int NRWU = 1856;
constexpr int CH = 16, NCH = TSEQ / CH;
constexpr int NUNIT = 2 * NH * NCH;
constexpr float LN_EPS = 1e-5f, GN_EPS = 64e-5f, RMS_EPS = 1e-6f;
constexpr float ALPHA = 1.6817928305074290f;
constexpr float QSCALE = 0.125f * 1.4426950408889634f;
constexpr size_t O_Y = 0, O_YS = 16777216, O_SHP = 16809984, O_SHS = 16818176, O_WKP = 16949248, O_WKS = 17211392,
                 O_KP = 21405696, O_VP = 29794304, O_KS = 38182912, O_VS = 38248448, O_END = 38313984;
constexpr size_t MiB = 1u << 20;
constexpr size_t WS_CTL = 0, CTL_ZERO_BYTES = 1 * MiB;
constexpr size_t WS_C1IN = 1 * MiB;
constexpr size_t WS_C2IN = WS_C1IN + 4 * NIN * 4;
constexpr size_t WS_C1UP = WS_C2IN + 4 * NIN * 4;
constexpr size_t WS_C2UP = WS_C1UP + 4 * FFD * 4;
constexpr size_t WS_DUPT = WS_C2UP + 4 * FFD * 4;
constexpr size_t WS_IUPT = WS_DUPT + 4 * 512 * 64 * 2;
constexpr size_t WS_GUPT = WS_IUPT + 4 * 512 * 64 * 2;
constexpr size_t WS_VUPT = WS_GUPT + 4 * 512 * 128 * 2;
constexpr size_t WS_SMALL_END = WS_VUPT + 3 * 512 * 32 * 2;
static_assert(WS_SMALL_END <= 3 * MiB, "small region");
constexpr size_t WS_ROPE = 3 * MiB;
constexpr size_t WS_DEC = 6 * MiB;
constexpr size_t WS_STAT1 = 8 * MiB, WS_STAT2 = 9 * MiB;
constexpr size_t WS_BON = 10 * MiB;
constexpr size_t WS_LSE = 11 * MiB;
constexpr size_t WS_GC = 13 * MiB;
constexpr size_t WS_WIN = 16 * MiB;
constexpr size_t WS_WINU = 44 * MiB;
constexpr size_t WS_WOUT = 60 * MiB;
constexpr size_t WS_WUP = 68 * MiB;
constexpr size_t WS_WDN = 100 * MiB;
constexpr size_t WS_XB2 = 132 * MiB;
constexpr size_t WS_XB1 = 164 * MiB;
constexpr size_t WS_T1 = 196 * MiB;
constexpr size_t WS_T2 = 260 * MiB;
constexpr size_t WS_QB = 324 * MiB, WS_KB = 340 * MiB, WS_VB = 356 * MiB;
constexpr size_t WS_PR = 372 * MiB;
constexpr size_t WS_OP = 436 * MiB;
constexpr size_t WS_MIX = 484 * MiB;
constexpr size_t WS_VF = 516 * MiB, WS_VV = 532 * MiB;
constexpr size_t WS_YPRE = 548 * MiB;
constexpr size_t WS_H = 580 * MiB;
constexpr size_t WS_PT = 580 * MiB;
constexpr size_t WS_QT = 644 * MiB;
constexpr size_t WS_REFF = 708 * MiB;
constexpr size_t WS_YLOC = 724 * MiB;
constexpr size_t WS_SEGQ = 756 * MiB, WS_SEGP = 760 * MiB;
constexpr size_t WS_CSUM = 764 * MiB;
constexpr size_t WS_CSUP = 766 * MiB;
constexpr size_t WS_END = 768 * MiB;
static_assert(WS_H + (size_t)M * FFD * 2 <= WS_END + 0 * MiB || true, "");
constexpr size_t DEC_XB2 = 0;
constexpr size_t DEC_XB1 = 64 * 1024;
constexpr size_t DEC_SHB = 128 * 1024;
constexpr size_t DEC_MIXB = 384 * 1024;
constexpr size_t DEC_HB = 448 * 1024;
constexpr size_t DEC_T1 = 704 * 1024;
constexpr size_t DEC_T2 = 832 * 1024;
constexpr size_t DEC_PD = 960 * 1024;
constexpr size_t DEC_PS = 1408 * 1024;
constexpr size_t DEC_OP = 1640 * 1024;
constexpr size_t DEC_LSE = 1832 * 1024;
constexpr size_t DEC_MIX = 1836 * 1024;
constexpr size_t DEC_ST1 = 1964 * 1024;
constexpr size_t DEC_ST2 = 1972 * 1024;
constexpr size_t DEC_VF = 1980 * 1024;
static_assert(DEC_VF + 32 * 512 * 4 <= 2 * MiB, "decode scratch");
constexpr int CW_BAR = 4096;
constexpr int RING_BYTES = 131072;
constexpr int MISC_OFF = RING_BYTES + 320;
constexpr int LDS_BYTES = 163840;
static_assert(pg8::WSO_C1IN == WS_C1IN && pg8::WSO_C2IN == WS_C2IN && pg8::WSO_C1UP == WS_C1UP && pg8::WSO_C2UP == WS_C2UP && pg8::WSO_ROPE == WS_ROPE && pg8::WSO_STAT1 == WS_STAT1 && pg8::WSO_STAT2 == WS_STAT2 &&
              pg8::WSO_XB2 == WS_XB2 && pg8::WSO_XB1 == WS_XB1 && pg8::WSO_T1 == WS_T1 && pg8::WSO_T2 == WS_T2 && pg8::WSO_QB == WS_QB && pg8::WSO_KB == WS_KB && pg8::WSO_VB == WS_VB && pg8::WSO_PR == WS_PR && pg8::WSO_H == WS_H &&
              pg8::OO_SHP == O_SHP && pg8::OO_KP == O_KP && pg8::OO_VP == O_VP, "epilogue offset mirrors");
#define GAS __attribute__((address_space(1)))
#define LAS __attribute__((address_space(3)))
typedef unsigned short bf16;
typedef unsigned v4u __attribute__((ext_vector_type(4)));
typedef unsigned v2u __attribute__((ext_vector_type(2)));
typedef float f32x4 __attribute__((ext_vector_type(4)));
typedef float f32x2 __attribute__((ext_vector_type(2)));
typedef float f32x16 __attribute__((ext_vector_type(16)));
typedef short bf16x8 __attribute__((ext_vector_type(8)));
typedef short s16x4 __attribute__((ext_vector_type(4)));
typedef GAS unsigned gu32;
#define RLX_AGENT __ATOMIC_RELAXED, __HIP_MEMORY_SCOPE_AGENT
#define LDS_WAIT() asm volatile("s_waitcnt lgkmcnt(0)" ::: "memory")
#define VM_WAIT() asm volatile("s_waitcnt vmcnt(0)" ::: "memory")
#define DI __device__ __forceinline__
DI unsigned f2bf(float f) { unsigned u = __builtin_bit_cast(unsigned, f); return (u + 0x7fffu + ((u >> 16) & 1u)) >> 16; }
DI float bf2f(unsigned b) { return __builtin_bit_cast(float, b << 16); }
DI float bflo(unsigned w) { return __builtin_bit_cast(float, w << 16); }
DI float bfhi(unsigned w) { return __builtin_bit_cast(float, w & 0xffff0000u); }
typedef __bf16 bf16x2_t __attribute__((ext_vector_type(2)));
DI unsigned pk2(float lo, float hi) { const f32x2 v = {lo, hi}; const bf16x2_t b = __builtin_convertvector(v, bf16x2_t); return __builtin_bit_cast(unsigned, b); }
DI unsigned pk2z(float x) { return pk2(x, 0.f) & 0xffffu; }
DI float rbf(float x) { return bf2f(f2bf(x)); }
DI bf16x8 pk8(float a0, float a1, float a2, float a3, float a4, float a5, float a6, float a7) {
    v4u w; w.x = pk2(a0, a1); w.y = pk2(a2, a3); w.z = pk2(a4, a5); w.w = pk2(a6, a7); return __builtin_bit_cast(bf16x8, w); }
DI bf16x8 pk8v(f32x4 a, f32x4 b) { return pk8(a[0], a[1], a[2], a[3], b[0], b[1], b[2], b[3]); }
DI bf16x8 pk4z(f32x4 a) { v4u w; w.x = pk2(a[0], a[1]); w.y = pk2(a[2], a[3]); w.z = 0u; w.w = 0u; return __builtin_bit_cast(bf16x8, w); }
DI bf16x8 ld8(const void* p) { return *(const bf16x8*)p; }
DI bf16x8 ld8nt(const void* p) { return __builtin_nontemporal_load((const bf16x8*)p); }
DI v4u ldv4nt(const void* p) { return __builtin_nontemporal_load((const v4u*)p); }
DI f32x4 ldf4nt(const void* p) { return __builtin_nontemporal_load((const f32x4*)p); }
DI bf16x8 ld4z(const void* p) { v2u t = *(const v2u*)p; v4u w; w.x = t.x; w.y = t.y; w.z = 0u; w.w = 0u; return __builtin_bit_cast(bf16x8, w); }
DI f32x4 mfma16(bf16x8 a, bf16x8 b, f32x4 c) { return __builtin_amdgcn_mfma_f32_16x16x32_bf16(a, b, c, 0, 0, 0); }
DI f32x16 mfma32(bf16x8 a, bf16x8 b, f32x16 c) { return __builtin_amdgcn_mfma_f32_32x32x16_bf16(a, b, c, 0, 0, 0); }
DI int crow(int r, int hi) { return (r & 3) + 8 * (r >> 2) + 4 * hi; }
DI float wave_sum(float v) {
#pragma unroll
    for (int o = 1; o < 64; o <<= 1) v += __shfl_xor(v, o);
    return v; }
DI float fexp(float x) { return __expf(x); }
DI float fsigmoid(float x) { return __builtin_amdgcn_rcpf(1.f + __expf(-x)); }
DI float ftanh(float x) { return 1.f - 2.f * __builtin_amdgcn_rcpf(__expf(2.f * x) + 1.f); }
DI float fsoftplus(float x) { return fmaxf(x, 0.f) + __logf(1.f + __expf(-fabsf(x))); }
DI int orig2lgcl(int o) { return (o & ~63) | (((o >> 4) & 1) << 5) | (((o >> 2) & 3) << 3) | (((o >> 5) & 1) << 2) | (o & 3); }
DI int lgcl2orig(int c) { return (c & ~63) | (((c >> 2) & 1) << 5) | (((c >> 5) & 1) << 4) | (((c >> 3) & 3) << 2) | (c & 3); }
#define XB_TMO      128
#define XB_XCNT(j)  (256  + 64 * (j))
#define XB_XSUB(j)  (1280 + 64 * (j))
#define XB_XGEN(j)  (2304 + 64 * (j))
#define XB_TOP      3328
#define XB_TOPGEN   3392
#define XCD_BAR_WORDS 3456
#define XB_SPIN_CAP (1u << 18)

__device__ __forceinline__ unsigned xb_ld(unsigned* p)              { return __hip_atomic_load(p, __ATOMIC_RELAXED, __HIP_MEMORY_SCOPE_AGENT); }
__device__ __forceinline__ unsigned xb_add(unsigned* p, unsigned v) { return __hip_atomic_fetch_add(p, v, __ATOMIC_RELAXED, __HIP_MEMORY_SCOPE_AGENT); }
__device__ __forceinline__ unsigned xb_xcc_id() { return (unsigned)__builtin_amdgcn_s_getreg((3 << 11) | 20) & 0xFu; }
#define XB_SPIN(cond, bar) do { unsigned _sp = 0; while (cond) { __builtin_amdgcn_s_sleep(1); \
    if ((++_sp & 255u) == 0u) { if (xb_ld(&(bar)[XB_TMO])) break; if (_sp > XB_SPIN_CAP) { atomicAdd(&(bar)[XB_TMO], 1u); break; } } } } while (0)

struct XcdBarrier {
    unsigned* bar; unsigned x;
    volatile LAS unsigned* st;
};

__device__ __forceinline__ XcdBarrier xcd_barrier_post(unsigned* bar, volatile LAS unsigned* st) {
    XcdBarrier b; b.bar = bar; b.x = xb_xcc_id(); b.st = st;
    if (threadIdx.x == 0) (void)xb_add(&bar[XB_XCNT(b.x)], 1u);
    return b;
}
__device__ __forceinline__ void xcd_barrier_complete(unsigned* bar, unsigned x, unsigned& nloc, unsigned& nx) {
    const unsigned G = gridDim.x * gridDim.y * gridDim.z;
    unsigned sum, cnt, mine, sp = 0u;
    for (;;) {
        sum = 0u; cnt = 0u; mine = 0u;
#pragma unroll
        for (unsigned j = 0; j < 16; ++j) { const unsigned c = xb_ld(&bar[XB_XCNT(j)]); sum += c; cnt += (c > 0u) ? 1u : 0u; mine = (j == x) ? c : mine; }
        if (sum == G) break;
        __builtin_amdgcn_s_sleep(1);
        if ((++sp & 255u) == 0u) { if (xb_ld(&bar[XB_TMO])) break; if (sp > XB_SPIN_CAP) { atomicAdd(&bar[XB_TMO], 1u); break; } }
    }
    nloc = mine > 0u ? mine : 1u; nx = cnt > 0u ? cnt : 1u;
}

__device__ __forceinline__ void xcd_barrier(const XcdBarrier& b) {
    asm volatile("s_waitcnt vmcnt(0)" ::: "memory");
    __syncthreads();
    if (threadIdx.x == 0) {
        unsigned* bar = b.bar;
        __builtin_amdgcn_s_waitcnt(0);
        unsigned nloc = b.st[0], nx = b.st[1];
        if (nloc == 0u) { xcd_barrier_complete(bar, b.x, nloc, nx); b.st[0] = nloc; b.st[1] = nx; }
        const unsigned old = xb_add(&bar[XB_XSUB(b.x)], 1u);
        const unsigned gen = old / nloc;
        if (old + 1u == (gen + 1u) * nloc) {
            __builtin_amdgcn_fence(__ATOMIC_RELEASE, "agent");
            asm volatile("s_waitcnt vmcnt(0)" ::: "memory");
            const unsigned og = xb_add(&bar[XB_TOP], 1u);
            const unsigned tg = og / nx;
            if (og + 1u == (tg + 1u) * nx) xb_add(&bar[XB_TOPGEN], 1u);
            else XB_SPIN(xb_ld(&bar[XB_TOPGEN]) == tg, bar);
            __builtin_amdgcn_fence(__ATOMIC_ACQUIRE, "agent");
            xb_add(&bar[XB_XGEN(b.x)], 1u);
            asm volatile("s_waitcnt vmcnt(0)" ::: "memory");
        } else {
            XB_SPIN(xb_ld(&bar[XB_XGEN(b.x)]) == gen, bar);
            __builtin_amdgcn_fence(__ATOMIC_ACQUIRE, "agent");
            asm volatile("s_waitcnt vmcnt(0)" ::: "memory");
        }
    }
    __syncthreads();
}
struct Args { const float* in[30]; float* out; unsigned char* ws; };
struct Frame {
    unsigned char* lds;
    volatile LAS unsigned* MISC;
    gu32* ctl;
    int tid, lane, wave, vcu, G, gw, NGW;
    const float* const* in; float* out; unsigned char* ws;
};
template <bool SWAP>
DI void p0_transpose_item(const float* W, int ldw, int K, int csrc0, bf16* WT, int row_off, const float* gsc, LAS float* scr, int kb, int nb, int lane, float* csum = nullptr, int ncs = 0, const float* bsh = nullptr) {
    const int k0 = 64 * kb, n0 = 32 * nb;
    f32x4 wv[8]; float gk = 1.f, bk = 0.f;
    const int lr = lane >> 3, lc = (lane & 7) * 4;
#pragma unroll
    for (int i = 0; i < 8; ++i) wv[i] = ldf4nt(W + (size_t)(k0 + 8 * i + lr) * ldw + csrc0 + n0 + lc);
    if (gsc) gk = gsc[k0 + lane]; if (bsh) bk = bsh[k0 + lane];
    f32x4 s1v = {0.f, 0.f, 0.f, 0.f}, s2v = s1v;
#pragma unroll
    for (int i = 0; i < 8; ++i) { const int kk = 8 * i + lr; f32x4 v = wv[i]; s2v = s2v + v * __shfl(bk, kk); v = v * __shfl(gk, kk);
#pragma unroll
        for (int e = 0; e < 4; ++e) { s1v[e] += rbf(v[e]); scr[kk * 33 + lc + e] = v[e]; } }
#pragma unroll
    for (int o = 8; o < 64; o <<= 1) {
#pragma unroll
        for (int e = 0; e < 4; ++e) { s1v[e] += __shfl_xor(s1v[e], o); s2v[e] += __shfl_xor(s2v[e], o); } }
    if (csum && lane < 8) {
#pragma unroll
        for (int e = 0; e < 4; ++e) { int dr = n0 + 4 * lane + e; if (SWAP) dr = orig2lgcl(dr); csum[(size_t)(kb * 2 + 0) * ncs + row_off + dr] = s1v[e]; csum[(size_t)(kb * 2 + 1) * ncs + row_off + dr] = s2v[e]; } }
    LDS_WAIT(); asm volatile("" ::: "memory");
    const int c = lane & 7;
#pragma unroll
    for (int j = 0; j < 4; ++j) { const int n = (lane >> 3) + 8 * j; const LAS float* s = scr + (8 * c) * 33 + n;
        v4u o; o.x = pk2(s[0 * 33], s[1 * 33]); o.y = pk2(s[2 * 33], s[3 * 33]); o.z = pk2(s[4 * 33], s[5 * 33]); o.w = pk2(s[6 * 33], s[7 * 33]);
        int dr = n0 + n; if (SWAP) dr = orig2lgcl(dr);
        *(v4u*)(WT + (size_t)(row_off + dr) * K + k0 + 8 * c) = o; }
    LDS_WAIT(); asm volatile("" ::: "memory");
}
DI void p0_prologue(Frame& F) {
    LAS float* scr = (LAS float*)((LAS unsigned char*)F.lds + F.wave * 16384);
    const float* const* in = F.in; unsigned char* ws = F.ws;
    constexpr int I_IN = 16 * 104, I_VR = 16, I_INU = 16 * 56, I_OUT = 16 * 32, I_UP = 16 * 128, I_DN = 64 * 32;
    constexpr int I_L = I_IN + I_VR + I_INU + I_VR + I_OUT + I_UP + I_DN;
    for (int it = F.gw; it < DEPTH * I_L; it += F.NGW) {
        const int l = it / I_L; int r = it % I_L;
        const float* g2p = l > 0 ? in[28] + (size_t)(l - 1) * DM : nullptr;
        bf16* win = (bf16*)(ws + WS_WIN) + (size_t)l * NIN * DM; bf16* winu = (bf16*)(ws + WS_WINU) + (size_t)l * NRWU * DM;
        if (r < I_IN) { const int kb = r / 104, nb = r % 104; const float* W = in[6] + (size_t)l * DM * 3328;
            float* cs = l > 0 ? (float*)(ws + WS_CSUM) + (size_t)l * 32 * NIN : nullptr; const float* b2p = l > 0 ? in[29] + (size_t)(l - 1) * DM : nullptr;
            if (nb < 32) p0_transpose_item<true>(W, 3328, DM, 0, win, 0, g2p, scr, kb, nb, F.lane, cs, NIN, b2p); else p0_transpose_item<false>(W, 3328, DM, 0, win, 0, g2p, scr, kb, nb, F.lane, cs, NIN, b2p); continue; } r -= I_IN;
        if (r < I_VR) { if (l > 0) p0_transpose_item<false>(in[7] + (size_t)(l - 1) * DM * 32, 32, DM, 0, win, 3328, g2p, scr, r, 0, F.lane, (float*)(ws + WS_CSUM) + (size_t)l * 32 * NIN, NIN, in[29] + (size_t)(l - 1) * DM); continue; } r -= I_VR;
        if (r < I_INU) { const int kb = r / 56, nb = r % 56; p0_transpose_item<false>(in[6] + (size_t)l * DM * 3328, 3328, DM, RW0, winu, 0, nullptr, scr, kb, nb, F.lane); continue; } r -= I_INU;
        if (r < I_VR) { if (l > 0) p0_transpose_item<false>(in[7] + (size_t)(l - 1) * DM * 32, 32, DM, 0, winu, 1792, nullptr, scr, r, 0, F.lane); continue; } r -= I_VR;
        if (r < I_OUT) { p0_transpose_item<false>(in[23] + (size_t)l * DM * DM, DM, DM, 0, (bf16*)(ws + WS_WOUT) + (size_t)l * DM * DM, 0, nullptr, scr, r / 32, r % 32, F.lane); continue; } r -= I_OUT;
        if (r < I_UP) { p0_transpose_item<false>(in[26] + (size_t)l * DM * FFD, FFD, DM, 0, (bf16*)(ws + WS_WUP) + (size_t)l * FFD * DM, 0, in[24] + (size_t)l * DM, scr, r / 128, r % 128, F.lane, (float*)(ws + WS_CSUP) + (size_t)l * 32 * FFD, FFD, in[25] + (size_t)l * DM); continue; } r -= I_UP;
        p0_transpose_item<false>(in[27] + (size_t)l * FFD * DM, DM, FFD, 0, (bf16*)(ws + WS_WDN) + (size_t)l * DM * FFD, 0, nullptr, scr, r / 32, r % 32, F.lane);
    }
    for (int m0 = F.gw; m0 < M; m0 += 4 * F.NGW) { f32x4 v[4][4];
#pragma unroll
        for (int q = 0; q < 4; ++q) { const f32x4* xr = (const f32x4*)(in[0] + (size_t)(m0 + q * F.NGW) * DM) + F.lane;
#pragma unroll
            for (int j = 0; j < 4; ++j) v[q][j] = ldf4nt(xr + 64 * j); }
#pragma unroll
        for (int q = 0; q < 4; ++q) { unsigned long long* o8 = (unsigned long long*)((bf16*)(ws + WS_XB2) + (size_t)(m0 + q * F.NGW) * DM) + F.lane;
#pragma unroll
            for (int j = 0; j < 4; ++j) o8[64 * j] = (unsigned long long)pk2(v[q][j].x, v[q][j].y) | ((unsigned long long)pk2(v[q][j].z, v[q][j].w) << 32); } }
    const int gt = F.gw * 64 + F.lane, NGT = F.NGW * 64;
    for (int e = gt; e < 8193 * 32; e += NGT) { const int pos = e >> 5, i = e & 31; const double ang = (double)pos * pow(10000.0, -(double)i / 32.0); ((f32x2*)(ws + WS_ROPE))[e] = (f32x2){(float)cos(ang), (float)sin(ang)}; }
    for (int e = gt; e < 4 * 512 * 64; e += NGT) { const int l = e / (512 * 64), n = (e / 64) % 512, m = e % 64; ((bf16*)(ws + WS_DUPT))[e] = (bf16)f2bf(in[11][((size_t)l * 64 + m) * 512 + n]); ((bf16*)(ws + WS_IUPT))[e] = (bf16)f2bf(in[13][((size_t)l * 64 + m) * 512 + n]); }
    for (int e = gt; e < 4 * 512 * 128; e += NGT) { const int l = e / (512 * 128), n = (e / 128) % 512, m = e % 128; ((bf16*)(ws + WS_GUPT))[e] = (bf16)f2bf(in[14][((size_t)l * 128 + m) * 512 + n]); }
    for (int e = gt; e < 3 * 512 * 32; e += NGT) { const int l = e / (512 * 32), n = (e / 32) % 512, m = e % 32; ((bf16*)(ws + WS_VUPT))[e] = (bf16)f2bf(in[16][((size_t)l * 32 + m) * 512 + n]); }
    for (int e = gt; e < 2 * DM; e += NGT) F.out[O_SHP + e] = in[0][((size_t)(e / DM) * TSEQ + TSEQ - 1) * DM + (e % DM)];
    for (int e = gt; e < MD * DM; e += NGT) { ((bf16*)(ws + WS_DEC + DEC_XB2))[e] = (bf16)f2bf(in[1][e]); }
    for (int e = gt; e < DEPTH * MD * DM; e += NGT) { ((bf16*)(ws + WS_DEC + DEC_SHB))[e] = (bf16)f2bf(in[2][e]); }
}
DI void colsum_finish(unsigned char* ws, int gt, int NGT) {
    for (int e = gt; e < 3 * NIN; e += NGT) { const int l = 1 + e / NIN, p = e % NIN; if (p >= 3360) continue; const float* cs = (const float*)(ws + WS_CSUM) + (size_t)l * 32 * NIN + p; float s1 = 0.f, s2 = 0.f;
#pragma unroll
        for (int kb = 0; kb < 16; ++kb) { s1 += cs[(size_t)(2 * kb) * NIN]; s2 += cs[(size_t)(2 * kb + 1) * NIN]; }
        ((float*)(ws + WS_C1IN))[l * NIN + p] = s1; ((float*)(ws + WS_C2IN))[l * NIN + p] = s2; }
    for (int e = gt; e < 4 * FFD; e += NGT) { const int l = e / FFD, p = e % FFD; const float* cs = (const float*)(ws + WS_CSUP) + (size_t)l * 32 * FFD + p; float s1 = 0.f, s2 = 0.f;
#pragma unroll
        for (int kb = 0; kb < 16; ++kb) { s1 += cs[(size_t)(2 * kb) * FFD]; s2 += cs[(size_t)(2 * kb + 1) * FFD]; }
        ((float*)(ws + WS_C1UP))[l * FFD + p] = s1; ((float*)(ws + WS_C2UP))[l * FFD + p] = s2; }
}
constexpr int VPITCH = 144;
constexpr int ATT_WLDS = 2 * 32 * VPITCH + 256;
DI void tr_read8(unsigned base, s16x4 (&t)[8]) {
    asm volatile("ds_read_b64_tr_b16 %0, %8\n\tds_read_b64_tr_b16 %1, %8 offset:%c9\n\tds_read_b64_tr_b16 %2, %8 offset:%c10\n\tds_read_b64_tr_b16 %3, %8 offset:%c11\n\t"
                 "ds_read_b64_tr_b16 %4, %8 offset:%c12\n\tds_read_b64_tr_b16 %5, %8 offset:%c13\n\tds_read_b64_tr_b16 %6, %8 offset:%c14\n\tds_read_b64_tr_b16 %7, %8 offset:%c15\n\ts_waitcnt lgkmcnt(0)"
                 : "=&v"(t[0]), "=&v"(t[1]), "=&v"(t[2]), "=&v"(t[3]), "=&v"(t[4]), "=&v"(t[5]), "=&v"(t[6]), "=&v"(t[7])
                 : "v"(base), "i"(8 * VPITCH), "i"(64), "i"(8 * VPITCH + 64), "i"(16 * VPITCH), "i"(24 * VPITCH), "i"(16 * VPITCH + 64), "i"(24 * VPITCH + 64) : "memory");
}
DI void attn_task(const bf16* QB, const bf16* KB, const bf16* VB, bf16* OP, float* LSE, int b, int h, int p, int cls, int qblk, LAS unsigned char* wl, int lane) {
    asm volatile("" : "+v"(lane));
    const int dd = 1 << (2 * p), r32 = lane & 31, hi = lane >> 5;
    const int m0 = 32 * qblk;
    const size_t rowb = (size_t)b * TSEQ;
    const size_t qrow = rowb + (size_t)(m0 + r32) * dd + cls;
    bf16x8 qf[4];
#pragma unroll
    for (int d0 = 0; d0 < 4; ++d0) qf[d0] = ld8(QB + qrow * 512 + h * 64 + d0 * 16 + hi * 8);
    f32x16 s[5];
    const int kt0 = (m0 >= 128) ? 0 : (128 - m0) / 32;
    const int krow8 = lane >> 3, kch = lane & 7;
    v4u kr[5][4];
#pragma unroll
    for (int kt = 0; kt < 5; ++kt)
#pragma unroll
        for (int i_ = 0; i_ < 4; ++i_) { const int mk = m0 - 128 + 32 * kt + 8 * i_ + krow8; const size_t krow = rowb + (size_t)(mk < 0 ? 0 : mk) * dd + cls;
            kr[kt][i_] = *(const v4u*)(KB + krow * 512 + h * 64 + kch * 8); }
#pragma unroll
    for (int kt = 0; kt < 5; ++kt) {
        LAS unsigned char* kb = wl + (kt & 1) * 32 * VPITCH;
#pragma unroll
        for (int i_ = 0; i_ < 4; ++i_) *(LAS v4u*)(kb + (8 * i_ + krow8) * VPITCH + kch * 16) = kr[kt][i_];
        LDS_WAIT();
        bf16x8 kf[4];
#pragma unroll
        for (int d0 = 0; d0 < 4; ++d0) kf[d0] = *(const LAS bf16x8*)(kb + r32 * VPITCH + d0 * 32 + hi * 16);
        f32x16 a; for (int i = 0; i < 16; ++i) a[i] = 0.f;
#pragma unroll
        for (int d0 = 0; d0 < 4; ++d0) a = mfma32(kf[d0], qf[d0], a);
        s[kt] = a;
    }
    LDS_WAIT();
#pragma unroll
    for (int kt = 0; kt < 5; ++kt) {
        if (kt < kt0) {
#pragma unroll
            for (int i = 0; i < 16; ++i) s[kt][i] = -INFINITY;
        } else if (kt == 0) {
#pragma unroll
            for (int i = 0; i < 16; ++i) s[kt][i] = (crow(i, hi) >= r32) ? s[kt][i] : -INFINITY;
        } else if (kt == 4) {
#pragma unroll
            for (int i = 0; i < 16; ++i) s[kt][i] = (crow(i, hi) <= r32) ? s[kt][i] : -INFINITY;
        }
    }
    float mx = -INFINITY;
#pragma unroll
    for (int kt = 0; kt < 5; ++kt)
#pragma unroll
        for (int i = 0; i < 16; ++i) mx = fmaxf(mx, s[kt][i]);
    mx = fmaxf(mx, __shfl_xor(mx, 32));
    float lsum = 0.f;
#pragma unroll
    for (int kt = 0; kt < 5; ++kt)
#pragma unroll
        for (int i = 0; i < 16; ++i) { const float e = __builtin_amdgcn_exp2f(s[kt][i] - mx); s[kt][i] = e; lsum += e; }
    lsum += __shfl_xor(lsum, 32);
    f32x16 o[2]; for (int i = 0; i < 16; ++i) { o[0][i] = 0.f; o[1][i] = 0.f; }
    LAS float* wsf = (LAS float*)(wl + 2 * 32 * VPITCH);
    const unsigned vb0 = (unsigned)(uintptr_t)wl;
    const int g = lane >> 4, i16 = lane & 15, qq = i16 >> 2, pp = i16 & 3;
    const unsigned traddr = (unsigned)((4 * (g >> 1) + qq) * VPITCH + (16 * (g & 1) + 4 * pp) * 2);
    const int vrow8 = lane >> 3, vch = lane & 7;
    v4u vr[4];
#define ATT_LOADV(KT) do { _Pragma("unroll") for (int i_ = 0; i_ < 4; ++i_) { const int mk_ = m0 - 128 + 32 * (KT) + 8 * i_ + vrow8; const size_t vrow_ = rowb + (size_t)mk_ * dd + cls; \
        vr[i_] = *(const v4u*)(VB + vrow_ * 512 + h * 64 + vch * 8); } } while (0)
    ATT_LOADV(kt0);
#pragma unroll
    for (int kt = 0; kt < 5; ++kt) {
        if (kt >= kt0) {
            LAS unsigned char* vb = wl + (kt & 1) * 32 * VPITCH;
#pragma unroll
            for (int i_ = 0; i_ < 4; ++i_) *(LAS v4u*)(vb + (8 * i_ + vrow8) * VPITCH + vch * 16) = vr[i_];
            if (kt + 1 < 5) ATT_LOADV(kt + 1);
            LDS_WAIT();
            const unsigned base = vb0 + (unsigned)((kt & 1) * 32 * VPITCH) + traddr;
            s16x4 t[8];
            tr_read8(base, t);
#pragma unroll
            for (int ss = 0; ss < 2; ++ss) {
                const bf16x8 pa = pk8(s[kt][8 * ss], s[kt][8 * ss + 1], s[kt][8 * ss + 2], s[kt][8 * ss + 3], s[kt][8 * ss + 4], s[kt][8 * ss + 5], s[kt][8 * ss + 6], s[kt][8 * ss + 7]);
#pragma unroll
                for (int db = 0; db < 2; ++db) { const bf16x8 vf = __builtin_shufflevector(t[4 * ss + 2 * db], t[4 * ss + 2 * db + 1], 0, 1, 2, 3, 4, 5, 6, 7); o[db] = mfma32(pa, vf, o[db]); }
            }
        }
    }
#undef ATT_LOADV
    if (hi == 0) { wsf[r32] = __builtin_amdgcn_rcpf(lsum); LSE[((size_t)p * M + qrow) * 8 + h] = mx + __builtin_amdgcn_logf(lsum); }
    LDS_WAIT();
#pragma unroll
    for (int i = 0; i < 16; ++i) { const int q = crow(i, hi); const float li = wsf[q];
        *(LAS bf16*)(wl + q * VPITCH + r32 * 2) = (bf16)pk2z(o[0][i] * li); *(LAS bf16*)(wl + q * VPITCH + 64 + r32 * 2) = (bf16)pk2z(o[1][i] * li); }
    LDS_WAIT();
    { const int orow8 = lane >> 3, och = lane & 7;
#pragma unroll
      for (int i_ = 0; i_ < 4; ++i_) { const v4u w = *(const LAS v4u*)(wl + (8 * i_ + orow8) * VPITCH + och * 16); const size_t orow = rowb + (size_t)(m0 + 8 * i_ + orow8) * dd + cls;
          *(v4u*)(OP + ((size_t)p * M + orow) * 512 + h * 64 + och * 8) = w; } }
    LDS_WAIT();
}
DI void attn_finalize_row(const bf16* OP, const float* LSE, const float* gain, bf16* MIX, int row, int lane) {
    asm volatile("" : "+v"(lane));
    const int h = lane >> 3;
    float l0 = LSE[((size_t)0 * M + row) * 8 + h], l1 = LSE[((size_t)1 * M + row) * 8 + h], l2 = LSE[((size_t)2 * M + row) * 8 + h];
    const float mx = fmaxf(l0, fmaxf(l1, l2));
    float w0 = __builtin_amdgcn_exp2f(l0 - mx), w1 = __builtin_amdgcn_exp2f(l1 - mx), w2 = __builtin_amdgcn_exp2f(l2 - mx);
    const float inv = __builtin_amdgcn_rcpf(w0 + w1 + w2); w0 *= inv; w1 *= inv; w2 *= inv;
    const v4u a = *(const v4u*)(OP + ((size_t)0 * M + row) * 512 + lane * 8), b = *(const v4u*)(OP + ((size_t)1 * M + row) * 512 + lane * 8), c = *(const v4u*)(OP + ((size_t)2 * M + row) * 512 + lane * 8);
    float v[8]; float ss = 0.f;
#pragma unroll
    for (int j = 0; j < 4; ++j) { v[2 * j] = w0 * bflo(a[j]) + w1 * bflo(b[j]) + w2 * bflo(c[j]); v[2 * j + 1] = w0 * bfhi(a[j]) + w1 * bfhi(b[j]) + w2 * bfhi(c[j]); ss += v[2 * j] * v[2 * j] + v[2 * j + 1] * v[2 * j + 1]; }
    ss = wave_sum(ss);
    const float rinv = 1.0f / sqrtf(ss * (1.f / 512.f) + RMS_EPS);
    const f32x4 g0 = *(const f32x4*)(gain + lane * 8), g1 = *(const f32x4*)(gain + lane * 8 + 4);
    v4u w; w.x = pk2(v[0] * rinv * g0[0], v[1] * rinv * g0[1]); w.y = pk2(v[2] * rinv * g0[2], v[3] * rinv * g0[3]); w.z = pk2(v[4] * rinv * g1[0], v[5] * rinv * g1[1]); w.w = pk2(v[6] * rinv * g1[2], v[7] * rinv * g1[3]);
    *(v4u*)(MIX + (size_t)row * 1024 + lane * 8) = w;
}
constexpr int B1_IMG = 2048, B1_WLDS = 5 * B1_IMG + 1024;
constexpr int IMG_V = 0, IMG_A = 1 * B1_IMG, IMG_B = 2 * B1_IMG, IMG_W = 3 * B1_IMG, IMG_M = 4 * B1_IMG;
constexpr int TIL = 1 * B1_IMG, TIL_LP = 336, TIL_RP = 144, TIL_RSZ = 17 * TIL_RP;
static_assert(17 * TIL_LP <= 4 * B1_IMG && 3 * TIL_RSZ <= 4 * B1_IMG, "input tiles fit the image area");
DI float dpp_shr(float x, int n) { int v;
    switch (n) { case 1: v = __builtin_amdgcn_update_dpp(0, __builtin_bit_cast(int, x), 0x111, 0xf, 0xf, true); break; case 2: v = __builtin_amdgcn_update_dpp(0, __builtin_bit_cast(int, x), 0x112, 0xf, 0xf, true); break;
                 case 4: v = __builtin_amdgcn_update_dpp(0, __builtin_bit_cast(int, x), 0x114, 0xf, 0xf, true); break; default: v = __builtin_amdgcn_update_dpp(0, __builtin_bit_cast(int, x), 0x118, 0xf, 0xf, true); break; }
    return __builtin_bit_cast(float, v); }
DI float dpp_shr1(float x, int n) { int v; const int one = 0x3f800000;
    switch (n) { case 1: v = __builtin_amdgcn_update_dpp(one, __builtin_bit_cast(int, x), 0x111, 0xf, 0xf, false); break; case 2: v = __builtin_amdgcn_update_dpp(one, __builtin_bit_cast(int, x), 0x112, 0xf, 0xf, false); break;
                 case 4: v = __builtin_amdgcn_update_dpp(one, __builtin_bit_cast(int, x), 0x114, 0xf, 0xf, false); break; default: v = __builtin_amdgcn_update_dpp(one, __builtin_bit_cast(int, x), 0x118, 0xf, 0xf, false); break; }
    return __builtin_bit_cast(float, v); }
struct RwkvP {
    const bf16* PR; const float* mu; const float* muv;
    const float *dbase, *ibase, *vbase, *ksk, *ksa, *brk, *gng, *gnb;
    const bf16 *dupT, *iupT, *vupT, *gupT;
    const bf16* ZROW; bf16 *VF, *VV; float* BON; float* GC; bf16 *W1S, *REFF, *BM; v4u* REC; float* YPRE; bf16* MIX; int layer0;
};
DI const f32x4* vec4p(const float*) { return nullptr; }
DI const LAS f32x4* vec4p(const LAS float*) { return nullptr; }
template <class MP> DI void lerp8(const bf16* crow_, const bf16* prow_, int col, MP mu, float (&z)[8]) {
    const v4u cur = *(const v4u*)(crow_ + col); const v4u prv = *(const v4u*)(prow_ + col);
    const f32x4 m0 = *(decltype(vec4p(mu)))(mu), m1 = *(decltype(vec4p(mu)))(mu + 4);
#pragma unroll
    for (int j = 0; j < 4; ++j) { const float a = bflo(cur[j]), b = bfhi(cur[j]), pa = bflo(prv[j]), pb = bfhi(prv[j]); const float ma = j < 2 ? m0[2 * j] : m1[2 * j - 4], mb = j < 2 ? m0[2 * j + 1] : m1[2 * j - 3];
        z[2 * j] = a + (pa - a) * ma; z[2 * j + 1] = b + (pb - b) * mb; }
}
template <class MP> DI f32x4 lerp4(const bf16* crow_, const bf16* prow_, int col, MP mu) {
    const v2u cur = *(const v2u*)(crow_ + col); const v2u prv = *(const v2u*)(prow_ + col);
    const f32x4 m = *(decltype(vec4p(mu)))(mu);
    f32x4 z; z[0] = bflo(cur.x) + (bflo(prv.x) - bflo(cur.x)) * m[0]; z[1] = bfhi(cur.x) + (bfhi(prv.x) - bfhi(cur.x)) * m[1];
    z[2] = bflo(cur.y) + (bflo(prv.y) - bflo(cur.y)) * m[2]; z[3] = bfhi(cur.y) + (bfhi(prv.y) - bfhi(cur.y)) * m[3]; return z;
}
template <class MP> DI void lerp8l(const LAS unsigned char* crow_, const LAS unsigned char* prow_, int colb, MP mu, float (&z)[8]) {
    const v4u cur = *(const LAS v4u*)(crow_ + colb); const v4u prv = *(const LAS v4u*)(prow_ + colb);
    const f32x4 m0 = *(decltype(vec4p(mu)))(mu), m1 = *(decltype(vec4p(mu)))(mu + 4);
#pragma unroll
    for (int j = 0; j < 4; ++j) { const float a = bflo(cur[j]), b = bfhi(cur[j]), pa = bflo(prv[j]), pb = bfhi(prv[j]); const float ma = j < 2 ? m0[2 * j] : m1[2 * j - 4], mb = j < 2 ? m0[2 * j + 1] : m1[2 * j - 3];
        z[2 * j] = a + (pa - a) * ma; z[2 * j + 1] = b + (pb - b) * mb; }
}
template <class MP> DI f32x4 lerp4l(const LAS unsigned char* crow_, const LAS unsigned char* prow_, int colb, MP mu) {
    const v2u cur = *(const LAS v2u*)(crow_ + colb); const v2u prv = *(const LAS v2u*)(prow_ + colb);
    const f32x4 m = *(decltype(vec4p(mu)))(mu);
    f32x4 z; z[0] = bflo(cur.x) + (bflo(prv.x) - bflo(cur.x)) * m[0]; z[1] = bfhi(cur.x) + (bfhi(prv.x) - bfhi(cur.x)) * m[1];
    z[2] = bflo(cur.y) + (bflo(prv.y) - bflo(cur.y)) * m[2]; z[3] = bfhi(cur.y) + (bfhi(prv.y) - bfhi(cur.y)) * m[3]; return z;
}
DI void img_write(LAS unsigned char* img, const f32x4 (&x)[4], int fr, int fq) {
#pragma unroll
    for (int mb = 0; mb < 4; ++mb)
#pragma unroll
        for (int reg = 0; reg < 4; ++reg) *(LAS bf16*)(img + (16 * mb + 4 * fq + reg) * 32 + fr * 2) = (bf16)pk2z(x[mb][reg]);
}
DI bf16x8 lds4z(const LAS unsigned char* p) { const v2u t = *(const LAS v2u*)p; v4u w; w.x = t.x; w.y = t.y; w.z = 0u; w.w = 0u; return __builtin_bit_cast(bf16x8, w); }
constexpr int HC_DUP = 0, HC_IUP = 9216, HC_VUP = 18432, HC_F = 23552, HC_BYTES = 23552 + 736 * 4;
enum { HF_MUR = 0, HF_MUK = 64, HF_MUV = 128, HF_MUW = 192, HF_MUA = 256, HF_MUVR = 320, HF_DB = 352, HF_IB = 416, HF_VB = 480, HF_SK = 544, HF_SA = 608, HF_BR = 672 };
DI void head_cache_fill(const RwkvP& P, int h, LAS unsigned char* hc, int tid) {
    { const int row = tid >> 3, ch = tid & 7;
      *(LAS v4u*)(hc + HC_DUP + row * 144 + ch * 16) = *(const v4u*)(P.dupT + (size_t)(h * 64 + row) * 64 + ch * 8);
      *(LAS v4u*)(hc + HC_IUP + row * 144 + ch * 16) = *(const v4u*)(P.iupT + (size_t)(h * 64 + row) * 64 + ch * 8); }
    if (tid < 256 && !P.layer0) { const int row = tid >> 2, ch = tid & 3; *(LAS v4u*)(hc + HC_VUP + row * 80 + ch * 16) = *(const v4u*)(P.vupT + (size_t)(h * 64 + row) * 32 + ch * 8); }
    LAS float* f = (LAS float*)(hc + HC_F);
    if (tid < 64) { const int c = h * 64 + tid; f[HF_MUR + tid] = P.mu[c]; f[HF_MUK + tid] = P.mu[512 + c]; f[HF_MUV + tid] = P.mu[1024 + c]; f[HF_MUW + tid] = P.mu[1536 + tid]; f[HF_MUA + tid] = P.mu[1600 + tid];
        f[HF_DB + tid] = P.dbase[c]; f[HF_IB + tid] = P.ibase[c]; f[HF_VB + tid] = P.layer0 ? 0.f : P.vbase[c]; f[HF_SK + tid] = P.ksk[c]; f[HF_SA + tid] = P.ksa[c]; f[HF_BR + tid] = P.brk[c];
        if (tid < 32) f[HF_MUVR + tid] = P.layer0 ? 0.f : P.muv[tid]; }
}
DI void rwkv_b1_unit(const RwkvP& P, int unit, LAS unsigned char* wl, const LAS unsigned char* hc, LAS float* gct  , int lane) {
    asm volatile("" : "+v"(lane));
    const int fr = lane & 15, fq = lane >> 4;
    const int seq = unit >> 9, c = unit & 511, b = seq >> 3, h = seq & 7;
    const size_t row = (size_t)b * TSEQ + 16 * c + fr;
    const f32x4 z4 = {0.f, 0.f, 0.f, 0.f};
    const LAS float* hf = (const LAS float*)(hc + HC_F);
    const bf16* row0p = P.PR + ((size_t)b * TSEQ + 16 * c) * PRP;
#define TROW(rr) (((rr) == 0 && c == 0) ? P.ZROW : row0p + ((rr) - 1) * PRP)
    v4u tl[6], tr3[3][3];
#pragma unroll
    for (int i = 0; i < 5; ++i) { const int idx = lane + 64 * i; if (idx < 272) { const int rr = idx >> 4, pc = idx & 15; tl[i] = *(const v4u*)(TROW(rr) + 1536 + pc * 8); } }
    { const int idx = lane; const int rr = idx >> 2, pc = idx & 3; tl[5] = (v4u){0u, 0u, 0u, 0u}; if (!P.layer0) { tl[5] = *(const v4u*)(TROW(rr) + 1792 + pc * 8); } }
    v4u tl16 = {0u, 0u, 0u, 0u}; if (!P.layer0 && lane < 4) tl16 = *(const v4u*)(TROW(16) + 1792 + lane * 8);
#pragma unroll
    for (int ten = 0; ten < 3; ++ten)
#pragma unroll
        for (int i = 0; i < 3; ++i) { const int idx = lane + 64 * i; if (idx < 136) { const int rr = idx >> 3, pc = idx & 7; tr3[ten][i] = *(const v4u*)(TROW(rr) + ten * 512 + h * 64 + pc * 8); } }
#pragma unroll
    for (int i = 0; i < 5; ++i) { const int idx = lane + 64 * i; if (idx < 272) { const int rr = idx >> 4, pc = idx & 15; *(LAS v4u*)(wl + TIL + rr * TIL_LP + pc * 16) = tl[i]; } }
    { const int rr = lane >> 2, pc = lane & 3; *(LAS v4u*)(wl + TIL + rr * TIL_LP + 256 + pc * 16) = tl[5]; if (lane < 4) *(LAS v4u*)(wl + TIL + 16 * TIL_LP + 256 + lane * 16) = tl16; }
    LDS_WAIT();
    const LAS unsigned char* lcr = wl + TIL + (fr + 1) * TIL_LP; const LAS unsigned char* lpr = wl + TIL + fr * TIL_LP;
    bf16x8 tw[2], al[2], vl;
#pragma unroll
    for (int ks = 0; ks < 2; ++ks) { float z[8]; lerp8l(lcr, lpr, (8 * fq + 32 * ks) * 2, hf + HF_MUW + 8 * fq + 32 * ks, z);
        tw[ks] = pk8(ftanh(z[0]), ftanh(z[1]), ftanh(z[2]), ftanh(z[3]), ftanh(z[4]), ftanh(z[5]), ftanh(z[6]), ftanh(z[7]));
        lerp8l(lcr, lpr, 128 + (8 * fq + 32 * ks) * 2, hf + HF_MUA + 8 * fq + 32 * ks, z); al[ks] = pk8(z[0], z[1], z[2], z[3], z[4], z[5], z[6], z[7]); }
    if (!P.layer0) { float z[8]; lerp8l(lcr, lpr, 256 + 8 * fq * 2, hf + HF_MUVR + 8 * fq, z); vl = pk8(z[0], z[1], z[2], z[3], z[4], z[5], z[6], z[7]); }
    LDS_WAIT();
#pragma unroll
    for (int ten = 0; ten < 3; ++ten)
#pragma unroll
        for (int i = 0; i < 3; ++i) { const int idx = lane + 64 * i; if (idx < 136) { const int rr = idx >> 3, pc = idx & 7; *(LAS v4u*)(wl + TIL + ten * TIL_RSZ + rr * TIL_RP + pc * 16) = tr3[ten][i]; } }
    LDS_WAIT();
#undef TROW
    const LAS unsigned char* rcr = wl + TIL + (fr + 1) * TIL_RP; const LAS unsigned char* rpr = wl + TIL + fr * TIL_RP;
    f32x4 zr[4], k2[4], kk[4], ai[4], ld[4];
    float nrm = 0.f, bon = 0.f;
#pragma unroll
    for (int mb = 0; mb < 4; ++mb) { const int ch = h * 64 + 16 * mb + 4 * fq; const int n = h * 64 + 16 * mb + fr;
        f32x4 dw = z4, da = z4, dv = z4;
        dw = mfma16(*(const LAS bf16x8*)(hc + HC_DUP + (16 * mb + fr) * 144 + 16 * fq), tw[0], dw); dw = mfma16(*(const LAS bf16x8*)(hc + HC_DUP + (16 * mb + fr) * 144 + 16 * fq + 64), tw[1], dw);
        da = mfma16(*(const LAS bf16x8*)(hc + HC_IUP + (16 * mb + fr) * 144 + 16 * fq), al[0], da); da = mfma16(*(const LAS bf16x8*)(hc + HC_IUP + (16 * mb + fr) * 144 + 16 * fq + 64), al[1], da);
        if (!P.layer0) dv = mfma16(*(const LAS bf16x8*)(hc + HC_VUP + (16 * mb + fr) * 80 + 16 * fq), vl, z4);
        const int cl = 16 * mb + 4 * fq;
        zr[mb] = lerp4l(rcr, rpr, cl * 2, hf + HF_MUR + cl);
        const f32x4 zk = lerp4l(rcr + TIL_RSZ, rpr + TIL_RSZ, cl * 2, hf + HF_MUK + cl);
        f32x4 zv = lerp4l(rcr + 2 * TIL_RSZ, rpr + 2 * TIL_RSZ, cl * 2, hf + HF_MUV + cl);
        const f32x4 db = *(const LAS f32x4*)(hf + HF_DB + cl), ib = *(const LAS f32x4*)(hf + HF_IB + cl), sk = *(const LAS f32x4*)(hf + HF_SK + cl), sa = *(const LAS f32x4*)(hf + HF_SA + cl), br = *(const LAS f32x4*)(hf + HF_BR + cl);
        if (P.layer0) { v2u w; w.x = pk2(zv[0], zv[1]); w.y = pk2(zv[2], zv[3]); *(v2u*)(P.VF + row * 512 + ch) = w; }
        else { const v2u f = *(const v2u*)(P.VF + row * 512 + ch); const f32x4 vb = *(const LAS f32x4*)(hf + HF_VB + cl); const f32x4 vf = {bflo(f.x), bfhi(f.x), bflo(f.y), bfhi(f.y)};
#pragma unroll
            for (int e = 0; e < 4; ++e) zv[e] = zv[e] + (vf[e] - zv[e]) * fsigmoid(vb[e] + dv[e]); }
        { v2u w; w.x = pk2(zv[0], zv[1]); w.y = pk2(zv[2], zv[3]); *(v2u*)(P.VV + row * 512 + ch) = w; }
#pragma unroll
        for (int reg = 0; reg < 4; ++reg) *(LAS bf16*)(wl + IMG_V + (16 * mb + 4 * fq + reg) * 32 + fr * 2) = (bf16)pk2z(zv[reg]);
#pragma unroll
        for (int e = 0; e < 4; ++e) {
            ld[mb][e] = fexp(-0.60653065971f * fsigmoid(db[e] + dw[e]));
            const float a = fsigmoid(ib[e] + da[e]); ai[mb][e] = a;
            const float kr = zk[e] * sk[e]; kk[mb][e] = kr; nrm += kr * kr;
            const float kx = zk[e] * (1.f + (a - 1.f) * sa[e]); k2[mb][e] = kx; bon += zr[mb][e] * kx * br[e]; }
        asm volatile("" ::: "memory");
    }
    nrm += __shfl_xor(nrm, 16); nrm += __shfl_xor(nrm, 32); bon += __shfl_xor(bon, 16); bon += __shfl_xor(bon, 32);
    if (fq == 0) P.BON[row * 8 + h] = bon;
    const float kinv = 1.0f / fmaxf(sqrtf(nrm), 1e-12f);
    f32x4 rt[4], kh[4];
    bf16x8 pa[2], pb[2], pk[2], pr[2];
#pragma unroll
    for (int ks = 0; ks < 2; ++ks) {
        f32x4 at2[2], bt2[2], kt2[2];
#pragma unroll
        for (int m2 = 0; m2 < 2; ++m2) { const int mb = 2 * ks + m2;
            f32x4 gcv, bhv;
#pragma unroll
            for (int e = 0; e < 4; ++e) {
                float gm = ld[mb][e]; gm *= dpp_shr1(gm, 1); gm *= dpp_shr1(gm, 2); gm *= dpp_shr1(gm, 4); gm *= dpp_shr1(gm, 8);
                const float gc = __shfl(gm, lane | 15), gp = dpp_shr1(gm, 1), gi = __builtin_amdgcn_rcpf(gm), ec = gc * gi;
                const float kn = kk[mb][e] * kinv, bb = kn * ai[mb][e];
                at2[m2][e] = -kn * gp; bt2[m2][e] = bb * gi; kt2[m2][e] = k2[mb][e] * gi; rt[mb][e] = zr[mb][e] * gm;
                bhv[e] = bb * ec; kh[mb][e] = k2[mb][e] * ec; gcv[e] = gc; }
            if (fr == 0) { *(f32x4*)(P.GC + (size_t)unit * 64 + 16 * mb + 4 * fq) = gcv; *(LAS f32x4*)(gct + (unit & 31) * 64 + 16 * mb + 4 * fq) = gcv; }
#pragma unroll
            for (int reg = 0; reg < 4; ++reg) { const int o = (16 * mb + 4 * fq + reg) * 32 + fr * 2;
                *(LAS bf16*)(wl + IMG_A + o) = (bf16)pk2z(at2[m2][reg]); *(LAS bf16*)(wl + IMG_B + o) = (bf16)pk2z(bhv[reg]); }
        }
        pa[ks] = pk8v(at2[0], at2[1]); pb[ks] = pk8v(bt2[0], bt2[1]); pk[ks] = pk8v(kt2[0], kt2[1]); pr[ks] = pk8v(rt[2 * ks], rt[2 * ks + 1]);
    }
    const f32x4 z4b = {0.f, 0.f, 0.f, 0.f};
    f32x4 Aab = mfma16(pb[1], pa[1], mfma16(pb[0], pa[0], z4b));
    f32x4 AakT = mfma16(pa[1], pk[1], mfma16(pa[0], pk[0], z4b));
    f32x4 Arb = mfma16(pb[1], pr[1], mfma16(pb[0], pr[0], z4b));
    f32x4 Ark = mfma16(pk[1], pr[1], mfma16(pk[0], pr[0], z4b));
#pragma unroll
    for (int e = 0; e < 4; ++e) { const int rr = 4 * fq + e; Aab[e] = rr < fr ? Aab[e] : 0.f; AakT[e] = fr < rr ? AakT[e] : 0.f; Arb[e] = rr <= fr ? Arb[e] : 0.f; Ark[e] = rr <= fr ? Ark[e] : 0.f; }
    LAS float* As = (LAS float*)(wl + 5 * B1_IMG);
#pragma unroll
    for (int e = 0; e < 4; ++e) As[(4 * fq + e) * 16 + fr] = Aab[e];
    LDS_WAIT();
    float x[16];
#pragma unroll
    for (int s = 15; s >= 0; --s) { float acc = (s == fr) ? 1.f : 0.f;
        const f32x4 r0 = *(const LAS f32x4*)(As + s * 16), r1 = *(const LAS f32x4*)(As + s * 16 + 4), r2 = *(const LAS f32x4*)(As + s * 16 + 8), r3 = *(const LAS f32x4*)(As + s * 16 + 12);
        const float rowv[16] = {r0[0], r0[1], r0[2], r0[3], r1[0], r1[1], r1[2], r1[3], r2[0], r2[1], r2[2], r2[3], r3[0], r3[1], r3[2], r3[3]};
#pragma unroll
        for (int uu = s + 1; uu < 16; ++uu) acc += rowv[uu] * x[uu];
        x[s] = acc; if ((s & 1) == 0) asm volatile("" ::: "memory"); }
    f32x4 xs;
#pragma unroll
    for (int e = 0; e < 4; ++e) xs[e] = fq == 0 ? x[e] : fq == 1 ? x[4 + e] : fq == 2 ? x[8 + e] : x[12 + e];
    const bf16x8 Tsel = pk4z(xs);
    f32x4 W1[4];
#pragma unroll
    for (int mb = 0; mb < 4; ++mb) W1[mb] = mfma16(lds4z(wl + IMG_A + (16 * mb + fr) * 32 + 8 * fq), Tsel, z4);
    const f32x4 GT = mfma16(Tsel, pk4z(AakT), z4);
    img_write(wl + IMG_W, W1, fr, fq);
    f32x4 M1T[4];
    const bf16x8 GTp = pk4z(GT);
#pragma unroll
    for (int mb = 0; mb < 4; ++mb) M1T[mb] = mfma16(lds4z(wl + IMG_B + (16 * mb + fr) * 32 + 8 * fq), GTp, kh[mb]);
    img_write(wl + IMG_M, M1T, fr, fq);
    LDS_WAIT();
    const bf16x8 Arbp = pk4z(Arb);
    f32x4 RE[4];
#pragma unroll
    for (int mb = 0; mb < 4; ++mb) RE[mb] = mfma16(lds4z(wl + IMG_W + (16 * mb + fr) * 32 + 8 * fq), Arbp, rt[mb]);
    const f32x4 M2 = mfma16(GTp, Arbp, Ark);
    {   bf16* w1s = P.W1S + (size_t)unit * 1024 + fr * 32; bf16* re = P.REFF + (size_t)unit * 1024 + fr * 32;
#pragma unroll
        for (int kp = 0; kp < 2; ++kp) { const int sg = kp * 512 + fq * 8;
            v4u w; w.x = pk2(W1[2 * kp][0], W1[2 * kp][1]); w.y = pk2(W1[2 * kp][2], W1[2 * kp][3]); w.z = pk2(W1[2 * kp + 1][0], W1[2 * kp + 1][1]); w.w = pk2(W1[2 * kp + 1][2], W1[2 * kp + 1][3]); *(v4u*)(w1s + sg) = w;
            w.x = pk2(RE[2 * kp][0], RE[2 * kp][1]); w.y = pk2(RE[2 * kp][2], RE[2 * kp][3]); w.z = pk2(RE[2 * kp + 1][0], RE[2 * kp + 1][1]); w.w = pk2(RE[2 * kp + 1][2], RE[2 * kp + 1][3]); *(v4u*)(re + sg) = w; }
        const v2u m2p = {pk2(M2[0], M2[1]), pk2(M2[2], M2[3])};
#pragma unroll
        for (int mb = 0; mb < 4; ++mb) {
            const v2u bq = *(const LAS v2u*)(wl + IMG_B + (16 * mb + fr) * 32 + 8 * fq), mq = *(const LAS v2u*)(wl + IMG_M + (16 * mb + fr) * 32 + 8 * fq);
            *(v4u*)(P.BM + (((size_t)unit * 64 + 16 * mb + fr) * 4 + fq) * 8) = (v4u){bq.x, bq.y, mq.x, mq.y};
            const v2u vq = *(const LAS v2u*)(wl + IMG_V + (16 * mb + fr) * 32 + 8 * fq);
            P.REC[((size_t)unit * 4 + mb) * 64 + lane] = (v4u){vq.x, vq.y, m2p.x, m2p.y}; }
    }
    LDS_WAIT();
}
constexpr int NSEG = 16, SEGCH = NCH / NSEG;
struct ChainIn { bf16x8 w1[2], re[2], bm[4]; v4u rec; };
constexpr int GCT_OFF = 149504;
template <int MODE> DI void chain_load(ChainIn& c, const RwkvP& P, int unit, int rb, int lane) {
    const int fr = lane & 15, fq = lane >> 4;
    const bf16* w1s = P.W1S + (size_t)unit * 1024 + fr * 32 + fq * 8;
    c.w1[0] = ld8(w1s); c.w1[1] = ld8(w1s + 512);
    if (MODE == 2) { const bf16* re = P.REFF + (size_t)unit * 1024 + fr * 32 + fq * 8; c.re[0] = ld8(re); c.re[1] = ld8(re + 512); }
#pragma unroll
    for (int mb = 0; mb < 4; ++mb) c.bm[mb] = ld8(P.BM + (((size_t)unit * 64 + 16 * mb + fr) * 4 + fq) * 8);
    if (MODE != 1) c.rec = P.REC[((size_t)unit * 4 + rb) * 64 + lane];
}
template <int MODE> DI void chain_step(f32x4 (&S)[4], const ChainIn& c, float* ypre  , const LAS float* gcl  ) {
    const f32x4 z4 = {0.f, 0.f, 0.f, 0.f};
    f32x4 gc[4];
#pragma unroll
    for (int mb = 0; mb < 4; ++mb) gc[mb] = *(const LAS f32x4*)(gcl + 16 * mb);
    const bf16x8 b0 = pk8v(S[0], S[1]), b1 = pk8v(S[2], S[3]);
    f32x4 ut = mfma16(c.w1[1], b1, mfma16(c.w1[0], b0, z4));
    if (MODE == 2) {
        v4u vlo; vlo.x = c.rec.x; vlo.y = c.rec.y; vlo.z = 0u; vlo.w = 0u;
        v4u m2a; m2a.x = c.rec.z; m2a.y = c.rec.w; m2a.z = 0u; m2a.w = 0u;
        f32x4 y = mfma16(__builtin_bit_cast(bf16x8, m2a), __builtin_bit_cast(bf16x8, vlo), z4);
        y = mfma16(c.re[0], b0, y); y = mfma16(c.re[1], b1, y);
#pragma unroll
        for (int e = 0; e < 4; ++e) ypre[(size_t)e * 512] = y[e];
    }
    v4u uv; uv.x = pk2(ut[0], ut[1]); uv.y = pk2(ut[2], ut[3]); uv.z = MODE == 1 ? 0u : c.rec.x; uv.w = MODE == 1 ? 0u : c.rec.y;
    const bf16x8 ub = __builtin_bit_cast(bf16x8, uv);
#pragma unroll
    for (int mb = 0; mb < 4; ++mb) S[mb] = mfma16(c.bm[mb], ub, S[mb] * gc[mb]);
}
template <int MODE> DI void chain_run(f32x4 (&S)[4], const RwkvP& P, int unit0, int nsteps  , int rb, float* yp, const LAS float* gct  , int lane) {
    ChainIn c0, c1, c2, c3;
    chain_load<MODE>(c0, P, unit0, rb, lane); chain_load<MODE>(c1, P, unit0 + 1, rb, lane); chain_load<MODE>(c2, P, unit0 + 2, rb, lane);
    for (int c = 0; c < nsteps; c += 4) {
        chain_load<MODE>(c3, P, unit0 + c + 3, rb, lane);
        chain_step<MODE>(S, c0, yp + (size_t)c * 16 * 512, gct + c * 64);
        if (c + 4 < nsteps) chain_load<MODE>(c0, P, unit0 + c + 4, rb, lane);
        chain_step<MODE>(S, c1, yp + (size_t)(c + 1) * 16 * 512, gct + (c + 1) * 64);
        if (c + 5 < nsteps) chain_load<MODE>(c1, P, unit0 + c + 5, rb, lane);
        chain_step<MODE>(S, c2, yp + (size_t)(c + 2) * 16 * 512, gct + (c + 2) * 64);
        if (c + 6 < nsteps) chain_load<MODE>(c2, P, unit0 + c + 6, rb, lane);
        chain_step<MODE>(S, c3, yp + (size_t)(c + 3) * 16 * 512, gct + (c + 3) * 64);
    }
}
DI void chain_step_dual(f32x4 (&SQ)[4], f32x4 (&SP)[4], const ChainIn& c, const LAS float* gcl) {
    const f32x4 z4 = {0.f, 0.f, 0.f, 0.f};
    f32x4 gc[4];
#pragma unroll
    for (int mb = 0; mb < 4; ++mb) gc[mb] = *(const LAS f32x4*)(gcl + 16 * mb);
    const bf16x8 q0 = pk8v(SQ[0], SQ[1]), q1 = pk8v(SQ[2], SQ[3]), p0 = pk8v(SP[0], SP[1]), p1 = pk8v(SP[2], SP[3]);
    const f32x4 utq = mfma16(c.w1[1], q1, mfma16(c.w1[0], q0, z4)), utp = mfma16(c.w1[1], p1, mfma16(c.w1[0], p0, z4));
    v4u uq; uq.x = pk2(utq[0], utq[1]); uq.y = pk2(utq[2], utq[3]); uq.z = c.rec.x; uq.w = c.rec.y;
    v4u up; up.x = pk2(utp[0], utp[1]); up.y = pk2(utp[2], utp[3]); up.z = 0u; up.w = 0u;
    const bf16x8 ubq = __builtin_bit_cast(bf16x8, uq), ubp = __builtin_bit_cast(bf16x8, up);
#pragma unroll
    for (int mb = 0; mb < 4; ++mb) { SQ[mb] = mfma16(c.bm[mb], ubq, SQ[mb] * gc[mb]); SP[mb] = mfma16(c.bm[mb], ubp, SP[mb] * gc[mb]); }
}
DI void chain_pass1(const RwkvP& P, float* QSEG, float* PSEGT, int seq, int g, int rb, const LAS float* gct0, int lane) {
    const int fr = lane & 15, fq = lane >> 4;
    f32x4 SQ[4], SP[4];
#pragma unroll
    for (int mb = 0; mb < 4; ++mb)
#pragma unroll
        for (int e = 0; e < 4; ++e) { SQ[mb][e] = 0.f; SP[mb][e] = ((16 * mb + 4 * fq + e) == (16 * rb + fr)) ? 1.f : 0.f; }
    const int unit0 = seq * NCH + g * SEGCH; const LAS float* gct = gct0 + 4 * fq;
    {   ChainIn c0, c1, c2;
        chain_load<0>(c0, P, unit0, rb, lane); chain_load<0>(c1, P, unit0 + 1, rb, lane);
        int c = 0;
        for (; c + 3 <= SEGCH; c += 3) {
            chain_load<0>(c2, P, unit0 + c + 2, rb, lane);
            chain_step_dual(SQ, SP, c0, gct + c * 64);
            if (c + 3 < SEGCH) chain_load<0>(c0, P, unit0 + c + 3, rb, lane);
            chain_step_dual(SQ, SP, c1, gct + (c + 1) * 64);
            if (c + 4 < SEGCH) chain_load<0>(c1, P, unit0 + c + 4, rb, lane);
            chain_step_dual(SQ, SP, c2, gct + (c + 2) * 64);
        }
        if (c < SEGCH) { chain_step_dual(SQ, SP, c0, gct + c * 64); ++c; }
        if (c < SEGCH) { chain_step_dual(SQ, SP, c1, gct + c * 64); ++c; }
    }
    const size_t sb = ((size_t)seq * NSEG + g) * 4096;
#pragma unroll
    for (int mb = 0; mb < 4; ++mb) *(f32x4*)(QSEG + sb + (size_t)(16 * rb + fr) * 64 + 16 * mb + 4 * fq) = SQ[mb];
#pragma unroll
    for (int mb = 0; mb < 4; ++mb)
#pragma unroll
        for (int e = 0; e < 4; ++e) PSEGT[sb + (size_t)((mb * 2 + (rb >> 1)) * 2 + (rb & 1)) * 256 + ((4 * fq + e) + 16 * (fr >> 2)) * 4 + (fr & 3)] = SP[mb][e];
}
DI void split_hl(const f32x4 a, const f32x4 b, bf16x8& hi, bf16x8& lo) {
    f32x4 ah, bh;
#pragma unroll
    for (int e = 0; e < 4; ++e) { ah[e] = rbf(a[e]); bh[e] = rbf(b[e]); }
    hi = pk8v(ah, bh); lo = pk8v(a - ah, b - bh);
}
DI void chain_pass23(const RwkvP& P, const float* QSEG, const float* PSEGT, int seq, int g, int rb, float* wkv_out, const LAS float* gct0, int lane) {
    const int fr = lane & 15, fq = lane >> 4, b = seq >> 3, h = seq & 7;
    f32x4 S[4]; for (int mb = 0; mb < 4; ++mb) S[mb] = (f32x4){0.f, 0.f, 0.f, 0.f};
    f32x4 pc[4][2][2], pn[4][2][2];
#define P2_LOAD(PD_, GP_) do { const size_t sb_ = ((size_t)seq * NSEG + (GP_)) * 4096; _Pragma("unroll") for (int mb = 0; mb < 4; ++mb) { \
        _Pragma("unroll") for (int ks = 0; ks < 2; ++ks) { const float* pr_ = PSEGT + sb_ + (size_t)((mb * 2 + ks) * 2) * 256 + (fr + 16 * fq) * 4; PD_[mb][ks][0] = *(const f32x4*)pr_; PD_[mb][ks][1] = *(const f32x4*)(pr_ + 256); } } } while (0)
    if (g > 0) P2_LOAD(pc, 0);
    for (int gp = 0; gp < g; ++gp) {
        f32x4 qc[4];
        { const size_t sb_ = ((size_t)seq * NSEG + gp) * 4096;
#pragma unroll
          for (int mb = 0; mb < 4; ++mb) qc[mb] = *(const f32x4*)(QSEG + sb_ + (size_t)(16 * rb + fr) * 64 + 16 * mb + 4 * fq); }
        if (gp + 1 < g) P2_LOAD(pn, gp + 1);
        bf16x8 bh[2], bl[2]; split_hl(S[0], S[1], bh[0], bl[0]); split_hl(S[2], S[3], bh[1], bl[1]);
#pragma unroll
        for (int mb = 0; mb < 4; ++mb) { f32x4 acc = {0.f, 0.f, 0.f, 0.f};
#pragma unroll
            for (int ks = 0; ks < 2; ++ks) { bf16x8 ah, al; split_hl(pc[mb][ks][0], pc[mb][ks][1], ah, al);
                acc = mfma16(ah, bh[ks], acc); acc = mfma16(al, bh[ks], acc); acc = mfma16(ah, bl[ks], acc); }
            S[mb] = acc + qc[mb]; }
#pragma unroll
        for (int mb = 0; mb < 4; ++mb) {
#pragma unroll
            for (int ks = 0; ks < 2; ++ks) { pc[mb][ks][0] = pn[mb][ks][0]; pc[mb][ks][1] = pn[mb][ks][1]; } }
    }
#undef P2_LOAD
    float* yp = P.YPRE + ((size_t)b * TSEQ + (size_t)g * SEGCH * 16 + 4 * fq) * 512 + h * 64 + 16 * rb + fr;
    chain_run<2>(S, P, seq * NCH + g * SEGCH, SEGCH, rb, yp, gct0 + 4 * fq, lane);
    if (g == NSEG - 1) {
#pragma unroll
        for (int mb = 0; mb < 4; ++mb) *(f32x4*)(wkv_out + (size_t)(16 * rb + fr) * 64 + 16 * mb + 4 * fq) = S[mb];
    }
}
constexpr int GC_GUP = 0, GC_F = 64 * 272, GC_BYTES = 64 * 272 + 256 * 4;
DI void gate_cache_fill(const RwkvP& P, int h, LAS unsigned char* gc, int tid) {
#pragma unroll
    for (int q = 0; q < 2; ++q) { const int idx = tid + 512 * q, row = idx >> 4, ch = idx & 15;
        *(LAS v4u*)(gc + GC_GUP + row * 272 + ch * 16) = *(const v4u*)(P.gupT + (size_t)(h * 64 + row) * 128 + ch * 8); }
    LAS float* f = (LAS float*)(gc + GC_F);
    if (tid < 64) { f[tid] = P.gng[h * 64 + tid]; f[64 + tid] = P.gnb[h * 64 + tid]; }
    if (tid >= 64 && tid < 192) f[128 + tid - 64] = P.mu[1664 + tid - 64];
}
constexpr int B3_GP = 272, B3_YP = 272, B3_VP = 144, B3_G = 0, B3_Y = 17 * B3_GP, B3_V = B3_Y + 16 * B3_YP, B3_WLDS = B3_V + 16 * B3_VP;
DI void rwkv_b3_unit(const RwkvP& P, int unit, const LAS unsigned char* gc, LAS unsigned char* wl, int lane) {
    asm volatile("" : "+v"(lane));
    const int fr = lane & 15, fq = lane >> 4;
    const int seq = unit >> 9, c = unit & 511, b = seq >> 3, h = seq & 7;
    const size_t row0 = (size_t)b * TSEQ + 16 * c;
    const f32x4 z4 = {0.f, 0.f, 0.f, 0.f};
    const LAS float* gf = (const LAS float*)(gc + GC_F);
    const bf16* row0p = P.PR + row0 * PRP;
    v4u tg[5], ty[4], tv[2];
#pragma unroll
    for (int i = 0; i < 5; ++i) { const int idx = lane + 64 * i; if (idx < 272) { const int rr = idx >> 4, pc = idx & 15; const bf16* rp = (rr == 0 && c == 0) ? P.ZROW : row0p + (rr - 1) * PRP; tg[i] = *(const v4u*)(rp + 1664 + pc * 8); } }
#pragma unroll
    for (int i = 0; i < 4; ++i) { const int idx = lane + 64 * i, rr = idx >> 4, pc = idx & 15; ty[i] = *(const v4u*)(P.YPRE + (row0 + rr) * 512 + h * 64 + pc * 4); }
#pragma unroll
    for (int i = 0; i < 2; ++i) { const int idx = lane + 64 * i, rr = idx >> 3, pc = idx & 7; tv[i] = *(const v4u*)(P.VV + (row0 + rr) * 512 + h * 64 + pc * 8); }
    const float bon = P.BON[(row0 + fr) * 8 + h];
#pragma unroll
    for (int i = 0; i < 5; ++i) { const int idx = lane + 64 * i; if (idx < 272) { const int rr = idx >> 4, pc = idx & 15; *(LAS v4u*)(wl + B3_G + rr * B3_GP + pc * 16) = tg[i]; } }
#pragma unroll
    for (int i = 0; i < 4; ++i) { const int idx = lane + 64 * i, rr = idx >> 4, pc = idx & 15; *(LAS v4u*)(wl + B3_Y + rr * B3_YP + pc * 16) = ty[i]; }
#pragma unroll
    for (int i = 0; i < 2; ++i) { const int idx = lane + 64 * i, rr = idx >> 3, pc = idx & 7; *(LAS v4u*)(wl + B3_V + rr * B3_VP + pc * 16) = tv[i]; }
    LDS_WAIT();
    const LAS unsigned char* gcr = wl + B3_G + (fr + 1) * B3_GP; const LAS unsigned char* gpr = wl + B3_G + fr * B3_GP;
    bf16x8 sg[4];
#pragma unroll
    for (int ks = 0; ks < 4; ++ks) { float z[8]; lerp8l(gcr, gpr, (8 * fq + 32 * ks) * 2, gf + 128 + 8 * fq + 32 * ks, z);
        sg[ks] = pk8(fsigmoid(z[0]), fsigmoid(z[1]), fsigmoid(z[2]), fsigmoid(z[3]), fsigmoid(z[4]), fsigmoid(z[5]), fsigmoid(z[6]), fsigmoid(z[7])); }
    f32x4 g[4], y[4]; float s = 0.f;
#pragma unroll
    for (int mb = 0; mb < 4; ++mb) { f32x4 a = z4;
#pragma unroll
        for (int ks = 0; ks < 4; ++ks) a = mfma16(*(const LAS bf16x8*)(gc + GC_GUP + (16 * mb + fr) * 272 + 16 * fq + 64 * ks), sg[ks], a);
        g[mb] = a;
        y[mb] = *(const LAS f32x4*)(wl + B3_Y + fr * B3_YP + (16 * mb + 4 * fq) * 4); s += (y[mb][0] + y[mb][1]) + (y[mb][2] + y[mb][3]); }
    s += __shfl_xor(s, 16); s += __shfl_xor(s, 32);
    const float mean = s * (1.f / 64.f); float q = 0.f;
#pragma unroll
    for (int mb = 0; mb < 4; ++mb) { y[mb] = y[mb] - mean; q += (y[mb][0] * y[mb][0] + y[mb][1] * y[mb][1]) + (y[mb][2] * y[mb][2] + y[mb][3] * y[mb][3]); }
    q += __shfl_xor(q, 16); q += __shfl_xor(q, 32);
    const float rstd = 1.0f / sqrtf(q * (1.f / 64.f) + GN_EPS);
    LDS_WAIT();
#pragma unroll
    for (int mb = 0; mb < 4; ++mb) { const int cl = 16 * mb + 4 * fq;
        const f32x4 gg = *(const LAS f32x4*)(gf + cl), gb = *(const LAS f32x4*)(gf + 64 + cl); const v2u vw = *(const LAS v2u*)(wl + B3_V + fr * B3_VP + cl * 2);
        const f32x4 v = {bflo(vw.x), bfhi(vw.x), bflo(vw.y), bfhi(vw.y)};
        const f32x4 o = (y[mb] * rstd * gg + gb + v * bon) * g[mb];
        v2u w; w.x = pk2(o[0], o[1]); w.y = pk2(o[2], o[3]); *(LAS v2u*)(wl + B3_G + fr * B3_VP + cl * 2) = w; }
    LDS_WAIT();
#pragma unroll
    for (int i = 0; i < 2; ++i) { const int idx = lane + 64 * i, rr = idx >> 3, pc = idx & 7; *(v4u*)(P.MIX + (row0 + rr) * 1024 + 512 + h * 64 + pc * 8) = *(const LAS v4u*)(wl + B3_G + rr * B3_VP + pc * 16); }
    LDS_WAIT();
}
DI f32x16 dec_gemm(const bf16* A, const bf16* Wt, int K, LAS float* red  , int wave, int lane) {
    const int r = lane & 31, h = lane >> 5, kw = K >> 3;
    const bf16* ap = A + (size_t)r * K + wave * kw + 8 * h; const bf16* bp = Wt + (size_t)r * K + wave * kw + 8 * h;
    f32x16 acc; for (int i = 0; i < 16; ++i) acc[i] = 0.f;
#pragma unroll 16
    for (int k = 0; k < kw; k += 16) acc = mfma32(ld8(ap + k), ld8(bp + k), acc);
    __syncthreads();
#pragma unroll
    for (int i = 0; i < 16; ++i) red[(wave * 16 + i) * 64 + lane] = acc[i];
    __syncthreads();
    if (wave == 0) {
#pragma unroll
        for (int i = 0; i < 16; ++i) { float s = 0.f;
#pragma unroll
            for (int w = 0; w < 8; ++w) s += red[(w * 16 + i) * 64 + lane];
            asm volatile("" : "+v"(s) :: "memory"); acc[i] = s; } }
    return acc;
}
DI void dec_row_stats(const float* st, LAS float* sc, int lane) {
    if (lane < 32) { float s = 0.f, q = 0.f; const f32x4* p = (const f32x4*)(st + (size_t)lane * 64);
#pragma unroll
        for (int i = 0; i < 16; ++i) { const f32x4 v = p[i]; s += v[0] + v[2]; q += v[1] + v[3]; if ((i & 3) == 3) asm volatile("" : "+v"(s), "+v"(q) :: "memory"); }
        const float mu = s * (1.f / 1024.f), var = fmaxf(q * (1.f / 1024.f) - mu * mu, 0.f); sc[2 * lane] = mu; sc[2 * lane + 1] = 1.0f / sqrtf(var + LN_EPS); }
    LDS_WAIT();
}
struct DecP {
    unsigned char* dec; int l;
    const float* xs;
    const float *c1in, *c2in, *c1up, *c2up, *g1, *b1, *g2p, *b2p;
    const bf16 *win, *winu, *wout, *wup, *wdn;
    float* out;
};
DI void dec_unit_in(const DecP& D, int u, LAS float* red, LAS float* sc, int wave, int lane) {
    const int r32 = lane & 31, hi = lane >> 5;
    if (u < 105) {
        const int n = 32 * u + r32; const bool fold = D.l > 0;
        const f32x16 acc = dec_gemm((const bf16*)(D.dec + DEC_XB2), D.win + (size_t)(32 * u) * DM, DM, red, wave, lane);
        if (wave != 0) return;
        if (fold) dec_row_stats((const float*)(D.dec + DEC_ST2), sc, lane);
        const float c1 = fold ? D.c1in[n] : 0.f, c2 = fold ? D.c2in[n] : 0.f; const int on = n < 1024 ? lgcl2orig(n) : n;
        float* PD = (float*)(D.dec + DEC_PD);
#pragma unroll
        for (int i = 0; i < 16; ++i) { const int row = crow(i, hi); float mu = 0.f, rs = 1.f; if (fold) { mu = sc[2 * row]; rs = sc[2 * row + 1]; } PD[(size_t)row * NIN + on] = (acc[i] - mu * c1) * rs + c2; }
    } else {
        const int v = u - 105, n = 32 * v + r32;
        const f32x16 acc = dec_gemm((const bf16*)(D.dec + DEC_SHB) + (size_t)D.l * MD * DM, D.winu + (size_t)(32 * v) * DM, DM, red, wave, lane);
        if (wave != 0) return;
        float* PS = (float*)(D.dec + DEC_PS);
#pragma unroll
        for (int i = 0; i < 16; ++i) PS[(size_t)crow(i, hi) * NRWU + n] = acc[i];
    }
    LDS_WAIT();
}
DI void dec_unit_res(const bf16* A, const bf16* Wt, int K, int u, bool raw, const float* src, const float* sstat, const float* g, const float* b, float* T, bf16* XB, float* ostat, float* shiftout, LAS float* red, LAS float* sc, int wave, int lane) {
    const int r32 = lane & 31, hi = lane >> 5, n = 32 * u + r32;
    const f32x16 acc = dec_gemm(A, Wt + (size_t)(32 * u) * K, K, red, wave, lane);
    if (wave != 0) return;
    if (!raw) dec_row_stats(sstat, sc, lane);
    const float gg = raw ? 1.f : g[n], bb = raw ? 0.f : b[n];
#pragma unroll
    for (int i = 0; i < 16; ++i) { const int row = crow(i, hi); float mu = 0.f, rs = 1.f; if (!raw) { mu = sc[2 * row]; rs = sc[2 * row + 1]; }
        const float x = (src[(size_t)row * DM + n] - mu) * rs * gg + bb; const float t = ALPHA * x + acc[i];
        T[(size_t)row * DM + n] = t; XB[(size_t)row * DM + n] = (bf16)f2bf(t); if (shiftout) shiftout[(size_t)row * DM + n] = x;
        float s = t, q = t * t;
#pragma unroll
        for (int o = 1; o < 32; o <<= 1) { s += __shfl_xor(s, o); q += __shfl_xor(q, o); }
        if (r32 == 0) { ostat[((size_t)row * 32 + u) * 2] = s; ostat[((size_t)row * 32 + u) * 2 + 1] = q; } }
    LDS_WAIT();
}
DI void dec_unit_up(const DecP& D, int u, LAS float* red, LAS float* sc, int wave, int lane) {
    const int r32 = lane & 31, hi = lane >> 5, n = 32 * u + r32;
    const f32x16 acc = dec_gemm((const bf16*)(D.dec + DEC_XB1), D.wup + (size_t)(32 * u) * DM, DM, red, wave, lane);
    if (wave != 0) return;
    dec_row_stats((const float*)(D.dec + DEC_ST1), sc, lane);
    const float c1 = D.c1up[n], c2 = D.c2up[n]; bf16* HB = (bf16*)(D.dec + DEC_HB);
#pragma unroll
    for (int i = 0; i < 16; ++i) { const int row = crow(i, hi); const float v = fmaxf((acc[i] - sc[2 * row] * c1) * sc[2 * row + 1] + c2, 0.f); HB[(size_t)row * FFD + n] = (bf16)f2bf(v * v); }
    LDS_WAIT();
}
DI void dec_attn_task(const DecP& D, const float* ck, const float* cv, const float* rope, int bd, int h, int p, int lane) {
    const int g = lane >> 4, dq = lane & 15, dd = 1 << (2 * p);
    const float* PD = (const float*)(D.dec + DEC_PD) + (size_t)bd * NIN;
    const f32x4 rr0 = *(const f32x4*)(rope + ((size_t)8192 * 32 + ((4 * dq) & 31)) * 2), rr1 = *(const f32x4*)(rope + ((size_t)8192 * 32 + ((4 * dq) & 31)) * 2 + 4);
    const f32x4 cs = {rr0[0], rr0[2], rr1[0], rr1[2]}, sn = {rr0[1], rr0[3], rr1[1], rr1[3]};
    const float sgn = dq < 8 ? -1.f : 1.f;
    f32x4 q = *(const f32x4*)(PD + h * 64 + 4 * dq), kn = *(const f32x4*)(PD + 512 + h * 64 + 4 * dq); const f32x4 vn = *(const f32x4*)(PD + 1024 + h * 64 + 4 * dq);
    { f32x4 qp, kp;
#pragma unroll
      for (int e = 0; e < 4; ++e) { qp[e] = __shfl_xor(q[e], 8); kp[e] = __shfl_xor(kn[e], 8); }
      q = q * cs + qp * sn * sgn; kn = kn * cs + kp * sn * sgn; }
    if (p == 0 && g == 0) { *(f32x4*)(D.out + O_KS + ((size_t)D.l * MD + bd) * 512 + h * 64 + 4 * dq) = kn; *(f32x4*)(D.out + O_VS + ((size_t)D.l * MD + bd) * 512 + h * 64 + 4 * dq) = vn; }
    float s0 = (q[0] * kn[0] + q[1] * kn[1]) + (q[2] * kn[2] + q[3] * kn[3]);
#pragma unroll
    for (int o = 1; o < 16; o <<= 1) s0 += __shfl_xor(s0, o);
    s0 *= 0.125f;
    const size_t cbase = (((size_t)D.l * MD + bd) * 2048) * 512 + h * 64 + 4 * dq;
    float mx = -INFINITY, den = 0.f; f32x4 o4 = {0.f, 0.f, 0.f, 0.f};
#pragma unroll 8
    for (int it = 0; it < 32; ++it) { const int j = 1 + 4 * it + g; const size_t off = cbase + (size_t)(2048 - j * dd) * 512;
        const f32x4 kr = ldf4nt(ck + off); const f32x4 vr = ldf4nt(cv + off);
        float s = (q[0] * kr[0] + q[1] * kr[1]) + (q[2] * kr[2] + q[3] * kr[3]);
#pragma unroll
        for (int o = 1; o < 16; o <<= 1) s += __shfl_xor(s, o);
        s *= 0.125f;
        const float mn = fmaxf(mx, s), sc = fexp(mx - mn), pj = fexp(s - mn);
        den = den * sc + pj; o4 = o4 * sc + vr * pj; mx = mn; }
    float mg = fmaxf(mx, __shfl_xor(mx, 16)); mg = fmaxf(mg, __shfl_xor(mg, 32)); mg = fmaxf(mg, s0);
    { const float sc = fexp(mx - mg); den *= sc; o4 = o4 * sc; }
    den += __shfl_xor(den, 16); den += __shfl_xor(den, 32);
#pragma unroll
    for (int e = 0; e < 4; ++e) { o4[e] += __shfl_xor(o4[e], 16); o4[e] += __shfl_xor(o4[e], 32); }
    const float p0 = fexp(s0 - mg); den += p0; o4 = (o4 + vn * p0) * (1.0f / den); mx = mg;
    if (g == 0) *(f32x4*)((float*)(D.dec + DEC_OP) + ((size_t)p * MD + bd) * 512 + h * 64 + 4 * dq) = o4;
    if (lane == 0) ((float*)(D.dec + DEC_LSE))[((size_t)p * MD + bd) * 8 + h] = mx + __logf(den);
}
DI void dec_rwkv_task(const DecP& D, const float* const* in, int bd, int h, LAS float* sv  , int lane) {
    const int l = D.l, ch = h * 64 + lane;
    const float* PD = (const float*)(D.dec + DEC_PD) + (size_t)bd * NIN + RW0; const float* PS = (const float*)(D.dec + DEC_PS) + (size_t)bd * NRWU;
    const float* mu = in[8] + (size_t)l * 1792;
    auto zf = [&](int col) { const float pr = PD[col], pv = PS[col]; return pr + (pv - pr) * mu[col]; };
    const float zr = zf(ch), zk = zf(512 + ch), zv0 = zf(1024 + ch);
    float vl = 0.f; if (l > 0 && lane < 32) { const float pr = PD[1792 + lane], pv = PS[1792 + lane]; vl = pr + (pv - pr) * in[9][(size_t)(l - 1) * 32 + lane]; }
    sv[lane] = ftanh(zf(1536 + lane)); sv[64 + lane] = zf(1600 + lane); sv[128 + lane] = fsigmoid(zf(1664 + lane)); sv[192 + lane] = fsigmoid(zf(1728 + lane)); sv[256 + lane] = vl;
    LDS_WAIT();
    float dw = 0.f, da = 0.f, dv = 0.f, gt = 0.f;
    const float* du = in[11] + (size_t)l * 64 * 512 + ch; const float* iu = in[13] + (size_t)l * 64 * 512 + ch; const float* gu = in[14] + (size_t)l * 128 * 512 + ch;
#pragma unroll 2
    for (int m4 = 0; m4 < 16; ++m4) { const f32x4 a = *(const LAS f32x4*)(sv + 4 * m4), b = *(const LAS f32x4*)(sv + 64 + 4 * m4), c = *(const LAS f32x4*)(sv + 128 + 4 * m4), d = *(const LAS f32x4*)(sv + 192 + 4 * m4);
#pragma unroll
        for (int e = 0; e < 4; ++e) { const int m = 4 * m4 + e; dw += a[e] * du[(size_t)m * 512]; da += b[e] * iu[(size_t)m * 512]; gt += c[e] * gu[(size_t)m * 512] + d[e] * gu[(size_t)(64 + m) * 512]; } }
    if (l > 0) { const float* vu = in[16] + (size_t)(l - 1) * 32 * 512 + ch;
#pragma unroll
        for (int m4 = 0; m4 < 8; ++m4) { const f32x4 a = *(const LAS f32x4*)(sv + 256 + 4 * m4);
#pragma unroll
            for (int e = 0; e < 4; ++e) dv += a[e] * vu[(size_t)(4 * m4 + e) * 512]; } }
    const float w = -fsoftplus(-(in[10][(size_t)l * 512 + ch] + dw)) - 0.5f, decay = fexp(-fexp(w));
    const float a = fsigmoid(in[12][(size_t)l * 512 + ch] + da);
    float* VFD = (float*)(D.dec + DEC_VF) + (size_t)bd * 512 + ch;
    float v = zv0; if (l == 0) *VFD = zv0; else v = zv0 + (*VFD - zv0) * fsigmoid(in[15][(size_t)(l - 1) * 512 + ch] + dv);
    const float kr = zk * in[17][(size_t)l * 512 + ch]; const float kn = kr / fmaxf(sqrtf(wave_sum(kr * kr)), 1e-12f);
    const float k2 = zk * (1.f + (a - 1.f) * in[18][(size_t)l * 512 + ch]);
    const float bon = wave_sum(zr * k2 * in[19][(size_t)l * 512 + ch]);
    LDS_WAIT();
    sv[320 + lane] = -kn; sv[384 + lane] = decay; sv[448 + lane] = kn * a; sv[512 + lane] = k2; sv[576 + lane] = zr; sv[640 + lane] = v;
    LDS_WAIT();
    const float* S0 = in[3] + (((size_t)l * MD + bd) * NH + h) * 4096;
    float* So = D.out + O_WKS + (((size_t)l * MD + bd) * NH + h) * 4096;
    { const int rr = lane >> 4, cq = lane & 15;
      const f32x4 a4 = *(const LAS f32x4*)(sv + 320 + 4 * cq), w4 = *(const LAS f32x4*)(sv + 384 + 4 * cq), b4 = *(const LAS f32x4*)(sv + 448 + 4 * cq), k4 = *(const LAS f32x4*)(sv + 512 + 4 * cq), r4 = *(const LAS f32x4*)(sv + 576 + 4 * cq);
      f32x4 Sr[16];
#pragma unroll
      for (int q = 0; q < 16; ++q) Sr[q] = *(const f32x4*)(S0 + (size_t)(4 * q + rr) * 64 + 4 * cq);
#pragma unroll
      for (int q = 0; q < 16; ++q) { const int i = 4 * q + rr;
          float sa = (Sr[q][0] * a4[0] + Sr[q][1] * a4[1]) + (Sr[q][2] * a4[2] + Sr[q][3] * a4[3]);
#pragma unroll
          for (int o = 1; o < 16; o <<= 1) sa += __shfl_xor(sa, o);
          const float vi = sv[640 + i];
          const f32x4 s4 = Sr[q] * w4 + b4 * sa + k4 * vi; *(f32x4*)(So + (size_t)i * 64 + 4 * cq) = s4;
          float yp = (s4[0] * r4[0] + s4[1] * r4[1]) + (s4[2] * r4[2] + s4[3] * r4[3]);
#pragma unroll
          for (int o = 1; o < 16; o <<= 1) yp += __shfl_xor(yp, o);
          if (cq == 0) sv[704 + i] = yp; } }
    LDS_WAIT();
    const float y = sv[704 + lane];
    const float mean = wave_sum(y) * (1.f / 64.f), dy = y - mean, var = wave_sum(dy * dy) * (1.f / 64.f);
    const float o = (dy * (1.0f / sqrtf(var + GN_EPS)) * in[20][(size_t)l * 512 + ch] + in[21][(size_t)l * 512 + ch] + bon * v) * gt;
    ((float*)(D.dec + DEC_MIX))[(size_t)bd * DM + 512 + ch] = o;
    LDS_WAIT();
}
DI void dec_finalize_row(const DecP& D, const float* gain, int bd, int lane) {
    const int h = lane >> 3; const float* L = (const float*)(D.dec + DEC_LSE); const float* OPD = (const float*)(D.dec + DEC_OP);
    const float l0 = L[((size_t)0 * MD + bd) * 8 + h], l1 = L[((size_t)1 * MD + bd) * 8 + h], l2 = L[((size_t)2 * MD + bd) * 8 + h];
    const float mx = fmaxf(l0, fmaxf(l1, l2)); float w0 = fexp(l0 - mx), w1 = fexp(l1 - mx), w2 = fexp(l2 - mx); const float inv = 1.0f / (w0 + w1 + w2); w0 *= inv; w1 *= inv; w2 *= inv;
    float v[8]; float ss = 0.f;
#pragma unroll
    for (int e = 0; e < 8; ++e) { v[e] = w0 * OPD[((size_t)0 * MD + bd) * 512 + lane * 8 + e] + w1 * OPD[((size_t)1 * MD + bd) * 512 + lane * 8 + e] + w2 * OPD[((size_t)2 * MD + bd) * 512 + lane * 8 + e]; ss += v[e] * v[e]; }
    ss = wave_sum(ss); const float rinv = 1.0f / sqrtf(ss * (1.f / 512.f) + RMS_EPS);
    bf16* MB = (bf16*)(D.dec + DEC_MIXB) + (size_t)bd * DM; const float* MX = (const float*)(D.dec + DEC_MIX) + (size_t)bd * DM + 512;
#pragma unroll
    for (int e = 0; e < 8; ++e) { MB[lane * 8 + e] = (bf16)f2bf(v[e] * rinv * gain[lane * 8 + e]); MB[512 + lane * 8 + e] = (bf16)f2bf(MX[lane * 8 + e]); }
}
#ifndef PH_MASK
#define PH_MASK 0x1ff
#endif
#define PH_ON(k) ((PH_MASK >> (k)) & 1)
#ifndef PH_DUP
#define PH_DUP 0
#endif
#define PH_REP(k) for (int rep_ = 0; rep_ < (((PH_DUP >> (k)) & 1) ? 2 : 1); ++rep_)
DI unsigned lds_task_next(volatile LAS unsigned* ctr, int lane) {
    unsigned t = 0; if (lane == 0) t = __hip_atomic_fetch_add((LAS unsigned*)ctr, 1u, __ATOMIC_RELAXED, __HIP_MEMORY_SCOPE_WORKGROUP);
    return (unsigned)__builtin_amdgcn_readfirstlane((int)t);
}
DI DecP make_dec(unsigned char* ws, const float* const* in, float* out, int l) {
    DecP D; D.dec = ws + WS_DEC; D.l = l; D.xs = in[1];
    D.c1in = (const float*)(ws + WS_C1IN) + l * NIN; D.c2in = (const float*)(ws + WS_C2IN) + l * NIN; D.c1up = (const float*)(ws + WS_C1UP) + l * FFD; D.c2up = (const float*)(ws + WS_C2UP) + l * FFD;
    D.g1 = in[24] + (size_t)l * DM; D.b1 = in[25] + (size_t)l * DM; D.g2p = l > 0 ? in[28] + (size_t)(l - 1) * DM : nullptr; D.b2p = l > 0 ? in[29] + (size_t)(l - 1) * DM : nullptr;
    D.win = (const bf16*)(ws + WS_WIN) + (size_t)l * NIN * DM; D.winu = (const bf16*)(ws + WS_WINU) + (size_t)l * NRWU * DM; D.wout = (const bf16*)(ws + WS_WOUT) + (size_t)l * DM * DM;
    D.wup = (const bf16*)(ws + WS_WUP) + (size_t)l * FFD * DM; D.wdn = (const bf16*)(ws + WS_WDN) + (size_t)l * DM * FFD; D.out = out; return D;
}
DI RwkvP make_rwkv(unsigned char* ws, const float* const* in, int l) {
    RwkvP R; R.PR = (const bf16*)(ws + WS_PR); R.mu = in[8] + (size_t)l * 1792; R.muv = l > 0 ? in[9] + (size_t)(l - 1) * 32 : nullptr;
    R.dbase = in[10] + (size_t)l * 512; R.ibase = in[12] + (size_t)l * 512; R.vbase = l > 0 ? in[15] + (size_t)(l - 1) * 512 : nullptr; R.ksk = in[17] + (size_t)l * 512; R.ksa = in[18] + (size_t)l * 512; R.brk = in[19] + (size_t)l * 512;
    R.gng = in[20] + (size_t)l * 512; R.gnb = in[21] + (size_t)l * 512;
    R.dupT = (const bf16*)(ws + WS_DUPT) + (size_t)l * 512 * 64; R.iupT = (const bf16*)(ws + WS_IUPT) + (size_t)l * 512 * 64; R.vupT = l > 0 ? (const bf16*)(ws + WS_VUPT) + (size_t)(l - 1) * 512 * 32 : nullptr; R.gupT = (const bf16*)(ws + WS_GUPT) + (size_t)l * 512 * 128;
    R.ZROW = (const bf16*)(ws + WS_CTL + 512 * 1024); R.VF = (bf16*)(ws + WS_VF); R.VV = (bf16*)(ws + WS_VV); R.BON = (float*)(ws + WS_BON); R.GC = (float*)(ws + WS_GC); R.W1S = (bf16*)(ws + WS_PT); R.REFF = (bf16*)(ws + WS_REFF); R.BM = (bf16*)(ws + WS_QT); R.REC = (v4u*)(ws + WS_YLOC);
    R.YPRE = (float*)(ws + WS_YPRE); R.MIX = (bf16*)(ws + WS_MIX); R.layer0 = (l == 0); return R;
}
#define PHASE_VARS() int tid_p = (int)threadIdx.x; asm volatile("" : "+v"(tid_p)); const int lane = tid_p & 63; const int wave = __builtin_amdgcn_readfirstlane(tid_p >> 6); \
    unsigned zo_p; asm volatile("s_mov_b32 %0, 0" : "=s"(zo_p)); unsigned char* ws = args.ws + zo_p; const float* const* in = args.in + zo_p; float* out = args.out + zo_p; \
    const int gw = F.vcu * NWAVES + wave; const int rgw = (F.G - 1 - (int)blockIdx.x) * NWAVES + wave; LAS float* dsc = (LAS float*)(L3 + 65536); LAS float* dred = (LAS float*)L3; const int rwg = F.G - 1 - (int)blockIdx.x; (void)gw; (void)rgw; (void)dsc; (void)dred; (void)rwg; (void)lane; (void)in; (void)out
__global__ void __launch_bounds__(NWAVES * 64, 2) mega_fwd(Args args) {
    extern __shared__ __attribute__((aligned(16))) unsigned char lds[];
    Frame F;
    F.lds = lds; F.MISC = (volatile LAS unsigned*)((LAS unsigned char*)lds + MISC_OFF);
    F.tid = threadIdx.x; F.lane = F.tid & 63; F.wave = __builtin_amdgcn_readfirstlane(F.tid >> 6);
    F.G = gridDim.x; { const int bx = blockIdx.x; F.vcu = (F.G % 8 == 0) ? (bx % 8) * (F.G / 8) + bx / 8 : bx; }
    F.gw = F.vcu * NWAVES + F.wave; F.NGW = F.G * NWAVES;
    F.in = args.in; F.out = args.out; F.ws = args.ws; F.ctl = (gu32*)(args.ws + WS_CTL);
    LAS unsigned char* L3 = (LAS unsigned char*)lds;
    for (int u = F.tid; u < (LDS_BYTES - RING_BYTES) / 4; u += NWAVES * 64) ((LAS unsigned*)(L3 + RING_BYTES))[u] = 0u;
    __syncthreads();
    XcdBarrier bar = xcd_barrier_post((unsigned*)(F.ctl + CW_BAR), F.MISC + 8);
#define GRID_BAR() do { XcdBarrier b2_ = bar; asm volatile("" : "+s"(b2_.x)); xcd_barrier(b2_); } while (0)

    PH_REP(0) { if (PH_ON(0)) p0_prologue(F);
    GRID_BAR(); }

    for (int l = 0; l < DEPTH; ++l) {
        PH_REP(1) {
        if (PH_ON(1))
        {   PHASE_VARS(); const DecP D = make_dec(ws, in, out, l);
            pg8::Gemm g{(const pg8::bf16_t*)(ws + WS_XB2), (const pg8::bf16_t*)D.win, M, NIN, DM}; pg8::StaticOrder S; S.init(M, NIN, F.G, (int)blockIdx.x);
            pg8::etab_fill((PG8_LAS unsigned char*)L3, S, (const float*)(ws + WS_STAT2), D.c1in, D.c2in, l > 0, tid_p); __syncthreads();
            pg8::EpiIn E{ws, out, l, (const PG8_LAS unsigned char*)L3};
            pg8::gemm_phase<pg8::EpiIn, pg8::StaticOrder, true, true>((PG8_LAS unsigned char*)L3, g, S, E, tid_p);
            if (rwg < 128) for (int u = rwg; u < 162; u += 128) dec_unit_in(D, u, dred, dsc, wave, lane);
        }
        GRID_BAR();
        }

#define ATT_QUEUE() do { LAS unsigned char* wl_ = L3 + wave * 10240; const int bh_ = F.vcu >> 4, span_ = F.vcu & 15; \
        for (;;) { const unsigned t_ = lds_task_next(F.MISC, lane); if (t_ >= 48u) break; \
            if (t_ >= 48u) { const int dt_ = (int)blockIdx.x * 4 + (int)(t_ - 48u); \
                if (dt_ < 768) dec_attn_task(D, in[4], in[5], (const float*)(ws + WS_ROPE), dt_ / 24, (dt_ % 24) / 3, dt_ % 3, lane); \
                else dec_rwkv_task(D, in, (dt_ - 768) >> 3, (dt_ - 768) & 7, (LAS float*)wl_, lane); continue; } \
            const int p_ = (int)t_ >> 4, idx_ = (int)t_ & 15; \
            const int cls_ = p_ == 0 ? 0 : p_ == 1 ? (idx_ >> 2) : idx_, qblk_ = p_ == 0 ? span_ * 16 + idx_ : p_ == 1 ? span_ * 4 + (idx_ & 3) : span_; \
            attn_task((const bf16*)(ws + WS_QB), (const bf16*)(ws + WS_KB), (const bf16*)(ws + WS_VB), (bf16*)(ws + WS_OP), (float*)(ws + WS_LSE), bh_ >> 3, bh_ & 7, p_, cls_, qblk_, wl_, lane); } } while (0)
        PH_REP(3) {
        if (PH_ON(3))
        {   PHASE_VARS(); const DecP D = make_dec(ws, in, out, l); const RwkvP R = make_rwkv(ws, in, l);
            if (tid_p == 0) F.MISC[0] = 0u;
            if (l == 0) colsum_finish(ws, gw * 64 + lane, F.NGW * 64);
            { LAS unsigned char* wl1 = L3 + wave * 12288; LAS unsigned char* hc = L3 + 8 * 12288;
              head_cache_fill(R, (F.vcu >> 4) & 7, hc, tid_p);
              __syncthreads();
#pragma unroll 1
              for (int i = 0; i < 4; ++i) rwkv_b1_unit(R, F.vcu * 32 + wave + 8 * i, wl1, hc, (LAS float*)(L3 + GCT_OFF), lane); }
            VM_WAIT(); __syncthreads();
            if (wave < 4) { chain_pass1(R, (float*)(ws + WS_SEGQ), (float*)(ws + WS_SEGP), F.vcu >> 4, F.vcu & 15, wave, (const LAS float*)(L3 + GCT_OFF), lane);
                const int dt = (int)blockIdx.x * 4 + wave;
                if (dt < 768) dec_attn_task(D, in[4], in[5], (const float*)(ws + WS_ROPE), dt / 24, (dt % 24) / 3, dt % 3, lane);
                else dec_rwkv_task(D, in, (dt - 768) >> 3, (dt - 768) & 7, (LAS float*)(L3 + wave * 10240), lane); }
            ATT_QUEUE();
            if ((PH_DUP >> 12) & 1) { __syncthreads(); if (tid_p == 0) F.MISC[0] = 0u; __syncthreads(); ATT_QUEUE(); }
        }
        GRID_BAR();
        }
        PH_REP(9) {
        if (PH_ON(3))
        {   PHASE_VARS(); const DecP D = make_dec(ws, in, out, l); const RwkvP R = make_rwkv(ws, in, l);
            const int seq = F.vcu >> 4, sg = F.vcu & 15;
            LAS unsigned char* gcache = L3 + 98304; gate_cache_fill(R, seq & 7, gcache, tid_p);
            for (int e = tid_p; e < SEGCH * 64; e += NWAVES * 64) ((LAS float*)(L3 + GCT_OFF))[e] = R.GC[(size_t)(seq * NCH + sg * SEGCH) * 64 + e];
            __syncthreads();
            if (wave < 4) chain_pass23(R, (const float*)(ws + WS_SEGQ), (const float*)(ws + WS_SEGP), seq, sg, wave, out + O_WKP + ((size_t)l * 16 + seq) * 4096, (const LAS float*)(L3 + GCT_OFF), lane);
            else { for (int i = 0; i < 16; ++i) attn_finalize_row((const bf16*)(ws + WS_OP), (const float*)(ws + WS_LSE), in[22] + (size_t)l * 512, (bf16*)(ws + WS_MIX), (int)blockIdx.x * 64 + (wave - 4) * 16 + i, lane);
                if (blockIdx.x < MD && wave == 4) dec_finalize_row(D, in[22] + (size_t)l * 512, (int)blockIdx.x, lane); }
            VM_WAIT(); __syncthreads();
#pragma unroll 1
            for (int i = 0; i < 4; ++i) rwkv_b3_unit(R, seq * NCH + sg * SEGCH + wave + 8 * i, gcache, L3 + wave * 12288, lane);
        }
        GRID_BAR();
        }

        PH_REP(5) {
        if (PH_ON(5))
        {   PHASE_VARS(); const DecP D = make_dec(ws, in, out, l);
            pg8::Gemm g{(const pg8::bf16_t*)(ws + WS_MIX), (const pg8::bf16_t*)D.wout, M, DM, DM}; pg8::StaticOrder S; S.init(M, DM, F.G, (int)blockIdx.x);
            pg8::EpiRes<false> E{ws, in, out, l};
            pg8::gemm_phase<pg8::EpiRes<false>, pg8::StaticOrder, false, true>((PG8_LAS unsigned char*)L3, g, S, E, tid_p);
            for (int u = rwg; u < 32; u += F.G)
                dec_unit_res((const bf16*)(D.dec + DEC_MIXB), D.wout, DM, u, l == 0, l == 0 ? D.xs : (const float*)(D.dec + DEC_T2), (const float*)(D.dec + DEC_ST2), D.g2p, D.b2p, (float*)(D.dec + DEC_T1), (bf16*)(D.dec + DEC_XB1), (float*)(D.dec + DEC_ST1),
                             out + O_SHS + (size_t)l * MD * DM, dred, dsc, wave, lane);
        }
        GRID_BAR();
        }

        PH_REP(6) {
        if (PH_ON(6))
        {   PHASE_VARS(); const DecP D = make_dec(ws, in, out, l);
            pg8::Gemm g{(const pg8::bf16_t*)(ws + WS_XB1), (const pg8::bf16_t*)D.wup, M, FFD, DM}; pg8::StaticOrder S; S.init(M, FFD, F.G, (int)blockIdx.x);
            pg8::etab_fill((PG8_LAS unsigned char*)L3, S, (const float*)(ws + WS_STAT1), D.c1up, D.c2up, true, tid_p); __syncthreads();
            pg8::EpiUp E{ws, (const PG8_LAS unsigned char*)L3};
            pg8::gemm_phase<pg8::EpiUp, pg8::StaticOrder, true, true>((PG8_LAS unsigned char*)L3, g, S, E, tid_p);
            for (int u = rwg; u < 128; u += F.G) dec_unit_up(D, u, dred, dsc, wave, lane);
        }
        GRID_BAR();
        }

        PH_REP(7) {
        if (PH_ON(7))
        {   PHASE_VARS(); const DecP D = make_dec(ws, in, out, l);
            pg8::Gemm g{(const pg8::bf16_t*)(ws + WS_H), (const pg8::bf16_t*)D.wdn, M, DM, FFD}; pg8::StaticOrder S; S.init(M, DM, F.G, (int)blockIdx.x);
            pg8::EpiRes<true> E{ws, in, out, l};
            PH_REP(11) { pg8::gemm_phase<pg8::EpiRes<true>, pg8::StaticOrder, false, true>((PG8_LAS unsigned char*)L3, g, S, E, tid_p); }
            PH_REP(10) for (int u = rwg; u < 32; u += F.G)
                dec_unit_res((const bf16*)(D.dec + DEC_HB), D.wdn, FFD, u, false, (const float*)(D.dec + DEC_T1), (const float*)(D.dec + DEC_ST1), D.g1, D.b1, (float*)(D.dec + DEC_T2), (bf16*)(D.dec + DEC_XB2), (float*)(D.dec + DEC_ST2), nullptr, dred, dsc, wave, lane);
        }
        GRID_BAR();
        }
    }
    if (PH_ON(8))
    {   PHASE_VARS(); const float* g = in[28] + (size_t)3 * DM; const float* b = in[29] + (size_t)3 * DM;
        for (int r = gw; r < M; r += F.NGW) { float mu, rs; pg8::row_stats((const float*)(ws + WS_STAT2), r, mu, rs);
            const v2u* t = (const v2u*)((const bf16*)(ws + WS_XB2) + (size_t)r * DM) + lane; f32x4* o = (f32x4*)(out + O_Y + (size_t)r * DM) + lane;
#pragma unroll
            for (int j = 0; j < 4; ++j) { const f32x4 gg = *((const f32x4*)g + lane + 64 * j), bb = *((const f32x4*)b + lane + 64 * j); const v2u w = t[64 * j]; const f32x4 tv = {bflo(w.x), bfhi(w.x), bflo(w.y), bfhi(w.y)}; o[64 * j] = (tv - mu) * rs * gg + bb; } }
        if (rgw < MD) { LAS float* fsc = dsc + wave * 64; dec_row_stats((const float*)(ws + WS_DEC + DEC_ST2), fsc, lane); const float mu = fsc[2 * rgw], rs = fsc[2 * rgw + 1];
            const f32x4* t = (const f32x4*)((const float*)(ws + WS_DEC + DEC_T2) + (size_t)rgw * DM) + lane; f32x4* o = (f32x4*)(out + O_YS + (size_t)rgw * DM) + lane;
#pragma unroll
            for (int j = 0; j < 4; ++j) { const f32x4 gg = *((const f32x4*)g + lane + 64 * j), bb = *((const f32x4*)b + lane + 64 * j); o[64 * j] = (t[64 * j] - mu) * rs * gg + bb; } }
    }
}

extern "C" void kernel_launch(void* const* d_in, const int* in_sizes, int n_in, void* d_out, int out_size, void* d_ws, size_t ws_size, hipStream_t stream) {
    static int grid = 0;
    if (grid == 0) {
        if (n_in != 30 || out_size != (int)O_END || ws_size < WS_END) { fprintf(stderr, "kernel_launch: unexpected problem (n_in %d, out %d, ws %zu); nothing launched\n", n_in, out_size, ws_size); grid = -1; return; }
        int dev = 0, cus = 0, per_cu = 0;
        if (hipGetDevice(&dev) != hipSuccess || hipDeviceGetAttribute(&cus, hipDeviceAttributeMultiprocessorCount, dev) != hipSuccess) { fprintf(stderr, "kernel_launch: device query failed\n"); grid = -1; return; }
        if (hipFuncSetAttribute((const void*)mega_fwd, hipFuncAttributeMaxDynamicSharedMemorySize, LDS_BYTES) != hipSuccess) { fprintf(stderr, "kernel_launch: hipFuncSetAttribute failed\n"); grid = -1; return; }
        if (hipOccupancyMaxActiveBlocksPerMultiprocessor(&per_cu, (const void*)mega_fwd, NWAVES * 64, LDS_BYTES) != hipSuccess || per_cu < 1) fprintf(stderr, "kernel_launch: occupancy query reports %d\n", per_cu);
        (void)hipGetLastError();
        if (cus < 256) { fprintf(stderr, "kernel_launch: needs 256 CUs (found %d)\n", cus); grid = -1; return; }
        grid = 256;
    }
    if (grid < 0) return;
    if (hipMemsetAsync((char*)d_ws + WS_CTL, 0, CTL_ZERO_BYTES, stream) != hipSuccess) { fprintf(stderr, "kernel_launch: memset failed\n"); return; }
    Args a{};
    for (int i = 0; i < 30; ++i) a.in[i] = (const float*)d_in[i];
    a.out = (float*)d_out; a.ws = (unsigned char*)d_ws;
    hipLaunchKernelGGL(mega_fwd, dim3(grid), dim3(NWAVES * 64), LDS_BYTES, stream, a);
    const hipError_t le = hipPeekAtLastError();
    if (le != hipSuccess) fprintf(stderr, "kernel_launch: launch failed: %s\n", hipGetErrorName(le));
}
```

```cpp
#include <hip/hip_runtime.h>
#include <cstdio>
#include <cstdint>
#include <cmath>
namespace pg8 {
#define PG8_LAS __attribute__((address_space(3)))
typedef unsigned short bf16_t;
typedef short bf16x8 __attribute__((ext_vector_type(8)));
typedef float f32x4 __attribute__((ext_vector_type(4)));
typedef unsigned u32x4 __attribute__((ext_vector_type(4)));
constexpr int BM = 256, BK = 64, HALF = 128, HTB = HALF * BK * 2  , STAGE_BYTES = 8 * HTB, NXCD = 8, WGM = 8;

__host__ __device__ __forceinline__ int lds_byte(int r, int c) { const int st = (r >> 4) * 2 + (c >> 5), rr = r & 15, cc = c & 31, ob = rr * 64 + cc * 2; return st * 1024 + (ob ^ (((ob >> 9) & 1) << 5)); }
__host__ __device__ __forceinline__ void stage_rc(int b, int& R, int& C) { const int st = b / 1024, sb = b % 1024, swz = sb ^ (((sb >> 9) & 1) << 5); R = (st >> 1) * 16 + swz / 64; C = (st & 1) * 32 + (swz % 64) / 2; }
__host__ __device__ __forceinline__ int perm32(int rho) { const int n = rho >> 4, i = rho & 15; return 8 * (i >> 2) + 4 * n + (i & 3); }

struct Unit { int pm, pn; };
struct Gemm { const bf16_t* A; const bf16_t* Bt; int M, N, K; };

struct StaticOrder {
    int nM, nN, nwg, G, c;
    __host__ __device__ void init(int M, int N, int G_, int c_) { nM = M / BM; nN = N / BM; nwg = nM * nN; G = G_; c = c_; }
    __host__ __device__ bool next(int i, Unit& u) const {
        const long L = (long)i * G + c; if (L >= nwg) return false;
        int wgid = (int)L; { const int q = nwg / NXCD, r = nwg % NXCD, xcd = wgid % NXCD, off = wgid / NXCD; wgid = (xcd < r ? xcd * (q + 1) : r * (q + 1) + (xcd - r) * q) + off; }
        const int nig = WGM * nN, gid = wgid / nig, fm = gid * WGM, gsz = (nM - fm) < WGM ? (nM - fm) : WGM;
        u.pm = fm + ((wgid % nig) % gsz); u.pn = (wgid % nig) / gsz; return true;
    }
    __device__ __forceinline__ void a_ready(const Unit&) const {}
    __device__ __forceinline__ void done(const Unit&) const {}
};

__device__ __forceinline__ unsigned cvt_pk_bf16(float lo, float hi) { unsigned r; asm volatile("v_cvt_pk_bf16_f32 %0, %1, %2" : "=v"(r) : "v"(lo), "v"(hi)); return r; }
typedef float f32x2 __attribute__((ext_vector_type(2)));
constexpr size_t WSO_C1IN = 1u << 20, WSO_C2IN = WSO_C1IN + 4 * 3584 * 4, WSO_C1UP = WSO_C2IN + 4 * 3584 * 4, WSO_C2UP = WSO_C1UP + 4 * 4096 * 4, WSO_ROPE = 3u << 20, WSO_STAT1 = 8u << 20, WSO_STAT2 = 9u << 20;
constexpr size_t WSO_XB2 = 132ull << 20, WSO_XB1 = 164ull << 20, WSO_T1 = 196ull << 20, WSO_T2 = 260ull << 20, WSO_QB = 324ull << 20, WSO_KB = 340ull << 20, WSO_VB = 356ull << 20, WSO_PR = 372ull << 20, WSO_H = 580ull << 20;
constexpr size_t OO_SHP = 16809984, OO_KP = 21405696, OO_VP = 29794304;
__device__ __forceinline__ void row_stats(const float* stat, int row, float& mu, float& rs) {
    const f32x4 a = *(const f32x4*)(stat + (size_t)row * 8), b = *(const f32x4*)(stat + (size_t)row * 8 + 4);
    const float s = (a[0] + a[2]) + (b[0] + b[2]), q = (a[1] + a[3]) + (b[1] + b[3]);
    mu = s * (1.f / 1024.f); const float var = fmaxf(q * (1.f / 1024.f) - mu * mu, 0.f); rs = 1.0f / sqrtf(var + 1e-5f);
}
typedef float f32x2e __attribute__((ext_vector_type(2)));
typedef unsigned u32x2e __attribute__((ext_vector_type(2)));
constexpr int ETAB_OFF = 132096, ETAB_SLOT = 4096;
constexpr int ETAB_IDS = ETAB_OFF + 4 * ETAB_SLOT;
template <class Sched> __device__ __forceinline__ void etab_fill(PG8_LAS unsigned char* lds0, const Sched& S, const float* stat, const float* c1, const float* c2, bool fold, int tid) {
#pragma unroll 1
    for (int i = 0; i < 4; ++i) { Unit u; const bool ok = S.next(i, u);
        if (tid == 0) { ((PG8_LAS int*)(lds0 + ETAB_IDS))[2 * i] = ok ? u.pm : -1; ((PG8_LAS int*)(lds0 + ETAB_IDS))[2 * i + 1] = ok ? u.pn : -1; }
        if (!ok) continue;
        PG8_LAS unsigned char* slot = lds0 + ETAB_OFF + i * ETAB_SLOT;
        if (tid < 256) { float mu = 0.f, rs = 1.f; if (fold) row_stats(stat, u.pm * BM + tid, mu, rs); ((PG8_LAS f32x2e*)slot)[tid] = (f32x2e){mu, rs}; }
        else { const int c = u.pn * BM + tid - 256; ((PG8_LAS float*)(slot + 2048))[tid - 256] = fold ? c1[c] : 0.f; ((PG8_LAS float*)(slot + 3072))[tid - 256] = fold ? c2[c] : 0.f; }
    }
}
__device__ __forceinline__ const PG8_LAS unsigned char* etab_find(const PG8_LAS unsigned char* lds0, const Unit& u) {
    const PG8_LAS int* ids = (const PG8_LAS int*)(lds0 + ETAB_IDS); int s = 0;
#pragma unroll
    for (int i = 1; i < 4; ++i) if (ids[2 * i] == u.pm && ids[2 * i + 1] == u.pn) s = i;
    return lds0 + ETAB_OFF + s * ETAB_SLOT;
}
struct EpiIn {
    static constexpr bool PERM = true, AFTER_DRAIN = false;
    unsigned char* ws; float* out; int l; const PG8_LAS unsigned char* lds0;
    __device__ __forceinline__ void operator()(const f32x4 (&acc)[2][2][4][2], const Unit& u, int wr, int wc, int fr, int fq) const {
        asm volatile("" ::: "memory"); __builtin_amdgcn_sched_barrier(0);
        const PG8_LAS unsigned char* slot = etab_find(lds0, u);
        const PG8_LAS f32x2e* st = (const PG8_LAS f32x2e*)slot; const PG8_LAS float* tc1 = (const PG8_LAS float*)(slot + 2048); const PG8_LAS float* tc2 = (const PG8_LAS float*)(slot + 3072);
        bf16_t* QB = (bf16_t*)(ws + WSO_QB); bf16_t* KB = (bf16_t*)(ws + WSO_KB); bf16_t* VB = (bf16_t*)(ws + WSO_VB); bf16_t* PR = (bf16_t*)(ws + WSO_PR); const float* rope = (const float*)(ws + WSO_ROPE);
        float* outk = out + OO_KP + (size_t)l * 2 * 2048 * 512; float* outv = out + OO_VP + (size_t)l * 2 * 2048 * 512; const float qscale = 0.125f * 1.4426950408889634f;
        const int cb = u.pn * BM + wc * 32 + 8 * fq;
        const int i0 = 16 * (wc & 1) + 4 * fq; const bool roped = u.pn < 4;
        const int rbase = u.pm * BM + wr * 64 + fr;
        const int cl = wc * 32 + 8 * fq;
#pragma unroll
        for (int bj = 0; bj < 2; ++bj) {
            f32x4 c1v[2], c2v[2];
#pragma unroll
            for (int n = 0; n < 2; ++n) { c1v[n] = *(const PG8_LAS f32x4*)(tc1 + cl + bj * HALF + n * 4); c2v[n] = *(const PG8_LAS f32x4*)(tc2 + cl + bj * HALF + n * 4); }
            f32x4 ran = {0.f, 0.f, 0.f, 0.f}, rbn = ran;
#pragma unroll
            for (int gq = 0; gq < 8; ++gq) {
                const int ai = gq >> 2, m = gq & 3;
                const int r = rbase + ai * HALF + m * 16;
                const f32x2e ms = st[ai * HALF + wr * 64 + m * 16 + fr]; const float mu = ms.x, rs = ms.y;
                if (gq == 0 && roped) { const float* rp = rope + ((size_t)(r & 8191) * 32 + i0) * 2; ran = *(const f32x4*)rp; rbn = *(const f32x4*)(rp + 4); }
                const f32x4 ra = ran, rb = rbn;
                if (roped && gq < 7) { const int rn = rbase + ((gq + 1) >> 2) * HALF + ((gq + 1) & 3) * 16; const float* rp = rope + ((size_t)(rn & 8191) * 32 + i0) * 2; ran = *(const f32x4*)rp; rbn = *(const f32x4*)(rp + 4); }
                asm volatile("" ::: "memory");
                f32x4 v[2];
#pragma unroll
                for (int n = 0; n < 2; ++n) v[n] = (acc[ai][bj][m][n] - mu * c1v[n]) * rs + c2v[n];
                const int pos = r & 8191, b = r >> 13;
                if (roped) {
                    const f32x4 cs = {ra[0], ra[2], rb[0], rb[2]}, sn = {ra[1], ra[3], rb[1], rb[3]};
                    const int head = (u.pn & 1) * 4 + bj * 2 + (wc >> 1);
                    f32x4 y1 = v[0] * cs - v[1] * sn, y2 = v[0] * sn + v[1] * cs;
                    const size_t o = (size_t)r * 512 + head * 64 + i0;
                    if (u.pn < 2) { y1 = y1 * qscale; y2 = y2 * qscale;
                        u32x2e w; w.x = cvt_pk_bf16(y1[0], y1[1]); w.y = cvt_pk_bf16(y1[2], y1[3]); *(u32x2e*)(QB + o) = w;
                        w.x = cvt_pk_bf16(y2[0], y2[1]); w.y = cvt_pk_bf16(y2[2], y2[3]); *(u32x2e*)(QB + o + 32) = w;
                    } else {
                        u32x2e w; w.x = cvt_pk_bf16(y1[0], y1[1]); w.y = cvt_pk_bf16(y1[2], y1[3]); *(u32x2e*)(KB + o) = w;
                        w.x = cvt_pk_bf16(y2[0], y2[1]); w.y = cvt_pk_bf16(y2[2], y2[3]); *(u32x2e*)(KB + o + 32) = w;
                        if (pos >= 6144) { float* ok = outk + ((size_t)(b * 2048 + pos - 6144)) * 512 + head * 64 + i0; *(f32x4*)ok = y1; *(f32x4*)(ok + 32) = y2; }
                    }
                } else if (u.pn < 6) {
                    const int c = cb + bj * HALF - 1024;
                    u32x4 w; w.x = cvt_pk_bf16(v[0][0], v[0][1]); w.y = cvt_pk_bf16(v[0][2], v[0][3]); w.z = cvt_pk_bf16(v[1][0], v[1][1]); w.w = cvt_pk_bf16(v[1][2], v[1][3]); *(u32x4*)(VB + (size_t)r * 512 + c) = w;
                    if (pos >= 6144) { float* ov = outv + ((size_t)(b * 2048 + pos - 6144)) * 512 + c; *(f32x4*)ov = v[0]; *(f32x4*)(ov + 4) = v[1]; }
                } else {
                    const int c = cb + bj * HALF - 1536;
                    if (c < 1824) { u32x4 w; w.x = cvt_pk_bf16(v[0][0], v[0][1]); w.y = cvt_pk_bf16(v[0][2], v[0][3]); w.z = cvt_pk_bf16(v[1][0], v[1][1]); w.w = cvt_pk_bf16(v[1][2], v[1][3]); *(u32x4*)(PR + (size_t)r * 2048 + c) = w; }
                }
            }
        }
    }
};
template <bool IS_F> struct EpiRes {
    static constexpr bool PERM = true, AFTER_DRAIN = true;
    unsigned char* ws; const float* const* in; float* out; int l;
    __device__ __forceinline__ void fused(f32x4 (&acc)[2][2][4][2], const Unit& u, int wr, int wc, int fr, int fq, PG8_LAS unsigned char* lds, int wid, int lane) const {
        const int raw = (!IS_F && l == 0) ? 1 : 0;
        const bf16_t* src = (const bf16_t*)(ws + (IS_F ? WSO_XB1 : WSO_XB2));
        const float* sstat = (const float*)(ws + (IS_F ? WSO_STAT1 : WSO_STAT2));
        const float* g = IS_F ? in[24] + (size_t)l * 1024 : in[28] + (size_t)(l > 0 ? l - 1 : 0) * 1024; const float* b = IS_F ? in[25] + (size_t)l * 1024 : in[29] + (size_t)(l > 0 ? l - 1 : 0) * 1024;
        bf16_t* XB = (bf16_t*)(ws + (IS_F ? WSO_XB2 : WSO_XB1)); float* ostat = (float*)(ws + (IS_F ? WSO_STAT2 : WSO_STAT1));
        float* shiftout = (IS_F || raw) ? nullptr : out + OO_SHP + (size_t)l * 2 * 1024; const float alpha = 1.6817928305074290f;
        PG8_LAS f32x2e* P = (PG8_LAS f32x2e*)lds;
        const int cb = u.pn * BM + wc * 32 + 8 * fq;
        const int rbase = u.pm * BM + wr * 64 + fr;
        u32x4 cur[2], nxt[2]; f32x4 sa = {0.f, 0.f, 0.f, 0.f}, sb = sa, san = sa, sbn = sa;
#pragma unroll
        for (int bj = 0; bj < 2; ++bj) { cur[bj] = *(const u32x4*)(src + (size_t)rbase * 1024 + cb + bj * HALF); nxt[bj] = cur[bj]; }
        if (!raw) { sa = *(const f32x4*)(sstat + (size_t)rbase * 8); sb = *(const f32x4*)(sstat + (size_t)rbase * 8 + 4); }
#pragma unroll
        for (int gq = 0; gq < 8; ++gq) {
            const int ai = gq >> 2, m = gq & 3;
            const int r = rbase + ai * HALF + m * 16;
            if (gq < 7) { const int rn = rbase + ((gq + 1) >> 2) * HALF + ((gq + 1) & 3) * 16;
#pragma unroll
                for (int bj = 0; bj < 2; ++bj) nxt[bj] = *(const u32x4*)(src + (size_t)rn * 1024 + cb + bj * HALF);
                if (!raw) { san = *(const f32x4*)(sstat + (size_t)rn * 8); sbn = *(const f32x4*)(sstat + (size_t)rn * 8 + 4); } }
            asm volatile("" ::: "memory");
            float mu = 0.f, rs = 1.f;
            if (!raw) { const float ssum = (sa[0] + sa[2]) + (sb[0] + sb[2]), qsum = (sa[1] + sa[3]) + (sb[1] + sb[3]); mu = ssum * (1.f / 1024.f); rs = 1.0f / sqrtf(fmaxf(qsum * (1.f / 1024.f) - mu * mu, 0.f) + 1e-5f); }
            float s = 0.f, q = 0.f;
#pragma unroll
            for (int bj = 0; bj < 2; ++bj) { const int c = cb + bj * HALF; const size_t off = (size_t)r * 1024 + c; const u32x4 cw = cur[bj]; u32x4 wout;
#pragma unroll
                for (int n = 0; n < 2; ++n) {
                    const f32x4 gvv = raw ? (f32x4){1.f, 1.f, 1.f, 1.f} : *(const f32x4*)(g + c + 4 * n), bvv = raw ? (f32x4){0.f, 0.f, 0.f, 0.f} : *(const f32x4*)(b + c + 4 * n);
                    const unsigned w0 = n ? cw.z : cw.x, w1 = n ? cw.w : cw.y;
                    const f32x4 cf = {__builtin_bit_cast(float, w0 << 16), __builtin_bit_cast(float, w0 & 0xffff0000u), __builtin_bit_cast(float, w1 << 16), __builtin_bit_cast(float, w1 & 0xffff0000u)};
                    const f32x4 x = (cf - mu) * rs * gvv + bvv;
                    const f32x4 t = x * alpha + acc[ai][bj][m][n];
                    const unsigned p0 = cvt_pk_bf16(t[0], t[1]), p1 = cvt_pk_bf16(t[2], t[3]); if (n) { wout.z = p0; wout.w = p1; } else { wout.x = p0; wout.y = p1; }
                    s += (t[0] + t[1]) + (t[2] + t[3]); q += (t[0] * t[0] + t[1] * t[1]) + (t[2] * t[2] + t[3] * t[3]);
                    if (shiftout && (r & 8191) == 8191) *(f32x4*)(shiftout + (size_t)(r >> 13) * 1024 + c + 4 * n) = x; }
                *(u32x4*)(XB + off) = wout; }
            s += __shfl_xor(s, 16); s += __shfl_xor(s, 32); q += __shfl_xor(q, 16); q += __shfl_xor(q, 32);
            if (fq == 0) P[(ai * HALF + wr * 64 + m * 16 + fr) * 4 + wc] = (f32x2e){s, q};
#pragma unroll
            for (int bj = 0; bj < 2; ++bj) cur[bj] = nxt[bj];
            sa = san; sb = sbn;
        }
        asm volatile("s_waitcnt lgkmcnt(0)" ::: "memory"); __builtin_amdgcn_s_barrier(); asm volatile("" ::: "memory");
        if (threadIdx.x < 256) { const int row = threadIdx.x; const f32x2e a = P[row * 4 + 0], b2 = P[row * 4 + 1], c = P[row * 4 + 2], d = P[row * 4 + 3];
            *(f32x2e*)(ostat + (size_t)(u.pm * BM + row) * 8 + u.pn * 2) = (f32x2e){(a.x + b2.x) + (c.x + d.x), (a.y + b2.y) + (c.y + d.y)}; }
        asm volatile("s_waitcnt lgkmcnt(0)" ::: "memory"); __builtin_amdgcn_s_barrier(); asm volatile("" ::: "memory");
    }
};
struct EpiUp {
    static constexpr bool PERM = true, AFTER_DRAIN = false;
    unsigned char* ws; const PG8_LAS unsigned char* lds0;
    __device__ __forceinline__ void operator()(const f32x4 (&acc)[2][2][4][2], const Unit& u, int wr, int wc, int fr, int fq) const {
        asm volatile("" ::: "memory"); __builtin_amdgcn_sched_barrier(0);
        bf16_t* H = (bf16_t*)(ws + WSO_H);
        const PG8_LAS unsigned char* slot = etab_find(lds0, u);
        const PG8_LAS f32x2e* st = (const PG8_LAS f32x2e*)slot; const PG8_LAS float* tc1 = (const PG8_LAS float*)(slot + 2048); const PG8_LAS float* tc2 = (const PG8_LAS float*)(slot + 3072);
        const int cb = u.pn * BM + wc * 32 + 8 * fq, cl = wc * 32 + 8 * fq;
#pragma unroll
        for (int bj = 0; bj < 2; ++bj) {
            f32x4 c1v[2], c2v[2];
#pragma unroll
            for (int n = 0; n < 2; ++n) { c1v[n] = *(const PG8_LAS f32x4*)(tc1 + cl + bj * HALF + 4 * n); c2v[n] = *(const PG8_LAS f32x4*)(tc2 + cl + bj * HALF + 4 * n); }
#pragma unroll
            for (int ai = 0; ai < 2; ++ai) {
#pragma unroll
                for (int m = 0; m < 4; ++m) {
                    const int rl = ai * HALF + wr * 64 + m * 16 + fr, r = u.pm * BM + rl;
                    const f32x2e ms = st[rl]; const float mu = ms.x, rs = ms.y;
                    f32x4 v0 = (acc[ai][bj][m][0] - mu * c1v[0]) * rs + c2v[0], v1 = (acc[ai][bj][m][1] - mu * c1v[1]) * rs + c2v[1];
#pragma unroll
                    for (int e = 0; e < 4; ++e) { const float a = fmaxf(v0[e], 0.f), b = fmaxf(v1[e], 0.f); v0[e] = a * a; v1[e] = b * b; }
                    u32x4 w; w.x = cvt_pk_bf16(v0[0], v0[1]); w.y = cvt_pk_bf16(v0[2], v0[3]); w.z = cvt_pk_bf16(v1[0], v1[1]); w.w = cvt_pk_bf16(v1[2], v1[3]);
                    *(u32x4*)(H + (size_t)r * 4096 + cb + bj * HALF) = w; }
            }
        }
    }
};
template <class Epi, class Sched, bool ALIGN_EPI = false, bool SP2 = false>
__device__ __forceinline__ void gemm_phase(PG8_LAS unsigned char* lds, const Gemm g, const Sched& S, const Epi& E, const int tid) {
    const int wid = __builtin_amdgcn_readfirstlane(tid >> 6), lane = tid & 63, wr = wid >> 2, wc = wid & 3, fr = lane & 15, fq = lane >> 4;
    const int K = g.K, nt = K / BK;
    unsigned voffA[2], voffB[2];
#pragma unroll
    for (int i = 0; i < 2; ++i) { int R, C; stage_rc(tid * 16 + i * 8192, R, C); const int Rb = Epi::PERM ? ((R & ~31) + perm32(R & 31)) : R;
        voffA[i] = (unsigned)(R * K + C) * 2u; voffB[i] = (unsigned)(Rb * K + C) * 2u; }
    const size_t kstep = (size_t)(BK * 2);
    const size_t hstep = (size_t)HALF * K * 2;
    const size_t tstep = 2 * hstep;
    const unsigned ldsw = (unsigned)wid * 1024u;
    const int aoff = lds_byte(wr * 64 + fr, fq * 8), boff = lds_byte(wc * 32 + fr, fq * 8);
#define PG8_SA(b, h) (((b) * 2 + (h)) * HTB)
#define PG8_SB(b, h) ((4 + (b) * 2 + (h)) * HTB)
#define PG8_STAGE(bufoff, gbase, voff) do { _Pragma("unroll") for (int _i = 0; _i < 2; ++_i) \
        __builtin_amdgcn_global_load_lds((const unsigned*)((const char*)(gbase) + (voff)[_i]), (PG8_LAS unsigned*)(lds + (bufoff) + ldsw + _i * 8192), 16, 0, 0); } while (0)
#define PG8_LDA(dst, b, h) do { _Pragma("unroll") for (int m = 0; m < 4; ++m) _Pragma("unroll") for (int k = 0; k < 2; ++k) dst[m][k] = *(const PG8_LAS bf16x8*)(lds + PG8_SA(b, h) + aoff + m * 2048 + k * 1024); } while (0)
#define PG8_LDB(dst, b, h) do { _Pragma("unroll") for (int n = 0; n < 2; ++n) _Pragma("unroll") for (int k = 0; k < 2; ++k) dst[n][k] = *(const PG8_LAS bf16x8*)(lds + PG8_SB(b, h) + boff + n * 2048 + k * 1024); } while (0)
#define PG8_MMA(ai, bj, At, Bt) do { __builtin_amdgcn_s_setprio(1); _Pragma("unroll") for (int m = 0; m < 4; ++m) _Pragma("unroll") for (int n = 0; n < 2; ++n) _Pragma("unroll") for (int k = 0; k < 2; ++k) \
        acc[ai][bj][m][n] = __builtin_amdgcn_mfma_f32_16x16x32_bf16(Bt[n][k], At[m][k], acc[ai][bj][m][n], 0, 0, 0); __builtin_amdgcn_s_setprio(0); } while (0)
#define PG8_WAIT_V(n) asm volatile("s_waitcnt vmcnt(" #n ")" ::: "memory")
#define PG8_WAIT_L(n) asm volatile("s_waitcnt lgkmcnt(" #n ")" ::: "memory")
#define PG8_BAR __builtin_amdgcn_s_barrier()
#define PG8_SCHED __builtin_amdgcn_sched_barrier(0)
    Unit cur, nxt; int ui = 0;
    if (!S.next(0, cur)) return;
    f32x4 acc[2][2][4][2];
#pragma unroll
    for (int a = 0; a < 2; ++a)
#pragma unroll
        for (int b = 0; b < 2; ++b)
#pragma unroll
            for (int m = 0; m < 4; ++m)
#pragma unroll
                for (int n = 0; n < 2; ++n) acc[a][b][m][n] = (f32x4){0.f, 0.f, 0.f, 0.f};
    bf16x8 At[4][2], B0[2][2], B1[2][2];
    const char* cA = (const char*)g.A + (size_t)cur.pm * tstep; const char* cB = (const char*)g.Bt + (size_t)cur.pn * tstep;
    S.a_ready(cur);
    if constexpr (SP2) {
        PG8_STAGE(PG8_SB(0, 0), cB, voffB); PG8_STAGE(PG8_SB(0, 1), cB + hstep, voffB); PG8_STAGE(PG8_SA(0, 0), cA, voffA); PG8_STAGE(PG8_SA(0, 1), cA + hstep, voffA);
        if (wr == 1) PG8_BAR;
        PG8_WAIT_V(2); PG8_BAR;
        PG8_STAGE(PG8_SB(1, 0), cB + kstep, voffB); PG8_STAGE(PG8_SA(1, 0), cA + kstep, voffA); PG8_STAGE(PG8_SB(1, 1), cB + hstep + kstep, voffB);
        PG8_WAIT_V(6); PG8_BAR;
    } else {
        PG8_STAGE(PG8_SB(0, 0), cB, voffB); PG8_STAGE(PG8_SA(0, 0), cA, voffA); PG8_STAGE(PG8_SB(0, 1), cB + hstep, voffB); PG8_STAGE(PG8_SA(0, 1), cA + hstep, voffA);
        if (wr == 1) PG8_BAR;
        PG8_WAIT_V(4); PG8_BAR;
        PG8_STAGE(PG8_SB(1, 0), cB + kstep, voffB); PG8_STAGE(PG8_SA(1, 0), cA + kstep, voffA); PG8_STAGE(PG8_SB(1, 1), cB + hstep + kstep, voffB);
        PG8_WAIT_V(6); PG8_BAR;
    }
    for (;;) {
        const bool has_next = S.next(ui + 1, nxt);
        const char* nA = has_next ? (const char*)g.A + (size_t)nxt.pm * tstep : cA; const char* nB = has_next ? (const char*)g.Bt + (size_t)nxt.pn * tstep : cB;
        for (int t = 0; t < nt; t += 2) {
            const bool last = (t == nt - 2);
            const char* a1 = cA + (size_t)(t + 1) * kstep;
            const char* a2 = last ? nA : cA + (size_t)(t + 2) * kstep; const char* b2 = last ? nB : cB + (size_t)(t + 2) * kstep;
            const char* a3 = a2 + kstep; const char* b3 = b2 + kstep;
            if (last && has_next) S.a_ready(nxt);
            if constexpr (SP2) {
            PG8_LDB(B0, 0, 0); PG8_LDB(B1, 0, 1); PG8_SCHED; PG8_LDA(At, 0, 0); PG8_STAGE(PG8_SA(1, 1), a1 + hstep, voffA);
            PG8_WAIT_V(8); PG8_WAIT_L(0); PG8_BAR; PG8_MMA(0, 0, At, B0); PG8_MMA(0, 1, At, B1); PG8_BAR; PG8_SCHED;
            PG8_LDA(At, 0, 1); PG8_STAGE(PG8_SB(0, 0), b2, voffB); PG8_STAGE(PG8_SB(0, 1), b2 + hstep, voffB); PG8_STAGE(PG8_SA(0, 0), a2, voffA);
            PG8_WAIT_V(8); PG8_WAIT_L(0); PG8_BAR; PG8_MMA(1, 0, At, B0); PG8_MMA(1, 1, At, B1); PG8_BAR; PG8_SCHED;
            PG8_LDB(B0, 1, 0); PG8_LDB(B1, 1, 1); PG8_SCHED; PG8_LDA(At, 1, 0); PG8_STAGE(PG8_SA(0, 1), a2 + hstep, voffA);
            PG8_WAIT_V(8); PG8_WAIT_L(0); PG8_BAR; PG8_MMA(0, 0, At, B0); PG8_MMA(0, 1, At, B1); PG8_BAR; PG8_SCHED;
            PG8_LDA(At, 1, 1); PG8_STAGE(PG8_SB(1, 0), b3, voffB); PG8_STAGE(PG8_SB(1, 1), b3 + hstep, voffB); PG8_STAGE(PG8_SA(1, 0), a3, voffA);
            PG8_WAIT_V(8); PG8_WAIT_L(0); PG8_BAR; PG8_MMA(1, 0, At, B0); PG8_MMA(1, 1, At, B1); PG8_BAR; PG8_SCHED;
            } else {
            PG8_LDB(B0, 0, 0); PG8_SCHED; PG8_LDA(At, 0, 0); PG8_STAGE(PG8_SA(1, 1), a1 + hstep, voffA);
            PG8_WAIT_L(8); PG8_BAR; PG8_WAIT_L(0); PG8_MMA(0, 0, At, B0); PG8_BAR; PG8_SCHED;
            PG8_LDB(B1, 0, 1); PG8_STAGE(PG8_SB(0, 0), b2, voffB);
            PG8_BAR; PG8_WAIT_L(0); PG8_MMA(0, 1, At, B1); PG8_BAR;
            PG8_LDA(At, 0, 1); PG8_STAGE(PG8_SA(0, 0), a2, voffA);
            PG8_BAR; PG8_WAIT_L(0); PG8_MMA(1, 0, At, B0); PG8_BAR; PG8_SCHED;
            PG8_STAGE(PG8_SB(0, 1), b2 + hstep, voffB);
            PG8_WAIT_V(6); PG8_BAR; PG8_MMA(1, 1, At, B1); PG8_BAR;
            PG8_LDB(B0, 1, 0); PG8_SCHED; PG8_LDA(At, 1, 0); PG8_STAGE(PG8_SA(0, 1), a2 + hstep, voffA);
            PG8_WAIT_L(8); PG8_BAR; PG8_WAIT_L(0); PG8_MMA(0, 0, At, B0); PG8_BAR; PG8_SCHED;
            PG8_LDB(B1, 1, 1); PG8_STAGE(PG8_SB(1, 0), b3, voffB);
            PG8_BAR; PG8_WAIT_L(0); PG8_MMA(0, 1, At, B1); PG8_BAR;
            PG8_LDA(At, 1, 1); PG8_STAGE(PG8_SA(1, 0), a3, voffA);
            PG8_BAR; PG8_WAIT_L(0); PG8_MMA(1, 0, At, B0); PG8_BAR; PG8_SCHED;
            PG8_STAGE(PG8_SB(1, 1), b3 + hstep, voffB);
            PG8_WAIT_V(6); PG8_BAR; PG8_MMA(1, 1, At, B1); PG8_BAR;
            }
        }
        if constexpr (ALIGN_EPI) { if (wr == 0) PG8_BAR; }
        if constexpr (!Epi::AFTER_DRAIN) { E(acc, cur, wr, wc, fr, fq); S.done(cur); }
        if (!has_next) break;
#pragma unroll
        for (int a = 0; a < 2; ++a)
#pragma unroll
            for (int b = 0; b < 2; ++b)
#pragma unroll
                for (int m = 0; m < 4; ++m)
#pragma unroll
                    for (int n = 0; n < 2; ++n) acc[a][b][m][n] = (f32x4){0.f, 0.f, 0.f, 0.f};
        cur = nxt; cA = nA; cB = nB; ++ui;
        if constexpr (ALIGN_EPI) { if (wr == 1) PG8_BAR; }
    }
    PG8_WAIT_V(0);
    if constexpr (!ALIGN_EPI) { if (wr == 0) PG8_BAR; }
    PG8_BAR;
    if constexpr (Epi::AFTER_DRAIN) { E.fused(acc, cur, wr, wc, fr, fq, lds, wid, lane); S.done(cur); }
#undef PG8_SA
#undef PG8_SB
#undef PG8_STAGE
#undef PG8_LDA
#undef PG8_LDB
#undef PG8_MMA
#undef PG8_WAIT_V
#undef PG8_WAIT_L
#undef PG8_BAR
#undef PG8_SCHED
}
}
constexpr int NWAVES = 8;
constexpr int M = 16384, TSEQ = 8192, DM = 1024, FFD = 4096, DEPTH = 4, MD = 32, NH = 8, HD = 64;
constexpr int NIN = 3584;
constexpr int RW0 = 1536;
constexpr int PRP = 2048;
constexpr int NRWU = 1856;
constexpr int CH = 16, NCH = TSEQ / CH;
constexpr int NUNIT = 2 * NH * NCH;
constexpr float LN_EPS = 1e-5f, GN_EPS = 64e-5f, RMS_EPS = 1e-6f;
constexpr float ALPHA = 1.6817928305074290f;
constexpr float QSCALE = 0.125f * 1.4426950408889634f;
constexpr size_t O_Y = 0, O_YS = 16777216, O_SHP = 16809984, O_SHS = 16818176, O_WKP = 16949248, O_WKS = 17211392,
                 O_KP = 21405696, O_VP = 29794304, O_KS = 38182912, O_VS = 38248448, O_END = 38313984;
constexpr size_t MiB = 1u << 20;
constexpr size_t WS_CTL = 0, CTL_ZERO_BYTES = 1 * MiB;
constexpr size_t WS_C1IN = 1 * MiB;
constexpr size_t WS_C2IN = WS_C1IN + 4 * NIN * 4;
constexpr size_t WS_C1UP = WS_C2IN + 4 * NIN * 4;
constexpr size_t WS_C2UP = WS_C1UP + 4 * FFD * 4;
constexpr size_t WS_DUPT = WS_C2UP + 4 * FFD * 4;
constexpr size_t WS_IUPT = WS_DUPT + 4 * 512 * 64 * 2;
constexpr size_t WS_GUPT = WS_IUPT + 4 * 512 * 64 * 2;
constexpr size_t WS_VUPT = WS_GUPT + 4 * 512 * 128 * 2;
constexpr size_t WS_SMALL_END = WS_VUPT + 3 * 512 * 32 * 2;
static_assert(WS_SMALL_END <= 3 * MiB, "small region");
constexpr size_t WS_ROPE = 3 * MiB;
constexpr size_t WS_DEC = 6 * MiB;
constexpr size_t WS_STAT1 = 8 * MiB, WS_STAT2 = 9 * MiB;
constexpr size_t WS_BON = 10 * MiB;
constexpr size_t WS_LSE = 11 * MiB;
constexpr size_t WS_GC = 13 * MiB;
constexpr size_t WS_WIN = 16 * MiB;
constexpr size_t WS_WINU = 44 * MiB;
constexpr size_t WS_WOUT = 60 * MiB;
constexpr size_t WS_WUP = 68 * MiB;
constexpr size_t WS_WDN = 100 * MiB;
constexpr size_t WS_XB2 = 132 * MiB;
constexpr size_t WS_XB1 = 164 * MiB;
constexpr size_t WS_T1 = 196 * MiB;
constexpr size_t WS_T2 = 260 * MiB;
constexpr size_t WS_QB = 324 * MiB, WS_KB = 340 * MiB, WS_VB = 356 * MiB;
constexpr size_t WS_PR = 372 * MiB;
constexpr size_t WS_OP = 436 * MiB;
constexpr size_t WS_MIX = 484 * MiB;
constexpr size_t WS_VF = 516 * MiB, WS_VV = 532 * MiB;
constexpr size_t WS_YPRE = 548 * MiB;
constexpr size_t WS_H = 580 * MiB;
constexpr size_t WS_PT = 580 * MiB;
constexpr size_t WS_QT = 644 * MiB;
constexpr size_t WS_REFF = 708 * MiB;
constexpr size_t WS_YLOC = 724 * MiB;
constexpr size_t WS_SEGQ = 756 * MiB, WS_SEGP = 760 * MiB;
constexpr size_t WS_CSUM = 764 * MiB;
constexpr size_t WS_CSUP = 766 * MiB;
constexpr size_t WS_END = 768 * MiB;
static_assert(WS_H + (size_t)M * FFD * 2 <= WS_END + 0 * MiB || true, "");
constexpr size_t DEC_XB2 = 0;
constexpr size_t DEC_XB1 = 64 * 1024;
constexpr size_t DEC_SHB = 128 * 1024;
constexpr size_t DEC_MIXB = 384 * 1024;
constexpr size_t DEC_HB = 448 * 1024;
constexpr size_t DEC_T1 = 704 * 1024;
constexpr size_t DEC_T2 = 832 * 1024;
constexpr size_t DEC_PD = 960 * 1024;
constexpr size_t DEC_PS = 1408 * 1024;
constexpr size_t DEC_OP = 1640 * 1024;
constexpr size_t DEC_LSE = 1832 * 1024;
constexpr size_t DEC_MIX = 1836 * 1024;
constexpr size_t DEC_ST1 = 1964 * 1024;
constexpr size_t DEC_ST2 = 1972 * 1024;
constexpr size_t DEC_VF = 1980 * 1024;
static_assert(DEC_VF + 32 * 512 * 4 <= 2 * MiB, "decode scratch");
constexpr int CW_BAR = 4096;
constexpr int CW_POOL = 16384;
constexpr int RING_BYTES = 131072;
constexpr int MISC_OFF = RING_BYTES + 320;
constexpr int LDS_BYTES = 163840;
static_assert(pg8::WSO_C1IN == WS_C1IN && pg8::WSO_C2IN == WS_C2IN && pg8::WSO_C1UP == WS_C1UP && pg8::WSO_C2UP == WS_C2UP && pg8::WSO_ROPE == WS_ROPE && pg8::WSO_STAT1 == WS_STAT1 && pg8::WSO_STAT2 == WS_STAT2 &&
              pg8::WSO_XB2 == WS_XB2 && pg8::WSO_XB1 == WS_XB1 && pg8::WSO_T1 == WS_T1 && pg8::WSO_T2 == WS_T2 && pg8::WSO_QB == WS_QB && pg8::WSO_KB == WS_KB && pg8::WSO_VB == WS_VB && pg8::WSO_PR == WS_PR && pg8::WSO_H == WS_H &&
              pg8::OO_SHP == O_SHP && pg8::OO_KP == O_KP && pg8::OO_VP == O_VP, "epilogue offset mirrors");
#define GAS __attribute__((address_space(1)))
#define LAS __attribute__((address_space(3)))
typedef unsigned short bf16;
typedef unsigned v4u __attribute__((ext_vector_type(4)));
typedef unsigned v2u __attribute__((ext_vector_type(2)));
typedef float f32x4 __attribute__((ext_vector_type(4)));
typedef float f32x2 __attribute__((ext_vector_type(2)));
typedef float f32x16 __attribute__((ext_vector_type(16)));
typedef short bf16x8 __attribute__((ext_vector_type(8)));
typedef short s16x4 __attribute__((ext_vector_type(4)));
typedef GAS unsigned gu32;
#define RLX_AGENT __ATOMIC_RELAXED, __HIP_MEMORY_SCOPE_AGENT
#define LDS_WAIT() asm volatile("s_waitcnt lgkmcnt(0)" ::: "memory")
#define VM_WAIT() asm volatile("s_waitcnt vmcnt(0)" ::: "memory")
#define DI __device__ __forceinline__
DI unsigned f2bf(float f) { unsigned u = __builtin_bit_cast(unsigned, f); return (u + 0x7fffu + ((u >> 16) & 1u)) >> 16; }
DI float bf2f(unsigned b) { return __builtin_bit_cast(float, b << 16); }
DI float bflo(unsigned w) { return __builtin_bit_cast(float, w << 16); }
DI float bfhi(unsigned w) { return __builtin_bit_cast(float, w & 0xffff0000u); }
typedef __bf16 bf16x2_t __attribute__((ext_vector_type(2)));
DI unsigned pk2(float lo, float hi) { const f32x2 v = {lo, hi}; const bf16x2_t b = __builtin_convertvector(v, bf16x2_t); return __builtin_bit_cast(unsigned, b); }
DI unsigned pk2z(float x) { return pk2(x, 0.f) & 0xffffu; }
DI float rbf(float x) { return bf2f(f2bf(x)); }
DI bf16x8 pk8(float a0, float a1, float a2, float a3, float a4, float a5, float a6, float a7) {
    v4u w; w.x = pk2(a0, a1); w.y = pk2(a2, a3); w.z = pk2(a4, a5); w.w = pk2(a6, a7); return __builtin_bit_cast(bf16x8, w); }
DI bf16x8 pk8v(f32x4 a, f32x4 b) { return pk8(a[0], a[1], a[2], a[3], b[0], b[1], b[2], b[3]); }
DI bf16x8 pk4z(f32x4 a) { v4u w; w.x = pk2(a[0], a[1]); w.y = pk2(a[2], a[3]); w.z = 0u; w.w = 0u; return __builtin_bit_cast(bf16x8, w); }
DI bf16x8 ld8(const void* p) { return *(const bf16x8*)p; }
DI bf16x8 ld8nt(const void* p) { return __builtin_nontemporal_load((const bf16x8*)p); }
DI v4u ldv4nt(const void* p) { return __builtin_nontemporal_load((const v4u*)p); }
DI f32x4 ldf4nt(const void* p) { return __builtin_nontemporal_load((const f32x4*)p); }
DI bf16x8 ld4z(const void* p) { v2u t = *(const v2u*)p; v4u w; w.x = t.x; w.y = t.y; w.z = 0u; w.w = 0u; return __builtin_bit_cast(bf16x8, w); }
DI f32x4 mfma16(bf16x8 a, bf16x8 b, f32x4 c) { return __builtin_amdgcn_mfma_f32_16x16x32_bf16(a, b, c, 0, 0, 0); }
DI f32x16 mfma32(bf16x8 a, bf16x8 b, f32x16 c) { return __builtin_amdgcn_mfma_f32_32x32x16_bf16(a, b, c, 0, 0, 0); }
DI int crow(int r, int hi) { return (r & 3) + 8 * (r >> 2) + 4 * hi; }
DI float wave_sum(float v) {
#pragma unroll
    for (int o = 1; o < 64; o <<= 1) v += __shfl_xor(v, o);
    return v; }
DI float fexp(float x) { return __expf(x); }
DI float fsigmoid(float x) { return __builtin_amdgcn_rcpf(1.f + __expf(-x)); }
DI float ftanh(float x) { return 1.f - 2.f * __builtin_amdgcn_rcpf(__expf(2.f * x) + 1.f); }
DI float fsoftplus(float x) { return fmaxf(x, 0.f) + __logf(1.f + __expf(-fabsf(x))); }
DI int orig2lgcl(int o) { return (o & ~63) | (((o >> 4) & 1) << 5) | (((o >> 2) & 3) << 3) | (((o >> 5) & 1) << 2) | (o & 3); }
DI int lgcl2orig(int c) { return (c & ~63) | (((c >> 2) & 1) << 5) | (((c >> 5) & 1) << 4) | (((c >> 3) & 3) << 2) | (c & 3); }
#define XB_TMO      128
#define XB_XCNT(j)  (256  + 64 * (j))
#define XB_XSUB(j)  (1280 + 64 * (j))
#define XB_XGEN(j)  (2304 + 64 * (j))
#define XB_TOP      3328
#define XB_TOPGEN   3392
#define XCD_BAR_WORDS 3456
#define XB_SPIN_CAP (1u << 18)

__device__ __forceinline__ unsigned xb_ld(unsigned* p)              { return __hip_atomic_load(p, __ATOMIC_RELAXED, __HIP_MEMORY_SCOPE_AGENT); }
__device__ __forceinline__ unsigned xb_add(unsigned* p, unsigned v) { return __hip_atomic_fetch_add(p, v, __ATOMIC_RELAXED, __HIP_MEMORY_SCOPE_AGENT); }
__device__ __forceinline__ unsigned xb_xcc_id() { return (unsigned)__builtin_amdgcn_s_getreg((3 << 11) | 20) & 0xFu; }
#define XB_SPIN(cond, bar) do { unsigned _sp = 0; while (cond) { __builtin_amdgcn_s_sleep(1); \
    if ((++_sp & 255u) == 0u) { if (xb_ld(&(bar)[XB_TMO])) break; if (_sp > XB_SPIN_CAP) { atomicAdd(&(bar)[XB_TMO], 1u); break; } } } } while (0)

struct XcdBarrier {
    unsigned* bar; unsigned x;
    volatile LAS unsigned* st;
};

__device__ __forceinline__ XcdBarrier xcd_barrier_post(unsigned* bar, volatile LAS unsigned* st) {
    XcdBarrier b; b.bar = bar; b.x = xb_xcc_id(); b.st = st;
    if (threadIdx.x == 0) (void)xb_add(&bar[XB_XCNT(b.x)], 1u);
    return b;
}
__device__ __forceinline__ void xcd_barrier_complete(unsigned* bar, unsigned x, unsigned& nloc, unsigned& nx) {
    const unsigned G = gridDim.x * gridDim.y * gridDim.z;
    unsigned sum, cnt, mine, sp = 0u;
    for (;;) {
        sum = 0u; cnt = 0u; mine = 0u;
#pragma unroll
        for (unsigned j = 0; j < 16; ++j) { const unsigned c = xb_ld(&bar[XB_XCNT(j)]); sum += c; cnt += (c > 0u) ? 1u : 0u; mine = (j == x) ? c : mine; }
        if (sum == G) break;
        __builtin_amdgcn_s_sleep(1);
        if ((++sp & 255u) == 0u) { if (xb_ld(&bar[XB_TMO])) break; if (sp > XB_SPIN_CAP) { atomicAdd(&bar[XB_TMO], 1u); break; } }
    }
    nloc = mine > 0u ? mine : 1u; nx = cnt > 0u ? cnt : 1u;
}

__device__ __forceinline__ void xcd_barrier(const XcdBarrier& b) {
    asm volatile("s_waitcnt vmcnt(0)" ::: "memory");
    __syncthreads();
    if (threadIdx.x == 0) {
        unsigned* bar = b.bar;
        __builtin_amdgcn_s_waitcnt(0);
        unsigned nloc = b.st[0], nx = b.st[1];
        if (nloc == 0u) { xcd_barrier_complete(bar, b.x, nloc, nx); b.st[0] = nloc; b.st[1] = nx; }
        const unsigned old = xb_add(&bar[XB_XSUB(b.x)], 1u);
        const unsigned gen = old / nloc;
        if (old + 1u == (gen + 1u) * nloc) {
            __builtin_amdgcn_fence(__ATOMIC_RELEASE, "agent");
            asm volatile("s_waitcnt vmcnt(0)" ::: "memory");
            const unsigned og = xb_add(&bar[XB_TOP], 1u);
            const unsigned tg = og / nx;
            if (og + 1u == (tg + 1u) * nx) xb_add(&bar[XB_TOPGEN], 1u);
            else XB_SPIN(xb_ld(&bar[XB_TOPGEN]) == tg, bar);
            __builtin_amdgcn_fence(__ATOMIC_ACQUIRE, "agent");
            xb_add(&bar[XB_XGEN(b.x)], 1u);
            asm volatile("s_waitcnt vmcnt(0)" ::: "memory");
        } else {
            XB_SPIN(xb_ld(&bar[XB_XGEN(b.x)]) == gen, bar);
            __builtin_amdgcn_fence(__ATOMIC_ACQUIRE, "agent");
            asm volatile("s_waitcnt vmcnt(0)" ::: "memory");
        }
    }
    __syncthreads();
}
struct Args { const float* in[30]; float* out; unsigned char* ws; };
struct Frame {
    unsigned char* lds;
    volatile LAS unsigned* MISC;
    gu32* ctl;
    int tid, lane, wave, vcu, G, gw, NGW;
    const float* const* in; float* out; unsigned char* ws;
};
template <bool SWAP>
DI void p0_transpose_item(const float* W, int ldw, int K, int csrc0, bf16* WT, int row_off, const float* gsc, LAS float* scr, int kb, int nb, int lane, float* csum = nullptr, int ncs = 0, const float* bsh = nullptr) {
    const int k0 = 64 * kb, n0 = 32 * nb;
    f32x4 wv[8]; float gk = 1.f, bk = 0.f;
    const int lr = lane >> 3, lc = (lane & 7) * 4;
#pragma unroll
    for (int i = 0; i < 8; ++i) wv[i] = ldf4nt(W + (size_t)(k0 + 8 * i + lr) * ldw + csrc0 + n0 + lc);
    if (gsc) gk = gsc[k0 + lane]; if (bsh) bk = bsh[k0 + lane];
    f32x4 s1v = {0.f, 0.f, 0.f, 0.f}, s2v = s1v;
#pragma unroll
    for (int i = 0; i < 8; ++i) { const int kk = 8 * i + lr; f32x4 v = wv[i]; s2v = s2v + v * __shfl(bk, kk); v = v * __shfl(gk, kk);
#pragma unroll
        for (int e = 0; e < 4; ++e) { s1v[e] += rbf(v[e]); scr[kk * 33 + lc + e] = v[e]; } }
#pragma unroll
    for (int o = 8; o < 64; o <<= 1) {
#pragma unroll
        for (int e = 0; e < 4; ++e) { s1v[e] += __shfl_xor(s1v[e], o); s2v[e] += __shfl_xor(s2v[e], o); } }
    if (csum && lane < 8) {
#pragma unroll
        for (int e = 0; e < 4; ++e) { int dr = n0 + 4 * lane + e; if (SWAP) dr = orig2lgcl(dr); csum[(size_t)(kb * 2 + 0) * ncs + row_off + dr] = s1v[e]; csum[(size_t)(kb * 2 + 1) * ncs + row_off + dr] = s2v[e]; } }
    LDS_WAIT(); asm volatile("" ::: "memory");
    const int c = lane & 7;
#pragma unroll
    for (int j = 0; j < 4; ++j) { const int n = (lane >> 3) + 8 * j; const LAS float* s = scr + (8 * c) * 33 + n;
        v4u o; o.x = pk2(s[0 * 33], s[1 * 33]); o.y = pk2(s[2 * 33], s[3 * 33]); o.z = pk2(s[4 * 33], s[5 * 33]); o.w = pk2(s[6 * 33], s[7 * 33]);
        int dr = n0 + n; if (SWAP) dr = orig2lgcl(dr);
        *(v4u*)(WT + (size_t)(row_off + dr) * K + k0 + 8 * c) = o; }
    LDS_WAIT(); asm volatile("" ::: "memory");
}
DI void p0_prologue(Frame& F) {
    LAS float* scr = (LAS float*)((LAS unsigned char*)F.lds + F.wave * 16384);
    const float* const* in = F.in; unsigned char* ws = F.ws;
    constexpr int I_IN = 16 * 104, I_VR = 16, I_INU = 16 * 56, I_OUT = 16 * 32, I_UP = 16 * 128, I_DN = 64 * 32;
    constexpr int I_L = I_IN + I_VR + I_INU + I_VR + I_OUT + I_UP + I_DN;
    for (int it = F.gw; it < DEPTH * I_L; it += F.NGW) {
        const int l = it / I_L; int r = it % I_L;
        const float* g2p = l > 0 ? in[28] + (size_t)(l - 1) * DM : nullptr;
        bf16* win = (bf16*)(ws + WS_WIN) + (size_t)l * NIN * DM; bf16* winu = (bf16*)(ws + WS_WINU) + (size_t)l * NRWU * DM;
        if (r < I_IN) { const int kb = r / 104, nb = r % 104; const float* W = in[6] + (size_t)l * DM * 3328;
            float* cs = l > 0 ? (float*)(ws + WS_CSUM) + (size_t)l * 32 * NIN : nullptr; const float* b2p = l > 0 ? in[29] + (size_t)(l - 1) * DM : nullptr;
            if (nb < 32) p0_transpose_item<true>(W, 3328, DM, 0, win, 0, g2p, scr, kb, nb, F.lane, cs, NIN, b2p); else p0_transpose_item<false>(W, 3328, DM, 0, win, 0, g2p, scr, kb, nb, F.lane, cs, NIN, b2p); continue; } r -= I_IN;
        if (r < I_VR) { if (l > 0) p0_transpose_item<false>(in[7] + (size_t)(l - 1) * DM * 32, 32, DM, 0, win, 3328, g2p, scr, r, 0, F.lane, (float*)(ws + WS_CSUM) + (size_t)l * 32 * NIN, NIN, in[29] + (size_t)(l - 1) * DM); continue; } r -= I_VR;
        if (r < I_INU) { const int kb = r / 56, nb = r % 56; p0_transpose_item<false>(in[6] + (size_t)l * DM * 3328, 3328, DM, RW0, winu, 0, nullptr, scr, kb, nb, F.lane); continue; } r -= I_INU;
        if (r < I_VR) { if (l > 0) p0_transpose_item<false>(in[7] + (size_t)(l - 1) * DM * 32, 32, DM, 0, winu, 1792, nullptr, scr, r, 0, F.lane); continue; } r -= I_VR;
        if (r < I_OUT) { p0_transpose_item<false>(in[23] + (size_t)l * DM * DM, DM, DM, 0, (bf16*)(ws + WS_WOUT) + (size_t)l * DM * DM, 0, nullptr, scr, r / 32, r % 32, F.lane); continue; } r -= I_OUT;
        if (r < I_UP) { p0_transpose_item<false>(in[26] + (size_t)l * DM * FFD, FFD, DM, 0, (bf16*)(ws + WS_WUP) + (size_t)l * FFD * DM, 0, in[24] + (size_t)l * DM, scr, r / 128, r % 128, F.lane, (float*)(ws + WS_CSUP) + (size_t)l * 32 * FFD, FFD, in[25] + (size_t)l * DM); continue; } r -= I_UP;
        p0_transpose_item<false>(in[27] + (size_t)l * FFD * DM, DM, FFD, 0, (bf16*)(ws + WS_WDN) + (size_t)l * DM * FFD, 0, nullptr, scr, r / 32, r % 32, F.lane);
    }
    for (int m0 = F.gw; m0 < M; m0 += 4 * F.NGW) { f32x4 v[4][4];
#pragma unroll
        for (int q = 0; q < 4; ++q) { const f32x4* xr = (const f32x4*)(in[0] + (size_t)(m0 + q * F.NGW) * DM) + F.lane;
#pragma unroll
            for (int j = 0; j < 4; ++j) v[q][j] = ldf4nt(xr + 64 * j); }
#pragma unroll
        for (int q = 0; q < 4; ++q) { unsigned long long* o8 = (unsigned long long*)((bf16*)(ws + WS_XB2) + (size_t)(m0 + q * F.NGW) * DM) + F.lane;
#pragma unroll
            for (int j = 0; j < 4; ++j) o8[64 * j] = (unsigned long long)pk2(v[q][j].x, v[q][j].y) | ((unsigned long long)pk2(v[q][j].z, v[q][j].w) << 32); } }
    const int gt = F.gw * 64 + F.lane, NGT = F.NGW * 64;
    for (int e = gt; e < 8193 * 32; e += NGT) { const int pos = e >> 5, i = e & 31; const double ang = (double)pos * pow(10000.0, -(double)i / 32.0); ((f32x2*)(ws + WS_ROPE))[e] = (f32x2){(float)cos(ang), (float)sin(ang)}; }
    for (int e = gt; e < 4 * 512 * 64; e += NGT) { const int l = e / (512 * 64), n = (e / 64) % 512, m = e % 64; ((bf16*)(ws + WS_DUPT))[e] = (bf16)f2bf(in[11][((size_t)l * 64 + m) * 512 + n]); ((bf16*)(ws + WS_IUPT))[e] = (bf16)f2bf(in[13][((size_t)l * 64 + m) * 512 + n]); }
    for (int e = gt; e < 4 * 512 * 128; e += NGT) { const int l = e / (512 * 128), n = (e / 128) % 512, m = e % 128; ((bf16*)(ws + WS_GUPT))[e] = (bf16)f2bf(in[14][((size_t)l * 128 + m) * 512 + n]); }
    for (int e = gt; e < 3 * 512 * 32; e += NGT) { const int l = e / (512 * 32), n = (e / 32) % 512, m = e % 32; ((bf16*)(ws + WS_VUPT))[e] = (bf16)f2bf(in[16][((size_t)l * 32 + m) * 512 + n]); }
    for (int e = gt; e < 2 * DM; e += NGT) F.out[O_SHP + e] = in[0][((size_t)(e / DM) * TSEQ + TSEQ - 1) * DM + (e % DM)];
    for (int e = gt; e < MD * DM; e += NGT) { ((bf16*)(ws + WS_DEC + DEC_XB2))[e] = (bf16)f2bf(in[1][e]); }
    for (int e = gt; e < DEPTH * MD * DM; e += NGT) { ((bf16*)(ws + WS_DEC + DEC_SHB))[e] = (bf16)f2bf(in[2][e]); }
}
DI void colsum_finish(unsigned char* ws, int gt, int NGT) {
    for (int e = gt; e < 3 * NIN; e += NGT) { const int l = 1 + e / NIN, p = e % NIN; if (p >= 3360) continue; const float* cs = (const float*)(ws + WS_CSUM) + (size_t)l * 32 * NIN + p; float s1 = 0.f, s2 = 0.f;
#pragma unroll
        for (int kb = 0; kb < 16; ++kb) { s1 += cs[(size_t)(2 * kb) * NIN]; s2 += cs[(size_t)(2 * kb + 1) * NIN]; }
        ((float*)(ws + WS_C1IN))[l * NIN + p] = s1; ((float*)(ws + WS_C2IN))[l * NIN + p] = s2; }
    for (int e = gt; e < 4 * FFD; e += NGT) { const int l = e / FFD, p = e % FFD; const float* cs = (const float*)(ws + WS_CSUP) + (size_t)l * 32 * FFD + p; float s1 = 0.f, s2 = 0.f;
#pragma unroll
        for (int kb = 0; kb < 16; ++kb) { s1 += cs[(size_t)(2 * kb) * FFD]; s2 += cs[(size_t)(2 * kb + 1) * FFD]; }
        ((float*)(ws + WS_C1UP))[l * FFD + p] = s1; ((float*)(ws + WS_C2UP))[l * FFD + p] = s2; }
}
constexpr int VPITCH = 144;
constexpr int ATT_WLDS = 2 * 32 * VPITCH + 256;
DI void tr_read8(unsigned base, s16x4 (&t)[8]) {
    asm volatile("ds_read_b64_tr_b16 %0, %8\n\tds_read_b64_tr_b16 %1, %8 offset:%c9\n\tds_read_b64_tr_b16 %2, %8 offset:%c10\n\tds_read_b64_tr_b16 %3, %8 offset:%c11\n\t"
                 "ds_read_b64_tr_b16 %4, %8 offset:%c12\n\tds_read_b64_tr_b16 %5, %8 offset:%c13\n\tds_read_b64_tr_b16 %6, %8 offset:%c14\n\tds_read_b64_tr_b16 %7, %8 offset:%c15\n\ts_waitcnt lgkmcnt(0)"
                 : "=&v"(t[0]), "=&v"(t[1]), "=&v"(t[2]), "=&v"(t[3]), "=&v"(t[4]), "=&v"(t[5]), "=&v"(t[6]), "=&v"(t[7])
                 : "v"(base), "i"(8 * VPITCH), "i"(64), "i"(8 * VPITCH + 64), "i"(16 * VPITCH), "i"(24 * VPITCH), "i"(16 * VPITCH + 64), "i"(24 * VPITCH + 64) : "memory");
}
DI void attn_task(const bf16* QB, const bf16* KB, const bf16* VB, bf16* OP, float* LSE, int b, int h, int p, int cls, int qblk, LAS unsigned char* wl, int lane) {
    asm volatile("" : "+v"(lane));
    const int dd = 1 << (2 * p), r32 = lane & 31, hi = lane >> 5;
    const int m0 = 32 * qblk;
    const size_t rowb = (size_t)b * TSEQ;
    const size_t qrow = rowb + (size_t)(m0 + r32) * dd + cls;
    bf16x8 qf[4];
#pragma unroll
    for (int d0 = 0; d0 < 4; ++d0) qf[d0] = ld8(QB + qrow * 512 + h * 64 + d0 * 16 + hi * 8);
    f32x16 s[5];
    const int kt0 = (m0 >= 128) ? 0 : (128 - m0) / 32;
    const int krow8 = lane >> 3, kch = lane & 7;
    v4u kr[5][4];
#pragma unroll
    for (int kt = 0; kt < 5; ++kt)
#pragma unroll
        for (int i_ = 0; i_ < 4; ++i_) { const int mk = m0 - 128 + 32 * kt + 8 * i_ + krow8; const size_t krow = rowb + (size_t)(mk < 0 ? 0 : mk) * dd + cls;
            kr[kt][i_] = *(const v4u*)(KB + krow * 512 + h * 64 + kch * 8); }
#pragma unroll
    for (int kt = 0; kt < 5; ++kt) {
        LAS unsigned char* kb = wl + (kt & 1) * 32 * VPITCH;
#pragma unroll
        for (int i_ = 0; i_ < 4; ++i_) *(LAS v4u*)(kb + (8 * i_ + krow8) * VPITCH + kch * 16) = kr[kt][i_];
        LDS_WAIT();
        bf16x8 kf[4];
#pragma unroll
        for (int d0 = 0; d0 < 4; ++d0) kf[d0] = *(const LAS bf16x8*)(kb + r32 * VPITCH + d0 * 32 + hi * 16);
        f32x16 a; for (int i = 0; i < 16; ++i) a[i] = 0.f;
#pragma unroll
        for (int d0 = 0; d0 < 4; ++d0) a = mfma32(kf[d0], qf[d0], a);
        s[kt] = a;
    }
    LDS_WAIT();
#pragma unroll
    for (int kt = 0; kt < 5; ++kt) {
        if (kt < kt0) {
#pragma unroll
            for (int i = 0; i < 16; ++i) s[kt][i] = -INFINITY;
        } else if (kt == 0) {
#pragma unroll
            for (int i = 0; i < 16; ++i) s[kt][i] = (crow(i, hi) >= r32) ? s[kt][i] : -INFINITY;
        } else if (kt == 4) {
#pragma unroll
            for (int i = 0; i < 16; ++i) s[kt][i] = (crow(i, hi) <= r32) ? s[kt][i] : -INFINITY;
        }
    }
    float mx = -INFINITY;
#pragma unroll
    for (int kt = 0; kt < 5; ++kt)
#pragma unroll
        for (int i = 0; i < 16; ++i) mx = fmaxf(mx, s[kt][i]);
    mx = fmaxf(mx, __shfl_xor(mx, 32));
    float lsum = 0.f;
#pragma unroll
    for (int kt = 0; kt < 5; ++kt)
#pragma unroll
        for (int i = 0; i < 16; ++i) { const float e = __builtin_amdgcn_exp2f(s[kt][i] - mx); s[kt][i] = e; lsum += e; }
    lsum += __shfl_xor(lsum, 32);
    f32x16 o[2]; for (int i = 0; i < 16; ++i) { o[0][i] = 0.f; o[1][i] = 0.f; }
    LAS float* wsf = (LAS float*)(wl + 2 * 32 * VPITCH);
    const unsigned vb0 = (unsigned)(uintptr_t)wl;
    const int g = lane >> 4, i16 = lane & 15, qq = i16 >> 2, pp = i16 & 3;
    const unsigned traddr = (unsigned)((4 * (g >> 1) + qq) * VPITCH + (16 * (g & 1) + 4 * pp) * 2);
    const int vrow8 = lane >> 3, vch = lane & 7;
    v4u vr[4];
#define ATT_LOADV(KT) do { _Pragma("unroll") for (int i_ = 0; i_ < 4; ++i_) { const int mk_ = m0 - 128 + 32 * (KT) + 8 * i_ + vrow8; const size_t vrow_ = rowb + (size_t)mk_ * dd + cls; \
        vr[i_] = *(const v4u*)(VB + vrow_ * 512 + h * 64 + vch * 8); } } while (0)
    ATT_LOADV(kt0);
#pragma unroll
    for (int kt = 0; kt < 5; ++kt) {
        if (kt >= kt0) {
            LAS unsigned char* vb = wl + (kt & 1) * 32 * VPITCH;
#pragma unroll
            for (int i_ = 0; i_ < 4; ++i_) *(LAS v4u*)(vb + (8 * i_ + vrow8) * VPITCH + vch * 16) = vr[i_];
            if (kt + 1 < 5) ATT_LOADV(kt + 1);
            LDS_WAIT();
            const unsigned base = vb0 + (unsigned)((kt & 1) * 32 * VPITCH) + traddr;
            s16x4 t[8];
            tr_read8(base, t);
#pragma unroll
            for (int ss = 0; ss < 2; ++ss) {
                const bf16x8 pa = pk8(s[kt][8 * ss], s[kt][8 * ss + 1], s[kt][8 * ss + 2], s[kt][8 * ss + 3], s[kt][8 * ss + 4], s[kt][8 * ss + 5], s[kt][8 * ss + 6], s[kt][8 * ss + 7]);
#pragma unroll
                for (int db = 0; db < 2; ++db) { const bf16x8 vf = __builtin_shufflevector(t[4 * ss + 2 * db], t[4 * ss + 2 * db + 1], 0, 1, 2, 3, 4, 5, 6, 7); o[db] = mfma32(pa, vf, o[db]); }
            }
        }
    }
#undef ATT_LOADV
    if (hi == 0) { wsf[r32] = __builtin_amdgcn_rcpf(lsum); LSE[((size_t)p * M + qrow) * 8 + h] = mx + __builtin_amdgcn_logf(lsum); }
    LDS_WAIT();
#pragma unroll
    for (int i = 0; i < 16; ++i) { const int q = crow(i, hi); const float li = wsf[q];
        *(LAS bf16*)(wl + q * VPITCH + r32 * 2) = (bf16)pk2z(o[0][i] * li); *(LAS bf16*)(wl + q * VPITCH + 64 + r32 * 2) = (bf16)pk2z(o[1][i] * li); }
    LDS_WAIT();
    { const int orow8 = lane >> 3, och = lane & 7;
#pragma unroll
      for (int i_ = 0; i_ < 4; ++i_) { const v4u w = *(const LAS v4u*)(wl + (8 * i_ + orow8) * VPITCH + och * 16); const size_t orow = rowb + (size_t)(m0 + 8 * i_ + orow8) * dd + cls;
          *(v4u*)(OP + ((size_t)p * M + orow) * 512 + h * 64 + och * 8) = w; } }
    LDS_WAIT();
}
DI void attn_finalize_row(const bf16* OP, const float* LSE, const float* gain, bf16* MIX, int row, int lane) {
    asm volatile("" : "+v"(lane));
    const int h = lane >> 3;
    float l0 = LSE[((size_t)0 * M + row) * 8 + h], l1 = LSE[((size_t)1 * M + row) * 8 + h], l2 = LSE[((size_t)2 * M + row) * 8 + h];
    const float mx = fmaxf(l0, fmaxf(l1, l2));
    float w0 = __builtin_amdgcn_exp2f(l0 - mx), w1 = __builtin_amdgcn_exp2f(l1 - mx), w2 = __builtin_amdgcn_exp2f(l2 - mx);
    const float inv = __builtin_amdgcn_rcpf(w0 + w1 + w2); w0 *= inv; w1 *= inv; w2 *= inv;
    const v4u a = *(const v4u*)(OP + ((size_t)0 * M + row) * 512 + lane * 8), b = *(const v4u*)(OP + ((size_t)1 * M + row) * 512 + lane * 8), c = *(const v4u*)(OP + ((size_t)2 * M + row) * 512 + lane * 8);
    float v[8]; float ss = 0.f;
#pragma unroll
    for (int j = 0; j < 4; ++j) { v[2 * j] = w0 * bflo(a[j]) + w1 * bflo(b[j]) + w2 * bflo(c[j]); v[2 * j + 1] = w0 * bfhi(a[j]) + w1 * bfhi(b[j]) + w2 * bfhi(c[j]); ss += v[2 * j] * v[2 * j] + v[2 * j + 1] * v[2 * j + 1]; }
    ss = wave_sum(ss);
    const float rinv = 1.0f / sqrtf(ss * (1.f / 512.f) + RMS_EPS);
    const f32x4 g0 = *(const f32x4*)(gain + lane * 8), g1 = *(const f32x4*)(gain + lane * 8 + 4);
    v4u w; w.x = pk2(v[0] * rinv * g0[0], v[1] * rinv * g0[1]); w.y = pk2(v[2] * rinv * g0[2], v[3] * rinv * g0[3]); w.z = pk2(v[4] * rinv * g1[0], v[5] * rinv * g1[1]); w.w = pk2(v[6] * rinv * g1[2], v[7] * rinv * g1[3]);
    *(v4u*)(MIX + (size_t)row * 1024 + lane * 8) = w;
}
constexpr int B1_IMG = 2048, B1_WLDS = 5 * B1_IMG + 1024;
constexpr int IMG_V = 0, IMG_A = 1 * B1_IMG, IMG_B = 2 * B1_IMG, IMG_W = 3 * B1_IMG, IMG_M = 4 * B1_IMG;
constexpr int TIL = 1 * B1_IMG, TIL_LP = 336, TIL_RP = 144, TIL_RSZ = 17 * TIL_RP;
static_assert(17 * TIL_LP <= 4 * B1_IMG && 3 * TIL_RSZ <= 4 * B1_IMG, "input tiles fit the image area");
DI float dpp_shr(float x, int n) { int v;
    switch (n) { case 1: v = __builtin_amdgcn_update_dpp(0, __builtin_bit_cast(int, x), 0x111, 0xf, 0xf, true); break; case 2: v = __builtin_amdgcn_update_dpp(0, __builtin_bit_cast(int, x), 0x112, 0xf, 0xf, true); break;
                 case 4: v = __builtin_amdgcn_update_dpp(0, __builtin_bit_cast(int, x), 0x114, 0xf, 0xf, true); break; default: v = __builtin_amdgcn_update_dpp(0, __builtin_bit_cast(int, x), 0x118, 0xf, 0xf, true); break; }
    return __builtin_bit_cast(float, v); }
DI float dpp_shr1(float x, int n) { int v; const int one = 0x3f800000;
    switch (n) { case 1: v = __builtin_amdgcn_update_dpp(one, __builtin_bit_cast(int, x), 0x111, 0xf, 0xf, false); break; case 2: v = __builtin_amdgcn_update_dpp(one, __builtin_bit_cast(int, x), 0x112, 0xf, 0xf, false); break;
                 case 4: v = __builtin_amdgcn_update_dpp(one, __builtin_bit_cast(int, x), 0x114, 0xf, 0xf, false); break; default: v = __builtin_amdgcn_update_dpp(one, __builtin_bit_cast(int, x), 0x118, 0xf, 0xf, false); break; }
    return __builtin_bit_cast(float, v); }
struct RwkvP {
    const bf16* PR; const float* mu; const float* muv;
    const float *dbase, *ibase, *vbase, *ksk, *ksa, *brk, *gng, *gnb;
    const bf16 *dupT, *iupT, *vupT, *gupT;
    const bf16* ZROW; bf16 *VF, *VV; float* BON; float* GC; bf16 *W1S, *REFF, *BM; v4u* REC; float* YPRE; bf16* MIX; int layer0;
};
DI const f32x4* vec4p(const float*) { return nullptr; }
DI const LAS f32x4* vec4p(const LAS float*) { return nullptr; }
template <class MP> DI void lerp8(const bf16* crow_, const bf16* prow_, int col, MP mu, float (&z)[8]) {
    const v4u cur = *(const v4u*)(crow_ + col); const v4u prv = *(const v4u*)(prow_ + col);
    const f32x4 m0 = *(decltype(vec4p(mu)))(mu), m1 = *(decltype(vec4p(mu)))(mu + 4);
#pragma unroll
    for (int j = 0; j < 4; ++j) { const float a = bflo(cur[j]), b = bfhi(cur[j]), pa = bflo(prv[j]), pb = bfhi(prv[j]); const float ma = j < 2 ? m0[2 * j] : m1[2 * j - 4], mb = j < 2 ? m0[2 * j + 1] : m1[2 * j - 3];
        z[2 * j] = a + (pa - a) * ma; z[2 * j + 1] = b + (pb - b) * mb; }
}
template <class MP> DI f32x4 lerp4(const bf16* crow_, const bf16* prow_, int col, MP mu) {
    const v2u cur = *(const v2u*)(crow_ + col); const v2u prv = *(const v2u*)(prow_ + col);
    const f32x4 m = *(decltype(vec4p(mu)))(mu);
    f32x4 z; z[0] = bflo(cur.x) + (bflo(prv.x) - bflo(cur.x)) * m[0]; z[1] = bfhi(cur.x) + (bfhi(prv.x) - bfhi(cur.x)) * m[1];
    z[2] = bflo(cur.y) + (bflo(prv.y) - bflo(cur.y)) * m[2]; z[3] = bfhi(cur.y) + (bfhi(prv.y) - bfhi(cur.y)) * m[3]; return z;
}
template <class MP> DI void lerp8l(const LAS unsigned char* crow_, const LAS unsigned char* prow_, int colb, MP mu, float (&z)[8]) {
    const v4u cur = *(const LAS v4u*)(crow_ + colb); const v4u prv = *(const LAS v4u*)(prow_ + colb);
    const f32x4 m0 = *(decltype(vec4p(mu)))(mu), m1 = *(decltype(vec4p(mu)))(mu + 4);
#pragma unroll
    for (int j = 0; j < 4; ++j) { const float a = bflo(cur[j]), b = bfhi(cur[j]), pa = bflo(prv[j]), pb = bfhi(prv[j]); const float ma = j < 2 ? m0[2 * j] : m1[2 * j - 4], mb = j < 2 ? m0[2 * j + 1] : m1[2 * j - 3];
        z[2 * j] = a + (pa - a) * ma; z[2 * j + 1] = b + (pb - b) * mb; }
}
template <class MP> DI f32x4 lerp4l(const LAS unsigned char* crow_, const LAS unsigned char* prow_, int colb, MP mu) {
    const v2u cur = *(const LAS v2u*)(crow_ + colb); const v2u prv = *(const LAS v2u*)(prow_ + colb);
    const f32x4 m = *(decltype(vec4p(mu)))(mu);
    f32x4 z; z[0] = bflo(cur.x) + (bflo(prv.x) - bflo(cur.x)) * m[0]; z[1] = bfhi(cur.x) + (bfhi(prv.x) - bfhi(cur.x)) * m[1];
    z[2] = bflo(cur.y) + (bflo(prv.y) - bflo(cur.y)) * m[2]; z[3] = bfhi(cur.y) + (bfhi(prv.y) - bfhi(cur.y)) * m[3]; return z;
}
DI void img_write(LAS unsigned char* img, const f32x4 (&x)[4], int fr, int fq) {
#pragma unroll
    for (int mb = 0; mb < 4; ++mb)
#pragma unroll
        for (int reg = 0; reg < 4; ++reg) *(LAS bf16*)(img + (16 * mb + 4 * fq + reg) * 32 + fr * 2) = (bf16)pk2z(x[mb][reg]);
}
DI bf16x8 lds4z(const LAS unsigned char* p) { const v2u t = *(const LAS v2u*)p; v4u w; w.x = t.x; w.y = t.y; w.z = 0u; w.w = 0u; return __builtin_bit_cast(bf16x8, w); }
constexpr int HC_DUP = 0, HC_IUP = 9216, HC_VUP = 18432, HC_F = 23552, HC_BYTES = 23552 + 736 * 4;
enum { HF_MUR = 0, HF_MUK = 64, HF_MUV = 128, HF_MUW = 192, HF_MUA = 256, HF_MUVR = 320, HF_DB = 352, HF_IB = 416, HF_VB = 480, HF_SK = 544, HF_SA = 608, HF_BR = 672 };
DI void head_cache_fill(const RwkvP& P, int h, LAS unsigned char* hc, int tid) {
    { const int row = tid >> 3, ch = tid & 7;
      *(LAS v4u*)(hc + HC_DUP + row * 144 + ch * 16) = *(const v4u*)(P.dupT + (size_t)(h * 64 + row) * 64 + ch * 8);
      *(LAS v4u*)(hc + HC_IUP + row * 144 + ch * 16) = *(const v4u*)(P.iupT + (size_t)(h * 64 + row) * 64 + ch * 8); }
    if (tid < 256 && !P.layer0) { const int row = tid >> 2, ch = tid & 3; *(LAS v4u*)(hc + HC_VUP + row * 80 + ch * 16) = *(const v4u*)(P.vupT + (size_t)(h * 64 + row) * 32 + ch * 8); }
    LAS float* f = (LAS float*)(hc + HC_F);
    if (tid < 64) { const int c = h * 64 + tid; f[HF_MUR + tid] = P.mu[c]; f[HF_MUK + tid] = P.mu[512 + c]; f[HF_MUV + tid] = P.mu[1024 + c]; f[HF_MUW + tid] = P.mu[1536 + tid]; f[HF_MUA + tid] = P.mu[1600 + tid];
        f[HF_DB + tid] = P.dbase[c]; f[HF_IB + tid] = P.ibase[c]; f[HF_VB + tid] = P.layer0 ? 0.f : P.vbase[c]; f[HF_SK + tid] = P.ksk[c]; f[HF_SA + tid] = P.ksa[c]; f[HF_BR + tid] = P.brk[c];
        if (tid < 32) f[HF_MUVR + tid] = P.layer0 ? 0.f : P.muv[tid]; }
}
DI void rwkv_b1_unit(const RwkvP& P, int unit, LAS unsigned char* wl, const LAS unsigned char* hc, LAS float* gct  , int lane) {
    asm volatile("" : "+v"(lane));
    const int fr = lane & 15, fq = lane >> 4;
    const int seq = unit >> 9, c = unit & 511, b = seq >> 3, h = seq & 7;
    const size_t row = (size_t)b * TSEQ + 16 * c + fr;
    const f32x4 z4 = {0.f, 0.f, 0.f, 0.f};
    const LAS float* hf = (const LAS float*)(hc + HC_F);
    const bf16* row0p = P.PR + ((size_t)b * TSEQ + 16 * c) * PRP;
#define TROW(rr) (((rr) == 0 && c == 0) ? P.ZROW : row0p + ((rr) - 1) * PRP)
    v4u tl[6], tr3[3][3];
#pragma unroll
    for (int i = 0; i < 5; ++i) { const int idx = lane + 64 * i; if (idx < 272) { const int rr = idx >> 4, pc = idx & 15; tl[i] = *(const v4u*)(TROW(rr) + 1536 + pc * 8); } }
    { const int idx = lane; const int rr = idx >> 2, pc = idx & 3; tl[5] = (v4u){0u, 0u, 0u, 0u}; if (!P.layer0) { tl[5] = *(const v4u*)(TROW(rr) + 1792 + pc * 8); } }
    v4u tl16 = {0u, 0u, 0u, 0u}; if (!P.layer0 && lane < 4) tl16 = *(const v4u*)(TROW(16) + 1792 + lane * 8);
#pragma unroll
    for (int ten = 0; ten < 3; ++ten)
#pragma unroll
        for (int i = 0; i < 3; ++i) { const int idx = lane + 64 * i; if (idx < 136) { const int rr = idx >> 3, pc = idx & 7; tr3[ten][i] = *(const v4u*)(TROW(rr) + ten * 512 + h * 64 + pc * 8); } }
#pragma unroll
    for (int i = 0; i < 5; ++i) { const int idx = lane + 64 * i; if (idx < 272) { const int rr = idx >> 4, pc = idx & 15; *(LAS v4u*)(wl + TIL + rr * TIL_LP + pc * 16) = tl[i]; } }
    { const int rr = lane >> 2, pc = lane & 3; *(LAS v4u*)(wl + TIL + rr * TIL_LP + 256 + pc * 16) = tl[5]; if (lane < 4) *(LAS v4u*)(wl + TIL + 16 * TIL_LP + 256 + lane * 16) = tl16; }
    LDS_WAIT();
    const LAS unsigned char* lcr = wl + TIL + (fr + 1) * TIL_LP; const LAS unsigned char* lpr = wl + TIL + fr * TIL_LP;
    bf16x8 tw[2], al[2], vl;
#pragma unroll
    for (int ks = 0; ks < 2; ++ks) { float z[8]; lerp8l(lcr, lpr, (8 * fq + 32 * ks) * 2, hf + HF_MUW + 8 * fq + 32 * ks, z);
        tw[ks] = pk8(ftanh(z[0]), ftanh(z[1]), ftanh(z[2]), ftanh(z[3]), ftanh(z[4]), ftanh(z[5]), ftanh(z[6]), ftanh(z[7]));
        lerp8l(lcr, lpr, 128 + (8 * fq + 32 * ks) * 2, hf + HF_MUA + 8 * fq + 32 * ks, z); al[ks] = pk8(z[0], z[1], z[2], z[3], z[4], z[5], z[6], z[7]); }
    if (!P.layer0) { float z[8]; lerp8l(lcr, lpr, 256 + 8 * fq * 2, hf + HF_MUVR + 8 * fq, z); vl = pk8(z[0], z[1], z[2], z[3], z[4], z[5], z[6], z[7]); }
    LDS_WAIT();
#pragma unroll
    for (int ten = 0; ten < 3; ++ten)
#pragma unroll
        for (int i = 0; i < 3; ++i) { const int idx = lane + 64 * i; if (idx < 136) { const int rr = idx >> 3, pc = idx & 7; *(LAS v4u*)(wl + TIL + ten * TIL_RSZ + rr * TIL_RP + pc * 16) = tr3[ten][i]; } }
    LDS_WAIT();
#undef TROW
    const LAS unsigned char* rcr = wl + TIL + (fr + 1) * TIL_RP; const LAS unsigned char* rpr = wl + TIL + fr * TIL_RP;
    f32x4 zr[4], k2[4], kk[4], ai[4], ld[4];
    float nrm = 0.f, bon = 0.f;
#pragma unroll
    for (int mb = 0; mb < 4; ++mb) { const int ch = h * 64 + 16 * mb + 4 * fq; const int n = h * 64 + 16 * mb + fr;
        f32x4 dw = z4, da = z4, dv = z4;
        dw = mfma16(*(const LAS bf16x8*)(hc + HC_DUP + (16 * mb + fr) * 144 + 16 * fq), tw[0], dw); dw = mfma16(*(const LAS bf16x8*)(hc + HC_DUP + (16 * mb + fr) * 144 + 16 * fq + 64), tw[1], dw);
        da = mfma16(*(const LAS bf16x8*)(hc + HC_IUP + (16 * mb + fr) * 144 + 16 * fq), al[0], da); da = mfma16(*(const LAS bf16x8*)(hc + HC_IUP + (16 * mb + fr) * 144 + 16 * fq + 64), al[1], da);
        if (!P.layer0) dv = mfma16(*(const LAS bf16x8*)(hc + HC_VUP + (16 * mb + fr) * 80 + 16 * fq), vl, z4);
        const int cl = 16 * mb + 4 * fq;
        zr[mb] = lerp4l(rcr, rpr, cl * 2, hf + HF_MUR + cl);
        const f32x4 zk = lerp4l(rcr + TIL_RSZ, rpr + TIL_RSZ, cl * 2, hf + HF_MUK + cl);
        f32x4 zv = lerp4l(rcr + 2 * TIL_RSZ, rpr + 2 * TIL_RSZ, cl * 2, hf + HF_MUV + cl);
        const f32x4 db = *(const LAS f32x4*)(hf + HF_DB + cl), ib = *(const LAS f32x4*)(hf + HF_IB + cl), sk = *(const LAS f32x4*)(hf + HF_SK + cl), sa = *(const LAS f32x4*)(hf + HF_SA + cl), br = *(const LAS f32x4*)(hf + HF_BR + cl);
        if (P.layer0) { v2u w; w.x = pk2(zv[0], zv[1]); w.y = pk2(zv[2], zv[3]); *(v2u*)(P.VF + row * 512 + ch) = w; }
        else { const v2u f = *(const v2u*)(P.VF + row * 512 + ch); const f32x4 vb = *(const LAS f32x4*)(hf + HF_VB + cl); const f32x4 vf = {bflo(f.x), bfhi(f.x), bflo(f.y), bfhi(f.y)};
#pragma unroll
            for (int e = 0; e < 4; ++e) zv[e] = zv[e] + (vf[e] - zv[e]) * fsigmoid(vb[e] + dv[e]); }
        { v2u w; w.x = pk2(zv[0], zv[1]); w.y = pk2(zv[2], zv[3]); *(v2u*)(P.VV + row * 512 + ch) = w; }
#pragma unroll
        for (int reg = 0; reg < 4; ++reg) *(LAS bf16*)(wl + IMG_V + (16 * mb + 4 * fq + reg) * 32 + fr * 2) = (bf16)pk2z(zv[reg]);
#pragma unroll
        for (int e = 0; e < 4; ++e) {
            ld[mb][e] = fexp(-0.60653065971f * fsigmoid(db[e] + dw[e]));
            const float a = fsigmoid(ib[e] + da[e]); ai[mb][e] = a;
            const float kr = zk[e] * sk[e]; kk[mb][e] = kr; nrm += kr * kr;
            const float kx = zk[e] * (1.f + (a - 1.f) * sa[e]); k2[mb][e] = kx; bon += zr[mb][e] * kx * br[e]; }
        asm volatile("" ::: "memory");
    }
    nrm += __shfl_xor(nrm, 16); nrm += __shfl_xor(nrm, 32); bon += __shfl_xor(bon, 16); bon += __shfl_xor(bon, 32);
    if (fq == 0) P.BON[row * 8 + h] = bon;
    const float kinv = 1.0f / fmaxf(sqrtf(nrm), 1e-12f);
    f32x4 rt[4], kh[4];
    bf16x8 pa[2], pb[2], pk[2], pr[2];
#pragma unroll
    for (int ks = 0; ks < 2; ++ks) {
        f32x4 at2[2], bt2[2], kt2[2];
#pragma unroll
        for (int m2 = 0; m2 < 2; ++m2) { const int mb = 2 * ks + m2;
            f32x4 gcv, bhv;
#pragma unroll
            for (int e = 0; e < 4; ++e) {
                float gm = ld[mb][e]; gm *= dpp_shr1(gm, 1); gm *= dpp_shr1(gm, 2); gm *= dpp_shr1(gm, 4); gm *= dpp_shr1(gm, 8);
                const float gc = __shfl(gm, lane | 15), gp = dpp_shr1(gm, 1), gi = __builtin_amdgcn_rcpf(gm), ec = gc * gi;
                const float kn = kk[mb][e] * kinv, bb = kn * ai[mb][e];
                at2[m2][e] = -kn * gp; bt2[m2][e] = bb * gi; kt2[m2][e] = k2[mb][e] * gi; rt[mb][e] = zr[mb][e] * gm;
                bhv[e] = bb * ec; kh[mb][e] = k2[mb][e] * ec; gcv[e] = gc; }
            if (fr == 0) { *(f32x4*)(P.GC + (size_t)unit * 64 + 16 * mb + 4 * fq) = gcv; *(LAS f32x4*)(gct + (unit & 31) * 64 + 16 * mb + 4 * fq) = gcv; }
#pragma unroll
            for (int reg = 0; reg < 4; ++reg) { const int o = (16 * mb + 4 * fq + reg) * 32 + fr * 2;
                *(LAS bf16*)(wl + IMG_A + o) = (bf16)pk2z(at2[m2][reg]); *(LAS bf16*)(wl + IMG_B + o) = (bf16)pk2z(bhv[reg]); }
        }
        pa[ks] = pk8v(at2[0], at2[1]); pb[ks] = pk8v(bt2[0], bt2[1]); pk[ks] = pk8v(kt2[0], kt2[1]); pr[ks] = pk8v(rt[2 * ks], rt[2 * ks + 1]);
    }
    const f32x4 z4b = {0.f, 0.f, 0.f, 0.f};
    f32x4 Aab = mfma16(pb[1], pa[1], mfma16(pb[0], pa[0], z4b));
    f32x4 AakT = mfma16(pa[1], pk[1], mfma16(pa[0], pk[0], z4b));
    f32x4 Arb = mfma16(pb[1], pr[1], mfma16(pb[0], pr[0], z4b));
    f32x4 Ark = mfma16(pk[1], pr[1], mfma16(pk[0], pr[0], z4b));
#pragma unroll
    for (int e = 0; e < 4; ++e) { const int rr = 4 * fq + e; Aab[e] = rr < fr ? Aab[e] : 0.f; AakT[e] = fr < rr ? AakT[e] : 0.f; Arb[e] = rr <= fr ? Arb[e] : 0.f; Ark[e] = rr <= fr ? Ark[e] : 0.f; }
    LAS float* As = (LAS float*)(wl + 5 * B1_IMG);
#pragma unroll
    for (int e = 0; e < 4; ++e) As[(4 * fq + e) * 16 + fr] = Aab[e];
    LDS_WAIT();
    float x[16];
#pragma unroll
    for (int s = 15; s >= 0; --s) { float acc = (s == fr) ? 1.f : 0.f;
        const f32x4 r0 = *(const LAS f32x4*)(As + s * 16), r1 = *(const LAS f32x4*)(As + s * 16 + 4), r2 = *(const LAS f32x4*)(As + s * 16 + 8), r3 = *(const LAS f32x4*)(As + s * 16 + 12);
        const float rowv[16] = {r0[0], r0[1], r0[2], r0[3], r1[0], r1[1], r1[2], r1[3], r2[0], r2[1], r2[2], r2[3], r3[0], r3[1], r3[2], r3[3]};
#pragma unroll
        for (int uu = s + 1; uu < 16; ++uu) acc += rowv[uu] * x[uu];
        x[s] = acc; if ((s & 1) == 0) asm volatile("" ::: "memory"); }
    f32x4 xs;
#pragma unroll
    for (int e = 0; e < 4; ++e) xs[e] = fq == 0 ? x[e] : fq == 1 ? x[4 + e] : fq == 2 ? x[8 + e] : x[12 + e];
    const bf16x8 Tsel = pk4z(xs);
    f32x4 W1[4];
#pragma unroll
    for (int mb = 0; mb < 4; ++mb) W1[mb] = mfma16(lds4z(wl + IMG_A + (16 * mb + fr) * 32 + 8 * fq), Tsel, z4);
    const f32x4 GT = mfma16(Tsel, pk4z(AakT), z4);
    img_write(wl + IMG_W, W1, fr, fq);
    f32x4 M1T[4];
    const bf16x8 GTp = pk4z(GT);
#pragma unroll
    for (int mb = 0; mb < 4; ++mb) M1T[mb] = mfma16(lds4z(wl + IMG_B + (16 * mb + fr) * 32 + 8 * fq), GTp, kh[mb]);
    img_write(wl + IMG_M, M1T, fr, fq);
    LDS_WAIT();
    const bf16x8 Arbp = pk4z(Arb);
    f32x4 RE[4];
#pragma unroll
    for (int mb = 0; mb < 4; ++mb) RE[mb] = mfma16(lds4z(wl + IMG_W + (16 * mb + fr) * 32 + 8 * fq), Arbp, rt[mb]);
    const f32x4 M2 = mfma16(GTp, Arbp, Ark);
    {   bf16* w1s = P.W1S + (size_t)unit * 1024 + fr * 32; bf16* re = P.REFF + (size_t)unit * 1024 + fr * 32;
#pragma unroll
        for (int kp = 0; kp < 2; ++kp) { const int sg = kp * 512 + fq * 8;
            v4u w; w.x = pk2(W1[2 * kp][0], W1[2 * kp][1]); w.y = pk2(W1[2 * kp][2], W1[2 * kp][3]); w.z = pk2(W1[2 * kp + 1][0], W1[2 * kp + 1][1]); w.w = pk2(W1[2 * kp + 1][2], W1[2 * kp + 1][3]); *(v4u*)(w1s + sg) = w;
            w.x = pk2(RE[2 * kp][0], RE[2 * kp][1]); w.y = pk2(RE[2 * kp][2], RE[2 * kp][3]); w.z = pk2(RE[2 * kp + 1][0], RE[2 * kp + 1][1]); w.w = pk2(RE[2 * kp + 1][2], RE[2 * kp + 1][3]); *(v4u*)(re + sg) = w; }
        const v2u m2p = {pk2(M2[0], M2[1]), pk2(M2[2], M2[3])};
#pragma unroll
        for (int mb = 0; mb < 4; ++mb) {
            const v2u bq = *(const LAS v2u*)(wl + IMG_B + (16 * mb + fr) * 32 + 8 * fq), mq = *(const LAS v2u*)(wl + IMG_M + (16 * mb + fr) * 32 + 8 * fq);
            *(v4u*)(P.BM + (((size_t)unit * 64 + 16 * mb + fr) * 4 + fq) * 8) = (v4u){bq.x, bq.y, mq.x, mq.y};
            const v2u vq = *(const LAS v2u*)(wl + IMG_V + (16 * mb + fr) * 32 + 8 * fq);
            P.REC[((size_t)unit * 4 + mb) * 64 + lane] = (v4u){vq.x, vq.y, m2p.x, m2p.y}; }
    }
    LDS_WAIT();
}
constexpr int NSEG = 16, SEGCH = NCH / NSEG;
struct ChainIn { bf16x8 w1[2], re[2], bm[4]; v4u rec; };
constexpr int GCT_OFF = 149504;
template <int MODE> DI void chain_load(ChainIn& c, const RwkvP& P, int unit, int rb, int lane) {
    const int fr = lane & 15, fq = lane >> 4;
    const bf16* w1s = P.W1S + (size_t)unit * 1024 + fr * 32 + fq * 8;
    c.w1[0] = ld8(w1s); c.w1[1] = ld8(w1s + 512);
    if (MODE == 2) { const bf16* re = P.REFF + (size_t)unit * 1024 + fr * 32 + fq * 8; c.re[0] = ld8(re); c.re[1] = ld8(re + 512); }
#pragma unroll
    for (int mb = 0; mb < 4; ++mb) c.bm[mb] = ld8(P.BM + (((size_t)unit * 64 + 16 * mb + fr) * 4 + fq) * 8);
    if (MODE != 1) c.rec = P.REC[((size_t)unit * 4 + rb) * 64 + lane];
}
template <int MODE> DI void chain_step(f32x4 (&S)[4], const ChainIn& c, float* ypre  , const LAS float* gcl  ) {
    const f32x4 z4 = {0.f, 0.f, 0.f, 0.f};
    f32x4 gc[4];
#pragma unroll
    for (int mb = 0; mb < 4; ++mb) gc[mb] = *(const LAS f32x4*)(gcl + 16 * mb);
    const bf16x8 b0 = pk8v(S[0], S[1]), b1 = pk8v(S[2], S[3]);
    f32x4 ut = mfma16(c.w1[1], b1, mfma16(c.w1[0], b0, z4));
    if (MODE == 2) {
        v4u vlo; vlo.x = c.rec.x; vlo.y = c.rec.y; vlo.z = 0u; vlo.w = 0u;
        v4u m2a; m2a.x = c.rec.z; m2a.y = c.rec.w; m2a.z = 0u; m2a.w = 0u;
        f32x4 y = mfma16(__builtin_bit_cast(bf16x8, m2a), __builtin_bit_cast(bf16x8, vlo), z4);
        y = mfma16(c.re[0], b0, y); y = mfma16(c.re[1], b1, y);
#pragma unroll
        for (int e = 0; e < 4; ++e) ypre[(size_t)e * 512] = y[e];
    }
    v4u uv; uv.x = pk2(ut[0], ut[1]); uv.y = pk2(ut[2], ut[3]); uv.z = MODE == 1 ? 0u : c.rec.x; uv.w = MODE == 1 ? 0u : c.rec.y;
    const bf16x8 ub = __builtin_bit_cast(bf16x8, uv);
#pragma unroll
    for (int mb = 0; mb < 4; ++mb) S[mb] = mfma16(c.bm[mb], ub, S[mb] * gc[mb]);
}
template <int MODE> DI void chain_run(f32x4 (&S)[4], const RwkvP& P, int unit0, int nsteps  , int rb, float* yp, const LAS float* gct  , int lane) {
    ChainIn c0, c1, c2, c3;
    chain_load<MODE>(c0, P, unit0, rb, lane); chain_load<MODE>(c1, P, unit0 + 1, rb, lane); chain_load<MODE>(c2, P, unit0 + 2, rb, lane);
    for (int c = 0; c < nsteps; c += 4) {
        chain_load<MODE>(c3, P, unit0 + c + 3, rb, lane);
        chain_step<MODE>(S, c0, yp + (size_t)c * 16 * 512, gct + c * 64);
        if (c + 4 < nsteps) chain_load<MODE>(c0, P, unit0 + c + 4, rb, lane);
        chain_step<MODE>(S, c1, yp + (size_t)(c + 1) * 16 * 512, gct + (c + 1) * 64);
        if (c + 5 < nsteps) chain_load<MODE>(c1, P, unit0 + c + 5, rb, lane);
        chain_step<MODE>(S, c2, yp + (size_t)(c + 2) * 16 * 512, gct + (c + 2) * 64);
        if (c + 6 < nsteps) chain_load<MODE>(c2, P, unit0 + c + 6, rb, lane);
        chain_step<MODE>(S, c3, yp + (size_t)(c + 3) * 16 * 512, gct + (c + 3) * 64);
    }
}
DI void chain_step_dual(f32x4 (&SQ)[4], f32x4 (&SP)[4], const ChainIn& c, const LAS float* gcl) {
    const f32x4 z4 = {0.f, 0.f, 0.f, 0.f};
    f32x4 gc[4];
#pragma unroll
    for (int mb = 0; mb < 4; ++mb) gc[mb] = *(const LAS f32x4*)(gcl + 16 * mb);
    const bf16x8 q0 = pk8v(SQ[0], SQ[1]), q1 = pk8v(SQ[2], SQ[3]), p0 = pk8v(SP[0], SP[1]), p1 = pk8v(SP[2], SP[3]);
    const f32x4 utq = mfma16(c.w1[1], q1, mfma16(c.w1[0], q0, z4)), utp = mfma16(c.w1[1], p1, mfma16(c.w1[0], p0, z4));
    v4u uq; uq.x = pk2(utq[0], utq[1]); uq.y = pk2(utq[2], utq[3]); uq.z = c.rec.x; uq.w = c.rec.y;
    v4u up; up.x = pk2(utp[0], utp[1]); up.y = pk2(utp[2], utp[3]); up.z = 0u; up.w = 0u;
    const bf16x8 ubq = __builtin_bit_cast(bf16x8, uq), ubp = __builtin_bit_cast(bf16x8, up);
#pragma unroll
    for (int mb = 0; mb < 4; ++mb) { SQ[mb] = mfma16(c.bm[mb], ubq, SQ[mb] * gc[mb]); SP[mb] = mfma16(c.bm[mb], ubp, SP[mb] * gc[mb]); }
}
DI void chain_pass1(const RwkvP& P, float* QSEG, float* PSEGT, int seq, int g, int rb, const LAS float* gct0, int lane) {
    const int fr = lane & 15, fq = lane >> 4;
    f32x4 SQ[4], SP[4];
#pragma unroll
    for (int mb = 0; mb < 4; ++mb)
#pragma unroll
        for (int e = 0; e < 4; ++e) { SQ[mb][e] = 0.f; SP[mb][e] = ((16 * mb + 4 * fq + e) == (16 * rb + fr)) ? 1.f : 0.f; }
    const int unit0 = seq * NCH + g * SEGCH; const LAS float* gct = gct0 + 4 * fq;
    {   ChainIn c0, c1, c2;
        chain_load<0>(c0, P, unit0, rb, lane); chain_load<0>(c1, P, unit0 + 1, rb, lane);
        int c = 0;
        for (; c + 3 <= SEGCH; c += 3) {
            chain_load<0>(c2, P, unit0 + c + 2, rb, lane);
            chain_step_dual(SQ, SP, c0, gct + c * 64);
            if (c + 3 < SEGCH) chain_load<0>(c0, P, unit0 + c + 3, rb, lane);
            chain_step_dual(SQ, SP, c1, gct + (c + 1) * 64);
            if (c + 4 < SEGCH) chain_load<0>(c1, P, unit0 + c + 4, rb, lane);
            chain_step_dual(SQ, SP, c2, gct + (c + 2) * 64);
        }
        if (c < SEGCH) { chain_step_dual(SQ, SP, c0, gct + c * 64); ++c; }
        if (c < SEGCH) { chain_step_dual(SQ, SP, c1, gct + c * 64); ++c; }
    }
    const size_t sb = ((size_t)seq * NSEG + g) * 4096;
#pragma unroll
    for (int mb = 0; mb < 4; ++mb) *(f32x4*)(QSEG + sb + (size_t)(16 * rb + fr) * 64 + 16 * mb + 4 * fq) = SQ[mb];
#pragma unroll
    for (int mb = 0; mb < 4; ++mb)
#pragma unroll
        for (int e = 0; e < 4; ++e) PSEGT[sb + (size_t)((mb * 2 + (rb >> 1)) * 2 + (rb & 1)) * 256 + ((4 * fq + e) + 16 * (fr >> 2)) * 4 + (fr & 3)] = SP[mb][e];
}
DI void split_hl(const f32x4 a, const f32x4 b, bf16x8& hi, bf16x8& lo) {
    f32x4 ah, bh;
#pragma unroll
    for (int e = 0; e < 4; ++e) { ah[e] = rbf(a[e]); bh[e] = rbf(b[e]); }
    hi = pk8v(ah, bh); lo = pk8v(a - ah, b - bh);
}
DI void chain_pass23(const RwkvP& P, const float* QSEG, const float* PSEGT, int seq, int g, int rb, float* wkv_out, const LAS float* gct0, int lane) {
    const int fr = lane & 15, fq = lane >> 4, b = seq >> 3, h = seq & 7;
    f32x4 S[4]; for (int mb = 0; mb < 4; ++mb) S[mb] = (f32x4){0.f, 0.f, 0.f, 0.f};
    f32x4 pc[4][2][2], pn[4][2][2];
#define P2_LOAD(PD_, GP_) do { const size_t sb_ = ((size_t)seq * NSEG + (GP_)) * 4096; _Pragma("unroll") for (int mb = 0; mb < 4; ++mb) { \
        _Pragma("unroll") for (int ks = 0; ks < 2; ++ks) { const float* pr_ = PSEGT + sb_ + (size_t)((mb * 2 + ks) * 2) * 256 + (fr + 16 * fq) * 4; PD_[mb][ks][0] = *(const f32x4*)pr_; PD_[mb][ks][1] = *(const f32x4*)(pr_ + 256); } } } while (0)
    if (g > 0) P2_LOAD(pc, 0);
    for (int gp = 0; gp < g; ++gp) {
        f32x4 qc[4];
        { const size_t sb_ = ((size_t)seq * NSEG + gp) * 4096;
#pragma unroll
          for (int mb = 0; mb < 4; ++mb) qc[mb] = *(const f32x4*)(QSEG + sb_ + (size_t)(16 * rb + fr) * 64 + 16 * mb + 4 * fq); }
        if (gp + 1 < g) P2_LOAD(pn, gp + 1);
        bf16x8 bh[2], bl[2]; split_hl(S[0], S[1], bh[0], bl[0]); split_hl(S[2], S[3], bh[1], bl[1]);
#pragma unroll
        for (int mb = 0; mb < 4; ++mb) { f32x4 acc = {0.f, 0.f, 0.f, 0.f};
#pragma unroll
            for (int ks = 0; ks < 2; ++ks) { bf16x8 ah, al; split_hl(pc[mb][ks][0], pc[mb][ks][1], ah, al);
                acc = mfma16(ah, bh[ks], acc); acc = mfma16(al, bh[ks], acc); acc = mfma16(ah, bl[ks], acc); }
            S[mb] = acc + qc[mb]; }
#pragma unroll
        for (int mb = 0; mb < 4; ++mb) {
#pragma unroll
            for (int ks = 0; ks < 2; ++ks) { pc[mb][ks][0] = pn[mb][ks][0]; pc[mb][ks][1] = pn[mb][ks][1]; } }
    }
#undef P2_LOAD
    float* yp = P.YPRE + ((size_t)b * TSEQ + (size_t)g * SEGCH * 16 + 4 * fq) * 512 + h * 64 + 16 * rb + fr;
    chain_run<2>(S, P, seq * NCH + g * SEGCH, SEGCH, rb, yp, gct0 + 4 * fq, lane);
    if (g == NSEG - 1) {
#pragma unroll
        for (int mb = 0; mb < 4; ++mb) *(f32x4*)(wkv_out + (size_t)(16 * rb + fr) * 64 + 16 * mb + 4 * fq) = S[mb];
    }
}
constexpr int GC_GUP = 0, GC_F = 64 * 272, GC_BYTES = 64 * 272 + 256 * 4;
DI void gate_cache_fill(const RwkvP& P, int h, LAS unsigned char* gc, int tid) {
#pragma unroll
    for (int q = 0; q < 2; ++q) { const int idx = tid + 512 * q, row = idx >> 4, ch = idx & 15;
        *(LAS v4u*)(gc + GC_GUP + row * 272 + ch * 16) = *(const v4u*)(P.gupT + (size_t)(h * 64 + row) * 128 + ch * 8); }
    LAS float* f = (LAS float*)(gc + GC_F);
    if (tid < 64) { f[tid] = P.gng[h * 64 + tid]; f[64 + tid] = P.gnb[h * 64 + tid]; }
    if (tid >= 64 && tid < 192) f[128 + tid - 64] = P.mu[1664 + tid - 64];
}
constexpr int B3_GP = 272, B3_YP = 272, B3_VP = 144, B3_G = 0, B3_Y = 17 * B3_GP, B3_V = B3_Y + 16 * B3_YP, B3_WLDS = B3_V + 16 * B3_VP;
DI void rwkv_b3_unit(const RwkvP& P, int unit, const LAS unsigned char* gc, LAS unsigned char* wl, int lane) {
    asm volatile("" : "+v"(lane));
    const int fr = lane & 15, fq = lane >> 4;
    const int seq = unit >> 9, c = unit & 511, b = seq >> 3, h = seq & 7;
    const size_t row0 = (size_t)b * TSEQ + 16 * c;
    const f32x4 z4 = {0.f, 0.f, 0.f, 0.f};
    const LAS float* gf = (const LAS float*)(gc + GC_F);
    const bf16* row0p = P.PR + row0 * PRP;
    v4u tg[5], ty[4], tv[2];
#pragma unroll
    for (int i = 0; i < 5; ++i) { const int idx = lane + 64 * i; if (idx < 272) { const int rr = idx >> 4, pc = idx & 15; const bf16* rp = (rr == 0 && c == 0) ? P.ZROW : row0p + (rr - 1) * PRP; tg[i] = *(const v4u*)(rp + 1664 + pc * 8); } }
#pragma unroll
    for (int i = 0; i < 4; ++i) { const int idx = lane + 64 * i, rr = idx >> 4, pc = idx & 15; ty[i] = *(const v4u*)(P.YPRE + (row0 + rr) * 512 + h * 64 + pc * 4); }
#pragma unroll
    for (int i = 0; i < 2; ++i) { const int idx = lane + 64 * i, rr = idx >> 3, pc = idx & 7; tv[i] = *(const v4u*)(P.VV + (row0 + rr) * 512 + h * 64 + pc * 8); }
    const float bon = P.BON[(row0 + fr) * 8 + h];
#pragma unroll
    for (int i = 0; i < 5; ++i) { const int idx = lane + 64 * i; if (idx < 272) { const int rr = idx >> 4, pc = idx & 15; *(LAS v4u*)(wl + B3_G + rr * B3_GP + pc * 16) = tg[i]; } }
#pragma unroll
    for (int i = 0; i < 4; ++i) { const int idx = lane + 64 * i, rr = idx >> 4, pc = idx & 15; *(LAS v4u*)(wl + B3_Y + rr * B3_YP + pc * 16) = ty[i]; }
#pragma unroll
    for (int i = 0; i < 2; ++i) { const int idx = lane + 64 * i, rr = idx >> 3, pc = idx & 7; *(LAS v4u*)(wl + B3_V + rr * B3_VP + pc * 16) = tv[i]; }
    LDS_WAIT();
    const LAS unsigned char* gcr = wl + B3_G + (fr + 1) * B3_GP; const LAS unsigned char* gpr = wl + B3_G + fr * B3_GP;
    bf16x8 sg[4];
#pragma unroll
    for (int ks = 0; ks < 4; ++ks) { float z[8]; lerp8l(gcr, gpr, (8 * fq + 32 * ks) * 2, gf + 128 + 8 * fq + 32 * ks, z);
        sg[ks] = pk8(fsigmoid(z[0]), fsigmoid(z[1]), fsigmoid(z[2]), fsigmoid(z[3]), fsigmoid(z[4]), fsigmoid(z[5]), fsigmoid(z[6]), fsigmoid(z[7])); }
    f32x4 g[4], y[4]; float s = 0.f;
#pragma unroll
    for (int mb = 0; mb < 4; ++mb) { f32x4 a = z4;
#pragma unroll
        for (int ks = 0; ks < 4; ++ks) a = mfma16(*(const LAS bf16x8*)(gc + GC_GUP + (16 * mb + fr) * 272 + 16 * fq + 64 * ks), sg[ks], a);
        g[mb] = a;
        y[mb] = *(const LAS f32x4*)(wl + B3_Y + fr * B3_YP + (16 * mb + 4 * fq) * 4); s += (y[mb][0] + y[mb][1]) + (y[mb][2] + y[mb][3]); }
    s += __shfl_xor(s, 16); s += __shfl_xor(s, 32);
    const float mean = s * (1.f / 64.f); float q = 0.f;
#pragma unroll
    for (int mb = 0; mb < 4; ++mb) { y[mb] = y[mb] - mean; q += (y[mb][0] * y[mb][0] + y[mb][1] * y[mb][1]) + (y[mb][2] * y[mb][2] + y[mb][3] * y[mb][3]); }
    q += __shfl_xor(q, 16); q += __shfl_xor(q, 32);
    const float rstd = 1.0f / sqrtf(q * (1.f / 64.f) + GN_EPS);
    LDS_WAIT();
#pragma unroll
    for (int mb = 0; mb < 4; ++mb) { const int cl = 16 * mb + 4 * fq;
        const f32x4 gg = *(const LAS f32x4*)(gf + cl), gb = *(const LAS f32x4*)(gf + 64 + cl); const v2u vw = *(const LAS v2u*)(wl + B3_V + fr * B3_VP + cl * 2);
        const f32x4 v = {bflo(vw.x), bfhi(vw.x), bflo(vw.y), bfhi(vw.y)};
        const f32x4 o = (y[mb] * rstd * gg + gb + v * bon) * g[mb];
        v2u w; w.x = pk2(o[0], o[1]); w.y = pk2(o[2], o[3]); *(LAS v2u*)(wl + B3_G + fr * B3_VP + cl * 2) = w; }
    LDS_WAIT();
#pragma unroll
    for (int i = 0; i < 2; ++i) { const int idx = lane + 64 * i, rr = idx >> 3, pc = idx & 7; *(v4u*)(P.MIX + (row0 + rr) * 1024 + 512 + h * 64 + pc * 8) = *(const LAS v4u*)(wl + B3_G + rr * B3_VP + pc * 16); }
    LDS_WAIT();
}
DI f32x16 dec_gemm(const bf16* A, const bf16* Wt, int K, LAS float* red  , int wave, int lane) {
    const int r = lane & 31, h = lane >> 5, kw = K >> 3;
    const bf16* ap = A + (size_t)r * K + wave * kw + 8 * h; const bf16* bp = Wt + (size_t)r * K + wave * kw + 8 * h;
    f32x16 acc; for (int i = 0; i < 16; ++i) acc[i] = 0.f;
#pragma unroll 16
    for (int k = 0; k < kw; k += 16) acc = mfma32(ld8(ap + k), ld8(bp + k), acc);
    __syncthreads();
#pragma unroll
    for (int i = 0; i < 16; ++i) red[(wave * 16 + i) * 64 + lane] = acc[i];
    __syncthreads();
    if (wave == 0) {
#pragma unroll
        for (int i = 0; i < 16; ++i) { float s = 0.f;
#pragma unroll
            for (int w = 0; w < 8; ++w) s += red[(w * 16 + i) * 64 + lane];
            asm volatile("" : "+v"(s) :: "memory"); acc[i] = s; } }
    return acc;
}
DI void dec_row_stats(const float* st, LAS float* sc, int lane) {
    if (lane < 32) { float s = 0.f, q = 0.f; const f32x4* p = (const f32x4*)(st + (size_t)lane * 64);
#pragma unroll
        for (int i = 0; i < 16; ++i) { const f32x4 v = p[i]; s += v[0] + v[2]; q += v[1] + v[3]; if ((i & 3) == 3) asm volatile("" : "+v"(s), "+v"(q) :: "memory"); }
        const float mu = s * (1.f / 1024.f), var = fmaxf(q * (1.f / 1024.f) - mu * mu, 0.f); sc[2 * lane] = mu; sc[2 * lane + 1] = 1.0f / sqrtf(var + LN_EPS); }
    LDS_WAIT();
}
struct DecP {
    unsigned char* dec; int l;
    const float* xs;
    const float *c1in, *c2in, *c1up, *c2up, *g1, *b1, *g2p, *b2p;
    const bf16 *win, *winu, *wout, *wup, *wdn;
    float* out;
};
DI void dec_unit_in(const DecP& D, int u, LAS float* red, LAS float* sc, int wave, int lane) {
    const int r32 = lane & 31, hi = lane >> 5;
    if (u < 105) {
        const int n = 32 * u + r32; const bool fold = D.l > 0;
        const f32x16 acc = dec_gemm((const bf16*)(D.dec + DEC_XB2), D.win + (size_t)(32 * u) * DM, DM, red, wave, lane);
        if (wave != 0) return;
        if (fold) dec_row_stats((const float*)(D.dec + DEC_ST2), sc, lane);
        const float c1 = fold ? D.c1in[n] : 0.f, c2 = fold ? D.c2in[n] : 0.f; const int on = n < 1024 ? lgcl2orig(n) : n;
        float* PD = (float*)(D.dec + DEC_PD);
#pragma unroll
        for (int i = 0; i < 16; ++i) { const int row = crow(i, hi); float mu = 0.f, rs = 1.f; if (fold) { mu = sc[2 * row]; rs = sc[2 * row + 1]; } PD[(size_t)row * NIN + on] = (acc[i] - mu * c1) * rs + c2; }
    } else {
        const int v = u - 105, n = 32 * v + r32;
        const f32x16 acc = dec_gemm((const bf16*)(D.dec + DEC_SHB) + (size_t)D.l * MD * DM, D.winu + (size_t)(32 * v) * DM, DM, red, wave, lane);
        if (wave != 0) return;
        float* PS = (float*)(D.dec + DEC_PS);
#pragma unroll
        for (int i = 0; i < 16; ++i) PS[(size_t)crow(i, hi) * NRWU + n] = acc[i];
    }
    LDS_WAIT();
}
DI void dec_unit_res(const bf16* A, const bf16* Wt, int K, int u, bool raw, const float* src, const float* sstat, const float* g, const float* b, float* T, bf16* XB, float* ostat, float* shiftout, LAS float* red, LAS float* sc, int wave, int lane) {
    const int r32 = lane & 31, hi = lane >> 5, n = 32 * u + r32;
    const f32x16 acc = dec_gemm(A, Wt + (size_t)(32 * u) * K, K, red, wave, lane);
    if (wave != 0) return;
    if (!raw) dec_row_stats(sstat, sc, lane);
    const float gg = raw ? 1.f : g[n], bb = raw ? 0.f : b[n];
#pragma unroll
    for (int i = 0; i < 16; ++i) { const int row = crow(i, hi); float mu = 0.f, rs = 1.f; if (!raw) { mu = sc[2 * row]; rs = sc[2 * row + 1]; }
        const float x = (src[(size_t)row * DM + n] - mu) * rs * gg + bb; const float t = ALPHA * x + acc[i];
        T[(size_t)row * DM + n] = t; XB[(size_t)row * DM + n] = (bf16)f2bf(t); if (shiftout) shiftout[(size_t)row * DM + n] = x;
        float s = t, q = t * t;
#pragma unroll
        for (int o = 1; o < 32; o <<= 1) { s += __shfl_xor(s, o); q += __shfl_xor(q, o); }
        if (r32 == 0) { ostat[((size_t)row * 32 + u) * 2] = s; ostat[((size_t)row * 32 + u) * 2 + 1] = q; } }
    LDS_WAIT();
}
DI void dec_unit_up(const DecP& D, int u, LAS float* red, LAS float* sc, int wave, int lane) {
    const int r32 = lane & 31, hi = lane >> 5, n = 32 * u + r32;
    const f32x16 acc = dec_gemm((const bf16*)(D.dec + DEC_XB1), D.wup + (size_t)(32 * u) * DM, DM, red, wave, lane);
    if (wave != 0) return;
    dec_row_stats((const float*)(D.dec + DEC_ST1), sc, lane);
    const float c1 = D.c1up[n], c2 = D.c2up[n]; bf16* HB = (bf16*)(D.dec + DEC_HB);
#pragma unroll
    for (int i = 0; i < 16; ++i) { const int row = crow(i, hi); const float v = fmaxf((acc[i] - sc[2 * row] * c1) * sc[2 * row + 1] + c2, 0.f); HB[(size_t)row * FFD + n] = (bf16)f2bf(v * v); }
    LDS_WAIT();
}
DI void dec_attn_task(const DecP& D, const float* ck, const float* cv, const float* rope, int bd, int h, int p, int lane) {
    const int g = lane >> 4, dq = lane & 15, dd = 1 << (2 * p);
    const float* PD = (const float*)(D.dec + DEC_PD) + (size_t)bd * NIN;
    const f32x4 rr0 = *(const f32x4*)(rope + ((size_t)8192 * 32 + ((4 * dq) & 31)) * 2), rr1 = *(const f32x4*)(rope + ((size_t)8192 * 32 + ((4 * dq) & 31)) * 2 + 4);
    const f32x4 cs = {rr0[0], rr0[2], rr1[0], rr1[2]}, sn = {rr0[1], rr0[3], rr1[1], rr1[3]};
    const float sgn = dq < 8 ? -1.f : 1.f;
    f32x4 q = *(const f32x4*)(PD + h * 64 + 4 * dq), kn = *(const f32x4*)(PD + 512 + h * 64 + 4 * dq); const f32x4 vn = *(const f32x4*)(PD + 1024 + h * 64 + 4 * dq);
    { f32x4 qp, kp;
#pragma unroll
      for (int e = 0; e < 4; ++e) { qp[e] = __shfl_xor(q[e], 8); kp[e] = __shfl_xor(kn[e], 8); }
      q = q * cs + qp * sn * sgn; kn = kn * cs + kp * sn * sgn; }
    if (p == 0 && g == 0) { *(f32x4*)(D.out + O_KS + ((size_t)D.l * MD + bd) * 512 + h * 64 + 4 * dq) = kn; *(f32x4*)(D.out + O_VS + ((size_t)D.l * MD + bd) * 512 + h * 64 + 4 * dq) = vn; }
    float s0 = (q[0] * kn[0] + q[1] * kn[1]) + (q[2] * kn[2] + q[3] * kn[3]);
#pragma unroll
    for (int o = 1; o < 16; o <<= 1) s0 += __shfl_xor(s0, o);
    s0 *= 0.125f;
    const size_t cbase = (((size_t)D.l * MD + bd) * 2048) * 512 + h * 64 + 4 * dq;
    float mx = -INFINITY, den = 0.f; f32x4 o4 = {0.f, 0.f, 0.f, 0.f};
#pragma unroll 8
    for (int it = 0; it < 32; ++it) { const int j = 1 + 4 * it + g; const size_t off = cbase + (size_t)(2048 - j * dd) * 512;
        const f32x4 kr = ldf4nt(ck + off); const f32x4 vr = ldf4nt(cv + off);
        float s = (q[0] * kr[0] + q[1] * kr[1]) + (q[2] * kr[2] + q[3] * kr[3]);
#pragma unroll
        for (int o = 1; o < 16; o <<= 1) s += __shfl_xor(s, o);
        s *= 0.125f;
        const float mn = fmaxf(mx, s), sc = fexp(mx - mn), pj = fexp(s - mn);
        den = den * sc + pj; o4 = o4 * sc + vr * pj; mx = mn; }
    float mg = fmaxf(mx, __shfl_xor(mx, 16)); mg = fmaxf(mg, __shfl_xor(mg, 32)); mg = fmaxf(mg, s0);
    { const float sc = fexp(mx - mg); den *= sc; o4 = o4 * sc; }
    den += __shfl_xor(den, 16); den += __shfl_xor(den, 32);
#pragma unroll
    for (int e = 0; e < 4; ++e) { o4[e] += __shfl_xor(o4[e], 16); o4[e] += __shfl_xor(o4[e], 32); }
    const float p0 = fexp(s0 - mg); den += p0; o4 = (o4 + vn * p0) * (1.0f / den); mx = mg;
    if (g == 0) *(f32x4*)((float*)(D.dec + DEC_OP) + ((size_t)p * MD + bd) * 512 + h * 64 + 4 * dq) = o4;
    if (lane == 0) ((float*)(D.dec + DEC_LSE))[((size_t)p * MD + bd) * 8 + h] = mx + __logf(den);
}
DI void dec_rwkv_task(const DecP& D, const float* const* in, int bd, int h, LAS float* sv  , int lane) {
    const int l = D.l, ch = h * 64 + lane;
    const float* PD = (const float*)(D.dec + DEC_PD) + (size_t)bd * NIN + RW0; const float* PS = (const float*)(D.dec + DEC_PS) + (size_t)bd * NRWU;
    const float* mu = in[8] + (size_t)l * 1792;
    auto zf = [&](int col) { const float pr = PD[col], pv = PS[col]; return pr + (pv - pr) * mu[col]; };
    const float zr = zf(ch), zk = zf(512 + ch), zv0 = zf(1024 + ch);
    float vl = 0.f; if (l > 0 && lane < 32) { const float pr = PD[1792 + lane], pv = PS[1792 + lane]; vl = pr + (pv - pr) * in[9][(size_t)(l - 1) * 32 + lane]; }
    sv[lane] = ftanh(zf(1536 + lane)); sv[64 + lane] = zf(1600 + lane); sv[128 + lane] = fsigmoid(zf(1664 + lane)); sv[192 + lane] = fsigmoid(zf(1728 + lane)); sv[256 + lane] = vl;
    LDS_WAIT();
    float dw = 0.f, da = 0.f, dv = 0.f, gt = 0.f;
    { const unsigned char* wsb = D.dec - WS_DEC;
      const bf16* du = (const bf16*)(wsb + WS_DUPT) + ((size_t)l * 512 + ch) * 64; const bf16* iu = (const bf16*)(wsb + WS_IUPT) + ((size_t)l * 512 + ch) * 64; const bf16* gu = (const bf16*)(wsb + WS_GUPT) + ((size_t)l * 512 + ch) * 128;
#define DOT8(acc_, t_, base_) do { const f32x4 x0_ = *(const LAS f32x4*)(sv + (base_)), x1_ = *(const LAS f32x4*)(sv + (base_) + 4); \
        acc_ += (x0_[0] * bflo((t_).x) + x0_[1] * bfhi((t_).x)) + (x0_[2] * bflo((t_).y) + x0_[3] * bfhi((t_).y)) + (x1_[0] * bflo((t_).z) + x1_[1] * bfhi((t_).z)) + (x1_[2] * bflo((t_).w) + x1_[3] * bfhi((t_).w)); \
        asm volatile("" : "+v"(acc_) :: "memory"); } while (0)
      { v4u tu[8], ti[8];
#pragma unroll
        for (int i = 0; i < 8; ++i) { tu[i] = *(const v4u*)(du + 8 * i); ti[i] = *(const v4u*)(iu + 8 * i); }
        asm volatile("" ::: "memory");
#pragma unroll
        for (int i = 0; i < 8; ++i) { DOT8(dw, tu[i], 8 * i); DOT8(da, ti[i], 64 + 8 * i); } }
      { v4u tg[16], tv[4];
#pragma unroll
        for (int i = 0; i < 16; ++i) tg[i] = *(const v4u*)(gu + 8 * i);
#pragma unroll
        for (int i = 0; i < 4; ++i) tv[i] = (v4u){0u, 0u, 0u, 0u};
        if (l > 0) { const bf16* vu = (const bf16*)(wsb + WS_VUPT) + ((size_t)(l - 1) * 512 + ch) * 32;
#pragma unroll
            for (int i = 0; i < 4; ++i) tv[i] = *(const v4u*)(vu + 8 * i); }
        asm volatile("" ::: "memory");
#pragma unroll
        for (int i = 0; i < 16; ++i) DOT8(gt, tg[i], 128 + 8 * i);
#pragma unroll
        for (int i = 0; i < 4; ++i) DOT8(dv, tv[i], 256 + 8 * i); }
#undef DOT8
    }
    const float w = -fsoftplus(-(in[10][(size_t)l * 512 + ch] + dw)) - 0.5f, decay = fexp(-fexp(w));
    const float a = fsigmoid(in[12][(size_t)l * 512 + ch] + da);
    float* VFD = (float*)(D.dec + DEC_VF) + (size_t)bd * 512 + ch;
    float v = zv0; if (l == 0) *VFD = zv0; else v = zv0 + (*VFD - zv0) * fsigmoid(in[15][(size_t)(l - 1) * 512 + ch] + dv);
    const float kr = zk * in[17][(size_t)l * 512 + ch]; const float kn = kr / fmaxf(sqrtf(wave_sum(kr * kr)), 1e-12f);
    const float k2 = zk * (1.f + (a - 1.f) * in[18][(size_t)l * 512 + ch]);
    const float bon = wave_sum(zr * k2 * in[19][(size_t)l * 512 + ch]);
    LDS_WAIT();
    sv[320 + lane] = -kn; sv[384 + lane] = decay; sv[448 + lane] = kn * a; sv[512 + lane] = k2; sv[576 + lane] = zr; sv[640 + lane] = v;
    LDS_WAIT();
    const float* S0 = in[3] + (((size_t)l * MD + bd) * NH + h) * 4096;
    float* So = D.out + O_WKS + (((size_t)l * MD + bd) * NH + h) * 4096;
    { const int rr = lane >> 4, cq = lane & 15;
      const f32x4 a4 = *(const LAS f32x4*)(sv + 320 + 4 * cq), w4 = *(const LAS f32x4*)(sv + 384 + 4 * cq), b4 = *(const LAS f32x4*)(sv + 448 + 4 * cq), k4 = *(const LAS f32x4*)(sv + 512 + 4 * cq), r4 = *(const LAS f32x4*)(sv + 576 + 4 * cq);
      f32x4 Sr[16];
#pragma unroll
      for (int q = 0; q < 16; ++q) Sr[q] = *(const f32x4*)(S0 + (size_t)(4 * q + rr) * 64 + 4 * cq);
#pragma unroll
      for (int q = 0; q < 16; ++q) { const int i = 4 * q + rr;
          float sa = (Sr[q][0] * a4[0] + Sr[q][1] * a4[1]) + (Sr[q][2] * a4[2] + Sr[q][3] * a4[3]);
#pragma unroll
          for (int o = 1; o < 16; o <<= 1) sa += __shfl_xor(sa, o);
          const float vi = sv[640 + i];
          const f32x4 s4 = Sr[q] * w4 + b4 * sa + k4 * vi; *(f32x4*)(So + (size_t)i * 64 + 4 * cq) = s4;
          float yp = (s4[0] * r4[0] + s4[1] * r4[1]) + (s4[2] * r4[2] + s4[3] * r4[3]);
#pragma unroll
          for (int o = 1; o < 16; o <<= 1) yp += __shfl_xor(yp, o);
          if (cq == 0) sv[704 + i] = yp; } }
    LDS_WAIT();
    const float y = sv[704 + lane];
    const float mean = wave_sum(y) * (1.f / 64.f), dy = y - mean, var = wave_sum(dy * dy) * (1.f / 64.f);
    const float o = (dy * (1.0f / sqrtf(var + GN_EPS)) * in[20][(size_t)l * 512 + ch] + in[21][(size_t)l * 512 + ch] + bon * v) * gt;
    ((float*)(D.dec + DEC_MIX))[(size_t)bd * DM + 512 + ch] = o;
    LDS_WAIT();
}
DI void dec_finalize_row(const DecP& D, const float* gain, int bd, int lane) {
    const int h = lane >> 3; const float* L = (const float*)(D.dec + DEC_LSE); const float* OPD = (const float*)(D.dec + DEC_OP);
    const float l0 = L[((size_t)0 * MD + bd) * 8 + h], l1 = L[((size_t)1 * MD + bd) * 8 + h], l2 = L[((size_t)2 * MD + bd) * 8 + h];
    const float mx = fmaxf(l0, fmaxf(l1, l2)); float w0 = fexp(l0 - mx), w1 = fexp(l1 - mx), w2 = fexp(l2 - mx); const float inv = 1.0f / (w0 + w1 + w2); w0 *= inv; w1 *= inv; w2 *= inv;
    float v[8]; float ss = 0.f;
#pragma unroll
    for (int e = 0; e < 8; ++e) { v[e] = w0 * OPD[((size_t)0 * MD + bd) * 512 + lane * 8 + e] + w1 * OPD[((size_t)1 * MD + bd) * 512 + lane * 8 + e] + w2 * OPD[((size_t)2 * MD + bd) * 512 + lane * 8 + e]; ss += v[e] * v[e]; }
    ss = wave_sum(ss); const float rinv = 1.0f / sqrtf(ss * (1.f / 512.f) + RMS_EPS);
    bf16* MB = (bf16*)(D.dec + DEC_MIXB) + (size_t)bd * DM; const float* MX = (const float*)(D.dec + DEC_MIX) + (size_t)bd * DM + 512;
#pragma unroll
    for (int e = 0; e < 8; ++e) { MB[lane * 8 + e] = (bf16)f2bf(v[e] * rinv * gain[lane * 8 + e]); MB[512 + lane * 8 + e] = (bf16)f2bf(MX[lane * 8 + e]); }
}
#ifndef PH_MASK
#define PH_MASK 0x1ff
#endif
#define PH_ON(k) ((PH_MASK >> (k)) & 1)
#ifndef PH_DUP
#define PH_DUP 0
#endif
#define PH_REP(k) for (int rep_ = 0; rep_ < (((PH_DUP >> (k)) & 1) ? 2 : 1); ++rep_)
DI unsigned lds_task_next(volatile LAS unsigned* ctr, int lane) {
    unsigned t = 0; if (lane == 0) t = __hip_atomic_fetch_add((LAS unsigned*)ctr, 1u, __ATOMIC_RELAXED, __HIP_MEMORY_SCOPE_WORKGROUP);
    return (unsigned)__builtin_amdgcn_readfirstlane((int)t);
}
DI DecP make_dec(unsigned char* ws, const float* const* in, float* out, int l) {
    DecP D; D.dec = ws + WS_DEC; D.l = l; D.xs = in[1];
    D.c1in = (const float*)(ws + WS_C1IN) + l * NIN; D.c2in = (const float*)(ws + WS_C2IN) + l * NIN; D.c1up = (const float*)(ws + WS_C1UP) + l * FFD; D.c2up = (const float*)(ws + WS_C2UP) + l * FFD;
    D.g1 = in[24] + (size_t)l * DM; D.b1 = in[25] + (size_t)l * DM; D.g2p = l > 0 ? in[28] + (size_t)(l - 1) * DM : nullptr; D.b2p = l > 0 ? in[29] + (size_t)(l - 1) * DM : nullptr;
    D.win = (const bf16*)(ws + WS_WIN) + (size_t)l * NIN * DM; D.winu = (const bf16*)(ws + WS_WINU) + (size_t)l * NRWU * DM; D.wout = (const bf16*)(ws + WS_WOUT) + (size_t)l * DM * DM;
    D.wup = (const bf16*)(ws + WS_WUP) + (size_t)l * FFD * DM; D.wdn = (const bf16*)(ws + WS_WDN) + (size_t)l * DM * FFD; D.out = out; return D;
}
DI RwkvP make_rwkv(unsigned char* ws, const float* const* in, int l) {
    RwkvP R; R.PR = (const bf16*)(ws + WS_PR); R.mu = in[8] + (size_t)l * 1792; R.muv = l > 0 ? in[9] + (size_t)(l - 1) * 32 : nullptr;
    R.dbase = in[10] + (size_t)l * 512; R.ibase = in[12] + (size_t)l * 512; R.vbase = l > 0 ? in[15] + (size_t)(l - 1) * 512 : nullptr; R.ksk = in[17] + (size_t)l * 512; R.ksa = in[18] + (size_t)l * 512; R.brk = in[19] + (size_t)l * 512;
    R.gng = in[20] + (size_t)l * 512; R.gnb = in[21] + (size_t)l * 512;
    R.dupT = (const bf16*)(ws + WS_DUPT) + (size_t)l * 512 * 64; R.iupT = (const bf16*)(ws + WS_IUPT) + (size_t)l * 512 * 64; R.vupT = l > 0 ? (const bf16*)(ws + WS_VUPT) + (size_t)(l - 1) * 512 * 32 : nullptr; R.gupT = (const bf16*)(ws + WS_GUPT) + (size_t)l * 512 * 128;
    R.ZROW = (const bf16*)(ws + WS_CTL + 512 * 1024); R.VF = (bf16*)(ws + WS_VF); R.VV = (bf16*)(ws + WS_VV); R.BON = (float*)(ws + WS_BON); R.GC = (float*)(ws + WS_GC); R.W1S = (bf16*)(ws + WS_PT); R.REFF = (bf16*)(ws + WS_REFF); R.BM = (bf16*)(ws + WS_QT); R.REC = (v4u*)(ws + WS_YLOC);
    R.YPRE = (float*)(ws + WS_YPRE); R.MIX = (bf16*)(ws + WS_MIX); R.layer0 = (l == 0); return R;
}
#define PHASE_VARS() int tid_p = (int)threadIdx.x; asm volatile("" : "+v"(tid_p)); const int lane = tid_p & 63; const int wave = __builtin_amdgcn_readfirstlane(tid_p >> 6); \
    unsigned zo_p; asm volatile("s_mov_b32 %0, 0" : "=s"(zo_p)); unsigned char* ws = args.ws + zo_p; const float* const* in = args.in + zo_p; float* out = args.out + zo_p; \
    const int gw = F.vcu * NWAVES + wave; const int rgw = (F.G - 1 - (int)blockIdx.x) * NWAVES + wave; LAS float* dsc = (LAS float*)(L3 + 65536); LAS float* dred = (LAS float*)L3; const int rwg = F.G - 1 - (int)blockIdx.x; (void)gw; (void)rgw; (void)dsc; (void)dred; (void)rwg; (void)lane; (void)in; (void)out
__global__ void __launch_bounds__(NWAVES * 64, 2) mega_fwd(Args args) {
    extern __shared__ __attribute__((aligned(16))) unsigned char lds[];
    Frame F;
    F.lds = lds; F.MISC = (volatile LAS unsigned*)((LAS unsigned char*)lds + MISC_OFF);
    F.tid = threadIdx.x; F.lane = F.tid & 63; F.wave = __builtin_amdgcn_readfirstlane(F.tid >> 6);
    F.G = gridDim.x; { const int bx = blockIdx.x; F.vcu = (F.G % 8 == 0) ? (bx % 8) * (F.G / 8) + bx / 8 : bx; }
    F.gw = F.vcu * NWAVES + F.wave; F.NGW = F.G * NWAVES;
    F.in = args.in; F.out = args.out; F.ws = args.ws; F.ctl = (gu32*)(args.ws + WS_CTL);
    LAS unsigned char* L3 = (LAS unsigned char*)lds;
    for (int u = F.tid; u < (LDS_BYTES - RING_BYTES) / 4; u += NWAVES * 64) ((LAS unsigned*)(L3 + RING_BYTES))[u] = 0u;
    __syncthreads();
    XcdBarrier bar = xcd_barrier_post((unsigned*)(F.ctl + CW_BAR), F.MISC + 8);
#define GRID_BAR() do { XcdBarrier b2_ = bar; asm volatile("" : "+s"(b2_.x)); xcd_barrier(b2_); } while (0)

    PH_REP(0) { if (PH_ON(0)) p0_prologue(F);
    GRID_BAR(); }

    for (int l = 0; l < DEPTH; ++l) {
        PH_REP(1) {
        if (PH_ON(1))
        {   PHASE_VARS(); const DecP D = make_dec(ws, in, out, l);
            pg8::Gemm g{(const pg8::bf16_t*)(ws + WS_XB2), (const pg8::bf16_t*)D.win, M, NIN, DM}; pg8::StaticOrder S; S.init(M, NIN, F.G, (int)blockIdx.x);
            pg8::etab_fill((PG8_LAS unsigned char*)L3, S, (const float*)(ws + WS_STAT2), D.c1in, D.c2in, l > 0, tid_p); __syncthreads();
            pg8::EpiIn E{ws, out, l, (const PG8_LAS unsigned char*)L3};
            pg8::gemm_phase<pg8::EpiIn, pg8::StaticOrder, true, true>((PG8_LAS unsigned char*)L3, g, S, E, tid_p);
            if (rwg < 128) for (int u = rwg; u < 162; u += 128) dec_unit_in(D, u, dred, dsc, wave, lane);
        }
        GRID_BAR();
        }

#ifdef PROBE_MODE
#define TSB(on) do { if ((on) && l == PROBE_L) { __syncthreads(); if (__builtin_amdgcn_readfirstlane(F.tid >> 6) == 0) { const unsigned tl_ = (unsigned)__builtin_amdgcn_s_memrealtime(); const unsigned so_ = 790528u + (unsigned)blockIdx.x * 4u; \
        asm volatile("s_store_dword %0, %1, %2\n\ts_waitcnt lgkmcnt(0)\n\ts_dcache_wb\n\ts_waitcnt lgkmcnt(0)" :: "s"(tl_), "s"(args.ws), "s"(so_) : "memory"); } } } while (0)
#else
#define TSB(on) do {} while (0)
#endif
#ifdef PROBE_A
#define TS(i) do { if (l == 1 && blockIdx.x == PROBE_WG) { const unsigned tl_ = (unsigned)__builtin_amdgcn_s_memrealtime(); const unsigned so_ = 786432u + (unsigned)((i) * 8 + __builtin_amdgcn_readfirstlane(F.tid >> 6)) * 4u; \
        asm volatile("s_store_dword %0, %1, %2\n\ts_waitcnt lgkmcnt(0)" :: "s"(tl_), "s"(args.ws), "s"(so_) : "memory"); } } while (0)
#else
#define TS(i) do {} while (0)
#endif
#define ATT_QUEUE() do { LAS unsigned char* wl_ = L3 + wave * 10240; const int bh_ = F.vcu >> 4; unsigned* pool_ = (unsigned*)(F.ctl + CW_POOL + (l * 16 + bh_) * 64); \
        for (;;) { unsigned t_ = lds_task_next(F.MISC, lane); int span_ = F.vcu & 15; \
            if (t_ >= 40u) { unsigned q_ = 0u; if (lane == 0) q_ = __hip_atomic_fetch_add(pool_, 1u, __ATOMIC_RELAXED, __HIP_MEMORY_SCOPE_AGENT); q_ = (unsigned)__builtin_amdgcn_readfirstlane((int)q_); \
                if (q_ >= 128u) break; t_ = 40u + (q_ >> 4); span_ = (int)(q_ & 15u); }        \
            const int p_ = (int)t_ >> 4, idx_ = (int)t_ & 15; \
            const int cls_ = p_ == 0 ? 0 : p_ == 1 ? (idx_ >> 2) : idx_, qblk_ = p_ == 0 ? span_ * 16 + idx_ : p_ == 1 ? span_ * 4 + (idx_ & 3) : span_; \
            attn_task((const bf16*)(ws + WS_QB), (const bf16*)(ws + WS_KB), (const bf16*)(ws + WS_VB), (bf16*)(ws + WS_OP), (float*)(ws + WS_LSE), bh_ >> 3, bh_ & 7, p_, cls_, qblk_, wl_, lane); } } while (0)
        PH_REP(3) {
        if (PH_ON(3))
        {   PHASE_VARS(); const DecP D = make_dec(ws, in, out, l); const RwkvP R = make_rwkv(ws, in, l);
            if (tid_p == 0) F.MISC[0] = 0u; TS(0);
            if (l == 0) colsum_finish(ws, gw * 64 + lane, F.NGW * 64);
            { LAS unsigned char* wl1 = L3 + wave * 12288; LAS unsigned char* hc = L3 + 8 * 12288;
              head_cache_fill(R, (F.vcu >> 4) & 7, hc, tid_p);
              __syncthreads();
#pragma unroll 1
              for (int i = 0; i < 4; ++i) rwkv_b1_unit(R, F.vcu * 32 + wave + 8 * i, wl1, hc, (LAS float*)(L3 + GCT_OFF), lane); }
            VM_WAIT(); __syncthreads(); TS(1);
            if (wave < 4) { chain_pass1(R, (float*)(ws + WS_SEGQ), (float*)(ws + WS_SEGP), F.vcu >> 4, F.vcu & 15, wave, (const LAS float*)(L3 + GCT_OFF), lane); TS(2);
                if (wave != 0) { const int dt = (int)blockIdx.x * 3 + (wave - 1); dec_attn_task(D, in[4], in[5], (const float*)(ws + WS_ROPE), dt / 24, (dt % 24) / 3, dt % 3, lane); }
                else dec_rwkv_task(D, in, (int)blockIdx.x >> 3, (int)blockIdx.x & 7, (LAS float*)(L3 + wave * 10240), lane); TS(3); }
            ATT_QUEUE(); TS(4);
            if ((PH_DUP >> 12) & 1) { __syncthreads(); if (tid_p == 0) F.MISC[0] = 0u; __syncthreads(); ATT_QUEUE(); }
        }
        TSB(PROBE_PH == 1);
        GRID_BAR();
        TS(5);
        }
        PH_REP(9) {
        if (PH_ON(3))
        {   PHASE_VARS(); const DecP D = make_dec(ws, in, out, l); const RwkvP R = make_rwkv(ws, in, l);
            const int seq = F.vcu >> 4, sg = F.vcu & 15;
            LAS unsigned char* gcache = L3 + 98304; gate_cache_fill(R, seq & 7, gcache, tid_p);
            for (int e = tid_p; e < SEGCH * 64; e += NWAVES * 64) ((LAS float*)(L3 + GCT_OFF))[e] = R.GC[(size_t)(seq * NCH + sg * SEGCH) * 64 + e];
            __syncthreads();
            if (wave < 4) chain_pass23(R, (const float*)(ws + WS_SEGQ), (const float*)(ws + WS_SEGP), seq, sg, wave, out + O_WKP + ((size_t)l * 16 + seq) * 4096, (const LAS float*)(L3 + GCT_OFF), lane);
            else { for (int i = 0; i < 16; ++i) attn_finalize_row((const bf16*)(ws + WS_OP), (const float*)(ws + WS_LSE), in[22] + (size_t)l * 512, (bf16*)(ws + WS_MIX), (int)blockIdx.x * 64 + (wave - 4) * 16 + i, lane);
                if (blockIdx.x < MD && wave == 4) dec_finalize_row(D, in[22] + (size_t)l * 512, (int)blockIdx.x, lane); }
            VM_WAIT(); __syncthreads();
#pragma unroll 1
            for (int i = 0; i < 4; ++i) rwkv_b3_unit(R, seq * NCH + sg * SEGCH + wave + 8 * i, gcache, L3 + wave * 12288, lane);
        }
        GRID_BAR();
        }

        PH_REP(5) {
        if (PH_ON(5))
        {   PHASE_VARS(); const DecP D = make_dec(ws, in, out, l);
            pg8::Gemm g{(const pg8::bf16_t*)(ws + WS_MIX), (const pg8::bf16_t*)D.wout, M, DM, DM}; pg8::StaticOrder S; S.init(M, DM, F.G, (int)blockIdx.x);
            pg8::EpiRes<false> E{ws, in, out, l};
            pg8::gemm_phase<pg8::EpiRes<false>, pg8::StaticOrder, false, true>((PG8_LAS unsigned char*)L3, g, S, E, tid_p);
            for (int u = rwg; u < 32; u += F.G)
                dec_unit_res((const bf16*)(D.dec + DEC_MIXB), D.wout, DM, u, l == 0, l == 0 ? D.xs : (const float*)(D.dec + DEC_T2), (const float*)(D.dec + DEC_ST2), D.g2p, D.b2p, (float*)(D.dec + DEC_T1), (bf16*)(D.dec + DEC_XB1), (float*)(D.dec + DEC_ST1),
                             out + O_SHS + (size_t)l * MD * DM, dred, dsc, wave, lane);
        }
        GRID_BAR();
        }

        PH_REP(6) {
        if (PH_ON(6))
        {   PHASE_VARS(); const DecP D = make_dec(ws, in, out, l);
            pg8::Gemm g{(const pg8::bf16_t*)(ws + WS_XB1), (const pg8::bf16_t*)D.wup, M, FFD, DM}; pg8::StaticOrder S; S.init(M, FFD, F.G, (int)blockIdx.x);
            pg8::etab_fill((PG8_LAS unsigned char*)L3, S, (const float*)(ws + WS_STAT1), D.c1up, D.c2up, true, tid_p); __syncthreads();
            pg8::EpiUp E{ws, (const PG8_LAS unsigned char*)L3};
            pg8::gemm_phase<pg8::EpiUp, pg8::StaticOrder, true, true>((PG8_LAS unsigned char*)L3, g, S, E, tid_p);
            for (int u = rwg; u < 128; u += F.G) dec_unit_up(D, u, dred, dsc, wave, lane);
        }
        GRID_BAR();
        }

        PH_REP(7) {
        if (PH_ON(7))
        {   PHASE_VARS(); const DecP D = make_dec(ws, in, out, l);
            pg8::Gemm g{(const pg8::bf16_t*)(ws + WS_H), (const pg8::bf16_t*)D.wdn, M, DM, FFD}; pg8::StaticOrder S; S.init(M, DM, F.G, (int)blockIdx.x);
            pg8::EpiRes<true> E{ws, in, out, l};
            PH_REP(11) { pg8::gemm_phase<pg8::EpiRes<true>, pg8::StaticOrder, false, true>((PG8_LAS unsigned char*)L3, g, S, E, tid_p); }
            PH_REP(10) for (int u = rwg; u < 32; u += F.G)
                dec_unit_res((const bf16*)(D.dec + DEC_HB), D.wdn, FFD, u, false, (const float*)(D.dec + DEC_T1), (const float*)(D.dec + DEC_ST1), D.g1, D.b1, (float*)(D.dec + DEC_T2), (bf16*)(D.dec + DEC_XB2), (float*)(D.dec + DEC_ST2), nullptr, dred, dsc, wave, lane);
        }
        GRID_BAR();
        }
    }
    if (PH_ON(8))
    {   PHASE_VARS(); const float* g = in[28] + (size_t)3 * DM; const float* b = in[29] + (size_t)3 * DM;
        for (int r = gw; r < M; r += F.NGW) { float mu, rs; pg8::row_stats((const float*)(ws + WS_STAT2), r, mu, rs);
            const v2u* t = (const v2u*)((const bf16*)(ws + WS_XB2) + (size_t)r * DM) + lane; f32x4* o = (f32x4*)(out + O_Y + (size_t)r * DM) + lane;
#pragma unroll
            for (int j = 0; j < 4; ++j) { const f32x4 gg = *((const f32x4*)g + lane + 64 * j), bb = *((const f32x4*)b + lane + 64 * j); const v2u w = t[64 * j]; const f32x4 tv = {bflo(w.x), bfhi(w.x), bflo(w.y), bfhi(w.y)}; o[64 * j] = (tv - mu) * rs * gg + bb; } }
        if (rgw < MD) { LAS float* fsc = dsc + wave * 64; dec_row_stats((const float*)(ws + WS_DEC + DEC_ST2), fsc, lane); const float mu = fsc[2 * rgw], rs = fsc[2 * rgw + 1];
            const f32x4* t = (const f32x4*)((const float*)(ws + WS_DEC + DEC_T2) + (size_t)rgw * DM) + lane; f32x4* o = (f32x4*)(out + O_YS + (size_t)rgw * DM) + lane;
#pragma unroll
            for (int j = 0; j < 4; ++j) { const f32x4 gg = *((const f32x4*)g + lane + 64 * j), bb = *((const f32x4*)b + lane + 64 * j); o[64 * j] = (t[64 * j] - mu) * rs * gg + bb; } }
    }
#ifdef PROBE_A
    if (blockIdx.x == PROBE_WG) { unsigned a_, b_;
        asm volatile("s_dcache_wb\n\ts_load_dword %0, %2, %3 glc\n\ts_load_dword %1, %2, %4 glc\n\ts_waitcnt lgkmcnt(0)" : "=&s"(a_), "=&s"(b_) : "s"(args.ws), "s"(786432u + PROBE_A * 4u), "s"(786432u + PROBE_B * 4u) : "memory");
        const unsigned d_ = (b_ - a_) * 64u; const unsigned t0_ = (unsigned)__builtin_amdgcn_s_memrealtime();
        while ((unsigned)__builtin_amdgcn_s_memrealtime() - t0_ < d_) { __builtin_amdgcn_s_sleep(8); } }
#endif
#ifdef PROBE_MODE
    if (blockIdx.x == 0) { unsigned mx = 0u, mn = 0xffffffffu, amx = 0u, amn = 0u, cnt = 0u;
        for (unsigned i = 0; i < 256u; ++i) { unsigned v; asm volatile("s_load_dword %0, %1, %2 glc\n\ts_waitcnt lgkmcnt(0)" : "=s"(v) : "s"(args.ws), "s"(790528u + i * 4u) : "memory"); if (v > mx) { mx = v; amx = i; } if (v < mn) { mn = v; amn = i; } }
        for (unsigned i = 0; i < 256u; ++i) { unsigned v; asm volatile("s_load_dword %0, %1, %2 glc\n\ts_waitcnt lgkmcnt(0)" : "=s"(v) : "s"(args.ws), "s"(790528u + i * 4u) : "memory"); if (v + PROBE_THR * 100u > mx && (PROBE_MODE != 5 || i >= 192u) && (PROBE_MODE != 6 || (i & 7u) == (amx & 7u))) ++cnt; }
        const unsigned d_ = PROBE_MODE == 1 ? amx * 1000u : PROBE_MODE == 2 ? (mx - mn) * 64u : (PROBE_MODE == 3 || PROBE_MODE == 5 || PROBE_MODE == 6) ? cnt * 1000u : amn * 1000u; const unsigned t0_ = (unsigned)__builtin_amdgcn_s_memrealtime();
        while ((unsigned)__builtin_amdgcn_s_memrealtime() - t0_ < d_) { __builtin_amdgcn_s_sleep(8); } }
#endif
}

extern "C" void kernel_launch(void* const* d_in, const int* in_sizes, int n_in, void* d_out, int out_size, void* d_ws, size_t ws_size, hipStream_t stream) {
    static int grid = 0;
    if (grid == 0) {
        if (n_in != 30 || out_size != (int)O_END || ws_size < WS_END) { fprintf(stderr, "kernel_launch: unexpected problem (n_in %d, out %d, ws %zu); nothing launched\n", n_in, out_size, ws_size); grid = -1; return; }
        int dev = 0, cus = 0, per_cu = 0;
        if (hipGetDevice(&dev) != hipSuccess || hipDeviceGetAttribute(&cus, hipDeviceAttributeMultiprocessorCount, dev) != hipSuccess) { fprintf(stderr, "kernel_launch: device query failed\n"); grid = -1; return; }
        if (hipFuncSetAttribute((const void*)mega_fwd, hipFuncAttributeMaxDynamicSharedMemorySize, LDS_BYTES) != hipSuccess) { fprintf(stderr, "kernel_launch: hipFuncSetAttribute failed\n"); grid = -1; return; }
        if (hipOccupancyMaxActiveBlocksPerMultiprocessor(&per_cu, (const void*)mega_fwd, NWAVES * 64, LDS_BYTES) != hipSuccess || per_cu < 1) fprintf(stderr, "kernel_launch: occupancy query reports %d\n", per_cu);
        (void)hipGetLastError();
        if (cus < 256) { fprintf(stderr, "kernel_launch: needs 256 CUs (found %d)\n", cus); grid = -1; return; }
        grid = 256;
    }
    if (grid < 0) return;
    if (hipMemsetAsync((char*)d_ws + WS_CTL, 0, CTL_ZERO_BYTES, stream) != hipSuccess) { fprintf(stderr, "kernel_launch: memset failed\n"); return; }
    Args a{};
    for (int i = 0; i < 30; ++i) a.in[i] = (const float*)d_in[i];
    a.out = (float*)d_out; a.ws = (unsigned char*)d_ws;
    hipLaunchKernelGGL(mega_fwd, dim3(grid), dim3(NWAVES * 64), LDS_BYTES, stream, a);
    const hipError_t le = hipPeekAtLastError();
    if (le != hipSuccess) fprintf(stderr, "kernel_launch: launch failed: %s\n", hipGetErrorName(le));
}
```

```cpp
#include <hip/hip_runtime.h>
#include <cstdio>
#include <cstdint>
#include <cmath>
namespace pg8 {
#define PG8_LAS __attribute__((address_space(3)))
typedef unsigned short bf16_t;
typedef short bf16x8 __attribute__((ext_vector_type(8)));
typedef float f32x4 __attribute__((ext_vector_type(4)));
typedef unsigned u32x4 __attribute__((ext_vector_type(4)));
constexpr int BM = 256, BK = 64, HALF = 128, HTB = HALF * BK * 2  , STAGE_BYTES = 8 * HTB, NXCD = 8, WGM = 8;

__host__ __device__ __forceinline__ int lds_byte(int r, int c) { const int st = (r >> 4) * 2 + (c >> 5), rr = r & 15, cc = c & 31, ob = rr * 64 + cc * 2; return st * 1024 + (ob ^ (((ob >> 9) & 1) << 5)); }
__host__ __device__ __forceinline__ void stage_rc(int b, int& R, int& C) { const int st = b / 1024, sb = b % 1024, swz = sb ^ (((sb >> 9) & 1) << 5); R = (st >> 1) * 16 + swz / 64; C = (st & 1) * 32 + (swz % 64) / 2; }
__host__ __device__ __forceinline__ int perm32(int rho) { const int n = rho >> 4, i = rho & 15; return 8 * (i >> 2) + 4 * n + (i & 3); }

struct Unit { int pm, pn; };
struct Gemm { const bf16_t* A; const bf16_t* Bt; int M, N, K; };

struct StaticOrder {
    int nM, nN, nwg, G, c;
    __host__ __device__ void init(int M, int N, int G_, int c_) { nM = M / BM; nN = N / BM; nwg = nM * nN; G = G_; c = c_; }
    __host__ __device__ bool next(int i, Unit& u) const {
        const long L = (long)i * G + c; if (L >= nwg) return false;
        int wgid = (int)L; { const int q = nwg / NXCD, r = nwg % NXCD, xcd = wgid % NXCD, off = wgid / NXCD; wgid = (xcd < r ? xcd * (q + 1) : r * (q + 1) + (xcd - r) * q) + off; }
        const int nig = WGM * nN, gid = wgid / nig, fm = gid * WGM, gsz = (nM - fm) < WGM ? (nM - fm) : WGM;
        u.pm = fm + ((wgid % nig) % gsz); u.pn = (wgid % nig) / gsz; return true;
    }
    __device__ __forceinline__ void a_ready(const Unit&) const {}
    __device__ __forceinline__ void done(const Unit&) const {}
};

__device__ __forceinline__ unsigned cvt_pk_bf16(float lo, float hi) { unsigned r; asm volatile("v_cvt_pk_bf16_f32 %0, %1, %2" : "=v"(r) : "v"(lo), "v"(hi)); return r; }
typedef float f32x2 __attribute__((ext_vector_type(2)));
constexpr size_t WSO_C1IN = 1u << 20, WSO_C2IN = WSO_C1IN + 4 * 3584 * 4, WSO_C1UP = WSO_C2IN + 4 * 3584 * 4, WSO_C2UP = WSO_C1UP + 4 * 4096 * 4, WSO_ROPE = 3u << 20, WSO_STAT1 = 8u << 20, WSO_STAT2 = 9u << 20;
constexpr size_t WSO_XB2 = 132ull << 20, WSO_XB1 = 164ull << 20, WSO_T1 = 196ull << 20, WSO_T2 = 260ull << 20, WSO_QB = 324ull << 20, WSO_KB = 340ull << 20, WSO_VB = 356ull << 20, WSO_PR = 372ull << 20, WSO_H = 580ull << 20;
constexpr size_t OO_SHP = 16809984, OO_KP = 21405696, OO_VP = 29794304;
__device__ __forceinline__ void row_stats(const float* stat, int row, float& mu, float& rs) {
    const f32x4 a = *(const f32x4*)(stat + (size_t)row * 8), b = *(const f32x4*)(stat + (size_t)row * 8 + 4);
    const float s = (a[0] + a[2]) + (b[0] + b[2]), q = (a[1] + a[3]) + (b[1] + b[3]);
    mu = s * (1.f / 1024.f); const float var = fmaxf(q * (1.f / 1024.f) - mu * mu, 0.f); rs = 1.0f / sqrtf(var + 1e-5f);
}
typedef float f32x2e __attribute__((ext_vector_type(2)));
typedef unsigned u32x2e __attribute__((ext_vector_type(2)));
constexpr int ETAB_OFF = 132096, ETAB_SLOT = 4096;
constexpr int ETAB_IDS = ETAB_OFF + 4 * ETAB_SLOT;
template <class Sched> __device__ __forceinline__ void etab_fill(PG8_LAS unsigned char* lds0, const Sched& S, const float* stat, const float* c1, const float* c2, bool fold, int tid) {
#pragma unroll 1
    for (int i = 0; i < 4; ++i) { Unit u; const bool ok = S.next(i, u);
        if (tid == 0) { ((PG8_LAS int*)(lds0 + ETAB_IDS))[2 * i] = ok ? u.pm : -1; ((PG8_LAS int*)(lds0 + ETAB_IDS))[2 * i + 1] = ok ? u.pn : -1; }
        if (!ok) continue;
        PG8_LAS unsigned char* slot = lds0 + ETAB_OFF + i * ETAB_SLOT;
        if (tid < 256) { float mu = 0.f, rs = 1.f; if (fold) row_stats(stat, u.pm * BM + tid, mu, rs); ((PG8_LAS f32x2e*)slot)[tid] = (f32x2e){mu, rs}; }
        else { const int c = u.pn * BM + tid - 256; ((PG8_LAS float*)(slot + 2048))[tid - 256] = fold ? c1[c] : 0.f; ((PG8_LAS float*)(slot + 3072))[tid - 256] = fold ? c2[c] : 0.f; }
    }
}
__device__ __forceinline__ const PG8_LAS unsigned char* etab_find(const PG8_LAS unsigned char* lds0, const Unit& u) {
    const PG8_LAS int* ids = (const PG8_LAS int*)(lds0 + ETAB_IDS); int s = 0;
#pragma unroll
    for (int i = 1; i < 4; ++i) if (ids[2 * i] == u.pm && ids[2 * i + 1] == u.pn) s = i;
    return lds0 + ETAB_OFF + s * ETAB_SLOT;
}
struct EpiIn {
    static constexpr bool PERM = true, AFTER_DRAIN = false;
    unsigned char* ws; float* out; int l; const PG8_LAS unsigned char* lds0;
    __device__ __forceinline__ void operator()(const f32x4 (&acc)[2][2][4][2], const Unit& u, int wr, int wc, int fr, int fq) const {
        asm volatile("" ::: "memory"); __builtin_amdgcn_sched_barrier(0);
        const PG8_LAS unsigned char* slot = etab_find(lds0, u);
        const PG8_LAS f32x2e* st = (const PG8_LAS f32x2e*)slot; const PG8_LAS float* tc1 = (const PG8_LAS float*)(slot + 2048); const PG8_LAS float* tc2 = (const PG8_LAS float*)(slot + 3072);
        bf16_t* QB = (bf16_t*)(ws + WSO_QB); bf16_t* KB = (bf16_t*)(ws + WSO_KB); bf16_t* VB = (bf16_t*)(ws + WSO_VB); bf16_t* PR = (bf16_t*)(ws + WSO_PR); const float* rope = (const float*)(ws + WSO_ROPE);
        float* outk = out + OO_KP + (size_t)l * 2 * 2048 * 512; float* outv = out + OO_VP + (size_t)l * 2 * 2048 * 512; const float qscale = 0.125f * 1.4426950408889634f;
        const int cb = u.pn * BM + wc * 32 + 8 * fq;
        const int i0 = 16 * (wc & 1) + 4 * fq; const bool roped = u.pn < 4;
        const int rbase = u.pm * BM + wr * 64 + fr;
        const int cl = wc * 32 + 8 * fq;
#pragma unroll
        for (int bj = 0; bj < 2; ++bj) {
            f32x4 c1v[2], c2v[2];
#pragma unroll
            for (int n = 0; n < 2; ++n) { c1v[n] = *(const PG8_LAS f32x4*)(tc1 + cl + bj * HALF + n * 4); c2v[n] = *(const PG8_LAS f32x4*)(tc2 + cl + bj * HALF + n * 4); }
            f32x4 ran = {0.f, 0.f, 0.f, 0.f}, rbn = ran;
#pragma unroll
            for (int gq = 0; gq < 8; ++gq) {
                const int ai = gq >> 2, m = gq & 3;
                const int r = rbase + ai * HALF + m * 16;
                const f32x2e ms = st[ai * HALF + wr * 64 + m * 16 + fr]; const float mu = ms.x, rs = ms.y;
                if (gq == 0 && roped) { const float* rp = rope + ((size_t)(r & 8191) * 32 + i0) * 2; ran = *(const f32x4*)rp; rbn = *(const f32x4*)(rp + 4); }
                const f32x4 ra = ran, rb = rbn;
                if (roped && gq < 7) { const int rn = rbase + ((gq + 1) >> 2) * HALF + ((gq + 1) & 3) * 16; const float* rp = rope + ((size_t)(rn & 8191) * 32 + i0) * 2; ran = *(const f32x4*)rp; rbn = *(const f32x4*)(rp + 4); }
                asm volatile("" ::: "memory");
                f32x4 v[2];
#pragma unroll
                for (int n = 0; n < 2; ++n) v[n] = (acc[ai][bj][m][n] - mu * c1v[n]) * rs + c2v[n];
                const int pos = r & 8191, b = r >> 13;
                if (roped) {
                    const f32x4 cs = {ra[0], ra[2], rb[0], rb[2]}, sn = {ra[1], ra[3], rb[1], rb[3]};
                    const int head = (u.pn & 1) * 4 + bj * 2 + (wc >> 1);
                    f32x4 y1 = v[0] * cs - v[1] * sn, y2 = v[0] * sn + v[1] * cs;
                    const size_t o = (size_t)r * 512 + head * 64 + i0;
                    if (u.pn < 2) { y1 = y1 * qscale; y2 = y2 * qscale;
                        u32x2e w; w.x = cvt_pk_bf16(y1[0], y1[1]); w.y = cvt_pk_bf16(y1[2], y1[3]); *(u32x2e*)(QB + o) = w;
                        w.x = cvt_pk_bf16(y2[0], y2[1]); w.y = cvt_pk_bf16(y2[2], y2[3]); *(u32x2e*)(QB + o + 32) = w;
                    } else {
                        u32x2e w; w.x = cvt_pk_bf16(y1[0], y1[1]); w.y = cvt_pk_bf16(y1[2], y1[3]); *(u32x2e*)(KB + o) = w;
                        w.x = cvt_pk_bf16(y2[0], y2[1]); w.y = cvt_pk_bf16(y2[2], y2[3]); *(u32x2e*)(KB + o + 32) = w;
                        if (pos >= 6144) { float* ok = outk + ((size_t)(b * 2048 + pos - 6144)) * 512 + head * 64 + i0; *(f32x4*)ok = y1; *(f32x4*)(ok + 32) = y2; }
                    }
                } else if (u.pn < 6) {
                    const int c = cb + bj * HALF - 1024;
                    u32x4 w; w.x = cvt_pk_bf16(v[0][0], v[0][1]); w.y = cvt_pk_bf16(v[0][2], v[0][3]); w.z = cvt_pk_bf16(v[1][0], v[1][1]); w.w = cvt_pk_bf16(v[1][2], v[1][3]); *(u32x4*)(VB + (size_t)r * 512 + c) = w;
                    if (pos >= 6144) { float* ov = outv + ((size_t)(b * 2048 + pos - 6144)) * 512 + c; *(f32x4*)ov = v[0]; *(f32x4*)(ov + 4) = v[1]; }
                } else {
                    const int c = cb + bj * HALF - 1536;
                    if (c < 1824) { u32x4 w; w.x = cvt_pk_bf16(v[0][0], v[0][1]); w.y = cvt_pk_bf16(v[0][2], v[0][3]); w.z = cvt_pk_bf16(v[1][0], v[1][1]); w.w = cvt_pk_bf16(v[1][2], v[1][3]); *(u32x4*)(PR + (size_t)r * 2048 + c) = w; }
                }
            }
        }
    }
};
template <bool IS_F> struct EpiRes {
    static constexpr bool PERM = true, AFTER_DRAIN = true;
    unsigned char* ws; const float* const* in; float* out; int l;
    __device__ __forceinline__ void fused(f32x4 (&acc)[2][2][4][2], const Unit& u, int wr, int wc, int fr, int fq, PG8_LAS unsigned char* lds, int wid, int lane) const {
        const int raw = (!IS_F && l == 0) ? 1 : 0;
        const bf16_t* src = (const bf16_t*)(ws + (IS_F ? WSO_XB1 : WSO_XB2));
        const float* sstat = (const float*)(ws + (IS_F ? WSO_STAT1 : WSO_STAT2));
        const float* g = IS_F ? in[24] + (size_t)l * 1024 : in[28] + (size_t)(l > 0 ? l - 1 : 0) * 1024; const float* b = IS_F ? in[25] + (size_t)l * 1024 : in[29] + (size_t)(l > 0 ? l - 1 : 0) * 1024;
        bf16_t* XB = (bf16_t*)(ws + (IS_F ? WSO_XB2 : WSO_XB1)); float* ostat = (float*)(ws + (IS_F ? WSO_STAT2 : WSO_STAT1));
        float* shiftout = (IS_F || raw) ? nullptr : out + OO_SHP + (size_t)l * 2 * 1024; const float alpha = 1.6817928305074290f;
        PG8_LAS f32x2e* P = (PG8_LAS f32x2e*)lds;
        const int cb = u.pn * BM + wc * 32 + 8 * fq;
        const int rbase = u.pm * BM + wr * 64 + fr;
        u32x4 cur[2], nxt[2]; f32x4 sa = {0.f, 0.f, 0.f, 0.f}, sb = sa, san = sa, sbn = sa;
#pragma unroll
        for (int bj = 0; bj < 2; ++bj) { cur[bj] = *(const u32x4*)(src + (size_t)rbase * 1024 + cb + bj * HALF); nxt[bj] = cur[bj]; }
        if (!raw) { sa = *(const f32x4*)(sstat + (size_t)rbase * 8); sb = *(const f32x4*)(sstat + (size_t)rbase * 8 + 4); }
#pragma unroll
        for (int gq = 0; gq < 8; ++gq) {
            const int ai = gq >> 2, m = gq & 3;
            const int r = rbase + ai * HALF + m * 16;
            if (gq < 7) { const int rn = rbase + ((gq + 1) >> 2) * HALF + ((gq + 1) & 3) * 16;
#pragma unroll
                for (int bj = 0; bj < 2; ++bj) nxt[bj] = *(const u32x4*)(src + (size_t)rn * 1024 + cb + bj * HALF);
                if (!raw) { san = *(const f32x4*)(sstat + (size_t)rn * 8); sbn = *(const f32x4*)(sstat + (size_t)rn * 8 + 4); } }
            asm volatile("" ::: "memory");
            float mu = 0.f, rs = 1.f;
            if (!raw) { const float ssum = (sa[0] + sa[2]) + (sb[0] + sb[2]), qsum = (sa[1] + sa[3]) + (sb[1] + sb[3]); mu = ssum * (1.f / 1024.f); rs = 1.0f / sqrtf(fmaxf(qsum * (1.f / 1024.f) - mu * mu, 0.f) + 1e-5f); }
            float s = 0.f, q = 0.f;
#pragma unroll
            for (int bj = 0; bj < 2; ++bj) { const int c = cb + bj * HALF; const size_t off = (size_t)r * 1024 + c; const u32x4 cw = cur[bj]; u32x4 wout;
#pragma unroll
                for (int n = 0; n < 2; ++n) {
                    const f32x4 gvv = raw ? (f32x4){1.f, 1.f, 1.f, 1.f} : *(const f32x4*)(g + c + 4 * n), bvv = raw ? (f32x4){0.f, 0.f, 0.f, 0.f} : *(const f32x4*)(b + c + 4 * n);
                    const unsigned w0 = n ? cw.z : cw.x, w1 = n ? cw.w : cw.y;
                    const f32x4 cf = {__builtin_bit_cast(float, w0 << 16), __builtin_bit_cast(float, w0 & 0xffff0000u), __builtin_bit_cast(float, w1 << 16), __builtin_bit_cast(float, w1 & 0xffff0000u)};
                    const f32x4 x = (cf - mu) * rs * gvv + bvv;
                    const f32x4 t = x * alpha + acc[ai][bj][m][n];
                    const unsigned p0 = cvt_pk_bf16(t[0], t[1]), p1 = cvt_pk_bf16(t[2], t[3]); if (n) { wout.z = p0; wout.w = p1; } else { wout.x = p0; wout.y = p1; }
                    s += (t[0] + t[1]) + (t[2] + t[3]); q += (t[0] * t[0] + t[1] * t[1]) + (t[2] * t[2] + t[3] * t[3]);
                    if (shiftout && (r & 8191) == 8191) *(f32x4*)(shiftout + (size_t)(r >> 13) * 1024 + c + 4 * n) = x; }
                *(u32x4*)(XB + off) = wout; }
            s += __shfl_xor(s, 16); s += __shfl_xor(s, 32); q += __shfl_xor(q, 16); q += __shfl_xor(q, 32);
            if (fq == 0) P[(ai * HALF + wr * 64 + m * 16 + fr) * 4 + wc] = (f32x2e){s, q};
#pragma unroll
            for (int bj = 0; bj < 2; ++bj) cur[bj] = nxt[bj];
            sa = san; sb = sbn;
        }
        asm volatile("s_waitcnt lgkmcnt(0)" ::: "memory"); __builtin_amdgcn_s_barrier(); asm volatile("" ::: "memory");
        if (threadIdx.x < 256) { const int row = threadIdx.x; const f32x2e a = P[row * 4 + 0], b2 = P[row * 4 + 1], c = P[row * 4 + 2], d = P[row * 4 + 3];
            *(f32x2e*)(ostat + (size_t)(u.pm * BM + row) * 8 + u.pn * 2) = (f32x2e){(a.x + b2.x) + (c.x + d.x), (a.y + b2.y) + (c.y + d.y)}; }
        asm volatile("s_waitcnt lgkmcnt(0)" ::: "memory"); __builtin_amdgcn_s_barrier(); asm volatile("" ::: "memory");
    }
};
struct EpiUp {
    static constexpr bool PERM = true, AFTER_DRAIN = false;
    unsigned char* ws; const PG8_LAS unsigned char* lds0;
    __device__ __forceinline__ void operator()(const f32x4 (&acc)[2][2][4][2], const Unit& u, int wr, int wc, int fr, int fq) const {
        asm volatile("" ::: "memory"); __builtin_amdgcn_sched_barrier(0);
        bf16_t* H = (bf16_t*)(ws + WSO_H);
        const PG8_LAS unsigned char* slot = etab_find(lds0, u);
        const PG8_LAS f32x2e* st = (const PG8_LAS f32x2e*)slot; const PG8_LAS float* tc1 = (const PG8_LAS float*)(slot + 2048); const PG8_LAS float* tc2 = (const PG8_LAS float*)(slot + 3072);
        const int cb = u.pn * BM + wc * 32 + 8 * fq, cl = wc * 32 + 8 * fq;
#pragma unroll
        for (int bj = 0; bj < 2; ++bj) {
            f32x4 c1v[2], c2v[2];
#pragma unroll
            for (int n = 0; n < 2; ++n) { c1v[n] = *(const PG8_LAS f32x4*)(tc1 + cl + bj * HALF + 4 * n); c2v[n] = *(const PG8_LAS f32x4*)(tc2 + cl + bj * HALF + 4 * n); }
#pragma unroll
            for (int ai = 0; ai < 2; ++ai) {
#pragma unroll
                for (int m = 0; m < 4; ++m) {
                    const int rl = ai * HALF + wr * 64 + m * 16 + fr, r = u.pm * BM + rl;
                    const f32x2e ms = st[rl]; const float mu = ms.x, rs = ms.y;
                    f32x4 v0 = (acc[ai][bj][m][0] - mu * c1v[0]) * rs + c2v[0], v1 = (acc[ai][bj][m][1] - mu * c1v[1]) * rs + c2v[1];
#pragma unroll
                    for (int e = 0; e < 4; ++e) { const float a = fmaxf(v0[e], 0.f), b = fmaxf(v1[e], 0.f); v0[e] = a * a; v1[e] = b * b; }
                    u32x4 w; w.x = cvt_pk_bf16(v0[0], v0[1]); w.y = cvt_pk_bf16(v0[2], v0[3]); w.z = cvt_pk_bf16(v1[0], v1[1]); w.w = cvt_pk_bf16(v1[2], v1[3]);
                    *(u32x4*)(H + (size_t)r * 4096 + cb + bj * HALF) = w; }
            }
        }
    }
};
template <class Epi, class Sched, bool ALIGN_EPI = false, bool SP2 = false>
__device__ __forceinline__ void gemm_phase(PG8_LAS unsigned char* lds, const Gemm g, const Sched& S, const Epi& E, const int tid) {
    const int wid = __builtin_amdgcn_readfirstlane(tid >> 6), lane = tid & 63, wr = wid >> 2, wc = wid & 3, fr = lane & 15, fq = lane >> 4;
    const int K = g.K, nt = K / BK;
    unsigned voffA[2], voffB[2];
#pragma unroll
    for (int i = 0; i < 2; ++i) { int R, C; stage_rc(tid * 16 + i * 8192, R, C); const int Rb = Epi::PERM ? ((R & ~31) + perm32(R & 31)) : R;
        voffA[i] = (unsigned)(R * K + C) * 2u; voffB[i] = (unsigned)(Rb * K + C) * 2u; }
    const size_t kstep = (size_t)(BK * 2);
    const size_t hstep = (size_t)HALF * K * 2;
    const size_t tstep = 2 * hstep;
    const unsigned ldsw = (unsigned)wid * 1024u;
    const int aoff = lds_byte(wr * 64 + fr, fq * 8), boff = lds_byte(wc * 32 + fr, fq * 8);
#define PG8_SA(b, h) (((b) * 2 + (h)) * HTB)
#define PG8_SB(b, h) ((4 + (b) * 2 + (h)) * HTB)
#define PG8_STAGE(bufoff, gbase, voff) do { _Pragma("unroll") for (int _i = 0; _i < 2; ++_i) \
        __builtin_amdgcn_global_load_lds((const unsigned*)((const char*)(gbase) + (voff)[_i]), (PG8_LAS unsigned*)(lds + (bufoff) + ldsw + _i * 8192), 16, 0, 0); } while (0)
#define PG8_LDA(dst, b, h) do { _Pragma("unroll") for (int m = 0; m < 4; ++m) _Pragma("unroll") for (int k = 0; k < 2; ++k) dst[m][k] = *(const PG8_LAS bf16x8*)(lds + PG8_SA(b, h) + aoff + m * 2048 + k * 1024); } while (0)
#define PG8_LDB(dst, b, h) do { _Pragma("unroll") for (int n = 0; n < 2; ++n) _Pragma("unroll") for (int k = 0; k < 2; ++k) dst[n][k] = *(const PG8_LAS bf16x8*)(lds + PG8_SB(b, h) + boff + n * 2048 + k * 1024); } while (0)
#define PG8_MMA(ai, bj, At, Bt) do { __builtin_amdgcn_s_setprio(1); _Pragma("unroll") for (int m = 0; m < 4; ++m) _Pragma("unroll") for (int n = 0; n < 2; ++n) _Pragma("unroll") for (int k = 0; k < 2; ++k) \
        acc[ai][bj][m][n] = __builtin_amdgcn_mfma_f32_16x16x32_bf16(Bt[n][k], At[m][k], acc[ai][bj][m][n], 0, 0, 0); __builtin_amdgcn_s_setprio(0); } while (0)
#define PG8_WAIT_V(n) asm volatile("s_waitcnt vmcnt(" #n ")" ::: "memory")
#define PG8_WAIT_L(n) asm volatile("s_waitcnt lgkmcnt(" #n ")" ::: "memory")
#define PG8_BAR __builtin_amdgcn_s_barrier()
#define PG8_SCHED __builtin_amdgcn_sched_barrier(0)
    Unit cur, nxt; int ui = 0;
    if (!S.next(0, cur)) return;
    f32x4 acc[2][2][4][2];
#pragma unroll
    for (int a = 0; a < 2; ++a)
#pragma unroll
        for (int b = 0; b < 2; ++b)
#pragma unroll
            for (int m = 0; m < 4; ++m)
#pragma unroll
                for (int n = 0; n < 2; ++n) acc[a][b][m][n] = (f32x4){0.f, 0.f, 0.f, 0.f};
    bf16x8 At[4][2], B0[2][2], B1[2][2];
    const char* cA = (const char*)g.A + (size_t)cur.pm * tstep; const char* cB = (const char*)g.Bt + (size_t)cur.pn * tstep;
    S.a_ready(cur);
    if constexpr (SP2) {
        PG8_STAGE(PG8_SB(0, 0), cB, voffB); PG8_STAGE(PG8_SB(0, 1), cB + hstep, voffB); PG8_STAGE(PG8_SA(0, 0), cA, voffA); PG8_STAGE(PG8_SA(0, 1), cA + hstep, voffA);
        if (wr == 1) PG8_BAR;
        PG8_WAIT_V(2); PG8_BAR;
        PG8_STAGE(PG8_SB(1, 0), cB + kstep, voffB); PG8_STAGE(PG8_SA(1, 0), cA + kstep, voffA); PG8_STAGE(PG8_SB(1, 1), cB + hstep + kstep, voffB);
        PG8_WAIT_V(6); PG8_BAR;
    } else {
        PG8_STAGE(PG8_SB(0, 0), cB, voffB); PG8_STAGE(PG8_SA(0, 0), cA, voffA); PG8_STAGE(PG8_SB(0, 1), cB + hstep, voffB); PG8_STAGE(PG8_SA(0, 1), cA + hstep, voffA);
        if (wr == 1) PG8_BAR;
        PG8_WAIT_V(4); PG8_BAR;
        PG8_STAGE(PG8_SB(1, 0), cB + kstep, voffB); PG8_STAGE(PG8_SA(1, 0), cA + kstep, voffA); PG8_STAGE(PG8_SB(1, 1), cB + hstep + kstep, voffB);
        PG8_WAIT_V(6); PG8_BAR;
    }
    for (;;) {
        const bool has_next = S.next(ui + 1, nxt);
        const char* nA = has_next ? (const char*)g.A + (size_t)nxt.pm * tstep : cA; const char* nB = has_next ? (const char*)g.Bt + (size_t)nxt.pn * tstep : cB;
        for (int t = 0; t < nt; t += 2) {
            const bool last = (t == nt - 2);
            const char* a1 = cA + (size_t)(t + 1) * kstep;
            const char* a2 = last ? nA : cA + (size_t)(t + 2) * kstep; const char* b2 = last ? nB : cB + (size_t)(t + 2) * kstep;
            const char* a3 = a2 + kstep; const char* b3 = b2 + kstep;
            if (last && has_next) S.a_ready(nxt);
            if constexpr (SP2) {
            PG8_LDB(B0, 0, 0); PG8_LDB(B1, 0, 1); PG8_SCHED; PG8_LDA(At, 0, 0); PG8_STAGE(PG8_SA(1, 1), a1 + hstep, voffA);
            PG8_WAIT_V(8); PG8_WAIT_L(0); PG8_BAR; PG8_MMA(0, 0, At, B0); PG8_MMA(0, 1, At, B1); PG8_BAR; PG8_SCHED;
            PG8_LDA(At, 0, 1); PG8_STAGE(PG8_SB(0, 0), b2, voffB); PG8_STAGE(PG8_SB(0, 1), b2 + hstep, voffB); PG8_STAGE(PG8_SA(0, 0), a2, voffA);
            PG8_WAIT_V(8); PG8_WAIT_L(0); PG8_BAR; PG8_MMA(1, 0, At, B0); PG8_MMA(1, 1, At, B1); PG8_BAR; PG8_SCHED;
            PG8_LDB(B0, 1, 0); PG8_LDB(B1, 1, 1); PG8_SCHED; PG8_LDA(At, 1, 0); PG8_STAGE(PG8_SA(0, 1), a2 + hstep, voffA);
            PG8_WAIT_V(8); PG8_WAIT_L(0); PG8_BAR; PG8_MMA(0, 0, At, B0); PG8_MMA(0, 1, At, B1); PG8_BAR; PG8_SCHED;
            PG8_LDA(At, 1, 1); PG8_STAGE(PG8_SB(1, 0), b3, voffB); PG8_STAGE(PG8_SB(1, 1), b3 + hstep, voffB); PG8_STAGE(PG8_SA(1, 0), a3, voffA);
            PG8_WAIT_V(8); PG8_WAIT_L(0); PG8_BAR; PG8_MMA(1, 0, At, B0); PG8_MMA(1, 1, At, B1); PG8_BAR; PG8_SCHED;
            } else {
            PG8_LDB(B0, 0, 0); PG8_SCHED; PG8_LDA(At, 0, 0); PG8_STAGE(PG8_SA(1, 1), a1 + hstep, voffA);
            PG8_WAIT_L(8); PG8_BAR; PG8_WAIT_L(0); PG8_MMA(0, 0, At, B0); PG8_BAR; PG8_SCHED;
            PG8_LDB(B1, 0, 1); PG8_STAGE(PG8_SB(0, 0), b2, voffB);
            PG8_BAR; PG8_WAIT_L(0); PG8_MMA(0, 1, At, B1); PG8_BAR;
            PG8_LDA(At, 0, 1); PG8_STAGE(PG8_SA(0, 0), a2, voffA);
            PG8_BAR; PG8_WAIT_L(0); PG8_MMA(1, 0, At, B0); PG8_BAR; PG8_SCHED;
            PG8_STAGE(PG8_SB(0, 1), b2 + hstep, voffB);
            PG8_WAIT_V(6); PG8_BAR; PG8_MMA(1, 1, At, B1); PG8_BAR;
            PG8_LDB(B0, 1, 0); PG8_SCHED; PG8_LDA(At, 1, 0); PG8_STAGE(PG8_SA(0, 1), a2 + hstep, voffA);
            PG8_WAIT_L(8); PG8_BAR; PG8_WAIT_L(0); PG8_MMA(0, 0, At, B0); PG8_BAR; PG8_SCHED;
            PG8_LDB(B1, 1, 1); PG8_STAGE(PG8_SB(1, 0), b3, voffB);
            PG8_BAR; PG8_WAIT_L(0); PG8_MMA(0, 1, At, B1); PG8_BAR;
            PG8_LDA(At, 1, 1); PG8_STAGE(PG8_SA(1, 0), a3, voffA);
            PG8_BAR; PG8_WAIT_L(0); PG8_MMA(1, 0, At, B0); PG8_BAR; PG8_SCHED;
            PG8_STAGE(PG8_SB(1, 1), b3 + hstep, voffB);
            PG8_WAIT_V(6); PG8_BAR; PG8_MMA(1, 1, At, B1); PG8_BAR;
            }
        }
        if constexpr (ALIGN_EPI) { if (wr == 0) PG8_BAR; }
        if constexpr (!Epi::AFTER_DRAIN) { E(acc, cur, wr, wc, fr, fq); S.done(cur); }
        if (!has_next) break;
#pragma unroll
        for (int a = 0; a < 2; ++a)
#pragma unroll
            for (int b = 0; b < 2; ++b)
#pragma unroll
                for (int m = 0; m < 4; ++m)
#pragma unroll
                    for (int n = 0; n < 2; ++n) acc[a][b][m][n] = (f32x4){0.f, 0.f, 0.f, 0.f};
        cur = nxt; cA = nA; cB = nB; ++ui;
        if constexpr (ALIGN_EPI) { if (wr == 1) PG8_BAR; }
    }
    PG8_WAIT_V(0);
    if constexpr (!ALIGN_EPI) { if (wr == 0) PG8_BAR; }
    PG8_BAR;
    if constexpr (Epi::AFTER_DRAIN) { E.fused(acc, cur, wr, wc, fr, fq, lds, wid, lane); S.done(cur); }
#undef PG8_SA
#undef PG8_SB
#undef PG8_STAGE
#undef PG8_LDA
#undef PG8_LDB
#undef PG8_MMA
#undef PG8_WAIT_V
#undef PG8_WAIT_L
#undef PG8_BAR
#undef PG8_SCHED
}
}
constexpr int NWAVES = 8;
constexpr int M = 16384, TSEQ = 8192, DM = 1024, FFD = 4096, DEPTH = 4, MD = 32, NH = 8, HD = 64;
constexpr int NIN = 3584;
constexpr int RW0 = 1536;
constexpr int PRP = 2048;
constexpr int NRWU = 1856;
constexpr int CH = 16, NCH = TSEQ / CH;
constexpr int NUNIT = 2 * NH * NCH;
constexpr float LN_EPS = 1e-5f, GN_EPS = 64e-5f, RMS_EPS = 1e-6f;
constexpr float ALPHA = 1.6817928305074290f;
constexpr float QSCALE = 0.125f * 1.4426950408889634f;
constexpr size_t O_Y = 0, O_YS = 16777216, O_SHP = 16809984, O_SHS = 16818176, O_WKP = 16949248, O_WKS = 17211392,
                 O_KP = 21405696, O_VP = 29794304, O_KS = 38182912, O_VS = 38248448, O_END = 38313984;
constexpr size_t MiB = 1u << 20;
constexpr size_t WS_CTL = 0, CTL_ZERO_BYTES = 1 * MiB;
constexpr size_t WS_C1IN = 1 * MiB;
constexpr size_t WS_C2IN = WS_C1IN + 4 * NIN * 4;
constexpr size_t WS_C1UP = WS_C2IN + 4 * NIN * 4;
constexpr size_t WS_C2UP = WS_C1UP + 4 * FFD * 4;
constexpr size_t WS_DUPT = WS_C2UP + 4 * FFD * 4;
constexpr size_t WS_IUPT = WS_DUPT + 4 * 512 * 64 * 2;
constexpr size_t WS_GUPT = WS_IUPT + 4 * 512 * 64 * 2;
constexpr size_t WS_VUPT = WS_GUPT + 4 * 512 * 128 * 2;
constexpr size_t WS_SMALL_END = WS_VUPT + 3 * 512 * 32 * 2;
static_assert(WS_SMALL_END <= 3 * MiB, "small region");
constexpr size_t WS_ROPE = 3 * MiB;
constexpr size_t WS_DEC = 6 * MiB;
constexpr size_t WS_STAT1 = 8 * MiB, WS_STAT2 = 9 * MiB;
constexpr size_t WS_BON = 10 * MiB;
constexpr size_t WS_LSE = 11 * MiB;
constexpr size_t WS_GC = 13 * MiB;
constexpr size_t WS_WIN = 16 * MiB;
constexpr size_t WS_WINU = 44 * MiB;
constexpr size_t WS_WOUT = 60 * MiB;
constexpr size_t WS_WUP = 68 * MiB;
constexpr size_t WS_WDN = 100 * MiB;
constexpr size_t WS_XB2 = 132 * MiB;
constexpr size_t WS_XB1 = 164 * MiB;
constexpr size_t WS_T1 = 196 * MiB;
constexpr size_t WS_T2 = 260 * MiB;
constexpr size_t WS_QB = 324 * MiB, WS_KB = 340 * MiB, WS_VB = 356 * MiB;
constexpr size_t WS_PR = 372 * MiB;
constexpr size_t WS_OP = 436 * MiB;
constexpr size_t WS_MIX = 484 * MiB;
constexpr size_t WS_VF = 516 * MiB, WS_VV = 532 * MiB;
constexpr size_t WS_YPRE = 548 * MiB;
constexpr size_t WS_H = 580 * MiB;
constexpr size_t WS_PT = 580 * MiB;
constexpr size_t WS_QT = 644 * MiB;
constexpr size_t WS_REFF = 708 * MiB;
constexpr size_t WS_YLOC = 724 * MiB;
constexpr size_t WS_SEGQ = 756 * MiB, WS_SEGP = 760 * MiB;
constexpr size_t WS_CSUM = 764 * MiB;
constexpr size_t WS_CSUP = 766 * MiB;
constexpr size_t WS_END = 768 * MiB;
static_assert(WS_H + (size_t)M * FFD * 2 <= WS_END + 0 * MiB || true, "");
constexpr size_t DEC_XB2 = 0;
constexpr size_t DEC_XB1 = 64 * 1024;
constexpr size_t DEC_SHB = 128 * 1024;
constexpr size_t DEC_MIXB = 384 * 1024;
constexpr size_t DEC_HB = 448 * 1024;
constexpr size_t DEC_T1 = 704 * 1024;
constexpr size_t DEC_T2 = 832 * 1024;
constexpr size_t DEC_PD = 960 * 1024;
constexpr size_t DEC_PS = 1408 * 1024;
constexpr size_t DEC_OP = 1640 * 1024;
constexpr size_t DEC_LSE = 1832 * 1024;
constexpr size_t DEC_MIX = 1836 * 1024;
constexpr size_t DEC_ST1 = 1964 * 1024;
constexpr size_t DEC_ST2 = 1972 * 1024;
constexpr size_t DEC_VF = 1980 * 1024;
static_assert(DEC_VF + 32 * 512 * 4 <= 2 * MiB, "decode scratch");
constexpr int CW_BAR = 4096;
constexpr int CW_DCNT = 24576;
constexpr int CW_POOL = 16384;
constexpr int RING_BYTES = 131072;
constexpr int MISC_OFF = RING_BYTES + 320;
constexpr int LDS_BYTES = 163840;
static_assert(pg8::WSO_C1IN == WS_C1IN && pg8::WSO_C2IN == WS_C2IN && pg8::WSO_C1UP == WS_C1UP && pg8::WSO_C2UP == WS_C2UP && pg8::WSO_ROPE == WS_ROPE && pg8::WSO_STAT1 == WS_STAT1 && pg8::WSO_STAT2 == WS_STAT2 &&
              pg8::WSO_XB2 == WS_XB2 && pg8::WSO_XB1 == WS_XB1 && pg8::WSO_T1 == WS_T1 && pg8::WSO_T2 == WS_T2 && pg8::WSO_QB == WS_QB && pg8::WSO_KB == WS_KB && pg8::WSO_VB == WS_VB && pg8::WSO_PR == WS_PR && pg8::WSO_H == WS_H &&
              pg8::OO_SHP == O_SHP && pg8::OO_KP == O_KP && pg8::OO_VP == O_VP, "epilogue offset mirrors");
#define GAS __attribute__((address_space(1)))
#define LAS __attribute__((address_space(3)))
typedef unsigned short bf16;
typedef unsigned v4u __attribute__((ext_vector_type(4)));
typedef unsigned v2u __attribute__((ext_vector_type(2)));
typedef float f32x4 __attribute__((ext_vector_type(4)));
typedef float f32x2 __attribute__((ext_vector_type(2)));
typedef float f32x16 __attribute__((ext_vector_type(16)));
typedef short bf16x8 __attribute__((ext_vector_type(8)));
typedef short s16x4 __attribute__((ext_vector_type(4)));
typedef GAS unsigned gu32;
#define RLX_AGENT __ATOMIC_RELAXED, __HIP_MEMORY_SCOPE_AGENT
#define LDS_WAIT() asm volatile("s_waitcnt lgkmcnt(0)" ::: "memory")
#define VM_WAIT() asm volatile("s_waitcnt vmcnt(0)" ::: "memory")
#define DI __device__ __forceinline__
DI unsigned f2bf(float f) { unsigned u = __builtin_bit_cast(unsigned, f); return (u + 0x7fffu + ((u >> 16) & 1u)) >> 16; }
DI float bf2f(unsigned b) { return __builtin_bit_cast(float, b << 16); }
DI float bflo(unsigned w) { return __builtin_bit_cast(float, w << 16); }
DI float bfhi(unsigned w) { return __builtin_bit_cast(float, w & 0xffff0000u); }
typedef __bf16 bf16x2_t __attribute__((ext_vector_type(2)));
DI unsigned pk2(float lo, float hi) { const f32x2 v = {lo, hi}; const bf16x2_t b = __builtin_convertvector(v, bf16x2_t); return __builtin_bit_cast(unsigned, b); }
DI unsigned pk2z(float x) { return pk2(x, 0.f) & 0xffffu; }
DI float rbf(float x) { return bf2f(f2bf(x)); }
DI bf16x8 pk8(float a0, float a1, float a2, float a3, float a4, float a5, float a6, float a7) {
    v4u w; w.x = pk2(a0, a1); w.y = pk2(a2, a3); w.z = pk2(a4, a5); w.w = pk2(a6, a7); return __builtin_bit_cast(bf16x8, w); }
DI bf16x8 pk8v(f32x4 a, f32x4 b) { return pk8(a[0], a[1], a[2], a[3], b[0], b[1], b[2], b[3]); }
DI bf16x8 pk4z(f32x4 a) { v4u w; w.x = pk2(a[0], a[1]); w.y = pk2(a[2], a[3]); w.z = 0u; w.w = 0u; return __builtin_bit_cast(bf16x8, w); }
DI bf16x8 ld8(const void* p) { return *(const bf16x8*)p; }
DI bf16x8 ld8nt(const void* p) { return __builtin_nontemporal_load((const bf16x8*)p); }
DI v4u ldv4nt(const void* p) { return __builtin_nontemporal_load((const v4u*)p); }
DI f32x4 ldf4nt(const void* p) { return __builtin_nontemporal_load((const f32x4*)p); }
DI bf16x8 ld4z(const void* p) { v2u t = *(const v2u*)p; v4u w; w.x = t.x; w.y = t.y; w.z = 0u; w.w = 0u; return __builtin_bit_cast(bf16x8, w); }
DI f32x4 mfma16(bf16x8 a, bf16x8 b, f32x4 c) { return __builtin_amdgcn_mfma_f32_16x16x32_bf16(a, b, c, 0, 0, 0); }
DI f32x16 mfma32(bf16x8 a, bf16x8 b, f32x16 c) { return __builtin_amdgcn_mfma_f32_32x32x16_bf16(a, b, c, 0, 0, 0); }
DI int crow(int r, int hi) { return (r & 3) + 8 * (r >> 2) + 4 * hi; }
DI float wave_sum(float v) {
#pragma unroll
    for (int o = 1; o < 64; o <<= 1) v += __shfl_xor(v, o);
    return v; }
DI float fexp(float x) { return __expf(x); }
DI float fsigmoid(float x) { return __builtin_amdgcn_rcpf(1.f + __expf(-x)); }
DI float ftanh(float x) { return 1.f - 2.f * __builtin_amdgcn_rcpf(__expf(2.f * x) + 1.f); }
DI float fsoftplus(float x) { return fmaxf(x, 0.f) + __logf(1.f + __expf(-fabsf(x))); }
DI int orig2lgcl(int o) { return (o & ~63) | (((o >> 4) & 1) << 5) | (((o >> 2) & 3) << 3) | (((o >> 5) & 1) << 2) | (o & 3); }
DI int lgcl2orig(int c) { return (c & ~63) | (((c >> 2) & 1) << 5) | (((c >> 5) & 1) << 4) | (((c >> 3) & 3) << 2) | (c & 3); }
#define XB_TMO      128
#define XB_XCNT(j)  (256  + 64 * (j))
#define XB_XSUB(j)  (1280 + 64 * (j))
#define XB_XGEN(j)  (2304 + 64 * (j))
#define XB_TOP      3328
#define XB_TOPGEN   3392
#define XCD_BAR_WORDS 3456
#define XB_SPIN_CAP (1u << 18)

__device__ __forceinline__ unsigned xb_ld(unsigned* p)              { return __hip_atomic_load(p, __ATOMIC_RELAXED, __HIP_MEMORY_SCOPE_AGENT); }
__device__ __forceinline__ unsigned xb_add(unsigned* p, unsigned v) { return __hip_atomic_fetch_add(p, v, __ATOMIC_RELAXED, __HIP_MEMORY_SCOPE_AGENT); }
__device__ __forceinline__ unsigned xb_xcc_id() { return (unsigned)__builtin_amdgcn_s_getreg((3 << 11) | 20) & 0xFu; }
#define XB_SPIN(cond, bar) do { unsigned _sp = 0; while (cond) { __builtin_amdgcn_s_sleep(1); \
    if ((++_sp & 255u) == 0u) { if (xb_ld(&(bar)[XB_TMO])) break; if (_sp > XB_SPIN_CAP) { atomicAdd(&(bar)[XB_TMO], 1u); break; } } } } while (0)

struct XcdBarrier {
    unsigned* bar; unsigned x;
    volatile LAS unsigned* st;
};

__device__ __forceinline__ XcdBarrier xcd_barrier_post(unsigned* bar, volatile LAS unsigned* st) {
    XcdBarrier b; b.bar = bar; b.x = xb_xcc_id(); b.st = st;
    if (threadIdx.x == 0) (void)xb_add(&bar[XB_XCNT(b.x)], 1u);
    return b;
}
__device__ __forceinline__ void xcd_barrier_complete(unsigned* bar, unsigned x, unsigned& nloc, unsigned& nx) {
    const unsigned G = gridDim.x * gridDim.y * gridDim.z;
    unsigned sum, cnt, mine, sp = 0u;
    for (;;) {
        sum = 0u; cnt = 0u; mine = 0u;
#pragma unroll
        for (unsigned j = 0; j < 16; ++j) { const unsigned c = xb_ld(&bar[XB_XCNT(j)]); sum += c; cnt += (c > 0u) ? 1u : 0u; mine = (j == x) ? c : mine; }
        if (sum == G) break;
        __builtin_amdgcn_s_sleep(1);
        if ((++sp & 255u) == 0u) { if (xb_ld(&bar[XB_TMO])) break; if (sp > XB_SPIN_CAP) { atomicAdd(&bar[XB_TMO], 1u); break; } }
    }
    nloc = mine > 0u ? mine : 1u; nx = cnt > 0u ? cnt : 1u;
}

__device__ __forceinline__ void xcd_barrier(const XcdBarrier& b) {
    asm volatile("s_waitcnt vmcnt(0)" ::: "memory");
    __syncthreads();
    if (threadIdx.x == 0) {
        unsigned* bar = b.bar;
        __builtin_amdgcn_s_waitcnt(0);
        unsigned nloc = b.st[0], nx = b.st[1];
        if (nloc == 0u) { xcd_barrier_complete(bar, b.x, nloc, nx); b.st[0] = nloc; b.st[1] = nx; }
        const unsigned old = xb_add(&bar[XB_XSUB(b.x)], 1u);
        const unsigned gen = old / nloc;
        if (old + 1u == (gen + 1u) * nloc) {
            __builtin_amdgcn_fence(__ATOMIC_RELEASE, "agent");
            asm volatile("s_waitcnt vmcnt(0)" ::: "memory");
            const unsigned og = xb_add(&bar[XB_TOP], 1u);
            const unsigned tg = og / nx;
            if (og + 1u == (tg + 1u) * nx) xb_add(&bar[XB_TOPGEN], 1u);
            else XB_SPIN(xb_ld(&bar[XB_TOPGEN]) == tg, bar);
            __builtin_amdgcn_fence(__ATOMIC_ACQUIRE, "agent");
            xb_add(&bar[XB_XGEN(b.x)], 1u);
            asm volatile("s_waitcnt vmcnt(0)" ::: "memory");
        } else {
            XB_SPIN(xb_ld(&bar[XB_XGEN(b.x)]) == gen, bar);
            __builtin_amdgcn_fence(__ATOMIC_ACQUIRE, "agent");
            asm volatile("s_waitcnt vmcnt(0)" ::: "memory");
        }
    }
    __syncthreads();
}
struct Args { const float* in[30]; float* out; unsigned char* ws; };
struct Frame {
    unsigned char* lds;
    volatile LAS unsigned* MISC;
    gu32* ctl;
    int tid, lane, wave, vcu, G, gw, NGW;
    const float* const* in; float* out; unsigned char* ws;
};
template <bool SWAP>
DI void p0_transpose_item(const float* W, int ldw, int K, int csrc0, bf16* WT, int row_off, const float* gsc, LAS float* scr, int kb, int nb, int lane, float* csum = nullptr, int ncs = 0, const float* bsh = nullptr) {
    const int k0 = 64 * kb, n0 = 32 * nb;
    f32x4 wv[8]; float gk = 1.f, bk = 0.f;
    const int lr = lane >> 3, lc = (lane & 7) * 4;
#pragma unroll
    for (int i = 0; i < 8; ++i) wv[i] = ldf4nt(W + (size_t)(k0 + 8 * i + lr) * ldw + csrc0 + n0 + lc);
    if (gsc) gk = gsc[k0 + lane]; if (bsh) bk = bsh[k0 + lane];
    f32x4 s1v = {0.f, 0.f, 0.f, 0.f}, s2v = s1v;
#pragma unroll
    for (int i = 0; i < 8; ++i) { const int kk = 8 * i + lr; f32x4 v = wv[i]; s2v = s2v + v * __shfl(bk, kk); v = v * __shfl(gk, kk);
#pragma unroll
        for (int e = 0; e < 4; ++e) { s1v[e] += rbf(v[e]); scr[kk * 33 + lc + e] = v[e]; } }
#pragma unroll
    for (int o = 8; o < 64; o <<= 1) {
#pragma unroll
        for (int e = 0; e < 4; ++e) { s1v[e] += __shfl_xor(s1v[e], o); s2v[e] += __shfl_xor(s2v[e], o); } }
    if (csum && lane < 8) {
#pragma unroll
        for (int e = 0; e < 4; ++e) { int dr = n0 + 4 * lane + e; if (SWAP) dr = orig2lgcl(dr); csum[(size_t)(kb * 2 + 0) * ncs + row_off + dr] = s1v[e]; csum[(size_t)(kb * 2 + 1) * ncs + row_off + dr] = s2v[e]; } }
    LDS_WAIT(); asm volatile("" ::: "memory");
    const int c = lane & 7;
#pragma unroll
    for (int j = 0; j < 4; ++j) { const int n = (lane >> 3) + 8 * j; const LAS float* s = scr + (8 * c) * 33 + n;
        v4u o; o.x = pk2(s[0 * 33], s[1 * 33]); o.y = pk2(s[2 * 33], s[3 * 33]); o.z = pk2(s[4 * 33], s[5 * 33]); o.w = pk2(s[6 * 33], s[7 * 33]);
        int dr = n0 + n; if (SWAP) dr = orig2lgcl(dr);
        *(v4u*)(WT + (size_t)(row_off + dr) * K + k0 + 8 * c) = o; }
    LDS_WAIT(); asm volatile("" ::: "memory");
}
DI void p0_prologue(Frame& F) {
    LAS float* scr = (LAS float*)((LAS unsigned char*)F.lds + F.wave * 16384);
    const float* const* in = F.in; unsigned char* ws = F.ws;
    constexpr int I_IN = 16 * 104, I_VR = 16, I_INU = 16 * 56, I_OUT = 16 * 32, I_UP = 16 * 128, I_DN = 64 * 32;
    constexpr int I_L = I_IN + I_VR + I_INU + I_VR + I_OUT + I_UP + I_DN;
    for (int it = F.gw; it < DEPTH * I_L; it += F.NGW) {
        const int l = it / I_L; int r = it % I_L;
        const float* g2p = l > 0 ? in[28] + (size_t)(l - 1) * DM : nullptr;
        bf16* win = (bf16*)(ws + WS_WIN) + (size_t)l * NIN * DM; bf16* winu = (bf16*)(ws + WS_WINU) + (size_t)l * NRWU * DM;
        if (r < I_IN) { const int kb = r / 104, nb = r % 104; const float* W = in[6] + (size_t)l * DM * 3328;
            float* cs = l > 0 ? (float*)(ws + WS_CSUM) + (size_t)l * 32 * NIN : nullptr; const float* b2p = l > 0 ? in[29] + (size_t)(l - 1) * DM : nullptr;
            if (nb < 32) p0_transpose_item<true>(W, 3328, DM, 0, win, 0, g2p, scr, kb, nb, F.lane, cs, NIN, b2p); else p0_transpose_item<false>(W, 3328, DM, 0, win, 0, g2p, scr, kb, nb, F.lane, cs, NIN, b2p); continue; } r -= I_IN;
        if (r < I_VR) { if (l > 0) p0_transpose_item<false>(in[7] + (size_t)(l - 1) * DM * 32, 32, DM, 0, win, 3328, g2p, scr, r, 0, F.lane, (float*)(ws + WS_CSUM) + (size_t)l * 32 * NIN, NIN, in[29] + (size_t)(l - 1) * DM); continue; } r -= I_VR;
        if (r < I_INU) { const int kb = r / 56, nb = r % 56; p0_transpose_item<false>(in[6] + (size_t)l * DM * 3328, 3328, DM, RW0, winu, 0, nullptr, scr, kb, nb, F.lane); continue; } r -= I_INU;
        if (r < I_VR) { if (l > 0) p0_transpose_item<false>(in[7] + (size_t)(l - 1) * DM * 32, 32, DM, 0, winu, 1792, nullptr, scr, r, 0, F.lane); continue; } r -= I_VR;
        if (r < I_OUT) { p0_transpose_item<false>(in[23] + (size_t)l * DM * DM, DM, DM, 0, (bf16*)(ws + WS_WOUT) + (size_t)l * DM * DM, 0, nullptr, scr, r / 32, r % 32, F.lane); continue; } r -= I_OUT;
        if (r < I_UP) { p0_transpose_item<false>(in[26] + (size_t)l * DM * FFD, FFD, DM, 0, (bf16*)(ws + WS_WUP) + (size_t)l * FFD * DM, 0, in[24] + (size_t)l * DM, scr, r / 128, r % 128, F.lane, (float*)(ws + WS_CSUP) + (size_t)l * 32 * FFD, FFD, in[25] + (size_t)l * DM); continue; } r -= I_UP;
        p0_transpose_item<false>(in[27] + (size_t)l * FFD * DM, DM, FFD, 0, (bf16*)(ws + WS_WDN) + (size_t)l * DM * FFD, 0, nullptr, scr, r / 32, r % 32, F.lane);
    }
    for (int m0 = F.gw; m0 < M; m0 += 4 * F.NGW) { f32x4 v[4][4];
#pragma unroll
        for (int q = 0; q < 4; ++q) { const f32x4* xr = (const f32x4*)(in[0] + (size_t)(m0 + q * F.NGW) * DM) + F.lane;
#pragma unroll
            for (int j = 0; j < 4; ++j) v[q][j] = ldf4nt(xr + 64 * j); }
#pragma unroll
        for (int q = 0; q < 4; ++q) { unsigned long long* o8 = (unsigned long long*)((bf16*)(ws + WS_XB2) + (size_t)(m0 + q * F.NGW) * DM) + F.lane;
#pragma unroll
            for (int j = 0; j < 4; ++j) o8[64 * j] = (unsigned long long)pk2(v[q][j].x, v[q][j].y) | ((unsigned long long)pk2(v[q][j].z, v[q][j].w) << 32); } }
    const int gt = F.gw * 64 + F.lane, NGT = F.NGW * 64;
    for (int e = gt; e < 8193 * 32; e += NGT) { const int pos = e >> 5, i = e & 31; const double ang = (double)pos * pow(10000.0, -(double)i / 32.0); ((f32x2*)(ws + WS_ROPE))[e] = (f32x2){(float)cos(ang), (float)sin(ang)}; }
    for (int e = gt; e < 4 * 512 * 64; e += NGT) { const int l = e / (512 * 64), n = (e / 64) % 512, m = e % 64; ((bf16*)(ws + WS_DUPT))[e] = (bf16)f2bf(in[11][((size_t)l * 64 + m) * 512 + n]); ((bf16*)(ws + WS_IUPT))[e] = (bf16)f2bf(in[13][((size_t)l * 64 + m) * 512 + n]); }
    for (int e = gt; e < 4 * 512 * 128; e += NGT) { const int l = e / (512 * 128), n = (e / 128) % 512, m = e % 128; ((bf16*)(ws + WS_GUPT))[e] = (bf16)f2bf(in[14][((size_t)l * 128 + m) * 512 + n]); }
    for (int e = gt; e < 3 * 512 * 32; e += NGT) { const int l = e / (512 * 32), n = (e / 32) % 512, m = e % 32; ((bf16*)(ws + WS_VUPT))[e] = (bf16)f2bf(in[16][((size_t)l * 32 + m) * 512 + n]); }
    for (int e = gt; e < 2 * DM; e += NGT) F.out[O_SHP + e] = in[0][((size_t)(e / DM) * TSEQ + TSEQ - 1) * DM + (e % DM)];
    for (int e = gt; e < MD * DM; e += NGT) { ((bf16*)(ws + WS_DEC + DEC_XB2))[e] = (bf16)f2bf(in[1][e]); }
    for (int e = gt; e < DEPTH * MD * DM; e += NGT) { ((bf16*)(ws + WS_DEC + DEC_SHB))[e] = (bf16)f2bf(in[2][e]); }
}
DI void colsum_finish(unsigned char* ws, int gt, int NGT) {
    for (int e = gt; e < 3 * NIN; e += NGT) { const int l = 1 + e / NIN, p = e % NIN; if (p >= 3360) continue; const float* cs = (const float*)(ws + WS_CSUM) + (size_t)l * 32 * NIN + p; float s1 = 0.f, s2 = 0.f;
#pragma unroll
        for (int kb = 0; kb < 16; ++kb) { s1 += cs[(size_t)(2 * kb) * NIN]; s2 += cs[(size_t)(2 * kb + 1) * NIN]; }
        ((float*)(ws + WS_C1IN))[l * NIN + p] = s1; ((float*)(ws + WS_C2IN))[l * NIN + p] = s2; }
    for (int e = gt; e < 4 * FFD; e += NGT) { const int l = e / FFD, p = e % FFD; const float* cs = (const float*)(ws + WS_CSUP) + (size_t)l * 32 * FFD + p; float s1 = 0.f, s2 = 0.f;
#pragma unroll
        for (int kb = 0; kb < 16; ++kb) { s1 += cs[(size_t)(2 * kb) * FFD]; s2 += cs[(size_t)(2 * kb + 1) * FFD]; }
        ((float*)(ws + WS_C1UP))[l * FFD + p] = s1; ((float*)(ws + WS_C2UP))[l * FFD + p] = s2; }
}
constexpr int VPITCH = 144;
constexpr int ATT_WLDS = 2 * 32 * VPITCH + 256;
DI void tr_read8(unsigned base, s16x4 (&t)[8]) {
    asm volatile("ds_read_b64_tr_b16 %0, %8\n\tds_read_b64_tr_b16 %1, %8 offset:%c9\n\tds_read_b64_tr_b16 %2, %8 offset:%c10\n\tds_read_b64_tr_b16 %3, %8 offset:%c11\n\t"
                 "ds_read_b64_tr_b16 %4, %8 offset:%c12\n\tds_read_b64_tr_b16 %5, %8 offset:%c13\n\tds_read_b64_tr_b16 %6, %8 offset:%c14\n\tds_read_b64_tr_b16 %7, %8 offset:%c15\n\ts_waitcnt lgkmcnt(0)"
                 : "=&v"(t[0]), "=&v"(t[1]), "=&v"(t[2]), "=&v"(t[3]), "=&v"(t[4]), "=&v"(t[5]), "=&v"(t[6]), "=&v"(t[7])
                 : "v"(base), "i"(8 * VPITCH), "i"(64), "i"(8 * VPITCH + 64), "i"(16 * VPITCH), "i"(24 * VPITCH), "i"(16 * VPITCH + 64), "i"(24 * VPITCH + 64) : "memory");
}
DI void attn_task(const bf16* QB, const bf16* KB, const bf16* VB, bf16* OP, float* LSE, int b, int h, int p, int cls, int qblk, LAS unsigned char* wl, int lane) {
    asm volatile("" : "+v"(lane));
    const int dd = 1 << (2 * p), r32 = lane & 31, hi = lane >> 5;
    const int m0 = 32 * qblk;
    const size_t rowb = (size_t)b * TSEQ;
    const size_t qrow = rowb + (size_t)(m0 + r32) * dd + cls;
    bf16x8 qf[4];
#pragma unroll
    for (int d0 = 0; d0 < 4; ++d0) qf[d0] = ld8(QB + qrow * 512 + h * 64 + d0 * 16 + hi * 8);
    f32x16 s[5];
    const int kt0 = (m0 >= 128) ? 0 : (128 - m0) / 32;
    const int krow8 = lane >> 3, kch = lane & 7;
    v4u kr[5][4];
#pragma unroll
    for (int kt = 0; kt < 5; ++kt)
#pragma unroll
        for (int i_ = 0; i_ < 4; ++i_) { const int mk = m0 - 128 + 32 * kt + 8 * i_ + krow8; const size_t krow = rowb + (size_t)(mk < 0 ? 0 : mk) * dd + cls;
            kr[kt][i_] = *(const v4u*)(KB + krow * 512 + h * 64 + kch * 8); }
#pragma unroll
    for (int kt = 0; kt < 5; ++kt) {
        LAS unsigned char* kb = wl + (kt & 1) * 32 * VPITCH;
#pragma unroll
        for (int i_ = 0; i_ < 4; ++i_) *(LAS v4u*)(kb + (8 * i_ + krow8) * VPITCH + kch * 16) = kr[kt][i_];
        LDS_WAIT();
        bf16x8 kf[4];
#pragma unroll
        for (int d0 = 0; d0 < 4; ++d0) kf[d0] = *(const LAS bf16x8*)(kb + r32 * VPITCH + d0 * 32 + hi * 16);
        f32x16 a; for (int i = 0; i < 16; ++i) a[i] = 0.f;
#pragma unroll
        for (int d0 = 0; d0 < 4; ++d0) a = mfma32(kf[d0], qf[d0], a);
        s[kt] = a;
    }
    LDS_WAIT();
#pragma unroll
    for (int kt = 0; kt < 5; ++kt) {
        if (kt < kt0) {
#pragma unroll
            for (int i = 0; i < 16; ++i) s[kt][i] = -INFINITY;
        } else if (kt == 0) {
#pragma unroll
            for (int i = 0; i < 16; ++i) s[kt][i] = (crow(i, hi) >= r32) ? s[kt][i] : -INFINITY;
        } else if (kt == 4) {
#pragma unroll
            for (int i = 0; i < 16; ++i) s[kt][i] = (crow(i, hi) <= r32) ? s[kt][i] : -INFINITY;
        }
    }
    float mx = -INFINITY;
#pragma unroll
    for (int kt = 0; kt < 5; ++kt)
#pragma unroll
        for (int i = 0; i < 16; ++i) mx = fmaxf(mx, s[kt][i]);
    mx = fmaxf(mx, __shfl_xor(mx, 32));
    float lsum = 0.f;
#pragma unroll
    for (int kt = 0; kt < 5; ++kt)
#pragma unroll
        for (int i = 0; i < 16; ++i) { const float e = __builtin_amdgcn_exp2f(s[kt][i] - mx); s[kt][i] = e; lsum += e; }
    lsum += __shfl_xor(lsum, 32);
    f32x16 o[2]; for (int i = 0; i < 16; ++i) { o[0][i] = 0.f; o[1][i] = 0.f; }
    LAS float* wsf = (LAS float*)(wl + 2 * 32 * VPITCH);
    const unsigned vb0 = (unsigned)(uintptr_t)wl;
    const int g = lane >> 4, i16 = lane & 15, qq = i16 >> 2, pp = i16 & 3;
    const unsigned traddr = (unsigned)((4 * (g >> 1) + qq) * VPITCH + (16 * (g & 1) + 4 * pp) * 2);
    const int vrow8 = lane >> 3, vch = lane & 7;
    v4u vr[4];
#define ATT_LOADV(KT) do { _Pragma("unroll") for (int i_ = 0; i_ < 4; ++i_) { const int mk_ = m0 - 128 + 32 * (KT) + 8 * i_ + vrow8; const size_t vrow_ = rowb + (size_t)mk_ * dd + cls; \
        vr[i_] = *(const v4u*)(VB + vrow_ * 512 + h * 64 + vch * 8); } } while (0)
    ATT_LOADV(kt0);
#pragma unroll
    for (int kt = 0; kt < 5; ++kt) {
        if (kt >= kt0) {
            LAS unsigned char* vb = wl + (kt & 1) * 32 * VPITCH;
#pragma unroll
            for (int i_ = 0; i_ < 4; ++i_) *(LAS v4u*)(vb + (8 * i_ + vrow8) * VPITCH + vch * 16) = vr[i_];
            if (kt + 1 < 5) ATT_LOADV(kt + 1);
            LDS_WAIT();
            const unsigned base = vb0 + (unsigned)((kt & 1) * 32 * VPITCH) + traddr;
            s16x4 t[8];
            tr_read8(base, t);
#pragma unroll
            for (int ss = 0; ss < 2; ++ss) {
                const bf16x8 pa = pk8(s[kt][8 * ss], s[kt][8 * ss + 1], s[kt][8 * ss + 2], s[kt][8 * ss + 3], s[kt][8 * ss + 4], s[kt][8 * ss + 5], s[kt][8 * ss + 6], s[kt][8 * ss + 7]);
#pragma unroll
                for (int db = 0; db < 2; ++db) { const bf16x8 vf = __builtin_shufflevector(t[4 * ss + 2 * db], t[4 * ss + 2 * db + 1], 0, 1, 2, 3, 4, 5, 6, 7); o[db] = mfma32(pa, vf, o[db]); }
            }
        }
    }
#undef ATT_LOADV
    if (hi == 0) { wsf[r32] = __builtin_amdgcn_rcpf(lsum); LSE[((size_t)p * M + qrow) * 8 + h] = mx + __builtin_amdgcn_logf(lsum); }
    LDS_WAIT();
#pragma unroll
    for (int i = 0; i < 16; ++i) { const int q = crow(i, hi); const float li = wsf[q];
        *(LAS bf16*)(wl + q * VPITCH + r32 * 2) = (bf16)pk2z(o[0][i] * li); *(LAS bf16*)(wl + q * VPITCH + 64 + r32 * 2) = (bf16)pk2z(o[1][i] * li); }
    LDS_WAIT();
    { const int orow8 = lane >> 3, och = lane & 7;
#pragma unroll
      for (int i_ = 0; i_ < 4; ++i_) { const v4u w = *(const LAS v4u*)(wl + (8 * i_ + orow8) * VPITCH + och * 16); const size_t orow = rowb + (size_t)(m0 + 8 * i_ + orow8) * dd + cls;
          *(v4u*)(OP + ((size_t)p * M + orow) * 512 + h * 64 + och * 8) = w; } }
    LDS_WAIT();
}
DI void attn_finalize_row(const bf16* OP, const float* LSE, const float* gain, bf16* MIX, int row, int lane) {
    asm volatile("" : "+v"(lane));
    const int h = lane >> 3;
    float l0 = LSE[((size_t)0 * M + row) * 8 + h], l1 = LSE[((size_t)1 * M + row) * 8 + h], l2 = LSE[((size_t)2 * M + row) * 8 + h];
    const float mx = fmaxf(l0, fmaxf(l1, l2));
    float w0 = __builtin_amdgcn_exp2f(l0 - mx), w1 = __builtin_amdgcn_exp2f(l1 - mx), w2 = __builtin_amdgcn_exp2f(l2 - mx);
    const float inv = __builtin_amdgcn_rcpf(w0 + w1 + w2); w0 *= inv; w1 *= inv; w2 *= inv;
    const v4u a = *(const v4u*)(OP + ((size_t)0 * M + row) * 512 + lane * 8), b = *(const v4u*)(OP + ((size_t)1 * M + row) * 512 + lane * 8), c = *(const v4u*)(OP + ((size_t)2 * M + row) * 512 + lane * 8);
    float v[8]; float ss = 0.f;
#pragma unroll
    for (int j = 0; j < 4; ++j) { v[2 * j] = w0 * bflo(a[j]) + w1 * bflo(b[j]) + w2 * bflo(c[j]); v[2 * j + 1] = w0 * bfhi(a[j]) + w1 * bfhi(b[j]) + w2 * bfhi(c[j]); ss += v[2 * j] * v[2 * j] + v[2 * j + 1] * v[2 * j + 1]; }
    ss = wave_sum(ss);
    const float rinv = 1.0f / sqrtf(ss * (1.f / 512.f) + RMS_EPS);
    const f32x4 g0 = *(const f32x4*)(gain + lane * 8), g1 = *(const f32x4*)(gain + lane * 8 + 4);
    v4u w; w.x = pk2(v[0] * rinv * g0[0], v[1] * rinv * g0[1]); w.y = pk2(v[2] * rinv * g0[2], v[3] * rinv * g0[3]); w.z = pk2(v[4] * rinv * g1[0], v[5] * rinv * g1[1]); w.w = pk2(v[6] * rinv * g1[2], v[7] * rinv * g1[3]);
    *(v4u*)(MIX + (size_t)row * 1024 + lane * 8) = w;
}
constexpr int B1_IMG = 2048, B1_WLDS = 5 * B1_IMG + 1024;
constexpr int IMG_V = 0, IMG_A = 1 * B1_IMG, IMG_B = 2 * B1_IMG, IMG_W = 3 * B1_IMG, IMG_M = 4 * B1_IMG;
constexpr int TIL = 1 * B1_IMG, TIL_LP = 336, TIL_RP = 144, TIL_RSZ = 17 * TIL_RP;
static_assert(17 * TIL_LP <= 4 * B1_IMG && 3 * TIL_RSZ <= 4 * B1_IMG, "input tiles fit the image area");
DI float dpp_shr(float x, int n) { int v;
    switch (n) { case 1: v = __builtin_amdgcn_update_dpp(0, __builtin_bit_cast(int, x), 0x111, 0xf, 0xf, true); break; case 2: v = __builtin_amdgcn_update_dpp(0, __builtin_bit_cast(int, x), 0x112, 0xf, 0xf, true); break;
                 case 4: v = __builtin_amdgcn_update_dpp(0, __builtin_bit_cast(int, x), 0x114, 0xf, 0xf, true); break; default: v = __builtin_amdgcn_update_dpp(0, __builtin_bit_cast(int, x), 0x118, 0xf, 0xf, true); break; }
    return __builtin_bit_cast(float, v); }
DI float dpp_shr1(float x, int n) { int v; const int one = 0x3f800000;
    switch (n) { case 1: v = __builtin_amdgcn_update_dpp(one, __builtin_bit_cast(int, x), 0x111, 0xf, 0xf, false); break; case 2: v = __builtin_amdgcn_update_dpp(one, __builtin_bit_cast(int, x), 0x112, 0xf, 0xf, false); break;
                 case 4: v = __builtin_amdgcn_update_dpp(one, __builtin_bit_cast(int, x), 0x114, 0xf, 0xf, false); break; default: v = __builtin_amdgcn_update_dpp(one, __builtin_bit_cast(int, x), 0x118, 0xf, 0xf, false); break; }
    return __builtin_bit_cast(float, v); }
struct RwkvP {
    const bf16* PR; const float* mu; const float* muv;
    const float *dbase, *ibase, *vbase, *ksk, *ksa, *brk, *gng, *gnb;
    const bf16 *dupT, *iupT, *vupT, *gupT;
    const bf16* ZROW; bf16 *VF, *VV; float* BON; float* GC; bf16 *W1S, *REFF, *BM; v4u* REC; float* YPRE; bf16* MIX; int layer0;
};
DI const f32x4* vec4p(const float*) { return nullptr; }
DI const LAS f32x4* vec4p(const LAS float*) { return nullptr; }
template <class MP> DI void lerp8(const bf16* crow_, const bf16* prow_, int col, MP mu, float (&z)[8]) {
    const v4u cur = *(const v4u*)(crow_ + col); const v4u prv = *(const v4u*)(prow_ + col);
    const f32x4 m0 = *(decltype(vec4p(mu)))(mu), m1 = *(decltype(vec4p(mu)))(mu + 4);
#pragma unroll
    for (int j = 0; j < 4; ++j) { const float a = bflo(cur[j]), b = bfhi(cur[j]), pa = bflo(prv[j]), pb = bfhi(prv[j]); const float ma = j < 2 ? m0[2 * j] : m1[2 * j - 4], mb = j < 2 ? m0[2 * j + 1] : m1[2 * j - 3];
        z[2 * j] = a + (pa - a) * ma; z[2 * j + 1] = b + (pb - b) * mb; }
}
template <class MP> DI f32x4 lerp4(const bf16* crow_, const bf16* prow_, int col, MP mu) {
    const v2u cur = *(const v2u*)(crow_ + col); const v2u prv = *(const v2u*)(prow_ + col);
    const f32x4 m = *(decltype(vec4p(mu)))(mu);
    f32x4 z; z[0] = bflo(cur.x) + (bflo(prv.x) - bflo(cur.x)) * m[0]; z[1] = bfhi(cur.x) + (bfhi(prv.x) - bfhi(cur.x)) * m[1];
    z[2] = bflo(cur.y) + (bflo(prv.y) - bflo(cur.y)) * m[2]; z[3] = bfhi(cur.y) + (bfhi(prv.y) - bfhi(cur.y)) * m[3]; return z;
}
template <class MP> DI void lerp8l(const LAS unsigned char* crow_, const LAS unsigned char* prow_, int colb, MP mu, float (&z)[8]) {
    const v4u cur = *(const LAS v4u*)(crow_ + colb); const v4u prv = *(const LAS v4u*)(prow_ + colb);
    const f32x4 m0 = *(decltype(vec4p(mu)))(mu), m1 = *(decltype(vec4p(mu)))(mu + 4);
#pragma unroll
    for (int j = 0; j < 4; ++j) { const float a = bflo(cur[j]), b = bfhi(cur[j]), pa = bflo(prv[j]), pb = bfhi(prv[j]); const float ma = j < 2 ? m0[2 * j] : m1[2 * j - 4], mb = j < 2 ? m0[2 * j + 1] : m1[2 * j - 3];
        z[2 * j] = a + (pa - a) * ma; z[2 * j + 1] = b + (pb - b) * mb; }
}
template <class MP> DI f32x4 lerp4l(const LAS unsigned char* crow_, const LAS unsigned char* prow_, int colb, MP mu) {
    const v2u cur = *(const LAS v2u*)(crow_ + colb); const v2u prv = *(const LAS v2u*)(prow_ + colb);
    const f32x4 m = *(decltype(vec4p(mu)))(mu);
    f32x4 z; z[0] = bflo(cur.x) + (bflo(prv.x) - bflo(cur.x)) * m[0]; z[1] = bfhi(cur.x) + (bfhi(prv.x) - bfhi(cur.x)) * m[1];
    z[2] = bflo(cur.y) + (bflo(prv.y) - bflo(cur.y)) * m[2]; z[3] = bfhi(cur.y) + (bfhi(prv.y) - bfhi(cur.y)) * m[3]; return z;
}
DI void img_write(LAS unsigned char* img, const f32x4 (&x)[4], int fr, int fq) {
#pragma unroll
    for (int mb = 0; mb < 4; ++mb)
#pragma unroll
        for (int reg = 0; reg < 4; ++reg) *(LAS bf16*)(img + (16 * mb + 4 * fq + reg) * 32 + fr * 2) = (bf16)pk2z(x[mb][reg]);
}
DI bf16x8 lds4z(const LAS unsigned char* p) { const v2u t = *(const LAS v2u*)p; v4u w; w.x = t.x; w.y = t.y; w.z = 0u; w.w = 0u; return __builtin_bit_cast(bf16x8, w); }
constexpr int HC_DUP = 0, HC_IUP = 9216, HC_VUP = 18432, HC_F = 23552, HC_BYTES = 23552 + 736 * 4;
enum { HF_MUR = 0, HF_MUK = 64, HF_MUV = 128, HF_MUW = 192, HF_MUA = 256, HF_MUVR = 320, HF_DB = 352, HF_IB = 416, HF_VB = 480, HF_SK = 544, HF_SA = 608, HF_BR = 672 };
DI void head_cache_fill(const RwkvP& P, int h, LAS unsigned char* hc, int tid) {
    { const int row = tid >> 3, ch = tid & 7;
      *(LAS v4u*)(hc + HC_DUP + row * 144 + ch * 16) = *(const v4u*)(P.dupT + (size_t)(h * 64 + row) * 64 + ch * 8);
      *(LAS v4u*)(hc + HC_IUP + row * 144 + ch * 16) = *(const v4u*)(P.iupT + (size_t)(h * 64 + row) * 64 + ch * 8); }
    if (tid < 256 && !P.layer0) { const int row = tid >> 2, ch = tid & 3; *(LAS v4u*)(hc + HC_VUP + row * 80 + ch * 16) = *(const v4u*)(P.vupT + (size_t)(h * 64 + row) * 32 + ch * 8); }
    LAS float* f = (LAS float*)(hc + HC_F);
    if (tid < 64) { const int c = h * 64 + tid; f[HF_MUR + tid] = P.mu[c]; f[HF_MUK + tid] = P.mu[512 + c]; f[HF_MUV + tid] = P.mu[1024 + c]; f[HF_MUW + tid] = P.mu[1536 + tid]; f[HF_MUA + tid] = P.mu[1600 + tid];
        f[HF_DB + tid] = P.dbase[c]; f[HF_IB + tid] = P.ibase[c]; f[HF_VB + tid] = P.layer0 ? 0.f : P.vbase[c]; f[HF_SK + tid] = P.ksk[c]; f[HF_SA + tid] = P.ksa[c]; f[HF_BR + tid] = P.brk[c];
        if (tid < 32) f[HF_MUVR + tid] = P.layer0 ? 0.f : P.muv[tid]; }
}
DI void rwkv_b1_unit(const RwkvP& P, int unit, LAS unsigned char* wl, const LAS unsigned char* hc, LAS float* gct  , int lane) {
    asm volatile("" : "+v"(lane));
    const int fr = lane & 15, fq = lane >> 4;
    const int seq = unit >> 9, c = unit & 511, b = seq >> 3, h = seq & 7;
    const size_t row = (size_t)b * TSEQ + 16 * c + fr;
    const f32x4 z4 = {0.f, 0.f, 0.f, 0.f};
    const LAS float* hf = (const LAS float*)(hc + HC_F);
    const bf16* row0p = P.PR + ((size_t)b * TSEQ + 16 * c) * PRP;
#define TROW(rr) (((rr) == 0 && c == 0) ? P.ZROW : row0p + ((rr) - 1) * PRP)
    v4u tl[6], tr3[3][3];
#pragma unroll
    for (int i = 0; i < 5; ++i) { const int idx = lane + 64 * i; if (idx < 272) { const int rr = idx >> 4, pc = idx & 15; tl[i] = *(const v4u*)(TROW(rr) + 1536 + pc * 8); } }
    { const int idx = lane; const int rr = idx >> 2, pc = idx & 3; tl[5] = (v4u){0u, 0u, 0u, 0u}; if (!P.layer0) { tl[5] = *(const v4u*)(TROW(rr) + 1792 + pc * 8); } }
    v4u tl16 = {0u, 0u, 0u, 0u}; if (!P.layer0 && lane < 4) tl16 = *(const v4u*)(TROW(16) + 1792 + lane * 8);
#pragma unroll
    for (int ten = 0; ten < 3; ++ten)
#pragma unroll
        for (int i = 0; i < 3; ++i) { const int idx = lane + 64 * i; if (idx < 136) { const int rr = idx >> 3, pc = idx & 7; tr3[ten][i] = *(const v4u*)(TROW(rr) + ten * 512 + h * 64 + pc * 8); } }
#pragma unroll
    for (int i = 0; i < 5; ++i) { const int idx = lane + 64 * i; if (idx < 272) { const int rr = idx >> 4, pc = idx & 15; *(LAS v4u*)(wl + TIL + rr * TIL_LP + pc * 16) = tl[i]; } }
    { const int rr = lane >> 2, pc = lane & 3; *(LAS v4u*)(wl + TIL + rr * TIL_LP + 256 + pc * 16) = tl[5]; if (lane < 4) *(LAS v4u*)(wl + TIL + 16 * TIL_LP + 256 + lane * 16) = tl16; }
    LDS_WAIT();
    const LAS unsigned char* lcr = wl + TIL + (fr + 1) * TIL_LP; const LAS unsigned char* lpr = wl + TIL + fr * TIL_LP;
    bf16x8 tw[2], al[2], vl;
#pragma unroll
    for (int ks = 0; ks < 2; ++ks) { float z[8]; lerp8l(lcr, lpr, (8 * fq + 32 * ks) * 2, hf + HF_MUW + 8 * fq + 32 * ks, z);
        tw[ks] = pk8(ftanh(z[0]), ftanh(z[1]), ftanh(z[2]), ftanh(z[3]), ftanh(z[4]), ftanh(z[5]), ftanh(z[6]), ftanh(z[7]));
        lerp8l(lcr, lpr, 128 + (8 * fq + 32 * ks) * 2, hf + HF_MUA + 8 * fq + 32 * ks, z); al[ks] = pk8(z[0], z[1], z[2], z[3], z[4], z[5], z[6], z[7]); }
    if (!P.layer0) { float z[8]; lerp8l(lcr, lpr, 256 + 8 * fq * 2, hf + HF_MUVR + 8 * fq, z); vl = pk8(z[0], z[1], z[2], z[3], z[4], z[5], z[6], z[7]); }
    LDS_WAIT();
#pragma unroll
    for (int ten = 0; ten < 3; ++ten)
#pragma unroll
        for (int i = 0; i < 3; ++i) { const int idx = lane + 64 * i; if (idx < 136) { const int rr = idx >> 3, pc = idx & 7; *(LAS v4u*)(wl + TIL + ten * TIL_RSZ + rr * TIL_RP + pc * 16) = tr3[ten][i]; } }
    LDS_WAIT();
#undef TROW
    const LAS unsigned char* rcr = wl + TIL + (fr + 1) * TIL_RP; const LAS unsigned char* rpr = wl + TIL + fr * TIL_RP;
    f32x4 zr[4], k2[4], kk[4], ai[4], ld[4];
    float nrm = 0.f, bon = 0.f;
#pragma unroll
    for (int mb = 0; mb < 4; ++mb) { const int ch = h * 64 + 16 * mb + 4 * fq; const int n = h * 64 + 16 * mb + fr;
        f32x4 dw = z4, da = z4, dv = z4;
        dw = mfma16(*(const LAS bf16x8*)(hc + HC_DUP + (16 * mb + fr) * 144 + 16 * fq), tw[0], dw); dw = mfma16(*(const LAS bf16x8*)(hc + HC_DUP + (16 * mb + fr) * 144 + 16 * fq + 64), tw[1], dw);
        da = mfma16(*(const LAS bf16x8*)(hc + HC_IUP + (16 * mb + fr) * 144 + 16 * fq), al[0], da); da = mfma16(*(const LAS bf16x8*)(hc + HC_IUP + (16 * mb + fr) * 144 + 16 * fq + 64), al[1], da);
        if (!P.layer0) dv = mfma16(*(const LAS bf16x8*)(hc + HC_VUP + (16 * mb + fr) * 80 + 16 * fq), vl, z4);
        const int cl = 16 * mb + 4 * fq;
        zr[mb] = lerp4l(rcr, rpr, cl * 2, hf + HF_MUR + cl);
        const f32x4 zk = lerp4l(rcr + TIL_RSZ, rpr + TIL_RSZ, cl * 2, hf + HF_MUK + cl);
        f32x4 zv = lerp4l(rcr + 2 * TIL_RSZ, rpr + 2 * TIL_RSZ, cl * 2, hf + HF_MUV + cl);
        const f32x4 db = *(const LAS f32x4*)(hf + HF_DB + cl), ib = *(const LAS f32x4*)(hf + HF_IB + cl), sk = *(const LAS f32x4*)(hf + HF_SK + cl), sa = *(const LAS f32x4*)(hf + HF_SA + cl), br = *(const LAS f32x4*)(hf + HF_BR + cl);
        if (P.layer0) { v2u w; w.x = pk2(zv[0], zv[1]); w.y = pk2(zv[2], zv[3]); *(v2u*)(P.VF + row * 512 + ch) = w; }
        else { const v2u f = *(const v2u*)(P.VF + row * 512 + ch); const f32x4 vb = *(const LAS f32x4*)(hf + HF_VB + cl); const f32x4 vf = {bflo(f.x), bfhi(f.x), bflo(f.y), bfhi(f.y)};
#pragma unroll
            for (int e = 0; e < 4; ++e) zv[e] = zv[e] + (vf[e] - zv[e]) * fsigmoid(vb[e] + dv[e]); }
        { v2u w; w.x = pk2(zv[0], zv[1]); w.y = pk2(zv[2], zv[3]); *(v2u*)(P.VV + row * 512 + ch) = w; }
#pragma unroll
        for (int reg = 0; reg < 4; ++reg) *(LAS bf16*)(wl + IMG_V + (16 * mb + 4 * fq + reg) * 32 + fr * 2) = (bf16)pk2z(zv[reg]);
#pragma unroll
        for (int e = 0; e < 4; ++e) {
            ld[mb][e] = fexp(-0.60653065971f * fsigmoid(db[e] + dw[e]));
            const float a = fsigmoid(ib[e] + da[e]); ai[mb][e] = a;
            const float kr = zk[e] * sk[e]; kk[mb][e] = kr; nrm += kr * kr;
            const float kx = zk[e] * (1.f + (a - 1.f) * sa[e]); k2[mb][e] = kx; bon += zr[mb][e] * kx * br[e]; }
        asm volatile("" ::: "memory");
    }
    nrm += __shfl_xor(nrm, 16); nrm += __shfl_xor(nrm, 32); bon += __shfl_xor(bon, 16); bon += __shfl_xor(bon, 32);
    if (fq == 0) P.BON[row * 8 + h] = bon;
    const float kinv = 1.0f / fmaxf(sqrtf(nrm), 1e-12f);
    f32x4 rt[4], kh[4];
    bf16x8 pa[2], pb[2], pk[2], pr[2];
#pragma unroll
    for (int ks = 0; ks < 2; ++ks) {
        f32x4 at2[2], bt2[2], kt2[2];
#pragma unroll
        for (int m2 = 0; m2 < 2; ++m2) { const int mb = 2 * ks + m2;
            f32x4 gcv, bhv;
#pragma unroll
            for (int e = 0; e < 4; ++e) {
                float gm = ld[mb][e]; gm *= dpp_shr1(gm, 1); gm *= dpp_shr1(gm, 2); gm *= dpp_shr1(gm, 4); gm *= dpp_shr1(gm, 8);
                const float gc = __shfl(gm, lane | 15), gp = dpp_shr1(gm, 1), gi = __builtin_amdgcn_rcpf(gm), ec = gc * gi;
                const float kn = kk[mb][e] * kinv, bb = kn * ai[mb][e];
                at2[m2][e] = -kn * gp; bt2[m2][e] = bb * gi; kt2[m2][e] = k2[mb][e] * gi; rt[mb][e] = zr[mb][e] * gm;
                bhv[e] = bb * ec; kh[mb][e] = k2[mb][e] * ec; gcv[e] = gc; }
            if (fr == 0) { *(f32x4*)(P.GC + (size_t)unit * 64 + 16 * mb + 4 * fq) = gcv; *(LAS f32x4*)(gct + (unit & 31) * 64 + 16 * mb + 4 * fq) = gcv; }
#pragma unroll
            for (int reg = 0; reg < 4; ++reg) { const int o = (16 * mb + 4 * fq + reg) * 32 + fr * 2;
                *(LAS bf16*)(wl + IMG_A + o) = (bf16)pk2z(at2[m2][reg]); *(LAS bf16*)(wl + IMG_B + o) = (bf16)pk2z(bhv[reg]); }
        }
        pa[ks] = pk8v(at2[0], at2[1]); pb[ks] = pk8v(bt2[0], bt2[1]); pk[ks] = pk8v(kt2[0], kt2[1]); pr[ks] = pk8v(rt[2 * ks], rt[2 * ks + 1]);
    }
    const f32x4 z4b = {0.f, 0.f, 0.f, 0.f};
    f32x4 Aab = mfma16(pb[1], pa[1], mfma16(pb[0], pa[0], z4b));
    f32x4 AakT = mfma16(pa[1], pk[1], mfma16(pa[0], pk[0], z4b));
    f32x4 Arb = mfma16(pb[1], pr[1], mfma16(pb[0], pr[0], z4b));
    f32x4 Ark = mfma16(pk[1], pr[1], mfma16(pk[0], pr[0], z4b));
#pragma unroll
    for (int e = 0; e < 4; ++e) { const int rr = 4 * fq + e; Aab[e] = rr < fr ? Aab[e] : 0.f; AakT[e] = fr < rr ? AakT[e] : 0.f; Arb[e] = rr <= fr ? Arb[e] : 0.f; Ark[e] = rr <= fr ? Ark[e] : 0.f; }
    LAS float* As = (LAS float*)(wl + 5 * B1_IMG);
#pragma unroll
    for (int e = 0; e < 4; ++e) As[(4 * fq + e) * 16 + fr] = Aab[e];
    LDS_WAIT();
    float x[16];
#pragma unroll
    for (int s = 15; s >= 0; --s) { float acc = (s == fr) ? 1.f : 0.f;
        const f32x4 r0 = *(const LAS f32x4*)(As + s * 16), r1 = *(const LAS f32x4*)(As + s * 16 + 4), r2 = *(const LAS f32x4*)(As + s * 16 + 8), r3 = *(const LAS f32x4*)(As + s * 16 + 12);
        const float rowv[16] = {r0[0], r0[1], r0[2], r0[3], r1[0], r1[1], r1[2], r1[3], r2[0], r2[1], r2[2], r2[3], r3[0], r3[1], r3[2], r3[3]};
#pragma unroll
        for (int uu = s + 1; uu < 16; ++uu) acc += rowv[uu] * x[uu];
        x[s] = acc; if ((s & 1) == 0) asm volatile("" ::: "memory"); }
    f32x4 xs;
#pragma unroll
    for (int e = 0; e < 4; ++e) xs[e] = fq == 0 ? x[e] : fq == 1 ? x[4 + e] : fq == 2 ? x[8 + e] : x[12 + e];
    const bf16x8 Tsel = pk4z(xs);
    f32x4 W1[4];
#pragma unroll
    for (int mb = 0; mb < 4; ++mb) W1[mb] = mfma16(lds4z(wl + IMG_A + (16 * mb + fr) * 32 + 8 * fq), Tsel, z4);
    const f32x4 GT = mfma16(Tsel, pk4z(AakT), z4);
    img_write(wl + IMG_W, W1, fr, fq);
    f32x4 M1T[4];
    const bf16x8 GTp = pk4z(GT);
#pragma unroll
    for (int mb = 0; mb < 4; ++mb) M1T[mb] = mfma16(lds4z(wl + IMG_B + (16 * mb + fr) * 32 + 8 * fq), GTp, kh[mb]);
    img_write(wl + IMG_M, M1T, fr, fq);
    LDS_WAIT();
    const bf16x8 Arbp = pk4z(Arb);
    f32x4 RE[4];
#pragma unroll
    for (int mb = 0; mb < 4; ++mb) RE[mb] = mfma16(lds4z(wl + IMG_W + (16 * mb + fr) * 32 + 8 * fq), Arbp, rt[mb]);
    const f32x4 M2 = mfma16(GTp, Arbp, Ark);
    {   bf16* w1s = P.W1S + (size_t)unit * 1024 + fr * 32; bf16* re = P.REFF + (size_t)unit * 1024 + fr * 32;
#pragma unroll
        for (int kp = 0; kp < 2; ++kp) { const int sg = kp * 512 + fq * 8;
            v4u w; w.x = pk2(W1[2 * kp][0], W1[2 * kp][1]); w.y = pk2(W1[2 * kp][2], W1[2 * kp][3]); w.z = pk2(W1[2 * kp + 1][0], W1[2 * kp + 1][1]); w.w = pk2(W1[2 * kp + 1][2], W1[2 * kp + 1][3]); *(v4u*)(w1s + sg) = w;
            w.x = pk2(RE[2 * kp][0], RE[2 * kp][1]); w.y = pk2(RE[2 * kp][2], RE[2 * kp][3]); w.z = pk2(RE[2 * kp + 1][0], RE[2 * kp + 1][1]); w.w = pk2(RE[2 * kp + 1][2], RE[2 * kp + 1][3]); *(v4u*)(re + sg) = w; }
        const v2u m2p = {pk2(M2[0], M2[1]), pk2(M2[2], M2[3])};
#pragma unroll
        for (int mb = 0; mb < 4; ++mb) {
            const v2u bq = *(const LAS v2u*)(wl + IMG_B + (16 * mb + fr) * 32 + 8 * fq), mq = *(const LAS v2u*)(wl + IMG_M + (16 * mb + fr) * 32 + 8 * fq);
            *(v4u*)(P.BM + (((size_t)unit * 64 + 16 * mb + fr) * 4 + fq) * 8) = (v4u){bq.x, bq.y, mq.x, mq.y};
            const v2u vq = *(const LAS v2u*)(wl + IMG_V + (16 * mb + fr) * 32 + 8 * fq);
            P.REC[((size_t)unit * 4 + mb) * 64 + lane] = (v4u){vq.x, vq.y, m2p.x, m2p.y}; }
    }
    LDS_WAIT();
}
constexpr int NSEG = 16, SEGCH = NCH / NSEG;
struct ChainIn { bf16x8 w1[2], re[2], bm[4]; v4u rec; };
constexpr int GCT_OFF = 149504;
template <int MODE> DI void chain_load(ChainIn& c, const RwkvP& P, int unit, int rb, int lane) {
    const int fr = lane & 15, fq = lane >> 4;
    const bf16* w1s = P.W1S + (size_t)unit * 1024 + fr * 32 + fq * 8;
    c.w1[0] = ld8(w1s); c.w1[1] = ld8(w1s + 512);
    if (MODE == 2) { const bf16* re = P.REFF + (size_t)unit * 1024 + fr * 32 + fq * 8; c.re[0] = ld8(re); c.re[1] = ld8(re + 512); }
#pragma unroll
    for (int mb = 0; mb < 4; ++mb) c.bm[mb] = ld8(P.BM + (((size_t)unit * 64 + 16 * mb + fr) * 4 + fq) * 8);
    if (MODE != 1) c.rec = P.REC[((size_t)unit * 4 + rb) * 64 + lane];
}
template <int MODE> DI void chain_step(f32x4 (&S)[4], const ChainIn& c, float* ypre  , const LAS float* gcl  ) {
    const f32x4 z4 = {0.f, 0.f, 0.f, 0.f};
    f32x4 gc[4];
#pragma unroll
    for (int mb = 0; mb < 4; ++mb) gc[mb] = *(const LAS f32x4*)(gcl + 16 * mb);
    const bf16x8 b0 = pk8v(S[0], S[1]), b1 = pk8v(S[2], S[3]);
    f32x4 ut = mfma16(c.w1[1], b1, mfma16(c.w1[0], b0, z4));
    if (MODE == 2) {
        v4u vlo; vlo.x = c.rec.x; vlo.y = c.rec.y; vlo.z = 0u; vlo.w = 0u;
        v4u m2a; m2a.x = c.rec.z; m2a.y = c.rec.w; m2a.z = 0u; m2a.w = 0u;
        f32x4 y = mfma16(__builtin_bit_cast(bf16x8, m2a), __builtin_bit_cast(bf16x8, vlo), z4);
        y = mfma16(c.re[0], b0, y); y = mfma16(c.re[1], b1, y);
#pragma unroll
        for (int e = 0; e < 4; ++e) ypre[(size_t)e * 512] = y[e];
    }
    v4u uv; uv.x = pk2(ut[0], ut[1]); uv.y = pk2(ut[2], ut[3]); uv.z = MODE == 1 ? 0u : c.rec.x; uv.w = MODE == 1 ? 0u : c.rec.y;
    const bf16x8 ub = __builtin_bit_cast(bf16x8, uv);
#pragma unroll
    for (int mb = 0; mb < 4; ++mb) S[mb] = mfma16(c.bm[mb], ub, S[mb] * gc[mb]);
}
template <int MODE> DI void chain_run(f32x4 (&S)[4], const RwkvP& P, int unit0, int nsteps  , int rb, float* yp, const LAS float* gct  , int lane) {
    ChainIn c0, c1, c2, c3;
    chain_load<MODE>(c0, P, unit0, rb, lane); chain_load<MODE>(c1, P, unit0 + 1, rb, lane); chain_load<MODE>(c2, P, unit0 + 2, rb, lane);
    for (int c = 0; c < nsteps; c += 4) {
        chain_load<MODE>(c3, P, unit0 + c + 3, rb, lane);
        chain_step<MODE>(S, c0, yp + (size_t)c * 16 * 512, gct + c * 64);
        if (c + 4 < nsteps) chain_load<MODE>(c0, P, unit0 + c + 4, rb, lane);
        chain_step<MODE>(S, c1, yp + (size_t)(c + 1) * 16 * 512, gct + (c + 1) * 64);
        if (c + 5 < nsteps) chain_load<MODE>(c1, P, unit0 + c + 5, rb, lane);
        chain_step<MODE>(S, c2, yp + (size_t)(c + 2) * 16 * 512, gct + (c + 2) * 64);
        if (c + 6 < nsteps) chain_load<MODE>(c2, P, unit0 + c + 6, rb, lane);
        chain_step<MODE>(S, c3, yp + (size_t)(c + 3) * 16 * 512, gct + (c + 3) * 64);
    }
}
DI void chain_step_dual(f32x4 (&SQ)[4], f32x4 (&SP)[4], const ChainIn& c, const LAS float* gcl) {
    const f32x4 z4 = {0.f, 0.f, 0.f, 0.f};
    f32x4 gc[4];
#pragma unroll
    for (int mb = 0; mb < 4; ++mb) gc[mb] = *(const LAS f32x4*)(gcl + 16 * mb);
    const bf16x8 q0 = pk8v(SQ[0], SQ[1]), q1 = pk8v(SQ[2], SQ[3]), p0 = pk8v(SP[0], SP[1]), p1 = pk8v(SP[2], SP[3]);
    const f32x4 utq = mfma16(c.w1[1], q1, mfma16(c.w1[0], q0, z4)), utp = mfma16(c.w1[1], p1, mfma16(c.w1[0], p0, z4));
    v4u uq; uq.x = pk2(utq[0], utq[1]); uq.y = pk2(utq[2], utq[3]); uq.z = c.rec.x; uq.w = c.rec.y;
    v4u up; up.x = pk2(utp[0], utp[1]); up.y = pk2(utp[2], utp[3]); up.z = 0u; up.w = 0u;
    const bf16x8 ubq = __builtin_bit_cast(bf16x8, uq), ubp = __builtin_bit_cast(bf16x8, up);
#pragma unroll
    for (int mb = 0; mb < 4; ++mb) { SQ[mb] = mfma16(c.bm[mb], ubq, SQ[mb] * gc[mb]); SP[mb] = mfma16(c.bm[mb], ubp, SP[mb] * gc[mb]); }
}
DI void chain_pass1(const RwkvP& P, float* QSEG, float* PSEGT, int seq, int g, int rb, const LAS float* gct0, int lane) {
    const int fr = lane & 15, fq = lane >> 4;
    f32x4 SQ[4], SP[4];
#pragma unroll
    for (int mb = 0; mb < 4; ++mb)
#pragma unroll
        for (int e = 0; e < 4; ++e) { SQ[mb][e] = 0.f; SP[mb][e] = ((16 * mb + 4 * fq + e) == (16 * rb + fr)) ? 1.f : 0.f; }
    const int unit0 = seq * NCH + g * SEGCH; const LAS float* gct = gct0 + 4 * fq;
    {   ChainIn c0, c1, c2;
        chain_load<0>(c0, P, unit0, rb, lane); chain_load<0>(c1, P, unit0 + 1, rb, lane);
        int c = 0;
        for (; c + 3 <= SEGCH; c += 3) {
            chain_load<0>(c2, P, unit0 + c + 2, rb, lane);
            chain_step_dual(SQ, SP, c0, gct + c * 64);
            if (c + 3 < SEGCH) chain_load<0>(c0, P, unit0 + c + 3, rb, lane);
            chain_step_dual(SQ, SP, c1, gct + (c + 1) * 64);
            if (c + 4 < SEGCH) chain_load<0>(c1, P, unit0 + c + 4, rb, lane);
            chain_step_dual(SQ, SP, c2, gct + (c + 2) * 64);
        }
        if (c < SEGCH) { chain_step_dual(SQ, SP, c0, gct + c * 64); ++c; }
        if (c < SEGCH) { chain_step_dual(SQ, SP, c1, gct + c * 64); ++c; }
    }
    const size_t sb = ((size_t)seq * NSEG + g) * 4096;
#pragma unroll
    for (int mb = 0; mb < 4; ++mb) *(f32x4*)(QSEG + sb + (size_t)(16 * rb + fr) * 64 + 16 * mb + 4 * fq) = SQ[mb];
#pragma unroll
    for (int mb = 0; mb < 4; ++mb)
#pragma unroll
        for (int e = 0; e < 4; ++e) { const float x = SP[mb][e]; const unsigned hb = f2bf(x), lb = f2bf(x - bf2f(hb));
            unsigned short* ph = (unsigned short*)PSEGT + sb * 2 + (size_t)((mb * 2 + (rb >> 1)) * 2) * 512 + ((4 * fq + e) + 16 * (fr >> 2)) * 8 + (rb & 1) * 4 + (fr & 3);
            ph[0] = (unsigned short)hb; ph[512] = (unsigned short)lb; }
}
DI void split_hl(const f32x4 a, const f32x4 b, bf16x8& hi, bf16x8& lo) {
    f32x4 ah, bh;
#pragma unroll
    for (int e = 0; e < 4; ++e) { ah[e] = rbf(a[e]); bh[e] = rbf(b[e]); }
    hi = pk8v(ah, bh); lo = pk8v(a - ah, b - bh);
}
DI void chain_pass23(const RwkvP& P, const float* QSEG, const float* PSEGT, int seq, int g, int rb, float* wkv_out, const LAS float* gct0, int lane) {
    const int fr = lane & 15, fq = lane >> 4, b = seq >> 3, h = seq & 7;
    f32x4 S[4]; for (int mb = 0; mb < 4; ++mb) S[mb] = (f32x4){0.f, 0.f, 0.f, 0.f};
    bf16x8 pc[4][2][2], pn[4][2][2];
#define P2_LOAD(PD_, GP_) do { const size_t sb_ = ((size_t)seq * NSEG + (GP_)) * 4096; _Pragma("unroll") for (int mb = 0; mb < 4; ++mb) { \
        _Pragma("unroll") for (int ks = 0; ks < 2; ++ks) { const unsigned short* pr_ = (const unsigned short*)PSEGT + sb_ * 2 + (size_t)((mb * 2 + ks) * 2) * 512 + (fr + 16 * fq) * 8; PD_[mb][ks][0] = *(const bf16x8*)pr_; PD_[mb][ks][1] = *(const bf16x8*)(pr_ + 512); } } } while (0)
    f32x4 qc[4], qn[4];
#define Q2_LOAD(QD_, GP_) do { const size_t sb_ = ((size_t)seq * NSEG + (GP_)) * 4096; _Pragma("unroll") for (int mb = 0; mb < 4; ++mb) QD_[mb] = *(const f32x4*)(QSEG + sb_ + (size_t)(16 * rb + fr) * 64 + 16 * mb + 4 * fq); } while (0)
    if (g > 0) { P2_LOAD(pc, 0); Q2_LOAD(qc, 0); }
    for (int gp = 0; gp < g; ++gp) {
        if (gp + 1 < g) { P2_LOAD(pn, gp + 1); Q2_LOAD(qn, gp + 1); }
        bf16x8 bh[2], bl[2]; split_hl(S[0], S[1], bh[0], bl[0]); split_hl(S[2], S[3], bh[1], bl[1]);
#pragma unroll
        for (int mb = 0; mb < 4; ++mb) { f32x4 acc = {0.f, 0.f, 0.f, 0.f};
#pragma unroll
            for (int ks = 0; ks < 2; ++ks) { const bf16x8 ah = pc[mb][ks][0], al = pc[mb][ks][1];
                acc = mfma16(ah, bh[ks], acc); acc = mfma16(al, bh[ks], acc); acc = mfma16(ah, bl[ks], acc); }
            S[mb] = acc + qc[mb]; }
#pragma unroll
        for (int mb = 0; mb < 4; ++mb) {
#pragma unroll
            for (int ks = 0; ks < 2; ++ks) { pc[mb][ks][0] = pn[mb][ks][0]; pc[mb][ks][1] = pn[mb][ks][1]; } qc[mb] = qn[mb]; }
    }
#undef P2_LOAD
#undef Q2_LOAD
    float* yp = P.YPRE + ((size_t)b * TSEQ + (size_t)g * SEGCH * 16 + 4 * fq) * 512 + h * 64 + 16 * rb + fr;
    chain_run<2>(S, P, seq * NCH + g * SEGCH, SEGCH, rb, yp, gct0 + 4 * fq, lane);
    if (g == NSEG - 1) {
#pragma unroll
        for (int mb = 0; mb < 4; ++mb) *(f32x4*)(wkv_out + (size_t)(16 * rb + fr) * 64 + 16 * mb + 4 * fq) = S[mb];
    }
}
constexpr int GC_GUP = 0, GC_F = 64 * 272, GC_BYTES = 64 * 272 + 256 * 4;
DI void gate_cache_fill(const RwkvP& P, int h, LAS unsigned char* gc, int tid) {
#pragma unroll
    for (int q = 0; q < 2; ++q) { const int idx = tid + 512 * q, row = idx >> 4, ch = idx & 15;
        *(LAS v4u*)(gc + GC_GUP + row * 272 + ch * 16) = *(const v4u*)(P.gupT + (size_t)(h * 64 + row) * 128 + ch * 8); }
    LAS float* f = (LAS float*)(gc + GC_F);
    if (tid < 64) { f[tid] = P.gng[h * 64 + tid]; f[64 + tid] = P.gnb[h * 64 + tid]; }
    if (tid >= 64 && tid < 192) f[128 + tid - 64] = P.mu[1664 + tid - 64];
}
constexpr int B3_GP = 272, B3_YP = 272, B3_VP = 144, B3_G = 0, B3_Y = 17 * B3_GP, B3_V = B3_Y + 16 * B3_YP, B3_WLDS = B3_V + 16 * B3_VP;
DI void rwkv_b3_unit(const RwkvP& P, int unit, const LAS unsigned char* gc, LAS unsigned char* wl, int lane) {
    asm volatile("" : "+v"(lane));
    const int fr = lane & 15, fq = lane >> 4;
    const int seq = unit >> 9, c = unit & 511, b = seq >> 3, h = seq & 7;
    const size_t row0 = (size_t)b * TSEQ + 16 * c;
    const f32x4 z4 = {0.f, 0.f, 0.f, 0.f};
    const LAS float* gf = (const LAS float*)(gc + GC_F);
    const bf16* row0p = P.PR + row0 * PRP;
    v4u tg[5], ty[4], tv[2];
#pragma unroll
    for (int i = 0; i < 5; ++i) { const int idx = lane + 64 * i; if (idx < 272) { const int rr = idx >> 4, pc = idx & 15; const bf16* rp = (rr == 0 && c == 0) ? P.ZROW : row0p + (rr - 1) * PRP; tg[i] = *(const v4u*)(rp + 1664 + pc * 8); } }
#pragma unroll
    for (int i = 0; i < 4; ++i) { const int idx = lane + 64 * i, rr = idx >> 4, pc = idx & 15; ty[i] = *(const v4u*)(P.YPRE + (row0 + rr) * 512 + h * 64 + pc * 4); }
#pragma unroll
    for (int i = 0; i < 2; ++i) { const int idx = lane + 64 * i, rr = idx >> 3, pc = idx & 7; tv[i] = *(const v4u*)(P.VV + (row0 + rr) * 512 + h * 64 + pc * 8); }
    const float bon = P.BON[(row0 + fr) * 8 + h];
#pragma unroll
    for (int i = 0; i < 5; ++i) { const int idx = lane + 64 * i; if (idx < 272) { const int rr = idx >> 4, pc = idx & 15; *(LAS v4u*)(wl + B3_G + rr * B3_GP + pc * 16) = tg[i]; } }
#pragma unroll
    for (int i = 0; i < 4; ++i) { const int idx = lane + 64 * i, rr = idx >> 4, pc = idx & 15; *(LAS v4u*)(wl + B3_Y + rr * B3_YP + pc * 16) = ty[i]; }
#pragma unroll
    for (int i = 0; i < 2; ++i) { const int idx = lane + 64 * i, rr = idx >> 3, pc = idx & 7; *(LAS v4u*)(wl + B3_V + rr * B3_VP + pc * 16) = tv[i]; }
    LDS_WAIT();
    const LAS unsigned char* gcr = wl + B3_G + (fr + 1) * B3_GP; const LAS unsigned char* gpr = wl + B3_G + fr * B3_GP;
    bf16x8 sg[4];
#pragma unroll
    for (int ks = 0; ks < 4; ++ks) { float z[8]; lerp8l(gcr, gpr, (8 * fq + 32 * ks) * 2, gf + 128 + 8 * fq + 32 * ks, z);
        sg[ks] = pk8(fsigmoid(z[0]), fsigmoid(z[1]), fsigmoid(z[2]), fsigmoid(z[3]), fsigmoid(z[4]), fsigmoid(z[5]), fsigmoid(z[6]), fsigmoid(z[7])); }
    f32x4 g[4], y[4]; float s = 0.f;
#pragma unroll
    for (int mb = 0; mb < 4; ++mb) { f32x4 a = z4;
#pragma unroll
        for (int ks = 0; ks < 4; ++ks) a = mfma16(*(const LAS bf16x8*)(gc + GC_GUP + (16 * mb + fr) * 272 + 16 * fq + 64 * ks), sg[ks], a);
        g[mb] = a;
        y[mb] = *(const LAS f32x4*)(wl + B3_Y + fr * B3_YP + (16 * mb + 4 * fq) * 4); s += (y[mb][0] + y[mb][1]) + (y[mb][2] + y[mb][3]); }
    s += __shfl_xor(s, 16); s += __shfl_xor(s, 32);
    const float mean = s * (1.f / 64.f); float q = 0.f;
#pragma unroll
    for (int mb = 0; mb < 4; ++mb) { y[mb] = y[mb] - mean; q += (y[mb][0] * y[mb][0] + y[mb][1] * y[mb][1]) + (y[mb][2] * y[mb][2] + y[mb][3] * y[mb][3]); }
    q += __shfl_xor(q, 16); q += __shfl_xor(q, 32);
    const float rstd = 1.0f / sqrtf(q * (1.f / 64.f) + GN_EPS);
    LDS_WAIT();
#pragma unroll
    for (int mb = 0; mb < 4; ++mb) { const int cl = 16 * mb + 4 * fq;
        const f32x4 gg = *(const LAS f32x4*)(gf + cl), gb = *(const LAS f32x4*)(gf + 64 + cl); const v2u vw = *(const LAS v2u*)(wl + B3_V + fr * B3_VP + cl * 2);
        const f32x4 v = {bflo(vw.x), bfhi(vw.x), bflo(vw.y), bfhi(vw.y)};
        const f32x4 o = (y[mb] * rstd * gg + gb + v * bon) * g[mb];
        v2u w; w.x = pk2(o[0], o[1]); w.y = pk2(o[2], o[3]); *(LAS v2u*)(wl + B3_G + fr * B3_VP + cl * 2) = w; }
    LDS_WAIT();
#pragma unroll
    for (int i = 0; i < 2; ++i) { const int idx = lane + 64 * i, rr = idx >> 3, pc = idx & 7; *(v4u*)(P.MIX + (row0 + rr) * 1024 + 512 + h * 64 + pc * 8) = *(const LAS v4u*)(wl + B3_G + rr * B3_VP + pc * 16); }
    LDS_WAIT();
}
DI void dec_gemm(const bf16* A, const bf16* Wt, int K, LAS float* red  , int wave, int lane, float (&v)[2]) {
    const int r = lane & 31, h = lane >> 5, kw = K >> 3, nb = kw >> 7;
    const bf16* ap = A + (size_t)r * K + wave * kw + 8 * h; const bf16* bp = Wt + (size_t)r * K + wave * kw + 8 * h;
    f32x16 acc; for (int i = 0; i < 16; ++i) acc[i] = 0.f;
    bf16x8 a0[8], b0[8], a1[8], b1[8];
#define DG_LOAD(a_, b_, kb_) do { _Pragma("unroll") for (int j = 0; j < 8; ++j) { a_[j] = ld8(ap + (kb_) * 128 + 16 * j); b_[j] = ld8(bp + (kb_) * 128 + 16 * j); } } while (0)
#define DG_MMA(a_, b_) do { _Pragma("unroll") for (int j = 0; j < 8; ++j) acc = mfma32(a_[j], b_[j], acc); } while (0)
    DG_LOAD(a0, b0, 0);
#pragma unroll 1
    for (int kb = 0; kb < nb; kb += 2) {
        if (kb + 1 < nb) DG_LOAD(a1, b1, kb + 1);
        DG_MMA(a0, b0);
        if (kb + 1 < nb) { if (kb + 2 < nb) DG_LOAD(a0, b0, kb + 2); DG_MMA(a1, b1); }
    }
#undef DG_LOAD
#undef DG_MMA
    __syncthreads();
#pragma unroll
    for (int i = 0; i < 16; ++i) red[(wave * 16 + i) * 64 + lane] = acc[i];
    __syncthreads();
#pragma unroll
    for (int ii = 0; ii < 2; ++ii) { float s = 0.f;
#pragma unroll
        for (int w = 0; w < 8; ++w) s += red[(w * 16 + 2 * wave + ii) * 64 + lane];
        v[ii] = s; }
}
struct DecSplit { int ks, nsplit; float* part; unsigned* cnt; volatile LAS unsigned* flag; };
DI bool dec_gemm_split(const bf16* A, const bf16* Wt, int K, const DecSplit& sp, LAS float* red, int wave, int lane, float (&v)[2]) {
    const int r = lane & 31, h = lane >> 5, ksl = K / sp.nsplit, kw = ksl >> 3;
    const bf16* ap = A + (size_t)r * K + sp.ks * ksl + wave * kw + 8 * h; const bf16* bp = Wt + (size_t)r * K + sp.ks * ksl + wave * kw + 8 * h;
    f32x16 acc; for (int i = 0; i < 16; ++i) acc[i] = 0.f;
#pragma unroll 4
    for (int k = 0; k < kw; k += 16) acc = mfma32(ld8(ap + k), ld8(bp + k), acc);
    __syncthreads();
#pragma unroll
    for (int i = 0; i < 16; ++i) red[(wave * 16 + i) * 64 + lane] = acc[i];
    __syncthreads();
#pragma unroll
    for (int ii = 0; ii < 2; ++ii) { float s = 0.f;
#pragma unroll
        for (int w = 0; w < 8; ++w) s += red[(w * 16 + 2 * wave + ii) * 64 + lane];
        __hip_atomic_store(sp.part + (size_t)(sp.ks * 16 + 2 * wave + ii) * 64 + lane, s, __ATOMIC_RELAXED, __HIP_MEMORY_SCOPE_AGENT); }
    asm volatile("s_waitcnt vmcnt(0)" ::: "memory");
    __syncthreads();
    if (wave == 0 && lane == 0) *sp.flag = __hip_atomic_fetch_add(sp.cnt, 1u, __ATOMIC_RELAXED, __HIP_MEMORY_SCOPE_AGENT);
    __syncthreads();
    const bool last = (int)*sp.flag == sp.nsplit - 1;
    if (!last) return false;
#pragma unroll
    for (int ii = 0; ii < 2; ++ii) { float s = 0.f;
#pragma unroll 8
        for (int k = 0; k < sp.nsplit; ++k) s += __hip_atomic_load(sp.part + (size_t)(k * 16 + 2 * wave + ii) * 64 + lane, __ATOMIC_RELAXED, __HIP_MEMORY_SCOPE_AGENT);
        v[ii] = s; }
    return true;
}
DI void dec_row_stats(const float* st, LAS float* sc, int lane) {
    if (lane < 32) { float s = 0.f, q = 0.f; const f32x4* p = (const f32x4*)(st + (size_t)lane * 64);
#pragma unroll
        for (int i = 0; i < 16; ++i) { const f32x4 v = p[i]; s += v[0] + v[2]; q += v[1] + v[3]; if ((i & 7) == 7) asm volatile("" : "+v"(s), "+v"(q) :: "memory"); }
        const float mu = s * (1.f / 1024.f), var = fmaxf(q * (1.f / 1024.f) - mu * mu, 0.f); sc[2 * lane] = mu; sc[2 * lane + 1] = 1.0f / sqrtf(var + LN_EPS); }
    LDS_WAIT();
}
DI void dec_stats_load(const float* st, int lane, f32x4 (&v)[8]) { const f32x4* p = (const f32x4*)(st + (size_t)(lane & 31) * 64) + (lane >> 5) * 8;
#pragma unroll
    for (int i = 0; i < 8; ++i) v[i] = p[i]; }
DI void dec_stats_finish(const f32x4 (&v)[8], LAS float* sc, int lane) { float s = 0.f, q = 0.f;
#pragma unroll
    for (int i = 0; i < 8; ++i) { s += v[i][0] + v[i][2]; q += v[i][1] + v[i][3]; }
    s += __shfl_xor(s, 32); q += __shfl_xor(q, 32);
    if (lane < 32) { const float mu = s * (1.f / 1024.f), var = fmaxf(q * (1.f / 1024.f) - mu * mu, 0.f); sc[2 * lane] = mu; sc[2 * lane + 1] = 1.0f / sqrtf(var + LN_EPS); }
    LDS_WAIT(); }
struct DecP {
    unsigned char* dec; int l;
    const float* xs;
    const float *c1in, *c2in, *c1up, *c2up, *g1, *b1, *g2p, *b2p;
    const bf16 *win, *winu, *wout, *wup, *wdn;
    float* out;
};
DI void dec_unit_in(const DecP& D, int u, LAS float* red, LAS float* sc, int wave, int lane) {
    const int r32 = lane & 31, hi = lane >> 5;
    if (u < 105) {
        const int n = 32 * u + r32; const bool fold = D.l > 0;
        const float c1 = fold ? D.c1in[n] : 0.f, c2 = fold ? D.c2in[n] : 0.f; const int on = n < 1024 ? lgcl2orig(n) : n;
        f32x4 stv[8]; if (fold) dec_stats_load((const float*)(D.dec + DEC_ST2), lane, stv);
        float acc[2]; dec_gemm((const bf16*)(D.dec + DEC_XB2), D.win + (size_t)(32 * u) * DM, DM, red, wave, lane, acc);
        sc += wave * 64;
        if (fold) dec_stats_finish(stv, sc, lane);
        float* PD = (float*)(D.dec + DEC_PD);
#pragma unroll
        for (int ii = 0; ii < 2; ++ii) { const int row = crow(2 * wave + ii, hi); float mu = 0.f, rs = 1.f; if (fold) { mu = sc[2 * row]; rs = sc[2 * row + 1]; } PD[(size_t)row * NIN + on] = (acc[ii] - mu * c1) * rs + c2; }
    } else {
        const int v = u - 105, n = 32 * v + r32;
        float acc[2]; dec_gemm((const bf16*)(D.dec + DEC_SHB) + (size_t)D.l * MD * DM, D.winu + (size_t)(32 * v) * DM, DM, red, wave, lane, acc);
        float* PS = (float*)(D.dec + DEC_PS);
#pragma unroll
        for (int ii = 0; ii < 2; ++ii) PS[(size_t)crow(2 * wave + ii, hi) * NRWU + n] = acc[ii];
    }
    LDS_WAIT();
}
DI void dec_unit_res(const bf16* A, const bf16* Wt, int K, int u, bool raw, const float* src, const float* sstat, const float* g, const float* b, float* T, bf16* XB, float* ostat, float* shiftout, const DecSplit& sp, LAS float* red, LAS float* sc, int wave, int lane) {
    const int r32 = lane & 31, hi = lane >> 5, n = 32 * u + r32;
    const float sv0 = src[(size_t)crow(2 * wave, hi) * DM + n], sv1 = src[(size_t)crow(2 * wave + 1, hi) * DM + n];
    const float gg = raw ? 1.f : g[n], bb = raw ? 0.f : b[n];
    f32x4 stv[8]; if (!raw) dec_stats_load(sstat, lane, stv);
    float acc[2]; if (!dec_gemm_split(A, Wt + (size_t)(32 * u) * K, K, sp, red, wave, lane, acc)) return;
    sc += wave * 64;
    if (!raw) dec_stats_finish(stv, sc, lane);
#pragma unroll
    for (int ii = 0; ii < 2; ++ii) { const int row = crow(2 * wave + ii, hi); float mu = 0.f, rs = 1.f; if (!raw) { mu = sc[2 * row]; rs = sc[2 * row + 1]; }
        const float x = ((ii ? sv1 : sv0) - mu) * rs * gg + bb; const float t = ALPHA * x + acc[ii];
        T[(size_t)row * DM + n] = t; XB[(size_t)row * DM + n] = (bf16)f2bf(t); if (shiftout) shiftout[(size_t)row * DM + n] = x;
        float s = t, q = t * t;
#pragma unroll
        for (int o = 1; o < 32; o <<= 1) { s += __shfl_xor(s, o); q += __shfl_xor(q, o); }
        if (r32 == 0) { ostat[((size_t)row * 32 + u) * 2] = s; ostat[((size_t)row * 32 + u) * 2 + 1] = q; } }
    LDS_WAIT();
}
DI void dec_unit_up(const DecP& D, int u, const DecSplit& sp, LAS float* red, LAS float* sc, int wave, int lane) {
    const int r32 = lane & 31, hi = lane >> 5, n = 32 * u + r32;
    const float c1 = D.c1up[n], c2 = D.c2up[n]; bf16* HB = (bf16*)(D.dec + DEC_HB);
    f32x4 stv[8]; dec_stats_load((const float*)(D.dec + DEC_ST1), lane, stv);
    float acc[2]; if (!dec_gemm_split((const bf16*)(D.dec + DEC_XB1), D.wup + (size_t)(32 * u) * DM, DM, sp, red, wave, lane, acc)) return;
    sc += wave * 64;
    dec_stats_finish(stv, sc, lane);
#pragma unroll
    for (int ii = 0; ii < 2; ++ii) { const int row = crow(2 * wave + ii, hi); const float v = fmaxf((acc[ii] - sc[2 * row] * c1) * sc[2 * row + 1] + c2, 0.f); HB[(size_t)row * FFD + n] = (bf16)f2bf(v * v); }
    LDS_WAIT();
}
DI void dec_attn_task(const DecP& D, const float* ck, const float* cv, const float* rope, int bd, int h, int p, int lane) {
    const int g = lane >> 4, dq = lane & 15, dd = 1 << (2 * p);
    const float* PD = (const float*)(D.dec + DEC_PD) + (size_t)bd * NIN;
    const f32x4 rr0 = *(const f32x4*)(rope + ((size_t)8192 * 32 + ((4 * dq) & 31)) * 2), rr1 = *(const f32x4*)(rope + ((size_t)8192 * 32 + ((4 * dq) & 31)) * 2 + 4);
    const f32x4 cs = {rr0[0], rr0[2], rr1[0], rr1[2]}, sn = {rr0[1], rr0[3], rr1[1], rr1[3]};
    const float sgn = dq < 8 ? -1.f : 1.f;
    f32x4 q = *(const f32x4*)(PD + h * 64 + 4 * dq), kn = *(const f32x4*)(PD + 512 + h * 64 + 4 * dq); const f32x4 vn = *(const f32x4*)(PD + 1024 + h * 64 + 4 * dq);
    { f32x4 qp, kp;
#pragma unroll
      for (int e = 0; e < 4; ++e) { qp[e] = __shfl_xor(q[e], 8); kp[e] = __shfl_xor(kn[e], 8); }
      q = q * cs + qp * sn * sgn; kn = kn * cs + kp * sn * sgn; }
    if (p == 0 && g == 0) { *(f32x4*)(D.out + O_KS + ((size_t)D.l * MD + bd) * 512 + h * 64 + 4 * dq) = kn; *(f32x4*)(D.out + O_VS + ((size_t)D.l * MD + bd) * 512 + h * 64 + 4 * dq) = vn; }
    float s0 = (q[0] * kn[0] + q[1] * kn[1]) + (q[2] * kn[2] + q[3] * kn[3]);
#pragma unroll
    for (int o = 1; o < 16; o <<= 1) s0 += __shfl_xor(s0, o);
    s0 *= 0.125f;
    const size_t cbase = (((size_t)D.l * MD + bd) * 2048) * 512 + h * 64 + 4 * dq;
    float mx = -INFINITY, den = 0.f; f32x4 o4 = {0.f, 0.f, 0.f, 0.f};
    f32x4 kA[8], vA[8], kB[8], vB[8];
#define DA_LOAD(kx_, vx_, itb_) do { _Pragma("unroll") for (int u = 0; u < 8; ++u) { const int j = 1 + 4 * ((itb_) * 8 + u) + g; const size_t off = cbase + (size_t)(2048 - j * dd) * 512; kx_[u] = ldf4nt(ck + off); vx_[u] = ldf4nt(cv + off); } } while (0)
#define DA_STEP(kx_, vx_) do { _Pragma("unroll") for (int u = 0; u < 8; ++u) { const f32x4 kr = kx_[u], vr = vx_[u]; \
        float s = (q[0] * kr[0] + q[1] * kr[1]) + (q[2] * kr[2] + q[3] * kr[3]); \
        _Pragma("unroll") for (int o = 1; o < 16; o <<= 1) s += __shfl_xor(s, o); \
        s *= 0.125f; \
        const float mn = fmaxf(mx, s), sc = fexp(mx - mn), pj = fexp(s - mn); \
        den = den * sc + pj; o4 = o4 * sc + vr * pj; mx = mn; } } while (0)
    DA_LOAD(kA, vA, 0); DA_LOAD(kB, vB, 1);
    DA_STEP(kA, vA); DA_LOAD(kA, vA, 2);
    DA_STEP(kB, vB); DA_LOAD(kB, vB, 3);
    DA_STEP(kA, vA); DA_STEP(kB, vB);
#undef DA_LOAD
#undef DA_STEP
    float mg = fmaxf(mx, __shfl_xor(mx, 16)); mg = fmaxf(mg, __shfl_xor(mg, 32)); mg = fmaxf(mg, s0);
    { const float sc = fexp(mx - mg); den *= sc; o4 = o4 * sc; }
    den += __shfl_xor(den, 16); den += __shfl_xor(den, 32);
#pragma unroll
    for (int e = 0; e < 4; ++e) { o4[e] += __shfl_xor(o4[e], 16); o4[e] += __shfl_xor(o4[e], 32); }
    const float p0 = fexp(s0 - mg); den += p0; o4 = (o4 + vn * p0) * (1.0f / den); mx = mg;
    if (g == 0) *(f32x4*)((float*)(D.dec + DEC_OP) + ((size_t)p * MD + bd) * 512 + h * 64 + 4 * dq) = o4;
    if (lane == 0) ((float*)(D.dec + DEC_LSE))[((size_t)p * MD + bd) * 8 + h] = mx + __logf(den);
}
DI void dec_rwkv_task(const DecP& D, const float* const* in, int bd, int h, LAS float* sv  , int lane) {
    const int l = D.l, ch = h * 64 + lane;
    const float* PD = (const float*)(D.dec + DEC_PD) + (size_t)bd * NIN + RW0; const float* PS = (const float*)(D.dec + DEC_PS) + (size_t)bd * NRWU;
    const float* mu = in[8] + (size_t)l * 1792;
    auto zf = [&](int col) { const float pr = PD[col], pv = PS[col]; return pr + (pv - pr) * mu[col]; };
    const float zr = zf(ch), zk = zf(512 + ch), zv0 = zf(1024 + ch);
    float vl = 0.f; if (l > 0 && lane < 32) { const float pr = PD[1792 + lane], pv = PS[1792 + lane]; vl = pr + (pv - pr) * in[9][(size_t)(l - 1) * 32 + lane]; }
    sv[lane] = ftanh(zf(1536 + lane)); sv[64 + lane] = zf(1600 + lane); sv[128 + lane] = fsigmoid(zf(1664 + lane)); sv[192 + lane] = fsigmoid(zf(1728 + lane)); sv[256 + lane] = vl;
    LDS_WAIT();
    float dw = 0.f, da = 0.f, dv = 0.f, gt = 0.f;
    { const unsigned char* wsb = D.dec - WS_DEC;
      const bf16* du = (const bf16*)(wsb + WS_DUPT) + ((size_t)l * 512 + ch) * 64; const bf16* iu = (const bf16*)(wsb + WS_IUPT) + ((size_t)l * 512 + ch) * 64; const bf16* gu = (const bf16*)(wsb + WS_GUPT) + ((size_t)l * 512 + ch) * 128;
#define DOT8(acc_, t_, base_) do { const f32x4 x0_ = *(const LAS f32x4*)(sv + (base_)), x1_ = *(const LAS f32x4*)(sv + (base_) + 4); \
        acc_ += (x0_[0] * bflo((t_).x) + x0_[1] * bfhi((t_).x)) + (x0_[2] * bflo((t_).y) + x0_[3] * bfhi((t_).y)) + (x1_[0] * bflo((t_).z) + x1_[1] * bfhi((t_).z)) + (x1_[2] * bflo((t_).w) + x1_[3] * bfhi((t_).w)); \
        asm volatile("" : "+v"(acc_) :: "memory"); } while (0)
      { v4u tu[8], ti[8];
#pragma unroll
        for (int i = 0; i < 8; ++i) { tu[i] = *(const v4u*)(du + 8 * i); ti[i] = *(const v4u*)(iu + 8 * i); }
        asm volatile("" ::: "memory");
#pragma unroll
        for (int i = 0; i < 8; ++i) { DOT8(dw, tu[i], 8 * i); DOT8(da, ti[i], 64 + 8 * i); } }
      { v4u tg[16], tv[4];
#pragma unroll
        for (int i = 0; i < 16; ++i) tg[i] = *(const v4u*)(gu + 8 * i);
#pragma unroll
        for (int i = 0; i < 4; ++i) tv[i] = (v4u){0u, 0u, 0u, 0u};
        if (l > 0) { const bf16* vu = (const bf16*)(wsb + WS_VUPT) + ((size_t)(l - 1) * 512 + ch) * 32;
#pragma unroll
            for (int i = 0; i < 4; ++i) tv[i] = *(const v4u*)(vu + 8 * i); }
        asm volatile("" ::: "memory");
#pragma unroll
        for (int i = 0; i < 16; ++i) DOT8(gt, tg[i], 128 + 8 * i);
#pragma unroll
        for (int i = 0; i < 4; ++i) DOT8(dv, tv[i], 256 + 8 * i); }
#undef DOT8
    }
    const float w = -fsoftplus(-(in[10][(size_t)l * 512 + ch] + dw)) - 0.5f, decay = fexp(-fexp(w));
    const float a = fsigmoid(in[12][(size_t)l * 512 + ch] + da);
    float* VFD = (float*)(D.dec + DEC_VF) + (size_t)bd * 512 + ch;
    float v = zv0; if (l == 0) *VFD = zv0; else v = zv0 + (*VFD - zv0) * fsigmoid(in[15][(size_t)(l - 1) * 512 + ch] + dv);
    const float kr = zk * in[17][(size_t)l * 512 + ch]; const float kn = kr / fmaxf(sqrtf(wave_sum(kr * kr)), 1e-12f);
    const float k2 = zk * (1.f + (a - 1.f) * in[18][(size_t)l * 512 + ch]);
    const float bon = wave_sum(zr * k2 * in[19][(size_t)l * 512 + ch]);
    LDS_WAIT();
    sv[320 + lane] = -kn; sv[384 + lane] = decay; sv[448 + lane] = kn * a; sv[512 + lane] = k2; sv[576 + lane] = zr; sv[640 + lane] = v;
    LDS_WAIT();
    const float* S0 = in[3] + (((size_t)l * MD + bd) * NH + h) * 4096;
    float* So = D.out + O_WKS + (((size_t)l * MD + bd) * NH + h) * 4096;
    { const int rr = lane >> 4, cq = lane & 15;
      const f32x4 a4 = *(const LAS f32x4*)(sv + 320 + 4 * cq), w4 = *(const LAS f32x4*)(sv + 384 + 4 * cq), b4 = *(const LAS f32x4*)(sv + 448 + 4 * cq), k4 = *(const LAS f32x4*)(sv + 512 + 4 * cq), r4 = *(const LAS f32x4*)(sv + 576 + 4 * cq);
      f32x4 Sr[16];
#pragma unroll
      for (int q = 0; q < 16; ++q) Sr[q] = *(const f32x4*)(S0 + (size_t)(4 * q + rr) * 64 + 4 * cq);
#pragma unroll
      for (int q = 0; q < 16; ++q) { const int i = 4 * q + rr;
          float sa = (Sr[q][0] * a4[0] + Sr[q][1] * a4[1]) + (Sr[q][2] * a4[2] + Sr[q][3] * a4[3]);
#pragma unroll
          for (int o = 1; o < 16; o <<= 1) sa += __shfl_xor(sa, o);
          const float vi = sv[640 + i];
          const f32x4 s4 = Sr[q] * w4 + b4 * sa + k4 * vi; *(f32x4*)(So + (size_t)i * 64 + 4 * cq) = s4;
          float yp = (s4[0] * r4[0] + s4[1] * r4[1]) + (s4[2] * r4[2] + s4[3] * r4[3]);
#pragma unroll
          for (int o = 1; o < 16; o <<= 1) yp += __shfl_xor(yp, o);
          if (cq == 0) sv[704 + i] = yp; } }
    LDS_WAIT();
    const float y = sv[704 + lane];
    const float mean = wave_sum(y) * (1.f / 64.f), dy = y - mean, var = wave_sum(dy * dy) * (1.f / 64.f);
    const float o = (dy * (1.0f / sqrtf(var + GN_EPS)) * in[20][(size_t)l * 512 + ch] + in[21][(size_t)l * 512 + ch] + bon * v) * gt;
    ((float*)(D.dec + DEC_MIX))[(size_t)bd * DM + 512 + ch] = o;
    LDS_WAIT();
}
DI void dec_finalize_row(const DecP& D, const float* gain, int bd, int lane) {
    const int h = lane >> 3; const float* L = (const float*)(D.dec + DEC_LSE); const float* OPD = (const float*)(D.dec + DEC_OP);
    const float l0 = L[((size_t)0 * MD + bd) * 8 + h], l1 = L[((size_t)1 * MD + bd) * 8 + h], l2 = L[((size_t)2 * MD + bd) * 8 + h];
    const float mx = fmaxf(l0, fmaxf(l1, l2)); float w0 = fexp(l0 - mx), w1 = fexp(l1 - mx), w2 = fexp(l2 - mx); const float inv = 1.0f / (w0 + w1 + w2); w0 *= inv; w1 *= inv; w2 *= inv;
    float v[8]; float ss = 0.f;
#pragma unroll
    for (int e = 0; e < 8; ++e) { v[e] = w0 * OPD[((size_t)0 * MD + bd) * 512 + lane * 8 + e] + w1 * OPD[((size_t)1 * MD + bd) * 512 + lane * 8 + e] + w2 * OPD[((size_t)2 * MD + bd) * 512 + lane * 8 + e]; ss += v[e] * v[e]; }
    ss = wave_sum(ss); const float rinv = 1.0f / sqrtf(ss * (1.f / 512.f) + RMS_EPS);
    bf16* MB = (bf16*)(D.dec + DEC_MIXB) + (size_t)bd * DM; const float* MX = (const float*)(D.dec + DEC_MIX) + (size_t)bd * DM + 512;
#pragma unroll
    for (int e = 0; e < 8; ++e) { MB[lane * 8 + e] = (bf16)f2bf(v[e] * rinv * gain[lane * 8 + e]); MB[512 + lane * 8 + e] = (bf16)f2bf(MX[lane * 8 + e]); }
}
#ifndef PH_MASK
#define PH_MASK 0x1ff
#endif
#define PH_ON(k) ((PH_MASK >> (k)) & 1)
#ifndef PH_DUP
#define PH_DUP 0
#endif
#define PH_REP(k) for (int rep_ = 0; rep_ < (((PH_DUP >> (k)) & 1) ? 2 : 1); ++rep_)
DI unsigned lds_task_next(volatile LAS unsigned* ctr, int lane) {
    unsigned t = 0; if (lane == 0) t = __hip_atomic_fetch_add((LAS unsigned*)ctr, 1u, __ATOMIC_RELAXED, __HIP_MEMORY_SCOPE_WORKGROUP);
    return (unsigned)__builtin_amdgcn_readfirstlane((int)t);
}
DI DecP make_dec(unsigned char* ws, const float* const* in, float* out, int l) {
    DecP D; D.dec = ws + WS_DEC; D.l = l; D.xs = in[1];
    D.c1in = (const float*)(ws + WS_C1IN) + l * NIN; D.c2in = (const float*)(ws + WS_C2IN) + l * NIN; D.c1up = (const float*)(ws + WS_C1UP) + l * FFD; D.c2up = (const float*)(ws + WS_C2UP) + l * FFD;
    D.g1 = in[24] + (size_t)l * DM; D.b1 = in[25] + (size_t)l * DM; D.g2p = l > 0 ? in[28] + (size_t)(l - 1) * DM : nullptr; D.b2p = l > 0 ? in[29] + (size_t)(l - 1) * DM : nullptr;
    D.win = (const bf16*)(ws + WS_WIN) + (size_t)l * NIN * DM; D.winu = (const bf16*)(ws + WS_WINU) + (size_t)l * NRWU * DM; D.wout = (const bf16*)(ws + WS_WOUT) + (size_t)l * DM * DM;
    D.wup = (const bf16*)(ws + WS_WUP) + (size_t)l * FFD * DM; D.wdn = (const bf16*)(ws + WS_WDN) + (size_t)l * DM * FFD; D.out = out; return D;
}
DI RwkvP make_rwkv(unsigned char* ws, const float* const* in, int l) {
    RwkvP R; R.PR = (const bf16*)(ws + WS_PR); R.mu = in[8] + (size_t)l * 1792; R.muv = l > 0 ? in[9] + (size_t)(l - 1) * 32 : nullptr;
    R.dbase = in[10] + (size_t)l * 512; R.ibase = in[12] + (size_t)l * 512; R.vbase = l > 0 ? in[15] + (size_t)(l - 1) * 512 : nullptr; R.ksk = in[17] + (size_t)l * 512; R.ksa = in[18] + (size_t)l * 512; R.brk = in[19] + (size_t)l * 512;
    R.gng = in[20] + (size_t)l * 512; R.gnb = in[21] + (size_t)l * 512;
    R.dupT = (const bf16*)(ws + WS_DUPT) + (size_t)l * 512 * 64; R.iupT = (const bf16*)(ws + WS_IUPT) + (size_t)l * 512 * 64; R.vupT = l > 0 ? (const bf16*)(ws + WS_VUPT) + (size_t)(l - 1) * 512 * 32 : nullptr; R.gupT = (const bf16*)(ws + WS_GUPT) + (size_t)l * 512 * 128;
    R.ZROW = (const bf16*)(ws + WS_CTL + 512 * 1024); R.VF = (bf16*)(ws + WS_VF); R.VV = (bf16*)(ws + WS_VV); R.BON = (float*)(ws + WS_BON); R.GC = (float*)(ws + WS_GC); R.W1S = (bf16*)(ws + WS_PT); R.REFF = (bf16*)(ws + WS_REFF); R.BM = (bf16*)(ws + WS_QT); R.REC = (v4u*)(ws + WS_YLOC);
    R.YPRE = (float*)(ws + WS_YPRE); R.MIX = (bf16*)(ws + WS_MIX); R.layer0 = (l == 0); return R;
}
#define PHASE_VARS() int tid_p = (int)threadIdx.x; asm volatile("" : "+v"(tid_p)); const int lane = tid_p & 63; const int wave = __builtin_amdgcn_readfirstlane(tid_p >> 6); \
    unsigned zo_p; asm volatile("s_mov_b32 %0, 0" : "=s"(zo_p)); unsigned char* ws = args.ws + zo_p; const float* const* in = args.in + zo_p; float* out = args.out + zo_p; \
    const int gw = F.vcu * NWAVES + wave; const int rgw = (F.G - 1 - (int)blockIdx.x) * NWAVES + wave; LAS float* dsc = (LAS float*)(L3 + 65536); LAS float* dred = (LAS float*)L3; const int rwg = F.G - 1 - (int)blockIdx.x; (void)gw; (void)rgw; (void)dsc; (void)dred; (void)rwg; (void)lane; (void)in; (void)out
__global__ void __launch_bounds__(NWAVES * 64, 2) mega_fwd(Args args) {
    extern __shared__ __attribute__((aligned(16))) unsigned char lds[];
    Frame F;
    F.lds = lds; F.MISC = (volatile LAS unsigned*)((LAS unsigned char*)lds + MISC_OFF);
    F.tid = threadIdx.x; F.lane = F.tid & 63; F.wave = __builtin_amdgcn_readfirstlane(F.tid >> 6);
    F.G = gridDim.x; { const int bx = blockIdx.x; F.vcu = (F.G % 8 == 0) ? (bx % 8) * (F.G / 8) + bx / 8 : bx; }
    F.gw = F.vcu * NWAVES + F.wave; F.NGW = F.G * NWAVES;
    F.in = args.in; F.out = args.out; F.ws = args.ws; F.ctl = (gu32*)(args.ws + WS_CTL);
    LAS unsigned char* L3 = (LAS unsigned char*)lds;
    for (int u = F.tid; u < (LDS_BYTES - RING_BYTES) / 4; u += NWAVES * 64) ((LAS unsigned*)(L3 + RING_BYTES))[u] = 0u;
    __syncthreads();
    XcdBarrier bar = xcd_barrier_post((unsigned*)(F.ctl + CW_BAR), F.MISC + 8);
#define GRID_BAR() do { XcdBarrier b2_ = bar; asm volatile("" : "+s"(b2_.x)); xcd_barrier(b2_); } while (0)

    PH_REP(0) { if (PH_ON(0)) p0_prologue(F);
    GRID_BAR(); }

#ifdef PROBE_MODE
#define TSB(on) do { if ((on) && l == PROBE_L) { __syncthreads(); if (__builtin_amdgcn_readfirstlane(F.tid >> 6) == 0) { const unsigned tl_ = (unsigned)__builtin_amdgcn_s_memrealtime(); const unsigned so_ = 790528u + (unsigned)blockIdx.x * 4u; \
        asm volatile("s_store_dword %0, %1, %2\n\ts_waitcnt lgkmcnt(0)\n\ts_dcache_wb\n\ts_waitcnt lgkmcnt(0)" :: "s"(tl_), "s"(args.ws), "s"(so_) : "memory"); } } } while (0)
#else
#define TSB(on) do {} while (0)
#endif
#ifdef PROBE_A
#define TS(i) do { if (l == 1 && blockIdx.x == PROBE_WG) { const unsigned tl_ = (unsigned)__builtin_amdgcn_s_memrealtime(); const unsigned so_ = 786432u + (unsigned)((i) * 8 + __builtin_amdgcn_readfirstlane(F.tid >> 6)) * 4u; \
        asm volatile("s_store_dword %0, %1, %2\n\ts_waitcnt lgkmcnt(0)" :: "s"(tl_), "s"(args.ws), "s"(so_) : "memory"); } } while (0)
#else
#define TS(i) do {} while (0)
#endif
    for (int l = 0; l < DEPTH; ++l) {
        PH_REP(1) {
        if (PH_ON(1))
        {   PHASE_VARS(); const DecP D = make_dec(ws, in, out, l);
            pg8::Gemm g{(const pg8::bf16_t*)(ws + WS_XB2), (const pg8::bf16_t*)D.win, M, NIN, DM}; pg8::StaticOrder S; S.init(M, NIN, F.G, (int)blockIdx.x);
            pg8::etab_fill((PG8_LAS unsigned char*)L3, S, (const float*)(ws + WS_STAT2), D.c1in, D.c2in, l > 0, tid_p); __syncthreads();
            pg8::EpiIn E{ws, out, l, (const PG8_LAS unsigned char*)L3};
            pg8::gemm_phase<pg8::EpiIn, pg8::StaticOrder, true, true>((PG8_LAS unsigned char*)L3, g, S, E, tid_p);
            if (rwg < 128) for (int u = rwg; u < 162; u += 128) dec_unit_in(D, u, dred, dsc, wave, lane);
        }
        TSB(PROBE_PH == 0);
        GRID_BAR();
        }

#define ATT_QUEUE() do { LAS unsigned char* wl_ = L3 + wave * 10240; const int bh_ = F.vcu >> 4; unsigned* pool_ = (unsigned*)(F.ctl + CW_POOL + (l * 16 + bh_) * 64); \
        for (;;) { unsigned t_ = lds_task_next(F.MISC, lane); int span_ = F.vcu & 15; \
            if (t_ >= 40u) { unsigned q_ = 0u; if (lane == 0) q_ = __hip_atomic_fetch_add(pool_, 1u, __ATOMIC_RELAXED, __HIP_MEMORY_SCOPE_AGENT); q_ = (unsigned)__builtin_amdgcn_readfirstlane((int)q_); \
                if (q_ >= 128u) break; t_ = 40u + (q_ >> 4); span_ = (int)(q_ & 15u); }        \
            const int p_ = (int)t_ >> 4, idx_ = (int)t_ & 15; \
            const int cls_ = p_ == 0 ? 0 : p_ == 1 ? (idx_ >> 2) : idx_, qblk_ = p_ == 0 ? span_ * 16 + idx_ : p_ == 1 ? span_ * 4 + (idx_ & 3) : span_; \
            attn_task((const bf16*)(ws + WS_QB), (const bf16*)(ws + WS_KB), (const bf16*)(ws + WS_VB), (bf16*)(ws + WS_OP), (float*)(ws + WS_LSE), bh_ >> 3, bh_ & 7, p_, cls_, qblk_, wl_, lane); } } while (0)
        PH_REP(3) {
        if (PH_ON(3))
        {   PHASE_VARS(); const DecP D = make_dec(ws, in, out, l); const RwkvP R = make_rwkv(ws, in, l);
            if (tid_p == 0) F.MISC[0] = 0u; TS(0);
            if (l == 0) colsum_finish(ws, gw * 64 + lane, F.NGW * 64);
            { LAS unsigned char* wl1 = L3 + wave * 12288; LAS unsigned char* hc = L3 + 8 * 12288;
              head_cache_fill(R, (F.vcu >> 4) & 7, hc, tid_p);
              __syncthreads();
#pragma unroll 1
              for (int i = 0; i < 4; ++i) rwkv_b1_unit(R, F.vcu * 32 + wave + 8 * i, wl1, hc, (LAS float*)(L3 + GCT_OFF), lane); }
            VM_WAIT(); __syncthreads(); TS(1);
            if (wave < 4) { chain_pass1(R, (float*)(ws + WS_SEGQ), (float*)(ws + WS_SEGP), F.vcu >> 4, F.vcu & 15, wave, (const LAS float*)(L3 + GCT_OFF), lane); TS(2);
                if (wave != 0) { const int dt = (int)blockIdx.x * 3 + (wave - 1); dec_attn_task(D, in[4], in[5], (const float*)(ws + WS_ROPE), dt / 24, (dt % 24) / 3, dt % 3, lane); }
                else dec_rwkv_task(D, in, (int)blockIdx.x >> 3, (int)blockIdx.x & 7, (LAS float*)(L3 + wave * 10240), lane); TS(3); }
            ATT_QUEUE(); TS(4);
            if ((PH_DUP >> 12) & 1) { __syncthreads(); if (tid_p == 0) F.MISC[0] = 0u; __syncthreads(); ATT_QUEUE(); }
        }
        TSB(PROBE_PH == 1);
        GRID_BAR();
        TS(5);
        }
        PH_REP(9) {
        if (PH_ON(3))
        {   PHASE_VARS(); const DecP D = make_dec(ws, in, out, l); const RwkvP R = make_rwkv(ws, in, l);
            const int seq = F.vcu >> 4, sg = F.vcu & 15;
            LAS unsigned char* gcache = L3 + 98304; gate_cache_fill(R, seq & 7, gcache, tid_p);
            for (int e = tid_p; e < SEGCH * 64; e += NWAVES * 64) ((LAS float*)(L3 + GCT_OFF))[e] = R.GC[(size_t)(seq * NCH + sg * SEGCH) * 64 + e];
            __syncthreads();
            if (wave < 4) chain_pass23(R, (const float*)(ws + WS_SEGQ), (const float*)(ws + WS_SEGP), seq, sg, wave, out + O_WKP + ((size_t)l * 16 + seq) * 4096, (const LAS float*)(L3 + GCT_OFF), lane);
            else { for (int i = 0; i < 16; ++i) attn_finalize_row((const bf16*)(ws + WS_OP), (const float*)(ws + WS_LSE), in[22] + (size_t)l * 512, (bf16*)(ws + WS_MIX), (int)blockIdx.x * 64 + (wave - 4) * 16 + i, lane);
                if (blockIdx.x < MD && wave == 4) dec_finalize_row(D, in[22] + (size_t)l * 512, (int)blockIdx.x, lane); }
            VM_WAIT(); __syncthreads();
#pragma unroll 1
            for (int i = 0; i < 4; ++i) rwkv_b3_unit(R, seq * NCH + sg * SEGCH + wave + 8 * i, gcache, L3 + wave * 12288, lane);
        }
        TSB(PROBE_PH == 2);
        GRID_BAR();
        }

        PH_REP(5) {
        if (PH_ON(5))
        {   PHASE_VARS(); const DecP D = make_dec(ws, in, out, l);
            pg8::Gemm g{(const pg8::bf16_t*)(ws + WS_MIX), (const pg8::bf16_t*)D.wout, M, DM, DM}; pg8::StaticOrder S; S.init(M, DM, F.G, (int)blockIdx.x);
            pg8::EpiRes<false> E{ws, in, out, l};
            pg8::gemm_phase<pg8::EpiRes<false>, pg8::StaticOrder, false, true>((PG8_LAS unsigned char*)L3, g, S, E, tid_p);
            { const int u = rwg & 31; const DecSplit sp{rwg >> 5, 8, (float*)(ws + WS_T1) + (size_t)u * 8192, (unsigned*)(F.ctl + CW_DCNT + (l * 3 + 0) * 128 + u), F.MISC + 1};
                dec_unit_res((const bf16*)(D.dec + DEC_MIXB), D.wout, DM, u, l == 0, l == 0 ? D.xs : (const float*)(D.dec + DEC_T2), (const float*)(D.dec + DEC_ST2), D.g2p, D.b2p, (float*)(D.dec + DEC_T1), (bf16*)(D.dec + DEC_XB1), (float*)(D.dec + DEC_ST1),
                             out + O_SHS + (size_t)l * MD * DM, sp, dred, dsc, wave, lane); }
        }
        TSB(PROBE_PH == 3);
        GRID_BAR();
        }

        PH_REP(6) {
        if (PH_ON(6))
        {   PHASE_VARS(); const DecP D = make_dec(ws, in, out, l);
            pg8::Gemm g{(const pg8::bf16_t*)(ws + WS_XB1), (const pg8::bf16_t*)D.wup, M, FFD, DM}; pg8::StaticOrder S; S.init(M, FFD, F.G, (int)blockIdx.x);
            pg8::etab_fill((PG8_LAS unsigned char*)L3, S, (const float*)(ws + WS_STAT1), D.c1up, D.c2up, true, tid_p); __syncthreads();
            pg8::EpiUp E{ws, (const PG8_LAS unsigned char*)L3};
            pg8::gemm_phase<pg8::EpiUp, pg8::StaticOrder, true, true>((PG8_LAS unsigned char*)L3, g, S, E, tid_p);
            { const int u = rwg & 127; const DecSplit sp{rwg >> 7, 2, (float*)(ws + WS_T1) + (size_t)u * 2048, (unsigned*)(F.ctl + CW_DCNT + (l * 3 + 1) * 128 + u), F.MISC + 1}; dec_unit_up(D, u, sp, dred, dsc, wave, lane); }
        }
        TSB(PROBE_PH == 4);
        GRID_BAR();
        }

        PH_REP(7) {
        if (PH_ON(7))
        {   PHASE_VARS(); const DecP D = make_dec(ws, in, out, l);
            pg8::Gemm g{(const pg8::bf16_t*)(ws + WS_H), (const pg8::bf16_t*)D.wdn, M, DM, FFD}; pg8::StaticOrder S; S.init(M, DM, F.G, (int)blockIdx.x);
            pg8::EpiRes<true> E{ws, in, out, l};
            PH_REP(11) { pg8::gemm_phase<pg8::EpiRes<true>, pg8::StaticOrder, false, true>((PG8_LAS unsigned char*)L3, g, S, E, tid_p); }
            { const int u = rwg & 31; const DecSplit sp{rwg >> 5, 8, (float*)(ws + WS_T1) + (size_t)u * 8192, (unsigned*)(F.ctl + CW_DCNT + (l * 3 + 2) * 128 + u), F.MISC + 1};
                dec_unit_res((const bf16*)(D.dec + DEC_HB), D.wdn, FFD, u, false, (const float*)(D.dec + DEC_T1), (const float*)(D.dec + DEC_ST1), D.g1, D.b1, (float*)(D.dec + DEC_T2), (bf16*)(D.dec + DEC_XB2), (float*)(D.dec + DEC_ST2), nullptr, sp, dred, dsc, wave, lane); }
        }
        TSB(PROBE_PH == 5);
        GRID_BAR();
        }
    }
    if (PH_ON(8))
    {   PHASE_VARS(); const float* g = in[28] + (size_t)3 * DM; const float* b = in[29] + (size_t)3 * DM;
        for (int r = gw; r < M; r += F.NGW) { float mu, rs; pg8::row_stats((const float*)(ws + WS_STAT2), r, mu, rs);
            const v2u* t = (const v2u*)((const bf16*)(ws + WS_XB2) + (size_t)r * DM) + lane; f32x4* o = (f32x4*)(out + O_Y + (size_t)r * DM) + lane;
#pragma unroll
            for (int j = 0; j < 4; ++j) { const f32x4 gg = *((const f32x4*)g + lane + 64 * j), bb = *((const f32x4*)b + lane + 64 * j); const v2u w = t[64 * j]; const f32x4 tv = {bflo(w.x), bfhi(w.x), bflo(w.y), bfhi(w.y)}; o[64 * j] = (tv - mu) * rs * gg + bb; } }
        if (rgw < MD) { LAS float* fsc = dsc + wave * 64; dec_row_stats((const float*)(ws + WS_DEC + DEC_ST2), fsc, lane); const float mu = fsc[2 * rgw], rs = fsc[2 * rgw + 1];
            const f32x4* t = (const f32x4*)((const float*)(ws + WS_DEC + DEC_T2) + (size_t)rgw * DM) + lane; f32x4* o = (f32x4*)(out + O_YS + (size_t)rgw * DM) + lane;
#pragma unroll
            for (int j = 0; j < 4; ++j) { const f32x4 gg = *((const f32x4*)g + lane + 64 * j), bb = *((const f32x4*)b + lane + 64 * j); o[64 * j] = (t[64 * j] - mu) * rs * gg + bb; } }
    }
#ifdef PROBE_A
    if (blockIdx.x == PROBE_WG) { unsigned a_, b_;
        asm volatile("s_dcache_wb\n\ts_load_dword %0, %2, %3 glc\n\ts_load_dword %1, %2, %4 glc\n\ts_waitcnt lgkmcnt(0)" : "=&s"(a_), "=&s"(b_) : "s"(args.ws), "s"(786432u + PROBE_A * 4u), "s"(786432u + PROBE_B * 4u) : "memory");
        const unsigned d_ = (b_ - a_) * 64u; const unsigned t0_ = (unsigned)__builtin_amdgcn_s_memrealtime();
        while ((unsigned)__builtin_amdgcn_s_memrealtime() - t0_ < d_) { __builtin_amdgcn_s_sleep(8); } }
#endif
#ifdef PROBE_MODE
    if (blockIdx.x == 0) { unsigned mx = 0u, mn = 0xffffffffu, amx = 0u, amn = 0u, cnt = 0u;
        for (unsigned i = 0; i < 256u; ++i) { unsigned v; asm volatile("s_load_dword %0, %1, %2 glc\n\ts_waitcnt lgkmcnt(0)" : "=s"(v) : "s"(args.ws), "s"(790528u + i * 4u) : "memory"); if (v > mx) { mx = v; amx = i; } if (v < mn) { mn = v; amn = i; } }
        for (unsigned i = 0; i < 256u; ++i) { unsigned v; asm volatile("s_load_dword %0, %1, %2 glc\n\ts_waitcnt lgkmcnt(0)" : "=s"(v) : "s"(args.ws), "s"(790528u + i * 4u) : "memory"); if (PROBE_MODE == 7) cnt += mx - v; else if (v + PROBE_THR * 100u > mx && (PROBE_MODE != 5 || i >= 192u) && (PROBE_MODE != 6 || (i & 7u) == (amx & 7u))) ++cnt; }
        const unsigned d_ = PROBE_MODE == 7 ? cnt / 4u : PROBE_MODE == 1 ? amx * 1000u : PROBE_MODE == 2 ? (mx - mn) * 64u : (PROBE_MODE == 3 || PROBE_MODE == 5 || PROBE_MODE == 6) ? cnt * 1000u : amn * 1000u; const unsigned t0_ = (unsigned)__builtin_amdgcn_s_memrealtime();
        while ((unsigned)__builtin_amdgcn_s_memrealtime() - t0_ < d_) { __builtin_amdgcn_s_sleep(8); } }
#endif
}

extern "C" void kernel_launch(void* const* d_in, const int* in_sizes, int n_in, void* d_out, int out_size, void* d_ws, size_t ws_size, hipStream_t stream) {
    static int grid = 0;
    if (grid == 0) {
        if (n_in != 30 || out_size != (int)O_END || ws_size < WS_END) { fprintf(stderr, "kernel_launch: unexpected problem (n_in %d, out %d, ws %zu); nothing launched\n", n_in, out_size, ws_size); grid = -1; return; }
        int dev = 0, cus = 0, per_cu = 0;
        if (hipGetDevice(&dev) != hipSuccess || hipDeviceGetAttribute(&cus, hipDeviceAttributeMultiprocessorCount, dev) != hipSuccess) { fprintf(stderr, "kernel_launch: device query failed\n"); grid = -1; return; }
        if (hipFuncSetAttribute((const void*)mega_fwd, hipFuncAttributeMaxDynamicSharedMemorySize, LDS_BYTES) != hipSuccess) { fprintf(stderr, "kernel_launch: hipFuncSetAttribute failed\n"); grid = -1; return; }
        if (hipOccupancyMaxActiveBlocksPerMultiprocessor(&per_cu, (const void*)mega_fwd, NWAVES * 64, LDS_BYTES) != hipSuccess || per_cu < 1) fprintf(stderr, "kernel_launch: occupancy query reports %d\n", per_cu);
        (void)hipGetLastError();
        if (cus < 256) { fprintf(stderr, "kernel_launch: needs 256 CUs (found %d)\n", cus); grid = -1; return; }
        grid = 256;
    }
    if (grid < 0) return;
    if (hipMemsetAsync((char*)d_ws + WS_CTL, 0, CTL_ZERO_BYTES, stream) != hipSuccess) { fprintf(stderr, "kernel_launch: memset failed\n"); return; }
    Args a{};
    for (int i = 0; i < 30; ++i) a.in[i] = (const float*)d_in[i];
    a.out = (float*)d_out; a.ws = (unsigned char*)d_ws;
    hipLaunchKernelGGL(mega_fwd, dim3(grid), dim3(NWAVES * 64), LDS_BYTES, stream, a);
    const hipError_t le = hipPeekAtLastError();
    if (le != hipSuccess) fprintf(stderr, "kernel_launch: launch failed: %s\n", hipGetErrorName(le));
}
```
